# Optimizing an MI355X kernel written in HIP

```python
import jax, jax.numpy as jnp
from jax import lax
import numpy as np

D_MODEL = 1024
BATCH = 32
SEQ = 2048
DEPTH = 1

CHUNK = 64
Q_BLOCK = 128
SB_HEADS = 8
SB_HEAD_DIM = 64
DSA_HEADS = 8
DSA_HEAD_DIM = 64
IDX_HEADS = 4
IDX_HEAD_DIM = 64
DSA_TOPK_MAX = 256
MEM_LEN = 256
MEM_HEADS = 4
MEM_HEAD_DIM = 128
N_BRANCH = 3
N_EXPERTS = 32
TOP_K = 4
D_EXPERT = D_MODEL
SWIGLU_LIMIT = 7.0
SWIGLU_ALPHA = 1.702
ROPE_THETA = 10000.0
EPS = 1e-6
MOE_BLOCK = 512

SB_W = SB_HEADS * SB_HEAD_DIM
DSA_W = DSA_HEADS * DSA_HEAD_DIM
IDX_QW = IDX_HEADS * IDX_HEAD_DIM
MEM_W = MEM_HEADS * MEM_HEAD_DIM
BRANCH_WIDTH = SB_W
IN_SIZES = (SB_W, SB_W, SB_W, DSA_W, DSA_HEAD_DIM, DSA_HEAD_DIM, IDX_QW, IDX_HEAD_DIM, IDX_HEADS, MEM_W)
IN_WIDTH = sum(IN_SIZES)

kernel_name = "hybrid_stickbreak_dsa_memory_moe_layer"


def rms_norm(x, g):
    xf = x.astype(jnp.float32)
    y = xf * lax.rsqrt(jnp.mean(xf * xf, axis=-1, keepdims=True) + EPS)
    return (y * g.astype(jnp.float32)).astype(x.dtype)


def rope(x, pos):
    half = x.shape[-1] // 2
    inv = ROPE_THETA ** (-jnp.arange(half, dtype=jnp.float32) / half)
    ang = pos.astype(jnp.float32)[:, None] * inv[None, :]
    cos = jnp.cos(ang)[:, None, :]
    sin = jnp.sin(ang)[:, None, :]
    xf = x.astype(jnp.float32)
    x1, x2 = xf[..., :half], xf[..., half:]
    return jnp.concatenate([x1 * cos - x2 * sin, x1 * sin + x2 * cos], axis=-1).astype(x.dtype)


def to_blocks(a):
    return jnp.swapaxes(a.reshape(a.shape[0], -1, Q_BLOCK, *a.shape[2:]), 0, 1)


def from_blocks(o):
    o = jnp.swapaxes(o, 0, 1)
    return o.reshape(o.shape[0], -1, *o.shape[3:])


def stick_breaking_attention(q, k, v):
    S, d = q.shape[1], q.shape[-1]
    scale = d ** -0.5
    kpos = jnp.arange(S)

    def block(args):
        qb, start = args
        qpos = start + jnp.arange(Q_BLOCK)
        z = jnp.einsum('bqhd,bshd->bhqs', qb, k, preferred_element_type=jnp.float32) * scale
        earlier = (kpos[None, :] < qpos[:, None])[None, None]
        log_keep = jnp.where(earlier, jax.nn.log_sigmoid(-z), 0.0)
        between = lax.cumsum(log_keep, axis=3, reverse=True) - log_keep
        w = jnp.where(earlier, jnp.exp(jax.nn.log_sigmoid(z) + between), 0.0)
        return jnp.einsum('bhqs,bshd->bqhd', w.astype(v.dtype), v)

    starts = jnp.arange(S // Q_BLOCK) * Q_BLOCK
    return from_blocks(lax.map(block, (to_blocks(q), starts)))


def dsa_attention(q, k, v, qi, ki, wi, topk):
    S, d = q.shape[1], q.shape[-1]
    scale = d ** -0.5
    kchunk = jnp.arange(S) // CHUNK

    def block(args):
        qb, qib, wib, start = args
        qchunk = (start + jnp.arange(Q_BLOCK)) // CHUNK
        admissible = kchunk[None, :] <= qchunk[:, None]
        idx_logits = jnp.einsum('bqhd,bsd->bhqs', qib, ki,
                                preferred_element_type=jnp.float32) * (IDX_HEAD_DIM ** -0.5)
        score = jnp.einsum('bqh,bhqs->bqs', wib.astype(jnp.float32) * (IDX_HEADS ** -0.5),
                           jax.nn.relu(idx_logits))
        score = jnp.where(admissible[None], score, -jnp.inf)
        _, sel = lax.top_k(score, topk)
        valid = (sel // CHUNK) <= qchunk[None, :, None]
        k_sel = jax.vmap(lambda kb, ib: kb[ib])(k, sel)
        v_sel = jax.vmap(lambda vb, ib: vb[ib])(v, sel)
        s = jnp.einsum('bqhd,bqkd->bhqk', qb, k_sel, preferred_element_type=jnp.float32) * scale
        s = jnp.where(valid[:, None], s, -jnp.inf)
        p = jax.nn.softmax(s, axis=-1)
        return jnp.einsum('bhqk,bqkd->bqhd', p.astype(v.dtype), v_sel)

    starts = jnp.arange(S // Q_BLOCK) * Q_BLOCK
    out = lax.map(block, (to_blocks(q), to_blocks(qi), to_blocks(wi), starts))
    return from_blocks(out)


def memory_attention(q, mk, mv):
    scale = q.shape[-1] ** -0.5
    s = jnp.einsum('bshd,bmhd->bhsm', q, mk, preferred_element_type=jnp.float32) * scale
    p = jax.nn.softmax(s, axis=-1)
    return jnp.einsum('bhsm,bmhd->bshd', p.astype(mv.dtype), mv)


def moe_ffn(h, w_router, b_router, w_e_in, b_e_in, w_e_out, b_e_out):
    B, S, D = h.shape
    N = B * S
    xt = h.reshape(N, D)
    logits = jnp.dot(xt, w_router, preferred_element_type=jnp.float32) + b_router.astype(jnp.float32)
    top_val, top_idx = lax.top_k(logits, TOP_K)
    gate = jax.nn.softmax(top_val, axis=-1)
    A = N * TOP_K
    flat_e = top_idx.reshape(A)
    flat_tok = jnp.arange(A, dtype=jnp.int32) // TOP_K
    flat_w = gate.reshape(A)
    order = jnp.argsort(flat_e)
    se = flat_e[order]
    counts = jnp.bincount(flat_e, length=N_EXPERTS)
    padded = (counts + MOE_BLOCK - 1) // MOE_BLOCK * MOE_BLOCK
    start = jnp.cumsum(counts) - counts
    pend = jnp.cumsum(padded)
    pstart = pend - padded
    dest = pstart[se] + jnp.arange(A, dtype=jnp.int32) - start[se]
    nblk = -(-A // MOE_BLOCK) + N_EXPERTS
    P = nblk * MOE_BLOCK
    slot_tok = jnp.full((P,), N, jnp.int32).at[dest].set(flat_tok[order])
    slot_w = jnp.zeros((P,), jnp.float32).at[dest].set(flat_w[order])
    blk_e = jnp.minimum(jnp.searchsorted(pend, jnp.arange(nblk) * MOE_BLOCK, side='right'), N_EXPERTS - 1)
    x_pad = jnp.concatenate([xt, jnp.zeros((1, D), xt.dtype)], axis=0)

    def expert_block(args):
        tok, e = args
        xb = x_pad[tok]
        hb = jnp.dot(xb, w_e_in[e], preferred_element_type=jnp.float32) + b_e_in[e].astype(jnp.float32)
        g = jnp.minimum(hb[:, :D_EXPERT], SWIGLU_LIMIT)
        u = jnp.clip(hb[:, D_EXPERT:], -SWIGLU_LIMIT, SWIGLU_LIMIT)
        act = (u + 1.0) * (g * jax.nn.sigmoid(SWIGLU_ALPHA * g))
        return jnp.dot(act.astype(xt.dtype), w_e_out[e], preferred_element_type=jnp.float32) \
            + b_e_out[e].astype(jnp.float32)

    yb = lax.map(expert_block, (slot_tok.reshape(nblk, MOE_BLOCK), blk_e))
    y = yb.reshape(P, D) * slot_w[:, None]
    out = jax.ops.segment_sum(y, slot_tok, num_segments=N + 1)[:N]
    return out.reshape(B, S, D).astype(h.dtype)


def hybrid_layer(x, mem, pos, topk, g_mix, w_in, g_q_dsa, g_k_dsa, g_q_mem, g_k_mem, g_mem,
                 w_mem_kv, w_gate, b_gate, w_branch, w_out, g_ffn, w_router, b_router,
                 w_e_in, b_e_in, w_e_out, b_e_out):
    B, S, _ = x.shape
    h = rms_norm(x, g_mix)
    proj = jnp.dot(h, w_in)
    (sq, sk, sv, dq, dk, dv, iq, ik, iw, mq) = jnp.split(proj, [int(c) for c in np.cumsum(IN_SIZES)[:-1]], axis=-1)

    o_sb = stick_breaking_attention(sq.reshape(B, S, SB_HEADS, SB_HEAD_DIM),
                                    sk.reshape(B, S, SB_HEADS, SB_HEAD_DIM),
                                    sv.reshape(B, S, SB_HEADS, SB_HEAD_DIM)).reshape(B, S, SB_W)

    dq = rope(rms_norm(dq.reshape(B, S, DSA_HEADS, DSA_HEAD_DIM), g_q_dsa), pos)
    dk = rope(rms_norm(dk, g_k_dsa)[:, :, None, :], pos)[:, :, 0, :]
    iq = rope(iq.reshape(B, S, IDX_HEADS, IDX_HEAD_DIM), pos)
    ik = rope(ik[:, :, None, :], pos)[:, :, 0, :]
    o_dsa = dsa_attention(dq, dk, dv, iq, ik, iw, topk).reshape(B, S, DSA_W)

    mkv = jnp.dot(rms_norm(mem, g_mem), w_mem_kv)
    M = mem.shape[1]
    mk = rms_norm(mkv[..., :MEM_W].reshape(B, M, MEM_HEADS, MEM_HEAD_DIM), g_k_mem)
    mv = mkv[..., MEM_W:].reshape(B, M, MEM_HEADS, MEM_HEAD_DIM)
    mq = rms_norm(mq.reshape(B, S, MEM_HEADS, MEM_HEAD_DIM), g_q_mem)
    o_mem = memory_attention(mq, mk, mv).reshape(B, S, MEM_W)

    merged = None
    for n, o in enumerate((o_sb, o_dsa, o_mem)):
        gate = jax.nn.sigmoid((jnp.dot(h, w_gate[n]) + b_gate[n]).astype(jnp.float32))
        term = gate * jnp.dot(o, w_branch[n]).astype(jnp.float32)
        merged = term if merged is None else merged + term
    x = x + jnp.dot(merged.astype(x.dtype), w_out)

    x = x + moe_ffn(rms_norm(x, g_ffn), w_router, b_router, w_e_in, b_e_in, w_e_out, b_e_out)
    return x


def setup_inputs(seed: int = 0) -> dict:
    key = jax.random.key(seed)
    ks = jax.random.split(key, 21)
    f32 = jnp.float32
    L = DEPTH

    def nrm(k, shape, scale):
        return jax.random.normal(k, shape, f32) * scale

    def gain(k, shape):
        return 1.0 + 0.02 * jax.random.normal(k, shape, f32)

    return {
        "x": nrm(ks[0], (BATCH, SEQ, D_MODEL), 1.0),
        "mem": nrm(ks[1], (BATCH, MEM_LEN, D_MODEL), 1.0),
        "g_mix": gain(ks[2], (L, D_MODEL)),
        "w_in": nrm(ks[3], (L, D_MODEL, IN_WIDTH), D_MODEL ** -0.5),
        "g_q_dsa": gain(ks[4], (L, DSA_HEAD_DIM)),
        "g_k_dsa": gain(ks[5], (L, DSA_HEAD_DIM)),
        "g_q_mem": gain(ks[6], (L, MEM_HEAD_DIM)),
        "g_k_mem": gain(ks[7], (L, MEM_HEAD_DIM)),
        "g_mem": gain(ks[8], (L, D_MODEL)),
        "w_mem_kv": nrm(ks[9], (L, D_MODEL, 2 * MEM_W), D_MODEL ** -0.5),
        "w_gate": nrm(ks[10], (L, N_BRANCH, D_MODEL, D_MODEL), D_MODEL ** -0.5),
        "b_gate": nrm(ks[11], (L, N_BRANCH, D_MODEL), 0.02),
        "w_branch": nrm(ks[12], (L, N_BRANCH, BRANCH_WIDTH, D_MODEL), BRANCH_WIDTH ** -0.5),
        "w_out": nrm(ks[13], (L, D_MODEL, D_MODEL), D_MODEL ** -0.5),
        "g_ffn": gain(ks[14], (L, D_MODEL)),
        "w_router": nrm(ks[15], (L, D_MODEL, N_EXPERTS), D_MODEL ** -0.5),
        "b_router": nrm(ks[16], (L, N_EXPERTS), 0.01),
        "w_e_in": nrm(ks[17], (L, N_EXPERTS, D_MODEL, 2 * D_EXPERT), D_MODEL ** -0.5),
        "b_e_in": nrm(ks[18], (L, N_EXPERTS, 2 * D_EXPERT), 0.02),
        "w_e_out": nrm(ks[19], (L, N_EXPERTS, D_EXPERT, D_MODEL), D_EXPERT ** -0.5),
        "b_e_out": nrm(ks[20], (L, N_EXPERTS, D_MODEL), 0.02),
    }


def reference(x, mem, g_mix, w_in, g_q_dsa, g_k_dsa, g_q_mem, g_k_mem, g_mem, w_mem_kv,
              w_gate, b_gate, w_branch, w_out, g_ffn, w_router, b_router,
              w_e_in, b_e_in, w_e_out, b_e_out):
    S = x.shape[1]
    pos = jnp.arange(S)
    topk = min(DSA_TOPK_MAX, S // 4)
    for l in range(DEPTH):
        x = hybrid_layer(x, mem, pos, topk, g_mix[l], w_in[l], g_q_dsa[l], g_k_dsa[l],
                         g_q_mem[l], g_k_mem[l], g_mem[l], w_mem_kv[l], w_gate[l], b_gate[l],
                         w_branch[l], w_out[l], g_ffn[l], w_router[l], b_router[l],
                         w_e_in[l], b_e_in[l], w_e_out[l], b_e_out[l])
    return x
```

```cpp
#include <hip/hip_runtime.h>
#include <cstdio>
#include <cstdint>

#define LAS __attribute__((address_space(3)))
#define GAS __attribute__((address_space(1)))
typedef unsigned short bf16_t;
typedef short bf16x8 __attribute__((ext_vector_type(8)));
typedef short s16x4 __attribute__((ext_vector_type(4)));
typedef short v4i16_t __attribute__((ext_vector_type(4)));
typedef float f32x2 __attribute__((ext_vector_type(2)));
typedef float f32x4 __attribute__((ext_vector_type(4)));
typedef float f32x16 __attribute__((ext_vector_type(16)));
typedef unsigned u32x2 __attribute__((ext_vector_type(2)));
typedef unsigned u32x4 __attribute__((ext_vector_type(4)));
typedef GAS unsigned gu32;

constexpr int NB = 32, SEQ = 2048, DM = 1024, NTOK = NB * SEQ;
constexpr int MEMLEN = 256, NMEM = NB * MEMLEN;
constexpr int PW = 3072;
constexpr int C_SQ = 0, C_SK = 512, C_SV = 1024, C_DQ = 1536, C_DK = 2048, C_DV = 2112, C_IQ = 2176, C_IK = 2432, C_IW = 2496, C_MQ = 2560;
constexpr int IN_W = 3012;
constexpr int NEXP = 32, TOPK = 4, DEXP = 1024;
constexpr int NSLOT = NTOK * TOPK;
constexpr int NSLOT_PAD = NSLOT + NEXP * 256;
constexpr float EPS = 1e-6f;
constexpr float LOG2E = 1.4426950408889634f;

constexpr size_t MiB = 1u << 20;
constexpr size_t WS_CTL = 0, CTL_ZERO_BYTES = 1 * MiB;
constexpr size_t WS_ROPE = 1 * MiB;
constexpr size_t WS_BLKCNT = 1 * MiB + 512 * 1024;
constexpr size_t WS_SLOT_TOK = 2 * MiB;
constexpr size_t WS_SLOT_W = 4 * MiB;
constexpr size_t WS_WIN = 8 * MiB;
constexpr size_t WS_WMKV = 14 * MiB;
constexpr size_t WS_WG = 16 * MiB;
constexpr size_t WS_WB = 22 * MiB;
constexpr size_t WS_WO = 25 * MiB;
constexpr size_t WS_WEI = 27 * MiB;
constexpr size_t WS_WEO = 155 * MiB;
constexpr size_t WS_H = 220 * MiB;
constexpr size_t WS_P = 348 * MiB;
constexpr size_t WS_O = 732 * MiB;
constexpr size_t WS_MEMN = 924 * MiB;
constexpr size_t WS_MKV = 940 * MiB;
constexpr size_t WS_END = 956 * MiB;
static_assert(WS_P + (size_t)NSLOT_PAD * DEXP * 2 <= WS_MEMN, "act overlays proj|o");
static_assert(WS_SLOT_TOK + (size_t)NSLOT_PAD * 4 <= WS_SLOT_W && WS_SLOT_W + (size_t)NSLOT_PAD * 4 <= WS_WIN, "slot tables");

constexpr int CW_BAR = 4096;

constexpr int RING_BYTES = 143360;
constexpr int MISC_OFF = RING_BYTES;
constexpr int LDS_BYTES = 147456;
constexpr int MW_BAR = 8;
constexpr int MW_LCNT = 16;
constexpr int MW_PSTART = 64;
constexpr int MW_TSTART = 128;
constexpr int MW_BEFORE = 192;
constexpr int MW_PART = 256;

__device__ __forceinline__ unsigned f2bf(float f) { unsigned u = __builtin_bit_cast(unsigned, f); return (u + 0x7fffu + ((u >> 16) & 1u)) >> 16; }
__device__ __forceinline__ unsigned pk2(float lo, float hi) { return f2bf(lo) | (f2bf(hi) << 16); }
__device__ __forceinline__ float bf2f(unsigned short b) { return __builtin_bit_cast(float, (unsigned)b << 16); }
__device__ __forceinline__ float bflo(unsigned w) { return __builtin_bit_cast(float, w << 16); }
__device__ __forceinline__ float bfhi(unsigned w) { return __builtin_bit_cast(float, w & 0xffff0000u); }
__device__ __forceinline__ unsigned cvt_pk_bf16(float lo, float hi) { unsigned r; asm volatile("v_cvt_pk_bf16_f32 %0, %1, %2" : "=v"(r) : "v"(lo), "v"(hi)); return r; }
__device__ __forceinline__ int crow(int r, int hi) { return (r & 3) + 8 * (r >> 2) + 4 * hi; }
#define LDS_WAIT() asm volatile("s_waitcnt lgkmcnt(0)" ::: "memory")
#define VM_WAIT() asm volatile("s_waitcnt vmcnt(0)" ::: "memory")

namespace pg8 {
constexpr int BM = 256, BK = 64, HALF = 128, HTB = HALF * BK * 2, STAGE_BYTES = 8 * HTB;
__host__ __device__ __forceinline__ int lds_byte(int r, int c) { const int st = (r >> 4) * 2 + (c >> 5), rr = r & 15, cc = c & 31, ob = rr * 64 + cc * 2; return st * 1024 + (ob ^ (((ob >> 9) & 1) << 5)); }
__host__ __device__ __forceinline__ void stage_rc(int b, int& R, int& C) { const int st = b / 1024, sb = b % 1024, swz = sb ^ (((sb >> 9) & 1) << 5); R = (st >> 1) * 16 + swz / 64; C = (st & 1) * 32 + (swz % 64) / 2; }
__host__ __device__ __forceinline__ int perm32(int rho) { const int n = rho >> 4, i = rho & 15; return 8 * (i >> 2) + 4 * n + (i & 3); }

struct Unit { int pm, pn, e; };

template <class Epi, class Sched, bool ALIGN_EPI>
__device__ __forceinline__ void gemm_phase(LAS unsigned char* lds, const int K, const Sched& S, const Epi& E) {
    const int tid = threadIdx.x, wid = __builtin_amdgcn_readfirstlane(tid >> 6), lane = tid & 63, wr = wid >> 2, wc = wid & 3, fr = lane & 15, fq = lane >> 4;
    const int nt = K / BK;
    int Rr[2], Cc[2]; unsigned voffB[2];
#pragma unroll
    for (int i = 0; i < 2; ++i) { int R, C; stage_rc(tid * 16 + i * 8192, R, C); Rr[i] = R; Cc[i] = C; const int Rb = Epi::PERM ? ((R & ~31) + perm32(R & 31)) : R; voffB[i] = (unsigned)(Rb * K + C) * 2u; }
    const size_t kstep = (size_t)(BK * 2);
    const size_t hstepB = (size_t)HALF * K * 2;
    const unsigned ldsw = (unsigned)wid * 1024u;
    const int aoff = lds_byte(wr * 64 + fr, fq * 8), boff = lds_byte(wc * 32 + fr, fq * 8);
#define PG8_SA(b, h) (((b) * 2 + (h)) * HTB)
#define PG8_SB(b, h) ((4 + (b) * 2 + (h)) * HTB)
#define PG8_STAGE(bufoff, gbase, voff) do { _Pragma("unroll") for (int _i = 0; _i < 2; ++_i) \
        __builtin_amdgcn_global_load_lds((const unsigned*)((const char*)(gbase) + (voff)[_i]), (LAS unsigned*)(lds + (bufoff) + ldsw + _i * 8192), 16, 0, 0); } while (0)
#define PG8_LDA(dst, b, h) do { _Pragma("unroll") for (int m = 0; m < 4; ++m) _Pragma("unroll") for (int k = 0; k < 2; ++k) dst[m][k] = *(const LAS bf16x8*)(lds + PG8_SA(b, h) + aoff + m * 2048 + k * 1024); } while (0)
#define PG8_LDB(dst, b, h) do { _Pragma("unroll") for (int n = 0; n < 2; ++n) _Pragma("unroll") for (int k = 0; k < 2; ++k) dst[n][k] = *(const LAS bf16x8*)(lds + PG8_SB(b, h) + boff + n * 2048 + k * 1024); } while (0)
#define PG8_MMA(ai, bj, At, Bt) do { __builtin_amdgcn_s_setprio(1); _Pragma("unroll") for (int m = 0; m < 4; ++m) _Pragma("unroll") for (int n = 0; n < 2; ++n) _Pragma("unroll") for (int k = 0; k < 2; ++k) \
        acc[ai][bj][m][n] = __builtin_amdgcn_mfma_f32_16x16x32_bf16(Bt[n][k], At[m][k], acc[ai][bj][m][n], 0, 0, 0); __builtin_amdgcn_s_setprio(0); } while (0)
#define PG8_WAIT_V(n) asm volatile("s_waitcnt vmcnt(" #n ")" ::: "memory")
#define PG8_WAIT_L(n) asm volatile("s_waitcnt lgkmcnt(" #n ")" ::: "memory")
#define PG8_BAR __builtin_amdgcn_s_barrier()
#define PG8_SCHED __builtin_amdgcn_sched_barrier(0)
    Unit cur, nxt; int ui = 0;
    if (!S.next(0, cur)) return;
    f32x4 acc[2][2][4][2];
#pragma unroll
    for (int a = 0; a < 2; ++a)
#pragma unroll
        for (int b = 0; b < 2; ++b)
#pragma unroll
            for (int m = 0; m < 4; ++m)
#pragma unroll
                for (int n = 0; n < 2; ++n) acc[a][b][m][n] = (f32x4){0.f, 0.f, 0.f, 0.f};
    bf16x8 At[4][2], B0[2][2], B1[2][2];
    const char* Ab = S.a_base();
    unsigned ca0[2], ca1[2], na0[2], na1[2];
#pragma unroll
    for (int i = 0; i < 2; ++i) { ca0[i] = S.a_off(cur, Rr[i], Cc[i]); ca1[i] = S.a_off(cur, HALF + Rr[i], Cc[i]); }
    const char* cB = S.b_tile(cur);
    PG8_STAGE(PG8_SB(0, 0), cB, voffB); PG8_STAGE(PG8_SB(0, 1), cB + hstepB, voffB); PG8_STAGE(PG8_SA(0, 0), Ab, ca0); PG8_STAGE(PG8_SA(0, 1), Ab, ca1);
    if (wr == 1) PG8_BAR;
    PG8_WAIT_V(2); PG8_BAR;
    PG8_STAGE(PG8_SB(1, 0), cB + kstep, voffB); PG8_STAGE(PG8_SA(1, 0), Ab + kstep, ca0); PG8_STAGE(PG8_SB(1, 1), cB + hstepB + kstep, voffB);
    PG8_WAIT_V(6); PG8_BAR;
    for (;;) {
        const bool has_next = S.next(ui + 1, nxt);
        const char* nB = cB;
#pragma unroll
        for (int i = 0; i < 2; ++i) { na0[i] = ca0[i]; na1[i] = ca1[i]; }
        if (has_next) { nB = S.b_tile(nxt);
#pragma unroll
            for (int i = 0; i < 2; ++i) { na0[i] = S.a_off(nxt, Rr[i], Cc[i]); na1[i] = S.a_off(nxt, HALF + Rr[i], Cc[i]); } }
        for (int t = 0; t < nt; t += 2) {
            const bool last = (t == nt - 2);
            const char* a1 = Ab + (size_t)(t + 1) * kstep;
            const char* a2 = last ? Ab : Ab + (size_t)(t + 2) * kstep; const char* b2 = last ? nB : cB + (size_t)(t + 2) * kstep;
            const char* a3 = a2 + kstep; const char* b3 = b2 + kstep;
            unsigned o20[2], o21[2];
#pragma unroll
            for (int i = 0; i < 2; ++i) { o20[i] = last ? na0[i] : ca0[i]; o21[i] = last ? na1[i] : ca1[i]; }
            PG8_LDB(B0, 0, 0); PG8_LDB(B1, 0, 1); PG8_SCHED; PG8_LDA(At, 0, 0); PG8_STAGE(PG8_SA(1, 1), a1, ca1);
            PG8_WAIT_V(8); PG8_WAIT_L(0); PG8_BAR; PG8_MMA(0, 0, At, B0); PG8_MMA(0, 1, At, B1); PG8_BAR; PG8_SCHED;
            PG8_LDA(At, 0, 1); PG8_STAGE(PG8_SB(0, 0), b2, voffB); PG8_STAGE(PG8_SB(0, 1), b2 + hstepB, voffB); PG8_STAGE(PG8_SA(0, 0), a2, o20);
            PG8_WAIT_V(8); PG8_WAIT_L(0); PG8_BAR; PG8_MMA(1, 0, At, B0); PG8_MMA(1, 1, At, B1); PG8_BAR; PG8_SCHED;
            PG8_LDB(B0, 1, 0); PG8_LDB(B1, 1, 1); PG8_SCHED; PG8_LDA(At, 1, 0); PG8_STAGE(PG8_SA(0, 1), a2, o21);
            PG8_WAIT_V(8); PG8_WAIT_L(0); PG8_BAR; PG8_MMA(0, 0, At, B0); PG8_MMA(0, 1, At, B1); PG8_BAR; PG8_SCHED;
            PG8_LDA(At, 1, 1); PG8_STAGE(PG8_SB(1, 0), b3, voffB); PG8_STAGE(PG8_SB(1, 1), b3 + hstepB, voffB); PG8_STAGE(PG8_SA(1, 0), a3, o20);
            PG8_WAIT_V(8); PG8_WAIT_L(0); PG8_BAR; PG8_MMA(1, 0, At, B0); PG8_MMA(1, 1, At, B1); PG8_BAR; PG8_SCHED;
        }
        if constexpr (ALIGN_EPI) { if (wr == 0) PG8_BAR; }
        E(acc, cur, wr, wc, fr, fq);
        if (!has_next) break;
#pragma unroll
        for (int a = 0; a < 2; ++a)
#pragma unroll
            for (int b = 0; b < 2; ++b)
#pragma unroll
                for (int m = 0; m < 4; ++m)
#pragma unroll
                    for (int n = 0; n < 2; ++n) acc[a][b][m][n] = (f32x4){0.f, 0.f, 0.f, 0.f};
        cur = nxt; cB = nB; ++ui;
#pragma unroll
        for (int i = 0; i < 2; ++i) { ca0[i] = na0[i]; ca1[i] = na1[i]; }
        if constexpr (ALIGN_EPI) { if (wr == 1) PG8_BAR; }
    }
    PG8_WAIT_V(0);
    if constexpr (!ALIGN_EPI) { if (wr == 0) PG8_BAR; }
    PG8_BAR;
#undef PG8_SA
#undef PG8_SB
#undef PG8_STAGE
#undef PG8_LDA
#undef PG8_LDB
#undef PG8_MMA
#undef PG8_WAIT_V
#undef PG8_WAIT_L
#undef PG8_BAR
#undef PG8_SCHED
}

struct DenseSched {
    const char* A; const char* Bt; int K, nM, nN, nwg, G, c;
    __device__ __forceinline__ void init(const void* A_, const void* Bt_, int M, int N, int K_, int G_, int c_) { A = (const char*)A_; Bt = (const char*)Bt_; K = K_; nM = M / BM; nN = N / BM; nwg = nM * nN; G = G_; c = c_; }
    __device__ __forceinline__ bool next(int i, Unit& u) const {
        const long L = (long)i * G + c; if (L >= nwg) return false;
        int wgid = (int)L; { const int q = nwg / 8, r = nwg % 8, xcd = wgid % 8, off = wgid / 8; wgid = (xcd < r ? xcd * (q + 1) : r * (q + 1) + (xcd - r) * q) + off; }
        const int nig = 8 * nN, gid = wgid / nig, fm = gid * 8, gsz = (nM - fm) < 8 ? (nM - fm) : 8;
        u.pm = fm + ((wgid % nig) % gsz); u.pn = (wgid % nig) / gsz; u.e = 0; return true;
    }
    __device__ __forceinline__ const char* a_base() const { return A; }
    __device__ __forceinline__ unsigned a_off(const Unit& u, int row, int col) const { return (unsigned)(((size_t)(u.pm * BM + row) * K + col) * 2); }
    __device__ __forceinline__ const char* b_tile(const Unit& u) const { return Bt + (size_t)u.pn * BM * K * 2; }
};
}

namespace pg8 {
struct MoeSched {
    const char* A; const char* Bt; const int* slot_tok; volatile LAS unsigned* tstart; int K, rowsE, nN, c;
    __device__ __forceinline__ bool next(int i, Unit& u) const {
        const int x = c & 7, j = c >> 3, rpr = 32 / nN;
        const int pm = (i * 8 + x) * rpr + j / nN;
        const int T = (int)tstart[32];
        if (pm >= T) return false;
        int e = 0;
#pragma unroll 1
        for (int k = 1; k < 32; ++k) e += ((int)tstart[k] <= pm) ? 1 : 0;
        u.pm = pm; u.pn = j % nN; u.e = __builtin_amdgcn_readfirstlane(e); return true;
    }
    __device__ __forceinline__ const char* a_base() const { return A; }
    __device__ __forceinline__ unsigned a_off(const Unit& u, int row, int col) const {
        const int pos = u.pm * BM + row;
        const int r = slot_tok ? slot_tok[pos] : pos;
        return (unsigned)(((size_t)r * K + col) * 2);
    }
    __device__ __forceinline__ const char* b_tile(const Unit& u) const { return Bt + ((size_t)u.e * rowsE + (size_t)u.pn * BM) * K * 2; }
};

template <int ACT> struct EpiBf16 {
    static constexpr bool PERM = true;
    bf16_t* O; int ldc; const float* bias;
    __device__ __forceinline__ void operator()(const f32x4 (&acc)[2][2][4][2], const Unit& u, int wr, int wc, int fr, int fq) const {
        const int row0 = u.pm * BM + wr * 64 + fr; const int col0 = u.pn * BM + wc * 32 + 8 * fq;
        f32x4 bv[2][2];
#pragma unroll
        for (int bj = 0; bj < 2; ++bj)
#pragma unroll
            for (int n = 0; n < 2; ++n) bv[bj][n] = bias ? *(const f32x4*)(bias + col0 + bj * HALF + 4 * n) : (f32x4){0.f, 0.f, 0.f, 0.f};
#pragma unroll
        for (int ai = 0; ai < 2; ++ai)
#pragma unroll
            for (int m = 0; m < 4; ++m) { bf16_t* rowp = O + (size_t)(row0 + ai * HALF + m * 16) * ldc + col0;
#pragma unroll
                for (int bj = 0; bj < 2; ++bj) { f32x4 v0 = acc[ai][bj][m][0] + bv[bj][0], v1 = acc[ai][bj][m][1] + bv[bj][1];
                    if (ACT == 2) {
#pragma unroll
                        for (int q = 0; q < 4; ++q) { v0[q] = __builtin_amdgcn_rcpf(1.f + __builtin_amdgcn_exp2f(-LOG2E * v0[q])); v1[q] = __builtin_amdgcn_rcpf(1.f + __builtin_amdgcn_exp2f(-LOG2E * v1[q])); } }
                    u32x4 w; w.x = cvt_pk_bf16(v0[0], v0[1]); w.y = cvt_pk_bf16(v0[2], v0[3]); w.z = cvt_pk_bf16(v1[0], v1[1]); w.w = cvt_pk_bf16(v1[2], v1[3]);
                    *(u32x4*)(rowp + bj * HALF) = w; } }
    }
};
struct EpiMerge {
    static constexpr bool PERM = true;
    const bf16_t* G; int goff; bf16_t* Mg; int first;
    __device__ __forceinline__ void operator()(const f32x4 (&acc)[2][2][4][2], const Unit& u, int wr, int wc, int fr, int fq) const {
        const int row0 = u.pm * BM + wr * 64 + fr; const int col0 = u.pn * BM + wc * 32 + 8 * fq;
#pragma unroll
        for (int ai = 0; ai < 2; ++ai)
#pragma unroll
            for (int m = 0; m < 4; ++m) { const size_t row = (size_t)(row0 + ai * HALF + m * 16);
#pragma unroll
                for (int bj = 0; bj < 2; ++bj) {
                    const u32x4 g = *(const u32x4*)(G + row * PW + goff + col0 + bj * HALF);
                    u32x4 p = (u32x4){0u, 0u, 0u, 0u};
                    if (!first) p = *(const u32x4*)(Mg + row * DM + col0 + bj * HALF);
                    const f32x4 a0 = acc[ai][bj][m][0], a1 = acc[ai][bj][m][1];
                    u32x4 w;
                    w.x = cvt_pk_bf16(bflo(p.x) + bflo(g.x) * a0[0], bfhi(p.x) + bfhi(g.x) * a0[1]);
                    w.y = cvt_pk_bf16(bflo(p.y) + bflo(g.y) * a0[2], bfhi(p.y) + bfhi(g.y) * a0[3]);
                    w.z = cvt_pk_bf16(bflo(p.z) + bflo(g.z) * a1[0], bfhi(p.z) + bfhi(g.z) * a1[1]);
                    w.w = cvt_pk_bf16(bflo(p.w) + bflo(g.w) * a1[2], bfhi(p.w) + bfhi(g.w) * a1[3]);
                    *(u32x4*)(Mg + row * DM + col0 + bj * HALF) = w; } }
    }
};
struct EpiResid {
    static constexpr bool PERM = false;
    const float* base; float* out;
    __device__ __forceinline__ void operator()(const f32x4 (&acc)[2][2][4][2], const Unit& u, int wr, int wc, int fr, int fq) const {
        const int row0 = u.pm * BM + wr * 64 + fr; const int col0 = u.pn * BM + wc * 32 + 4 * fq;
#pragma unroll
        for (int ai = 0; ai < 2; ++ai)
#pragma unroll
            for (int m = 0; m < 4; ++m) { const size_t off = (size_t)(row0 + ai * HALF + m * 16) * DM + col0;
#pragma unroll
                for (int bj = 0; bj < 2; ++bj)
#pragma unroll
                    for (int n = 0; n < 2; ++n) { const f32x4 b = *(const f32x4*)(base + off + bj * HALF + n * 16); *(f32x4*)(out + off + bj * HALF + n * 16) = b + acc[ai][bj][m][n]; } }
    }
};
struct EpiSwiglu {
    static constexpr bool PERM = true;
    bf16_t* act; const float* bias;
    __device__ __forceinline__ void operator()(const f32x4 (&acc)[2][2][4][2], const Unit& u, int wr, int wc, int fr, int fq) const {
        const int row0 = u.pm * BM + wr * 64 + fr; const int col0 = u.pn * HALF + wc * 32 + 8 * fq;
        const float* be = bias + (size_t)u.e * 2048 + col0;
        f32x4 bg[2], bu[2];
#pragma unroll
        for (int n = 0; n < 2; ++n) { bg[n] = *(const f32x4*)(be + 4 * n); bu[n] = *(const f32x4*)(be + 1024 + 4 * n); }
#pragma unroll
        for (int ai = 0; ai < 2; ++ai)
#pragma unroll
            for (int m = 0; m < 4; ++m) { bf16_t* rowp = act + (size_t)(row0 + ai * HALF + m * 16) * DEXP + col0;
                float o[8];
#pragma unroll
                for (int n = 0; n < 2; ++n) { const f32x4 gv = acc[ai][0][m][n] + bg[n], uv = acc[ai][1][m][n] + bu[n];
#pragma unroll
                    for (int q = 0; q < 4; ++q) { const float g = fminf(gv[q], 7.0f); const float uu = fminf(fmaxf(uv[q], -7.0f), 7.0f);
                        const float sg = __builtin_amdgcn_rcpf(1.f + __builtin_amdgcn_exp2f(-1.702f * LOG2E * g));
                        o[4 * n + q] = (uu + 1.0f) * (g * sg); } }
                u32x4 w; w.x = cvt_pk_bf16(o[0], o[1]); w.y = cvt_pk_bf16(o[2], o[3]); w.z = cvt_pk_bf16(o[4], o[5]); w.w = cvt_pk_bf16(o[6], o[7]);
                *(u32x4*)rowp = w; }
    }
};
struct EpiScatter {
    static constexpr bool PERM = false;
    float* out; const int* slot_tok; const float* slot_w; const float* bias;
    __device__ __forceinline__ void operator()(const f32x4 (&acc)[2][2][4][2], const Unit& u, int wr, int wc, int fr, int fq) const {
        const int row0 = u.pm * BM + wr * 64 + fr; const int col0 = u.pn * BM + wc * 32 + 4 * fq;
        const float* be = bias + (size_t)u.e * DM + col0;
        f32x4 bv[2][2];
#pragma unroll
        for (int bj = 0; bj < 2; ++bj)
#pragma unroll
            for (int n = 0; n < 2; ++n) bv[bj][n] = *(const f32x4*)(be + bj * HALF + n * 16);
#pragma unroll
        for (int ai = 0; ai < 2; ++ai)
#pragma unroll
            for (int m = 0; m < 4; ++m) { const int pos = row0 + ai * HALF + m * 16; const float w = slot_w[pos]; const int tok = slot_tok[pos];
                if (w != 0.f) { float* op = out + (size_t)tok * DM + col0;
#pragma unroll
                    for (int bj = 0; bj < 2; ++bj)
#pragma unroll
                        for (int n = 0; n < 2; ++n) { const f32x4 y = (acc[ai][bj][m][n] + bv[bj][n]) * w;
#pragma unroll
                            for (int q = 0; q < 4; ++q) unsafeAtomicAdd(op + bj * HALF + n * 16 + q, y[q]); } } }
    }
};
}

#define XB_TMO      128
#define XB_XCNT(j)  (256  + 64 * (j))
#define XB_XSUB(j)  (1280 + 64 * (j))
#define XB_XGEN(j)  (2304 + 64 * (j))
#define XB_TOP      3328
#define XB_TOPGEN   3392
#define XCD_BAR_WORDS 3456
#define XB_SPIN_CAP (1u << 18)

__device__ __forceinline__ unsigned xb_ld(unsigned* p)              { return __hip_atomic_load(p, __ATOMIC_RELAXED, __HIP_MEMORY_SCOPE_AGENT); }
__device__ __forceinline__ unsigned xb_add(unsigned* p, unsigned v) { return __hip_atomic_fetch_add(p, v, __ATOMIC_RELAXED, __HIP_MEMORY_SCOPE_AGENT); }
__device__ __forceinline__ unsigned xb_xcc_id() { return (unsigned)__builtin_amdgcn_s_getreg((3 << 11) | 20) & 0xFu; }
#define XB_SPIN(cond, bar) do { unsigned _sp = 0; while (cond) { __builtin_amdgcn_s_sleep(1); \
    if ((++_sp & 255u) == 0u) { if (xb_ld(&(bar)[XB_TMO])) break; if (_sp > XB_SPIN_CAP) { atomicAdd(&(bar)[XB_TMO], 1u); break; } } } } while (0)

struct XcdBarrier {
    unsigned* bar; unsigned x;
    volatile LAS unsigned* st;
};

__device__ __forceinline__ XcdBarrier xcd_barrier_post(unsigned* bar, volatile LAS unsigned* st) {
    XcdBarrier b; b.bar = bar; b.x = xb_xcc_id(); b.st = st;
    if (threadIdx.x == 0) (void)xb_add(&bar[XB_XCNT(b.x)], 1u);
    return b;
}
__device__ __forceinline__ void xcd_barrier_complete(unsigned* bar, unsigned x, unsigned& nloc, unsigned& nx) {
    const unsigned G = gridDim.x * gridDim.y * gridDim.z;
    unsigned sum, cnt, mine, sp = 0u;
    for (;;) {
        sum = 0u; cnt = 0u; mine = 0u;
#pragma unroll
        for (unsigned j = 0; j < 16; ++j) { const unsigned c = xb_ld(&bar[XB_XCNT(j)]); sum += c; cnt += (c > 0u) ? 1u : 0u; mine = (j == x) ? c : mine; }
        if (sum == G) break;
        __builtin_amdgcn_s_sleep(1);
        if ((++sp & 255u) == 0u) { if (xb_ld(&bar[XB_TMO])) break; if (sp > XB_SPIN_CAP) { atomicAdd(&bar[XB_TMO], 1u); break; } }
    }
    nloc = mine > 0u ? mine : 1u; nx = cnt > 0u ? cnt : 1u;
}

__device__ __forceinline__ void xcd_barrier(const XcdBarrier& b) {
    asm volatile("s_waitcnt vmcnt(0)" ::: "memory");
    __syncthreads();
    if (threadIdx.x == 0) {
        unsigned* bar = b.bar;
        __builtin_amdgcn_s_waitcnt(0);
        unsigned nloc = b.st[0], nx = b.st[1];
        if (nloc == 0u) { xcd_barrier_complete(bar, b.x, nloc, nx); b.st[0] = nloc; b.st[1] = nx; }
        const unsigned old = xb_add(&bar[XB_XSUB(b.x)], 1u);
        const unsigned gen = old / nloc;
        if (old + 1u == (gen + 1u) * nloc) {
            __builtin_amdgcn_fence(__ATOMIC_RELEASE, "agent");
            asm volatile("s_waitcnt vmcnt(0)" ::: "memory");
            const unsigned og = xb_add(&bar[XB_TOP], 1u);
            const unsigned tg = og / nx;
            if (og + 1u == (tg + 1u) * nx) xb_add(&bar[XB_TOPGEN], 1u);
            else XB_SPIN(xb_ld(&bar[XB_TOPGEN]) == tg, bar);
            __builtin_amdgcn_fence(__ATOMIC_ACQUIRE, "agent");
            xb_add(&bar[XB_XGEN(b.x)], 1u);
            asm volatile("s_waitcnt vmcnt(0)" ::: "memory");
        } else {
            XB_SPIN(xb_ld(&bar[XB_XGEN(b.x)]) == gen, bar);
            __builtin_amdgcn_fence(__ATOMIC_ACQUIRE, "agent");
            asm volatile("s_waitcnt vmcnt(0)" ::: "memory");
        }
    }
    __syncthreads();
}

constexpr int NWAVES = 8;
struct Frame {
    LAS unsigned char* lds;
    volatile LAS unsigned* MISC;
    gu32* ctl;
    int tid, lane, wave, G, blk;
    const float* in[21];
    float* out; unsigned char* ws;
};
__device__ __forceinline__ float wave_sum(float v) {
#pragma unroll
    for (int o = 1; o < 64; o <<= 1) v += __shfl_xor(v, o);
    return v;
}

__device__ __forceinline__ int map_src(int mode, int n) {
    if (mode == 1) return n < 2500 ? n : (n >= C_MQ ? n - (C_MQ - 2500) : -1);
    if (mode == 2) { const int pn = n >> 8, bj = (n >> 7) & 1, j = n & 127; return bj * 1024 + pn * 128 + j; }
    return n;
}
__device__ __forceinline__ void transpose_item(const float* W, int K, int Nsrc, int Ndst, bf16_t* WT, int mode, LAS float* scr, int item, int lane) {
    const int nblk = Ndst / 32, kb = item / nblk, nb = item % nblk, k0 = 64 * kb, n0 = 32 * nb;
    const int sc = map_src(mode, n0 + (lane & 31));
    const float scale = (mode == 1 && (n0 + (lane & 31)) < 512) ? 0.125f : 1.0f;
#pragma unroll 8
    for (int i = 0; i < 32; ++i) { const int kk = 2 * i + (lane >> 5); scr[kk * 33 + (lane & 31)] = sc >= 0 ? W[(size_t)(k0 + kk) * Nsrc + sc] * scale : 0.f; }
    LDS_WAIT(); asm volatile("" ::: "memory");
    const int c = lane & 7;
#pragma unroll
    for (int j = 0; j < 4; ++j) { const int n = (lane >> 3) + 8 * j; const LAS float* s = scr + (8 * c) * 33 + n;
        u32x4 o; o.x = pk2(s[0 * 33], s[1 * 33]); o.y = pk2(s[2 * 33], s[3 * 33]); o.z = pk2(s[4 * 33], s[5 * 33]); o.w = pk2(s[6 * 33], s[7 * 33]);
        *(GAS u32x4*)(WT + (size_t)(n0 + n) * K + k0 + 8 * c) = o; }
    LDS_WAIT(); asm volatile("" ::: "memory");
}
__device__ __forceinline__ void rms_row_to_bf16(int lane, const float* xrow, const float* g, bf16_t* orow) {
    const GAS f32x4* xr = (const GAS f32x4*)xrow + lane; const GAS f32x4* gr = (const GAS f32x4*)g + lane;
    f32x4 v[4]; float s = 0.f;
#pragma unroll
    for (int j = 0; j < 4; ++j) { v[j] = xr[64 * j]; s += (v[j].x * v[j].x + v[j].y * v[j].y) + (v[j].z * v[j].z + v[j].w * v[j].w); }
    const float rstd = 1.0f / sqrtf(wave_sum(s) * (1.f / DM) + EPS);
    GAS u32x2* o8 = (GAS u32x2*)orow + lane;
#pragma unroll
    for (int j = 0; j < 4; ++j) { const f32x4 gg = gr[64 * j]; u32x2 o; o.x = pk2(v[j].x * rstd * gg.x, v[j].y * rstd * gg.y); o.y = pk2(v[j].z * rstd * gg.z, v[j].w * rstd * gg.w); o8[64 * j] = o; }
}

__device__ __forceinline__ void p0_prologue(Frame& F) {
    LAS float* scr = (LAS float*)(F.lds + F.wave * 16384);
    const int gw = F.blk * NWAVES + F.wave, NGW = F.G * NWAVES, lane = F.lane;
    unsigned char* ws = F.ws;
    constexpr int I_IN = 16 * 96, I_MKV = 16 * 32, I_G = 16 * 32, I_B = 8 * 32, I_O = 16 * 32, I_EI = 16 * 64, I_EO = 16 * 32;
    constexpr int NITEMS = I_IN + I_MKV + 3 * I_G + 3 * I_B + I_O + NEXP * I_EI + NEXP * I_EO;
    for (int it = gw; it < NITEMS; it += NGW) {
        int r = it;
        if (r < I_IN) { transpose_item(F.in[3], DM, IN_W, PW, (bf16_t*)(ws + WS_WIN), 1, scr, r, lane); continue; } r -= I_IN;
        if (r < I_MKV) { transpose_item(F.in[9], DM, DM, DM, (bf16_t*)(ws + WS_WMKV), 0, scr, r, lane); continue; } r -= I_MKV;
        if (r < 3 * I_G) { const int n = r / I_G; transpose_item(F.in[10] + (size_t)n * DM * DM, DM, DM, DM, (bf16_t*)(ws + WS_WG) + (size_t)n * DM * DM, 0, scr, r % I_G, lane); continue; } r -= 3 * I_G;
        if (r < 3 * I_B) { const int n = r / I_B; transpose_item(F.in[12] + (size_t)n * 512 * DM, 512, DM, DM, (bf16_t*)(ws + WS_WB) + (size_t)n * DM * 512, 0, scr, r % I_B, lane); continue; } r -= 3 * I_B;
        if (r < I_O) { transpose_item(F.in[13], DM, DM, DM, (bf16_t*)(ws + WS_WO), 0, scr, r, lane); continue; } r -= I_O;
        if (r < NEXP * I_EI) { const int e = r / I_EI; transpose_item(F.in[17] + (size_t)e * DM * 2048, DM, 2048, 2048, (bf16_t*)(ws + WS_WEI) + (size_t)e * 2048 * DM, 2, scr, r % I_EI, lane); continue; } r -= NEXP * I_EI;
        { const int e = r / I_EO; transpose_item(F.in[19] + (size_t)e * DM * DM, DM, DM, DM, (bf16_t*)(ws + WS_WEO) + (size_t)e * DM * DM, 0, scr, r % I_EO, lane); }
    }
    { f32x2* tab = (f32x2*)(ws + WS_ROPE);
      for (int idx = (F.blk * NWAVES * 64) + F.tid; idx < SEQ * 32; idx += F.G * NWAVES * 64) {
          const int s = idx >> 5, i = idx & 31;
          const float inv = exp2f(-(float)i * (13.287712379549449f / 32.0f));
          const float ang = (float)s * inv;
          const double rev = (double)ang * 0.15915494309189535;
          const float fr = (float)(rev - __builtin_rint(rev));
          tab[idx] = (f32x2){__builtin_amdgcn_cosf(fr), __builtin_amdgcn_sinf(fr)}; } }
    for (int m = gw; m < NTOK; m += NGW) rms_row_to_bf16(lane, F.in[0] + (size_t)m * DM, F.in[2], (bf16_t*)(ws + WS_H) + (size_t)m * DM);
    for (int m = gw; m < NMEM; m += NGW) rms_row_to_bf16(lane, F.in[1] + (size_t)m * DM, F.in[8], (bf16_t*)(ws + WS_MEMN) + (size_t)m * DM);
    { int* st = (int*)(ws + WS_SLOT_TOK); float* sw = (float*)(ws + WS_SLOT_W);
      for (int i = F.blk * NWAVES * 64 + F.tid; i < NSLOT_PAD; i += F.G * NWAVES * 64) { st[i] = 0; sw[i] = 0.f; } }
}

__device__ __forceinline__ void ld8(const bf16_t* p, float (&v)[8]) { const u32x4 w = *(const u32x4*)p; v[0] = bflo(w.x); v[1] = bfhi(w.x); v[2] = bflo(w.y); v[3] = bfhi(w.y); v[4] = bflo(w.z); v[5] = bfhi(w.z); v[6] = bflo(w.w); v[7] = bfhi(w.w); }
__device__ __forceinline__ void st8(bf16_t* p, const float (&v)[8]) { u32x4 w; w.x = pk2(v[0], v[1]); w.y = pk2(v[2], v[3]); w.z = pk2(v[4], v[5]); w.w = pk2(v[6], v[7]); *(u32x4*)p = w; }
__device__ __forceinline__ void rope8(float (&v)[8], const f32x2* tabrow, int lane) {
    const int i0 = (lane & 3) * 8; const bool up = (lane & 4) != 0;
#pragma unroll
    for (int j = 0; j < 8; ++j) { const float other = __shfl_xor(v[j], 4); const f32x2 cs = tabrow[i0 + j];
        v[j] = up ? (other * cs.y + v[j] * cs.x) : (v[j] * cs.x - other * cs.y); }
}
__device__ __forceinline__ void p2_prep(Frame& F) {
    const int gw = F.blk * NWAVES + F.wave, NGW = F.G * NWAVES, lane = F.lane;
    bf16_t* proj = (bf16_t*)(F.ws + WS_P);
    const f32x2* tab = (const f32x2*)(F.ws + WS_ROPE);
    const float* g_q_dsa = F.in[4]; const float* g_k_dsa = F.in[5]; const float* g_q_mem = F.in[6]; const float* g_k_mem = F.in[7];
    for (int m = gw; m < NTOK; m += NGW) {
        bf16_t* row = proj + (size_t)m * PW; const f32x2* tr = tab + (size_t)(m & (SEQ - 1)) * 32;
        float v[8];
        { ld8(row + C_DQ + 8 * lane, v); float ss = 0.f;
#pragma unroll
          for (int j = 0; j < 8; ++j) ss += v[j] * v[j];
          ss += __shfl_xor(ss, 1); ss += __shfl_xor(ss, 2); ss += __shfl_xor(ss, 4);
          const float rstd = 1.0f / sqrtf(ss * (1.f / 64.f) + EPS);
#pragma unroll
          for (int j = 0; j < 8; ++j) v[j] = v[j] * rstd * g_q_dsa[8 * (lane & 7) + j];
          rope8(v, tr, lane);
#pragma unroll
          for (int j = 0; j < 8; ++j) v[j] *= 0.125f * LOG2E;
          st8(row + C_DQ + 8 * lane, v); }
        { ld8(row + C_DK + 8 * (lane & 7), v); float ss = 0.f;
#pragma unroll
          for (int j = 0; j < 8; ++j) ss += v[j] * v[j];
          ss += __shfl_xor(ss, 1); ss += __shfl_xor(ss, 2); ss += __shfl_xor(ss, 4);
          const float rstd = 1.0f / sqrtf(ss * (1.f / 64.f) + EPS);
#pragma unroll
          for (int j = 0; j < 8; ++j) v[j] = v[j] * rstd * g_k_dsa[8 * (lane & 7) + j];
          rope8(v, tr, lane);
          if (lane < 8) st8(row + C_DK + 8 * lane, v); }
        { ld8(row + C_IQ + 8 * (lane & 31), v); rope8(v, tr, lane); if (lane < 32) st8(row + C_IQ + 8 * lane, v); }
        { ld8(row + C_IK + 8 * (lane & 7), v); rope8(v, tr, lane); if (lane < 8) st8(row + C_IK + 8 * lane, v); }
        { ld8(row + C_MQ + 8 * lane, v); float ss = 0.f;
#pragma unroll
          for (int j = 0; j < 8; ++j) ss += v[j] * v[j];
          ss += __shfl_xor(ss, 1); ss += __shfl_xor(ss, 2); ss += __shfl_xor(ss, 4); ss += __shfl_xor(ss, 8);
          const float rstd = 1.0f / sqrtf(ss * (1.f / 128.f) + EPS) * (0.08838834764831845f * LOG2E);
#pragma unroll
          for (int j = 0; j < 8; ++j) v[j] = v[j] * rstd * g_q_mem[8 * (lane & 15) + j];
          st8(row + C_MQ + 8 * lane, v); }
    }
    bf16_t* mkv = (bf16_t*)(F.ws + WS_MKV);
    for (int m = gw; m < NMEM; m += NGW) {
        bf16_t* row = mkv + (size_t)m * DM; float v[8];
        ld8(row + 8 * lane, v); float ss = 0.f;
#pragma unroll
        for (int j = 0; j < 8; ++j) ss += v[j] * v[j];
        ss += __shfl_xor(ss, 1); ss += __shfl_xor(ss, 2); ss += __shfl_xor(ss, 4); ss += __shfl_xor(ss, 8);
        const float rstd = 1.0f / sqrtf(ss * (1.f / 128.f) + EPS);
#pragma unroll
        for (int j = 0; j < 8; ++j) v[j] = v[j] * rstd * g_k_mem[8 * (lane & 15) + j];
        st8(row + 8 * lane, v);
    }
}

#define MFMA32(a, b, c) __builtin_amdgcn_mfma_f32_32x32x16_bf16((a), (b), (c), 0, 0, 0)
typedef LAS const unsigned char* lds_cptr;
__device__ __forceinline__ s16x4 vtr(lds_cptr p) { return __builtin_bit_cast(s16x4, __builtin_amdgcn_ds_read_tr16_b64_v4i16((LAS v4i16_t*)p)); }
__device__ __forceinline__ bf16x8 vfrag(lds_cptr vbase_lane, int off) {
    const s16x4 lo = vtr(vbase_lane + off), hi = vtr(vbase_lane + off + 512);
    return (bf16x8){lo[0], lo[1], lo[2], lo[3], hi[0], hi[1], hi[2], hi[3]};
}
__device__ __forceinline__ int vtr_lane_off(int lane) { return ((lane >> 4) & 1) * 32 + (lane & 3) * 8 + (4 * (lane >> 5) + ((lane & 15) >> 2)) * 64; }
__device__ __forceinline__ bf16x8 pack8(const float* p) {
    u32x4 w; w.x = cvt_pk_bf16(p[0], p[1]); w.y = cvt_pk_bf16(p[2], p[3]); w.z = cvt_pk_bf16(p[4], p[5]); w.w = cvt_pk_bf16(p[6], p[7]);
    return __builtin_bit_cast(bf16x8, w);
}
__device__ __forceinline__ float softplus_f(float z) { return fmaxf(z, 0.f) + __logf(1.f + __expf(-fabsf(z))); }

__device__ __forceinline__ void sb_item(const bf16_t* proj, bf16_t* osb, int b, int h, int qblk, LAS unsigned char* vlds, int lane) {
    const int r32 = lane & 31, hi = lane >> 5;
    const size_t tok0 = (size_t)b * SEQ + (size_t)qblk * 32;
    bf16x8 qr[4];
    { const bf16_t* qp = proj + (tok0 + r32) * PW + C_SQ + h * 64 + hi * 8;
#pragma unroll
      for (int kk = 0; kk < 4; ++kk) qr[kk] = *(const bf16x8*)(qp + kk * 16); }
    f32x16 o0 = {}, o1 = {}; float R = 0.f;
    const lds_cptr vrd = (lds_cptr)vlds + vtr_lane_off(lane);
    for (int kt = qblk; kt >= 0; --kt) {
        const size_t key0 = (size_t)b * SEQ + (size_t)kt * 32;
        const bf16_t* kp = proj + (key0 + r32) * PW + C_SK + h * 64 + hi * 8;
        bf16x8 kf[4];
#pragma unroll
        for (int kk = 0; kk < 4; ++kk) kf[kk] = *(const bf16x8*)(kp + kk * 16);
        u32x4 vv[4];
#pragma unroll
        for (int p = 0; p < 4; ++p) vv[p] = *(const u32x4*)(proj + (key0 + 16 * (p & 1) + (lane >> 2)) * PW + C_SV + h * 64 + (p >> 1) * 32 + (lane & 3) * 8);
        f32x16 s = {};
#pragma unroll
        for (int kk = 0; kk < 4; ++kk) s = MFMA32(kf[kk], qr[kk], s);
        asm volatile("" ::: "memory");
#pragma unroll
        for (int p = 0; p < 4; ++p) *(LAS u32x4*)(vlds + p * 1024 + lane * 16) = vv[p];
        const bool diag = (kt == qblk);
        float sp[16], pr[16];
#pragma unroll
        for (int r = 0; r < 16; ++r) { const bool valid = !diag || (crow(r, hi) < r32); sp[r] = valid ? softplus_f(s[r]) : 0.f; }
        float T[4], U[4];
#pragma unroll
        for (int g = 0; g < 4; ++g) { T[g] = (sp[4 * g] + sp[4 * g + 1]) + (sp[4 * g + 2] + sp[4 * g + 3]); U[g] = __shfl_xor(T[g], 32); }
        float run = 0.f, above[4];
#pragma unroll
        for (int g = 3; g >= 0; --g) { above[g] = run + (hi == 0 ? U[g] : 0.f); run += T[g] + U[g]; }
#pragma unroll
        for (int g = 0; g < 4; ++g) { float c = R + above[g];
#pragma unroll
            for (int j = 3; j >= 0; --j) { const int r = 4 * g + j; c += sp[r]; const bool valid = !diag || (crow(r, hi) < r32); pr[r] = valid ? __expf(s[r] - c) : 0.f; } }
        R += run;
        const bf16x8 p0 = pack8(pr), p1 = pack8(pr + 8);
        LDS_WAIT();
        const bf16x8 v00 = vfrag(vrd, 0), v01 = vfrag(vrd, 1024), v10 = vfrag(vrd, 2048), v11 = vfrag(vrd, 3072);
        o0 = MFMA32(v00, p0, o0); o0 = MFMA32(v01, p1, o0);
        o1 = MFMA32(v10, p0, o1); o1 = MFMA32(v11, p1, o1);
        asm volatile("" ::: "memory");
        if (__all(R > 30.0f)) break;
    }
    bf16_t* op = osb + (tok0 + r32) * 512 + h * 64 + 4 * hi;
#pragma unroll
    for (int g = 0; g < 4; ++g) {
        u32x2 w0, w1; w0.x = cvt_pk_bf16(o0[4 * g], o0[4 * g + 1]); w0.y = cvt_pk_bf16(o0[4 * g + 2], o0[4 * g + 3]); w1.x = cvt_pk_bf16(o1[4 * g], o1[4 * g + 1]); w1.y = cvt_pk_bf16(o1[4 * g + 2], o1[4 * g + 3]);
        *(u32x2*)(op + 8 * g) = w0; *(u32x2*)(op + 32 + 8 * g) = w1; }
}

__device__ __forceinline__ void mem_item(const bf16_t* proj, const bf16_t* mkv, bf16_t* omem, int b, int h, int qblk, LAS unsigned char* vlds  , int lane) {
    const int r32 = lane & 31, hi = lane >> 5;
    const size_t tok0 = (size_t)b * SEQ + (size_t)qblk * 32;
    bf16x8 qr[8];
    { const bf16_t* qp = proj + (tok0 + r32) * PW + C_MQ + h * 128 + hi * 8;
#pragma unroll
      for (int kk = 0; kk < 8; ++kk) qr[kk] = *(const bf16x8*)(qp + kk * 16); }
    f32x16 o[4] = {{}, {}, {}, {}}; float m = -1e30f, l = 0.f;
    const lds_cptr vrd = (lds_cptr)vlds + vtr_lane_off(lane);
    for (int kb = 0; kb < 8; ++kb) {
        const size_t key0 = (size_t)b * MEMLEN + (size_t)kb * 32;
        const bf16_t* kp = mkv + (key0 + r32) * DM + h * 128 + hi * 8;
        f32x16 s = {};
#pragma unroll
        for (int kk = 0; kk < 8; ++kk) { const bf16x8 kf = *(const bf16x8*)(kp + kk * 16); s = MFMA32(kf, qr[kk], s); }
        u32x4 vv[8];
#pragma unroll
        for (int p = 0; p < 8; ++p) vv[p] = *(const u32x4*)(mkv + (key0 + 16 * (p & 1) + (lane >> 2)) * DM + 512 + h * 128 + (p >> 1) * 32 + (lane & 3) * 8);
        asm volatile("" ::: "memory");
#pragma unroll
        for (int p = 0; p < 8; ++p) *(LAS u32x4*)(vlds + p * 1024 + lane * 16) = vv[p];
        float mx = s[0];
#pragma unroll
        for (int r = 1; r < 16; ++r) mx = fmaxf(mx, s[r]);
        mx = fmaxf(mx, __shfl_xor(mx, 32));
        const float mn = fmaxf(m, mx), alpha = __builtin_amdgcn_exp2f(m - mn);
        float pr[16], rs = 0.f;
#pragma unroll
        for (int r = 0; r < 16; ++r) { pr[r] = __builtin_amdgcn_exp2f(s[r] - mn); rs += pr[r]; }
        l = l * alpha + rs; m = mn;
#pragma unroll
        for (int d = 0; d < 4; ++d)
#pragma unroll
            for (int r = 0; r < 16; ++r) o[d][r] *= alpha;
        const bf16x8 p0 = pack8(pr), p1 = pack8(pr + 8);
        LDS_WAIT();
#pragma unroll
        for (int d = 0; d < 4; ++d) { const bf16x8 va = vfrag(vrd, d * 2048), vb = vfrag(vrd, d * 2048 + 1024); o[d] = MFMA32(va, p0, o[d]); o[d] = MFMA32(vb, p1, o[d]); }
        asm volatile("" ::: "memory");
    }
    l += __shfl_xor(l, 32);
    const float il = 1.0f / l;
    bf16_t* op = omem + (tok0 + r32) * 512 + h * 128 + 4 * hi;
#pragma unroll
    for (int d = 0; d < 4; ++d)
#pragma unroll
        for (int g = 0; g < 4; ++g) { u32x2 w; w.x = cvt_pk_bf16(o[d][4 * g] * il, o[d][4 * g + 1] * il); w.y = cvt_pk_bf16(o[d][4 * g + 2] * il, o[d][4 * g + 3] * il); *(u32x2*)(op + 32 * d + 8 * g) = w; }
}

constexpr int DL_HIST = 0, DL_PREFIX = 66048, DL_KREM = DL_PREFIX + 256, DL_MASK = 67072, DL_VT = 73728, DL_END = DL_VT + 2 * 16384;
constexpr int TOPK_DSA = 256;

__device__ __forceinline__ void idx_scores(const bf16_t* iq_row  , const bf16_t* ik_row  , const float (&wq)[4], unsigned (&uk)[16]) {
    bf16x8 kf[4];
#pragma unroll
    for (int kk = 0; kk < 4; ++kk) kf[kk] = *(const bf16x8*)(ik_row + kk * 16);
    float scv[16];
#pragma unroll
    for (int hd = 0; hd < 4; ++hd) { f32x16 a = (f32x16){};
#pragma unroll
        for (int kk = 0; kk < 4; ++kk) { const bf16x8 qf = *(const GAS bf16x8*)((const GAS bf16_t*)iq_row + hd * 64 + kk * 16); a = MFMA32(kf[kk], qf, a); }
#pragma unroll
        for (int r = 0; r < 16; ++r) scv[r] = (hd == 0) ? wq[0] * fmaxf(a[r], 0.f) : __builtin_fmaf(wq[hd], fmaxf(a[r], 0.f), scv[r]); }
#pragma unroll
    for (int r = 0; r < 16; ++r) {
        const float sc = scv[r];
        unsigned bits = __builtin_bit_cast(unsigned, sc);
        if (bits == 0x80000000u) bits = 0u;
        uk[r] = (bits & 0x80000000u) ? ~bits : (bits | 0x80000000u);
    }
}

__device__ __forceinline__ void dsa_unit(const bf16_t* proj, bf16_t* odsa, int b, int c, LAS unsigned char* dl, int tid) {
    const int lane = tid & 63, wid = __builtin_amdgcn_readfirstlane(tid >> 6), r32 = lane & 31, hi = lane >> 5;
    const int n = 64 * (c + 1), nsteps = (n + 127) >> 7;
    const size_t tokq0 = (size_t)b * SEQ + (size_t)c * 64, tokb = (size_t)b * SEQ;
    LAS unsigned* hist = (LAS unsigned*)(dl + DL_HIST);
    LAS unsigned* prefix = (LAS unsigned*)(dl + DL_PREFIX);
    LAS unsigned* krem = (LAS unsigned*)(dl + DL_KREM);
    LAS unsigned* mask = (LAS unsigned*)(dl + DL_MASK);
    const int kb = wid >> 1, qh = wid & 1;
    const bf16_t* iq_row = proj + (tokq0 + 32 * qh + r32) * PW + C_IQ + 8 * hi;
    float wq[4];
    { const u32x2 w = *(const u32x2*)(proj + (tokq0 + 32 * qh + r32) * PW + C_IW);
      wq[0] = bflo(w.x) * 0.0625f; wq[1] = bfhi(w.x) * 0.0625f; wq[2] = bflo(w.y) * 0.0625f; wq[3] = bfhi(w.y) * 0.0625f; }
    if (tid < 64) { prefix[tid] = 0u; krem[tid] = (n > TOPK_DSA) ? (unsigned)TOPK_DSA : 0x7fffffffu; }
    __syncthreads();
#ifndef NO_SEL
    if (n > TOPK_DSA) {
        for (int pass = 0; pass < 4; ++pass) {
            for (int i = tid; i < 64 * 257; i += 512) hist[i] = 0u;
            __syncthreads();
            const int shift = 24 - 8 * pass;
            const unsigned pfx = prefix[32 * qh + r32];
            for (int step = 0; step < nsteps; ++step) {
                const int kbase = 128 * step + 32 * kb;
                if (kbase < n) {
                    unsigned uk[16];
                    const bf16_t* iq_l = iq_row; asm volatile("" : "+v"(iq_l));
                    idx_scores(iq_l, proj + (tokb + kbase + r32) * PW + C_IK + 8 * hi, wq, uk);
#pragma unroll
                    for (int r = 0; r < 16; ++r) {
                        const bool match = (pass == 0) || ((uk[r] >> (shift + 8)) == pfx);
                        if (match) __hip_atomic_fetch_add(hist + (32 * qh + r32) * 257 + ((uk[r] >> shift) & 255u), 1u, __ATOMIC_RELAXED, __HIP_MEMORY_SCOPE_WORKGROUP);
                    }
                }
            }
            __syncthreads();
            for (int qi = 0; qi < 8; ++qi) {
                const int q = 8 * wid + qi;
                const LAS unsigned* hq = hist + q * 257;
                const unsigned c0 = hq[255 - 4 * lane], c1 = hq[254 - 4 * lane], c2 = hq[253 - 4 * lane], c3 = hq[252 - 4 * lane];
                const unsigned s4 = c0 + c1 + c2 + c3;
                unsigned incl = s4;
#pragma unroll
                for (int o = 1; o < 64; o <<= 1) { const unsigned t = __shfl_up(incl, o); if (lane >= o) incl += t; }
                const unsigned excl = incl - s4, kr = krem[q];
                if (excl < kr && kr <= incl) {
                    unsigned cum = excl, bin, nk;
                    if (cum + c0 >= kr) { bin = 255 - 4 * lane; nk = kr - cum; }
                    else { cum += c0; if (cum + c1 >= kr) { bin = 254 - 4 * lane; nk = kr - cum; }
                    else { cum += c1; if (cum + c2 >= kr) { bin = 253 - 4 * lane; nk = kr - cum; }
                    else { cum += c2; bin = 252 - 4 * lane; nk = kr - cum; } } }
                    prefix[q] = (prefix[q] << 8) | bin; krem[q] = nk;
                }
            }
            __syncthreads();
        }
    }
#endif
#ifndef NO_ATT
    LAS unsigned* selall = (LAS unsigned*)(dl + DL_HIST);
    {
        const unsigned thr = prefix[32 * qh + r32];
        for (int step = 0; step < nsteps; ++step) {
            LAS unsigned* mk = mask + (step & 1) * 768;
            { const int kbase = 128 * step + 32 * kb; unsigned gtw = 0u, eqw = 0u;
              if (kbase < n) { unsigned uk[16];
                  const bf16_t* iq_l = iq_row; asm volatile("" : "+v"(iq_l));
                  idx_scores(iq_l, proj + (tokb + kbase + r32) * PW + C_IK + 8 * hi, wq, uk);
#pragma unroll
                  for (int r = 0; r < 16; ++r) { gtw |= (uk[r] > thr ? 1u : 0u) << crow(r, hi); eqw |= (uk[r] == thr ? 1u : 0u) << crow(r, hi); } }
              gtw |= __shfl_xor(gtw, 32); eqw |= __shfl_xor(eqw, 32);
              if (hi == 0) { mk[(32 * qh + r32) * 4 + kb] = gtw; mk[256 + (32 * qh + r32) * 4 + kb] = eqw; } }
            __syncthreads();
            if (wid == 0) { unsigned nd = krem[lane];
#pragma unroll
                for (int k4 = 0; k4 < 4; ++k4) { const unsigned g = mk[lane * 4 + k4]; unsigned e = mk[256 + lane * 4 + k4]; unsigned sel = g;
                    if (e != 0u) { const unsigned cnt = (unsigned)__builtin_popcount(e);
                        if (cnt <= nd) { sel |= e; nd -= cnt; }
                        else { unsigned chosen = 0u; while (nd > 0u) { const unsigned lb = e & (0u - e); chosen |= lb; e ^= lb; --nd; } sel |= chosen; } }
                    selall[lane * 64 + step * 4 + k4] = sel; }
                krem[lane] = nd; }
        }
        __syncthreads();
    }
    const int hd = wid;
    for (int qb = 0; qb < 2; ++qb) {
        bf16x8 qr[4];
        { const bf16_t* qp = proj + (tokq0 + 32 * qb + r32) * PW + C_DQ + hd * 64 + 8 * hi;
#pragma unroll
          for (int kk = 0; kk < 4; ++kk) qr[kk] = *(const bf16x8*)(qp + kk * 16); }
        f32x16 o0 = {}, o1 = {}; float mrun = -1e30f, lrun = 0.f;
        for (int step = 0; step < nsteps; ++step) {
            LAS unsigned char* vt = dl + DL_VT + (step & 1) * 16384;
#pragma unroll
            for (int i = 0; i < 2; ++i) { const int ch = tid + 512 * i, key = ch >> 3, c8 = ch & 7, kk = key & 31;
                int krow = 128 * step + key; if (krow > SEQ - 1) krow = SEQ - 1;
                const u32x4 v = *(const u32x4*)(proj + (tokb + krow) * PW + C_DV + c8 * 8);
                *(LAS u32x4*)(vt + (key >> 5) * 4096 + ((c8 >> 2) * 2 + (kk >> 4)) * 1024 + (kk & 15) * 64 + (c8 & 3) * 16) = v; }
            __syncthreads();
            for (int k4 = 0; k4 < 4; ++k4) {
                const int kbase = 128 * step + 32 * k4;
                if (kbase >= n) break;
                const bf16_t* kp = proj + (tokb + kbase + r32) * PW + C_DK + 8 * hi;
                f32x16 s = {};
#pragma unroll
                for (int kk = 0; kk < 4; ++kk) { const bf16x8 kf = *(const bf16x8*)(kp + kk * 16); s = MFMA32(kf, qr[kk], s); }
                const lds_cptr vrd = (lds_cptr)vt + k4 * 4096 + vtr_lane_off(lane);
                const unsigned selw = selall[(32 * qb + r32) * 64 + step * 4 + k4];
                float mx = -INFINITY;
#pragma unroll
                for (int r = 0; r < 16; ++r) { if (!((selw >> crow(r, hi)) & 1u)) s[r] = -INFINITY; mx = fmaxf(mx, s[r]); }
                mx = fmaxf(mx, __shfl_xor(mx, 32));
                const float mn = fmaxf(mrun, mx), alpha = __builtin_amdgcn_exp2f(mrun - mn);
                float pr[16], rs = 0.f;
#pragma unroll
                for (int r = 0; r < 16; ++r) { pr[r] = __builtin_amdgcn_exp2f(s[r] - mn); rs += pr[r]; }
                lrun = lrun * alpha + rs; mrun = mn;
#pragma unroll
                for (int r = 0; r < 16; ++r) { o0[r] *= alpha; o1[r] *= alpha; }
                const bf16x8 p0 = pack8(pr), p1 = pack8(pr + 8);
                const bf16x8 v00 = vfrag(vrd, 0), v01 = vfrag(vrd, 1024), v10 = vfrag(vrd, 2048), v11 = vfrag(vrd, 3072);
                o0 = MFMA32(v00, p0, o0); o0 = MFMA32(v01, p1, o0);
                o1 = MFMA32(v10, p0, o1); o1 = MFMA32(v11, p1, o1);
            }
        }
        float l = lrun; l += __shfl_xor(l, 32);
        const float il = 1.0f / l;
        bf16_t* op = odsa + (tokq0 + 32 * qb + r32) * 512 + hd * 64 + 4 * hi;
#pragma unroll
        for (int g = 0; g < 4; ++g) {
            u32x2 w0, w1; w0.x = cvt_pk_bf16(o0[4 * g] * il, o0[4 * g + 1] * il); w0.y = cvt_pk_bf16(o0[4 * g + 2] * il, o0[4 * g + 3] * il);
            w1.x = cvt_pk_bf16(o1[4 * g] * il, o1[4 * g + 1] * il); w1.y = cvt_pk_bf16(o1[4 * g + 2] * il, o1[4 * g + 3] * il);
            *(u32x2*)(op + 8 * g) = w0; *(u32x2*)(op + 32 + 8 * g) = w1; }
        __syncthreads();
    }
#endif
    __syncthreads();
}

constexpr int RL_WR = 0, RL_WR_STRIDE = 1028, RL_TKE = 131584, RL_TKW = RL_TKE + 4096;
__device__ __forceinline__ void p9_router(Frame& F) {
    const int lane = F.lane, wave = F.wave, tid = F.tid;
    LAS float* Wr = (LAS float*)(F.lds + RL_WR);
    LAS int* tke = (LAS int*)(F.lds + RL_TKE); LAS float* tkw = (LAS float*)(F.lds + RL_TKW);
    const float* w_router = F.in[15]; const float* b_router = F.in[16]; const float* g_ffn = F.in[14];
    for (int idx = tid; idx < DM * NEXP; idx += NWAVES * 64) { const int k = idx >> 5, e = idx & 31; Wr[e * RL_WR_STRIDE + k] = w_router[idx]; }
    if (tid < 32) F.MISC[MW_LCNT + tid] = 0u;
    __syncthreads();
    bf16_t* h2 = (bf16_t*)(F.ws + WS_H);
    const GAS f32x4* gr = (const GAS f32x4*)g_ffn + lane;
    f32x4 gg[4];
#pragma unroll
    for (int j = 0; j < 4; ++j) gg[j] = gr[64 * j];
    const float bias_e = b_router[lane >> 1];
    for (int it = 0; it < 16; ++it) {
        const int tl0 = 32 * wave + 2 * it;
        f32x4 hn[2][4];
#pragma unroll
        for (int tk = 0; tk < 2; ++tk) {
            const size_t t = (size_t)F.blk * 256 + tl0 + tk;
            const GAS f32x4* xr = (const GAS f32x4*)(F.out + t * DM) + lane;
            float s = 0.f;
#pragma unroll
            for (int j = 0; j < 4; ++j) { hn[tk][j] = xr[64 * j]; s += (hn[tk][j].x * hn[tk][j].x + hn[tk][j].y * hn[tk][j].y) + (hn[tk][j].z * hn[tk][j].z + hn[tk][j].w * hn[tk][j].w); }
            const float rstd = 1.0f / sqrtf(wave_sum(s) * (1.f / DM) + EPS);
            GAS u32x2* o8 = (GAS u32x2*)(h2 + t * DM) + lane;
#pragma unroll
            for (int j = 0; j < 4; ++j) { hn[tk][j] = hn[tk][j] * rstd * gg[j]; u32x2 o; o.x = pk2(hn[tk][j].x, hn[tk][j].y); o.y = pk2(hn[tk][j].z, hn[tk][j].w); o8[64 * j] = o; }
        }
        float acc[2][32];
        const LAS float* wl = Wr + 4 * lane; asm volatile("" : "+v"(wl));
#pragma unroll
        for (int e = 0; e < 32; ++e) {
            float a0 = 0.f, a1 = 0.f;
#pragma unroll
            for (int j = 0; j < 4; ++j) { const f32x4 w = *(const LAS f32x4*)(wl + e * RL_WR_STRIDE + 256 * j);
                a0 += (hn[0][j].x * w.x + hn[0][j].y * w.y) + (hn[0][j].z * w.z + hn[0][j].w * w.w);
                a1 += (hn[1][j].x * w.x + hn[1][j].y * w.y) + (hn[1][j].z * w.z + hn[1][j].w * w.w); }
            asm volatile("" : "+v"(a0), "+v"(a1));
            acc[0][e] = a0; acc[1][e] = a1;
        }
#pragma unroll
        for (int tk = 0; tk < 2; ++tk) {
            float v16[16], v8[8], v4[4], v2[2];
            const bool b5 = (lane & 32) != 0, b4 = (lane & 16) != 0, b3 = (lane & 8) != 0, b2 = (lane & 4) != 0, b1 = (lane & 2) != 0;
#pragma unroll
            for (int i = 0; i < 16; ++i) { const float mine = b5 ? acc[tk][16 + i] : acc[tk][i], oth = b5 ? acc[tk][i] : acc[tk][16 + i]; v16[i] = mine + __shfl_xor(oth, 32); }
#pragma unroll
            for (int i = 0; i < 8; ++i) { const float mine = b4 ? v16[8 + i] : v16[i], oth = b4 ? v16[i] : v16[8 + i]; v8[i] = mine + __shfl_xor(oth, 16); }
#pragma unroll
            for (int i = 0; i < 4; ++i) { const float mine = b3 ? v8[4 + i] : v8[i], oth = b3 ? v8[i] : v8[4 + i]; v4[i] = mine + __shfl_xor(oth, 8); }
#pragma unroll
            for (int i = 0; i < 2; ++i) { const float mine = b2 ? v4[2 + i] : v4[i], oth = b2 ? v4[i] : v4[2 + i]; v2[i] = mine + __shfl_xor(oth, 4); }
            float v1; { const float mine = b1 ? v2[1] : v2[0], oth = b1 ? v2[0] : v2[1]; v1 = mine + __shfl_xor(oth, 2); }
            float val = v1 + __shfl_xor(v1, 1) + bias_e;
            const int e = lane >> 1;
            float topv[4]; int topi[4];
#pragma unroll
            for (int k = 0; k < 4; ++k) {
                float bv = val; int bi = e;
#pragma unroll
                for (int o = 1; o < 64; o <<= 1) { const float ov = __shfl_xor(bv, o); const int oi = __shfl_xor(bi, o); if (ov > bv || (ov == bv && oi < bi)) { bv = ov; bi = oi; } }
                topv[k] = bv; topi[k] = bi; if (e == bi) val = -INFINITY;
            }
            const float e1 = __expf(topv[1] - topv[0]), e2 = __expf(topv[2] - topv[0]), e3 = __expf(topv[3] - topv[0]);
            const float inv = 1.0f / (1.0f + e1 + e2 + e3);
            const float gate[4] = {inv, e1 * inv, e2 * inv, e3 * inv};
            const int tl = tl0 + tk;
#pragma unroll
            for (int k = 0; k < 4; ++k) if (lane == k) { tke[tl * 4 + k] = topi[k]; tkw[tl * 4 + k] = gate[k];
                __hip_atomic_fetch_add((LAS unsigned*)F.MISC + MW_LCNT + topi[k], 1u, __ATOMIC_RELAXED, __HIP_MEMORY_SCOPE_WORKGROUP); }
        }
    }
    __syncthreads();
    if (tid < 32) ((int*)(F.ws + WS_BLKCNT))[F.blk * 32 + tid] = (int)F.MISC[MW_LCNT + tid];
}
__device__ __forceinline__ void p10_assign(Frame& F) {
    const int tid = F.tid;
    const int* blkcnt = (const int*)(F.ws + WS_BLKCNT);
    LAS int* part = (LAS int*)(F.lds);
    LAS int* tke = (LAS int*)(F.lds + RL_TKE); LAS float* tkw = (LAS float*)(F.lds + RL_TKW);
    { const int e = tid & 31, p = tid >> 5; int tot = 0, bef = 0;
      for (int j = 0; j < 16; ++j) { const int bl = p * 16 + j; const int c = blkcnt[bl * 32 + e]; tot += c; bef += (bl < F.blk) ? c : 0; }
      part[p * 32 + e] = tot; part[512 + p * 32 + e] = bef; }
    __syncthreads();
    if (tid < 32) { int tot = 0, bef = 0;
        for (int p = 0; p < 16; ++p) { tot += part[p * 32 + tid]; bef += part[512 + p * 32 + tid]; }
        part[1024 + tid] = tot; F.MISC[MW_BEFORE + tid] = (unsigned)bef; F.MISC[MW_LCNT + tid] = 0u; }
    __syncthreads();
    if (tid == 0) { int ps = 0;
        for (int e = 0; e < 32; ++e) { F.MISC[MW_PSTART + e] = (unsigned)ps; F.MISC[MW_TSTART + e] = (unsigned)(ps >> 8); ps += (part[1024 + e] + 255) & ~255; }
        F.MISC[MW_PSTART + 32] = (unsigned)ps; F.MISC[MW_TSTART + 32] = (unsigned)(ps >> 8); }
    __syncthreads();
    int* slot_tok = (int*)(F.ws + WS_SLOT_TOK); float* slot_w = (float*)(F.ws + WS_SLOT_W);
    for (int idx = tid; idx < 1024; idx += NWAVES * 64) {
        const int e = tke[idx]; const float w = tkw[idx];
        const unsigned r = __hip_atomic_fetch_add((LAS unsigned*)F.MISC + MW_LCNT + e, 1u, __ATOMIC_RELAXED, __HIP_MEMORY_SCOPE_WORKGROUP);
        const unsigned pos = F.MISC[MW_PSTART + e] + F.MISC[MW_BEFORE + e] + r;
        slot_tok[pos] = F.blk * 256 + (idx >> 2); slot_w[pos] = w;
    }
}

#ifndef MK_ONE_LAUNCH
#define MK_ONE_LAUNCH 1
#endif
constexpr int N_PHASES = 13;
struct Args { const float* in[21]; float* out; unsigned char* ws; int ph_lo, ph_hi; };
static_assert(sizeof(Args) == 21 * 8 + 8 + 8 + 8, "no padding");

__global__ void __launch_bounds__(NWAVES * 64, 2) fwd_kernel(Args args) {
    extern __shared__ __attribute__((aligned(16))) unsigned char lds[];
    Frame F;
    F.lds = (LAS unsigned char*)lds;
    F.MISC = (volatile LAS unsigned*)(F.lds + MISC_OFF);
    F.tid = threadIdx.x; F.lane = F.tid & 63; F.wave = __builtin_amdgcn_readfirstlane(F.tid >> 6);
    F.G = gridDim.x; F.blk = blockIdx.x;
    F.ws = args.ws; F.out = args.out; F.ctl = (gu32*)(args.ws + WS_CTL);
#pragma unroll
    for (int i = 0; i < 21; ++i) F.in[i] = args.in[i];
    for (int u = F.tid; u < (LDS_BYTES - MISC_OFF) / 4; u += NWAVES * 64) ((LAS unsigned*)(F.lds + MISC_OFF))[u] = 0u;
    __syncthreads();
    const int lo = args.ph_lo, hi = args.ph_hi;
    XcdBarrier bar; bar.bar = (unsigned*)(F.ctl + CW_BAR); bar.x = 0; bar.st = nullptr;
    if (hi - lo > 1) bar = xcd_barrier_post((unsigned*)(F.ctl + CW_BAR), F.MISC + MW_BAR);
#ifndef PH_MASK
#define PH_MASK 0x1fff
#endif
#define IN(k) (((PH_MASK >> (k)) & 1) && lo <= (k) && (k) < hi)
#define SEAM(k) do { if (IN(k) && IN((k) + 1)) xcd_barrier(bar); } while (0)
    unsigned char* ws = args.ws;
    bf16_t* proj = (bf16_t*)(ws + WS_P);

    if (IN(0)) { p0_prologue(F); } SEAM(0);

    if (IN(1)) {
        { pg8::DenseSched S; S.init(ws + WS_H, ws + WS_WIN, NTOK, PW, DM, F.G, F.blk);
          pg8::EpiBf16<0> E{proj, PW, nullptr};
          pg8::gemm_phase<pg8::EpiBf16<0>, pg8::DenseSched, true>(F.lds, DM, S, E); }
        { pg8::DenseSched S; S.init(ws + WS_MEMN, ws + WS_WMKV, NMEM, DM, DM, F.G, F.blk);
          pg8::EpiBf16<0> E{(bf16_t*)(ws + WS_MKV), DM, nullptr};
          pg8::gemm_phase<pg8::EpiBf16<0>, pg8::DenseSched, true>(F.lds, DM, S, E); }
    } SEAM(1);

    if (IN(2)) { p2_prep(F); } SEAM(2);

    if (IN(3)) {
        bf16_t* osb = (bf16_t*)(ws + WS_O); bf16_t* odsa = osb + (size_t)NTOK * 512; bf16_t* omem = odsa + (size_t)NTOK * 512;
#ifndef NO_DSA
        if (F.G == 256) {
            for (int i = 0; i < 4; ++i) { const int p = 2 * F.blk + (i >> 1), b = p >> 4, cc = p & 15, c = (i & 1) ? 31 - cc : cc; dsa_unit(proj, odsa, b, c, F.lds, F.tid); }
        } else {
            for (int u = F.blk; u < 1024; u += F.G) dsa_unit(proj, odsa, u >> 5, u & 31, F.lds, F.tid);
        }
#endif
        const int gw = F.blk * NWAVES + F.wave, NGW = F.G * NWAVES;
#ifndef NO_SB
        for (int it = gw; it < NB * 8 * 64; it += NGW) { const int qblk = 63 - (it >> 8), bh = it & 255; sb_item(proj, osb, bh >> 3, bh & 7, qblk, F.lds + F.wave * 4096, F.lane); }
#endif
#ifndef NO_MEM
        for (int it = gw; it < NB * 4 * 64; it += NGW) { const int qblk = it & 63, bh = it >> 6; mem_item(proj, (const bf16_t*)(ws + WS_MKV), omem, bh >> 2, bh & 3, qblk, F.lds + 32768 + F.wave * 8192, F.lane); }
#endif
    } SEAM(3);

    if (IN(4)) {
        pg8::DenseSched S; S.init(ws + WS_H, ws + WS_WG, NTOK, 3 * DM, DM, F.G, F.blk);
        pg8::EpiBf16<2> E{proj, PW, F.in[11]};
        pg8::gemm_phase<pg8::EpiBf16<2>, pg8::DenseSched, true>(F.lds, DM, S, E);
    } SEAM(4);

    if (IN(5)) { pg8::DenseSched S; S.init(ws + WS_O, ws + WS_WB, NTOK, DM, 512, F.G, F.blk);
        pg8::EpiMerge E{proj, 0, (bf16_t*)(ws + WS_H), 1};
        pg8::gemm_phase<pg8::EpiMerge, pg8::DenseSched, true>(F.lds, 512, S, E); } SEAM(5);
    if (IN(6)) { pg8::DenseSched S; S.init(ws + WS_O + (size_t)NTOK * 1024, ws + WS_WB + (size_t)DM * 1024, NTOK, DM, 512, F.G, F.blk);
        pg8::EpiMerge E{proj, DM, (bf16_t*)(ws + WS_H), 0};
        pg8::gemm_phase<pg8::EpiMerge, pg8::DenseSched, true>(F.lds, 512, S, E); } SEAM(6);
    if (IN(7)) { pg8::DenseSched S; S.init(ws + WS_O + (size_t)NTOK * 2048, ws + WS_WB + (size_t)DM * 2048, NTOK, DM, 512, F.G, F.blk);
        pg8::EpiMerge E{proj, 2 * DM, (bf16_t*)(ws + WS_H), 0};
        pg8::gemm_phase<pg8::EpiMerge, pg8::DenseSched, true>(F.lds, 512, S, E); } SEAM(7);

    if (IN(8)) {
        pg8::DenseSched S; S.init(ws + WS_H, ws + WS_WO, NTOK, DM, DM, F.G, F.blk);
        pg8::EpiResid E{F.in[0], F.out};
        pg8::gemm_phase<pg8::EpiResid, pg8::DenseSched, true>(F.lds, DM, S, E);
    } SEAM(8);

    if (IN(9)) { p9_router(F); } SEAM(9);
    if (IN(10)) { p10_assign(F); } SEAM(10);

    if (IN(11)) {
        pg8::MoeSched S{(const char*)(ws + WS_H), (const char*)(ws + WS_WEI), (const int*)(ws + WS_SLOT_TOK), F.MISC + MW_TSTART, DM, 2048, 8, F.blk};
        pg8::EpiSwiglu E{(bf16_t*)(ws + WS_P), F.in[18]};
        pg8::gemm_phase<pg8::EpiSwiglu, pg8::MoeSched, true>(F.lds, DM, S, E);
    } SEAM(11);

    if (IN(12)) {
        pg8::MoeSched S{(const char*)(ws + WS_P), (const char*)(ws + WS_WEO), nullptr, F.MISC + MW_TSTART, DM, DM, 4, F.blk};
        pg8::EpiScatter E{F.out, (const int*)(ws + WS_SLOT_TOK), (const float*)(ws + WS_SLOT_W), F.in[20]};
        pg8::gemm_phase<pg8::EpiScatter, pg8::MoeSched, true>(F.lds, DM, S, E);
    }
#undef IN
#undef SEAM
}

extern "C" void kernel_launch(void* const* d_in, const int* in_sizes, int n_in, void* d_out, int out_size, void* d_ws, size_t ws_size, hipStream_t stream) {
    static int grid = 0;
    if (grid == 0) {
        if (n_in != 21 || in_sizes[0] != NTOK * DM || out_size != NTOK * DM || ws_size < WS_END) {
            fprintf(stderr, "kernel_launch: unexpected shapes: n_in %d in0 %d out %d ws %zu (need >= %zu); nothing launched\n", n_in, n_in > 0 ? in_sizes[0] : -1, out_size, ws_size, (size_t)WS_END); grid = -1; return; }
        int dev = 0, cus = 0, per_cu = 0;
        if (hipGetDevice(&dev) != hipSuccess || hipDeviceGetAttribute(&cus, hipDeviceAttributeMultiprocessorCount, dev) != hipSuccess) { fprintf(stderr, "kernel_launch: device query failed\n"); grid = -1; return; }
        if (hipFuncSetAttribute((const void*)fwd_kernel, hipFuncAttributeMaxDynamicSharedMemorySize, LDS_BYTES) != hipSuccess) { fprintf(stderr, "kernel_launch: hipFuncSetAttribute failed\n"); grid = -1; return; }
        if (hipOccupancyMaxActiveBlocksPerMultiprocessor(&per_cu, (const void*)fwd_kernel, NWAVES * 64, LDS_BYTES) != hipSuccess || per_cu < 1)
            fprintf(stderr, "kernel_launch: note: occupancy query reports %d workgroups per CU\n", per_cu);
        (void)hipGetLastError();
        grid = cus;
        if (grid != 256) { fprintf(stderr, "kernel_launch: this kernel is built for 256 CUs (got %d); nothing launched\n", grid); grid = -1; return; }
    }
    if (grid < 0) return;
    if (hipMemsetAsync((char*)d_ws + WS_CTL, 0, CTL_ZERO_BYTES, stream) != hipSuccess) { fprintf(stderr, "kernel_launch: hipMemsetAsync failed\n"); return; }
    Args a{};
    for (int i = 0; i < 21; ++i) a.in[i] = (const float*)d_in[i];
    a.out = (float*)d_out; a.ws = (unsigned char*)d_ws;
#if MK_ONE_LAUNCH
    const int cuts[2] = {0, N_PHASES}; const int nl = 1;
#else
    const int cuts[11] = {0, 1, 2, 3, 4, 5, 6, 7, 8, 9, N_PHASES}; const int nl = 10;
#endif
    for (int li = 0; li < nl; ++li) {
        a.ph_lo = cuts[li]; a.ph_hi = cuts[li + 1];
        hipLaunchKernelGGL(fwd_kernel, dim3(grid), dim3(NWAVES * 64), LDS_BYTES, stream, a);
        const hipError_t le = hipPeekAtLastError();
        if (le != hipSuccess) { fprintf(stderr, "kernel_launch: launch %d failed: %s\n", li, hipGetErrorName(le)); break; }
    }
}
```

```cpp
#include <hip/hip_runtime.h>
#include <cstdio>
#include <cstdint>

#define LAS __attribute__((address_space(3)))
#define GAS __attribute__((address_space(1)))
typedef unsigned short bf16_t;
typedef short bf16x8 __attribute__((ext_vector_type(8)));
typedef short s16x4 __attribute__((ext_vector_type(4)));
typedef short v4i16_t __attribute__((ext_vector_type(4)));
typedef float f32x2 __attribute__((ext_vector_type(2)));
typedef float f32x4 __attribute__((ext_vector_type(4)));
typedef float f32x16 __attribute__((ext_vector_type(16)));
typedef unsigned u32x2 __attribute__((ext_vector_type(2)));
typedef unsigned u32x4 __attribute__((ext_vector_type(4)));
typedef GAS unsigned gu32;

constexpr int NB = 32, SEQ = 2048, DM = 1024, NTOK = NB * SEQ;
constexpr int MEMLEN = 256, NMEM = NB * MEMLEN;
constexpr int PW = 3072;
constexpr int C_SQ = 0, C_SK = 512, C_SV = 1024, C_DQ = 1536, C_DK = 2048, C_DV = 2112, C_IQ = 2176, C_IK = 2432, C_IW = 2496, C_MQ = 2560;
constexpr int IN_W = 3012;
constexpr int NEXP = 32, TOPK = 4, DEXP = 1024;
constexpr int NSLOT = NTOK * TOPK;
constexpr int NSLOT_PAD = NSLOT + NEXP * 256;
constexpr float EPS = 1e-6f;
constexpr float LOG2E = 1.4426950408889634f;

constexpr size_t MiB = 1u << 20;
constexpr size_t WS_CTL = 0, CTL_ZERO_BYTES = 1 * MiB;
constexpr size_t WS_ROPE = 1 * MiB;
constexpr size_t WS_BLKCNT = 1 * MiB + 512 * 1024;
constexpr size_t WS_SLOT_TOK = 2 * MiB;
constexpr size_t WS_SLOT_W = 4 * MiB;
constexpr size_t WS_WIN = 8 * MiB;
constexpr size_t WS_WMKV = 14 * MiB;
constexpr size_t WS_WG = 16 * MiB;
constexpr size_t WS_WB = 22 * MiB;
constexpr size_t WS_WO = 25 * MiB;
constexpr size_t WS_WEI = 27 * MiB;
constexpr size_t WS_WEO = 155 * MiB;
constexpr size_t WS_H = 220 * MiB;
constexpr size_t WS_P = 348 * MiB;
constexpr size_t WS_O = 732 * MiB;
constexpr size_t WS_MEMN = 924 * MiB;
constexpr size_t WS_MKV = 940 * MiB;
constexpr size_t WS_END = 956 * MiB;
static_assert(WS_P + (size_t)NSLOT_PAD * DEXP * 2 <= WS_MEMN, "act overlays proj|o");
static_assert(WS_SLOT_TOK + (size_t)NSLOT_PAD * 4 <= WS_SLOT_W && WS_SLOT_W + (size_t)NSLOT_PAD * 4 <= WS_WIN, "slot tables");

constexpr int CW_BAR = 4096;

constexpr int RING_BYTES = 151552;
constexpr int MISC_OFF = RING_BYTES;
constexpr int LDS_BYTES = 155648;
constexpr int MW_BAR = 8;
constexpr int MW_LCNT = 16;
constexpr int MW_PSTART = 64;
constexpr int MW_TSTART = 128;
constexpr int MW_BEFORE = 192;
constexpr int MW_PART = 256;

__device__ __forceinline__ unsigned f2bf(float f) { unsigned u = __builtin_bit_cast(unsigned, f); return (u + 0x7fffu + ((u >> 16) & 1u)) >> 16; }
__device__ __forceinline__ unsigned pk2(float lo, float hi) { return f2bf(lo) | (f2bf(hi) << 16); }
__device__ __forceinline__ float bf2f(unsigned short b) { return __builtin_bit_cast(float, (unsigned)b << 16); }
__device__ __forceinline__ float bflo(unsigned w) { return __builtin_bit_cast(float, w << 16); }
__device__ __forceinline__ float bfhi(unsigned w) { return __builtin_bit_cast(float, w & 0xffff0000u); }
__device__ __forceinline__ unsigned cvt_pk_bf16(float lo, float hi) { unsigned r; asm volatile("v_cvt_pk_bf16_f32 %0, %1, %2" : "=v"(r) : "v"(lo), "v"(hi)); return r; }
__device__ __forceinline__ int crow(int r, int hi) { return (r & 3) + 8 * (r >> 2) + 4 * hi; }
#define LDS_WAIT() asm volatile("s_waitcnt lgkmcnt(0)" ::: "memory")
#define VM_WAIT() asm volatile("s_waitcnt vmcnt(0)" ::: "memory")

namespace pg8 {
constexpr int BM = 256, BK = 64, HALF = 128, HTB = HALF * BK * 2, STAGE_BYTES = 8 * HTB;
__host__ __device__ __forceinline__ int lds_byte(int r, int c) { const int st = (r >> 4) * 2 + (c >> 5), rr = r & 15, cc = c & 31, ob = rr * 64 + cc * 2; return st * 1024 + (ob ^ (((ob >> 9) & 1) << 5)); }
__host__ __device__ __forceinline__ void stage_rc(int b, int& R, int& C) { const int st = b / 1024, sb = b % 1024, swz = sb ^ (((sb >> 9) & 1) << 5); R = (st >> 1) * 16 + swz / 64; C = (st & 1) * 32 + (swz % 64) / 2; }
__host__ __device__ __forceinline__ int perm32(int rho) { const int n = rho >> 4, i = rho & 15; return 8 * (i >> 2) + 4 * n + (i & 3); }

struct Unit { int pm, pn, e; };

template <class Epi, class Sched, bool ALIGN_EPI>
__device__ __forceinline__ void gemm_phase(LAS unsigned char* lds, const int K, const Sched& S, const Epi& E) {
    const int tid = threadIdx.x, wid = __builtin_amdgcn_readfirstlane(tid >> 6), lane = tid & 63, wr = wid >> 2, wc = wid & 3, fr = lane & 15, fq = lane >> 4;
    const int nt = K / BK;
    int Rr[2], Cc[2]; unsigned voffB[2];
#pragma unroll
    for (int i = 0; i < 2; ++i) { int R, C; stage_rc(tid * 16 + i * 8192, R, C); Rr[i] = R; Cc[i] = C; const int Rb = Epi::PERM ? ((R & ~31) + perm32(R & 31)) : R; voffB[i] = (unsigned)(Rb * K + C) * 2u; }
    const size_t kstep = (size_t)(BK * 2);
    const size_t hstepB = (size_t)HALF * K * 2;
    const unsigned ldsw = (unsigned)wid * 1024u;
    const int aoff = lds_byte(wr * 64 + fr, fq * 8), boff = lds_byte(wc * 32 + fr, fq * 8);
#define PG8_SA(b, h) (((b) * 2 + (h)) * HTB)
#define PG8_SB(b, h) ((4 + (b) * 2 + (h)) * HTB)
#define PG8_STAGE(bufoff, gbase, voff) do { _Pragma("unroll") for (int _i = 0; _i < 2; ++_i) \
        __builtin_amdgcn_global_load_lds((const unsigned*)((const char*)(gbase) + (voff)[_i]), (LAS unsigned*)(lds + (bufoff) + ldsw + _i * 8192), 16, 0, 0); } while (0)
#define PG8_LDA(dst, b, h) do { _Pragma("unroll") for (int m = 0; m < 4; ++m) _Pragma("unroll") for (int k = 0; k < 2; ++k) dst[m][k] = *(const LAS bf16x8*)(lds + PG8_SA(b, h) + aoff + m * 2048 + k * 1024); } while (0)
#define PG8_LDB(dst, b, h) do { _Pragma("unroll") for (int n = 0; n < 2; ++n) _Pragma("unroll") for (int k = 0; k < 2; ++k) dst[n][k] = *(const LAS bf16x8*)(lds + PG8_SB(b, h) + boff + n * 2048 + k * 1024); } while (0)
#define PG8_MMA(ai, bj, At, Bt) do { __builtin_amdgcn_s_setprio(1); _Pragma("unroll") for (int m = 0; m < 4; ++m) _Pragma("unroll") for (int n = 0; n < 2; ++n) _Pragma("unroll") for (int k = 0; k < 2; ++k) \
        acc[ai][bj][m][n] = __builtin_amdgcn_mfma_f32_16x16x32_bf16(Bt[n][k], At[m][k], acc[ai][bj][m][n], 0, 0, 0); __builtin_amdgcn_s_setprio(0); } while (0)
#define PG8_WAIT_V(n) asm volatile("s_waitcnt vmcnt(" #n ")" ::: "memory")
#define PG8_WAIT_L(n) asm volatile("s_waitcnt lgkmcnt(" #n ")" ::: "memory")
#define PG8_BAR __builtin_amdgcn_s_barrier()
#define PG8_SCHED __builtin_amdgcn_sched_barrier(0)
    Unit cur, nxt; int ui = 0;
    if (!S.next(0, cur)) return;
    f32x4 acc[2][2][4][2];
#pragma unroll
    for (int a = 0; a < 2; ++a)
#pragma unroll
        for (int b = 0; b < 2; ++b)
#pragma unroll
            for (int m = 0; m < 4; ++m)
#pragma unroll
                for (int n = 0; n < 2; ++n) acc[a][b][m][n] = (f32x4){0.f, 0.f, 0.f, 0.f};
    bf16x8 At[4][2], B0[2][2], B1[2][2];
    const char* Ab = S.a_base();
    unsigned ca0[2], ca1[2], na0[2], na1[2];
#pragma unroll
    for (int i = 0; i < 2; ++i) { ca0[i] = S.a_off(cur, Rr[i], Cc[i]); ca1[i] = S.a_off(cur, HALF + Rr[i], Cc[i]); }
    const char* cB = S.b_tile(cur);
    PG8_STAGE(PG8_SB(0, 0), cB, voffB); PG8_STAGE(PG8_SB(0, 1), cB + hstepB, voffB); PG8_STAGE(PG8_SA(0, 0), Ab, ca0); PG8_STAGE(PG8_SA(0, 1), Ab, ca1);
    if (wr == 1) PG8_BAR;
    PG8_WAIT_V(2); PG8_BAR;
    PG8_STAGE(PG8_SB(1, 0), cB + kstep, voffB); PG8_STAGE(PG8_SA(1, 0), Ab + kstep, ca0); PG8_STAGE(PG8_SB(1, 1), cB + hstepB + kstep, voffB);
    PG8_WAIT_V(6); PG8_BAR;
    for (;;) {
        const bool has_next = S.next(ui + 1, nxt);
        const char* nB = cB;
#pragma unroll
        for (int i = 0; i < 2; ++i) { na0[i] = ca0[i]; na1[i] = ca1[i]; }
        if (has_next) { nB = S.b_tile(nxt);
#pragma unroll
            for (int i = 0; i < 2; ++i) { na0[i] = S.a_off(nxt, Rr[i], Cc[i]); na1[i] = S.a_off(nxt, HALF + Rr[i], Cc[i]); } }
        for (int t = 0; t < nt; t += 2) {
            const bool last = (t == nt - 2);
            const char* a1 = Ab + (size_t)(t + 1) * kstep;
            const char* a2 = last ? Ab : Ab + (size_t)(t + 2) * kstep; const char* b2 = last ? nB : cB + (size_t)(t + 2) * kstep;
            const char* a3 = a2 + kstep; const char* b3 = b2 + kstep;
            unsigned o20[2], o21[2];
#pragma unroll
            for (int i = 0; i < 2; ++i) { o20[i] = last ? na0[i] : ca0[i]; o21[i] = last ? na1[i] : ca1[i]; }
            PG8_LDB(B0, 0, 0); PG8_LDB(B1, 0, 1); PG8_SCHED; PG8_LDA(At, 0, 0); PG8_STAGE(PG8_SA(1, 1), a1, ca1);
            PG8_WAIT_V(8); PG8_WAIT_L(0); PG8_BAR; PG8_MMA(0, 0, At, B0); PG8_MMA(0, 1, At, B1); PG8_BAR; PG8_SCHED;
            PG8_LDA(At, 0, 1); PG8_STAGE(PG8_SB(0, 0), b2, voffB); PG8_STAGE(PG8_SB(0, 1), b2 + hstepB, voffB); PG8_STAGE(PG8_SA(0, 0), a2, o20);
            PG8_WAIT_V(8); PG8_WAIT_L(0); PG8_BAR; PG8_MMA(1, 0, At, B0); PG8_MMA(1, 1, At, B1); PG8_BAR; PG8_SCHED;
            PG8_LDB(B0, 1, 0); PG8_LDB(B1, 1, 1); PG8_SCHED; PG8_LDA(At, 1, 0); PG8_STAGE(PG8_SA(0, 1), a2, o21);
            PG8_WAIT_V(8); PG8_WAIT_L(0); PG8_BAR; PG8_MMA(0, 0, At, B0); PG8_MMA(0, 1, At, B1); PG8_BAR; PG8_SCHED;
            PG8_LDA(At, 1, 1); PG8_STAGE(PG8_SB(1, 0), b3, voffB); PG8_STAGE(PG8_SB(1, 1), b3 + hstepB, voffB); PG8_STAGE(PG8_SA(1, 0), a3, o20);
            PG8_WAIT_V(8); PG8_WAIT_L(0); PG8_BAR; PG8_MMA(1, 0, At, B0); PG8_MMA(1, 1, At, B1); PG8_BAR; PG8_SCHED;
        }
        if constexpr (ALIGN_EPI) { if (wr == 0) PG8_BAR; }
        E(acc, cur, wr, wc, fr, fq);
        if (!has_next) break;
#pragma unroll
        for (int a = 0; a < 2; ++a)
#pragma unroll
            for (int b = 0; b < 2; ++b)
#pragma unroll
                for (int m = 0; m < 4; ++m)
#pragma unroll
                    for (int n = 0; n < 2; ++n) acc[a][b][m][n] = (f32x4){0.f, 0.f, 0.f, 0.f};
        cur = nxt; cB = nB; ++ui;
#pragma unroll
        for (int i = 0; i < 2; ++i) { ca0[i] = na0[i]; ca1[i] = na1[i]; }
        if constexpr (ALIGN_EPI) { if (wr == 1) PG8_BAR; }
    }
    PG8_WAIT_V(0);
    if constexpr (!ALIGN_EPI) { if (wr == 0) PG8_BAR; }
    PG8_BAR;
#undef PG8_SA
#undef PG8_SB
#undef PG8_STAGE
#undef PG8_LDA
#undef PG8_LDB
#undef PG8_MMA
#undef PG8_WAIT_V
#undef PG8_WAIT_L
#undef PG8_BAR
#undef PG8_SCHED
}

struct DenseSched {
    const char* A; const char* Bt; int K, nM, nN, nwg, G, c;
    __device__ __forceinline__ void init(const void* A_, const void* Bt_, int M, int N, int K_, int G_, int c_) { A = (const char*)A_; Bt = (const char*)Bt_; K = K_; nM = M / BM; nN = N / BM; nwg = nM * nN; G = G_; c = c_; }
    __device__ __forceinline__ bool next(int i, Unit& u) const {
        const long L = (long)i * G + c; if (L >= nwg) return false;
        int wgid = (int)L; { const int q = nwg / 8, r = nwg % 8, xcd = wgid % 8, off = wgid / 8; wgid = (xcd < r ? xcd * (q + 1) : r * (q + 1) + (xcd - r) * q) + off; }
        const int nig = 8 * nN, gid = wgid / nig, fm = gid * 8, gsz = (nM - fm) < 8 ? (nM - fm) : 8;
        u.pm = fm + ((wgid % nig) % gsz); u.pn = (wgid % nig) / gsz; u.e = 0; return true;
    }
    __device__ __forceinline__ const char* a_base() const { return A; }
    __device__ __forceinline__ unsigned a_off(const Unit& u, int row, int col) const { return (unsigned)(((size_t)(u.pm * BM + row) * K + col) * 2); }
    __device__ __forceinline__ const char* b_tile(const Unit& u) const { return Bt + (size_t)u.pn * BM * K * 2; }
};
}

namespace pg8 {
struct MoeSched {
    const char* A; const char* Bt; const int* slot_tok; volatile LAS unsigned* tstart; int K, rowsE, nN, c;
    __device__ __forceinline__ bool next(int i, Unit& u) const {
        const int x = c & 7, j = c >> 3, rpr = 32 / nN;
        const int pm = (i * 8 + x) * rpr + j / nN;
        const int T = (int)tstart[32];
        if (pm >= T) return false;
        int e = 0;
#pragma unroll 1
        for (int k = 1; k < 32; ++k) e += ((int)tstart[k] <= pm) ? 1 : 0;
        u.pm = pm; u.pn = j % nN; u.e = __builtin_amdgcn_readfirstlane(e); return true;
    }
    __device__ __forceinline__ const char* a_base() const { return A; }
    __device__ __forceinline__ unsigned a_off(const Unit& u, int row, int col) const {
        const int pos = u.pm * BM + row;
        const int r = slot_tok ? slot_tok[pos] : pos;
        return (unsigned)(((size_t)r * K + col) * 2);
    }
    __device__ __forceinline__ const char* b_tile(const Unit& u) const { return Bt + ((size_t)u.e * rowsE + (size_t)u.pn * BM) * K * 2; }
};

template <int ACT> struct EpiBf16 {
    static constexpr bool PERM = true;
    bf16_t* O; int ldc; const float* bias;
    __device__ __forceinline__ void operator()(const f32x4 (&acc)[2][2][4][2], const Unit& u, int wr, int wc, int fr, int fq) const {
        const int row0 = u.pm * BM + wr * 64 + fr; const int col0 = u.pn * BM + wc * 32 + 8 * fq;
        f32x4 bv[2][2];
#pragma unroll
        for (int bj = 0; bj < 2; ++bj)
#pragma unroll
            for (int n = 0; n < 2; ++n) bv[bj][n] = bias ? *(const f32x4*)(bias + col0 + bj * HALF + 4 * n) : (f32x4){0.f, 0.f, 0.f, 0.f};
#pragma unroll
        for (int ai = 0; ai < 2; ++ai)
#pragma unroll
            for (int m = 0; m < 4; ++m) { bf16_t* rowp = O + (size_t)(row0 + ai * HALF + m * 16) * ldc + col0;
#pragma unroll
                for (int bj = 0; bj < 2; ++bj) { f32x4 v0 = acc[ai][bj][m][0] + bv[bj][0], v1 = acc[ai][bj][m][1] + bv[bj][1];
                    if (ACT == 2) {
#pragma unroll
                        for (int q = 0; q < 4; ++q) { v0[q] = __builtin_amdgcn_rcpf(1.f + __builtin_amdgcn_exp2f(-LOG2E * v0[q])); v1[q] = __builtin_amdgcn_rcpf(1.f + __builtin_amdgcn_exp2f(-LOG2E * v1[q])); } }
                    u32x4 w; w.x = cvt_pk_bf16(v0[0], v0[1]); w.y = cvt_pk_bf16(v0[2], v0[3]); w.z = cvt_pk_bf16(v1[0], v1[1]); w.w = cvt_pk_bf16(v1[2], v1[3]);
                    *(u32x4*)(rowp + bj * HALF) = w; } }
    }
};
struct EpiMerge {
    static constexpr bool PERM = true;
    const bf16_t* G; int goff; bf16_t* Mg; int first;
    __device__ __forceinline__ void operator()(const f32x4 (&acc)[2][2][4][2], const Unit& u, int wr, int wc, int fr, int fq) const {
        const int row0 = u.pm * BM + wr * 64 + fr; const int col0 = u.pn * BM + wc * 32 + 8 * fq;
#pragma unroll
        for (int ai = 0; ai < 2; ++ai)
#pragma unroll
            for (int m = 0; m < 4; ++m) { const size_t row = (size_t)(row0 + ai * HALF + m * 16);
#pragma unroll
                for (int bj = 0; bj < 2; ++bj) {
                    const u32x4 g = *(const u32x4*)(G + row * PW + goff + col0 + bj * HALF);
                    u32x4 p = (u32x4){0u, 0u, 0u, 0u};
                    if (!first) p = *(const u32x4*)(Mg + row * DM + col0 + bj * HALF);
                    const f32x4 a0 = acc[ai][bj][m][0], a1 = acc[ai][bj][m][1];
                    u32x4 w;
                    w.x = cvt_pk_bf16(bflo(p.x) + bflo(g.x) * a0[0], bfhi(p.x) + bfhi(g.x) * a0[1]);
                    w.y = cvt_pk_bf16(bflo(p.y) + bflo(g.y) * a0[2], bfhi(p.y) + bfhi(g.y) * a0[3]);
                    w.z = cvt_pk_bf16(bflo(p.z) + bflo(g.z) * a1[0], bfhi(p.z) + bfhi(g.z) * a1[1]);
                    w.w = cvt_pk_bf16(bflo(p.w) + bflo(g.w) * a1[2], bfhi(p.w) + bfhi(g.w) * a1[3]);
                    *(u32x4*)(Mg + row * DM + col0 + bj * HALF) = w; } }
    }
};
struct EpiResid {
    static constexpr bool PERM = false;
    const float* base; float* out;
    __device__ __forceinline__ void operator()(const f32x4 (&acc)[2][2][4][2], const Unit& u, int wr, int wc, int fr, int fq) const {
        const int row0 = u.pm * BM + wr * 64 + fr; const int col0 = u.pn * BM + wc * 32 + 4 * fq;
#pragma unroll
        for (int ai = 0; ai < 2; ++ai)
#pragma unroll
            for (int m = 0; m < 4; ++m) { const size_t off = (size_t)(row0 + ai * HALF + m * 16) * DM + col0;
#pragma unroll
                for (int bj = 0; bj < 2; ++bj)
#pragma unroll
                    for (int n = 0; n < 2; ++n) { const f32x4 b = *(const f32x4*)(base + off + bj * HALF + n * 16); *(f32x4*)(out + off + bj * HALF + n * 16) = b + acc[ai][bj][m][n]; } }
    }
};
struct EpiSwiglu {
    static constexpr bool PERM = true;
    bf16_t* act; const float* bias;
    __device__ __forceinline__ void operator()(const f32x4 (&acc)[2][2][4][2], const Unit& u, int wr, int wc, int fr, int fq) const {
        const int row0 = u.pm * BM + wr * 64 + fr; const int col0 = u.pn * HALF + wc * 32 + 8 * fq;
        const float* be = bias + (size_t)u.e * 2048 + col0;
        f32x4 bg[2], bu[2];
#pragma unroll
        for (int n = 0; n < 2; ++n) { bg[n] = *(const f32x4*)(be + 4 * n); bu[n] = *(const f32x4*)(be + 1024 + 4 * n); }
#pragma unroll
        for (int ai = 0; ai < 2; ++ai)
#pragma unroll
            for (int m = 0; m < 4; ++m) { bf16_t* rowp = act + (size_t)(row0 + ai * HALF + m * 16) * DEXP + col0;
                float o[8];
#pragma unroll
                for (int n = 0; n < 2; ++n) { const f32x4 gv = acc[ai][0][m][n] + bg[n], uv = acc[ai][1][m][n] + bu[n];
#pragma unroll
                    for (int q = 0; q < 4; ++q) { const float g = fminf(gv[q], 7.0f); const float uu = fminf(fmaxf(uv[q], -7.0f), 7.0f);
                        const float sg = __builtin_amdgcn_rcpf(1.f + __builtin_amdgcn_exp2f(-1.702f * LOG2E * g));
                        o[4 * n + q] = (uu + 1.0f) * (g * sg); } }
                u32x4 w; w.x = cvt_pk_bf16(o[0], o[1]); w.y = cvt_pk_bf16(o[2], o[3]); w.z = cvt_pk_bf16(o[4], o[5]); w.w = cvt_pk_bf16(o[6], o[7]);
                *(u32x4*)rowp = w; }
    }
};
constexpr int EPI_STAGE_OFF = 131072, EPI_STAGE_WAVE = 2304;
struct EpiScatter {
    static constexpr bool PERM = false;
    float* out; const int* slot_tok; const float* slot_w; const float* bias; LAS unsigned char* lds;
    __device__ __forceinline__ void operator()(const f32x4 (&acc)[2][2][4][2], const Unit& u, int wr, int wc, int fr, int fq) const {
        const int lane = fr + 16 * fq, wid = wr * 4 + wc;
        LAS float* st = (LAS float*)(lds + EPI_STAGE_OFF + wid * EPI_STAGE_WAVE);
        const int row0 = u.pm * BM + wr * 64 + fr;
        const int lcol = lane & 31, lrow = lane >> 5;
        float bv[2];
#pragma unroll
        for (int bj = 0; bj < 2; ++bj) bv[bj] = bias[(size_t)u.e * DM + u.pn * BM + bj * HALF + wc * 32 + lcol];
#pragma unroll
        for (int ai = 0; ai < 2; ++ai)
#pragma unroll
            for (int m = 0; m < 4; ++m) { const int pos = row0 + ai * HALF + m * 16; const float w = slot_w[pos]; const int tok = slot_tok[pos];
#pragma unroll
                for (int bj = 0; bj < 2; ++bj) {
#pragma unroll
                    for (int n = 0; n < 2; ++n) *(LAS f32x4*)(st + fr * 36 + 16 * n + 4 * fq) = acc[ai][bj][m][n];
                    asm volatile("s_waitcnt lgkmcnt(0)" ::: "memory");
#pragma unroll
                    for (int i = 0; i < 8; ++i) { const int r = 2 * i + lrow; const float v = st[r * 36 + lcol];
                        const float wr_ = __shfl(w, r); const int tr_ = __shfl(tok, r);
                        if (wr_ != 0.f) unsafeAtomicAdd(out + (size_t)tr_ * DM + u.pn * BM + bj * HALF + wc * 32 + lcol, (v + bv[bj]) * wr_); }
                    asm volatile("s_waitcnt lgkmcnt(0)" ::: "memory");
                } }
    }
};
}

#define XB_TMO      128
#define XB_XCNT(j)  (256  + 64 * (j))
#define XB_XSUB(j)  (1280 + 64 * (j))
#define XB_XGEN(j)  (2304 + 64 * (j))
#define XB_TOP      3328
#define XB_TOPGEN   3392
#define XCD_BAR_WORDS 3456
#define XB_SPIN_CAP (1u << 18)

__device__ __forceinline__ unsigned xb_ld(unsigned* p)              { return __hip_atomic_load(p, __ATOMIC_RELAXED, __HIP_MEMORY_SCOPE_AGENT); }
__device__ __forceinline__ unsigned xb_add(unsigned* p, unsigned v) { return __hip_atomic_fetch_add(p, v, __ATOMIC_RELAXED, __HIP_MEMORY_SCOPE_AGENT); }
__device__ __forceinline__ unsigned xb_xcc_id() { return (unsigned)__builtin_amdgcn_s_getreg((3 << 11) | 20) & 0xFu; }
#define XB_SPIN(cond, bar) do { unsigned _sp = 0; while (cond) { __builtin_amdgcn_s_sleep(1); \
    if ((++_sp & 255u) == 0u) { if (xb_ld(&(bar)[XB_TMO])) break; if (_sp > XB_SPIN_CAP) { atomicAdd(&(bar)[XB_TMO], 1u); break; } } } } while (0)

struct XcdBarrier {
    unsigned* bar; unsigned x;
    volatile LAS unsigned* st;
};

__device__ __forceinline__ XcdBarrier xcd_barrier_post(unsigned* bar, volatile LAS unsigned* st) {
    XcdBarrier b; b.bar = bar; b.x = xb_xcc_id(); b.st = st;
    if (threadIdx.x == 0) (void)xb_add(&bar[XB_XCNT(b.x)], 1u);
    return b;
}
__device__ __forceinline__ void xcd_barrier_complete(unsigned* bar, unsigned x, unsigned& nloc, unsigned& nx) {
    const unsigned G = gridDim.x * gridDim.y * gridDim.z;
    unsigned sum, cnt, mine, sp = 0u;
    for (;;) {
        sum = 0u; cnt = 0u; mine = 0u;
#pragma unroll
        for (unsigned j = 0; j < 16; ++j) { const unsigned c = xb_ld(&bar[XB_XCNT(j)]); sum += c; cnt += (c > 0u) ? 1u : 0u; mine = (j == x) ? c : mine; }
        if (sum == G) break;
        __builtin_amdgcn_s_sleep(1);
        if ((++sp & 255u) == 0u) { if (xb_ld(&bar[XB_TMO])) break; if (sp > XB_SPIN_CAP) { atomicAdd(&bar[XB_TMO], 1u); break; } }
    }
    nloc = mine > 0u ? mine : 1u; nx = cnt > 0u ? cnt : 1u;
}

__device__ __forceinline__ void xcd_barrier(const XcdBarrier& b) {
    asm volatile("s_waitcnt vmcnt(0)" ::: "memory");
    __syncthreads();
    if (threadIdx.x == 0) {
        unsigned* bar = b.bar;
        __builtin_amdgcn_s_waitcnt(0);
        unsigned nloc = b.st[0], nx = b.st[1];
        if (nloc == 0u) { xcd_barrier_complete(bar, b.x, nloc, nx); b.st[0] = nloc; b.st[1] = nx; }
        const unsigned old = xb_add(&bar[XB_XSUB(b.x)], 1u);
        const unsigned gen = old / nloc;
        if (old + 1u == (gen + 1u) * nloc) {
            __builtin_amdgcn_fence(__ATOMIC_RELEASE, "agent");
            asm volatile("s_waitcnt vmcnt(0)" ::: "memory");
            const unsigned og = xb_add(&bar[XB_TOP], 1u);
            const unsigned tg = og / nx;
            if (og + 1u == (tg + 1u) * nx) xb_add(&bar[XB_TOPGEN], 1u);
            else XB_SPIN(xb_ld(&bar[XB_TOPGEN]) == tg, bar);
            __builtin_amdgcn_fence(__ATOMIC_ACQUIRE, "agent");
            xb_add(&bar[XB_XGEN(b.x)], 1u);
            asm volatile("s_waitcnt vmcnt(0)" ::: "memory");
        } else {
            XB_SPIN(xb_ld(&bar[XB_XGEN(b.x)]) == gen, bar);
            __builtin_amdgcn_fence(__ATOMIC_ACQUIRE, "agent");
            asm volatile("s_waitcnt vmcnt(0)" ::: "memory");
        }
    }
    __syncthreads();
}

constexpr int NWAVES = 8;
struct Frame {
    LAS unsigned char* lds;
    volatile LAS unsigned* MISC;
    gu32* ctl;
    int tid, lane, wave, G, blk;
    const float* in[21];
    float* out; unsigned char* ws;
};
__device__ __forceinline__ float wave_sum(float v) {
#pragma unroll
    for (int o = 1; o < 64; o <<= 1) v += __shfl_xor(v, o);
    return v;
}

__device__ __forceinline__ int map_src(int mode, int n) {
    if (mode == 1) return n < 2500 ? n : (n >= C_MQ ? n - (C_MQ - 2500) : -1);
    if (mode == 2) { const int pn = n >> 8, bj = (n >> 7) & 1, j = n & 127; return bj * 1024 + pn * 128 + j; }
    return n;
}
__device__ __forceinline__ void transpose_item(const float* W, int K, int Nsrc, int Ndst, bf16_t* WT, int mode, LAS float* scr, int item, int lane) {
    const int nblk = Ndst / 32, kb = item / nblk, nb = item % nblk, k0 = 64 * kb, n0 = 32 * nb;
    const int sc = map_src(mode, n0 + (lane & 31));
    const float scale = (mode == 1 && (n0 + (lane & 31)) < 512) ? 0.125f : 1.0f;
#pragma unroll 8
    for (int i = 0; i < 32; ++i) { const int kk = 2 * i + (lane >> 5); scr[kk * 33 + (lane & 31)] = sc >= 0 ? W[(size_t)(k0 + kk) * Nsrc + sc] * scale : 0.f; }
    LDS_WAIT(); asm volatile("" ::: "memory");
    const int c = lane & 7;
#pragma unroll
    for (int j = 0; j < 4; ++j) { const int n = (lane >> 3) + 8 * j; const LAS float* s = scr + (8 * c) * 33 + n;
        u32x4 o; o.x = pk2(s[0 * 33], s[1 * 33]); o.y = pk2(s[2 * 33], s[3 * 33]); o.z = pk2(s[4 * 33], s[5 * 33]); o.w = pk2(s[6 * 33], s[7 * 33]);
        *(GAS u32x4*)(WT + (size_t)(n0 + n) * K + k0 + 8 * c) = o; }
    LDS_WAIT(); asm volatile("" ::: "memory");
}
__device__ __forceinline__ void rms_row_to_bf16(int lane, const float* xrow, const float* g, bf16_t* orow) {
    const GAS f32x4* xr = (const GAS f32x4*)xrow + lane; const GAS f32x4* gr = (const GAS f32x4*)g + lane;
    f32x4 v[4]; float s = 0.f;
#pragma unroll
    for (int j = 0; j < 4; ++j) { v[j] = xr[64 * j]; s += (v[j].x * v[j].x + v[j].y * v[j].y) + (v[j].z * v[j].z + v[j].w * v[j].w); }
    const float rstd = 1.0f / sqrtf(wave_sum(s) * (1.f / DM) + EPS);
    GAS u32x2* o8 = (GAS u32x2*)orow + lane;
#pragma unroll
    for (int j = 0; j < 4; ++j) { const f32x4 gg = gr[64 * j]; u32x2 o; o.x = pk2(v[j].x * rstd * gg.x, v[j].y * rstd * gg.y); o.y = pk2(v[j].z * rstd * gg.z, v[j].w * rstd * gg.w); o8[64 * j] = o; }
}

__device__ __forceinline__ void p0_prologue(Frame& F) {
    LAS float* scr = (LAS float*)(F.lds + F.wave * 16384);
    const int gw = F.blk * NWAVES + F.wave, NGW = F.G * NWAVES, lane = F.lane;
    unsigned char* ws = F.ws;
    constexpr int I_IN = 16 * 96, I_MKV = 16 * 32, I_G = 16 * 32, I_B = 8 * 32, I_O = 16 * 32, I_EI = 16 * 64, I_EO = 16 * 32;
    constexpr int NITEMS = I_IN + I_MKV + 3 * I_G + 3 * I_B + I_O + NEXP * I_EI + NEXP * I_EO;
    for (int it = gw; it < NITEMS; it += NGW) {
        int r = it;
        if (r < I_IN) { transpose_item(F.in[3], DM, IN_W, PW, (bf16_t*)(ws + WS_WIN), 1, scr, r, lane); continue; } r -= I_IN;
        if (r < I_MKV) { transpose_item(F.in[9], DM, DM, DM, (bf16_t*)(ws + WS_WMKV), 0, scr, r, lane); continue; } r -= I_MKV;
        if (r < 3 * I_G) { const int n = r / I_G; transpose_item(F.in[10] + (size_t)n * DM * DM, DM, DM, DM, (bf16_t*)(ws + WS_WG) + (size_t)n * DM * DM, 0, scr, r % I_G, lane); continue; } r -= 3 * I_G;
        if (r < 3 * I_B) { const int n = r / I_B; transpose_item(F.in[12] + (size_t)n * 512 * DM, 512, DM, DM, (bf16_t*)(ws + WS_WB) + (size_t)n * DM * 512, 0, scr, r % I_B, lane); continue; } r -= 3 * I_B;
        if (r < I_O) { transpose_item(F.in[13], DM, DM, DM, (bf16_t*)(ws + WS_WO), 0, scr, r, lane); continue; } r -= I_O;
        if (r < NEXP * I_EI) { const int e = r / I_EI; transpose_item(F.in[17] + (size_t)e * DM * 2048, DM, 2048, 2048, (bf16_t*)(ws + WS_WEI) + (size_t)e * 2048 * DM, 2, scr, r % I_EI, lane); continue; } r -= NEXP * I_EI;
        { const int e = r / I_EO; transpose_item(F.in[19] + (size_t)e * DM * DM, DM, DM, DM, (bf16_t*)(ws + WS_WEO) + (size_t)e * DM * DM, 0, scr, r % I_EO, lane); }
    }
    { f32x2* tab = (f32x2*)(ws + WS_ROPE);
      for (int idx = (F.blk * NWAVES * 64) + F.tid; idx < SEQ * 32; idx += F.G * NWAVES * 64) {
          const int s = idx >> 5, i = idx & 31;
          const float inv = exp2f(-(float)i * (13.287712379549449f / 32.0f));
          const float ang = (float)s * inv;
          const double rev = (double)ang * 0.15915494309189535;
          const float fr = (float)(rev - __builtin_rint(rev));
          tab[idx] = (f32x2){__builtin_amdgcn_cosf(fr), __builtin_amdgcn_sinf(fr)}; } }
    for (int m = gw; m < NTOK; m += NGW) rms_row_to_bf16(lane, F.in[0] + (size_t)m * DM, F.in[2], (bf16_t*)(ws + WS_H) + (size_t)m * DM);
    for (int m = gw; m < NMEM; m += NGW) rms_row_to_bf16(lane, F.in[1] + (size_t)m * DM, F.in[8], (bf16_t*)(ws + WS_MEMN) + (size_t)m * DM);
    { int* st = (int*)(ws + WS_SLOT_TOK); float* sw = (float*)(ws + WS_SLOT_W);
      for (int i = F.blk * NWAVES * 64 + F.tid; i < NSLOT_PAD; i += F.G * NWAVES * 64) { st[i] = 0; sw[i] = 0.f; } }
}

__device__ __forceinline__ void ld8(const bf16_t* p, float (&v)[8]) { const u32x4 w = *(const u32x4*)p; v[0] = bflo(w.x); v[1] = bfhi(w.x); v[2] = bflo(w.y); v[3] = bfhi(w.y); v[4] = bflo(w.z); v[5] = bfhi(w.z); v[6] = bflo(w.w); v[7] = bfhi(w.w); }
__device__ __forceinline__ void st8(bf16_t* p, const float (&v)[8]) { u32x4 w; w.x = pk2(v[0], v[1]); w.y = pk2(v[2], v[3]); w.z = pk2(v[4], v[5]); w.w = pk2(v[6], v[7]); *(u32x4*)p = w; }
__device__ __forceinline__ void rope8(float (&v)[8], const f32x2* tabrow, int lane) {
    const int i0 = (lane & 3) * 8; const bool up = (lane & 4) != 0;
#pragma unroll
    for (int j = 0; j < 8; ++j) { const float other = __shfl_xor(v[j], 4); const f32x2 cs = tabrow[i0 + j];
        v[j] = up ? (other * cs.y + v[j] * cs.x) : (v[j] * cs.x - other * cs.y); }
}
__device__ __forceinline__ void p2_prep(Frame& F) {
    const int gw = F.blk * NWAVES + F.wave, NGW = F.G * NWAVES, lane = F.lane;
    bf16_t* proj = (bf16_t*)(F.ws + WS_P);
    const f32x2* tab = (const f32x2*)(F.ws + WS_ROPE);
    const float* g_q_dsa = F.in[4]; const float* g_k_dsa = F.in[5]; const float* g_q_mem = F.in[6]; const float* g_k_mem = F.in[7];
    for (int m = gw; m < NTOK; m += NGW) {
        bf16_t* row = proj + (size_t)m * PW; const f32x2* tr = tab + (size_t)(m & (SEQ - 1)) * 32;
        float v[8];
        { ld8(row + C_DQ + 8 * lane, v); float ss = 0.f;
#pragma unroll
          for (int j = 0; j < 8; ++j) ss += v[j] * v[j];
          ss += __shfl_xor(ss, 1); ss += __shfl_xor(ss, 2); ss += __shfl_xor(ss, 4);
          const float rstd = 1.0f / sqrtf(ss * (1.f / 64.f) + EPS);
#pragma unroll
          for (int j = 0; j < 8; ++j) v[j] = v[j] * rstd * g_q_dsa[8 * (lane & 7) + j];
          rope8(v, tr, lane);
#pragma unroll
          for (int j = 0; j < 8; ++j) v[j] *= 0.125f * LOG2E;
          st8(row + C_DQ + 8 * lane, v); }
        { ld8(row + C_DK + 8 * (lane & 7), v); float ss = 0.f;
#pragma unroll
          for (int j = 0; j < 8; ++j) ss += v[j] * v[j];
          ss += __shfl_xor(ss, 1); ss += __shfl_xor(ss, 2); ss += __shfl_xor(ss, 4);
          const float rstd = 1.0f / sqrtf(ss * (1.f / 64.f) + EPS);
#pragma unroll
          for (int j = 0; j < 8; ++j) v[j] = v[j] * rstd * g_k_dsa[8 * (lane & 7) + j];
          rope8(v, tr, lane);
          if (lane < 8) st8(row + C_DK + 8 * lane, v); }
        { ld8(row + C_IQ + 8 * (lane & 31), v); rope8(v, tr, lane); if (lane < 32) st8(row + C_IQ + 8 * lane, v); }
        { ld8(row + C_IK + 8 * (lane & 7), v); rope8(v, tr, lane); if (lane < 8) st8(row + C_IK + 8 * lane, v); }
        { ld8(row + C_MQ + 8 * lane, v); float ss = 0.f;
#pragma unroll
          for (int j = 0; j < 8; ++j) ss += v[j] * v[j];
          ss += __shfl_xor(ss, 1); ss += __shfl_xor(ss, 2); ss += __shfl_xor(ss, 4); ss += __shfl_xor(ss, 8);
          const float rstd = 1.0f / sqrtf(ss * (1.f / 128.f) + EPS) * (0.08838834764831845f * LOG2E);
#pragma unroll
          for (int j = 0; j < 8; ++j) v[j] = v[j] * rstd * g_q_mem[8 * (lane & 15) + j];
          st8(row + C_MQ + 8 * lane, v); }
    }
    bf16_t* mkv = (bf16_t*)(F.ws + WS_MKV);
    for (int m = gw; m < NMEM; m += NGW) {
        bf16_t* row = mkv + (size_t)m * DM; float v[8];
        ld8(row + 8 * lane, v); float ss = 0.f;
#pragma unroll
        for (int j = 0; j < 8; ++j) ss += v[j] * v[j];
        ss += __shfl_xor(ss, 1); ss += __shfl_xor(ss, 2); ss += __shfl_xor(ss, 4); ss += __shfl_xor(ss, 8);
        const float rstd = 1.0f / sqrtf(ss * (1.f / 128.f) + EPS);
#pragma unroll
        for (int j = 0; j < 8; ++j) v[j] = v[j] * rstd * g_k_mem[8 * (lane & 15) + j];
        st8(row + 8 * lane, v);
    }
}

#define MFMA32(a, b, c) __builtin_amdgcn_mfma_f32_32x32x16_bf16((a), (b), (c), 0, 0, 0)
typedef LAS const unsigned char* lds_cptr;
__device__ __forceinline__ s16x4 vtr(lds_cptr p) { return __builtin_bit_cast(s16x4, __builtin_amdgcn_ds_read_tr16_b64_v4i16((LAS v4i16_t*)p)); }
__device__ __forceinline__ bf16x8 vfrag(lds_cptr vbase_lane, int off) {
    const s16x4 lo = vtr(vbase_lane + off), hi = vtr(vbase_lane + off + 512);
    return (bf16x8){lo[0], lo[1], lo[2], lo[3], hi[0], hi[1], hi[2], hi[3]};
}
__device__ __forceinline__ int vtr_lane_off(int lane) { return ((lane >> 4) & 1) * 32 + (lane & 3) * 8 + (4 * (lane >> 5) + ((lane & 15) >> 2)) * 64; }
__device__ __forceinline__ bf16x8 pack8(const float* p) {
    u32x4 w; w.x = cvt_pk_bf16(p[0], p[1]); w.y = cvt_pk_bf16(p[2], p[3]); w.z = cvt_pk_bf16(p[4], p[5]); w.w = cvt_pk_bf16(p[6], p[7]);
    return __builtin_bit_cast(bf16x8, w);
}
__device__ __forceinline__ float softplus_f(float z) { return fmaxf(z, 0.f) + __logf(1.f + __expf(-fabsf(z))); }

__device__ __forceinline__ void sb_item(const bf16_t* proj, bf16_t* osb, int b, int h, int qblk, LAS unsigned char* vlds, int lane) {
    const int r32 = lane & 31, hi = lane >> 5;
    const size_t tok0 = (size_t)b * SEQ + (size_t)qblk * 32;
    bf16x8 qr[4];
    { const bf16_t* qp = proj + (tok0 + r32) * PW + C_SQ + h * 64 + hi * 8;
#pragma unroll
      for (int kk = 0; kk < 4; ++kk) qr[kk] = *(const bf16x8*)(qp + kk * 16); }
    f32x16 o0 = {}, o1 = {}; float R = 0.f;
    const lds_cptr vrd = (lds_cptr)vlds + vtr_lane_off(lane);
    for (int kt = qblk; kt >= 0; --kt) {
        const size_t key0 = (size_t)b * SEQ + (size_t)kt * 32;
        const bf16_t* kp = proj + (key0 + r32) * PW + C_SK + h * 64 + hi * 8;
        bf16x8 kf[4];
#pragma unroll
        for (int kk = 0; kk < 4; ++kk) kf[kk] = *(const bf16x8*)(kp + kk * 16);
        u32x4 vv[4];
#pragma unroll
        for (int p = 0; p < 4; ++p) vv[p] = *(const u32x4*)(proj + (key0 + 16 * (p & 1) + (lane >> 2)) * PW + C_SV + h * 64 + (p >> 1) * 32 + (lane & 3) * 8);
        f32x16 s = {};
#pragma unroll
        for (int kk = 0; kk < 4; ++kk) s = MFMA32(kf[kk], qr[kk], s);
        asm volatile("" ::: "memory");
#pragma unroll
        for (int p = 0; p < 4; ++p) *(LAS u32x4*)(vlds + p * 1024 + lane * 16) = vv[p];
        const bool diag = (kt == qblk);
        float sp[16], pr[16];
#pragma unroll
        for (int r = 0; r < 16; ++r) { const bool valid = !diag || (crow(r, hi) < r32); sp[r] = valid ? softplus_f(s[r]) : 0.f; }
        float T[4], U[4];
#pragma unroll
        for (int g = 0; g < 4; ++g) { T[g] = (sp[4 * g] + sp[4 * g + 1]) + (sp[4 * g + 2] + sp[4 * g + 3]); U[g] = __shfl_xor(T[g], 32); }
        float run = 0.f, above[4];
#pragma unroll
        for (int g = 3; g >= 0; --g) { above[g] = run + (hi == 0 ? U[g] : 0.f); run += T[g] + U[g]; }
#pragma unroll
        for (int g = 0; g < 4; ++g) { float c = R + above[g];
#pragma unroll
            for (int j = 3; j >= 0; --j) { const int r = 4 * g + j; c += sp[r]; const bool valid = !diag || (crow(r, hi) < r32); pr[r] = valid ? __expf(s[r] - c) : 0.f; } }
        R += run;
        const bf16x8 p0 = pack8(pr), p1 = pack8(pr + 8);
        LDS_WAIT();
        const bf16x8 v00 = vfrag(vrd, 0), v01 = vfrag(vrd, 1024), v10 = vfrag(vrd, 2048), v11 = vfrag(vrd, 3072);
        o0 = MFMA32(v00, p0, o0); o0 = MFMA32(v01, p1, o0);
        o1 = MFMA32(v10, p0, o1); o1 = MFMA32(v11, p1, o1);
        asm volatile("" ::: "memory");
        if (__all(R > 30.0f)) break;
    }
    bf16_t* op = osb + (tok0 + r32) * 512 + h * 64 + 4 * hi;
#pragma unroll
    for (int g = 0; g < 4; ++g) {
        u32x2 w0, w1; w0.x = cvt_pk_bf16(o0[4 * g], o0[4 * g + 1]); w0.y = cvt_pk_bf16(o0[4 * g + 2], o0[4 * g + 3]); w1.x = cvt_pk_bf16(o1[4 * g], o1[4 * g + 1]); w1.y = cvt_pk_bf16(o1[4 * g + 2], o1[4 * g + 3]);
        *(u32x2*)(op + 8 * g) = w0; *(u32x2*)(op + 32 + 8 * g) = w1; }
}

__device__ __forceinline__ void mem_item(const bf16_t* proj, const bf16_t* mkv, bf16_t* omem, int b, int h, int qblk, LAS unsigned char* vlds  , int lane) {
    const int r32 = lane & 31, hi = lane >> 5;
    const size_t tok0 = (size_t)b * SEQ + (size_t)qblk * 32;
    bf16x8 qr[8];
    { const bf16_t* qp = proj + (tok0 + r32) * PW + C_MQ + h * 128 + hi * 8;
#pragma unroll
      for (int kk = 0; kk < 8; ++kk) qr[kk] = *(const bf16x8*)(qp + kk * 16); }
    f32x16 o[4] = {{}, {}, {}, {}}; float m = -1e30f, l = 0.f;
    const lds_cptr vrd = (lds_cptr)vlds + vtr_lane_off(lane);
    for (int kb = 0; kb < 8; ++kb) {
        const size_t key0 = (size_t)b * MEMLEN + (size_t)kb * 32;
        const bf16_t* kp = mkv + (key0 + r32) * DM + h * 128 + hi * 8;
        f32x16 s = {};
#pragma unroll
        for (int kk = 0; kk < 8; ++kk) { const bf16x8 kf = *(const bf16x8*)(kp + kk * 16); s = MFMA32(kf, qr[kk], s); }
        u32x4 vv[8];
#pragma unroll
        for (int p = 0; p < 8; ++p) vv[p] = *(const u32x4*)(mkv + (key0 + 16 * (p & 1) + (lane >> 2)) * DM + 512 + h * 128 + (p >> 1) * 32 + (lane & 3) * 8);
        asm volatile("" ::: "memory");
#pragma unroll
        for (int p = 0; p < 8; ++p) *(LAS u32x4*)(vlds + p * 1024 + lane * 16) = vv[p];
        float mx = s[0];
#pragma unroll
        for (int r = 1; r < 16; ++r) mx = fmaxf(mx, s[r]);
        mx = fmaxf(mx, __shfl_xor(mx, 32));
        const float mn = fmaxf(m, mx), alpha = __builtin_amdgcn_exp2f(m - mn);
        float pr[16], rs = 0.f;
#pragma unroll
        for (int r = 0; r < 16; ++r) { pr[r] = __builtin_amdgcn_exp2f(s[r] - mn); rs += pr[r]; }
        l = l * alpha + rs; m = mn;
#pragma unroll
        for (int d = 0; d < 4; ++d)
#pragma unroll
            for (int r = 0; r < 16; ++r) o[d][r] *= alpha;
        const bf16x8 p0 = pack8(pr), p1 = pack8(pr + 8);
        LDS_WAIT();
#pragma unroll
        for (int d = 0; d < 4; ++d) { const bf16x8 va = vfrag(vrd, d * 2048), vb = vfrag(vrd, d * 2048 + 1024); o[d] = MFMA32(va, p0, o[d]); o[d] = MFMA32(vb, p1, o[d]); }
        asm volatile("" ::: "memory");
    }
    l += __shfl_xor(l, 32);
    const float il = 1.0f / l;
    bf16_t* op = omem + (tok0 + r32) * 512 + h * 128 + 4 * hi;
#pragma unroll
    for (int d = 0; d < 4; ++d)
#pragma unroll
        for (int g = 0; g < 4; ++g) { u32x2 w; w.x = cvt_pk_bf16(o[d][4 * g] * il, o[d][4 * g + 1] * il); w.y = cvt_pk_bf16(o[d][4 * g + 2] * il, o[d][4 * g + 3] * il); *(u32x2*)(op + 32 * d + 8 * g) = w; }
}

constexpr int DL_HIST = 0, DL_PREFIX = 66048, DL_KREM = DL_PREFIX + 256, DL_MASK = 67072, DL_VT = 73728, DL_END = DL_VT + 2 * 16384;
constexpr int TOPK_DSA = 256;

__device__ __forceinline__ void idx_scores(const bf16_t* iq_row  , const bf16_t* ik_row  , const float (&wq)[4], unsigned (&uk)[16]) {
    bf16x8 kf[4];
#pragma unroll
    for (int kk = 0; kk < 4; ++kk) kf[kk] = *(const bf16x8*)(ik_row + kk * 16);
    float scv[16];
#pragma unroll
    for (int hd = 0; hd < 4; ++hd) { f32x16 a = (f32x16){};
#pragma unroll
        for (int kk = 0; kk < 4; ++kk) { const bf16x8 qf = *(const GAS bf16x8*)((const GAS bf16_t*)iq_row + hd * 64 + kk * 16); a = MFMA32(kf[kk], qf, a); }
#pragma unroll
        for (int r = 0; r < 16; ++r) scv[r] = (hd == 0) ? wq[0] * fmaxf(a[r], 0.f) : __builtin_fmaf(wq[hd], fmaxf(a[r], 0.f), scv[r]); }
#pragma unroll
    for (int r = 0; r < 16; ++r) {
        const float sc = scv[r];
        unsigned bits = __builtin_bit_cast(unsigned, sc);
        if (bits == 0x80000000u) bits = 0u;
        uk[r] = (bits & 0x80000000u) ? ~bits : (bits | 0x80000000u);
    }
}

__device__ __forceinline__ void dsa_unit(const bf16_t* proj, bf16_t* odsa, int b, int c, LAS unsigned char* dl, int tid) {
    const int lane = tid & 63, wid = __builtin_amdgcn_readfirstlane(tid >> 6), r32 = lane & 31, hi = lane >> 5;
    const int n = 64 * (c + 1), nsteps = (n + 127) >> 7;
    const size_t tokq0 = (size_t)b * SEQ + (size_t)c * 64, tokb = (size_t)b * SEQ;
    LAS unsigned* hist = (LAS unsigned*)(dl + DL_HIST);
    LAS unsigned* prefix = (LAS unsigned*)(dl + DL_PREFIX);
    LAS unsigned* krem = (LAS unsigned*)(dl + DL_KREM);
    LAS unsigned* mask = (LAS unsigned*)(dl + DL_MASK);
    const int kb = wid >> 1, qh = wid & 1;
    const bf16_t* iq_row = proj + (tokq0 + 32 * qh + r32) * PW + C_IQ + 8 * hi;
    float wq[4];
    { const u32x2 w = *(const u32x2*)(proj + (tokq0 + 32 * qh + r32) * PW + C_IW);
      wq[0] = bflo(w.x) * 0.0625f; wq[1] = bfhi(w.x) * 0.0625f; wq[2] = bflo(w.y) * 0.0625f; wq[3] = bfhi(w.y) * 0.0625f; }
    if (tid < 64) { prefix[tid] = 0u; krem[tid] = (n > TOPK_DSA) ? (unsigned)TOPK_DSA : 0x7fffffffu; }
    __syncthreads();
#ifndef NO_SEL
    if (n > TOPK_DSA) {
        for (int pass = 0; pass < 4; ++pass) {
            for (int i = tid; i < 64 * 257; i += 512) hist[i] = 0u;
            __syncthreads();
            const int shift = 24 - 8 * pass;
            const unsigned pfx = prefix[32 * qh + r32];
            for (int step = 0; step < nsteps; ++step) {
                const int kbase = 128 * step + 32 * kb;
                if (kbase < n) {
                    unsigned uk[16];
                    const bf16_t* iq_l = iq_row; asm volatile("" : "+v"(iq_l));
                    idx_scores(iq_l, proj + (tokb + kbase + r32) * PW + C_IK + 8 * hi, wq, uk);
#pragma unroll
                    for (int r = 0; r < 16; ++r) {
                        const bool match = (pass == 0) || ((uk[r] >> (shift + 8)) == pfx);
                        if (match) __hip_atomic_fetch_add(hist + (32 * qh + r32) * 257 + ((uk[r] >> shift) & 255u), 1u, __ATOMIC_RELAXED, __HIP_MEMORY_SCOPE_WORKGROUP);
                    }
                }
            }
            __syncthreads();
            for (int qi = 0; qi < 8; ++qi) {
                const int q = 8 * wid + qi;
                const LAS unsigned* hq = hist + q * 257;
                const unsigned c0 = hq[255 - 4 * lane], c1 = hq[254 - 4 * lane], c2 = hq[253 - 4 * lane], c3 = hq[252 - 4 * lane];
                const unsigned s4 = c0 + c1 + c2 + c3;
                unsigned incl = s4;
#pragma unroll
                for (int o = 1; o < 64; o <<= 1) { const unsigned t = __shfl_up(incl, o); if (lane >= o) incl += t; }
                const unsigned excl = incl - s4, kr = krem[q];
                if (excl < kr && kr <= incl) {
                    unsigned cum = excl, bin, nk;
                    if (cum + c0 >= kr) { bin = 255 - 4 * lane; nk = kr - cum; }
                    else { cum += c0; if (cum + c1 >= kr) { bin = 254 - 4 * lane; nk = kr - cum; }
                    else { cum += c1; if (cum + c2 >= kr) { bin = 253 - 4 * lane; nk = kr - cum; }
                    else { cum += c2; bin = 252 - 4 * lane; nk = kr - cum; } } }
                    prefix[q] = (prefix[q] << 8) | bin; krem[q] = nk;
                }
            }
            __syncthreads();
        }
    }
#endif
#ifndef NO_ATT
    LAS unsigned* selall = (LAS unsigned*)(dl + DL_HIST);
    {
        const unsigned thr = prefix[32 * qh + r32];
        for (int step = 0; step < nsteps; ++step) {
            LAS unsigned* mk = mask + (step & 1) * 768;
            { const int kbase = 128 * step + 32 * kb; unsigned gtw = 0u, eqw = 0u;
              if (kbase < n) { unsigned uk[16];
                  const bf16_t* iq_l = iq_row; asm volatile("" : "+v"(iq_l));
                  idx_scores(iq_l, proj + (tokb + kbase + r32) * PW + C_IK + 8 * hi, wq, uk);
#pragma unroll
                  for (int r = 0; r < 16; ++r) { gtw |= (uk[r] > thr ? 1u : 0u) << crow(r, hi); eqw |= (uk[r] == thr ? 1u : 0u) << crow(r, hi); } }
              gtw |= __shfl_xor(gtw, 32); eqw |= __shfl_xor(eqw, 32);
              if (hi == 0) { mk[(32 * qh + r32) * 4 + kb] = gtw; mk[256 + (32 * qh + r32) * 4 + kb] = eqw; } }
            __syncthreads();
            if (wid == 0) { unsigned nd = krem[lane];
#pragma unroll
                for (int k4 = 0; k4 < 4; ++k4) { const unsigned g = mk[lane * 4 + k4]; unsigned e = mk[256 + lane * 4 + k4]; unsigned sel = g;
                    if (e != 0u) { const unsigned cnt = (unsigned)__builtin_popcount(e);
                        if (cnt <= nd) { sel |= e; nd -= cnt; }
                        else { unsigned chosen = 0u; while (nd > 0u) { const unsigned lb = e & (0u - e); chosen |= lb; e ^= lb; --nd; } sel |= chosen; } }
                    selall[lane * 64 + step * 4 + k4] = sel; }
                krem[lane] = nd; }
        }
        __syncthreads();
    }
    const int hd = wid;
    for (int qb = 0; qb < 2; ++qb) {
        bf16x8 qr[4];
        { const bf16_t* qp = proj + (tokq0 + 32 * qb + r32) * PW + C_DQ + hd * 64 + 8 * hi;
#pragma unroll
          for (int kk = 0; kk < 4; ++kk) qr[kk] = *(const bf16x8*)(qp + kk * 16); }
        f32x16 o0 = {}, o1 = {}; float mrun = -1e30f, lrun = 0.f;
        for (int step = 0; step < nsteps; ++step) {
            LAS unsigned char* vt = dl + DL_VT + (step & 1) * 16384;
#pragma unroll
            for (int i = 0; i < 2; ++i) { const int ch = tid + 512 * i, key = ch >> 3, c8 = ch & 7, kk = key & 31;
                int krow = 128 * step + key; if (krow > SEQ - 1) krow = SEQ - 1;
                const u32x4 v = *(const u32x4*)(proj + (tokb + krow) * PW + C_DV + c8 * 8);
                *(LAS u32x4*)(vt + (key >> 5) * 4096 + ((c8 >> 2) * 2 + (kk >> 4)) * 1024 + (kk & 15) * 64 + (c8 & 3) * 16) = v; }
            __syncthreads();
            for (int k4 = 0; k4 < 4; ++k4) {
                const int kbase = 128 * step + 32 * k4;
                if (kbase >= n) break;
                const bf16_t* kp = proj + (tokb + kbase + r32) * PW + C_DK + 8 * hi;
                f32x16 s = {};
#pragma unroll
                for (int kk = 0; kk < 4; ++kk) { const bf16x8 kf = *(const bf16x8*)(kp + kk * 16); s = MFMA32(kf, qr[kk], s); }
                const lds_cptr vrd = (lds_cptr)vt + k4 * 4096 + vtr_lane_off(lane);
                const unsigned selw = selall[(32 * qb + r32) * 64 + step * 4 + k4];
                float mx = -INFINITY;
#pragma unroll
                for (int r = 0; r < 16; ++r) { if (!((selw >> crow(r, hi)) & 1u)) s[r] = -INFINITY; mx = fmaxf(mx, s[r]); }
                mx = fmaxf(mx, __shfl_xor(mx, 32));
                const float mn = fmaxf(mrun, mx), alpha = __builtin_amdgcn_exp2f(mrun - mn);
                float pr[16], rs = 0.f;
#pragma unroll
                for (int r = 0; r < 16; ++r) { pr[r] = __builtin_amdgcn_exp2f(s[r] - mn); rs += pr[r]; }
                lrun = lrun * alpha + rs; mrun = mn;
#pragma unroll
                for (int r = 0; r < 16; ++r) { o0[r] *= alpha; o1[r] *= alpha; }
                const bf16x8 p0 = pack8(pr), p1 = pack8(pr + 8);
                const bf16x8 v00 = vfrag(vrd, 0), v01 = vfrag(vrd, 1024), v10 = vfrag(vrd, 2048), v11 = vfrag(vrd, 3072);
                o0 = MFMA32(v00, p0, o0); o0 = MFMA32(v01, p1, o0);
                o1 = MFMA32(v10, p0, o1); o1 = MFMA32(v11, p1, o1);
            }
        }
        float l = lrun; l += __shfl_xor(l, 32);
        const float il = 1.0f / l;
        bf16_t* op = odsa + (tokq0 + 32 * qb + r32) * 512 + hd * 64 + 4 * hi;
#pragma unroll
        for (int g = 0; g < 4; ++g) {
            u32x2 w0, w1; w0.x = cvt_pk_bf16(o0[4 * g] * il, o0[4 * g + 1] * il); w0.y = cvt_pk_bf16(o0[4 * g + 2] * il, o0[4 * g + 3] * il);
            w1.x = cvt_pk_bf16(o1[4 * g] * il, o1[4 * g + 1] * il); w1.y = cvt_pk_bf16(o1[4 * g + 2] * il, o1[4 * g + 3] * il);
            *(u32x2*)(op + 8 * g) = w0; *(u32x2*)(op + 32 + 8 * g) = w1; }
        __syncthreads();
    }
#endif
    __syncthreads();
}

constexpr int RL_WR = 0, RL_WR_STRIDE = 1028, RL_TKE = 131584, RL_TKW = RL_TKE + 4096;
__device__ __forceinline__ void p9_router(Frame& F) {
    const int lane = F.lane, wave = F.wave, tid = F.tid;
    LAS float* Wr = (LAS float*)(F.lds + RL_WR);
    LAS int* tke = (LAS int*)(F.lds + RL_TKE); LAS float* tkw = (LAS float*)(F.lds + RL_TKW);
    const float* w_router = F.in[15]; const float* b_router = F.in[16]; const float* g_ffn = F.in[14];
    for (int idx = tid; idx < DM * NEXP; idx += NWAVES * 64) { const int k = idx >> 5, e = idx & 31; Wr[e * RL_WR_STRIDE + k] = w_router[idx]; }
    if (tid < 32) F.MISC[MW_LCNT + tid] = 0u;
    __syncthreads();
    bf16_t* h2 = (bf16_t*)(F.ws + WS_H);
    const GAS f32x4* gr = (const GAS f32x4*)g_ffn + lane;
    f32x4 gg[4];
#pragma unroll
    for (int j = 0; j < 4; ++j) gg[j] = gr[64 * j];
    const float bias_e = b_router[lane >> 1];
    for (int it = 0; it < 16; ++it) {
        const int tl0 = 32 * wave + 2 * it;
        f32x4 hn[2][4];
#pragma unroll
        for (int tk = 0; tk < 2; ++tk) {
            const size_t t = (size_t)F.blk * 256 + tl0 + tk;
            const GAS f32x4* xr = (const GAS f32x4*)(F.out + t * DM) + lane;
            float s = 0.f;
#pragma unroll
            for (int j = 0; j < 4; ++j) { hn[tk][j] = xr[64 * j]; s += (hn[tk][j].x * hn[tk][j].x + hn[tk][j].y * hn[tk][j].y) + (hn[tk][j].z * hn[tk][j].z + hn[tk][j].w * hn[tk][j].w); }
            const float rstd = 1.0f / sqrtf(wave_sum(s) * (1.f / DM) + EPS);
            GAS u32x2* o8 = (GAS u32x2*)(h2 + t * DM) + lane;
#pragma unroll
            for (int j = 0; j < 4; ++j) { hn[tk][j] = hn[tk][j] * rstd * gg[j]; u32x2 o; o.x = pk2(hn[tk][j].x, hn[tk][j].y); o.y = pk2(hn[tk][j].z, hn[tk][j].w); o8[64 * j] = o; }
        }
        float acc[2][32];
        const LAS float* wl = Wr + 4 * lane; asm volatile("" : "+v"(wl));
#pragma unroll
        for (int e = 0; e < 32; ++e) {
            float a0 = 0.f, a1 = 0.f;
#pragma unroll
            for (int j = 0; j < 4; ++j) { const f32x4 w = *(const LAS f32x4*)(wl + e * RL_WR_STRIDE + 256 * j);
                a0 += (hn[0][j].x * w.x + hn[0][j].y * w.y) + (hn[0][j].z * w.z + hn[0][j].w * w.w);
                a1 += (hn[1][j].x * w.x + hn[1][j].y * w.y) + (hn[1][j].z * w.z + hn[1][j].w * w.w); }
            asm volatile("" : "+v"(a0), "+v"(a1));
            acc[0][e] = a0; acc[1][e] = a1;
        }
#pragma unroll
        for (int tk = 0; tk < 2; ++tk) {
            float v16[16], v8[8], v4[4], v2[2];
            const bool b5 = (lane & 32) != 0, b4 = (lane & 16) != 0, b3 = (lane & 8) != 0, b2 = (lane & 4) != 0, b1 = (lane & 2) != 0;
#pragma unroll
            for (int i = 0; i < 16; ++i) { const float mine = b5 ? acc[tk][16 + i] : acc[tk][i], oth = b5 ? acc[tk][i] : acc[tk][16 + i]; v16[i] = mine + __shfl_xor(oth, 32); }
#pragma unroll
            for (int i = 0; i < 8; ++i) { const float mine = b4 ? v16[8 + i] : v16[i], oth = b4 ? v16[i] : v16[8 + i]; v8[i] = mine + __shfl_xor(oth, 16); }
#pragma unroll
            for (int i = 0; i < 4; ++i) { const float mine = b3 ? v8[4 + i] : v8[i], oth = b3 ? v8[i] : v8[4 + i]; v4[i] = mine + __shfl_xor(oth, 8); }
#pragma unroll
            for (int i = 0; i < 2; ++i) { const float mine = b2 ? v4[2 + i] : v4[i], oth = b2 ? v4[i] : v4[2 + i]; v2[i] = mine + __shfl_xor(oth, 4); }
            float v1; { const float mine = b1 ? v2[1] : v2[0], oth = b1 ? v2[0] : v2[1]; v1 = mine + __shfl_xor(oth, 2); }
            float val = v1 + __shfl_xor(v1, 1) + bias_e;
            const int e = lane >> 1;
            float topv[4]; int topi[4];
#pragma unroll
            for (int k = 0; k < 4; ++k) {
                float bv = val; int bi = e;
#pragma unroll
                for (int o = 1; o < 64; o <<= 1) { const float ov = __shfl_xor(bv, o); const int oi = __shfl_xor(bi, o); if (ov > bv || (ov == bv && oi < bi)) { bv = ov; bi = oi; } }
                topv[k] = bv; topi[k] = bi; if (e == bi) val = -INFINITY;
            }
            const float e1 = __expf(topv[1] - topv[0]), e2 = __expf(topv[2] - topv[0]), e3 = __expf(topv[3] - topv[0]);
            const float inv = 1.0f / (1.0f + e1 + e2 + e3);
            const float gate[4] = {inv, e1 * inv, e2 * inv, e3 * inv};
            const int tl = tl0 + tk;
#pragma unroll
            for (int k = 0; k < 4; ++k) if (lane == k) { tke[tl * 4 + k] = topi[k]; tkw[tl * 4 + k] = gate[k];
                __hip_atomic_fetch_add((LAS unsigned*)F.MISC + MW_LCNT + topi[k], 1u, __ATOMIC_RELAXED, __HIP_MEMORY_SCOPE_WORKGROUP); }
        }
    }
    __syncthreads();
    if (tid < 32) ((int*)(F.ws + WS_BLKCNT))[F.blk * 32 + tid] = (int)F.MISC[MW_LCNT + tid];
}
__device__ __forceinline__ void p10_assign(Frame& F) {
    const int tid = F.tid;
    const int* blkcnt = (const int*)(F.ws + WS_BLKCNT);
    LAS int* part = (LAS int*)(F.lds);
    LAS int* tke = (LAS int*)(F.lds + RL_TKE); LAS float* tkw = (LAS float*)(F.lds + RL_TKW);
    { const int e = tid & 31, p = tid >> 5; int tot = 0, bef = 0;
      for (int j = 0; j < 16; ++j) { const int bl = p * 16 + j; const int c = blkcnt[bl * 32 + e]; tot += c; bef += (bl < F.blk) ? c : 0; }
      part[p * 32 + e] = tot; part[512 + p * 32 + e] = bef; }
    __syncthreads();
    if (tid < 32) { int tot = 0, bef = 0;
        for (int p = 0; p < 16; ++p) { tot += part[p * 32 + tid]; bef += part[512 + p * 32 + tid]; }
        part[1024 + tid] = tot; F.MISC[MW_BEFORE + tid] = (unsigned)bef; F.MISC[MW_LCNT + tid] = 0u; }
    __syncthreads();
    if (tid == 0) { int ps = 0;
        for (int e = 0; e < 32; ++e) { F.MISC[MW_PSTART + e] = (unsigned)ps; F.MISC[MW_TSTART + e] = (unsigned)(ps >> 8); ps += (part[1024 + e] + 255) & ~255; }
        F.MISC[MW_PSTART + 32] = (unsigned)ps; F.MISC[MW_TSTART + 32] = (unsigned)(ps >> 8); }
    __syncthreads();
    int* slot_tok = (int*)(F.ws + WS_SLOT_TOK); float* slot_w = (float*)(F.ws + WS_SLOT_W);
    for (int idx = tid; idx < 1024; idx += NWAVES * 64) {
        const int e = tke[idx]; const float w = tkw[idx];
        const unsigned r = __hip_atomic_fetch_add((LAS unsigned*)F.MISC + MW_LCNT + e, 1u, __ATOMIC_RELAXED, __HIP_MEMORY_SCOPE_WORKGROUP);
        const unsigned pos = F.MISC[MW_PSTART + e] + F.MISC[MW_BEFORE + e] + r;
        slot_tok[pos] = F.blk * 256 + (idx >> 2); slot_w[pos] = w;
    }
}

#ifndef MK_ONE_LAUNCH
#define MK_ONE_LAUNCH 1
#endif
constexpr int N_PHASES = 13;
struct Args { const float* in[21]; float* out; unsigned char* ws; int ph_lo, ph_hi; };
static_assert(sizeof(Args) == 21 * 8 + 8 + 8 + 8, "no padding");

__global__ void __launch_bounds__(NWAVES * 64, 2) fwd_kernel(Args args) {
    extern __shared__ __attribute__((aligned(16))) unsigned char lds[];
    Frame F;
    F.lds = (LAS unsigned char*)lds;
    F.MISC = (volatile LAS unsigned*)(F.lds + MISC_OFF);
    F.tid = threadIdx.x; F.lane = F.tid & 63; F.wave = __builtin_amdgcn_readfirstlane(F.tid >> 6);
    F.G = gridDim.x; F.blk = blockIdx.x;
    F.ws = args.ws; F.out = args.out; F.ctl = (gu32*)(args.ws + WS_CTL);
#pragma unroll
    for (int i = 0; i < 21; ++i) F.in[i] = args.in[i];
    for (int u = F.tid; u < (LDS_BYTES - MISC_OFF) / 4; u += NWAVES * 64) ((LAS unsigned*)(F.lds + MISC_OFF))[u] = 0u;
    __syncthreads();
    const int lo = args.ph_lo, hi = args.ph_hi;
    XcdBarrier bar; bar.bar = (unsigned*)(F.ctl + CW_BAR); bar.x = 0; bar.st = nullptr;
    if (hi - lo > 1) bar = xcd_barrier_post((unsigned*)(F.ctl + CW_BAR), F.MISC + MW_BAR);
#ifndef PH_MASK
#define PH_MASK 0x1fff
#endif
#define IN(k) (((PH_MASK >> (k)) & 1) && lo <= (k) && (k) < hi)
#ifndef REP_MASK
#define REP_MASK 0
#endif
#define NREP(k) (1 + ((REP_MASK >> (k)) & 1))
#define SEAM(k) do { if (IN(k) && IN((k) + 1)) xcd_barrier(bar); } while (0)
    unsigned char* ws = args.ws;
    bf16_t* proj = (bf16_t*)(ws + WS_P);

    if (IN(0)) for (int rep = 0; rep < NREP(0); ++rep) { if (rep) xcd_barrier(bar); p0_prologue(F); } SEAM(0);

    if (IN(1)) {
        { pg8::DenseSched S; S.init(ws + WS_H, ws + WS_WIN, NTOK, PW, DM, F.G, F.blk);
          pg8::EpiBf16<0> E{proj, PW, nullptr};
          pg8::gemm_phase<pg8::EpiBf16<0>, pg8::DenseSched, true>(F.lds, DM, S, E); }
        { pg8::DenseSched S; S.init(ws + WS_MEMN, ws + WS_WMKV, NMEM, DM, DM, F.G, F.blk);
          pg8::EpiBf16<0> E{(bf16_t*)(ws + WS_MKV), DM, nullptr};
          pg8::gemm_phase<pg8::EpiBf16<0>, pg8::DenseSched, true>(F.lds, DM, S, E); }
    } SEAM(1);

    if (IN(2)) { p2_prep(F); } SEAM(2);

    if (IN(3)) {
        bf16_t* osb = (bf16_t*)(ws + WS_O); bf16_t* odsa = osb + (size_t)NTOK * 512; bf16_t* omem = odsa + (size_t)NTOK * 512;
#ifndef REP_DSA
#define REP_DSA 1
#endif
#ifndef REP_SB
#define REP_SB 1
#endif
#ifndef REP_MEM
#define REP_MEM 1
#endif
#ifndef NO_DSA
        for (int rep = 0; rep < REP_DSA; ++rep)
        if (F.G == 256) {
            for (int i = 0; i < 4; ++i) { const int p = 2 * F.blk + (i >> 1), b = p >> 4, cc = p & 15, c = (i & 1) ? 31 - cc : cc; dsa_unit(proj, odsa, b, c, F.lds, F.tid); }
        } else {
            for (int u = F.blk; u < 1024; u += F.G) dsa_unit(proj, odsa, u >> 5, u & 31, F.lds, F.tid);
        }
#endif
        const int gw = F.blk * NWAVES + F.wave, NGW = F.G * NWAVES;
#ifndef NO_SB
        for (int rep = 0; rep < REP_SB; ++rep)
        for (int it = gw; it < NB * 8 * 64; it += NGW) { const int qblk = 63 - (it >> 8), bh = it & 255; sb_item(proj, osb, bh >> 3, bh & 7, qblk, F.lds + F.wave * 4096, F.lane); }
#endif
#ifndef NO_MEM
        for (int rep = 0; rep < REP_MEM; ++rep)
        for (int it = gw; it < NB * 4 * 64; it += NGW) { const int qblk = it & 63, bh = it >> 6; mem_item(proj, (const bf16_t*)(ws + WS_MKV), omem, bh >> 2, bh & 3, qblk, F.lds + 32768 + F.wave * 8192, F.lane); }
#endif
    } SEAM(3);

    if (IN(4)) {
        pg8::DenseSched S; S.init(ws + WS_H, ws + WS_WG, NTOK, 3 * DM, DM, F.G, F.blk);
        pg8::EpiBf16<2> E{proj, PW, F.in[11]};
        pg8::gemm_phase<pg8::EpiBf16<2>, pg8::DenseSched, true>(F.lds, DM, S, E);
    } SEAM(4);

    if (IN(5)) {
 pg8::DenseSched S; S.init(ws + WS_O, ws + WS_WB, NTOK, DM, 512, F.G, F.blk);
        pg8::EpiMerge E{proj, 0, (bf16_t*)(ws + WS_H), 1};
        pg8::gemm_phase<pg8::EpiMerge, pg8::DenseSched, true>(F.lds, 512, S, E); } SEAM(5);
    if (IN(6)) { pg8::DenseSched S; S.init(ws + WS_O + (size_t)NTOK * 1024, ws + WS_WB + (size_t)DM * 1024, NTOK, DM, 512, F.G, F.blk);
        pg8::EpiMerge E{proj, DM, (bf16_t*)(ws + WS_H), 0};
        pg8::gemm_phase<pg8::EpiMerge, pg8::DenseSched, true>(F.lds, 512, S, E); } SEAM(6);
    if (IN(7)) { pg8::DenseSched S; S.init(ws + WS_O + (size_t)NTOK * 2048, ws + WS_WB + (size_t)DM * 2048, NTOK, DM, 512, F.G, F.blk);
        pg8::EpiMerge E{proj, 2 * DM, (bf16_t*)(ws + WS_H), 0};
        pg8::gemm_phase<pg8::EpiMerge, pg8::DenseSched, true>(F.lds, 512, S, E); } SEAM(7);

    if (IN(8)) {
        pg8::DenseSched S; S.init(ws + WS_H, ws + WS_WO, NTOK, DM, DM, F.G, F.blk);
        pg8::EpiResid E{F.in[0], F.out};
        pg8::gemm_phase<pg8::EpiResid, pg8::DenseSched, true>(F.lds, DM, S, E);
    } SEAM(8);

    if (IN(9)) for (int rep = 0; rep < NREP(9); ++rep) { if (rep) xcd_barrier(bar); p9_router(F); } SEAM(9);
    if (IN(10)) for (int rep = 0; rep < NREP(10); ++rep) { if (rep) xcd_barrier(bar); p10_assign(F); } SEAM(10);

    if (IN(11)) for (int rep = 0; rep < NREP(11); ++rep) {  if (rep) xcd_barrier(bar);
        pg8::MoeSched S{(const char*)(ws + WS_H), (const char*)(ws + WS_WEI), (const int*)(ws + WS_SLOT_TOK), F.MISC + MW_TSTART, DM, 2048, 8, F.blk};
        pg8::EpiSwiglu E{(bf16_t*)(ws + WS_P), F.in[18]};
        pg8::gemm_phase<pg8::EpiSwiglu, pg8::MoeSched, true>(F.lds, DM, S, E);
    } SEAM(11);

    if (IN(12)) {
        pg8::MoeSched S{(const char*)(ws + WS_P), (const char*)(ws + WS_WEO), nullptr, F.MISC + MW_TSTART, DM, DM, 4, F.blk};
        pg8::EpiScatter E{F.out, (const int*)(ws + WS_SLOT_TOK), (const float*)(ws + WS_SLOT_W), F.in[20], F.lds};
        pg8::gemm_phase<pg8::EpiScatter, pg8::MoeSched, true>(F.lds, DM, S, E);
    }
#undef IN
#undef SEAM
}

extern "C" void kernel_launch(void* const* d_in, const int* in_sizes, int n_in, void* d_out, int out_size, void* d_ws, size_t ws_size, hipStream_t stream) {
    static int grid = 0;
    if (grid == 0) {
        if (n_in != 21 || in_sizes[0] != NTOK * DM || out_size != NTOK * DM || ws_size < WS_END) {
            fprintf(stderr, "kernel_launch: unexpected shapes: n_in %d in0 %d out %d ws %zu (need >= %zu); nothing launched\n", n_in, n_in > 0 ? in_sizes[0] : -1, out_size, ws_size, (size_t)WS_END); grid = -1; return; }
        int dev = 0, cus = 0, per_cu = 0;
        if (hipGetDevice(&dev) != hipSuccess || hipDeviceGetAttribute(&cus, hipDeviceAttributeMultiprocessorCount, dev) != hipSuccess) { fprintf(stderr, "kernel_launch: device query failed\n"); grid = -1; return; }
        if (hipFuncSetAttribute((const void*)fwd_kernel, hipFuncAttributeMaxDynamicSharedMemorySize, LDS_BYTES) != hipSuccess) { fprintf(stderr, "kernel_launch: hipFuncSetAttribute failed\n"); grid = -1; return; }
        if (hipOccupancyMaxActiveBlocksPerMultiprocessor(&per_cu, (const void*)fwd_kernel, NWAVES * 64, LDS_BYTES) != hipSuccess || per_cu < 1)
            fprintf(stderr, "kernel_launch: note: occupancy query reports %d workgroups per CU\n", per_cu);
        (void)hipGetLastError();
        grid = cus;
        if (grid != 256) { fprintf(stderr, "kernel_launch: this kernel is built for 256 CUs (got %d); nothing launched\n", grid); grid = -1; return; }
    }
    if (grid < 0) return;
    if (hipMemsetAsync((char*)d_ws + WS_CTL, 0, CTL_ZERO_BYTES, stream) != hipSuccess) { fprintf(stderr, "kernel_launch: hipMemsetAsync failed\n"); return; }
    Args a{};
    for (int i = 0; i < 21; ++i) a.in[i] = (const float*)d_in[i];
    a.out = (float*)d_out; a.ws = (unsigned char*)d_ws;
#if MK_ONE_LAUNCH
    const int cuts[2] = {0, N_PHASES}; const int nl = 1;
#else
    const int cuts[11] = {0, 1, 2, 3, 4, 5, 6, 7, 8, 9, N_PHASES}; const int nl = 10;
#endif
    for (int li = 0; li < nl; ++li) {
        a.ph_lo = cuts[li]; a.ph_hi = cuts[li + 1];
        hipLaunchKernelGGL(fwd_kernel, dim3(grid), dim3(NWAVES * 64), LDS_BYTES, stream, a);
        const hipError_t le = hipPeekAtLastError();
        if (le != hipSuccess) { fprintf(stderr, "kernel_launch: launch %d failed: %s\n", li, hipGetErrorName(le)); break; }
    }
}
```

```cpp
#include <hip/hip_runtime.h>
#include <cstdio>
#include <cstdint>

#define LAS __attribute__((address_space(3)))
#define GAS __attribute__((address_space(1)))
typedef unsigned short bf16_t;
typedef short bf16x8 __attribute__((ext_vector_type(8)));
typedef short s16x4 __attribute__((ext_vector_type(4)));
typedef short v4i16_t __attribute__((ext_vector_type(4)));
typedef float f32x2 __attribute__((ext_vector_type(2)));
typedef float f32x4 __attribute__((ext_vector_type(4)));
typedef float f32x16 __attribute__((ext_vector_type(16)));
typedef unsigned u32x2 __attribute__((ext_vector_type(2)));
typedef unsigned u32x4 __attribute__((ext_vector_type(4)));
typedef GAS unsigned gu32;

constexpr int NB = 32, SEQ = 2048, DM = 1024, NTOK = NB * SEQ;
constexpr int MEMLEN = 256, NMEM = NB * MEMLEN;
constexpr int PW = 3072;
constexpr int C_SQ = 0, C_SK = 512, C_SV = 1024, C_DQ = 1536, C_DK = 2048, C_DV = 2112, C_IQ = 2176, C_IK = 2432, C_IW = 2496, C_MQ = 2560;
constexpr int IN_W = 3012;
constexpr int NEXP = 32, TOPK = 4, DEXP = 1024;
constexpr int NSLOT = NTOK * TOPK;
constexpr int NSLOT_PAD = NSLOT + NEXP * 256;
constexpr float EPS = 1e-6f;
constexpr float LOG2E = 1.4426950408889634f;

constexpr size_t MiB = 1u << 20;
constexpr size_t WS_CTL = 0, CTL_ZERO_BYTES = 1 * MiB;
constexpr size_t WS_ROPE = 1 * MiB;
constexpr size_t WS_BLKCNT = 1 * MiB + 512 * 1024;
constexpr size_t WS_SLOT_TOK = 2 * MiB;
constexpr size_t WS_SLOT_W = 4 * MiB;
constexpr size_t WS_WIN = 8 * MiB;
constexpr size_t WS_WMKV = 14 * MiB;
constexpr size_t WS_WG = 16 * MiB;
constexpr size_t WS_WB = 22 * MiB;
constexpr size_t WS_WO = 25 * MiB;
constexpr size_t WS_WEI = 27 * MiB;
constexpr size_t WS_WEO = 155 * MiB;
constexpr size_t WS_H = 220 * MiB;
constexpr size_t WS_P = 348 * MiB;
constexpr size_t WS_O = 732 * MiB;
constexpr size_t WS_MEMN = 924 * MiB;
constexpr size_t WS_MKV = 940 * MiB;
constexpr size_t WS_END = 956 * MiB;
static_assert(WS_P + (size_t)NSLOT_PAD * DEXP * 2 <= WS_MEMN, "act overlays proj|o");
static_assert(WS_SLOT_TOK + (size_t)NSLOT_PAD * 4 <= WS_SLOT_W && WS_SLOT_W + (size_t)NSLOT_PAD * 4 <= WS_WIN, "slot tables");

constexpr int CW_BAR = 4096;

constexpr int RING_BYTES = 151552;
constexpr int MISC_OFF = RING_BYTES;
constexpr int LDS_BYTES = 155648;
constexpr int MW_BAR = 8;
constexpr int MW_LCNT = 16;
constexpr int MW_PSTART = 64;
constexpr int MW_TSTART = 128;
constexpr int MW_BEFORE = 192;
constexpr int MW_PART = 256;

__device__ __forceinline__ unsigned f2bf(float f) { unsigned u = __builtin_bit_cast(unsigned, f); return (u + 0x7fffu + ((u >> 16) & 1u)) >> 16; }
__device__ __forceinline__ unsigned pk2(float lo, float hi) { return f2bf(lo) | (f2bf(hi) << 16); }
__device__ __forceinline__ float bf2f(unsigned short b) { return __builtin_bit_cast(float, (unsigned)b << 16); }
__device__ __forceinline__ float bflo(unsigned w) { return __builtin_bit_cast(float, w << 16); }
__device__ __forceinline__ float bfhi(unsigned w) { return __builtin_bit_cast(float, w & 0xffff0000u); }
__device__ __forceinline__ unsigned cvt_pk_bf16(float lo, float hi) { unsigned r; asm volatile("v_cvt_pk_bf16_f32 %0, %1, %2" : "=v"(r) : "v"(lo), "v"(hi)); return r; }
__device__ __forceinline__ int crow(int r, int hi) { return (r & 3) + 8 * (r >> 2) + 4 * hi; }
#define LDS_WAIT() asm volatile("s_waitcnt lgkmcnt(0)" ::: "memory")
#define VM_WAIT() asm volatile("s_waitcnt vmcnt(0)" ::: "memory")

namespace pg8 {
constexpr int BM = 256, BK = 64, HALF = 128, HTB = HALF * BK * 2, STAGE_BYTES = 8 * HTB;
__host__ __device__ __forceinline__ int lds_byte(int r, int c) { const int st = (r >> 4) * 2 + (c >> 5), rr = r & 15, cc = c & 31, ob = rr * 64 + cc * 2; return st * 1024 + (ob ^ (((ob >> 9) & 1) << 5)); }
__host__ __device__ __forceinline__ void stage_rc(int b, int& R, int& C) { const int st = b / 1024, sb = b % 1024, swz = sb ^ (((sb >> 9) & 1) << 5); R = (st >> 1) * 16 + swz / 64; C = (st & 1) * 32 + (swz % 64) / 2; }
__host__ __device__ __forceinline__ int perm32(int rho) { const int n = rho >> 4, i = rho & 15; return 8 * (i >> 2) + 4 * n + (i & 3); }

struct Unit { int pm, pn, e; };

template <class Epi, class Sched, bool ALIGN_EPI>
__device__ __forceinline__ void gemm_phase(LAS unsigned char* lds, const int K, const Sched& S, const Epi& E) {
    const int tid = threadIdx.x, wid = __builtin_amdgcn_readfirstlane(tid >> 6), lane = tid & 63, wr = wid >> 2, wc = wid & 3, fr = lane & 15, fq = lane >> 4;
    const int nt = K / BK;
    int Rr[2], Cc[2]; unsigned voffB[2];
#pragma unroll
    for (int i = 0; i < 2; ++i) { int R, C; stage_rc(tid * 16 + i * 8192, R, C); Rr[i] = R; Cc[i] = C; const int Rb = Epi::PERM ? ((R & ~31) + perm32(R & 31)) : R; voffB[i] = (unsigned)(Rb * K + C) * 2u; }
    const size_t kstep = (size_t)(BK * 2);
    const size_t hstepB = (size_t)HALF * K * 2;
    const unsigned ldsw = (unsigned)wid * 1024u;
    const int aoff = lds_byte(wr * 64 + fr, fq * 8), boff = lds_byte(wc * 32 + fr, fq * 8);
#define PG8_SA(b, h) (((b) * 2 + (h)) * HTB)
#define PG8_SB(b, h) ((4 + (b) * 2 + (h)) * HTB)
#define PG8_STAGE(bufoff, gbase, voff) do { _Pragma("unroll") for (int _i = 0; _i < 2; ++_i) \
        __builtin_amdgcn_global_load_lds((const unsigned*)((const char*)(gbase) + (voff)[_i]), (LAS unsigned*)(lds + (bufoff) + ldsw + _i * 8192), 16, 0, 0); } while (0)
#define PG8_LDA(dst, b, h) do { _Pragma("unroll") for (int m = 0; m < 4; ++m) _Pragma("unroll") for (int k = 0; k < 2; ++k) dst[m][k] = *(const LAS bf16x8*)(lds + PG8_SA(b, h) + aoff + m * 2048 + k * 1024); } while (0)
#define PG8_LDB(dst, b, h) do { _Pragma("unroll") for (int n = 0; n < 2; ++n) _Pragma("unroll") for (int k = 0; k < 2; ++k) dst[n][k] = *(const LAS bf16x8*)(lds + PG8_SB(b, h) + boff + n * 2048 + k * 1024); } while (0)
#define PG8_MMA(ai, bj, At, Bt) do { __builtin_amdgcn_s_setprio(1); _Pragma("unroll") for (int m = 0; m < 4; ++m) _Pragma("unroll") for (int n = 0; n < 2; ++n) _Pragma("unroll") for (int k = 0; k < 2; ++k) \
        acc[ai][bj][m][n] = __builtin_amdgcn_mfma_f32_16x16x32_bf16(Bt[n][k], At[m][k], acc[ai][bj][m][n], 0, 0, 0); __builtin_amdgcn_s_setprio(0); } while (0)
#define PG8_WAIT_V(n) asm volatile("s_waitcnt vmcnt(" #n ")" ::: "memory")
#define PG8_WAIT_L(n) asm volatile("s_waitcnt lgkmcnt(" #n ")" ::: "memory")
#define PG8_BAR __builtin_amdgcn_s_barrier()
#define PG8_SCHED __builtin_amdgcn_sched_barrier(0)
    Unit cur, nxt; int ui = 0;
    if (!S.next(0, cur)) return;
    f32x4 acc[2][2][4][2];
#pragma unroll
    for (int a = 0; a < 2; ++a)
#pragma unroll
        for (int b = 0; b < 2; ++b)
#pragma unroll
            for (int m = 0; m < 4; ++m)
#pragma unroll
                for (int n = 0; n < 2; ++n) acc[a][b][m][n] = (f32x4){0.f, 0.f, 0.f, 0.f};
    bf16x8 At[4][2], B0[2][2], B1[2][2];
    const char* Ab = S.a_base();
    unsigned ca0[2], ca1[2], na0[2], na1[2];
#pragma unroll
    for (int i = 0; i < 2; ++i) { ca0[i] = S.a_off(cur, Rr[i], Cc[i]); ca1[i] = S.a_off(cur, HALF + Rr[i], Cc[i]); }
    const char* cB = S.b_tile(cur);
    PG8_STAGE(PG8_SB(0, 0), cB, voffB); PG8_STAGE(PG8_SB(0, 1), cB + hstepB, voffB); PG8_STAGE(PG8_SA(0, 0), Ab, ca0); PG8_STAGE(PG8_SA(0, 1), Ab, ca1);
    if (wr == 1) PG8_BAR;
    PG8_WAIT_V(2); PG8_BAR;
    PG8_STAGE(PG8_SB(1, 0), cB + kstep, voffB); PG8_STAGE(PG8_SA(1, 0), Ab + kstep, ca0); PG8_STAGE(PG8_SB(1, 1), cB + hstepB + kstep, voffB);
    PG8_WAIT_V(6); PG8_BAR;
    for (;;) {
        const bool has_next = S.next(ui + 1, nxt);
        const char* nB = cB;
#pragma unroll
        for (int i = 0; i < 2; ++i) { na0[i] = ca0[i]; na1[i] = ca1[i]; }
        if (has_next) { nB = S.b_tile(nxt);
#pragma unroll
            for (int i = 0; i < 2; ++i) { na0[i] = S.a_off(nxt, Rr[i], Cc[i]); na1[i] = S.a_off(nxt, HALF + Rr[i], Cc[i]); } }
        for (int t = 0; t < nt; t += 2) {
            const bool last = (t == nt - 2);
            const char* a1 = Ab + (size_t)(t + 1) * kstep;
            const char* a2 = last ? Ab : Ab + (size_t)(t + 2) * kstep; const char* b2 = last ? nB : cB + (size_t)(t + 2) * kstep;
            const char* a3 = a2 + kstep; const char* b3 = b2 + kstep;
            unsigned o20[2], o21[2];
#pragma unroll
            for (int i = 0; i < 2; ++i) { o20[i] = last ? na0[i] : ca0[i]; o21[i] = last ? na1[i] : ca1[i]; }
            PG8_LDB(B0, 0, 0); PG8_LDB(B1, 0, 1); PG8_SCHED; PG8_LDA(At, 0, 0); PG8_STAGE(PG8_SA(1, 1), a1, ca1);
            PG8_WAIT_V(8); PG8_WAIT_L(0); PG8_BAR; PG8_MMA(0, 0, At, B0); PG8_MMA(0, 1, At, B1); PG8_BAR; PG8_SCHED;
            PG8_LDA(At, 0, 1); PG8_STAGE(PG8_SB(0, 0), b2, voffB); PG8_STAGE(PG8_SB(0, 1), b2 + hstepB, voffB); PG8_STAGE(PG8_SA(0, 0), a2, o20);
            PG8_WAIT_V(8); PG8_WAIT_L(0); PG8_BAR; PG8_MMA(1, 0, At, B0); PG8_MMA(1, 1, At, B1); PG8_BAR; PG8_SCHED;
            PG8_LDB(B0, 1, 0); PG8_LDB(B1, 1, 1); PG8_SCHED; PG8_LDA(At, 1, 0); PG8_STAGE(PG8_SA(0, 1), a2, o21);
            PG8_WAIT_V(8); PG8_WAIT_L(0); PG8_BAR; PG8_MMA(0, 0, At, B0); PG8_MMA(0, 1, At, B1); PG8_BAR; PG8_SCHED;
            PG8_LDA(At, 1, 1); PG8_STAGE(PG8_SB(1, 0), b3, voffB); PG8_STAGE(PG8_SB(1, 1), b3 + hstepB, voffB); PG8_STAGE(PG8_SA(1, 0), a3, o20);
            PG8_WAIT_V(8); PG8_WAIT_L(0); PG8_BAR; PG8_MMA(1, 0, At, B0); PG8_MMA(1, 1, At, B1); PG8_BAR; PG8_SCHED;
        }
        if constexpr (ALIGN_EPI) { if (wr == 0) PG8_BAR; }
        E(acc, cur, wr, wc, fr, fq);
        if (!has_next) break;
#pragma unroll
        for (int a = 0; a < 2; ++a)
#pragma unroll
            for (int b = 0; b < 2; ++b)
#pragma unroll
                for (int m = 0; m < 4; ++m)
#pragma unroll
                    for (int n = 0; n < 2; ++n) acc[a][b][m][n] = (f32x4){0.f, 0.f, 0.f, 0.f};
        cur = nxt; cB = nB; ++ui;
#pragma unroll
        for (int i = 0; i < 2; ++i) { ca0[i] = na0[i]; ca1[i] = na1[i]; }
        if constexpr (ALIGN_EPI) { if (wr == 1) PG8_BAR; }
    }
    PG8_WAIT_V(0);
    if constexpr (!ALIGN_EPI) { if (wr == 0) PG8_BAR; }
    PG8_BAR;
#undef PG8_SA
#undef PG8_SB
#undef PG8_STAGE
#undef PG8_LDA
#undef PG8_LDB
#undef PG8_MMA
#undef PG8_WAIT_V
#undef PG8_WAIT_L
#undef PG8_BAR
#undef PG8_SCHED
}

struct DenseSched {
    const char* A; const char* Bt; int K, nM, nN, nwg, G, c;
    __device__ __forceinline__ void init(const void* A_, const void* Bt_, int M, int N, int K_, int G_, int c_) { A = (const char*)A_; Bt = (const char*)Bt_; K = K_; nM = M / BM; nN = N / BM; nwg = nM * nN; G = G_; c = c_; }
    __device__ __forceinline__ bool next(int i, Unit& u) const {
        const long L = (long)i * G + c; if (L >= nwg) return false;
        int wgid = (int)L; { const int q = nwg / 8, r = nwg % 8, xcd = wgid % 8, off = wgid / 8; wgid = (xcd < r ? xcd * (q + 1) : r * (q + 1) + (xcd - r) * q) + off; }
        const int nig = 8 * nN, gid = wgid / nig, fm = gid * 8, gsz = (nM - fm) < 8 ? (nM - fm) : 8;
        u.pm = fm + ((wgid % nig) % gsz); u.pn = (wgid % nig) / gsz; u.e = 0; return true;
    }
    __device__ __forceinline__ const char* a_base() const { return A; }
    __device__ __forceinline__ unsigned a_off(const Unit& u, int row, int col) const { return (unsigned)(((size_t)(u.pm * BM + row) * K + col) * 2); }
    __device__ __forceinline__ const char* b_tile(const Unit& u) const { return Bt + (size_t)u.pn * BM * K * 2; }
};
}

namespace pg8 {
struct MoeSched {
    const char* A; const char* Bt; const int* slot_tok; volatile LAS unsigned* tstart; int K, rowsE, nN, c;
    __device__ __forceinline__ bool next(int i, Unit& u) const {
        const int x = c & 7, j = c >> 3, rpr = 32 / nN;
        const int pm = (i * 8 + x) * rpr + j / nN;
        const int T = (int)tstart[32];
        if (pm >= T) return false;
        int e = 0;
#pragma unroll 1
        for (int k = 1; k < 32; ++k) e += ((int)tstart[k] <= pm) ? 1 : 0;
        u.pm = pm; u.pn = j % nN; u.e = __builtin_amdgcn_readfirstlane(e); return true;
    }
    __device__ __forceinline__ const char* a_base() const { return A; }
    __device__ __forceinline__ unsigned a_off(const Unit& u, int row, int col) const {
        const int pos = u.pm * BM + row;
        const int r = slot_tok ? slot_tok[pos] : pos;
        return (unsigned)(((size_t)r * K + col) * 2);
    }
    __device__ __forceinline__ const char* b_tile(const Unit& u) const { return Bt + ((size_t)u.e * rowsE + (size_t)u.pn * BM) * K * 2; }
};

template <int ACT> struct EpiBf16 {
    static constexpr bool PERM = true;
    bf16_t* O; int ldc; const float* bias;
    __device__ __forceinline__ void operator()(const f32x4 (&acc)[2][2][4][2], const Unit& u, int wr, int wc, int fr, int fq) const {
        const int row0 = u.pm * BM + wr * 64 + fr; const int col0 = u.pn * BM + wc * 32 + 8 * fq;
        f32x4 bv[2][2];
#pragma unroll
        for (int bj = 0; bj < 2; ++bj)
#pragma unroll
            for (int n = 0; n < 2; ++n) bv[bj][n] = bias ? *(const f32x4*)(bias + col0 + bj * HALF + 4 * n) : (f32x4){0.f, 0.f, 0.f, 0.f};
#pragma unroll
        for (int ai = 0; ai < 2; ++ai)
#pragma unroll
            for (int m = 0; m < 4; ++m) { bf16_t* rowp = O + (size_t)(row0 + ai * HALF + m * 16) * ldc + col0;
#pragma unroll
                for (int bj = 0; bj < 2; ++bj) { f32x4 v0 = acc[ai][bj][m][0] + bv[bj][0], v1 = acc[ai][bj][m][1] + bv[bj][1];
                    if (ACT == 2) {
#pragma unroll
                        for (int q = 0; q < 4; ++q) { v0[q] = __builtin_amdgcn_rcpf(1.f + __builtin_amdgcn_exp2f(-LOG2E * v0[q])); v1[q] = __builtin_amdgcn_rcpf(1.f + __builtin_amdgcn_exp2f(-LOG2E * v1[q])); } }
                    u32x4 w; w.x = cvt_pk_bf16(v0[0], v0[1]); w.y = cvt_pk_bf16(v0[2], v0[3]); w.z = cvt_pk_bf16(v1[0], v1[1]); w.w = cvt_pk_bf16(v1[2], v1[3]);
                    *(u32x4*)(rowp + bj * HALF) = w; } }
    }
};
struct EpiMerge {
    static constexpr bool PERM = true;
    const bf16_t* G; int goff; bf16_t* Mg; int first;
    __device__ __forceinline__ void operator()(const f32x4 (&acc)[2][2][4][2], const Unit& u, int wr, int wc, int fr, int fq) const {
        const int row0 = u.pm * BM + wr * 64 + fr; const int col0 = u.pn * BM + wc * 32 + 8 * fq;
#pragma unroll
        for (int ai = 0; ai < 2; ++ai)
#pragma unroll
            for (int m = 0; m < 4; ++m) { const size_t row = (size_t)(row0 + ai * HALF + m * 16);
#pragma unroll
                for (int bj = 0; bj < 2; ++bj) {
                    const u32x4 g = *(const u32x4*)(G + row * PW + goff + col0 + bj * HALF);
                    u32x4 p = (u32x4){0u, 0u, 0u, 0u};
                    if (!first) p = *(const u32x4*)(Mg + row * DM + col0 + bj * HALF);
                    const f32x4 a0 = acc[ai][bj][m][0], a1 = acc[ai][bj][m][1];
                    u32x4 w;
                    w.x = cvt_pk_bf16(bflo(p.x) + bflo(g.x) * a0[0], bfhi(p.x) + bfhi(g.x) * a0[1]);
                    w.y = cvt_pk_bf16(bflo(p.y) + bflo(g.y) * a0[2], bfhi(p.y) + bfhi(g.y) * a0[3]);
                    w.z = cvt_pk_bf16(bflo(p.z) + bflo(g.z) * a1[0], bfhi(p.z) + bfhi(g.z) * a1[1]);
                    w.w = cvt_pk_bf16(bflo(p.w) + bflo(g.w) * a1[2], bfhi(p.w) + bfhi(g.w) * a1[3]);
                    *(u32x4*)(Mg + row * DM + col0 + bj * HALF) = w; } }
    }
};
struct EpiResid {
    static constexpr bool PERM = false;
    const float* base; float* out;
    __device__ __forceinline__ void operator()(const f32x4 (&acc)[2][2][4][2], const Unit& u, int wr, int wc, int fr, int fq) const {
        const int row0 = u.pm * BM + wr * 64 + fr; const int col0 = u.pn * BM + wc * 32 + 4 * fq;
#pragma unroll
        for (int ai = 0; ai < 2; ++ai)
#pragma unroll
            for (int m = 0; m < 4; ++m) { const size_t off = (size_t)(row0 + ai * HALF + m * 16) * DM + col0;
#pragma unroll
                for (int bj = 0; bj < 2; ++bj)
#pragma unroll
                    for (int n = 0; n < 2; ++n) { const f32x4 b = *(const f32x4*)(base + off + bj * HALF + n * 16); *(f32x4*)(out + off + bj * HALF + n * 16) = b + acc[ai][bj][m][n]; } }
    }
};
struct EpiSwiglu {
    static constexpr bool PERM = true;
    bf16_t* act; const float* bias;
    __device__ __forceinline__ void operator()(const f32x4 (&acc)[2][2][4][2], const Unit& u, int wr, int wc, int fr, int fq) const {
        const int row0 = u.pm * BM + wr * 64 + fr; const int col0 = u.pn * HALF + wc * 32 + 8 * fq;
        const float* be = bias + (size_t)u.e * 2048 + col0;
        f32x4 bg[2], bu[2];
#pragma unroll
        for (int n = 0; n < 2; ++n) { bg[n] = *(const f32x4*)(be + 4 * n); bu[n] = *(const f32x4*)(be + 1024 + 4 * n); }
#pragma unroll
        for (int ai = 0; ai < 2; ++ai)
#pragma unroll
            for (int m = 0; m < 4; ++m) { bf16_t* rowp = act + (size_t)(row0 + ai * HALF + m * 16) * DEXP + col0;
                float o[8];
#pragma unroll
                for (int n = 0; n < 2; ++n) { const f32x4 gv = acc[ai][0][m][n] + bg[n], uv = acc[ai][1][m][n] + bu[n];
#pragma unroll
                    for (int q = 0; q < 4; ++q) { const float g = fminf(gv[q], 7.0f); const float uu = fminf(fmaxf(uv[q], -7.0f), 7.0f);
                        const float sg = __builtin_amdgcn_rcpf(1.f + __builtin_amdgcn_exp2f(-1.702f * LOG2E * g));
                        o[4 * n + q] = (uu + 1.0f) * (g * sg); } }
                u32x4 w; w.x = cvt_pk_bf16(o[0], o[1]); w.y = cvt_pk_bf16(o[2], o[3]); w.z = cvt_pk_bf16(o[4], o[5]); w.w = cvt_pk_bf16(o[6], o[7]);
                *(u32x4*)rowp = w; }
    }
};
constexpr int EPI_STAGE_OFF = 131072, EPI_STAGE_WAVE = 2304;
struct EpiScatter {
    static constexpr bool PERM = false;
    float* out; const int* slot_tok; const float* slot_w; const float* bias; LAS unsigned char* lds;
    __device__ __forceinline__ void operator()(const f32x4 (&acc)[2][2][4][2], const Unit& u, int wr, int wc, int fr, int fq) const {
        const int lane = fr + 16 * fq, wid = wr * 4 + wc;
        LAS float* st = (LAS float*)(lds + EPI_STAGE_OFF + wid * EPI_STAGE_WAVE);
        const int row0 = u.pm * BM + wr * 64 + fr;
        const int lcol = lane & 31, lrow = lane >> 5;
        float bv[2];
#pragma unroll
        for (int bj = 0; bj < 2; ++bj) bv[bj] = bias[(size_t)u.e * DM + u.pn * BM + bj * HALF + wc * 32 + lcol];
#pragma unroll
        for (int ai = 0; ai < 2; ++ai)
#pragma unroll
            for (int m = 0; m < 4; ++m) { const int pos = row0 + ai * HALF + m * 16; const float w = slot_w[pos]; const int tok = slot_tok[pos];
#pragma unroll
                for (int bj = 0; bj < 2; ++bj) {
#pragma unroll
                    for (int n = 0; n < 2; ++n) *(LAS f32x4*)(st + fr * 36 + 16 * n + 4 * fq) = acc[ai][bj][m][n];
                    asm volatile("s_waitcnt lgkmcnt(0)" ::: "memory");
#pragma unroll
                    for (int i = 0; i < 8; ++i) { const int r = 2 * i + lrow; const float v = st[r * 36 + lcol];
                        const float wr_ = __shfl(w, r); const int tr_ = __shfl(tok, r);
                        if (wr_ != 0.f) unsafeAtomicAdd(out + (size_t)tr_ * DM + u.pn * BM + bj * HALF + wc * 32 + lcol, (v + bv[bj]) * wr_); }
                    asm volatile("s_waitcnt lgkmcnt(0)" ::: "memory");
                } }
    }
};
}

#define XB_TMO      128
#define XB_XCNT(j)  (256  + 64 * (j))
#define XB_XSUB(j)  (1280 + 64 * (j))
#define XB_XGEN(j)  (2304 + 64 * (j))
#define XB_TOP      3328
#define XB_TOPGEN   3392
#define XCD_BAR_WORDS 3456
#define XB_SPIN_CAP (1u << 18)

__device__ __forceinline__ unsigned xb_ld(unsigned* p)              { return __hip_atomic_load(p, __ATOMIC_RELAXED, __HIP_MEMORY_SCOPE_AGENT); }
__device__ __forceinline__ unsigned xb_add(unsigned* p, unsigned v) { return __hip_atomic_fetch_add(p, v, __ATOMIC_RELAXED, __HIP_MEMORY_SCOPE_AGENT); }
__device__ __forceinline__ unsigned xb_xcc_id() { return (unsigned)__builtin_amdgcn_s_getreg((3 << 11) | 20) & 0xFu; }
#define XB_SPIN(cond, bar) do { unsigned _sp = 0; while (cond) { __builtin_amdgcn_s_sleep(1); \
    if ((++_sp & 255u) == 0u) { if (xb_ld(&(bar)[XB_TMO])) break; if (_sp > XB_SPIN_CAP) { atomicAdd(&(bar)[XB_TMO], 1u); break; } } } } while (0)

struct XcdBarrier {
    unsigned* bar; unsigned x;
    volatile LAS unsigned* st;
};

__device__ __forceinline__ XcdBarrier xcd_barrier_post(unsigned* bar, volatile LAS unsigned* st) {
    XcdBarrier b; b.bar = bar; b.x = xb_xcc_id(); b.st = st;
    if (threadIdx.x == 0) (void)xb_add(&bar[XB_XCNT(b.x)], 1u);
    return b;
}
__device__ __forceinline__ void xcd_barrier_complete(unsigned* bar, unsigned x, unsigned& nloc, unsigned& nx) {
    const unsigned G = gridDim.x * gridDim.y * gridDim.z;
    unsigned sum, cnt, mine, sp = 0u;
    for (;;) {
        sum = 0u; cnt = 0u; mine = 0u;
#pragma unroll
        for (unsigned j = 0; j < 16; ++j) { const unsigned c = xb_ld(&bar[XB_XCNT(j)]); sum += c; cnt += (c > 0u) ? 1u : 0u; mine = (j == x) ? c : mine; }
        if (sum == G) break;
        __builtin_amdgcn_s_sleep(1);
        if ((++sp & 255u) == 0u) { if (xb_ld(&bar[XB_TMO])) break; if (sp > XB_SPIN_CAP) { atomicAdd(&bar[XB_TMO], 1u); break; } }
    }
    nloc = mine > 0u ? mine : 1u; nx = cnt > 0u ? cnt : 1u;
}

__device__ __forceinline__ void xcd_barrier(const XcdBarrier& b) {
    asm volatile("s_waitcnt vmcnt(0)" ::: "memory");
    __syncthreads();
    if (threadIdx.x == 0) {
        unsigned* bar = b.bar;
        __builtin_amdgcn_s_waitcnt(0);
        unsigned nloc = b.st[0], nx = b.st[1];
        if (nloc == 0u) { xcd_barrier_complete(bar, b.x, nloc, nx); b.st[0] = nloc; b.st[1] = nx; }
        const unsigned old = xb_add(&bar[XB_XSUB(b.x)], 1u);
        const unsigned gen = old / nloc;
        if (old + 1u == (gen + 1u) * nloc) {
            __builtin_amdgcn_fence(__ATOMIC_RELEASE, "agent");
            asm volatile("s_waitcnt vmcnt(0)" ::: "memory");
            const unsigned og = xb_add(&bar[XB_TOP], 1u);
            const unsigned tg = og / nx;
            if (og + 1u == (tg + 1u) * nx) xb_add(&bar[XB_TOPGEN], 1u);
            else XB_SPIN(xb_ld(&bar[XB_TOPGEN]) == tg, bar);
            __builtin_amdgcn_fence(__ATOMIC_ACQUIRE, "agent");
            xb_add(&bar[XB_XGEN(b.x)], 1u);
            asm volatile("s_waitcnt vmcnt(0)" ::: "memory");
        } else {
            XB_SPIN(xb_ld(&bar[XB_XGEN(b.x)]) == gen, bar);
            __builtin_amdgcn_fence(__ATOMIC_ACQUIRE, "agent");
            asm volatile("s_waitcnt vmcnt(0)" ::: "memory");
        }
    }
    __syncthreads();
}

constexpr int NWAVES = 8;
struct Frame {
    LAS unsigned char* lds;
    volatile LAS unsigned* MISC;
    gu32* ctl;
    int tid, lane, wave, G, blk;
    const float* in[21];
    float* out; unsigned char* ws;
};
__device__ __forceinline__ float wave_sum(float v) {
#pragma unroll
    for (int o = 1; o < 64; o <<= 1) v += __shfl_xor(v, o);
    return v;
}

__device__ __forceinline__ int map_src(int mode, int n) {
    if (mode == 1) return n < 2500 ? n : (n >= C_MQ ? n - (C_MQ - 2500) : -1);
    if (mode == 2) { const int pn = n >> 8, bj = (n >> 7) & 1, j = n & 127; return bj * 1024 + pn * 128 + j; }
    return n;
}
__device__ __forceinline__ void transpose_item(const float* W, int K, int Nsrc, int Ndst, bf16_t* WT, int mode, LAS float* scr, int item, int lane) {
    const int nblk = Ndst / 32, kb = item / nblk, nb = item % nblk, k0 = 64 * kb, n0 = 32 * nb;
    const int sc = map_src(mode, n0 + (lane & 31));
    const float scale = (mode == 1 && (n0 + (lane & 31)) < 512) ? 0.125f : 1.0f;
#pragma unroll 8
    for (int i = 0; i < 32; ++i) { const int kk = 2 * i + (lane >> 5); scr[kk * 33 + (lane & 31)] = sc >= 0 ? W[(size_t)(k0 + kk) * Nsrc + sc] * scale : 0.f; }
    LDS_WAIT(); asm volatile("" ::: "memory");
    const int c = lane & 7;
#pragma unroll
    for (int j = 0; j < 4; ++j) { const int n = (lane >> 3) + 8 * j; const LAS float* s = scr + (8 * c) * 33 + n;
        u32x4 o; o.x = pk2(s[0 * 33], s[1 * 33]); o.y = pk2(s[2 * 33], s[3 * 33]); o.z = pk2(s[4 * 33], s[5 * 33]); o.w = pk2(s[6 * 33], s[7 * 33]);
        *(GAS u32x4*)(WT + (size_t)(n0 + n) * K + k0 + 8 * c) = o; }
    LDS_WAIT(); asm volatile("" ::: "memory");
}
__device__ __forceinline__ void rms_row_to_bf16(int lane, const float* xrow, const float* g, bf16_t* orow) {
    const GAS f32x4* xr = (const GAS f32x4*)xrow + lane; const GAS f32x4* gr = (const GAS f32x4*)g + lane;
    f32x4 v[4]; float s = 0.f;
#pragma unroll
    for (int j = 0; j < 4; ++j) { v[j] = xr[64 * j]; s += (v[j].x * v[j].x + v[j].y * v[j].y) + (v[j].z * v[j].z + v[j].w * v[j].w); }
    const float rstd = 1.0f / sqrtf(wave_sum(s) * (1.f / DM) + EPS);
    GAS u32x2* o8 = (GAS u32x2*)orow + lane;
#pragma unroll
    for (int j = 0; j < 4; ++j) { const f32x4 gg = gr[64 * j]; u32x2 o; o.x = pk2(v[j].x * rstd * gg.x, v[j].y * rstd * gg.y); o.y = pk2(v[j].z * rstd * gg.z, v[j].w * rstd * gg.w); o8[64 * j] = o; }
}

__device__ __forceinline__ void p0_prologue(Frame& F) {
    LAS float* scr = (LAS float*)(F.lds + F.wave * 16384);
    const int gw = F.blk * NWAVES + F.wave, NGW = F.G * NWAVES, lane = F.lane;
    unsigned char* ws = F.ws;
    constexpr int I_IN = 16 * 96, I_MKV = 16 * 32, I_G = 16 * 32, I_B = 8 * 32, I_O = 16 * 32, I_EI = 16 * 64, I_EO = 16 * 32;
    constexpr int NITEMS = I_IN + I_MKV + 3 * I_G + 3 * I_B + I_O + NEXP * I_EI + NEXP * I_EO;
    for (int it = gw; it < NITEMS; it += NGW) {
        int r = it;
        if (r < I_IN) { transpose_item(F.in[3], DM, IN_W, PW, (bf16_t*)(ws + WS_WIN), 1, scr, r, lane); continue; } r -= I_IN;
        if (r < I_MKV) { transpose_item(F.in[9], DM, DM, DM, (bf16_t*)(ws + WS_WMKV), 0, scr, r, lane); continue; } r -= I_MKV;
        if (r < 3 * I_G) { const int n = r / I_G; transpose_item(F.in[10] + (size_t)n * DM * DM, DM, DM, DM, (bf16_t*)(ws + WS_WG) + (size_t)n * DM * DM, 0, scr, r % I_G, lane); continue; } r -= 3 * I_G;
        if (r < 3 * I_B) { const int n = r / I_B; transpose_item(F.in[12] + (size_t)n * 512 * DM, 512, DM, DM, (bf16_t*)(ws + WS_WB) + (size_t)n * DM * 512, 0, scr, r % I_B, lane); continue; } r -= 3 * I_B;
        if (r < I_O) { transpose_item(F.in[13], DM, DM, DM, (bf16_t*)(ws + WS_WO), 0, scr, r, lane); continue; } r -= I_O;
        if (r < NEXP * I_EI) { const int e = r / I_EI; transpose_item(F.in[17] + (size_t)e * DM * 2048, DM, 2048, 2048, (bf16_t*)(ws + WS_WEI) + (size_t)e * 2048 * DM, 2, scr, r % I_EI, lane); continue; } r -= NEXP * I_EI;
        { const int e = r / I_EO; transpose_item(F.in[19] + (size_t)e * DM * DM, DM, DM, DM, (bf16_t*)(ws + WS_WEO) + (size_t)e * DM * DM, 0, scr, r % I_EO, lane); }
    }
    { f32x2* tab = (f32x2*)(ws + WS_ROPE);
      for (int idx = (F.blk * NWAVES * 64) + F.tid; idx < SEQ * 32; idx += F.G * NWAVES * 64) {
          const int s = idx >> 5, i = idx & 31;
          const float inv = exp2f(-(float)i * (13.287712379549449f / 32.0f));
          const float ang = (float)s * inv;
          const double rev = (double)ang * 0.15915494309189535;
          const float fr = (float)(rev - __builtin_rint(rev));
          tab[idx] = (f32x2){__builtin_amdgcn_cosf(fr), __builtin_amdgcn_sinf(fr)}; } }
    for (int m = gw; m < NTOK; m += NGW) rms_row_to_bf16(lane, F.in[0] + (size_t)m * DM, F.in[2], (bf16_t*)(ws + WS_H) + (size_t)m * DM);
    for (int m = gw; m < NMEM; m += NGW) rms_row_to_bf16(lane, F.in[1] + (size_t)m * DM, F.in[8], (bf16_t*)(ws + WS_MEMN) + (size_t)m * DM);
    { int* st = (int*)(ws + WS_SLOT_TOK); float* sw = (float*)(ws + WS_SLOT_W);
      for (int i = F.blk * NWAVES * 64 + F.tid; i < NSLOT_PAD; i += F.G * NWAVES * 64) { st[i] = 0; sw[i] = 0.f; } }
}

__device__ __forceinline__ void ld8(const bf16_t* p, float (&v)[8]) { const u32x4 w = *(const u32x4*)p; v[0] = bflo(w.x); v[1] = bfhi(w.x); v[2] = bflo(w.y); v[3] = bfhi(w.y); v[4] = bflo(w.z); v[5] = bfhi(w.z); v[6] = bflo(w.w); v[7] = bfhi(w.w); }
__device__ __forceinline__ void st8(bf16_t* p, const float (&v)[8]) { u32x4 w; w.x = pk2(v[0], v[1]); w.y = pk2(v[2], v[3]); w.z = pk2(v[4], v[5]); w.w = pk2(v[6], v[7]); *(u32x4*)p = w; }
__device__ __forceinline__ void rope8(float (&v)[8], const f32x2* tabrow, int lane) {
    const int i0 = (lane & 3) * 8; const bool up = (lane & 4) != 0;
#pragma unroll
    for (int j = 0; j < 8; ++j) { const float other = __shfl_xor(v[j], 4); const f32x2 cs = tabrow[i0 + j];
        v[j] = up ? (other * cs.y + v[j] * cs.x) : (v[j] * cs.x - other * cs.y); }
}
__device__ __forceinline__ void p2_prep(Frame& F) {
    const int gw = F.blk * NWAVES + F.wave, NGW = F.G * NWAVES, lane = F.lane;
    bf16_t* proj = (bf16_t*)(F.ws + WS_P);
    const f32x2* tab = (const f32x2*)(F.ws + WS_ROPE);
    const float* g_q_dsa = F.in[4]; const float* g_k_dsa = F.in[5]; const float* g_q_mem = F.in[6]; const float* g_k_mem = F.in[7];
    for (int m = gw; m < NTOK; m += NGW) {
        bf16_t* row = proj + (size_t)m * PW; const f32x2* tr = tab + (size_t)(m & (SEQ - 1)) * 32;
        float v[8];
        { ld8(row + C_DQ + 8 * lane, v); float ss = 0.f;
#pragma unroll
          for (int j = 0; j < 8; ++j) ss += v[j] * v[j];
          ss += __shfl_xor(ss, 1); ss += __shfl_xor(ss, 2); ss += __shfl_xor(ss, 4);
          const float rstd = 1.0f / sqrtf(ss * (1.f / 64.f) + EPS);
#pragma unroll
          for (int j = 0; j < 8; ++j) v[j] = v[j] * rstd * g_q_dsa[8 * (lane & 7) + j];
          rope8(v, tr, lane);
#pragma unroll
          for (int j = 0; j < 8; ++j) v[j] *= 0.125f * LOG2E;
          st8(row + C_DQ + 8 * lane, v); }
        { ld8(row + C_DK + 8 * (lane & 7), v); float ss = 0.f;
#pragma unroll
          for (int j = 0; j < 8; ++j) ss += v[j] * v[j];
          ss += __shfl_xor(ss, 1); ss += __shfl_xor(ss, 2); ss += __shfl_xor(ss, 4);
          const float rstd = 1.0f / sqrtf(ss * (1.f / 64.f) + EPS);
#pragma unroll
          for (int j = 0; j < 8; ++j) v[j] = v[j] * rstd * g_k_dsa[8 * (lane & 7) + j];
          rope8(v, tr, lane);
          if (lane < 8) st8(row + C_DK + 8 * lane, v); }
        { ld8(row + C_IQ + 8 * (lane & 31), v); rope8(v, tr, lane); if (lane < 32) st8(row + C_IQ + 8 * lane, v); }
        { ld8(row + C_IK + 8 * (lane & 7), v); rope8(v, tr, lane); if (lane < 8) st8(row + C_IK + 8 * lane, v); }
        { ld8(row + C_MQ + 8 * lane, v); float ss = 0.f;
#pragma unroll
          for (int j = 0; j < 8; ++j) ss += v[j] * v[j];
          ss += __shfl_xor(ss, 1); ss += __shfl_xor(ss, 2); ss += __shfl_xor(ss, 4); ss += __shfl_xor(ss, 8);
          const float rstd = 1.0f / sqrtf(ss * (1.f / 128.f) + EPS) * (0.08838834764831845f * LOG2E);
#pragma unroll
          for (int j = 0; j < 8; ++j) v[j] = v[j] * rstd * g_q_mem[8 * (lane & 15) + j];
          st8(row + C_MQ + 8 * lane, v); }
    }
    bf16_t* mkv = (bf16_t*)(F.ws + WS_MKV);
    for (int m = gw; m < NMEM; m += NGW) {
        bf16_t* row = mkv + (size_t)m * DM; float v[8];
        ld8(row + 8 * lane, v); float ss = 0.f;
#pragma unroll
        for (int j = 0; j < 8; ++j) ss += v[j] * v[j];
        ss += __shfl_xor(ss, 1); ss += __shfl_xor(ss, 2); ss += __shfl_xor(ss, 4); ss += __shfl_xor(ss, 8);
        const float rstd = 1.0f / sqrtf(ss * (1.f / 128.f) + EPS);
#pragma unroll
        for (int j = 0; j < 8; ++j) v[j] = v[j] * rstd * g_k_mem[8 * (lane & 15) + j];
        st8(row + 8 * lane, v);
    }
}

#define MFMA32(a, b, c) __builtin_amdgcn_mfma_f32_32x32x16_bf16((a), (b), (c), 0, 0, 0)
typedef LAS const unsigned char* lds_cptr;
__device__ __forceinline__ s16x4 vtr(lds_cptr p) { return __builtin_bit_cast(s16x4, __builtin_amdgcn_ds_read_tr16_b64_v4i16((LAS v4i16_t*)p)); }
__device__ __forceinline__ bf16x8 vfrag(lds_cptr vbase_lane, int off) {
    const s16x4 lo = vtr(vbase_lane + off), hi = vtr(vbase_lane + off + 512);
    return (bf16x8){lo[0], lo[1], lo[2], lo[3], hi[0], hi[1], hi[2], hi[3]};
}
__device__ __forceinline__ int vtr_lane_off(int lane) { return ((lane >> 4) & 1) * 32 + (lane & 3) * 8 + (4 * (lane >> 5) + ((lane & 15) >> 2)) * 64; }
__device__ __forceinline__ bf16x8 pack8(const float* p) {
    u32x4 w; w.x = cvt_pk_bf16(p[0], p[1]); w.y = cvt_pk_bf16(p[2], p[3]); w.z = cvt_pk_bf16(p[4], p[5]); w.w = cvt_pk_bf16(p[6], p[7]);
    return __builtin_bit_cast(bf16x8, w);
}
__device__ __forceinline__ float softplus_f(float z) { return fmaxf(z, 0.f) + __logf(1.f + __expf(-fabsf(z))); }

__device__ __forceinline__ void sb_item(const bf16_t* proj, bf16_t* osb, int b, int h, int qblk, LAS unsigned char* vlds, int lane) {
    const int r32 = lane & 31, hi = lane >> 5;
    const size_t tok0 = (size_t)b * SEQ + (size_t)qblk * 32;
    bf16x8 qr[4];
    { const bf16_t* qp = proj + (tok0 + r32) * PW + C_SQ + h * 64 + hi * 8;
#pragma unroll
      for (int kk = 0; kk < 4; ++kk) qr[kk] = *(const bf16x8*)(qp + kk * 16); }
    f32x16 o0 = {}, o1 = {}; float R = 0.f;
    const lds_cptr vrd = (lds_cptr)vlds + vtr_lane_off(lane);
    for (int kt = qblk; kt >= 0; --kt) {
        const size_t key0 = (size_t)b * SEQ + (size_t)kt * 32;
        const bf16_t* kp = proj + (key0 + r32) * PW + C_SK + h * 64 + hi * 8;
        bf16x8 kf[4];
#pragma unroll
        for (int kk = 0; kk < 4; ++kk) kf[kk] = *(const bf16x8*)(kp + kk * 16);
        u32x4 vv[4];
#pragma unroll
        for (int p = 0; p < 4; ++p) vv[p] = *(const u32x4*)(proj + (key0 + 16 * (p & 1) + (lane >> 2)) * PW + C_SV + h * 64 + (p >> 1) * 32 + (lane & 3) * 8);
        f32x16 s = {};
#pragma unroll
        for (int kk = 0; kk < 4; ++kk) s = MFMA32(kf[kk], qr[kk], s);
        asm volatile("" ::: "memory");
#pragma unroll
        for (int p = 0; p < 4; ++p) *(LAS u32x4*)(vlds + p * 1024 + lane * 16) = vv[p];
        const bool diag = (kt == qblk);
        float sp[16], pr[16];
#pragma unroll
        for (int r = 0; r < 16; ++r) { const bool valid = !diag || (crow(r, hi) < r32); sp[r] = valid ? softplus_f(s[r]) : 0.f; }
        float T[4], U[4];
#pragma unroll
        for (int g = 0; g < 4; ++g) { T[g] = (sp[4 * g] + sp[4 * g + 1]) + (sp[4 * g + 2] + sp[4 * g + 3]); U[g] = __shfl_xor(T[g], 32); }
        float run = 0.f, above[4];
#pragma unroll
        for (int g = 3; g >= 0; --g) { above[g] = run + (hi == 0 ? U[g] : 0.f); run += T[g] + U[g]; }
#pragma unroll
        for (int g = 0; g < 4; ++g) { float c = R + above[g];
#pragma unroll
            for (int j = 3; j >= 0; --j) { const int r = 4 * g + j; c += sp[r]; const bool valid = !diag || (crow(r, hi) < r32); pr[r] = valid ? __expf(s[r] - c) : 0.f; } }
        R += run;
        const bf16x8 p0 = pack8(pr), p1 = pack8(pr + 8);
        LDS_WAIT();
        const bf16x8 v00 = vfrag(vrd, 0), v01 = vfrag(vrd, 1024), v10 = vfrag(vrd, 2048), v11 = vfrag(vrd, 3072);
        o0 = MFMA32(v00, p0, o0); o0 = MFMA32(v01, p1, o0);
        o1 = MFMA32(v10, p0, o1); o1 = MFMA32(v11, p1, o1);
        asm volatile("" ::: "memory");
        if (__all(R > 30.0f)) break;
    }
    bf16_t* op = osb + (tok0 + r32) * 512 + h * 64 + 4 * hi;
#pragma unroll
    for (int g = 0; g < 4; ++g) {
        u32x2 w0, w1; w0.x = cvt_pk_bf16(o0[4 * g], o0[4 * g + 1]); w0.y = cvt_pk_bf16(o0[4 * g + 2], o0[4 * g + 3]); w1.x = cvt_pk_bf16(o1[4 * g], o1[4 * g + 1]); w1.y = cvt_pk_bf16(o1[4 * g + 2], o1[4 * g + 3]);
        *(u32x2*)(op + 8 * g) = w0; *(u32x2*)(op + 32 + 8 * g) = w1; }
}

__device__ __forceinline__ void mem_item(const bf16_t* proj, const bf16_t* mkv, bf16_t* omem, int b, int h, int qblk, LAS unsigned char* vlds  , int lane) {
    const int r32 = lane & 31, hi = lane >> 5;
    const size_t tok0 = (size_t)b * SEQ + (size_t)qblk * 32;
    bf16x8 qr[8];
    { const bf16_t* qp = proj + (tok0 + r32) * PW + C_MQ + h * 128 + hi * 8;
#pragma unroll
      for (int kk = 0; kk < 8; ++kk) qr[kk] = *(const bf16x8*)(qp + kk * 16); }
    f32x16 o[4] = {{}, {}, {}, {}}; float m = -1e30f, l = 0.f;
    const lds_cptr vrd = (lds_cptr)vlds + vtr_lane_off(lane);
    for (int kb = 0; kb < 8; ++kb) {
        const size_t key0 = (size_t)b * MEMLEN + (size_t)kb * 32;
        const bf16_t* kp = mkv + (key0 + r32) * DM + h * 128 + hi * 8;
        f32x16 s = {};
#pragma unroll
        for (int kk = 0; kk < 8; ++kk) { const bf16x8 kf = *(const bf16x8*)(kp + kk * 16); s = MFMA32(kf, qr[kk], s); }
        u32x4 vv[8];
#pragma unroll
        for (int p = 0; p < 8; ++p) vv[p] = *(const u32x4*)(mkv + (key0 + 16 * (p & 1) + (lane >> 2)) * DM + 512 + h * 128 + (p >> 1) * 32 + (lane & 3) * 8);
        asm volatile("" ::: "memory");
#pragma unroll
        for (int p = 0; p < 8; ++p) *(LAS u32x4*)(vlds + p * 1024 + lane * 16) = vv[p];
        float mx = s[0];
#pragma unroll
        for (int r = 1; r < 16; ++r) mx = fmaxf(mx, s[r]);
        mx = fmaxf(mx, __shfl_xor(mx, 32));
        const float mn = fmaxf(m, mx), alpha = __builtin_amdgcn_exp2f(m - mn);
        float pr[16], rs = 0.f;
#pragma unroll
        for (int r = 0; r < 16; ++r) { pr[r] = __builtin_amdgcn_exp2f(s[r] - mn); rs += pr[r]; }
        l = l * alpha + rs; m = mn;
#pragma unroll
        for (int d = 0; d < 4; ++d)
#pragma unroll
            for (int r = 0; r < 16; ++r) o[d][r] *= alpha;
        const bf16x8 p0 = pack8(pr), p1 = pack8(pr + 8);
        LDS_WAIT();
#pragma unroll
        for (int d = 0; d < 4; ++d) { const bf16x8 va = vfrag(vrd, d * 2048), vb = vfrag(vrd, d * 2048 + 1024); o[d] = MFMA32(va, p0, o[d]); o[d] = MFMA32(vb, p1, o[d]); }
        asm volatile("" ::: "memory");
    }
    l += __shfl_xor(l, 32);
    const float il = 1.0f / l;
    bf16_t* op = omem + (tok0 + r32) * 512 + h * 128 + 4 * hi;
#pragma unroll
    for (int d = 0; d < 4; ++d)
#pragma unroll
        for (int g = 0; g < 4; ++g) { u32x2 w; w.x = cvt_pk_bf16(o[d][4 * g] * il, o[d][4 * g + 1] * il); w.y = cvt_pk_bf16(o[d][4 * g + 2] * il, o[d][4 * g + 3] * il); *(u32x2*)(op + 32 * d + 8 * g) = w; }
}

constexpr int DL_HIST = 0, DL_PREFIX = 66048, DL_KREM = DL_PREFIX + 256, DL_MASK = 67072, DL_VT = 73728, DL_KT = DL_VT + 2 * 16384, DL_END = DL_KT + 2 * 18432, DL_IQ = DL_VT;
constexpr int TOPK_DSA = 256;

struct IqLds { const LAS unsigned char* p; __device__ __forceinline__ bf16x8 operator()(int j) const { return *(const LAS bf16x8*)(p + j * 32); } };
template <class QF>
__device__ __forceinline__ void idx_scores(const QF& qf, const bf16x8 (&kf)[4], const float (&wq)[4], unsigned (&uk)[16]) {
    float scv[16];
#pragma unroll
    for (int hd = 0; hd < 4; ++hd) { f32x16 a = (f32x16){};
#pragma unroll
        for (int kk = 0; kk < 4; ++kk) a = MFMA32(kf[kk], qf(hd * 4 + kk), a);
#pragma unroll
        for (int r = 0; r < 16; ++r) scv[r] = (hd == 0) ? wq[0] * fmaxf(a[r], 0.f) : __builtin_fmaf(wq[hd], fmaxf(a[r], 0.f), scv[r]); }
#pragma unroll
    for (int r = 0; r < 16; ++r) {
        unsigned bits = __builtin_bit_cast(unsigned, scv[r]);
        if (bits == 0x80000000u) bits = 0u;
        uk[r] = bits ^ ((unsigned)((int)bits >> 31) | 0x80000000u);
    }
}
__device__ __forceinline__ void load_ik(const bf16_t* proj, size_t tokb, int kbase, int r32, int hi, bf16x8 (&kf)[4]) {
    int kr = kbase + r32; if (kr > SEQ - 1) kr = SEQ - 1;
    const GAS bf16_t* p = (const GAS bf16_t*)proj + (tokb + kr) * PW + C_IK + 8 * hi;
#pragma unroll
    for (int kk = 0; kk < 4; ++kk) kf[kk] = *(const GAS bf16x8*)(p + kk * 16);
}

__device__ __forceinline__ void dsa_unit(const bf16_t* proj, bf16_t* odsa, int b, int c, LAS unsigned char* dl, int tid) {
    const int lane = tid & 63, wid = __builtin_amdgcn_readfirstlane(tid >> 6), r32 = lane & 31, hi = lane >> 5;
    const int n = 64 * (c + 1), nsteps = (n + 127) >> 7;
    const size_t tokq0 = (size_t)b * SEQ + (size_t)c * 64, tokb = (size_t)b * SEQ;
    LAS unsigned* hist = (LAS unsigned*)(dl + DL_HIST);
    LAS unsigned* prefix = (LAS unsigned*)(dl + DL_PREFIX);
    LAS unsigned* krem = (LAS unsigned*)(dl + DL_KREM);
    LAS unsigned* mask = (LAS unsigned*)(dl + DL_MASK);
    const int kb = wid >> 1, qh = wid & 1;
    { const int row = tid >> 3, c = tid & 7;
      const GAS bf16_t* src = (const GAS bf16_t*)proj + (tokq0 + row) * PW + C_IQ + c * 32;
#pragma unroll
      for (int i = 0; i < 4; ++i) *(LAS u32x4*)(dl + DL_IQ + row * 528 + c * 64 + i * 16) = *(const GAS u32x4*)(src + i * 8); }
    const IqLds iqf{dl + DL_IQ + (32 * qh + r32) * 528 + hi * 16};
    float wq[4];
    { const u32x2 w = *(const u32x2*)(proj + (tokq0 + 32 * qh + r32) * PW + C_IW);
      wq[0] = bflo(w.x) * 0.0625f; wq[1] = bfhi(w.x) * 0.0625f; wq[2] = bflo(w.y) * 0.0625f; wq[3] = bfhi(w.y) * 0.0625f; }
#ifndef REP_SEL
#define REP_SEL 1
#endif
#ifndef REP_B2
#define REP_B2 1
#endif
    LAS unsigned* selall = (LAS unsigned*)(dl + DL_HIST);
    if (tid < 64) { prefix[tid] = 0u; krem[tid] = (n > TOPK_DSA) ? (unsigned)TOPK_DSA : 0x7fffffffu; }
    __syncthreads();
    for (int pass = (n > TOPK_DSA) ? 0 : 4; pass < 5; ++pass) {
        const bool sel = pass < 4;
        if (sel) { for (int i = tid; i < 64 * 257; i += 512) hist[i] = 0u; __syncthreads(); }
        const int shift = 24 - 8 * pass;
        const unsigned pfx = prefix[32 * qh + r32];
        bf16x8 kfn[4]; load_ik(proj, tokb, 32 * kb, r32, hi, kfn);
        for (int step = 0; step < nsteps; ++step) {
            const int kbase = 128 * step + 32 * kb;
            bf16x8 kf[4];
#pragma unroll
            for (int kk = 0; kk < 4; ++kk) kf[kk] = kfn[kk];
            if (step + 1 < nsteps) load_ik(proj, tokb, kbase + 128, r32, hi, kfn);
            unsigned gtw = 0u, eqw = 0u;
            if (kbase < n) {
                unsigned uk[16];
                idx_scores(iqf, kf, wq, uk);
                if (sel) {
#pragma unroll
                    for (int r = 0; r < 16; ++r) {
                        const bool match = (pass == 0) || ((uk[r] >> (shift + 8)) == pfx);
                        if (match) __hip_atomic_fetch_add(hist + (32 * qh + r32) * 257 + ((uk[r] >> shift) & 255u), 1u, __ATOMIC_RELAXED, __HIP_MEMORY_SCOPE_WORKGROUP);
                    }
                } else {
#pragma unroll
                    for (int r = 0; r < 16; ++r) { gtw |= (uk[r] > pfx ? 1u : 0u) << crow(r, hi); eqw |= (uk[r] == pfx ? 1u : 0u) << crow(r, hi); }
                }
            }
            if (!sel) {
                LAS unsigned* mk = mask + (step & 1) * 768;
                gtw |= __shfl_xor(gtw, 32); eqw |= __shfl_xor(eqw, 32);
                if (hi == 0) { mk[(32 * qh + r32) * 4 + kb] = gtw; mk[256 + (32 * qh + r32) * 4 + kb] = eqw; }
                __syncthreads();
                if (wid == 0) { unsigned nd = krem[lane];
#pragma unroll
                    for (int k4 = 0; k4 < 4; ++k4) { const unsigned g = mk[lane * 4 + k4]; unsigned e = mk[256 + lane * 4 + k4]; unsigned sl = g;
                        if (e != 0u) { const unsigned cnt = (unsigned)__builtin_popcount(e);
                            if (cnt <= nd) { sl |= e; nd -= cnt; }
                            else { unsigned chosen = 0u; while (nd > 0u) { const unsigned lb = e & (0u - e); chosen |= lb; e ^= lb; --nd; } sl |= chosen; } }
                        selall[lane * 64 + step * 4 + k4] = sl; }
                    krem[lane] = nd; }
            }
        }
        if (sel) {
            __syncthreads();
            for (int qi = 0; qi < 8; ++qi) {
                const int q = 8 * wid + qi;
                const LAS unsigned* hq = hist + q * 257;
                const unsigned c0 = hq[255 - 4 * lane], c1 = hq[254 - 4 * lane], c2 = hq[253 - 4 * lane], c3 = hq[252 - 4 * lane];
                const unsigned s4 = c0 + c1 + c2 + c3;
                unsigned incl = s4;
#pragma unroll
                for (int o = 1; o < 64; o <<= 1) { const unsigned t = __shfl_up(incl, o); if (lane >= o) incl += t; }
                const unsigned excl = incl - s4, kr = krem[q];
                if (excl < kr && kr <= incl) {
                    unsigned cum = excl, bin, nk;
                    if (cum + c0 >= kr) { bin = 255 - 4 * lane; nk = kr - cum; }
                    else { cum += c0; if (cum + c1 >= kr) { bin = 254 - 4 * lane; nk = kr - cum; }
                    else { cum += c1; if (cum + c2 >= kr) { bin = 253 - 4 * lane; nk = kr - cum; }
                    else { cum += c2; bin = 252 - 4 * lane; nk = kr - cum; } } }
                    prefix[q] = (prefix[q] << 8) | bin; krem[q] = nk;
                }
            }
            __syncthreads();
        }
    }
    const int hd = wid;
    u32x4 pk[2], pv[2];
#define DSA_LOADKV(step_) do { _Pragma("unroll") for (int i_ = 0; i_ < 2; ++i_) { const int ch_ = tid + 512 * i_; int krow_ = 128 * (step_) + (ch_ >> 3); if (krow_ > SEQ - 1) krow_ = SEQ - 1; \
        const GAS bf16_t* rp_ = (const GAS bf16_t*)proj + (tokb + krow_) * PW + (ch_ & 7) * 8; pk[i_] = *(const GAS u32x4*)(rp_ + C_DK); pv[i_] = *(const GAS u32x4*)(rp_ + C_DV); } } while (0)
#define DSA_STOREKV(buf_) do { _Pragma("unroll") for (int i_ = 0; i_ < 2; ++i_) { const int ch_ = tid + 512 * i_, key_ = ch_ >> 3, c8_ = ch_ & 7, kk_ = key_ & 31; \
        *(LAS u32x4*)(dl + DL_KT + (buf_) * 18432 + key_ * 144 + c8_ * 16) = pk[i_]; \
        *(LAS u32x4*)(dl + DL_VT + (buf_) * 16384 + (key_ >> 5) * 4096 + ((c8_ >> 2) * 2 + (kk_ >> 4)) * 1024 + (kk_ & 15) * 64 + (c8_ & 3) * 16) = pv[i_]; } } while (0)
    for (int qb = 0; qb < 2; ++qb) {
        bf16x8 qr[4];
        { const GAS bf16_t* qp = (const GAS bf16_t*)proj + (tokq0 + 32 * qb + r32) * PW + C_DQ + hd * 64 + 8 * hi;
#pragma unroll
          for (int kk = 0; kk < 4; ++kk) qr[kk] = *(const GAS bf16x8*)(qp + kk * 16); }
        f32x16 o0 = {}, o1 = {}; float mrun = -1e30f, lrun = 0.f;
        DSA_LOADKV(0);
        DSA_STOREKV(0);
        __syncthreads();
        for (int step = 0; step < nsteps; ++step) {
            const int buf = step & 1;
            if (step + 1 < nsteps) DSA_LOADKV(step + 1);
            LAS unsigned char* kt = dl + DL_KT + buf * 18432;
            LAS unsigned char* vt = dl + DL_VT + buf * 16384;
            for (int k4 = 0; k4 < 4; ++k4) {
                const int kbase = 128 * step + 32 * k4;
                if (kbase >= n) break;
                const LAS unsigned char* krd = kt + (32 * k4 + r32) * 144 + hi * 16;
                f32x16 s = {};
#pragma unroll
                for (int kk = 0; kk < 4; ++kk) { const bf16x8 kf = *(const LAS bf16x8*)(krd + kk * 32); s = MFMA32(kf, qr[kk], s); }
                const lds_cptr vrd = (lds_cptr)vt + k4 * 4096 + vtr_lane_off(lane);
                const bf16x8 v00 = vfrag(vrd, 0), v01 = vfrag(vrd, 1024), v10 = vfrag(vrd, 2048), v11 = vfrag(vrd, 3072);
                const unsigned selw = selall[(32 * qb + r32) * 64 + step * 4 + k4];
                float mx = -INFINITY;
#pragma unroll
                for (int r = 0; r < 16; ++r) { if (!((selw >> crow(r, hi)) & 1u)) s[r] = -INFINITY; mx = fmaxf(mx, s[r]); }
                mx = fmaxf(mx, __shfl_xor(mx, 32));
                const float mn = fmaxf(mrun, mx), alpha = __builtin_amdgcn_exp2f(mrun - mn);
                float pr[16], rs = 0.f;
#pragma unroll
                for (int r = 0; r < 16; ++r) { pr[r] = __builtin_amdgcn_exp2f(s[r] - mn); rs += pr[r]; }
                lrun = lrun * alpha + rs; mrun = mn;
#pragma unroll
                for (int r = 0; r < 16; ++r) { o0[r] *= alpha; o1[r] *= alpha; }
                const bf16x8 p0 = pack8(pr), p1 = pack8(pr + 8);
                o0 = MFMA32(v00, p0, o0); o0 = MFMA32(v01, p1, o0);
                o1 = MFMA32(v10, p0, o1); o1 = MFMA32(v11, p1, o1);
            }
            if (step + 1 < nsteps) DSA_STOREKV(buf ^ 1);
            __syncthreads();
        }
        float l = lrun; l += __shfl_xor(l, 32);
        const float il = 1.0f / l;
        bf16_t* op = odsa + (tokq0 + 32 * qb + r32) * 512 + hd * 64 + 4 * hi;
#pragma unroll
        for (int g = 0; g < 4; ++g) {
            u32x2 w0, w1; w0.x = cvt_pk_bf16(o0[4 * g] * il, o0[4 * g + 1] * il); w0.y = cvt_pk_bf16(o0[4 * g + 2] * il, o0[4 * g + 3] * il);
            w1.x = cvt_pk_bf16(o1[4 * g] * il, o1[4 * g + 1] * il); w1.y = cvt_pk_bf16(o1[4 * g + 2] * il, o1[4 * g + 3] * il);
            *(u32x2*)(op + 8 * g) = w0; *(u32x2*)(op + 32 + 8 * g) = w1; }
    }
#undef DSA_LOADKV
#undef DSA_STOREKV
    __syncthreads();
}

constexpr int RL_WR = 0, RL_WR_STRIDE = 1028, RL_TKE = 131584, RL_TKW = RL_TKE + 4096;
__device__ __forceinline__ void p9_router(Frame& F) {
    const int lane = F.lane, wave = F.wave, tid = F.tid;
    LAS float* Wr = (LAS float*)(F.lds + RL_WR);
    LAS int* tke = (LAS int*)(F.lds + RL_TKE); LAS float* tkw = (LAS float*)(F.lds + RL_TKW);
    const float* w_router = F.in[15]; const float* b_router = F.in[16]; const float* g_ffn = F.in[14];
    for (int idx = tid; idx < DM * NEXP; idx += NWAVES * 64) { const int k = idx >> 5, e = idx & 31; Wr[e * RL_WR_STRIDE + k] = w_router[idx]; }
    if (tid < 32) F.MISC[MW_LCNT + tid] = 0u;
    __syncthreads();
    bf16_t* h2 = (bf16_t*)(F.ws + WS_H);
    const GAS f32x4* gr = (const GAS f32x4*)g_ffn + lane;
    f32x4 gg[4];
#pragma unroll
    for (int j = 0; j < 4; ++j) gg[j] = gr[64 * j];
    const float bias_e = b_router[lane >> 1];
    for (int it = 0; it < 16; ++it) {
        const int tl0 = 32 * wave + 2 * it;
        f32x4 hn[2][4];
#pragma unroll
        for (int tk = 0; tk < 2; ++tk) {
            const size_t t = (size_t)F.blk * 256 + tl0 + tk;
            const GAS f32x4* xr = (const GAS f32x4*)(F.out + t * DM) + lane;
            float s = 0.f;
#pragma unroll
            for (int j = 0; j < 4; ++j) { hn[tk][j] = xr[64 * j]; s += (hn[tk][j].x * hn[tk][j].x + hn[tk][j].y * hn[tk][j].y) + (hn[tk][j].z * hn[tk][j].z + hn[tk][j].w * hn[tk][j].w); }
            const float rstd = 1.0f / sqrtf(wave_sum(s) * (1.f / DM) + EPS);
            GAS u32x2* o8 = (GAS u32x2*)(h2 + t * DM) + lane;
#pragma unroll
            for (int j = 0; j < 4; ++j) { hn[tk][j] = hn[tk][j] * rstd * gg[j]; u32x2 o; o.x = pk2(hn[tk][j].x, hn[tk][j].y); o.y = pk2(hn[tk][j].z, hn[tk][j].w); o8[64 * j] = o; }
        }
        float acc[2][32];
        const LAS float* wl = Wr + 4 * lane; asm volatile("" : "+v"(wl));
#pragma unroll
        for (int e = 0; e < 32; ++e) {
            float a0 = 0.f, a1 = 0.f;
#pragma unroll
            for (int j = 0; j < 4; ++j) { const f32x4 w = *(const LAS f32x4*)(wl + e * RL_WR_STRIDE + 256 * j);
                a0 += (hn[0][j].x * w.x + hn[0][j].y * w.y) + (hn[0][j].z * w.z + hn[0][j].w * w.w);
                a1 += (hn[1][j].x * w.x + hn[1][j].y * w.y) + (hn[1][j].z * w.z + hn[1][j].w * w.w); }
            asm volatile("" : "+v"(a0), "+v"(a1));
            acc[0][e] = a0; acc[1][e] = a1;
        }
#pragma unroll
        for (int tk = 0; tk < 2; ++tk) {
            float v16[16], v8[8], v4[4], v2[2];
            const bool b5 = (lane & 32) != 0, b4 = (lane & 16) != 0, b3 = (lane & 8) != 0, b2 = (lane & 4) != 0, b1 = (lane & 2) != 0;
#pragma unroll
            for (int i = 0; i < 16; ++i) { const float mine = b5 ? acc[tk][16 + i] : acc[tk][i], oth = b5 ? acc[tk][i] : acc[tk][16 + i]; v16[i] = mine + __shfl_xor(oth, 32); }
#pragma unroll
            for (int i = 0; i < 8; ++i) { const float mine = b4 ? v16[8 + i] : v16[i], oth = b4 ? v16[i] : v16[8 + i]; v8[i] = mine + __shfl_xor(oth, 16); }
#pragma unroll
            for (int i = 0; i < 4; ++i) { const float mine = b3 ? v8[4 + i] : v8[i], oth = b3 ? v8[i] : v8[4 + i]; v4[i] = mine + __shfl_xor(oth, 8); }
#pragma unroll
            for (int i = 0; i < 2; ++i) { const float mine = b2 ? v4[2 + i] : v4[i], oth = b2 ? v4[i] : v4[2 + i]; v2[i] = mine + __shfl_xor(oth, 4); }
            float v1; { const float mine = b1 ? v2[1] : v2[0], oth = b1 ? v2[0] : v2[1]; v1 = mine + __shfl_xor(oth, 2); }
            float val = v1 + __shfl_xor(v1, 1) + bias_e;
            const int e = lane >> 1;
            float topv[4]; int topi[4];
#pragma unroll
            for (int k = 0; k < 4; ++k) {
                float bv = val; int bi = e;
#pragma unroll
                for (int o = 1; o < 64; o <<= 1) { const float ov = __shfl_xor(bv, o); const int oi = __shfl_xor(bi, o); if (ov > bv || (ov == bv && oi < bi)) { bv = ov; bi = oi; } }
                topv[k] = bv; topi[k] = bi; if (e == bi) val = -INFINITY;
            }
            const float e1 = __expf(topv[1] - topv[0]), e2 = __expf(topv[2] - topv[0]), e3 = __expf(topv[3] - topv[0]);
            const float inv = 1.0f / (1.0f + e1 + e2 + e3);
            const float gate[4] = {inv, e1 * inv, e2 * inv, e3 * inv};
            const int tl = tl0 + tk;
#pragma unroll
            for (int k = 0; k < 4; ++k) if (lane == k) { tke[tl * 4 + k] = topi[k]; tkw[tl * 4 + k] = gate[k];
                __hip_atomic_fetch_add((LAS unsigned*)F.MISC + MW_LCNT + topi[k], 1u, __ATOMIC_RELAXED, __HIP_MEMORY_SCOPE_WORKGROUP); }
        }
    }
    __syncthreads();
    if (tid < 32) ((int*)(F.ws + WS_BLKCNT))[F.blk * 32 + tid] = (int)F.MISC[MW_LCNT + tid];
}
__device__ __forceinline__ void p10_assign(Frame& F) {
    const int tid = F.tid;
    const int* blkcnt = (const int*)(F.ws + WS_BLKCNT);
    LAS int* part = (LAS int*)(F.lds);
    LAS int* tke = (LAS int*)(F.lds + RL_TKE); LAS float* tkw = (LAS float*)(F.lds + RL_TKW);
    { const int e = tid & 31, p = tid >> 5; int tot = 0, bef = 0;
      for (int j = 0; j < 16; ++j) { const int bl = p * 16 + j; const int c = blkcnt[bl * 32 + e]; tot += c; bef += (bl < F.blk) ? c : 0; }
      part[p * 32 + e] = tot; part[512 + p * 32 + e] = bef; }
    __syncthreads();
    if (tid < 32) { int tot = 0, bef = 0;
        for (int p = 0; p < 16; ++p) { tot += part[p * 32 + tid]; bef += part[512 + p * 32 + tid]; }
        part[1024 + tid] = tot; F.MISC[MW_BEFORE + tid] = (unsigned)bef; F.MISC[MW_LCNT + tid] = 0u; }
    __syncthreads();
    if (tid == 0) { int ps = 0;
        for (int e = 0; e < 32; ++e) { F.MISC[MW_PSTART + e] = (unsigned)ps; F.MISC[MW_TSTART + e] = (unsigned)(ps >> 8); ps += (part[1024 + e] + 255) & ~255; }
        F.MISC[MW_PSTART + 32] = (unsigned)ps; F.MISC[MW_TSTART + 32] = (unsigned)(ps >> 8); }
    __syncthreads();
    int* slot_tok = (int*)(F.ws + WS_SLOT_TOK); float* slot_w = (float*)(F.ws + WS_SLOT_W);
    for (int idx = tid; idx < 1024; idx += NWAVES * 64) {
        const int e = tke[idx]; const float w = tkw[idx];
        const unsigned r = __hip_atomic_fetch_add((LAS unsigned*)F.MISC + MW_LCNT + e, 1u, __ATOMIC_RELAXED, __HIP_MEMORY_SCOPE_WORKGROUP);
        const unsigned pos = F.MISC[MW_PSTART + e] + F.MISC[MW_BEFORE + e] + r;
        slot_tok[pos] = F.blk * 256 + (idx >> 2); slot_w[pos] = w;
    }
}

#ifndef MK_ONE_LAUNCH
#define MK_ONE_LAUNCH 1
#endif
constexpr int N_PHASES = 13;
struct Args { const float* in[21]; float* out; unsigned char* ws; int ph_lo, ph_hi; };
static_assert(sizeof(Args) == 21 * 8 + 8 + 8 + 8, "no padding");

__global__ void __launch_bounds__(NWAVES * 64, 2) fwd_kernel(Args args) {
    extern __shared__ __attribute__((aligned(16))) unsigned char lds[];
    Frame F;
    F.lds = (LAS unsigned char*)lds;
    F.MISC = (volatile LAS unsigned*)(F.lds + MISC_OFF);
    F.tid = threadIdx.x; F.lane = F.tid & 63; F.wave = __builtin_amdgcn_readfirstlane(F.tid >> 6);
    F.G = gridDim.x; F.blk = blockIdx.x;
    F.ws = args.ws; F.out = args.out; F.ctl = (gu32*)(args.ws + WS_CTL);
#pragma unroll
    for (int i = 0; i < 21; ++i) F.in[i] = args.in[i];
    for (int u = F.tid; u < (LDS_BYTES - MISC_OFF) / 4; u += NWAVES * 64) ((LAS unsigned*)(F.lds + MISC_OFF))[u] = 0u;
    __syncthreads();
    const int lo = args.ph_lo, hi = args.ph_hi;
    XcdBarrier bar; bar.bar = (unsigned*)(F.ctl + CW_BAR); bar.x = 0; bar.st = nullptr;
    if (hi - lo > 1) bar = xcd_barrier_post((unsigned*)(F.ctl + CW_BAR), F.MISC + MW_BAR);
#ifndef PH_MASK
#define PH_MASK 0x1fff
#endif
#define IN(k) (((PH_MASK >> (k)) & 1) && lo <= (k) && (k) < hi)
#ifndef REP_MASK
#define REP_MASK 0
#endif
#define NREP(k) (1 + ((REP_MASK >> (k)) & 1))
#define SEAM(k) do { if (IN(k) && IN((k) + 1)) xcd_barrier(bar); } while (0)
    unsigned char* ws = args.ws;
    bf16_t* proj = (bf16_t*)(ws + WS_P);

    if (IN(0)) for (int rep = 0; rep < NREP(0); ++rep) { if (rep) xcd_barrier(bar); p0_prologue(F); } SEAM(0);

    if (IN(1)) {
        { pg8::DenseSched S; S.init(ws + WS_H, ws + WS_WIN, NTOK, PW, DM, F.G, F.blk);
          pg8::EpiBf16<0> E{proj, PW, nullptr};
          pg8::gemm_phase<pg8::EpiBf16<0>, pg8::DenseSched, true>(F.lds, DM, S, E); }
        { pg8::DenseSched S; S.init(ws + WS_MEMN, ws + WS_WMKV, NMEM, DM, DM, F.G, F.blk);
          pg8::EpiBf16<0> E{(bf16_t*)(ws + WS_MKV), DM, nullptr};
          pg8::gemm_phase<pg8::EpiBf16<0>, pg8::DenseSched, true>(F.lds, DM, S, E); }
    } SEAM(1);

    if (IN(2)) { p2_prep(F); } SEAM(2);

    if (IN(3)) {
        bf16_t* osb = (bf16_t*)(ws + WS_O); bf16_t* odsa = osb + (size_t)NTOK * 512; bf16_t* omem = odsa + (size_t)NTOK * 512;
#ifndef REP_DSA
#define REP_DSA 1
#endif
#ifndef REP_SB
#define REP_SB 1
#endif
#ifndef REP_MEM
#define REP_MEM 1
#endif
#ifndef NO_DSA
        for (int rep = 0; rep < REP_DSA; ++rep)
        for (int i = 0; i < 4; ++i) { const int p = 2 * F.blk + (i >> 1), b = p >> 4, cc = p & 15, c = (i & 1) ? 31 - cc : cc; dsa_unit(proj, odsa, b, c, F.lds, F.tid); }
#endif
        const int gw = F.blk * NWAVES + F.wave, NGW = F.G * NWAVES;
#ifndef NO_SB
        for (int rep = 0; rep < REP_SB; ++rep)
        for (int it = gw; it < NB * 8 * 64; it += NGW) { const int qblk = 63 - (it >> 8), bh = it & 255; sb_item(proj, osb, bh >> 3, bh & 7, qblk, F.lds + F.wave * 4096, F.lane); }
#endif
#ifndef NO_MEM
        for (int rep = 0; rep < REP_MEM; ++rep)
        for (int it = gw; it < NB * 4 * 64; it += NGW) { const int qblk = it & 63, bh = it >> 6; mem_item(proj, (const bf16_t*)(ws + WS_MKV), omem, bh >> 2, bh & 3, qblk, F.lds + 32768 + F.wave * 8192, F.lane); }
#endif
    } SEAM(3);

    if (IN(4)) {
        pg8::DenseSched S; S.init(ws + WS_H, ws + WS_WG, NTOK, 3 * DM, DM, F.G, F.blk);
        pg8::EpiBf16<2> E{proj, PW, F.in[11]};
        pg8::gemm_phase<pg8::EpiBf16<2>, pg8::DenseSched, true>(F.lds, DM, S, E);
    } SEAM(4);

    if (IN(5)) {
 pg8::DenseSched S; S.init(ws + WS_O, ws + WS_WB, NTOK, DM, 512, F.G, F.blk);
        pg8::EpiMerge E{proj, 0, (bf16_t*)(ws + WS_H), 1};
        pg8::gemm_phase<pg8::EpiMerge, pg8::DenseSched, true>(F.lds, 512, S, E); } SEAM(5);
    if (IN(6)) { pg8::DenseSched S; S.init(ws + WS_O + (size_t)NTOK * 1024, ws + WS_WB + (size_t)DM * 1024, NTOK, DM, 512, F.G, F.blk);
        pg8::EpiMerge E{proj, DM, (bf16_t*)(ws + WS_H), 0};
        pg8::gemm_phase<pg8::EpiMerge, pg8::DenseSched, true>(F.lds, 512, S, E); } SEAM(6);
    if (IN(7)) { pg8::DenseSched S; S.init(ws + WS_O + (size_t)NTOK * 2048, ws + WS_WB + (size_t)DM * 2048, NTOK, DM, 512, F.G, F.blk);
        pg8::EpiMerge E{proj, 2 * DM, (bf16_t*)(ws + WS_H), 0};
        pg8::gemm_phase<pg8::EpiMerge, pg8::DenseSched, true>(F.lds, 512, S, E); } SEAM(7);

    if (IN(8)) {
        pg8::DenseSched S; S.init(ws + WS_H, ws + WS_WO, NTOK, DM, DM, F.G, F.blk);
        pg8::EpiResid E{F.in[0], F.out};
        pg8::gemm_phase<pg8::EpiResid, pg8::DenseSched, true>(F.lds, DM, S, E);
    } SEAM(8);

    if (IN(9)) for (int rep = 0; rep < NREP(9); ++rep) { if (rep) xcd_barrier(bar); p9_router(F); } SEAM(9);
    if (IN(10)) for (int rep = 0; rep < NREP(10); ++rep) { if (rep) xcd_barrier(bar); p10_assign(F); } SEAM(10);

    if (IN(11)) for (int rep = 0; rep < NREP(11); ++rep) {  if (rep) xcd_barrier(bar);
        pg8::MoeSched S{(const char*)(ws + WS_H), (const char*)(ws + WS_WEI), (const int*)(ws + WS_SLOT_TOK), F.MISC + MW_TSTART, DM, 2048, 8, F.blk};
        pg8::EpiSwiglu E{(bf16_t*)(ws + WS_P), F.in[18]};
        pg8::gemm_phase<pg8::EpiSwiglu, pg8::MoeSched, true>(F.lds, DM, S, E);
    } SEAM(11);

    if (IN(12)) {
        pg8::MoeSched S{(const char*)(ws + WS_P), (const char*)(ws + WS_WEO), nullptr, F.MISC + MW_TSTART, DM, DM, 4, F.blk};
        pg8::EpiScatter E{F.out, (const int*)(ws + WS_SLOT_TOK), (const float*)(ws + WS_SLOT_W), F.in[20], F.lds};
        pg8::gemm_phase<pg8::EpiScatter, pg8::MoeSched, true>(F.lds, DM, S, E);
    }
#undef IN
#undef SEAM
}

extern "C" void kernel_launch(void* const* d_in, const int* in_sizes, int n_in, void* d_out, int out_size, void* d_ws, size_t ws_size, hipStream_t stream) {
    static int grid = 0;
    if (grid == 0) {
        if (n_in != 21 || in_sizes[0] != NTOK * DM || out_size != NTOK * DM || ws_size < WS_END) {
            fprintf(stderr, "kernel_launch: unexpected shapes: n_in %d in0 %d out %d ws %zu (need >= %zu); nothing launched\n", n_in, n_in > 0 ? in_sizes[0] : -1, out_size, ws_size, (size_t)WS_END); grid = -1; return; }
        int dev = 0, cus = 0, per_cu = 0;
        if (hipGetDevice(&dev) != hipSuccess || hipDeviceGetAttribute(&cus, hipDeviceAttributeMultiprocessorCount, dev) != hipSuccess) { fprintf(stderr, "kernel_launch: device query failed\n"); grid = -1; return; }
        if (hipFuncSetAttribute((const void*)fwd_kernel, hipFuncAttributeMaxDynamicSharedMemorySize, LDS_BYTES) != hipSuccess) { fprintf(stderr, "kernel_launch: hipFuncSetAttribute failed\n"); grid = -1; return; }
        if (hipOccupancyMaxActiveBlocksPerMultiprocessor(&per_cu, (const void*)fwd_kernel, NWAVES * 64, LDS_BYTES) != hipSuccess || per_cu < 1)
            fprintf(stderr, "kernel_launch: note: occupancy query reports %d workgroups per CU\n", per_cu);
        (void)hipGetLastError();
        grid = cus;
        if (grid != 256) { fprintf(stderr, "kernel_launch: this kernel is built for 256 CUs (got %d); nothing launched\n", grid); grid = -1; return; }
    }
    if (grid < 0) return;
    if (hipMemsetAsync((char*)d_ws + WS_CTL, 0, CTL_ZERO_BYTES, stream) != hipSuccess) { fprintf(stderr, "kernel_launch: hipMemsetAsync failed\n"); return; }
    Args a{};
    for (int i = 0; i < 21; ++i) a.in[i] = (const float*)d_in[i];
    a.out = (float*)d_out; a.ws = (unsigned char*)d_ws;
#if MK_ONE_LAUNCH
    const int cuts[2] = {0, N_PHASES}; const int nl = 1;
#else
    const int cuts[11] = {0, 1, 2, 3, 4, 5, 6, 7, 8, 9, N_PHASES}; const int nl = 10;
#endif
    for (int li = 0; li < nl; ++li) {
        a.ph_lo = cuts[li]; a.ph_hi = cuts[li + 1];
        hipLaunchKernelGGL(fwd_kernel, dim3(grid), dim3(NWAVES * 64), LDS_BYTES, stream, a);
        const hipError_t le = hipPeekAtLastError();
        if (le != hipSuccess) { fprintf(stderr, "kernel_launch: launch %d failed: %s\n", li, hipGetErrorName(le)); break; }
    }
}
```

```cpp
#include <hip/hip_runtime.h>
#include <cstdio>
#include <cstdint>

#define LAS __attribute__((address_space(3)))
#define GAS __attribute__((address_space(1)))
typedef unsigned short bf16_t;
typedef short bf16x8 __attribute__((ext_vector_type(8)));
typedef short s16x4 __attribute__((ext_vector_type(4)));
typedef short v4i16_t __attribute__((ext_vector_type(4)));
typedef float f32x2 __attribute__((ext_vector_type(2)));
typedef float f32x4 __attribute__((ext_vector_type(4)));
typedef float f32x16 __attribute__((ext_vector_type(16)));
typedef unsigned u32x2 __attribute__((ext_vector_type(2)));
typedef unsigned u32x4 __attribute__((ext_vector_type(4)));
typedef GAS unsigned gu32;

constexpr int NB = 32, SEQ = 2048, DM = 1024, NTOK = NB * SEQ;
constexpr int MEMLEN = 256, NMEM = NB * MEMLEN;
constexpr int PW = 3072;
constexpr int C_SQ = 0, C_SK = 512, C_SV = 1024, C_DQ = 1536, C_DK = 2048, C_DV = 2112, C_IQ = 2176, C_IK = 2432, C_IW = 2496, C_MQ = 2560;
constexpr int IN_W = 3012;
constexpr int NEXP = 32, TOPK = 4, DEXP = 1024;
constexpr int NSLOT = NTOK * TOPK;
constexpr int NSLOT_PAD = NSLOT + NEXP * 256;
constexpr float EPS = 1e-6f;
constexpr float LOG2E = 1.4426950408889634f;

constexpr size_t MiB = 1u << 20;
constexpr size_t WS_CTL = 0, CTL_ZERO_BYTES = 1 * MiB;
constexpr size_t WS_ROPE = 1 * MiB;
constexpr size_t WS_BLKCNT = 1 * MiB + 512 * 1024;
constexpr size_t WS_SLOT_TOK = 2 * MiB;
constexpr size_t WS_SLOT_W = 4 * MiB;
constexpr size_t WS_WIN = 8 * MiB;
constexpr size_t WS_WMKV = 14 * MiB;
constexpr size_t WS_WG = 16 * MiB;
constexpr size_t WS_WB = 22 * MiB;
constexpr size_t WS_WO = 25 * MiB;
constexpr size_t WS_WEI = 27 * MiB;
constexpr size_t WS_WEO = 155 * MiB;
constexpr size_t WS_H = 220 * MiB;
constexpr size_t WS_P = 348 * MiB;
constexpr size_t WS_O = 732 * MiB;
constexpr size_t WS_MEMN = 924 * MiB;
constexpr size_t WS_MKV = 940 * MiB;
constexpr size_t WS_END = 956 * MiB;
static_assert(WS_P + (size_t)NSLOT_PAD * DEXP * 2 <= WS_MEMN, "act overlays proj|o");
static_assert(WS_SLOT_TOK + (size_t)NSLOT_PAD * 4 <= WS_SLOT_W && WS_SLOT_W + (size_t)NSLOT_PAD * 4 <= WS_WIN, "slot tables");

constexpr int CW_BAR = 4096;

constexpr int RING_BYTES = 151552;
constexpr int MISC_OFF = RING_BYTES;
constexpr int LDS_BYTES = 155648;
constexpr int MW_BAR = 8;
constexpr int MW_LCNT = 16;
constexpr int MW_PSTART = 64;
constexpr int MW_TSTART = 128;
constexpr int MW_BEFORE = 192;
constexpr int MW_PART = 256;

__device__ __forceinline__ unsigned f2bf(float f) { unsigned u = __builtin_bit_cast(unsigned, f); return (u + 0x7fffu + ((u >> 16) & 1u)) >> 16; }
__device__ __forceinline__ unsigned pk2(float lo, float hi) { return f2bf(lo) | (f2bf(hi) << 16); }
__device__ __forceinline__ float bf2f(unsigned short b) { return __builtin_bit_cast(float, (unsigned)b << 16); }
__device__ __forceinline__ float bflo(unsigned w) { return __builtin_bit_cast(float, w << 16); }
__device__ __forceinline__ float bfhi(unsigned w) { return __builtin_bit_cast(float, w & 0xffff0000u); }
__device__ __forceinline__ unsigned cvt_pk_bf16(float lo, float hi) { unsigned r; asm volatile("v_cvt_pk_bf16_f32 %0, %1, %2" : "=v"(r) : "v"(lo), "v"(hi)); return r; }
__device__ __forceinline__ int crow(int r, int hi) { return (r & 3) + 8 * (r >> 2) + 4 * hi; }
#define LDS_WAIT() asm volatile("s_waitcnt lgkmcnt(0)" ::: "memory")
#define VM_WAIT() asm volatile("s_waitcnt vmcnt(0)" ::: "memory")

namespace pg8 {
constexpr int BM = 256, BK = 64, HALF = 128, HTB = HALF * BK * 2, STAGE_BYTES = 8 * HTB;
__host__ __device__ __forceinline__ int lds_byte(int r, int c) { const int st = (r >> 4) * 2 + (c >> 5), rr = r & 15, cc = c & 31, ob = rr * 64 + cc * 2; return st * 1024 + (ob ^ (((ob >> 9) & 1) << 5)); }
__host__ __device__ __forceinline__ void stage_rc(int b, int& R, int& C) { const int st = b / 1024, sb = b % 1024, swz = sb ^ (((sb >> 9) & 1) << 5); R = (st >> 1) * 16 + swz / 64; C = (st & 1) * 32 + (swz % 64) / 2; }
__host__ __device__ __forceinline__ int perm32(int rho) { const int n = rho >> 4, i = rho & 15; return 8 * (i >> 2) + 4 * n + (i & 3); }

struct Unit { int pm, pn, e; };

template <class Epi, class Sched, bool ALIGN_EPI>
__device__ __forceinline__ void gemm_phase(LAS unsigned char* lds, const int K, const Sched& S, const Epi& E) {
    const int tid = threadIdx.x, wid = __builtin_amdgcn_readfirstlane(tid >> 6), lane = tid & 63, wr = wid >> 2, wc = wid & 3, fr = lane & 15, fq = lane >> 4;
    const int nt = K / BK;
    int Rr[2], Cc[2]; unsigned voffB[2];
#pragma unroll
    for (int i = 0; i < 2; ++i) { int R, C; stage_rc(tid * 16 + i * 8192, R, C); Rr[i] = R; Cc[i] = C; const int Rb = Epi::PERM ? ((R & ~31) + perm32(R & 31)) : R; voffB[i] = (unsigned)(Rb * K + C) * 2u; }
    const size_t kstep = (size_t)(BK * 2);
    const size_t hstepB = (size_t)HALF * K * 2;
    const unsigned ldsw = (unsigned)wid * 1024u;
    const int aoff = lds_byte(wr * 64 + fr, fq * 8), boff = lds_byte(wc * 32 + fr, fq * 8);
#define PG8_SA(b, h) (((b) * 2 + (h)) * HTB)
#define PG8_SB(b, h) ((4 + (b) * 2 + (h)) * HTB)
#define PG8_STAGE(bufoff, gbase, voff) do { _Pragma("unroll") for (int _i = 0; _i < 2; ++_i) \
        __builtin_amdgcn_global_load_lds((const unsigned*)((const char*)(gbase) + (voff)[_i]), (LAS unsigned*)(lds + (bufoff) + ldsw + _i * 8192), 16, 0, 0); } while (0)
#define PG8_LDA(dst, b, h) do { _Pragma("unroll") for (int m = 0; m < 4; ++m) _Pragma("unroll") for (int k = 0; k < 2; ++k) dst[m][k] = *(const LAS bf16x8*)(lds + PG8_SA(b, h) + aoff + m * 2048 + k * 1024); } while (0)
#define PG8_LDB(dst, b, h) do { _Pragma("unroll") for (int n = 0; n < 2; ++n) _Pragma("unroll") for (int k = 0; k < 2; ++k) dst[n][k] = *(const LAS bf16x8*)(lds + PG8_SB(b, h) + boff + n * 2048 + k * 1024); } while (0)
#define PG8_MMA(ai, bj, At, Bt) do { __builtin_amdgcn_s_setprio(1); _Pragma("unroll") for (int m = 0; m < 4; ++m) _Pragma("unroll") for (int n = 0; n < 2; ++n) _Pragma("unroll") for (int k = 0; k < 2; ++k) \
        acc[ai][bj][m][n] = __builtin_amdgcn_mfma_f32_16x16x32_bf16(Bt[n][k], At[m][k], acc[ai][bj][m][n], 0, 0, 0); __builtin_amdgcn_s_setprio(0); } while (0)
#define PG8_WAIT_V(n) asm volatile("s_waitcnt vmcnt(" #n ")" ::: "memory")
#define PG8_WAIT_L(n) asm volatile("s_waitcnt lgkmcnt(" #n ")" ::: "memory")
#define PG8_BAR __builtin_amdgcn_s_barrier()
#define PG8_SCHED __builtin_amdgcn_sched_barrier(0)
    Unit cur, nxt; int ui = 0;
    if (!S.next(0, cur)) return;
    f32x4 acc[2][2][4][2];
#pragma unroll
    for (int a = 0; a < 2; ++a)
#pragma unroll
        for (int b = 0; b < 2; ++b)
#pragma unroll
            for (int m = 0; m < 4; ++m)
#pragma unroll
                for (int n = 0; n < 2; ++n) acc[a][b][m][n] = (f32x4){0.f, 0.f, 0.f, 0.f};
    bf16x8 At[4][2], B0[2][2], B1[2][2];
    const char* Ab = S.a_base();
    unsigned ca0[2], ca1[2], na0[2], na1[2];
#pragma unroll
    for (int i = 0; i < 2; ++i) { ca0[i] = S.a_off(cur, Rr[i], Cc[i]); ca1[i] = S.a_off(cur, HALF + Rr[i], Cc[i]); }
    const char* cB = S.b_tile(cur);
    PG8_STAGE(PG8_SB(0, 0), cB, voffB); PG8_STAGE(PG8_SB(0, 1), cB + hstepB, voffB); PG8_STAGE(PG8_SA(0, 0), Ab, ca0); PG8_STAGE(PG8_SA(0, 1), Ab, ca1);
    if (wr == 1) PG8_BAR;
    PG8_WAIT_V(2); PG8_BAR;
    PG8_STAGE(PG8_SB(1, 0), cB + kstep, voffB); PG8_STAGE(PG8_SA(1, 0), Ab + kstep, ca0); PG8_STAGE(PG8_SB(1, 1), cB + hstepB + kstep, voffB);
    PG8_WAIT_V(6); PG8_BAR;
    for (;;) {
        const bool has_next = S.next(ui + 1, nxt);
        const char* nB = cB;
#pragma unroll
        for (int i = 0; i < 2; ++i) { na0[i] = ca0[i]; na1[i] = ca1[i]; }
        if (has_next) { nB = S.b_tile(nxt);
#pragma unroll
            for (int i = 0; i < 2; ++i) { na0[i] = S.a_off(nxt, Rr[i], Cc[i]); na1[i] = S.a_off(nxt, HALF + Rr[i], Cc[i]); } }
        for (int t = 0; t < nt; t += 2) {
            const bool last = (t == nt - 2);
            const char* a1 = Ab + (size_t)(t + 1) * kstep;
            const char* a2 = last ? Ab : Ab + (size_t)(t + 2) * kstep; const char* b2 = last ? nB : cB + (size_t)(t + 2) * kstep;
            const char* a3 = a2 + kstep; const char* b3 = b2 + kstep;
            unsigned o20[2], o21[2];
#pragma unroll
            for (int i = 0; i < 2; ++i) { o20[i] = last ? na0[i] : ca0[i]; o21[i] = last ? na1[i] : ca1[i]; }
            PG8_LDB(B0, 0, 0); PG8_LDB(B1, 0, 1); PG8_SCHED; PG8_LDA(At, 0, 0); PG8_STAGE(PG8_SA(1, 1), a1, ca1);
            PG8_WAIT_V(8); PG8_WAIT_L(0); PG8_BAR; PG8_MMA(0, 0, At, B0); PG8_MMA(0, 1, At, B1); PG8_BAR; PG8_SCHED;
            PG8_LDA(At, 0, 1); PG8_STAGE(PG8_SB(0, 0), b2, voffB); PG8_STAGE(PG8_SB(0, 1), b2 + hstepB, voffB); PG8_STAGE(PG8_SA(0, 0), a2, o20);
            PG8_WAIT_V(8); PG8_WAIT_L(0); PG8_BAR; PG8_MMA(1, 0, At, B0); PG8_MMA(1, 1, At, B1); PG8_BAR; PG8_SCHED;
            PG8_LDB(B0, 1, 0); PG8_LDB(B1, 1, 1); PG8_SCHED; PG8_LDA(At, 1, 0); PG8_STAGE(PG8_SA(0, 1), a2, o21);
            PG8_WAIT_V(8); PG8_WAIT_L(0); PG8_BAR; PG8_MMA(0, 0, At, B0); PG8_MMA(0, 1, At, B1); PG8_BAR; PG8_SCHED;
            PG8_LDA(At, 1, 1); PG8_STAGE(PG8_SB(1, 0), b3, voffB); PG8_STAGE(PG8_SB(1, 1), b3 + hstepB, voffB); PG8_STAGE(PG8_SA(1, 0), a3, o20);
            PG8_WAIT_V(8); PG8_WAIT_L(0); PG8_BAR; PG8_MMA(1, 0, At, B0); PG8_MMA(1, 1, At, B1); PG8_BAR; PG8_SCHED;
        }
        if constexpr (ALIGN_EPI) { if (wr == 0) PG8_BAR; }
        E(acc, cur, wr, wc, fr, fq);
        if (!has_next) break;
#pragma unroll
        for (int a = 0; a < 2; ++a)
#pragma unroll
            for (int b = 0; b < 2; ++b)
#pragma unroll
                for (int m = 0; m < 4; ++m)
#pragma unroll
                    for (int n = 0; n < 2; ++n) acc[a][b][m][n] = (f32x4){0.f, 0.f, 0.f, 0.f};
        cur = nxt; cB = nB; ++ui;
#pragma unroll
        for (int i = 0; i < 2; ++i) { ca0[i] = na0[i]; ca1[i] = na1[i]; }
        if constexpr (ALIGN_EPI) { if (wr == 1) PG8_BAR; }
    }
    PG8_WAIT_V(0);
    if constexpr (!ALIGN_EPI) { if (wr == 0) PG8_BAR; }
    PG8_BAR;
#undef PG8_SA
#undef PG8_SB
#undef PG8_STAGE
#undef PG8_LDA
#undef PG8_LDB
#undef PG8_MMA
#undef PG8_WAIT_V
#undef PG8_WAIT_L
#undef PG8_BAR
#undef PG8_SCHED
}

struct DenseSched {
    const char* A; const char* Bt; int K, nM, nN, nwg, G, c;
    __device__ __forceinline__ void init(const void* A_, const void* Bt_, int M, int N, int K_, int G_, int c_) { A = (const char*)A_; Bt = (const char*)Bt_; K = K_; nM = M / BM; nN = N / BM; nwg = nM * nN; G = G_; c = c_; }
    __device__ __forceinline__ bool next(int i, Unit& u) const {
        const long L = (long)i * G + c; if (L >= nwg) return false;
        int wgid = (int)L; { const int q = nwg / 8, r = nwg % 8, xcd = wgid % 8, off = wgid / 8; wgid = (xcd < r ? xcd * (q + 1) : r * (q + 1) + (xcd - r) * q) + off; }
        const int nig = 8 * nN, gid = wgid / nig, fm = gid * 8, gsz = (nM - fm) < 8 ? (nM - fm) : 8;
        u.pm = fm + ((wgid % nig) % gsz); u.pn = (wgid % nig) / gsz; u.e = 0; return true;
    }
    __device__ __forceinline__ const char* a_base() const { return A; }
    __device__ __forceinline__ unsigned a_off(const Unit& u, int row, int col) const { return (unsigned)(((size_t)(u.pm * BM + row) * K + col) * 2); }
    __device__ __forceinline__ const char* b_tile(const Unit& u) const { return Bt + (size_t)u.pn * BM * K * 2; }
};
}

namespace pg8 {
struct MoeSched {
    const char* A; const char* Bt; const int* slot_tok; volatile LAS unsigned* tstart; int K, rowsE, nN, c;
    __device__ __forceinline__ bool next(int i, Unit& u) const {
        const int x = c & 7, j = c >> 3, rpr = 32 / nN;
        const int pm = (i * 8 + x) * rpr + j / nN;
        const int T = (int)tstart[32];
        if (pm >= T) return false;
        int e = 0;
#pragma unroll 1
        for (int k = 1; k < 32; ++k) e += ((int)tstart[k] <= pm) ? 1 : 0;
        u.pm = pm; u.pn = j % nN; u.e = __builtin_amdgcn_readfirstlane(e); return true;
    }
    __device__ __forceinline__ const char* a_base() const { return A; }
    __device__ __forceinline__ unsigned a_off(const Unit& u, int row, int col) const {
        const int pos = u.pm * BM + row;
        const int r = slot_tok ? slot_tok[pos] : pos;
        return (unsigned)(((size_t)r * K + col) * 2);
    }
    __device__ __forceinline__ const char* b_tile(const Unit& u) const { return Bt + ((size_t)u.e * rowsE + (size_t)u.pn * BM) * K * 2; }
};

template <int ACT> struct EpiBf16 {
    static constexpr bool PERM = true;
    bf16_t* O; int ldc; const float* bias;
    __device__ __forceinline__ void operator()(const f32x4 (&acc)[2][2][4][2], const Unit& u, int wr, int wc, int fr, int fq) const {
        const int row0 = u.pm * BM + wr * 64 + fr; const int col0 = u.pn * BM + wc * 32 + 8 * fq;
        f32x4 bv[2][2];
#pragma unroll
        for (int bj = 0; bj < 2; ++bj)
#pragma unroll
            for (int n = 0; n < 2; ++n) bv[bj][n] = bias ? *(const f32x4*)(bias + col0 + bj * HALF + 4 * n) : (f32x4){0.f, 0.f, 0.f, 0.f};
#pragma unroll
        for (int ai = 0; ai < 2; ++ai)
#pragma unroll
            for (int m = 0; m < 4; ++m) { bf16_t* rowp = O + (size_t)(row0 + ai * HALF + m * 16) * ldc + col0;
#pragma unroll
                for (int bj = 0; bj < 2; ++bj) { f32x4 v0 = acc[ai][bj][m][0] + bv[bj][0], v1 = acc[ai][bj][m][1] + bv[bj][1];
                    if (ACT == 2) {
#pragma unroll
                        for (int q = 0; q < 4; ++q) { v0[q] = __builtin_amdgcn_rcpf(1.f + __builtin_amdgcn_exp2f(-LOG2E * v0[q])); v1[q] = __builtin_amdgcn_rcpf(1.f + __builtin_amdgcn_exp2f(-LOG2E * v1[q])); } }
                    u32x4 w; w.x = cvt_pk_bf16(v0[0], v0[1]); w.y = cvt_pk_bf16(v0[2], v0[3]); w.z = cvt_pk_bf16(v1[0], v1[1]); w.w = cvt_pk_bf16(v1[2], v1[3]);
                    *(u32x4*)(rowp + bj * HALF) = w; } }
    }
};
struct EpiMerge {
    static constexpr bool PERM = true;
    const bf16_t* G; int goff; bf16_t* Mg; int first;
    __device__ __forceinline__ void operator()(const f32x4 (&acc)[2][2][4][2], const Unit& u, int wr, int wc, int fr, int fq) const {
        const int row0 = u.pm * BM + wr * 64 + fr; const int col0 = u.pn * BM + wc * 32 + 8 * fq;
#pragma unroll
        for (int ai = 0; ai < 2; ++ai)
#pragma unroll
            for (int m = 0; m < 4; ++m) { const size_t row = (size_t)(row0 + ai * HALF + m * 16);
#pragma unroll
                for (int bj = 0; bj < 2; ++bj) {
                    const u32x4 g = *(const u32x4*)(G + row * PW + goff + col0 + bj * HALF);
                    u32x4 p = (u32x4){0u, 0u, 0u, 0u};
                    if (!first) p = *(const u32x4*)(Mg + row * DM + col0 + bj * HALF);
                    const f32x4 a0 = acc[ai][bj][m][0], a1 = acc[ai][bj][m][1];
                    u32x4 w;
                    w.x = cvt_pk_bf16(bflo(p.x) + bflo(g.x) * a0[0], bfhi(p.x) + bfhi(g.x) * a0[1]);
                    w.y = cvt_pk_bf16(bflo(p.y) + bflo(g.y) * a0[2], bfhi(p.y) + bfhi(g.y) * a0[3]);
                    w.z = cvt_pk_bf16(bflo(p.z) + bflo(g.z) * a1[0], bfhi(p.z) + bfhi(g.z) * a1[1]);
                    w.w = cvt_pk_bf16(bflo(p.w) + bflo(g.w) * a1[2], bfhi(p.w) + bfhi(g.w) * a1[3]);
                    *(u32x4*)(Mg + row * DM + col0 + bj * HALF) = w; } }
    }
};
struct EpiResid {
    static constexpr bool PERM = false;
    const float* base; float* out;
    __device__ __forceinline__ void operator()(const f32x4 (&acc)[2][2][4][2], const Unit& u, int wr, int wc, int fr, int fq) const {
        const int row0 = u.pm * BM + wr * 64 + fr; const int col0 = u.pn * BM + wc * 32 + 4 * fq;
#pragma unroll
        for (int ai = 0; ai < 2; ++ai)
#pragma unroll
            for (int m = 0; m < 4; ++m) { const size_t off = (size_t)(row0 + ai * HALF + m * 16) * DM + col0;
#pragma unroll
                for (int bj = 0; bj < 2; ++bj)
#pragma unroll
                    for (int n = 0; n < 2; ++n) { const f32x4 b = *(const f32x4*)(base + off + bj * HALF + n * 16); *(f32x4*)(out + off + bj * HALF + n * 16) = b + acc[ai][bj][m][n]; } }
    }
};
struct EpiSwiglu {
    static constexpr bool PERM = true;
    bf16_t* act; const float* bias;
    __device__ __forceinline__ void operator()(const f32x4 (&acc)[2][2][4][2], const Unit& u, int wr, int wc, int fr, int fq) const {
        const int row0 = u.pm * BM + wr * 64 + fr; const int col0 = u.pn * HALF + wc * 32 + 8 * fq;
        const float* be = bias + (size_t)u.e * 2048 + col0;
        f32x4 bg[2], bu[2];
#pragma unroll
        for (int n = 0; n < 2; ++n) { bg[n] = *(const f32x4*)(be + 4 * n); bu[n] = *(const f32x4*)(be + 1024 + 4 * n); }
#pragma unroll
        for (int ai = 0; ai < 2; ++ai)
#pragma unroll
            for (int m = 0; m < 4; ++m) { bf16_t* rowp = act + (size_t)(row0 + ai * HALF + m * 16) * DEXP + col0;
                float o[8];
#pragma unroll
                for (int n = 0; n < 2; ++n) { const f32x4 gv = acc[ai][0][m][n] + bg[n], uv = acc[ai][1][m][n] + bu[n];
#pragma unroll
                    for (int q = 0; q < 4; ++q) { const float g = fminf(gv[q], 7.0f); const float uu = fminf(fmaxf(uv[q], -7.0f), 7.0f);
                        const float sg = __builtin_amdgcn_rcpf(1.f + __builtin_amdgcn_exp2f(-1.702f * LOG2E * g));
                        o[4 * n + q] = (uu + 1.0f) * (g * sg); } }
                u32x4 w; w.x = cvt_pk_bf16(o[0], o[1]); w.y = cvt_pk_bf16(o[2], o[3]); w.z = cvt_pk_bf16(o[4], o[5]); w.w = cvt_pk_bf16(o[6], o[7]);
                *(u32x4*)rowp = w; }
    }
};
constexpr int EPI_STAGE_OFF = 131072, EPI_STAGE_WAVE = 2304;
struct EpiScatter {
    static constexpr bool PERM = false;
    float* out; const int* slot_tok; const float* slot_w; const float* bias; LAS unsigned char* lds;
    __device__ __forceinline__ void operator()(const f32x4 (&acc)[2][2][4][2], const Unit& u, int wr, int wc, int fr, int fq) const {
        const int lane = fr + 16 * fq, wid = wr * 4 + wc;
        LAS float* st = (LAS float*)(lds + EPI_STAGE_OFF + wid * EPI_STAGE_WAVE);
        const int row0 = u.pm * BM + wr * 64 + fr;
        const int lcol = lane & 31, lrow = lane >> 5;
        float bv[2];
#pragma unroll
        for (int bj = 0; bj < 2; ++bj) bv[bj] = bias[(size_t)u.e * DM + u.pn * BM + bj * HALF + wc * 32 + lcol];
#pragma unroll
        for (int ai = 0; ai < 2; ++ai)
#pragma unroll
            for (int m = 0; m < 4; ++m) { const int pos = row0 + ai * HALF + m * 16; const float w = slot_w[pos]; const int tok = slot_tok[pos];
#pragma unroll
                for (int bj = 0; bj < 2; ++bj) {
#pragma unroll
                    for (int n = 0; n < 2; ++n) *(LAS f32x4*)(st + fr * 36 + 16 * n + 4 * fq) = acc[ai][bj][m][n];
                    asm volatile("s_waitcnt lgkmcnt(0)" ::: "memory");
#pragma unroll
                    for (int i = 0; i < 8; ++i) { const int r = 2 * i + lrow; const float v = st[r * 36 + lcol];
                        const float wr_ = __shfl(w, r); const int tr_ = __shfl(tok, r);
                        if (wr_ != 0.f) unsafeAtomicAdd(out + (size_t)tr_ * DM + u.pn * BM + bj * HALF + wc * 32 + lcol, (v + bv[bj]) * wr_); }
                    asm volatile("s_waitcnt lgkmcnt(0)" ::: "memory");
                } }
    }
};
}

#define XB_TMO      128
#define XB_XCNT(j)  (256  + 64 * (j))
#define XB_XSUB(j)  (1280 + 64 * (j))
#define XB_XGEN(j)  (2304 + 64 * (j))
#define XB_TOP      3328
#define XB_TOPGEN   3392
#define XCD_BAR_WORDS 3456
#define XB_SPIN_CAP (1u << 18)

__device__ __forceinline__ unsigned xb_ld(unsigned* p)              { return __hip_atomic_load(p, __ATOMIC_RELAXED, __HIP_MEMORY_SCOPE_AGENT); }
__device__ __forceinline__ unsigned xb_add(unsigned* p, unsigned v) { return __hip_atomic_fetch_add(p, v, __ATOMIC_RELAXED, __HIP_MEMORY_SCOPE_AGENT); }
__device__ __forceinline__ unsigned xb_xcc_id() { return (unsigned)__builtin_amdgcn_s_getreg((3 << 11) | 20) & 0xFu; }
#define XB_SPIN(cond, bar) do { unsigned _sp = 0; while (cond) { __builtin_amdgcn_s_sleep(1); \
    if ((++_sp & 255u) == 0u) { if (xb_ld(&(bar)[XB_TMO])) break; if (_sp > XB_SPIN_CAP) { atomicAdd(&(bar)[XB_TMO], 1u); break; } } } } while (0)

struct XcdBarrier {
    unsigned* bar; unsigned x;
    volatile LAS unsigned* st;
};

__device__ __forceinline__ XcdBarrier xcd_barrier_post(unsigned* bar, volatile LAS unsigned* st) {
    XcdBarrier b; b.bar = bar; b.x = xb_xcc_id(); b.st = st;
    if (threadIdx.x == 0) (void)xb_add(&bar[XB_XCNT(b.x)], 1u);
    return b;
}
__device__ __forceinline__ void xcd_barrier_complete(unsigned* bar, unsigned x, unsigned& nloc, unsigned& nx) {
    const unsigned G = gridDim.x * gridDim.y * gridDim.z;
    unsigned sum, cnt, mine, sp = 0u;
    for (;;) {
        sum = 0u; cnt = 0u; mine = 0u;
#pragma unroll
        for (unsigned j = 0; j < 16; ++j) { const unsigned c = xb_ld(&bar[XB_XCNT(j)]); sum += c; cnt += (c > 0u) ? 1u : 0u; mine = (j == x) ? c : mine; }
        if (sum == G) break;
        __builtin_amdgcn_s_sleep(1);
        if ((++sp & 255u) == 0u) { if (xb_ld(&bar[XB_TMO])) break; if (sp > XB_SPIN_CAP) { atomicAdd(&bar[XB_TMO], 1u); break; } }
    }
    nloc = mine > 0u ? mine : 1u; nx = cnt > 0u ? cnt : 1u;
}

__device__ __forceinline__ void xcd_barrier(const XcdBarrier& b) {
    asm volatile("s_waitcnt vmcnt(0)" ::: "memory");
    __syncthreads();
    if (threadIdx.x == 0) {
        unsigned* bar = b.bar;
        __builtin_amdgcn_s_waitcnt(0);
        unsigned nloc = b.st[0], nx = b.st[1];
        if (nloc == 0u) { xcd_barrier_complete(bar, b.x, nloc, nx); b.st[0] = nloc; b.st[1] = nx; }
        const unsigned old = xb_add(&bar[XB_XSUB(b.x)], 1u);
        const unsigned gen = old / nloc;
        if (old + 1u == (gen + 1u) * nloc) {
            __builtin_amdgcn_fence(__ATOMIC_RELEASE, "agent");
            asm volatile("s_waitcnt vmcnt(0)" ::: "memory");
            const unsigned og = xb_add(&bar[XB_TOP], 1u);
            const unsigned tg = og / nx;
            if (og + 1u == (tg + 1u) * nx) xb_add(&bar[XB_TOPGEN], 1u);
            else XB_SPIN(xb_ld(&bar[XB_TOPGEN]) == tg, bar);
            __builtin_amdgcn_fence(__ATOMIC_ACQUIRE, "agent");
            xb_add(&bar[XB_XGEN(b.x)], 1u);
            asm volatile("s_waitcnt vmcnt(0)" ::: "memory");
        } else {
            XB_SPIN(xb_ld(&bar[XB_XGEN(b.x)]) == gen, bar);
            __builtin_amdgcn_fence(__ATOMIC_ACQUIRE, "agent");
            asm volatile("s_waitcnt vmcnt(0)" ::: "memory");
        }
    }
    __syncthreads();
}

constexpr int NWAVES = 8;
struct Frame {
    LAS unsigned char* lds;
    volatile LAS unsigned* MISC;
    gu32* ctl;
    int tid, lane, wave, G, blk;
    const float* in[21];
    float* out; unsigned char* ws;
};
__device__ __forceinline__ float wave_sum(float v) {
#pragma unroll
    for (int o = 1; o < 64; o <<= 1) v += __shfl_xor(v, o);
    return v;
}

__device__ __forceinline__ int map_src(int mode, int n) {
    if (mode == 1) return n < 2500 ? n : (n >= C_MQ ? n - (C_MQ - 2500) : -1);
    if (mode == 2) { const int pn = n >> 8, bj = (n >> 7) & 1, j = n & 127; return bj * 1024 + pn * 128 + j; }
    return n;
}
__device__ __forceinline__ void transpose_item(const float* W, int K, int Nsrc, int Ndst, bf16_t* WT, int mode, LAS float* scr, int item, int lane) {
    const int nblk = Ndst / 32, kb = item / nblk, nb = item % nblk, k0 = 64 * kb, n0 = 32 * nb;
    const int sc = map_src(mode, n0 + (lane & 31));
    const float scale = (mode == 1 && (n0 + (lane & 31)) < 512) ? 0.125f : 1.0f;
#pragma unroll 8
    for (int i = 0; i < 32; ++i) { const int kk = 2 * i + (lane >> 5); scr[kk * 33 + (lane & 31)] = sc >= 0 ? W[(size_t)(k0 + kk) * Nsrc + sc] * scale : 0.f; }
    LDS_WAIT(); asm volatile("" ::: "memory");
    const int c = lane & 7;
#pragma unroll
    for (int j = 0; j < 4; ++j) { const int n = (lane >> 3) + 8 * j; const LAS float* s = scr + (8 * c) * 33 + n;
        u32x4 o; o.x = pk2(s[0 * 33], s[1 * 33]); o.y = pk2(s[2 * 33], s[3 * 33]); o.z = pk2(s[4 * 33], s[5 * 33]); o.w = pk2(s[6 * 33], s[7 * 33]);
        *(GAS u32x4*)(WT + (size_t)(n0 + n) * K + k0 + 8 * c) = o; }
    LDS_WAIT(); asm volatile("" ::: "memory");
}
__device__ __forceinline__ void rms_row_to_bf16(int lane, const float* xrow, const float* g, bf16_t* orow) {
    const GAS f32x4* xr = (const GAS f32x4*)xrow + lane; const GAS f32x4* gr = (const GAS f32x4*)g + lane;
    f32x4 v[4]; float s = 0.f;
#pragma unroll
    for (int j = 0; j < 4; ++j) { v[j] = xr[64 * j]; s += (v[j].x * v[j].x + v[j].y * v[j].y) + (v[j].z * v[j].z + v[j].w * v[j].w); }
    const float rstd = 1.0f / sqrtf(wave_sum(s) * (1.f / DM) + EPS);
    GAS u32x2* o8 = (GAS u32x2*)orow + lane;
#pragma unroll
    for (int j = 0; j < 4; ++j) { const f32x4 gg = gr[64 * j]; u32x2 o; o.x = pk2(v[j].x * rstd * gg.x, v[j].y * rstd * gg.y); o.y = pk2(v[j].z * rstd * gg.z, v[j].w * rstd * gg.w); o8[64 * j] = o; }
}

__device__ __forceinline__ void p0_prologue(Frame& F) {
    LAS float* scr = (LAS float*)(F.lds + F.wave * 16384);
    const int gw = F.blk * NWAVES + F.wave, NGW = F.G * NWAVES, lane = F.lane;
    unsigned char* ws = F.ws;
    constexpr int I_IN = 16 * 96, I_MKV = 16 * 32, I_G = 16 * 32, I_B = 8 * 32, I_O = 16 * 32, I_EI = 16 * 64, I_EO = 16 * 32;
    constexpr int NITEMS = I_IN + I_MKV + 3 * I_G + 3 * I_B + I_O + NEXP * I_EI + NEXP * I_EO;
    for (int it = gw; it < NITEMS; it += NGW) {
        int r = it;
        if (r < I_IN) { transpose_item(F.in[3], DM, IN_W, PW, (bf16_t*)(ws + WS_WIN), 1, scr, r, lane); continue; } r -= I_IN;
        if (r < I_MKV) { transpose_item(F.in[9], DM, DM, DM, (bf16_t*)(ws + WS_WMKV), 0, scr, r, lane); continue; } r -= I_MKV;
        if (r < 3 * I_G) { const int n = r / I_G; transpose_item(F.in[10] + (size_t)n * DM * DM, DM, DM, DM, (bf16_t*)(ws + WS_WG) + (size_t)n * DM * DM, 0, scr, r % I_G, lane); continue; } r -= 3 * I_G;
        if (r < 3 * I_B) { const int n = r / I_B; transpose_item(F.in[12] + (size_t)n * 512 * DM, 512, DM, DM, (bf16_t*)(ws + WS_WB) + (size_t)n * DM * 512, 0, scr, r % I_B, lane); continue; } r -= 3 * I_B;
        if (r < I_O) { transpose_item(F.in[13], DM, DM, DM, (bf16_t*)(ws + WS_WO), 0, scr, r, lane); continue; } r -= I_O;
        if (r < NEXP * I_EI) { const int e = r / I_EI; transpose_item(F.in[17] + (size_t)e * DM * 2048, DM, 2048, 2048, (bf16_t*)(ws + WS_WEI) + (size_t)e * 2048 * DM, 2, scr, r % I_EI, lane); continue; } r -= NEXP * I_EI;
        { const int e = r / I_EO; transpose_item(F.in[19] + (size_t)e * DM * DM, DM, DM, DM, (bf16_t*)(ws + WS_WEO) + (size_t)e * DM * DM, 0, scr, r % I_EO, lane); }
    }
    { f32x2* tab = (f32x2*)(ws + WS_ROPE);
      for (int idx = (F.blk * NWAVES * 64) + F.tid; idx < SEQ * 32; idx += F.G * NWAVES * 64) {
          const int s = idx >> 5, i = idx & 31;
          const float inv = exp2f(-(float)i * (13.287712379549449f / 32.0f));
          const float ang = (float)s * inv;
          const double rev = (double)ang * 0.15915494309189535;
          const float fr = (float)(rev - __builtin_rint(rev));
          tab[idx] = (f32x2){__builtin_amdgcn_cosf(fr), __builtin_amdgcn_sinf(fr)}; } }
    for (int m = gw; m < NTOK; m += NGW) rms_row_to_bf16(lane, F.in[0] + (size_t)m * DM, F.in[2], (bf16_t*)(ws + WS_H) + (size_t)m * DM);
    for (int m = gw; m < NMEM; m += NGW) rms_row_to_bf16(lane, F.in[1] + (size_t)m * DM, F.in[8], (bf16_t*)(ws + WS_MEMN) + (size_t)m * DM);
    { int* st = (int*)(ws + WS_SLOT_TOK); float* sw = (float*)(ws + WS_SLOT_W);
      for (int i = F.blk * NWAVES * 64 + F.tid; i < NSLOT_PAD; i += F.G * NWAVES * 64) { st[i] = 0; sw[i] = 0.f; } }
}

__device__ __forceinline__ void ld8(const bf16_t* p, float (&v)[8]) { const u32x4 w = *(const u32x4*)p; v[0] = bflo(w.x); v[1] = bfhi(w.x); v[2] = bflo(w.y); v[3] = bfhi(w.y); v[4] = bflo(w.z); v[5] = bfhi(w.z); v[6] = bflo(w.w); v[7] = bfhi(w.w); }
__device__ __forceinline__ void st8(bf16_t* p, const float (&v)[8]) { u32x4 w; w.x = pk2(v[0], v[1]); w.y = pk2(v[2], v[3]); w.z = pk2(v[4], v[5]); w.w = pk2(v[6], v[7]); *(u32x4*)p = w; }
__device__ __forceinline__ void rope8(float (&v)[8], const f32x2* tabrow, int lane) {
    const int i0 = (lane & 3) * 8; const bool up = (lane & 4) != 0;
#pragma unroll
    for (int j = 0; j < 8; ++j) { const float other = __shfl_xor(v[j], 4); const f32x2 cs = tabrow[i0 + j];
        v[j] = up ? (other * cs.y + v[j] * cs.x) : (v[j] * cs.x - other * cs.y); }
}
__device__ __forceinline__ void p2_prep(Frame& F, const bool dummy = false) {
    const int gw = F.blk * NWAVES + F.wave, NGW = F.G * NWAVES, lane = F.lane;
    bf16_t* proj = (bf16_t*)(F.ws + WS_P);
    bf16_t* projw = dummy ? (bf16_t*)(F.ws + WS_END) : proj;
    const int wmask = dummy ? 8191 : 0x7fffffff;
    const f32x2* tab = (const f32x2*)(F.ws + WS_ROPE);
    const float* g_q_dsa = F.in[4]; const float* g_k_dsa = F.in[5]; const float* g_q_mem = F.in[6]; const float* g_k_mem = F.in[7];
    for (int m = gw; m < NTOK; m += NGW) {
        const bf16_t* row = proj + (size_t)m * PW; bf16_t* roww = projw + (size_t)(m & wmask) * PW; const f32x2* tr = tab + (size_t)(m & (SEQ - 1)) * 32;
        float v[8];
        { ld8(row + C_DQ + 8 * lane, v); float ss = 0.f;
#pragma unroll
          for (int j = 0; j < 8; ++j) ss += v[j] * v[j];
          ss += __shfl_xor(ss, 1); ss += __shfl_xor(ss, 2); ss += __shfl_xor(ss, 4);
          const float rstd = 1.0f / sqrtf(ss * (1.f / 64.f) + EPS);
#pragma unroll
          for (int j = 0; j < 8; ++j) v[j] = v[j] * rstd * g_q_dsa[8 * (lane & 7) + j];
          rope8(v, tr, lane);
#pragma unroll
          for (int j = 0; j < 8; ++j) v[j] *= 0.125f * LOG2E;
          st8(roww + C_DQ + 8 * lane, v); }
        { ld8(row + C_DK + 8 * (lane & 7), v); float ss = 0.f;
#pragma unroll
          for (int j = 0; j < 8; ++j) ss += v[j] * v[j];
          ss += __shfl_xor(ss, 1); ss += __shfl_xor(ss, 2); ss += __shfl_xor(ss, 4);
          const float rstd = 1.0f / sqrtf(ss * (1.f / 64.f) + EPS);
#pragma unroll
          for (int j = 0; j < 8; ++j) v[j] = v[j] * rstd * g_k_dsa[8 * (lane & 7) + j];
          rope8(v, tr, lane);
          if (lane < 8) st8(roww + C_DK + 8 * lane, v); }
        { ld8(row + C_IQ + 8 * (lane & 31), v); rope8(v, tr, lane); if (lane < 32) st8(roww + C_IQ + 8 * lane, v); }
        { ld8(row + C_IK + 8 * (lane & 7), v); rope8(v, tr, lane); if (lane < 8) st8(roww + C_IK + 8 * lane, v); }
        { ld8(row + C_MQ + 8 * lane, v); float ss = 0.f;
#pragma unroll
          for (int j = 0; j < 8; ++j) ss += v[j] * v[j];
          ss += __shfl_xor(ss, 1); ss += __shfl_xor(ss, 2); ss += __shfl_xor(ss, 4); ss += __shfl_xor(ss, 8);
          const float rstd = 1.0f / sqrtf(ss * (1.f / 128.f) + EPS) * (0.08838834764831845f * LOG2E);
#pragma unroll
          for (int j = 0; j < 8; ++j) v[j] = v[j] * rstd * g_q_mem[8 * (lane & 15) + j];
          st8(roww + C_MQ + 8 * lane, v); }
    }
    bf16_t* mkv = (bf16_t*)(F.ws + WS_MKV);
    if (!dummy) for (int m = gw; m < NMEM; m += NGW) {
        bf16_t* row = mkv + (size_t)m * DM; float v[8];
        ld8(row + 8 * lane, v); float ss = 0.f;
#pragma unroll
        for (int j = 0; j < 8; ++j) ss += v[j] * v[j];
        ss += __shfl_xor(ss, 1); ss += __shfl_xor(ss, 2); ss += __shfl_xor(ss, 4); ss += __shfl_xor(ss, 8);
        const float rstd = 1.0f / sqrtf(ss * (1.f / 128.f) + EPS);
#pragma unroll
        for (int j = 0; j < 8; ++j) v[j] = v[j] * rstd * g_k_mem[8 * (lane & 15) + j];
        st8(row + 8 * lane, v);
    }
}

#define MFMA32(a, b, c) __builtin_amdgcn_mfma_f32_32x32x16_bf16((a), (b), (c), 0, 0, 0)
typedef LAS const unsigned char* lds_cptr;
__device__ __forceinline__ s16x4 vtr(lds_cptr p) { return __builtin_bit_cast(s16x4, __builtin_amdgcn_ds_read_tr16_b64_v4i16((LAS v4i16_t*)p)); }
__device__ __forceinline__ bf16x8 vfrag(lds_cptr vbase_lane, int off) {
    const s16x4 lo = vtr(vbase_lane + off), hi = vtr(vbase_lane + off + 512);
    return (bf16x8){lo[0], lo[1], lo[2], lo[3], hi[0], hi[1], hi[2], hi[3]};
}
__device__ __forceinline__ int vtr_lane_off(int lane) { return ((lane >> 4) & 1) * 32 + (lane & 3) * 8 + (4 * (lane >> 5) + ((lane & 15) >> 2)) * 64; }
__device__ __forceinline__ bf16x8 pack8(const float* p) {
    u32x4 w; w.x = cvt_pk_bf16(p[0], p[1]); w.y = cvt_pk_bf16(p[2], p[3]); w.z = cvt_pk_bf16(p[4], p[5]); w.w = cvt_pk_bf16(p[6], p[7]);
    return __builtin_bit_cast(bf16x8, w);
}
__device__ __forceinline__ float softplus_f(float z) { return fmaxf(z, 0.f) + __logf(1.f + __expf(-fabsf(z))); }

__device__ __forceinline__ void sb_item(const bf16_t* proj, bf16_t* osb, int b, int h, int qblk, LAS unsigned char* vlds, int lane) {
    const int r32 = lane & 31, hi = lane >> 5;
    const size_t tok0 = (size_t)b * SEQ + (size_t)qblk * 32;
    bf16x8 qr[4];
    { const bf16_t* qp = proj + (tok0 + r32) * PW + C_SQ + h * 64 + hi * 8;
#pragma unroll
      for (int kk = 0; kk < 4; ++kk) qr[kk] = *(const bf16x8*)(qp + kk * 16); }
    f32x16 o0 = {}, o1 = {}; float R = 0.f;
    const lds_cptr vrd = (lds_cptr)vlds + vtr_lane_off(lane);
    for (int kt = qblk; kt >= 0; --kt) {
        const size_t key0 = (size_t)b * SEQ + (size_t)kt * 32;
        const bf16_t* kp = proj + (key0 + r32) * PW + C_SK + h * 64 + hi * 8;
        bf16x8 kf[4];
#pragma unroll
        for (int kk = 0; kk < 4; ++kk) kf[kk] = *(const bf16x8*)(kp + kk * 16);
        u32x4 vv[4];
#pragma unroll
        for (int p = 0; p < 4; ++p) vv[p] = *(const u32x4*)(proj + (key0 + 16 * (p & 1) + (lane >> 2)) * PW + C_SV + h * 64 + (p >> 1) * 32 + (lane & 3) * 8);
        f32x16 s = {};
#pragma unroll
        for (int kk = 0; kk < 4; ++kk) s = MFMA32(kf[kk], qr[kk], s);
        asm volatile("" ::: "memory");
#pragma unroll
        for (int p = 0; p < 4; ++p) *(LAS u32x4*)(vlds + p * 1024 + lane * 16) = vv[p];
        const bool diag = (kt == qblk);
        float sp[16], pr[16];
#pragma unroll
        for (int r = 0; r < 16; ++r) { const bool valid = !diag || (crow(r, hi) < r32); sp[r] = valid ? softplus_f(s[r]) : 0.f; }
        float T[4], U[4];
#pragma unroll
        for (int g = 0; g < 4; ++g) { T[g] = (sp[4 * g] + sp[4 * g + 1]) + (sp[4 * g + 2] + sp[4 * g + 3]); U[g] = __shfl_xor(T[g], 32); }
        float run = 0.f, above[4];
#pragma unroll
        for (int g = 3; g >= 0; --g) { above[g] = run + (hi == 0 ? U[g] : 0.f); run += T[g] + U[g]; }
#pragma unroll
        for (int g = 0; g < 4; ++g) { float c = R + above[g];
#pragma unroll
            for (int j = 3; j >= 0; --j) { const int r = 4 * g + j; c += sp[r]; const bool valid = !diag || (crow(r, hi) < r32); pr[r] = valid ? __expf(s[r] - c) : 0.f; } }
        R += run;
        const bf16x8 p0 = pack8(pr), p1 = pack8(pr + 8);
        LDS_WAIT();
        const bf16x8 v00 = vfrag(vrd, 0), v01 = vfrag(vrd, 1024), v10 = vfrag(vrd, 2048), v11 = vfrag(vrd, 3072);
        o0 = MFMA32(v00, p0, o0); o0 = MFMA32(v01, p1, o0);
        o1 = MFMA32(v10, p0, o1); o1 = MFMA32(v11, p1, o1);
        asm volatile("" ::: "memory");
        if (__all(R > 30.0f)) break;
    }
    bf16_t* op = osb + (tok0 + r32) * 512 + h * 64 + 4 * hi;
#pragma unroll
    for (int g = 0; g < 4; ++g) {
        u32x2 w0, w1; w0.x = cvt_pk_bf16(o0[4 * g], o0[4 * g + 1]); w0.y = cvt_pk_bf16(o0[4 * g + 2], o0[4 * g + 3]); w1.x = cvt_pk_bf16(o1[4 * g], o1[4 * g + 1]); w1.y = cvt_pk_bf16(o1[4 * g + 2], o1[4 * g + 3]);
        *(u32x2*)(op + 8 * g) = w0; *(u32x2*)(op + 32 + 8 * g) = w1; }
}

constexpr int ML_K = 0, ML_KROW = 272, ML_V = 256 * ML_KROW, ML_END = ML_V + 65536;
__device__ __forceinline__ void mem_unit(const bf16_t* proj, const bf16_t* mkv, bf16_t* omem, int b, int h, int half, LAS unsigned char* ml, int tid) {
    const int lane = tid & 63, wid = __builtin_amdgcn_readfirstlane(tid >> 6), r32 = lane & 31, hi = lane >> 5;
    { const GAS bf16_t* src = (const GAS bf16_t*)mkv + (size_t)b * MEMLEN * DM + h * 128;
#pragma unroll
      for (int i = 0; i < 8; ++i) { const int ch = tid + 512 * i, key = ch >> 4, c16 = ch & 15, kk = key & 31;
          const u32x4 kv = *(const GAS u32x4*)(src + (size_t)key * DM + c16 * 8);
          const u32x4 vv = *(const GAS u32x4*)(src + (size_t)key * DM + 512 + c16 * 8);
          *(LAS u32x4*)(ml + ML_K + key * ML_KROW + c16 * 16) = kv;
          *(LAS u32x4*)(ml + ML_V + (key >> 5) * 8192 + ((c16 >> 2) * 2 + (kk >> 4)) * 1024 + (kk & 15) * 64 + (c16 & 3) * 16) = vv; } }
    __syncthreads();
    for (int i = 0; i < 4; ++i) {
        const int qblk = half * 32 + wid * 4 + i;
        const size_t tok0 = (size_t)b * SEQ + (size_t)qblk * 32;
        bf16x8 qr[8];
        { const GAS bf16_t* qp = (const GAS bf16_t*)proj + (tok0 + r32) * PW + C_MQ + h * 128 + hi * 8;
#pragma unroll
          for (int kk = 0; kk < 8; ++kk) qr[kk] = *(const GAS bf16x8*)(qp + kk * 16); }
        f32x16 o[4] = {{}, {}, {}, {}}; float m = -1e30f, l = 0.f;
        for (int kb = 0; kb < 8; ++kb) {
            const LAS unsigned char* krd = ml + ML_K + (32 * kb + r32) * ML_KROW + hi * 16;
            f32x16 s = {};
#pragma unroll
            for (int kk = 0; kk < 8; ++kk) { const bf16x8 kf = *(const LAS bf16x8*)(krd + kk * 32); s = MFMA32(kf, qr[kk], s); }
            float mx = s[0];
#pragma unroll
            for (int r = 1; r < 16; ++r) mx = fmaxf(mx, s[r]);
            mx = fmaxf(mx, __shfl_xor(mx, 32));
            if (__any(mx > m + 8.0f)) {
                const float mn = fmaxf(m, mx), alpha = __builtin_amdgcn_exp2f(m - mn);
                l *= alpha; m = mn;
#pragma unroll
                for (int d = 0; d < 4; ++d)
#pragma unroll
                    for (int r = 0; r < 16; ++r) o[d][r] *= alpha;
            }
            float pr[16], rs = 0.f;
#pragma unroll
            for (int r = 0; r < 16; ++r) { pr[r] = __builtin_amdgcn_exp2f(s[r] - m); rs += pr[r]; }
            l += rs;
            const bf16x8 p0 = pack8(pr), p1 = pack8(pr + 8);
            const lds_cptr vrd = (lds_cptr)ml + ML_V + kb * 8192 + vtr_lane_off(lane);
#pragma unroll
            for (int d = 0; d < 4; ++d) { const bf16x8 va = vfrag(vrd, d * 2048), vb = vfrag(vrd, d * 2048 + 1024); o[d] = MFMA32(va, p0, o[d]); o[d] = MFMA32(vb, p1, o[d]); }
        }
        l += __shfl_xor(l, 32);
        const float il = 1.0f / l;
        bf16_t* op = omem + (tok0 + r32) * 512 + h * 128 + 4 * hi;
#pragma unroll
        for (int d = 0; d < 4; ++d)
#pragma unroll
            for (int g = 0; g < 4; ++g) { u32x2 w; w.x = cvt_pk_bf16(o[d][4 * g] * il, o[d][4 * g + 1] * il); w.y = cvt_pk_bf16(o[d][4 * g + 2] * il, o[d][4 * g + 3] * il); *(u32x2*)(op + 32 * d + 8 * g) = w; }
    }
    __syncthreads();
}

constexpr int DL_HIST = 0, DL_PREFIX = 66048, DL_KREM = DL_PREFIX + 256, DL_MASK = 67072, DL_VT = 73728, DL_KT = DL_VT + 2 * 16384, DL_END = DL_KT + 2 * 18432, DL_IQ = DL_VT;
constexpr int TOPK_DSA = 256;

struct IqLds { const LAS unsigned char* p; __device__ __forceinline__ bf16x8 operator()(int j) const { return *(const LAS bf16x8*)(p + j * 32); } };
template <class QF>
__device__ __forceinline__ void idx_scores(const QF& qf, const bf16x8 (&kf)[4], const float (&wq)[4], unsigned (&uk)[16]) {
    float scv[16];
#pragma unroll
    for (int hd = 0; hd < 4; ++hd) { f32x16 a = (f32x16){};
#pragma unroll
        for (int kk = 0; kk < 4; ++kk) a = MFMA32(kf[kk], qf(hd * 4 + kk), a);
#pragma unroll
        for (int r = 0; r < 16; ++r) scv[r] = (hd == 0) ? wq[0] * fmaxf(a[r], 0.f) : __builtin_fmaf(wq[hd], fmaxf(a[r], 0.f), scv[r]); }
#pragma unroll
    for (int r = 0; r < 16; ++r) {
        unsigned bits = __builtin_bit_cast(unsigned, scv[r]);
        if (bits == 0x80000000u) bits = 0u;
        uk[r] = bits ^ ((unsigned)((int)bits >> 31) | 0x80000000u);
    }
}
__device__ __forceinline__ void load_ik(const bf16_t* proj, size_t tokb, int kbase, int r32, int hi, bf16x8 (&kf)[4]) {
    int kr = kbase + r32; if (kr > SEQ - 1) kr = SEQ - 1;
    const GAS bf16_t* p = (const GAS bf16_t*)proj + (tokb + kr) * PW + C_IK + 8 * hi;
#pragma unroll
    for (int kk = 0; kk < 4; ++kk) kf[kk] = *(const GAS bf16x8*)(p + kk * 16);
}

__device__ __forceinline__ void dsa_unit(const bf16_t* proj, bf16_t* odsa, int b, int c, LAS unsigned char* dl, int tid) {
    const int lane = tid & 63, wid = __builtin_amdgcn_readfirstlane(tid >> 6), r32 = lane & 31, hi = lane >> 5;
    const int n = 64 * (c + 1), nsteps = (n + 127) >> 7;
    const size_t tokq0 = (size_t)b * SEQ + (size_t)c * 64, tokb = (size_t)b * SEQ;
    LAS unsigned* hist = (LAS unsigned*)(dl + DL_HIST);
    LAS unsigned* prefix = (LAS unsigned*)(dl + DL_PREFIX);
    LAS unsigned* krem = (LAS unsigned*)(dl + DL_KREM);
    LAS unsigned* mask = (LAS unsigned*)(dl + DL_MASK);
    const int kb = wid >> 1, qh = wid & 1;
    { const int row = tid >> 3, c = tid & 7;
      const GAS bf16_t* src = (const GAS bf16_t*)proj + (tokq0 + row) * PW + C_IQ + c * 32;
#pragma unroll
      for (int i = 0; i < 4; ++i) *(LAS u32x4*)(dl + DL_IQ + row * 528 + c * 64 + i * 16) = *(const GAS u32x4*)(src + i * 8); }
    const IqLds iqf{dl + DL_IQ + (32 * qh + r32) * 528 + hi * 16};
    float wq[4];
    { const u32x2 w = *(const u32x2*)(proj + (tokq0 + 32 * qh + r32) * PW + C_IW);
      wq[0] = bflo(w.x) * 0.0625f; wq[1] = bfhi(w.x) * 0.0625f; wq[2] = bflo(w.y) * 0.0625f; wq[3] = bfhi(w.y) * 0.0625f; }
#ifndef REP_SEL
#define REP_SEL 1
#endif
#ifndef REP_B2
#define REP_B2 1
#endif
    LAS unsigned* selall = (LAS unsigned*)(dl + DL_HIST);
    if (tid < 64) { prefix[tid] = 0u; krem[tid] = (n > TOPK_DSA) ? (unsigned)TOPK_DSA : 0x7fffffffu; }
    __syncthreads();
    for (int pass = (n > TOPK_DSA) ? 0 : 3; pass < 4; ++pass) {
        const bool sel = pass < 3;
        if (sel) { for (int i = tid; i < 64 * 257; i += 512) hist[i] = 0u; __syncthreads(); }
        const int shift = 24 - 8 * pass;
        const unsigned pfx = prefix[32 * qh + r32];
        bf16x8 kfn[4]; load_ik(proj, tokb, 32 * kb, r32, hi, kfn);
        for (int step = 0; step < nsteps; ++step) {
            const int kbase = 128 * step + 32 * kb;
            bf16x8 kf[4];
#pragma unroll
            for (int kk = 0; kk < 4; ++kk) kf[kk] = kfn[kk];
            if (step + 1 < nsteps) load_ik(proj, tokb, kbase + 128, r32, hi, kfn);
            unsigned gtw = 0u, eqw = 0u;
            if (kbase < n) {
                unsigned uk[16];
                idx_scores(iqf, kf, wq, uk);
                if (sel) {
#pragma unroll
                    for (int r = 0; r < 16; ++r) {
                        const bool match = (pass == 0) || ((uk[r] >> (shift + 8)) == pfx);
                        if (match) __hip_atomic_fetch_add(hist + (32 * qh + r32) * 257 + ((uk[r] >> shift) & 255u), 1u, __ATOMIC_RELAXED, __HIP_MEMORY_SCOPE_WORKGROUP);
                    }
                } else {
#pragma unroll
                    for (int r = 0; r < 16; ++r) { const unsigned k24 = uk[r] >> 8; gtw |= (k24 > pfx ? 1u : 0u) << crow(r, hi); eqw |= (k24 == pfx ? 1u : 0u) << crow(r, hi); }
                }
            }
            if (!sel) {
                LAS unsigned* mk = mask + (step & 1) * 768;
                gtw |= __shfl_xor(gtw, 32); eqw |= __shfl_xor(eqw, 32);
                if (hi == 0) { mk[(32 * qh + r32) * 4 + kb] = gtw; mk[256 + (32 * qh + r32) * 4 + kb] = eqw; }
                __syncthreads();
                if (wid == 0) { unsigned nd = krem[lane];
#pragma unroll
                    for (int k4 = 0; k4 < 4; ++k4) { const unsigned g = mk[lane * 4 + k4]; unsigned e = mk[256 + lane * 4 + k4]; unsigned sl = g;
                        if (e != 0u) { const unsigned cnt = (unsigned)__builtin_popcount(e);
                            if (cnt <= nd) { sl |= e; nd -= cnt; }
                            else { unsigned chosen = 0u; while (nd > 0u) { const unsigned lb = e & (0u - e); chosen |= lb; e ^= lb; --nd; } sl |= chosen; } }
                        selall[lane * 64 + step * 4 + k4] = sl; }
                    krem[lane] = nd; }
            }
        }
        if (sel) {
            __syncthreads();
#pragma unroll
            for (int qi = 0; qi < 8; ++qi) {
                const int q = 8 * wid + qi;
                const LAS unsigned* hq = hist + q * 257;
                const unsigned c0 = hq[255 - 4 * lane], c1 = hq[254 - 4 * lane], c2 = hq[253 - 4 * lane], c3 = hq[252 - 4 * lane];
                const unsigned s4 = c0 + c1 + c2 + c3;
                unsigned incl = s4;
#pragma unroll
                for (int o = 1; o < 64; o <<= 1) { const unsigned t = __shfl_up(incl, o); if (lane >= o) incl += t; }
                const unsigned excl = incl - s4, kr = krem[q];
                if (excl < kr && kr <= incl) {
                    unsigned cum = excl, bin, nk;
                    if (cum + c0 >= kr) { bin = 255 - 4 * lane; nk = kr - cum; }
                    else { cum += c0; if (cum + c1 >= kr) { bin = 254 - 4 * lane; nk = kr - cum; }
                    else { cum += c1; if (cum + c2 >= kr) { bin = 253 - 4 * lane; nk = kr - cum; }
                    else { cum += c2; bin = 252 - 4 * lane; nk = kr - cum; } } }
                    prefix[q] = (prefix[q] << 8) | bin; krem[q] = nk;
                }
            }
            __syncthreads();
        }
    }
    const int hd = wid;
    u32x4 pk[2], pv[2];
#define DSA_LOADKV(step_) do { _Pragma("unroll") for (int i_ = 0; i_ < 2; ++i_) { const int ch_ = tid + 512 * i_; int krow_ = 128 * (step_) + (ch_ >> 3); if (krow_ > SEQ - 1) krow_ = SEQ - 1; \
        const GAS bf16_t* rp_ = (const GAS bf16_t*)proj + (tokb + krow_) * PW + (ch_ & 7) * 8; pk[i_] = *(const GAS u32x4*)(rp_ + C_DK); pv[i_] = *(const GAS u32x4*)(rp_ + C_DV); } } while (0)
#define DSA_STOREKV(buf_) do { _Pragma("unroll") for (int i_ = 0; i_ < 2; ++i_) { const int ch_ = tid + 512 * i_, key_ = ch_ >> 3, c8_ = ch_ & 7, kk_ = key_ & 31; \
        *(LAS u32x4*)(dl + DL_KT + (buf_) * 18432 + key_ * 144 + c8_ * 16) = pk[i_]; \
        *(LAS u32x4*)(dl + DL_VT + (buf_) * 16384 + (key_ >> 5) * 4096 + ((c8_ >> 2) * 2 + (kk_ >> 4)) * 1024 + (kk_ & 15) * 64 + (c8_ & 3) * 16) = pv[i_]; } } while (0)
    for (int qb = 0; qb < 2; ++qb) {
        bf16x8 qr[4];
        { const GAS bf16_t* qp = (const GAS bf16_t*)proj + (tokq0 + 32 * qb + r32) * PW + C_DQ + hd * 64 + 8 * hi;
#pragma unroll
          for (int kk = 0; kk < 4; ++kk) qr[kk] = *(const GAS bf16x8*)(qp + kk * 16); }
        f32x16 o0 = {}, o1 = {}; float mrun = -1e30f, lrun = 0.f;
        DSA_LOADKV(0);
        DSA_STOREKV(0);
        __syncthreads();
        for (int step = 0; step < nsteps; ++step) {
            const int buf = step & 1;
            if (step + 1 < nsteps) DSA_LOADKV(step + 1);
            LAS unsigned char* kt = dl + DL_KT + buf * 18432;
            LAS unsigned char* vt = dl + DL_VT + buf * 16384;
            for (int k4 = 0; k4 < 4; ++k4) {
                const int kbase = 128 * step + 32 * k4;
                if (kbase >= n) break;
                const LAS unsigned char* krd = kt + (32 * k4 + r32) * 144 + hi * 16;
                f32x16 s = {};
#pragma unroll
                for (int kk = 0; kk < 4; ++kk) { const bf16x8 kf = *(const LAS bf16x8*)(krd + kk * 32); s = MFMA32(kf, qr[kk], s); }
                const lds_cptr vrd = (lds_cptr)vt + k4 * 4096 + vtr_lane_off(lane);
                const bf16x8 v00 = vfrag(vrd, 0), v01 = vfrag(vrd, 1024), v10 = vfrag(vrd, 2048), v11 = vfrag(vrd, 3072);
                const unsigned selw = selall[(32 * qb + r32) * 64 + step * 4 + k4];
                float mx = -INFINITY;
#pragma unroll
                for (int r = 0; r < 16; ++r) { if (!((selw >> crow(r, hi)) & 1u)) s[r] = -INFINITY; mx = fmaxf(mx, s[r]); }
                mx = fmaxf(mx, __shfl_xor(mx, 32));
                if (__any(mx > mrun + 8.0f)) {
                    const float mn = fmaxf(mrun, mx), alpha = __builtin_amdgcn_exp2f(mrun - mn);
                    lrun *= alpha; mrun = mn;
#pragma unroll
                    for (int r = 0; r < 16; ++r) { o0[r] *= alpha; o1[r] *= alpha; }
                }
                float pr[16], rs = 0.f;
#pragma unroll
                for (int r = 0; r < 16; ++r) { pr[r] = __builtin_amdgcn_exp2f(s[r] - mrun); rs += pr[r]; }
                lrun += rs;
                const bf16x8 p0 = pack8(pr), p1 = pack8(pr + 8);
                o0 = MFMA32(v00, p0, o0); o0 = MFMA32(v01, p1, o0);
                o1 = MFMA32(v10, p0, o1); o1 = MFMA32(v11, p1, o1);
            }
            if (step + 1 < nsteps) DSA_STOREKV(buf ^ 1);
            __syncthreads();
        }
        float l = lrun; l += __shfl_xor(l, 32);
        const float il = 1.0f / l;
        bf16_t* op = odsa + (tokq0 + 32 * qb + r32) * 512 + hd * 64 + 4 * hi;
#pragma unroll
        for (int g = 0; g < 4; ++g) {
            u32x2 w0, w1; w0.x = cvt_pk_bf16(o0[4 * g] * il, o0[4 * g + 1] * il); w0.y = cvt_pk_bf16(o0[4 * g + 2] * il, o0[4 * g + 3] * il);
            w1.x = cvt_pk_bf16(o1[4 * g] * il, o1[4 * g + 1] * il); w1.y = cvt_pk_bf16(o1[4 * g + 2] * il, o1[4 * g + 3] * il);
            *(u32x2*)(op + 8 * g) = w0; *(u32x2*)(op + 32 + 8 * g) = w1; }
    }
#undef DSA_LOADKV
#undef DSA_STOREKV
    __syncthreads();
}

template <int CTRL> __device__ __forceinline__ float dpp_f(float v) { return __builtin_bit_cast(float, __builtin_amdgcn_update_dpp(0, __builtin_bit_cast(int, v), CTRL, 0xF, 0xF, false)); }
constexpr int RL_WR = 0, RL_WR_STRIDE = 1028, RL_TKE = 131584, RL_TKW = RL_TKE + 4096;
__device__ __forceinline__ void p9_router(Frame& F) {
    const int lane = F.lane, wave = F.wave, tid = F.tid;
    LAS float* Wr = (LAS float*)(F.lds + RL_WR);
    LAS int* tke = (LAS int*)(F.lds + RL_TKE); LAS float* tkw = (LAS float*)(F.lds + RL_TKW);
    const float* w_router = F.in[15]; const float* b_router = F.in[16]; const float* g_ffn = F.in[14];
    for (int idx = tid; idx < DM * NEXP; idx += NWAVES * 64) { const int k = idx >> 5, e = idx & 31; Wr[e * RL_WR_STRIDE + k] = w_router[idx]; }
    if (tid < 32) F.MISC[MW_LCNT + tid] = 0u;
    __syncthreads();
    bf16_t* h2 = (bf16_t*)(F.ws + WS_H);
    const GAS f32x4* gr = (const GAS f32x4*)g_ffn + lane;
    f32x4 gg[4];
#pragma unroll
    for (int j = 0; j < 4; ++j) gg[j] = gr[64 * j];
    const float bias_e = b_router[lane >> 1];
    f32x4 xnext[2][4];
#pragma unroll
    for (int tk = 0; tk < 2; ++tk) { const GAS f32x4* xr = (const GAS f32x4*)(F.out + ((size_t)F.blk * 256 + 32 * wave + tk) * DM) + lane;
#pragma unroll
        for (int j = 0; j < 4; ++j) xnext[tk][j] = xr[64 * j]; }
    for (int it = 0; it < 16; ++it) {
        const int tl0 = 32 * wave + 2 * it;
        f32x4 hn[2][4];
#pragma unroll
        for (int tk = 0; tk < 2; ++tk)
#pragma unroll
            for (int j = 0; j < 4; ++j) hn[tk][j] = xnext[tk][j];
        if (it + 1 < 16) {
#pragma unroll
            for (int tk = 0; tk < 2; ++tk) { const GAS f32x4* xr = (const GAS f32x4*)(F.out + ((size_t)F.blk * 256 + tl0 + 2 + tk) * DM) + lane;
#pragma unroll
                for (int j = 0; j < 4; ++j) xnext[tk][j] = xr[64 * j]; } }
#pragma unroll
        for (int tk = 0; tk < 2; ++tk) {
            const size_t t = (size_t)F.blk * 256 + tl0 + tk;
            float s = 0.f;
#pragma unroll
            for (int j = 0; j < 4; ++j) { s += (hn[tk][j].x * hn[tk][j].x + hn[tk][j].y * hn[tk][j].y) + (hn[tk][j].z * hn[tk][j].z + hn[tk][j].w * hn[tk][j].w); }
            const float rstd = 1.0f / sqrtf(wave_sum(s) * (1.f / DM) + EPS);
            GAS u32x2* o8 = (GAS u32x2*)(h2 + t * DM) + lane;
#pragma unroll
            for (int j = 0; j < 4; ++j) { hn[tk][j] = hn[tk][j] * rstd * gg[j]; u32x2 o; o.x = pk2(hn[tk][j].x, hn[tk][j].y); o.y = pk2(hn[tk][j].z, hn[tk][j].w); o8[64 * j] = o; }
        }
        f32x2 hp[4][4];
#pragma unroll
        for (int j = 0; j < 4; ++j)
#pragma unroll
            for (int c = 0; c < 4; ++c) hp[j][c] = (f32x2){hn[0][j][c], hn[1][j][c]};
        float acc[2][32];
        const LAS float* wl = Wr + 4 * lane; asm volatile("" : "+v"(wl));
#pragma unroll
        for (int e = 0; e < 32; ++e) {
            f32x2 a2 = (f32x2){0.f, 0.f};
#pragma unroll
            for (int j = 0; j < 4; ++j) { const f32x4 w = *(const LAS f32x4*)(wl + e * RL_WR_STRIDE + 256 * j);
#pragma unroll
                for (int c = 0; c < 4; ++c) a2 = __builtin_elementwise_fma(hp[j][c], (f32x2){w[c], w[c]}, a2); }
            asm volatile("" : "+v"(a2));
            acc[0][e] = a2.x; acc[1][e] = a2.y;
        }
#pragma unroll
        for (int tk = 0; tk < 2; ++tk) {
            float v16[16], v8[8], v4[4], v2[2];
            const bool b3 = (lane & 8) != 0, b2 = (lane & 4) != 0, b1 = (lane & 2) != 0;
#pragma unroll
            for (int i = 0; i < 16; ++i) { const auto rr = __builtin_amdgcn_permlane32_swap(__float_as_uint(acc[tk][i]), __float_as_uint(acc[tk][16 + i]), false, false); v16[i] = __uint_as_float(rr[0]) + __uint_as_float(rr[1]); }
#pragma unroll
            for (int i = 0; i < 8; ++i) { const auto rr = __builtin_amdgcn_permlane16_swap(__float_as_uint(v16[i]), __float_as_uint(v16[8 + i]), false, false); v8[i] = __uint_as_float(rr[0]) + __uint_as_float(rr[1]); }
#pragma unroll
            for (int i = 0; i < 4; ++i) { const float mine = b3 ? v8[4 + i] : v8[i], oth = b3 ? v8[i] : v8[4 + i]; v4[i] = mine + dpp_f<0x128>(oth); }
#pragma unroll
            for (int i = 0; i < 2; ++i) { const float mine = b2 ? v4[2 + i] : v4[i], oth = b2 ? v4[i] : v4[2 + i]; v2[i] = mine + dpp_f<0x141>(oth); }
            float v1; { const float mine = b1 ? v2[1] : v2[0], oth = b1 ? v2[0] : v2[1]; v1 = mine + dpp_f<0x4E>(oth); }
            const float val = v1 + dpp_f<0xB1>(v1) + bias_e;
            const int e = lane >> 1;
            int rank = 0;
#pragma unroll
            for (int e2 = 0; e2 < 32; ++e2) { const float sv = __builtin_bit_cast(float, __builtin_amdgcn_readlane(__builtin_bit_cast(int, val), 2 * e2)); rank += ((sv > val) || (sv == val && e2 < e)) ? 1 : 0; }
            float tv[4]; int te[4];
#pragma unroll
            for (int k = 0; k < 4; ++k) { const unsigned long long bm = __ballot(rank == k && !(lane & 1)); const int src = (int)__builtin_ctzll(bm);
                tv[k] = __builtin_bit_cast(float, __builtin_amdgcn_readlane(__builtin_bit_cast(int, val), src)); te[k] = src >> 1; }
            const float e1 = __expf(tv[1] - tv[0]), e2x = __expf(tv[2] - tv[0]), e3 = __expf(tv[3] - tv[0]);
            const float inv = 1.0f / (1.0f + e1 + e2x + e3);
            const float gate[4] = {inv, e1 * inv, e2x * inv, e3 * inv};
            const int tl = tl0 + tk;
#pragma unroll
            for (int k = 0; k < 4; ++k) if (lane == k) { tke[tl * 4 + k] = te[k]; tkw[tl * 4 + k] = gate[k];
                __hip_atomic_fetch_add((LAS unsigned*)F.MISC + MW_LCNT + te[k], 1u, __ATOMIC_RELAXED, __HIP_MEMORY_SCOPE_WORKGROUP); }
        }
    }
    __syncthreads();
    if (tid < 32) ((int*)(F.ws + WS_BLKCNT))[F.blk * 32 + tid] = (int)F.MISC[MW_LCNT + tid];
}
__device__ __forceinline__ void p10_assign(Frame& F) {
    const int tid = F.tid;
    const int* blkcnt = (const int*)(F.ws + WS_BLKCNT);
    LAS int* part = (LAS int*)(F.lds);
    LAS int* tke = (LAS int*)(F.lds + RL_TKE); LAS float* tkw = (LAS float*)(F.lds + RL_TKW);
    { const int e = tid & 31, p = tid >> 5; int tot = 0, bef = 0;
      for (int j = 0; j < 16; ++j) { const int bl = p * 16 + j; const int c = blkcnt[bl * 32 + e]; tot += c; bef += (bl < F.blk) ? c : 0; }
      part[p * 32 + e] = tot; part[512 + p * 32 + e] = bef; }
    __syncthreads();
    if (tid < 32) { int tot = 0, bef = 0;
        for (int p = 0; p < 16; ++p) { tot += part[p * 32 + tid]; bef += part[512 + p * 32 + tid]; }
        part[1024 + tid] = tot; F.MISC[MW_BEFORE + tid] = (unsigned)bef; F.MISC[MW_LCNT + tid] = 0u; }
    __syncthreads();
    if (tid == 0) { int ps = 0;
        for (int e = 0; e < 32; ++e) { F.MISC[MW_PSTART + e] = (unsigned)ps; F.MISC[MW_TSTART + e] = (unsigned)(ps >> 8); ps += (part[1024 + e] + 255) & ~255; }
        F.MISC[MW_PSTART + 32] = (unsigned)ps; F.MISC[MW_TSTART + 32] = (unsigned)(ps >> 8); }
    __syncthreads();
    int* slot_tok = (int*)(F.ws + WS_SLOT_TOK); float* slot_w = (float*)(F.ws + WS_SLOT_W);
    for (int idx = tid; idx < 1024; idx += NWAVES * 64) {
        const int e = tke[idx]; const float w = tkw[idx];
        const unsigned r = __hip_atomic_fetch_add((LAS unsigned*)F.MISC + MW_LCNT + e, 1u, __ATOMIC_RELAXED, __HIP_MEMORY_SCOPE_WORKGROUP);
        const unsigned pos = F.MISC[MW_PSTART + e] + F.MISC[MW_BEFORE + e] + r;
        slot_tok[pos] = F.blk * 256 + (idx >> 2); slot_w[pos] = w;
    }
}

#ifndef MK_ONE_LAUNCH
#define MK_ONE_LAUNCH 1
#endif
constexpr int N_PHASES = 13;
struct Args { const float* in[21]; float* out; unsigned char* ws; int ph_lo, ph_hi; };
static_assert(sizeof(Args) == 21 * 8 + 8 + 8 + 8, "no padding");

__global__ void __launch_bounds__(NWAVES * 64, 2) fwd_kernel(Args args) {
    extern __shared__ __attribute__((aligned(16))) unsigned char lds[];
    Frame F;
    F.lds = (LAS unsigned char*)lds;
    F.MISC = (volatile LAS unsigned*)(F.lds + MISC_OFF);
    F.tid = threadIdx.x; F.lane = F.tid & 63; F.wave = __builtin_amdgcn_readfirstlane(F.tid >> 6);
    F.G = gridDim.x; F.blk = blockIdx.x;
    F.ws = args.ws; F.out = args.out; F.ctl = (gu32*)(args.ws + WS_CTL);
#pragma unroll
    for (int i = 0; i < 21; ++i) F.in[i] = args.in[i];
    for (int u = F.tid; u < (LDS_BYTES - MISC_OFF) / 4; u += NWAVES * 64) ((LAS unsigned*)(F.lds + MISC_OFF))[u] = 0u;
    __syncthreads();
    const int lo = args.ph_lo, hi = args.ph_hi;
    XcdBarrier bar; bar.bar = (unsigned*)(F.ctl + CW_BAR); bar.x = 0; bar.st = nullptr;
    if (hi - lo > 1) bar = xcd_barrier_post((unsigned*)(F.ctl + CW_BAR), F.MISC + MW_BAR);
#ifndef PH_MASK
#define PH_MASK 0x1fff
#endif
#define IN(k) (((PH_MASK >> (k)) & 1) && lo <= (k) && (k) < hi)
#ifndef REP_MASK
#define REP_MASK 0
#endif
#define NREP(k) (1 + ((REP_MASK >> (k)) & 1))
#define SEAM(k) do { if (IN(k) && IN((k) + 1)) xcd_barrier(bar); } while (0)
    unsigned char* ws = args.ws;
    bf16_t* proj = (bf16_t*)(ws + WS_P);

    if (IN(0)) for (int rep = 0; rep < NREP(0); ++rep) { if (rep) xcd_barrier(bar); p0_prologue(F); } SEAM(0);

    if (IN(1)) {
        { pg8::DenseSched S; S.init(ws + WS_H, ws + WS_WIN, NTOK, PW, DM, F.G, F.blk);
          pg8::EpiBf16<0> E{proj, PW, nullptr};
          pg8::gemm_phase<pg8::EpiBf16<0>, pg8::DenseSched, true>(F.lds, DM, S, E); }
        { pg8::DenseSched S; S.init(ws + WS_MEMN, ws + WS_WMKV, NMEM, DM, DM, F.G, F.blk);
          pg8::EpiBf16<0> E{(bf16_t*)(ws + WS_MKV), DM, nullptr};
          pg8::gemm_phase<pg8::EpiBf16<0>, pg8::DenseSched, true>(F.lds, DM, S, E); }
    } SEAM(1);

    if (IN(2)) { if (REP_MASK & 4) { p2_prep(F, true); xcd_barrier(bar); } p2_prep(F); } SEAM(2);

    if (IN(3)) {
        bf16_t* osb = (bf16_t*)(ws + WS_O); bf16_t* odsa = osb + (size_t)NTOK * 512; bf16_t* omem = odsa + (size_t)NTOK * 512;
#ifndef REP_DSA
#define REP_DSA 1
#endif
#ifndef REP_SB
#define REP_SB 1
#endif
#ifndef REP_MEM
#define REP_MEM 1
#endif
#ifndef NO_DSA
        for (int rep = 0; rep < REP_DSA; ++rep)
        for (int i = 0; i < 4; ++i) { const int p = 2 * F.blk + (i >> 1), b = p >> 4, cc = p & 15, c = (i & 1) ? 31 - cc : cc; dsa_unit(proj, odsa, b, c, F.lds, F.tid); }
#endif
        const int gw = F.blk * NWAVES + F.wave, NGW = F.G * NWAVES;
#ifndef NO_SB
        for (int rep = 0; rep < REP_SB; ++rep)
        for (int it = gw; it < NB * 8 * 64; it += NGW) { const int qblk = 63 - (it >> 8), bh = it & 255; sb_item(proj, osb, bh >> 3, bh & 7, qblk, F.lds + F.wave * 4096, F.lane); }
#endif
#ifndef NO_MEM
        for (int rep = 0; rep < REP_MEM; ++rep) {
            __syncthreads();
            for (int u = F.blk; u < NB * 4 * 2; u += F.G) mem_unit(proj, (const bf16_t*)(ws + WS_MKV), omem, u >> 3, (u >> 1) & 3, u & 1, F.lds, F.tid);
        }
#endif
    } SEAM(3);

    if (IN(4)) {
        pg8::DenseSched S; S.init(ws + WS_H, ws + WS_WG, NTOK, 3 * DM, DM, F.G, F.blk);
        pg8::EpiBf16<2> E{proj, PW, F.in[11]};
        pg8::gemm_phase<pg8::EpiBf16<2>, pg8::DenseSched, true>(F.lds, DM, S, E);
    } SEAM(4);

    if (IN(5)) {
 pg8::DenseSched S; S.init(ws + WS_O, ws + WS_WB, NTOK, DM, 512, F.G, F.blk);
        pg8::EpiMerge E{proj, 0, (bf16_t*)(ws + WS_H), 1};
        pg8::gemm_phase<pg8::EpiMerge, pg8::DenseSched, true>(F.lds, 512, S, E); } SEAM(5);
    if (IN(6)) { pg8::DenseSched S; S.init(ws + WS_O + (size_t)NTOK * 1024, ws + WS_WB + (size_t)DM * 1024, NTOK, DM, 512, F.G, F.blk);
        pg8::EpiMerge E{proj, DM, (bf16_t*)(ws + WS_H), 0};
        pg8::gemm_phase<pg8::EpiMerge, pg8::DenseSched, true>(F.lds, 512, S, E); } SEAM(6);
    if (IN(7)) { pg8::DenseSched S; S.init(ws + WS_O + (size_t)NTOK * 2048, ws + WS_WB + (size_t)DM * 2048, NTOK, DM, 512, F.G, F.blk);
        pg8::EpiMerge E{proj, 2 * DM, (bf16_t*)(ws + WS_H), 0};
        pg8::gemm_phase<pg8::EpiMerge, pg8::DenseSched, true>(F.lds, 512, S, E); } SEAM(7);

    if (IN(8)) {
        pg8::DenseSched S; S.init(ws + WS_H, ws + WS_WO, NTOK, DM, DM, F.G, F.blk);
        pg8::EpiResid E{F.in[0], F.out};
        pg8::gemm_phase<pg8::EpiResid, pg8::DenseSched, true>(F.lds, DM, S, E);
    } SEAM(8);

    if (IN(9)) for (int rep = 0; rep < NREP(9); ++rep) { if (rep) xcd_barrier(bar); p9_router(F); } SEAM(9);
    if (IN(10)) for (int rep = 0; rep < NREP(10); ++rep) { if (rep) xcd_barrier(bar); p10_assign(F); } SEAM(10);

    if (IN(11)) for (int rep = 0; rep < NREP(11); ++rep) {  if (rep) xcd_barrier(bar);
        pg8::MoeSched S{(const char*)(ws + WS_H), (const char*)(ws + WS_WEI), (const int*)(ws + WS_SLOT_TOK), F.MISC + MW_TSTART, DM, 2048, 8, F.blk};
        pg8::EpiSwiglu E{(bf16_t*)(ws + WS_P), F.in[18]};
        pg8::gemm_phase<pg8::EpiSwiglu, pg8::MoeSched, true>(F.lds, DM, S, E);
    } SEAM(11);

    if (IN(12)) {
        pg8::MoeSched S{(const char*)(ws + WS_P), (const char*)(ws + WS_WEO), nullptr, F.MISC + MW_TSTART, DM, DM, 4, F.blk};
        pg8::EpiScatter E{F.out, (const int*)(ws + WS_SLOT_TOK), (const float*)(ws + WS_SLOT_W), F.in[20], F.lds};
        pg8::gemm_phase<pg8::EpiScatter, pg8::MoeSched, true>(F.lds, DM, S, E);
    }
#undef IN
#undef SEAM
}

extern "C" void kernel_launch(void* const* d_in, const int* in_sizes, int n_in, void* d_out, int out_size, void* d_ws, size_t ws_size, hipStream_t stream) {
    static int grid = 0;
    if (grid == 0) {
        if (n_in != 21 || in_sizes[0] != NTOK * DM || out_size != NTOK * DM || ws_size < WS_END) {
            fprintf(stderr, "kernel_launch: unexpected shapes: n_in %d in0 %d out %d ws %zu (need >= %zu); nothing launched\n", n_in, n_in > 0 ? in_sizes[0] : -1, out_size, ws_size, (size_t)WS_END); grid = -1; return; }
        int dev = 0, cus = 0, per_cu = 0;
        if (hipGetDevice(&dev) != hipSuccess || hipDeviceGetAttribute(&cus, hipDeviceAttributeMultiprocessorCount, dev) != hipSuccess) { fprintf(stderr, "kernel_launch: device query failed\n"); grid = -1; return; }
        if (hipFuncSetAttribute((const void*)fwd_kernel, hipFuncAttributeMaxDynamicSharedMemorySize, LDS_BYTES) != hipSuccess) { fprintf(stderr, "kernel_launch: hipFuncSetAttribute failed\n"); grid = -1; return; }
        if (hipOccupancyMaxActiveBlocksPerMultiprocessor(&per_cu, (const void*)fwd_kernel, NWAVES * 64, LDS_BYTES) != hipSuccess || per_cu < 1)
            fprintf(stderr, "kernel_launch: note: occupancy query reports %d workgroups per CU\n", per_cu);
        (void)hipGetLastError();
        grid = cus;
        if (grid != 256) { fprintf(stderr, "kernel_launch: this kernel is built for 256 CUs (got %d); nothing launched\n", grid); grid = -1; return; }
    }
    if (grid < 0) return;
    if (hipMemsetAsync((char*)d_ws + WS_CTL, 0, CTL_ZERO_BYTES, stream) != hipSuccess) { fprintf(stderr, "kernel_launch: hipMemsetAsync failed\n"); return; }
    Args a{};
    for (int i = 0; i < 21; ++i) a.in[i] = (const float*)d_in[i];
    a.out = (float*)d_out; a.ws = (unsigned char*)d_ws;
#if MK_ONE_LAUNCH
    const int cuts[2] = {0, N_PHASES}; const int nl = 1;
#else
    const int cuts[11] = {0, 1, 2, 3, 4, 5, 6, 7, 8, 9, N_PHASES}; const int nl = 10;
#endif
    for (int li = 0; li < nl; ++li) {
        a.ph_lo = cuts[li]; a.ph_hi = cuts[li + 1];
        hipLaunchKernelGGL(fwd_kernel, dim3(grid), dim3(NWAVES * 64), LDS_BYTES, stream, a);
        const hipError_t le = hipPeekAtLastError();
        if (le != hipSuccess) { fprintf(stderr, "kernel_launch: launch %d failed: %s\n", li, hipGetErrorName(le)); break; }
    }
}
```

```cpp
#include <hip/hip_runtime.h>
#include <cstdio>
#include <cstdint>

#define LAS __attribute__((address_space(3)))
#define GAS __attribute__((address_space(1)))
typedef unsigned short bf16_t;
typedef short bf16x8 __attribute__((ext_vector_type(8)));
typedef short s16x4 __attribute__((ext_vector_type(4)));
typedef short v4i16_t __attribute__((ext_vector_type(4)));
typedef float f32x2 __attribute__((ext_vector_type(2)));
typedef float f32x4 __attribute__((ext_vector_type(4)));
typedef float f32x16 __attribute__((ext_vector_type(16)));
typedef unsigned u32x2 __attribute__((ext_vector_type(2)));
typedef unsigned u32x4 __attribute__((ext_vector_type(4)));
typedef GAS unsigned gu32;

constexpr int NB = 32, SEQ = 2048, DM = 1024, NTOK = NB * SEQ;
constexpr int MEMLEN = 256, NMEM = NB * MEMLEN;
constexpr int PW = 3072;
constexpr int C_SQ = 0, C_SK = 512, C_SV = 1024, C_DQ = 1536, C_DK = 2048, C_DV = 2112, C_IQ = 2176, C_IK = 2432, C_IW = 2496, C_MQ = 2560;
constexpr int IN_W = 3012;
constexpr int NEXP = 32, TOPK = 4, DEXP = 1024;
constexpr int NSLOT = NTOK * TOPK;
constexpr int NSLOT_PAD = NSLOT + NEXP * 256;
constexpr float EPS = 1e-6f;
constexpr float LOG2E = 1.4426950408889634f;

constexpr size_t MiB = 1u << 20;
constexpr size_t WS_CTL = 0, CTL_ZERO_BYTES = 1 * MiB;
constexpr size_t WS_ROPE = 1 * MiB;
constexpr size_t WS_BLKCNT = 1 * MiB + 512 * 1024;
constexpr size_t WS_SLOT_TOK = 2 * MiB;
constexpr size_t WS_SLOT_W = 4 * MiB;
constexpr size_t WS_WIN = 8 * MiB;
constexpr size_t WS_WMKV = 14 * MiB;
constexpr size_t WS_WG = 16 * MiB;
constexpr size_t WS_WB = 22 * MiB;
constexpr size_t WS_WO = 25 * MiB;
constexpr size_t WS_WEI = 27 * MiB;
constexpr size_t WS_WEO = 155 * MiB;
constexpr size_t WS_H = 220 * MiB;
constexpr size_t WS_P = 348 * MiB;
constexpr size_t WS_O = 732 * MiB;
constexpr size_t WS_MEMN = 924 * MiB;
constexpr size_t WS_MKV = 940 * MiB;
constexpr size_t WS_END = 956 * MiB;
static_assert(WS_P + (size_t)NSLOT_PAD * DEXP * 2 <= WS_MEMN, "act overlays proj|o");
static_assert(WS_SLOT_TOK + (size_t)NSLOT_PAD * 4 <= WS_SLOT_W && WS_SLOT_W + (size_t)NSLOT_PAD * 4 <= WS_WIN, "slot tables");

constexpr int CW_BAR = 4096;

constexpr int RING_BYTES = 151552;
constexpr int MISC_OFF = RING_BYTES;
constexpr int LDS_BYTES = 155648;
constexpr int MW_BAR = 8;
constexpr int MW_LCNT = 16;
constexpr int MW_PSTART = 64;
constexpr int MW_TSTART = 128;
constexpr int MW_BEFORE = 192;
constexpr int MW_PART = 256;

__device__ __forceinline__ unsigned f2bf(float f) { unsigned u = __builtin_bit_cast(unsigned, f); return (u + 0x7fffu + ((u >> 16) & 1u)) >> 16; }
__device__ __forceinline__ unsigned pk2(float lo, float hi) { return f2bf(lo) | (f2bf(hi) << 16); }
__device__ __forceinline__ float bf2f(unsigned short b) { return __builtin_bit_cast(float, (unsigned)b << 16); }
__device__ __forceinline__ float bflo(unsigned w) { return __builtin_bit_cast(float, w << 16); }
__device__ __forceinline__ float bfhi(unsigned w) { return __builtin_bit_cast(float, w & 0xffff0000u); }
__device__ __forceinline__ unsigned cvt_pk_bf16(float lo, float hi) { unsigned r; asm volatile("v_cvt_pk_bf16_f32 %0, %1, %2" : "=v"(r) : "v"(lo), "v"(hi)); return r; }
__device__ __forceinline__ int crow(int r, int hi) { return (r & 3) + 8 * (r >> 2) + 4 * hi; }
#define LDS_WAIT() asm volatile("s_waitcnt lgkmcnt(0)" ::: "memory")
#define VM_WAIT() asm volatile("s_waitcnt vmcnt(0)" ::: "memory")

namespace pg8 {
constexpr int BM = 256, BK = 64, HALF = 128, HTB = HALF * BK * 2, STAGE_BYTES = 8 * HTB;
__host__ __device__ __forceinline__ int lds_byte(int r, int c) { const int st = (r >> 4) * 2 + (c >> 5), rr = r & 15, cc = c & 31, ob = rr * 64 + cc * 2; return st * 1024 + (ob ^ (((ob >> 9) & 1) << 5)); }
__host__ __device__ __forceinline__ void stage_rc(int b, int& R, int& C) { const int st = b / 1024, sb = b % 1024, swz = sb ^ (((sb >> 9) & 1) << 5); R = (st >> 1) * 16 + swz / 64; C = (st & 1) * 32 + (swz % 64) / 2; }
__host__ __device__ __forceinline__ int perm32(int rho) { const int n = rho >> 4, i = rho & 15; return 8 * (i >> 2) + 4 * n + (i & 3); }

struct Unit { int pm, pn, e; };

template <class Epi, class Sched, bool ALIGN_EPI>
__device__ __forceinline__ void gemm_phase(LAS unsigned char* lds, const int K, const Sched& S, const Epi& E) {
    const int tid = threadIdx.x, wid = __builtin_amdgcn_readfirstlane(tid >> 6), lane = tid & 63, wr = wid >> 2, wc = wid & 3, fr = lane & 15, fq = lane >> 4;
    const int nt = K / BK;
    int Rr[2], Cc[2]; unsigned voffB[2];
#pragma unroll
    for (int i = 0; i < 2; ++i) { int R, C; stage_rc(tid * 16 + i * 8192, R, C); Rr[i] = R; Cc[i] = C; const int Rb = Epi::PERM ? ((R & ~31) + perm32(R & 31)) : R; voffB[i] = (unsigned)(Rb * K + C) * 2u; }
    const size_t kstep = (size_t)(BK * 2);
    const size_t hstepB = (size_t)HALF * K * 2;
    const unsigned ldsw = (unsigned)wid * 1024u;
    const int aoff = lds_byte(wr * 64 + fr, fq * 8), boff = lds_byte(wc * 32 + fr, fq * 8);
#define PG8_SA(b, h) (((b) * 2 + (h)) * HTB)
#define PG8_SB(b, h) ((4 + (b) * 2 + (h)) * HTB)
#define PG8_STAGE(bufoff, gbase, voff) do { _Pragma("unroll") for (int _i = 0; _i < 2; ++_i) \
        __builtin_amdgcn_global_load_lds((const unsigned*)((const char*)(gbase) + (voff)[_i]), (LAS unsigned*)(lds + (bufoff) + ldsw + _i * 8192), 16, 0, 0); } while (0)
#define PG8_LDA(dst, b, h) do { _Pragma("unroll") for (int m = 0; m < 4; ++m) _Pragma("unroll") for (int k = 0; k < 2; ++k) dst[m][k] = *(const LAS bf16x8*)(lds + PG8_SA(b, h) + aoff + m * 2048 + k * 1024); } while (0)
#define PG8_LDB(dst, b, h) do { _Pragma("unroll") for (int n = 0; n < 2; ++n) _Pragma("unroll") for (int k = 0; k < 2; ++k) dst[n][k] = *(const LAS bf16x8*)(lds + PG8_SB(b, h) + boff + n * 2048 + k * 1024); } while (0)
#define PG8_MMA(ai, bj, At, Bt) do { __builtin_amdgcn_s_setprio(1); _Pragma("unroll") for (int m = 0; m < 4; ++m) _Pragma("unroll") for (int n = 0; n < 2; ++n) _Pragma("unroll") for (int k = 0; k < 2; ++k) \
        acc[ai][bj][m][n] = __builtin_amdgcn_mfma_f32_16x16x32_bf16(Bt[n][k], At[m][k], acc[ai][bj][m][n], 0, 0, 0); __builtin_amdgcn_s_setprio(0); } while (0)
#define PG8_WAIT_V(n) asm volatile("s_waitcnt vmcnt(" #n ")" ::: "memory")
#define PG8_WAIT_L(n) asm volatile("s_waitcnt lgkmcnt(" #n ")" ::: "memory")
#define PG8_BAR __builtin_amdgcn_s_barrier()
#define PG8_SCHED __builtin_amdgcn_sched_barrier(0)
    Unit cur, nxt; int ui = 0;
    if (!S.next(0, cur)) return;
    { const int ns = S.stagger();
      for (int q = 0; q < ns; ++q) __builtin_amdgcn_s_sleep(4); }
    f32x4 acc[2][2][4][2];
#pragma unroll
    for (int a = 0; a < 2; ++a)
#pragma unroll
        for (int b = 0; b < 2; ++b)
#pragma unroll
            for (int m = 0; m < 4; ++m)
#pragma unroll
                for (int n = 0; n < 2; ++n) acc[a][b][m][n] = (f32x4){0.f, 0.f, 0.f, 0.f};
    bf16x8 At[4][2], B0[2][2], B1[2][2];
    const char* Ab = S.a_base();
    unsigned ca0[2], ca1[2], na0[2], na1[2];
#pragma unroll
    for (int i = 0; i < 2; ++i) { ca0[i] = S.a_off(cur, Rr[i], Cc[i]); ca1[i] = S.a_off(cur, HALF + Rr[i], Cc[i]); }
    const char* cB = S.b_tile(cur);
    PG8_STAGE(PG8_SB(0, 0), cB, voffB); PG8_STAGE(PG8_SB(0, 1), cB + hstepB, voffB); PG8_STAGE(PG8_SA(0, 0), Ab, ca0); PG8_STAGE(PG8_SA(0, 1), Ab, ca1);
    if (wr == 1) PG8_BAR;
    PG8_WAIT_V(2); PG8_BAR;
    PG8_STAGE(PG8_SB(1, 0), cB + kstep, voffB); PG8_STAGE(PG8_SA(1, 0), Ab + kstep, ca0); PG8_STAGE(PG8_SB(1, 1), cB + hstepB + kstep, voffB);
    PG8_WAIT_V(6); PG8_BAR;
    for (;;) {
        typename Epi::Pre pre = E.preload(cur, wr, wc, fr, fq);
        const bool has_next = S.next(ui + 1, nxt);
        const char* nB = cB;
#pragma unroll
        for (int i = 0; i < 2; ++i) { na0[i] = ca0[i]; na1[i] = ca1[i]; }
        if (has_next) { nB = S.b_tile(nxt);
#pragma unroll
            for (int i = 0; i < 2; ++i) { na0[i] = S.a_off(nxt, Rr[i], Cc[i]); na1[i] = S.a_off(nxt, HALF + Rr[i], Cc[i]); } }
        for (int t = 0; t < nt; t += 2) {
            const bool last = (t == nt - 2);
            const char* a1 = Ab + (size_t)(t + 1) * kstep;
            const char* a2 = last ? Ab : Ab + (size_t)(t + 2) * kstep; const char* b2 = last ? nB : cB + (size_t)(t + 2) * kstep;
            const char* a3 = a2 + kstep; const char* b3 = b2 + kstep;
            unsigned o20[2], o21[2];
#pragma unroll
            for (int i = 0; i < 2; ++i) { o20[i] = last ? na0[i] : ca0[i]; o21[i] = last ? na1[i] : ca1[i]; }
            PG8_LDB(B0, 0, 0); PG8_LDB(B1, 0, 1); PG8_SCHED; PG8_LDA(At, 0, 0); PG8_STAGE(PG8_SA(1, 1), a1, ca1);
            PG8_WAIT_V(8); PG8_WAIT_L(0); PG8_BAR; PG8_MMA(0, 0, At, B0); PG8_MMA(0, 1, At, B1); PG8_BAR; PG8_SCHED;
            PG8_LDA(At, 0, 1); PG8_STAGE(PG8_SB(0, 0), b2, voffB); PG8_STAGE(PG8_SB(0, 1), b2 + hstepB, voffB); PG8_STAGE(PG8_SA(0, 0), a2, o20);
            PG8_WAIT_V(8); PG8_WAIT_L(0); PG8_BAR; PG8_MMA(1, 0, At, B0); PG8_MMA(1, 1, At, B1); PG8_BAR; PG8_SCHED;
            PG8_LDB(B0, 1, 0); PG8_LDB(B1, 1, 1); PG8_SCHED; PG8_LDA(At, 1, 0); PG8_STAGE(PG8_SA(0, 1), a2, o21);
            PG8_WAIT_V(8); PG8_WAIT_L(0); PG8_BAR; PG8_MMA(0, 0, At, B0); PG8_MMA(0, 1, At, B1); PG8_BAR; PG8_SCHED;
            PG8_LDA(At, 1, 1); PG8_STAGE(PG8_SB(1, 0), b3, voffB); PG8_STAGE(PG8_SB(1, 1), b3 + hstepB, voffB); PG8_STAGE(PG8_SA(1, 0), a3, o20);
            PG8_WAIT_V(8); PG8_WAIT_L(0); PG8_BAR; PG8_MMA(1, 0, At, B0); PG8_MMA(1, 1, At, B1); PG8_BAR; PG8_SCHED;
        }
        if constexpr (ALIGN_EPI) { if (wr == 0) PG8_BAR; }
        E(acc, cur, wr, wc, fr, fq, pre);
        if (!has_next) break;
#pragma unroll
        for (int a = 0; a < 2; ++a)
#pragma unroll
            for (int b = 0; b < 2; ++b)
#pragma unroll
                for (int m = 0; m < 4; ++m)
#pragma unroll
                    for (int n = 0; n < 2; ++n) acc[a][b][m][n] = (f32x4){0.f, 0.f, 0.f, 0.f};
        cur = nxt; cB = nB; ++ui;
#pragma unroll
        for (int i = 0; i < 2; ++i) { ca0[i] = na0[i]; ca1[i] = na1[i]; }
        if constexpr (ALIGN_EPI) { if (wr == 1) PG8_BAR; }
    }
    PG8_WAIT_V(0);
    if constexpr (!ALIGN_EPI) { if (wr == 0) PG8_BAR; }
    PG8_BAR;
#undef PG8_SA
#undef PG8_SB
#undef PG8_STAGE
#undef PG8_LDA
#undef PG8_LDB
#undef PG8_MMA
#undef PG8_WAIT_V
#undef PG8_WAIT_L
#undef PG8_BAR
#undef PG8_SCHED
}

struct DenseSched {
    const char* A; const char* Bt; int K, nM, nN, nwg, G, c;
    __device__ __forceinline__ void init(const void* A_, const void* Bt_, int M, int N, int K_, int G_, int c_) { A = (const char*)A_; Bt = (const char*)Bt_; K = K_; nM = M / BM; nN = N / BM; nwg = nM * nN; G = G_; c = c_; }
    __device__ __forceinline__ bool next(int i, Unit& u) const {
        const long L = (long)i * G + c; if (L >= nwg) return false;
        int wgid = (int)L; { const int q = nwg / 8, r = nwg % 8, xcd = wgid % 8, off = wgid / 8; wgid = (xcd < r ? xcd * (q + 1) : r * (q + 1) + (xcd - r) * q) + off; }
        const int nig = 8 * nN, gid = wgid / nig, fm = gid * 8, gsz = (nM - fm) < 8 ? (nM - fm) : 8;
        u.pm = fm + ((wgid % nig) % gsz); u.pn = (wgid % nig) / gsz; u.e = 0; return true;
    }
    __device__ __forceinline__ const char* a_base() const { return A; }
    __device__ __forceinline__ int stagger() const { return 0; }
    __device__ __forceinline__ unsigned a_off(const Unit& u, int row, int col) const { return (unsigned)(((size_t)(u.pm * BM + row) * K + col) * 2); }
    __device__ __forceinline__ const char* b_tile(const Unit& u) const { return Bt + (size_t)u.pn * BM * K * 2; }
};
}

namespace pg8 {
struct MoeSched {
    const char* A; const char* Bt; const int* slot_tok; volatile LAS unsigned* tstart; int K, rowsE, nN, c;
    __device__ __forceinline__ bool next(int i, Unit& u) const {
        const int x = c & 7, j = c >> 3, rpr = 32 / nN;
        const int pm = (i * 8 + x) * rpr + j / nN;
        const int T = (int)tstart[32];
        if (pm >= T) return false;
        int e = 0;
#pragma unroll 1
        for (int k = 1; k < 32; ++k) e += ((int)tstart[k] <= pm) ? 1 : 0;
        u.pm = pm; u.pn = j % nN; u.e = __builtin_amdgcn_readfirstlane(e); return true;
    }
    __device__ __forceinline__ const char* a_base() const { return A; }
    __device__ __forceinline__ int stagger() const { const int g = (c >> 3) / nN, ng = 32 / nN; (void)g; (void)ng; return 0; }
    __device__ __forceinline__ unsigned a_off(const Unit& u, int row, int col) const {
        const int pos = u.pm * BM + row;
        const int r = slot_tok ? slot_tok[pos] : pos;
        return (unsigned)(((size_t)r * K + col) * 2);
    }
    __device__ __forceinline__ const char* b_tile(const Unit& u) const { return Bt + ((size_t)u.e * rowsE + (size_t)u.pn * BM) * K * 2; }
};

struct NoPre {};
template <int ACT> struct EpiBf16 {
    static constexpr bool PERM = true;
    typedef NoPre Pre; __device__ __forceinline__ Pre preload(const Unit&, int, int, int, int) const { return Pre{}; }
    bf16_t* O; int ldc; const float* bias;
    __device__ __forceinline__ void operator()(const f32x4 (&acc)[2][2][4][2], const Unit& u, int wr, int wc, int fr, int fq, const Pre&) const {
        const int row0 = u.pm * BM + wr * 64 + fr; const int col0 = u.pn * BM + wc * 32 + 8 * fq;
        f32x4 bv[2][2];
#pragma unroll
        for (int bj = 0; bj < 2; ++bj)
#pragma unroll
            for (int n = 0; n < 2; ++n) bv[bj][n] = bias ? *(const f32x4*)(bias + col0 + bj * HALF + 4 * n) : (f32x4){0.f, 0.f, 0.f, 0.f};
#pragma unroll
        for (int ai = 0; ai < 2; ++ai)
#pragma unroll
            for (int m = 0; m < 4; ++m) { bf16_t* rowp = O + (size_t)(row0 + ai * HALF + m * 16) * ldc + col0;
#pragma unroll
                for (int bj = 0; bj < 2; ++bj) { f32x4 v0 = acc[ai][bj][m][0] + bv[bj][0], v1 = acc[ai][bj][m][1] + bv[bj][1];
                    if (ACT == 2) {
#pragma unroll
                        for (int q = 0; q < 4; ++q) { v0[q] = __builtin_amdgcn_rcpf(1.f + __builtin_amdgcn_exp2f(-LOG2E * v0[q])); v1[q] = __builtin_amdgcn_rcpf(1.f + __builtin_amdgcn_exp2f(-LOG2E * v1[q])); } }
                    u32x4 w; w.x = cvt_pk_bf16(v0[0], v0[1]); w.y = cvt_pk_bf16(v0[2], v0[3]); w.z = cvt_pk_bf16(v1[0], v1[1]); w.w = cvt_pk_bf16(v1[2], v1[3]);
                    *(u32x4*)(rowp + bj * HALF) = w; } }
    }
};
struct EpiMerge {
    static constexpr bool PERM = true;
    typedef NoPre Pre; __device__ __forceinline__ Pre preload(const Unit&, int, int, int, int) const { return Pre{}; }
    const bf16_t* G; int goff; bf16_t* Mg; int first;
    __device__ __forceinline__ void operator()(const f32x4 (&acc)[2][2][4][2], const Unit& u, int wr, int wc, int fr, int fq, const Pre&) const {
        const int row0 = u.pm * BM + wr * 64 + fr; const int col0 = u.pn * BM + wc * 32 + 8 * fq;
#pragma unroll
        for (int ai = 0; ai < 2; ++ai)
#pragma unroll
            for (int m = 0; m < 4; ++m) { const size_t row = (size_t)(row0 + ai * HALF + m * 16);
#pragma unroll
                for (int bj = 0; bj < 2; ++bj) {
                    const u32x4 g = *(const u32x4*)(G + row * PW + goff + col0 + bj * HALF);
                    u32x4 p = (u32x4){0u, 0u, 0u, 0u};
                    if (!first) p = *(const u32x4*)(Mg + row * DM + col0 + bj * HALF);
                    const f32x4 a0 = acc[ai][bj][m][0], a1 = acc[ai][bj][m][1];
                    u32x4 w;
                    w.x = cvt_pk_bf16(bflo(p.x) + bflo(g.x) * a0[0], bfhi(p.x) + bfhi(g.x) * a0[1]);
                    w.y = cvt_pk_bf16(bflo(p.y) + bflo(g.y) * a0[2], bfhi(p.y) + bfhi(g.y) * a0[3]);
                    w.z = cvt_pk_bf16(bflo(p.z) + bflo(g.z) * a1[0], bfhi(p.z) + bfhi(g.z) * a1[1]);
                    w.w = cvt_pk_bf16(bflo(p.w) + bflo(g.w) * a1[2], bfhi(p.w) + bfhi(g.w) * a1[3]);
                    *(u32x4*)(Mg + row * DM + col0 + bj * HALF) = w; } }
    }
};
struct EpiResid {
    static constexpr bool PERM = false;
    typedef NoPre Pre; __device__ __forceinline__ Pre preload(const Unit&, int, int, int, int) const { return Pre{}; }
    const float* base; float* out;
    __device__ __forceinline__ void operator()(const f32x4 (&acc)[2][2][4][2], const Unit& u, int wr, int wc, int fr, int fq, const Pre&) const {
        const int row0 = u.pm * BM + wr * 64 + fr; const int col0 = u.pn * BM + wc * 32 + 4 * fq;
#pragma unroll
        for (int ai = 0; ai < 2; ++ai)
#pragma unroll
            for (int m = 0; m < 4; ++m) { const size_t off = (size_t)(row0 + ai * HALF + m * 16) * DM + col0;
#pragma unroll
                for (int bj = 0; bj < 2; ++bj)
#pragma unroll
                    for (int n = 0; n < 2; ++n) { const f32x4 b = *(const f32x4*)(base + off + bj * HALF + n * 16); *(f32x4*)(out + off + bj * HALF + n * 16) = b + acc[ai][bj][m][n]; } }
    }
};
struct EpiSwiglu {
    static constexpr bool PERM = true;
    bf16_t* act; const float* bias;
    struct Pre { f32x4 bg[2], bu[2]; };
    __device__ __forceinline__ Pre preload(const Unit& u, int wr, int wc, int fr, int fq) const {
        const GAS float* be = (const GAS float*)bias + (size_t)u.e * 2048 + u.pn * HALF + wc * 32 + 8 * fq; Pre p;
#pragma unroll
        for (int n = 0; n < 2; ++n) { p.bg[n] = *(const GAS f32x4*)(be + 4 * n); p.bu[n] = *(const GAS f32x4*)(be + 1024 + 4 * n); }
        return p; }
    __device__ __forceinline__ void operator()(const f32x4 (&acc)[2][2][4][2], const Unit& u, int wr, int wc, int fr, int fq, const Pre& pre) const {
        const int row0 = u.pm * BM + wr * 64 + fr; const int col0 = u.pn * HALF + wc * 32 + 8 * fq;
        f32x4 bg[2], bu[2];
#pragma unroll
        for (int n = 0; n < 2; ++n) { bg[n] = pre.bg[n]; bu[n] = pre.bu[n]; }
#pragma unroll
        for (int ai = 0; ai < 2; ++ai)
#pragma unroll
            for (int m = 0; m < 4; ++m) { bf16_t* rowp = act + (size_t)(row0 + ai * HALF + m * 16) * DEXP + col0;
                float o[8];
#pragma unroll
                for (int n = 0; n < 2; ++n) { const f32x4 gv = acc[ai][0][m][n] + bg[n], uv = acc[ai][1][m][n] + bu[n];
#pragma unroll
                    for (int q = 0; q < 4; ++q) { const float g = fminf(gv[q], 7.0f); const float uu = fminf(fmaxf(uv[q], -7.0f), 7.0f);
                        const float sg = __builtin_amdgcn_rcpf(1.f + __builtin_amdgcn_exp2f(-1.702f * LOG2E * g));
                        o[4 * n + q] = (uu + 1.0f) * (g * sg); } }
                u32x4 w; w.x = cvt_pk_bf16(o[0], o[1]); w.y = cvt_pk_bf16(o[2], o[3]); w.z = cvt_pk_bf16(o[4], o[5]); w.w = cvt_pk_bf16(o[6], o[7]);
                *(u32x4*)rowp = w; }
    }
};
constexpr int EPI_STAGE_OFF = 131072, EPI_STAGE_WAVE = 2304;
struct EpiScatter {
    static constexpr bool PERM = false;
    typedef NoPre Pre; __device__ __forceinline__ Pre preload(const Unit&, int, int, int, int) const { return Pre{}; }
    float* out; const int* slot_tok; const float* slot_w; const float* bias; LAS unsigned char* lds;
    __device__ __forceinline__ void operator()(const f32x4 (&acc)[2][2][4][2], const Unit& u, int wr, int wc, int fr, int fq, const Pre&) const {
        const int lane = fr + 16 * fq, wid = wr * 4 + wc;
        LAS float* st = (LAS float*)(lds + EPI_STAGE_OFF + wid * EPI_STAGE_WAVE);
        const int row0 = u.pm * BM + wr * 64 + fr;
        const int lcol = lane & 31, lrow = lane >> 5;
        float bv[2];
#pragma unroll
        for (int bj = 0; bj < 2; ++bj) bv[bj] = bias[(size_t)u.e * DM + u.pn * BM + bj * HALF + wc * 32 + lcol];
#pragma unroll
        for (int ai = 0; ai < 2; ++ai)
#pragma unroll
            for (int m = 0; m < 4; ++m) { const int pos = row0 + ai * HALF + m * 16; const float w = slot_w[pos]; const int tok = slot_tok[pos];
#pragma unroll
                for (int bj = 0; bj < 2; ++bj) {
#pragma unroll
                    for (int n = 0; n < 2; ++n) *(LAS f32x4*)(st + fr * 36 + 16 * n + 4 * fq) = acc[ai][bj][m][n];
                    asm volatile("s_waitcnt lgkmcnt(0)" ::: "memory");
#pragma unroll
                    for (int i = 0; i < 8; ++i) { const int r = 2 * i + lrow; const float v = st[r * 36 + lcol];
                        const float wr_ = __shfl(w, r); const int tr_ = __shfl(tok, r);
                        if (wr_ != 0.f) unsafeAtomicAdd(out + (size_t)tr_ * DM + u.pn * BM + bj * HALF + wc * 32 + lcol, (v + bv[bj]) * wr_); }
                    asm volatile("s_waitcnt lgkmcnt(0)" ::: "memory");
                } }
    }
};
}

#define XB_TMO      128
#define XB_XCNT(j)  (256  + 64 * (j))
#define XB_XSUB(j)  (1280 + 64 * (j))
#define XB_XGEN(j)  (2304 + 64 * (j))
#define XB_TOP      3328
#define XB_TOPGEN   3392
#define XCD_BAR_WORDS 3456
#define XB_SPIN_CAP (1u << 18)

__device__ __forceinline__ unsigned xb_ld(unsigned* p)              { return __hip_atomic_load(p, __ATOMIC_RELAXED, __HIP_MEMORY_SCOPE_AGENT); }
__device__ __forceinline__ unsigned xb_add(unsigned* p, unsigned v) { return __hip_atomic_fetch_add(p, v, __ATOMIC_RELAXED, __HIP_MEMORY_SCOPE_AGENT); }
__device__ __forceinline__ unsigned xb_xcc_id() { return (unsigned)__builtin_amdgcn_s_getreg((3 << 11) | 20) & 0xFu; }
#define XB_SPIN(cond, bar) do { unsigned _sp = 0; while (cond) { __builtin_amdgcn_s_sleep(1); \
    if ((++_sp & 255u) == 0u) { if (xb_ld(&(bar)[XB_TMO])) break; if (_sp > XB_SPIN_CAP) { atomicAdd(&(bar)[XB_TMO], 1u); break; } } } } while (0)

struct XcdBarrier {
    unsigned* bar; unsigned x;
    volatile LAS unsigned* st;
};

__device__ __forceinline__ XcdBarrier xcd_barrier_post(unsigned* bar, volatile LAS unsigned* st) {
    XcdBarrier b; b.bar = bar; b.x = xb_xcc_id(); b.st = st;
    if (threadIdx.x == 0) (void)xb_add(&bar[XB_XCNT(b.x)], 1u);
    return b;
}
__device__ __forceinline__ void xcd_barrier_complete(unsigned* bar, unsigned x, unsigned& nloc, unsigned& nx) {
    const unsigned G = gridDim.x * gridDim.y * gridDim.z;
    unsigned sum, cnt, mine, sp = 0u;
    for (;;) {
        sum = 0u; cnt = 0u; mine = 0u;
#pragma unroll
        for (unsigned j = 0; j < 16; ++j) { const unsigned c = xb_ld(&bar[XB_XCNT(j)]); sum += c; cnt += (c > 0u) ? 1u : 0u; mine = (j == x) ? c : mine; }
        if (sum == G) break;
        __builtin_amdgcn_s_sleep(1);
        if ((++sp & 255u) == 0u) { if (xb_ld(&bar[XB_TMO])) break; if (sp > XB_SPIN_CAP) { atomicAdd(&bar[XB_TMO], 1u); break; } }
    }
    nloc = mine > 0u ? mine : 1u; nx = cnt > 0u ? cnt : 1u;
}

__device__ __forceinline__ void xcd_barrier(const XcdBarrier& b) {
    asm volatile("s_waitcnt vmcnt(0)" ::: "memory");
    __syncthreads();
    if (threadIdx.x == 0) {
        unsigned* bar = b.bar;
        __builtin_amdgcn_s_waitcnt(0);
        unsigned nloc = b.st[0], nx = b.st[1];
        if (nloc == 0u) { xcd_barrier_complete(bar, b.x, nloc, nx); b.st[0] = nloc; b.st[1] = nx; }
        const unsigned old = xb_add(&bar[XB_XSUB(b.x)], 1u);
        const unsigned gen = old / nloc;
        if (old + 1u == (gen + 1u) * nloc) {
            __builtin_amdgcn_fence(__ATOMIC_RELEASE, "agent");
            asm volatile("s_waitcnt vmcnt(0)" ::: "memory");
            const unsigned og = xb_add(&bar[XB_TOP], 1u);
            const unsigned tg = og / nx;
            if (og + 1u == (tg + 1u) * nx) xb_add(&bar[XB_TOPGEN], 1u);
            else XB_SPIN(xb_ld(&bar[XB_TOPGEN]) == tg, bar);
            __builtin_amdgcn_fence(__ATOMIC_ACQUIRE, "agent");
            xb_add(&bar[XB_XGEN(b.x)], 1u);
            asm volatile("s_waitcnt vmcnt(0)" ::: "memory");
        } else {
            XB_SPIN(xb_ld(&bar[XB_XGEN(b.x)]) == gen, bar);
            __builtin_amdgcn_fence(__ATOMIC_ACQUIRE, "agent");
            asm volatile("s_waitcnt vmcnt(0)" ::: "memory");
        }
    }
    __syncthreads();
}

constexpr int NWAVES = 8;
struct Frame {
    LAS unsigned char* lds;
    volatile LAS unsigned* MISC;
    gu32* ctl;
    int tid, lane, wave, G, blk;
    const float* in[21];
    float* out; unsigned char* ws;
};
__device__ __forceinline__ float wave_sum(float v) {
#pragma unroll
    for (int o = 1; o < 64; o <<= 1) v += __shfl_xor(v, o);
    return v;
}

__device__ __forceinline__ int map_src(int mode, int n) {
    if (mode == 1) return n < 2500 ? n : (n >= C_MQ ? n - (C_MQ - 2500) : -1);
    if (mode == 2) { const int pn = n >> 8, bj = (n >> 7) & 1, j = n & 127; return bj * 1024 + pn * 128 + j; }
    return n;
}
__device__ __forceinline__ void transpose_item(const float* W, int K, int Nsrc, int Ndst, bf16_t* WT, int mode, LAS float* scr, int item, int lane) {
    const int nblk = Ndst / 32, kb = item / nblk, nb = item % nblk, k0 = 64 * kb, n0 = 32 * nb;
    const int sc = map_src(mode, n0 + (lane & 31));
    const float scale = (mode == 1 && (n0 + (lane & 31)) < 512) ? 0.125f : 1.0f;
#pragma unroll
    for (int i = 0; i < 32; ++i) { const int kk = 2 * i + (lane >> 5); scr[kk * 33 + (lane & 31)] = sc >= 0 ? W[(size_t)(k0 + kk) * Nsrc + sc] * scale : 0.f; }
    LDS_WAIT(); asm volatile("" ::: "memory");
    const int c = lane & 7;
#pragma unroll
    for (int j = 0; j < 4; ++j) { const int n = (lane >> 3) + 8 * j; const LAS float* s = scr + (8 * c) * 33 + n;
        u32x4 o; o.x = pk2(s[0 * 33], s[1 * 33]); o.y = pk2(s[2 * 33], s[3 * 33]); o.z = pk2(s[4 * 33], s[5 * 33]); o.w = pk2(s[6 * 33], s[7 * 33]);
        *(GAS u32x4*)(WT + (size_t)(n0 + n) * K + k0 + 8 * c) = o; }
    LDS_WAIT(); asm volatile("" ::: "memory");
}
__device__ __forceinline__ void rms_row_to_bf16(int lane, const float* xrow, const float* g, bf16_t* orow) {
    const GAS f32x4* xr = (const GAS f32x4*)xrow + lane; const GAS f32x4* gr = (const GAS f32x4*)g + lane;
    f32x4 v[4]; float s = 0.f;
#pragma unroll
    for (int j = 0; j < 4; ++j) { v[j] = xr[64 * j]; s += (v[j].x * v[j].x + v[j].y * v[j].y) + (v[j].z * v[j].z + v[j].w * v[j].w); }
    const float rstd = 1.0f / sqrtf(wave_sum(s) * (1.f / DM) + EPS);
    GAS u32x2* o8 = (GAS u32x2*)orow + lane;
#pragma unroll
    for (int j = 0; j < 4; ++j) { const f32x4 gg = gr[64 * j]; u32x2 o; o.x = pk2(v[j].x * rstd * gg.x, v[j].y * rstd * gg.y); o.y = pk2(v[j].z * rstd * gg.z, v[j].w * rstd * gg.w); o8[64 * j] = o; }
}

__device__ __forceinline__ void rms_rows4_to_bf16(int lane, const float* x, const float* g, bf16_t* o, size_t m0, size_t stride) {
    f32x4 v[4][4]; float s[4];
#pragma unroll
    for (int r = 0; r < 4; ++r) { const GAS f32x4* xr = (const GAS f32x4*)(x + (m0 + r * stride) * DM) + lane;
#pragma unroll
        for (int j = 0; j < 4; ++j) v[r][j] = xr[64 * j]; }
    const GAS f32x4* gr = (const GAS f32x4*)g + lane;
    f32x4 gg[4];
#pragma unroll
    for (int j = 0; j < 4; ++j) gg[j] = gr[64 * j];
#pragma unroll
    for (int r = 0; r < 4; ++r) { float a = 0.f;
#pragma unroll
        for (int j = 0; j < 4; ++j) a += (v[r][j].x * v[r][j].x + v[r][j].y * v[r][j].y) + (v[r][j].z * v[r][j].z + v[r][j].w * v[r][j].w);
        s[r] = a; }
#pragma unroll
    for (int of = 1; of < 64; of <<= 1) {
#pragma unroll
        for (int r = 0; r < 4; ++r) s[r] += __shfl_xor(s[r], of); }
#pragma unroll
    for (int r = 0; r < 4; ++r) { const float rstd = 1.0f / sqrtf(s[r] * (1.f / DM) + EPS);
        GAS u32x2* o8 = (GAS u32x2*)(o + (m0 + r * stride) * DM) + lane;
#pragma unroll
        for (int j = 0; j < 4; ++j) { u32x2 w; w.x = pk2(v[r][j].x * rstd * gg[j].x, v[r][j].y * rstd * gg[j].y); w.y = pk2(v[r][j].z * rstd * gg[j].z, v[r][j].w * rstd * gg[j].w); o8[64 * j] = w; } }
}
__device__ __forceinline__ void p0_prologue(Frame& F) {
    LAS float* scr = (LAS float*)(F.lds + F.wave * 16384);
    const int gw = F.blk * NWAVES + F.wave, NGW = F.G * NWAVES, lane = F.lane;
    unsigned char* ws = F.ws;
    constexpr int I_IN = 16 * 96, I_MKV = 16 * 32, I_G = 16 * 32, I_B = 8 * 32, I_O = 16 * 32, I_EI = 16 * 64, I_EO = 16 * 32;
    constexpr int NITEMS = I_IN + I_MKV + 3 * I_G + 3 * I_B + I_O + NEXP * I_EI + NEXP * I_EO;
    for (int it = gw; it < NITEMS; it += NGW) {
        int r = it;
        if (r < I_IN) { transpose_item(F.in[3], DM, IN_W, PW, (bf16_t*)(ws + WS_WIN), 1, scr, r, lane); continue; } r -= I_IN;
        if (r < I_MKV) { transpose_item(F.in[9], DM, DM, DM, (bf16_t*)(ws + WS_WMKV), 0, scr, r, lane); continue; } r -= I_MKV;
        if (r < 3 * I_G) { const int n = r / I_G; transpose_item(F.in[10] + (size_t)n * DM * DM, DM, DM, DM, (bf16_t*)(ws + WS_WG) + (size_t)n * DM * DM, 0, scr, r % I_G, lane); continue; } r -= 3 * I_G;
        if (r < 3 * I_B) { const int n = r / I_B; transpose_item(F.in[12] + (size_t)n * 512 * DM, 512, DM, DM, (bf16_t*)(ws + WS_WB) + (size_t)n * DM * 512, 0, scr, r % I_B, lane); continue; } r -= 3 * I_B;
        if (r < I_O) { transpose_item(F.in[13], DM, DM, DM, (bf16_t*)(ws + WS_WO), 0, scr, r, lane); continue; } r -= I_O;
        if (r < NEXP * I_EI) { const int e = r / I_EI; transpose_item(F.in[17] + (size_t)e * DM * 2048, DM, 2048, 2048, (bf16_t*)(ws + WS_WEI) + (size_t)e * 2048 * DM, 2, scr, r % I_EI, lane); continue; } r -= NEXP * I_EI;
        { const int e = r / I_EO; transpose_item(F.in[19] + (size_t)e * DM * DM, DM, DM, DM, (bf16_t*)(ws + WS_WEO) + (size_t)e * DM * DM, 0, scr, r % I_EO, lane); }
    }
    { f32x2* tab = (f32x2*)(ws + WS_ROPE);
      for (int idx = (F.blk * NWAVES * 64) + F.tid; idx < SEQ * 32; idx += F.G * NWAVES * 64) {
          const int s = idx >> 5, i = idx & 31;
          const float inv = exp2f(-(float)i * (13.287712379549449f / 32.0f));
          const float ang = (float)s * inv;
          const double rev = (double)ang * 0.15915494309189535;
          const float fr = (float)(rev - __builtin_rint(rev));
          tab[idx] = (f32x2){__builtin_amdgcn_cosf(fr), __builtin_amdgcn_sinf(fr)}; } }
    for (int m = gw; m < NTOK; m += 4 * NGW) rms_rows4_to_bf16(lane, F.in[0], F.in[2], (bf16_t*)(ws + WS_H), (size_t)m, (size_t)NGW);
    for (int m = gw; m < NMEM; m += 4 * NGW) rms_rows4_to_bf16(lane, F.in[1], F.in[8], (bf16_t*)(ws + WS_MEMN), (size_t)m, (size_t)NGW);
    { int* st = (int*)(ws + WS_SLOT_TOK); float* sw = (float*)(ws + WS_SLOT_W);
      for (int i = F.blk * NWAVES * 64 + F.tid; i < NSLOT_PAD; i += F.G * NWAVES * 64) { st[i] = 0; sw[i] = 0.f; } }
}

template <int CTRL> __device__ __forceinline__ float dppf(float v) { return __builtin_bit_cast(float, __builtin_amdgcn_update_dpp(0, __builtin_bit_cast(int, v), CTRL, 0xF, 0xF, false)); }
__device__ __forceinline__ float lx1(float v) { return dppf<0xB1>(v); }
__device__ __forceinline__ float lx2(float v) { return dppf<0x4E>(v); }
__device__ __forceinline__ float lx4(float v) { return dppf<0x1B>(dppf<0x141>(v)); }
__device__ __forceinline__ float lx8(float v) { return dppf<0x128>(v); }
__device__ __forceinline__ void un8(const u32x4 w, float (&v)[8]) { v[0] = bflo(w.x); v[1] = bfhi(w.x); v[2] = bflo(w.y); v[3] = bfhi(w.y); v[4] = bflo(w.z); v[5] = bfhi(w.z); v[6] = bflo(w.w); v[7] = bfhi(w.w); }
__device__ __forceinline__ u32x4 pk8(const float (&v)[8]) { u32x4 w; w.x = pk2(v[0], v[1]); w.y = pk2(v[2], v[3]); w.z = pk2(v[4], v[5]); w.w = pk2(v[6], v[7]); return w; }
__device__ __forceinline__ void rope8(float (&v)[8], const f32x2 (&cs)[8], bool up) {
#pragma unroll
    for (int j = 0; j < 8; ++j) { const float other = lx4(v[j]); v[j] = up ? (other * cs[j].y + v[j] * cs[j].x) : (v[j] * cs[j].x - other * cs[j].y); }
}
__device__ __forceinline__ void p2_prep(Frame& F, const bool dummy = false) {
    const int gw = F.blk * NWAVES + F.wave, NGW = F.G * NWAVES, lane = F.lane;
    bf16_t* proj = (bf16_t*)(F.ws + WS_P);
    bf16_t* projw = dummy ? (bf16_t*)(F.ws + WS_END) : proj;
    const int wmask = dummy ? 8191 : 0x7fffffff;
    const f32x2* tab = (const f32x2*)(F.ws + WS_ROPE);
    float gqd[8], gkd[8], gqm[8];
#pragma unroll
    for (int j = 0; j < 8; ++j) { gqd[j] = F.in[4][8 * (lane & 7) + j] * (0.125f * LOG2E); gkd[j] = F.in[5][8 * (lane & 7) + j]; gqm[j] = F.in[6][8 * (lane & 15) + j] * (0.08838834764831845f * LOG2E); }
    const bool up = (lane & 4) != 0; const int i0 = (lane & 3) * 8;
    for (int m0 = gw; m0 < NTOK; m0 += 2 * NGW) {
        u32x4 raw[2][5]; f32x2 cs[2][8];
#pragma unroll
        for (int t = 0; t < 2; ++t) { const GAS bf16_t* row = (const GAS bf16_t*)proj + (size_t)(m0 + t * NGW) * PW;
            raw[t][0] = *(const GAS u32x4*)(row + C_DQ + 8 * lane); raw[t][1] = *(const GAS u32x4*)(row + C_DK + 8 * (lane & 7)); raw[t][2] = *(const GAS u32x4*)(row + C_IQ + 8 * (lane & 31));
            raw[t][3] = *(const GAS u32x4*)(row + C_IK + 8 * (lane & 7)); raw[t][4] = *(const GAS u32x4*)(row + C_MQ + 8 * lane);
            const GAS f32x2* tr = (const GAS f32x2*)tab + (size_t)((m0 + t * NGW) & (SEQ - 1)) * 32 + i0;
#pragma unroll
            for (int j = 0; j < 8; ++j) cs[t][j] = tr[j]; }
#pragma unroll
        for (int t = 0; t < 2; ++t) {
            GAS bf16_t* roww = (GAS bf16_t*)projw + (size_t)((m0 + t * NGW) & wmask) * PW;
            float v[8];
            { un8(raw[t][0], v); float ss = 0.f;
#pragma unroll
              for (int j = 0; j < 8; ++j) ss += v[j] * v[j];
              ss += lx1(ss); ss += lx2(ss); ss += lx4(ss);
              const float rstd = 1.0f / sqrtf(ss * (1.f / 64.f) + EPS);
#pragma unroll
              for (int j = 0; j < 8; ++j) v[j] = v[j] * rstd * gqd[j];
              rope8(v, cs[t], up);
              *(GAS u32x4*)(roww + C_DQ + 8 * lane) = pk8(v); }
            { un8(raw[t][1], v); float ss = 0.f;
#pragma unroll
              for (int j = 0; j < 8; ++j) ss += v[j] * v[j];
              ss += lx1(ss); ss += lx2(ss); ss += lx4(ss);
              const float rstd = 1.0f / sqrtf(ss * (1.f / 64.f) + EPS);
#pragma unroll
              for (int j = 0; j < 8; ++j) v[j] = v[j] * rstd * gkd[j];
              rope8(v, cs[t], up);
              if (lane < 8) *(GAS u32x4*)(roww + C_DK + 8 * lane) = pk8(v); }
            { un8(raw[t][2], v); rope8(v, cs[t], up); if (lane < 32) *(GAS u32x4*)(roww + C_IQ + 8 * lane) = pk8(v); }
            { un8(raw[t][3], v); rope8(v, cs[t], up); if (lane < 8) *(GAS u32x4*)(roww + C_IK + 8 * lane) = pk8(v); }
            { un8(raw[t][4], v); float ss = 0.f;
#pragma unroll
              for (int j = 0; j < 8; ++j) ss += v[j] * v[j];
              ss += lx1(ss); ss += lx2(ss); ss += lx4(ss); ss += lx8(ss);
              const float rstd = 1.0f / sqrtf(ss * (1.f / 128.f) + EPS);
#pragma unroll
              for (int j = 0; j < 8; ++j) v[j] = v[j] * rstd * gqm[j];
              *(GAS u32x4*)(roww + C_MQ + 8 * lane) = pk8(v); }
        }
    }
    bf16_t* mkv = (bf16_t*)(F.ws + WS_MKV);
    if (!dummy) for (int m = gw; m < NMEM; m += NGW) {
        GAS bf16_t* row = (GAS bf16_t*)mkv + (size_t)m * DM; float v[8];
        un8(*(const GAS u32x4*)(row + 8 * lane), v); float ss = 0.f;
#pragma unroll
        for (int j = 0; j < 8; ++j) ss += v[j] * v[j];
        ss += lx1(ss); ss += lx2(ss); ss += lx4(ss); ss += lx8(ss);
        const float rstd = 1.0f / sqrtf(ss * (1.f / 128.f) + EPS);
#pragma unroll
        for (int j = 0; j < 8; ++j) v[j] = v[j] * rstd * F.in[7][8 * (lane & 15) + j];
        *(GAS u32x4*)(row + 8 * lane) = pk8(v);
    }
}

#define MFMA32(a, b, c) __builtin_amdgcn_mfma_f32_32x32x16_bf16((a), (b), (c), 0, 0, 0)
typedef LAS const unsigned char* lds_cptr;
__device__ __forceinline__ s16x4 vtr(lds_cptr p) { return __builtin_bit_cast(s16x4, __builtin_amdgcn_ds_read_tr16_b64_v4i16((LAS v4i16_t*)p)); }
__device__ __forceinline__ bf16x8 vfrag(lds_cptr vbase_lane, int off) {
    const s16x4 lo = vtr(vbase_lane + off), hi = vtr(vbase_lane + off + 512);
    return (bf16x8){lo[0], lo[1], lo[2], lo[3], hi[0], hi[1], hi[2], hi[3]};
}
__device__ __forceinline__ int vtr_lane_off(int lane) { return ((lane >> 4) & 1) * 32 + (lane & 3) * 8 + (4 * (lane >> 5) + ((lane & 15) >> 2)) * 64; }
__device__ __forceinline__ bf16x8 pack8(const float* p) {
    u32x4 w; w.x = cvt_pk_bf16(p[0], p[1]); w.y = cvt_pk_bf16(p[2], p[3]); w.z = cvt_pk_bf16(p[4], p[5]); w.w = cvt_pk_bf16(p[6], p[7]);
    return __builtin_bit_cast(bf16x8, w);
}
__device__ __forceinline__ float softplus_f(float z) { return fmaxf(z, 0.f) + __logf(1.f + __expf(-fabsf(z))); }

__device__ __forceinline__ void sb_item(const bf16_t* proj, bf16_t* osb, int b, int h, int qblk, LAS unsigned char* vlds, int lane) {
    const int r32 = lane & 31, hi = lane >> 5;
    const size_t tok0 = (size_t)b * SEQ + (size_t)qblk * 32;
    bf16x8 qr[4];
    { const bf16_t* qp = proj + (tok0 + r32) * PW + C_SQ + h * 64 + hi * 8;
#pragma unroll
      for (int kk = 0; kk < 4; ++kk) qr[kk] = *(const bf16x8*)(qp + kk * 16); }
    f32x16 o0 = {}, o1 = {}; float R = 0.f;
    const lds_cptr vrd = (lds_cptr)vlds + vtr_lane_off(lane);
    bf16x8 kfn[4]; u32x4 vvn[4];
#define SB_LOAD(kt_) do { const size_t key0_ = (size_t)b * SEQ + (size_t)(kt_) * 32; const GAS bf16_t* kp_ = (const GAS bf16_t*)proj + (key0_ + r32) * PW + C_SK + h * 64 + hi * 8; \
        _Pragma("unroll") for (int kk = 0; kk < 4; ++kk) kfn[kk] = *(const GAS bf16x8*)(kp_ + kk * 16); \
        _Pragma("unroll") for (int p = 0; p < 4; ++p) vvn[p] = *(const GAS u32x4*)((const GAS bf16_t*)proj + (key0_ + 16 * (p & 1) + (lane >> 2)) * PW + C_SV + h * 64 + (p >> 1) * 32 + (lane & 3) * 8); } while (0)
    SB_LOAD(qblk);
    for (int kt = qblk; kt >= 0; --kt) {
        bf16x8 kf[4]; u32x4 vv[4];
#pragma unroll
        for (int i = 0; i < 4; ++i) { kf[i] = kfn[i]; vv[i] = vvn[i]; }
        if (kt > 0) SB_LOAD(kt - 1);
        f32x16 s = {};
#pragma unroll
        for (int kk = 0; kk < 4; ++kk) s = MFMA32(kf[kk], qr[kk], s);
        asm volatile("" ::: "memory");
#pragma unroll
        for (int p = 0; p < 4; ++p) *(LAS u32x4*)(vlds + p * 1024 + lane * 16) = vv[p];
        const bool diag = (kt == qblk);
        float sp[16], pr[16];
#pragma unroll
        for (int r = 0; r < 16; ++r) { const bool valid = !diag || (crow(r, hi) < r32); sp[r] = valid ? softplus_f(s[r]) : 0.f; }
        float T[4], U[4];
#pragma unroll
        for (int g = 0; g < 4; ++g) { T[g] = (sp[4 * g] + sp[4 * g + 1]) + (sp[4 * g + 2] + sp[4 * g + 3]); U[g] = __shfl_xor(T[g], 32); }
        float run = 0.f, above[4];
#pragma unroll
        for (int g = 3; g >= 0; --g) { above[g] = run + (hi == 0 ? U[g] : 0.f); run += T[g] + U[g]; }
#pragma unroll
        for (int g = 0; g < 4; ++g) { float c = R + above[g];
#pragma unroll
            for (int j = 3; j >= 0; --j) { const int r = 4 * g + j; c += sp[r]; const bool valid = !diag || (crow(r, hi) < r32); pr[r] = valid ? __expf(s[r] - c) : 0.f; } }
        R += run;
        const bf16x8 p0 = pack8(pr), p1 = pack8(pr + 8);
        LDS_WAIT();
        const bf16x8 v00 = vfrag(vrd, 0), v01 = vfrag(vrd, 1024), v10 = vfrag(vrd, 2048), v11 = vfrag(vrd, 3072);
        o0 = MFMA32(v00, p0, o0); o0 = MFMA32(v01, p1, o0);
        o1 = MFMA32(v10, p0, o1); o1 = MFMA32(v11, p1, o1);
        asm volatile("" ::: "memory");
        if (__all(R > 30.0f)) break;
    }
#undef SB_LOAD
    bf16_t* op = osb + (tok0 + r32) * 512 + h * 64 + 4 * hi;
#pragma unroll
    for (int g = 0; g < 4; ++g) {
        u32x2 w0, w1; w0.x = cvt_pk_bf16(o0[4 * g], o0[4 * g + 1]); w0.y = cvt_pk_bf16(o0[4 * g + 2], o0[4 * g + 3]); w1.x = cvt_pk_bf16(o1[4 * g], o1[4 * g + 1]); w1.y = cvt_pk_bf16(o1[4 * g + 2], o1[4 * g + 3]);
        *(u32x2*)(op + 8 * g) = w0; *(u32x2*)(op + 32 + 8 * g) = w1; }
}

constexpr int ML_K = 0, ML_KROW = 272, ML_V = 256 * ML_KROW, ML_END = ML_V + 65536;
__device__ __forceinline__ void mem_unit(const bf16_t* proj, const bf16_t* mkv, bf16_t* omem, int b, int h, int half, LAS unsigned char* ml, int tid) {
    const int lane = tid & 63, wid = __builtin_amdgcn_readfirstlane(tid >> 6), r32 = lane & 31, hi = lane >> 5;
    { const GAS bf16_t* src = (const GAS bf16_t*)mkv + (size_t)b * MEMLEN * DM + h * 128;
#pragma unroll
      for (int i = 0; i < 8; ++i) { const int ch = tid + 512 * i, key = ch >> 4, c16 = ch & 15, kk = key & 31;
          const u32x4 kv = *(const GAS u32x4*)(src + (size_t)key * DM + c16 * 8);
          const u32x4 vv = *(const GAS u32x4*)(src + (size_t)key * DM + 512 + c16 * 8);
          *(LAS u32x4*)(ml + ML_K + key * ML_KROW + c16 * 16) = kv;
          *(LAS u32x4*)(ml + ML_V + (key >> 5) * 8192 + ((c16 >> 2) * 2 + (kk >> 4)) * 1024 + (kk & 15) * 64 + (c16 & 3) * 16) = vv; } }
    __syncthreads();
    for (int i = 0; i < 4; ++i) {
        const int qblk = half * 32 + wid * 4 + i;
        const size_t tok0 = (size_t)b * SEQ + (size_t)qblk * 32;
        bf16x8 qr[8];
        { const GAS bf16_t* qp = (const GAS bf16_t*)proj + (tok0 + r32) * PW + C_MQ + h * 128 + hi * 8;
#pragma unroll
          for (int kk = 0; kk < 8; ++kk) qr[kk] = *(const GAS bf16x8*)(qp + kk * 16); }
        f32x16 o[4] = {{}, {}, {}, {}}; float m = -1e30f, l = 0.f;
        for (int kb = 0; kb < 8; ++kb) {
            const LAS unsigned char* krd = ml + ML_K + (32 * kb + r32) * ML_KROW + hi * 16;
            f32x16 s = {};
#pragma unroll
            for (int kk = 0; kk < 8; ++kk) { const bf16x8 kf = *(const LAS bf16x8*)(krd + kk * 32); s = MFMA32(kf, qr[kk], s); }
            float mx = s[0];
#pragma unroll
            for (int r = 1; r < 16; ++r) mx = fmaxf(mx, s[r]);
            mx = fmaxf(mx, __shfl_xor(mx, 32));
            if (__any(mx > m + 8.0f)) {
                const float mn = fmaxf(m, mx), alpha = __builtin_amdgcn_exp2f(m - mn);
                l *= alpha; m = mn;
#pragma unroll
                for (int d = 0; d < 4; ++d)
#pragma unroll
                    for (int r = 0; r < 16; ++r) o[d][r] *= alpha;
            }
            float pr[16], rs = 0.f;
#pragma unroll
            for (int r = 0; r < 16; ++r) { pr[r] = __builtin_amdgcn_exp2f(s[r] - m); rs += pr[r]; }
            l += rs;
            const bf16x8 p0 = pack8(pr), p1 = pack8(pr + 8);
            const lds_cptr vrd = (lds_cptr)ml + ML_V + kb * 8192 + vtr_lane_off(lane);
#pragma unroll
            for (int d = 0; d < 4; ++d) { const bf16x8 va = vfrag(vrd, d * 2048), vb = vfrag(vrd, d * 2048 + 1024); o[d] = MFMA32(va, p0, o[d]); o[d] = MFMA32(vb, p1, o[d]); }
        }
        l += __shfl_xor(l, 32);
        const float il = 1.0f / l;
        bf16_t* op = omem + (tok0 + r32) * 512 + h * 128 + 4 * hi;
#pragma unroll
        for (int d = 0; d < 4; ++d)
#pragma unroll
            for (int g = 0; g < 4; ++g) { u32x2 w; w.x = cvt_pk_bf16(o[d][4 * g] * il, o[d][4 * g + 1] * il); w.y = cvt_pk_bf16(o[d][4 * g + 2] * il, o[d][4 * g + 3] * il); *(u32x2*)(op + 32 * d + 8 * g) = w; }
    }
    __syncthreads();
}

constexpr int DL_HIST = 0, DL_PREFIX = 66048, DL_KREM = DL_PREFIX + 256, DL_MASK = 67072, DL_VT = 73728, DL_KT = DL_VT + 2 * 16384, DL_END = DL_KT + 2 * 18432, DL_IQ = DL_VT;
constexpr int TOPK_DSA = 256;

struct IqLds { const LAS unsigned char* p; __device__ __forceinline__ bf16x8 operator()(int j) const { return *(const LAS bf16x8*)(p + j * 32); } };
template <class QF>
__device__ __forceinline__ void idx_scores(const QF& qf, const bf16x8 (&kf)[4], const float (&wq)[4], unsigned (&uk)[16]) {
    float scv[16];
#pragma unroll
    for (int hd = 0; hd < 4; ++hd) { f32x16 a = (f32x16){};
#pragma unroll
        for (int kk = 0; kk < 4; ++kk) a = MFMA32(kf[kk], qf(hd * 4 + kk), a);
#pragma unroll
        for (int r = 0; r < 16; ++r) scv[r] = (hd == 0) ? wq[0] * fmaxf(a[r], 0.f) : __builtin_fmaf(wq[hd], fmaxf(a[r], 0.f), scv[r]); }
#pragma unroll
    for (int r = 0; r < 16; ++r) {
        unsigned bits = __builtin_bit_cast(unsigned, scv[r]);
        if (bits == 0x80000000u) bits = 0u;
        uk[r] = bits ^ ((unsigned)((int)bits >> 31) | 0x80000000u);
    }
}
__device__ __forceinline__ void load_ik(const bf16_t* proj, size_t tokb, int kbase, int r32, int hi, bf16x8 (&kf)[4]) {
    int kr = kbase + r32; if (kr > SEQ - 1) kr = SEQ - 1;
    const GAS bf16_t* p = (const GAS bf16_t*)proj + (tokb + kr) * PW + C_IK + 8 * hi;
#pragma unroll
    for (int kk = 0; kk < 4; ++kk) kf[kk] = *(const GAS bf16x8*)(p + kk * 16);
}

__device__ __forceinline__ void dsa_unit(const bf16_t* proj, bf16_t* odsa, int b, int c, LAS unsigned char* dl, int tid) {
    const int lane = tid & 63, wid = __builtin_amdgcn_readfirstlane(tid >> 6), r32 = lane & 31, hi = lane >> 5;
    const int n = 64 * (c + 1), nsteps = (n + 127) >> 7;
    const size_t tokq0 = (size_t)b * SEQ + (size_t)c * 64, tokb = (size_t)b * SEQ;
    LAS unsigned* hist = (LAS unsigned*)(dl + DL_HIST);
    LAS unsigned* prefix = (LAS unsigned*)(dl + DL_PREFIX);
    LAS unsigned* krem = (LAS unsigned*)(dl + DL_KREM);
    LAS unsigned* mask = (LAS unsigned*)(dl + DL_MASK);
    const int kb = wid >> 1, qh = wid & 1;
    { const int row = tid >> 3, c = tid & 7;
      const GAS bf16_t* src = (const GAS bf16_t*)proj + (tokq0 + row) * PW + C_IQ + c * 32;
#pragma unroll
      for (int i = 0; i < 4; ++i) *(LAS u32x4*)(dl + DL_IQ + row * 528 + c * 64 + i * 16) = *(const GAS u32x4*)(src + i * 8); }
    const IqLds iqf{dl + DL_IQ + (32 * qh + r32) * 528 + hi * 16};
    float wq[4];
    { const u32x2 w = *(const u32x2*)(proj + (tokq0 + 32 * qh + r32) * PW + C_IW);
      wq[0] = bflo(w.x) * 0.0625f; wq[1] = bfhi(w.x) * 0.0625f; wq[2] = bflo(w.y) * 0.0625f; wq[3] = bfhi(w.y) * 0.0625f; }
#ifndef REP_SEL
#define REP_SEL 1
#endif
#ifndef REP_B2
#define REP_B2 1
#endif
    LAS unsigned* selall = (LAS unsigned*)(dl + DL_HIST);
    if (tid < 64) { prefix[tid] = 0u; krem[tid] = (n > TOPK_DSA) ? (unsigned)TOPK_DSA : 0x7fffffffu; }
    __syncthreads();
    for (int pass = (n > TOPK_DSA) ? 0 : 3; pass < 4; ++pass) {
        const bool sel = pass < 3;
        if (sel) { for (int i = tid; i < 64 * 257; i += 512) hist[i] = 0u; __syncthreads(); }
        const int shift = 24 - 8 * pass;
        const unsigned pfx = prefix[32 * qh + r32];
        bf16x8 kfn[4]; load_ik(proj, tokb, 32 * kb, r32, hi, kfn);
        for (int step = 0; step < nsteps; ++step) {
            const int kbase = 128 * step + 32 * kb;
            bf16x8 kf[4];
#pragma unroll
            for (int kk = 0; kk < 4; ++kk) kf[kk] = kfn[kk];
            if (step + 1 < nsteps) load_ik(proj, tokb, kbase + 128, r32, hi, kfn);
            unsigned gtw = 0u, eqw = 0u;
            if (kbase < n) {
                unsigned uk[16];
                idx_scores(iqf, kf, wq, uk);
                if (sel) {
#pragma unroll
                    for (int r = 0; r < 16; ++r) {
                        const bool match = (pass == 0) || ((uk[r] >> (shift + 8)) == pfx);
                        if (match) __hip_atomic_fetch_add(hist + (32 * qh + r32) * 257 + ((uk[r] >> shift) & 255u), 1u, __ATOMIC_RELAXED, __HIP_MEMORY_SCOPE_WORKGROUP);
                    }
                } else {
#pragma unroll
                    for (int r = 0; r < 16; ++r) { const unsigned k24 = uk[r] >> 8; gtw |= (k24 > pfx ? 1u : 0u) << crow(r, hi); eqw |= (k24 == pfx ? 1u : 0u) << crow(r, hi); }
                }
            }
            if (!sel) {
                LAS unsigned* mk = mask + (step & 1) * 768;
                gtw |= __shfl_xor(gtw, 32); eqw |= __shfl_xor(eqw, 32);
                if (hi == 0) { mk[(32 * qh + r32) * 4 + kb] = gtw; mk[256 + (32 * qh + r32) * 4 + kb] = eqw; }
                __syncthreads();
                if (wid == 0) { unsigned nd = krem[lane];
#pragma unroll
                    for (int k4 = 0; k4 < 4; ++k4) { const unsigned g = mk[lane * 4 + k4]; unsigned e = mk[256 + lane * 4 + k4]; unsigned sl = g;
                        if (e != 0u) { const unsigned cnt = (unsigned)__builtin_popcount(e);
                            if (cnt <= nd) { sl |= e; nd -= cnt; }
                            else { unsigned chosen = 0u; while (nd > 0u) { const unsigned lb = e & (0u - e); chosen |= lb; e ^= lb; --nd; } sl |= chosen; } }
                        selall[lane * 64 + step * 4 + k4] = sl; }
                    krem[lane] = nd; }
            }
        }
        if (sel) {
            __syncthreads();
#pragma unroll
            for (int qi = 0; qi < 8; ++qi) {
                const int q = 8 * wid + qi;
                const LAS unsigned* hq = hist + q * 257;
                const unsigned c0 = hq[255 - 4 * lane], c1 = hq[254 - 4 * lane], c2 = hq[253 - 4 * lane], c3 = hq[252 - 4 * lane];
                const unsigned s4 = c0 + c1 + c2 + c3;
                unsigned incl = s4;
#pragma unroll
                for (int o = 1; o < 64; o <<= 1) { const unsigned t = __shfl_up(incl, o); if (lane >= o) incl += t; }
                const unsigned excl = incl - s4, kr = krem[q];
                if (excl < kr && kr <= incl) {
                    unsigned cum = excl, bin, nk;
                    if (cum + c0 >= kr) { bin = 255 - 4 * lane; nk = kr - cum; }
                    else { cum += c0; if (cum + c1 >= kr) { bin = 254 - 4 * lane; nk = kr - cum; }
                    else { cum += c1; if (cum + c2 >= kr) { bin = 253 - 4 * lane; nk = kr - cum; }
                    else { cum += c2; bin = 252 - 4 * lane; nk = kr - cum; } } }
                    prefix[q] = (prefix[q] << 8) | bin; krem[q] = nk;
                }
            }
            __syncthreads();
        }
    }
    const int hd = wid;
    u32x4 pk[2], pv[2];
#define DSA_LOADKV(step_) do { _Pragma("unroll") for (int i_ = 0; i_ < 2; ++i_) { const int ch_ = tid + 512 * i_; int krow_ = 128 * (step_) + (ch_ >> 3); if (krow_ > SEQ - 1) krow_ = SEQ - 1; \
        const GAS bf16_t* rp_ = (const GAS bf16_t*)proj + (tokb + krow_) * PW + (ch_ & 7) * 8; pk[i_] = *(const GAS u32x4*)(rp_ + C_DK); pv[i_] = *(const GAS u32x4*)(rp_ + C_DV); } } while (0)
#define DSA_STOREKV(buf_) do { _Pragma("unroll") for (int i_ = 0; i_ < 2; ++i_) { const int ch_ = tid + 512 * i_, key_ = ch_ >> 3, c8_ = ch_ & 7, kk_ = key_ & 31; \
        *(LAS u32x4*)(dl + DL_KT + (buf_) * 18432 + key_ * 144 + c8_ * 16) = pk[i_]; \
        *(LAS u32x4*)(dl + DL_VT + (buf_) * 16384 + (key_ >> 5) * 4096 + ((c8_ >> 2) * 2 + (kk_ >> 4)) * 1024 + (kk_ & 15) * 64 + (c8_ & 3) * 16) = pv[i_]; } } while (0)
    for (int qb = 0; qb < 2; ++qb) {
        bf16x8 qr[4];
        { const GAS bf16_t* qp = (const GAS bf16_t*)proj + (tokq0 + 32 * qb + r32) * PW + C_DQ + hd * 64 + 8 * hi;
#pragma unroll
          for (int kk = 0; kk < 4; ++kk) qr[kk] = *(const GAS bf16x8*)(qp + kk * 16); }
        f32x16 o0 = {}, o1 = {}; float mrun = -1e30f, lrun = 0.f;
        DSA_LOADKV(0);
        DSA_STOREKV(0);
        __syncthreads();
        for (int step = 0; step < nsteps; ++step) {
            const int buf = step & 1;
            if (step + 1 < nsteps) DSA_LOADKV(step + 1);
            LAS unsigned char* kt = dl + DL_KT + buf * 18432;
            LAS unsigned char* vt = dl + DL_VT + buf * 16384;
            for (int k4 = 0; k4 < 4; ++k4) {
                const int kbase = 128 * step + 32 * k4;
                if (kbase >= n) break;
                const LAS unsigned char* krd = kt + (32 * k4 + r32) * 144 + hi * 16;
                f32x16 s = {};
#pragma unroll
                for (int kk = 0; kk < 4; ++kk) { const bf16x8 kf = *(const LAS bf16x8*)(krd + kk * 32); s = MFMA32(kf, qr[kk], s); }
                const lds_cptr vrd = (lds_cptr)vt + k4 * 4096 + vtr_lane_off(lane);
                const bf16x8 v00 = vfrag(vrd, 0), v01 = vfrag(vrd, 1024), v10 = vfrag(vrd, 2048), v11 = vfrag(vrd, 3072);
                const unsigned selw = selall[(32 * qb + r32) * 64 + step * 4 + k4];
                float mx = -INFINITY;
#pragma unroll
                for (int r = 0; r < 16; ++r) { if (!((selw >> crow(r, hi)) & 1u)) s[r] = -INFINITY; mx = fmaxf(mx, s[r]); }
                mx = fmaxf(mx, __shfl_xor(mx, 32));
                if (__any(mx > mrun + 8.0f)) {
                    const float mn = fmaxf(mrun, mx), alpha = __builtin_amdgcn_exp2f(mrun - mn);
                    lrun *= alpha; mrun = mn;
#pragma unroll
                    for (int r = 0; r < 16; ++r) { o0[r] *= alpha; o1[r] *= alpha; }
                }
                float pr[16], rs = 0.f;
#pragma unroll
                for (int r = 0; r < 16; ++r) { pr[r] = __builtin_amdgcn_exp2f(s[r] - mrun); rs += pr[r]; }
                lrun += rs;
                const bf16x8 p0 = pack8(pr), p1 = pack8(pr + 8);
                o0 = MFMA32(v00, p0, o0); o0 = MFMA32(v01, p1, o0);
                o1 = MFMA32(v10, p0, o1); o1 = MFMA32(v11, p1, o1);
            }
            if (step + 1 < nsteps) DSA_STOREKV(buf ^ 1);
            __syncthreads();
        }
        float l = lrun; l += __shfl_xor(l, 32);
        const float il = 1.0f / l;
        bf16_t* op = odsa + (tokq0 + 32 * qb + r32) * 512 + hd * 64 + 4 * hi;
#pragma unroll
        for (int g = 0; g < 4; ++g) {
            u32x2 w0, w1; w0.x = cvt_pk_bf16(o0[4 * g] * il, o0[4 * g + 1] * il); w0.y = cvt_pk_bf16(o0[4 * g + 2] * il, o0[4 * g + 3] * il);
            w1.x = cvt_pk_bf16(o1[4 * g] * il, o1[4 * g + 1] * il); w1.y = cvt_pk_bf16(o1[4 * g + 2] * il, o1[4 * g + 3] * il);
            *(u32x2*)(op + 8 * g) = w0; *(u32x2*)(op + 32 + 8 * g) = w1; }
    }
#undef DSA_LOADKV
#undef DSA_STOREKV
    __syncthreads();
}

template <int CTRL> __device__ __forceinline__ float dpp_f(float v) { return __builtin_bit_cast(float, __builtin_amdgcn_update_dpp(0, __builtin_bit_cast(int, v), CTRL, 0xF, 0xF, false)); }
constexpr int RL_WR = 0, RL_WR_STRIDE = 1028, RL_TKE = 131584, RL_TKW = RL_TKE + 4096;
__device__ __forceinline__ void p9_router(Frame& F) {
    const int lane = F.lane, wave = F.wave, tid = F.tid;
    LAS float* Wr = (LAS float*)(F.lds + RL_WR);
    LAS int* tke = (LAS int*)(F.lds + RL_TKE); LAS float* tkw = (LAS float*)(F.lds + RL_TKW);
    const float* w_router = F.in[15]; const float* b_router = F.in[16]; const float* g_ffn = F.in[14];
    for (int idx = tid; idx < DM * NEXP; idx += NWAVES * 64) { const int k = idx >> 5, e = idx & 31; Wr[e * RL_WR_STRIDE + k] = w_router[idx]; }
    if (tid < 32) F.MISC[MW_LCNT + tid] = 0u;
    __syncthreads();
    bf16_t* h2 = (bf16_t*)(F.ws + WS_H);
    const GAS f32x4* gr = (const GAS f32x4*)g_ffn + lane;
    f32x4 gg[4];
#pragma unroll
    for (int j = 0; j < 4; ++j) gg[j] = gr[64 * j];
    const float bias_e = b_router[lane >> 1];
    f32x4 xnext[2][4];
#pragma unroll
    for (int tk = 0; tk < 2; ++tk) { const GAS f32x4* xr = (const GAS f32x4*)(F.out + ((size_t)F.blk * 256 + 32 * wave + tk) * DM) + lane;
#pragma unroll
        for (int j = 0; j < 4; ++j) xnext[tk][j] = xr[64 * j]; }
    for (int it = 0; it < 16; ++it) {
        const int tl0 = 32 * wave + 2 * it;
        f32x4 hn[2][4];
#pragma unroll
        for (int tk = 0; tk < 2; ++tk)
#pragma unroll
            for (int j = 0; j < 4; ++j) hn[tk][j] = xnext[tk][j];
        if (it + 1 < 16) {
#pragma unroll
            for (int tk = 0; tk < 2; ++tk) { const GAS f32x4* xr = (const GAS f32x4*)(F.out + ((size_t)F.blk * 256 + tl0 + 2 + tk) * DM) + lane;
#pragma unroll
                for (int j = 0; j < 4; ++j) xnext[tk][j] = xr[64 * j]; } }
#pragma unroll
        for (int tk = 0; tk < 2; ++tk) {
            const size_t t = (size_t)F.blk * 256 + tl0 + tk;
            float s = 0.f;
#pragma unroll
            for (int j = 0; j < 4; ++j) { s += (hn[tk][j].x * hn[tk][j].x + hn[tk][j].y * hn[tk][j].y) + (hn[tk][j].z * hn[tk][j].z + hn[tk][j].w * hn[tk][j].w); }
            const float rstd = 1.0f / sqrtf(wave_sum(s) * (1.f / DM) + EPS);
            GAS u32x2* o8 = (GAS u32x2*)(h2 + t * DM) + lane;
#pragma unroll
            for (int j = 0; j < 4; ++j) { hn[tk][j] = hn[tk][j] * rstd * gg[j]; u32x2 o; o.x = pk2(hn[tk][j].x, hn[tk][j].y); o.y = pk2(hn[tk][j].z, hn[tk][j].w); o8[64 * j] = o; }
        }
        f32x2 hp[4][4];
#pragma unroll
        for (int j = 0; j < 4; ++j)
#pragma unroll
            for (int c = 0; c < 4; ++c) hp[j][c] = (f32x2){hn[0][j][c], hn[1][j][c]};
        float acc[2][32];
        const LAS float* wl = Wr + 4 * lane; asm volatile("" : "+v"(wl));
#pragma unroll
        for (int e = 0; e < 32; ++e) {
            f32x2 a2 = (f32x2){0.f, 0.f};
#pragma unroll
            for (int j = 0; j < 4; ++j) { const f32x4 w = *(const LAS f32x4*)(wl + e * RL_WR_STRIDE + 256 * j);
#pragma unroll
                for (int c = 0; c < 4; ++c) a2 = __builtin_elementwise_fma(hp[j][c], (f32x2){w[c], w[c]}, a2); }
            asm volatile("" : "+v"(a2));
            acc[0][e] = a2.x; acc[1][e] = a2.y;
        }
#pragma unroll
        for (int tk = 0; tk < 2; ++tk) {
            float v16[16], v8[8], v4[4], v2[2];
            const bool b3 = (lane & 8) != 0, b2 = (lane & 4) != 0, b1 = (lane & 2) != 0;
#pragma unroll
            for (int i = 0; i < 16; ++i) { const auto rr = __builtin_amdgcn_permlane32_swap(__float_as_uint(acc[tk][i]), __float_as_uint(acc[tk][16 + i]), false, false); v16[i] = __uint_as_float(rr[0]) + __uint_as_float(rr[1]); }
#pragma unroll
            for (int i = 0; i < 8; ++i) { const auto rr = __builtin_amdgcn_permlane16_swap(__float_as_uint(v16[i]), __float_as_uint(v16[8 + i]), false, false); v8[i] = __uint_as_float(rr[0]) + __uint_as_float(rr[1]); }
#pragma unroll
            for (int i = 0; i < 4; ++i) { const float mine = b3 ? v8[4 + i] : v8[i], oth = b3 ? v8[i] : v8[4 + i]; v4[i] = mine + dpp_f<0x128>(oth); }
#pragma unroll
            for (int i = 0; i < 2; ++i) { const float mine = b2 ? v4[2 + i] : v4[i], oth = b2 ? v4[i] : v4[2 + i]; v2[i] = mine + dpp_f<0x141>(oth); }
            float v1; { const float mine = b1 ? v2[1] : v2[0], oth = b1 ? v2[0] : v2[1]; v1 = mine + dpp_f<0x4E>(oth); }
            const float val = v1 + dpp_f<0xB1>(v1) + bias_e;
            const int e = lane >> 1;
            float tv[4]; int te[4]; float cur = val;
#pragma unroll
            for (int k = 0; k < 4; ++k) {
                float mx = cur;
                mx = fmaxf(mx, dpp_f<0xB1>(mx)); mx = fmaxf(mx, dpp_f<0x4E>(mx)); mx = fmaxf(mx, dpp_f<0x141>(mx)); mx = fmaxf(mx, dpp_f<0x128>(mx));
                { const auto rr = __builtin_amdgcn_permlane16_swap(__float_as_uint(mx), __float_as_uint(mx), false, false); mx = fmaxf(__uint_as_float(rr[0]), __uint_as_float(rr[1])); }
                { const auto rr = __builtin_amdgcn_permlane32_swap(__float_as_uint(mx), __float_as_uint(mx), false, false); mx = fmaxf(__uint_as_float(rr[0]), __uint_as_float(rr[1])); }
                const unsigned long long bm = __ballot(cur == mx);
                const int src = (int)__builtin_ctzll(bm);
                tv[k] = mx; te[k] = src >> 1;
                if ((lane >> 1) == (src >> 1)) cur = -INFINITY;
            }
            const float e1 = __expf(tv[1] - tv[0]), e2x = __expf(tv[2] - tv[0]), e3 = __expf(tv[3] - tv[0]);
            const float inv = 1.0f / (1.0f + e1 + e2x + e3);
            const float gate[4] = {inv, e1 * inv, e2x * inv, e3 * inv};
            const int tl = tl0 + tk;
#pragma unroll
            for (int k = 0; k < 4; ++k) if (lane == k) { tke[tl * 4 + k] = te[k]; tkw[tl * 4 + k] = gate[k];
                __hip_atomic_fetch_add((LAS unsigned*)F.MISC + MW_LCNT + te[k], 1u, __ATOMIC_RELAXED, __HIP_MEMORY_SCOPE_WORKGROUP); }
        }
    }
    __syncthreads();
    if (tid < 32) ((int*)(F.ws + WS_BLKCNT))[F.blk * 32 + tid] = (int)F.MISC[MW_LCNT + tid];
}
__device__ __forceinline__ void p10_assign(Frame& F) {
    const int tid = F.tid;
    const int* blkcnt = (const int*)(F.ws + WS_BLKCNT);
    LAS int* part = (LAS int*)(F.lds);
    LAS int* tke = (LAS int*)(F.lds + RL_TKE); LAS float* tkw = (LAS float*)(F.lds + RL_TKW);
    { const int e = tid & 31, p = tid >> 5; int tot = 0, bef = 0;
      for (int j = 0; j < 16; ++j) { const int bl = p * 16 + j; const int c = blkcnt[bl * 32 + e]; tot += c; bef += (bl < F.blk) ? c : 0; }
      part[p * 32 + e] = tot; part[512 + p * 32 + e] = bef; }
    __syncthreads();
    if (tid < 32) { int tot = 0, bef = 0;
        for (int p = 0; p < 16; ++p) { tot += part[p * 32 + tid]; bef += part[512 + p * 32 + tid]; }
        part[1024 + tid] = tot; F.MISC[MW_BEFORE + tid] = (unsigned)bef; F.MISC[MW_LCNT + tid] = 0u; }
    __syncthreads();
    if (tid == 0) { int ps = 0;
        for (int e = 0; e < 32; ++e) { F.MISC[MW_PSTART + e] = (unsigned)ps; F.MISC[MW_TSTART + e] = (unsigned)(ps >> 8); ps += (part[1024 + e] + 255) & ~255; }
        F.MISC[MW_PSTART + 32] = (unsigned)ps; F.MISC[MW_TSTART + 32] = (unsigned)(ps >> 8); }
    __syncthreads();
    int* slot_tok = (int*)(F.ws + WS_SLOT_TOK); float* slot_w = (float*)(F.ws + WS_SLOT_W);
    for (int idx = tid; idx < 1024; idx += NWAVES * 64) {
        const int e = tke[idx]; const float w = tkw[idx];
        const unsigned r = __hip_atomic_fetch_add((LAS unsigned*)F.MISC + MW_LCNT + e, 1u, __ATOMIC_RELAXED, __HIP_MEMORY_SCOPE_WORKGROUP);
        const unsigned pos = F.MISC[MW_PSTART + e] + F.MISC[MW_BEFORE + e] + r;
        slot_tok[pos] = F.blk * 256 + (idx >> 2); slot_w[pos] = w;
    }
}

#ifndef MK_ONE_LAUNCH
#define MK_ONE_LAUNCH 1
#endif
constexpr int N_PHASES = 13;
struct Args { const float* in[21]; float* out; unsigned char* ws; int ph_lo, ph_hi; };
static_assert(sizeof(Args) == 21 * 8 + 8 + 8 + 8, "no padding");

__global__ void __launch_bounds__(NWAVES * 64, 2) fwd_kernel(Args args) {
    extern __shared__ __attribute__((aligned(16))) unsigned char lds[];
    Frame F;
    F.lds = (LAS unsigned char*)lds;
    F.MISC = (volatile LAS unsigned*)(F.lds + MISC_OFF);
    F.tid = threadIdx.x; F.lane = F.tid & 63; F.wave = __builtin_amdgcn_readfirstlane(F.tid >> 6);
    F.G = gridDim.x; F.blk = blockIdx.x;
    F.ws = args.ws; F.out = args.out; F.ctl = (gu32*)(args.ws + WS_CTL);
#pragma unroll
    for (int i = 0; i < 21; ++i) F.in[i] = args.in[i];
    for (int u = F.tid; u < (LDS_BYTES - MISC_OFF) / 4; u += NWAVES * 64) ((LAS unsigned*)(F.lds + MISC_OFF))[u] = 0u;
    __syncthreads();
    const int lo = args.ph_lo, hi = args.ph_hi;
    XcdBarrier bar; bar.bar = (unsigned*)(F.ctl + CW_BAR); bar.x = 0; bar.st = nullptr;
    if (hi - lo > 1) bar = xcd_barrier_post((unsigned*)(F.ctl + CW_BAR), F.MISC + MW_BAR);
#ifndef PH_MASK
#define PH_MASK 0x1fff
#endif
#define IN(k) (((PH_MASK >> (k)) & 1) && lo <= (k) && (k) < hi)
#ifndef REP_MASK
#define REP_MASK 0
#endif
#define NREP(k) (1 + ((REP_MASK >> (k)) & 1))
#define SEAM(k) do { if (IN(k) && IN((k) + 1)) xcd_barrier(bar); } while (0)
    unsigned char* ws = args.ws;
    bf16_t* proj = (bf16_t*)(ws + WS_P);

    if (IN(0)) for (int rep = 0; rep < NREP(0); ++rep) { if (rep) xcd_barrier(bar); p0_prologue(F); } SEAM(0);

    if (IN(1)) {
        { pg8::DenseSched S; S.init(ws + WS_H, ws + WS_WIN, NTOK, PW, DM, F.G, F.blk);
          pg8::EpiBf16<0> E{proj, PW, nullptr};
          pg8::gemm_phase<pg8::EpiBf16<0>, pg8::DenseSched, true>(F.lds, DM, S, E); }
        { pg8::DenseSched S; S.init(ws + WS_MEMN, ws + WS_WMKV, NMEM, DM, DM, F.G, F.blk);
          pg8::EpiBf16<0> E{(bf16_t*)(ws + WS_MKV), DM, nullptr};
          pg8::gemm_phase<pg8::EpiBf16<0>, pg8::DenseSched, true>(F.lds, DM, S, E); }
    } SEAM(1);

    if (IN(2)) { if (REP_MASK & 4) { p2_prep(F, true); xcd_barrier(bar); } p2_prep(F); } SEAM(2);

    if (IN(3)) {
        bf16_t* osb = (bf16_t*)(ws + WS_O); bf16_t* odsa = osb + (size_t)NTOK * 512; bf16_t* omem = odsa + (size_t)NTOK * 512;
#ifndef REP_DSA
#define REP_DSA 1
#endif
#ifndef REP_SB
#define REP_SB 1
#endif
#ifndef REP_MEM
#define REP_MEM 1
#endif
#ifndef NO_DSA
        for (int rep = 0; rep < REP_DSA; ++rep)
        for (int i = 0; i < 4; ++i) { const int p = 2 * F.blk + (i >> 1), b = p >> 4, cc = p & 15, c = (i & 1) ? 31 - cc : cc; dsa_unit(proj, odsa, b, c, F.lds, F.tid); }
#endif
        const int gw = F.blk * NWAVES + F.wave, NGW = F.G * NWAVES;
#ifndef NO_SB
        for (int rep = 0; rep < REP_SB; ++rep)
        for (int it = gw; it < NB * 8 * 64; it += NGW) { const int qblk = 63 - (it >> 8), bh = it & 255; sb_item(proj, osb, bh >> 3, bh & 7, qblk, F.lds + F.wave * 4096, F.lane); }
#endif
#ifndef NO_MEM
        for (int rep = 0; rep < REP_MEM; ++rep) {
            __syncthreads();
            for (int u = F.blk; u < NB * 4 * 2; u += F.G) mem_unit(proj, (const bf16_t*)(ws + WS_MKV), omem, u >> 3, (u >> 1) & 3, u & 1, F.lds, F.tid);
        }
#endif
    } SEAM(3);

    if (IN(4)) {
        pg8::DenseSched S; S.init(ws + WS_H, ws + WS_WG, NTOK, 3 * DM, DM, F.G, F.blk);
        pg8::EpiBf16<2> E{proj, PW, F.in[11]};
        pg8::gemm_phase<pg8::EpiBf16<2>, pg8::DenseSched, true>(F.lds, DM, S, E);
    } SEAM(4);

    if (IN(5)) {
 pg8::DenseSched S; S.init(ws + WS_O, ws + WS_WB, NTOK, DM, 512, F.G, F.blk);
        pg8::EpiMerge E{proj, 0, (bf16_t*)(ws + WS_H), 1};
        pg8::gemm_phase<pg8::EpiMerge, pg8::DenseSched, true>(F.lds, 512, S, E); } SEAM(5);
    if (IN(6)) { pg8::DenseSched S; S.init(ws + WS_O + (size_t)NTOK * 1024, ws + WS_WB + (size_t)DM * 1024, NTOK, DM, 512, F.G, F.blk);
        pg8::EpiMerge E{proj, DM, (bf16_t*)(ws + WS_H), 0};
        pg8::gemm_phase<pg8::EpiMerge, pg8::DenseSched, true>(F.lds, 512, S, E); } SEAM(6);
    if (IN(7)) { pg8::DenseSched S; S.init(ws + WS_O + (size_t)NTOK * 2048, ws + WS_WB + (size_t)DM * 2048, NTOK, DM, 512, F.G, F.blk);
        pg8::EpiMerge E{proj, 2 * DM, (bf16_t*)(ws + WS_H), 0};
        pg8::gemm_phase<pg8::EpiMerge, pg8::DenseSched, true>(F.lds, 512, S, E); } SEAM(7);

    if (IN(8)) {
        pg8::DenseSched S; S.init(ws + WS_H, ws + WS_WO, NTOK, DM, DM, F.G, F.blk);
        pg8::EpiResid E{F.in[0], F.out};
        pg8::gemm_phase<pg8::EpiResid, pg8::DenseSched, true>(F.lds, DM, S, E);
    } SEAM(8);

    if (IN(9)) for (int rep = 0; rep < NREP(9); ++rep) { if (rep) xcd_barrier(bar); p9_router(F); } SEAM(9);
    if (IN(10)) for (int rep = 0; rep < NREP(10); ++rep) { if (rep) xcd_barrier(bar); p10_assign(F); } SEAM(10);

    if (IN(11)) for (int rep = 0; rep < NREP(11); ++rep) {  if (rep) xcd_barrier(bar);
        pg8::MoeSched S{(const char*)(ws + WS_H), (const char*)(ws + WS_WEI), (const int*)(ws + WS_SLOT_TOK), F.MISC + MW_TSTART, DM, 2048, 8, F.blk};
        pg8::EpiSwiglu E{(bf16_t*)(ws + WS_P), F.in[18]};
        pg8::gemm_phase<pg8::EpiSwiglu, pg8::MoeSched, true>(F.lds, DM, S, E);
    } SEAM(11);

    if (IN(12)) {
        pg8::MoeSched S{(const char*)(ws + WS_P), (const char*)(ws + WS_WEO), nullptr, F.MISC + MW_TSTART, DM, DM, 4, F.blk};
        pg8::EpiScatter E{F.out, (const int*)(ws + WS_SLOT_TOK), (const float*)(ws + WS_SLOT_W), F.in[20], F.lds};
        pg8::gemm_phase<pg8::EpiScatter, pg8::MoeSched, true>(F.lds, DM, S, E);
    }
#undef IN
#undef SEAM
}

extern "C" void kernel_launch(void* const* d_in, const int* in_sizes, int n_in, void* d_out, int out_size, void* d_ws, size_t ws_size, hipStream_t stream) {
    static int grid = 0;
    if (grid == 0) {
        if (n_in != 21 || in_sizes[0] != NTOK * DM || out_size != NTOK * DM || ws_size < WS_END) {
            fprintf(stderr, "kernel_launch: unexpected shapes: n_in %d in0 %d out %d ws %zu (need >= %zu); nothing launched\n", n_in, n_in > 0 ? in_sizes[0] : -1, out_size, ws_size, (size_t)WS_END); grid = -1; return; }
        int dev = 0, cus = 0, per_cu = 0;
        if (hipGetDevice(&dev) != hipSuccess || hipDeviceGetAttribute(&cus, hipDeviceAttributeMultiprocessorCount, dev) != hipSuccess) { fprintf(stderr, "kernel_launch: device query failed\n"); grid = -1; return; }
        if (hipFuncSetAttribute((const void*)fwd_kernel, hipFuncAttributeMaxDynamicSharedMemorySize, LDS_BYTES) != hipSuccess) { fprintf(stderr, "kernel_launch: hipFuncSetAttribute failed\n"); grid = -1; return; }
        if (hipOccupancyMaxActiveBlocksPerMultiprocessor(&per_cu, (const void*)fwd_kernel, NWAVES * 64, LDS_BYTES) != hipSuccess || per_cu < 1)
            fprintf(stderr, "kernel_launch: note: occupancy query reports %d workgroups per CU\n", per_cu);
        (void)hipGetLastError();
        grid = cus;
        if (grid != 256) { fprintf(stderr, "kernel_launch: this kernel is built for 256 CUs (got %d); nothing launched\n", grid); grid = -1; return; }
    }
    if (grid < 0) return;
    if (hipMemsetAsync((char*)d_ws + WS_CTL, 0, CTL_ZERO_BYTES, stream) != hipSuccess) { fprintf(stderr, "kernel_launch: hipMemsetAsync failed\n"); return; }
    Args a{};
    for (int i = 0; i < 21; ++i) a.in[i] = (const float*)d_in[i];
    a.out = (float*)d_out; a.ws = (unsigned char*)d_ws;
#if MK_ONE_LAUNCH
    const int cuts[2] = {0, N_PHASES}; const int nl = 1;
#else
    const int cuts[11] = {0, 1, 2, 3, 4, 5, 6, 7, 8, 9, N_PHASES}; const int nl = 10;
#endif
    for (int li = 0; li < nl; ++li) {
        a.ph_lo = cuts[li]; a.ph_hi = cuts[li + 1];
        hipLaunchKernelGGL(fwd_kernel, dim3(grid), dim3(NWAVES * 64), LDS_BYTES, stream, a);
        const hipError_t le = hipPeekAtLastError();
        if (le != hipSuccess) { fprintf(stderr, "kernel_launch: launch %d failed: %s\n", li, hipGetErrorName(le)); break; }
    }
}
```

```cpp
#include <hip/hip_runtime.h>
#include <cstdio>
#include <cstdint>

#define LAS __attribute__((address_space(3)))
#define GAS __attribute__((address_space(1)))
typedef unsigned short bf16_t;
typedef short bf16x8 __attribute__((ext_vector_type(8)));
typedef short s16x4 __attribute__((ext_vector_type(4)));
typedef short v4i16_t __attribute__((ext_vector_type(4)));
typedef float f32x2 __attribute__((ext_vector_type(2)));
typedef float f32x4 __attribute__((ext_vector_type(4)));
typedef float f32x16 __attribute__((ext_vector_type(16)));
typedef unsigned u32x2 __attribute__((ext_vector_type(2)));
typedef unsigned u32x4 __attribute__((ext_vector_type(4)));
typedef GAS unsigned gu32;

constexpr int NB = 32, SEQ = 2048, DM = 1024, NTOK = NB * SEQ;
constexpr int MEMLEN = 256, NMEM = NB * MEMLEN;
constexpr int PW = 3072;
constexpr int C_SQ = 0, C_SK = 512, C_SV = 1024, C_DQ = 1536, C_DK = 2048, C_DV = 2112, C_IQ = 2176, C_IK = 2432, C_IW = 2496, C_MQ = 2560;
constexpr int IN_W = 3012;
constexpr int NEXP = 32, TOPK = 4, DEXP = 1024;
constexpr int NSLOT = NTOK * TOPK;
constexpr int NSLOT_PAD = NSLOT + NEXP * 256;
constexpr float EPS = 1e-6f;
constexpr float LOG2E = 1.4426950408889634f;

constexpr size_t MiB = 1u << 20;
constexpr size_t WS_CTL = 0, CTL_ZERO_BYTES = 1 * MiB;
constexpr size_t WS_ROPE = 1 * MiB;
constexpr size_t WS_BLKCNT = 1 * MiB + 512 * 1024;
constexpr size_t WS_SLOT_TOK = 2 * MiB;
constexpr size_t WS_SLOT_W = 4 * MiB;
constexpr size_t WS_WIN = 8 * MiB;
constexpr size_t WS_WMKV = 14 * MiB;
constexpr size_t WS_WG = 16 * MiB;
constexpr size_t WS_WB = 22 * MiB;
constexpr size_t WS_WO = 25 * MiB;
constexpr size_t WS_WEI = 27 * MiB;
constexpr size_t WS_WEO = 155 * MiB;
constexpr size_t WS_H = 220 * MiB;
constexpr size_t WS_P = 348 * MiB;
constexpr size_t WS_O = 732 * MiB;
constexpr size_t WS_MEMN = 924 * MiB;
constexpr size_t WS_MKV = 940 * MiB;
constexpr size_t WS_END = 956 * MiB;
static_assert(WS_P + (size_t)NSLOT_PAD * DEXP * 2 <= WS_MEMN, "act overlays proj|o");
static_assert(WS_SLOT_TOK + (size_t)NSLOT_PAD * 4 <= WS_SLOT_W && WS_SLOT_W + (size_t)NSLOT_PAD * 4 <= WS_WIN, "slot tables");

constexpr int CW_BAR = 4096;

constexpr int RING_BYTES = 151552;
constexpr int MISC_OFF = RING_BYTES;
constexpr int LDS_BYTES = 155648;
constexpr int MW_BAR = 8;
constexpr int MW_LCNT = 16;
constexpr int MW_PSTART = 64;
constexpr int MW_TSTART = 128;
constexpr int MW_BEFORE = 192;
constexpr int MW_PART = 256;

__device__ __forceinline__ unsigned f2bf(float f) { unsigned u = __builtin_bit_cast(unsigned, f); return (u + 0x7fffu + ((u >> 16) & 1u)) >> 16; }
__device__ __forceinline__ unsigned pk2(float lo, float hi) { return f2bf(lo) | (f2bf(hi) << 16); }
__device__ __forceinline__ float bf2f(unsigned short b) { return __builtin_bit_cast(float, (unsigned)b << 16); }
__device__ __forceinline__ float bflo(unsigned w) { return __builtin_bit_cast(float, w << 16); }
__device__ __forceinline__ float bfhi(unsigned w) { return __builtin_bit_cast(float, w & 0xffff0000u); }
__device__ __forceinline__ unsigned cvt_pk_bf16(float lo, float hi) { unsigned r; asm volatile("v_cvt_pk_bf16_f32 %0, %1, %2" : "=v"(r) : "v"(lo), "v"(hi)); return r; }
__device__ __forceinline__ int crow(int r, int hi) { return (r & 3) + 8 * (r >> 2) + 4 * hi; }
#define LDS_WAIT() asm volatile("s_waitcnt lgkmcnt(0)" ::: "memory")
#define VM_WAIT() asm volatile("s_waitcnt vmcnt(0)" ::: "memory")

namespace pg8 {
constexpr int BM = 256, BK = 64, HALF = 128, HTB = HALF * BK * 2, STAGE_BYTES = 8 * HTB;
__host__ __device__ __forceinline__ int lds_byte(int r, int c) { const int st = (r >> 4) * 2 + (c >> 5), rr = r & 15, cc = c & 31, ob = rr * 64 + cc * 2; return st * 1024 + (ob ^ (((ob >> 9) & 1) << 5)); }
__host__ __device__ __forceinline__ void stage_rc(int b, int& R, int& C) { const int st = b / 1024, sb = b % 1024, swz = sb ^ (((sb >> 9) & 1) << 5); R = (st >> 1) * 16 + swz / 64; C = (st & 1) * 32 + (swz % 64) / 2; }
__host__ __device__ __forceinline__ int perm32(int rho) { const int n = rho >> 4, i = rho & 15; return 8 * (i >> 2) + 4 * n + (i & 3); }

struct Unit { int pm, pn, e; };

template <class Epi, class Sched, bool ALIGN_EPI>
__device__ __forceinline__ void gemm_phase(LAS unsigned char* lds, const int K, const Sched& S, const Epi& E) {
    const int tid = threadIdx.x, wid = __builtin_amdgcn_readfirstlane(tid >> 6), lane = tid & 63, wr = wid >> 2, wc = wid & 3, fr = lane & 15, fq = lane >> 4;
    const int nt = K / BK;
    int Rr[2], Cc[2]; unsigned voffB[2];
#pragma unroll
    for (int i = 0; i < 2; ++i) { int R, C; stage_rc(tid * 16 + i * 8192, R, C); Rr[i] = R; Cc[i] = C; const int Rb = Epi::PERM ? ((R & ~31) + perm32(R & 31)) : R; voffB[i] = (unsigned)(Rb * K + C) * 2u; }
    const size_t kstep = (size_t)(BK * 2);
    const size_t hstepB = (size_t)HALF * K * 2;
    const unsigned ldsw = (unsigned)wid * 1024u;
    const int aoff = lds_byte(wr * 64 + fr, fq * 8), boff = lds_byte(wc * 32 + fr, fq * 8);
#define PG8_SA(b, h) (((b) * 2 + (h)) * HTB)
#define PG8_SB(b, h) ((4 + (b) * 2 + (h)) * HTB)
#define PG8_STAGE(bufoff, gbase, voff) do { _Pragma("unroll") for (int _i = 0; _i < 2; ++_i) \
        __builtin_amdgcn_global_load_lds((const unsigned*)((const char*)(gbase) + (voff)[_i]), (LAS unsigned*)(lds + (bufoff) + ldsw + _i * 8192), 16, 0, 0); } while (0)
#define PG8_LDA(dst, b, h) do { _Pragma("unroll") for (int m = 0; m < 4; ++m) _Pragma("unroll") for (int k = 0; k < 2; ++k) dst[m][k] = *(const LAS bf16x8*)(lds + PG8_SA(b, h) + aoff + m * 2048 + k * 1024); } while (0)
#define PG8_LDB(dst, b, h) do { _Pragma("unroll") for (int n = 0; n < 2; ++n) _Pragma("unroll") for (int k = 0; k < 2; ++k) dst[n][k] = *(const LAS bf16x8*)(lds + PG8_SB(b, h) + boff + n * 2048 + k * 1024); } while (0)
#define PG8_MMA(ai, bj, At, Bt) do { __builtin_amdgcn_s_setprio(1); _Pragma("unroll") for (int m = 0; m < 4; ++m) _Pragma("unroll") for (int n = 0; n < 2; ++n) _Pragma("unroll") for (int k = 0; k < 2; ++k) \
        acc[ai][bj][m][n] = __builtin_amdgcn_mfma_f32_16x16x32_bf16(Bt[n][k], At[m][k], acc[ai][bj][m][n], 0, 0, 0); __builtin_amdgcn_s_setprio(0); } while (0)
#define PG8_WAIT_V(n) asm volatile("s_waitcnt vmcnt(" #n ")" ::: "memory")
#define PG8_WAIT_L(n) asm volatile("s_waitcnt lgkmcnt(" #n ")" ::: "memory")
#define PG8_BAR __builtin_amdgcn_s_barrier()
#define PG8_SCHED __builtin_amdgcn_sched_barrier(0)
    Unit cur, nxt; int ui = 0;
    if (!S.next(0, cur)) return;
    { const int ns = S.stagger();
      for (int q = 0; q < ns; ++q) __builtin_amdgcn_s_sleep(4); }
    f32x4 acc[2][2][4][2];
#pragma unroll
    for (int a = 0; a < 2; ++a)
#pragma unroll
        for (int b = 0; b < 2; ++b)
#pragma unroll
            for (int m = 0; m < 4; ++m)
#pragma unroll
                for (int n = 0; n < 2; ++n) acc[a][b][m][n] = (f32x4){0.f, 0.f, 0.f, 0.f};
    bf16x8 At[4][2], B0[2][2], B1[2][2];
    const char* Ab = S.a_base();
    unsigned ca0[2], ca1[2], na0[2], na1[2];
#pragma unroll
    for (int i = 0; i < 2; ++i) { ca0[i] = S.a_off(cur, Rr[i], Cc[i]); ca1[i] = S.a_off(cur, HALF + Rr[i], Cc[i]); }
    const char* cB = S.b_tile(cur);
    PG8_STAGE(PG8_SB(0, 0), cB, voffB); PG8_STAGE(PG8_SB(0, 1), cB + hstepB, voffB); PG8_STAGE(PG8_SA(0, 0), Ab, ca0); PG8_STAGE(PG8_SA(0, 1), Ab, ca1);
    if (wr == 1) PG8_BAR;
    PG8_WAIT_V(2); PG8_BAR;
    PG8_STAGE(PG8_SB(1, 0), cB + kstep, voffB); PG8_STAGE(PG8_SA(1, 0), Ab + kstep, ca0); PG8_STAGE(PG8_SB(1, 1), cB + hstepB + kstep, voffB);
    PG8_WAIT_V(6); PG8_BAR;
    for (;;) {
        typename Epi::Pre pre = E.preload(cur, wr, wc, fr, fq);
        const bool has_next = S.next(ui + 1, nxt);
        const char* nB = cB;
#pragma unroll
        for (int i = 0; i < 2; ++i) { na0[i] = ca0[i]; na1[i] = ca1[i]; }
        if (has_next) { nB = S.b_tile(nxt);
#pragma unroll
            for (int i = 0; i < 2; ++i) { na0[i] = S.a_off(nxt, Rr[i], Cc[i]); na1[i] = S.a_off(nxt, HALF + Rr[i], Cc[i]); } }
        if constexpr (Epi::DRAIN_TOP) { PG8_WAIT_V(0); }
        for (int t = 0; t < nt; t += 2) {
            const bool last = (t == nt - 2);
            const char* a1 = Ab + (size_t)(t + 1) * kstep;
            const char* a2 = last ? Ab : Ab + (size_t)(t + 2) * kstep; const char* b2 = last ? nB : cB + (size_t)(t + 2) * kstep;
            const char* a3 = a2 + kstep; const char* b3 = b2 + kstep;
            unsigned o20[2], o21[2];
#pragma unroll
            for (int i = 0; i < 2; ++i) { o20[i] = last ? na0[i] : ca0[i]; o21[i] = last ? na1[i] : ca1[i]; }
            PG8_LDB(B0, 0, 0); PG8_LDB(B1, 0, 1); PG8_SCHED; PG8_LDA(At, 0, 0); PG8_STAGE(PG8_SA(1, 1), a1, ca1);
            PG8_WAIT_V(8); PG8_WAIT_L(0); PG8_BAR; PG8_MMA(0, 0, At, B0); PG8_MMA(0, 1, At, B1); PG8_BAR; PG8_SCHED;
            PG8_LDA(At, 0, 1); PG8_STAGE(PG8_SB(0, 0), b2, voffB); PG8_STAGE(PG8_SB(0, 1), b2 + hstepB, voffB); PG8_STAGE(PG8_SA(0, 0), a2, o20);
            PG8_WAIT_V(8); PG8_WAIT_L(0); PG8_BAR; PG8_MMA(1, 0, At, B0); PG8_MMA(1, 1, At, B1); PG8_BAR; PG8_SCHED;
            PG8_LDB(B0, 1, 0); PG8_LDB(B1, 1, 1); PG8_SCHED; PG8_LDA(At, 1, 0); PG8_STAGE(PG8_SA(0, 1), a2, o21);
            PG8_WAIT_V(8); PG8_WAIT_L(0); PG8_BAR; PG8_MMA(0, 0, At, B0); PG8_MMA(0, 1, At, B1); PG8_BAR; PG8_SCHED;
            PG8_LDA(At, 1, 1); PG8_STAGE(PG8_SB(1, 0), b3, voffB); PG8_STAGE(PG8_SB(1, 1), b3 + hstepB, voffB); PG8_STAGE(PG8_SA(1, 0), a3, o20);
            PG8_WAIT_V(8); PG8_WAIT_L(0); PG8_BAR; PG8_MMA(1, 0, At, B0); PG8_MMA(1, 1, At, B1); PG8_BAR; PG8_SCHED;
        }
        if constexpr (ALIGN_EPI) { if (wr == 0) PG8_BAR; }
        E(acc, cur, wr, wc, fr, fq, pre);
        if (!has_next) break;
#pragma unroll
        for (int a = 0; a < 2; ++a)
#pragma unroll
            for (int b = 0; b < 2; ++b)
#pragma unroll
                for (int m = 0; m < 4; ++m)
#pragma unroll
                    for (int n = 0; n < 2; ++n) acc[a][b][m][n] = (f32x4){0.f, 0.f, 0.f, 0.f};
        cur = nxt; cB = nB; ++ui;
#pragma unroll
        for (int i = 0; i < 2; ++i) { ca0[i] = na0[i]; ca1[i] = na1[i]; }
        if constexpr (ALIGN_EPI) { if (wr == 1) PG8_BAR; }
    }
    PG8_WAIT_V(0);
    if constexpr (!ALIGN_EPI) { if (wr == 0) PG8_BAR; }
    PG8_BAR;
#undef PG8_SA
#undef PG8_SB
#undef PG8_STAGE
#undef PG8_LDA
#undef PG8_LDB
#undef PG8_MMA
#undef PG8_WAIT_V
#undef PG8_WAIT_L
#undef PG8_BAR
#undef PG8_SCHED
}

struct DenseSched {
    const char* A; const char* Bt; int K, nM, nN, nwg, G, c, stag = 0, amask = -1;
    __device__ __forceinline__ void init(const void* A_, const void* Bt_, int M, int N, int K_, int G_, int c_) { A = (const char*)A_; Bt = (const char*)Bt_; K = K_; nM = M / BM; nN = N / BM; nwg = nM * nN; G = G_; c = c_; }
    __device__ __forceinline__ bool next(int i, Unit& u) const {
        const long L = (long)i * G + c; if (L >= nwg) return false;
        int wgid = (int)L; { const int q = nwg / 8, r = nwg % 8, xcd = wgid % 8, off = wgid / 8; wgid = (xcd < r ? xcd * (q + 1) : r * (q + 1) + (xcd - r) * q) + off; }
        const int nig = 8 * nN, gid = wgid / nig, fm = gid * 8, gsz = (nM - fm) < 8 ? (nM - fm) : 8;
        u.pm = fm + ((wgid % nig) % gsz); u.pn = (wgid % nig) / gsz; u.e = 0; return true;
    }
    __device__ __forceinline__ const char* a_base() const { return A; }
    __device__ __forceinline__ int stagger() const { return stag ? ((c >> 3) & 7) * (K / 55) : 0; }
    __device__ __forceinline__ unsigned a_off(const Unit& u, int row, int col) const { return (unsigned)(((size_t)((u.pm * BM + row) & amask) * K + col) * 2); }
    __device__ __forceinline__ int a_row(const Unit& u, int row) const { return (u.pm * BM + row) & amask; }
    __device__ __forceinline__ unsigned row_off(int r, int col) const { return (unsigned)(((size_t)r * K + col) * 2); }
    __device__ __forceinline__ const char* b_tile(const Unit& u) const { return Bt + (size_t)u.pn * BM * K * 2; }
};
}

namespace pg8 {
struct MoeSched {
    const char* A; const char* Bt; const int* slot_tok; volatile LAS unsigned* tstart; int K, rowsE, nN, c;
    __device__ __forceinline__ bool next(int i, Unit& u) const {
        const int x = c & 7, j = c >> 3, rpr = 32 / nN;
        const int pm = (i * 8 + x) * rpr + j / nN;
        const int T = (int)tstart[32];
        if (pm >= T) return false;
        int e = 0;
#pragma unroll 1
        for (int k = 1; k < 32; ++k) e += ((int)tstart[k] <= pm) ? 1 : 0;
        u.pm = pm; u.pn = j % nN; u.e = __builtin_amdgcn_readfirstlane(e); return true;
    }
    __device__ __forceinline__ const char* a_base() const { return A; }
    __device__ __forceinline__ int stagger() const { const int g = (c >> 3) / nN, ng = 32 / nN; (void)g; (void)ng; return 0; }
    __device__ __forceinline__ unsigned a_off(const Unit& u, int row, int col) const {
        const int pos = u.pm * BM + row;
        const int r = slot_tok ? slot_tok[pos] : pos;
        return (unsigned)(((size_t)r * K + col) * 2);
    }
    __device__ __forceinline__ int a_row(const Unit& u, int row) const { const int pos = u.pm * BM + row; return slot_tok ? ((const GAS int*)slot_tok)[pos] : pos; }
    __device__ __forceinline__ unsigned row_off(int r, int col) const { return (unsigned)(((size_t)r * K + col) * 2); }
    __device__ __forceinline__ const char* b_tile(const Unit& u) const { return Bt + ((size_t)u.e * rowsE + (size_t)u.pn * BM) * K * 2; }
};

struct NoPre {};
template <int ACT> struct EpiBf16 {
    static constexpr bool PERM = true, DRAIN_TOP = false;
    struct Pre { f32x4 bv[2][2]; };
    bf16_t* O; int ldc; const float* bias; int rowmask = -1;
    __device__ __forceinline__ Pre preload(const Unit& u, int wr, int wc, int fr, int fq) const { Pre p; const int col0 = u.pn * BM + wc * 32 + 8 * fq;
#pragma unroll
        for (int bj = 0; bj < 2; ++bj)
#pragma unroll
            for (int n = 0; n < 2; ++n) p.bv[bj][n] = (f32x4){0.f, 0.f, 0.f, 0.f};
        return p; }
    __device__ __forceinline__ void arrived(Pre& p) const { asm volatile("" : "+v"(p.bv[0][0]), "+v"(p.bv[0][1]), "+v"(p.bv[1][0]), "+v"(p.bv[1][1])); }
    __device__ __forceinline__ void operator()(const f32x4 (&acc)[2][2][4][2], const Unit& u, int wr, int wc, int fr, int fq, const Pre& pre) const {
        const int row0 = u.pm * BM + wr * 64 + fr; const int col0 = u.pn * BM + wc * 32 + 8 * fq;
        f32x4 bv[2][2];
#pragma unroll
        for (int bj = 0; bj < 2; ++bj)
#pragma unroll
            for (int n = 0; n < 2; ++n) bv[bj][n] = bias ? *(const f32x4*)(bias + col0 + bj * HALF + 4 * n) : pre.bv[bj][n];
#pragma unroll
        for (int ai = 0; ai < 2; ++ai)
#pragma unroll
            for (int m = 0; m < 4; ++m) { bf16_t* rowp = O + (size_t)((row0 + ai * HALF + m * 16) & rowmask) * ldc + col0;
#pragma unroll
                for (int bj = 0; bj < 2; ++bj) { f32x4 v0 = acc[ai][bj][m][0] + bv[bj][0], v1 = acc[ai][bj][m][1] + bv[bj][1];
                    if (ACT == 2) {
#pragma unroll
                        for (int q = 0; q < 4; ++q) { v0[q] = __builtin_amdgcn_rcpf(1.f + __builtin_amdgcn_exp2f(-LOG2E * v0[q])); v1[q] = __builtin_amdgcn_rcpf(1.f + __builtin_amdgcn_exp2f(-LOG2E * v1[q])); } }
                    u32x4 w; w.x = cvt_pk_bf16(v0[0], v0[1]); w.y = cvt_pk_bf16(v0[2], v0[3]); w.z = cvt_pk_bf16(v1[0], v1[1]); w.w = cvt_pk_bf16(v1[2], v1[3]);
                    *(u32x4*)(rowp + bj * HALF) = w; } }
    }
};
struct EpiMerge {
    static constexpr bool PERM = true, DRAIN_TOP = false;
    typedef NoPre Pre; __device__ __forceinline__ Pre preload(const Unit&, int, int, int, int) const { return Pre{}; }
    const bf16_t* G; int goff; bf16_t* Mg; int first;
    __device__ __forceinline__ void operator()(const f32x4 (&acc)[2][2][4][2], const Unit& u, int wr, int wc, int fr, int fq, const Pre&) const {
        const int row0 = u.pm * BM + wr * 64 + fr; const int col0 = u.pn * BM + wc * 32 + 8 * fq;
#pragma unroll
        for (int ai = 0; ai < 2; ++ai)
#pragma unroll
            for (int m = 0; m < 4; ++m) { const size_t row = (size_t)(row0 + ai * HALF + m * 16);
#pragma unroll
                for (int bj = 0; bj < 2; ++bj) {
                    const u32x4 g = *(const u32x4*)(G + row * PW + goff + col0 + bj * HALF);
                    u32x4 p = (u32x4){0u, 0u, 0u, 0u};
                    if (!first) p = *(const u32x4*)(Mg + row * DM + col0 + bj * HALF);
                    const f32x4 a0 = acc[ai][bj][m][0], a1 = acc[ai][bj][m][1];
                    u32x4 w;
                    w.x = cvt_pk_bf16(bflo(p.x) + bflo(g.x) * a0[0], bfhi(p.x) + bfhi(g.x) * a0[1]);
                    w.y = cvt_pk_bf16(bflo(p.y) + bflo(g.y) * a0[2], bfhi(p.y) + bfhi(g.y) * a0[3]);
                    w.z = cvt_pk_bf16(bflo(p.z) + bflo(g.z) * a1[0], bfhi(p.z) + bfhi(g.z) * a1[1]);
                    w.w = cvt_pk_bf16(bflo(p.w) + bflo(g.w) * a1[2], bfhi(p.w) + bfhi(g.w) * a1[3]);
                    *(u32x4*)(Mg + row * DM + col0 + bj * HALF) = w; } }
    }
};
struct EpiResid {
    static constexpr bool PERM = false, DRAIN_TOP = false;
    typedef NoPre Pre; __device__ __forceinline__ Pre preload(const Unit&, int, int, int, int) const { return Pre{}; }
    const float* base; float* out;
    __device__ __forceinline__ void operator()(const f32x4 (&acc)[2][2][4][2], const Unit& u, int wr, int wc, int fr, int fq, const Pre&) const {
        const int row0 = u.pm * BM + wr * 64 + fr; const int col0 = u.pn * BM + wc * 32 + 4 * fq;
#pragma unroll
        for (int ai = 0; ai < 2; ++ai)
#pragma unroll
            for (int m = 0; m < 4; ++m) { const size_t off = (size_t)(row0 + ai * HALF + m * 16) * DM + col0;
#pragma unroll
                for (int bj = 0; bj < 2; ++bj)
#pragma unroll
                    for (int n = 0; n < 2; ++n) { const f32x4 b = *(const f32x4*)(base + off + bj * HALF + n * 16); *(f32x4*)(out + off + bj * HALF + n * 16) = b + acc[ai][bj][m][n]; } }
    }
};
struct EpiSwiglu {
    static constexpr bool PERM = true, DRAIN_TOP = true;
    bf16_t* act; const float* bias;
    struct Pre { f32x4 bg[2], bu[2]; };
    __device__ __forceinline__ void arrived(Pre& p) const { asm volatile("" : "+v"(p.bg[0]), "+v"(p.bg[1]), "+v"(p.bu[0]), "+v"(p.bu[1])); }
    __device__ __forceinline__ Pre preload(const Unit& u, int wr, int wc, int fr, int fq) const {
        const GAS float* be = (const GAS float*)bias + (size_t)u.e * 2048 + u.pn * HALF + wc * 32 + 8 * fq; Pre p;
#pragma unroll
        for (int n = 0; n < 2; ++n) { p.bg[n] = *(const GAS f32x4*)(be + 4 * n); p.bu[n] = *(const GAS f32x4*)(be + 1024 + 4 * n); }
        return p; }
    __device__ __forceinline__ void operator()(const f32x4 (&acc)[2][2][4][2], const Unit& u, int wr, int wc, int fr, int fq, const Pre& pre) const {
        const int row0 = u.pm * BM + wr * 64 + fr; const int col0 = u.pn * HALF + wc * 32 + 8 * fq;
        f32x4 bg[2], bu[2];
#pragma unroll
        for (int n = 0; n < 2; ++n) { bg[n] = pre.bg[n]; bu[n] = pre.bu[n]; }
#pragma unroll
        for (int ai = 0; ai < 2; ++ai)
#pragma unroll
            for (int m = 0; m < 4; ++m) { bf16_t* rowp = act + (size_t)(row0 + ai * HALF + m * 16) * DEXP + col0;
                float o[8];
#pragma unroll
                for (int n = 0; n < 2; ++n) { const f32x4 gv = acc[ai][0][m][n] + bg[n], uv = acc[ai][1][m][n] + bu[n];
#pragma unroll
                    for (int q = 0; q < 4; ++q) { const float g = fminf(gv[q], 7.0f); const float uu = fminf(fmaxf(uv[q], -7.0f), 7.0f);
                        const float sg = __builtin_amdgcn_rcpf(1.f + __builtin_amdgcn_exp2f(-1.702f * LOG2E * g));
                        o[4 * n + q] = (uu + 1.0f) * (g * sg); } }
                u32x4 w; w.x = cvt_pk_bf16(o[0], o[1]); w.y = cvt_pk_bf16(o[2], o[3]); w.z = cvt_pk_bf16(o[4], o[5]); w.w = cvt_pk_bf16(o[6], o[7]);
                *(u32x4*)rowp = w; }
    }
};
constexpr int EPI_STAGE_OFF = 131072, EPI_STAGE_WAVE = 2304;
struct EpiScatter {
    static constexpr bool PERM = false, DRAIN_TOP = false;
    typedef NoPre Pre; __device__ __forceinline__ Pre preload(const Unit&, int, int, int, int) const { return Pre{}; }
    float* out; const int* slot_tok; const float* slot_w; const float* bias; LAS unsigned char* lds;
    __device__ __forceinline__ void operator()(const f32x4 (&acc)[2][2][4][2], const Unit& u, int wr, int wc, int fr, int fq, const Pre&) const {
        const int lane = fr + 16 * fq, wid = wr * 4 + wc;
        LAS float* st = (LAS float*)(lds + EPI_STAGE_OFF + wid * EPI_STAGE_WAVE);
        const int row0 = u.pm * BM + wr * 64 + fr;
        const int lcol = lane & 31, lrow = lane >> 5;
        float bv[2];
#pragma unroll
        for (int bj = 0; bj < 2; ++bj) bv[bj] = bias[(size_t)u.e * DM + u.pn * BM + bj * HALF + wc * 32 + lcol];
#pragma unroll
        for (int ai = 0; ai < 2; ++ai)
#pragma unroll
            for (int m = 0; m < 4; ++m) { const int pos = row0 + ai * HALF + m * 16; const float w = slot_w[pos]; const int tok = slot_tok[pos];
#pragma unroll
                for (int bj = 0; bj < 2; ++bj) {
#pragma unroll
                    for (int n = 0; n < 2; ++n) *(LAS f32x4*)(st + fr * 36 + 16 * n + 4 * fq) = acc[ai][bj][m][n];
                    asm volatile("s_waitcnt lgkmcnt(0)" ::: "memory");
#pragma unroll
                    for (int i = 0; i < 8; ++i) { const int r = 2 * i + lrow; const float v = st[r * 36 + lcol];
                        const float wr_ = __shfl(w, r); const int tr_ = __shfl(tok, r);
                        if (wr_ != 0.f) unsafeAtomicAdd(out + (size_t)tr_ * DM + u.pn * BM + bj * HALF + wc * 32 + lcol, (v + bv[bj]) * wr_); }
                    asm volatile("s_waitcnt lgkmcnt(0)" ::: "memory");
                } }
    }
};
}

#define XB_TMO      128
#define XB_XCNT(j)  (256  + 64 * (j))
#define XB_XSUB(j)  (1280 + 64 * (j))
#define XB_XGEN(j)  (2304 + 64 * (j))
#define XB_TOP      3328
#define XB_TOPGEN   3392
#define XCD_BAR_WORDS 3456
#define XB_SPIN_CAP (1u << 18)

__device__ __forceinline__ unsigned xb_ld(unsigned* p)              { return __hip_atomic_load(p, __ATOMIC_RELAXED, __HIP_MEMORY_SCOPE_AGENT); }
__device__ __forceinline__ unsigned xb_add(unsigned* p, unsigned v) { return __hip_atomic_fetch_add(p, v, __ATOMIC_RELAXED, __HIP_MEMORY_SCOPE_AGENT); }
__device__ __forceinline__ unsigned xb_xcc_id() { return (unsigned)__builtin_amdgcn_s_getreg((3 << 11) | 20) & 0xFu; }
#define XB_SPIN(cond, bar) do { unsigned _sp = 0; while (cond) { __builtin_amdgcn_s_sleep(1); \
    if ((++_sp & 255u) == 0u) { if (xb_ld(&(bar)[XB_TMO])) break; if (_sp > XB_SPIN_CAP) { atomicAdd(&(bar)[XB_TMO], 1u); break; } } } } while (0)

struct XcdBarrier {
    unsigned* bar; unsigned x;
    volatile LAS unsigned* st;
};

__device__ __forceinline__ XcdBarrier xcd_barrier_post(unsigned* bar, volatile LAS unsigned* st) {
    XcdBarrier b; b.bar = bar; b.x = xb_xcc_id(); b.st = st;
    if (threadIdx.x == 0) (void)xb_add(&bar[XB_XCNT(b.x)], 1u);
    return b;
}
__device__ __forceinline__ void xcd_barrier_complete(unsigned* bar, unsigned x, unsigned& nloc, unsigned& nx) {
    const unsigned G = gridDim.x * gridDim.y * gridDim.z;
    unsigned sum, cnt, mine, sp = 0u;
    for (;;) {
        sum = 0u; cnt = 0u; mine = 0u;
#pragma unroll
        for (unsigned j = 0; j < 16; ++j) { const unsigned c = xb_ld(&bar[XB_XCNT(j)]); sum += c; cnt += (c > 0u) ? 1u : 0u; mine = (j == x) ? c : mine; }
        if (sum == G) break;
        __builtin_amdgcn_s_sleep(1);
        if ((++sp & 255u) == 0u) { if (xb_ld(&bar[XB_TMO])) break; if (sp > XB_SPIN_CAP) { atomicAdd(&bar[XB_TMO], 1u); break; } }
    }
    nloc = mine > 0u ? mine : 1u; nx = cnt > 0u ? cnt : 1u;
}

__device__ __forceinline__ void xcd_barrier(const XcdBarrier& b) {
    asm volatile("s_waitcnt vmcnt(0)" ::: "memory");
    __syncthreads();
    if (threadIdx.x == 0) {
        unsigned* bar = b.bar;
        __builtin_amdgcn_s_waitcnt(0);
        unsigned nloc = b.st[0], nx = b.st[1];
        if (nloc == 0u) { xcd_barrier_complete(bar, b.x, nloc, nx); b.st[0] = nloc; b.st[1] = nx; }
        const unsigned old = xb_add(&bar[XB_XSUB(b.x)], 1u);
        const unsigned gen = old / nloc;
        if (old + 1u == (gen + 1u) * nloc) {
            __builtin_amdgcn_fence(__ATOMIC_RELEASE, "agent");
            asm volatile("s_waitcnt vmcnt(0)" ::: "memory");
            const unsigned og = xb_add(&bar[XB_TOP], 1u);
            const unsigned tg = og / nx;
            if (og + 1u == (tg + 1u) * nx) xb_add(&bar[XB_TOPGEN], 1u);
            else XB_SPIN(xb_ld(&bar[XB_TOPGEN]) == tg, bar);
            __builtin_amdgcn_fence(__ATOMIC_ACQUIRE, "agent");
            xb_add(&bar[XB_XGEN(b.x)], 1u);
            asm volatile("s_waitcnt vmcnt(0)" ::: "memory");
        } else {
            XB_SPIN(xb_ld(&bar[XB_XGEN(b.x)]) == gen, bar);
            __builtin_amdgcn_fence(__ATOMIC_ACQUIRE, "agent");
            asm volatile("s_waitcnt vmcnt(0)" ::: "memory");
        }
    }
    __syncthreads();
}

constexpr int NWAVES = 8;
struct Frame {
    LAS unsigned char* lds;
    volatile LAS unsigned* MISC;
    gu32* ctl;
    int tid, lane, wave, G, blk;
    const float* in[21];
    float* out; unsigned char* ws;
};
__device__ __forceinline__ float wave_sum(float v) {
#pragma unroll
    for (int o = 1; o < 64; o <<= 1) v += __shfl_xor(v, o);
    return v;
}

__device__ __forceinline__ int map_src(int mode, int n) {
    if (mode == 1) return n < 2500 ? n : (n >= C_MQ ? n - (C_MQ - 2500) : -1);
    if (mode == 2) { const int pn = n >> 8, bj = (n >> 7) & 1, j = n & 127; return bj * 1024 + pn * 128 + j; }
    return n;
}
__device__ __forceinline__ void transpose_item(const float* W, int K, int Nsrc, int Ndst, bf16_t* WT, int mode, LAS float* scr, int item, int lane) {
    const int nblk = Ndst / 32, kb = item / nblk, nb = item % nblk, k0 = 64 * kb, n0 = 32 * nb;
    const int sc = map_src(mode, n0 + (lane & 31));
    const float scale = (mode == 1 && (n0 + (lane & 31)) < 512) ? 0.125f : 1.0f;
#pragma unroll
    for (int i = 0; i < 32; ++i) { const int kk = 2 * i + (lane >> 5); scr[kk * 33 + (lane & 31)] = sc >= 0 ? W[(size_t)(k0 + kk) * Nsrc + sc] * scale : 0.f; }
    LDS_WAIT(); asm volatile("" ::: "memory");
    const int c = lane & 7;
#pragma unroll
    for (int j = 0; j < 4; ++j) { const int n = (lane >> 3) + 8 * j; const LAS float* s = scr + (8 * c) * 33 + n;
        u32x4 o; o.x = pk2(s[0 * 33], s[1 * 33]); o.y = pk2(s[2 * 33], s[3 * 33]); o.z = pk2(s[4 * 33], s[5 * 33]); o.w = pk2(s[6 * 33], s[7 * 33]);
        *(GAS u32x4*)(WT + (size_t)(n0 + n) * K + k0 + 8 * c) = o; }
    LDS_WAIT(); asm volatile("" ::: "memory");
}
__device__ __forceinline__ void rms_row_to_bf16(int lane, const float* xrow, const float* g, bf16_t* orow) {
    const GAS f32x4* xr = (const GAS f32x4*)xrow + lane; const GAS f32x4* gr = (const GAS f32x4*)g + lane;
    f32x4 v[4]; float s = 0.f;
#pragma unroll
    for (int j = 0; j < 4; ++j) { v[j] = xr[64 * j]; s += (v[j].x * v[j].x + v[j].y * v[j].y) + (v[j].z * v[j].z + v[j].w * v[j].w); }
    const float rstd = 1.0f / sqrtf(wave_sum(s) * (1.f / DM) + EPS);
    GAS u32x2* o8 = (GAS u32x2*)orow + lane;
#pragma unroll
    for (int j = 0; j < 4; ++j) { const f32x4 gg = gr[64 * j]; u32x2 o; o.x = pk2(v[j].x * rstd * gg.x, v[j].y * rstd * gg.y); o.y = pk2(v[j].z * rstd * gg.z, v[j].w * rstd * gg.w); o8[64 * j] = o; }
}

__device__ __forceinline__ void rms_rows4_to_bf16(int lane, const float* x, const float* g, bf16_t* o, size_t m0, size_t stride) {
    f32x4 v[4][4]; float s[4];
#pragma unroll
    for (int r = 0; r < 4; ++r) { const GAS f32x4* xr = (const GAS f32x4*)(x + (m0 + r * stride) * DM) + lane;
#pragma unroll
        for (int j = 0; j < 4; ++j) v[r][j] = xr[64 * j]; }
    const GAS f32x4* gr = (const GAS f32x4*)g + lane;
    f32x4 gg[4];
#pragma unroll
    for (int j = 0; j < 4; ++j) gg[j] = gr[64 * j];
#pragma unroll
    for (int r = 0; r < 4; ++r) { float a = 0.f;
#pragma unroll
        for (int j = 0; j < 4; ++j) a += (v[r][j].x * v[r][j].x + v[r][j].y * v[r][j].y) + (v[r][j].z * v[r][j].z + v[r][j].w * v[r][j].w);
        s[r] = a; }
#pragma unroll
    for (int of = 1; of < 64; of <<= 1) {
#pragma unroll
        for (int r = 0; r < 4; ++r) s[r] += __shfl_xor(s[r], of); }
#pragma unroll
    for (int r = 0; r < 4; ++r) { const float rstd = 1.0f / sqrtf(s[r] * (1.f / DM) + EPS);
        GAS u32x2* o8 = (GAS u32x2*)(o + (m0 + r * stride) * DM) + lane;
#pragma unroll
        for (int j = 0; j < 4; ++j) { u32x2 w; w.x = pk2(v[r][j].x * rstd * gg[j].x, v[r][j].y * rstd * gg[j].y); w.y = pk2(v[r][j].z * rstd * gg[j].z, v[r][j].w * rstd * gg[j].w); o8[64 * j] = w; } }
}
__device__ __forceinline__ void p0_prologue(Frame& F) {
    LAS float* scr = (LAS float*)(F.lds + F.wave * 16384);
    const int gw = F.blk * NWAVES + F.wave, NGW = F.G * NWAVES, lane = F.lane;
    unsigned char* ws = F.ws;
    constexpr int I_IN = 16 * 96, I_MKV = 16 * 32, I_G = 16 * 32, I_B = 8 * 32, I_O = 16 * 32, I_EI = 16 * 64, I_EO = 16 * 32;
    constexpr int NITEMS = I_IN + I_MKV + 3 * I_G + 3 * I_B + I_O + NEXP * I_EI + NEXP * I_EO;
    for (int it = gw; it < NITEMS; it += NGW) {
        int r = it;
        if (r < I_IN) { transpose_item(F.in[3], DM, IN_W, PW, (bf16_t*)(ws + WS_WIN), 1, scr, r, lane); continue; } r -= I_IN;
        if (r < I_MKV) { transpose_item(F.in[9], DM, DM, DM, (bf16_t*)(ws + WS_WMKV), 0, scr, r, lane); continue; } r -= I_MKV;
        if (r < 3 * I_G) { const int n = r / I_G; transpose_item(F.in[10] + (size_t)n * DM * DM, DM, DM, DM, (bf16_t*)(ws + WS_WG) + (size_t)n * DM * DM, 0, scr, r % I_G, lane); continue; } r -= 3 * I_G;
        if (r < 3 * I_B) { const int n = r / I_B; transpose_item(F.in[12] + (size_t)n * 512 * DM, 512, DM, DM, (bf16_t*)(ws + WS_WB) + (size_t)n * DM * 512, 0, scr, r % I_B, lane); continue; } r -= 3 * I_B;
        if (r < I_O) { transpose_item(F.in[13], DM, DM, DM, (bf16_t*)(ws + WS_WO), 0, scr, r, lane); continue; } r -= I_O;
        if (r < NEXP * I_EI) { const int e = r / I_EI; transpose_item(F.in[17] + (size_t)e * DM * 2048, DM, 2048, 2048, (bf16_t*)(ws + WS_WEI) + (size_t)e * 2048 * DM, 2, scr, r % I_EI, lane); continue; } r -= NEXP * I_EI;
        { const int e = r / I_EO; transpose_item(F.in[19] + (size_t)e * DM * DM, DM, DM, DM, (bf16_t*)(ws + WS_WEO) + (size_t)e * DM * DM, 0, scr, r % I_EO, lane); }
    }
    { f32x2* tab = (f32x2*)(ws + WS_ROPE);
      for (int idx = (F.blk * NWAVES * 64) + F.tid; idx < SEQ * 32; idx += F.G * NWAVES * 64) {
          const int s = idx >> 5, i = idx & 31;
          const float inv = exp2f(-(float)i * (13.287712379549449f / 32.0f));
          const float ang = (float)s * inv;
          const double rev = (double)ang * 0.15915494309189535;
          const float fr = (float)(rev - __builtin_rint(rev));
          tab[idx] = (f32x2){__builtin_amdgcn_cosf(fr), __builtin_amdgcn_sinf(fr)}; } }
    for (int m = gw; m < NTOK; m += 4 * NGW) rms_rows4_to_bf16(lane, F.in[0], F.in[2], (bf16_t*)(ws + WS_H), (size_t)m, (size_t)NGW);
    for (int m = gw; m < NMEM; m += 4 * NGW) rms_rows4_to_bf16(lane, F.in[1], F.in[8], (bf16_t*)(ws + WS_MEMN), (size_t)m, (size_t)NGW);
    { int* st = (int*)(ws + WS_SLOT_TOK); float* sw = (float*)(ws + WS_SLOT_W);
      for (int i = F.blk * NWAVES * 64 + F.tid; i < NSLOT_PAD; i += F.G * NWAVES * 64) { st[i] = 0; sw[i] = 0.f; } }
}

template <int CTRL> __device__ __forceinline__ float dppf(float v) { return __builtin_bit_cast(float, __builtin_amdgcn_update_dpp(0, __builtin_bit_cast(int, v), CTRL, 0xF, 0xF, false)); }
__device__ __forceinline__ float lx1(float v) { return dppf<0xB1>(v); }
__device__ __forceinline__ float lx2(float v) { return dppf<0x4E>(v); }
__device__ __forceinline__ float lx4(float v) { return dppf<0x1B>(dppf<0x141>(v)); }
__device__ __forceinline__ float lx8(float v) { return dppf<0x128>(v); }
__device__ __forceinline__ void un8(const u32x4 w, float (&v)[8]) { v[0] = bflo(w.x); v[1] = bfhi(w.x); v[2] = bflo(w.y); v[3] = bfhi(w.y); v[4] = bflo(w.z); v[5] = bfhi(w.z); v[6] = bflo(w.w); v[7] = bfhi(w.w); }
__device__ __forceinline__ u32x4 pk8(const float (&v)[8]) { u32x4 w; w.x = pk2(v[0], v[1]); w.y = pk2(v[2], v[3]); w.z = pk2(v[4], v[5]); w.w = pk2(v[6], v[7]); return w; }
__device__ __forceinline__ void rope8(float (&v)[8], const f32x2 (&cs)[8], bool up) {
#pragma unroll
    for (int j = 0; j < 8; ++j) { const float other = lx4(v[j]); v[j] = up ? (other * cs[j].y + v[j] * cs[j].x) : (v[j] * cs[j].x - other * cs[j].y); }
}
__device__ __forceinline__ void p2_prep(Frame& F, const bool dummy = false) {
    const int gw = F.blk * NWAVES + F.wave, NGW = F.G * NWAVES, lane = F.lane;
    bf16_t* proj = (bf16_t*)(F.ws + WS_P);
    bf16_t* projw = dummy ? (bf16_t*)(F.ws + WS_END) : proj;
    const int wmask = dummy ? 8191 : 0x7fffffff;
    const f32x2* tab = (const f32x2*)(F.ws + WS_ROPE);
    float gqd[8], gkd[8], gqm[8];
#pragma unroll
    for (int j = 0; j < 8; ++j) { gqd[j] = F.in[4][8 * (lane & 7) + j] * (0.125f * LOG2E); gkd[j] = F.in[5][8 * (lane & 7) + j]; gqm[j] = F.in[6][8 * (lane & 15) + j] * (0.08838834764831845f * LOG2E); }
    const bool up = (lane & 4) != 0; const int i0 = (lane & 3) * 8;
    for (int m0 = gw; m0 < NTOK; m0 += 2 * NGW) {
        u32x4 raw[2][5]; f32x2 cs[2][8];
#pragma unroll
        for (int t = 0; t < 2; ++t) { const GAS bf16_t* row = (const GAS bf16_t*)proj + (size_t)(m0 + t * NGW) * PW;
            raw[t][0] = *(const GAS u32x4*)(row + C_DQ + 8 * lane); raw[t][1] = *(const GAS u32x4*)(row + C_DK + 8 * (lane & 7)); raw[t][2] = *(const GAS u32x4*)(row + C_IQ + 8 * (lane & 31));
            raw[t][3] = *(const GAS u32x4*)(row + C_IK + 8 * (lane & 7)); raw[t][4] = *(const GAS u32x4*)(row + C_MQ + 8 * lane);
            const GAS f32x2* tr = (const GAS f32x2*)tab + (size_t)((m0 + t * NGW) & (SEQ - 1)) * 32 + i0;
#pragma unroll
            for (int j = 0; j < 8; ++j) cs[t][j] = tr[j]; }
#pragma unroll
        for (int t = 0; t < 2; ++t) {
            GAS bf16_t* roww = (GAS bf16_t*)projw + (size_t)((m0 + t * NGW) & wmask) * PW;
            float v[8];
            { un8(raw[t][0], v); float ss = 0.f;
#pragma unroll
              for (int j = 0; j < 8; ++j) ss += v[j] * v[j];
              ss += lx1(ss); ss += lx2(ss); ss += lx4(ss);
              const float rstd = 1.0f / sqrtf(ss * (1.f / 64.f) + EPS);
#pragma unroll
              for (int j = 0; j < 8; ++j) v[j] = v[j] * rstd * gqd[j];
              rope8(v, cs[t], up);
              *(GAS u32x4*)(roww + C_DQ + 8 * lane) = pk8(v); }
            { un8(raw[t][1], v); float ss = 0.f;
#pragma unroll
              for (int j = 0; j < 8; ++j) ss += v[j] * v[j];
              ss += lx1(ss); ss += lx2(ss); ss += lx4(ss);
              const float rstd = 1.0f / sqrtf(ss * (1.f / 64.f) + EPS);
#pragma unroll
              for (int j = 0; j < 8; ++j) v[j] = v[j] * rstd * gkd[j];
              rope8(v, cs[t], up);
              if (lane < 8) *(GAS u32x4*)(roww + C_DK + 8 * lane) = pk8(v); }
            { un8(raw[t][2], v); rope8(v, cs[t], up); if (lane < 32) *(GAS u32x4*)(roww + C_IQ + 8 * lane) = pk8(v); }
            { un8(raw[t][3], v); rope8(v, cs[t], up); if (lane < 8) *(GAS u32x4*)(roww + C_IK + 8 * lane) = pk8(v); }
            { un8(raw[t][4], v); float ss = 0.f;
#pragma unroll
              for (int j = 0; j < 8; ++j) ss += v[j] * v[j];
              ss += lx1(ss); ss += lx2(ss); ss += lx4(ss); ss += lx8(ss);
              const float rstd = 1.0f / sqrtf(ss * (1.f / 128.f) + EPS);
#pragma unroll
              for (int j = 0; j < 8; ++j) v[j] = v[j] * rstd * gqm[j];
              *(GAS u32x4*)(roww + C_MQ + 8 * lane) = pk8(v); }
        }
    }
    bf16_t* mkv = (bf16_t*)(F.ws + WS_MKV);
    if (!dummy) for (int m = gw; m < NMEM; m += NGW) {
        GAS bf16_t* row = (GAS bf16_t*)mkv + (size_t)m * DM; float v[8];
        un8(*(const GAS u32x4*)(row + 8 * lane), v); float ss = 0.f;
#pragma unroll
        for (int j = 0; j < 8; ++j) ss += v[j] * v[j];
        ss += lx1(ss); ss += lx2(ss); ss += lx4(ss); ss += lx8(ss);
        const float rstd = 1.0f / sqrtf(ss * (1.f / 128.f) + EPS);
#pragma unroll
        for (int j = 0; j < 8; ++j) v[j] = v[j] * rstd * F.in[7][8 * (lane & 15) + j];
        *(GAS u32x4*)(row + 8 * lane) = pk8(v);
    }
}

#define MFMA32(a, b, c) __builtin_amdgcn_mfma_f32_32x32x16_bf16((a), (b), (c), 0, 0, 0)
typedef LAS const unsigned char* lds_cptr;
__device__ __forceinline__ s16x4 vtr(lds_cptr p) { return __builtin_bit_cast(s16x4, __builtin_amdgcn_ds_read_tr16_b64_v4i16((LAS v4i16_t*)p)); }
__device__ __forceinline__ bf16x8 vfrag(lds_cptr vbase_lane, int off) {
    const s16x4 lo = vtr(vbase_lane + off), hi = vtr(vbase_lane + off + 512);
    return (bf16x8){lo[0], lo[1], lo[2], lo[3], hi[0], hi[1], hi[2], hi[3]};
}
__device__ __forceinline__ int vtr_lane_off(int lane) { return ((lane >> 4) & 1) * 32 + (lane & 3) * 8 + (4 * (lane >> 5) + ((lane & 15) >> 2)) * 64; }
__device__ __forceinline__ bf16x8 pack8(const float* p) {
    u32x4 w; w.x = cvt_pk_bf16(p[0], p[1]); w.y = cvt_pk_bf16(p[2], p[3]); w.z = cvt_pk_bf16(p[4], p[5]); w.w = cvt_pk_bf16(p[6], p[7]);
    return __builtin_bit_cast(bf16x8, w);
}
__device__ __forceinline__ float softplus_f(float z) { return fmaxf(z, 0.f) + __logf(1.f + __expf(-fabsf(z))); }

__device__ __forceinline__ void sb_item(const bf16_t* proj, bf16_t* osb, int b, int h, int qblk, LAS unsigned char* vlds, int lane) {
    const int r32 = lane & 31, hi = lane >> 5;
    const size_t tok0 = (size_t)b * SEQ + (size_t)qblk * 32;
    bf16x8 qr[4];
    { const bf16_t* qp = proj + (tok0 + r32) * PW + C_SQ + h * 64 + hi * 8;
#pragma unroll
      for (int kk = 0; kk < 4; ++kk) qr[kk] = *(const bf16x8*)(qp + kk * 16); }
    f32x16 o0 = {}, o1 = {}; float R = 0.f;
    const lds_cptr vrd = (lds_cptr)vlds + vtr_lane_off(lane);
    bf16x8 kfn[4]; u32x4 vvn[4];
#define SB_LOAD(kt_) do { const size_t key0_ = (size_t)b * SEQ + (size_t)(kt_) * 32; const GAS bf16_t* kp_ = (const GAS bf16_t*)proj + (key0_ + r32) * PW + C_SK + h * 64 + hi * 8; \
        _Pragma("unroll") for (int kk = 0; kk < 4; ++kk) kfn[kk] = *(const GAS bf16x8*)(kp_ + kk * 16); \
        _Pragma("unroll") for (int p = 0; p < 4; ++p) vvn[p] = *(const GAS u32x4*)((const GAS bf16_t*)proj + (key0_ + 16 * (p & 1) + (lane >> 2)) * PW + C_SV + h * 64 + (p >> 1) * 32 + (lane & 3) * 8); } while (0)
    SB_LOAD(qblk);
    for (int kt = qblk; kt >= 0; --kt) {
        bf16x8 kf[4]; u32x4 vv[4];
#pragma unroll
        for (int i = 0; i < 4; ++i) { kf[i] = kfn[i]; vv[i] = vvn[i]; }
        if (kt > 0) SB_LOAD(kt - 1);
        f32x16 s = {};
#pragma unroll
        for (int kk = 0; kk < 4; ++kk) s = MFMA32(kf[kk], qr[kk], s);
        asm volatile("" ::: "memory");
#pragma unroll
        for (int p = 0; p < 4; ++p) *(LAS u32x4*)(vlds + p * 1024 + lane * 16) = vv[p];
        const bool diag = (kt == qblk);
        float sp[16], pr[16];
#pragma unroll
        for (int r = 0; r < 16; ++r) { const bool valid = !diag || (crow(r, hi) < r32); sp[r] = valid ? softplus_f(s[r]) : 0.f; }
        float T[4], U[4];
#pragma unroll
        for (int g = 0; g < 4; ++g) { T[g] = (sp[4 * g] + sp[4 * g + 1]) + (sp[4 * g + 2] + sp[4 * g + 3]); U[g] = __shfl_xor(T[g], 32); }
        float run = 0.f, above[4];
#pragma unroll
        for (int g = 3; g >= 0; --g) { above[g] = run + (hi == 0 ? U[g] : 0.f); run += T[g] + U[g]; }
#pragma unroll
        for (int g = 0; g < 4; ++g) { float c = R + above[g];
#pragma unroll
            for (int j = 3; j >= 0; --j) { const int r = 4 * g + j; c += sp[r]; const bool valid = !diag || (crow(r, hi) < r32); pr[r] = valid ? __expf(s[r] - c) : 0.f; } }
        R += run;
        const bf16x8 p0 = pack8(pr), p1 = pack8(pr + 8);
        LDS_WAIT();
        const bf16x8 v00 = vfrag(vrd, 0), v01 = vfrag(vrd, 1024), v10 = vfrag(vrd, 2048), v11 = vfrag(vrd, 3072);
        o0 = MFMA32(v00, p0, o0); o0 = MFMA32(v01, p1, o0);
        o1 = MFMA32(v10, p0, o1); o1 = MFMA32(v11, p1, o1);
        asm volatile("" ::: "memory");
        if (__all(R > 30.0f)) break;
    }
#undef SB_LOAD
    bf16_t* op = osb + (tok0 + r32) * 512 + h * 64 + 4 * hi;
#pragma unroll
    for (int g = 0; g < 4; ++g) {
        u32x2 w0, w1; w0.x = cvt_pk_bf16(o0[4 * g], o0[4 * g + 1]); w0.y = cvt_pk_bf16(o0[4 * g + 2], o0[4 * g + 3]); w1.x = cvt_pk_bf16(o1[4 * g], o1[4 * g + 1]); w1.y = cvt_pk_bf16(o1[4 * g + 2], o1[4 * g + 3]);
        *(u32x2*)(op + 8 * g) = w0; *(u32x2*)(op + 32 + 8 * g) = w1; }
}

constexpr int ML_K = 0, ML_KROW = 272, ML_V = 256 * ML_KROW, ML_END = ML_V + 65536;
__device__ __forceinline__ void mem_unit(const bf16_t* proj, const bf16_t* mkv, bf16_t* omem, int b, int h, int half, LAS unsigned char* ml, int tid) {
    const int lane = tid & 63, wid = __builtin_amdgcn_readfirstlane(tid >> 6), r32 = lane & 31, hi = lane >> 5;
    { const GAS bf16_t* src = (const GAS bf16_t*)mkv + (size_t)b * MEMLEN * DM + h * 128;
#pragma unroll
      for (int i = 0; i < 8; ++i) { const int ch = tid + 512 * i, key = ch >> 4, c16 = ch & 15, kk = key & 31;
          const u32x4 kv = *(const GAS u32x4*)(src + (size_t)key * DM + c16 * 8);
          const u32x4 vv = *(const GAS u32x4*)(src + (size_t)key * DM + 512 + c16 * 8);
          *(LAS u32x4*)(ml + ML_K + key * ML_KROW + c16 * 16) = kv;
          *(LAS u32x4*)(ml + ML_V + (key >> 5) * 8192 + ((c16 >> 2) * 2 + (kk >> 4)) * 1024 + (kk & 15) * 64 + (c16 & 3) * 16) = vv; } }
    __syncthreads();
    for (int i = 0; i < 4; ++i) {
        const int qblk = half * 32 + wid * 4 + i;
        const size_t tok0 = (size_t)b * SEQ + (size_t)qblk * 32;
        bf16x8 qr[8];
        { const GAS bf16_t* qp = (const GAS bf16_t*)proj + (tok0 + r32) * PW + C_MQ + h * 128 + hi * 8;
#pragma unroll
          for (int kk = 0; kk < 8; ++kk) qr[kk] = *(const GAS bf16x8*)(qp + kk * 16); }
        f32x16 o[4] = {{}, {}, {}, {}}; float m = -1e30f, l = 0.f;
        for (int kb = 0; kb < 8; ++kb) {
            const LAS unsigned char* krd = ml + ML_K + (32 * kb + r32) * ML_KROW + hi * 16;
            f32x16 s = {};
#pragma unroll
            for (int kk = 0; kk < 8; ++kk) { const bf16x8 kf = *(const LAS bf16x8*)(krd + kk * 32); s = MFMA32(kf, qr[kk], s); }
            float mx = s[0];
#pragma unroll
            for (int r = 1; r < 16; ++r) mx = fmaxf(mx, s[r]);
            mx = fmaxf(mx, __shfl_xor(mx, 32));
            if (__any(mx > m + 8.0f)) {
                const float mn = fmaxf(m, mx), alpha = __builtin_amdgcn_exp2f(m - mn);
                l *= alpha; m = mn;
#pragma unroll
                for (int d = 0; d < 4; ++d)
#pragma unroll
                    for (int r = 0; r < 16; ++r) o[d][r] *= alpha;
            }
            float pr[16], rs = 0.f;
#pragma unroll
            for (int r = 0; r < 16; ++r) { pr[r] = __builtin_amdgcn_exp2f(s[r] - m); rs += pr[r]; }
            l += rs;
            const bf16x8 p0 = pack8(pr), p1 = pack8(pr + 8);
            const lds_cptr vrd = (lds_cptr)ml + ML_V + kb * 8192 + vtr_lane_off(lane);
#pragma unroll
            for (int d = 0; d < 4; ++d) { const bf16x8 va = vfrag(vrd, d * 2048), vb = vfrag(vrd, d * 2048 + 1024); o[d] = MFMA32(va, p0, o[d]); o[d] = MFMA32(vb, p1, o[d]); }
        }
        l += __shfl_xor(l, 32);
        const float il = 1.0f / l;
        bf16_t* op = omem + (tok0 + r32) * 512 + h * 128 + 4 * hi;
#pragma unroll
        for (int d = 0; d < 4; ++d)
#pragma unroll
            for (int g = 0; g < 4; ++g) { u32x2 w; w.x = cvt_pk_bf16(o[d][4 * g] * il, o[d][4 * g + 1] * il); w.y = cvt_pk_bf16(o[d][4 * g + 2] * il, o[d][4 * g + 3] * il); *(u32x2*)(op + 32 * d + 8 * g) = w; }
    }
    __syncthreads();
}

constexpr int DL_HIST = 0, DL_PREFIX = 66048, DL_KREM = DL_PREFIX + 256, DL_MASK = 67072, DL_VT = 73728, DL_KT = DL_VT + 2 * 16384, DL_END = DL_KT + 2 * 18432, DL_IQ = DL_VT;
constexpr int TOPK_DSA = 256;

struct IqLds { const LAS unsigned char* p; __device__ __forceinline__ bf16x8 operator()(int j) const { return *(const LAS bf16x8*)(p + j * 32); } };
template <class QF>
__device__ __forceinline__ void idx_scores(const QF& qf, const bf16x8 (&kf)[4], const float (&wq)[4], unsigned (&uk)[16]) {
    float scv[16];
#pragma unroll
    for (int hd = 0; hd < 4; ++hd) { f32x16 a = (f32x16){};
#pragma unroll
        for (int kk = 0; kk < 4; ++kk) a = MFMA32(kf[kk], qf(hd * 4 + kk), a);
#pragma unroll
        for (int r = 0; r < 16; ++r) scv[r] = (hd == 0) ? wq[0] * fmaxf(a[r], 0.f) : __builtin_fmaf(wq[hd], fmaxf(a[r], 0.f), scv[r]); }
#pragma unroll
    for (int r = 0; r < 16; ++r) {
        unsigned bits = __builtin_bit_cast(unsigned, scv[r]);
        if (bits == 0x80000000u) bits = 0u;
        uk[r] = bits ^ ((unsigned)((int)bits >> 31) | 0x80000000u);
    }
}
__device__ __forceinline__ void load_ik(const bf16_t* proj, size_t tokb, int kbase, int r32, int hi, bf16x8 (&kf)[4]) {
    int kr = kbase + r32; if (kr > SEQ - 1) kr = SEQ - 1;
    const GAS bf16_t* p = (const GAS bf16_t*)proj + (tokb + kr) * PW + C_IK + 8 * hi;
#pragma unroll
    for (int kk = 0; kk < 4; ++kk) kf[kk] = *(const GAS bf16x8*)(p + kk * 16);
}

__device__ __forceinline__ void dsa_unit(const bf16_t* proj, bf16_t* odsa, unsigned* kscr  , int b, int c, LAS unsigned char* dl, int tid) {
    const int lane = tid & 63, wid = __builtin_amdgcn_readfirstlane(tid >> 6), r32 = lane & 31, hi = lane >> 5;
    const int n = 64 * (c + 1), nsteps = (n + 127) >> 7;
    const size_t tokq0 = (size_t)b * SEQ + (size_t)c * 64, tokb = (size_t)b * SEQ;
    LAS unsigned* hist = (LAS unsigned*)(dl + DL_HIST);
    LAS unsigned* prefix = (LAS unsigned*)(dl + DL_PREFIX);
    LAS unsigned* krem = (LAS unsigned*)(dl + DL_KREM);
    LAS unsigned* mask = (LAS unsigned*)(dl + DL_MASK);
    const int kb = wid >> 1, qh = wid & 1;
    { const int row = tid >> 3, c = tid & 7;
      const GAS bf16_t* src = (const GAS bf16_t*)proj + (tokq0 + row) * PW + C_IQ + c * 32;
#pragma unroll
      for (int i = 0; i < 4; ++i) *(LAS u32x4*)(dl + DL_IQ + row * 528 + c * 64 + i * 16) = *(const GAS u32x4*)(src + i * 8); }
    const IqLds iqf{dl + DL_IQ + (32 * qh + r32) * 528 + hi * 16};
    float wq[4];
    { const u32x2 w = *(const u32x2*)(proj + (tokq0 + 32 * qh + r32) * PW + C_IW);
      wq[0] = bflo(w.x) * 0.0625f; wq[1] = bfhi(w.x) * 0.0625f; wq[2] = bflo(w.y) * 0.0625f; wq[3] = bfhi(w.y) * 0.0625f; }
#ifndef REP_SEL
#define REP_SEL 1
#endif
#ifndef REP_B2
#define REP_B2 1
#endif
    LAS unsigned* selall = (LAS unsigned*)(dl + DL_HIST);
#ifndef PROBE_NOATOM
#define PROBE_NOATOM 0
#endif
    unsigned dummy = 0u;
    for (int rep_sel = 0; rep_sel < REP_SEL; ++rep_sel) {
    if (tid < 64) { prefix[tid] = 0u; krem[tid] = (n > TOPK_DSA) ? (unsigned)TOPK_DSA : 0x7fffffffu; }
    __syncthreads();
    const int pass0 = (n > TOPK_DSA) ? 0 : 3;
    GAS u32x4* kmine = (GAS u32x4*)kscr + ((size_t)wid * 64 + lane) * 4;
#define DSA_CONSUME(uk_) do { \
        if (sel) { _Pragma("unroll") for (int r = 0; r < 16; ++r) { const bool match = (pass == 0) || (((uk_)[r] >> (shift + 8)) == pfx); \
                if (match && !(PROBE_NOATOM && rep_sel + 1 < REP_SEL)) __hip_atomic_fetch_add(hist + (32 * qh + r32) * 257 + (((uk_)[r] >> shift) & 255u), 1u, __ATOMIC_RELAXED, __HIP_MEMORY_SCOPE_WORKGROUP); else dummy ^= (uk_)[r]; } } \
        else { _Pragma("unroll") for (int r = 0; r < 16; ++r) { const unsigned k24 = (uk_)[r] >> 8; gtw |= (k24 > pfx ? 1u : 0u) << crow(r, hi); eqw |= (k24 == pfx ? 1u : 0u) << crow(r, hi); } } } while (0)
#define DSA_TIES() do { if (!sel) { \
        LAS unsigned* mk = mask + (step & 1) * 768; \
        gtw |= __shfl_xor(gtw, 32); eqw |= __shfl_xor(eqw, 32); \
        if (hi == 0) { mk[(32 * qh + r32) * 4 + kb] = gtw; mk[256 + (32 * qh + r32) * 4 + kb] = eqw; } \
        __syncthreads(); \
        if (wid == 0) { unsigned nd = krem[lane]; \
            _Pragma("unroll") for (int k4 = 0; k4 < 4; ++k4) { const unsigned g = mk[lane * 4 + k4]; unsigned e = mk[256 + lane * 4 + k4]; unsigned sl = g; \
                if (e != 0u) { const unsigned cnt = (unsigned)__builtin_popcount(e); \
                    if (cnt <= nd) { sl |= e; nd -= cnt; } \
                    else { unsigned chosen = 0u; while (nd > 0u) { const unsigned lb = e & (0u - e); chosen |= lb; e ^= lb; --nd; } sl |= chosen; } } \
                selall[lane * 64 + step * 4 + k4] = sl; } \
            krem[lane] = nd; } } } while (0)
    for (int pass = pass0; pass < ((rep_sel + 1 < REP_SEL) ? 3 : 4); ++pass) {
        const bool sel = pass < 3;
        if (sel) { for (int i = tid; i < 64 * 257; i += 512) hist[i] = 0u; __syncthreads(); }
        const int shift = 24 - 8 * pass;
        const unsigned pfx = prefix[32 * qh + r32];
        if (pass == pass0) {
            bf16x8 kfn[4]; load_ik(proj, tokb, 32 * kb, r32, hi, kfn);
            for (int step = 0; step < nsteps; ++step) {
                const int kbase = 128 * step + 32 * kb;
                bf16x8 kf[4];
#pragma unroll
                for (int kk = 0; kk < 4; ++kk) kf[kk] = kfn[kk];
                if (step + 1 < nsteps) load_ik(proj, tokb, kbase + 128, r32, hi, kfn);
                unsigned gtw = 0u, eqw = 0u;
                if (kbase < n) {
                    unsigned uk[16];
                    idx_scores(iqf, kf, wq, uk);
                    if (pass0 == 0) {
#pragma unroll
                        for (int g = 0; g < 4; ++g) kmine[(size_t)step * 2048 + g] = (u32x4){uk[4 * g], uk[4 * g + 1], uk[4 * g + 2], uk[4 * g + 3]};
                    }
                    DSA_CONSUME(uk);
                }
                DSA_TIES();
            }
        } else {
            u32x4 ka[4], kb4[4];
#define DSA_KLOAD(dst, st_) do { _Pragma("unroll") for (int g = 0; g < 4; ++g) dst[g] = kmine[(size_t)(st_) * 2048 + g]; } while (0)
            DSA_KLOAD(ka, 0);
            if (nsteps > 1 && 128 + 32 * kb < n) DSA_KLOAD(kb4, 1);
            for (int step = 0; step < nsteps; ++step) {
                const int kbase = 128 * step + 32 * kb;
                unsigned uk[16];
#pragma unroll
                for (int g = 0; g < 4; ++g) { uk[4 * g] = ka[g].x; uk[4 * g + 1] = ka[g].y; uk[4 * g + 2] = ka[g].z; uk[4 * g + 3] = ka[g].w; }
#pragma unroll
                for (int g = 0; g < 4; ++g) ka[g] = kb4[g];
                if (step + 2 < nsteps && kbase + 256 < n) DSA_KLOAD(kb4, step + 2);
                unsigned gtw = 0u, eqw = 0u;
                if (kbase < n) DSA_CONSUME(uk);
                DSA_TIES();
            }
#undef DSA_KLOAD
        }
        if (sel) {
            __syncthreads();
#pragma unroll
            for (int qi = 0; qi < 8; ++qi) {
                const int q = 8 * wid + qi;
                const LAS unsigned* hq = hist + q * 257;
                const unsigned c0 = hq[255 - 4 * lane], c1 = hq[254 - 4 * lane], c2 = hq[253 - 4 * lane], c3 = hq[252 - 4 * lane];
                const unsigned s4 = c0 + c1 + c2 + c3;
                unsigned incl = s4;
#pragma unroll
                for (int o = 1; o < 64; o <<= 1) { const unsigned t = __shfl_up(incl, o); if (lane >= o) incl += t; }
                const unsigned excl = incl - s4, kr = krem[q];
                if (excl < kr && kr <= incl) {
                    unsigned cum = excl, bin, nk;
                    if (cum + c0 >= kr) { bin = 255 - 4 * lane; nk = kr - cum; }
                    else { cum += c0; if (cum + c1 >= kr) { bin = 254 - 4 * lane; nk = kr - cum; }
                    else { cum += c1; if (cum + c2 >= kr) { bin = 253 - 4 * lane; nk = kr - cum; }
                    else { cum += c2; bin = 252 - 4 * lane; nk = kr - cum; } } }
                    prefix[q] = (prefix[q] << 8) | bin; krem[q] = nk;
                }
            }
            __syncthreads();
        }
    }
    }
    if (dummy == 0x9e3779b9u) hist[tid] = 1u;
    const int hd = wid;
    u32x4 pk[2], pv[2];
#define DSA_LOADKV(step_) do { _Pragma("unroll") for (int i_ = 0; i_ < 2; ++i_) { const int ch_ = tid + 512 * i_; int krow_ = 128 * (step_) + (ch_ >> 3); if (krow_ > SEQ - 1) krow_ = SEQ - 1; \
        const GAS bf16_t* rp_ = (const GAS bf16_t*)proj + (tokb + krow_) * PW + (ch_ & 7) * 8; pk[i_] = *(const GAS u32x4*)(rp_ + C_DK); pv[i_] = *(const GAS u32x4*)(rp_ + C_DV); } } while (0)
#define DSA_STOREKV(buf_) do { _Pragma("unroll") for (int i_ = 0; i_ < 2; ++i_) { const int ch_ = tid + 512 * i_, key_ = ch_ >> 3, c8_ = ch_ & 7, kk_ = key_ & 31; \
        *(LAS u32x4*)(dl + DL_KT + (buf_) * 18432 + key_ * 144 + c8_ * 16) = pk[i_]; \
        *(LAS u32x4*)(dl + DL_VT + (buf_) * 16384 + (key_ >> 5) * 4096 + ((c8_ >> 2) * 2 + (kk_ >> 4)) * 1024 + (kk_ & 15) * 64 + (c8_ & 3) * 16) = pv[i_]; } } while (0)
    for (int qb = 0; qb < 2; ++qb) {
        bf16x8 qr[4];
        { const GAS bf16_t* qp = (const GAS bf16_t*)proj + (tokq0 + 32 * qb + r32) * PW + C_DQ + hd * 64 + 8 * hi;
#pragma unroll
          for (int kk = 0; kk < 4; ++kk) qr[kk] = *(const GAS bf16x8*)(qp + kk * 16); }
        f32x16 o0 = {}, o1 = {}; float mrun = -1e30f, lrun = 0.f;
        DSA_LOADKV(0);
        DSA_STOREKV(0);
        __syncthreads();
        for (int step = 0; step < nsteps; ++step) {
            const int buf = step & 1;
            if (step + 1 < nsteps) DSA_LOADKV(step + 1);
            LAS unsigned char* kt = dl + DL_KT + buf * 18432;
            LAS unsigned char* vt = dl + DL_VT + buf * 16384;
            for (int k4 = 0; k4 < 4; ++k4) {
                const int kbase = 128 * step + 32 * k4;
                if (kbase >= n) break;
                const LAS unsigned char* krd = kt + (32 * k4 + r32) * 144 + hi * 16;
                f32x16 s = {};
#pragma unroll
                for (int kk = 0; kk < 4; ++kk) { const bf16x8 kf = *(const LAS bf16x8*)(krd + kk * 32); s = MFMA32(kf, qr[kk], s); }
                const lds_cptr vrd = (lds_cptr)vt + k4 * 4096 + vtr_lane_off(lane);
                const bf16x8 v00 = vfrag(vrd, 0), v01 = vfrag(vrd, 1024), v10 = vfrag(vrd, 2048), v11 = vfrag(vrd, 3072);
                const unsigned selw = selall[(32 * qb + r32) * 64 + step * 4 + k4];
                float mx = -INFINITY;
#pragma unroll
                for (int r = 0; r < 16; ++r) { if (!((selw >> crow(r, hi)) & 1u)) s[r] = -INFINITY; mx = fmaxf(mx, s[r]); }
                mx = fmaxf(mx, __shfl_xor(mx, 32));
                if (__any(mx > mrun + 8.0f)) {
                    const float mn = fmaxf(mrun, mx), alpha = __builtin_amdgcn_exp2f(mrun - mn);
                    lrun *= alpha; mrun = mn;
#pragma unroll
                    for (int r = 0; r < 16; ++r) { o0[r] *= alpha; o1[r] *= alpha; }
                }
                float pr[16], rs = 0.f;
#pragma unroll
                for (int r = 0; r < 16; ++r) { pr[r] = __builtin_amdgcn_exp2f(s[r] - mrun); rs += pr[r]; }
                lrun += rs;
                const bf16x8 p0 = pack8(pr), p1 = pack8(pr + 8);
                o0 = MFMA32(v00, p0, o0); o0 = MFMA32(v01, p1, o0);
                o1 = MFMA32(v10, p0, o1); o1 = MFMA32(v11, p1, o1);
            }
            if (step + 1 < nsteps) DSA_STOREKV(buf ^ 1);
            __syncthreads();
        }
        float l = lrun; l += __shfl_xor(l, 32);
        const float il = 1.0f / l;
        bf16_t* op = odsa + (tokq0 + 32 * qb + r32) * 512 + hd * 64 + 4 * hi;
#pragma unroll
        for (int g = 0; g < 4; ++g) {
            u32x2 w0, w1; w0.x = cvt_pk_bf16(o0[4 * g] * il, o0[4 * g + 1] * il); w0.y = cvt_pk_bf16(o0[4 * g + 2] * il, o0[4 * g + 3] * il);
            w1.x = cvt_pk_bf16(o1[4 * g] * il, o1[4 * g + 1] * il); w1.y = cvt_pk_bf16(o1[4 * g + 2] * il, o1[4 * g + 3] * il);
            *(u32x2*)(op + 8 * g) = w0; *(u32x2*)(op + 32 + 8 * g) = w1; }
    }
#undef DSA_LOADKV
#undef DSA_STOREKV
#undef DSA_CONSUME
#undef DSA_TIES
    __syncthreads();
}

template <int CTRL> __device__ __forceinline__ float dpp_f(float v) { return __builtin_bit_cast(float, __builtin_amdgcn_update_dpp(0, __builtin_bit_cast(int, v), CTRL, 0xF, 0xF, false)); }
constexpr int RL_WR = 0, RL_WR_STRIDE = 1028, RL_TKE = 131584, RL_TKW = RL_TKE + 4096;
__device__ __forceinline__ void p9_router(Frame& F) {
    const int lane = F.lane, wave = F.wave, tid = F.tid;
    LAS float* Wr = (LAS float*)(F.lds + RL_WR);
    LAS int* tke = (LAS int*)(F.lds + RL_TKE); LAS float* tkw = (LAS float*)(F.lds + RL_TKW);
    const float* w_router = F.in[15]; const float* b_router = F.in[16]; const float* g_ffn = F.in[14];
    for (int idx = tid; idx < DM * NEXP; idx += NWAVES * 64) { const int k = idx >> 5, e = idx & 31; Wr[e * RL_WR_STRIDE + k] = w_router[idx]; }
    if (tid < 32) F.MISC[MW_LCNT + tid] = 0u;
    __syncthreads();
    bf16_t* h2 = (bf16_t*)(F.ws + WS_H);
    const GAS f32x4* gr = (const GAS f32x4*)g_ffn + lane;
    f32x4 gg[4];
#pragma unroll
    for (int j = 0; j < 4; ++j) gg[j] = gr[64 * j];
    const float bias_e = b_router[lane >> 1];
    f32x4 xnext[2][4];
#pragma unroll
    for (int tk = 0; tk < 2; ++tk) { const GAS f32x4* xr = (const GAS f32x4*)(F.out + ((size_t)F.blk * 256 + 32 * wave + tk) * DM) + lane;
#pragma unroll
        for (int j = 0; j < 4; ++j) xnext[tk][j] = xr[64 * j]; }
    for (int it = 0; it < 16; ++it) {
        const int tl0 = 32 * wave + 2 * it;
        f32x4 hn[2][4];
#pragma unroll
        for (int tk = 0; tk < 2; ++tk)
#pragma unroll
            for (int j = 0; j < 4; ++j) hn[tk][j] = xnext[tk][j];
        if (it + 1 < 16) {
#pragma unroll
            for (int tk = 0; tk < 2; ++tk) { const GAS f32x4* xr = (const GAS f32x4*)(F.out + ((size_t)F.blk * 256 + tl0 + 2 + tk) * DM) + lane;
#pragma unroll
                for (int j = 0; j < 4; ++j) xnext[tk][j] = xr[64 * j]; } }
#pragma unroll
        for (int tk = 0; tk < 2; ++tk) {
            const size_t t = (size_t)F.blk * 256 + tl0 + tk;
            float s = 0.f;
#pragma unroll
            for (int j = 0; j < 4; ++j) { s += (hn[tk][j].x * hn[tk][j].x + hn[tk][j].y * hn[tk][j].y) + (hn[tk][j].z * hn[tk][j].z + hn[tk][j].w * hn[tk][j].w); }
            const float rstd = 1.0f / sqrtf(wave_sum(s) * (1.f / DM) + EPS);
            GAS u32x2* o8 = (GAS u32x2*)(h2 + t * DM) + lane;
#pragma unroll
            for (int j = 0; j < 4; ++j) { hn[tk][j] = hn[tk][j] * rstd * gg[j]; u32x2 o; o.x = pk2(hn[tk][j].x, hn[tk][j].y); o.y = pk2(hn[tk][j].z, hn[tk][j].w); o8[64 * j] = o; }
        }
        f32x2 hp[4][4];
#pragma unroll
        for (int j = 0; j < 4; ++j)
#pragma unroll
            for (int c = 0; c < 4; ++c) hp[j][c] = (f32x2){hn[0][j][c], hn[1][j][c]};
        float acc[2][32];
        const LAS float* wl = Wr + 4 * lane; asm volatile("" : "+v"(wl));
#pragma unroll
        for (int e = 0; e < 32; ++e) {
            f32x2 a2 = (f32x2){0.f, 0.f};
#pragma unroll
            for (int j = 0; j < 4; ++j) { const f32x4 w = *(const LAS f32x4*)(wl + e * RL_WR_STRIDE + 256 * j);
#pragma unroll
                for (int c = 0; c < 4; ++c) a2 = __builtin_elementwise_fma(hp[j][c], (f32x2){w[c], w[c]}, a2); }
            asm volatile("" : "+v"(a2));
            acc[0][e] = a2.x; acc[1][e] = a2.y;
        }
#pragma unroll
        for (int tk = 0; tk < 2; ++tk) {
            float v16[16], v8[8], v4[4], v2[2];
            const bool b3 = (lane & 8) != 0, b2 = (lane & 4) != 0, b1 = (lane & 2) != 0;
#pragma unroll
            for (int i = 0; i < 16; ++i) { const auto rr = __builtin_amdgcn_permlane32_swap(__float_as_uint(acc[tk][i]), __float_as_uint(acc[tk][16 + i]), false, false); v16[i] = __uint_as_float(rr[0]) + __uint_as_float(rr[1]); }
#pragma unroll
            for (int i = 0; i < 8; ++i) { const auto rr = __builtin_amdgcn_permlane16_swap(__float_as_uint(v16[i]), __float_as_uint(v16[8 + i]), false, false); v8[i] = __uint_as_float(rr[0]) + __uint_as_float(rr[1]); }
#pragma unroll
            for (int i = 0; i < 4; ++i) { const float mine = b3 ? v8[4 + i] : v8[i], oth = b3 ? v8[i] : v8[4 + i]; v4[i] = mine + dpp_f<0x128>(oth); }
#pragma unroll
            for (int i = 0; i < 2; ++i) { const float mine = b2 ? v4[2 + i] : v4[i], oth = b2 ? v4[i] : v4[2 + i]; v2[i] = mine + dpp_f<0x141>(oth); }
            float v1; { const float mine = b1 ? v2[1] : v2[0], oth = b1 ? v2[0] : v2[1]; v1 = mine + dpp_f<0x4E>(oth); }
            const float val = v1 + dpp_f<0xB1>(v1) + bias_e;
            const int e = lane >> 1;
            float tv[4]; int te[4]; float cur = val;
#pragma unroll
            for (int k = 0; k < 4; ++k) {
                float mx = cur;
                mx = fmaxf(mx, dpp_f<0xB1>(mx)); mx = fmaxf(mx, dpp_f<0x4E>(mx)); mx = fmaxf(mx, dpp_f<0x141>(mx)); mx = fmaxf(mx, dpp_f<0x128>(mx));
                { const auto rr = __builtin_amdgcn_permlane16_swap(__float_as_uint(mx), __float_as_uint(mx), false, false); mx = fmaxf(__uint_as_float(rr[0]), __uint_as_float(rr[1])); }
                { const auto rr = __builtin_amdgcn_permlane32_swap(__float_as_uint(mx), __float_as_uint(mx), false, false); mx = fmaxf(__uint_as_float(rr[0]), __uint_as_float(rr[1])); }
                const unsigned long long bm = __ballot(cur == mx);
                const int src = (int)__builtin_ctzll(bm);
                tv[k] = mx; te[k] = src >> 1;
                if ((lane >> 1) == (src >> 1)) cur = -INFINITY;
            }
            const float e1 = __expf(tv[1] - tv[0]), e2x = __expf(tv[2] - tv[0]), e3 = __expf(tv[3] - tv[0]);
            const float inv = 1.0f / (1.0f + e1 + e2x + e3);
            const float gate[4] = {inv, e1 * inv, e2x * inv, e3 * inv};
            const int tl = tl0 + tk;
#pragma unroll
            for (int k = 0; k < 4; ++k) if (lane == k) { tke[tl * 4 + k] = te[k]; tkw[tl * 4 + k] = gate[k];
                __hip_atomic_fetch_add((LAS unsigned*)F.MISC + MW_LCNT + te[k], 1u, __ATOMIC_RELAXED, __HIP_MEMORY_SCOPE_WORKGROUP); }
        }
    }
    __syncthreads();
    if (tid < 32) ((int*)(F.ws + WS_BLKCNT))[F.blk * 32 + tid] = (int)F.MISC[MW_LCNT + tid];
}
__device__ __forceinline__ void p10_assign(Frame& F) {
    const int tid = F.tid;
    const int* blkcnt = (const int*)(F.ws + WS_BLKCNT);
    LAS int* part = (LAS int*)(F.lds);
    LAS int* tke = (LAS int*)(F.lds + RL_TKE); LAS float* tkw = (LAS float*)(F.lds + RL_TKW);
    { const int e = tid & 31, p = tid >> 5; int tot = 0, bef = 0;
      for (int j = 0; j < 16; ++j) { const int bl = p * 16 + j; const int c = blkcnt[bl * 32 + e]; tot += c; bef += (bl < F.blk) ? c : 0; }
      part[p * 32 + e] = tot; part[512 + p * 32 + e] = bef; }
    __syncthreads();
    if (tid < 32) { int tot = 0, bef = 0;
        for (int p = 0; p < 16; ++p) { tot += part[p * 32 + tid]; bef += part[512 + p * 32 + tid]; }
        part[1024 + tid] = tot; F.MISC[MW_BEFORE + tid] = (unsigned)bef; F.MISC[MW_LCNT + tid] = 0u; }
    __syncthreads();
    if (tid == 0) { int ps = 0;
        for (int e = 0; e < 32; ++e) { F.MISC[MW_PSTART + e] = (unsigned)ps; F.MISC[MW_TSTART + e] = (unsigned)(ps >> 8); ps += (part[1024 + e] + 255) & ~255; }
        F.MISC[MW_PSTART + 32] = (unsigned)ps; F.MISC[MW_TSTART + 32] = (unsigned)(ps >> 8); }
    __syncthreads();
    int* slot_tok = (int*)(F.ws + WS_SLOT_TOK); float* slot_w = (float*)(F.ws + WS_SLOT_W);
    for (int idx = tid; idx < 1024; idx += NWAVES * 64) {
        const int e = tke[idx]; const float w = tkw[idx];
        const unsigned r = __hip_atomic_fetch_add((LAS unsigned*)F.MISC + MW_LCNT + e, 1u, __ATOMIC_RELAXED, __HIP_MEMORY_SCOPE_WORKGROUP);
        const unsigned pos = F.MISC[MW_PSTART + e] + F.MISC[MW_BEFORE + e] + r;
        slot_tok[pos] = F.blk * 256 + (idx >> 2); slot_w[pos] = w;
    }
}

#ifndef MK_ONE_LAUNCH
#define MK_ONE_LAUNCH 1
#endif
constexpr int N_PHASES = 13;
struct Args { const float* in[21]; float* out; unsigned char* ws; int ph_lo, ph_hi; };
static_assert(sizeof(Args) == 21 * 8 + 8 + 8 + 8, "no padding");

__global__ void __launch_bounds__(NWAVES * 64, 2) fwd_kernel(Args args) {
    extern __shared__ __attribute__((aligned(16))) unsigned char lds[];
    Frame F;
    F.lds = (LAS unsigned char*)lds;
    F.MISC = (volatile LAS unsigned*)(F.lds + MISC_OFF);
    F.tid = threadIdx.x; F.lane = F.tid & 63; F.wave = __builtin_amdgcn_readfirstlane(F.tid >> 6);
    F.G = gridDim.x; F.blk = blockIdx.x;
    F.ws = args.ws; F.out = args.out; F.ctl = (gu32*)(args.ws + WS_CTL);
#pragma unroll
    for (int i = 0; i < 21; ++i) F.in[i] = args.in[i];
    for (int u = F.tid; u < (LDS_BYTES - MISC_OFF) / 4; u += NWAVES * 64) ((LAS unsigned*)(F.lds + MISC_OFF))[u] = 0u;
    __syncthreads();
    const int lo = args.ph_lo, hi = args.ph_hi;
    XcdBarrier bar; bar.bar = (unsigned*)(F.ctl + CW_BAR); bar.x = 0; bar.st = nullptr;
    if (hi - lo > 1) bar = xcd_barrier_post((unsigned*)(F.ctl + CW_BAR), F.MISC + MW_BAR);
#ifndef STAG
#define STAG 0
#endif
#ifndef PH_MASK
#define PH_MASK 0x1fff
#endif
#define IN(k) (((PH_MASK >> (k)) & 1) && lo <= (k) && (k) < hi)
#ifndef REP_MASK
#define REP_MASK 0
#endif
#define NREP(k) (1 + ((REP_MASK >> (k)) & 1))
#define SEAM(k) do { if (IN(k) && IN((k) + 1)) xcd_barrier(bar); } while (0)
    unsigned char* ws = args.ws;
    bf16_t* proj = (bf16_t*)(ws + WS_P);

    if (IN(0)) for (int rep = 0; rep < NREP(0); ++rep) { if (rep) xcd_barrier(bar); p0_prologue(F); } SEAM(0);

    if (IN(1)) {
#ifdef PROBE_P1
        { pg8::DenseSched S; S.init(ws + WS_H, ws + WS_WIN, NTOK, PW, DM, F.G, F.blk); S.amask = PROBE_P1;
          pg8::EpiBf16<0> E{(bf16_t*)(ws + WS_END), PW, nullptr, 1023};
          pg8::gemm_phase<pg8::EpiBf16<0>, pg8::DenseSched, true>(F.lds, DM, S, E); }
        xcd_barrier(bar);
#endif
        { pg8::DenseSched S; S.init(ws + WS_H, ws + WS_WIN, NTOK, PW, DM, F.G, F.blk);
          pg8::EpiBf16<0> E{proj, PW, nullptr};
          pg8::gemm_phase<pg8::EpiBf16<0>, pg8::DenseSched, true>(F.lds, DM, S, E); }
        { pg8::DenseSched S; S.init(ws + WS_MEMN, ws + WS_WMKV, NMEM, DM, DM, F.G, F.blk);
          pg8::EpiBf16<0> E{(bf16_t*)(ws + WS_MKV), DM, nullptr};
          pg8::gemm_phase<pg8::EpiBf16<0>, pg8::DenseSched, true>(F.lds, DM, S, E); }
    } SEAM(1);

    if (IN(2)) { if (REP_MASK & 4) { p2_prep(F, true); xcd_barrier(bar); } p2_prep(F); } SEAM(2);

    if (IN(3)) {
        bf16_t* osb = (bf16_t*)(ws + WS_O); bf16_t* odsa = osb + (size_t)NTOK * 512; bf16_t* omem = odsa + (size_t)NTOK * 512;
#ifndef REP_DSA
#define REP_DSA 1
#endif
#ifndef REP_SB
#define REP_SB 1
#endif
#ifndef REP_MEM
#define REP_MEM 1
#endif
#ifndef NO_DSA
        for (int rep = 0; rep < REP_DSA; ++rep)
        for (int i = 0; i < 4; ++i) { const int p = 2 * F.blk + (i >> 1), b = p >> 4, cc = p & 15, c = (i & 1) ? 31 - cc : cc; dsa_unit(proj, odsa, (unsigned*)F.out + (size_t)F.blk * 131072, b, c, F.lds, F.tid); }
#endif
        const int gw = F.blk * NWAVES + F.wave, NGW = F.G * NWAVES;
#ifndef NO_SB
        for (int rep = 0; rep < REP_SB; ++rep)
        for (int it = gw; it < NB * 8 * 64; it += NGW) { const int qblk = 63 - (it >> 8), bh = it & 255; sb_item(proj, osb, bh >> 3, bh & 7, qblk, F.lds + F.wave * 4096, F.lane); }
#endif
#ifndef NO_MEM
        for (int rep = 0; rep < REP_MEM; ++rep) {
            __syncthreads();
            for (int u = F.blk; u < NB * 4 * 2; u += F.G) mem_unit(proj, (const bf16_t*)(ws + WS_MKV), omem, u >> 3, (u >> 1) & 3, u & 1, F.lds, F.tid);
        }
#endif
    } SEAM(3);

    if (IN(4)) {
        pg8::DenseSched S; S.init(ws + WS_H, ws + WS_WG, NTOK, 3 * DM, DM, F.G, F.blk);
        pg8::EpiBf16<2> E{proj, PW, F.in[11]};
        pg8::gemm_phase<pg8::EpiBf16<2>, pg8::DenseSched, true>(F.lds, DM, S, E);
    } SEAM(4);

    if (IN(5)) {
 pg8::DenseSched S; S.init(ws + WS_O, ws + WS_WB, NTOK, DM, 512, F.G, F.blk); S.stag = STAG;
        pg8::EpiMerge E{proj, 0, (bf16_t*)(ws + WS_H), 1};
        pg8::gemm_phase<pg8::EpiMerge, pg8::DenseSched, true>(F.lds, 512, S, E); } SEAM(5);
    if (IN(6)) { pg8::DenseSched S; S.init(ws + WS_O + (size_t)NTOK * 1024, ws + WS_WB + (size_t)DM * 1024, NTOK, DM, 512, F.G, F.blk); S.stag = STAG;
        pg8::EpiMerge E{proj, DM, (bf16_t*)(ws + WS_H), 0};
        pg8::gemm_phase<pg8::EpiMerge, pg8::DenseSched, true>(F.lds, 512, S, E); } SEAM(6);
    if (IN(7)) { pg8::DenseSched S; S.init(ws + WS_O + (size_t)NTOK * 2048, ws + WS_WB + (size_t)DM * 2048, NTOK, DM, 512, F.G, F.blk); S.stag = STAG;
        pg8::EpiMerge E{proj, 2 * DM, (bf16_t*)(ws + WS_H), 0};
        pg8::gemm_phase<pg8::EpiMerge, pg8::DenseSched, true>(F.lds, 512, S, E); } SEAM(7);

    if (IN(8)) {
        pg8::DenseSched S; S.init(ws + WS_H, ws + WS_WO, NTOK, DM, DM, F.G, F.blk); S.stag = STAG;
        pg8::EpiResid E{F.in[0], F.out};
        pg8::gemm_phase<pg8::EpiResid, pg8::DenseSched, true>(F.lds, DM, S, E);
    } SEAM(8);

    if (IN(9)) for (int rep = 0; rep < NREP(9); ++rep) { if (rep) xcd_barrier(bar); p9_router(F); } SEAM(9);
    if (IN(10)) for (int rep = 0; rep < NREP(10); ++rep) { if (rep) xcd_barrier(bar); p10_assign(F); } SEAM(10);

    if (IN(11)) for (int rep = 0; rep < NREP(11); ++rep) {  if (rep) xcd_barrier(bar);
        pg8::MoeSched S{(const char*)(ws + WS_H), (const char*)(ws + WS_WEI), (const int*)(ws + WS_SLOT_TOK), F.MISC + MW_TSTART, DM, 2048, 8, F.blk};
        pg8::EpiSwiglu E{(bf16_t*)(ws + WS_P), F.in[18]};
        pg8::gemm_phase<pg8::EpiSwiglu, pg8::MoeSched, true>(F.lds, DM, S, E);
    } SEAM(11);

    if (IN(12)) {
        pg8::MoeSched S{(const char*)(ws + WS_P), (const char*)(ws + WS_WEO), nullptr, F.MISC + MW_TSTART, DM, DM, 4, F.blk};
        pg8::EpiScatter E{F.out, (const int*)(ws + WS_SLOT_TOK), (const float*)(ws + WS_SLOT_W), F.in[20], F.lds};
        pg8::gemm_phase<pg8::EpiScatter, pg8::MoeSched, true>(F.lds, DM, S, E);
    }
#undef IN
#undef SEAM
}

extern "C" void kernel_launch(void* const* d_in, const int* in_sizes, int n_in, void* d_out, int out_size, void* d_ws, size_t ws_size, hipStream_t stream) {
    static int grid = 0;
    if (grid == 0) {
        if (n_in != 21 || in_sizes[0] != NTOK * DM || out_size != NTOK * DM || ws_size < WS_END) {
            fprintf(stderr, "kernel_launch: unexpected shapes: n_in %d in0 %d out %d ws %zu (need >= %zu); nothing launched\n", n_in, n_in > 0 ? in_sizes[0] : -1, out_size, ws_size, (size_t)WS_END); grid = -1; return; }
        int dev = 0, cus = 0, per_cu = 0;
        if (hipGetDevice(&dev) != hipSuccess || hipDeviceGetAttribute(&cus, hipDeviceAttributeMultiprocessorCount, dev) != hipSuccess) { fprintf(stderr, "kernel_launch: device query failed\n"); grid = -1; return; }
        if (hipFuncSetAttribute((const void*)fwd_kernel, hipFuncAttributeMaxDynamicSharedMemorySize, LDS_BYTES) != hipSuccess) { fprintf(stderr, "kernel_launch: hipFuncSetAttribute failed\n"); grid = -1; return; }
        if (hipOccupancyMaxActiveBlocksPerMultiprocessor(&per_cu, (const void*)fwd_kernel, NWAVES * 64, LDS_BYTES) != hipSuccess || per_cu < 1)
            fprintf(stderr, "kernel_launch: note: occupancy query reports %d workgroups per CU\n", per_cu);
        (void)hipGetLastError();
        grid = cus;
        if (grid != 256) { fprintf(stderr, "kernel_launch: this kernel is built for 256 CUs (got %d); nothing launched\n", grid); grid = -1; return; }
    }
    if (grid < 0) return;
    if (hipMemsetAsync((char*)d_ws + WS_CTL, 0, CTL_ZERO_BYTES, stream) != hipSuccess) { fprintf(stderr, "kernel_launch: hipMemsetAsync failed\n"); return; }
    Args a{};
    for (int i = 0; i < 21; ++i) a.in[i] = (const float*)d_in[i];
    a.out = (float*)d_out; a.ws = (unsigned char*)d_ws;
#if MK_ONE_LAUNCH
    const int cuts[2] = {0, N_PHASES}; const int nl = 1;
#else
    const int cuts[11] = {0, 1, 2, 3, 4, 5, 6, 7, 8, 9, N_PHASES}; const int nl = 10;
#endif
    for (int li = 0; li < nl; ++li) {
        a.ph_lo = cuts[li]; a.ph_hi = cuts[li + 1];
        hipLaunchKernelGGL(fwd_kernel, dim3(grid), dim3(NWAVES * 64), LDS_BYTES, stream, a);
        const hipError_t le = hipPeekAtLastError();
        if (le != hipSuccess) { fprintf(stderr, "kernel_launch: launch %d failed: %s\n", li, hipGetErrorName(le)); break; }
    }
}
```

```cpp
#include <hip/hip_runtime.h>
#include <cstdio>
#include <cstdint>

#define LAS __attribute__((address_space(3)))
#define GAS __attribute__((address_space(1)))
typedef unsigned short bf16_t;
typedef short bf16x8 __attribute__((ext_vector_type(8)));
typedef short s16x4 __attribute__((ext_vector_type(4)));
typedef short v4i16_t __attribute__((ext_vector_type(4)));
typedef float f32x2 __attribute__((ext_vector_type(2)));
typedef float f32x4 __attribute__((ext_vector_type(4)));
typedef float f32x16 __attribute__((ext_vector_type(16)));
typedef unsigned u32x2 __attribute__((ext_vector_type(2)));
typedef unsigned u32x4 __attribute__((ext_vector_type(4)));
typedef GAS unsigned gu32;

constexpr int NB = 32, SEQ = 2048, DM = 1024, NTOK = NB * SEQ;
constexpr int MEMLEN = 256, NMEM = NB * MEMLEN;
constexpr int PW = 3072;
constexpr int C_SQ = 0, C_SK = 512, C_SV = 1024, C_DQ = 1536, C_DK = 2048, C_DV = 2112, C_IQ = 2176, C_IK = 2432, C_IW = 2496, C_MQ = 2560;
constexpr int IN_W = 3012;
constexpr int NEXP = 32, TOPK = 4, DEXP = 1024;
constexpr int NSLOT = NTOK * TOPK;
constexpr int NSLOT_PAD = NSLOT + NEXP * 256;
constexpr float EPS = 1e-6f;
constexpr float LOG2E = 1.4426950408889634f;

constexpr size_t MiB = 1u << 20;
constexpr size_t WS_CTL = 0, CTL_ZERO_BYTES = 1 * MiB;
constexpr size_t WS_ROPE = 1 * MiB;
constexpr size_t WS_BLKCNT = 1 * MiB + 512 * 1024;
constexpr size_t WS_SLOT_TOK = 2 * MiB;
constexpr size_t WS_SLOT_W = 4 * MiB;
constexpr size_t WS_WIN = 8 * MiB;
constexpr size_t WS_WMKV = 14 * MiB;
constexpr size_t WS_WG = 16 * MiB;
constexpr size_t WS_WB = 22 * MiB;
constexpr size_t WS_WO = 25 * MiB;
constexpr size_t WS_WEI = 27 * MiB;
constexpr size_t WS_WEO = 155 * MiB;
constexpr size_t WS_H = 220 * MiB;
constexpr size_t WS_P = 348 * MiB;
constexpr size_t WS_O = 732 * MiB;
constexpr size_t WS_MEMN = 924 * MiB;
constexpr size_t WS_MKV = 940 * MiB;
constexpr size_t WS_END = 956 * MiB;
static_assert(WS_P + (size_t)NSLOT_PAD * DEXP * 2 <= WS_MEMN, "act overlays proj|o");
static_assert(WS_SLOT_TOK + (size_t)NSLOT_PAD * 4 <= WS_SLOT_W && WS_SLOT_W + (size_t)NSLOT_PAD * 4 <= WS_WIN, "slot tables");

constexpr int CW_BAR = 4096;

constexpr int RING_BYTES = 151552;
constexpr int MISC_OFF = RING_BYTES;
constexpr int LDS_BYTES = 155648;
constexpr int MW_BAR = 8;
constexpr int MW_LCNT = 16;
constexpr int MW_PSTART = 64;
constexpr int MW_TSTART = 128;
constexpr int MW_BEFORE = 192;
constexpr int MW_PART = 256;

__device__ __forceinline__ unsigned f2bf(float f) { unsigned u = __builtin_bit_cast(unsigned, f); return (u + 0x7fffu + ((u >> 16) & 1u)) >> 16; }
__device__ __forceinline__ unsigned pk2(float lo, float hi) { return f2bf(lo) | (f2bf(hi) << 16); }
__device__ __forceinline__ float bf2f(unsigned short b) { return __builtin_bit_cast(float, (unsigned)b << 16); }
__device__ __forceinline__ float bflo(unsigned w) { return __builtin_bit_cast(float, w << 16); }
__device__ __forceinline__ float bfhi(unsigned w) { return __builtin_bit_cast(float, w & 0xffff0000u); }
__device__ __forceinline__ unsigned cvt_pk_bf16(float lo, float hi) { unsigned r; asm volatile("v_cvt_pk_bf16_f32 %0, %1, %2" : "=v"(r) : "v"(lo), "v"(hi)); return r; }
__device__ __forceinline__ int crow(int r, int hi) { return (r & 3) + 8 * (r >> 2) + 4 * hi; }
#define LDS_WAIT() asm volatile("s_waitcnt lgkmcnt(0)" ::: "memory")
#define VM_WAIT() asm volatile("s_waitcnt vmcnt(0)" ::: "memory")

namespace pg8 {
constexpr int BM = 256, BK = 64, HALF = 128, HTB = HALF * BK * 2, STAGE_BYTES = 8 * HTB;
__host__ __device__ __forceinline__ int lds_byte(int r, int c) { const int st = (r >> 4) * 2 + (c >> 5), rr = r & 15, cc = c & 31, ob = rr * 64 + cc * 2; return st * 1024 + (ob ^ (((ob >> 9) & 1) << 5)); }
__host__ __device__ __forceinline__ void stage_rc(int b, int& R, int& C) { const int st = b / 1024, sb = b % 1024, swz = sb ^ (((sb >> 9) & 1) << 5); R = (st >> 1) * 16 + swz / 64; C = (st & 1) * 32 + (swz % 64) / 2; }
__host__ __device__ __forceinline__ int perm32(int rho) { const int n = rho >> 4, i = rho & 15; return 8 * (i >> 2) + 4 * n + (i & 3); }

struct Unit { int pm, pn, e; };

template <class Epi, class Sched, bool ALIGN_EPI>
__device__ __forceinline__ void gemm_phase(LAS unsigned char* lds, const int K, const Sched& S, const Epi& E) {
    const int tid = threadIdx.x, wid = __builtin_amdgcn_readfirstlane(tid >> 6), lane = tid & 63, wr = wid >> 2, wc = wid & 3, fr = lane & 15, fq = lane >> 4;
    const int nt = K / BK;
    int Rr[2], Cc[2]; unsigned voffB[2];
#pragma unroll
    for (int i = 0; i < 2; ++i) { int R, C; stage_rc(tid * 16 + i * 8192, R, C); Rr[i] = R; Cc[i] = C; const int Rb = Epi::PERM ? ((R & ~31) + perm32(R & 31)) : R; voffB[i] = (unsigned)(Rb * K + C) * 2u; }
    const size_t kstep = (size_t)(BK * 2);
    const size_t hstepB = (size_t)HALF * K * 2;
    const unsigned ldsw = (unsigned)wid * 1024u;
    const int aoff = lds_byte(wr * 64 + fr, fq * 8), boff = lds_byte(wc * 32 + fr, fq * 8);
#define PG8_SA(b, h) (((b) * 2 + (h)) * HTB)
#define PG8_SB(b, h) ((4 + (b) * 2 + (h)) * HTB)
#define PG8_STAGE(bufoff, gbase, voff) do { _Pragma("unroll") for (int _i = 0; _i < 2; ++_i) \
        __builtin_amdgcn_global_load_lds((const unsigned*)((const char*)(gbase) + (voff)[_i]), (LAS unsigned*)(lds + (bufoff) + ldsw + _i * 8192), 16, 0, 0); } while (0)
#define PG8_LDA(dst, b, h) do { _Pragma("unroll") for (int m = 0; m < 4; ++m) _Pragma("unroll") for (int k = 0; k < 2; ++k) dst[m][k] = *(const LAS bf16x8*)(lds + PG8_SA(b, h) + aoff + m * 2048 + k * 1024); } while (0)
#define PG8_LDB(dst, b, h) do { _Pragma("unroll") for (int n = 0; n < 2; ++n) _Pragma("unroll") for (int k = 0; k < 2; ++k) dst[n][k] = *(const LAS bf16x8*)(lds + PG8_SB(b, h) + boff + n * 2048 + k * 1024); } while (0)
#define PG8_MMA(ai, bj, At, Bt) do { __builtin_amdgcn_s_setprio(1); _Pragma("unroll") for (int m = 0; m < 4; ++m) _Pragma("unroll") for (int n = 0; n < 2; ++n) _Pragma("unroll") for (int k = 0; k < 2; ++k) \
        acc[ai][bj][m][n] = __builtin_amdgcn_mfma_f32_16x16x32_bf16(Bt[n][k], At[m][k], acc[ai][bj][m][n], 0, 0, 0); __builtin_amdgcn_s_setprio(0); } while (0)
#define PG8_WAIT_V(n) asm volatile("s_waitcnt vmcnt(" #n ")" ::: "memory")
#define PG8_WAIT_L(n) asm volatile("s_waitcnt lgkmcnt(" #n ")" ::: "memory")
#define PG8_BAR __builtin_amdgcn_s_barrier()
#define PG8_SCHED __builtin_amdgcn_sched_barrier(0)
    Unit cur, nxt; int ui = 0;
    if (!S.next(0, cur)) return;
    { const int ns = S.stagger();
      for (int q = 0; q < ns; ++q) __builtin_amdgcn_s_sleep(4); }
    f32x4 acc[2][2][4][2];
#pragma unroll
    for (int a = 0; a < 2; ++a)
#pragma unroll
        for (int b = 0; b < 2; ++b)
#pragma unroll
            for (int m = 0; m < 4; ++m)
#pragma unroll
                for (int n = 0; n < 2; ++n) acc[a][b][m][n] = (f32x4){0.f, 0.f, 0.f, 0.f};
    bf16x8 At[4][2], B0[2][2], B1[2][2];
    const char* Ab = S.a_base();
    unsigned ca0[2], ca1[2], na0[2], na1[2];
#pragma unroll
    for (int i = 0; i < 2; ++i) { ca0[i] = S.a_off(cur, Rr[i], Cc[i]); ca1[i] = S.a_off(cur, HALF + Rr[i], Cc[i]); }
    const char* cB = S.b_tile(cur);
    PG8_STAGE(PG8_SB(0, 0), cB, voffB); PG8_STAGE(PG8_SB(0, 1), cB + hstepB, voffB); PG8_STAGE(PG8_SA(0, 0), Ab, ca0); PG8_STAGE(PG8_SA(0, 1), Ab, ca1);
    if (wr == 1) PG8_BAR;
    PG8_WAIT_V(2); PG8_BAR;
    PG8_STAGE(PG8_SB(1, 0), cB + kstep, voffB); PG8_STAGE(PG8_SA(1, 0), Ab + kstep, ca0); PG8_STAGE(PG8_SB(1, 1), cB + hstepB + kstep, voffB);
    PG8_WAIT_V(6); PG8_BAR;
    for (;;) {
        typename Epi::Pre pre = E.preload(cur, wr, wc, fr, fq);
        const bool has_next = S.next(ui + 1, nxt);
        const char* nB = cB;
#pragma unroll
        for (int i = 0; i < 2; ++i) { na0[i] = ca0[i]; na1[i] = ca1[i]; }
        if (has_next) { nB = S.b_tile(nxt);
#pragma unroll
            for (int i = 0; i < 2; ++i) { na0[i] = S.a_off(nxt, Rr[i], Cc[i]); na1[i] = S.a_off(nxt, HALF + Rr[i], Cc[i]); } }
        if constexpr (Epi::DRAIN_TOP) { PG8_WAIT_V(0); }
        for (int t = 0; t < nt; t += 2) {
            const bool last = (t == nt - 2);
            const char* a1 = Ab + (size_t)(t + 1) * kstep;
            const char* a2 = last ? Ab : Ab + (size_t)(t + 2) * kstep; const char* b2 = last ? nB : cB + (size_t)(t + 2) * kstep;
            const char* a3 = a2 + kstep; const char* b3 = b2 + kstep;
            unsigned o20[2], o21[2];
#pragma unroll
            for (int i = 0; i < 2; ++i) { o20[i] = last ? na0[i] : ca0[i]; o21[i] = last ? na1[i] : ca1[i]; }
            PG8_LDB(B0, 0, 0); PG8_LDB(B1, 0, 1); PG8_SCHED; PG8_LDA(At, 0, 0); PG8_STAGE(PG8_SA(1, 1), a1, ca1);
            PG8_WAIT_V(8); PG8_WAIT_L(0); PG8_BAR; PG8_MMA(0, 0, At, B0); PG8_MMA(0, 1, At, B1); PG8_BAR; PG8_SCHED;
            PG8_LDA(At, 0, 1); PG8_STAGE(PG8_SB(0, 0), b2, voffB); PG8_STAGE(PG8_SB(0, 1), b2 + hstepB, voffB); PG8_STAGE(PG8_SA(0, 0), a2, o20);
            PG8_WAIT_V(8); PG8_WAIT_L(0); PG8_BAR; PG8_MMA(1, 0, At, B0); PG8_MMA(1, 1, At, B1); PG8_BAR; PG8_SCHED;
            PG8_LDB(B0, 1, 0); PG8_LDB(B1, 1, 1); PG8_SCHED; PG8_LDA(At, 1, 0); PG8_STAGE(PG8_SA(0, 1), a2, o21);
            PG8_WAIT_V(8); PG8_WAIT_L(0); PG8_BAR; PG8_MMA(0, 0, At, B0); PG8_MMA(0, 1, At, B1); PG8_BAR; PG8_SCHED;
            PG8_LDA(At, 1, 1); PG8_STAGE(PG8_SB(1, 0), b3, voffB); PG8_STAGE(PG8_SB(1, 1), b3 + hstepB, voffB); PG8_STAGE(PG8_SA(1, 0), a3, o20);
            PG8_WAIT_V(8); PG8_WAIT_L(0); PG8_BAR; PG8_MMA(1, 0, At, B0); PG8_MMA(1, 1, At, B1); PG8_BAR; PG8_SCHED;
        }
        if constexpr (ALIGN_EPI) { if (wr == 0) PG8_BAR; }
        E(acc, cur, wr, wc, fr, fq, pre);
        if (!has_next) break;
#pragma unroll
        for (int a = 0; a < 2; ++a)
#pragma unroll
            for (int b = 0; b < 2; ++b)
#pragma unroll
                for (int m = 0; m < 4; ++m)
#pragma unroll
                    for (int n = 0; n < 2; ++n) acc[a][b][m][n] = (f32x4){0.f, 0.f, 0.f, 0.f};
        cur = nxt; cB = nB; ++ui;
#pragma unroll
        for (int i = 0; i < 2; ++i) { ca0[i] = na0[i]; ca1[i] = na1[i]; }
        if constexpr (ALIGN_EPI) { if (wr == 1) PG8_BAR; }
    }
    PG8_WAIT_V(0);
    if constexpr (!ALIGN_EPI) { if (wr == 0) PG8_BAR; }
    PG8_BAR;
#undef PG8_SA
#undef PG8_SB
#undef PG8_STAGE
#undef PG8_LDA
#undef PG8_LDB
#undef PG8_MMA
#undef PG8_WAIT_V
#undef PG8_WAIT_L
#undef PG8_BAR
#undef PG8_SCHED
}

struct DenseSched {
    const char* A; const char* Bt; int K, nM, nN, nwg, G, c, stag = 0, amask = -1;
    __device__ __forceinline__ void init(const void* A_, const void* Bt_, int M, int N, int K_, int G_, int c_) { A = (const char*)A_; Bt = (const char*)Bt_; K = K_; nM = M / BM; nN = N / BM; nwg = nM * nN; G = G_; c = c_; }
    __device__ __forceinline__ bool next(int i, Unit& u) const {
        const long L = (long)i * G + c; if (L >= nwg) return false;
        int wgid = (int)L; { const int q = nwg / 8, r = nwg % 8, xcd = wgid % 8, off = wgid / 8; wgid = (xcd < r ? xcd * (q + 1) : r * (q + 1) + (xcd - r) * q) + off; }
        const int nig = 8 * nN, gid = wgid / nig, fm = gid * 8, gsz = (nM - fm) < 8 ? (nM - fm) : 8;
        u.pm = fm + ((wgid % nig) % gsz); u.pn = (wgid % nig) / gsz; u.e = 0; return true;
    }
    __device__ __forceinline__ const char* a_base() const { return A; }
    __device__ __forceinline__ int stagger() const { return stag ? ((c >> 3) & 7) * (K / 55) : 0; }
    __device__ __forceinline__ unsigned a_off(const Unit& u, int row, int col) const { return (unsigned)(((size_t)((u.pm * BM + row) & amask) * K + col) * 2); }
    __device__ __forceinline__ int a_row(const Unit& u, int row) const { return (u.pm * BM + row) & amask; }
    __device__ __forceinline__ unsigned row_off(int r, int col) const { return (unsigned)(((size_t)r * K + col) * 2); }
    __device__ __forceinline__ const char* b_tile(const Unit& u) const { return Bt + (size_t)u.pn * BM * K * 2; }
};
}

namespace pg8 {
struct MoeSched {
    const char* A; const char* Bt; const int* slot_tok; volatile LAS unsigned* tstart; int K, rowsE, nN, c;
    __device__ __forceinline__ bool next(int i, Unit& u) const {
        const int x = c & 7, j = c >> 3, rpr = 32 / nN;
        const int pm = (i * 8 + x) * rpr + j / nN;
        const int T = (int)tstart[32];
        if (pm >= T) return false;
        int e = 0;
#pragma unroll 1
        for (int k = 1; k < 32; ++k) e += ((int)tstart[k] <= pm) ? 1 : 0;
        u.pm = pm; u.pn = j % nN; u.e = __builtin_amdgcn_readfirstlane(e); return true;
    }
    __device__ __forceinline__ const char* a_base() const { return A; }
    __device__ __forceinline__ int stagger() const { const int g = (c >> 3) / nN, ng = 32 / nN; (void)g; (void)ng; return 0; }
    __device__ __forceinline__ unsigned a_off(const Unit& u, int row, int col) const {
        const int pos = u.pm * BM + row;
        const int r = slot_tok ? slot_tok[pos] : pos;
        return (unsigned)(((size_t)r * K + col) * 2);
    }
    __device__ __forceinline__ int a_row(const Unit& u, int row) const { const int pos = u.pm * BM + row; return slot_tok ? ((const GAS int*)slot_tok)[pos] : pos; }
    __device__ __forceinline__ unsigned row_off(int r, int col) const { return (unsigned)(((size_t)r * K + col) * 2); }
    __device__ __forceinline__ const char* b_tile(const Unit& u) const { return Bt + ((size_t)u.e * rowsE + (size_t)u.pn * BM) * K * 2; }
};

struct MergeSched {
    const char* A; const char* Bt; int nM, nN, nwg, G, c;
    __device__ __forceinline__ void init(const void* A_, const void* Bt_, int M, int N, int G_, int c_) { A = (const char*)A_; Bt = (const char*)Bt_; nM = M / BM; nN = N / BM; nwg = nM * nN; G = G_; c = c_; }
    __device__ __forceinline__ bool next(int i, Unit& u) const {
        const int r = i / 3; const long L = (long)r * G + c; if (L >= nwg) return false;
        int wgid = (int)L; { const int q = nwg / 8, rr = nwg % 8, xcd = wgid % 8, off = wgid / 8; wgid = (xcd < rr ? xcd * (q + 1) : rr * (q + 1) + (xcd - rr) * q) + off; }
        const int nig = 8 * nN, gid = wgid / nig, fm = gid * 8, gsz = (nM - fm) < 8 ? (nM - fm) : 8;
        u.pm = fm + ((wgid % nig) % gsz); u.pn = (wgid % nig) / gsz; u.e = i - 3 * r; return true;
    }
    __device__ __forceinline__ const char* a_base() const { return A; }
    __device__ __forceinline__ int stagger() const { return 0; }
    __device__ __forceinline__ unsigned a_off(const Unit& u, int row, int col) const { return (unsigned)(((size_t)(u.pm * BM + row) * 512 + col) * 2 + (size_t)u.e * ((size_t)NTOK * 512 * 2)); }
    __device__ __forceinline__ const char* b_tile(const Unit& u) const { return Bt + ((size_t)u.e * DM + (size_t)u.pn * BM) * 512 * 2; }
};

struct NoPre {};
template <int ACT> struct EpiBf16 {
    static constexpr bool PERM = true, DRAIN_TOP = false;
    struct Pre { f32x4 bv[2][2]; };
    bf16_t* O; int ldc; const float* bias; int rowmask = -1;
    __device__ __forceinline__ Pre preload(const Unit& u, int wr, int wc, int fr, int fq) const { Pre p; const int col0 = u.pn * BM + wc * 32 + 8 * fq;
#pragma unroll
        for (int bj = 0; bj < 2; ++bj)
#pragma unroll
            for (int n = 0; n < 2; ++n) p.bv[bj][n] = (f32x4){0.f, 0.f, 0.f, 0.f};
        return p; }
    __device__ __forceinline__ void arrived(Pre& p) const { asm volatile("" : "+v"(p.bv[0][0]), "+v"(p.bv[0][1]), "+v"(p.bv[1][0]), "+v"(p.bv[1][1])); }
    __device__ __forceinline__ void operator()(const f32x4 (&acc)[2][2][4][2], const Unit& u, int wr, int wc, int fr, int fq, const Pre& pre) const {
        const int row0 = u.pm * BM + wr * 64 + fr; const int col0 = u.pn * BM + wc * 32 + 8 * fq;
        f32x4 bv[2][2];
#pragma unroll
        for (int bj = 0; bj < 2; ++bj)
#pragma unroll
            for (int n = 0; n < 2; ++n) bv[bj][n] = bias ? *(const f32x4*)(bias + col0 + bj * HALF + 4 * n) : pre.bv[bj][n];
#pragma unroll
        for (int ai = 0; ai < 2; ++ai)
#pragma unroll
            for (int m = 0; m < 4; ++m) { bf16_t* rowp = O + (size_t)((row0 + ai * HALF + m * 16) & rowmask) * ldc + col0;
#pragma unroll
                for (int bj = 0; bj < 2; ++bj) { f32x4 v0 = acc[ai][bj][m][0] + bv[bj][0], v1 = acc[ai][bj][m][1] + bv[bj][1];
                    if (ACT == 2) {
#pragma unroll
                        for (int q = 0; q < 4; ++q) { v0[q] = __builtin_amdgcn_rcpf(1.f + __builtin_amdgcn_exp2f(-LOG2E * v0[q])); v1[q] = __builtin_amdgcn_rcpf(1.f + __builtin_amdgcn_exp2f(-LOG2E * v1[q])); } }
                    u32x4 w; w.x = cvt_pk_bf16(v0[0], v0[1]); w.y = cvt_pk_bf16(v0[2], v0[3]); w.z = cvt_pk_bf16(v1[0], v1[1]); w.w = cvt_pk_bf16(v1[2], v1[3]);
                    *(u32x4*)(rowp + bj * HALF) = w; } }
    }
};
struct EpiMerge {
    static constexpr bool PERM = true, DRAIN_TOP = false;
    typedef NoPre Pre; __device__ __forceinline__ Pre preload(const Unit&, int, int, int, int) const { return Pre{}; }
    const bf16_t* G; bf16_t* Mg;
    __device__ __forceinline__ void operator()(const f32x4 (&acc)[2][2][4][2], const Unit& u, int wr, int wc, int fr, int fq, const Pre&) const {
        const int row0 = u.pm * BM + wr * 64 + fr; const int col0 = u.pn * BM + wc * 32 + 8 * fq;
        const int goff = u.e * DM; const bool first = (u.e == 0);
#pragma unroll
        for (int ai = 0; ai < 2; ++ai)
#pragma unroll
            for (int m = 0; m < 4; ++m) { const size_t row = (size_t)(row0 + ai * HALF + m * 16);
#pragma unroll
                for (int bj = 0; bj < 2; ++bj) {
                    const u32x4 g = *(const u32x4*)(G + row * PW + goff + col0 + bj * HALF);
                    u32x4 p = (u32x4){0u, 0u, 0u, 0u};
                    if (!first) p = *(const u32x4*)(Mg + row * DM + col0 + bj * HALF);
                    const f32x4 a0 = acc[ai][bj][m][0], a1 = acc[ai][bj][m][1];
                    u32x4 w;
                    w.x = cvt_pk_bf16(bflo(p.x) + bflo(g.x) * a0[0], bfhi(p.x) + bfhi(g.x) * a0[1]);
                    w.y = cvt_pk_bf16(bflo(p.y) + bflo(g.y) * a0[2], bfhi(p.y) + bfhi(g.y) * a0[3]);
                    w.z = cvt_pk_bf16(bflo(p.z) + bflo(g.z) * a1[0], bfhi(p.z) + bfhi(g.z) * a1[1]);
                    w.w = cvt_pk_bf16(bflo(p.w) + bflo(g.w) * a1[2], bfhi(p.w) + bfhi(g.w) * a1[3]);
                    *(u32x4*)(Mg + row * DM + col0 + bj * HALF) = w; } }
    }
};
struct EpiResid {
    static constexpr bool PERM = false, DRAIN_TOP = false;
    typedef NoPre Pre; __device__ __forceinline__ Pre preload(const Unit&, int, int, int, int) const { return Pre{}; }
    const float* base; float* out;
    __device__ __forceinline__ void operator()(const f32x4 (&acc)[2][2][4][2], const Unit& u, int wr, int wc, int fr, int fq, const Pre&) const {
        const int row0 = u.pm * BM + wr * 64 + fr; const int col0 = u.pn * BM + wc * 32 + 4 * fq;
#pragma unroll
        for (int ai = 0; ai < 2; ++ai)
#pragma unroll
            for (int m = 0; m < 4; ++m) { const size_t off = (size_t)(row0 + ai * HALF + m * 16) * DM + col0;
#pragma unroll
                for (int bj = 0; bj < 2; ++bj)
#pragma unroll
                    for (int n = 0; n < 2; ++n) { const f32x4 b = *(const f32x4*)(base + off + bj * HALF + n * 16); *(f32x4*)(out + off + bj * HALF + n * 16) = b + acc[ai][bj][m][n]; } }
    }
};
struct EpiSwiglu {
    static constexpr bool PERM = true, DRAIN_TOP = true;
    bf16_t* act; const float* bias;
    struct Pre { f32x4 bg[2], bu[2]; };
    __device__ __forceinline__ void arrived(Pre& p) const { asm volatile("" : "+v"(p.bg[0]), "+v"(p.bg[1]), "+v"(p.bu[0]), "+v"(p.bu[1])); }
    __device__ __forceinline__ Pre preload(const Unit& u, int wr, int wc, int fr, int fq) const {
        const GAS float* be = (const GAS float*)bias + (size_t)u.e * 2048 + u.pn * HALF + wc * 32 + 8 * fq; Pre p;
#pragma unroll
        for (int n = 0; n < 2; ++n) { p.bg[n] = *(const GAS f32x4*)(be + 4 * n); p.bu[n] = *(const GAS f32x4*)(be + 1024 + 4 * n); }
        return p; }
    __device__ __forceinline__ void operator()(const f32x4 (&acc)[2][2][4][2], const Unit& u, int wr, int wc, int fr, int fq, const Pre& pre) const {
        const int row0 = u.pm * BM + wr * 64 + fr; const int col0 = u.pn * HALF + wc * 32 + 8 * fq;
        f32x4 bg[2], bu[2];
#pragma unroll
        for (int n = 0; n < 2; ++n) { bg[n] = pre.bg[n]; bu[n] = pre.bu[n]; }
#pragma unroll
        for (int ai = 0; ai < 2; ++ai)
#pragma unroll
            for (int m = 0; m < 4; ++m) { bf16_t* rowp = act + (size_t)(row0 + ai * HALF + m * 16) * DEXP + col0;
                float o[8];
#pragma unroll
                for (int n = 0; n < 2; ++n) { const f32x4 gv = acc[ai][0][m][n] + bg[n], uv = acc[ai][1][m][n] + bu[n];
#pragma unroll
                    for (int q = 0; q < 4; ++q) { const float g = fminf(gv[q], 7.0f); const float uu = fminf(fmaxf(uv[q], -7.0f), 7.0f);
                        const float sg = __builtin_amdgcn_rcpf(1.f + __builtin_amdgcn_exp2f(-1.702f * LOG2E * g));
                        o[4 * n + q] = (uu + 1.0f) * (g * sg); } }
                u32x4 w; w.x = cvt_pk_bf16(o[0], o[1]); w.y = cvt_pk_bf16(o[2], o[3]); w.z = cvt_pk_bf16(o[4], o[5]); w.w = cvt_pk_bf16(o[6], o[7]);
                *(u32x4*)rowp = w; }
    }
};
constexpr int EPI_STAGE_OFF = 131072, EPI_STAGE_WAVE = 2304;
struct EpiScatter {
    static constexpr bool PERM = false, DRAIN_TOP = false;
    typedef NoPre Pre; __device__ __forceinline__ Pre preload(const Unit&, int, int, int, int) const { return Pre{}; }
    float* out; const int* slot_tok; const float* slot_w; const float* bias; LAS unsigned char* lds;
    __device__ __forceinline__ void operator()(const f32x4 (&acc)[2][2][4][2], const Unit& u, int wr, int wc, int fr, int fq, const Pre&) const {
        const int lane = fr + 16 * fq, wid = wr * 4 + wc;
        LAS float* st = (LAS float*)(lds + EPI_STAGE_OFF + wid * EPI_STAGE_WAVE);
        const int row0 = u.pm * BM + wr * 64 + fr;
        const int lcol = lane & 31, lrow = lane >> 5;
        float bv[2];
#pragma unroll
        for (int bj = 0; bj < 2; ++bj) bv[bj] = bias[(size_t)u.e * DM + u.pn * BM + bj * HALF + wc * 32 + lcol];
#pragma unroll
        for (int ai = 0; ai < 2; ++ai)
#pragma unroll
            for (int m = 0; m < 4; ++m) { const int pos = row0 + ai * HALF + m * 16; const float w = slot_w[pos]; const int tok = slot_tok[pos];
#pragma unroll
                for (int bj = 0; bj < 2; ++bj) {
#pragma unroll
                    for (int n = 0; n < 2; ++n) *(LAS f32x4*)(st + fr * 36 + 16 * n + 4 * fq) = acc[ai][bj][m][n];
                    asm volatile("s_waitcnt lgkmcnt(0)" ::: "memory");
#pragma unroll
                    for (int i = 0; i < 8; ++i) { const int r = 2 * i + lrow; const float v = st[r * 36 + lcol];
                        const float wr_ = __shfl(w, r); const int tr_ = __shfl(tok, r);
                        if (wr_ != 0.f) unsafeAtomicAdd(out + (size_t)tr_ * DM + u.pn * BM + bj * HALF + wc * 32 + lcol, (v + bv[bj]) * wr_); }
                    asm volatile("s_waitcnt lgkmcnt(0)" ::: "memory");
                } }
    }
};
}

#define XB_TMO      128
#define XB_XCNT(j)  (256  + 64 * (j))
#define XB_XSUB(j)  (1280 + 64 * (j))
#define XB_XGEN(j)  (2304 + 64 * (j))
#define XB_TOP      3328
#define XB_TOPGEN   3392
#define XCD_BAR_WORDS 3456
#define XB_SPIN_CAP (1u << 18)

__device__ __forceinline__ unsigned xb_ld(unsigned* p)              { return __hip_atomic_load(p, __ATOMIC_RELAXED, __HIP_MEMORY_SCOPE_AGENT); }
__device__ __forceinline__ unsigned xb_add(unsigned* p, unsigned v) { return __hip_atomic_fetch_add(p, v, __ATOMIC_RELAXED, __HIP_MEMORY_SCOPE_AGENT); }
__device__ __forceinline__ unsigned xb_xcc_id() { return (unsigned)__builtin_amdgcn_s_getreg((3 << 11) | 20) & 0xFu; }
#define XB_SPIN(cond, bar) do { unsigned _sp = 0; while (cond) { __builtin_amdgcn_s_sleep(1); \
    if ((++_sp & 255u) == 0u) { if (xb_ld(&(bar)[XB_TMO])) break; if (_sp > XB_SPIN_CAP) { atomicAdd(&(bar)[XB_TMO], 1u); break; } } } } while (0)

struct XcdBarrier {
    unsigned* bar; unsigned x;
    volatile LAS unsigned* st;
};

__device__ __forceinline__ XcdBarrier xcd_barrier_post(unsigned* bar, volatile LAS unsigned* st) {
    XcdBarrier b; b.bar = bar; b.x = xb_xcc_id(); b.st = st;
    if (threadIdx.x == 0) (void)xb_add(&bar[XB_XCNT(b.x)], 1u);
    return b;
}
__device__ __forceinline__ void xcd_barrier_complete(unsigned* bar, unsigned x, unsigned& nloc, unsigned& nx) {
    const unsigned G = gridDim.x * gridDim.y * gridDim.z;
    unsigned sum, cnt, mine, sp = 0u;
    for (;;) {
        sum = 0u; cnt = 0u; mine = 0u;
#pragma unroll
        for (unsigned j = 0; j < 16; ++j) { const unsigned c = xb_ld(&bar[XB_XCNT(j)]); sum += c; cnt += (c > 0u) ? 1u : 0u; mine = (j == x) ? c : mine; }
        if (sum == G) break;
        __builtin_amdgcn_s_sleep(1);
        if ((++sp & 255u) == 0u) { if (xb_ld(&bar[XB_TMO])) break; if (sp > XB_SPIN_CAP) { atomicAdd(&bar[XB_TMO], 1u); break; } }
    }
    nloc = mine > 0u ? mine : 1u; nx = cnt > 0u ? cnt : 1u;
}

__device__ __forceinline__ void xcd_barrier(const XcdBarrier& b) {
    asm volatile("s_waitcnt vmcnt(0)" ::: "memory");
    __syncthreads();
    if (threadIdx.x == 0) {
        unsigned* bar = b.bar;
        __builtin_amdgcn_s_waitcnt(0);
        unsigned nloc = b.st[0], nx = b.st[1];
        if (nloc == 0u) { xcd_barrier_complete(bar, b.x, nloc, nx); b.st[0] = nloc; b.st[1] = nx; }
        const unsigned old = xb_add(&bar[XB_XSUB(b.x)], 1u);
        const unsigned gen = old / nloc;
        if (old + 1u == (gen + 1u) * nloc) {
            __builtin_amdgcn_fence(__ATOMIC_RELEASE, "agent");
            asm volatile("s_waitcnt vmcnt(0)" ::: "memory");
            const unsigned og = xb_add(&bar[XB_TOP], 1u);
            const unsigned tg = og / nx;
            if (og + 1u == (tg + 1u) * nx) xb_add(&bar[XB_TOPGEN], 1u);
            else XB_SPIN(xb_ld(&bar[XB_TOPGEN]) == tg, bar);
            __builtin_amdgcn_fence(__ATOMIC_ACQUIRE, "agent");
            xb_add(&bar[XB_XGEN(b.x)], 1u);
            asm volatile("s_waitcnt vmcnt(0)" ::: "memory");
        } else {
            XB_SPIN(xb_ld(&bar[XB_XGEN(b.x)]) == gen, bar);
            __builtin_amdgcn_fence(__ATOMIC_ACQUIRE, "agent");
            asm volatile("s_waitcnt vmcnt(0)" ::: "memory");
        }
    }
    __syncthreads();
}

constexpr int NWAVES = 8;
struct Frame {
    LAS unsigned char* lds;
    volatile LAS unsigned* MISC;
    gu32* ctl;
    int tid, lane, wave, G, blk;
    const float* in[21];
    float* out; unsigned char* ws;
};
__device__ __forceinline__ float wave_sum(float v) {
#pragma unroll
    for (int o = 1; o < 64; o <<= 1) v += __shfl_xor(v, o);
    return v;
}

__device__ __forceinline__ int map_src(int mode, int n) {
    if (mode == 1) return n < 2500 ? n : (n >= C_MQ ? n - (C_MQ - 2500) : -1);
    if (mode == 2) { const int pn = n >> 8, bj = (n >> 7) & 1, j = n & 127; return bj * 1024 + pn * 128 + j; }
    return n;
}
__device__ __forceinline__ void transpose_item(const float* W, int K, int Nsrc, int Ndst, bf16_t* WT, int mode, LAS float* scr, int item, int lane) {
    const int nblk = Ndst / 32, kb = item / nblk, nb = item % nblk, k0 = 64 * kb, n0 = 32 * nb;
    const int sc = map_src(mode, n0 + (lane & 31));
    const float scale = (mode == 1 && (n0 + (lane & 31)) < 512) ? 0.125f : 1.0f;
#pragma unroll
    for (int i = 0; i < 32; ++i) { const int kk = 2 * i + (lane >> 5); scr[kk * 33 + (lane & 31)] = sc >= 0 ? W[(size_t)(k0 + kk) * Nsrc + sc] * scale : 0.f; }
    LDS_WAIT(); asm volatile("" ::: "memory");
    const int c = lane & 7;
#pragma unroll
    for (int j = 0; j < 4; ++j) { const int n = (lane >> 3) + 8 * j; const LAS float* s = scr + (8 * c) * 33 + n;
        u32x4 o; o.x = pk2(s[0 * 33], s[1 * 33]); o.y = pk2(s[2 * 33], s[3 * 33]); o.z = pk2(s[4 * 33], s[5 * 33]); o.w = pk2(s[6 * 33], s[7 * 33]);
        *(GAS u32x4*)(WT + (size_t)(n0 + n) * K + k0 + 8 * c) = o; }
    LDS_WAIT(); asm volatile("" ::: "memory");
}
__device__ __forceinline__ void rms_row_to_bf16(int lane, const float* xrow, const float* g, bf16_t* orow) {
    const GAS f32x4* xr = (const GAS f32x4*)xrow + lane; const GAS f32x4* gr = (const GAS f32x4*)g + lane;
    f32x4 v[4]; float s = 0.f;
#pragma unroll
    for (int j = 0; j < 4; ++j) { v[j] = xr[64 * j]; s += (v[j].x * v[j].x + v[j].y * v[j].y) + (v[j].z * v[j].z + v[j].w * v[j].w); }
    const float rstd = 1.0f / sqrtf(wave_sum(s) * (1.f / DM) + EPS);
    GAS u32x2* o8 = (GAS u32x2*)orow + lane;
#pragma unroll
    for (int j = 0; j < 4; ++j) { const f32x4 gg = gr[64 * j]; u32x2 o; o.x = pk2(v[j].x * rstd * gg.x, v[j].y * rstd * gg.y); o.y = pk2(v[j].z * rstd * gg.z, v[j].w * rstd * gg.w); o8[64 * j] = o; }
}

__device__ __forceinline__ void rms_rows4_to_bf16(int lane, const float* x, const float* g, bf16_t* o, size_t m0, size_t stride) {
    f32x4 v[4][4]; float s[4];
#pragma unroll
    for (int r = 0; r < 4; ++r) { const GAS f32x4* xr = (const GAS f32x4*)(x + (m0 + r * stride) * DM) + lane;
#pragma unroll
        for (int j = 0; j < 4; ++j) v[r][j] = xr[64 * j]; }
    const GAS f32x4* gr = (const GAS f32x4*)g + lane;
    f32x4 gg[4];
#pragma unroll
    for (int j = 0; j < 4; ++j) gg[j] = gr[64 * j];
#pragma unroll
    for (int r = 0; r < 4; ++r) { float a = 0.f;
#pragma unroll
        for (int j = 0; j < 4; ++j) a += (v[r][j].x * v[r][j].x + v[r][j].y * v[r][j].y) + (v[r][j].z * v[r][j].z + v[r][j].w * v[r][j].w);
        s[r] = a; }
#pragma unroll
    for (int of = 1; of < 64; of <<= 1) {
#pragma unroll
        for (int r = 0; r < 4; ++r) s[r] += __shfl_xor(s[r], of); }
#pragma unroll
    for (int r = 0; r < 4; ++r) { const float rstd = 1.0f / sqrtf(s[r] * (1.f / DM) + EPS);
        GAS u32x2* o8 = (GAS u32x2*)(o + (m0 + r * stride) * DM) + lane;
#pragma unroll
        for (int j = 0; j < 4; ++j) { u32x2 w; w.x = pk2(v[r][j].x * rstd * gg[j].x, v[r][j].y * rstd * gg[j].y); w.y = pk2(v[r][j].z * rstd * gg[j].z, v[r][j].w * rstd * gg[j].w); o8[64 * j] = w; } }
}
__device__ __forceinline__ void p0_prologue(Frame& F) {
    LAS float* scr = (LAS float*)(F.lds + F.wave * 16384);
    const int gw = F.blk * NWAVES + F.wave, NGW = F.G * NWAVES, lane = F.lane;
    unsigned char* ws = F.ws;
    constexpr int I_IN = 16 * 96, I_MKV = 16 * 32, I_G = 16 * 32, I_B = 8 * 32, I_O = 16 * 32, I_EI = 16 * 64, I_EO = 16 * 32;
    constexpr int NITEMS = I_IN + I_MKV + 3 * I_G + 3 * I_B + I_O + NEXP * I_EI + NEXP * I_EO;
    for (int it = gw; it < NITEMS; it += NGW) {
        int r = it;
        if (r < I_IN) { transpose_item(F.in[3], DM, IN_W, PW, (bf16_t*)(ws + WS_WIN), 1, scr, r, lane); continue; } r -= I_IN;
        if (r < I_MKV) { transpose_item(F.in[9], DM, DM, DM, (bf16_t*)(ws + WS_WMKV), 0, scr, r, lane); continue; } r -= I_MKV;
        if (r < 3 * I_G) { const int n = r / I_G; transpose_item(F.in[10] + (size_t)n * DM * DM, DM, DM, DM, (bf16_t*)(ws + WS_WG) + (size_t)n * DM * DM, 0, scr, r % I_G, lane); continue; } r -= 3 * I_G;
        if (r < 3 * I_B) { const int n = r / I_B; transpose_item(F.in[12] + (size_t)n * 512 * DM, 512, DM, DM, (bf16_t*)(ws + WS_WB) + (size_t)n * DM * 512, 0, scr, r % I_B, lane); continue; } r -= 3 * I_B;
        if (r < I_O) { transpose_item(F.in[13], DM, DM, DM, (bf16_t*)(ws + WS_WO), 0, scr, r, lane); continue; } r -= I_O;
        if (r < NEXP * I_EI) { const int e = r / I_EI; transpose_item(F.in[17] + (size_t)e * DM * 2048, DM, 2048, 2048, (bf16_t*)(ws + WS_WEI) + (size_t)e * 2048 * DM, 2, scr, r % I_EI, lane); continue; } r -= NEXP * I_EI;
        { const int e = r / I_EO; transpose_item(F.in[19] + (size_t)e * DM * DM, DM, DM, DM, (bf16_t*)(ws + WS_WEO) + (size_t)e * DM * DM, 0, scr, r % I_EO, lane); }
    }
    { f32x2* tab = (f32x2*)(ws + WS_ROPE);
      for (int idx = (F.blk * NWAVES * 64) + F.tid; idx < SEQ * 32; idx += F.G * NWAVES * 64) {
          const int s = idx >> 5, i = idx & 31;
          const float inv = exp2f(-(float)i * (13.287712379549449f / 32.0f));
          const float ang = (float)s * inv;
          const double rev = (double)ang * 0.15915494309189535;
          const float fr = (float)(rev - __builtin_rint(rev));
          tab[idx] = (f32x2){__builtin_amdgcn_cosf(fr), __builtin_amdgcn_sinf(fr)}; } }
    for (int m = gw; m < NTOK; m += 4 * NGW) rms_rows4_to_bf16(lane, F.in[0], F.in[2], (bf16_t*)(ws + WS_H), (size_t)m, (size_t)NGW);
    for (int m = gw; m < NMEM; m += 4 * NGW) rms_rows4_to_bf16(lane, F.in[1], F.in[8], (bf16_t*)(ws + WS_MEMN), (size_t)m, (size_t)NGW);
    { int* st = (int*)(ws + WS_SLOT_TOK); float* sw = (float*)(ws + WS_SLOT_W);
      for (int i = F.blk * NWAVES * 64 + F.tid; i < NSLOT_PAD; i += F.G * NWAVES * 64) { st[i] = 0; sw[i] = 0.f; } }
}

template <int CTRL> __device__ __forceinline__ float dppf(float v) { return __builtin_bit_cast(float, __builtin_amdgcn_update_dpp(0, __builtin_bit_cast(int, v), CTRL, 0xF, 0xF, false)); }
__device__ __forceinline__ float lx1(float v) { return dppf<0xB1>(v); }
__device__ __forceinline__ float lx2(float v) { return dppf<0x4E>(v); }
__device__ __forceinline__ float lx4(float v) { return dppf<0x1B>(dppf<0x141>(v)); }
__device__ __forceinline__ float lx8(float v) { return dppf<0x128>(v); }
__device__ __forceinline__ void un8(const u32x4 w, float (&v)[8]) { v[0] = bflo(w.x); v[1] = bfhi(w.x); v[2] = bflo(w.y); v[3] = bfhi(w.y); v[4] = bflo(w.z); v[5] = bfhi(w.z); v[6] = bflo(w.w); v[7] = bfhi(w.w); }
__device__ __forceinline__ u32x4 pk8(const float (&v)[8]) { u32x4 w; w.x = pk2(v[0], v[1]); w.y = pk2(v[2], v[3]); w.z = pk2(v[4], v[5]); w.w = pk2(v[6], v[7]); return w; }
__device__ __forceinline__ void rope8(float (&v)[8], const f32x2 (&cs)[8], bool up) {
#pragma unroll
    for (int j = 0; j < 8; ++j) { const float other = lx4(v[j]); v[j] = up ? (other * cs[j].y + v[j] * cs[j].x) : (v[j] * cs[j].x - other * cs[j].y); }
}
__device__ __forceinline__ void p2_prep(Frame& F, const bool dummy = false) {
    const int gw = F.blk * NWAVES + F.wave, NGW = F.G * NWAVES, lane = F.lane;
    bf16_t* proj = (bf16_t*)(F.ws + WS_P);
    bf16_t* projw = dummy ? (bf16_t*)(F.ws + WS_END) : proj;
    const int wmask = dummy ? 8191 : 0x7fffffff;
    const f32x2* tab = (const f32x2*)(F.ws + WS_ROPE);
    float gqd[8], gkd[8], gqm[8];
#pragma unroll
    for (int j = 0; j < 8; ++j) { gqd[j] = F.in[4][8 * (lane & 7) + j] * (0.125f * LOG2E); gkd[j] = F.in[5][8 * (lane & 7) + j]; gqm[j] = F.in[6][8 * (lane & 15) + j] * (0.08838834764831845f * LOG2E); }
    const bool up = (lane & 4) != 0; const int i0 = (lane & 3) * 8;
    for (int m0 = gw; m0 < NTOK; m0 += 2 * NGW) {
        u32x4 raw[2][5]; f32x2 cs[2][8];
#pragma unroll
        for (int t = 0; t < 2; ++t) { const GAS bf16_t* row = (const GAS bf16_t*)proj + (size_t)(m0 + t * NGW) * PW;
            raw[t][0] = *(const GAS u32x4*)(row + C_DQ + 8 * lane); raw[t][1] = *(const GAS u32x4*)(row + C_DK + 8 * (lane & 7)); raw[t][2] = *(const GAS u32x4*)(row + C_IQ + 8 * (lane & 31));
            raw[t][3] = *(const GAS u32x4*)(row + C_IK + 8 * (lane & 7)); raw[t][4] = *(const GAS u32x4*)(row + C_MQ + 8 * lane);
            const GAS f32x2* tr = (const GAS f32x2*)tab + (size_t)((m0 + t * NGW) & (SEQ - 1)) * 32 + i0;
#pragma unroll
            for (int j = 0; j < 8; ++j) cs[t][j] = tr[j]; }
#pragma unroll
        for (int t = 0; t < 2; ++t) {
            GAS bf16_t* roww = (GAS bf16_t*)projw + (size_t)((m0 + t * NGW) & wmask) * PW;
            float v[8];
            { un8(raw[t][0], v); float ss = 0.f;
#pragma unroll
              for (int j = 0; j < 8; ++j) ss += v[j] * v[j];
              ss += lx1(ss); ss += lx2(ss); ss += lx4(ss);
              const float rstd = 1.0f / sqrtf(ss * (1.f / 64.f) + EPS);
#pragma unroll
              for (int j = 0; j < 8; ++j) v[j] = v[j] * rstd * gqd[j];
              rope8(v, cs[t], up);
              *(GAS u32x4*)(roww + C_DQ + 8 * lane) = pk8(v); }
            { un8(raw[t][1], v); float ss = 0.f;
#pragma unroll
              for (int j = 0; j < 8; ++j) ss += v[j] * v[j];
              ss += lx1(ss); ss += lx2(ss); ss += lx4(ss);
              const float rstd = 1.0f / sqrtf(ss * (1.f / 64.f) + EPS);
#pragma unroll
              for (int j = 0; j < 8; ++j) v[j] = v[j] * rstd * gkd[j];
              rope8(v, cs[t], up);
              if (lane < 8) *(GAS u32x4*)(roww + C_DK + 8 * lane) = pk8(v); }
            { un8(raw[t][2], v); rope8(v, cs[t], up); if (lane < 32) *(GAS u32x4*)(roww + C_IQ + 8 * lane) = pk8(v); }
            { un8(raw[t][3], v); rope8(v, cs[t], up); if (lane < 8) *(GAS u32x4*)(roww + C_IK + 8 * lane) = pk8(v); }
            { un8(raw[t][4], v); float ss = 0.f;
#pragma unroll
              for (int j = 0; j < 8; ++j) ss += v[j] * v[j];
              ss += lx1(ss); ss += lx2(ss); ss += lx4(ss); ss += lx8(ss);
              const float rstd = 1.0f / sqrtf(ss * (1.f / 128.f) + EPS);
#pragma unroll
              for (int j = 0; j < 8; ++j) v[j] = v[j] * rstd * gqm[j];
              *(GAS u32x4*)(roww + C_MQ + 8 * lane) = pk8(v); }
        }
    }
    bf16_t* mkv = (bf16_t*)(F.ws + WS_MKV);
    if (!dummy) for (int m = gw; m < NMEM; m += NGW) {
        GAS bf16_t* row = (GAS bf16_t*)mkv + (size_t)m * DM; float v[8];
        un8(*(const GAS u32x4*)(row + 8 * lane), v); float ss = 0.f;
#pragma unroll
        for (int j = 0; j < 8; ++j) ss += v[j] * v[j];
        ss += lx1(ss); ss += lx2(ss); ss += lx4(ss); ss += lx8(ss);
        const float rstd = 1.0f / sqrtf(ss * (1.f / 128.f) + EPS);
#pragma unroll
        for (int j = 0; j < 8; ++j) v[j] = v[j] * rstd * F.in[7][8 * (lane & 15) + j];
        *(GAS u32x4*)(row + 8 * lane) = pk8(v);
    }
}

#define MFMA32(a, b, c) __builtin_amdgcn_mfma_f32_32x32x16_bf16((a), (b), (c), 0, 0, 0)
typedef LAS const unsigned char* lds_cptr;
__device__ __forceinline__ s16x4 vtr(lds_cptr p) { return __builtin_bit_cast(s16x4, __builtin_amdgcn_ds_read_tr16_b64_v4i16((LAS v4i16_t*)p)); }
__device__ __forceinline__ bf16x8 vfrag(lds_cptr vbase_lane, int off) {
    const s16x4 lo = vtr(vbase_lane + off), hi = vtr(vbase_lane + off + 512);
    return (bf16x8){lo[0], lo[1], lo[2], lo[3], hi[0], hi[1], hi[2], hi[3]};
}
__device__ __forceinline__ int vtr_lane_off(int lane) { return ((lane >> 4) & 1) * 32 + (lane & 3) * 8 + (4 * (lane >> 5) + ((lane & 15) >> 2)) * 64; }
__device__ __forceinline__ bf16x8 pack8(const float* p) {
    u32x4 w; w.x = cvt_pk_bf16(p[0], p[1]); w.y = cvt_pk_bf16(p[2], p[3]); w.z = cvt_pk_bf16(p[4], p[5]); w.w = cvt_pk_bf16(p[6], p[7]);
    return __builtin_bit_cast(bf16x8, w);
}
__device__ __forceinline__ float softplus_f(float z) { return fmaxf(z, 0.f) + __logf(1.f + __expf(-fabsf(z))); }

__device__ __forceinline__ void sb_item(const bf16_t* proj, bf16_t* osb, int b, int h, int qblk, LAS unsigned char* vlds, int lane) {
    const int r32 = lane & 31, hi = lane >> 5;
    const size_t tok0 = (size_t)b * SEQ + (size_t)qblk * 32;
    bf16x8 qr[4];
    { const bf16_t* qp = proj + (tok0 + r32) * PW + C_SQ + h * 64 + hi * 8;
#pragma unroll
      for (int kk = 0; kk < 4; ++kk) qr[kk] = *(const bf16x8*)(qp + kk * 16); }
    f32x16 o0 = {}, o1 = {}; float R = 0.f;
    const lds_cptr vrd = (lds_cptr)vlds + vtr_lane_off(lane);
    bf16x8 kfn[4]; u32x4 vvn[4];
#define SB_LOAD(kt_) do { const size_t key0_ = (size_t)b * SEQ + (size_t)(kt_) * 32; const GAS bf16_t* kp_ = (const GAS bf16_t*)proj + (key0_ + r32) * PW + C_SK + h * 64 + hi * 8; \
        _Pragma("unroll") for (int kk = 0; kk < 4; ++kk) kfn[kk] = *(const GAS bf16x8*)(kp_ + kk * 16); \
        _Pragma("unroll") for (int p = 0; p < 4; ++p) vvn[p] = *(const GAS u32x4*)((const GAS bf16_t*)proj + (key0_ + 16 * (p & 1) + (lane >> 2)) * PW + C_SV + h * 64 + (p >> 1) * 32 + (lane & 3) * 8); } while (0)
    SB_LOAD(qblk);
    for (int kt = qblk; kt >= 0; --kt) {
        bf16x8 kf[4]; u32x4 vv[4];
#pragma unroll
        for (int i = 0; i < 4; ++i) { kf[i] = kfn[i]; vv[i] = vvn[i]; }
        if (kt > 0) SB_LOAD(kt - 1);
        f32x16 s = {};
#pragma unroll
        for (int kk = 0; kk < 4; ++kk) s = MFMA32(kf[kk], qr[kk], s);
        asm volatile("" ::: "memory");
#pragma unroll
        for (int p = 0; p < 4; ++p) *(LAS u32x4*)(vlds + p * 1024 + lane * 16) = vv[p];
        const bool diag = (kt == qblk);
        float sp[16], pr[16];
#pragma unroll
        for (int r = 0; r < 16; ++r) { const bool valid = !diag || (crow(r, hi) < r32); sp[r] = valid ? softplus_f(s[r]) : 0.f; }
        float T[4], U[4];
#pragma unroll
        for (int g = 0; g < 4; ++g) { T[g] = (sp[4 * g] + sp[4 * g + 1]) + (sp[4 * g + 2] + sp[4 * g + 3]); U[g] = __shfl_xor(T[g], 32); }
        float run = 0.f, above[4];
#pragma unroll
        for (int g = 3; g >= 0; --g) { above[g] = run + (hi == 0 ? U[g] : 0.f); run += T[g] + U[g]; }
#pragma unroll
        for (int g = 0; g < 4; ++g) { float c = R + above[g];
#pragma unroll
            for (int j = 3; j >= 0; --j) { const int r = 4 * g + j; c += sp[r]; const bool valid = !diag || (crow(r, hi) < r32); pr[r] = valid ? __expf(s[r] - c) : 0.f; } }
        R += run;
        const bf16x8 p0 = pack8(pr), p1 = pack8(pr + 8);
        LDS_WAIT();
        const bf16x8 v00 = vfrag(vrd, 0), v01 = vfrag(vrd, 1024), v10 = vfrag(vrd, 2048), v11 = vfrag(vrd, 3072);
        o0 = MFMA32(v00, p0, o0); o0 = MFMA32(v01, p1, o0);
        o1 = MFMA32(v10, p0, o1); o1 = MFMA32(v11, p1, o1);
        asm volatile("" ::: "memory");
        if (__all(R > 30.0f)) break;
    }
#undef SB_LOAD
    bf16_t* op = osb + (tok0 + r32) * 512 + h * 64 + 4 * hi;
#pragma unroll
    for (int g = 0; g < 4; ++g) {
        u32x2 w0, w1; w0.x = cvt_pk_bf16(o0[4 * g], o0[4 * g + 1]); w0.y = cvt_pk_bf16(o0[4 * g + 2], o0[4 * g + 3]); w1.x = cvt_pk_bf16(o1[4 * g], o1[4 * g + 1]); w1.y = cvt_pk_bf16(o1[4 * g + 2], o1[4 * g + 3]);
        *(u32x2*)(op + 8 * g) = w0; *(u32x2*)(op + 32 + 8 * g) = w1; }
}

constexpr int ML_K = 0, ML_KROW = 272, ML_V = 256 * ML_KROW, ML_END = ML_V + 65536;
__device__ __forceinline__ void mem_unit(const bf16_t* proj, const bf16_t* mkv, bf16_t* omem, int b, int h, int half, LAS unsigned char* ml, int tid) {
    const int lane = tid & 63, wid = __builtin_amdgcn_readfirstlane(tid >> 6), r32 = lane & 31, hi = lane >> 5;
    { const GAS bf16_t* src = (const GAS bf16_t*)mkv + (size_t)b * MEMLEN * DM + h * 128;
#pragma unroll
      for (int i = 0; i < 8; ++i) { const int ch = tid + 512 * i, key = ch >> 4, c16 = ch & 15, kk = key & 31;
          const u32x4 kv = *(const GAS u32x4*)(src + (size_t)key * DM + c16 * 8);
          const u32x4 vv = *(const GAS u32x4*)(src + (size_t)key * DM + 512 + c16 * 8);
          *(LAS u32x4*)(ml + ML_K + key * ML_KROW + c16 * 16) = kv;
          *(LAS u32x4*)(ml + ML_V + (key >> 5) * 8192 + ((c16 >> 2) * 2 + (kk >> 4)) * 1024 + (kk & 15) * 64 + (c16 & 3) * 16) = vv; } }
    __syncthreads();
    for (int i = 0; i < 4; ++i) {
        const int qblk = half * 32 + wid * 4 + i;
        const size_t tok0 = (size_t)b * SEQ + (size_t)qblk * 32;
        bf16x8 qr[8];
        { const GAS bf16_t* qp = (const GAS bf16_t*)proj + (tok0 + r32) * PW + C_MQ + h * 128 + hi * 8;
#pragma unroll
          for (int kk = 0; kk < 8; ++kk) qr[kk] = *(const GAS bf16x8*)(qp + kk * 16); }
        f32x16 o[4] = {{}, {}, {}, {}}; float m = -1e30f, l = 0.f;
        for (int kb = 0; kb < 8; ++kb) {
            const LAS unsigned char* krd = ml + ML_K + (32 * kb + r32) * ML_KROW + hi * 16;
            f32x16 s = {};
#pragma unroll
            for (int kk = 0; kk < 8; ++kk) { const bf16x8 kf = *(const LAS bf16x8*)(krd + kk * 32); s = MFMA32(kf, qr[kk], s); }
            float mx = s[0];
#pragma unroll
            for (int r = 1; r < 16; ++r) mx = fmaxf(mx, s[r]);
            mx = fmaxf(mx, __shfl_xor(mx, 32));
            if (__any(mx > m + 8.0f)) {
                const float mn = fmaxf(m, mx), alpha = __builtin_amdgcn_exp2f(m - mn);
                l *= alpha; m = mn;
#pragma unroll
                for (int d = 0; d < 4; ++d)
#pragma unroll
                    for (int r = 0; r < 16; ++r) o[d][r] *= alpha;
            }
            float pr[16], rs = 0.f;
#pragma unroll
            for (int r = 0; r < 16; ++r) { pr[r] = __builtin_amdgcn_exp2f(s[r] - m); rs += pr[r]; }
            l += rs;
            const bf16x8 p0 = pack8(pr), p1 = pack8(pr + 8);
            const lds_cptr vrd = (lds_cptr)ml + ML_V + kb * 8192 + vtr_lane_off(lane);
#pragma unroll
            for (int d = 0; d < 4; ++d) { const bf16x8 va = vfrag(vrd, d * 2048), vb = vfrag(vrd, d * 2048 + 1024); o[d] = MFMA32(va, p0, o[d]); o[d] = MFMA32(vb, p1, o[d]); }
        }
        l += __shfl_xor(l, 32);
        const float il = 1.0f / l;
        bf16_t* op = omem + (tok0 + r32) * 512 + h * 128 + 4 * hi;
#pragma unroll
        for (int d = 0; d < 4; ++d)
#pragma unroll
            for (int g = 0; g < 4; ++g) { u32x2 w; w.x = cvt_pk_bf16(o[d][4 * g] * il, o[d][4 * g + 1] * il); w.y = cvt_pk_bf16(o[d][4 * g + 2] * il, o[d][4 * g + 3] * il); *(u32x2*)(op + 32 * d + 8 * g) = w; }
    }
    __syncthreads();
}

constexpr int DL_HIST = 0, DL_PREFIX = 66048, DL_KREM = DL_PREFIX + 256, DL_MASK = 67072, DL_VT = 73728, DL_KT = DL_VT + 2 * 16384, DL_END = DL_KT + 2 * 18432, DL_IQ = DL_VT;
constexpr int TOPK_DSA = 256;

struct IqLds { const LAS unsigned char* p; __device__ __forceinline__ bf16x8 operator()(int j) const { return *(const LAS bf16x8*)(p + j * 32); } };
template <class QF>
__device__ __forceinline__ void idx_scores(const QF& qf, const bf16x8 (&kf)[4], const float (&wq)[4], unsigned (&uk)[16]) {
    float scv[16];
#pragma unroll
    for (int hd = 0; hd < 4; ++hd) { f32x16 a = (f32x16){};
#pragma unroll
        for (int kk = 0; kk < 4; ++kk) a = MFMA32(kf[kk], qf(hd * 4 + kk), a);
#pragma unroll
        for (int r = 0; r < 16; ++r) scv[r] = (hd == 0) ? wq[0] * fmaxf(a[r], 0.f) : __builtin_fmaf(wq[hd], fmaxf(a[r], 0.f), scv[r]); }
#pragma unroll
    for (int r = 0; r < 16; ++r) {
        unsigned bits = __builtin_bit_cast(unsigned, scv[r]);
        if (bits == 0x80000000u) bits = 0u;
        uk[r] = bits ^ ((unsigned)((int)bits >> 31) | 0x80000000u);
    }
}
__device__ __forceinline__ void load_ik(const bf16_t* proj, size_t tokb, int kbase, int r32, int hi, bf16x8 (&kf)[4]) {
    int kr = kbase + r32; if (kr > SEQ - 1) kr = SEQ - 1;
    const GAS bf16_t* p = (const GAS bf16_t*)proj + (tokb + kr) * PW + C_IK + 8 * hi;
#pragma unroll
    for (int kk = 0; kk < 4; ++kk) kf[kk] = *(const GAS bf16x8*)(p + kk * 16);
}

__device__ __forceinline__ void dsa_unit(const bf16_t* proj, bf16_t* odsa, unsigned* kscr  , int b, int c, LAS unsigned char* dl, int tid) {
    const int lane = tid & 63, wid = __builtin_amdgcn_readfirstlane(tid >> 6), r32 = lane & 31, hi = lane >> 5;
    const int n = 64 * (c + 1), nsteps = (n + 127) >> 7;
    const size_t tokq0 = (size_t)b * SEQ + (size_t)c * 64, tokb = (size_t)b * SEQ;
    LAS unsigned* hist = (LAS unsigned*)(dl + DL_HIST);
    LAS unsigned* prefix = (LAS unsigned*)(dl + DL_PREFIX);
    LAS unsigned* krem = (LAS unsigned*)(dl + DL_KREM);
    LAS unsigned* mask = (LAS unsigned*)(dl + DL_MASK);
    const int kb = wid >> 1, qh = wid & 1;
    { const int row = tid >> 3, c = tid & 7;
      const GAS bf16_t* src = (const GAS bf16_t*)proj + (tokq0 + row) * PW + C_IQ + c * 32;
#pragma unroll
      for (int i = 0; i < 4; ++i) *(LAS u32x4*)(dl + DL_IQ + row * 528 + c * 64 + i * 16) = *(const GAS u32x4*)(src + i * 8); }
    const IqLds iqf{dl + DL_IQ + (32 * qh + r32) * 528 + hi * 16};
    float wq[4];
    { const u32x2 w = *(const u32x2*)(proj + (tokq0 + 32 * qh + r32) * PW + C_IW);
      wq[0] = bflo(w.x) * 0.0625f; wq[1] = bfhi(w.x) * 0.0625f; wq[2] = bflo(w.y) * 0.0625f; wq[3] = bfhi(w.y) * 0.0625f; }
#ifndef REP_SEL
#define REP_SEL 1
#endif
#ifndef REP_B2
#define REP_B2 1
#endif
    LAS unsigned* selall = (LAS unsigned*)(dl + DL_HIST);
#ifndef PROBE_NOATOM
#define PROBE_NOATOM 0
#endif
    unsigned dummy = 0u;
    for (int rep_sel = 0; rep_sel < REP_SEL; ++rep_sel) {
    if (tid < 64) { prefix[tid] = 0u; krem[tid] = (n > TOPK_DSA) ? (unsigned)TOPK_DSA : 0x7fffffffu; }
    __syncthreads();
    const int pass0 = (n > TOPK_DSA) ? 0 : 3;
    GAS u32x4* kmine = (GAS u32x4*)kscr + ((size_t)wid * 64 + lane) * 4;
#define DSA_CONSUME(uk_) do { \
        if (sel) { _Pragma("unroll") for (int r = 0; r < 16; ++r) { const bool match = (pass == 0) || (((uk_)[r] >> (shift + 8)) == pfx); \
                if (match && !(PROBE_NOATOM && rep_sel + 1 < REP_SEL)) __hip_atomic_fetch_add(hist + (32 * qh + r32) * 257 + (((uk_)[r] >> shift) & 255u), 1u, __ATOMIC_RELAXED, __HIP_MEMORY_SCOPE_WORKGROUP); else dummy ^= (uk_)[r]; } } \
        else { _Pragma("unroll") for (int r = 0; r < 16; ++r) { const unsigned k24 = (uk_)[r] >> 8; gtw |= (k24 > pfx ? 1u : 0u) << crow(r, hi); eqw |= (k24 == pfx ? 1u : 0u) << crow(r, hi); } } } while (0)
#define DSA_TIES() do { if (!sel) { \
        LAS unsigned* mk = mask + (step & 1) * 768; \
        gtw |= __shfl_xor(gtw, 32); eqw |= __shfl_xor(eqw, 32); \
        if (hi == 0) { mk[(32 * qh + r32) * 4 + kb] = gtw; mk[256 + (32 * qh + r32) * 4 + kb] = eqw; } \
        __syncthreads(); \
        if (wid == 0) { unsigned nd = krem[lane]; \
            _Pragma("unroll") for (int k4 = 0; k4 < 4; ++k4) { const unsigned g = mk[lane * 4 + k4]; unsigned e = mk[256 + lane * 4 + k4]; unsigned sl = g; \
                if (e != 0u) { const unsigned cnt = (unsigned)__builtin_popcount(e); \
                    if (cnt <= nd) { sl |= e; nd -= cnt; } \
                    else { unsigned chosen = 0u; while (nd > 0u) { const unsigned lb = e & (0u - e); chosen |= lb; e ^= lb; --nd; } sl |= chosen; } } \
                selall[lane * 64 + step * 4 + k4] = sl; } \
            krem[lane] = nd; } } } while (0)
    for (int pass = pass0; pass < ((rep_sel + 1 < REP_SEL) ? 3 : 4); ++pass) {
        const bool sel = pass < 3;
        if (sel) { for (int i = tid; i < 64 * 257; i += 512) hist[i] = 0u; __syncthreads(); }
        const int shift = 24 - 8 * pass;
        const unsigned pfx = prefix[32 * qh + r32];
        if (pass == pass0) {
            bf16x8 kfn[4]; load_ik(proj, tokb, 32 * kb, r32, hi, kfn);
            for (int step = 0; step < nsteps; ++step) {
                const int kbase = 128 * step + 32 * kb;
                bf16x8 kf[4];
#pragma unroll
                for (int kk = 0; kk < 4; ++kk) kf[kk] = kfn[kk];
                if (step + 1 < nsteps) load_ik(proj, tokb, kbase + 128, r32, hi, kfn);
                unsigned gtw = 0u, eqw = 0u;
                if (kbase < n) {
                    unsigned uk[16];
                    idx_scores(iqf, kf, wq, uk);
                    if (pass0 == 0) {
#pragma unroll
                        for (int g = 0; g < 4; ++g) kmine[(size_t)step * 2048 + g] = (u32x4){uk[4 * g], uk[4 * g + 1], uk[4 * g + 2], uk[4 * g + 3]};
                    }
                    DSA_CONSUME(uk);
                }
                DSA_TIES();
            }
        } else {
            u32x4 ka[4], kb4[4];
#define DSA_KLOAD(dst, st_) do { _Pragma("unroll") for (int g = 0; g < 4; ++g) dst[g] = kmine[(size_t)(st_) * 2048 + g]; } while (0)
            DSA_KLOAD(ka, 0);
            if (nsteps > 1 && 128 + 32 * kb < n) DSA_KLOAD(kb4, 1);
            for (int step = 0; step < nsteps; ++step) {
                const int kbase = 128 * step + 32 * kb;
                unsigned uk[16];
#pragma unroll
                for (int g = 0; g < 4; ++g) { uk[4 * g] = ka[g].x; uk[4 * g + 1] = ka[g].y; uk[4 * g + 2] = ka[g].z; uk[4 * g + 3] = ka[g].w; }
#pragma unroll
                for (int g = 0; g < 4; ++g) ka[g] = kb4[g];
                if (step + 2 < nsteps && kbase + 256 < n) DSA_KLOAD(kb4, step + 2);
                unsigned gtw = 0u, eqw = 0u;
                if (kbase < n) DSA_CONSUME(uk);
                DSA_TIES();
            }
#undef DSA_KLOAD
        }
        if (sel) {
            __syncthreads();
#pragma unroll
            for (int qi = 0; qi < 8; ++qi) {
                const int q = 8 * wid + qi;
                const LAS unsigned* hq = hist + q * 257;
                const unsigned c0 = hq[255 - 4 * lane], c1 = hq[254 - 4 * lane], c2 = hq[253 - 4 * lane], c3 = hq[252 - 4 * lane];
                const unsigned s4 = c0 + c1 + c2 + c3;
                unsigned incl = s4;
#pragma unroll
                for (int o = 1; o < 64; o <<= 1) { const unsigned t = __shfl_up(incl, o); if (lane >= o) incl += t; }
                const unsigned excl = incl - s4, kr = krem[q];
                if (excl < kr && kr <= incl) {
                    unsigned cum = excl, bin, nk;
                    if (cum + c0 >= kr) { bin = 255 - 4 * lane; nk = kr - cum; }
                    else { cum += c0; if (cum + c1 >= kr) { bin = 254 - 4 * lane; nk = kr - cum; }
                    else { cum += c1; if (cum + c2 >= kr) { bin = 253 - 4 * lane; nk = kr - cum; }
                    else { cum += c2; bin = 252 - 4 * lane; nk = kr - cum; } } }
                    prefix[q] = (prefix[q] << 8) | bin; krem[q] = nk;
                }
            }
            __syncthreads();
        }
    }
    }
    if (dummy == 0x9e3779b9u) hist[tid] = 1u;
    const int hd = wid;
    u32x4 pk[2], pv[2];
#define DSA_LOADKV(step_) do { _Pragma("unroll") for (int i_ = 0; i_ < 2; ++i_) { const int ch_ = tid + 512 * i_; int krow_ = 128 * (step_) + (ch_ >> 3); if (krow_ > SEQ - 1) krow_ = SEQ - 1; \
        const GAS bf16_t* rp_ = (const GAS bf16_t*)proj + (tokb + krow_) * PW + (ch_ & 7) * 8; pk[i_] = *(const GAS u32x4*)(rp_ + C_DK); pv[i_] = *(const GAS u32x4*)(rp_ + C_DV); } } while (0)
#define DSA_STOREKV(buf_) do { _Pragma("unroll") for (int i_ = 0; i_ < 2; ++i_) { const int ch_ = tid + 512 * i_, key_ = ch_ >> 3, c8_ = ch_ & 7, kk_ = key_ & 31; \
        *(LAS u32x4*)(dl + DL_KT + (buf_) * 18432 + key_ * 144 + c8_ * 16) = pk[i_]; \
        *(LAS u32x4*)(dl + DL_VT + (buf_) * 16384 + (key_ >> 5) * 4096 + ((c8_ >> 2) * 2 + (kk_ >> 4)) * 1024 + (kk_ & 15) * 64 + (c8_ & 3) * 16) = pv[i_]; } } while (0)
    for (int qb = 0; qb < 2; ++qb) {
        bf16x8 qr[4];
        { const GAS bf16_t* qp = (const GAS bf16_t*)proj + (tokq0 + 32 * qb + r32) * PW + C_DQ + hd * 64 + 8 * hi;
#pragma unroll
          for (int kk = 0; kk < 4; ++kk) qr[kk] = *(const GAS bf16x8*)(qp + kk * 16); }
        f32x16 o0 = {}, o1 = {}; float mrun = -1e30f, lrun = 0.f;
        DSA_LOADKV(0);
        DSA_STOREKV(0);
        __syncthreads();
        for (int step = 0; step < nsteps; ++step) {
            const int buf = step & 1;
            if (step + 1 < nsteps) DSA_LOADKV(step + 1);
            LAS unsigned char* kt = dl + DL_KT + buf * 18432;
            LAS unsigned char* vt = dl + DL_VT + buf * 16384;
            for (int k4 = 0; k4 < 4; ++k4) {
                const int kbase = 128 * step + 32 * k4;
                if (kbase >= n) break;
                const LAS unsigned char* krd = kt + (32 * k4 + r32) * 144 + hi * 16;
                f32x16 s = {};
#pragma unroll
                for (int kk = 0; kk < 4; ++kk) { const bf16x8 kf = *(const LAS bf16x8*)(krd + kk * 32); s = MFMA32(kf, qr[kk], s); }
                const lds_cptr vrd = (lds_cptr)vt + k4 * 4096 + vtr_lane_off(lane);
                const bf16x8 v00 = vfrag(vrd, 0), v01 = vfrag(vrd, 1024), v10 = vfrag(vrd, 2048), v11 = vfrag(vrd, 3072);
                const unsigned selw = selall[(32 * qb + r32) * 64 + step * 4 + k4];
                float mx = -INFINITY;
#pragma unroll
                for (int r = 0; r < 16; ++r) { if (!((selw >> crow(r, hi)) & 1u)) s[r] = -INFINITY; mx = fmaxf(mx, s[r]); }
                mx = fmaxf(mx, __shfl_xor(mx, 32));
                if (__any(mx > mrun + 8.0f)) {
                    const float mn = fmaxf(mrun, mx), alpha = __builtin_amdgcn_exp2f(mrun - mn);
                    lrun *= alpha; mrun = mn;
#pragma unroll
                    for (int r = 0; r < 16; ++r) { o0[r] *= alpha; o1[r] *= alpha; }
                }
                float pr[16], rs = 0.f;
#pragma unroll
                for (int r = 0; r < 16; ++r) { pr[r] = __builtin_amdgcn_exp2f(s[r] - mrun); rs += pr[r]; }
                lrun += rs;
                const bf16x8 p0 = pack8(pr), p1 = pack8(pr + 8);
                o0 = MFMA32(v00, p0, o0); o0 = MFMA32(v01, p1, o0);
                o1 = MFMA32(v10, p0, o1); o1 = MFMA32(v11, p1, o1);
            }
            if (step + 1 < nsteps) DSA_STOREKV(buf ^ 1);
            __syncthreads();
        }
        float l = lrun; l += __shfl_xor(l, 32);
        const float il = 1.0f / l;
        bf16_t* op = odsa + (tokq0 + 32 * qb + r32) * 512 + hd * 64 + 4 * hi;
#pragma unroll
        for (int g = 0; g < 4; ++g) {
            u32x2 w0, w1; w0.x = cvt_pk_bf16(o0[4 * g] * il, o0[4 * g + 1] * il); w0.y = cvt_pk_bf16(o0[4 * g + 2] * il, o0[4 * g + 3] * il);
            w1.x = cvt_pk_bf16(o1[4 * g] * il, o1[4 * g + 1] * il); w1.y = cvt_pk_bf16(o1[4 * g + 2] * il, o1[4 * g + 3] * il);
            *(u32x2*)(op + 8 * g) = w0; *(u32x2*)(op + 32 + 8 * g) = w1; }
    }
#undef DSA_LOADKV
#undef DSA_STOREKV
#undef DSA_CONSUME
#undef DSA_TIES
    __syncthreads();
}

template <int CTRL> __device__ __forceinline__ float dpp_f(float v) { return __builtin_bit_cast(float, __builtin_amdgcn_update_dpp(0, __builtin_bit_cast(int, v), CTRL, 0xF, 0xF, false)); }
constexpr int RL_WR = 0, RL_WR_STRIDE = 1028, RL_TKE = 131584, RL_TKW = RL_TKE + 4096;
__device__ __forceinline__ void p9_router(Frame& F) {
    const int lane = F.lane, wave = F.wave, tid = F.tid;
    LAS float* Wr = (LAS float*)(F.lds + RL_WR);
    LAS int* tke = (LAS int*)(F.lds + RL_TKE); LAS float* tkw = (LAS float*)(F.lds + RL_TKW);
    const float* w_router = F.in[15]; const float* b_router = F.in[16]; const float* g_ffn = F.in[14];
    for (int idx = tid; idx < DM * NEXP; idx += NWAVES * 64) { const int k = idx >> 5, e = idx & 31; Wr[e * RL_WR_STRIDE + k] = w_router[idx]; }
    if (tid < 32) F.MISC[MW_LCNT + tid] = 0u;
    __syncthreads();
    bf16_t* h2 = (bf16_t*)(F.ws + WS_H);
    const GAS f32x4* gr = (const GAS f32x4*)g_ffn + lane;
    f32x4 gg[4];
#pragma unroll
    for (int j = 0; j < 4; ++j) gg[j] = gr[64 * j];
    const float bias_e = b_router[lane >> 1];
    f32x4 xnext[2][4];
#pragma unroll
    for (int tk = 0; tk < 2; ++tk) { const GAS f32x4* xr = (const GAS f32x4*)(F.out + ((size_t)F.blk * 256 + 32 * wave + tk) * DM) + lane;
#pragma unroll
        for (int j = 0; j < 4; ++j) xnext[tk][j] = xr[64 * j]; }
    for (int it = 0; it < 16; ++it) {
        const int tl0 = 32 * wave + 2 * it;
        f32x4 hn[2][4];
#pragma unroll
        for (int tk = 0; tk < 2; ++tk)
#pragma unroll
            for (int j = 0; j < 4; ++j) hn[tk][j] = xnext[tk][j];
        if (it + 1 < 16) {
#pragma unroll
            for (int tk = 0; tk < 2; ++tk) { const GAS f32x4* xr = (const GAS f32x4*)(F.out + ((size_t)F.blk * 256 + tl0 + 2 + tk) * DM) + lane;
#pragma unroll
                for (int j = 0; j < 4; ++j) xnext[tk][j] = xr[64 * j]; } }
#pragma unroll
        for (int tk = 0; tk < 2; ++tk) {
            const size_t t = (size_t)F.blk * 256 + tl0 + tk;
            float s = 0.f;
#pragma unroll
            for (int j = 0; j < 4; ++j) { s += (hn[tk][j].x * hn[tk][j].x + hn[tk][j].y * hn[tk][j].y) + (hn[tk][j].z * hn[tk][j].z + hn[tk][j].w * hn[tk][j].w); }
            const float rstd = 1.0f / sqrtf(wave_sum(s) * (1.f / DM) + EPS);
            GAS u32x2* o8 = (GAS u32x2*)(h2 + t * DM) + lane;
#pragma unroll
            for (int j = 0; j < 4; ++j) { hn[tk][j] = hn[tk][j] * rstd * gg[j]; u32x2 o; o.x = pk2(hn[tk][j].x, hn[tk][j].y); o.y = pk2(hn[tk][j].z, hn[tk][j].w); o8[64 * j] = o; }
        }
        f32x2 hp[4][4];
#pragma unroll
        for (int j = 0; j < 4; ++j)
#pragma unroll
            for (int c = 0; c < 4; ++c) hp[j][c] = (f32x2){hn[0][j][c], hn[1][j][c]};
        float acc[2][32];
        const LAS float* wl = Wr + 4 * lane; asm volatile("" : "+v"(wl));
#pragma unroll
        for (int e = 0; e < 32; ++e) {
            f32x2 a2 = (f32x2){0.f, 0.f};
#pragma unroll
            for (int j = 0; j < 4; ++j) { const f32x4 w = *(const LAS f32x4*)(wl + e * RL_WR_STRIDE + 256 * j);
#pragma unroll
                for (int c = 0; c < 4; ++c) a2 = __builtin_elementwise_fma(hp[j][c], (f32x2){w[c], w[c]}, a2); }
            asm volatile("" : "+v"(a2));
            acc[0][e] = a2.x; acc[1][e] = a2.y;
        }
#pragma unroll
        for (int tk = 0; tk < 2; ++tk) {
            float v16[16], v8[8], v4[4], v2[2];
            const bool b3 = (lane & 8) != 0, b2 = (lane & 4) != 0, b1 = (lane & 2) != 0;
#pragma unroll
            for (int i = 0; i < 16; ++i) { const auto rr = __builtin_amdgcn_permlane32_swap(__float_as_uint(acc[tk][i]), __float_as_uint(acc[tk][16 + i]), false, false); v16[i] = __uint_as_float(rr[0]) + __uint_as_float(rr[1]); }
#pragma unroll
            for (int i = 0; i < 8; ++i) { const auto rr = __builtin_amdgcn_permlane16_swap(__float_as_uint(v16[i]), __float_as_uint(v16[8 + i]), false, false); v8[i] = __uint_as_float(rr[0]) + __uint_as_float(rr[1]); }
#pragma unroll
            for (int i = 0; i < 4; ++i) { const float mine = b3 ? v8[4 + i] : v8[i], oth = b3 ? v8[i] : v8[4 + i]; v4[i] = mine + dpp_f<0x128>(oth); }
#pragma unroll
            for (int i = 0; i < 2; ++i) { const float mine = b2 ? v4[2 + i] : v4[i], oth = b2 ? v4[i] : v4[2 + i]; v2[i] = mine + dpp_f<0x141>(oth); }
            float v1; { const float mine = b1 ? v2[1] : v2[0], oth = b1 ? v2[0] : v2[1]; v1 = mine + dpp_f<0x4E>(oth); }
            const float val = v1 + dpp_f<0xB1>(v1) + bias_e;
            const int e = lane >> 1;
            float tv[4]; int te[4]; float cur = val;
#pragma unroll
            for (int k = 0; k < 4; ++k) {
                float mx = cur;
                mx = fmaxf(mx, dpp_f<0xB1>(mx)); mx = fmaxf(mx, dpp_f<0x4E>(mx)); mx = fmaxf(mx, dpp_f<0x141>(mx)); mx = fmaxf(mx, dpp_f<0x128>(mx));
                { const auto rr = __builtin_amdgcn_permlane16_swap(__float_as_uint(mx), __float_as_uint(mx), false, false); mx = fmaxf(__uint_as_float(rr[0]), __uint_as_float(rr[1])); }
                { const auto rr = __builtin_amdgcn_permlane32_swap(__float_as_uint(mx), __float_as_uint(mx), false, false); mx = fmaxf(__uint_as_float(rr[0]), __uint_as_float(rr[1])); }
                const unsigned long long bm = __ballot(cur == mx);
                const int src = (int)__builtin_ctzll(bm);
                tv[k] = mx; te[k] = src >> 1;
                if ((lane >> 1) == (src >> 1)) cur = -INFINITY;
            }
            const float e1 = __expf(tv[1] - tv[0]), e2x = __expf(tv[2] - tv[0]), e3 = __expf(tv[3] - tv[0]);
            const float inv = 1.0f / (1.0f + e1 + e2x + e3);
            const float gate[4] = {inv, e1 * inv, e2x * inv, e3 * inv};
            const int tl = tl0 + tk;
#pragma unroll
            for (int k = 0; k < 4; ++k) if (lane == k) { tke[tl * 4 + k] = te[k]; tkw[tl * 4 + k] = gate[k];
                __hip_atomic_fetch_add((LAS unsigned*)F.MISC + MW_LCNT + te[k], 1u, __ATOMIC_RELAXED, __HIP_MEMORY_SCOPE_WORKGROUP); }
        }
    }
    __syncthreads();
    if (tid < 32) ((int*)(F.ws + WS_BLKCNT))[F.blk * 32 + tid] = (int)F.MISC[MW_LCNT + tid];
}
__device__ __forceinline__ void p10_assign(Frame& F) {
    const int tid = F.tid;
    const int* blkcnt = (const int*)(F.ws + WS_BLKCNT);
    LAS int* part = (LAS int*)(F.lds);
    LAS int* tke = (LAS int*)(F.lds + RL_TKE); LAS float* tkw = (LAS float*)(F.lds + RL_TKW);
    { const int e = tid & 31, p = tid >> 5; int tot = 0, bef = 0;
      for (int j = 0; j < 16; ++j) { const int bl = p * 16 + j; const int c = blkcnt[bl * 32 + e]; tot += c; bef += (bl < F.blk) ? c : 0; }
      part[p * 32 + e] = tot; part[512 + p * 32 + e] = bef; }
    __syncthreads();
    if (tid < 32) { int tot = 0, bef = 0;
        for (int p = 0; p < 16; ++p) { tot += part[p * 32 + tid]; bef += part[512 + p * 32 + tid]; }
        part[1024 + tid] = tot; F.MISC[MW_BEFORE + tid] = (unsigned)bef; F.MISC[MW_LCNT + tid] = 0u; }
    __syncthreads();
    if (tid == 0) { int ps = 0;
        for (int e = 0; e < 32; ++e) { F.MISC[MW_PSTART + e] = (unsigned)ps; F.MISC[MW_TSTART + e] = (unsigned)(ps >> 8); ps += (part[1024 + e] + 255) & ~255; }
        F.MISC[MW_PSTART + 32] = (unsigned)ps; F.MISC[MW_TSTART + 32] = (unsigned)(ps >> 8); }
    __syncthreads();
    int* slot_tok = (int*)(F.ws + WS_SLOT_TOK); float* slot_w = (float*)(F.ws + WS_SLOT_W);
    for (int idx = tid; idx < 1024; idx += NWAVES * 64) {
        const int e = tke[idx]; const float w = tkw[idx];
        const unsigned r = __hip_atomic_fetch_add((LAS unsigned*)F.MISC + MW_LCNT + e, 1u, __ATOMIC_RELAXED, __HIP_MEMORY_SCOPE_WORKGROUP);
        const unsigned pos = F.MISC[MW_PSTART + e] + F.MISC[MW_BEFORE + e] + r;
        slot_tok[pos] = F.blk * 256 + (idx >> 2); slot_w[pos] = w;
    }
}

#ifndef MK_ONE_LAUNCH
#define MK_ONE_LAUNCH 1
#endif
constexpr int N_PHASES = 13;
struct Args { const float* in[21]; float* out; unsigned char* ws; int ph_lo, ph_hi; };
static_assert(sizeof(Args) == 21 * 8 + 8 + 8 + 8, "no padding");

__global__ void __launch_bounds__(NWAVES * 64, 2) fwd_kernel(Args args) {
    extern __shared__ __attribute__((aligned(16))) unsigned char lds[];
    Frame F;
    F.lds = (LAS unsigned char*)lds;
    F.MISC = (volatile LAS unsigned*)(F.lds + MISC_OFF);
    F.tid = threadIdx.x; F.lane = F.tid & 63; F.wave = __builtin_amdgcn_readfirstlane(F.tid >> 6);
    F.G = gridDim.x; F.blk = blockIdx.x;
    F.ws = args.ws; F.out = args.out; F.ctl = (gu32*)(args.ws + WS_CTL);
#pragma unroll
    for (int i = 0; i < 21; ++i) F.in[i] = args.in[i];
    for (int u = F.tid; u < (LDS_BYTES - MISC_OFF) / 4; u += NWAVES * 64) ((LAS unsigned*)(F.lds + MISC_OFF))[u] = 0u;
    __syncthreads();
    const int lo = args.ph_lo, hi = args.ph_hi;
    XcdBarrier bar; bar.bar = (unsigned*)(F.ctl + CW_BAR); bar.x = 0; bar.st = nullptr;
    if (hi - lo > 1) bar = xcd_barrier_post((unsigned*)(F.ctl + CW_BAR), F.MISC + MW_BAR);
#ifndef STAG
#define STAG 0
#endif
#ifndef PH_MASK
#define PH_MASK 0x1fff
#endif
#define IN(k) (((PH_MASK >> (k)) & 1) && lo <= (k) && (k) < hi)
#ifndef REP_MASK
#define REP_MASK 0
#endif
#define NREP(k) (1 + ((REP_MASK >> (k)) & 1))
#define SEAM(k) do { if (IN(k) && IN((k) + 1)) xcd_barrier(bar); } while (0)
    unsigned char* ws = args.ws;
    bf16_t* proj = (bf16_t*)(ws + WS_P);

    if (IN(0)) for (int rep = 0; rep < NREP(0); ++rep) { if (rep) xcd_barrier(bar); p0_prologue(F); } SEAM(0);

    if (IN(1)) {
#ifdef PROBE_P1
        { pg8::DenseSched S; S.init(ws + WS_H, ws + WS_WIN, NTOK, PW, DM, F.G, F.blk); S.amask = PROBE_P1;
          pg8::EpiBf16<0> E{(bf16_t*)(ws + WS_END), PW, nullptr, 1023};
          pg8::gemm_phase<pg8::EpiBf16<0>, pg8::DenseSched, true>(F.lds, DM, S, E); }
        xcd_barrier(bar);
#endif
        { pg8::DenseSched S; S.init(ws + WS_H, ws + WS_WIN, NTOK, PW, DM, F.G, F.blk);
          pg8::EpiBf16<0> E{proj, PW, nullptr};
          pg8::gemm_phase<pg8::EpiBf16<0>, pg8::DenseSched, true>(F.lds, DM, S, E); }
        { pg8::DenseSched S; S.init(ws + WS_MEMN, ws + WS_WMKV, NMEM, DM, DM, F.G, F.blk);
          pg8::EpiBf16<0> E{(bf16_t*)(ws + WS_MKV), DM, nullptr};
          pg8::gemm_phase<pg8::EpiBf16<0>, pg8::DenseSched, true>(F.lds, DM, S, E); }
    } SEAM(1);

    if (IN(2)) { if (REP_MASK & 4) { p2_prep(F, true); xcd_barrier(bar); } p2_prep(F); } SEAM(2);

    if (IN(3)) {
        bf16_t* osb = (bf16_t*)(ws + WS_O); bf16_t* odsa = osb + (size_t)NTOK * 512; bf16_t* omem = odsa + (size_t)NTOK * 512;
#ifndef REP_DSA
#define REP_DSA 1
#endif
#ifndef REP_SB
#define REP_SB 1
#endif
#ifndef REP_MEM
#define REP_MEM 1
#endif
#ifndef NO_DSA
        for (int rep = 0; rep < REP_DSA; ++rep)
        for (int i = 0; i < 4; ++i) { const int p = 2 * F.blk + (i >> 1), b = p >> 4, cc = p & 15, c = (i & 1) ? 31 - cc : cc; dsa_unit(proj, odsa, (unsigned*)F.out + (size_t)F.blk * 131072, b, c, F.lds, F.tid); }
#endif
        const int gw = F.blk * NWAVES + F.wave, NGW = F.G * NWAVES;
#ifndef NO_SB
        for (int rep = 0; rep < REP_SB; ++rep)
        for (int it = gw; it < NB * 8 * 64; it += NGW) { const int qblk = 63 - (it >> 8), bh = it & 255; sb_item(proj, osb, bh >> 3, bh & 7, qblk, F.lds + F.wave * 4096, F.lane); }
#endif
#ifndef NO_MEM
        for (int rep = 0; rep < REP_MEM; ++rep) {
            __syncthreads();
            for (int u = F.blk; u < NB * 4 * 2; u += F.G) mem_unit(proj, (const bf16_t*)(ws + WS_MKV), omem, u >> 3, (u >> 1) & 3, u & 1, F.lds, F.tid);
        }
#endif
    } SEAM(3);

    if (IN(4)) {
        pg8::DenseSched S; S.init(ws + WS_H, ws + WS_WG, NTOK, 3 * DM, DM, F.G, F.blk);
        pg8::EpiBf16<2> E{proj, PW, F.in[11]};
        pg8::gemm_phase<pg8::EpiBf16<2>, pg8::DenseSched, true>(F.lds, DM, S, E);
    } SEAM(4);

    if (IN(5)) { pg8::MergeSched S; S.init(ws + WS_O, ws + WS_WB, NTOK, DM, F.G, F.blk);
        pg8::EpiMerge E{proj, (bf16_t*)(ws + WS_H)};
        pg8::gemm_phase<pg8::EpiMerge, pg8::MergeSched, true>(F.lds, 512, S, E); } SEAM(5);


    if (IN(8)) {
        pg8::DenseSched S; S.init(ws + WS_H, ws + WS_WO, NTOK, DM, DM, F.G, F.blk); S.stag = STAG;
        pg8::EpiResid E{F.in[0], F.out};
        pg8::gemm_phase<pg8::EpiResid, pg8::DenseSched, true>(F.lds, DM, S, E);
    } SEAM(8);

    if (IN(9)) for (int rep = 0; rep < NREP(9); ++rep) { if (rep) xcd_barrier(bar); p9_router(F); } SEAM(9);
    if (IN(10)) for (int rep = 0; rep < NREP(10); ++rep) { if (rep) xcd_barrier(bar); p10_assign(F); } SEAM(10);

    if (IN(11)) for (int rep = 0; rep < NREP(11); ++rep) {  if (rep) xcd_barrier(bar);
        pg8::MoeSched S{(const char*)(ws + WS_H), (const char*)(ws + WS_WEI), (const int*)(ws + WS_SLOT_TOK), F.MISC + MW_TSTART, DM, 2048, 8, F.blk};
        pg8::EpiSwiglu E{(bf16_t*)(ws + WS_P), F.in[18]};
        pg8::gemm_phase<pg8::EpiSwiglu, pg8::MoeSched, true>(F.lds, DM, S, E);
    } SEAM(11);

    if (IN(12)) {
        pg8::MoeSched S{(const char*)(ws + WS_P), (const char*)(ws + WS_WEO), nullptr, F.MISC + MW_TSTART, DM, DM, 4, F.blk};
        pg8::EpiScatter E{F.out, (const int*)(ws + WS_SLOT_TOK), (const float*)(ws + WS_SLOT_W), F.in[20], F.lds};
        pg8::gemm_phase<pg8::EpiScatter, pg8::MoeSched, true>(F.lds, DM, S, E);
    }
#undef IN
#undef SEAM
}

extern "C" void kernel_launch(void* const* d_in, const int* in_sizes, int n_in, void* d_out, int out_size, void* d_ws, size_t ws_size, hipStream_t stream) {
    static int grid = 0;
    if (grid == 0) {
        if (n_in != 21 || in_sizes[0] != NTOK * DM || out_size != NTOK * DM || ws_size < WS_END) {
            fprintf(stderr, "kernel_launch: unexpected shapes: n_in %d in0 %d out %d ws %zu (need >= %zu); nothing launched\n", n_in, n_in > 0 ? in_sizes[0] : -1, out_size, ws_size, (size_t)WS_END); grid = -1; return; }
        int dev = 0, cus = 0, per_cu = 0;
        if (hipGetDevice(&dev) != hipSuccess || hipDeviceGetAttribute(&cus, hipDeviceAttributeMultiprocessorCount, dev) != hipSuccess) { fprintf(stderr, "kernel_launch: device query failed\n"); grid = -1; return; }
        if (hipFuncSetAttribute((const void*)fwd_kernel, hipFuncAttributeMaxDynamicSharedMemorySize, LDS_BYTES) != hipSuccess) { fprintf(stderr, "kernel_launch: hipFuncSetAttribute failed\n"); grid = -1; return; }
        if (hipOccupancyMaxActiveBlocksPerMultiprocessor(&per_cu, (const void*)fwd_kernel, NWAVES * 64, LDS_BYTES) != hipSuccess || per_cu < 1)
            fprintf(stderr, "kernel_launch: note: occupancy query reports %d workgroups per CU\n", per_cu);
        (void)hipGetLastError();
        grid = cus;
        if (grid != 256) { fprintf(stderr, "kernel_launch: this kernel is built for 256 CUs (got %d); nothing launched\n", grid); grid = -1; return; }
    }
    if (grid < 0) return;
    if (hipMemsetAsync((char*)d_ws + WS_CTL, 0, CTL_ZERO_BYTES, stream) != hipSuccess) { fprintf(stderr, "kernel_launch: hipMemsetAsync failed\n"); return; }
    Args a{};
    for (int i = 0; i < 21; ++i) a.in[i] = (const float*)d_in[i];
    a.out = (float*)d_out; a.ws = (unsigned char*)d_ws;
#if MK_ONE_LAUNCH
    const int cuts[2] = {0, N_PHASES}; const int nl = 1;
#else
    const int cuts[11] = {0, 1, 2, 3, 4, 5, 6, 7, 8, 9, N_PHASES}; const int nl = 10;
#endif
    for (int li = 0; li < nl; ++li) {
        a.ph_lo = cuts[li]; a.ph_hi = cuts[li + 1];
        hipLaunchKernelGGL(fwd_kernel, dim3(grid), dim3(NWAVES * 64), LDS_BYTES, stream, a);
        const hipError_t le = hipPeekAtLastError();
        if (le != hipSuccess) { fprintf(stderr, "kernel_launch: launch %d failed: %s\n", li, hipGetErrorName(le)); break; }
    }
}
```

```cpp
#include <hip/hip_runtime.h>
#include <cstdio>
#include <cstdint>

#define LAS __attribute__((address_space(3)))
#define GAS __attribute__((address_space(1)))
typedef unsigned short bf16_t;
typedef short bf16x8 __attribute__((ext_vector_type(8)));
typedef short s16x4 __attribute__((ext_vector_type(4)));
typedef short v4i16_t __attribute__((ext_vector_type(4)));
typedef float f32x2 __attribute__((ext_vector_type(2)));
typedef float f32x4 __attribute__((ext_vector_type(4)));
typedef float f32x16 __attribute__((ext_vector_type(16)));
typedef unsigned u32x2 __attribute__((ext_vector_type(2)));
typedef unsigned u32x4 __attribute__((ext_vector_type(4)));
typedef GAS unsigned gu32;

constexpr int NB = 32, SEQ = 2048, DM = 1024, NTOK = NB * SEQ;
constexpr int MEMLEN = 256, NMEM = NB * MEMLEN;
constexpr int PW = 3072;
constexpr int C_SQ = 0, C_SK = 512, C_SV = 1024, C_DQ = 1536, C_DK = 2048, C_DV = 2112, C_IQ = 2176, C_IK = 2432, C_IW = 2496, C_MQ = 2560;
constexpr int IN_W = 3012;
constexpr int NEXP = 32, TOPK = 4, DEXP = 1024;
constexpr int NSLOT = NTOK * TOPK;
constexpr int NSLOT_PAD = NSLOT + NEXP * 256;
constexpr float EPS = 1e-6f;
constexpr float LOG2E = 1.4426950408889634f;

constexpr size_t MiB = 1u << 20;
constexpr size_t WS_CTL = 0, CTL_ZERO_BYTES = 1 * MiB;
constexpr size_t WS_ROPE = 1 * MiB;
constexpr size_t WS_BLKCNT = 1 * MiB + 512 * 1024;
constexpr size_t WS_SLOT_TOK = 2 * MiB;
constexpr size_t WS_SLOT_W = 4 * MiB;
constexpr size_t WS_WIN = 8 * MiB;
constexpr size_t WS_WMKV = 14 * MiB;
constexpr size_t WS_WG = 16 * MiB;
constexpr size_t WS_WB = 22 * MiB;
constexpr size_t WS_WO = 25 * MiB;
constexpr size_t WS_WEI = 27 * MiB;
constexpr size_t WS_WEO = 155 * MiB;
constexpr size_t WS_H = 220 * MiB;
constexpr size_t WS_P = 348 * MiB;
constexpr size_t WS_O = 732 * MiB;
constexpr size_t WS_MEMN = 924 * MiB;
constexpr size_t WS_MKV = 940 * MiB;
constexpr size_t WS_END = 956 * MiB;
static_assert(WS_P + (size_t)NSLOT_PAD * DEXP * 2 <= WS_MEMN, "act overlays proj|o");
static_assert(WS_SLOT_TOK + (size_t)NSLOT_PAD * 4 <= WS_SLOT_W && WS_SLOT_W + (size_t)NSLOT_PAD * 4 <= WS_WIN, "slot tables");

constexpr int CW_BAR = 4096;

constexpr int RING_BYTES = 151552;
constexpr int MISC_OFF = RING_BYTES;
constexpr int LDS_BYTES = 155648;
constexpr int MW_BAR = 8;
constexpr int MW_LCNT = 16;
constexpr int MW_PSTART = 64;
constexpr int MW_TSTART = 128;
constexpr int MW_BEFORE = 192;
constexpr int MW_PART = 256;

__device__ __forceinline__ unsigned f2bf(float f) { unsigned u = __builtin_bit_cast(unsigned, f); return (u + 0x7fffu + ((u >> 16) & 1u)) >> 16; }
__device__ __forceinline__ unsigned pk2(float lo, float hi) { return f2bf(lo) | (f2bf(hi) << 16); }
__device__ __forceinline__ float bf2f(unsigned short b) { return __builtin_bit_cast(float, (unsigned)b << 16); }
__device__ __forceinline__ float bflo(unsigned w) { return __builtin_bit_cast(float, w << 16); }
__device__ __forceinline__ float bfhi(unsigned w) { return __builtin_bit_cast(float, w & 0xffff0000u); }
__device__ __forceinline__ unsigned cvt_pk_bf16(float lo, float hi) { unsigned r; asm volatile("v_cvt_pk_bf16_f32 %0, %1, %2" : "=v"(r) : "v"(lo), "v"(hi)); return r; }
__device__ __forceinline__ int crow(int r, int hi) { return (r & 3) + 8 * (r >> 2) + 4 * hi; }
#define LDS_WAIT() asm volatile("s_waitcnt lgkmcnt(0)" ::: "memory")
#define VM_WAIT() asm volatile("s_waitcnt vmcnt(0)" ::: "memory")

namespace pg8 {
constexpr int BM = 256, BK = 64, HALF = 128, HTB = HALF * BK * 2, STAGE_BYTES = 8 * HTB;
__host__ __device__ __forceinline__ int lds_byte(int r, int c) { const int st = (r >> 4) * 2 + (c >> 5), rr = r & 15, cc = c & 31, ob = rr * 64 + cc * 2; return st * 1024 + (ob ^ (((ob >> 9) & 1) << 5)); }
__host__ __device__ __forceinline__ void stage_rc(int b, int& R, int& C) { const int st = b / 1024, sb = b % 1024, swz = sb ^ (((sb >> 9) & 1) << 5); R = (st >> 1) * 16 + swz / 64; C = (st & 1) * 32 + (swz % 64) / 2; }
__host__ __device__ __forceinline__ int perm32(int rho) { const int n = rho >> 4, i = rho & 15; return 8 * (i >> 2) + 4 * n + (i & 3); }

struct Unit { int pm, pn, e; };

template <class Epi, class Sched, bool ALIGN_EPI>
__device__ __forceinline__ void gemm_phase(LAS unsigned char* lds, const int K, const Sched& S, const Epi& E) {
    const int tid = threadIdx.x, wid = __builtin_amdgcn_readfirstlane(tid >> 6), lane = tid & 63, wr = wid >> 2, wc = wid & 3, fr = lane & 15, fq = lane >> 4;
    const int nt = K / BK;
    int Rr[2], Cc[2]; unsigned voffB[2];
#pragma unroll
    for (int i = 0; i < 2; ++i) { int R, C; stage_rc(tid * 16 + i * 8192, R, C); Rr[i] = R; Cc[i] = C; const int Rb = Epi::PERM ? ((R & ~31) + perm32(R & 31)) : R; voffB[i] = (unsigned)(Rb * K + C) * 2u; }
    const size_t kstep = (size_t)(BK * 2);
    const size_t hstepB = (size_t)HALF * K * 2;
    const unsigned ldsw = (unsigned)wid * 1024u;
    const int aoff = lds_byte(wr * 64 + fr, fq * 8), boff = lds_byte(wc * 32 + fr, fq * 8);
#define PG8_SA(b, h) (((b) * 2 + (h)) * HTB)
#define PG8_SB(b, h) ((4 + (b) * 2 + (h)) * HTB)
#define PG8_STAGE(bufoff, gbase, voff) do { _Pragma("unroll") for (int _i = 0; _i < 2; ++_i) \
        __builtin_amdgcn_global_load_lds((const unsigned*)((const char*)(gbase) + (voff)[_i]), (LAS unsigned*)(lds + (bufoff) + ldsw + _i * 8192), 16, 0, 0); } while (0)
#define PG8_LDA(dst, b, h) do { _Pragma("unroll") for (int m = 0; m < 4; ++m) _Pragma("unroll") for (int k = 0; k < 2; ++k) dst[m][k] = *(const LAS bf16x8*)(lds + PG8_SA(b, h) + aoff + m * 2048 + k * 1024); } while (0)
#define PG8_LDB(dst, b, h) do { _Pragma("unroll") for (int n = 0; n < 2; ++n) _Pragma("unroll") for (int k = 0; k < 2; ++k) dst[n][k] = *(const LAS bf16x8*)(lds + PG8_SB(b, h) + boff + n * 2048 + k * 1024); } while (0)
#define PG8_MMA(ai, bj, At, Bt) do { __builtin_amdgcn_s_setprio(1); _Pragma("unroll") for (int m = 0; m < 4; ++m) _Pragma("unroll") for (int n = 0; n < 2; ++n) _Pragma("unroll") for (int k = 0; k < 2; ++k) \
        acc[ai][bj][m][n] = __builtin_amdgcn_mfma_f32_16x16x32_bf16(Bt[n][k], At[m][k], acc[ai][bj][m][n], 0, 0, 0); __builtin_amdgcn_s_setprio(0); } while (0)
#define PG8_WAIT_V(n) asm volatile("s_waitcnt vmcnt(" #n ")" ::: "memory")
#define PG8_WAIT_L(n) asm volatile("s_waitcnt lgkmcnt(" #n ")" ::: "memory")
#define PG8_BAR __builtin_amdgcn_s_barrier()
#define PG8_SCHED __builtin_amdgcn_sched_barrier(0)
    Unit cur, nxt; int ui = 0;
    if (!S.next(0, cur)) return;
    { const int ns = S.stagger();
      for (int q = 0; q < ns; ++q) __builtin_amdgcn_s_sleep(4); }
    f32x4 acc[2][2][4][2];
#pragma unroll
    for (int a = 0; a < 2; ++a)
#pragma unroll
        for (int b = 0; b < 2; ++b)
#pragma unroll
            for (int m = 0; m < 4; ++m)
#pragma unroll
                for (int n = 0; n < 2; ++n) acc[a][b][m][n] = (f32x4){0.f, 0.f, 0.f, 0.f};
    bf16x8 At[4][2], B0[2][2], B1[2][2];
    const char* Ab = S.a_base();
    unsigned ca0[2], ca1[2], na0[2], na1[2];
#pragma unroll
    for (int i = 0; i < 2; ++i) { ca0[i] = S.a_off(cur, Rr[i], Cc[i]); ca1[i] = S.a_off(cur, HALF + Rr[i], Cc[i]); }
    const char* cB = S.b_tile(cur);
    PG8_STAGE(PG8_SB(0, 0), cB, voffB); PG8_STAGE(PG8_SB(0, 1), cB + hstepB, voffB); PG8_STAGE(PG8_SA(0, 0), Ab, ca0); PG8_STAGE(PG8_SA(0, 1), Ab, ca1);
    if (wr == 1) PG8_BAR;
    PG8_WAIT_V(2); PG8_BAR;
    PG8_STAGE(PG8_SB(1, 0), cB + kstep, voffB); PG8_STAGE(PG8_SA(1, 0), Ab + kstep, ca0); PG8_STAGE(PG8_SB(1, 1), cB + hstepB + kstep, voffB);
    PG8_WAIT_V(6); PG8_BAR;
    for (;;) {
        typename Epi::Pre pre = E.preload(cur, wr, wc, fr, fq);
        const bool has_next = S.next(ui + 1, nxt);
        const char* nB = cB;
#pragma unroll
        for (int i = 0; i < 2; ++i) { na0[i] = ca0[i]; na1[i] = ca1[i]; }
        if (has_next) { nB = S.b_tile(nxt);
#pragma unroll
            for (int i = 0; i < 2; ++i) { na0[i] = S.a_off(nxt, Rr[i], Cc[i]); na1[i] = S.a_off(nxt, HALF + Rr[i], Cc[i]); } }
        if constexpr (Epi::DRAIN_TOP) { PG8_WAIT_V(0); }
        for (int t = 0; t < nt; t += 2) {
            const bool last = (t == nt - 2);
            const char* a1 = Ab + (size_t)(t + 1) * kstep;
            const char* a2 = last ? Ab : Ab + (size_t)(t + 2) * kstep; const char* b2 = last ? nB : cB + (size_t)(t + 2) * kstep;
            const char* a3 = a2 + kstep; const char* b3 = b2 + kstep;
            unsigned o20[2], o21[2];
#pragma unroll
            for (int i = 0; i < 2; ++i) { o20[i] = last ? na0[i] : ca0[i]; o21[i] = last ? na1[i] : ca1[i]; }
            PG8_LDB(B0, 0, 0); PG8_LDB(B1, 0, 1); PG8_SCHED; PG8_LDA(At, 0, 0); PG8_STAGE(PG8_SA(1, 1), a1, ca1);
            PG8_WAIT_V(8); PG8_WAIT_L(0); PG8_BAR; PG8_MMA(0, 0, At, B0); PG8_MMA(0, 1, At, B1); PG8_BAR; PG8_SCHED;
            PG8_LDA(At, 0, 1); PG8_STAGE(PG8_SB(0, 0), b2, voffB); PG8_STAGE(PG8_SB(0, 1), b2 + hstepB, voffB); PG8_STAGE(PG8_SA(0, 0), a2, o20);
            PG8_WAIT_V(8); PG8_WAIT_L(0); PG8_BAR; PG8_MMA(1, 0, At, B0); PG8_MMA(1, 1, At, B1); PG8_BAR; PG8_SCHED;
            PG8_LDB(B0, 1, 0); PG8_LDB(B1, 1, 1); PG8_SCHED; PG8_LDA(At, 1, 0); PG8_STAGE(PG8_SA(0, 1), a2, o21);
            PG8_WAIT_V(8); PG8_WAIT_L(0); PG8_BAR; PG8_MMA(0, 0, At, B0); PG8_MMA(0, 1, At, B1); PG8_BAR; PG8_SCHED;
            PG8_LDA(At, 1, 1); PG8_STAGE(PG8_SB(1, 0), b3, voffB); PG8_STAGE(PG8_SB(1, 1), b3 + hstepB, voffB); PG8_STAGE(PG8_SA(1, 0), a3, o20);
            PG8_WAIT_V(8); PG8_WAIT_L(0); PG8_BAR; PG8_MMA(1, 0, At, B0); PG8_MMA(1, 1, At, B1); PG8_BAR; PG8_SCHED;
        }
        if constexpr (ALIGN_EPI) { if (wr == 0) PG8_BAR; }
        E(acc, cur, wr, wc, fr, fq, pre);
        if (!has_next) break;
#pragma unroll
        for (int a = 0; a < 2; ++a)
#pragma unroll
            for (int b = 0; b < 2; ++b)
#pragma unroll
                for (int m = 0; m < 4; ++m)
#pragma unroll
                    for (int n = 0; n < 2; ++n) acc[a][b][m][n] = (f32x4){0.f, 0.f, 0.f, 0.f};
        cur = nxt; cB = nB; ++ui;
#pragma unroll
        for (int i = 0; i < 2; ++i) { ca0[i] = na0[i]; ca1[i] = na1[i]; }
        if constexpr (ALIGN_EPI) { if (wr == 1) PG8_BAR; }
    }
    PG8_WAIT_V(0);
    if constexpr (!ALIGN_EPI) { if (wr == 0) PG8_BAR; }
    PG8_BAR;
#undef PG8_SA
#undef PG8_SB
#undef PG8_STAGE
#undef PG8_LDA
#undef PG8_LDB
#undef PG8_MMA
#undef PG8_WAIT_V
#undef PG8_WAIT_L
#undef PG8_BAR
#undef PG8_SCHED
}

struct DenseSched {
    const char* A; const char* Bt; int K, nM, nN, nwg, G, c, stag = 0, amask = -1;
    __device__ __forceinline__ void init(const void* A_, const void* Bt_, int M, int N, int K_, int G_, int c_) { A = (const char*)A_; Bt = (const char*)Bt_; K = K_; nM = M / BM; nN = N / BM; nwg = nM * nN; G = G_; c = c_; }
    __device__ __forceinline__ bool next(int i, Unit& u) const {
        const long L = (long)i * G + c; if (L >= nwg) return false;
        int wgid = (int)L; { const int q = nwg / 8, r = nwg % 8, xcd = wgid % 8, off = wgid / 8; wgid = (xcd < r ? xcd * (q + 1) : r * (q + 1) + (xcd - r) * q) + off; }
        const int nig = 8 * nN, gid = wgid / nig, fm = gid * 8, gsz = (nM - fm) < 8 ? (nM - fm) : 8;
        u.pm = fm + ((wgid % nig) % gsz); u.pn = (wgid % nig) / gsz; u.e = 0; return true;
    }
    __device__ __forceinline__ const char* a_base() const { return A; }
    __device__ __forceinline__ int stagger() const { return stag ? ((c >> 3) & 7) * (K / 55) : 0; }
    __device__ __forceinline__ unsigned a_off(const Unit& u, int row, int col) const { return (unsigned)(((size_t)((u.pm * BM + row) & amask) * K + col) * 2); }
    __device__ __forceinline__ int a_row(const Unit& u, int row) const { return (u.pm * BM + row) & amask; }
    __device__ __forceinline__ unsigned row_off(int r, int col) const { return (unsigned)(((size_t)r * K + col) * 2); }
    __device__ __forceinline__ const char* b_tile(const Unit& u) const { return Bt + (size_t)u.pn * BM * K * 2; }
};
}

namespace pg8 {
struct MoeSched {
    const char* A; const char* Bt; const int* slot_tok; volatile LAS unsigned* tstart; int K, rowsE, nN, c;
    __device__ __forceinline__ bool next(int i, Unit& u) const {
        const int x = c & 7, j = c >> 3, rpr = 32 / nN;
        const int pm = (i * 8 + x) * rpr + j / nN;
        const int T = (int)tstart[32];
        if (pm >= T) return false;
        int e = 0;
#pragma unroll 1
        for (int k = 1; k < 32; ++k) e += ((int)tstart[k] <= pm) ? 1 : 0;
        u.pm = pm; u.pn = j % nN; u.e = __builtin_amdgcn_readfirstlane(e); return true;
    }
    __device__ __forceinline__ const char* a_base() const { return A; }
    __device__ __forceinline__ int stagger() const { const int g = (c >> 3) / nN, ng = 32 / nN; (void)g; (void)ng; return 0; }
    __device__ __forceinline__ unsigned a_off(const Unit& u, int row, int col) const {
        const int pos = u.pm * BM + row;
        const int r = slot_tok ? slot_tok[pos] : pos;
        return (unsigned)(((size_t)r * K + col) * 2);
    }
    __device__ __forceinline__ int a_row(const Unit& u, int row) const { const int pos = u.pm * BM + row; return slot_tok ? ((const GAS int*)slot_tok)[pos] : pos; }
    __device__ __forceinline__ unsigned row_off(int r, int col) const { return (unsigned)(((size_t)r * K + col) * 2); }
    __device__ __forceinline__ const char* b_tile(const Unit& u) const { return Bt + ((size_t)u.e * rowsE + (size_t)u.pn * BM) * K * 2; }
};

struct MergeSched {
    const char* A; const char* Bt; int nM, nN, nwg, G, c;
    __device__ __forceinline__ void init(const void* A_, const void* Bt_, int M, int N, int G_, int c_) { A = (const char*)A_; Bt = (const char*)Bt_; nM = M / BM; nN = N / BM; nwg = nM * nN; G = G_; c = c_; }
    __device__ __forceinline__ bool next(int i, Unit& u) const {
        const int r = i / 3; const long L = (long)r * G + c; if (L >= nwg) return false;
        int wgid = (int)L; { const int q = nwg / 8, rr = nwg % 8, xcd = wgid % 8, off = wgid / 8; wgid = (xcd < rr ? xcd * (q + 1) : rr * (q + 1) + (xcd - rr) * q) + off; }
        const int nig = 8 * nN, gid = wgid / nig, fm = gid * 8, gsz = (nM - fm) < 8 ? (nM - fm) : 8;
        u.pm = fm + ((wgid % nig) % gsz); u.pn = (wgid % nig) / gsz; u.e = i - 3 * r; return true;
    }
    __device__ __forceinline__ const char* a_base() const { return A; }
    __device__ __forceinline__ int stagger() const { return 0; }
    __device__ __forceinline__ unsigned a_off(const Unit& u, int row, int col) const { return (unsigned)(((size_t)(u.pm * BM + row) * 512 + col) * 2 + (size_t)u.e * ((size_t)NTOK * 512 * 2)); }
    __device__ __forceinline__ const char* b_tile(const Unit& u) const { return Bt + ((size_t)u.e * DM + (size_t)u.pn * BM) * 512 * 2; }
};

struct NoPre {};
template <int ACT> struct EpiBf16 {
    static constexpr bool PERM = true, DRAIN_TOP = false;
    struct Pre { f32x4 bv[2][2]; };
    bf16_t* O; int ldc; const float* bias; int rowmask = -1;
    __device__ __forceinline__ Pre preload(const Unit& u, int wr, int wc, int fr, int fq) const { Pre p; const int col0 = u.pn * BM + wc * 32 + 8 * fq;
#pragma unroll
        for (int bj = 0; bj < 2; ++bj)
#pragma unroll
            for (int n = 0; n < 2; ++n) p.bv[bj][n] = (f32x4){0.f, 0.f, 0.f, 0.f};
        return p; }
    __device__ __forceinline__ void arrived(Pre& p) const { asm volatile("" : "+v"(p.bv[0][0]), "+v"(p.bv[0][1]), "+v"(p.bv[1][0]), "+v"(p.bv[1][1])); }
    __device__ __forceinline__ void operator()(const f32x4 (&acc)[2][2][4][2], const Unit& u, int wr, int wc, int fr, int fq, const Pre& pre) const {
        const int row0 = u.pm * BM + wr * 64 + fr; const int col0 = u.pn * BM + wc * 32 + 8 * fq;
        f32x4 bv[2][2];
#pragma unroll
        for (int bj = 0; bj < 2; ++bj)
#pragma unroll
            for (int n = 0; n < 2; ++n) bv[bj][n] = bias ? *(const f32x4*)(bias + col0 + bj * HALF + 4 * n) : pre.bv[bj][n];
#pragma unroll
        for (int ai = 0; ai < 2; ++ai)
#pragma unroll
            for (int m = 0; m < 4; ++m) { bf16_t* rowp = O + (size_t)((row0 + ai * HALF + m * 16) & rowmask) * ldc + col0;
#pragma unroll
                for (int bj = 0; bj < 2; ++bj) { f32x4 v0 = acc[ai][bj][m][0] + bv[bj][0], v1 = acc[ai][bj][m][1] + bv[bj][1];
                    if (ACT == 2) {
#pragma unroll
                        for (int q = 0; q < 4; ++q) { v0[q] = __builtin_amdgcn_rcpf(1.f + __builtin_amdgcn_exp2f(-LOG2E * v0[q])); v1[q] = __builtin_amdgcn_rcpf(1.f + __builtin_amdgcn_exp2f(-LOG2E * v1[q])); } }
                    u32x4 w; w.x = cvt_pk_bf16(v0[0], v0[1]); w.y = cvt_pk_bf16(v0[2], v0[3]); w.z = cvt_pk_bf16(v1[0], v1[1]); w.w = cvt_pk_bf16(v1[2], v1[3]);
                    *(u32x4*)(rowp + bj * HALF) = w; } }
    }
};
struct EpiMerge {
    static constexpr bool PERM = true, DRAIN_TOP = false;
    typedef NoPre Pre; __device__ __forceinline__ Pre preload(const Unit&, int, int, int, int) const { return Pre{}; }
    const bf16_t* G; bf16_t* Mg;
    __device__ __forceinline__ void operator()(const f32x4 (&acc)[2][2][4][2], const Unit& u, int wr, int wc, int fr, int fq, const Pre&) const {
        const int row0 = u.pm * BM + wr * 64 + fr; const int col0 = u.pn * BM + wc * 32 + 8 * fq;
        const int goff = u.e * DM; const bool first = (u.e == 0);
#pragma unroll
        for (int ai = 0; ai < 2; ++ai)
#pragma unroll
            for (int m = 0; m < 4; ++m) { const size_t row = (size_t)(row0 + ai * HALF + m * 16);
#pragma unroll
                for (int bj = 0; bj < 2; ++bj) {
                    const u32x4 g = *(const u32x4*)(G + row * PW + goff + col0 + bj * HALF);
                    u32x4 p = (u32x4){0u, 0u, 0u, 0u};
                    if (!first) p = *(const u32x4*)(Mg + row * DM + col0 + bj * HALF);
                    const f32x4 a0 = acc[ai][bj][m][0], a1 = acc[ai][bj][m][1];
                    u32x4 w;
                    w.x = cvt_pk_bf16(bflo(p.x) + bflo(g.x) * a0[0], bfhi(p.x) + bfhi(g.x) * a0[1]);
                    w.y = cvt_pk_bf16(bflo(p.y) + bflo(g.y) * a0[2], bfhi(p.y) + bfhi(g.y) * a0[3]);
                    w.z = cvt_pk_bf16(bflo(p.z) + bflo(g.z) * a1[0], bfhi(p.z) + bfhi(g.z) * a1[1]);
                    w.w = cvt_pk_bf16(bflo(p.w) + bflo(g.w) * a1[2], bfhi(p.w) + bfhi(g.w) * a1[3]);
                    *(u32x4*)(Mg + row * DM + col0 + bj * HALF) = w; } }
    }
};
struct EpiResid {
    static constexpr bool PERM = false, DRAIN_TOP = false;
    typedef NoPre Pre; __device__ __forceinline__ Pre preload(const Unit&, int, int, int, int) const { return Pre{}; }
    const float* base; float* out;
    __device__ __forceinline__ void operator()(const f32x4 (&acc)[2][2][4][2], const Unit& u, int wr, int wc, int fr, int fq, const Pre&) const {
        const int row0 = u.pm * BM + wr * 64 + fr; const int col0 = u.pn * BM + wc * 32 + 4 * fq;
#pragma unroll
        for (int ai = 0; ai < 2; ++ai)
#pragma unroll
            for (int m = 0; m < 4; ++m) { const size_t off = (size_t)(row0 + ai * HALF + m * 16) * DM + col0;
#pragma unroll
                for (int bj = 0; bj < 2; ++bj)
#pragma unroll
                    for (int n = 0; n < 2; ++n) { const f32x4 b = *(const f32x4*)(base + off + bj * HALF + n * 16); *(f32x4*)(out + off + bj * HALF + n * 16) = b + acc[ai][bj][m][n]; } }
    }
};
struct EpiSwiglu {
    static constexpr bool PERM = true, DRAIN_TOP = true;
    bf16_t* act; const float* bias;
    struct Pre { f32x4 bg[2], bu[2]; };
    __device__ __forceinline__ void arrived(Pre& p) const { asm volatile("" : "+v"(p.bg[0]), "+v"(p.bg[1]), "+v"(p.bu[0]), "+v"(p.bu[1])); }
    __device__ __forceinline__ Pre preload(const Unit& u, int wr, int wc, int fr, int fq) const {
        const GAS float* be = (const GAS float*)bias + (size_t)u.e * 2048 + u.pn * HALF + wc * 32 + 8 * fq; Pre p;
#pragma unroll
        for (int n = 0; n < 2; ++n) { p.bg[n] = *(const GAS f32x4*)(be + 4 * n); p.bu[n] = *(const GAS f32x4*)(be + 1024 + 4 * n); }
        return p; }
    __device__ __forceinline__ void operator()(const f32x4 (&acc)[2][2][4][2], const Unit& u, int wr, int wc, int fr, int fq, const Pre& pre) const {
        const int row0 = u.pm * BM + wr * 64 + fr; const int col0 = u.pn * HALF + wc * 32 + 8 * fq;
        f32x4 bg[2], bu[2];
#pragma unroll
        for (int n = 0; n < 2; ++n) { bg[n] = pre.bg[n]; bu[n] = pre.bu[n]; }
#pragma unroll
        for (int ai = 0; ai < 2; ++ai)
#pragma unroll
            for (int m = 0; m < 4; ++m) { bf16_t* rowp = act + (size_t)(row0 + ai * HALF + m * 16) * DEXP + col0;
                float o[8];
#pragma unroll
                for (int n = 0; n < 2; ++n) { const f32x4 gv = acc[ai][0][m][n] + bg[n], uv = acc[ai][1][m][n] + bu[n];
#pragma unroll
                    for (int q = 0; q < 4; ++q) { const float g = fminf(gv[q], 7.0f); const float uu = fminf(fmaxf(uv[q], -7.0f), 7.0f);
                        const float sg = __builtin_amdgcn_rcpf(1.f + __builtin_amdgcn_exp2f(-1.702f * LOG2E * g));
                        o[4 * n + q] = (uu + 1.0f) * (g * sg); } }
                u32x4 w; w.x = cvt_pk_bf16(o[0], o[1]); w.y = cvt_pk_bf16(o[2], o[3]); w.z = cvt_pk_bf16(o[4], o[5]); w.w = cvt_pk_bf16(o[6], o[7]);
                *(u32x4*)rowp = w; }
    }
};
constexpr int EPI_STAGE_OFF = 131072, EPI_STAGE_WAVE = 2304;
struct EpiScatter {
    static constexpr bool PERM = false, DRAIN_TOP = false;
    typedef NoPre Pre; __device__ __forceinline__ Pre preload(const Unit&, int, int, int, int) const { return Pre{}; }
    float* out; const int* slot_tok; const float* slot_w; const float* bias; LAS unsigned char* lds;
    __device__ __forceinline__ void operator()(const f32x4 (&acc)[2][2][4][2], const Unit& u, int wr, int wc, int fr, int fq, const Pre&) const {
        const int lane = fr + 16 * fq, wid = wr * 4 + wc;
        LAS float* st = (LAS float*)(lds + EPI_STAGE_OFF + wid * EPI_STAGE_WAVE);
        const int row0 = u.pm * BM + wr * 64 + fr;
        const int lcol = lane & 31, lrow = lane >> 5;
        float bv[2];
#pragma unroll
        for (int bj = 0; bj < 2; ++bj) bv[bj] = bias[(size_t)u.e * DM + u.pn * BM + bj * HALF + wc * 32 + lcol];
#pragma unroll
        for (int ai = 0; ai < 2; ++ai)
#pragma unroll
            for (int m = 0; m < 4; ++m) { const int pos = row0 + ai * HALF + m * 16; const float w = slot_w[pos]; const int tok = slot_tok[pos];
#pragma unroll
                for (int bj = 0; bj < 2; ++bj) {
#pragma unroll
                    for (int n = 0; n < 2; ++n) *(LAS f32x4*)(st + fr * 36 + 16 * n + 4 * fq) = acc[ai][bj][m][n];
                    asm volatile("s_waitcnt lgkmcnt(0)" ::: "memory");
#pragma unroll
                    for (int i = 0; i < 8; ++i) { const int r = 2 * i + lrow; const float v = st[r * 36 + lcol];
                        const float wr_ = __shfl(w, r); const int tr_ = __shfl(tok, r);
                        if (wr_ != 0.f) unsafeAtomicAdd(out + (size_t)tr_ * DM + u.pn * BM + bj * HALF + wc * 32 + lcol, (v + bv[bj]) * wr_); }
                    asm volatile("s_waitcnt lgkmcnt(0)" ::: "memory");
                } }
    }
};
}

#define XB_TMO      128
#define XB_XCNT(j)  (256  + 64 * (j))
#define XB_XSUB(j)  (1280 + 64 * (j))
#define XB_XGEN(j)  (2304 + 64 * (j))
#define XB_TOP      3328
#define XB_TOPGEN   3392
#define XCD_BAR_WORDS 3456
#define XB_SPIN_CAP (1u << 18)

__device__ __forceinline__ unsigned xb_ld(unsigned* p)              { return __hip_atomic_load(p, __ATOMIC_RELAXED, __HIP_MEMORY_SCOPE_AGENT); }
__device__ __forceinline__ unsigned xb_add(unsigned* p, unsigned v) { return __hip_atomic_fetch_add(p, v, __ATOMIC_RELAXED, __HIP_MEMORY_SCOPE_AGENT); }
__device__ __forceinline__ unsigned xb_xcc_id() { return (unsigned)__builtin_amdgcn_s_getreg((3 << 11) | 20) & 0xFu; }
#define XB_SPIN(cond, bar) do { unsigned _sp = 0; while (cond) { __builtin_amdgcn_s_sleep(1); \
    if ((++_sp & 255u) == 0u) { if (xb_ld(&(bar)[XB_TMO])) break; if (_sp > XB_SPIN_CAP) { atomicAdd(&(bar)[XB_TMO], 1u); break; } } } } while (0)

struct XcdBarrier {
    unsigned* bar; unsigned x;
    volatile LAS unsigned* st;
};

__device__ __forceinline__ XcdBarrier xcd_barrier_post(unsigned* bar, volatile LAS unsigned* st) {
    XcdBarrier b; b.bar = bar; b.x = xb_xcc_id(); b.st = st;
    if (threadIdx.x == 0) (void)xb_add(&bar[XB_XCNT(b.x)], 1u);
    return b;
}
__device__ __forceinline__ void xcd_barrier_complete(unsigned* bar, unsigned x, unsigned& nloc, unsigned& nx) {
    const unsigned G = gridDim.x * gridDim.y * gridDim.z;
    unsigned sum, cnt, mine, sp = 0u;
    for (;;) {
        sum = 0u; cnt = 0u; mine = 0u;
#pragma unroll
        for (unsigned j = 0; j < 16; ++j) { const unsigned c = xb_ld(&bar[XB_XCNT(j)]); sum += c; cnt += (c > 0u) ? 1u : 0u; mine = (j == x) ? c : mine; }
        if (sum == G) break;
        __builtin_amdgcn_s_sleep(1);
        if ((++sp & 255u) == 0u) { if (xb_ld(&bar[XB_TMO])) break; if (sp > XB_SPIN_CAP) { atomicAdd(&bar[XB_TMO], 1u); break; } }
    }
    nloc = mine > 0u ? mine : 1u; nx = cnt > 0u ? cnt : 1u;
}

__device__ __forceinline__ void xcd_barrier(const XcdBarrier& b) {
    asm volatile("s_waitcnt vmcnt(0)" ::: "memory");
    __syncthreads();
    if (threadIdx.x == 0) {
        unsigned* bar = b.bar;
        __builtin_amdgcn_s_waitcnt(0);
        unsigned nloc = b.st[0], nx = b.st[1];
        if (nloc == 0u) { xcd_barrier_complete(bar, b.x, nloc, nx); b.st[0] = nloc; b.st[1] = nx; }
        const unsigned old = xb_add(&bar[XB_XSUB(b.x)], 1u);
        const unsigned gen = old / nloc;
        if (old + 1u == (gen + 1u) * nloc) {
            __builtin_amdgcn_fence(__ATOMIC_RELEASE, "agent");
            asm volatile("s_waitcnt vmcnt(0)" ::: "memory");
            const unsigned og = xb_add(&bar[XB_TOP], 1u);
            const unsigned tg = og / nx;
            if (og + 1u == (tg + 1u) * nx) xb_add(&bar[XB_TOPGEN], 1u);
            else XB_SPIN(xb_ld(&bar[XB_TOPGEN]) == tg, bar);
            __builtin_amdgcn_fence(__ATOMIC_ACQUIRE, "agent");
            xb_add(&bar[XB_XGEN(b.x)], 1u);
            asm volatile("s_waitcnt vmcnt(0)" ::: "memory");
        } else {
            XB_SPIN(xb_ld(&bar[XB_XGEN(b.x)]) == gen, bar);
            __builtin_amdgcn_fence(__ATOMIC_ACQUIRE, "agent");
            asm volatile("s_waitcnt vmcnt(0)" ::: "memory");
        }
    }
    __syncthreads();
}

constexpr int NWAVES = 8;
struct Frame {
    LAS unsigned char* lds;
    volatile LAS unsigned* MISC;
    gu32* ctl;
    int tid, lane, wave, G, blk;
    const float* in[21];
    float* out; unsigned char* ws;
};
__device__ __forceinline__ float wave_sum(float v) {
#pragma unroll
    for (int o = 1; o < 64; o <<= 1) v += __shfl_xor(v, o);
    return v;
}

__device__ __forceinline__ int map_src(int mode, int n) {
    if (mode == 1) return n < 2500 ? n : (n >= C_MQ ? n - (C_MQ - 2500) : -1);
    if (mode == 2) { const int pn = n >> 8, bj = (n >> 7) & 1, j = n & 127; return bj * 1024 + pn * 128 + j; }
    return n;
}
__device__ __forceinline__ void transpose_item(const float* W, int K, int Nsrc, int Ndst, bf16_t* WT, int mode, LAS float* scr, int item, int lane) {
    const int nblk = Ndst / 32, kb = item / nblk, nb = item % nblk, k0 = 64 * kb, n0 = 32 * nb;
    const int sc = map_src(mode, n0 + (lane & 31));
    const float scale = (mode == 1 && (n0 + (lane & 31)) < 512) ? 0.125f : 1.0f;
#pragma unroll
    for (int i = 0; i < 32; ++i) { const int kk = 2 * i + (lane >> 5); scr[kk * 33 + (lane & 31)] = sc >= 0 ? W[(size_t)(k0 + kk) * Nsrc + sc] * scale : 0.f; }
    LDS_WAIT(); asm volatile("" ::: "memory");
    const int c = lane & 7;
#pragma unroll
    for (int j = 0; j < 4; ++j) { const int n = (lane >> 3) + 8 * j; const LAS float* s = scr + (8 * c) * 33 + n;
        u32x4 o; o.x = pk2(s[0 * 33], s[1 * 33]); o.y = pk2(s[2 * 33], s[3 * 33]); o.z = pk2(s[4 * 33], s[5 * 33]); o.w = pk2(s[6 * 33], s[7 * 33]);
        *(GAS u32x4*)(WT + (size_t)(n0 + n) * K + k0 + 8 * c) = o; }
    LDS_WAIT(); asm volatile("" ::: "memory");
}
__device__ __forceinline__ void rms_row_to_bf16(int lane, const float* xrow, const float* g, bf16_t* orow) {
    const GAS f32x4* xr = (const GAS f32x4*)xrow + lane; const GAS f32x4* gr = (const GAS f32x4*)g + lane;
    f32x4 v[4]; float s = 0.f;
#pragma unroll
    for (int j = 0; j < 4; ++j) { v[j] = xr[64 * j]; s += (v[j].x * v[j].x + v[j].y * v[j].y) + (v[j].z * v[j].z + v[j].w * v[j].w); }
    const float rstd = 1.0f / sqrtf(wave_sum(s) * (1.f / DM) + EPS);
    GAS u32x2* o8 = (GAS u32x2*)orow + lane;
#pragma unroll
    for (int j = 0; j < 4; ++j) { const f32x4 gg = gr[64 * j]; u32x2 o; o.x = pk2(v[j].x * rstd * gg.x, v[j].y * rstd * gg.y); o.y = pk2(v[j].z * rstd * gg.z, v[j].w * rstd * gg.w); o8[64 * j] = o; }
}

__device__ __forceinline__ void rms_rows4_to_bf16(int lane, const float* x, const float* g, bf16_t* o, size_t m0, size_t stride) {
    f32x4 v[4][4]; float s[4];
#pragma unroll
    for (int r = 0; r < 4; ++r) { const GAS f32x4* xr = (const GAS f32x4*)(x + (m0 + r * stride) * DM) + lane;
#pragma unroll
        for (int j = 0; j < 4; ++j) v[r][j] = xr[64 * j]; }
    const GAS f32x4* gr = (const GAS f32x4*)g + lane;
    f32x4 gg[4];
#pragma unroll
    for (int j = 0; j < 4; ++j) gg[j] = gr[64 * j];
#pragma unroll
    for (int r = 0; r < 4; ++r) { float a = 0.f;
#pragma unroll
        for (int j = 0; j < 4; ++j) a += (v[r][j].x * v[r][j].x + v[r][j].y * v[r][j].y) + (v[r][j].z * v[r][j].z + v[r][j].w * v[r][j].w);
        s[r] = a; }
#pragma unroll
    for (int of = 1; of < 64; of <<= 1) {
#pragma unroll
        for (int r = 0; r < 4; ++r) s[r] += __shfl_xor(s[r], of); }
#pragma unroll
    for (int r = 0; r < 4; ++r) { const float rstd = 1.0f / sqrtf(s[r] * (1.f / DM) + EPS);
        GAS u32x2* o8 = (GAS u32x2*)(o + (m0 + r * stride) * DM) + lane;
#pragma unroll
        for (int j = 0; j < 4; ++j) { u32x2 w; w.x = pk2(v[r][j].x * rstd * gg[j].x, v[r][j].y * rstd * gg[j].y); w.y = pk2(v[r][j].z * rstd * gg[j].z, v[r][j].w * rstd * gg[j].w); o8[64 * j] = w; } }
}
__device__ __forceinline__ void p0_prologue(Frame& F) {
    LAS float* scr = (LAS float*)(F.lds + F.wave * 16384);
    const int gw = F.blk * NWAVES + F.wave, NGW = F.G * NWAVES, lane = F.lane;
    unsigned char* ws = F.ws;
    constexpr int I_IN = 16 * 96, I_MKV = 16 * 32, I_G = 16 * 32, I_B = 8 * 32, I_O = 16 * 32, I_EI = 16 * 64, I_EO = 16 * 32;
    constexpr int NITEMS = I_IN + I_MKV + 3 * I_G + 3 * I_B + I_O + NEXP * I_EI + NEXP * I_EO;
    for (int it = gw; it < NITEMS; it += NGW) {
        int r = it;
        if (r < I_IN) { transpose_item(F.in[3], DM, IN_W, PW, (bf16_t*)(ws + WS_WIN), 1, scr, r, lane); continue; } r -= I_IN;
        if (r < I_MKV) { transpose_item(F.in[9], DM, DM, DM, (bf16_t*)(ws + WS_WMKV), 0, scr, r, lane); continue; } r -= I_MKV;
        if (r < 3 * I_G) { const int n = r / I_G; transpose_item(F.in[10] + (size_t)n * DM * DM, DM, DM, DM, (bf16_t*)(ws + WS_WG) + (size_t)n * DM * DM, 0, scr, r % I_G, lane); continue; } r -= 3 * I_G;
        if (r < 3 * I_B) { const int n = r / I_B; transpose_item(F.in[12] + (size_t)n * 512 * DM, 512, DM, DM, (bf16_t*)(ws + WS_WB) + (size_t)n * DM * 512, 0, scr, r % I_B, lane); continue; } r -= 3 * I_B;
        if (r < I_O) { transpose_item(F.in[13], DM, DM, DM, (bf16_t*)(ws + WS_WO), 0, scr, r, lane); continue; } r -= I_O;
        if (r < NEXP * I_EI) { const int e = r / I_EI; transpose_item(F.in[17] + (size_t)e * DM * 2048, DM, 2048, 2048, (bf16_t*)(ws + WS_WEI) + (size_t)e * 2048 * DM, 2, scr, r % I_EI, lane); continue; } r -= NEXP * I_EI;
        { const int e = r / I_EO; transpose_item(F.in[19] + (size_t)e * DM * DM, DM, DM, DM, (bf16_t*)(ws + WS_WEO) + (size_t)e * DM * DM, 0, scr, r % I_EO, lane); }
    }
    { f32x2* tab = (f32x2*)(ws + WS_ROPE);
      for (int idx = (F.blk * NWAVES * 64) + F.tid; idx < SEQ * 32; idx += F.G * NWAVES * 64) {
          const int s = idx >> 5, i = idx & 31;
          const float inv = exp2f(-(float)i * (13.287712379549449f / 32.0f));
          const float ang = (float)s * inv;
          const double rev = (double)ang * 0.15915494309189535;
          const float fr = (float)(rev - __builtin_rint(rev));
          tab[idx] = (f32x2){__builtin_amdgcn_cosf(fr), __builtin_amdgcn_sinf(fr)}; } }
    for (int m = gw; m < NTOK; m += 4 * NGW) rms_rows4_to_bf16(lane, F.in[0], F.in[2], (bf16_t*)(ws + WS_H), (size_t)m, (size_t)NGW);
    for (int m = gw; m < NMEM; m += 4 * NGW) rms_rows4_to_bf16(lane, F.in[1], F.in[8], (bf16_t*)(ws + WS_MEMN), (size_t)m, (size_t)NGW);
    { int* st = (int*)(ws + WS_SLOT_TOK); float* sw = (float*)(ws + WS_SLOT_W);
      for (int i = F.blk * NWAVES * 64 + F.tid; i < NSLOT_PAD; i += F.G * NWAVES * 64) { st[i] = 0; sw[i] = 0.f; } }
}

template <int CTRL> __device__ __forceinline__ float dppf(float v) { return __builtin_bit_cast(float, __builtin_amdgcn_update_dpp(0, __builtin_bit_cast(int, v), CTRL, 0xF, 0xF, false)); }
__device__ __forceinline__ float lx1(float v) { return dppf<0xB1>(v); }
__device__ __forceinline__ float lx2(float v) { return dppf<0x4E>(v); }
__device__ __forceinline__ float lx4(float v) { return dppf<0x1B>(dppf<0x141>(v)); }
__device__ __forceinline__ float lx8(float v) { return dppf<0x128>(v); }
__device__ __forceinline__ void un8(const u32x4 w, float (&v)[8]) { v[0] = bflo(w.x); v[1] = bfhi(w.x); v[2] = bflo(w.y); v[3] = bfhi(w.y); v[4] = bflo(w.z); v[5] = bfhi(w.z); v[6] = bflo(w.w); v[7] = bfhi(w.w); }
__device__ __forceinline__ u32x4 pk8(const float (&v)[8]) { u32x4 w; w.x = pk2(v[0], v[1]); w.y = pk2(v[2], v[3]); w.z = pk2(v[4], v[5]); w.w = pk2(v[6], v[7]); return w; }
__device__ __forceinline__ void rope8(float (&v)[8], const f32x2 (&cs)[8], bool up) {
#pragma unroll
    for (int j = 0; j < 8; ++j) { const float other = lx4(v[j]); v[j] = up ? (other * cs[j].y + v[j] * cs[j].x) : (v[j] * cs[j].x - other * cs[j].y); }
}
__device__ __forceinline__ void p2_prep(Frame& F, const bool dummy = false) {
    const int gw = F.blk * NWAVES + F.wave, NGW = F.G * NWAVES, lane = F.lane;
    bf16_t* proj = (bf16_t*)(F.ws + WS_P);
    bf16_t* projw = dummy ? (bf16_t*)(F.ws + WS_END) : proj;
    const int wmask = dummy ? 8191 : 0x7fffffff;
    const f32x2* tab = (const f32x2*)(F.ws + WS_ROPE);
    float gqd[8], gkd[8], gqm[8];
#pragma unroll
    for (int j = 0; j < 8; ++j) { gqd[j] = F.in[4][8 * (lane & 7) + j] * (0.125f * LOG2E); gkd[j] = F.in[5][8 * (lane & 7) + j]; gqm[j] = F.in[6][8 * (lane & 15) + j] * (0.08838834764831845f * LOG2E); }
    const bool up = (lane & 4) != 0; const int i0 = (lane & 3) * 8;
    for (int m0 = gw; m0 < NTOK; m0 += 2 * NGW) {
        u32x4 raw[2][5]; f32x2 cs[2][8];
#pragma unroll
        for (int t = 0; t < 2; ++t) { const GAS bf16_t* row = (const GAS bf16_t*)proj + (size_t)(m0 + t * NGW) * PW;
            raw[t][0] = *(const GAS u32x4*)(row + C_DQ + 8 * lane); raw[t][1] = *(const GAS u32x4*)(row + C_DK + 8 * (lane & 7)); raw[t][2] = *(const GAS u32x4*)(row + C_IQ + 8 * (lane & 31));
            raw[t][3] = *(const GAS u32x4*)(row + C_IK + 8 * (lane & 7)); raw[t][4] = *(const GAS u32x4*)(row + C_MQ + 8 * lane);
            const GAS f32x2* tr = (const GAS f32x2*)tab + (size_t)((m0 + t * NGW) & (SEQ - 1)) * 32 + i0;
#pragma unroll
            for (int j = 0; j < 8; ++j) cs[t][j] = tr[j]; }
#pragma unroll
        for (int t = 0; t < 2; ++t) {
            GAS bf16_t* roww = (GAS bf16_t*)projw + (size_t)((m0 + t * NGW) & wmask) * PW;
            float v[8];
            { un8(raw[t][0], v); float ss = 0.f;
#pragma unroll
              for (int j = 0; j < 8; ++j) ss += v[j] * v[j];
              ss += lx1(ss); ss += lx2(ss); ss += lx4(ss);
              const float rstd = 1.0f / sqrtf(ss * (1.f / 64.f) + EPS);
#pragma unroll
              for (int j = 0; j < 8; ++j) v[j] = v[j] * rstd * gqd[j];
              rope8(v, cs[t], up);
              *(GAS u32x4*)(roww + C_DQ + 8 * lane) = pk8(v); }
            { un8(raw[t][1], v); float ss = 0.f;
#pragma unroll
              for (int j = 0; j < 8; ++j) ss += v[j] * v[j];
              ss += lx1(ss); ss += lx2(ss); ss += lx4(ss);
              const float rstd = 1.0f / sqrtf(ss * (1.f / 64.f) + EPS);
#pragma unroll
              for (int j = 0; j < 8; ++j) v[j] = v[j] * rstd * gkd[j];
              rope8(v, cs[t], up);
              if (lane < 8) *(GAS u32x4*)(roww + C_DK + 8 * lane) = pk8(v); }
            { un8(raw[t][2], v); rope8(v, cs[t], up); if (lane < 32) *(GAS u32x4*)(roww + C_IQ + 8 * lane) = pk8(v); }
            { un8(raw[t][3], v); rope8(v, cs[t], up); if (lane < 8) *(GAS u32x4*)(roww + C_IK + 8 * lane) = pk8(v); }
            { un8(raw[t][4], v); float ss = 0.f;
#pragma unroll
              for (int j = 0; j < 8; ++j) ss += v[j] * v[j];
              ss += lx1(ss); ss += lx2(ss); ss += lx4(ss); ss += lx8(ss);
              const float rstd = 1.0f / sqrtf(ss * (1.f / 128.f) + EPS);
#pragma unroll
              for (int j = 0; j < 8; ++j) v[j] = v[j] * rstd * gqm[j];
              *(GAS u32x4*)(roww + C_MQ + 8 * lane) = pk8(v); }
        }
    }
    bf16_t* mkv = (bf16_t*)(F.ws + WS_MKV);
    if (!dummy) for (int m = gw; m < NMEM; m += NGW) {
        GAS bf16_t* row = (GAS bf16_t*)mkv + (size_t)m * DM; float v[8];
        un8(*(const GAS u32x4*)(row + 8 * lane), v); float ss = 0.f;
#pragma unroll
        for (int j = 0; j < 8; ++j) ss += v[j] * v[j];
        ss += lx1(ss); ss += lx2(ss); ss += lx4(ss); ss += lx8(ss);
        const float rstd = 1.0f / sqrtf(ss * (1.f / 128.f) + EPS);
#pragma unroll
        for (int j = 0; j < 8; ++j) v[j] = v[j] * rstd * F.in[7][8 * (lane & 15) + j];
        *(GAS u32x4*)(row + 8 * lane) = pk8(v);
    }
}

#define MFMA32(a, b, c) __builtin_amdgcn_mfma_f32_32x32x16_bf16((a), (b), (c), 0, 0, 0)
typedef LAS const unsigned char* lds_cptr;
__device__ __forceinline__ s16x4 vtr(lds_cptr p) { return __builtin_bit_cast(s16x4, __builtin_amdgcn_ds_read_tr16_b64_v4i16((LAS v4i16_t*)p)); }
__device__ __forceinline__ bf16x8 vfrag(lds_cptr vbase_lane, int off) {
    const s16x4 lo = vtr(vbase_lane + off), hi = vtr(vbase_lane + off + 512);
    return (bf16x8){lo[0], lo[1], lo[2], lo[3], hi[0], hi[1], hi[2], hi[3]};
}
__device__ __forceinline__ int vtr_lane_off(int lane) { return ((lane >> 4) & 1) * 32 + (lane & 3) * 8 + (4 * (lane >> 5) + ((lane & 15) >> 2)) * 64; }
__device__ __forceinline__ bf16x8 pack8(const float* p) {
    u32x4 w; w.x = cvt_pk_bf16(p[0], p[1]); w.y = cvt_pk_bf16(p[2], p[3]); w.z = cvt_pk_bf16(p[4], p[5]); w.w = cvt_pk_bf16(p[6], p[7]);
    return __builtin_bit_cast(bf16x8, w);
}
__device__ __forceinline__ float softplus_f(float z) { return fmaxf(z, 0.f) + __logf(1.f + __expf(-fabsf(z))); }

__device__ __forceinline__ void sb_item(const bf16_t* proj, bf16_t* osb, int b, int h, int qblk, LAS unsigned char* vlds, int lane) {
    const int r32 = lane & 31, hi = lane >> 5;
    const size_t tok0 = (size_t)b * SEQ + (size_t)qblk * 32;
    bf16x8 qr[4];
    { const bf16_t* qp = proj + (tok0 + r32) * PW + C_SQ + h * 64 + hi * 8;
#pragma unroll
      for (int kk = 0; kk < 4; ++kk) qr[kk] = *(const bf16x8*)(qp + kk * 16); }
    f32x16 o0 = {}, o1 = {}; float R = 0.f;
    const lds_cptr vrd = (lds_cptr)vlds + vtr_lane_off(lane);
    bf16x8 kfn[4]; u32x4 vvn[4];
#define SB_LOAD(kt_) do { const size_t key0_ = (size_t)b * SEQ + (size_t)(kt_) * 32; const GAS bf16_t* kp_ = (const GAS bf16_t*)proj + (key0_ + r32) * PW + C_SK + h * 64 + hi * 8; \
        _Pragma("unroll") for (int kk = 0; kk < 4; ++kk) kfn[kk] = *(const GAS bf16x8*)(kp_ + kk * 16); \
        _Pragma("unroll") for (int p = 0; p < 4; ++p) vvn[p] = *(const GAS u32x4*)((const GAS bf16_t*)proj + (key0_ + 16 * (p & 1) + (lane >> 2)) * PW + C_SV + h * 64 + (p >> 1) * 32 + (lane & 3) * 8); } while (0)
    SB_LOAD(qblk);
    for (int kt = qblk; kt >= 0; --kt) {
        bf16x8 kf[4]; u32x4 vv[4];
#pragma unroll
        for (int i = 0; i < 4; ++i) { kf[i] = kfn[i]; vv[i] = vvn[i]; }
        if (kt > 0) SB_LOAD(kt - 1);
        f32x16 s = {};
#pragma unroll
        for (int kk = 0; kk < 4; ++kk) s = MFMA32(kf[kk], qr[kk], s);
        asm volatile("" ::: "memory");
#pragma unroll
        for (int p = 0; p < 4; ++p) *(LAS u32x4*)(vlds + p * 1024 + lane * 16) = vv[p];
        const bool diag = (kt == qblk);
        float sp[16], pr[16];
#pragma unroll
        for (int r = 0; r < 16; ++r) { const bool valid = !diag || (crow(r, hi) < r32); sp[r] = valid ? softplus_f(s[r]) : 0.f; }
        float T[4], U[4];
#pragma unroll
        for (int g = 0; g < 4; ++g) { T[g] = (sp[4 * g] + sp[4 * g + 1]) + (sp[4 * g + 2] + sp[4 * g + 3]); U[g] = __shfl_xor(T[g], 32); }
        float run = 0.f, above[4];
#pragma unroll
        for (int g = 3; g >= 0; --g) { above[g] = run + (hi == 0 ? U[g] : 0.f); run += T[g] + U[g]; }
#pragma unroll
        for (int g = 0; g < 4; ++g) { float c = R + above[g];
#pragma unroll
            for (int j = 3; j >= 0; --j) { const int r = 4 * g + j; c += sp[r]; const bool valid = !diag || (crow(r, hi) < r32); pr[r] = valid ? __expf(s[r] - c) : 0.f; } }
        R += run;
        const bf16x8 p0 = pack8(pr), p1 = pack8(pr + 8);
        LDS_WAIT();
        const bf16x8 v00 = vfrag(vrd, 0), v01 = vfrag(vrd, 1024), v10 = vfrag(vrd, 2048), v11 = vfrag(vrd, 3072);
        o0 = MFMA32(v00, p0, o0); o0 = MFMA32(v01, p1, o0);
        o1 = MFMA32(v10, p0, o1); o1 = MFMA32(v11, p1, o1);
        asm volatile("" ::: "memory");
        if (__all(R > 30.0f)) break;
    }
#undef SB_LOAD
    bf16_t* op = osb + (tok0 + r32) * 512 + h * 64 + 4 * hi;
#pragma unroll
    for (int g = 0; g < 4; ++g) {
        u32x2 w0, w1; w0.x = cvt_pk_bf16(o0[4 * g], o0[4 * g + 1]); w0.y = cvt_pk_bf16(o0[4 * g + 2], o0[4 * g + 3]); w1.x = cvt_pk_bf16(o1[4 * g], o1[4 * g + 1]); w1.y = cvt_pk_bf16(o1[4 * g + 2], o1[4 * g + 3]);
        *(u32x2*)(op + 8 * g) = w0; *(u32x2*)(op + 32 + 8 * g) = w1; }
}

constexpr int ML_K = 0, ML_KROW = 272, ML_V = 256 * ML_KROW, ML_END = ML_V + 65536;
__device__ __forceinline__ void mem_unit(const bf16_t* proj, const bf16_t* mkv, bf16_t* omem, int b, int h, int half, LAS unsigned char* ml, int tid) {
    const int lane = tid & 63, wid = __builtin_amdgcn_readfirstlane(tid >> 6), r32 = lane & 31, hi = lane >> 5;
    { const GAS bf16_t* src = (const GAS bf16_t*)mkv + (size_t)b * MEMLEN * DM + h * 128;
#pragma unroll
      for (int i = 0; i < 8; ++i) { const int ch = tid + 512 * i, key = ch >> 4, c16 = ch & 15, kk = key & 31;
          const u32x4 kv = *(const GAS u32x4*)(src + (size_t)key * DM + c16 * 8);
          const u32x4 vv = *(const GAS u32x4*)(src + (size_t)key * DM + 512 + c16 * 8);
          *(LAS u32x4*)(ml + ML_K + key * ML_KROW + c16 * 16) = kv;
          *(LAS u32x4*)(ml + ML_V + (key >> 5) * 8192 + ((c16 >> 2) * 2 + (kk >> 4)) * 1024 + (kk & 15) * 64 + (c16 & 3) * 16) = vv; } }
    __syncthreads();
    for (int i = 0; i < 4; ++i) {
        const int qblk = half * 32 + wid * 4 + i;
        const size_t tok0 = (size_t)b * SEQ + (size_t)qblk * 32;
        bf16x8 qr[8];
        { const GAS bf16_t* qp = (const GAS bf16_t*)proj + (tok0 + r32) * PW + C_MQ + h * 128 + hi * 8;
#pragma unroll
          for (int kk = 0; kk < 8; ++kk) qr[kk] = *(const GAS bf16x8*)(qp + kk * 16); }
        f32x16 o[4] = {{}, {}, {}, {}}; float m = -1e30f, l = 0.f;
        for (int kb = 0; kb < 8; ++kb) {
            const LAS unsigned char* krd = ml + ML_K + (32 * kb + r32) * ML_KROW + hi * 16;
            f32x16 s = {};
#pragma unroll
            for (int kk = 0; kk < 8; ++kk) { const bf16x8 kf = *(const LAS bf16x8*)(krd + kk * 32); s = MFMA32(kf, qr[kk], s); }
            float mx = s[0];
#pragma unroll
            for (int r = 1; r < 16; ++r) mx = fmaxf(mx, s[r]);
            mx = fmaxf(mx, __shfl_xor(mx, 32));
            if (__any(mx > m + 8.0f)) {
                const float mn = fmaxf(m, mx), alpha = __builtin_amdgcn_exp2f(m - mn);
                l *= alpha; m = mn;
#pragma unroll
                for (int d = 0; d < 4; ++d)
#pragma unroll
                    for (int r = 0; r < 16; ++r) o[d][r] *= alpha;
            }
            float pr[16], rs = 0.f;
#pragma unroll
            for (int r = 0; r < 16; ++r) { pr[r] = __builtin_amdgcn_exp2f(s[r] - m); rs += pr[r]; }
            l += rs;
            const bf16x8 p0 = pack8(pr), p1 = pack8(pr + 8);
            const lds_cptr vrd = (lds_cptr)ml + ML_V + kb * 8192 + vtr_lane_off(lane);
#pragma unroll
            for (int d = 0; d < 4; ++d) { const bf16x8 va = vfrag(vrd, d * 2048), vb = vfrag(vrd, d * 2048 + 1024); o[d] = MFMA32(va, p0, o[d]); o[d] = MFMA32(vb, p1, o[d]); }
        }
        l += __shfl_xor(l, 32);
        const float il = 1.0f / l;
        bf16_t* op = omem + (tok0 + r32) * 512 + h * 128 + 4 * hi;
#pragma unroll
        for (int d = 0; d < 4; ++d)
#pragma unroll
            for (int g = 0; g < 4; ++g) { u32x2 w; w.x = cvt_pk_bf16(o[d][4 * g] * il, o[d][4 * g + 1] * il); w.y = cvt_pk_bf16(o[d][4 * g + 2] * il, o[d][4 * g + 3] * il); *(u32x2*)(op + 32 * d + 8 * g) = w; }
    }
    __syncthreads();
}

constexpr int DL_HIST = 0, DL_PREFIX = 66048, DL_KREM = DL_PREFIX + 256, DL_MASK = 67072, DL_VT = 73728, DL_KT = DL_VT + 2 * 16384, DL_END = DL_KT + 2 * 18432, DL_IQ = DL_VT;
constexpr int TOPK_DSA = 256;

struct IqLds { const LAS unsigned char* p; __device__ __forceinline__ bf16x8 operator()(int j) const { return *(const LAS bf16x8*)(p + j * 32); } };
template <class QF>
__device__ __forceinline__ void idx_scores(const QF& qf, const bf16x8 (&kf)[4], const float (&wq)[4], unsigned (&uk)[16]) {
    float scv[16];
#pragma unroll
    for (int hd = 0; hd < 4; ++hd) { f32x16 a = (f32x16){};
#pragma unroll
        for (int kk = 0; kk < 4; ++kk) a = MFMA32(kf[kk], qf(hd * 4 + kk), a);
#pragma unroll
        for (int r = 0; r < 16; ++r) scv[r] = (hd == 0) ? wq[0] * fmaxf(a[r], 0.f) : __builtin_fmaf(wq[hd], fmaxf(a[r], 0.f), scv[r]); }
#pragma unroll
    for (int r = 0; r < 16; ++r) {
        unsigned bits = __builtin_bit_cast(unsigned, scv[r]);
        if (bits == 0x80000000u) bits = 0u;
        uk[r] = bits ^ ((unsigned)((int)bits >> 31) | 0x80000000u);
    }
}
__device__ __forceinline__ void load_ik(const bf16_t* proj, size_t tokb, int kbase, int r32, int hi, bf16x8 (&kf)[4]) {
    int kr = kbase + r32; if (kr > SEQ - 1) kr = SEQ - 1;
    const GAS bf16_t* p = (const GAS bf16_t*)proj + (tokb + kr) * PW + C_IK + 8 * hi;
#pragma unroll
    for (int kk = 0; kk < 4; ++kk) kf[kk] = *(const GAS bf16x8*)(p + kk * 16);
}

__device__ __forceinline__ void dsa_unit(const bf16_t* proj, bf16_t* odsa, unsigned* kscr  , int b, int c, LAS unsigned char* dl, int tid) {
    const int lane = tid & 63, wid = __builtin_amdgcn_readfirstlane(tid >> 6), r32 = lane & 31, hi = lane >> 5;
    const int n = 64 * (c + 1), nsteps = (n + 127) >> 7;
    const size_t tokq0 = (size_t)b * SEQ + (size_t)c * 64, tokb = (size_t)b * SEQ;
    LAS unsigned* hist = (LAS unsigned*)(dl + DL_HIST);
    LAS unsigned* prefix = (LAS unsigned*)(dl + DL_PREFIX);
    LAS unsigned* krem = (LAS unsigned*)(dl + DL_KREM);
    LAS unsigned* mask = (LAS unsigned*)(dl + DL_MASK);
    const int kb = wid >> 1, qh = wid & 1;
    { const int row = tid >> 3, c = tid & 7;
      const GAS bf16_t* src = (const GAS bf16_t*)proj + (tokq0 + row) * PW + C_IQ + c * 32;
#pragma unroll
      for (int i = 0; i < 4; ++i) *(LAS u32x4*)(dl + DL_IQ + row * 528 + c * 64 + i * 16) = *(const GAS u32x4*)(src + i * 8); }
    const IqLds iqf{dl + DL_IQ + (32 * qh + r32) * 528 + hi * 16};
    float wq[4];
    { const u32x2 w = *(const u32x2*)(proj + (tokq0 + 32 * qh + r32) * PW + C_IW);
      wq[0] = bflo(w.x) * 0.0625f; wq[1] = bfhi(w.x) * 0.0625f; wq[2] = bflo(w.y) * 0.0625f; wq[3] = bfhi(w.y) * 0.0625f; }
#ifndef REP_SEL
#define REP_SEL 1
#endif
#ifndef REP_B2
#define REP_B2 1
#endif
    LAS unsigned* selall = (LAS unsigned*)(dl + DL_HIST);
#ifndef PROBE_NOATOM
#define PROBE_NOATOM 0
#endif
    unsigned dummy = 0u;
    for (int rep_sel = 0; rep_sel < REP_SEL; ++rep_sel) {
    if (tid < 64) { prefix[tid] = 0u; krem[tid] = (n > TOPK_DSA) ? (unsigned)TOPK_DSA : 0x7fffffffu; }
    __syncthreads();
    const int pass0 = (n > TOPK_DSA) ? 0 : 3;
    GAS u32x4* kmine = (GAS u32x4*)kscr + ((size_t)wid * 64 + lane) * 4;
#define DSA_CONSUME(uk_) do { \
        if (sel) { _Pragma("unroll") for (int r = 0; r < 16; ++r) { const bool match = (pass == 0) || (((uk_)[r] >> (shift + 8)) == pfx); \
                if (match && !(PROBE_NOATOM && rep_sel + 1 < REP_SEL)) __hip_atomic_fetch_add(hist + (32 * qh + r32) * 257 + (((uk_)[r] >> shift) & 255u), 1u, __ATOMIC_RELAXED, __HIP_MEMORY_SCOPE_WORKGROUP); else dummy ^= (uk_)[r]; } } \
        else { _Pragma("unroll") for (int r = 0; r < 16; ++r) { const unsigned k24 = (uk_)[r] >> 8; gtw |= (k24 > pfx ? 1u : 0u) << crow(r, hi); eqw |= (k24 == pfx ? 1u : 0u) << crow(r, hi); } } } while (0)
#define DSA_TIES() do { if (!sel) { \
        LAS unsigned* mk = mask + (step & 1) * 768; \
        gtw |= __shfl_xor(gtw, 32); eqw |= __shfl_xor(eqw, 32); \
        if (hi == 0) { mk[(32 * qh + r32) * 4 + kb] = gtw; mk[256 + (32 * qh + r32) * 4 + kb] = eqw; } \
        __syncthreads(); \
        if (wid == 0) { unsigned nd = krem[lane]; \
            _Pragma("unroll") for (int k4 = 0; k4 < 4; ++k4) { const unsigned g = mk[lane * 4 + k4]; unsigned e = mk[256 + lane * 4 + k4]; unsigned sl = g; \
                if (e != 0u) { const unsigned cnt = (unsigned)__builtin_popcount(e); \
                    if (cnt <= nd) { sl |= e; nd -= cnt; } \
                    else { unsigned chosen = 0u; while (nd > 0u) { const unsigned lb = e & (0u - e); chosen |= lb; e ^= lb; --nd; } sl |= chosen; } } \
                selall[lane * 64 + step * 4 + k4] = sl; } \
            krem[lane] = nd; } } } while (0)
    for (int pass = pass0; pass < ((rep_sel + 1 < REP_SEL) ? 3 : 4); ++pass) {
        const bool sel = pass < 3;
        if (sel) { for (int i = tid; i < 64 * 257; i += 512) hist[i] = 0u; __syncthreads(); }
        const int shift = 24 - 8 * pass;
        const unsigned pfx = prefix[32 * qh + r32];
        if (pass == pass0) {
            bf16x8 kfn[4]; load_ik(proj, tokb, 32 * kb, r32, hi, kfn);
            for (int step = 0; step < nsteps; ++step) {
                const int kbase = 128 * step + 32 * kb;
                bf16x8 kf[4];
#pragma unroll
                for (int kk = 0; kk < 4; ++kk) kf[kk] = kfn[kk];
                if (step + 1 < nsteps) load_ik(proj, tokb, kbase + 128, r32, hi, kfn);
                unsigned gtw = 0u, eqw = 0u;
                if (kbase < n) {
                    unsigned uk[16];
                    idx_scores(iqf, kf, wq, uk);
                    if (pass0 == 0) {
#pragma unroll
                        for (int g = 0; g < 4; ++g) kmine[(size_t)step * 2048 + g] = (u32x4){uk[4 * g], uk[4 * g + 1], uk[4 * g + 2], uk[4 * g + 3]};
                    }
                    DSA_CONSUME(uk);
                }
                DSA_TIES();
            }
        } else {
            u32x4 ka[4], kb4[4];
#define DSA_KLOAD(dst, st_) do { _Pragma("unroll") for (int g = 0; g < 4; ++g) dst[g] = kmine[(size_t)(st_) * 2048 + g]; } while (0)
            DSA_KLOAD(ka, 0);
            if (nsteps > 1 && 128 + 32 * kb < n) DSA_KLOAD(kb4, 1);
            for (int step = 0; step < nsteps; ++step) {
                const int kbase = 128 * step + 32 * kb;
                unsigned uk[16];
#pragma unroll
                for (int g = 0; g < 4; ++g) { uk[4 * g] = ka[g].x; uk[4 * g + 1] = ka[g].y; uk[4 * g + 2] = ka[g].z; uk[4 * g + 3] = ka[g].w; }
#pragma unroll
                for (int g = 0; g < 4; ++g) ka[g] = kb4[g];
                if (step + 2 < nsteps && kbase + 256 < n) DSA_KLOAD(kb4, step + 2);
                unsigned gtw = 0u, eqw = 0u;
                if (kbase < n) DSA_CONSUME(uk);
                DSA_TIES();
            }
#undef DSA_KLOAD
        }
        if (sel) {
            __syncthreads();
#pragma unroll
            for (int qi = 0; qi < 8; ++qi) {
                const int q = 8 * wid + qi;
                const LAS unsigned* hq = hist + q * 257;
                const unsigned c0 = hq[255 - 4 * lane], c1 = hq[254 - 4 * lane], c2 = hq[253 - 4 * lane], c3 = hq[252 - 4 * lane];
                const unsigned s4 = c0 + c1 + c2 + c3;
                unsigned incl = s4;
#pragma unroll
                for (int o = 1; o < 64; o <<= 1) { const unsigned t = __shfl_up(incl, o); if (lane >= o) incl += t; }
                const unsigned excl = incl - s4, kr = krem[q];
                if (excl < kr && kr <= incl) {
                    unsigned cum = excl, bin, nk;
                    if (cum + c0 >= kr) { bin = 255 - 4 * lane; nk = kr - cum; }
                    else { cum += c0; if (cum + c1 >= kr) { bin = 254 - 4 * lane; nk = kr - cum; }
                    else { cum += c1; if (cum + c2 >= kr) { bin = 253 - 4 * lane; nk = kr - cum; }
                    else { cum += c2; bin = 252 - 4 * lane; nk = kr - cum; } } }
                    prefix[q] = (prefix[q] << 8) | bin; krem[q] = nk;
                }
            }
            __syncthreads();
        }
    }
    }
    if (dummy == 0x9e3779b9u) hist[tid] = 1u;
    const int hd = wid;
    u32x4 pk[2], pv[2];
#define DSA_LOADKV(step_) do { _Pragma("unroll") for (int i_ = 0; i_ < 2; ++i_) { const int ch_ = tid + 512 * i_; int krow_ = 128 * (step_) + (ch_ >> 3); if (krow_ > SEQ - 1) krow_ = SEQ - 1; \
        const GAS bf16_t* rp_ = (const GAS bf16_t*)proj + (tokb + krow_) * PW + (ch_ & 7) * 8; pk[i_] = *(const GAS u32x4*)(rp_ + C_DK); pv[i_] = *(const GAS u32x4*)(rp_ + C_DV); } } while (0)
#define DSA_STOREKV(buf_) do { _Pragma("unroll") for (int i_ = 0; i_ < 2; ++i_) { const int ch_ = tid + 512 * i_, key_ = ch_ >> 3, c8_ = ch_ & 7, kk_ = key_ & 31; \
        *(LAS u32x4*)(dl + DL_KT + (buf_) * 18432 + key_ * 144 + c8_ * 16) = pk[i_]; \
        *(LAS u32x4*)(dl + DL_VT + (buf_) * 16384 + (key_ >> 5) * 4096 + ((c8_ >> 2) * 2 + (kk_ >> 4)) * 1024 + (kk_ & 15) * 64 + (c8_ & 3) * 16) = pv[i_]; } } while (0)
    for (int qb = 0; qb < 2; ++qb) {
        bf16x8 qr[4];
        { const GAS bf16_t* qp = (const GAS bf16_t*)proj + (tokq0 + 32 * qb + r32) * PW + C_DQ + hd * 64 + 8 * hi;
#pragma unroll
          for (int kk = 0; kk < 4; ++kk) qr[kk] = *(const GAS bf16x8*)(qp + kk * 16); }
        f32x16 o0 = {}, o1 = {}; float mrun = -1e30f, lrun = 0.f;
        DSA_LOADKV(0);
        DSA_STOREKV(0);
        __syncthreads();
        for (int step = 0; step < nsteps; ++step) {
            const int buf = step & 1;
            if (step + 1 < nsteps) DSA_LOADKV(step + 1);
            LAS unsigned char* kt = dl + DL_KT + buf * 18432;
            LAS unsigned char* vt = dl + DL_VT + buf * 16384;
            for (int k4 = 0; k4 < 4; ++k4) {
                const int kbase = 128 * step + 32 * k4;
                if (kbase >= n) break;
                const LAS unsigned char* krd = kt + (32 * k4 + r32) * 144 + hi * 16;
                f32x16 s = {};
#pragma unroll
                for (int kk = 0; kk < 4; ++kk) { const bf16x8 kf = *(const LAS bf16x8*)(krd + kk * 32); s = MFMA32(kf, qr[kk], s); }
                const lds_cptr vrd = (lds_cptr)vt + k4 * 4096 + vtr_lane_off(lane);
                const bf16x8 v00 = vfrag(vrd, 0), v01 = vfrag(vrd, 1024), v10 = vfrag(vrd, 2048), v11 = vfrag(vrd, 3072);
                const unsigned selw = selall[(32 * qb + r32) * 64 + step * 4 + k4];
                float mx = -INFINITY;
#pragma unroll
                for (int r = 0; r < 16; ++r) { if (!((selw >> crow(r, hi)) & 1u)) s[r] = -INFINITY; mx = fmaxf(mx, s[r]); }
                mx = fmaxf(mx, __shfl_xor(mx, 32));
                if (__any(mx > mrun + 8.0f)) {
                    const float mn = fmaxf(mrun, mx), alpha = __builtin_amdgcn_exp2f(mrun - mn);
                    lrun *= alpha; mrun = mn;
#pragma unroll
                    for (int r = 0; r < 16; ++r) { o0[r] *= alpha; o1[r] *= alpha; }
                }
                float pr[16], rs = 0.f;
#pragma unroll
                for (int r = 0; r < 16; ++r) { pr[r] = __builtin_amdgcn_exp2f(s[r] - mrun); rs += pr[r]; }
                lrun += rs;
                const bf16x8 p0 = pack8(pr), p1 = pack8(pr + 8);
                o0 = MFMA32(v00, p0, o0); o0 = MFMA32(v01, p1, o0);
                o1 = MFMA32(v10, p0, o1); o1 = MFMA32(v11, p1, o1);
            }
            if (step + 1 < nsteps) DSA_STOREKV(buf ^ 1);
            __syncthreads();
        }
        float l = lrun; l += __shfl_xor(l, 32);
        const float il = 1.0f / l;
        bf16_t* op = odsa + (tokq0 + 32 * qb + r32) * 512 + hd * 64 + 4 * hi;
#pragma unroll
        for (int g = 0; g < 4; ++g) {
            u32x2 w0, w1; w0.x = cvt_pk_bf16(o0[4 * g] * il, o0[4 * g + 1] * il); w0.y = cvt_pk_bf16(o0[4 * g + 2] * il, o0[4 * g + 3] * il);
            w1.x = cvt_pk_bf16(o1[4 * g] * il, o1[4 * g + 1] * il); w1.y = cvt_pk_bf16(o1[4 * g + 2] * il, o1[4 * g + 3] * il);
            *(u32x2*)(op + 8 * g) = w0; *(u32x2*)(op + 32 + 8 * g) = w1; }
    }
#undef DSA_LOADKV
#undef DSA_STOREKV
#undef DSA_CONSUME
#undef DSA_TIES
    __syncthreads();
}

template <int CTRL> __device__ __forceinline__ float dpp_f(float v) { return __builtin_bit_cast(float, __builtin_amdgcn_update_dpp(0, __builtin_bit_cast(int, v), CTRL, 0xF, 0xF, false)); }
constexpr int RL_WROW = 2064, RL_WHI = 0, RL_WLO = 32 * RL_WROW, RL_TKE = 2 * 32 * RL_WROW, RL_TKW = RL_TKE + 4096;
__device__ __forceinline__ void p9_router(Frame& F) {
    const int lane = F.lane, wave = F.wave, tid = F.tid, r32 = lane & 31, hi = lane >> 5;
    LAS int* tke = (LAS int*)(F.lds + RL_TKE); LAS float* tkw = (LAS float*)(F.lds + RL_TKW);
    const float* w_router = F.in[15]; const float* b_router = F.in[16]; const float* g_ffn = F.in[14];
    for (int idx = tid; idx < DM * NEXP; idx += NWAVES * 64) { const int k = idx >> 5, e = idx & 31; const float w = w_router[idx];
        const unsigned wh = f2bf(w); const unsigned wl = f2bf(w - __builtin_bit_cast(float, wh << 16));
        *(LAS bf16_t*)(F.lds + RL_WHI + e * RL_WROW + k * 2) = (bf16_t)wh; *(LAS bf16_t*)(F.lds + RL_WLO + e * RL_WROW + k * 2) = (bf16_t)wl; }
    if (tid < 32) F.MISC[MW_LCNT + tid] = 0u;
    __syncthreads();
    bf16_t* h2 = (bf16_t*)(F.ws + WS_H);
    const GAS f32x4* gr = (const GAS f32x4*)g_ffn + lane;
    f32x4 gg[4];
#pragma unroll
    for (int j = 0; j < 4; ++j) gg[j] = gr[64 * j];
    const size_t tok0 = (size_t)F.blk * 256 + 32 * wave;
    f32x4 xnext[2][4];
#pragma unroll
    for (int tk = 0; tk < 2; ++tk) { const GAS f32x4* xr = (const GAS f32x4*)(F.out + (tok0 + tk) * DM) + lane;
#pragma unroll
        for (int j = 0; j < 4; ++j) xnext[tk][j] = xr[64 * j]; }
    for (int it = 0; it < 16; ++it) {
        f32x4 hn[2][4];
#pragma unroll
        for (int tk = 0; tk < 2; ++tk)
#pragma unroll
            for (int j = 0; j < 4; ++j) hn[tk][j] = xnext[tk][j];
        if (it + 1 < 16) {
#pragma unroll
            for (int tk = 0; tk < 2; ++tk) { const GAS f32x4* xr = (const GAS f32x4*)(F.out + (tok0 + 2 * it + 2 + tk) * DM) + lane;
#pragma unroll
                for (int j = 0; j < 4; ++j) xnext[tk][j] = xr[64 * j]; } }
        float s[2];
#pragma unroll
        for (int tk = 0; tk < 2; ++tk) { float a = 0.f;
#pragma unroll
            for (int j = 0; j < 4; ++j) a += (hn[tk][j].x * hn[tk][j].x + hn[tk][j].y * hn[tk][j].y) + (hn[tk][j].z * hn[tk][j].z + hn[tk][j].w * hn[tk][j].w);
            s[tk] = a; }
#pragma unroll
        for (int tk = 0; tk < 2; ++tk) { float a = s[tk];
            a += dpp_f<0xB1>(a); a += dpp_f<0x4E>(a); a += dpp_f<0x141>(a); a += dpp_f<0x128>(a);
            { const auto rr = __builtin_amdgcn_permlane16_swap(__float_as_uint(a), __float_as_uint(a), false, false); a = __uint_as_float(rr[0]) + __uint_as_float(rr[1]); }
            { const auto rr = __builtin_amdgcn_permlane32_swap(__float_as_uint(a), __float_as_uint(a), false, false); a = __uint_as_float(rr[0]) + __uint_as_float(rr[1]); }
            s[tk] = a; }
#pragma unroll
        for (int tk = 0; tk < 2; ++tk) {
            const float rstd = 1.0f / sqrtf(s[tk] * (1.f / DM) + EPS);
            GAS u32x2* o8 = (GAS u32x2*)(h2 + (tok0 + 2 * it + tk) * DM) + lane;
#pragma unroll
            for (int j = 0; j < 4; ++j) { const f32x4 v = hn[tk][j] * rstd * gg[j]; u32x2 o; o.x = pk2(v.x, v.y); o.y = pk2(v.z, v.w); o8[64 * j] = o; }
        }
    }
    asm volatile("s_waitcnt vmcnt(0)" ::: "memory");
    f32x16 acc = {};
    { const GAS bf16_t* hp = (const GAS bf16_t*)h2 + (tok0 + r32) * DM + 8 * hi;
      const LAS unsigned char* wp = F.lds + RL_WHI + r32 * RL_WROW + 16 * hi;
#pragma unroll 8
      for (int kk = 0; kk < 64; ++kk) { const bf16x8 hb = *(const GAS bf16x8*)(hp + 16 * kk);
          const bf16x8 wh = *(const LAS bf16x8*)(wp + 32 * kk), wl = *(const LAS bf16x8*)(wp + RL_WLO + 32 * kk);
          acc = MFMA32(wh, hb, acc); acc = MFMA32(wl, hb, acc); } }
    float lg[16];
#pragma unroll
    for (int r = 0; r < 16; ++r) lg[r] = acc[r] + b_router[crow(r, hi)];
    float lv[4]; int li[4];
#pragma unroll
    for (int k = 0; k < 4; ++k) { float bv = lg[0]; int br = 0;
#pragma unroll
        for (int r = 1; r < 16; ++r) { const bool g = lg[r] > bv; bv = g ? lg[r] : bv; br = g ? r : br; }
        lv[k] = bv; li[k] = crow(br, hi);
#pragma unroll
        for (int r = 0; r < 16; ++r) lg[r] = (r == br) ? -INFINITY : lg[r]; }
    float ov[4]; int oi[4];
#pragma unroll
    for (int k = 0; k < 4; ++k) { const auto rv = __builtin_amdgcn_permlane32_swap(__float_as_uint(lv[k]), __float_as_uint(lv[k]), false, false); const auto ri = __builtin_amdgcn_permlane32_swap((unsigned)li[k], (unsigned)li[k], false, false);
        ov[k] = hi ? __uint_as_float(rv[0]) : __uint_as_float(rv[1]); oi[k] = hi ? (int)ri[0] : (int)ri[1]; }
    float tv[4]; int te[4];
    { float a0 = lv[0], a1 = lv[1], a2 = lv[2], a3 = lv[3], b0 = ov[0], b1 = ov[1], b2 = ov[2], b3 = ov[3];
      int i0 = li[0], i1 = li[1], i2 = li[2], i3 = li[3], j0 = oi[0], j1 = oi[1], j2 = oi[2], j3 = oi[3];
#pragma unroll
      for (int k = 0; k < 4; ++k) { const bool ta = (a0 > b0) || (a0 == b0 && i0 < j0);
          tv[k] = ta ? a0 : b0; te[k] = ta ? i0 : j0;
          if (ta) { a0 = a1; a1 = a2; a2 = a3; a3 = -INFINITY; i0 = i1; i1 = i2; i2 = i3; i3 = 64; }
          else { b0 = b1; b1 = b2; b2 = b3; b3 = -INFINITY; j0 = j1; j1 = j2; j2 = j3; j3 = 64; } } }
    const float e1 = __expf(tv[1] - tv[0]), e2x = __expf(tv[2] - tv[0]), e3 = __expf(tv[3] - tv[0]);
    const float inv = 1.0f / (1.0f + e1 + e2x + e3);
    if (hi == 0) { const int tl = 32 * wave + r32;
        *(LAS int*)(tke + tl * 4 + 0) = te[0]; tke[tl * 4 + 1] = te[1]; tke[tl * 4 + 2] = te[2]; tke[tl * 4 + 3] = te[3];
        tkw[tl * 4 + 0] = inv; tkw[tl * 4 + 1] = e1 * inv; tkw[tl * 4 + 2] = e2x * inv; tkw[tl * 4 + 3] = e3 * inv;
#pragma unroll
        for (int k = 0; k < 4; ++k) __hip_atomic_fetch_add((LAS unsigned*)F.MISC + MW_LCNT + te[k], 1u, __ATOMIC_RELAXED, __HIP_MEMORY_SCOPE_WORKGROUP); }
    __syncthreads();
    if (tid < 32) ((int*)(F.ws + WS_BLKCNT))[F.blk * 32 + tid] = (int)F.MISC[MW_LCNT + tid];
}
__device__ __forceinline__ void p10_assign(Frame& F) {
    const int tid = F.tid;
    const int* blkcnt = (const int*)(F.ws + WS_BLKCNT);
    LAS int* part = (LAS int*)(F.lds);
    LAS int* tke = (LAS int*)(F.lds + RL_TKE); LAS float* tkw = (LAS float*)(F.lds + RL_TKW);
    { const int e = tid & 31, p = tid >> 5; int tot = 0, bef = 0;
      for (int j = 0; j < 16; ++j) { const int bl = p * 16 + j; const int c = blkcnt[bl * 32 + e]; tot += c; bef += (bl < F.blk) ? c : 0; }
      part[p * 32 + e] = tot; part[512 + p * 32 + e] = bef; }
    __syncthreads();
    if (tid < 32) { int tot = 0, bef = 0;
        for (int p = 0; p < 16; ++p) { tot += part[p * 32 + tid]; bef += part[512 + p * 32 + tid]; }
        part[1024 + tid] = tot; F.MISC[MW_BEFORE + tid] = (unsigned)bef; F.MISC[MW_LCNT + tid] = 0u; }
    __syncthreads();
    if (tid == 0) { int ps = 0;
        for (int e = 0; e < 32; ++e) { F.MISC[MW_PSTART + e] = (unsigned)ps; F.MISC[MW_TSTART + e] = (unsigned)(ps >> 8); ps += (part[1024 + e] + 255) & ~255; }
        F.MISC[MW_PSTART + 32] = (unsigned)ps; F.MISC[MW_TSTART + 32] = (unsigned)(ps >> 8); }
    __syncthreads();
    int* slot_tok = (int*)(F.ws + WS_SLOT_TOK); float* slot_w = (float*)(F.ws + WS_SLOT_W);
    for (int idx = tid; idx < 1024; idx += NWAVES * 64) {
        const int e = tke[idx]; const float w = tkw[idx];
        const unsigned r = __hip_atomic_fetch_add((LAS unsigned*)F.MISC + MW_LCNT + e, 1u, __ATOMIC_RELAXED, __HIP_MEMORY_SCOPE_WORKGROUP);
        const unsigned pos = F.MISC[MW_PSTART + e] + F.MISC[MW_BEFORE + e] + r;
        slot_tok[pos] = F.blk * 256 + (idx >> 2); slot_w[pos] = w;
    }
}

#ifndef MK_ONE_LAUNCH
#define MK_ONE_LAUNCH 1
#endif
constexpr int N_PHASES = 13;
struct Args { const float* in[21]; float* out; unsigned char* ws; int ph_lo, ph_hi; };
static_assert(sizeof(Args) == 21 * 8 + 8 + 8 + 8, "no padding");

__global__ void __launch_bounds__(NWAVES * 64, 2) fwd_kernel(Args args) {
    extern __shared__ __attribute__((aligned(16))) unsigned char lds[];
    Frame F;
    F.lds = (LAS unsigned char*)lds;
    F.MISC = (volatile LAS unsigned*)(F.lds + MISC_OFF);
    F.tid = threadIdx.x; F.lane = F.tid & 63; F.wave = __builtin_amdgcn_readfirstlane(F.tid >> 6);
    F.G = gridDim.x; F.blk = blockIdx.x;
    F.ws = args.ws; F.out = args.out; F.ctl = (gu32*)(args.ws + WS_CTL);
#pragma unroll
    for (int i = 0; i < 21; ++i) F.in[i] = args.in[i];
    for (int u = F.tid; u < (LDS_BYTES - MISC_OFF) / 4; u += NWAVES * 64) ((LAS unsigned*)(F.lds + MISC_OFF))[u] = 0u;
    __syncthreads();
    const int lo = args.ph_lo, hi = args.ph_hi;
    XcdBarrier bar; bar.bar = (unsigned*)(F.ctl + CW_BAR); bar.x = 0; bar.st = nullptr;
    if (hi - lo > 1) bar = xcd_barrier_post((unsigned*)(F.ctl + CW_BAR), F.MISC + MW_BAR);
#ifndef STAG
#define STAG 0
#endif
#ifndef PH_MASK
#define PH_MASK 0x1fff
#endif
#define IN(k) (((PH_MASK >> (k)) & 1) && lo <= (k) && (k) < hi)
#ifndef REP_MASK
#define REP_MASK 0
#endif
#define NREP(k) (1 + ((REP_MASK >> (k)) & 1))
#define SEAM(k) do { if (IN(k) && IN((k) + 1)) xcd_barrier(bar); } while (0)
    unsigned char* ws = args.ws;
    bf16_t* proj = (bf16_t*)(ws + WS_P);

    if (IN(0)) for (int rep = 0; rep < NREP(0); ++rep) { if (rep) xcd_barrier(bar); p0_prologue(F); } SEAM(0);

    if (IN(1)) {
#ifdef PROBE_P1
        { pg8::DenseSched S; S.init(ws + WS_H, ws + WS_WIN, NTOK, PW, DM, F.G, F.blk); S.amask = PROBE_P1;
          pg8::EpiBf16<0> E{(bf16_t*)(ws + WS_END), PW, nullptr, 1023};
          pg8::gemm_phase<pg8::EpiBf16<0>, pg8::DenseSched, true>(F.lds, DM, S, E); }
        xcd_barrier(bar);
#endif
        { pg8::DenseSched S; S.init(ws + WS_H, ws + WS_WIN, NTOK, PW, DM, F.G, F.blk);
          pg8::EpiBf16<0> E{proj, PW, nullptr};
          pg8::gemm_phase<pg8::EpiBf16<0>, pg8::DenseSched, true>(F.lds, DM, S, E); }
        { pg8::DenseSched S; S.init(ws + WS_MEMN, ws + WS_WMKV, NMEM, DM, DM, F.G, F.blk);
          pg8::EpiBf16<0> E{(bf16_t*)(ws + WS_MKV), DM, nullptr};
          pg8::gemm_phase<pg8::EpiBf16<0>, pg8::DenseSched, true>(F.lds, DM, S, E); }
    } SEAM(1);

    if (IN(2)) { if (REP_MASK & 4) { p2_prep(F, true); xcd_barrier(bar); } p2_prep(F); } SEAM(2);

    if (IN(3)) {
        bf16_t* osb = (bf16_t*)(ws + WS_O); bf16_t* odsa = osb + (size_t)NTOK * 512; bf16_t* omem = odsa + (size_t)NTOK * 512;
#ifndef REP_DSA
#define REP_DSA 1
#endif
#ifndef REP_SB
#define REP_SB 1
#endif
#ifndef REP_MEM
#define REP_MEM 1
#endif
#ifndef NO_DSA
        for (int rep = 0; rep < REP_DSA; ++rep)
        for (int i = 0; i < 4; ++i) { const int p = 2 * F.blk + (i >> 1), b = p >> 4, cc = p & 15, c = (i & 1) ? 31 - cc : cc; dsa_unit(proj, odsa, (unsigned*)F.out + (size_t)F.blk * 131072, b, c, F.lds, F.tid); }
#endif
        const int gw = F.blk * NWAVES + F.wave, NGW = F.G * NWAVES;
#ifndef NO_SB
        for (int rep = 0; rep < REP_SB; ++rep)
        for (int it = gw; it < NB * 8 * 64; it += NGW) { const int qblk = 63 - (it >> 8), bh = it & 255; sb_item(proj, osb, bh >> 3, bh & 7, qblk, F.lds + F.wave * 4096, F.lane); }
#endif
#ifndef NO_MEM
        for (int rep = 0; rep < REP_MEM; ++rep) {
            __syncthreads();
            for (int u = F.blk; u < NB * 4 * 2; u += F.G) mem_unit(proj, (const bf16_t*)(ws + WS_MKV), omem, u >> 3, (u >> 1) & 3, u & 1, F.lds, F.tid);
        }
#endif
    } SEAM(3);

    if (IN(4)) {
        pg8::DenseSched S; S.init(ws + WS_H, ws + WS_WG, NTOK, 3 * DM, DM, F.G, F.blk);
        pg8::EpiBf16<2> E{proj, PW, F.in[11]};
        pg8::gemm_phase<pg8::EpiBf16<2>, pg8::DenseSched, true>(F.lds, DM, S, E);
    } SEAM(4);

    if (IN(5)) { pg8::MergeSched S; S.init(ws + WS_O, ws + WS_WB, NTOK, DM, F.G, F.blk);
        pg8::EpiMerge E{proj, (bf16_t*)(ws + WS_H)};
        pg8::gemm_phase<pg8::EpiMerge, pg8::MergeSched, true>(F.lds, 512, S, E); } SEAM(5);


    if (IN(8)) {
        pg8::DenseSched S; S.init(ws + WS_H, ws + WS_WO, NTOK, DM, DM, F.G, F.blk); S.stag = STAG;
        pg8::EpiResid E{F.in[0], F.out};
        pg8::gemm_phase<pg8::EpiResid, pg8::DenseSched, true>(F.lds, DM, S, E);
    } SEAM(8);

    if (IN(9)) for (int rep = 0; rep < NREP(9); ++rep) { if (rep) xcd_barrier(bar); p9_router(F); } SEAM(9);
    if (IN(10)) for (int rep = 0; rep < NREP(10); ++rep) { if (rep) xcd_barrier(bar); p10_assign(F); } SEAM(10);

    if (IN(11)) for (int rep = 0; rep < NREP(11); ++rep) {  if (rep) xcd_barrier(bar);
        pg8::MoeSched S{(const char*)(ws + WS_H), (const char*)(ws + WS_WEI), (const int*)(ws + WS_SLOT_TOK), F.MISC + MW_TSTART, DM, 2048, 8, F.blk};
        pg8::EpiSwiglu E{(bf16_t*)(ws + WS_P), F.in[18]};
        pg8::gemm_phase<pg8::EpiSwiglu, pg8::MoeSched, true>(F.lds, DM, S, E);
    } SEAM(11);

    if (IN(12)) {
        pg8::MoeSched S{(const char*)(ws + WS_P), (const char*)(ws + WS_WEO), nullptr, F.MISC + MW_TSTART, DM, DM, 4, F.blk};
        pg8::EpiScatter E{F.out, (const int*)(ws + WS_SLOT_TOK), (const float*)(ws + WS_SLOT_W), F.in[20], F.lds};
        pg8::gemm_phase<pg8::EpiScatter, pg8::MoeSched, true>(F.lds, DM, S, E);
    }
#undef IN
#undef SEAM
}

extern "C" void kernel_launch(void* const* d_in, const int* in_sizes, int n_in, void* d_out, int out_size, void* d_ws, size_t ws_size, hipStream_t stream) {
    static int grid = 0;
    if (grid == 0) {
        if (n_in != 21 || in_sizes[0] != NTOK * DM || out_size != NTOK * DM || ws_size < WS_END) {
            fprintf(stderr, "kernel_launch: unexpected shapes: n_in %d in0 %d out %d ws %zu (need >= %zu); nothing launched\n", n_in, n_in > 0 ? in_sizes[0] : -1, out_size, ws_size, (size_t)WS_END); grid = -1; return; }
        int dev = 0, cus = 0, per_cu = 0;
        if (hipGetDevice(&dev) != hipSuccess || hipDeviceGetAttribute(&cus, hipDeviceAttributeMultiprocessorCount, dev) != hipSuccess) { fprintf(stderr, "kernel_launch: device query failed\n"); grid = -1; return; }
        if (hipFuncSetAttribute((const void*)fwd_kernel, hipFuncAttributeMaxDynamicSharedMemorySize, LDS_BYTES) != hipSuccess) { fprintf(stderr, "kernel_launch: hipFuncSetAttribute failed\n"); grid = -1; return; }
        if (hipOccupancyMaxActiveBlocksPerMultiprocessor(&per_cu, (const void*)fwd_kernel, NWAVES * 64, LDS_BYTES) != hipSuccess || per_cu < 1)
            fprintf(stderr, "kernel_launch: note: occupancy query reports %d workgroups per CU\n", per_cu);
        (void)hipGetLastError();
        grid = cus;
        if (grid != 256) { fprintf(stderr, "kernel_launch: this kernel is built for 256 CUs (got %d); nothing launched\n", grid); grid = -1; return; }
    }
    if (grid < 0) return;
    if (hipMemsetAsync((char*)d_ws + WS_CTL, 0, CTL_ZERO_BYTES, stream) != hipSuccess) { fprintf(stderr, "kernel_launch: hipMemsetAsync failed\n"); return; }
    Args a{};
    for (int i = 0; i < 21; ++i) a.in[i] = (const float*)d_in[i];
    a.out = (float*)d_out; a.ws = (unsigned char*)d_ws;
#if MK_ONE_LAUNCH
    const int cuts[2] = {0, N_PHASES}; const int nl = 1;
#else
    const int cuts[11] = {0, 1, 2, 3, 4, 5, 6, 7, 8, 9, N_PHASES}; const int nl = 10;
#endif
    for (int li = 0; li < nl; ++li) {
        a.ph_lo = cuts[li]; a.ph_hi = cuts[li + 1];
        hipLaunchKernelGGL(fwd_kernel, dim3(grid), dim3(NWAVES * 64), LDS_BYTES, stream, a);
        const hipError_t le = hipPeekAtLastError();
        if (le != hipSuccess) { fprintf(stderr, "kernel_launch: launch %d failed: %s\n", li, hipGetErrorName(le)); break; }
    }
}
```

```cpp
#include <hip/hip_runtime.h>
#include <cstdio>
#include <cstdint>

#define LAS __attribute__((address_space(3)))
#define GAS __attribute__((address_space(1)))
typedef unsigned short bf16_t;
typedef short bf16x8 __attribute__((ext_vector_type(8)));
typedef short s16x4 __attribute__((ext_vector_type(4)));
typedef short v4i16_t __attribute__((ext_vector_type(4)));
typedef float f32x2 __attribute__((ext_vector_type(2)));
typedef float f32x4 __attribute__((ext_vector_type(4)));
typedef float f32x16 __attribute__((ext_vector_type(16)));
typedef unsigned u32x2 __attribute__((ext_vector_type(2)));
typedef unsigned u32x4 __attribute__((ext_vector_type(4)));
typedef GAS unsigned gu32;

constexpr int NB = 32, SEQ = 2048, DM = 1024, NTOK = NB * SEQ;
constexpr int MEMLEN = 256, NMEM = NB * MEMLEN;
constexpr int PW = 3072;
constexpr int C_SQ = 0, C_SK = 512, C_SV = 1024, C_DQ = 1536, C_DK = 2048, C_DV = 2112, C_IQ = 2176, C_IK = 2432, C_IW = 2496, C_MQ = 2560;
constexpr int IN_W = 3012;
constexpr int NEXP = 32, TOPK = 4, DEXP = 1024;
constexpr int NSLOT = NTOK * TOPK;
constexpr int NSLOT_PAD = NSLOT + NEXP * 256;
constexpr float EPS = 1e-6f;
constexpr float LOG2E = 1.4426950408889634f;

constexpr size_t MiB = 1u << 20;
constexpr size_t WS_CTL = 0, CTL_ZERO_BYTES = 1 * MiB;
constexpr size_t WS_ROPE = 1 * MiB;
constexpr size_t WS_BLKCNT = 1 * MiB + 512 * 1024;
constexpr size_t WS_SLOT_TOK = 2 * MiB;
constexpr size_t WS_SLOT_W = 4 * MiB;
constexpr size_t WS_WIN = 8 * MiB;
constexpr size_t WS_WMKV = 14 * MiB;
constexpr size_t WS_WG = 16 * MiB;
constexpr size_t WS_WB = 22 * MiB;
constexpr size_t WS_WO = 25 * MiB;
constexpr size_t WS_WEI = 27 * MiB;
constexpr size_t WS_WEO = 155 * MiB;
constexpr size_t WS_H = 220 * MiB;
constexpr size_t WS_P = 348 * MiB;
constexpr size_t WS_O = 732 * MiB;
constexpr size_t WS_MEMN = 924 * MiB;
constexpr size_t WS_MKV = 940 * MiB;
constexpr size_t WS_END = 956 * MiB;
static_assert(WS_P + (size_t)NSLOT_PAD * DEXP * 2 <= WS_MEMN, "act overlays proj|o");
static_assert(WS_SLOT_TOK + (size_t)NSLOT_PAD * 4 <= WS_SLOT_W && WS_SLOT_W + (size_t)NSLOT_PAD * 4 <= WS_WIN, "slot tables");

constexpr int CW_BAR = 4096;

constexpr int RING_BYTES = 151552;
constexpr int MISC_OFF = RING_BYTES;
constexpr int LDS_BYTES = 155648;
constexpr int MW_BAR = 8;
constexpr int MW_LCNT = 16;
constexpr int MW_PSTART = 64;
constexpr int MW_TSTART = 128;
constexpr int MW_BEFORE = 192;
constexpr int MW_PART = 256;

__device__ __forceinline__ unsigned f2bf(float f) { unsigned u = __builtin_bit_cast(unsigned, f); return (u + 0x7fffu + ((u >> 16) & 1u)) >> 16; }
__device__ __forceinline__ unsigned pk2(float lo, float hi) { return f2bf(lo) | (f2bf(hi) << 16); }
__device__ __forceinline__ float bf2f(unsigned short b) { return __builtin_bit_cast(float, (unsigned)b << 16); }
__device__ __forceinline__ float bflo(unsigned w) { return __builtin_bit_cast(float, w << 16); }
__device__ __forceinline__ float bfhi(unsigned w) { return __builtin_bit_cast(float, w & 0xffff0000u); }
__device__ __forceinline__ unsigned cvt_pk_bf16(float lo, float hi) { unsigned r; asm volatile("v_cvt_pk_bf16_f32 %0, %1, %2" : "=v"(r) : "v"(lo), "v"(hi)); return r; }
__device__ __forceinline__ int crow(int r, int hi) { return (r & 3) + 8 * (r >> 2) + 4 * hi; }
#define LDS_WAIT() asm volatile("s_waitcnt lgkmcnt(0)" ::: "memory")
#define VM_WAIT() asm volatile("s_waitcnt vmcnt(0)" ::: "memory")

namespace pg8 {
constexpr int BM = 256, BK = 64, HALF = 128, HTB = HALF * BK * 2, STAGE_BYTES = 8 * HTB;
__host__ __device__ __forceinline__ int lds_byte(int r, int c) { const int st = (r >> 4) * 2 + (c >> 5), rr = r & 15, cc = c & 31, ob = rr * 64 + cc * 2; return st * 1024 + (ob ^ (((ob >> 9) & 1) << 5)); }
__host__ __device__ __forceinline__ void stage_rc(int b, int& R, int& C) { const int st = b / 1024, sb = b % 1024, swz = sb ^ (((sb >> 9) & 1) << 5); R = (st >> 1) * 16 + swz / 64; C = (st & 1) * 32 + (swz % 64) / 2; }
__host__ __device__ __forceinline__ int perm32(int rho) { const int n = rho >> 4, i = rho & 15; return 8 * (i >> 2) + 4 * n + (i & 3); }

struct Unit { int pm, pn, e; };

template <class Epi, class Sched, bool ALIGN_EPI>
__device__ __forceinline__ void gemm_phase(LAS unsigned char* lds, const int K, const Sched& S, const Epi& E) {
    int tid = threadIdx.x; asm volatile("" : "+v"(tid));
    const int wid = __builtin_amdgcn_readfirstlane(tid >> 6), lane = tid & 63, wr = wid >> 2, wc = wid & 3, fr = lane & 15, fq = lane >> 4;
    const int nt = K / BK;
    int Rr[2], Cc[2]; unsigned voffB[2];
#pragma unroll
    for (int i = 0; i < 2; ++i) { int R, C; stage_rc(tid * 16 + i * 8192, R, C); Rr[i] = R; Cc[i] = C; const int Rb = Epi::PERM ? ((R & ~31) + perm32(R & 31)) : R; voffB[i] = (unsigned)(Rb * K + C) * 2u; }
    const size_t kstep = (size_t)(BK * 2);
    const size_t hstepB = (size_t)HALF * K * 2;
    const unsigned ldsw = (unsigned)wid * 1024u;
    const int aoff = lds_byte(wr * 64 + fr, fq * 8), boff = lds_byte(wc * 32 + fr, fq * 8);
#define PG8_SA(b, h) (((b) * 2 + (h)) * HTB)
#define PG8_SB(b, h) ((4 + (b) * 2 + (h)) * HTB)
#define PG8_STAGE(bufoff, gbase, voff) do { _Pragma("unroll") for (int _i = 0; _i < 2; ++_i) \
        __builtin_amdgcn_global_load_lds((const unsigned*)((const char*)(gbase) + (voff)[_i]), (LAS unsigned*)(lds + (bufoff) + ldsw + _i * 8192), 16, 0, 0); } while (0)
#define PG8_LDA(dst, b, h) do { _Pragma("unroll") for (int m = 0; m < 4; ++m) _Pragma("unroll") for (int k = 0; k < 2; ++k) dst[m][k] = *(const LAS bf16x8*)(lds + PG8_SA(b, h) + aoff + m * 2048 + k * 1024); } while (0)
#define PG8_LDB(dst, b, h) do { _Pragma("unroll") for (int n = 0; n < 2; ++n) _Pragma("unroll") for (int k = 0; k < 2; ++k) dst[n][k] = *(const LAS bf16x8*)(lds + PG8_SB(b, h) + boff + n * 2048 + k * 1024); } while (0)
#define PG8_MMA(ai, bj, At, Bt) do { __builtin_amdgcn_s_setprio(1); _Pragma("unroll") for (int m = 0; m < 4; ++m) _Pragma("unroll") for (int n = 0; n < 2; ++n) _Pragma("unroll") for (int k = 0; k < 2; ++k) \
        acc[ai][bj][m][n] = __builtin_amdgcn_mfma_f32_16x16x32_bf16(Bt[n][k], At[m][k], acc[ai][bj][m][n], 0, 0, 0); __builtin_amdgcn_s_setprio(0); } while (0)
#define PG8_WAIT_V(n) asm volatile("s_waitcnt vmcnt(" #n ")" ::: "memory")
#define PG8_WAIT_L(n) asm volatile("s_waitcnt lgkmcnt(" #n ")" ::: "memory")
#define PG8_BAR __builtin_amdgcn_s_barrier()
#define PG8_SCHED __builtin_amdgcn_sched_barrier(0)
    Unit cur, nxt; int ui = 0;
    if (!S.next(0, cur)) return;
    { const int ns = S.stagger();
      for (int q = 0; q < ns; ++q) __builtin_amdgcn_s_sleep(4); }
    f32x4 acc[2][2][4][2];
#pragma unroll
    for (int a = 0; a < 2; ++a)
#pragma unroll
        for (int b = 0; b < 2; ++b)
#pragma unroll
            for (int m = 0; m < 4; ++m)
#pragma unroll
                for (int n = 0; n < 2; ++n) acc[a][b][m][n] = (f32x4){0.f, 0.f, 0.f, 0.f};
    bf16x8 At[4][2], B0[2][2], B1[2][2];
    const char* Ab = S.a_base();
    unsigned ca0[2], ca1[2], na0[2], na1[2];
#pragma unroll
    for (int i = 0; i < 2; ++i) { ca0[i] = S.a_off(cur, Rr[i], Cc[i]); ca1[i] = S.a_off(cur, HALF + Rr[i], Cc[i]); }
    const char* cB = S.b_tile(cur);
    PG8_STAGE(PG8_SB(0, 0), cB, voffB); PG8_STAGE(PG8_SB(0, 1), cB + hstepB, voffB); PG8_STAGE(PG8_SA(0, 0), Ab, ca0); PG8_STAGE(PG8_SA(0, 1), Ab, ca1);
    if (wr == 1) PG8_BAR;
    PG8_WAIT_V(2); PG8_BAR;
    PG8_STAGE(PG8_SB(1, 0), cB + kstep, voffB); PG8_STAGE(PG8_SA(1, 0), Ab + kstep, ca0); PG8_STAGE(PG8_SB(1, 1), cB + hstepB + kstep, voffB);
    PG8_WAIT_V(6); PG8_BAR;
    for (;;) {
        typename Epi::Pre pre = E.preload(cur, wr, wc, fr, fq);
        const bool has_next = S.next(ui + 1, nxt);
        const char* nB = cB;
#pragma unroll
        for (int i = 0; i < 2; ++i) { na0[i] = ca0[i]; na1[i] = ca1[i]; }
        if (has_next) { nB = S.b_tile(nxt);
#pragma unroll
            for (int i = 0; i < 2; ++i) { int R, C; stage_rc(tid * 16 + i * 8192, R, C);
                na0[i] = S.a_off(nxt, R, C); na1[i] = S.a_off(nxt, HALF + R, C); } }
        if constexpr (Epi::DRAIN_TOP) { PG8_WAIT_V(0); }
        for (int t = 0; t < nt; t += 2) {
            const bool last = (t == nt - 2);
            const char* a1 = Ab + (size_t)(t + 1) * kstep;
            const char* a2 = last ? Ab : Ab + (size_t)(t + 2) * kstep; const char* b2 = last ? nB : cB + (size_t)(t + 2) * kstep;
            const char* a3 = a2 + kstep; const char* b3 = b2 + kstep;
            unsigned o20[2], o21[2];
#pragma unroll
            for (int i = 0; i < 2; ++i) { o20[i] = last ? na0[i] : ca0[i]; o21[i] = last ? na1[i] : ca1[i]; }
            PG8_LDB(B0, 0, 0); PG8_LDB(B1, 0, 1); PG8_SCHED; PG8_LDA(At, 0, 0); PG8_STAGE(PG8_SA(1, 1), a1, ca1);
            PG8_WAIT_V(8); PG8_WAIT_L(0); PG8_BAR; PG8_MMA(0, 0, At, B0); PG8_MMA(0, 1, At, B1); PG8_BAR; PG8_SCHED;
            PG8_LDA(At, 0, 1); PG8_STAGE(PG8_SB(0, 0), b2, voffB); PG8_STAGE(PG8_SB(0, 1), b2 + hstepB, voffB); PG8_STAGE(PG8_SA(0, 0), a2, o20);
            PG8_WAIT_V(8); PG8_WAIT_L(0); PG8_BAR; PG8_MMA(1, 0, At, B0); PG8_MMA(1, 1, At, B1); PG8_BAR; PG8_SCHED;
            PG8_LDB(B0, 1, 0); PG8_LDB(B1, 1, 1); PG8_SCHED; PG8_LDA(At, 1, 0); PG8_STAGE(PG8_SA(0, 1), a2, o21);
            PG8_WAIT_V(8); PG8_WAIT_L(0); PG8_BAR; PG8_MMA(0, 0, At, B0); PG8_MMA(0, 1, At, B1); PG8_BAR; PG8_SCHED;
            PG8_LDA(At, 1, 1); PG8_STAGE(PG8_SB(1, 0), b3, voffB); PG8_STAGE(PG8_SB(1, 1), b3 + hstepB, voffB); PG8_STAGE(PG8_SA(1, 0), a3, o20);
            PG8_WAIT_V(8); PG8_WAIT_L(0); PG8_BAR; PG8_MMA(1, 0, At, B0); PG8_MMA(1, 1, At, B1); PG8_BAR; PG8_SCHED;
        }
        if constexpr (ALIGN_EPI) { if (wr == 0) PG8_BAR; }
        E(acc, cur, wr, wc, fr, fq, pre);
        if (!has_next) break;
#pragma unroll
        for (int a = 0; a < 2; ++a)
#pragma unroll
            for (int b = 0; b < 2; ++b)
#pragma unroll
                for (int m = 0; m < 4; ++m)
#pragma unroll
                    for (int n = 0; n < 2; ++n) acc[a][b][m][n] = (f32x4){0.f, 0.f, 0.f, 0.f};
        cur = nxt; cB = nB; ++ui;
#pragma unroll
        for (int i = 0; i < 2; ++i) { ca0[i] = na0[i]; ca1[i] = na1[i]; }
        if constexpr (ALIGN_EPI) { if (wr == 1) PG8_BAR; }
    }
    PG8_WAIT_V(0);
    if constexpr (!ALIGN_EPI) { if (wr == 0) PG8_BAR; }
    PG8_BAR;
#undef PG8_SA
#undef PG8_SB
#undef PG8_STAGE
#undef PG8_LDA
#undef PG8_LDB
#undef PG8_MMA
#undef PG8_WAIT_V
#undef PG8_WAIT_L
#undef PG8_BAR
#undef PG8_SCHED
}

struct DenseSched {
    const char* A; const char* Bt; int K, nM, nN, nwg, G, c, stag = 0, amask = -1;
    __device__ __forceinline__ void init(const void* A_, const void* Bt_, int M, int N, int K_, int G_, int c_) { A = (const char*)A_; Bt = (const char*)Bt_; K = K_; nM = M / BM; nN = N / BM; nwg = nM * nN; G = G_; c = c_; }
    __device__ __forceinline__ bool next(int i, Unit& u) const {
        const long L = (long)i * G + c; if (L >= nwg) return false;
        int wgid = (int)L; { const int q = nwg / 8, r = nwg % 8, xcd = wgid % 8, off = wgid / 8; wgid = (xcd < r ? xcd * (q + 1) : r * (q + 1) + (xcd - r) * q) + off; }
        const int nig = 8 * nN, gid = wgid / nig, fm = gid * 8, gsz = (nM - fm) < 8 ? (nM - fm) : 8;
        u.pm = fm + ((wgid % nig) % gsz); u.pn = (wgid % nig) / gsz; u.e = 0; return true;
    }
    __device__ __forceinline__ const char* a_base() const { return A; }
    __device__ __forceinline__ int stagger() const { return stag ? ((c >> 3) & 7) * (K / 55) : 0; }
    __device__ __forceinline__ unsigned a_off(const Unit& u, int row, int col) const { return (unsigned)(((size_t)((u.pm * BM + row) & amask) * K + col) * 2); }
    __device__ __forceinline__ int a_row(const Unit& u, int row) const { return (u.pm * BM + row) & amask; }
    __device__ __forceinline__ unsigned row_off(int r, int col) const { return (unsigned)(((size_t)r * K + col) * 2); }
    __device__ __forceinline__ const char* b_tile(const Unit& u) const { return Bt + (size_t)u.pn * BM * K * 2; }
};
}

namespace pg8 {
struct MoeSched {
    const char* A; const char* Bt; const int* slot_tok; volatile LAS unsigned* tstart; int K, rowsE, nN, c;
    __device__ __forceinline__ bool next(int i, Unit& u) const {
        const int x = c & 7, j = c >> 3, rpr = 32 / nN;
        const int pm = (i * 8 + x) * rpr + j / nN;
        const int T = (int)tstart[32];
        if (pm >= T) return false;
        int e = 0;
#pragma unroll 1
        for (int k = 1; k < 32; ++k) e += ((int)tstart[k] <= pm) ? 1 : 0;
        u.pm = pm; u.pn = j % nN; u.e = __builtin_amdgcn_readfirstlane(e); return true;
    }
    __device__ __forceinline__ const char* a_base() const { return A; }
    __device__ __forceinline__ int stagger() const { const int g = (c >> 3) / nN, ng = 32 / nN; (void)g; (void)ng; return 0; }
    __device__ __forceinline__ unsigned a_off(const Unit& u, int row, int col) const {
        const int pos = u.pm * BM + row;
        const int r = slot_tok ? slot_tok[pos] : pos;
        return (unsigned)(((size_t)r * K + col) * 2);
    }
    __device__ __forceinline__ int a_row(const Unit& u, int row) const { const int pos = u.pm * BM + row; return slot_tok ? ((const GAS int*)slot_tok)[pos] : pos; }
    __device__ __forceinline__ unsigned row_off(int r, int col) const { return (unsigned)(((size_t)r * K + col) * 2); }
    __device__ __forceinline__ const char* b_tile(const Unit& u) const { return Bt + ((size_t)u.e * rowsE + (size_t)u.pn * BM) * K * 2; }
};

struct MergeSched {
    const char* A; const char* Bt; int nM, nN, nwg, G, c;
    __device__ __forceinline__ void init(const void* A_, const void* Bt_, int M, int N, int G_, int c_) { A = (const char*)A_; Bt = (const char*)Bt_; nM = M / BM; nN = N / BM; nwg = nM * nN; G = G_; c = c_; }
    __device__ __forceinline__ bool next(int i, Unit& u) const {
        const int r = i / 3; const long L = (long)r * G + c; if (L >= nwg) return false;
        int wgid = (int)L; { const int q = nwg / 8, rr = nwg % 8, xcd = wgid % 8, off = wgid / 8; wgid = (xcd < rr ? xcd * (q + 1) : rr * (q + 1) + (xcd - rr) * q) + off; }
        const int nig = 8 * nN, gid = wgid / nig, fm = gid * 8, gsz = (nM - fm) < 8 ? (nM - fm) : 8;
        u.pm = fm + ((wgid % nig) % gsz); u.pn = (wgid % nig) / gsz; u.e = i - 3 * r; return true;
    }
    __device__ __forceinline__ const char* a_base() const { return A; }
    __device__ __forceinline__ int stagger() const { return 0; }
    __device__ __forceinline__ unsigned a_off(const Unit& u, int row, int col) const { return (unsigned)(((size_t)(u.pm * BM + row) * 512 + col) * 2 + (size_t)u.e * ((size_t)NTOK * 512 * 2)); }
    __device__ __forceinline__ const char* b_tile(const Unit& u) const { return Bt + ((size_t)u.e * DM + (size_t)u.pn * BM) * 512 * 2; }
};

struct NoPre {};
template <int ACT> struct EpiBf16 {
    static constexpr bool PERM = true, DRAIN_TOP = false;
    struct Pre { f32x4 bv[2][2]; };
    bf16_t* O; int ldc; const float* bias; int rowmask = -1;
    __device__ __forceinline__ Pre preload(const Unit& u, int wr, int wc, int fr, int fq) const { Pre p; const int col0 = u.pn * BM + wc * 32 + 8 * fq;
#pragma unroll
        for (int bj = 0; bj < 2; ++bj)
#pragma unroll
            for (int n = 0; n < 2; ++n) p.bv[bj][n] = (f32x4){0.f, 0.f, 0.f, 0.f};
        return p; }
    __device__ __forceinline__ void arrived(Pre& p) const { asm volatile("" : "+v"(p.bv[0][0]), "+v"(p.bv[0][1]), "+v"(p.bv[1][0]), "+v"(p.bv[1][1])); }
    __device__ __forceinline__ void operator()(const f32x4 (&acc)[2][2][4][2], const Unit& u, int wr, int wc, int fr, int fq, const Pre& pre) const {
        const int row0 = u.pm * BM + wr * 64 + fr; const int col0 = u.pn * BM + wc * 32 + 8 * fq;
        f32x4 bv[2][2];
#pragma unroll
        for (int bj = 0; bj < 2; ++bj)
#pragma unroll
            for (int n = 0; n < 2; ++n) bv[bj][n] = bias ? *(const f32x4*)(bias + col0 + bj * HALF + 4 * n) : pre.bv[bj][n];
#pragma unroll
        for (int ai = 0; ai < 2; ++ai)
#pragma unroll
            for (int m = 0; m < 4; ++m) { bf16_t* rowp = O + (size_t)((row0 + ai * HALF + m * 16) & rowmask) * ldc + col0;
#pragma unroll
                for (int bj = 0; bj < 2; ++bj) { f32x4 v0 = acc[ai][bj][m][0] + bv[bj][0], v1 = acc[ai][bj][m][1] + bv[bj][1];
                    u32x4 w; w.x = cvt_pk_bf16(v0[0], v0[1]); w.y = cvt_pk_bf16(v0[2], v0[3]); w.z = cvt_pk_bf16(v1[0], v1[1]); w.w = cvt_pk_bf16(v1[2], v1[3]);
                    *(u32x4*)(rowp + bj * HALF) = w; } }
    }
};
struct EpiMerge {
    static constexpr bool PERM = true, DRAIN_TOP = false;
    typedef NoPre Pre; __device__ __forceinline__ Pre preload(const Unit&, int, int, int, int) const { return Pre{}; }
    const bf16_t* G; bf16_t* Mg;
    __device__ __forceinline__ void operator()(const f32x4 (&acc)[2][2][4][2], const Unit& u, int wr, int wc, int fr, int fq, const Pre&) const {
        const int row0 = u.pm * BM + wr * 64 + fr; const int col0 = u.pn * BM + wc * 32 + 8 * fq;
        const int goff = u.e * DM; const bool first = (u.e == 0);
#pragma unroll
        for (int ai = 0; ai < 2; ++ai)
#pragma unroll
            for (int m = 0; m < 4; ++m) { const size_t row = (size_t)(row0 + ai * HALF + m * 16);
#pragma unroll
                for (int bj = 0; bj < 2; ++bj) {
                    const u32x4 g = *(const u32x4*)(G + row * PW + goff + col0 + bj * HALF);
                    u32x4 p = (u32x4){0u, 0u, 0u, 0u};
                    if (!first) p = *(const u32x4*)(Mg + row * DM + col0 + bj * HALF);
                    const f32x4 a0 = acc[ai][bj][m][0], a1 = acc[ai][bj][m][1];
                    u32x4 w;
#define SGM(x_) __builtin_amdgcn_rcpf(1.f + __builtin_amdgcn_exp2f(-LOG2E * (x_)))
                    w.x = cvt_pk_bf16(bflo(p.x) + SGM(bflo(g.x)) * a0[0], bfhi(p.x) + SGM(bfhi(g.x)) * a0[1]);
                    w.y = cvt_pk_bf16(bflo(p.y) + SGM(bflo(g.y)) * a0[2], bfhi(p.y) + SGM(bfhi(g.y)) * a0[3]);
                    w.z = cvt_pk_bf16(bflo(p.z) + SGM(bflo(g.z)) * a1[0], bfhi(p.z) + SGM(bfhi(g.z)) * a1[1]);
                    w.w = cvt_pk_bf16(bflo(p.w) + SGM(bflo(g.w)) * a1[2], bfhi(p.w) + SGM(bfhi(g.w)) * a1[3]);
#undef SGM
                    *(u32x4*)(Mg + row * DM + col0 + bj * HALF) = w; } }
    }
};
struct EpiResid {
    static constexpr bool PERM = false, DRAIN_TOP = false;
    typedef NoPre Pre; __device__ __forceinline__ Pre preload(const Unit&, int, int, int, int) const { return Pre{}; }
    const float* base; float* out;
    __device__ __forceinline__ void operator()(const f32x4 (&acc)[2][2][4][2], const Unit& u, int wr, int wc, int fr, int fq, const Pre&) const {
        const int row0 = u.pm * BM + wr * 64 + fr; const int col0 = u.pn * BM + wc * 32 + 4 * fq;
#pragma unroll
        for (int ai = 0; ai < 2; ++ai)
#pragma unroll
            for (int m = 0; m < 4; ++m) { const size_t off = (size_t)(row0 + ai * HALF + m * 16) * DM + col0;
#pragma unroll
                for (int bj = 0; bj < 2; ++bj)
#pragma unroll
                    for (int n = 0; n < 2; ++n) { const f32x4 b = *(const f32x4*)(base + off + bj * HALF + n * 16); *(f32x4*)(out + off + bj * HALF + n * 16) = b + acc[ai][bj][m][n]; } }
    }
};
struct EpiSwiglu {
    static constexpr bool PERM = true, DRAIN_TOP = true;
    bf16_t* act; const float* bias;
    struct Pre { f32x4 bg[2], bu[2]; };
    __device__ __forceinline__ void arrived(Pre& p) const { asm volatile("" : "+v"(p.bg[0]), "+v"(p.bg[1]), "+v"(p.bu[0]), "+v"(p.bu[1])); }
    __device__ __forceinline__ Pre preload(const Unit& u, int wr, int wc, int fr, int fq) const {
        const GAS float* be = (const GAS float*)bias + (size_t)u.e * 2048 + u.pn * HALF + wc * 32 + 8 * fq; Pre p;
#pragma unroll
        for (int n = 0; n < 2; ++n) { p.bg[n] = *(const GAS f32x4*)(be + 4 * n); p.bu[n] = *(const GAS f32x4*)(be + 1024 + 4 * n); }
        return p; }
    __device__ __forceinline__ void operator()(const f32x4 (&acc)[2][2][4][2], const Unit& u, int wr, int wc, int fr, int fq, const Pre& pre) const {
        const int row0 = u.pm * BM + wr * 64 + fr; const int col0 = u.pn * HALF + wc * 32 + 8 * fq;
        f32x4 bg[2], bu[2];
#pragma unroll
        for (int n = 0; n < 2; ++n) { bg[n] = pre.bg[n]; bu[n] = pre.bu[n]; }
#pragma unroll
        for (int ai = 0; ai < 2; ++ai)
#pragma unroll
            for (int m = 0; m < 4; ++m) { bf16_t* rowp = act + (size_t)(row0 + ai * HALF + m * 16) * DEXP + col0;
                float o[8];
#pragma unroll
                for (int n = 0; n < 2; ++n) { const f32x4 gv = acc[ai][0][m][n] + bg[n], uv = acc[ai][1][m][n] + bu[n];
#pragma unroll
                    for (int q = 0; q < 4; ++q) { const float g = fminf(gv[q], 7.0f); const float uu = fminf(fmaxf(uv[q], -7.0f), 7.0f);
                        const float sg = __builtin_amdgcn_rcpf(1.f + __builtin_amdgcn_exp2f(-1.702f * LOG2E * g));
                        o[4 * n + q] = (uu + 1.0f) * (g * sg); } }
                u32x4 w; w.x = cvt_pk_bf16(o[0], o[1]); w.y = cvt_pk_bf16(o[2], o[3]); w.z = cvt_pk_bf16(o[4], o[5]); w.w = cvt_pk_bf16(o[6], o[7]);
                *(u32x4*)rowp = w; }
    }
};
constexpr int EPI_STAGE_OFF = 131072, EPI_STAGE_WAVE = 2304;
struct EpiScatter {
    static constexpr bool PERM = false, DRAIN_TOP = false;
    typedef NoPre Pre; __device__ __forceinline__ Pre preload(const Unit&, int, int, int, int) const { return Pre{}; }
    float* out; const int* slot_tok; const float* slot_w; const float* bias; LAS unsigned char* lds;
    __device__ __forceinline__ void operator()(const f32x4 (&acc)[2][2][4][2], const Unit& u, int wr, int wc, int fr, int fq, const Pre&) const {
        const int lane = fr + 16 * fq, wid = wr * 4 + wc;
        LAS float* st = (LAS float*)(lds + EPI_STAGE_OFF + wid * EPI_STAGE_WAVE);
        const int row0 = u.pm * BM + wr * 64 + fr;
        const int lcol = lane & 31, lrow = lane >> 5;
        float bv[2];
#pragma unroll
        for (int bj = 0; bj < 2; ++bj) bv[bj] = bias[(size_t)u.e * DM + u.pn * BM + bj * HALF + wc * 32 + lcol];
#pragma unroll
        for (int ai = 0; ai < 2; ++ai)
#pragma unroll
            for (int m = 0; m < 4; ++m) { const int pos = row0 + ai * HALF + m * 16; const float w = slot_w[pos]; const int tok = slot_tok[pos];
#pragma unroll
                for (int bj = 0; bj < 2; ++bj) {
#pragma unroll
                    for (int n = 0; n < 2; ++n) *(LAS f32x4*)(st + fr * 36 + 16 * n + 4 * fq) = acc[ai][bj][m][n];
                    asm volatile("s_waitcnt lgkmcnt(0)" ::: "memory");
#pragma unroll
                    for (int i = 0; i < 8; ++i) { const int r = 2 * i + lrow; const float v = st[r * 36 + lcol];
                        const float wr_ = __shfl(w, r); const int tr_ = __shfl(tok, r);
                        if (wr_ != 0.f) unsafeAtomicAdd(out + (size_t)tr_ * DM + u.pn * BM + bj * HALF + wc * 32 + lcol, (v + bv[bj]) * wr_); }
                    asm volatile("s_waitcnt lgkmcnt(0)" ::: "memory");
                } }
    }
};
}

#define XB_TMO      128
#define XB_XCNT(j)  (256  + 64 * (j))
#define XB_XSUB(j)  (1280 + 64 * (j))
#define XB_XGEN(j)  (2304 + 64 * (j))
#define XB_TOP      3328
#define XB_TOPGEN   3392
#define XCD_BAR_WORDS 3456
#define XB_SPIN_CAP (1u << 18)

__device__ __forceinline__ unsigned xb_ld(unsigned* p)              { return __hip_atomic_load(p, __ATOMIC_RELAXED, __HIP_MEMORY_SCOPE_AGENT); }
__device__ __forceinline__ unsigned xb_add(unsigned* p, unsigned v) { return __hip_atomic_fetch_add(p, v, __ATOMIC_RELAXED, __HIP_MEMORY_SCOPE_AGENT); }
__device__ __forceinline__ unsigned xb_xcc_id() { return (unsigned)__builtin_amdgcn_s_getreg((3 << 11) | 20) & 0xFu; }
#define XB_SPIN(cond, bar) do { unsigned _sp = 0; while (cond) { __builtin_amdgcn_s_sleep(1); \
    if ((++_sp & 255u) == 0u) { if (xb_ld(&(bar)[XB_TMO])) break; if (_sp > XB_SPIN_CAP) { atomicAdd(&(bar)[XB_TMO], 1u); break; } } } } while (0)

struct XcdBarrier {
    unsigned* bar; unsigned x;
    volatile LAS unsigned* st;
};

__device__ __forceinline__ XcdBarrier xcd_barrier_post(unsigned* bar, volatile LAS unsigned* st) {
    XcdBarrier b; b.bar = bar; b.x = xb_xcc_id(); b.st = st;
    if (threadIdx.x == 0) (void)xb_add(&bar[XB_XCNT(b.x)], 1u);
    return b;
}
__device__ __forceinline__ void xcd_barrier_complete(unsigned* bar, unsigned x, unsigned& nloc, unsigned& nx) {
    const unsigned G = gridDim.x * gridDim.y * gridDim.z;
    unsigned sum, cnt, mine, sp = 0u;
    for (;;) {
        sum = 0u; cnt = 0u; mine = 0u;
#pragma unroll
        for (unsigned j = 0; j < 16; ++j) { const unsigned c = xb_ld(&bar[XB_XCNT(j)]); sum += c; cnt += (c > 0u) ? 1u : 0u; mine = (j == x) ? c : mine; }
        if (sum == G) break;
        __builtin_amdgcn_s_sleep(1);
        if ((++sp & 255u) == 0u) { if (xb_ld(&bar[XB_TMO])) break; if (sp > XB_SPIN_CAP) { atomicAdd(&bar[XB_TMO], 1u); break; } }
    }
    nloc = mine > 0u ? mine : 1u; nx = cnt > 0u ? cnt : 1u;
}

__device__ __forceinline__ void xcd_barrier(const XcdBarrier& b) {
    asm volatile("s_waitcnt vmcnt(0)" ::: "memory");
    __syncthreads();
    if (threadIdx.x == 0) {
        unsigned* bar = b.bar;
        __builtin_amdgcn_s_waitcnt(0);
        unsigned nloc = b.st[0], nx = b.st[1];
        if (nloc == 0u) { xcd_barrier_complete(bar, b.x, nloc, nx); b.st[0] = nloc; b.st[1] = nx; }
        const unsigned old = xb_add(&bar[XB_XSUB(b.x)], 1u);
        const unsigned gen = old / nloc;
        if (old + 1u == (gen + 1u) * nloc) {
            __builtin_amdgcn_fence(__ATOMIC_RELEASE, "agent");
            asm volatile("s_waitcnt vmcnt(0)" ::: "memory");
            const unsigned og = xb_add(&bar[XB_TOP], 1u);
            const unsigned tg = og / nx;
            if (og + 1u == (tg + 1u) * nx) xb_add(&bar[XB_TOPGEN], 1u);
            else XB_SPIN(xb_ld(&bar[XB_TOPGEN]) == tg, bar);
            __builtin_amdgcn_fence(__ATOMIC_ACQUIRE, "agent");
            xb_add(&bar[XB_XGEN(b.x)], 1u);
            asm volatile("s_waitcnt vmcnt(0)" ::: "memory");
        } else {
            XB_SPIN(xb_ld(&bar[XB_XGEN(b.x)]) == gen, bar);
            __builtin_amdgcn_fence(__ATOMIC_ACQUIRE, "agent");
            asm volatile("s_waitcnt vmcnt(0)" ::: "memory");
        }
    }
    __syncthreads();
}

constexpr int NWAVES = 8;
struct Frame {
    LAS unsigned char* lds;
    volatile LAS unsigned* MISC;
    gu32* ctl;
    int tid, lane, wave, G, blk;
    const float* in[21];
    float* out; unsigned char* ws;
};
__device__ __forceinline__ float wave_sum(float v) {
#pragma unroll
    for (int o = 1; o < 64; o <<= 1) v += __shfl_xor(v, o);
    return v;
}

__device__ __forceinline__ int map_src(int mode, int n) {
    if (mode == 1) return n < 2500 ? n : (n >= C_MQ ? n - (C_MQ - 2500) : -1);
    if (mode == 2) { const int pn = n >> 8, bj = (n >> 7) & 1, j = n & 127; return bj * 1024 + pn * 128 + j; }
    return n;
}
__device__ __forceinline__ void transpose_item(const float* W, int K, int Nsrc, int Ndst, bf16_t* WT, int mode, LAS float* scr, int item, int lane) {
    const int nblk = Ndst / 32, kb = item / nblk, nb = item % nblk, k0 = 64 * kb, n0 = 32 * nb;
    const int sc = map_src(mode, n0 + (lane & 31));
    const float scale = (mode == 1 && (n0 + (lane & 31)) < 512) ? 0.125f : 1.0f;
#pragma unroll
    for (int i = 0; i < 32; ++i) { const int kk = 2 * i + (lane >> 5); scr[kk * 33 + (lane & 31)] = sc >= 0 ? W[(size_t)(k0 + kk) * Nsrc + sc] * scale : 0.f; }
    LDS_WAIT(); asm volatile("" ::: "memory");
    const int c = lane & 7;
#pragma unroll
    for (int j = 0; j < 4; ++j) { const int n = (lane >> 3) + 8 * j; const LAS float* s = scr + (8 * c) * 33 + n;
        u32x4 o; o.x = pk2(s[0 * 33], s[1 * 33]); o.y = pk2(s[2 * 33], s[3 * 33]); o.z = pk2(s[4 * 33], s[5 * 33]); o.w = pk2(s[6 * 33], s[7 * 33]);
        *(GAS u32x4*)(WT + (size_t)(n0 + n) * K + k0 + 8 * c) = o; }
    LDS_WAIT(); asm volatile("" ::: "memory");
}
__device__ __forceinline__ void rms_row_to_bf16(int lane, const float* xrow, const float* g, bf16_t* orow) {
    const GAS f32x4* xr = (const GAS f32x4*)xrow + lane; const GAS f32x4* gr = (const GAS f32x4*)g + lane;
    f32x4 v[4]; float s = 0.f;
#pragma unroll
    for (int j = 0; j < 4; ++j) { v[j] = xr[64 * j]; s += (v[j].x * v[j].x + v[j].y * v[j].y) + (v[j].z * v[j].z + v[j].w * v[j].w); }
    const float rstd = 1.0f / sqrtf(wave_sum(s) * (1.f / DM) + EPS);
    GAS u32x2* o8 = (GAS u32x2*)orow + lane;
#pragma unroll
    for (int j = 0; j < 4; ++j) { const f32x4 gg = gr[64 * j]; u32x2 o; o.x = pk2(v[j].x * rstd * gg.x, v[j].y * rstd * gg.y); o.y = pk2(v[j].z * rstd * gg.z, v[j].w * rstd * gg.w); o8[64 * j] = o; }
}

__device__ __forceinline__ void rms_rows4_to_bf16(int lane, const float* x, const float* g, bf16_t* o, size_t m0, size_t stride) {
    f32x4 v[4][4]; float s[4];
#pragma unroll
    for (int r = 0; r < 4; ++r) { const GAS f32x4* xr = (const GAS f32x4*)(x + (m0 + r * stride) * DM) + lane;
#pragma unroll
        for (int j = 0; j < 4; ++j) v[r][j] = xr[64 * j]; }
    const GAS f32x4* gr = (const GAS f32x4*)g + lane;
    f32x4 gg[4];
#pragma unroll
    for (int j = 0; j < 4; ++j) gg[j] = gr[64 * j];
#pragma unroll
    for (int r = 0; r < 4; ++r) { float a = 0.f;
#pragma unroll
        for (int j = 0; j < 4; ++j) a += (v[r][j].x * v[r][j].x + v[r][j].y * v[r][j].y) + (v[r][j].z * v[r][j].z + v[r][j].w * v[r][j].w);
        s[r] = a; }
#pragma unroll
    for (int of = 1; of < 64; of <<= 1) {
#pragma unroll
        for (int r = 0; r < 4; ++r) s[r] += __shfl_xor(s[r], of); }
#pragma unroll
    for (int r = 0; r < 4; ++r) { const float rstd = 1.0f / sqrtf(s[r] * (1.f / DM) + EPS);
        GAS u32x2* o8 = (GAS u32x2*)(o + (m0 + r * stride) * DM) + lane;
#pragma unroll
        for (int j = 0; j < 4; ++j) { u32x2 w; w.x = pk2(v[r][j].x * rstd * gg[j].x, v[r][j].y * rstd * gg[j].y); w.y = pk2(v[r][j].z * rstd * gg[j].z, v[r][j].w * rstd * gg[j].w); o8[64 * j] = w; } }
}
__device__ __forceinline__ void p0_prologue(Frame& F) {
    LAS float* scr = (LAS float*)(F.lds + F.wave * 16384);
    const int gw = F.blk * NWAVES + F.wave, NGW = F.G * NWAVES, lane = F.lane;
    unsigned char* ws = F.ws;
    constexpr int I_IN = 16 * 96, I_MKV = 16 * 32, I_G = 16 * 32, I_B = 8 * 32, I_O = 16 * 32, I_EI = 16 * 64, I_EO = 16 * 32;
    constexpr int NITEMS = I_IN + I_MKV + 3 * I_G + 3 * I_B + I_O + NEXP * I_EI + NEXP * I_EO;
    for (int it = gw; it < NITEMS; it += NGW) {
        int r = it;
        if (r < I_IN) { transpose_item(F.in[3], DM, IN_W, PW, (bf16_t*)(ws + WS_WIN), 1, scr, r, lane); continue; } r -= I_IN;
        if (r < I_MKV) { transpose_item(F.in[9], DM, DM, DM, (bf16_t*)(ws + WS_WMKV), 0, scr, r, lane); continue; } r -= I_MKV;
        if (r < 3 * I_G) { const int n = r / I_G; transpose_item(F.in[10] + (size_t)n * DM * DM, DM, DM, DM, (bf16_t*)(ws + WS_WG) + (size_t)n * DM * DM, 0, scr, r % I_G, lane); continue; } r -= 3 * I_G;
        if (r < 3 * I_B) { const int n = r / I_B; transpose_item(F.in[12] + (size_t)n * 512 * DM, 512, DM, DM, (bf16_t*)(ws + WS_WB) + (size_t)n * DM * 512, 0, scr, r % I_B, lane); continue; } r -= 3 * I_B;
        if (r < I_O) { transpose_item(F.in[13], DM, DM, DM, (bf16_t*)(ws + WS_WO), 0, scr, r, lane); continue; } r -= I_O;
        if (r < NEXP * I_EI) { const int e = r / I_EI; transpose_item(F.in[17] + (size_t)e * DM * 2048, DM, 2048, 2048, (bf16_t*)(ws + WS_WEI) + (size_t)e * 2048 * DM, 2, scr, r % I_EI, lane); continue; } r -= NEXP * I_EI;
        { const int e = r / I_EO; transpose_item(F.in[19] + (size_t)e * DM * DM, DM, DM, DM, (bf16_t*)(ws + WS_WEO) + (size_t)e * DM * DM, 0, scr, r % I_EO, lane); }
    }
    { f32x2* tab = (f32x2*)(ws + WS_ROPE);
      for (int idx = (F.blk * NWAVES * 64) + F.tid; idx < SEQ * 32; idx += F.G * NWAVES * 64) {
          const int s = idx >> 5, i = idx & 31;
          const float inv = exp2f(-(float)i * (13.287712379549449f / 32.0f));
          const float ang = (float)s * inv;
          const double rev = (double)ang * 0.15915494309189535;
          const float fr = (float)(rev - __builtin_rint(rev));
          tab[idx] = (f32x2){__builtin_amdgcn_cosf(fr), __builtin_amdgcn_sinf(fr)}; } }
    for (int m = gw; m < NTOK; m += 4 * NGW) rms_rows4_to_bf16(lane, F.in[0], F.in[2], (bf16_t*)(ws + WS_H), (size_t)m, (size_t)NGW);
    for (int m = gw; m < NMEM; m += 4 * NGW) rms_rows4_to_bf16(lane, F.in[1], F.in[8], (bf16_t*)(ws + WS_MEMN), (size_t)m, (size_t)NGW);
    { int* st = (int*)(ws + WS_SLOT_TOK); float* sw = (float*)(ws + WS_SLOT_W);
      for (int i = F.blk * NWAVES * 64 + F.tid; i < NSLOT_PAD; i += F.G * NWAVES * 64) { st[i] = 0; sw[i] = 0.f; } }
}

template <int CTRL> __device__ __forceinline__ float dppf(float v) { return __builtin_bit_cast(float, __builtin_amdgcn_update_dpp(0, __builtin_bit_cast(int, v), CTRL, 0xF, 0xF, false)); }
__device__ __forceinline__ float lx1(float v) { return dppf<0xB1>(v); }
__device__ __forceinline__ float lx2(float v) { return dppf<0x4E>(v); }
__device__ __forceinline__ float lx4(float v) { return dppf<0x1B>(dppf<0x141>(v)); }
__device__ __forceinline__ float lx8(float v) { return dppf<0x128>(v); }
__device__ __forceinline__ void un8(const u32x4 w, float (&v)[8]) { v[0] = bflo(w.x); v[1] = bfhi(w.x); v[2] = bflo(w.y); v[3] = bfhi(w.y); v[4] = bflo(w.z); v[5] = bfhi(w.z); v[6] = bflo(w.w); v[7] = bfhi(w.w); }
__device__ __forceinline__ u32x4 pk8(const float (&v)[8]) { u32x4 w; w.x = pk2(v[0], v[1]); w.y = pk2(v[2], v[3]); w.z = pk2(v[4], v[5]); w.w = pk2(v[6], v[7]); return w; }
__device__ __forceinline__ void rope8(float (&v)[8], const f32x2 (&cs)[8], bool up) {
#pragma unroll
    for (int j = 0; j < 8; ++j) { const float other = lx4(v[j]); v[j] = up ? (other * cs[j].y + v[j] * cs[j].x) : (v[j] * cs[j].x - other * cs[j].y); }
}
__device__ __forceinline__ void p2_prep(Frame& F, const bool dummy = false) {
    const int gw = F.blk * NWAVES + F.wave, NGW = F.G * NWAVES, lane = F.lane;
    bf16_t* proj = (bf16_t*)(F.ws + WS_P);
    bf16_t* projw = dummy ? (bf16_t*)(F.ws + WS_END) : proj;
    const int wmask = dummy ? 8191 : 0x7fffffff;
    const f32x2* tab = (const f32x2*)(F.ws + WS_ROPE);
    float gqd[8], gkd[8], gqm[8];
#pragma unroll
    for (int j = 0; j < 8; ++j) { gqd[j] = F.in[4][8 * (lane & 7) + j] * (0.125f * LOG2E); gkd[j] = F.in[5][8 * (lane & 7) + j]; gqm[j] = F.in[6][8 * (lane & 15) + j] * (0.08838834764831845f * LOG2E); }
    const bool up = (lane & 4) != 0; const int i0 = (lane & 3) * 8;
    for (int m0 = gw; m0 < NTOK; m0 += 2 * NGW) {
        u32x4 raw[2][5]; f32x2 cs[2][8];
#pragma unroll
        for (int t = 0; t < 2; ++t) { const GAS bf16_t* row = (const GAS bf16_t*)proj + (size_t)(m0 + t * NGW) * PW;
            raw[t][0] = *(const GAS u32x4*)(row + C_DQ + 8 * lane); raw[t][1] = *(const GAS u32x4*)(row + C_DK + 8 * (lane & 7)); raw[t][2] = *(const GAS u32x4*)(row + C_IQ + 8 * (lane & 31));
            raw[t][3] = *(const GAS u32x4*)(row + C_IK + 8 * (lane & 7)); raw[t][4] = *(const GAS u32x4*)(row + C_MQ + 8 * lane);
            const GAS f32x2* tr = (const GAS f32x2*)tab + (size_t)((m0 + t * NGW) & (SEQ - 1)) * 32 + i0;
#pragma unroll
            for (int j = 0; j < 8; ++j) cs[t][j] = tr[j]; }
#pragma unroll
        for (int t = 0; t < 2; ++t) {
            GAS bf16_t* roww = (GAS bf16_t*)projw + (size_t)((m0 + t * NGW) & wmask) * PW;
            float v[8];
            { un8(raw[t][0], v); float ss = 0.f;
#pragma unroll
              for (int j = 0; j < 8; ++j) ss += v[j] * v[j];
              ss += lx1(ss); ss += lx2(ss); ss += lx4(ss);
              const float rstd = 1.0f / sqrtf(ss * (1.f / 64.f) + EPS);
#pragma unroll
              for (int j = 0; j < 8; ++j) v[j] = v[j] * rstd * gqd[j];
              rope8(v, cs[t], up);
              *(GAS u32x4*)(roww + C_DQ + 8 * lane) = pk8(v); }
            { un8(raw[t][1], v); float ss = 0.f;
#pragma unroll
              for (int j = 0; j < 8; ++j) ss += v[j] * v[j];
              ss += lx1(ss); ss += lx2(ss); ss += lx4(ss);
              const float rstd = 1.0f / sqrtf(ss * (1.f / 64.f) + EPS);
#pragma unroll
              for (int j = 0; j < 8; ++j) v[j] = v[j] * rstd * gkd[j];
              rope8(v, cs[t], up);
              if (lane < 8) *(GAS u32x4*)(roww + C_DK + 8 * lane) = pk8(v); }
            { un8(raw[t][2], v); rope8(v, cs[t], up); if (lane < 32) *(GAS u32x4*)(roww + C_IQ + 8 * lane) = pk8(v); }
            { un8(raw[t][3], v); rope8(v, cs[t], up); if (lane < 8) *(GAS u32x4*)(roww + C_IK + 8 * lane) = pk8(v); }
            { un8(raw[t][4], v); float ss = 0.f;
#pragma unroll
              for (int j = 0; j < 8; ++j) ss += v[j] * v[j];
              ss += lx1(ss); ss += lx2(ss); ss += lx4(ss); ss += lx8(ss);
              const float rstd = 1.0f / sqrtf(ss * (1.f / 128.f) + EPS);
#pragma unroll
              for (int j = 0; j < 8; ++j) v[j] = v[j] * rstd * gqm[j];
              *(GAS u32x4*)(roww + C_MQ + 8 * lane) = pk8(v); }
        }
    }
    bf16_t* mkv = (bf16_t*)(F.ws + WS_MKV);
    if (!dummy) for (int m = gw; m < NMEM; m += NGW) {
        GAS bf16_t* row = (GAS bf16_t*)mkv + (size_t)m * DM; float v[8];
        un8(*(const GAS u32x4*)(row + 8 * lane), v); float ss = 0.f;
#pragma unroll
        for (int j = 0; j < 8; ++j) ss += v[j] * v[j];
        ss += lx1(ss); ss += lx2(ss); ss += lx4(ss); ss += lx8(ss);
        const float rstd = 1.0f / sqrtf(ss * (1.f / 128.f) + EPS);
#pragma unroll
        for (int j = 0; j < 8; ++j) v[j] = v[j] * rstd * F.in[7][8 * (lane & 15) + j];
        *(GAS u32x4*)(row + 8 * lane) = pk8(v);
    }
}

#define MFMA32(a, b, c) __builtin_amdgcn_mfma_f32_32x32x16_bf16((a), (b), (c), 0, 0, 0)
typedef LAS const unsigned char* lds_cptr;
__device__ __forceinline__ s16x4 vtr(lds_cptr p) { return __builtin_bit_cast(s16x4, __builtin_amdgcn_ds_read_tr16_b64_v4i16((LAS v4i16_t*)p)); }
__device__ __forceinline__ bf16x8 vfrag(lds_cptr vbase_lane, int off) {
    const s16x4 lo = vtr(vbase_lane + off), hi = vtr(vbase_lane + off + 512);
    return (bf16x8){lo[0], lo[1], lo[2], lo[3], hi[0], hi[1], hi[2], hi[3]};
}
__device__ __forceinline__ int vtr_lane_off(int lane) { return ((lane >> 4) & 1) * 32 + (lane & 3) * 8 + (4 * (lane >> 5) + ((lane & 15) >> 2)) * 64; }
__device__ __forceinline__ bf16x8 pack8(const float* p) {
    u32x4 w; w.x = cvt_pk_bf16(p[0], p[1]); w.y = cvt_pk_bf16(p[2], p[3]); w.z = cvt_pk_bf16(p[4], p[5]); w.w = cvt_pk_bf16(p[6], p[7]);
    return __builtin_bit_cast(bf16x8, w);
}
__device__ __forceinline__ float softplus_f(float z) { return fmaxf(z, 0.f) + __logf(1.f + __expf(-fabsf(z))); }

__device__ __forceinline__ void sb_item(const bf16_t* proj, bf16_t* osb, int b, int h, int qblk, LAS unsigned char* vlds, int lane) {
    const int r32 = lane & 31, hi = lane >> 5;
    const size_t tok0 = (size_t)b * SEQ + (size_t)qblk * 32;
    bf16x8 qr[4];
    { const bf16_t* qp = proj + (tok0 + r32) * PW + C_SQ + h * 64 + hi * 8;
#pragma unroll
      for (int kk = 0; kk < 4; ++kk) qr[kk] = *(const bf16x8*)(qp + kk * 16); }
    f32x16 o0 = {}, o1 = {}; float R = 0.f;
    const lds_cptr vrd = (lds_cptr)vlds + vtr_lane_off(lane);
    bf16x8 kfn[4]; u32x4 vvn[4];
#define SB_LOAD(kt_) do { const size_t key0_ = (size_t)b * SEQ + (size_t)(kt_) * 32; const GAS bf16_t* kp_ = (const GAS bf16_t*)proj + (key0_ + r32) * PW + C_SK + h * 64 + hi * 8; \
        _Pragma("unroll") for (int kk = 0; kk < 4; ++kk) kfn[kk] = *(const GAS bf16x8*)(kp_ + kk * 16); \
        _Pragma("unroll") for (int p = 0; p < 4; ++p) vvn[p] = *(const GAS u32x4*)((const GAS bf16_t*)proj + (key0_ + 16 * (p & 1) + (lane >> 2)) * PW + C_SV + h * 64 + (p >> 1) * 32 + (lane & 3) * 8); } while (0)
    SB_LOAD(qblk);
    for (int kt = qblk; kt >= 0; --kt) {
        bf16x8 kf[4]; u32x4 vv[4];
#pragma unroll
        for (int i = 0; i < 4; ++i) { kf[i] = kfn[i]; vv[i] = vvn[i]; }
        if (kt > 0) SB_LOAD(kt - 1);
        f32x16 s = {};
#pragma unroll
        for (int kk = 0; kk < 4; ++kk) s = MFMA32(kf[kk], qr[kk], s);
        asm volatile("" ::: "memory");
#pragma unroll
        for (int p = 0; p < 4; ++p) *(LAS u32x4*)(vlds + p * 1024 + lane * 16) = vv[p];
        const bool diag = (kt == qblk);
        float sp[16], pr[16];
#pragma unroll
        for (int r = 0; r < 16; ++r) { const bool valid = !diag || (crow(r, hi) < r32); sp[r] = valid ? softplus_f(s[r]) : 0.f; }
        float T[4], U[4];
#pragma unroll
        for (int g = 0; g < 4; ++g) { T[g] = (sp[4 * g] + sp[4 * g + 1]) + (sp[4 * g + 2] + sp[4 * g + 3]); { const auto rr = __builtin_amdgcn_permlane32_swap(__float_as_uint(T[g]), __float_as_uint(T[g]), false, false); U[g] = hi ? __uint_as_float(rr[0]) : __uint_as_float(rr[1]); } }
        float run = 0.f, above[4];
#pragma unroll
        for (int g = 3; g >= 0; --g) { above[g] = run + (hi == 0 ? U[g] : 0.f); run += T[g] + U[g]; }
#pragma unroll
        for (int g = 0; g < 4; ++g) { float c = R + above[g];
#pragma unroll
            for (int j = 3; j >= 0; --j) { const int r = 4 * g + j; c += sp[r]; const bool valid = !diag || (crow(r, hi) < r32); pr[r] = valid ? __expf(s[r] - c) : 0.f; } }
        R += run;
        const bf16x8 p0 = pack8(pr), p1 = pack8(pr + 8);
        LDS_WAIT();
        const bf16x8 v00 = vfrag(vrd, 0), v01 = vfrag(vrd, 1024), v10 = vfrag(vrd, 2048), v11 = vfrag(vrd, 3072);
        o0 = MFMA32(v00, p0, o0); o0 = MFMA32(v01, p1, o0);
        o1 = MFMA32(v10, p0, o1); o1 = MFMA32(v11, p1, o1);
        asm volatile("" ::: "memory");
        if (__all(R > 30.0f)) break;
    }
#undef SB_LOAD
    bf16_t* op = osb + (tok0 + r32) * 512 + h * 64 + 4 * hi;
#pragma unroll
    for (int g = 0; g < 4; ++g) {
        u32x2 w0, w1; w0.x = cvt_pk_bf16(o0[4 * g], o0[4 * g + 1]); w0.y = cvt_pk_bf16(o0[4 * g + 2], o0[4 * g + 3]); w1.x = cvt_pk_bf16(o1[4 * g], o1[4 * g + 1]); w1.y = cvt_pk_bf16(o1[4 * g + 2], o1[4 * g + 3]);
        *(u32x2*)(op + 8 * g) = w0; *(u32x2*)(op + 32 + 8 * g) = w1; }
}

constexpr int ML_K = 0, ML_KROW = 272, ML_V = 256 * ML_KROW, ML_END = ML_V + 65536;
__device__ __forceinline__ void mem_unit(const bf16_t* proj, const bf16_t* mkv, bf16_t* omem, int b, int h, int half, LAS unsigned char* ml, int tid) {
    const int lane = tid & 63, wid = __builtin_amdgcn_readfirstlane(tid >> 6), r32 = lane & 31, hi = lane >> 5;
    { const GAS bf16_t* src = (const GAS bf16_t*)mkv + (size_t)b * MEMLEN * DM + h * 128;
#pragma unroll
      for (int i = 0; i < 8; ++i) { const int ch = tid + 512 * i, key = ch >> 4, c16 = ch & 15, kk = key & 31;
          const u32x4 kv = *(const GAS u32x4*)(src + (size_t)key * DM + c16 * 8);
          const u32x4 vv = *(const GAS u32x4*)(src + (size_t)key * DM + 512 + c16 * 8);
          *(LAS u32x4*)(ml + ML_K + key * ML_KROW + c16 * 16) = kv;
          *(LAS u32x4*)(ml + ML_V + (key >> 5) * 8192 + ((c16 >> 2) * 2 + (kk >> 4)) * 1024 + (kk & 15) * 64 + (c16 & 3) * 16) = vv; } }
    __syncthreads();
    for (int i = 0; i < 4; ++i) {
        const int qblk = half * 32 + wid * 4 + i;
        const size_t tok0 = (size_t)b * SEQ + (size_t)qblk * 32;
        bf16x8 qr[8];
        { const GAS bf16_t* qp = (const GAS bf16_t*)proj + (tok0 + r32) * PW + C_MQ + h * 128 + hi * 8;
#pragma unroll
          for (int kk = 0; kk < 8; ++kk) qr[kk] = *(const GAS bf16x8*)(qp + kk * 16); }
        f32x16 o[4] = {{}, {}, {}, {}}; float m = -1e30f, l = 0.f;
        for (int kb = 0; kb < 8; ++kb) {
            const LAS unsigned char* krd = ml + ML_K + (32 * kb + r32) * ML_KROW + hi * 16;
            f32x16 s = {};
#pragma unroll
            for (int kk = 0; kk < 8; ++kk) { const bf16x8 kf = *(const LAS bf16x8*)(krd + kk * 32); s = MFMA32(kf, qr[kk], s); }
            float mx = s[0];
#pragma unroll
            for (int r = 1; r < 16; ++r) mx = fmaxf(mx, s[r]);
            { const auto rr = __builtin_amdgcn_permlane32_swap(__float_as_uint(mx), __float_as_uint(mx), false, false); mx = fmaxf(__uint_as_float(rr[0]), __uint_as_float(rr[1])); }
            if (__any(mx > m + 8.0f)) {
                const float mn = fmaxf(m, mx), alpha = __builtin_amdgcn_exp2f(m - mn);
                l *= alpha; m = mn;
#pragma unroll
                for (int d = 0; d < 4; ++d)
#pragma unroll
                    for (int r = 0; r < 16; ++r) o[d][r] *= alpha;
            }
            float pr[16], rs = 0.f;
#pragma unroll
            for (int r = 0; r < 16; ++r) { pr[r] = __builtin_amdgcn_exp2f(s[r] - m); rs += pr[r]; }
            l += rs;
            const bf16x8 p0 = pack8(pr), p1 = pack8(pr + 8);
            const lds_cptr vrd = (lds_cptr)ml + ML_V + kb * 8192 + vtr_lane_off(lane);
#pragma unroll
            for (int d = 0; d < 4; ++d) { const bf16x8 va = vfrag(vrd, d * 2048), vb = vfrag(vrd, d * 2048 + 1024); o[d] = MFMA32(va, p0, o[d]); o[d] = MFMA32(vb, p1, o[d]); }
        }
        { const auto rr = __builtin_amdgcn_permlane32_swap(__float_as_uint(l), __float_as_uint(l), false, false); l = __uint_as_float(rr[0]) + __uint_as_float(rr[1]); }
        const float il = 1.0f / l;
        bf16_t* op = omem + (tok0 + r32) * 512 + h * 128 + 4 * hi;
#pragma unroll
        for (int d = 0; d < 4; ++d)
#pragma unroll
            for (int g = 0; g < 4; ++g) { u32x2 w; w.x = cvt_pk_bf16(o[d][4 * g] * il, o[d][4 * g + 1] * il); w.y = cvt_pk_bf16(o[d][4 * g + 2] * il, o[d][4 * g + 3] * il); *(u32x2*)(op + 32 * d + 8 * g) = w; }
    }
    __syncthreads();
}

constexpr int DL_HIST = 0, DL_PREFIX = 66048, DL_KREM = DL_PREFIX + 256, DL_MASK = 67072, DL_VT = 73728, DL_KT = DL_VT + 2 * 16384, DL_END = DL_KT + 2 * 18432, DL_IQ = DL_VT;
constexpr int TOPK_DSA = 256;

struct IqLds { const LAS unsigned char* p; __device__ __forceinline__ bf16x8 operator()(int j) const { return *(const LAS bf16x8*)(p + j * 32); } };
template <class QF>
__device__ __forceinline__ void idx_scores(const QF& qf, const bf16x8 (&kf)[4], const float (&wq)[4], unsigned (&uk)[16]) {
    float scv[16];
#pragma unroll
    for (int hd = 0; hd < 4; ++hd) { f32x16 a = (f32x16){};
#pragma unroll
        for (int kk = 0; kk < 4; ++kk) a = MFMA32(kf[kk], qf(hd * 4 + kk), a);
#pragma unroll
        for (int r = 0; r < 16; ++r) scv[r] = (hd == 0) ? wq[0] * fmaxf(a[r], 0.f) : __builtin_fmaf(wq[hd], fmaxf(a[r], 0.f), scv[r]); }
#pragma unroll
    for (int r = 0; r < 16; ++r) {
        unsigned bits = __builtin_bit_cast(unsigned, scv[r]);
        if (bits == 0x80000000u) bits = 0u;
        uk[r] = bits ^ ((unsigned)((int)bits >> 31) | 0x80000000u);
    }
}
__device__ __forceinline__ void load_ik(const bf16_t* proj, size_t tokb, int kbase, int r32, int hi, bf16x8 (&kf)[4]) {
    int kr = kbase + r32; if (kr > SEQ - 1) kr = SEQ - 1;
    const GAS bf16_t* p = (const GAS bf16_t*)proj + (tokb + kr) * PW + C_IK + 8 * hi;
#pragma unroll
    for (int kk = 0; kk < 4; ++kk) kf[kk] = *(const GAS bf16x8*)(p + kk * 16);
}

__device__ __forceinline__ void dsa_unit(const bf16_t* proj, bf16_t* odsa, unsigned* kscr  , int b, int c, LAS unsigned char* dl, int tid) {
    const int lane = tid & 63, wid = __builtin_amdgcn_readfirstlane(tid >> 6), r32 = lane & 31, hi = lane >> 5;
    const int n = 64 * (c + 1), nsteps = (n + 127) >> 7;
    const size_t tokq0 = (size_t)b * SEQ + (size_t)c * 64, tokb = (size_t)b * SEQ;
    LAS unsigned* hist = (LAS unsigned*)(dl + DL_HIST);
    LAS unsigned* prefix = (LAS unsigned*)(dl + DL_PREFIX);
    LAS unsigned* krem = (LAS unsigned*)(dl + DL_KREM);
    LAS unsigned* mask = (LAS unsigned*)(dl + DL_MASK);
    const int kb = wid >> 1, qh = wid & 1;
    { const int row = tid >> 3, c = tid & 7;
      const GAS bf16_t* src = (const GAS bf16_t*)proj + (tokq0 + row) * PW + C_IQ + c * 32;
#pragma unroll
      for (int i = 0; i < 4; ++i) *(LAS u32x4*)(dl + DL_IQ + row * 528 + c * 64 + i * 16) = *(const GAS u32x4*)(src + i * 8); }
    const IqLds iqf{dl + DL_IQ + (32 * qh + r32) * 528 + hi * 16};
    float wq[4];
    { const u32x2 w = *(const u32x2*)(proj + (tokq0 + 32 * qh + r32) * PW + C_IW);
      wq[0] = bflo(w.x) * 0.0625f; wq[1] = bfhi(w.x) * 0.0625f; wq[2] = bflo(w.y) * 0.0625f; wq[3] = bfhi(w.y) * 0.0625f; }
#ifndef REP_SEL
#define REP_SEL 1
#endif
#ifndef REP_B2
#define REP_B2 1
#endif
    LAS unsigned* selall = (LAS unsigned*)(dl + DL_HIST);
#ifndef PROBE_NOATOM
#define PROBE_NOATOM 0
#endif
    unsigned dummy = 0u;
    for (int rep_sel = 0; rep_sel < REP_SEL; ++rep_sel) {
    if (tid < 64) { prefix[tid] = 0u; krem[tid] = (n > TOPK_DSA) ? (unsigned)TOPK_DSA : 0x7fffffffu; }
    __syncthreads();
    const int pass0 = (n > TOPK_DSA) ? 0 : 3;
    GAS u32x4* kmine = (GAS u32x4*)kscr + ((size_t)wid * 64 + lane) * 4;
#define DSA_CONSUME(uk_) do { \
        if (sel) { _Pragma("unroll") for (int r = 0; r < 16; ++r) { const bool match = (pass == 0) || (((uk_)[r] >> (shift + 8)) == pfx); \
                if (match && !(PROBE_NOATOM && rep_sel + 1 < REP_SEL)) __hip_atomic_fetch_add(hist + (32 * qh + r32) * 257 + (((uk_)[r] >> shift) & 255u), 1u, __ATOMIC_RELAXED, __HIP_MEMORY_SCOPE_WORKGROUP); else dummy ^= (uk_)[r]; } } \
        else { _Pragma("unroll") for (int r = 0; r < 16; ++r) { const unsigned k24 = (uk_)[r] >> 8; gtw |= (k24 > pfx ? 1u : 0u) << crow(r, hi); eqw |= (k24 == pfx ? 1u : 0u) << crow(r, hi); } } } while (0)
#define DSA_TIES() do { if (!sel) { \
        LAS unsigned* mk = mask + (step & 1) * 768; \
        { const auto rg = __builtin_amdgcn_permlane32_swap(gtw, gtw, false, false); gtw = rg[0] | rg[1]; const auto re = __builtin_amdgcn_permlane32_swap(eqw, eqw, false, false); eqw = re[0] | re[1]; } \
        if (hi == 0) { mk[(32 * qh + r32) * 4 + kb] = gtw; mk[256 + (32 * qh + r32) * 4 + kb] = eqw; } \
        __syncthreads(); \
        if (wid == 0) { unsigned nd = krem[lane]; \
            _Pragma("unroll") for (int k4 = 0; k4 < 4; ++k4) { const unsigned g = mk[lane * 4 + k4]; unsigned e = mk[256 + lane * 4 + k4]; unsigned sl = g; \
                if (e != 0u) { const unsigned cnt = (unsigned)__builtin_popcount(e); \
                    if (cnt <= nd) { sl |= e; nd -= cnt; } \
                    else { unsigned chosen = 0u; while (nd > 0u) { const unsigned lb = e & (0u - e); chosen |= lb; e ^= lb; --nd; } sl |= chosen; } } \
                selall[lane * 64 + step * 4 + k4] = sl; } \
            krem[lane] = nd; } } } while (0)
    for (int pass = pass0; pass < ((rep_sel + 1 < REP_SEL) ? 3 : 4); ++pass) {
        const bool sel = pass < 3;
        if (sel) { for (int i = tid; i < 64 * 257; i += 512) hist[i] = 0u; __syncthreads(); }
        const int shift = 24 - 8 * pass;
        const unsigned pfx = prefix[32 * qh + r32];
        if (pass == pass0) {
            bf16x8 kfn[4]; load_ik(proj, tokb, 32 * kb, r32, hi, kfn);
            for (int step = 0; step < nsteps; ++step) {
                const int kbase = 128 * step + 32 * kb;
                bf16x8 kf[4];
#pragma unroll
                for (int kk = 0; kk < 4; ++kk) kf[kk] = kfn[kk];
                if (step + 1 < nsteps) load_ik(proj, tokb, kbase + 128, r32, hi, kfn);
                unsigned gtw = 0u, eqw = 0u;
                if (kbase < n) {
                    unsigned uk[16];
                    idx_scores(iqf, kf, wq, uk);
                    if (pass0 == 0) {
#pragma unroll
                        for (int g = 0; g < 4; ++g) kmine[(size_t)step * 2048 + g] = (u32x4){uk[4 * g], uk[4 * g + 1], uk[4 * g + 2], uk[4 * g + 3]};
                    }
                    DSA_CONSUME(uk);
                }
                DSA_TIES();
            }
        } else {
            u32x4 ka[4], kb4[4];
#define DSA_KLOAD(dst, st_) do { _Pragma("unroll") for (int g = 0; g < 4; ++g) dst[g] = kmine[(size_t)(st_) * 2048 + g]; } while (0)
            DSA_KLOAD(ka, 0);
            if (nsteps > 1 && 128 + 32 * kb < n) DSA_KLOAD(kb4, 1);
            for (int step = 0; step < nsteps; ++step) {
                const int kbase = 128 * step + 32 * kb;
                unsigned uk[16];
#pragma unroll
                for (int g = 0; g < 4; ++g) { uk[4 * g] = ka[g].x; uk[4 * g + 1] = ka[g].y; uk[4 * g + 2] = ka[g].z; uk[4 * g + 3] = ka[g].w; }
#pragma unroll
                for (int g = 0; g < 4; ++g) ka[g] = kb4[g];
                if (step + 2 < nsteps && kbase + 256 < n) DSA_KLOAD(kb4, step + 2);
                unsigned gtw = 0u, eqw = 0u;
                if (kbase < n) DSA_CONSUME(uk);
                DSA_TIES();
            }
#undef DSA_KLOAD
        }
        if (sel) {
            __syncthreads();
#pragma unroll
            for (int qi = 0; qi < 8; ++qi) {
                const int q = 8 * wid + qi;
                const LAS unsigned* hq = hist + q * 257;
                const unsigned c0 = hq[255 - 4 * lane], c1 = hq[254 - 4 * lane], c2 = hq[253 - 4 * lane], c3 = hq[252 - 4 * lane];
                const unsigned s4 = c0 + c1 + c2 + c3;
                unsigned incl = s4;
#pragma unroll
                for (int o = 1; o < 64; o <<= 1) { const unsigned t = __shfl_up(incl, o); if (lane >= o) incl += t; }
                const unsigned excl = incl - s4, kr = krem[q];
                if (excl < kr && kr <= incl) {
                    unsigned cum = excl, bin, nk;
                    if (cum + c0 >= kr) { bin = 255 - 4 * lane; nk = kr - cum; }
                    else { cum += c0; if (cum + c1 >= kr) { bin = 254 - 4 * lane; nk = kr - cum; }
                    else { cum += c1; if (cum + c2 >= kr) { bin = 253 - 4 * lane; nk = kr - cum; }
                    else { cum += c2; bin = 252 - 4 * lane; nk = kr - cum; } } }
                    prefix[q] = (prefix[q] << 8) | bin; krem[q] = nk;
                }
            }
            __syncthreads();
        }
    }
    }
    if (dummy == 0x9e3779b9u) hist[tid] = 1u;
    const int hd = wid;
    u32x4 pk[2], pv[2];
#define DSA_LOADKV(step_) do { _Pragma("unroll") for (int i_ = 0; i_ < 2; ++i_) { const int ch_ = tid + 512 * i_; int krow_ = 128 * (step_) + (ch_ >> 3); if (krow_ > SEQ - 1) krow_ = SEQ - 1; \
        const GAS bf16_t* rp_ = (const GAS bf16_t*)proj + (tokb + krow_) * PW + (ch_ & 7) * 8; pk[i_] = *(const GAS u32x4*)(rp_ + C_DK); pv[i_] = *(const GAS u32x4*)(rp_ + C_DV); } } while (0)
#define DSA_STOREKV(buf_) do { _Pragma("unroll") for (int i_ = 0; i_ < 2; ++i_) { const int ch_ = tid + 512 * i_, key_ = ch_ >> 3, c8_ = ch_ & 7, kk_ = key_ & 31; \
        *(LAS u32x4*)(dl + DL_KT + (buf_) * 18432 + key_ * 144 + c8_ * 16) = pk[i_]; \
        *(LAS u32x4*)(dl + DL_VT + (buf_) * 16384 + (key_ >> 5) * 4096 + ((c8_ >> 2) * 2 + (kk_ >> 4)) * 1024 + (kk_ & 15) * 64 + (c8_ & 3) * 16) = pv[i_]; } } while (0)
    for (int rep_b2 = 0; rep_b2 < REP_B2; ++rep_b2)
    for (int qb = 0; qb < 2; ++qb) {
        bf16x8 qr[4];
        { const GAS bf16_t* qp = (const GAS bf16_t*)proj + (tokq0 + 32 * qb + r32) * PW + C_DQ + hd * 64 + 8 * hi;
#pragma unroll
          for (int kk = 0; kk < 4; ++kk) qr[kk] = *(const GAS bf16x8*)(qp + kk * 16); }
        f32x16 o0 = {}, o1 = {}; float mrun = -1e30f, lrun = 0.f;
        DSA_LOADKV(0);
        DSA_STOREKV(0);
        __syncthreads();
#define B2_QK(S_, k4_) do { const LAS unsigned char* krd_ = kt + (32 * (k4_) + r32) * 144 + hi * 16; S_ = (f32x16){}; \
        _Pragma("unroll") for (int kk = 0; kk < 4; ++kk) { const bf16x8 kf_ = *(const LAS bf16x8*)(krd_ + kk * 32); S_ = MFMA32(kf_, qr[kk], S_); } } while (0)
#define B2_SM_PV(S_, k4_) do { \
        const int selw_ = (int)selall[(32 * qb + r32) * 64 + step * 4 + (k4_)]; float mx_ = -INFINITY; \
        _Pragma("unroll") for (int r = 0; r < 16; ++r) { const unsigned m_ = (unsigned)__builtin_amdgcn_sbfe(selw_, crow(r, hi), 1); \
            S_[r] = __uint_as_float((__float_as_uint(S_[r]) & m_) | (0xFF800000u & ~m_)); mx_ = fmaxf(mx_, S_[r]); } \
        { const auto rr_ = __builtin_amdgcn_permlane32_swap(__float_as_uint(mx_), __float_as_uint(mx_), false, false); mx_ = fmaxf(__uint_as_float(rr_[0]), __uint_as_float(rr_[1])); } \
        if (__any(mx_ > mrun + 8.0f)) { const float mn_ = fmaxf(mrun, mx_), alpha_ = __builtin_amdgcn_exp2f(mrun - mn_); lrun *= alpha_; mrun = mn_; \
            _Pragma("unroll") for (int r = 0; r < 16; ++r) { o0[r] *= alpha_; o1[r] *= alpha_; } } \
        float pr_[16], rs_ = 0.f; \
        _Pragma("unroll") for (int r = 0; r < 16; ++r) { pr_[r] = __builtin_amdgcn_exp2f(S_[r] - mrun); rs_ += pr_[r]; } \
        lrun += rs_; \
        const bf16x8 pa_ = pack8(pr_), pb_ = pack8(pr_ + 8); \
        const lds_cptr vrd_ = (lds_cptr)vt + (k4_) * 4096 + vtr_lane_off(lane); \
        const bf16x8 v00_ = vfrag(vrd_, 0), v01_ = vfrag(vrd_, 1024), v10_ = vfrag(vrd_, 2048), v11_ = vfrag(vrd_, 3072); \
        o0 = MFMA32(v00_, pa_, o0); o0 = MFMA32(v01_, pb_, o0); o1 = MFMA32(v10_, pa_, o1); o1 = MFMA32(v11_, pb_, o1); } while (0)
        for (int step = 0; step < nsteps; ++step) {
            const int buf = step & 1;
            if (step + 1 < nsteps) DSA_LOADKV(step + 1);
            LAS unsigned char* kt = dl + DL_KT + buf * 18432;
            LAS unsigned char* vt = dl + DL_VT + buf * 16384;
            f32x16 sa, sb;
            B2_QK(sa, 0);
            B2_QK(sb, 1); B2_SM_PV(sa, 0); __builtin_amdgcn_sched_barrier(0);
            if (128 * step + 64 < n) {
                B2_QK(sa, 2); B2_SM_PV(sb, 1); __builtin_amdgcn_sched_barrier(0);
                B2_QK(sb, 3); B2_SM_PV(sa, 2); __builtin_amdgcn_sched_barrier(0);
                B2_SM_PV(sb, 3);
            } else {
                B2_SM_PV(sb, 1);
            }
            if (step + 1 < nsteps) DSA_STOREKV(buf ^ 1);
            __syncthreads();
        }
#undef B2_QK
#undef B2_SM_PV
        float l = lrun; { const auto rr = __builtin_amdgcn_permlane32_swap(__float_as_uint(l), __float_as_uint(l), false, false); l = __uint_as_float(rr[0]) + __uint_as_float(rr[1]); }
        const float il = 1.0f / l;
        bf16_t* op = odsa + (tokq0 + 32 * qb + r32) * 512 + hd * 64 + 4 * hi;
#pragma unroll
        for (int g = 0; g < 4; ++g) {
            u32x2 w0, w1; w0.x = cvt_pk_bf16(o0[4 * g] * il, o0[4 * g + 1] * il); w0.y = cvt_pk_bf16(o0[4 * g + 2] * il, o0[4 * g + 3] * il);
            w1.x = cvt_pk_bf16(o1[4 * g] * il, o1[4 * g + 1] * il); w1.y = cvt_pk_bf16(o1[4 * g + 2] * il, o1[4 * g + 3] * il);
            *(u32x2*)(op + 8 * g) = w0; *(u32x2*)(op + 32 + 8 * g) = w1; }
    }
#undef DSA_LOADKV
#undef DSA_STOREKV
#undef DSA_CONSUME
#undef DSA_TIES
    __syncthreads();
}

template <int CTRL> __device__ __forceinline__ float dpp_f(float v) { return __builtin_bit_cast(float, __builtin_amdgcn_update_dpp(0, __builtin_bit_cast(int, v), CTRL, 0xF, 0xF, false)); }
constexpr int RL_WROW = 2064, RL_WHI = 0, RL_WLO = 32 * RL_WROW, RL_TKE = 2 * 32 * RL_WROW, RL_TKW = RL_TKE + 4096;
__device__ __forceinline__ void p9_router(Frame& F) {
    const int lane = F.lane, wave = F.wave, tid = F.tid, r32 = lane & 31, hi = lane >> 5;
    LAS int* tke = (LAS int*)(F.lds + RL_TKE); LAS float* tkw = (LAS float*)(F.lds + RL_TKW);
    const float* w_router = F.in[15]; const float* b_router = F.in[16]; const float* g_ffn = F.in[14];
    for (int idx = tid; idx < DM * NEXP; idx += NWAVES * 64) { const int k = idx >> 5, e = idx & 31; const float w = w_router[idx];
        const unsigned wh = f2bf(w); const unsigned wl = f2bf(w - __builtin_bit_cast(float, wh << 16));
        *(LAS bf16_t*)(F.lds + RL_WHI + e * RL_WROW + k * 2) = (bf16_t)wh; *(LAS bf16_t*)(F.lds + RL_WLO + e * RL_WROW + k * 2) = (bf16_t)wl; }
    if (tid < 32) F.MISC[MW_LCNT + tid] = 0u;
    __syncthreads();
    bf16_t* h2 = (bf16_t*)(F.ws + WS_H);
    const GAS f32x4* gr = (const GAS f32x4*)g_ffn + lane;
    f32x4 gg[4];
#pragma unroll
    for (int j = 0; j < 4; ++j) gg[j] = gr[64 * j];
    const size_t tok0 = (size_t)F.blk * 256 + 32 * wave;
    f32x4 xnext[2][4];
#pragma unroll
    for (int tk = 0; tk < 2; ++tk) { const GAS f32x4* xr = (const GAS f32x4*)(F.out + (tok0 + tk) * DM) + lane;
#pragma unroll
        for (int j = 0; j < 4; ++j) xnext[tk][j] = xr[64 * j]; }
    for (int it = 0; it < 16; ++it) {
        f32x4 hn[2][4];
#pragma unroll
        for (int tk = 0; tk < 2; ++tk)
#pragma unroll
            for (int j = 0; j < 4; ++j) hn[tk][j] = xnext[tk][j];
        if (it + 1 < 16) {
#pragma unroll
            for (int tk = 0; tk < 2; ++tk) { const GAS f32x4* xr = (const GAS f32x4*)(F.out + (tok0 + 2 * it + 2 + tk) * DM) + lane;
#pragma unroll
                for (int j = 0; j < 4; ++j) xnext[tk][j] = xr[64 * j]; } }
        float s[2];
#pragma unroll
        for (int tk = 0; tk < 2; ++tk) { float a = 0.f;
#pragma unroll
            for (int j = 0; j < 4; ++j) a += (hn[tk][j].x * hn[tk][j].x + hn[tk][j].y * hn[tk][j].y) + (hn[tk][j].z * hn[tk][j].z + hn[tk][j].w * hn[tk][j].w);
            s[tk] = a; }
#pragma unroll
        for (int tk = 0; tk < 2; ++tk) { float a = s[tk];
            a += dpp_f<0xB1>(a); a += dpp_f<0x4E>(a); a += dpp_f<0x141>(a); a += dpp_f<0x128>(a);
            { const auto rr = __builtin_amdgcn_permlane16_swap(__float_as_uint(a), __float_as_uint(a), false, false); a = __uint_as_float(rr[0]) + __uint_as_float(rr[1]); }
            { const auto rr = __builtin_amdgcn_permlane32_swap(__float_as_uint(a), __float_as_uint(a), false, false); a = __uint_as_float(rr[0]) + __uint_as_float(rr[1]); }
            s[tk] = a; }
#pragma unroll
        for (int tk = 0; tk < 2; ++tk) {
            const float rstd = 1.0f / sqrtf(s[tk] * (1.f / DM) + EPS);
            GAS u32x2* o8 = (GAS u32x2*)(h2 + (tok0 + 2 * it + tk) * DM) + lane;
#pragma unroll
            for (int j = 0; j < 4; ++j) { const f32x4 v = hn[tk][j] * rstd * gg[j]; u32x2 o; o.x = pk2(v.x, v.y); o.y = pk2(v.z, v.w); o8[64 * j] = o; }
        }
    }
    asm volatile("s_waitcnt vmcnt(0)" ::: "memory");
    f32x16 acc = {};
    { const GAS bf16_t* hp = (const GAS bf16_t*)h2 + (tok0 + r32) * DM + 8 * hi;
      const LAS unsigned char* wp = F.lds + RL_WHI + r32 * RL_WROW + 16 * hi;
#pragma unroll 8
      for (int kk = 0; kk < 64; ++kk) { const bf16x8 hb = *(const GAS bf16x8*)(hp + 16 * kk);
          const bf16x8 wh = *(const LAS bf16x8*)(wp + 32 * kk), wl = *(const LAS bf16x8*)(wp + RL_WLO + 32 * kk);
          acc = MFMA32(wh, hb, acc); acc = MFMA32(wl, hb, acc); } }
    float lg[16];
#pragma unroll
    for (int r = 0; r < 16; ++r) lg[r] = acc[r] + b_router[crow(r, hi)];
    float lv[4]; int li[4];
#pragma unroll
    for (int k = 0; k < 4; ++k) { float bv = lg[0]; int br = 0;
#pragma unroll
        for (int r = 1; r < 16; ++r) { const bool g = lg[r] > bv; bv = g ? lg[r] : bv; br = g ? r : br; }
        lv[k] = bv; li[k] = crow(br, hi);
#pragma unroll
        for (int r = 0; r < 16; ++r) lg[r] = (r == br) ? -INFINITY : lg[r]; }
    float ov[4]; int oi[4];
#pragma unroll
    for (int k = 0; k < 4; ++k) { const auto rv = __builtin_amdgcn_permlane32_swap(__float_as_uint(lv[k]), __float_as_uint(lv[k]), false, false); const auto ri = __builtin_amdgcn_permlane32_swap((unsigned)li[k], (unsigned)li[k], false, false);
        ov[k] = hi ? __uint_as_float(rv[0]) : __uint_as_float(rv[1]); oi[k] = hi ? (int)ri[0] : (int)ri[1]; }
    float tv[4]; int te[4];
    { float a0 = lv[0], a1 = lv[1], a2 = lv[2], a3 = lv[3], b0 = ov[0], b1 = ov[1], b2 = ov[2], b3 = ov[3];
      int i0 = li[0], i1 = li[1], i2 = li[2], i3 = li[3], j0 = oi[0], j1 = oi[1], j2 = oi[2], j3 = oi[3];
#pragma unroll
      for (int k = 0; k < 4; ++k) { const bool ta = (a0 > b0) || (a0 == b0 && i0 < j0);
          tv[k] = ta ? a0 : b0; te[k] = ta ? i0 : j0;
          if (ta) { a0 = a1; a1 = a2; a2 = a3; a3 = -INFINITY; i0 = i1; i1 = i2; i2 = i3; i3 = 64; }
          else { b0 = b1; b1 = b2; b2 = b3; b3 = -INFINITY; j0 = j1; j1 = j2; j2 = j3; j3 = 64; } } }
    const float e1 = __expf(tv[1] - tv[0]), e2x = __expf(tv[2] - tv[0]), e3 = __expf(tv[3] - tv[0]);
    const float inv = 1.0f / (1.0f + e1 + e2x + e3);
    if (hi == 0) { const int tl = 32 * wave + r32;
        *(LAS int*)(tke + tl * 4 + 0) = te[0]; tke[tl * 4 + 1] = te[1]; tke[tl * 4 + 2] = te[2]; tke[tl * 4 + 3] = te[3];
        tkw[tl * 4 + 0] = inv; tkw[tl * 4 + 1] = e1 * inv; tkw[tl * 4 + 2] = e2x * inv; tkw[tl * 4 + 3] = e3 * inv;
#pragma unroll
        for (int k = 0; k < 4; ++k) __hip_atomic_fetch_add((LAS unsigned*)F.MISC + MW_LCNT + te[k], 1u, __ATOMIC_RELAXED, __HIP_MEMORY_SCOPE_WORKGROUP); }
    __syncthreads();
    if (tid < 32) ((int*)(F.ws + WS_BLKCNT))[F.blk * 32 + tid] = (int)F.MISC[MW_LCNT + tid];
}
__device__ __forceinline__ void p10_assign(Frame& F) {
    const int tid = F.tid;
    const int* blkcnt = (const int*)(F.ws + WS_BLKCNT);
    LAS int* part = (LAS int*)(F.lds);
    LAS int* tke = (LAS int*)(F.lds + RL_TKE); LAS float* tkw = (LAS float*)(F.lds + RL_TKW);
    { const int e = tid & 31, p = tid >> 5; int tot = 0, bef = 0;
      for (int j = 0; j < 16; ++j) { const int bl = p * 16 + j; const int c = blkcnt[bl * 32 + e]; tot += c; bef += (bl < F.blk) ? c : 0; }
      part[p * 32 + e] = tot; part[512 + p * 32 + e] = bef; }
    __syncthreads();
    if (tid < 32) { int tot = 0, bef = 0;
        for (int p = 0; p < 16; ++p) { tot += part[p * 32 + tid]; bef += part[512 + p * 32 + tid]; }
        part[1024 + tid] = tot; F.MISC[MW_BEFORE + tid] = (unsigned)bef; F.MISC[MW_LCNT + tid] = 0u; }
    __syncthreads();
    if (tid == 0) { int ps = 0;
        for (int e = 0; e < 32; ++e) { F.MISC[MW_PSTART + e] = (unsigned)ps; F.MISC[MW_TSTART + e] = (unsigned)(ps >> 8); ps += (part[1024 + e] + 255) & ~255; }
        F.MISC[MW_PSTART + 32] = (unsigned)ps; F.MISC[MW_TSTART + 32] = (unsigned)(ps >> 8); }
    __syncthreads();
    int* slot_tok = (int*)(F.ws + WS_SLOT_TOK); float* slot_w = (float*)(F.ws + WS_SLOT_W);
    for (int idx = tid; idx < 1024; idx += NWAVES * 64) {
        const int e = tke[idx]; const float w = tkw[idx];
        const unsigned r = __hip_atomic_fetch_add((LAS unsigned*)F.MISC + MW_LCNT + e, 1u, __ATOMIC_RELAXED, __HIP_MEMORY_SCOPE_WORKGROUP);
        const unsigned pos = F.MISC[MW_PSTART + e] + F.MISC[MW_BEFORE + e] + r;
        slot_tok[pos] = F.blk * 256 + (idx >> 2); slot_w[pos] = w;
    }
}

#ifndef MK_ONE_LAUNCH
#define MK_ONE_LAUNCH 1
#endif
constexpr int N_PHASES = 13;
struct Args { const float* in[21]; float* out; unsigned char* ws; int ph_lo, ph_hi; };
static_assert(sizeof(Args) == 21 * 8 + 8 + 8 + 8, "no padding");

__global__ void __launch_bounds__(NWAVES * 64, 2) fwd_kernel(Args args) {
    extern __shared__ __attribute__((aligned(16))) unsigned char lds[];
    Frame F;
    F.lds = (LAS unsigned char*)lds;
    F.MISC = (volatile LAS unsigned*)(F.lds + MISC_OFF);
    F.tid = threadIdx.x; F.lane = F.tid & 63; F.wave = __builtin_amdgcn_readfirstlane(F.tid >> 6);
    F.G = gridDim.x; F.blk = blockIdx.x;
    F.ws = args.ws; F.out = args.out; F.ctl = (gu32*)(args.ws + WS_CTL);
#pragma unroll
    for (int i = 0; i < 21; ++i) F.in[i] = args.in[i];
    for (int u = F.tid; u < (LDS_BYTES - MISC_OFF) / 4; u += NWAVES * 64) ((LAS unsigned*)(F.lds + MISC_OFF))[u] = 0u;
    __syncthreads();
    const int lo = args.ph_lo, hi = args.ph_hi;
    XcdBarrier bar; bar.bar = (unsigned*)(F.ctl + CW_BAR); bar.x = 0; bar.st = nullptr;
    if (hi - lo > 1) bar = xcd_barrier_post((unsigned*)(F.ctl + CW_BAR), F.MISC + MW_BAR);
#ifndef STAG
#define STAG 0
#endif
#ifndef PH_MASK
#define PH_MASK 0x1fff
#endif
#define IN(k) (((PH_MASK >> (k)) & 1) && lo <= (k) && (k) < hi)
#ifndef REP_MASK
#define REP_MASK 0
#endif
#define NREP(k) (1 + ((REP_MASK >> (k)) & 1))
#define SEAM(k) do { if (IN(k) && IN((k) + 1)) xcd_barrier(bar); } while (0)
    unsigned char* ws = args.ws;
    bf16_t* proj = (bf16_t*)(ws + WS_P);

    if (IN(0)) for (int rep = 0; rep < NREP(0); ++rep) { if (rep) xcd_barrier(bar); p0_prologue(F); } SEAM(0);

    if (IN(1)) {
#ifdef PROBE_P1
        { pg8::DenseSched S; S.init(ws + WS_H, ws + WS_WIN, NTOK, PW, DM, F.G, F.blk); S.amask = PROBE_P1;
          pg8::EpiBf16<0> E{(bf16_t*)(ws + WS_END), PW, nullptr, 1023};
          pg8::gemm_phase<pg8::EpiBf16<0>, pg8::DenseSched, true>(F.lds, DM, S, E); }
        xcd_barrier(bar);
#endif
        { pg8::DenseSched S; S.init(ws + WS_H, ws + WS_WIN, NTOK, PW, DM, F.G, F.blk);
          pg8::EpiBf16<0> E{proj, PW, nullptr};
          pg8::gemm_phase<pg8::EpiBf16<0>, pg8::DenseSched, true>(F.lds, DM, S, E); }
        { pg8::DenseSched S; S.init(ws + WS_MEMN, ws + WS_WMKV, NMEM, DM, DM, F.G, F.blk);
          pg8::EpiBf16<0> E{(bf16_t*)(ws + WS_MKV), DM, nullptr};
          pg8::gemm_phase<pg8::EpiBf16<0>, pg8::DenseSched, true>(F.lds, DM, S, E); }
    } SEAM(1);

    if (IN(2)) { if (REP_MASK & 4) { p2_prep(F, true); xcd_barrier(bar); } p2_prep(F); } SEAM(2);

    if (IN(3)) {
        bf16_t* osb = (bf16_t*)(ws + WS_O); bf16_t* odsa = osb + (size_t)NTOK * 512; bf16_t* omem = odsa + (size_t)NTOK * 512;
#ifndef REP_DSA
#define REP_DSA 1
#endif
#ifndef REP_SB
#define REP_SB 1
#endif
#ifndef REP_MEM
#define REP_MEM 1
#endif
#ifndef NO_DSA
        for (int rep = 0; rep < REP_DSA; ++rep)
        for (int i = 0; i < 4; ++i) { const int p = 2 * F.blk + (i >> 1), b = p >> 4, cc = p & 15, c = (i & 1) ? 31 - cc : cc; dsa_unit(proj, odsa, (unsigned*)F.out + (size_t)F.blk * 131072, b, c, F.lds, F.tid); }
#endif
        const int gw = F.blk * NWAVES + F.wave, NGW = F.G * NWAVES;
#ifndef NO_SB
        for (int rep = 0; rep < REP_SB; ++rep)
        for (int it = gw; it < NB * 8 * 64; it += NGW) { const int qblk = 63 - (it >> 8), bh = it & 255; sb_item(proj, osb, bh >> 3, bh & 7, qblk, F.lds + F.wave * 4096, F.lane); }
#endif
#ifndef NO_MEM
        for (int rep = 0; rep < REP_MEM; ++rep) {
            __syncthreads();
            for (int u = F.blk; u < NB * 4 * 2; u += F.G) mem_unit(proj, (const bf16_t*)(ws + WS_MKV), omem, u >> 3, (u >> 1) & 3, u & 1, F.lds, F.tid);
        }
#endif
    } SEAM(3);

    if (IN(4)) {
        pg8::DenseSched S; S.init(ws + WS_H, ws + WS_WG, NTOK, 3 * DM, DM, F.G, F.blk);
        pg8::EpiBf16<2> E{proj, PW, F.in[11]};
        pg8::gemm_phase<pg8::EpiBf16<2>, pg8::DenseSched, true>(F.lds, DM, S, E);
    } SEAM(4);

    if (IN(5)) { pg8::MergeSched S; S.init(ws + WS_O, ws + WS_WB, NTOK, DM, F.G, F.blk);
        pg8::EpiMerge E{proj, (bf16_t*)(ws + WS_H)};
        pg8::gemm_phase<pg8::EpiMerge, pg8::MergeSched, true>(F.lds, 512, S, E); } SEAM(5);


    if (IN(8)) {
        pg8::DenseSched S; S.init(ws + WS_H, ws + WS_WO, NTOK, DM, DM, F.G, F.blk); S.stag = STAG;
        pg8::EpiResid E{F.in[0], F.out};
        pg8::gemm_phase<pg8::EpiResid, pg8::DenseSched, true>(F.lds, DM, S, E);
    } SEAM(8);

    if (IN(9)) for (int rep = 0; rep < NREP(9); ++rep) { if (rep) xcd_barrier(bar); p9_router(F); } SEAM(9);
    if (IN(10)) for (int rep = 0; rep < NREP(10); ++rep) { if (rep) xcd_barrier(bar); p10_assign(F); } SEAM(10);

    if (IN(11)) for (int rep = 0; rep < NREP(11); ++rep) {  if (rep) xcd_barrier(bar);
        pg8::MoeSched S{(const char*)(ws + WS_H), (const char*)(ws + WS_WEI), (const int*)(ws + WS_SLOT_TOK), F.MISC + MW_TSTART, DM, 2048, 8, F.blk};
        pg8::EpiSwiglu E{(bf16_t*)(ws + WS_P), F.in[18]};
        pg8::gemm_phase<pg8::EpiSwiglu, pg8::MoeSched, true>(F.lds, DM, S, E);
    } SEAM(11);

    if (IN(12)) {
        pg8::MoeSched S{(const char*)(ws + WS_P), (const char*)(ws + WS_WEO), nullptr, F.MISC + MW_TSTART, DM, DM, 4, F.blk};
        pg8::EpiScatter E{F.out, (const int*)(ws + WS_SLOT_TOK), (const float*)(ws + WS_SLOT_W), F.in[20], F.lds};
        pg8::gemm_phase<pg8::EpiScatter, pg8::MoeSched, true>(F.lds, DM, S, E);
    }
#undef IN
#undef SEAM
}

extern "C" void kernel_launch(void* const* d_in, const int* in_sizes, int n_in, void* d_out, int out_size, void* d_ws, size_t ws_size, hipStream_t stream) {
    static int grid = 0;
    if (grid == 0) {
        if (n_in != 21 || in_sizes[0] != NTOK * DM || out_size != NTOK * DM || ws_size < WS_END) {
            fprintf(stderr, "kernel_launch: unexpected shapes: n_in %d in0 %d out %d ws %zu (need >= %zu); nothing launched\n", n_in, n_in > 0 ? in_sizes[0] : -1, out_size, ws_size, (size_t)WS_END); grid = -1; return; }
        int dev = 0, cus = 0, per_cu = 0;
        if (hipGetDevice(&dev) != hipSuccess || hipDeviceGetAttribute(&cus, hipDeviceAttributeMultiprocessorCount, dev) != hipSuccess) { fprintf(stderr, "kernel_launch: device query failed\n"); grid = -1; return; }
        if (hipFuncSetAttribute((const void*)fwd_kernel, hipFuncAttributeMaxDynamicSharedMemorySize, LDS_BYTES) != hipSuccess) { fprintf(stderr, "kernel_launch: hipFuncSetAttribute failed\n"); grid = -1; return; }
        if (hipOccupancyMaxActiveBlocksPerMultiprocessor(&per_cu, (const void*)fwd_kernel, NWAVES * 64, LDS_BYTES) != hipSuccess || per_cu < 1)
            fprintf(stderr, "kernel_launch: note: occupancy query reports %d workgroups per CU\n", per_cu);
        (void)hipGetLastError();
        grid = cus;
        if (grid != 256) { fprintf(stderr, "kernel_launch: this kernel is built for 256 CUs (got %d); nothing launched\n", grid); grid = -1; return; }
    }
    if (grid < 0) return;
    if (hipMemsetAsync((char*)d_ws + WS_CTL, 0, CTL_ZERO_BYTES, stream) != hipSuccess) { fprintf(stderr, "kernel_launch: hipMemsetAsync failed\n"); return; }
    Args a{};
    for (int i = 0; i < 21; ++i) a.in[i] = (const float*)d_in[i];
    a.out = (float*)d_out; a.ws = (unsigned char*)d_ws;
#if MK_ONE_LAUNCH
    const int cuts[2] = {0, N_PHASES}; const int nl = 1;
#else
    const int cuts[11] = {0, 1, 2, 3, 4, 5, 6, 7, 8, 9, N_PHASES}; const int nl = 10;
#endif
    for (int li = 0; li < nl; ++li) {
        a.ph_lo = cuts[li]; a.ph_hi = cuts[li + 1];
        hipLaunchKernelGGL(fwd_kernel, dim3(grid), dim3(NWAVES * 64), LDS_BYTES, stream, a);
        const hipError_t le = hipPeekAtLastError();
        if (le != hipSuccess) { fprintf(stderr, "kernel_launch: launch %d failed: %s\n", li, hipGetErrorName(le)); break; }
    }
}
```

```cpp
#include <hip/hip_runtime.h>
#include <cstdio>
#include <cstdint>

#define LAS __attribute__((address_space(3)))
#define GAS __attribute__((address_space(1)))
typedef unsigned short bf16_t;
typedef short bf16x8 __attribute__((ext_vector_type(8)));
typedef short s16x4 __attribute__((ext_vector_type(4)));
typedef short v4i16_t __attribute__((ext_vector_type(4)));
typedef float f32x2 __attribute__((ext_vector_type(2)));
typedef float f32x4 __attribute__((ext_vector_type(4)));
typedef float f32x16 __attribute__((ext_vector_type(16)));
typedef unsigned u32x2 __attribute__((ext_vector_type(2)));
typedef unsigned u32x4 __attribute__((ext_vector_type(4)));
typedef int i32x4 __attribute__((ext_vector_type(4)));
typedef int i32x8 __attribute__((ext_vector_type(8)));
typedef GAS unsigned gu32;

constexpr int NB = 32, SEQ = 2048, DM = 1024, NTOK = NB * SEQ;
constexpr int MEMLEN = 256, NMEM = NB * MEMLEN;
constexpr int PW = 3072;
constexpr int C_SQ = 0, C_SK = 512, C_SV = 1024, C_DQ = 1536, C_DK = 2048, C_DV = 2112, C_IQ = 2176, C_IK = 2432, C_IW = 2496, C_MQ = 2560;
constexpr int IN_W = 3012;
constexpr int NEXP = 32, TOPK = 4, DEXP = 1024;
constexpr int NSLOT = NTOK * TOPK;
constexpr int NSLOT_PAD = NSLOT + NEXP * 256;
constexpr float EPS = 1e-6f;
constexpr float LOG2E = 1.4426950408889634f;

constexpr size_t MiB = 1u << 20;
constexpr size_t WS_CTL = 0, CTL_ZERO_BYTES = 1 * MiB;
constexpr size_t WS_ROPE = 1 * MiB;
constexpr size_t WS_BLKCNT = 1 * MiB + 512 * 1024;
constexpr size_t WS_SLOT_TOK = 2 * MiB;
constexpr size_t WS_SLOT_W = 4 * MiB;
constexpr size_t WS_WIN = 8 * MiB;
constexpr size_t WS_WMKV = 14 * MiB;
constexpr size_t WS_WG = 16 * MiB;
constexpr size_t WS_WB = 22 * MiB;
constexpr size_t WS_WO = 25 * MiB;
constexpr size_t WS_WEI = 27 * MiB;
constexpr size_t WS_WEO = 155 * MiB;
__device__ __forceinline__ int lane_id_fresh() { int l; asm volatile("v_mbcnt_lo_u32_b32 %0, -1, 0\n\tv_mbcnt_hi_u32_b32 %0, -1, %0" : "=v"(l)); return l; }
constexpr float W8_SCALE = 64.f, W8_INV = 1.f / 64.f;
constexpr size_t WS_H = 220 * MiB;
constexpr size_t WS_P = 348 * MiB;
constexpr size_t WS_O = 732 * MiB;
constexpr size_t WS_H2F8 = 91 * MiB;
constexpr size_t WS_MEMN = 924 * MiB;
constexpr size_t WS_MKV = 940 * MiB;
constexpr size_t WS_END = 956 * MiB;
static_assert(WS_P + (size_t)NSLOT_PAD * DEXP * 2 <= WS_MEMN, "act overlays proj|o");
static_assert(WS_SLOT_TOK + (size_t)NSLOT_PAD * 4 <= WS_SLOT_W && WS_SLOT_W + (size_t)NSLOT_PAD * 4 <= WS_WIN, "slot tables");

constexpr int CW_BAR = 4096;

constexpr int RING_BYTES = 151552;
constexpr int MISC_OFF = RING_BYTES;
constexpr int LDS_BYTES = 155648;
constexpr int MW_BAR = 8;
constexpr int MW_LCNT = 16;
constexpr int MW_PSTART = 64;
constexpr int MW_TSTART = 128;
constexpr int MW_BEFORE = 192;
constexpr int MW_PART = 256;

__device__ __forceinline__ unsigned f2bf(float f) { unsigned u = __builtin_bit_cast(unsigned, f); return (u + 0x7fffu + ((u >> 16) & 1u)) >> 16; }
__device__ __forceinline__ unsigned pk2(float lo, float hi) { return f2bf(lo) | (f2bf(hi) << 16); }
__device__ __forceinline__ float bf2f(unsigned short b) { return __builtin_bit_cast(float, (unsigned)b << 16); }
__device__ __forceinline__ float bflo(unsigned w) { return __builtin_bit_cast(float, w << 16); }
__device__ __forceinline__ float bfhi(unsigned w) { return __builtin_bit_cast(float, w & 0xffff0000u); }
__device__ __forceinline__ unsigned cvt_pk_bf16(float lo, float hi) { unsigned r; asm volatile("v_cvt_pk_bf16_f32 %0, %1, %2" : "=v"(r) : "v"(lo), "v"(hi)); return r; }
__device__ __forceinline__ int crow(int r, int hi) { return (r & 3) + 8 * (r >> 2) + 4 * hi; }
#define LDS_WAIT() asm volatile("s_waitcnt lgkmcnt(0)" ::: "memory")
#define VM_WAIT() asm volatile("s_waitcnt vmcnt(0)" ::: "memory")

namespace pg8 {
constexpr int BM = 256, BK = 64, HALF = 128, HTB = HALF * BK * 2, STAGE_BYTES = 8 * HTB, EPI_NA_OFF = STAGE_BYTES + 2048;
__host__ __device__ __forceinline__ int lds_byte(int r, int c) { const int st = (r >> 4) * 2 + (c >> 5), rr = r & 15, cc = c & 31, ob = rr * 64 + cc * 2; return st * 1024 + (ob ^ (((ob >> 9) & 1) << 5)); }
__host__ __device__ __forceinline__ void stage_rc(int b, int& R, int& C) { const int st = b / 1024, sb = b % 1024, swz = sb ^ (((sb >> 9) & 1) << 5); R = (st >> 1) * 16 + swz / 64; C = (st & 1) * 32 + (swz % 64) / 2; }
__host__ __device__ __forceinline__ int perm32(int rho) { const int n = rho >> 4, i = rho & 15; return 8 * (i >> 2) + 4 * n + (i & 3); }

struct Unit { int pm, pn, e; };

template <class Epi, class Sched, bool ALIGN_EPI, bool FP8 = false>
__device__ __forceinline__ void gemm_phase(LAS unsigned char* lds, const int wave_, const int K, const Sched& S, const Epi& E) {
    int tid = wave_ * 64 + lane_id_fresh();
    const int wid = __builtin_amdgcn_readfirstlane(tid >> 6), lane = tid & 63, wr = wid >> 2, wc = wid & 3, fr = lane & 15, fq = lane >> 4;
    const int nt = K / BK;
    int Rr[2], Cc[2]; unsigned voffB[2];
#pragma unroll
    for (int i = 0; i < 2; ++i) { int R, C; stage_rc(tid * 16 + i * 8192, R, C); Rr[i] = R; Cc[i] = C; const int Rb = Epi::PERM ? ((R & ~31) + perm32(R & 31)) : R; voffB[i] = (unsigned)(Rb * K + C) * 2u; }
    const size_t kstep = (size_t)(BK * 2);
    const size_t hstepB = (size_t)HALF * K * 2;
    const unsigned ldsw = (unsigned)wid * 1024u;
    const int aoff = lds_byte(wr * 64 + fr, fq * 8), boff = lds_byte(wc * 32 + fr, fq * 8);
#define PG8_SA(b, h) (((b) * 2 + (h)) * HTB)
#define PG8_SB(b, h) ((4 + (b) * 2 + (h)) * HTB)
#define PG8_STAGE(bufoff, gbase, voff) do { _Pragma("unroll") for (int _i = 0; _i < 2; ++_i) { unsigned o_ = (voff)[_i]; asm volatile("" : "+v"(o_)); \
        __builtin_amdgcn_global_load_lds((const unsigned*)((const char*)(gbase) + o_), (LAS unsigned*)(lds + (bufoff) + ldsw + _i * 8192), 16, 0, 0); } } while (0)
#define PG8_J8(x, y) __builtin_shufflevector(x, y, 0, 1, 2, 3, 4, 5, 6, 7)
#define PG8_LDA(dst, b, h) do { _Pragma("unroll") for (int m = 0; m < 4; ++m) { const LAS unsigned char* p_ = lds + PG8_SA(b, h) + aoff + m * 2048; \
        if constexpr (FP8) dst##8[m] = PG8_J8(*(const LAS i32x4*)p_, *(const LAS i32x4*)(p_ + 1024)); else { dst[m][0] = *(const LAS bf16x8*)p_; dst[m][1] = *(const LAS bf16x8*)(p_ + 1024); } } } while (0)
#define PG8_LDB(dst, b, h) do { _Pragma("unroll") for (int n = 0; n < 2; ++n) { const LAS unsigned char* p_ = lds + PG8_SB(b, h) + boff + n * 2048; \
        if constexpr (FP8) dst##8[n] = PG8_J8(*(const LAS i32x4*)p_, *(const LAS i32x4*)(p_ + 1024)); else { dst[n][0] = *(const LAS bf16x8*)p_; dst[n][1] = *(const LAS bf16x8*)(p_ + 1024); } } } while (0)
#define PG8_MMA(ai, bj, At, Bt) do { __builtin_amdgcn_s_setprio(1); _Pragma("unroll") for (int m = 0; m < 4; ++m) _Pragma("unroll") for (int n = 0; n < 2; ++n) { \
        if constexpr (FP8) acc[ai][bj][m][n] = __builtin_amdgcn_mfma_scale_f32_16x16x128_f8f6f4(Bt##8[n], At##8[m], acc[ai][bj][m][n], 0, 0, 0, 0, 0, 0); \
        else { _Pragma("unroll") for (int k = 0; k < 2; ++k) acc[ai][bj][m][n] = __builtin_amdgcn_mfma_f32_16x16x32_bf16(Bt[n][k], At[m][k], acc[ai][bj][m][n], 0, 0, 0); } } \
        __builtin_amdgcn_s_setprio(0); } while (0)
#define PG8_WAIT_V(n) asm volatile("s_waitcnt vmcnt(" #n ")" ::: "memory")
#define PG8_WAIT_L(n) asm volatile("s_waitcnt lgkmcnt(" #n ")" ::: "memory")
#define PG8_BAR __builtin_amdgcn_s_barrier()
#define PG8_SCHED __builtin_amdgcn_sched_barrier(0)
    Unit cur, nxt; int ui = 0;
    if (!S.next(0, cur)) return;
    { const int ns = S.stagger();
      for (int q = 0; q < ns; ++q) __builtin_amdgcn_s_sleep(4); }
    f32x4 acc[2][2][4][2];
#pragma unroll
    for (int a = 0; a < 2; ++a)
#pragma unroll
        for (int b = 0; b < 2; ++b)
#pragma unroll
            for (int m = 0; m < 4; ++m)
#pragma unroll
                for (int n = 0; n < 2; ++n) acc[a][b][m][n] = (f32x4){0.f, 0.f, 0.f, 0.f};
    bf16x8 At[4][2], B0[2][2], B1[2][2]; i32x8 At8[4], B08[2], B18[2];
    const char* Ab = S.a_base();
    unsigned ca0[2], ca1[2], na0[2], na1[2];
#pragma unroll
    for (int i = 0; i < 2; ++i) { ca0[i] = S.a_off(cur, Rr[i], Cc[i]); ca1[i] = S.a_off(cur, HALF + Rr[i], Cc[i]); }
    const char* cB = S.b_tile(cur);
    PG8_STAGE(PG8_SB(0, 0), cB, voffB); PG8_STAGE(PG8_SB(0, 1), cB + hstepB, voffB); PG8_STAGE(PG8_SA(0, 0), Ab, ca0); PG8_STAGE(PG8_SA(0, 1), Ab, ca1);
    if (wr == 1) PG8_BAR;
    PG8_WAIT_V(2); PG8_BAR;
    PG8_STAGE(PG8_SB(1, 0), cB + kstep, voffB); PG8_STAGE(PG8_SA(1, 0), Ab + kstep, ca0); PG8_STAGE(PG8_SB(1, 1), cB + hstepB + kstep, voffB);
    PG8_WAIT_V(6); PG8_BAR;
    for (;;) {
        typename Epi::Pre pre = E.preload(cur, wr, wc, fr, fq);
        const bool has_next = S.next(ui + 1, nxt);
        const char* nB = cB;
#pragma unroll
        for (int i = 0; i < 2; ++i) { na0[i] = ca0[i]; na1[i] = ca1[i]; }
        if (has_next) { nB = S.b_tile(nxt);
#pragma unroll
            for (int i = 0; i < 2; ++i) { int R, C; int tq = tid; if constexpr (FP8) asm volatile("" : "+v"(tq));
                stage_rc(tq * 16 + i * 8192, R, C);
                na0[i] = S.a_off(nxt, R, C); na1[i] = S.a_off(nxt, HALF + R, C); } }
        if constexpr (Epi::DRAIN_TOP) { PG8_WAIT_V(0); }
        if constexpr (Epi::STASH) E.stash(pre, wid, fr, fq);
#define PG8_NAST(v) unsigned v = (unsigned)(EPI_NA_OFF + tid * 16); asm volatile("" : "+v"(v))
        if constexpr (FP8) { PG8_NAST(nast); *(LAS u32x4*)(lds + nast) = (u32x4){na0[0], na0[1], na1[0], na1[1]}; }
#pragma unroll 1
        for (int t = 0; t < nt; t += 2) {
            const bool last = (t == nt - 2);
            const char* a1 = Ab + (size_t)(t + 1) * kstep;
            const char* a2 = last ? Ab : Ab + (size_t)(t + 2) * kstep; const char* b2 = last ? nB : cB + (size_t)(t + 2) * kstep;
            const char* a3 = a2 + kstep; const char* b3 = b2 + kstep;
            if constexpr (FP8) { asm volatile("" : "+s"(a1), "+s"(a2), "+s"(b2), "+s"(a3), "+s"(b3)); }
            unsigned o20[2], o21[2];
#pragma unroll
            for (int i = 0; i < 2; ++i) { o20[i] = last ? na0[i] : ca0[i]; o21[i] = last ? na1[i] : ca1[i]; }
            if constexpr (FP8) { if (last) { PG8_NAST(nast); const u32x4 nv = *(const LAS u32x4*)(lds + nast); o20[0] = nv.x; o20[1] = nv.y; o21[0] = nv.z; o21[1] = nv.w; } }
            PG8_LDB(B0, 0, 0); PG8_LDB(B1, 0, 1); PG8_SCHED; PG8_LDA(At, 0, 0); PG8_STAGE(PG8_SA(1, 1), a1, ca1);
            PG8_WAIT_V(8); PG8_WAIT_L(0); PG8_BAR; PG8_MMA(0, 0, At, B0); PG8_MMA(0, 1, At, B1); PG8_BAR; PG8_SCHED;
            PG8_LDA(At, 0, 1); PG8_STAGE(PG8_SB(0, 0), b2, voffB); PG8_STAGE(PG8_SB(0, 1), b2 + hstepB, voffB); PG8_STAGE(PG8_SA(0, 0), a2, o20);
            PG8_WAIT_V(8); PG8_WAIT_L(0); PG8_BAR; PG8_MMA(1, 0, At, B0); PG8_MMA(1, 1, At, B1); PG8_BAR; PG8_SCHED;
            PG8_LDB(B0, 1, 0); PG8_LDB(B1, 1, 1); PG8_SCHED; PG8_LDA(At, 1, 0); PG8_STAGE(PG8_SA(0, 1), a2, o21);
            PG8_WAIT_V(8); PG8_WAIT_L(0); PG8_BAR; PG8_MMA(0, 0, At, B0); PG8_MMA(0, 1, At, B1); PG8_BAR; PG8_SCHED;
            PG8_LDA(At, 1, 1); PG8_STAGE(PG8_SB(1, 0), b3, voffB); PG8_STAGE(PG8_SB(1, 1), b3 + hstepB, voffB); PG8_STAGE(PG8_SA(1, 0), a3, o20);
            PG8_WAIT_V(8); PG8_WAIT_L(0); PG8_BAR; PG8_MMA(1, 0, At, B0); PG8_MMA(1, 1, At, B1); PG8_BAR; PG8_SCHED;
        }
        if constexpr (ALIGN_EPI) { if (wr == 0) PG8_BAR; }
        if constexpr (Epi::STASH) { int lq = tid; asm volatile("" : "+v"(lq));
            E(acc, cur, wr, wc, lq & 15, (lq >> 4) & 3, typename Epi::Pre{}); }
        else E(acc, cur, wr, wc, fr, fq, pre);
        if (!has_next) break;
#pragma unroll
        for (int a = 0; a < 2; ++a)
#pragma unroll
            for (int b = 0; b < 2; ++b)
#pragma unroll
                for (int m = 0; m < 4; ++m)
#pragma unroll
                    for (int n = 0; n < 2; ++n) acc[a][b][m][n] = (f32x4){0.f, 0.f, 0.f, 0.f};
        cur = nxt; cB = nB; ++ui;
#pragma unroll
        for (int i = 0; i < 2; ++i) { ca0[i] = na0[i]; ca1[i] = na1[i]; }
        if constexpr (FP8) { PG8_NAST(nast); const u32x4 nv = *(const LAS u32x4*)(lds + nast); ca0[0] = nv.x; ca0[1] = nv.y; ca1[0] = nv.z; ca1[1] = nv.w; }
        if constexpr (ALIGN_EPI) { if (wr == 1) PG8_BAR; }
    }
    PG8_WAIT_V(0);
    if constexpr (!ALIGN_EPI) { if (wr == 0) PG8_BAR; }
    PG8_BAR;
#undef PG8_SA
#undef PG8_SB
#undef PG8_STAGE
#undef PG8_LDA
#undef PG8_LDB
#undef PG8_MMA
#undef PG8_NAST
#undef PG8_J8
#undef PG8_WAIT_V
#undef PG8_WAIT_L
#undef PG8_BAR
#undef PG8_SCHED
}

struct DenseSched {
    const char* A; const char* Bt; int K, nM, nN, nwg, G, c, stag = 0, amask = -1;
    __device__ __forceinline__ void init(const void* A_, const void* Bt_, int M, int N, int K_, int G_, int c_) { A = (const char*)A_; Bt = (const char*)Bt_; K = K_; nM = M / BM; nN = N / BM; nwg = nM * nN; G = G_; c = c_; }
    __device__ __forceinline__ bool next(int i, Unit& u) const {
        const long L = (long)i * G + c; if (L >= nwg) return false;
        int wgid = (int)L; { const int q = nwg / 8, r = nwg % 8, xcd = wgid % 8, off = wgid / 8; wgid = (xcd < r ? xcd * (q + 1) : r * (q + 1) + (xcd - r) * q) + off; }
        const int nig = 8 * nN, gid = wgid / nig, fm = gid * 8, gsz = (nM - fm) < 8 ? (nM - fm) : 8;
        u.pm = fm + ((wgid % nig) % gsz); u.pn = (wgid % nig) / gsz; u.e = 0; return true;
    }
    __device__ __forceinline__ const char* a_base() const { return A; }
    __device__ __forceinline__ int stagger() const { return stag ? ((c >> 3) & 7) * (K / 55) : 0; }
    __device__ __forceinline__ unsigned a_off(const Unit& u, int row, int col) const { return (unsigned)(((size_t)((u.pm * BM + row) & amask) * K + col) * 2); }
    __device__ __forceinline__ int a_row(const Unit& u, int row) const { return (u.pm * BM + row) & amask; }
    __device__ __forceinline__ unsigned row_off(int r, int col) const { return (unsigned)(((size_t)r * K + col) * 2); }
    __device__ __forceinline__ const char* b_tile(const Unit& u) const { return Bt + (size_t)u.pn * BM * K * 2; }
};
}

namespace pg8 {
struct MoeSched {
    const char* A; const char* Bt; const int* slot_tok; volatile LAS unsigned* tstart; int K, rowsE, nN, c;
    __device__ __forceinline__ bool next(int i, Unit& u) const {
        const int x = c & 7, j = c >> 3, rpr = 32 / nN;
        const int pm = (i * 8 + x) * rpr + j / nN;
        const int T = (int)tstart[32];
        if (pm >= T) return false;
        int e = 0;
#pragma unroll 1
        for (int k = 1; k < 32; ++k) e += ((int)tstart[k] <= pm) ? 1 : 0;
        u.pm = pm; u.pn = j % nN; u.e = __builtin_amdgcn_readfirstlane(e); return true;
    }
    __device__ __forceinline__ const char* a_base() const { return A; }
    __device__ __forceinline__ int stagger() const { const int g = (c >> 3) / nN, ng = 32 / nN; (void)g; (void)ng; return 0; }
    __device__ __forceinline__ unsigned a_off(const Unit& u, int row, int col) const {
        const int pos = u.pm * BM + row;
        const int r = slot_tok ? slot_tok[pos] : pos;
        return (unsigned)(((size_t)r * K + col) * 2);
    }
    __device__ __forceinline__ int a_row(const Unit& u, int row) const { const int pos = u.pm * BM + row; return slot_tok ? ((const GAS int*)slot_tok)[pos] : pos; }
    __device__ __forceinline__ unsigned row_off(int r, int col) const { return (unsigned)(((size_t)r * K + col) * 2); }
    __device__ __forceinline__ const char* b_tile(const Unit& u) const { return Bt + ((size_t)u.e * rowsE + (size_t)u.pn * BM) * K * 2; }
};

struct MergeSched {
    const char* A; const char* Bt; int nM, nN, nwg, G, c;
    __device__ __forceinline__ void init(const void* A_, const void* Bt_, int M, int N, int G_, int c_) { A = (const char*)A_; Bt = (const char*)Bt_; nM = M / BM; nN = N / BM; nwg = nM * nN; G = G_; c = c_; }
    __device__ __forceinline__ bool next(int i, Unit& u) const {
        const int r = i / 3; const long L = (long)r * G + c; if (L >= nwg) return false;
        int wgid = (int)L; { const int q = nwg / 8, rr = nwg % 8, xcd = wgid % 8, off = wgid / 8; wgid = (xcd < rr ? xcd * (q + 1) : rr * (q + 1) + (xcd - rr) * q) + off; }
        const int nig = 8 * nN, gid = wgid / nig, fm = gid * 8, gsz = (nM - fm) < 8 ? (nM - fm) : 8;
        u.pm = fm + ((wgid % nig) % gsz); u.pn = (wgid % nig) / gsz; u.e = i - 3 * r; return true;
    }
    __device__ __forceinline__ const char* a_base() const { return A; }
    __device__ __forceinline__ int stagger() const { return 0; }
    __device__ __forceinline__ unsigned a_off(const Unit& u, int row, int col) const { return (unsigned)(((size_t)(u.pm * BM + row) * 512 + col) * 2 + (size_t)u.e * ((size_t)NTOK * 512 * 2)); }
    __device__ __forceinline__ const char* b_tile(const Unit& u) const { return Bt + ((size_t)u.e * DM + (size_t)u.pn * BM) * 512 * 2; }
};

constexpr int EPI_STAGE_OFF = 131072, EPI_STAGE_WAVE = 2304;
struct NoPre {};
template <int ACT> struct EpiBf16 {
    static constexpr bool PERM = true, DRAIN_TOP = false, STASH = false;
    struct Pre { f32x4 bv[2][2]; };
    bf16_t* O; int ldc; const float* bias; int rowmask = -1;
    __device__ __forceinline__ Pre preload(const Unit& u, int wr, int wc, int fr, int fq) const { Pre p; const int col0 = u.pn * BM + wc * 32 + 8 * fq;
#pragma unroll
        for (int bj = 0; bj < 2; ++bj)
#pragma unroll
            for (int n = 0; n < 2; ++n) p.bv[bj][n] = (f32x4){0.f, 0.f, 0.f, 0.f};
        return p; }
    __device__ __forceinline__ void arrived(Pre& p) const { asm volatile("" : "+v"(p.bv[0][0]), "+v"(p.bv[0][1]), "+v"(p.bv[1][0]), "+v"(p.bv[1][1])); }
    __device__ __forceinline__ void operator()(const f32x4 (&acc)[2][2][4][2], const Unit& u, int wr, int wc, int fr, int fq, const Pre& pre) const {
        const int row0 = u.pm * BM + wr * 64 + fr; const int col0 = u.pn * BM + wc * 32 + 8 * fq;
        f32x4 bv[2][2];
#pragma unroll
        for (int bj = 0; bj < 2; ++bj)
#pragma unroll
            for (int n = 0; n < 2; ++n) bv[bj][n] = bias ? *(const f32x4*)(bias + col0 + bj * HALF + 4 * n) : pre.bv[bj][n];
#pragma unroll
        for (int ai = 0; ai < 2; ++ai)
#pragma unroll
            for (int m = 0; m < 4; ++m) { bf16_t* rowp = O + (size_t)((row0 + ai * HALF + m * 16) & rowmask) * ldc + col0;
#pragma unroll
                for (int bj = 0; bj < 2; ++bj) { f32x4 v0 = acc[ai][bj][m][0] + bv[bj][0], v1 = acc[ai][bj][m][1] + bv[bj][1];
                    u32x4 w; w.x = cvt_pk_bf16(v0[0], v0[1]); w.y = cvt_pk_bf16(v0[2], v0[3]); w.z = cvt_pk_bf16(v1[0], v1[1]); w.w = cvt_pk_bf16(v1[2], v1[3]);
                    *(u32x4*)(rowp + bj * HALF) = w; } }
    }
};
struct EpiMerge {
    static constexpr bool PERM = true, DRAIN_TOP = false, STASH = false;
    typedef NoPre Pre; __device__ __forceinline__ Pre preload(const Unit&, int, int, int, int) const { return Pre{}; }
    const bf16_t* G; bf16_t* Mg;
    __device__ __forceinline__ void operator()(const f32x4 (&acc)[2][2][4][2], const Unit& u, int wr, int wc, int fr, int fq, const Pre&) const {
        const int row0 = u.pm * BM + wr * 64 + fr; const int col0 = u.pn * BM + wc * 32 + 8 * fq;
        const int goff = u.e * DM; const bool first = (u.e == 0);
#pragma unroll
        for (int ai = 0; ai < 2; ++ai)
#pragma unroll
            for (int m = 0; m < 4; ++m) { const size_t row = (size_t)(row0 + ai * HALF + m * 16);
#pragma unroll
                for (int bj = 0; bj < 2; ++bj) {
                    const u32x4 g = *(const u32x4*)(G + row * PW + goff + col0 + bj * HALF);
                    u32x4 p = (u32x4){0u, 0u, 0u, 0u};
                    if (!first) p = *(const u32x4*)(Mg + row * DM + col0 + bj * HALF);
                    const f32x4 a0 = acc[ai][bj][m][0], a1 = acc[ai][bj][m][1];
                    u32x4 w;
#define SGM(x_) __builtin_amdgcn_rcpf(1.f + __builtin_amdgcn_exp2f(-LOG2E * (x_)))
                    w.x = cvt_pk_bf16(bflo(p.x) + SGM(bflo(g.x)) * a0[0], bfhi(p.x) + SGM(bfhi(g.x)) * a0[1]);
                    w.y = cvt_pk_bf16(bflo(p.y) + SGM(bflo(g.y)) * a0[2], bfhi(p.y) + SGM(bfhi(g.y)) * a0[3]);
                    w.z = cvt_pk_bf16(bflo(p.z) + SGM(bflo(g.z)) * a1[0], bfhi(p.z) + SGM(bfhi(g.z)) * a1[1]);
                    w.w = cvt_pk_bf16(bflo(p.w) + SGM(bflo(g.w)) * a1[2], bfhi(p.w) + SGM(bfhi(g.w)) * a1[3]);
#undef SGM
                    *(u32x4*)(Mg + row * DM + col0 + bj * HALF) = w; } }
    }
};
struct EpiResid {
    static constexpr bool PERM = false, DRAIN_TOP = false, STASH = false;
    typedef NoPre Pre; __device__ __forceinline__ Pre preload(const Unit&, int, int, int, int) const { return Pre{}; }
    const float* base; float* out;
    __device__ __forceinline__ void operator()(const f32x4 (&acc)[2][2][4][2], const Unit& u, int wr, int wc, int fr, int fq, const Pre&) const {
        const int row0 = u.pm * BM + wr * 64 + fr; const int col0 = u.pn * BM + wc * 32 + 4 * fq;
#pragma unroll
        for (int ai = 0; ai < 2; ++ai)
#pragma unroll
            for (int m = 0; m < 4; ++m) { const size_t off = (size_t)(row0 + ai * HALF + m * 16) * DM + col0;
#pragma unroll
                for (int bj = 0; bj < 2; ++bj)
#pragma unroll
                    for (int n = 0; n < 2; ++n) { const f32x4 b = *(const f32x4*)(base + off + bj * HALF + n * 16); *(f32x4*)(out + off + bj * HALF + n * 16) = b + acc[ai][bj][m][n]; } }
    }
};
struct EpiSwiglu {
    static constexpr bool PERM = true, DRAIN_TOP = true, STASH = true;
    bf16_t* act; const float* bias; LAS unsigned char* lds;
    struct Pre { f32x4 bg[2], bu[2]; };
    __device__ __forceinline__ Pre preload(const Unit& u, int wr, int wc, int fr, int fq) const {
        const GAS float* be = (const GAS float*)bias + (size_t)u.e * 2048 + u.pn * HALF + wc * 32 + 8 * fq; Pre p;
#pragma unroll
        for (int n = 0; n < 2; ++n) { p.bg[n] = *(const GAS f32x4*)(be + 4 * n); p.bu[n] = *(const GAS f32x4*)(be + 1024 + 4 * n); }
        return p; }
    __device__ __forceinline__ void stash(const Pre& p, int wid, int fr, int fq) const {
        LAS f32x4* st = (LAS f32x4*)(lds + EPI_STAGE_OFF + wid * 256 + fq * 64);
        if (fr == 0) { st[0] = p.bg[0]; st[1] = p.bg[1]; st[2] = p.bu[0]; st[3] = p.bu[1]; } }
    __device__ __forceinline__ void operator()(const f32x4 (&acc)[2][2][4][2], const Unit& u, int wr, int wc, int fr, int fq, const Pre& pre) const {
        const int row0 = u.pm * BM + wr * 64 + fr; const int col0 = u.pn * HALF + wc * 32 + 8 * fq;
        f32x4 bg[2], bu[2];
#pragma unroll
        for (int n = 0; n < 2; ++n) { const LAS f32x4* st = (const LAS f32x4*)(lds + EPI_STAGE_OFF + (wr * 4 + wc) * 256 + fq * 64); bg[n] = st[n]; bu[n] = st[2 + n]; }
#pragma unroll
        for (int ai = 0; ai < 2; ++ai)
#pragma unroll
            for (int m = 0; m < 4; ++m) { bf16_t* rowp = act + (size_t)(row0 + ai * HALF + m * 16) * DEXP + col0;
                float o[8];
#pragma unroll
                for (int n = 0; n < 2; ++n) { const f32x4 gv = acc[ai][0][m][n] * W8_INV + bg[n], uv = acc[ai][1][m][n] * W8_INV + bu[n];
#pragma unroll
                    for (int q = 0; q < 4; ++q) { const float g = fminf(gv[q], 7.0f); const float uu = fminf(fmaxf(uv[q], -7.0f), 7.0f);
                        const float sg = __builtin_amdgcn_rcpf(1.f + __builtin_amdgcn_exp2f(-1.702f * LOG2E * g));
                        o[4 * n + q] = (uu + 1.0f) * (g * sg); } }
                u32x4 w; w.x = cvt_pk_bf16(o[0], o[1]); w.y = cvt_pk_bf16(o[2], o[3]); w.z = cvt_pk_bf16(o[4], o[5]); w.w = cvt_pk_bf16(o[6], o[7]);
                *(u32x4*)rowp = w; }
    }
};
struct EpiScatter {
    static constexpr bool PERM = false, DRAIN_TOP = false, STASH = false;
    typedef NoPre Pre; __device__ __forceinline__ Pre preload(const Unit&, int, int, int, int) const { return Pre{}; }
    float* out; const int* slot_tok; const float* slot_w; const float* bias; LAS unsigned char* lds;
    __device__ __forceinline__ void operator()(const f32x4 (&acc)[2][2][4][2], const Unit& u, int wr, int wc, int fr, int fq, const Pre&) const {
        const int lane = fr + 16 * fq, wid = wr * 4 + wc;
        LAS float* st = (LAS float*)(lds + EPI_STAGE_OFF + wid * EPI_STAGE_WAVE);
        const int row0 = u.pm * BM + wr * 64 + fr;
        const int lcol = lane & 31, lrow = lane >> 5;
        float bv[2];
#pragma unroll
        for (int bj = 0; bj < 2; ++bj) bv[bj] = bias[(size_t)u.e * DM + u.pn * BM + bj * HALF + wc * 32 + lcol];
#pragma unroll
        for (int ai = 0; ai < 2; ++ai)
#pragma unroll
            for (int m = 0; m < 4; ++m) { const int pos = row0 + ai * HALF + m * 16; const float w = slot_w[pos]; const int tok = slot_tok[pos];
#pragma unroll
                for (int bj = 0; bj < 2; ++bj) {
#pragma unroll
                    for (int n = 0; n < 2; ++n) *(LAS f32x4*)(st + fr * 36 + 16 * n + 4 * fq) = acc[ai][bj][m][n];
                    asm volatile("s_waitcnt lgkmcnt(0)" ::: "memory");
#pragma unroll
                    for (int i = 0; i < 8; ++i) { const int r = 2 * i + lrow; const float v = st[r * 36 + lcol];
                        const float wr_ = __shfl(w, r); const int tr_ = __shfl(tok, r);
                        if (wr_ != 0.f) unsafeAtomicAdd(out + (size_t)tr_ * DM + u.pn * BM + bj * HALF + wc * 32 + lcol, (v + bv[bj]) * wr_); }
                    asm volatile("s_waitcnt lgkmcnt(0)" ::: "memory");
                } }
    }
};
}

#define XB_TMO      128
#define XB_XCNT(j)  (256  + 64 * (j))
#define XB_XSUB(j)  (1280 + 64 * (j))
#define XB_XGEN(j)  (2304 + 64 * (j))
#define XB_TOP      3328
#define XB_TOPGEN   3392
#define XCD_BAR_WORDS 3456
#define XB_SPIN_CAP (1u << 18)

__device__ __forceinline__ unsigned xb_ld(unsigned* p)              { return __hip_atomic_load(p, __ATOMIC_RELAXED, __HIP_MEMORY_SCOPE_AGENT); }
__device__ __forceinline__ unsigned xb_add(unsigned* p, unsigned v) { return __hip_atomic_fetch_add(p, v, __ATOMIC_RELAXED, __HIP_MEMORY_SCOPE_AGENT); }
__device__ __forceinline__ unsigned xb_xcc_id() { return (unsigned)__builtin_amdgcn_s_getreg((3 << 11) | 20) & 0xFu; }
#define XB_SPIN(cond, bar) do { unsigned _sp = 0; while (cond) { __builtin_amdgcn_s_sleep(1); \
    if ((++_sp & 255u) == 0u) { if (xb_ld(&(bar)[XB_TMO])) break; if (_sp > XB_SPIN_CAP) { atomicAdd(&(bar)[XB_TMO], 1u); break; } } } } while (0)

struct XcdBarrier {
    unsigned* bar; unsigned x; int wave;
    volatile LAS unsigned* st;
};

__device__ __forceinline__ XcdBarrier xcd_barrier_post(unsigned* bar, volatile LAS unsigned* st) {
    XcdBarrier b; b.bar = bar; b.x = xb_xcc_id(); b.st = st; b.wave = __builtin_amdgcn_readfirstlane((int)(threadIdx.x >> 6));
    if (threadIdx.x == 0) (void)xb_add(&bar[XB_XCNT(b.x)], 1u);
    return b;
}
__device__ __forceinline__ void xcd_barrier_complete(unsigned* bar, unsigned x, unsigned& nloc, unsigned& nx) {
    const unsigned G = gridDim.x * gridDim.y * gridDim.z;
    unsigned sum, cnt, mine, sp = 0u;
    for (;;) {
        sum = 0u; cnt = 0u; mine = 0u;
#pragma unroll
        for (unsigned j = 0; j < 16; ++j) { const unsigned c = xb_ld(&bar[XB_XCNT(j)]); sum += c; cnt += (c > 0u) ? 1u : 0u; mine = (j == x) ? c : mine; }
        if (sum == G) break;
        __builtin_amdgcn_s_sleep(1);
        if ((++sp & 255u) == 0u) { if (xb_ld(&bar[XB_TMO])) break; if (sp > XB_SPIN_CAP) { atomicAdd(&bar[XB_TMO], 1u); break; } }
    }
    nloc = mine > 0u ? mine : 1u; nx = cnt > 0u ? cnt : 1u;
}

__device__ __forceinline__ void xcd_barrier(const XcdBarrier& b) {
    asm volatile("s_waitcnt vmcnt(0)" ::: "memory");
    __syncthreads();
    if (b.wave == 0 && lane_id_fresh() == 0) {
        unsigned* bar = b.bar;
        __builtin_amdgcn_s_waitcnt(0);
        unsigned nloc = b.st[0], nx = b.st[1];
        if (nloc == 0u) { xcd_barrier_complete(bar, b.x, nloc, nx); b.st[0] = nloc; b.st[1] = nx; }
        const unsigned old = xb_add(&bar[XB_XSUB(b.x)], 1u);
        const unsigned gen = old / nloc;
        if (old + 1u == (gen + 1u) * nloc) {
            __builtin_amdgcn_fence(__ATOMIC_RELEASE, "agent");
            asm volatile("s_waitcnt vmcnt(0)" ::: "memory");
            const unsigned og = xb_add(&bar[XB_TOP], 1u);
            const unsigned tg = og / nx;
            if (og + 1u == (tg + 1u) * nx) xb_add(&bar[XB_TOPGEN], 1u);
            else XB_SPIN(xb_ld(&bar[XB_TOPGEN]) == tg, bar);
            __builtin_amdgcn_fence(__ATOMIC_ACQUIRE, "agent");
            xb_add(&bar[XB_XGEN(b.x)], 1u);
            asm volatile("s_waitcnt vmcnt(0)" ::: "memory");
        } else {
            XB_SPIN(xb_ld(&bar[XB_XGEN(b.x)]) == gen, bar);
            __builtin_amdgcn_fence(__ATOMIC_ACQUIRE, "agent");
            asm volatile("s_waitcnt vmcnt(0)" ::: "memory");
        }
    }
    __syncthreads();
}

constexpr int NWAVES = 8;
struct Frame {
    LAS unsigned char* lds;
    volatile LAS unsigned* MISC;
    gu32* ctl;
    int tid, lane, wave, G, blk;
    const float* in[21];
    float* out; unsigned char* ws;
};
__device__ __forceinline__ float wave_sum(float v) {
#pragma unroll
    for (int o = 1; o < 64; o <<= 1) v += __shfl_xor(v, o);
    return v;
}

__device__ __forceinline__ int map_src(int mode, int n) {
    if (mode == 1) return n < 2500 ? n : (n >= C_MQ ? n - (C_MQ - 2500) : -1);
    if (mode == 2) { const int pn = n >> 8, bj = (n >> 7) & 1, j = n & 127; return bj * 1024 + pn * 128 + j; }
    return n;
}
__device__ __forceinline__ void transpose_item(const float* W, int K, int Nsrc, int Ndst, bf16_t* WT, int mode, LAS float* scr, int item, int lane) {
    const int nblk = Ndst / 32, kb = item / nblk, nb = item % nblk, k0 = 64 * kb, n0 = 32 * nb;
    const int sc = map_src(mode, n0 + (lane & 31));
    const float scale = (mode == 1 && (n0 + (lane & 31)) < 512) ? 0.125f : 1.0f;
#pragma unroll
    for (int i = 0; i < 32; ++i) { const int kk = 2 * i + (lane >> 5); scr[kk * 33 + (lane & 31)] = sc >= 0 ? W[(size_t)(k0 + kk) * Nsrc + sc] * scale : 0.f; }
    LDS_WAIT(); asm volatile("" ::: "memory");
    const int c = lane & 7;
#pragma unroll
    for (int j = 0; j < 4; ++j) { const int n = (lane >> 3) + 8 * j; const LAS float* s = scr + (8 * c) * 33 + n;
        u32x4 o; o.x = pk2(s[0 * 33], s[1 * 33]); o.y = pk2(s[2 * 33], s[3 * 33]); o.z = pk2(s[4 * 33], s[5 * 33]); o.w = pk2(s[6 * 33], s[7 * 33]);
        *(GAS u32x4*)(WT + (size_t)(n0 + n) * K + k0 + 8 * c) = o; }
    LDS_WAIT(); asm volatile("" ::: "memory");
}
__device__ __forceinline__ unsigned pk4_f8(float a, float b, float c, float d) { int v = __builtin_amdgcn_cvt_pk_fp8_f32(a, b, 0, false); return (unsigned)__builtin_amdgcn_cvt_pk_fp8_f32(c, d, v, true); }
__device__ __forceinline__ void transpose_item_f8(const float* W, int K, int Nsrc, int Ndst, unsigned char* WT, int mode, float scale, LAS float* scr, int item, int lane) {
    const int nblk = Ndst / 32, kb = item / nblk, nb = item % nblk, k0 = 64 * kb, n0 = 32 * nb;
    const int sc = map_src(mode, n0 + (lane & 31));
#pragma unroll
    for (int i = 0; i < 32; ++i) { const int kk = 2 * i + (lane >> 5); scr[kk * 33 + (lane & 31)] = sc >= 0 ? W[(size_t)(k0 + kk) * Nsrc + sc] * scale : 0.f; }
    LDS_WAIT(); asm volatile("" ::: "memory");
    const int c = lane & 7;
#pragma unroll
    for (int j = 0; j < 4; ++j) { const int n = (lane >> 3) + 8 * j; const LAS float* s = scr + (8 * c) * 33 + n;
        u32x2 o; o.x = pk4_f8(s[0 * 33], s[1 * 33], s[2 * 33], s[3 * 33]); o.y = pk4_f8(s[4 * 33], s[5 * 33], s[6 * 33], s[7 * 33]);
        *(GAS u32x2*)(WT + (size_t)(n0 + n) * K + k0 + 8 * c) = o; }
    LDS_WAIT(); asm volatile("" ::: "memory");
}
__device__ __forceinline__ void rms_row_to_bf16(int lane, const float* xrow, const float* g, bf16_t* orow) {
    const GAS f32x4* xr = (const GAS f32x4*)xrow + lane; const GAS f32x4* gr = (const GAS f32x4*)g + lane;
    f32x4 v[4]; float s = 0.f;
#pragma unroll
    for (int j = 0; j < 4; ++j) { v[j] = xr[64 * j]; s += (v[j].x * v[j].x + v[j].y * v[j].y) + (v[j].z * v[j].z + v[j].w * v[j].w); }
    const float rstd = 1.0f / sqrtf(wave_sum(s) * (1.f / DM) + EPS);
    GAS u32x2* o8 = (GAS u32x2*)orow + lane;
#pragma unroll
    for (int j = 0; j < 4; ++j) { const f32x4 gg = gr[64 * j]; u32x2 o; o.x = pk2(v[j].x * rstd * gg.x, v[j].y * rstd * gg.y); o.y = pk2(v[j].z * rstd * gg.z, v[j].w * rstd * gg.w); o8[64 * j] = o; }
}

__device__ __forceinline__ void rms_rows4_to_bf16(int lane, const float* x, const float* g, bf16_t* o, size_t m0, size_t stride) {
    f32x4 v[4][4]; float s[4];
#pragma unroll
    for (int r = 0; r < 4; ++r) { const GAS f32x4* xr = (const GAS f32x4*)(x + (m0 + r * stride) * DM) + lane;
#pragma unroll
        for (int j = 0; j < 4; ++j) v[r][j] = xr[64 * j]; }
    const GAS f32x4* gr = (const GAS f32x4*)g + lane;
    f32x4 gg[4];
#pragma unroll
    for (int j = 0; j < 4; ++j) gg[j] = gr[64 * j];
#pragma unroll
    for (int r = 0; r < 4; ++r) { float a = 0.f;
#pragma unroll
        for (int j = 0; j < 4; ++j) a += (v[r][j].x * v[r][j].x + v[r][j].y * v[r][j].y) + (v[r][j].z * v[r][j].z + v[r][j].w * v[r][j].w);
        s[r] = a; }
#pragma unroll
    for (int of = 1; of < 64; of <<= 1) {
#pragma unroll
        for (int r = 0; r < 4; ++r) s[r] += __shfl_xor(s[r], of); }
#pragma unroll
    for (int r = 0; r < 4; ++r) { const float rstd = 1.0f / sqrtf(s[r] * (1.f / DM) + EPS);
        GAS u32x2* o8 = (GAS u32x2*)(o + (m0 + r * stride) * DM) + lane;
#pragma unroll
        for (int j = 0; j < 4; ++j) { u32x2 w; w.x = pk2(v[r][j].x * rstd * gg[j].x, v[r][j].y * rstd * gg[j].y); w.y = pk2(v[r][j].z * rstd * gg[j].z, v[r][j].w * rstd * gg[j].w); o8[64 * j] = w; } }
}
__device__ __forceinline__ void p0_prologue(Frame& F) {
    LAS float* scr = (LAS float*)(F.lds + F.wave * 16384);
    const int gw = F.blk * NWAVES + F.wave, NGW = F.G * NWAVES, lane = F.lane;
    unsigned char* ws = F.ws;
    constexpr int I_IN = 16 * 96, I_MKV = 16 * 32, I_G = 16 * 32, I_B = 8 * 32, I_O = 16 * 32, I_EI = 16 * 64, I_EO = 16 * 32;
    constexpr int NITEMS = I_IN + I_MKV + 3 * I_G + 3 * I_B + I_O + NEXP * I_EI + NEXP * I_EO;
    for (int it = gw; it < NITEMS; it += NGW) {
        int r = it;
        if (r < I_IN) { transpose_item(F.in[3], DM, IN_W, PW, (bf16_t*)(ws + WS_WIN), 1, scr, r, lane); continue; } r -= I_IN;
        if (r < I_MKV) { transpose_item(F.in[9], DM, DM, DM, (bf16_t*)(ws + WS_WMKV), 0, scr, r, lane); continue; } r -= I_MKV;
        if (r < 3 * I_G) { const int n = r / I_G; transpose_item(F.in[10] + (size_t)n * DM * DM, DM, DM, DM, (bf16_t*)(ws + WS_WG) + (size_t)n * DM * DM, 0, scr, r % I_G, lane); continue; } r -= 3 * I_G;
        if (r < 3 * I_B) { const int n = r / I_B; transpose_item(F.in[12] + (size_t)n * 512 * DM, 512, DM, DM, (bf16_t*)(ws + WS_WB) + (size_t)n * DM * 512, 0, scr, r % I_B, lane); continue; } r -= 3 * I_B;
        if (r < I_O) { transpose_item(F.in[13], DM, DM, DM, (bf16_t*)(ws + WS_WO), 0, scr, r, lane); continue; } r -= I_O;
        if (r < NEXP * I_EI) { const int e = r / I_EI; transpose_item_f8(F.in[17] + (size_t)e * DM * 2048, DM, 2048, 2048, ws + WS_WEI + (size_t)e * 2048 * DM, 2, W8_SCALE, scr, r % I_EI, lane); continue; } r -= NEXP * I_EI;
        { const int e = r / I_EO; transpose_item(F.in[19] + (size_t)e * DM * DM, DM, DM, DM, (bf16_t*)(ws + WS_WEO) + (size_t)e * DM * DM, 0, scr, r % I_EO, lane); }
    }
    { f32x2* tab = (f32x2*)(ws + WS_ROPE);
      for (int idx = (F.blk * NWAVES * 64) + F.tid; idx < SEQ * 32; idx += F.G * NWAVES * 64) {
          const int s = idx >> 5, i = idx & 31;
          const float inv = exp2f(-(float)i * (13.287712379549449f / 32.0f));
          const float ang = (float)s * inv;
          const double rev = (double)ang * 0.15915494309189535;
          const float fr = (float)(rev - __builtin_rint(rev));
          tab[idx] = (f32x2){__builtin_amdgcn_cosf(fr), __builtin_amdgcn_sinf(fr)}; } }
    for (int m = gw; m < NTOK; m += 4 * NGW) rms_rows4_to_bf16(lane, F.in[0], F.in[2], (bf16_t*)(ws + WS_H), (size_t)m, (size_t)NGW);
    for (int m = gw; m < NMEM; m += 4 * NGW) rms_rows4_to_bf16(lane, F.in[1], F.in[8], (bf16_t*)(ws + WS_MEMN), (size_t)m, (size_t)NGW);
    { int* st = (int*)(ws + WS_SLOT_TOK); float* sw = (float*)(ws + WS_SLOT_W);
      for (int i = F.blk * NWAVES * 64 + F.tid; i < NSLOT_PAD; i += F.G * NWAVES * 64) { st[i] = 0; sw[i] = 0.f; } }
}

template <int CTRL> __device__ __forceinline__ float dppf(float v) { return __builtin_bit_cast(float, __builtin_amdgcn_update_dpp(0, __builtin_bit_cast(int, v), CTRL, 0xF, 0xF, false)); }
__device__ __forceinline__ float lx1(float v) { return dppf<0xB1>(v); }
__device__ __forceinline__ float lx2(float v) { return dppf<0x4E>(v); }
__device__ __forceinline__ float lx4(float v) { return dppf<0x1B>(dppf<0x141>(v)); }
__device__ __forceinline__ float lx8(float v) { return dppf<0x128>(v); }
__device__ __forceinline__ void un8(const u32x4 w, float (&v)[8]) { v[0] = bflo(w.x); v[1] = bfhi(w.x); v[2] = bflo(w.y); v[3] = bfhi(w.y); v[4] = bflo(w.z); v[5] = bfhi(w.z); v[6] = bflo(w.w); v[7] = bfhi(w.w); }
__device__ __forceinline__ u32x4 pk8(const float (&v)[8]) { u32x4 w; w.x = pk2(v[0], v[1]); w.y = pk2(v[2], v[3]); w.z = pk2(v[4], v[5]); w.w = pk2(v[6], v[7]); return w; }
__device__ __forceinline__ void rope8(float (&v)[8], const f32x2 (&cs)[8], bool up) {
#pragma unroll
    for (int j = 0; j < 8; ++j) { const float other = lx4(v[j]); v[j] = up ? (other * cs[j].y + v[j] * cs[j].x) : (v[j] * cs[j].x - other * cs[j].y); }
}
__device__ __forceinline__ void p2_prep(Frame& F, const bool dummy = false) {
    const int gw = F.blk * NWAVES + F.wave, NGW = F.G * NWAVES, lane = F.lane;
    bf16_t* proj = (bf16_t*)(F.ws + WS_P);
    bf16_t* projw = dummy ? (bf16_t*)(F.ws + WS_END) : proj;
    const int wmask = dummy ? 8191 : 0x7fffffff;
    const f32x2* tab = (const f32x2*)(F.ws + WS_ROPE);
    float gqd[8], gkd[8], gqm[8];
#pragma unroll
    for (int j = 0; j < 8; ++j) { gqd[j] = F.in[4][8 * (lane & 7) + j] * (0.125f * LOG2E); gkd[j] = F.in[5][8 * (lane & 7) + j]; gqm[j] = F.in[6][8 * (lane & 15) + j] * (0.08838834764831845f * LOG2E); }
    const bool up = (lane & 4) != 0; const int i0 = (lane & 3) * 8;
    for (int m0 = gw; m0 < NTOK; m0 += 2 * NGW) {
        u32x4 raw[2][5]; f32x2 cs[2][8];
#pragma unroll
        for (int t = 0; t < 2; ++t) { const GAS bf16_t* row = (const GAS bf16_t*)proj + (size_t)(m0 + t * NGW) * PW;
            raw[t][0] = *(const GAS u32x4*)(row + C_DQ + 8 * lane); raw[t][1] = *(const GAS u32x4*)(row + C_DK + 8 * (lane & 7)); raw[t][2] = *(const GAS u32x4*)(row + C_IQ + 8 * (lane & 31));
            raw[t][3] = *(const GAS u32x4*)(row + C_IK + 8 * (lane & 7)); raw[t][4] = *(const GAS u32x4*)(row + C_MQ + 8 * lane);
            const GAS f32x2* tr = (const GAS f32x2*)tab + (size_t)((m0 + t * NGW) & (SEQ - 1)) * 32 + i0;
#pragma unroll
            for (int j = 0; j < 8; ++j) cs[t][j] = tr[j]; }
#pragma unroll
        for (int t = 0; t < 2; ++t) {
            GAS bf16_t* roww = (GAS bf16_t*)projw + (size_t)((m0 + t * NGW) & wmask) * PW;
            float v[8];
            { un8(raw[t][0], v); float ss = 0.f;
#pragma unroll
              for (int j = 0; j < 8; ++j) ss += v[j] * v[j];
              ss += lx1(ss); ss += lx2(ss); ss += lx4(ss);
              const float rstd = 1.0f / sqrtf(ss * (1.f / 64.f) + EPS);
#pragma unroll
              for (int j = 0; j < 8; ++j) v[j] = v[j] * rstd * gqd[j];
              rope8(v, cs[t], up);
              *(GAS u32x4*)(roww + C_DQ + 8 * lane) = pk8(v); }
            { un8(raw[t][1], v); float ss = 0.f;
#pragma unroll
              for (int j = 0; j < 8; ++j) ss += v[j] * v[j];
              ss += lx1(ss); ss += lx2(ss); ss += lx4(ss);
              const float rstd = 1.0f / sqrtf(ss * (1.f / 64.f) + EPS);
#pragma unroll
              for (int j = 0; j < 8; ++j) v[j] = v[j] * rstd * gkd[j];
              rope8(v, cs[t], up);
              if (lane < 8) *(GAS u32x4*)(roww + C_DK + 8 * lane) = pk8(v); }
            { un8(raw[t][2], v); rope8(v, cs[t], up); if (lane < 32) *(GAS u32x4*)(roww + C_IQ + 8 * lane) = pk8(v); }
            { un8(raw[t][3], v); rope8(v, cs[t], up); if (lane < 8) *(GAS u32x4*)(roww + C_IK + 8 * lane) = pk8(v); }
            { un8(raw[t][4], v); float ss = 0.f;
#pragma unroll
              for (int j = 0; j < 8; ++j) ss += v[j] * v[j];
              ss += lx1(ss); ss += lx2(ss); ss += lx4(ss); ss += lx8(ss);
              const float rstd = 1.0f / sqrtf(ss * (1.f / 128.f) + EPS);
#pragma unroll
              for (int j = 0; j < 8; ++j) v[j] = v[j] * rstd * gqm[j];
              *(GAS u32x4*)(roww + C_MQ + 8 * lane) = pk8(v); }
        }
    }
    bf16_t* mkv = (bf16_t*)(F.ws + WS_MKV);
    if (!dummy) for (int m = gw; m < NMEM; m += NGW) {
        GAS bf16_t* row = (GAS bf16_t*)mkv + (size_t)m * DM; float v[8];
        un8(*(const GAS u32x4*)(row + 8 * lane), v); float ss = 0.f;
#pragma unroll
        for (int j = 0; j < 8; ++j) ss += v[j] * v[j];
        ss += lx1(ss); ss += lx2(ss); ss += lx4(ss); ss += lx8(ss);
        const float rstd = 1.0f / sqrtf(ss * (1.f / 128.f) + EPS);
#pragma unroll
        for (int j = 0; j < 8; ++j) v[j] = v[j] * rstd * F.in[7][8 * (lane & 15) + j];
        *(GAS u32x4*)(row + 8 * lane) = pk8(v);
    }
}

#define MFMA32(a, b, c) __builtin_amdgcn_mfma_f32_32x32x16_bf16((a), (b), (c), 0, 0, 0)
typedef LAS const unsigned char* lds_cptr;
__device__ __forceinline__ s16x4 vtr(lds_cptr p) { return __builtin_bit_cast(s16x4, __builtin_amdgcn_ds_read_tr16_b64_v4i16((LAS v4i16_t*)p)); }
__device__ __forceinline__ bf16x8 vfrag(lds_cptr vbase_lane, int off) {
    const s16x4 lo = vtr(vbase_lane + off), hi = vtr(vbase_lane + off + 512);
    return (bf16x8){lo[0], lo[1], lo[2], lo[3], hi[0], hi[1], hi[2], hi[3]};
}
__device__ __forceinline__ int vtr_lane_off(int lane) { return ((lane >> 4) & 1) * 32 + (lane & 3) * 8 + (4 * (lane >> 5) + ((lane & 15) >> 2)) * 64; }
__device__ __forceinline__ bf16x8 pack8(const float* p) {
    u32x4 w; w.x = cvt_pk_bf16(p[0], p[1]); w.y = cvt_pk_bf16(p[2], p[3]); w.z = cvt_pk_bf16(p[4], p[5]); w.w = cvt_pk_bf16(p[6], p[7]);
    return __builtin_bit_cast(bf16x8, w);
}
__device__ __forceinline__ float softplus_f(float z) { return fmaxf(z, 0.f) + __logf(1.f + __expf(-fabsf(z))); }

__device__ __forceinline__ void sb_item(const bf16_t* proj, bf16_t* osb, int b, int h, int qblk, LAS unsigned char* vlds, int lane) {
    const int r32 = lane & 31, hi = lane >> 5;
    const size_t tok0 = (size_t)b * SEQ + (size_t)qblk * 32;
    bf16x8 qr[4];
    { const bf16_t* qp = proj + (tok0 + r32) * PW + C_SQ + h * 64 + hi * 8;
#pragma unroll
      for (int kk = 0; kk < 4; ++kk) qr[kk] = *(const bf16x8*)(qp + kk * 16); }
    f32x16 o0 = {}, o1 = {}; float R = 0.f;
    const lds_cptr vrd = (lds_cptr)vlds + vtr_lane_off(lane);
    bf16x8 kfn[4]; u32x4 vvn[4];
#define SB_LOAD(kt_) do { const size_t key0_ = (size_t)b * SEQ + (size_t)(kt_) * 32; const GAS bf16_t* kp_ = (const GAS bf16_t*)proj + (key0_ + r32) * PW + C_SK + h * 64 + hi * 8; \
        _Pragma("unroll") for (int kk = 0; kk < 4; ++kk) kfn[kk] = *(const GAS bf16x8*)(kp_ + kk * 16); \
        _Pragma("unroll") for (int p = 0; p < 4; ++p) vvn[p] = *(const GAS u32x4*)((const GAS bf16_t*)proj + (key0_ + 16 * (p & 1) + (lane >> 2)) * PW + C_SV + h * 64 + (p >> 1) * 32 + (lane & 3) * 8); } while (0)
    SB_LOAD(qblk);
    for (int kt = qblk; kt >= 0; --kt) {
        bf16x8 kf[4]; u32x4 vv[4];
#pragma unroll
        for (int i = 0; i < 4; ++i) { kf[i] = kfn[i]; vv[i] = vvn[i]; }
        if (kt > 0) SB_LOAD(kt - 1);
        f32x16 s = {};
#pragma unroll
        for (int kk = 0; kk < 4; ++kk) s = MFMA32(kf[kk], qr[kk], s);
        asm volatile("" ::: "memory");
#pragma unroll
        for (int p = 0; p < 4; ++p) *(LAS u32x4*)(vlds + p * 1024 + lane * 16) = vv[p];
        const bool diag = (kt == qblk);
        float sp[16], pr[16];
#pragma unroll
        for (int r = 0; r < 16; ++r) { const bool valid = !diag || (crow(r, hi) < r32); sp[r] = valid ? softplus_f(s[r]) : 0.f; }
        float T[4], U[4];
#pragma unroll
        for (int g = 0; g < 4; ++g) { T[g] = (sp[4 * g] + sp[4 * g + 1]) + (sp[4 * g + 2] + sp[4 * g + 3]); { const auto rr = __builtin_amdgcn_permlane32_swap(__float_as_uint(T[g]), __float_as_uint(T[g]), false, false); U[g] = hi ? __uint_as_float(rr[0]) : __uint_as_float(rr[1]); } }
        float run = 0.f, above[4];
#pragma unroll
        for (int g = 3; g >= 0; --g) { above[g] = run + (hi == 0 ? U[g] : 0.f); run += T[g] + U[g]; }
#pragma unroll
        for (int g = 0; g < 4; ++g) { float c = R + above[g];
#pragma unroll
            for (int j = 3; j >= 0; --j) { const int r = 4 * g + j; c += sp[r]; const bool valid = !diag || (crow(r, hi) < r32); pr[r] = valid ? __expf(s[r] - c) : 0.f; } }
        R += run;
        const bf16x8 p0 = pack8(pr), p1 = pack8(pr + 8);
        LDS_WAIT();
        const bf16x8 v00 = vfrag(vrd, 0), v01 = vfrag(vrd, 1024), v10 = vfrag(vrd, 2048), v11 = vfrag(vrd, 3072);
        o0 = MFMA32(v00, p0, o0); o0 = MFMA32(v01, p1, o0);
        o1 = MFMA32(v10, p0, o1); o1 = MFMA32(v11, p1, o1);
        asm volatile("" ::: "memory");
        if (__all(R > 30.0f)) break;
    }
#undef SB_LOAD
    bf16_t* op = osb + (tok0 + r32) * 512 + h * 64 + 4 * hi;
#pragma unroll
    for (int g = 0; g < 4; ++g) {
        u32x2 w0, w1; w0.x = cvt_pk_bf16(o0[4 * g], o0[4 * g + 1]); w0.y = cvt_pk_bf16(o0[4 * g + 2], o0[4 * g + 3]); w1.x = cvt_pk_bf16(o1[4 * g], o1[4 * g + 1]); w1.y = cvt_pk_bf16(o1[4 * g + 2], o1[4 * g + 3]);
        *(u32x2*)(op + 8 * g) = w0; *(u32x2*)(op + 32 + 8 * g) = w1; }
}

constexpr int ML_K = 0, ML_KROW = 272, ML_V = 256 * ML_KROW, ML_END = ML_V + 65536;
__device__ __forceinline__ void mem_unit(const bf16_t* proj, const bf16_t* mkv, bf16_t* omem, int b, int h, int half, LAS unsigned char* ml, int tid) {
    const int lane = tid & 63, wid = __builtin_amdgcn_readfirstlane(tid >> 6), r32 = lane & 31, hi = lane >> 5;
    { const GAS bf16_t* src = (const GAS bf16_t*)mkv + (size_t)b * MEMLEN * DM + h * 128;
#pragma unroll
      for (int i = 0; i < 8; ++i) { const int ch = tid + 512 * i, key = ch >> 4, c16 = ch & 15, kk = key & 31;
          const u32x4 kv = *(const GAS u32x4*)(src + (size_t)key * DM + c16 * 8);
          const u32x4 vv = *(const GAS u32x4*)(src + (size_t)key * DM + 512 + c16 * 8);
          *(LAS u32x4*)(ml + ML_K + key * ML_KROW + c16 * 16) = kv;
          *(LAS u32x4*)(ml + ML_V + (key >> 5) * 8192 + ((c16 >> 2) * 2 + (kk >> 4)) * 1024 + (kk & 15) * 64 + (c16 & 3) * 16) = vv; } }
    __syncthreads();
    for (int i = 0; i < 4; ++i) {
        const int qblk = half * 32 + wid * 4 + i;
        const size_t tok0 = (size_t)b * SEQ + (size_t)qblk * 32;
        bf16x8 qr[8];
        { const GAS bf16_t* qp = (const GAS bf16_t*)proj + (tok0 + r32) * PW + C_MQ + h * 128 + hi * 8;
#pragma unroll
          for (int kk = 0; kk < 8; ++kk) qr[kk] = *(const GAS bf16x8*)(qp + kk * 16); }
        f32x16 o[4] = {{}, {}, {}, {}}; float m = -1e30f, l = 0.f;
        for (int kb = 0; kb < 8; ++kb) {
            const LAS unsigned char* krd = ml + ML_K + (32 * kb + r32) * ML_KROW + hi * 16;
            f32x16 s = {};
#pragma unroll
            for (int kk = 0; kk < 8; ++kk) { const bf16x8 kf = *(const LAS bf16x8*)(krd + kk * 32); s = MFMA32(kf, qr[kk], s); }
            float mx = s[0];
#pragma unroll
            for (int r = 1; r < 16; ++r) mx = fmaxf(mx, s[r]);
            { const auto rr = __builtin_amdgcn_permlane32_swap(__float_as_uint(mx), __float_as_uint(mx), false, false); mx = fmaxf(__uint_as_float(rr[0]), __uint_as_float(rr[1])); }
            if (__any(mx > m + 8.0f)) {
                const float mn = fmaxf(m, mx), alpha = __builtin_amdgcn_exp2f(m - mn);
                l *= alpha; m = mn;
#pragma unroll
                for (int d = 0; d < 4; ++d)
#pragma unroll
                    for (int r = 0; r < 16; ++r) o[d][r] *= alpha;
            }
            float pr[16], rs = 0.f;
#pragma unroll
            for (int r = 0; r < 16; ++r) { pr[r] = __builtin_amdgcn_exp2f(s[r] - m); rs += pr[r]; }
            l += rs;
            const bf16x8 p0 = pack8(pr), p1 = pack8(pr + 8);
            const lds_cptr vrd = (lds_cptr)ml + ML_V + kb * 8192 + vtr_lane_off(lane);
#pragma unroll
            for (int d = 0; d < 4; ++d) { const bf16x8 va = vfrag(vrd, d * 2048), vb = vfrag(vrd, d * 2048 + 1024); o[d] = MFMA32(va, p0, o[d]); o[d] = MFMA32(vb, p1, o[d]); }
        }
        { const auto rr = __builtin_amdgcn_permlane32_swap(__float_as_uint(l), __float_as_uint(l), false, false); l = __uint_as_float(rr[0]) + __uint_as_float(rr[1]); }
        const float il = 1.0f / l;
        bf16_t* op = omem + (tok0 + r32) * 512 + h * 128 + 4 * hi;
#pragma unroll
        for (int d = 0; d < 4; ++d)
#pragma unroll
            for (int g = 0; g < 4; ++g) { u32x2 w; w.x = cvt_pk_bf16(o[d][4 * g] * il, o[d][4 * g + 1] * il); w.y = cvt_pk_bf16(o[d][4 * g + 2] * il, o[d][4 * g + 3] * il); *(u32x2*)(op + 32 * d + 8 * g) = w; }
    }
    __syncthreads();
}

constexpr int DL_HIST = 0, DL_PREFIX = 66048, DL_KREM = DL_PREFIX + 256, DL_MASK = 67072, DL_VT = 73728, DL_KT = DL_VT + 2 * 16384, DL_END = DL_KT + 2 * 18432, DL_IQ = DL_VT;
constexpr int TOPK_DSA = 256;

struct IqLds { const LAS unsigned char* p; __device__ __forceinline__ bf16x8 operator()(int j) const { return *(const LAS bf16x8*)(p + j * 32); } };
template <class QF>
__device__ __forceinline__ void idx_scores(const QF& qf, const bf16x8 (&kf)[4], const float (&wq)[4], unsigned (&uk)[16]) {
    float scv[16];
#pragma unroll
    for (int hd = 0; hd < 4; ++hd) { f32x16 a = (f32x16){};
#pragma unroll
        for (int kk = 0; kk < 4; ++kk) a = MFMA32(kf[kk], qf(hd * 4 + kk), a);
#pragma unroll
        for (int r = 0; r < 16; ++r) scv[r] = (hd == 0) ? wq[0] * fmaxf(a[r], 0.f) : __builtin_fmaf(wq[hd], fmaxf(a[r], 0.f), scv[r]); }
#pragma unroll
    for (int r = 0; r < 16; ++r) {
        unsigned bits = __builtin_bit_cast(unsigned, scv[r]);
        if (bits == 0x80000000u) bits = 0u;
        uk[r] = bits ^ ((unsigned)((int)bits >> 31) | 0x80000000u);
    }
}
__device__ __forceinline__ void load_ik(const bf16_t* proj, size_t tokb, int kbase, int r32, int hi, bf16x8 (&kf)[4]) {
    int kr = kbase + r32; if (kr > SEQ - 1) kr = SEQ - 1;
    const GAS bf16_t* p = (const GAS bf16_t*)proj + (tokb + kr) * PW + C_IK + 8 * hi;
#pragma unroll
    for (int kk = 0; kk < 4; ++kk) kf[kk] = *(const GAS bf16x8*)(p + kk * 16);
}

__device__ __forceinline__ void dsa_unit(const bf16_t* proj, bf16_t* odsa, unsigned* kscr  , int b, int c, LAS unsigned char* dl, int tid) {
    const int lane = tid & 63, wid = __builtin_amdgcn_readfirstlane(tid >> 6), r32 = lane & 31, hi = lane >> 5;
    const int n = 64 * (c + 1), nsteps = (n + 127) >> 7;
    const size_t tokq0 = (size_t)b * SEQ + (size_t)c * 64, tokb = (size_t)b * SEQ;
    LAS unsigned* hist = (LAS unsigned*)(dl + DL_HIST);
    LAS unsigned* prefix = (LAS unsigned*)(dl + DL_PREFIX);
    LAS unsigned* krem = (LAS unsigned*)(dl + DL_KREM);
    LAS unsigned* mask = (LAS unsigned*)(dl + DL_MASK);
    const int kb = wid >> 1, qh = wid & 1;
    { const int row = tid >> 3, c = tid & 7;
      const GAS bf16_t* src = (const GAS bf16_t*)proj + (tokq0 + row) * PW + C_IQ + c * 32;
#pragma unroll
      for (int i = 0; i < 4; ++i) *(LAS u32x4*)(dl + DL_IQ + row * 528 + c * 64 + i * 16) = *(const GAS u32x4*)(src + i * 8); }
    const IqLds iqf{dl + DL_IQ + (32 * qh + r32) * 528 + hi * 16};
    float wq[4];
    { const u32x2 w = *(const u32x2*)(proj + (tokq0 + 32 * qh + r32) * PW + C_IW);
      wq[0] = bflo(w.x) * 0.0625f; wq[1] = bfhi(w.x) * 0.0625f; wq[2] = bflo(w.y) * 0.0625f; wq[3] = bfhi(w.y) * 0.0625f; }
#ifndef REP_SEL
#define REP_SEL 1
#endif
#ifndef REP_B2
#define REP_B2 1
#endif
    LAS unsigned* selall = (LAS unsigned*)(dl + DL_HIST);
#ifndef PROBE_NOATOM
#define PROBE_NOATOM 0
#endif
    unsigned dummy = 0u;
    for (int rep_sel = 0; rep_sel < REP_SEL; ++rep_sel) {
    if (tid < 64) { prefix[tid] = 0u; krem[tid] = (n > TOPK_DSA) ? (unsigned)TOPK_DSA : 0x7fffffffu; }
    __syncthreads();
    const int pass0 = (n > TOPK_DSA) ? 0 : 3;
    GAS u32x4* kmine = (GAS u32x4*)kscr + ((size_t)wid * 64 + lane) * 4;
#define DSA_CONSUME(uk_) do { \
        if (sel) { _Pragma("unroll") for (int r = 0; r < 16; ++r) { const bool match = (pass == 0) || (((uk_)[r] >> (shift + 8)) == pfx); \
                if (match && !(PROBE_NOATOM && rep_sel + 1 < REP_SEL)) __hip_atomic_fetch_add(hist + (32 * qh + r32) * 257 + (((uk_)[r] >> shift) & 255u), 1u, __ATOMIC_RELAXED, __HIP_MEMORY_SCOPE_WORKGROUP); else dummy ^= (uk_)[r]; } } \
        else { _Pragma("unroll") for (int r = 0; r < 16; ++r) { const unsigned k24 = (uk_)[r] >> 8; gtw |= (k24 > pfx ? 1u : 0u) << crow(r, hi); eqw |= (k24 == pfx ? 1u : 0u) << crow(r, hi); } } } while (0)
#define DSA_TIES() do { if (!sel) { \
        LAS unsigned* mk = mask + (step & 1) * 768; \
        { const auto rg = __builtin_amdgcn_permlane32_swap(gtw, gtw, false, false); gtw = rg[0] | rg[1]; const auto re = __builtin_amdgcn_permlane32_swap(eqw, eqw, false, false); eqw = re[0] | re[1]; } \
        if (hi == 0) { mk[(32 * qh + r32) * 4 + kb] = gtw; mk[256 + (32 * qh + r32) * 4 + kb] = eqw; } \
        __syncthreads(); \
        if (wid == 0) { unsigned nd = krem[lane]; \
            _Pragma("unroll") for (int k4 = 0; k4 < 4; ++k4) { const unsigned g = mk[lane * 4 + k4]; unsigned e = mk[256 + lane * 4 + k4]; unsigned sl = g; \
                if (e != 0u) { const unsigned cnt = (unsigned)__builtin_popcount(e); \
                    if (cnt <= nd) { sl |= e; nd -= cnt; } \
                    else { unsigned chosen = 0u; while (nd > 0u) { const unsigned lb = e & (0u - e); chosen |= lb; e ^= lb; --nd; } sl |= chosen; } } \
                selall[lane * 64 + step * 4 + k4] = sl; } \
            krem[lane] = nd; } } } while (0)
    for (int pass = pass0; pass < ((rep_sel + 1 < REP_SEL) ? 3 : 4); ++pass) {
        const bool sel = pass < 3;
        if (sel) { for (int i = tid; i < 64 * 257; i += 512) hist[i] = 0u; __syncthreads(); }
        const int shift = 24 - 8 * pass;
        const unsigned pfx = prefix[32 * qh + r32];
        if (pass == pass0) {
            bf16x8 kfn[4]; load_ik(proj, tokb, 32 * kb, r32, hi, kfn);
            for (int step = 0; step < nsteps; ++step) {
                const int kbase = 128 * step + 32 * kb;
                bf16x8 kf[4];
#pragma unroll
                for (int kk = 0; kk < 4; ++kk) kf[kk] = kfn[kk];
                if (step + 1 < nsteps) load_ik(proj, tokb, kbase + 128, r32, hi, kfn);
                unsigned gtw = 0u, eqw = 0u;
                if (kbase < n) {
                    unsigned uk[16];
                    idx_scores(iqf, kf, wq, uk);
                    if (pass0 == 0) {
#pragma unroll
                        for (int g = 0; g < 4; ++g) kmine[(size_t)step * 2048 + g] = (u32x4){uk[4 * g], uk[4 * g + 1], uk[4 * g + 2], uk[4 * g + 3]};
                    }
                    DSA_CONSUME(uk);
                }
                DSA_TIES();
            }
        } else {
            u32x4 ka[4], kb4[4];
#define DSA_KLOAD(dst, st_) do { _Pragma("unroll") for (int g = 0; g < 4; ++g) dst[g] = kmine[(size_t)(st_) * 2048 + g]; } while (0)
            DSA_KLOAD(ka, 0);
            if (nsteps > 1 && 128 + 32 * kb < n) DSA_KLOAD(kb4, 1);
            for (int step = 0; step < nsteps; ++step) {
                const int kbase = 128 * step + 32 * kb;
                unsigned uk[16];
#pragma unroll
                for (int g = 0; g < 4; ++g) { uk[4 * g] = ka[g].x; uk[4 * g + 1] = ka[g].y; uk[4 * g + 2] = ka[g].z; uk[4 * g + 3] = ka[g].w; }
#pragma unroll
                for (int g = 0; g < 4; ++g) ka[g] = kb4[g];
                if (step + 2 < nsteps && kbase + 256 < n) DSA_KLOAD(kb4, step + 2);
                unsigned gtw = 0u, eqw = 0u;
                if (kbase < n) DSA_CONSUME(uk);
                DSA_TIES();
            }
#undef DSA_KLOAD
        }
        if (sel) {
            __syncthreads();
#pragma unroll
            for (int qi = 0; qi < 8; ++qi) {
                const int q = 8 * wid + qi;
                const LAS unsigned* hq = hist + q * 257;
                const unsigned c0 = hq[255 - 4 * lane], c1 = hq[254 - 4 * lane], c2 = hq[253 - 4 * lane], c3 = hq[252 - 4 * lane];
                const unsigned s4 = c0 + c1 + c2 + c3;
                unsigned incl = s4;
#pragma unroll
                for (int o = 1; o < 64; o <<= 1) { const unsigned t = __shfl_up(incl, o); if (lane >= o) incl += t; }
                const unsigned excl = incl - s4, kr = krem[q];
                if (excl < kr && kr <= incl) {
                    unsigned cum = excl, bin, nk;
                    if (cum + c0 >= kr) { bin = 255 - 4 * lane; nk = kr - cum; }
                    else { cum += c0; if (cum + c1 >= kr) { bin = 254 - 4 * lane; nk = kr - cum; }
                    else { cum += c1; if (cum + c2 >= kr) { bin = 253 - 4 * lane; nk = kr - cum; }
                    else { cum += c2; bin = 252 - 4 * lane; nk = kr - cum; } } }
                    prefix[q] = (prefix[q] << 8) | bin; krem[q] = nk;
                }
            }
            __syncthreads();
        }
    }
    }
    if (dummy == 0x9e3779b9u) hist[tid] = 1u;
    const int hd = wid;
    u32x4 pk[2], pv[2];
#define DSA_LOADKV(step_) do { _Pragma("unroll") for (int i_ = 0; i_ < 2; ++i_) { const int ch_ = tid + 512 * i_; int krow_ = 128 * (step_) + (ch_ >> 3); if (krow_ > SEQ - 1) krow_ = SEQ - 1; \
        const GAS bf16_t* rp_ = (const GAS bf16_t*)proj + (tokb + krow_) * PW + (ch_ & 7) * 8; pk[i_] = *(const GAS u32x4*)(rp_ + C_DK); pv[i_] = *(const GAS u32x4*)(rp_ + C_DV); } } while (0)
#define DSA_STOREKV(buf_) do { _Pragma("unroll") for (int i_ = 0; i_ < 2; ++i_) { const int ch_ = tid + 512 * i_, key_ = ch_ >> 3, c8_ = ch_ & 7, kk_ = key_ & 31; \
        *(LAS u32x4*)(dl + DL_KT + (buf_) * 18432 + key_ * 144 + c8_ * 16) = pk[i_]; \
        *(LAS u32x4*)(dl + DL_VT + (buf_) * 16384 + (key_ >> 5) * 4096 + ((c8_ >> 2) * 2 + (kk_ >> 4)) * 1024 + (kk_ & 15) * 64 + (c8_ & 3) * 16) = pv[i_]; } } while (0)
    for (int rep_b2 = 0; rep_b2 < REP_B2; ++rep_b2)
    for (int qb = 0; qb < 2; ++qb) {
        bf16x8 qr[4];
        { const GAS bf16_t* qp = (const GAS bf16_t*)proj + (tokq0 + 32 * qb + r32) * PW + C_DQ + hd * 64 + 8 * hi;
#pragma unroll
          for (int kk = 0; kk < 4; ++kk) qr[kk] = *(const GAS bf16x8*)(qp + kk * 16); }
        f32x16 o0 = {}, o1 = {}; float mrun = -1e30f, lrun = 0.f;
        DSA_LOADKV(0);
        DSA_STOREKV(0);
        __syncthreads();
#define B2_QK(S_, k4_) do { const LAS unsigned char* krd_ = kt + (32 * (k4_) + r32) * 144 + hi * 16; S_ = (f32x16){}; \
        _Pragma("unroll") for (int kk = 0; kk < 4; ++kk) { const bf16x8 kf_ = *(const LAS bf16x8*)(krd_ + kk * 32); S_ = MFMA32(kf_, qr[kk], S_); } } while (0)
#define B2_SM_PV(S_, k4_) do { \
        const int selw_ = (int)selall[(32 * qb + r32) * 64 + step * 4 + (k4_)]; float mx_ = -INFINITY; \
        _Pragma("unroll") for (int r = 0; r < 16; ++r) { const unsigned m_ = (unsigned)__builtin_amdgcn_sbfe(selw_, crow(r, hi), 1); \
            S_[r] = __uint_as_float((__float_as_uint(S_[r]) & m_) | (0xFF800000u & ~m_)); mx_ = fmaxf(mx_, S_[r]); } \
        { const auto rr_ = __builtin_amdgcn_permlane32_swap(__float_as_uint(mx_), __float_as_uint(mx_), false, false); mx_ = fmaxf(__uint_as_float(rr_[0]), __uint_as_float(rr_[1])); } \
        if (__any(mx_ > mrun + 8.0f)) { const float mn_ = fmaxf(mrun, mx_), alpha_ = __builtin_amdgcn_exp2f(mrun - mn_); lrun *= alpha_; mrun = mn_; \
            _Pragma("unroll") for (int r = 0; r < 16; ++r) { o0[r] *= alpha_; o1[r] *= alpha_; } } \
        float pr_[16], rs_ = 0.f; \
        _Pragma("unroll") for (int r = 0; r < 16; ++r) { pr_[r] = __builtin_amdgcn_exp2f(S_[r] - mrun); rs_ += pr_[r]; } \
        lrun += rs_; \
        const bf16x8 pa_ = pack8(pr_), pb_ = pack8(pr_ + 8); \
        const lds_cptr vrd_ = (lds_cptr)vt + (k4_) * 4096 + vtr_lane_off(lane); \
        const bf16x8 v00_ = vfrag(vrd_, 0), v01_ = vfrag(vrd_, 1024), v10_ = vfrag(vrd_, 2048), v11_ = vfrag(vrd_, 3072); \
        o0 = MFMA32(v00_, pa_, o0); o0 = MFMA32(v01_, pb_, o0); o1 = MFMA32(v10_, pa_, o1); o1 = MFMA32(v11_, pb_, o1); } while (0)
        for (int step = 0; step < nsteps; ++step) {
            const int buf = step & 1;
            if (step + 1 < nsteps) DSA_LOADKV(step + 1);
            LAS unsigned char* kt = dl + DL_KT + buf * 18432;
            LAS unsigned char* vt = dl + DL_VT + buf * 16384;
            f32x16 sa, sb;
            B2_QK(sa, 0);
            B2_QK(sb, 1); B2_SM_PV(sa, 0); __builtin_amdgcn_sched_barrier(0);
            if (128 * step + 64 < n) {
                B2_QK(sa, 2); B2_SM_PV(sb, 1); __builtin_amdgcn_sched_barrier(0);
                B2_QK(sb, 3); B2_SM_PV(sa, 2); __builtin_amdgcn_sched_barrier(0);
                B2_SM_PV(sb, 3);
            } else {
                B2_SM_PV(sb, 1);
            }
            if (step + 1 < nsteps) DSA_STOREKV(buf ^ 1);
            __syncthreads();
        }
#undef B2_QK
#undef B2_SM_PV
        float l = lrun; { const auto rr = __builtin_amdgcn_permlane32_swap(__float_as_uint(l), __float_as_uint(l), false, false); l = __uint_as_float(rr[0]) + __uint_as_float(rr[1]); }
        const float il = 1.0f / l;
        bf16_t* op = odsa + (tokq0 + 32 * qb + r32) * 512 + hd * 64 + 4 * hi;
#pragma unroll
        for (int g = 0; g < 4; ++g) {
            u32x2 w0, w1; w0.x = cvt_pk_bf16(o0[4 * g] * il, o0[4 * g + 1] * il); w0.y = cvt_pk_bf16(o0[4 * g + 2] * il, o0[4 * g + 3] * il);
            w1.x = cvt_pk_bf16(o1[4 * g] * il, o1[4 * g + 1] * il); w1.y = cvt_pk_bf16(o1[4 * g + 2] * il, o1[4 * g + 3] * il);
            *(u32x2*)(op + 8 * g) = w0; *(u32x2*)(op + 32 + 8 * g) = w1; }
    }
#undef DSA_LOADKV
#undef DSA_STOREKV
#undef DSA_CONSUME
#undef DSA_TIES
    __syncthreads();
}

template <int CTRL> __device__ __forceinline__ float dpp_f(float v) { return __builtin_bit_cast(float, __builtin_amdgcn_update_dpp(0, __builtin_bit_cast(int, v), CTRL, 0xF, 0xF, false)); }
constexpr int RL_WROW = 2064, RL_WHI = 0, RL_WLO = 32 * RL_WROW, RL_TKE = 2 * 32 * RL_WROW, RL_TKW = RL_TKE + 4096;
__device__ __forceinline__ void p9_router(Frame& F) {
    const int lane = F.lane, wave = F.wave, tid = F.tid, r32 = lane & 31, hi = lane >> 5;
    LAS int* tke = (LAS int*)(F.lds + RL_TKE); LAS float* tkw = (LAS float*)(F.lds + RL_TKW);
    const float* w_router = F.in[15]; const float* b_router = F.in[16]; const float* g_ffn = F.in[14];
    for (int idx = tid; idx < DM * NEXP; idx += NWAVES * 64) { const int k = idx >> 5, e = idx & 31; const float w = w_router[idx];
        const unsigned wh = f2bf(w); const unsigned wl = f2bf(w - __builtin_bit_cast(float, wh << 16));
        *(LAS bf16_t*)(F.lds + RL_WHI + e * RL_WROW + k * 2) = (bf16_t)wh; *(LAS bf16_t*)(F.lds + RL_WLO + e * RL_WROW + k * 2) = (bf16_t)wl; }
    if (tid < 32) F.MISC[MW_LCNT + tid] = 0u;
    __syncthreads();
    bf16_t* h2 = (bf16_t*)(F.ws + WS_H); unsigned char* h2f8 = F.ws + WS_H2F8;
    const GAS f32x4* gr = (const GAS f32x4*)g_ffn + lane;
    f32x4 gg[4];
#pragma unroll
    for (int j = 0; j < 4; ++j) gg[j] = gr[64 * j];
    const size_t tok0 = (size_t)F.blk * 256 + 32 * wave;
    f32x4 xnext[2][4];
#pragma unroll
    for (int tk = 0; tk < 2; ++tk) { const GAS f32x4* xr = (const GAS f32x4*)(F.out + (tok0 + tk) * DM) + lane;
#pragma unroll
        for (int j = 0; j < 4; ++j) xnext[tk][j] = xr[64 * j]; }
    for (int it = 0; it < 16; ++it) {
        f32x4 hn[2][4];
#pragma unroll
        for (int tk = 0; tk < 2; ++tk)
#pragma unroll
            for (int j = 0; j < 4; ++j) hn[tk][j] = xnext[tk][j];
        if (it + 1 < 16) {
#pragma unroll
            for (int tk = 0; tk < 2; ++tk) { const GAS f32x4* xr = (const GAS f32x4*)(F.out + (tok0 + 2 * it + 2 + tk) * DM) + lane;
#pragma unroll
                for (int j = 0; j < 4; ++j) xnext[tk][j] = xr[64 * j]; } }
        float s[2];
#pragma unroll
        for (int tk = 0; tk < 2; ++tk) { float a = 0.f;
#pragma unroll
            for (int j = 0; j < 4; ++j) a += (hn[tk][j].x * hn[tk][j].x + hn[tk][j].y * hn[tk][j].y) + (hn[tk][j].z * hn[tk][j].z + hn[tk][j].w * hn[tk][j].w);
            s[tk] = a; }
#pragma unroll
        for (int tk = 0; tk < 2; ++tk) { float a = s[tk];
            a += dpp_f<0xB1>(a); a += dpp_f<0x4E>(a); a += dpp_f<0x141>(a); a += dpp_f<0x128>(a);
            { const auto rr = __builtin_amdgcn_permlane16_swap(__float_as_uint(a), __float_as_uint(a), false, false); a = __uint_as_float(rr[0]) + __uint_as_float(rr[1]); }
            { const auto rr = __builtin_amdgcn_permlane32_swap(__float_as_uint(a), __float_as_uint(a), false, false); a = __uint_as_float(rr[0]) + __uint_as_float(rr[1]); }
            s[tk] = a; }
#pragma unroll
        for (int tk = 0; tk < 2; ++tk) {
            const float rstd = 1.0f / sqrtf(s[tk] * (1.f / DM) + EPS);
            GAS u32x2* o8 = (GAS u32x2*)(h2 + (tok0 + 2 * it + tk) * DM) + lane;
#pragma unroll
            for (int j = 0; j < 4; ++j) { const f32x4 v = hn[tk][j] * rstd * gg[j]; u32x2 o; o.x = pk2(v.x, v.y); o.y = pk2(v.z, v.w); o8[64 * j] = o;
                *((GAS unsigned*)(h2f8 + (tok0 + 2 * it + tk) * DM) + lane + 64 * j) = pk4_f8(v.x, v.y, v.z, v.w); }
        }
    }
    asm volatile("s_waitcnt vmcnt(0)" ::: "memory");
    f32x16 acc = {};
    { const GAS bf16_t* hp = (const GAS bf16_t*)h2 + (tok0 + r32) * DM + 8 * hi;
      const LAS unsigned char* wp = F.lds + RL_WHI + r32 * RL_WROW + 16 * hi;
#pragma unroll 8
      for (int kk = 0; kk < 64; ++kk) { const bf16x8 hb = *(const GAS bf16x8*)(hp + 16 * kk);
          const bf16x8 wh = *(const LAS bf16x8*)(wp + 32 * kk), wl = *(const LAS bf16x8*)(wp + RL_WLO + 32 * kk);
          acc = MFMA32(wh, hb, acc); acc = MFMA32(wl, hb, acc); } }
    float lg[16];
#pragma unroll
    for (int r = 0; r < 16; ++r) lg[r] = acc[r] + b_router[crow(r, hi)];
    float lv[4]; int li[4];
#pragma unroll
    for (int k = 0; k < 4; ++k) { float bv = lg[0]; int br = 0;
#pragma unroll
        for (int r = 1; r < 16; ++r) { const bool g = lg[r] > bv; bv = g ? lg[r] : bv; br = g ? r : br; }
        lv[k] = bv; li[k] = crow(br, hi);
#pragma unroll
        for (int r = 0; r < 16; ++r) lg[r] = (r == br) ? -INFINITY : lg[r]; }
    float ov[4]; int oi[4];
#pragma unroll
    for (int k = 0; k < 4; ++k) { const auto rv = __builtin_amdgcn_permlane32_swap(__float_as_uint(lv[k]), __float_as_uint(lv[k]), false, false); const auto ri = __builtin_amdgcn_permlane32_swap((unsigned)li[k], (unsigned)li[k], false, false);
        ov[k] = hi ? __uint_as_float(rv[0]) : __uint_as_float(rv[1]); oi[k] = hi ? (int)ri[0] : (int)ri[1]; }
    float tv[4]; int te[4];
    { float a0 = lv[0], a1 = lv[1], a2 = lv[2], a3 = lv[3], b0 = ov[0], b1 = ov[1], b2 = ov[2], b3 = ov[3];
      int i0 = li[0], i1 = li[1], i2 = li[2], i3 = li[3], j0 = oi[0], j1 = oi[1], j2 = oi[2], j3 = oi[3];
#pragma unroll
      for (int k = 0; k < 4; ++k) { const bool ta = (a0 > b0) || (a0 == b0 && i0 < j0);
          tv[k] = ta ? a0 : b0; te[k] = ta ? i0 : j0;
          if (ta) { a0 = a1; a1 = a2; a2 = a3; a3 = -INFINITY; i0 = i1; i1 = i2; i2 = i3; i3 = 64; }
          else { b0 = b1; b1 = b2; b2 = b3; b3 = -INFINITY; j0 = j1; j1 = j2; j2 = j3; j3 = 64; } } }
    const float e1 = __expf(tv[1] - tv[0]), e2x = __expf(tv[2] - tv[0]), e3 = __expf(tv[3] - tv[0]);
    const float inv = 1.0f / (1.0f + e1 + e2x + e3);
    if (hi == 0) { const int tl = 32 * wave + r32;
        *(LAS int*)(tke + tl * 4 + 0) = te[0]; tke[tl * 4 + 1] = te[1]; tke[tl * 4 + 2] = te[2]; tke[tl * 4 + 3] = te[3];
        tkw[tl * 4 + 0] = inv; tkw[tl * 4 + 1] = e1 * inv; tkw[tl * 4 + 2] = e2x * inv; tkw[tl * 4 + 3] = e3 * inv;
#pragma unroll
        for (int k = 0; k < 4; ++k) __hip_atomic_fetch_add((LAS unsigned*)F.MISC + MW_LCNT + te[k], 1u, __ATOMIC_RELAXED, __HIP_MEMORY_SCOPE_WORKGROUP); }
    __syncthreads();
    if (tid < 32) ((int*)(F.ws + WS_BLKCNT))[F.blk * 32 + tid] = (int)F.MISC[MW_LCNT + tid];
}
__device__ __forceinline__ void p10_assign(Frame& F) {
    const int tid = F.tid;
    const int* blkcnt = (const int*)(F.ws + WS_BLKCNT);
    LAS int* part = (LAS int*)(F.lds);
    LAS int* tke = (LAS int*)(F.lds + RL_TKE); LAS float* tkw = (LAS float*)(F.lds + RL_TKW);
    { const int e = tid & 31, p = tid >> 5; int tot = 0, bef = 0;
      for (int j = 0; j < 16; ++j) { const int bl = p * 16 + j; const int c = blkcnt[bl * 32 + e]; tot += c; bef += (bl < F.blk) ? c : 0; }
      part[p * 32 + e] = tot; part[512 + p * 32 + e] = bef; }
    __syncthreads();
    if (tid < 32) { int tot = 0, bef = 0;
        for (int p = 0; p < 16; ++p) { tot += part[p * 32 + tid]; bef += part[512 + p * 32 + tid]; }
        part[1024 + tid] = tot; F.MISC[MW_BEFORE + tid] = (unsigned)bef; F.MISC[MW_LCNT + tid] = 0u; }
    __syncthreads();
    if (tid == 0) { int ps = 0;
        for (int e = 0; e < 32; ++e) { F.MISC[MW_PSTART + e] = (unsigned)ps; F.MISC[MW_TSTART + e] = (unsigned)(ps >> 8); ps += (part[1024 + e] + 255) & ~255; }
        F.MISC[MW_PSTART + 32] = (unsigned)ps; F.MISC[MW_TSTART + 32] = (unsigned)(ps >> 8); }
    __syncthreads();
    int* slot_tok = (int*)(F.ws + WS_SLOT_TOK); float* slot_w = (float*)(F.ws + WS_SLOT_W);
    for (int idx = tid; idx < 1024; idx += NWAVES * 64) {
        const int e = tke[idx]; const float w = tkw[idx];
        const unsigned r = __hip_atomic_fetch_add((LAS unsigned*)F.MISC + MW_LCNT + e, 1u, __ATOMIC_RELAXED, __HIP_MEMORY_SCOPE_WORKGROUP);
        const unsigned pos = F.MISC[MW_PSTART + e] + F.MISC[MW_BEFORE + e] + r;
        slot_tok[pos] = F.blk * 256 + (idx >> 2); slot_w[pos] = w;
    }
}

#ifndef MK_ONE_LAUNCH
#define MK_ONE_LAUNCH 1
#endif
constexpr int N_PHASES = 13;
struct Args { const float* in[21]; float* out; unsigned char* ws; int ph_lo, ph_hi; };
static_assert(sizeof(Args) == 21 * 8 + 8 + 8 + 8, "no padding");

__global__ void __launch_bounds__(NWAVES * 64, 2) fwd_kernel(Args args) {
    extern __shared__ __attribute__((aligned(16))) unsigned char lds[];
    Frame F;
    F.lds = (LAS unsigned char*)lds;
    F.MISC = (volatile LAS unsigned*)(F.lds + MISC_OFF);
    F.tid = threadIdx.x; F.lane = F.tid & 63; F.wave = __builtin_amdgcn_readfirstlane(F.tid >> 6);
#define FRESH() do { F.lane = lane_id_fresh(); F.tid = F.wave * 64 + F.lane; } while (0)
    F.G = gridDim.x; F.blk = blockIdx.x;
    F.ws = args.ws; F.out = args.out; F.ctl = (gu32*)(args.ws + WS_CTL);
#pragma unroll
    for (int i = 0; i < 21; ++i) F.in[i] = args.in[i];
    for (int u = F.tid; u < (LDS_BYTES - MISC_OFF) / 4; u += NWAVES * 64) ((LAS unsigned*)(F.lds + MISC_OFF))[u] = 0u;
    __syncthreads();
    const int lo = args.ph_lo, hi = args.ph_hi;
    XcdBarrier bar; bar.bar = (unsigned*)(F.ctl + CW_BAR); bar.x = 0; bar.st = nullptr; bar.wave = F.wave;
    if (hi - lo > 1) bar = xcd_barrier_post((unsigned*)(F.ctl + CW_BAR), F.MISC + MW_BAR);
#ifndef STAG
#define STAG 0
#endif
#ifndef PH_MASK
#define PH_MASK 0x1fff
#endif
#define IN(k) (((PH_MASK >> (k)) & 1) && lo <= (k) && (k) < hi)
#ifndef REP_MASK
#define REP_MASK 0
#endif
#define NREP(k) (1 + ((REP_MASK >> (k)) & 1))
#define SEAM(k) do { if (IN(k) && IN((k) + 1)) xcd_barrier(bar); } while (0)
    unsigned char* ws = args.ws;
    bf16_t* proj = (bf16_t*)(ws + WS_P);

    if (IN(0)) for (int rep = 0; rep < NREP(0); ++rep) { if (rep) xcd_barrier(bar); FRESH(); p0_prologue(F); } SEAM(0);

    if (IN(1)) {
#ifdef PROBE_P1
        { pg8::DenseSched S; S.init(ws + WS_H, ws + WS_WIN, NTOK, PW, DM, F.G, F.blk); S.amask = PROBE_P1;
          pg8::EpiBf16<0> E{(bf16_t*)(ws + WS_END), PW, nullptr, 1023};
          pg8::gemm_phase<pg8::EpiBf16<0>, pg8::DenseSched, true>(F.lds, F.wave, DM, S, E); }
        xcd_barrier(bar);
#endif
        { pg8::DenseSched S; S.init(ws + WS_H, ws + WS_WIN, NTOK, PW, DM, F.G, F.blk);
          pg8::EpiBf16<0> E{proj, PW, nullptr};
          pg8::gemm_phase<pg8::EpiBf16<0>, pg8::DenseSched, true>(F.lds, F.wave, DM, S, E); }
        { pg8::DenseSched S; S.init(ws + WS_MEMN, ws + WS_WMKV, NMEM, DM, DM, F.G, F.blk);
          pg8::EpiBf16<0> E{(bf16_t*)(ws + WS_MKV), DM, nullptr};
          pg8::gemm_phase<pg8::EpiBf16<0>, pg8::DenseSched, true>(F.lds, F.wave, DM, S, E); }
    } SEAM(1);

    if (IN(2)) { FRESH(); if (REP_MASK & 4) { p2_prep(F, true); xcd_barrier(bar); } p2_prep(F); } SEAM(2);

    if (IN(3)) {
        FRESH();
        bf16_t* osb = (bf16_t*)(ws + WS_O); bf16_t* odsa = osb + (size_t)NTOK * 512; bf16_t* omem = odsa + (size_t)NTOK * 512;
#ifndef REP_DSA
#define REP_DSA 1
#endif
#ifndef REP_SB
#define REP_SB 1
#endif
#ifndef REP_MEM
#define REP_MEM 1
#endif
#ifndef NO_DSA
        for (int rep = 0; rep < REP_DSA; ++rep)
        for (int i = 0; i < 4; ++i) { const int p = 2 * F.blk + (i >> 1), b = p >> 4, cc = p & 15, c = (i & 1) ? 31 - cc : cc; dsa_unit(proj, odsa, (unsigned*)F.out + (size_t)F.blk * 131072, b, c, F.lds, F.tid); }
#endif
        const int gw = F.blk * NWAVES + F.wave, NGW = F.G * NWAVES;
#ifndef NO_SB
        for (int rep = 0; rep < REP_SB; ++rep)
        for (int it = gw; it < NB * 8 * 64; it += NGW) { const int qblk = 63 - (it >> 8), bh = it & 255; sb_item(proj, osb, bh >> 3, bh & 7, qblk, F.lds + F.wave * 4096, F.lane); }
#endif
#ifndef NO_MEM
        for (int rep = 0; rep < REP_MEM; ++rep) {
            __syncthreads();
            for (int u = F.blk; u < NB * 4 * 2; u += F.G) mem_unit(proj, (const bf16_t*)(ws + WS_MKV), omem, u >> 3, (u >> 1) & 3, u & 1, F.lds, F.tid);
        }
#endif
    } SEAM(3);

    if (IN(4)) {
        pg8::DenseSched S; S.init(ws + WS_H, ws + WS_WG, NTOK, 3 * DM, DM, F.G, F.blk);
        pg8::EpiBf16<2> E{proj, PW, F.in[11]};
        pg8::gemm_phase<pg8::EpiBf16<2>, pg8::DenseSched, true>(F.lds, F.wave, DM, S, E);
    } SEAM(4);

    if (IN(5)) { pg8::MergeSched S; S.init(ws + WS_O, ws + WS_WB, NTOK, DM, F.G, F.blk);
        pg8::EpiMerge E{proj, (bf16_t*)(ws + WS_H)};
        pg8::gemm_phase<pg8::EpiMerge, pg8::MergeSched, true>(F.lds, F.wave, 512, S, E); } SEAM(5);


    if (IN(8)) {
        pg8::DenseSched S; S.init(ws + WS_H, ws + WS_WO, NTOK, DM, DM, F.G, F.blk); S.stag = STAG;
        pg8::EpiResid E{F.in[0], F.out};
        pg8::gemm_phase<pg8::EpiResid, pg8::DenseSched, true>(F.lds, F.wave, DM, S, E);
    } SEAM(8);

    if (IN(9)) for (int rep = 0; rep < NREP(9); ++rep) { if (rep) xcd_barrier(bar); FRESH(); p9_router(F); } SEAM(9);
    if (IN(10)) for (int rep = 0; rep < NREP(10); ++rep) { if (rep) xcd_barrier(bar); FRESH(); p10_assign(F); } SEAM(10);

    if (IN(11)) for (int rep = 0; rep < NREP(11); ++rep) {  if (rep) xcd_barrier(bar);
        pg8::MoeSched S{(const char*)(ws + WS_H2F8), (const char*)(ws + WS_WEI), (const int*)(ws + WS_SLOT_TOK), F.MISC + MW_TSTART, DM / 2, 2048, 8, F.blk};
        pg8::EpiSwiglu E{(bf16_t*)(ws + WS_P), F.in[18], F.lds};
        pg8::gemm_phase<pg8::EpiSwiglu, pg8::MoeSched, true, true>(F.lds, F.wave, DM / 2, S, E);
    } SEAM(11);

    if (IN(12)) {
        pg8::MoeSched S{(const char*)(ws + WS_P), (const char*)(ws + WS_WEO), nullptr, F.MISC + MW_TSTART, DM, DM, 4, F.blk};
        pg8::EpiScatter E{F.out, (const int*)(ws + WS_SLOT_TOK), (const float*)(ws + WS_SLOT_W), F.in[20], F.lds};
        pg8::gemm_phase<pg8::EpiScatter, pg8::MoeSched, true>(F.lds, F.wave, DM, S, E);
    }
#undef IN
#undef SEAM
}

extern "C" void kernel_launch(void* const* d_in, const int* in_sizes, int n_in, void* d_out, int out_size, void* d_ws, size_t ws_size, hipStream_t stream) {
    static int grid = 0;
    if (grid == 0) {
        if (n_in != 21 || in_sizes[0] != NTOK * DM || out_size != NTOK * DM || ws_size < WS_END) {
            fprintf(stderr, "kernel_launch: unexpected shapes: n_in %d in0 %d out %d ws %zu (need >= %zu); nothing launched\n", n_in, n_in > 0 ? in_sizes[0] : -1, out_size, ws_size, (size_t)WS_END); grid = -1; return; }
        int dev = 0, cus = 0, per_cu = 0;
        if (hipGetDevice(&dev) != hipSuccess || hipDeviceGetAttribute(&cus, hipDeviceAttributeMultiprocessorCount, dev) != hipSuccess) { fprintf(stderr, "kernel_launch: device query failed\n"); grid = -1; return; }
        if (hipFuncSetAttribute((const void*)fwd_kernel, hipFuncAttributeMaxDynamicSharedMemorySize, LDS_BYTES) != hipSuccess) { fprintf(stderr, "kernel_launch: hipFuncSetAttribute failed\n"); grid = -1; return; }
        if (hipOccupancyMaxActiveBlocksPerMultiprocessor(&per_cu, (const void*)fwd_kernel, NWAVES * 64, LDS_BYTES) != hipSuccess || per_cu < 1)
            fprintf(stderr, "kernel_launch: note: occupancy query reports %d workgroups per CU\n", per_cu);
        (void)hipGetLastError();
        grid = cus;
        if (grid != 256) { fprintf(stderr, "kernel_launch: this kernel is built for 256 CUs (got %d); nothing launched\n", grid); grid = -1; return; }
    }
    if (grid < 0) return;
    if (hipMemsetAsync((char*)d_ws + WS_CTL, 0, CTL_ZERO_BYTES, stream) != hipSuccess) { fprintf(stderr, "kernel_launch: hipMemsetAsync failed\n"); return; }
    Args a{};
    for (int i = 0; i < 21; ++i) a.in[i] = (const float*)d_in[i];
    a.out = (float*)d_out; a.ws = (unsigned char*)d_ws;
#if MK_ONE_LAUNCH
    const int cuts[2] = {0, N_PHASES}; const int nl = 1;
#else
    const int cuts[11] = {0, 1, 2, 3, 4, 5, 6, 7, 8, 9, N_PHASES}; const int nl = 10;
#endif
    for (int li = 0; li < nl; ++li) {
        a.ph_lo = cuts[li]; a.ph_hi = cuts[li + 1];
        hipLaunchKernelGGL(fwd_kernel, dim3(grid), dim3(NWAVES * 64), LDS_BYTES, stream, a);
        const hipError_t le = hipPeekAtLastError();
        if (le != hipSuccess) { fprintf(stderr, "kernel_launch: launch %d failed: %s\n", li, hipGetErrorName(le)); break; }
    }
}
```

```cpp
#include <hip/hip_runtime.h>
#include <cstdio>
#include <cstdint>

#define LAS __attribute__((address_space(3)))
#define GAS __attribute__((address_space(1)))
typedef unsigned short bf16_t;
typedef short bf16x8 __attribute__((ext_vector_type(8)));
typedef short s16x4 __attribute__((ext_vector_type(4)));
typedef short v4i16_t __attribute__((ext_vector_type(4)));
typedef float f32x2 __attribute__((ext_vector_type(2)));
typedef float f32x4 __attribute__((ext_vector_type(4)));
typedef float f32x16 __attribute__((ext_vector_type(16)));
typedef unsigned u32x2 __attribute__((ext_vector_type(2)));
typedef unsigned u32x4 __attribute__((ext_vector_type(4)));
typedef int i32x4 __attribute__((ext_vector_type(4)));
typedef int i32x8 __attribute__((ext_vector_type(8)));
typedef GAS unsigned gu32;

constexpr int NB = 32, SEQ = 2048, DM = 1024, NTOK = NB * SEQ;
constexpr int MEMLEN = 256, NMEM = NB * MEMLEN;
constexpr int PW = 3072;
constexpr int C_SQ = 0, C_SK = 512, C_SV = 1024, C_DQ = 1536, C_DK = 2048, C_DV = 2112, C_IQ = 2176, C_IK = 2432, C_IW = 2496, C_MQ = 2560;
constexpr int IN_W = 3012;
constexpr int NEXP = 32, TOPK = 4, DEXP = 1024;
constexpr int NSLOT = NTOK * TOPK;
constexpr int NSLOT_PAD = NSLOT + NEXP * 256;
constexpr float EPS = 1e-6f;
constexpr float LOG2E = 1.4426950408889634f;

constexpr size_t MiB = 1u << 20;
constexpr size_t WS_CTL = 0, CTL_ZERO_BYTES = 1 * MiB;
constexpr size_t WS_ROPE = 1 * MiB;
constexpr size_t WS_BLKCNT = 1 * MiB + 512 * 1024;
constexpr size_t WS_SLOT_TOK = 2 * MiB;
constexpr size_t WS_SLOT_W = 4 * MiB;
constexpr size_t WS_WIN = 8 * MiB;
constexpr size_t WS_WMKV = 14 * MiB;
constexpr size_t WS_WG = 16 * MiB;
constexpr size_t WS_WB = 22 * MiB;
constexpr size_t WS_WO = 25 * MiB;
constexpr size_t WS_WEI = 27 * MiB;
constexpr size_t WS_WEO = 155 * MiB;
__device__ __forceinline__ int lane_id_fresh() { int l; asm volatile("v_mbcnt_lo_u32_b32 %0, -1, 0\n\tv_mbcnt_hi_u32_b32 %0, -1, %0" : "=v"(l)); return l; }
constexpr float W8_SCALE = 64.f, W8_INV = 1.f / 64.f;
constexpr size_t WS_H = 220 * MiB;
constexpr size_t WS_P = 348 * MiB;
constexpr size_t WS_O = 732 * MiB;
constexpr size_t WS_H8 = 91 * MiB;
constexpr size_t WS_H2F8 = 91 * MiB;
constexpr size_t WS_MEMN = 924 * MiB;
constexpr size_t WS_MKV = 940 * MiB;
constexpr size_t WS_END = 956 * MiB;
static_assert(WS_P + (size_t)NSLOT_PAD * DEXP * 2 <= WS_MEMN, "act overlays proj|o");
static_assert(WS_SLOT_TOK + (size_t)NSLOT_PAD * 4 <= WS_SLOT_W && WS_SLOT_W + (size_t)NSLOT_PAD * 4 <= WS_WIN, "slot tables");

constexpr int CW_BAR = 4096;

constexpr int RING_BYTES = 151552;
constexpr int MISC_OFF = RING_BYTES;
constexpr int LDS_BYTES = 155648;
constexpr int MW_BAR = 8;
constexpr int MW_LCNT = 16;
constexpr int MW_PSTART = 64;
constexpr int MW_TSTART = 128;
constexpr int MW_BEFORE = 192;
constexpr int MW_PART = 256;

__device__ __forceinline__ unsigned f2bf(float f) { unsigned u = __builtin_bit_cast(unsigned, f); return (u + 0x7fffu + ((u >> 16) & 1u)) >> 16; }
__device__ __forceinline__ unsigned pk2(float lo, float hi) { return f2bf(lo) | (f2bf(hi) << 16); }
__device__ __forceinline__ float bf2f(unsigned short b) { return __builtin_bit_cast(float, (unsigned)b << 16); }
__device__ __forceinline__ float bflo(unsigned w) { return __builtin_bit_cast(float, w << 16); }
__device__ __forceinline__ float bfhi(unsigned w) { return __builtin_bit_cast(float, w & 0xffff0000u); }
__device__ __forceinline__ unsigned cvt_pk_bf16(float lo, float hi) { unsigned r; asm volatile("v_cvt_pk_bf16_f32 %0, %1, %2" : "=v"(r) : "v"(lo), "v"(hi)); return r; }
__device__ __forceinline__ int crow(int r, int hi) { return (r & 3) + 8 * (r >> 2) + 4 * hi; }
#define LDS_WAIT() asm volatile("s_waitcnt lgkmcnt(0)" ::: "memory")
#define VM_WAIT() asm volatile("s_waitcnt vmcnt(0)" ::: "memory")

namespace pg8 {
constexpr int BM = 256, BK = 64, HALF = 128, HTB = HALF * BK * 2, STAGE_BYTES = 8 * HTB, EPI_NA_OFF = STAGE_BYTES + 2048;
__host__ __device__ __forceinline__ int lds_byte(int r, int c) { const int st = (r >> 4) * 2 + (c >> 5), rr = r & 15, cc = c & 31, ob = rr * 64 + cc * 2; return st * 1024 + (ob ^ (((ob >> 9) & 1) << 5)); }
__host__ __device__ __forceinline__ void stage_rc(int b, int& R, int& C) { const int st = b / 1024, sb = b % 1024, swz = sb ^ (((sb >> 9) & 1) << 5); R = (st >> 1) * 16 + swz / 64; C = (st & 1) * 32 + (swz % 64) / 2; }
__host__ __device__ __forceinline__ int perm32(int rho) { const int n = rho >> 4, i = rho & 15; return 8 * (i >> 2) + 4 * n + (i & 3); }

struct Unit { int pm, pn, e; };

template <class Epi, class Sched, bool ALIGN_EPI, bool FP8 = false>
__device__ __forceinline__ void gemm_phase(LAS unsigned char* lds, const int wave_, const int K, const Sched& S, const Epi& E) {
    int tid = wave_ * 64 + lane_id_fresh();
    const int wid = __builtin_amdgcn_readfirstlane(tid >> 6), lane = tid & 63, wr = wid >> 2, wc = wid & 3, fr = lane & 15, fq = lane >> 4;
    const int nt = K / BK;
    int Rr[2], Cc[2]; unsigned voffB[2];
#pragma unroll
    for (int i = 0; i < 2; ++i) { int R, C; stage_rc(tid * 16 + i * 8192, R, C); Rr[i] = R; Cc[i] = C; const int Rb = Epi::PERM ? ((R & ~31) + perm32(R & 31)) : R; voffB[i] = (unsigned)(Rb * K + C) * 2u; }
    const size_t kstep = (size_t)(BK * 2);
    const size_t hstepB = (size_t)HALF * K * 2;
    const unsigned ldsw = (unsigned)wid * 1024u;
    const int aoff = lds_byte(wr * 64 + fr, fq * 8), boff = lds_byte(wc * 32 + fr, fq * 8);
#define PG8_SA(b, h) (((b) * 2 + (h)) * HTB)
#define PG8_SB(b, h) ((4 + (b) * 2 + (h)) * HTB)
#define PG8_STAGE(bufoff, gbase, voff) do { _Pragma("unroll") for (int _i = 0; _i < 2; ++_i) { unsigned o_ = (voff)[_i]; asm volatile("" : "+v"(o_)); \
        __builtin_amdgcn_global_load_lds((const unsigned*)((const char*)(gbase) + o_), (LAS unsigned*)(lds + (bufoff) + ldsw + _i * 8192), 16, 0, 0); } } while (0)
#define PG8_J8(x, y) __builtin_shufflevector(x, y, 0, 1, 2, 3, 4, 5, 6, 7)
#define PG8_LDA(dst, b, h) do { _Pragma("unroll") for (int m = 0; m < 4; ++m) { const LAS unsigned char* p_ = lds + PG8_SA(b, h) + aoff + m * 2048; \
        if constexpr (FP8) dst##8[m] = PG8_J8(*(const LAS i32x4*)p_, *(const LAS i32x4*)(p_ + 1024)); else { dst[m][0] = *(const LAS bf16x8*)p_; dst[m][1] = *(const LAS bf16x8*)(p_ + 1024); } } } while (0)
#define PG8_LDB(dst, b, h) do { _Pragma("unroll") for (int n = 0; n < 2; ++n) { const LAS unsigned char* p_ = lds + PG8_SB(b, h) + boff + n * 2048; \
        if constexpr (FP8) dst##8[n] = PG8_J8(*(const LAS i32x4*)p_, *(const LAS i32x4*)(p_ + 1024)); else { dst[n][0] = *(const LAS bf16x8*)p_; dst[n][1] = *(const LAS bf16x8*)(p_ + 1024); } } } while (0)
#define PG8_MMA(ai, bj, At, Bt) do { __builtin_amdgcn_s_setprio(1); _Pragma("unroll") for (int m = 0; m < 4; ++m) _Pragma("unroll") for (int n = 0; n < 2; ++n) { \
        if constexpr (FP8) acc[ai][bj][m][n] = __builtin_amdgcn_mfma_scale_f32_16x16x128_f8f6f4(Bt##8[n], At##8[m], acc[ai][bj][m][n], 0, 0, 0, 0, 0, 0); \
        else { _Pragma("unroll") for (int k = 0; k < 2; ++k) acc[ai][bj][m][n] = __builtin_amdgcn_mfma_f32_16x16x32_bf16(Bt[n][k], At[m][k], acc[ai][bj][m][n], 0, 0, 0); } } \
        __builtin_amdgcn_s_setprio(0); } while (0)
#define PG8_WAIT_V(n) asm volatile("s_waitcnt vmcnt(" #n ")" ::: "memory")
#define PG8_WAIT_L(n) asm volatile("s_waitcnt lgkmcnt(" #n ")" ::: "memory")
#define PG8_BAR __builtin_amdgcn_s_barrier()
#define PG8_SCHED __builtin_amdgcn_sched_barrier(0)
    Unit cur, nxt; int ui = 0;
    if (!S.next(0, cur)) return;
    { const int ns = S.stagger();
      for (int q = 0; q < ns; ++q) __builtin_amdgcn_s_sleep(4); }
    f32x4 acc[2][2][4][2];
#pragma unroll
    for (int a = 0; a < 2; ++a)
#pragma unroll
        for (int b = 0; b < 2; ++b)
#pragma unroll
            for (int m = 0; m < 4; ++m)
#pragma unroll
                for (int n = 0; n < 2; ++n) acc[a][b][m][n] = (f32x4){0.f, 0.f, 0.f, 0.f};
    bf16x8 At[4][2], B0[2][2], B1[2][2]; i32x8 At8[4], B08[2], B18[2];
    const char* Ab = S.a_base();
    unsigned ca0[2], ca1[2], na0[2], na1[2];
#pragma unroll
    for (int i = 0; i < 2; ++i) { ca0[i] = S.a_off(cur, Rr[i], Cc[i]); ca1[i] = S.a_off(cur, HALF + Rr[i], Cc[i]); }
    const char* cB = S.b_tile(cur);
    PG8_STAGE(PG8_SB(0, 0), cB, voffB); PG8_STAGE(PG8_SB(0, 1), cB + hstepB, voffB); PG8_STAGE(PG8_SA(0, 0), Ab, ca0); PG8_STAGE(PG8_SA(0, 1), Ab, ca1);
    if (wr == 1) PG8_BAR;
    PG8_WAIT_V(2); PG8_BAR;
    PG8_STAGE(PG8_SB(1, 0), cB + kstep, voffB); PG8_STAGE(PG8_SA(1, 0), Ab + kstep, ca0); PG8_STAGE(PG8_SB(1, 1), cB + hstepB + kstep, voffB);
    PG8_WAIT_V(6); PG8_BAR;
    for (;;) {
        typename Epi::Pre pre = E.preload(cur, wr, wc, fr, fq);
        const bool has_next = S.next(ui + 1, nxt);
        const char* nB = cB;
#pragma unroll
        for (int i = 0; i < 2; ++i) { na0[i] = ca0[i]; na1[i] = ca1[i]; }
        if (has_next) { nB = S.b_tile(nxt);
#pragma unroll
            for (int i = 0; i < 2; ++i) { int R, C; int tq = tid; if constexpr (FP8) asm volatile("" : "+v"(tq));
                stage_rc(tq * 16 + i * 8192, R, C);
                na0[i] = S.a_off(nxt, R, C); na1[i] = S.a_off(nxt, HALF + R, C); } }
        if constexpr (Epi::DRAIN_TOP) { PG8_WAIT_V(0); }
        if constexpr (Epi::STASH) E.stash(pre, wid, fr, fq);
#define PG8_NAST(v) unsigned v = (unsigned)(EPI_NA_OFF + tid * 16); asm volatile("" : "+v"(v))
        if constexpr (FP8) { PG8_NAST(nast); *(LAS u32x4*)(lds + nast) = (u32x4){na0[0], na0[1], na1[0], na1[1]}; }
#pragma unroll 1
        for (int t = 0; t < nt; t += 2) {
            const bool last = (t == nt - 2);
            const char* a1 = Ab + (size_t)(t + 1) * kstep;
            const char* a2 = last ? Ab : Ab + (size_t)(t + 2) * kstep; const char* b2 = last ? nB : cB + (size_t)(t + 2) * kstep;
            const char* a3 = a2 + kstep; const char* b3 = b2 + kstep;
            if constexpr (FP8) { asm volatile("" : "+s"(a1), "+s"(a2), "+s"(b2), "+s"(a3), "+s"(b3)); }
            unsigned o20[2], o21[2];
#pragma unroll
            for (int i = 0; i < 2; ++i) { o20[i] = last ? na0[i] : ca0[i]; o21[i] = last ? na1[i] : ca1[i]; }
            if constexpr (FP8) { if (last) { PG8_NAST(nast); const u32x4 nv = *(const LAS u32x4*)(lds + nast); o20[0] = nv.x; o20[1] = nv.y; o21[0] = nv.z; o21[1] = nv.w; } }
            PG8_LDB(B0, 0, 0); PG8_LDB(B1, 0, 1); PG8_SCHED; PG8_LDA(At, 0, 0); PG8_STAGE(PG8_SA(1, 1), a1, ca1);
            PG8_WAIT_V(8); PG8_WAIT_L(0); PG8_BAR; PG8_MMA(0, 0, At, B0); PG8_MMA(0, 1, At, B1); PG8_BAR; PG8_SCHED;
            PG8_LDA(At, 0, 1); PG8_STAGE(PG8_SB(0, 0), b2, voffB); PG8_STAGE(PG8_SB(0, 1), b2 + hstepB, voffB); PG8_STAGE(PG8_SA(0, 0), a2, o20);
            PG8_WAIT_V(8); PG8_WAIT_L(0); PG8_BAR; PG8_MMA(1, 0, At, B0); PG8_MMA(1, 1, At, B1); PG8_BAR; PG8_SCHED;
            PG8_LDB(B0, 1, 0); PG8_LDB(B1, 1, 1); PG8_SCHED; PG8_LDA(At, 1, 0); PG8_STAGE(PG8_SA(0, 1), a2, o21);
            PG8_WAIT_V(8); PG8_WAIT_L(0); PG8_BAR; PG8_MMA(0, 0, At, B0); PG8_MMA(0, 1, At, B1); PG8_BAR; PG8_SCHED;
            PG8_LDA(At, 1, 1); PG8_STAGE(PG8_SB(1, 0), b3, voffB); PG8_STAGE(PG8_SB(1, 1), b3 + hstepB, voffB); PG8_STAGE(PG8_SA(1, 0), a3, o20);
            PG8_WAIT_V(8); PG8_WAIT_L(0); PG8_BAR; PG8_MMA(1, 0, At, B0); PG8_MMA(1, 1, At, B1); PG8_BAR; PG8_SCHED;
        }
        if constexpr (ALIGN_EPI) { if (wr == 0) PG8_BAR; }
        if constexpr (FP8) { int lq = tid; asm volatile("" : "+v"(lq));
            if constexpr (Epi::STASH) E(acc, cur, wr, wc, lq & 15, (lq >> 4) & 3, typename Epi::Pre{}); else E(acc, cur, wr, wc, lq & 15, (lq >> 4) & 3, pre); }
        else E(acc, cur, wr, wc, fr, fq, pre);
        if (!has_next) break;
#pragma unroll
        for (int a = 0; a < 2; ++a)
#pragma unroll
            for (int b = 0; b < 2; ++b)
#pragma unroll
                for (int m = 0; m < 4; ++m)
#pragma unroll
                    for (int n = 0; n < 2; ++n) acc[a][b][m][n] = (f32x4){0.f, 0.f, 0.f, 0.f};
        cur = nxt; cB = nB; ++ui;
#pragma unroll
        for (int i = 0; i < 2; ++i) { ca0[i] = na0[i]; ca1[i] = na1[i]; }
        if constexpr (FP8) { PG8_NAST(nast); const u32x4 nv = *(const LAS u32x4*)(lds + nast); ca0[0] = nv.x; ca0[1] = nv.y; ca1[0] = nv.z; ca1[1] = nv.w; }
        if constexpr (ALIGN_EPI) { if (wr == 1) PG8_BAR; }
    }
    PG8_WAIT_V(0);
    if constexpr (!ALIGN_EPI) { if (wr == 0) PG8_BAR; }
    PG8_BAR;
#undef PG8_SA
#undef PG8_SB
#undef PG8_STAGE
#undef PG8_LDA
#undef PG8_LDB
#undef PG8_MMA
#undef PG8_NAST
#undef PG8_J8
#undef PG8_WAIT_V
#undef PG8_WAIT_L
#undef PG8_BAR
#undef PG8_SCHED
}

struct DenseSched {
    const char* A; const char* Bt; int K, nM, nN, nwg, G, c, stag = 0, amask = -1;
    __device__ __forceinline__ void init(const void* A_, const void* Bt_, int M, int N, int K_, int G_, int c_) { A = (const char*)A_; Bt = (const char*)Bt_; K = K_; nM = M / BM; nN = N / BM; nwg = nM * nN; G = G_; c = c_; }
    __device__ __forceinline__ bool next(int i, Unit& u) const {
        const long L = (long)i * G + c; if (L >= nwg) return false;
        int wgid = (int)L; { const int q = nwg / 8, r = nwg % 8, xcd = wgid % 8, off = wgid / 8; wgid = (xcd < r ? xcd * (q + 1) : r * (q + 1) + (xcd - r) * q) + off; }
        const int nig = 8 * nN, gid = wgid / nig, fm = gid * 8, gsz = (nM - fm) < 8 ? (nM - fm) : 8;
        u.pm = fm + ((wgid % nig) % gsz); u.pn = (wgid % nig) / gsz; u.e = 0; return true;
    }
    __device__ __forceinline__ const char* a_base() const { return A; }
    __device__ __forceinline__ int stagger() const { return stag ? ((c >> 3) & 7) * (K / 55) : 0; }
    __device__ __forceinline__ unsigned a_off(const Unit& u, int row, int col) const { return (unsigned)(((size_t)((u.pm * BM + row) & amask) * K + col) * 2); }
    __device__ __forceinline__ int a_row(const Unit& u, int row) const { return (u.pm * BM + row) & amask; }
    __device__ __forceinline__ unsigned row_off(int r, int col) const { return (unsigned)(((size_t)r * K + col) * 2); }
    __device__ __forceinline__ const char* b_tile(const Unit& u) const { return Bt + (size_t)u.pn * BM * K * 2; }
};
}

namespace pg8 {
struct MoeSched {
    const char* A; const char* Bt; const int* slot_tok; volatile LAS unsigned* tstart; int K, rowsE, nN, c;
    __device__ __forceinline__ bool next(int i, Unit& u) const {
        const int x = c & 7, j = c >> 3, rpr = 32 / nN;
        const int pm = (i * 8 + x) * rpr + j / nN;
        const int T = (int)tstart[32];
        if (pm >= T) return false;
        int e = 0;
#pragma unroll 1
        for (int k = 1; k < 32; ++k) e += ((int)tstart[k] <= pm) ? 1 : 0;
        u.pm = pm; u.pn = j % nN; u.e = __builtin_amdgcn_readfirstlane(e); return true;
    }
    __device__ __forceinline__ const char* a_base() const { return A; }
    __device__ __forceinline__ int stagger() const { const int g = (c >> 3) / nN, ng = 32 / nN; (void)g; (void)ng; return 0; }
    __device__ __forceinline__ unsigned a_off(const Unit& u, int row, int col) const {
        const int pos = u.pm * BM + row;
        const int r = slot_tok ? slot_tok[pos] : pos;
        return (unsigned)(((size_t)r * K + col) * 2);
    }
    __device__ __forceinline__ int a_row(const Unit& u, int row) const { const int pos = u.pm * BM + row; return slot_tok ? ((const GAS int*)slot_tok)[pos] : pos; }
    __device__ __forceinline__ unsigned row_off(int r, int col) const { return (unsigned)(((size_t)r * K + col) * 2); }
    __device__ __forceinline__ const char* b_tile(const Unit& u) const { return Bt + ((size_t)u.e * rowsE + (size_t)u.pn * BM) * K * 2; }
};

struct MergeSched {
    const char* A; const char* Bt; int nM, nN, nwg, G, c;
    __device__ __forceinline__ void init(const void* A_, const void* Bt_, int M, int N, int G_, int c_) { A = (const char*)A_; Bt = (const char*)Bt_; nM = M / BM; nN = N / BM; nwg = nM * nN; G = G_; c = c_; }
    __device__ __forceinline__ bool next(int i, Unit& u) const {
        const int r = i / 3; const long L = (long)r * G + c; if (L >= nwg) return false;
        int wgid = (int)L; { const int q = nwg / 8, rr = nwg % 8, xcd = wgid % 8, off = wgid / 8; wgid = (xcd < rr ? xcd * (q + 1) : rr * (q + 1) + (xcd - rr) * q) + off; }
        const int nig = 8 * nN, gid = wgid / nig, fm = gid * 8, gsz = (nM - fm) < 8 ? (nM - fm) : 8;
        u.pm = fm + ((wgid % nig) % gsz); u.pn = (wgid % nig) / gsz; u.e = i - 3 * r; return true;
    }
    __device__ __forceinline__ const char* a_base() const { return A; }
    __device__ __forceinline__ int stagger() const { return 0; }
    __device__ __forceinline__ unsigned a_off(const Unit& u, int row, int col) const { return (unsigned)(((size_t)(u.pm * BM + row) * 512 + col) * 2 + (size_t)u.e * ((size_t)NTOK * 512 * 2)); }
    __device__ __forceinline__ const char* b_tile(const Unit& u) const { return Bt + ((size_t)u.e * DM + (size_t)u.pn * BM) * 512 * 2; }
};

constexpr int EPI_STAGE_OFF = 131072, EPI_STAGE_WAVE = 2304;
struct NoPre {};
template <int ACT> struct EpiBf16 {
    static constexpr bool PERM = true, DRAIN_TOP = false, STASH = false;
    struct Pre { f32x4 bv[2][2]; };
    bf16_t* O; int ldc; const float* bias; int rowmask = -1;
    __device__ __forceinline__ Pre preload(const Unit& u, int wr, int wc, int fr, int fq) const { Pre p; const int col0 = u.pn * BM + wc * 32 + 8 * fq;
#pragma unroll
        for (int bj = 0; bj < 2; ++bj)
#pragma unroll
            for (int n = 0; n < 2; ++n) p.bv[bj][n] = (f32x4){0.f, 0.f, 0.f, 0.f};
        return p; }
    __device__ __forceinline__ void arrived(Pre& p) const { asm volatile("" : "+v"(p.bv[0][0]), "+v"(p.bv[0][1]), "+v"(p.bv[1][0]), "+v"(p.bv[1][1])); }
    __device__ __forceinline__ void operator()(const f32x4 (&acc)[2][2][4][2], const Unit& u, int wr, int wc, int fr, int fq, const Pre& pre) const {
        const int row0 = u.pm * BM + wr * 64 + fr; const int col0 = u.pn * BM + wc * 32 + 8 * fq;
        f32x4 bv[2][2];
#pragma unroll
        for (int bj = 0; bj < 2; ++bj)
#pragma unroll
            for (int n = 0; n < 2; ++n) bv[bj][n] = bias ? *(const f32x4*)(bias + col0 + bj * HALF + 4 * n) : pre.bv[bj][n];
#pragma unroll
        for (int ai = 0; ai < 2; ++ai)
#pragma unroll
            for (int m = 0; m < 4; ++m) { bf16_t* rowp = O + (size_t)((row0 + ai * HALF + m * 16) & rowmask) * ldc + col0;
#pragma unroll
                for (int bj = 0; bj < 2; ++bj) { constexpr float sc = (ACT == 2) ? W8_INV : 1.f;
                    f32x4 v0 = acc[ai][bj][m][0] * sc + bv[bj][0], v1 = acc[ai][bj][m][1] * sc + bv[bj][1];
                    u32x4 w; w.x = cvt_pk_bf16(v0[0], v0[1]); w.y = cvt_pk_bf16(v0[2], v0[3]); w.z = cvt_pk_bf16(v1[0], v1[1]); w.w = cvt_pk_bf16(v1[2], v1[3]);
                    *(u32x4*)(rowp + bj * HALF) = w; } }
    }
};
struct EpiMerge {
    static constexpr bool PERM = true, DRAIN_TOP = false, STASH = false;
    typedef NoPre Pre; __device__ __forceinline__ Pre preload(const Unit&, int, int, int, int) const { return Pre{}; }
    const bf16_t* G; bf16_t* Mg;
    __device__ __forceinline__ void operator()(const f32x4 (&acc)[2][2][4][2], const Unit& u, int wr, int wc, int fr, int fq, const Pre&) const {
        const int row0 = u.pm * BM + wr * 64 + fr; const int col0 = u.pn * BM + wc * 32 + 8 * fq;
        const int goff = u.e * DM; const bool first = (u.e == 0);
#pragma unroll
        for (int ai = 0; ai < 2; ++ai)
#pragma unroll
            for (int m = 0; m < 4; ++m) { const size_t row = (size_t)(row0 + ai * HALF + m * 16);
#pragma unroll
                for (int bj = 0; bj < 2; ++bj) {
                    const u32x4 g = *(const u32x4*)(G + row * PW + goff + col0 + bj * HALF);
                    u32x4 p = (u32x4){0u, 0u, 0u, 0u};
                    if (!first) p = *(const u32x4*)(Mg + row * DM + col0 + bj * HALF);
                    const f32x4 a0 = acc[ai][bj][m][0], a1 = acc[ai][bj][m][1];
                    u32x4 w;
#define SGM(x_) __builtin_amdgcn_rcpf(1.f + __builtin_amdgcn_exp2f(-LOG2E * (x_)))
                    w.x = cvt_pk_bf16(bflo(p.x) + SGM(bflo(g.x)) * a0[0], bfhi(p.x) + SGM(bfhi(g.x)) * a0[1]);
                    w.y = cvt_pk_bf16(bflo(p.y) + SGM(bflo(g.y)) * a0[2], bfhi(p.y) + SGM(bfhi(g.y)) * a0[3]);
                    w.z = cvt_pk_bf16(bflo(p.z) + SGM(bflo(g.z)) * a1[0], bfhi(p.z) + SGM(bfhi(g.z)) * a1[1]);
                    w.w = cvt_pk_bf16(bflo(p.w) + SGM(bflo(g.w)) * a1[2], bfhi(p.w) + SGM(bfhi(g.w)) * a1[3]);
#undef SGM
                    *(u32x4*)(Mg + row * DM + col0 + bj * HALF) = w; } }
    }
};
struct EpiResid {
    static constexpr bool PERM = false, DRAIN_TOP = false, STASH = false;
    typedef NoPre Pre; __device__ __forceinline__ Pre preload(const Unit&, int, int, int, int) const { return Pre{}; }
    const float* base; float* out;
    __device__ __forceinline__ void operator()(const f32x4 (&acc)[2][2][4][2], const Unit& u, int wr, int wc, int fr, int fq, const Pre&) const {
        const int row0 = u.pm * BM + wr * 64 + fr; const int col0 = u.pn * BM + wc * 32 + 4 * fq;
#pragma unroll
        for (int ai = 0; ai < 2; ++ai)
#pragma unroll
            for (int m = 0; m < 4; ++m) { const size_t off = (size_t)(row0 + ai * HALF + m * 16) * DM + col0;
#pragma unroll
                for (int bj = 0; bj < 2; ++bj)
#pragma unroll
                    for (int n = 0; n < 2; ++n) { const f32x4 b = *(const f32x4*)(base + off + bj * HALF + n * 16); *(f32x4*)(out + off + bj * HALF + n * 16) = b + acc[ai][bj][m][n]; } }
    }
};
struct EpiSwiglu {
    static constexpr bool PERM = true, DRAIN_TOP = true, STASH = true;
    bf16_t* act; const float* bias; LAS unsigned char* lds;
    struct Pre { f32x4 bg[2], bu[2]; };
    __device__ __forceinline__ Pre preload(const Unit& u, int wr, int wc, int fr, int fq) const {
        const GAS float* be = (const GAS float*)bias + (size_t)u.e * 2048 + u.pn * HALF + wc * 32 + 8 * fq; Pre p;
#pragma unroll
        for (int n = 0; n < 2; ++n) { p.bg[n] = *(const GAS f32x4*)(be + 4 * n); p.bu[n] = *(const GAS f32x4*)(be + 1024 + 4 * n); }
        return p; }
    __device__ __forceinline__ void stash(const Pre& p, int wid, int fr, int fq) const {
        LAS f32x4* st = (LAS f32x4*)(lds + EPI_STAGE_OFF + wid * 256 + fq * 64);
        if (fr == 0) { st[0] = p.bg[0]; st[1] = p.bg[1]; st[2] = p.bu[0]; st[3] = p.bu[1]; } }
    __device__ __forceinline__ void operator()(const f32x4 (&acc)[2][2][4][2], const Unit& u, int wr, int wc, int fr, int fq, const Pre& pre) const {
        const int row0 = u.pm * BM + wr * 64 + fr; const int col0 = u.pn * HALF + wc * 32 + 8 * fq;
        f32x4 bg[2], bu[2];
#pragma unroll
        for (int n = 0; n < 2; ++n) { const LAS f32x4* st = (const LAS f32x4*)(lds + EPI_STAGE_OFF + (wr * 4 + wc) * 256 + fq * 64); bg[n] = st[n]; bu[n] = st[2 + n]; }
#pragma unroll
        for (int ai = 0; ai < 2; ++ai)
#pragma unroll
            for (int m = 0; m < 4; ++m) { bf16_t* rowp = act + (size_t)(row0 + ai * HALF + m * 16) * DEXP + col0;
                float o[8];
#pragma unroll
                for (int n = 0; n < 2; ++n) { const f32x4 gv = acc[ai][0][m][n] * W8_INV + bg[n], uv = acc[ai][1][m][n] * W8_INV + bu[n];
#pragma unroll
                    for (int q = 0; q < 4; ++q) { const float g = fminf(gv[q], 7.0f); const float uu = fminf(fmaxf(uv[q], -7.0f), 7.0f);
                        const float sg = __builtin_amdgcn_rcpf(1.f + __builtin_amdgcn_exp2f(-1.702f * LOG2E * g));
                        o[4 * n + q] = (uu + 1.0f) * (g * sg); } }
                u32x4 w; w.x = cvt_pk_bf16(o[0], o[1]); w.y = cvt_pk_bf16(o[2], o[3]); w.z = cvt_pk_bf16(o[4], o[5]); w.w = cvt_pk_bf16(o[6], o[7]);
                *(u32x4*)rowp = w; }
    }
};
struct EpiScatter {
    static constexpr bool PERM = false, DRAIN_TOP = false, STASH = false;
    typedef NoPre Pre; __device__ __forceinline__ Pre preload(const Unit&, int, int, int, int) const { return Pre{}; }
    float* out; const int* slot_tok; const float* slot_w; const float* bias; LAS unsigned char* lds;
    __device__ __forceinline__ void operator()(const f32x4 (&acc)[2][2][4][2], const Unit& u, int wr, int wc, int fr, int fq, const Pre&) const {
        const int lane = fr + 16 * fq, wid = wr * 4 + wc;
        LAS float* st = (LAS float*)(lds + EPI_STAGE_OFF + wid * EPI_STAGE_WAVE);
        const int row0 = u.pm * BM + wr * 64 + fr;
        const int lcol = lane & 31, lrow = lane >> 5;
        float bv[2];
#pragma unroll
        for (int bj = 0; bj < 2; ++bj) bv[bj] = bias[(size_t)u.e * DM + u.pn * BM + bj * HALF + wc * 32 + lcol];
#pragma unroll
        for (int ai = 0; ai < 2; ++ai)
#pragma unroll
            for (int m = 0; m < 4; ++m) { const int pos = row0 + ai * HALF + m * 16; const float w = slot_w[pos]; const int tok = slot_tok[pos];
#pragma unroll
                for (int bj = 0; bj < 2; ++bj) {
#pragma unroll
                    for (int n = 0; n < 2; ++n) *(LAS f32x4*)(st + fr * 36 + 16 * n + 4 * fq) = acc[ai][bj][m][n];
                    asm volatile("s_waitcnt lgkmcnt(0)" ::: "memory");
#pragma unroll
                    for (int i = 0; i < 8; ++i) { const int r = 2 * i + lrow; const float v = st[r * 36 + lcol];
                        const float wr_ = __shfl(w, r); const int tr_ = __shfl(tok, r);
                        if (wr_ != 0.f) unsafeAtomicAdd(out + (size_t)tr_ * DM + u.pn * BM + bj * HALF + wc * 32 + lcol, (v + bv[bj]) * wr_); }
                    asm volatile("s_waitcnt lgkmcnt(0)" ::: "memory");
                } }
    }
};
}

#define XB_TMO      128
#define XB_XCNT(j)  (256  + 64 * (j))
#define XB_XSUB(j)  (1280 + 64 * (j))
#define XB_XGEN(j)  (2304 + 64 * (j))
#define XB_TOP      3328
#define XB_TOPGEN   3392
#define XCD_BAR_WORDS 3456
#define XB_SPIN_CAP (1u << 18)

__device__ __forceinline__ unsigned xb_ld(unsigned* p)              { return __hip_atomic_load(p, __ATOMIC_RELAXED, __HIP_MEMORY_SCOPE_AGENT); }
__device__ __forceinline__ unsigned xb_add(unsigned* p, unsigned v) { return __hip_atomic_fetch_add(p, v, __ATOMIC_RELAXED, __HIP_MEMORY_SCOPE_AGENT); }
__device__ __forceinline__ unsigned xb_xcc_id() { return (unsigned)__builtin_amdgcn_s_getreg((3 << 11) | 20) & 0xFu; }
#define XB_SPIN(cond, bar) do { unsigned _sp = 0; while (cond) { __builtin_amdgcn_s_sleep(1); \
    if ((++_sp & 255u) == 0u) { if (xb_ld(&(bar)[XB_TMO])) break; if (_sp > XB_SPIN_CAP) { atomicAdd(&(bar)[XB_TMO], 1u); break; } } } } while (0)

struct XcdBarrier {
    unsigned* bar; unsigned x; int wave;
    volatile LAS unsigned* st;
};

__device__ __forceinline__ XcdBarrier xcd_barrier_post(unsigned* bar, volatile LAS unsigned* st) {
    XcdBarrier b; b.bar = bar; b.x = xb_xcc_id(); b.st = st; b.wave = __builtin_amdgcn_readfirstlane((int)(threadIdx.x >> 6));
    if (threadIdx.x == 0) (void)xb_add(&bar[XB_XCNT(b.x)], 1u);
    return b;
}
__device__ __forceinline__ void xcd_barrier_complete(unsigned* bar, unsigned x, unsigned& nloc, unsigned& nx) {
    const unsigned G = gridDim.x * gridDim.y * gridDim.z;
    unsigned sum, cnt, mine, sp = 0u;
    for (;;) {
        sum = 0u; cnt = 0u; mine = 0u;
#pragma unroll
        for (unsigned j = 0; j < 16; ++j) { const unsigned c = xb_ld(&bar[XB_XCNT(j)]); sum += c; cnt += (c > 0u) ? 1u : 0u; mine = (j == x) ? c : mine; }
        if (sum == G) break;
        __builtin_amdgcn_s_sleep(1);
        if ((++sp & 255u) == 0u) { if (xb_ld(&bar[XB_TMO])) break; if (sp > XB_SPIN_CAP) { atomicAdd(&bar[XB_TMO], 1u); break; } }
    }
    nloc = mine > 0u ? mine : 1u; nx = cnt > 0u ? cnt : 1u;
}

__device__ __forceinline__ void xcd_barrier(const XcdBarrier& b) {
    asm volatile("s_waitcnt vmcnt(0)" ::: "memory");
    __syncthreads();
    if (b.wave == 0 && lane_id_fresh() == 0) {
        unsigned* bar = b.bar;
        __builtin_amdgcn_s_waitcnt(0);
        unsigned nloc = b.st[0], nx = b.st[1];
        if (nloc == 0u) { xcd_barrier_complete(bar, b.x, nloc, nx); b.st[0] = nloc; b.st[1] = nx; }
        const unsigned old = xb_add(&bar[XB_XSUB(b.x)], 1u);
        const unsigned gen = old / nloc;
        if (old + 1u == (gen + 1u) * nloc) {
            __builtin_amdgcn_fence(__ATOMIC_RELEASE, "agent");
            asm volatile("s_waitcnt vmcnt(0)" ::: "memory");
            const unsigned og = xb_add(&bar[XB_TOP], 1u);
            const unsigned tg = og / nx;
            if (og + 1u == (tg + 1u) * nx) xb_add(&bar[XB_TOPGEN], 1u);
            else XB_SPIN(xb_ld(&bar[XB_TOPGEN]) == tg, bar);
            __builtin_amdgcn_fence(__ATOMIC_ACQUIRE, "agent");
            xb_add(&bar[XB_XGEN(b.x)], 1u);
            asm volatile("s_waitcnt vmcnt(0)" ::: "memory");
        } else {
            XB_SPIN(xb_ld(&bar[XB_XGEN(b.x)]) == gen, bar);
            __builtin_amdgcn_fence(__ATOMIC_ACQUIRE, "agent");
            asm volatile("s_waitcnt vmcnt(0)" ::: "memory");
        }
    }
    __syncthreads();
}

constexpr int NWAVES = 8;
struct Frame {
    LAS unsigned char* lds;
    volatile LAS unsigned* MISC;
    gu32* ctl;
    int tid, lane, wave, G, blk;
    const float* in[21];
    float* out; unsigned char* ws;
};
__device__ __forceinline__ float wave_sum(float v) {
#pragma unroll
    for (int o = 1; o < 64; o <<= 1) v += __shfl_xor(v, o);
    return v;
}

__device__ __forceinline__ int map_src(int mode, int n) {
    if (mode == 1) return n < 2500 ? n : (n >= C_MQ ? n - (C_MQ - 2500) : -1);
    if (mode == 2) { const int pn = n >> 8, bj = (n >> 7) & 1, j = n & 127; return bj * 1024 + pn * 128 + j; }
    return n;
}
__device__ __forceinline__ void transpose_item(const float* W, int K, int Nsrc, int Ndst, bf16_t* WT, int mode, LAS float* scr, int item, int lane) {
    const int nblk = Ndst / 32, kb = item / nblk, nb = item % nblk, k0 = 64 * kb, n0 = 32 * nb;
    const int sc = map_src(mode, n0 + (lane & 31));
    const float scale = (mode == 1 && (n0 + (lane & 31)) < 512) ? 0.125f : 1.0f;
#pragma unroll
    for (int i = 0; i < 32; ++i) { const int kk = 2 * i + (lane >> 5); scr[kk * 33 + (lane & 31)] = sc >= 0 ? W[(size_t)(k0 + kk) * Nsrc + sc] * scale : 0.f; }
    LDS_WAIT(); asm volatile("" ::: "memory");
    const int c = lane & 7;
#pragma unroll
    for (int j = 0; j < 4; ++j) { const int n = (lane >> 3) + 8 * j; const LAS float* s = scr + (8 * c) * 33 + n;
        u32x4 o; o.x = pk2(s[0 * 33], s[1 * 33]); o.y = pk2(s[2 * 33], s[3 * 33]); o.z = pk2(s[4 * 33], s[5 * 33]); o.w = pk2(s[6 * 33], s[7 * 33]);
        *(GAS u32x4*)(WT + (size_t)(n0 + n) * K + k0 + 8 * c) = o; }
    LDS_WAIT(); asm volatile("" ::: "memory");
}
__device__ __forceinline__ unsigned pk4_f8(float a, float b, float c, float d) { int v = __builtin_amdgcn_cvt_pk_fp8_f32(a, b, 0, false); return (unsigned)__builtin_amdgcn_cvt_pk_fp8_f32(c, d, v, true); }
__device__ __forceinline__ void transpose_item_f8(const float* W, int K, int Nsrc, int Ndst, unsigned char* WT, int mode, float scale, LAS float* scr, int item, int lane) {
    const int nblk = Ndst / 32, kb = item / nblk, nb = item % nblk, k0 = 64 * kb, n0 = 32 * nb;
    const int sc = map_src(mode, n0 + (lane & 31));
#pragma unroll
    for (int i = 0; i < 32; ++i) { const int kk = 2 * i + (lane >> 5); scr[kk * 33 + (lane & 31)] = sc >= 0 ? W[(size_t)(k0 + kk) * Nsrc + sc] * scale : 0.f; }
    LDS_WAIT(); asm volatile("" ::: "memory");
    const int c = lane & 7;
#pragma unroll
    for (int j = 0; j < 4; ++j) { const int n = (lane >> 3) + 8 * j; const LAS float* s = scr + (8 * c) * 33 + n;
        u32x2 o; o.x = pk4_f8(s[0 * 33], s[1 * 33], s[2 * 33], s[3 * 33]); o.y = pk4_f8(s[4 * 33], s[5 * 33], s[6 * 33], s[7 * 33]);
        *(GAS u32x2*)(WT + (size_t)(n0 + n) * K + k0 + 8 * c) = o; }
    LDS_WAIT(); asm volatile("" ::: "memory");
}
__device__ __forceinline__ void rms_row_to_bf16(int lane, const float* xrow, const float* g, bf16_t* orow) {
    const GAS f32x4* xr = (const GAS f32x4*)xrow + lane; const GAS f32x4* gr = (const GAS f32x4*)g + lane;
    f32x4 v[4]; float s = 0.f;
#pragma unroll
    for (int j = 0; j < 4; ++j) { v[j] = xr[64 * j]; s += (v[j].x * v[j].x + v[j].y * v[j].y) + (v[j].z * v[j].z + v[j].w * v[j].w); }
    const float rstd = 1.0f / sqrtf(wave_sum(s) * (1.f / DM) + EPS);
    GAS u32x2* o8 = (GAS u32x2*)orow + lane;
#pragma unroll
    for (int j = 0; j < 4; ++j) { const f32x4 gg = gr[64 * j]; u32x2 o; o.x = pk2(v[j].x * rstd * gg.x, v[j].y * rstd * gg.y); o.y = pk2(v[j].z * rstd * gg.z, v[j].w * rstd * gg.w); o8[64 * j] = o; }
}

__device__ __forceinline__ void rms_rows4_to_bf16(int lane, const float* x, const float* g, bf16_t* o, size_t m0, size_t stride, unsigned char* o8f = nullptr) {
    f32x4 v[4][4]; float s[4];
#pragma unroll
    for (int r = 0; r < 4; ++r) { const GAS f32x4* xr = (const GAS f32x4*)(x + (m0 + r * stride) * DM) + lane;
#pragma unroll
        for (int j = 0; j < 4; ++j) v[r][j] = xr[64 * j]; }
    const GAS f32x4* gr = (const GAS f32x4*)g + lane;
    f32x4 gg[4];
#pragma unroll
    for (int j = 0; j < 4; ++j) gg[j] = gr[64 * j];
#pragma unroll
    for (int r = 0; r < 4; ++r) { float a = 0.f;
#pragma unroll
        for (int j = 0; j < 4; ++j) a += (v[r][j].x * v[r][j].x + v[r][j].y * v[r][j].y) + (v[r][j].z * v[r][j].z + v[r][j].w * v[r][j].w);
        s[r] = a; }
#pragma unroll
    for (int of = 1; of < 64; of <<= 1) {
#pragma unroll
        for (int r = 0; r < 4; ++r) s[r] += __shfl_xor(s[r], of); }
#pragma unroll
    for (int r = 0; r < 4; ++r) { const float rstd = 1.0f / sqrtf(s[r] * (1.f / DM) + EPS);
        GAS u32x2* o8 = (GAS u32x2*)(o + (m0 + r * stride) * DM) + lane;
#pragma unroll
        for (int j = 0; j < 4; ++j) { const float a0 = v[r][j].x * rstd * gg[j].x, a1 = v[r][j].y * rstd * gg[j].y, a2 = v[r][j].z * rstd * gg[j].z, a3 = v[r][j].w * rstd * gg[j].w;
            u32x2 w; w.x = pk2(a0, a1); w.y = pk2(a2, a3); o8[64 * j] = w;
            if (o8f) *((GAS unsigned*)(o8f + (m0 + r * stride) * DM) + lane + 64 * j) = pk4_f8(a0, a1, a2, a3); } }
}
__device__ __forceinline__ void p0_prologue(Frame& F) {
    LAS float* scr = (LAS float*)(F.lds + F.wave * 16384);
    const int gw = F.blk * NWAVES + F.wave, NGW = F.G * NWAVES, lane = F.lane;
    unsigned char* ws = F.ws;
    constexpr int I_IN = 16 * 96, I_MKV = 16 * 32, I_G = 16 * 32, I_B = 8 * 32, I_O = 16 * 32, I_EI = 16 * 64, I_EO = 16 * 32;
    constexpr int NITEMS = I_IN + I_MKV + 3 * I_G + 3 * I_B + I_O + NEXP * I_EI + NEXP * I_EO;
    for (int it = gw; it < NITEMS; it += NGW) {
        int r = it;
        if (r < I_IN) { transpose_item(F.in[3], DM, IN_W, PW, (bf16_t*)(ws + WS_WIN), 1, scr, r, lane); continue; } r -= I_IN;
        if (r < I_MKV) { transpose_item(F.in[9], DM, DM, DM, (bf16_t*)(ws + WS_WMKV), 0, scr, r, lane); continue; } r -= I_MKV;
        if (r < 3 * I_G) { const int n = r / I_G; transpose_item_f8(F.in[10] + (size_t)n * DM * DM, DM, DM, DM, ws + WS_WG + (size_t)n * DM * DM, 0, W8_SCALE, scr, r % I_G, lane); continue; } r -= 3 * I_G;
        if (r < 3 * I_B) { const int n = r / I_B; transpose_item(F.in[12] + (size_t)n * 512 * DM, 512, DM, DM, (bf16_t*)(ws + WS_WB) + (size_t)n * DM * 512, 0, scr, r % I_B, lane); continue; } r -= 3 * I_B;
        if (r < I_O) { transpose_item(F.in[13], DM, DM, DM, (bf16_t*)(ws + WS_WO), 0, scr, r, lane); continue; } r -= I_O;
        if (r < NEXP * I_EI) { const int e = r / I_EI; transpose_item_f8(F.in[17] + (size_t)e * DM * 2048, DM, 2048, 2048, ws + WS_WEI + (size_t)e * 2048 * DM, 2, W8_SCALE, scr, r % I_EI, lane); continue; } r -= NEXP * I_EI;
        { const int e = r / I_EO; transpose_item(F.in[19] + (size_t)e * DM * DM, DM, DM, DM, (bf16_t*)(ws + WS_WEO) + (size_t)e * DM * DM, 0, scr, r % I_EO, lane); }
    }
    { f32x2* tab = (f32x2*)(ws + WS_ROPE);
      for (int idx = (F.blk * NWAVES * 64) + F.tid; idx < SEQ * 32; idx += F.G * NWAVES * 64) {
          const int s = idx >> 5, i = idx & 31;
          const float inv = exp2f(-(float)i * (13.287712379549449f / 32.0f));
          const float ang = (float)s * inv;
          const double rev = (double)ang * 0.15915494309189535;
          const float fr = (float)(rev - __builtin_rint(rev));
          tab[idx] = (f32x2){__builtin_amdgcn_cosf(fr), __builtin_amdgcn_sinf(fr)}; } }
    for (int m = gw; m < NTOK; m += 4 * NGW) rms_rows4_to_bf16(lane, F.in[0], F.in[2], (bf16_t*)(ws + WS_H), (size_t)m, (size_t)NGW, ws + WS_H8);
    for (int m = gw; m < NMEM; m += 4 * NGW) rms_rows4_to_bf16(lane, F.in[1], F.in[8], (bf16_t*)(ws + WS_MEMN), (size_t)m, (size_t)NGW);
    { int* st = (int*)(ws + WS_SLOT_TOK); float* sw = (float*)(ws + WS_SLOT_W);
      for (int i = F.blk * NWAVES * 64 + F.tid; i < NSLOT_PAD; i += F.G * NWAVES * 64) { st[i] = 0; sw[i] = 0.f; } }
}

template <int CTRL> __device__ __forceinline__ float dppf(float v) { return __builtin_bit_cast(float, __builtin_amdgcn_update_dpp(0, __builtin_bit_cast(int, v), CTRL, 0xF, 0xF, false)); }
__device__ __forceinline__ float lx1(float v) { return dppf<0xB1>(v); }
__device__ __forceinline__ float lx2(float v) { return dppf<0x4E>(v); }
__device__ __forceinline__ float lx4(float v) { return dppf<0x1B>(dppf<0x141>(v)); }
__device__ __forceinline__ float lx8(float v) { return dppf<0x128>(v); }
__device__ __forceinline__ void un8(const u32x4 w, float (&v)[8]) { v[0] = bflo(w.x); v[1] = bfhi(w.x); v[2] = bflo(w.y); v[3] = bfhi(w.y); v[4] = bflo(w.z); v[5] = bfhi(w.z); v[6] = bflo(w.w); v[7] = bfhi(w.w); }
__device__ __forceinline__ u32x4 pk8(const float (&v)[8]) { u32x4 w; w.x = pk2(v[0], v[1]); w.y = pk2(v[2], v[3]); w.z = pk2(v[4], v[5]); w.w = pk2(v[6], v[7]); return w; }
__device__ __forceinline__ void rope8(float (&v)[8], const f32x2 (&cs)[8], bool up) {
#pragma unroll
    for (int j = 0; j < 8; ++j) { const float other = lx4(v[j]); v[j] = up ? (other * cs[j].y + v[j] * cs[j].x) : (v[j] * cs[j].x - other * cs[j].y); }
}
__device__ __forceinline__ void p2_prep(Frame& F, const bool dummy = false) {
    const int gw = F.blk * NWAVES + F.wave, NGW = F.G * NWAVES, lane = F.lane;
    bf16_t* proj = (bf16_t*)(F.ws + WS_P);
    bf16_t* projw = dummy ? (bf16_t*)(F.ws + WS_END) : proj;
    const int wmask = dummy ? 8191 : 0x7fffffff;
    const f32x2* tab = (const f32x2*)(F.ws + WS_ROPE);
    float gqd[8], gkd[8], gqm[8];
#pragma unroll
    for (int j = 0; j < 8; ++j) { gqd[j] = F.in[4][8 * (lane & 7) + j] * (0.125f * LOG2E); gkd[j] = F.in[5][8 * (lane & 7) + j]; gqm[j] = F.in[6][8 * (lane & 15) + j] * (0.08838834764831845f * LOG2E); }
    const bool up = (lane & 4) != 0; const int i0 = (lane & 3) * 8;
    for (int m0 = gw; m0 < NTOK; m0 += 2 * NGW) {
        u32x4 raw[2][5]; f32x2 cs[2][8];
#pragma unroll
        for (int t = 0; t < 2; ++t) { const GAS bf16_t* row = (const GAS bf16_t*)proj + (size_t)(m0 + t * NGW) * PW;
            raw[t][0] = *(const GAS u32x4*)(row + C_DQ + 8 * lane); raw[t][1] = *(const GAS u32x4*)(row + C_DK + 8 * (lane & 7)); raw[t][2] = *(const GAS u32x4*)(row + C_IQ + 8 * (lane & 31));
            raw[t][3] = *(const GAS u32x4*)(row + C_IK + 8 * (lane & 7)); raw[t][4] = *(const GAS u32x4*)(row + C_MQ + 8 * lane);
            const GAS f32x2* tr = (const GAS f32x2*)tab + (size_t)((m0 + t * NGW) & (SEQ - 1)) * 32 + i0;
#pragma unroll
            for (int j = 0; j < 8; ++j) cs[t][j] = tr[j]; }
#pragma unroll
        for (int t = 0; t < 2; ++t) {
            GAS bf16_t* roww = (GAS bf16_t*)projw + (size_t)((m0 + t * NGW) & wmask) * PW;
            float v[8];
            { un8(raw[t][0], v); float ss = 0.f;
#pragma unroll
              for (int j = 0; j < 8; ++j) ss += v[j] * v[j];
              ss += lx1(ss); ss += lx2(ss); ss += lx4(ss);
              const float rstd = 1.0f / sqrtf(ss * (1.f / 64.f) + EPS);
#pragma unroll
              for (int j = 0; j < 8; ++j) v[j] = v[j] * rstd * gqd[j];
              rope8(v, cs[t], up);
              *(GAS u32x4*)(roww + C_DQ + 8 * lane) = pk8(v); }
            { un8(raw[t][1], v); float ss = 0.f;
#pragma unroll
              for (int j = 0; j < 8; ++j) ss += v[j] * v[j];
              ss += lx1(ss); ss += lx2(ss); ss += lx4(ss);
              const float rstd = 1.0f / sqrtf(ss * (1.f / 64.f) + EPS);
#pragma unroll
              for (int j = 0; j < 8; ++j) v[j] = v[j] * rstd * gkd[j];
              rope8(v, cs[t], up);
              if (lane < 8) *(GAS u32x4*)(roww + C_DK + 8 * lane) = pk8(v); }
            { un8(raw[t][2], v); rope8(v, cs[t], up); if (lane < 32) *(GAS u32x4*)(roww + C_IQ + 8 * lane) = pk8(v); }
            { un8(raw[t][3], v); rope8(v, cs[t], up); if (lane < 8) *(GAS u32x4*)(roww + C_IK + 8 * lane) = pk8(v); }
            { un8(raw[t][4], v); float ss = 0.f;
#pragma unroll
              for (int j = 0; j < 8; ++j) ss += v[j] * v[j];
              ss += lx1(ss); ss += lx2(ss); ss += lx4(ss); ss += lx8(ss);
              const float rstd = 1.0f / sqrtf(ss * (1.f / 128.f) + EPS);
#pragma unroll
              for (int j = 0; j < 8; ++j) v[j] = v[j] * rstd * gqm[j];
              *(GAS u32x4*)(roww + C_MQ + 8 * lane) = pk8(v); }
        }
    }
    bf16_t* mkv = (bf16_t*)(F.ws + WS_MKV);
    if (!dummy) for (int m = gw; m < NMEM; m += NGW) {
        GAS bf16_t* row = (GAS bf16_t*)mkv + (size_t)m * DM; float v[8];
        un8(*(const GAS u32x4*)(row + 8 * lane), v); float ss = 0.f;
#pragma unroll
        for (int j = 0; j < 8; ++j) ss += v[j] * v[j];
        ss += lx1(ss); ss += lx2(ss); ss += lx4(ss); ss += lx8(ss);
        const float rstd = 1.0f / sqrtf(ss * (1.f / 128.f) + EPS);
#pragma unroll
        for (int j = 0; j < 8; ++j) v[j] = v[j] * rstd * F.in[7][8 * (lane & 15) + j];
        *(GAS u32x4*)(row + 8 * lane) = pk8(v);
    }
}

#define MFMA32(a, b, c) __builtin_amdgcn_mfma_f32_32x32x16_bf16((a), (b), (c), 0, 0, 0)
typedef LAS const unsigned char* lds_cptr;
__device__ __forceinline__ s16x4 vtr(lds_cptr p) { return __builtin_bit_cast(s16x4, __builtin_amdgcn_ds_read_tr16_b64_v4i16((LAS v4i16_t*)p)); }
__device__ __forceinline__ bf16x8 vfrag(lds_cptr vbase_lane, int off) {
    const s16x4 lo = vtr(vbase_lane + off), hi = vtr(vbase_lane + off + 512);
    return (bf16x8){lo[0], lo[1], lo[2], lo[3], hi[0], hi[1], hi[2], hi[3]};
}
__device__ __forceinline__ int vtr_lane_off(int lane) { return ((lane >> 4) & 1) * 32 + (lane & 3) * 8 + (4 * (lane >> 5) + ((lane & 15) >> 2)) * 64; }
__device__ __forceinline__ bf16x8 pack8(const float* p) {
    u32x4 w; w.x = cvt_pk_bf16(p[0], p[1]); w.y = cvt_pk_bf16(p[2], p[3]); w.z = cvt_pk_bf16(p[4], p[5]); w.w = cvt_pk_bf16(p[6], p[7]);
    return __builtin_bit_cast(bf16x8, w);
}
__device__ __forceinline__ float softplus_f(float z) { return fmaxf(z, 0.f) + __logf(1.f + __expf(-fabsf(z))); }

__device__ __forceinline__ void sb_item(const bf16_t* proj, bf16_t* osb, int b, int h, int qblk, LAS unsigned char* vlds, int lane) {
    const int r32 = lane & 31, hi = lane >> 5;
    const size_t tok0 = (size_t)b * SEQ + (size_t)qblk * 32;
    bf16x8 qr[4];
    { const bf16_t* qp = proj + (tok0 + r32) * PW + C_SQ + h * 64 + hi * 8;
#pragma unroll
      for (int kk = 0; kk < 4; ++kk) qr[kk] = *(const bf16x8*)(qp + kk * 16); }
    f32x16 o0 = {}, o1 = {}; float R = 0.f;
    const lds_cptr vrd = (lds_cptr)vlds + vtr_lane_off(lane);
    bf16x8 kfn[4]; u32x4 vvn[4];
#define SB_LOAD(kt_) do { const size_t key0_ = (size_t)b * SEQ + (size_t)(kt_) * 32; const GAS bf16_t* kp_ = (const GAS bf16_t*)proj + (key0_ + r32) * PW + C_SK + h * 64 + hi * 8; \
        _Pragma("unroll") for (int kk = 0; kk < 4; ++kk) kfn[kk] = *(const GAS bf16x8*)(kp_ + kk * 16); \
        _Pragma("unroll") for (int p = 0; p < 4; ++p) vvn[p] = *(const GAS u32x4*)((const GAS bf16_t*)proj + (key0_ + 16 * (p & 1) + (lane >> 2)) * PW + C_SV + h * 64 + (p >> 1) * 32 + (lane & 3) * 8); } while (0)
    SB_LOAD(qblk);
    for (int kt = qblk; kt >= 0; --kt) {
        bf16x8 kf[4]; u32x4 vv[4];
#pragma unroll
        for (int i = 0; i < 4; ++i) { kf[i] = kfn[i]; vv[i] = vvn[i]; }
        if (kt > 0) SB_LOAD(kt - 1);
        f32x16 s = {};
#pragma unroll
        for (int kk = 0; kk < 4; ++kk) s = MFMA32(kf[kk], qr[kk], s);
        asm volatile("" ::: "memory");
#pragma unroll
        for (int p = 0; p < 4; ++p) *(LAS u32x4*)(vlds + p * 1024 + lane * 16) = vv[p];
        const bool diag = (kt == qblk);
        float sp[16], pr[16];
#pragma unroll
        for (int r = 0; r < 16; ++r) { const bool valid = !diag || (crow(r, hi) < r32); sp[r] = valid ? softplus_f(s[r]) : 0.f; }
        float T[4], U[4];
#pragma unroll
        for (int g = 0; g < 4; ++g) { T[g] = (sp[4 * g] + sp[4 * g + 1]) + (sp[4 * g + 2] + sp[4 * g + 3]); { const auto rr = __builtin_amdgcn_permlane32_swap(__float_as_uint(T[g]), __float_as_uint(T[g]), false, false); U[g] = hi ? __uint_as_float(rr[0]) : __uint_as_float(rr[1]); } }
        float run = 0.f, above[4];
#pragma unroll
        for (int g = 3; g >= 0; --g) { above[g] = run + (hi == 0 ? U[g] : 0.f); run += T[g] + U[g]; }
#pragma unroll
        for (int g = 0; g < 4; ++g) { float c = R + above[g];
#pragma unroll
            for (int j = 3; j >= 0; --j) { const int r = 4 * g + j; c += sp[r]; const bool valid = !diag || (crow(r, hi) < r32); pr[r] = valid ? __expf(s[r] - c) : 0.f; } }
        R += run;
        const bf16x8 p0 = pack8(pr), p1 = pack8(pr + 8);
        LDS_WAIT();
        const bf16x8 v00 = vfrag(vrd, 0), v01 = vfrag(vrd, 1024), v10 = vfrag(vrd, 2048), v11 = vfrag(vrd, 3072);
        o0 = MFMA32(v00, p0, o0); o0 = MFMA32(v01, p1, o0);
        o1 = MFMA32(v10, p0, o1); o1 = MFMA32(v11, p1, o1);
        asm volatile("" ::: "memory");
        if (__all(R > 30.0f)) break;
    }
#undef SB_LOAD
    bf16_t* op = osb + (tok0 + r32) * 512 + h * 64 + 4 * hi;
#pragma unroll
    for (int g = 0; g < 4; ++g) {
        u32x2 w0, w1; w0.x = cvt_pk_bf16(o0[4 * g], o0[4 * g + 1]); w0.y = cvt_pk_bf16(o0[4 * g + 2], o0[4 * g + 3]); w1.x = cvt_pk_bf16(o1[4 * g], o1[4 * g + 1]); w1.y = cvt_pk_bf16(o1[4 * g + 2], o1[4 * g + 3]);
        *(u32x2*)(op + 8 * g) = w0; *(u32x2*)(op + 32 + 8 * g) = w1; }
}

constexpr int ML_K = 0, ML_KROW = 272, ML_V = 256 * ML_KROW, ML_END = ML_V + 65536;
__device__ __forceinline__ void mem_unit(const bf16_t* proj, const bf16_t* mkv, bf16_t* omem, int b, int h, int half, LAS unsigned char* ml, int tid) {
    const int lane = tid & 63, wid = __builtin_amdgcn_readfirstlane(tid >> 6), r32 = lane & 31, hi = lane >> 5;
    { const GAS bf16_t* src = (const GAS bf16_t*)mkv + (size_t)b * MEMLEN * DM + h * 128;
#pragma unroll
      for (int i = 0; i < 8; ++i) { const int ch = tid + 512 * i, key = ch >> 4, c16 = ch & 15, kk = key & 31;
          const u32x4 kv = *(const GAS u32x4*)(src + (size_t)key * DM + c16 * 8);
          const u32x4 vv = *(const GAS u32x4*)(src + (size_t)key * DM + 512 + c16 * 8);
          *(LAS u32x4*)(ml + ML_K + key * ML_KROW + c16 * 16) = kv;
          *(LAS u32x4*)(ml + ML_V + (key >> 5) * 8192 + ((c16 >> 2) * 2 + (kk >> 4)) * 1024 + (kk & 15) * 64 + (c16 & 3) * 16) = vv; } }
    __syncthreads();
    for (int i = 0; i < 4; ++i) {
        const int qblk = half * 32 + wid * 4 + i;
        const size_t tok0 = (size_t)b * SEQ + (size_t)qblk * 32;
        bf16x8 qr[8];
        { const GAS bf16_t* qp = (const GAS bf16_t*)proj + (tok0 + r32) * PW + C_MQ + h * 128 + hi * 8;
#pragma unroll
          for (int kk = 0; kk < 8; ++kk) qr[kk] = *(const GAS bf16x8*)(qp + kk * 16); }
        f32x16 o[4] = {{}, {}, {}, {}}; float m = -1e30f, l = 0.f;
        for (int kb = 0; kb < 8; ++kb) {
            const LAS unsigned char* krd = ml + ML_K + (32 * kb + r32) * ML_KROW + hi * 16;
            f32x16 s = {};
#pragma unroll
            for (int kk = 0; kk < 8; ++kk) { const bf16x8 kf = *(const LAS bf16x8*)(krd + kk * 32); s = MFMA32(kf, qr[kk], s); }
            float mx = s[0];
#pragma unroll
            for (int r = 1; r < 16; ++r) mx = fmaxf(mx, s[r]);
            { const auto rr = __builtin_amdgcn_permlane32_swap(__float_as_uint(mx), __float_as_uint(mx), false, false); mx = fmaxf(__uint_as_float(rr[0]), __uint_as_float(rr[1])); }
            if (__any(mx > m + 8.0f)) {
                const float mn = fmaxf(m, mx), alpha = __builtin_amdgcn_exp2f(m - mn);
                l *= alpha; m = mn;
#pragma unroll
                for (int d = 0; d < 4; ++d)
#pragma unroll
                    for (int r = 0; r < 16; ++r) o[d][r] *= alpha;
            }
            float pr[16], rs = 0.f;
#pragma unroll
            for (int r = 0; r < 16; ++r) { pr[r] = __builtin_amdgcn_exp2f(s[r] - m); rs += pr[r]; }
            l += rs;
            const bf16x8 p0 = pack8(pr), p1 = pack8(pr + 8);
            const lds_cptr vrd = (lds_cptr)ml + ML_V + kb * 8192 + vtr_lane_off(lane);
#pragma unroll
            for (int d = 0; d < 4; ++d) { const bf16x8 va = vfrag(vrd, d * 2048), vb = vfrag(vrd, d * 2048 + 1024); o[d] = MFMA32(va, p0, o[d]); o[d] = MFMA32(vb, p1, o[d]); }
        }
        { const auto rr = __builtin_amdgcn_permlane32_swap(__float_as_uint(l), __float_as_uint(l), false, false); l = __uint_as_float(rr[0]) + __uint_as_float(rr[1]); }
        const float il = 1.0f / l;
        bf16_t* op = omem + (tok0 + r32) * 512 + h * 128 + 4 * hi;
#pragma unroll
        for (int d = 0; d < 4; ++d)
#pragma unroll
            for (int g = 0; g < 4; ++g) { u32x2 w; w.x = cvt_pk_bf16(o[d][4 * g] * il, o[d][4 * g + 1] * il); w.y = cvt_pk_bf16(o[d][4 * g + 2] * il, o[d][4 * g + 3] * il); *(u32x2*)(op + 32 * d + 8 * g) = w; }
    }
    __syncthreads();
}

constexpr int DL_HIST = 0, DL_PREFIX = 66048, DL_KREM = DL_PREFIX + 256, DL_MASK = 67072, DL_VT = 73728, DL_KT = DL_VT + 2 * 16384, DL_END = DL_KT + 2 * 18432, DL_IQ = DL_VT;
constexpr int TOPK_DSA = 256;

struct IqLds { const LAS unsigned char* p; __device__ __forceinline__ bf16x8 operator()(int j) const { return *(const LAS bf16x8*)(p + j * 32); } };
template <class QF>
__device__ __forceinline__ void idx_scores(const QF& qf, const bf16x8 (&kf)[4], const float (&wq)[4], unsigned (&uk)[16]) {
    float scv[16];
#pragma unroll
    for (int hd = 0; hd < 4; ++hd) { f32x16 a = (f32x16){};
#pragma unroll
        for (int kk = 0; kk < 4; ++kk) a = MFMA32(kf[kk], qf(hd * 4 + kk), a);
#pragma unroll
        for (int r = 0; r < 16; ++r) scv[r] = (hd == 0) ? wq[0] * fmaxf(a[r], 0.f) : __builtin_fmaf(wq[hd], fmaxf(a[r], 0.f), scv[r]); }
#pragma unroll
    for (int r = 0; r < 16; ++r) {
        unsigned bits = __builtin_bit_cast(unsigned, scv[r]);
        if (bits == 0x80000000u) bits = 0u;
        uk[r] = bits ^ ((unsigned)((int)bits >> 31) | 0x80000000u);
    }
}
__device__ __forceinline__ void load_ik(const bf16_t* proj, size_t tokb, int kbase, int r32, int hi, bf16x8 (&kf)[4]) {
    int kr = kbase + r32; if (kr > SEQ - 1) kr = SEQ - 1;
    const GAS bf16_t* p = (const GAS bf16_t*)proj + (tokb + kr) * PW + C_IK + 8 * hi;
#pragma unroll
    for (int kk = 0; kk < 4; ++kk) kf[kk] = *(const GAS bf16x8*)(p + kk * 16);
}

__device__ __forceinline__ void dsa_unit(const bf16_t* proj, bf16_t* odsa, unsigned* kscr  , int b, int c, LAS unsigned char* dl, int tid) {
    const int lane = tid & 63, wid = __builtin_amdgcn_readfirstlane(tid >> 6), r32 = lane & 31, hi = lane >> 5;
    const int n = 64 * (c + 1), nsteps = (n + 127) >> 7;
    const size_t tokq0 = (size_t)b * SEQ + (size_t)c * 64, tokb = (size_t)b * SEQ;
    LAS unsigned* hist = (LAS unsigned*)(dl + DL_HIST);
    LAS unsigned* prefix = (LAS unsigned*)(dl + DL_PREFIX);
    LAS unsigned* krem = (LAS unsigned*)(dl + DL_KREM);
    LAS unsigned* mask = (LAS unsigned*)(dl + DL_MASK);
    const int kb = wid >> 1, qh = wid & 1;
    { const int row = tid >> 3, c = tid & 7;
      const GAS bf16_t* src = (const GAS bf16_t*)proj + (tokq0 + row) * PW + C_IQ + c * 32;
#pragma unroll
      for (int i = 0; i < 4; ++i) *(LAS u32x4*)(dl + DL_IQ + row * 528 + c * 64 + i * 16) = *(const GAS u32x4*)(src + i * 8); }
    const IqLds iqf{dl + DL_IQ + (32 * qh + r32) * 528 + hi * 16};
    float wq[4];
    { const u32x2 w = *(const u32x2*)(proj + (tokq0 + 32 * qh + r32) * PW + C_IW);
      wq[0] = bflo(w.x) * 0.0625f; wq[1] = bfhi(w.x) * 0.0625f; wq[2] = bflo(w.y) * 0.0625f; wq[3] = bfhi(w.y) * 0.0625f; }
#ifndef REP_SEL
#define REP_SEL 1
#endif
#ifndef REP_B2
#define REP_B2 1
#endif
    LAS unsigned* selall = (LAS unsigned*)(dl + DL_HIST);
#ifndef PROBE_NOATOM
#define PROBE_NOATOM 0
#endif
    unsigned dummy = 0u;
    for (int rep_sel = 0; rep_sel < REP_SEL; ++rep_sel) {
    if (tid < 64) { prefix[tid] = 0u; krem[tid] = (n > TOPK_DSA) ? (unsigned)TOPK_DSA : 0x7fffffffu; }
    __syncthreads();
    const int pass0 = (n > TOPK_DSA) ? 0 : 3;
    GAS u32x4* kmine = (GAS u32x4*)kscr + ((size_t)wid * 64 + lane) * 4;
#define DSA_CONSUME(uk_) do { \
        if (sel) { _Pragma("unroll") for (int r = 0; r < 16; ++r) { const bool match = (pass == 0) || (((uk_)[r] >> (shift + 8)) == pfx); \
                if (match && !(PROBE_NOATOM && rep_sel + 1 < REP_SEL)) __hip_atomic_fetch_add(hist + (32 * qh + r32) * 257 + (((uk_)[r] >> shift) & 255u), 1u, __ATOMIC_RELAXED, __HIP_MEMORY_SCOPE_WORKGROUP); else dummy ^= (uk_)[r]; } } \
        else { _Pragma("unroll") for (int r = 0; r < 16; ++r) { const unsigned k24 = (uk_)[r] >> 8; gtw |= (k24 > pfx ? 1u : 0u) << crow(r, hi); eqw |= (k24 == pfx ? 1u : 0u) << crow(r, hi); } } } while (0)
#define DSA_TIES() do { if (!sel) { \
        LAS unsigned* mk = mask + (step & 1) * 768; \
        { const auto rg = __builtin_amdgcn_permlane32_swap(gtw, gtw, false, false); gtw = rg[0] | rg[1]; const auto re = __builtin_amdgcn_permlane32_swap(eqw, eqw, false, false); eqw = re[0] | re[1]; } \
        if (hi == 0) { mk[(32 * qh + r32) * 4 + kb] = gtw; mk[256 + (32 * qh + r32) * 4 + kb] = eqw; } \
        __syncthreads(); \
        if (wid == 0) { unsigned nd = krem[lane]; \
            _Pragma("unroll") for (int k4 = 0; k4 < 4; ++k4) { const unsigned g = mk[lane * 4 + k4]; unsigned e = mk[256 + lane * 4 + k4]; unsigned sl = g; \
                if (e != 0u) { const unsigned cnt = (unsigned)__builtin_popcount(e); \
                    if (cnt <= nd) { sl |= e; nd -= cnt; } \
                    else { unsigned chosen = 0u; while (nd > 0u) { const unsigned lb = e & (0u - e); chosen |= lb; e ^= lb; --nd; } sl |= chosen; } } \
                selall[lane * 64 + step * 4 + k4] = sl; } \
            krem[lane] = nd; } } } while (0)
    for (int pass = pass0; pass < ((rep_sel + 1 < REP_SEL) ? 3 : 4); ++pass) {
        const bool sel = pass < 3;
        if (sel) { for (int i = tid; i < 64 * 257; i += 512) hist[i] = 0u; __syncthreads(); }
        const int shift = 24 - 8 * pass;
        const unsigned pfx = prefix[32 * qh + r32];
        if (pass == pass0) {
            bf16x8 kfn[4]; load_ik(proj, tokb, 32 * kb, r32, hi, kfn);
            for (int step = 0; step < nsteps; ++step) {
                const int kbase = 128 * step + 32 * kb;
                bf16x8 kf[4];
#pragma unroll
                for (int kk = 0; kk < 4; ++kk) kf[kk] = kfn[kk];
                if (step + 1 < nsteps) load_ik(proj, tokb, kbase + 128, r32, hi, kfn);
                unsigned gtw = 0u, eqw = 0u;
                if (kbase < n) {
                    unsigned uk[16];
                    idx_scores(iqf, kf, wq, uk);
                    if (pass0 == 0) {
#pragma unroll
                        for (int g = 0; g < 4; ++g) kmine[(size_t)step * 2048 + g] = (u32x4){uk[4 * g], uk[4 * g + 1], uk[4 * g + 2], uk[4 * g + 3]};
                    }
                    DSA_CONSUME(uk);
                }
                DSA_TIES();
            }
        } else {
            u32x4 ka[4], kb4[4];
#define DSA_KLOAD(dst, st_) do { _Pragma("unroll") for (int g = 0; g < 4; ++g) dst[g] = kmine[(size_t)(st_) * 2048 + g]; } while (0)
            DSA_KLOAD(ka, 0);
            if (nsteps > 1 && 128 + 32 * kb < n) DSA_KLOAD(kb4, 1);
            for (int step = 0; step < nsteps; ++step) {
                const int kbase = 128 * step + 32 * kb;
                unsigned uk[16];
#pragma unroll
                for (int g = 0; g < 4; ++g) { uk[4 * g] = ka[g].x; uk[4 * g + 1] = ka[g].y; uk[4 * g + 2] = ka[g].z; uk[4 * g + 3] = ka[g].w; }
#pragma unroll
                for (int g = 0; g < 4; ++g) ka[g] = kb4[g];
                if (step + 2 < nsteps && kbase + 256 < n) DSA_KLOAD(kb4, step + 2);
                unsigned gtw = 0u, eqw = 0u;
                if (kbase < n) DSA_CONSUME(uk);
                DSA_TIES();
            }
#undef DSA_KLOAD
        }
        if (sel) {
            __syncthreads();
#pragma unroll
            for (int qi = 0; qi < 8; ++qi) {
                const int q = 8 * wid + qi;
                const LAS unsigned* hq = hist + q * 257;
                const unsigned c0 = hq[255 - 4 * lane], c1 = hq[254 - 4 * lane], c2 = hq[253 - 4 * lane], c3 = hq[252 - 4 * lane];
                const unsigned s4 = c0 + c1 + c2 + c3;
                unsigned incl = s4;
#pragma unroll
                for (int o = 1; o < 64; o <<= 1) { const unsigned t = __shfl_up(incl, o); if (lane >= o) incl += t; }
                const unsigned excl = incl - s4, kr = krem[q];
                if (excl < kr && kr <= incl) {
                    unsigned cum = excl, bin, nk;
                    if (cum + c0 >= kr) { bin = 255 - 4 * lane; nk = kr - cum; }
                    else { cum += c0; if (cum + c1 >= kr) { bin = 254 - 4 * lane; nk = kr - cum; }
                    else { cum += c1; if (cum + c2 >= kr) { bin = 253 - 4 * lane; nk = kr - cum; }
                    else { cum += c2; bin = 252 - 4 * lane; nk = kr - cum; } } }
                    prefix[q] = (prefix[q] << 8) | bin; krem[q] = nk;
                }
            }
            __syncthreads();
        }
    }
    }
    if (dummy == 0x9e3779b9u) hist[tid] = 1u;
    const int hd = wid;
    u32x4 pk[2], pv[2];
#define DSA_LOADKV(step_) do { _Pragma("unroll") for (int i_ = 0; i_ < 2; ++i_) { const int ch_ = tid + 512 * i_; int krow_ = 128 * (step_) + (ch_ >> 3); if (krow_ > SEQ - 1) krow_ = SEQ - 1; \
        const GAS bf16_t* rp_ = (const GAS bf16_t*)proj + (tokb + krow_) * PW + (ch_ & 7) * 8; pk[i_] = *(const GAS u32x4*)(rp_ + C_DK); pv[i_] = *(const GAS u32x4*)(rp_ + C_DV); } } while (0)
#define DSA_STOREKV(buf_) do { _Pragma("unroll") for (int i_ = 0; i_ < 2; ++i_) { const int ch_ = tid + 512 * i_, key_ = ch_ >> 3, c8_ = ch_ & 7, kk_ = key_ & 31; \
        *(LAS u32x4*)(dl + DL_KT + (buf_) * 18432 + key_ * 144 + c8_ * 16) = pk[i_]; \
        *(LAS u32x4*)(dl + DL_VT + (buf_) * 16384 + (key_ >> 5) * 4096 + ((c8_ >> 2) * 2 + (kk_ >> 4)) * 1024 + (kk_ & 15) * 64 + (c8_ & 3) * 16) = pv[i_]; } } while (0)
    for (int rep_b2 = 0; rep_b2 < REP_B2; ++rep_b2)
    for (int qb = 0; qb < 2; ++qb) {
        bf16x8 qr[4];
        { const GAS bf16_t* qp = (const GAS bf16_t*)proj + (tokq0 + 32 * qb + r32) * PW + C_DQ + hd * 64 + 8 * hi;
#pragma unroll
          for (int kk = 0; kk < 4; ++kk) qr[kk] = *(const GAS bf16x8*)(qp + kk * 16); }
        f32x16 o0 = {}, o1 = {}; float mrun = -1e30f, lrun = 0.f;
        DSA_LOADKV(0);
        DSA_STOREKV(0);
        __syncthreads();
#define B2_QK(S_, k4_) do { const LAS unsigned char* krd_ = kt + (32 * (k4_) + r32) * 144 + hi * 16; S_ = (f32x16){}; \
        _Pragma("unroll") for (int kk = 0; kk < 4; ++kk) { const bf16x8 kf_ = *(const LAS bf16x8*)(krd_ + kk * 32); S_ = MFMA32(kf_, qr[kk], S_); } } while (0)
#define B2_SM_PV(S_, k4_) do { \
        const int selw_ = (int)selall[(32 * qb + r32) * 64 + step * 4 + (k4_)]; float mx_ = -INFINITY; \
        _Pragma("unroll") for (int r = 0; r < 16; ++r) { const unsigned m_ = (unsigned)__builtin_amdgcn_sbfe(selw_, crow(r, hi), 1); \
            S_[r] = __uint_as_float((__float_as_uint(S_[r]) & m_) | (0xFF800000u & ~m_)); mx_ = fmaxf(mx_, S_[r]); } \
        { const auto rr_ = __builtin_amdgcn_permlane32_swap(__float_as_uint(mx_), __float_as_uint(mx_), false, false); mx_ = fmaxf(__uint_as_float(rr_[0]), __uint_as_float(rr_[1])); } \
        if (__any(mx_ > mrun + 8.0f)) { const float mn_ = fmaxf(mrun, mx_), alpha_ = __builtin_amdgcn_exp2f(mrun - mn_); lrun *= alpha_; mrun = mn_; \
            _Pragma("unroll") for (int r = 0; r < 16; ++r) { o0[r] *= alpha_; o1[r] *= alpha_; } } \
        float pr_[16], rs_ = 0.f; \
        _Pragma("unroll") for (int r = 0; r < 16; ++r) { pr_[r] = __builtin_amdgcn_exp2f(S_[r] - mrun); rs_ += pr_[r]; } \
        lrun += rs_; \
        const bf16x8 pa_ = pack8(pr_), pb_ = pack8(pr_ + 8); \
        const lds_cptr vrd_ = (lds_cptr)vt + (k4_) * 4096 + vtr_lane_off(lane); \
        const bf16x8 v00_ = vfrag(vrd_, 0), v01_ = vfrag(vrd_, 1024), v10_ = vfrag(vrd_, 2048), v11_ = vfrag(vrd_, 3072); \
        o0 = MFMA32(v00_, pa_, o0); o0 = MFMA32(v01_, pb_, o0); o1 = MFMA32(v10_, pa_, o1); o1 = MFMA32(v11_, pb_, o1); } while (0)
        for (int step = 0; step < nsteps; ++step) {
            const int buf = step & 1;
            if (step + 1 < nsteps) DSA_LOADKV(step + 1);
            LAS unsigned char* kt = dl + DL_KT + buf * 18432;
            LAS unsigned char* vt = dl + DL_VT + buf * 16384;
            f32x16 sa, sb;
            B2_QK(sa, 0);
            B2_QK(sb, 1); B2_SM_PV(sa, 0); __builtin_amdgcn_sched_barrier(0);
            if (128 * step + 64 < n) {
                B2_QK(sa, 2); B2_SM_PV(sb, 1); __builtin_amdgcn_sched_barrier(0);
                B2_QK(sb, 3); B2_SM_PV(sa, 2); __builtin_amdgcn_sched_barrier(0);
                B2_SM_PV(sb, 3);
            } else {
                B2_SM_PV(sb, 1);
            }
            if (step + 1 < nsteps) DSA_STOREKV(buf ^ 1);
            __syncthreads();
        }
#undef B2_QK
#undef B2_SM_PV
        float l = lrun; { const auto rr = __builtin_amdgcn_permlane32_swap(__float_as_uint(l), __float_as_uint(l), false, false); l = __uint_as_float(rr[0]) + __uint_as_float(rr[1]); }
        const float il = 1.0f / l;
        bf16_t* op = odsa + (tokq0 + 32 * qb + r32) * 512 + hd * 64 + 4 * hi;
#pragma unroll
        for (int g = 0; g < 4; ++g) {
            u32x2 w0, w1; w0.x = cvt_pk_bf16(o0[4 * g] * il, o0[4 * g + 1] * il); w0.y = cvt_pk_bf16(o0[4 * g + 2] * il, o0[4 * g + 3] * il);
            w1.x = cvt_pk_bf16(o1[4 * g] * il, o1[4 * g + 1] * il); w1.y = cvt_pk_bf16(o1[4 * g + 2] * il, o1[4 * g + 3] * il);
            *(u32x2*)(op + 8 * g) = w0; *(u32x2*)(op + 32 + 8 * g) = w1; }
    }
#undef DSA_LOADKV
#undef DSA_STOREKV
#undef DSA_CONSUME
#undef DSA_TIES
    __syncthreads();
}

template <int CTRL> __device__ __forceinline__ float dpp_f(float v) { return __builtin_bit_cast(float, __builtin_amdgcn_update_dpp(0, __builtin_bit_cast(int, v), CTRL, 0xF, 0xF, false)); }
constexpr int RL_WROW = 2064, RL_WHI = 0, RL_WLO = 32 * RL_WROW, RL_TKE = 2 * 32 * RL_WROW, RL_TKW = RL_TKE + 4096;
__device__ __forceinline__ void p9_router(Frame& F) {
    const int lane = F.lane, wave = F.wave, tid = F.tid, r32 = lane & 31, hi = lane >> 5;
    LAS int* tke = (LAS int*)(F.lds + RL_TKE); LAS float* tkw = (LAS float*)(F.lds + RL_TKW);
    const float* w_router = F.in[15]; const float* b_router = F.in[16]; const float* g_ffn = F.in[14];
    for (int idx = tid; idx < DM * NEXP; idx += NWAVES * 64) { const int k = idx >> 5, e = idx & 31; const float w = w_router[idx];
        const unsigned wh = f2bf(w); const unsigned wl = f2bf(w - __builtin_bit_cast(float, wh << 16));
        *(LAS bf16_t*)(F.lds + RL_WHI + e * RL_WROW + k * 2) = (bf16_t)wh; *(LAS bf16_t*)(F.lds + RL_WLO + e * RL_WROW + k * 2) = (bf16_t)wl; }
    if (tid < 32) F.MISC[MW_LCNT + tid] = 0u;
    __syncthreads();
    bf16_t* h2 = (bf16_t*)(F.ws + WS_H); unsigned char* h2f8 = F.ws + WS_H2F8;
    const GAS f32x4* gr = (const GAS f32x4*)g_ffn + lane;
    f32x4 gg[4];
#pragma unroll
    for (int j = 0; j < 4; ++j) gg[j] = gr[64 * j];
    const size_t tok0 = (size_t)F.blk * 256 + 32 * wave;
    f32x4 xnext[2][4];
#pragma unroll
    for (int tk = 0; tk < 2; ++tk) { const GAS f32x4* xr = (const GAS f32x4*)(F.out + (tok0 + tk) * DM) + lane;
#pragma unroll
        for (int j = 0; j < 4; ++j) xnext[tk][j] = xr[64 * j]; }
    for (int it = 0; it < 16; ++it) {
        f32x4 hn[2][4];
#pragma unroll
        for (int tk = 0; tk < 2; ++tk)
#pragma unroll
            for (int j = 0; j < 4; ++j) hn[tk][j] = xnext[tk][j];
        if (it + 1 < 16) {
#pragma unroll
            for (int tk = 0; tk < 2; ++tk) { const GAS f32x4* xr = (const GAS f32x4*)(F.out + (tok0 + 2 * it + 2 + tk) * DM) + lane;
#pragma unroll
                for (int j = 0; j < 4; ++j) xnext[tk][j] = xr[64 * j]; } }
        float s[2];
#pragma unroll
        for (int tk = 0; tk < 2; ++tk) { float a = 0.f;
#pragma unroll
            for (int j = 0; j < 4; ++j) a += (hn[tk][j].x * hn[tk][j].x + hn[tk][j].y * hn[tk][j].y) + (hn[tk][j].z * hn[tk][j].z + hn[tk][j].w * hn[tk][j].w);
            s[tk] = a; }
#pragma unroll
        for (int tk = 0; tk < 2; ++tk) { float a = s[tk];
            a += dpp_f<0xB1>(a); a += dpp_f<0x4E>(a); a += dpp_f<0x141>(a); a += dpp_f<0x128>(a);
            { const auto rr = __builtin_amdgcn_permlane16_swap(__float_as_uint(a), __float_as_uint(a), false, false); a = __uint_as_float(rr[0]) + __uint_as_float(rr[1]); }
            { const auto rr = __builtin_amdgcn_permlane32_swap(__float_as_uint(a), __float_as_uint(a), false, false); a = __uint_as_float(rr[0]) + __uint_as_float(rr[1]); }
            s[tk] = a; }
#pragma unroll
        for (int tk = 0; tk < 2; ++tk) {
            const float rstd = 1.0f / sqrtf(s[tk] * (1.f / DM) + EPS);
            GAS u32x2* o8 = (GAS u32x2*)(h2 + (tok0 + 2 * it + tk) * DM) + lane;
#pragma unroll
            for (int j = 0; j < 4; ++j) { const f32x4 v = hn[tk][j] * rstd * gg[j]; u32x2 o; o.x = pk2(v.x, v.y); o.y = pk2(v.z, v.w); o8[64 * j] = o;
                *((GAS unsigned*)(h2f8 + (tok0 + 2 * it + tk) * DM) + lane + 64 * j) = pk4_f8(v.x, v.y, v.z, v.w); }
        }
    }
    asm volatile("s_waitcnt vmcnt(0)" ::: "memory");
    f32x16 acc = {};
    { const GAS bf16_t* hp = (const GAS bf16_t*)h2 + (tok0 + r32) * DM + 8 * hi;
      const LAS unsigned char* wp = F.lds + RL_WHI + r32 * RL_WROW + 16 * hi;
#pragma unroll 8
      for (int kk = 0; kk < 64; ++kk) { const bf16x8 hb = *(const GAS bf16x8*)(hp + 16 * kk);
          const bf16x8 wh = *(const LAS bf16x8*)(wp + 32 * kk), wl = *(const LAS bf16x8*)(wp + RL_WLO + 32 * kk);
          acc = MFMA32(wh, hb, acc); acc = MFMA32(wl, hb, acc); } }
    float lg[16];
#pragma unroll
    for (int r = 0; r < 16; ++r) lg[r] = acc[r] + b_router[crow(r, hi)];
    float lv[4]; int li[4];
#pragma unroll
    for (int k = 0; k < 4; ++k) { float bv = lg[0]; int br = 0;
#pragma unroll
        for (int r = 1; r < 16; ++r) { const bool g = lg[r] > bv; bv = g ? lg[r] : bv; br = g ? r : br; }
        lv[k] = bv; li[k] = crow(br, hi);
#pragma unroll
        for (int r = 0; r < 16; ++r) lg[r] = (r == br) ? -INFINITY : lg[r]; }
    float ov[4]; int oi[4];
#pragma unroll
    for (int k = 0; k < 4; ++k) { const auto rv = __builtin_amdgcn_permlane32_swap(__float_as_uint(lv[k]), __float_as_uint(lv[k]), false, false); const auto ri = __builtin_amdgcn_permlane32_swap((unsigned)li[k], (unsigned)li[k], false, false);
        ov[k] = hi ? __uint_as_float(rv[0]) : __uint_as_float(rv[1]); oi[k] = hi ? (int)ri[0] : (int)ri[1]; }
    float tv[4]; int te[4];
    { float a0 = lv[0], a1 = lv[1], a2 = lv[2], a3 = lv[3], b0 = ov[0], b1 = ov[1], b2 = ov[2], b3 = ov[3];
      int i0 = li[0], i1 = li[1], i2 = li[2], i3 = li[3], j0 = oi[0], j1 = oi[1], j2 = oi[2], j3 = oi[3];
#pragma unroll
      for (int k = 0; k < 4; ++k) { const bool ta = (a0 > b0) || (a0 == b0 && i0 < j0);
          tv[k] = ta ? a0 : b0; te[k] = ta ? i0 : j0;
          if (ta) { a0 = a1; a1 = a2; a2 = a3; a3 = -INFINITY; i0 = i1; i1 = i2; i2 = i3; i3 = 64; }
          else { b0 = b1; b1 = b2; b2 = b3; b3 = -INFINITY; j0 = j1; j1 = j2; j2 = j3; j3 = 64; } } }
    const float e1 = __expf(tv[1] - tv[0]), e2x = __expf(tv[2] - tv[0]), e3 = __expf(tv[3] - tv[0]);
    const float inv = 1.0f / (1.0f + e1 + e2x + e3);
    if (hi == 0) { const int tl = 32 * wave + r32;
        *(LAS int*)(tke + tl * 4 + 0) = te[0]; tke[tl * 4 + 1] = te[1]; tke[tl * 4 + 2] = te[2]; tke[tl * 4 + 3] = te[3];
        tkw[tl * 4 + 0] = inv; tkw[tl * 4 + 1] = e1 * inv; tkw[tl * 4 + 2] = e2x * inv; tkw[tl * 4 + 3] = e3 * inv;
#pragma unroll
        for (int k = 0; k < 4; ++k) __hip_atomic_fetch_add((LAS unsigned*)F.MISC + MW_LCNT + te[k], 1u, __ATOMIC_RELAXED, __HIP_MEMORY_SCOPE_WORKGROUP); }
    __syncthreads();
    if (tid < 32) ((int*)(F.ws + WS_BLKCNT))[F.blk * 32 + tid] = (int)F.MISC[MW_LCNT + tid];
}
__device__ __forceinline__ void p10_assign(Frame& F) {
    const int tid = F.tid;
    const int* blkcnt = (const int*)(F.ws + WS_BLKCNT);
    LAS int* part = (LAS int*)(F.lds);
    LAS int* tke = (LAS int*)(F.lds + RL_TKE); LAS float* tkw = (LAS float*)(F.lds + RL_TKW);
    { const int e = tid & 31, p = tid >> 5; int tot = 0, bef = 0;
      for (int j = 0; j < 16; ++j) { const int bl = p * 16 + j; const int c = blkcnt[bl * 32 + e]; tot += c; bef += (bl < F.blk) ? c : 0; }
      part[p * 32 + e] = tot; part[512 + p * 32 + e] = bef; }
    __syncthreads();
    if (tid < 32) { int tot = 0, bef = 0;
        for (int p = 0; p < 16; ++p) { tot += part[p * 32 + tid]; bef += part[512 + p * 32 + tid]; }
        part[1024 + tid] = tot; F.MISC[MW_BEFORE + tid] = (unsigned)bef; F.MISC[MW_LCNT + tid] = 0u; }
    __syncthreads();
    if (tid == 0) { int ps = 0;
        for (int e = 0; e < 32; ++e) { F.MISC[MW_PSTART + e] = (unsigned)ps; F.MISC[MW_TSTART + e] = (unsigned)(ps >> 8); ps += (part[1024 + e] + 255) & ~255; }
        F.MISC[MW_PSTART + 32] = (unsigned)ps; F.MISC[MW_TSTART + 32] = (unsigned)(ps >> 8); }
    __syncthreads();
    int* slot_tok = (int*)(F.ws + WS_SLOT_TOK); float* slot_w = (float*)(F.ws + WS_SLOT_W);
    for (int idx = tid; idx < 1024; idx += NWAVES * 64) {
        const int e = tke[idx]; const float w = tkw[idx];
        const unsigned r = __hip_atomic_fetch_add((LAS unsigned*)F.MISC + MW_LCNT + e, 1u, __ATOMIC_RELAXED, __HIP_MEMORY_SCOPE_WORKGROUP);
        const unsigned pos = F.MISC[MW_PSTART + e] + F.MISC[MW_BEFORE + e] + r;
        slot_tok[pos] = F.blk * 256 + (idx >> 2); slot_w[pos] = w;
    }
}

#ifndef MK_ONE_LAUNCH
#define MK_ONE_LAUNCH 1
#endif
constexpr int N_PHASES = 13;
struct Args { const float* in[21]; float* out; unsigned char* ws; int ph_lo, ph_hi; };
static_assert(sizeof(Args) == 21 * 8 + 8 + 8 + 8, "no padding");

__global__ void __launch_bounds__(NWAVES * 64, 2) fwd_kernel(Args args) {
    extern __shared__ __attribute__((aligned(16))) unsigned char lds[];
    Frame F;
    F.lds = (LAS unsigned char*)lds;
    F.MISC = (volatile LAS unsigned*)(F.lds + MISC_OFF);
    F.tid = threadIdx.x; F.lane = F.tid & 63; F.wave = __builtin_amdgcn_readfirstlane(F.tid >> 6);
#define FRESH() do { F.lane = lane_id_fresh(); F.tid = F.wave * 64 + F.lane; } while (0)
    F.G = gridDim.x; F.blk = blockIdx.x;
    F.ws = args.ws; F.out = args.out; F.ctl = (gu32*)(args.ws + WS_CTL);
#pragma unroll
    for (int i = 0; i < 21; ++i) F.in[i] = args.in[i];
    for (int u = F.tid; u < (LDS_BYTES - MISC_OFF) / 4; u += NWAVES * 64) ((LAS unsigned*)(F.lds + MISC_OFF))[u] = 0u;
    __syncthreads();
    const int lo = args.ph_lo, hi = args.ph_hi;
    XcdBarrier bar; bar.bar = (unsigned*)(F.ctl + CW_BAR); bar.x = 0; bar.st = nullptr; bar.wave = F.wave;
    if (hi - lo > 1) bar = xcd_barrier_post((unsigned*)(F.ctl + CW_BAR), F.MISC + MW_BAR);
#ifndef STAG
#define STAG 0
#endif
#ifndef PH_MASK
#define PH_MASK 0x1fff
#endif
#define IN(k) (((PH_MASK >> (k)) & 1) && lo <= (k) && (k) < hi)
#ifndef REP_MASK
#define REP_MASK 0
#endif
#define NREP(k) (1 + ((REP_MASK >> (k)) & 1))
#define SEAM(k) do { if (IN(k) && IN((k) + 1)) xcd_barrier(bar); } while (0)
    unsigned char* ws = args.ws;
    bf16_t* proj = (bf16_t*)(ws + WS_P);

    if (IN(0)) for (int rep = 0; rep < NREP(0); ++rep) { if (rep) xcd_barrier(bar); FRESH(); p0_prologue(F); } SEAM(0);

    if (IN(1)) {
#ifdef PROBE_P1
        { pg8::DenseSched S; S.init(ws + WS_H, ws + WS_WIN, NTOK, PW, DM, F.G, F.blk); S.amask = PROBE_P1;
          pg8::EpiBf16<0> E{(bf16_t*)(ws + WS_END), PW, nullptr, 1023};
          pg8::gemm_phase<pg8::EpiBf16<0>, pg8::DenseSched, true>(F.lds, F.wave, DM, S, E); }
        xcd_barrier(bar);
#endif
        { pg8::DenseSched S; S.init(ws + WS_H, ws + WS_WIN, NTOK, PW, DM, F.G, F.blk);
          pg8::EpiBf16<0> E{proj, PW, nullptr};
          pg8::gemm_phase<pg8::EpiBf16<0>, pg8::DenseSched, true>(F.lds, F.wave, DM, S, E); }
        { pg8::DenseSched S; S.init(ws + WS_MEMN, ws + WS_WMKV, NMEM, DM, DM, F.G, F.blk);
          pg8::EpiBf16<0> E{(bf16_t*)(ws + WS_MKV), DM, nullptr};
          pg8::gemm_phase<pg8::EpiBf16<0>, pg8::DenseSched, true>(F.lds, F.wave, DM, S, E); }
    } SEAM(1);

    if (IN(2)) { FRESH(); if (REP_MASK & 4) { p2_prep(F, true); xcd_barrier(bar); } p2_prep(F); } SEAM(2);

    if (IN(3)) {
        FRESH();
        bf16_t* osb = (bf16_t*)(ws + WS_O); bf16_t* odsa = osb + (size_t)NTOK * 512; bf16_t* omem = odsa + (size_t)NTOK * 512;
#ifndef REP_DSA
#define REP_DSA 1
#endif
#ifndef REP_SB
#define REP_SB 1
#endif
#ifndef REP_MEM
#define REP_MEM 1
#endif
#ifndef NO_DSA
        for (int rep = 0; rep < REP_DSA; ++rep)
        for (int i = 0; i < 4; ++i) { const int p = 2 * F.blk + (i >> 1), b = p >> 4, cc = p & 15, c = (i & 1) ? 31 - cc : cc; dsa_unit(proj, odsa, (unsigned*)F.out + (size_t)F.blk * 131072, b, c, F.lds, F.tid); }
#endif
        const int gw = F.blk * NWAVES + F.wave, NGW = F.G * NWAVES;
#ifndef NO_SB
        for (int rep = 0; rep < REP_SB; ++rep)
        for (int it = gw; it < NB * 8 * 64; it += NGW) { const int qblk = 63 - (it >> 8), bh = it & 255; sb_item(proj, osb, bh >> 3, bh & 7, qblk, F.lds + F.wave * 4096, F.lane); }
#endif
#ifndef NO_MEM
        for (int rep = 0; rep < REP_MEM; ++rep) {
            __syncthreads();
            for (int u = F.blk; u < NB * 4 * 2; u += F.G) mem_unit(proj, (const bf16_t*)(ws + WS_MKV), omem, u >> 3, (u >> 1) & 3, u & 1, F.lds, F.tid);
        }
#endif
    } SEAM(3);

    if (IN(4)) {
        pg8::DenseSched S; S.init(ws + WS_H8, ws + WS_WG, NTOK, 3 * DM, DM / 2, F.G, F.blk);
        pg8::EpiBf16<2> E{proj, PW, F.in[11]};
        pg8::gemm_phase<pg8::EpiBf16<2>, pg8::DenseSched, true, true>(F.lds, F.wave, DM / 2, S, E);
    } SEAM(4);

    if (IN(5)) { pg8::MergeSched S; S.init(ws + WS_O, ws + WS_WB, NTOK, DM, F.G, F.blk);
        pg8::EpiMerge E{proj, (bf16_t*)(ws + WS_H)};
        pg8::gemm_phase<pg8::EpiMerge, pg8::MergeSched, true>(F.lds, F.wave, 512, S, E); } SEAM(5);


    if (IN(8)) {
        pg8::DenseSched S; S.init(ws + WS_H, ws + WS_WO, NTOK, DM, DM, F.G, F.blk); S.stag = STAG;
        pg8::EpiResid E{F.in[0], F.out};
        pg8::gemm_phase<pg8::EpiResid, pg8::DenseSched, true>(F.lds, F.wave, DM, S, E);
    } SEAM(8);

    if (IN(9)) for (int rep = 0; rep < NREP(9); ++rep) { if (rep) xcd_barrier(bar); FRESH(); p9_router(F); } SEAM(9);
    if (IN(10)) for (int rep = 0; rep < NREP(10); ++rep) { if (rep) xcd_barrier(bar); FRESH(); p10_assign(F); } SEAM(10);

    if (IN(11)) for (int rep = 0; rep < NREP(11); ++rep) {  if (rep) xcd_barrier(bar);
        pg8::MoeSched S{(const char*)(ws + WS_H2F8), (const char*)(ws + WS_WEI), (const int*)(ws + WS_SLOT_TOK), F.MISC + MW_TSTART, DM / 2, 2048, 8, F.blk};
        pg8::EpiSwiglu E{(bf16_t*)(ws + WS_P), F.in[18], F.lds};
        pg8::gemm_phase<pg8::EpiSwiglu, pg8::MoeSched, true, true>(F.lds, F.wave, DM / 2, S, E);
    } SEAM(11);

    if (IN(12)) {
        pg8::MoeSched S{(const char*)(ws + WS_P), (const char*)(ws + WS_WEO), nullptr, F.MISC + MW_TSTART, DM, DM, 4, F.blk};
        pg8::EpiScatter E{F.out, (const int*)(ws + WS_SLOT_TOK), (const float*)(ws + WS_SLOT_W), F.in[20], F.lds};
        pg8::gemm_phase<pg8::EpiScatter, pg8::MoeSched, true>(F.lds, F.wave, DM, S, E);
    }
#undef IN
#undef SEAM
}

extern "C" void kernel_launch(void* const* d_in, const int* in_sizes, int n_in, void* d_out, int out_size, void* d_ws, size_t ws_size, hipStream_t stream) {
    static int grid = 0;
    if (grid == 0) {
        if (n_in != 21 || in_sizes[0] != NTOK * DM || out_size != NTOK * DM || ws_size < WS_END) {
            fprintf(stderr, "kernel_launch: unexpected shapes: n_in %d in0 %d out %d ws %zu (need >= %zu); nothing launched\n", n_in, n_in > 0 ? in_sizes[0] : -1, out_size, ws_size, (size_t)WS_END); grid = -1; return; }
        int dev = 0, cus = 0, per_cu = 0;
        if (hipGetDevice(&dev) != hipSuccess || hipDeviceGetAttribute(&cus, hipDeviceAttributeMultiprocessorCount, dev) != hipSuccess) { fprintf(stderr, "kernel_launch: device query failed\n"); grid = -1; return; }
        if (hipFuncSetAttribute((const void*)fwd_kernel, hipFuncAttributeMaxDynamicSharedMemorySize, LDS_BYTES) != hipSuccess) { fprintf(stderr, "kernel_launch: hipFuncSetAttribute failed\n"); grid = -1; return; }
        if (hipOccupancyMaxActiveBlocksPerMultiprocessor(&per_cu, (const void*)fwd_kernel, NWAVES * 64, LDS_BYTES) != hipSuccess || per_cu < 1)
            fprintf(stderr, "kernel_launch: note: occupancy query reports %d workgroups per CU\n", per_cu);
        (void)hipGetLastError();
        grid = cus;
        if (grid != 256) { fprintf(stderr, "kernel_launch: this kernel is built for 256 CUs (got %d); nothing launched\n", grid); grid = -1; return; }
    }
    if (grid < 0) return;
    if (hipMemsetAsync((char*)d_ws + WS_CTL, 0, CTL_ZERO_BYTES, stream) != hipSuccess) { fprintf(stderr, "kernel_launch: hipMemsetAsync failed\n"); return; }
    Args a{};
    for (int i = 0; i < 21; ++i) a.in[i] = (const float*)d_in[i];
    a.out = (float*)d_out; a.ws = (unsigned char*)d_ws;
#if MK_ONE_LAUNCH
    const int cuts[2] = {0, N_PHASES}; const int nl = 1;
#else
    const int cuts[11] = {0, 1, 2, 3, 4, 5, 6, 7, 8, 9, N_PHASES}; const int nl = 10;
#endif
    for (int li = 0; li < nl; ++li) {
        a.ph_lo = cuts[li]; a.ph_hi = cuts[li + 1];
        hipLaunchKernelGGL(fwd_kernel, dim3(grid), dim3(NWAVES * 64), LDS_BYTES, stream, a);
        const hipError_t le = hipPeekAtLastError();
        if (le != hipSuccess) { fprintf(stderr, "kernel_launch: launch %d failed: %s\n", li, hipGetErrorName(le)); break; }
    }
}
```

```cpp
#include <hip/hip_runtime.h>
#include <cstdio>
#include <cstdint>

#define LAS __attribute__((address_space(3)))
#define GAS __attribute__((address_space(1)))
typedef unsigned short bf16_t;
typedef short bf16x8 __attribute__((ext_vector_type(8)));
typedef short s16x4 __attribute__((ext_vector_type(4)));
typedef short v4i16_t __attribute__((ext_vector_type(4)));
typedef float f32x2 __attribute__((ext_vector_type(2)));
typedef float f32x4 __attribute__((ext_vector_type(4)));
typedef float f32x16 __attribute__((ext_vector_type(16)));
typedef unsigned u32x2 __attribute__((ext_vector_type(2)));
typedef unsigned u32x4 __attribute__((ext_vector_type(4)));
typedef int i32x4 __attribute__((ext_vector_type(4)));
typedef int i32x8 __attribute__((ext_vector_type(8)));
typedef GAS unsigned gu32;

constexpr int NB = 32, SEQ = 2048, DM = 1024, NTOK = NB * SEQ;
constexpr int MEMLEN = 256, NMEM = NB * MEMLEN;
constexpr int PW = 3072;
constexpr int C_SQ = 0, C_SK = 512, C_SV = 1024, C_DQ = 1536, C_DK = 2048, C_DV = 2112, C_IQ = 2176, C_IK = 2432, C_IW = 2496, C_MQ = 2560;
constexpr int IN_W = 3012;
constexpr int NEXP = 32, TOPK = 4, DEXP = 1024;
constexpr int NSLOT = NTOK * TOPK;
constexpr int NSLOT_PAD = NSLOT + NEXP * 256;
constexpr float EPS = 1e-6f;
constexpr float LOG2E = 1.4426950408889634f;

constexpr size_t MiB = 1u << 20;
constexpr size_t WS_CTL = 0, CTL_ZERO_BYTES = 1 * MiB;
constexpr size_t WS_ROPE = 1 * MiB;
constexpr size_t WS_BLKCNT = 1 * MiB + 512 * 1024;
constexpr size_t WS_SLOT_TOK = 2 * MiB;
constexpr size_t WS_TOK_SLOT = 4 * MiB;
constexpr size_t WS_TOK_GATE = 5 * MiB;
constexpr size_t WS_WIN = 8 * MiB;
constexpr size_t WS_WMKV = 14 * MiB;
constexpr size_t WS_WG = 16 * MiB;
constexpr size_t WS_WB = 22 * MiB;
constexpr size_t WS_WO = 25 * MiB;
constexpr size_t WS_WEI = 27 * MiB;
constexpr size_t WS_WEO = 155 * MiB;
__device__ __forceinline__ int lane_id_fresh() { int l; asm volatile("v_mbcnt_lo_u32_b32 %0, -1, 0\n\tv_mbcnt_hi_u32_b32 %0, -1, %0" : "=v"(l)); return l; }
__device__ __forceinline__ unsigned pk4_f8(float a, float b, float c, float d) { int v = __builtin_amdgcn_cvt_pk_fp8_f32(a, b, 0, false); return (unsigned)__builtin_amdgcn_cvt_pk_fp8_f32(c, d, v, true); }
constexpr float W8_SCALE = 64.f, W8_INV = 1.f / 64.f;
constexpr size_t WS_H = 220 * MiB;
constexpr size_t WS_P = 348 * MiB;
constexpr size_t WS_O = 732 * MiB;
constexpr size_t WS_H8 = 91 * MiB;
constexpr size_t WS_H2F8 = 91 * MiB;
constexpr size_t WS_MEMN = 924 * MiB;
constexpr size_t WS_MKV = 940 * MiB;
constexpr size_t WS_Y = 220 * MiB;
constexpr size_t WS_ACT8 = 748 * MiB;
constexpr size_t WS_END = 1012 * MiB;
static_assert(WS_Y + (size_t)NSLOT_PAD * DM * 2 <= WS_ACT8 && WS_ACT8 + (size_t)NSLOT_PAD * DEXP <= WS_END, "y | act8");
static_assert(WS_SLOT_TOK + (size_t)NSLOT_PAD * 4 <= WS_TOK_SLOT && WS_TOK_GATE + (size_t)NTOK * 16 <= WS_WIN, "slot tables");

constexpr int CW_BAR = 4096;

constexpr int RING_BYTES = 151552;
constexpr int MISC_OFF = RING_BYTES;
constexpr int LDS_BYTES = 155648;
constexpr int MW_BAR = 8;
constexpr int MW_LCNT = 16;
constexpr int MW_PSTART = 64;
constexpr int MW_TSTART = 128;
constexpr int MW_BEFORE = 192;
constexpr int MW_PART = 256;

__device__ __forceinline__ unsigned f2bf(float f) { unsigned u = __builtin_bit_cast(unsigned, f); return (u + 0x7fffu + ((u >> 16) & 1u)) >> 16; }
__device__ __forceinline__ unsigned pk2(float lo, float hi) { return f2bf(lo) | (f2bf(hi) << 16); }
__device__ __forceinline__ float bf2f(unsigned short b) { return __builtin_bit_cast(float, (unsigned)b << 16); }
__device__ __forceinline__ float bflo(unsigned w) { return __builtin_bit_cast(float, w << 16); }
__device__ __forceinline__ float bfhi(unsigned w) { return __builtin_bit_cast(float, w & 0xffff0000u); }
__device__ __forceinline__ unsigned cvt_pk_bf16(float lo, float hi) { unsigned r; asm volatile("v_cvt_pk_bf16_f32 %0, %1, %2" : "=v"(r) : "v"(lo), "v"(hi)); return r; }
__device__ __forceinline__ int crow(int r, int hi) { return (r & 3) + 8 * (r >> 2) + 4 * hi; }
#define LDS_WAIT() asm volatile("s_waitcnt lgkmcnt(0)" ::: "memory")
#define VM_WAIT() asm volatile("s_waitcnt vmcnt(0)" ::: "memory")

namespace pg8 {
constexpr int BM = 256, BK = 64, HALF = 128, HTB = HALF * BK * 2, STAGE_BYTES = 8 * HTB, EPI_NA_OFF = STAGE_BYTES + 2048;
__host__ __device__ __forceinline__ int lds_byte(int r, int c) { const int st = (r >> 4) * 2 + (c >> 5), rr = r & 15, cc = c & 31, ob = rr * 64 + cc * 2; return st * 1024 + (ob ^ (((ob >> 9) & 1) << 5)); }
__host__ __device__ __forceinline__ void stage_rc(int b, int& R, int& C) { const int st = b / 1024, sb = b % 1024, swz = sb ^ (((sb >> 9) & 1) << 5); R = (st >> 1) * 16 + swz / 64; C = (st & 1) * 32 + (swz % 64) / 2; }
__host__ __device__ __forceinline__ int perm32(int rho) { const int n = rho >> 4, i = rho & 15; return 8 * (i >> 2) + 4 * n + (i & 3); }

struct Unit { int pm, pn, e; };

template <class Epi, class Sched, bool ALIGN_EPI, bool FP8 = false>
__device__ __forceinline__ void gemm_phase(LAS unsigned char* lds, const int wave_, const int K, const Sched& S, const Epi& E) {
    int tid = wave_ * 64 + lane_id_fresh();
    const int wid = __builtin_amdgcn_readfirstlane(tid >> 6), lane = tid & 63, wr = wid >> 2, wc = wid & 3, fr = lane & 15, fq = lane >> 4;
    const int nt = K / BK;
    int Rr[2], Cc[2]; unsigned voffB[2];
#pragma unroll
    for (int i = 0; i < 2; ++i) { int R, C; stage_rc(tid * 16 + i * 8192, R, C); Rr[i] = R; Cc[i] = C; const int Rb = Epi::PERM ? ((R & ~31) + perm32(R & 31)) : R; voffB[i] = (unsigned)(Rb * K + C) * 2u; }
    const size_t kstep = (size_t)(BK * 2);
    const size_t hstepB = (size_t)HALF * K * 2;
    const unsigned ldsw = (unsigned)wid * 1024u;
    const int aoff = lds_byte(wr * 64 + fr, fq * 8), boff = lds_byte(wc * 32 + fr, fq * 8);
#define PG8_SA(b, h) (((b) * 2 + (h)) * HTB)
#define PG8_SB(b, h) ((4 + (b) * 2 + (h)) * HTB)
#define PG8_STAGE(bufoff, gbase, voff) do { _Pragma("unroll") for (int _i = 0; _i < 2; ++_i) { unsigned o_ = (voff)[_i]; asm volatile("" : "+v"(o_)); \
        __builtin_amdgcn_global_load_lds((const unsigned*)((const char*)(gbase) + o_), (LAS unsigned*)(lds + (bufoff) + ldsw + _i * 8192), 16, 0, 0); } } while (0)
#define PG8_J8(x, y) __builtin_shufflevector(x, y, 0, 1, 2, 3, 4, 5, 6, 7)
#define PG8_LDA(dst, b, h) do { _Pragma("unroll") for (int m = 0; m < 4; ++m) { const LAS unsigned char* p_ = lds + PG8_SA(b, h) + aoff + m * 2048; \
        if constexpr (FP8) dst##8[m] = PG8_J8(*(const LAS i32x4*)p_, *(const LAS i32x4*)(p_ + 1024)); else { dst[m][0] = *(const LAS bf16x8*)p_; dst[m][1] = *(const LAS bf16x8*)(p_ + 1024); } } } while (0)
#define PG8_LDB(dst, b, h) do { _Pragma("unroll") for (int n = 0; n < 2; ++n) { const LAS unsigned char* p_ = lds + PG8_SB(b, h) + boff + n * 2048; \
        if constexpr (FP8) dst##8[n] = PG8_J8(*(const LAS i32x4*)p_, *(const LAS i32x4*)(p_ + 1024)); else { dst[n][0] = *(const LAS bf16x8*)p_; dst[n][1] = *(const LAS bf16x8*)(p_ + 1024); } } } while (0)
#define PG8_MMA(ai, bj, At, Bt) do { __builtin_amdgcn_s_setprio(1); _Pragma("unroll") for (int m = 0; m < 4; ++m) _Pragma("unroll") for (int n = 0; n < 2; ++n) { \
        if constexpr (FP8) acc[ai][bj][m][n] = __builtin_amdgcn_mfma_scale_f32_16x16x128_f8f6f4(Bt##8[n], At##8[m], acc[ai][bj][m][n], 0, 0, 0, 0, 0, 0); \
        else { _Pragma("unroll") for (int k = 0; k < 2; ++k) acc[ai][bj][m][n] = __builtin_amdgcn_mfma_f32_16x16x32_bf16(Bt[n][k], At[m][k], acc[ai][bj][m][n], 0, 0, 0); } } \
        __builtin_amdgcn_s_setprio(0); } while (0)
#define PG8_WAIT_V(n) asm volatile("s_waitcnt vmcnt(" #n ")" ::: "memory")
#define PG8_WAIT_L(n) asm volatile("s_waitcnt lgkmcnt(" #n ")" ::: "memory")
#define PG8_BAR __builtin_amdgcn_s_barrier()
#define PG8_SCHED __builtin_amdgcn_sched_barrier(0)
    Unit cur, nxt; int ui = 0;
    if (!S.next(0, cur)) return;
    { const int ns = S.stagger();
      for (int q = 0; q < ns; ++q) __builtin_amdgcn_s_sleep(4); }
    f32x4 acc[2][2][4][2];
    bf16x8 At[4][2], B0[2][2], B1[2][2]; i32x8 At8[4], B08[2], B18[2];
    const char* Ab = S.a_base();
    unsigned ca0[2], ca1[2], na0[2], na1[2];
#pragma unroll
    for (int i = 0; i < 2; ++i) { ca0[i] = S.a_off(cur, Rr[i], Cc[i]); ca1[i] = S.a_off(cur, HALF + Rr[i], Cc[i]); }
    const char* cB = S.b_tile(cur);
    PG8_STAGE(PG8_SB(0, 0), cB, voffB); PG8_STAGE(PG8_SB(0, 1), cB + hstepB, voffB); PG8_STAGE(PG8_SA(0, 0), Ab, ca0); PG8_STAGE(PG8_SA(0, 1), Ab, ca1);
    if (wr == 1) PG8_BAR;
    PG8_WAIT_V(2); PG8_BAR;
    PG8_STAGE(PG8_SB(1, 0), cB + kstep, voffB); PG8_STAGE(PG8_SA(1, 0), Ab + kstep, ca0); PG8_STAGE(PG8_SB(1, 1), cB + hstepB + kstep, voffB);
    PG8_WAIT_V(6); PG8_BAR;
    for (;;) {
        typename Epi::Pre pre = E.preload(cur, wr, wc, fr, fq);
        const bool has_next = S.next(ui + 1, nxt);
        const char* nB = cB;
#pragma unroll
        for (int i = 0; i < 2; ++i) { na0[i] = ca0[i]; na1[i] = ca1[i]; }
        if (has_next) { nB = S.b_tile(nxt);
#pragma unroll
            for (int i = 0; i < 2; ++i) { int R, C; int tq = tid; if constexpr (FP8) tq = wave_ * 64 + lane_id_fresh();
                stage_rc(tq * 16 + i * 8192, R, C);
                na0[i] = S.a_off(nxt, R, C); na1[i] = S.a_off(nxt, HALF + R, C); } }
        if constexpr (Epi::DRAIN_TOP) { PG8_WAIT_V(0); }
        if constexpr (Epi::STASH) E.stash(pre, wid, fr, fq);
#define PG8_NAST(v) const unsigned v = (unsigned)(EPI_NA_OFF + (wave_ * 64 + lane_id_fresh()) * 16)
        if constexpr (FP8) { PG8_NAST(nast); *(LAS u32x4*)(lds + nast) = (u32x4){na0[0], na0[1], na1[0], na1[1]}; }
#pragma unroll
        for (int a = 0; a < 2; ++a)
#pragma unroll
            for (int b = 0; b < 2; ++b)
#pragma unroll
                for (int m = 0; m < 4; ++m)
#pragma unroll
                    for (int n = 0; n < 2; ++n) acc[a][b][m][n] = (f32x4){0.f, 0.f, 0.f, 0.f};
#pragma unroll 1
        for (int t = 0; t < nt; t += 2) {
            const bool last = (t == nt - 2);
            const char* a1 = Ab + (size_t)(t + 1) * kstep;
            const char* a2 = last ? Ab : Ab + (size_t)(t + 2) * kstep; const char* b2 = last ? nB : cB + (size_t)(t + 2) * kstep;
            const char* a3 = a2 + kstep; const char* b3 = b2 + kstep;
            if constexpr (FP8) { asm volatile("" : "+s"(a1), "+s"(a2), "+s"(b2), "+s"(a3), "+s"(b3)); }
            unsigned o20[2], o21[2];
#pragma unroll
            for (int i = 0; i < 2; ++i) { o20[i] = last ? na0[i] : ca0[i]; o21[i] = last ? na1[i] : ca1[i]; }
            if constexpr (FP8) { if (last) { PG8_NAST(nast); const u32x4 nv = *(const LAS u32x4*)(lds + nast); o20[0] = nv.x; o20[1] = nv.y; o21[0] = nv.z; o21[1] = nv.w; } }
            PG8_LDB(B0, 0, 0); PG8_LDB(B1, 0, 1); PG8_SCHED; PG8_LDA(At, 0, 0); PG8_STAGE(PG8_SA(1, 1), a1, ca1);
            PG8_WAIT_V(8); PG8_WAIT_L(0); PG8_BAR; PG8_MMA(0, 0, At, B0); PG8_MMA(0, 1, At, B1); PG8_BAR; PG8_SCHED;
            PG8_LDA(At, 0, 1); PG8_STAGE(PG8_SB(0, 0), b2, voffB); PG8_STAGE(PG8_SB(0, 1), b2 + hstepB, voffB); PG8_STAGE(PG8_SA(0, 0), a2, o20);
            PG8_WAIT_V(8); PG8_WAIT_L(0); PG8_BAR; PG8_MMA(1, 0, At, B0); PG8_MMA(1, 1, At, B1); PG8_BAR; PG8_SCHED;
            PG8_LDB(B0, 1, 0); PG8_LDB(B1, 1, 1); PG8_SCHED; PG8_LDA(At, 1, 0); PG8_STAGE(PG8_SA(0, 1), a2, o21);
            PG8_WAIT_V(8); PG8_WAIT_L(0); PG8_BAR; PG8_MMA(0, 0, At, B0); PG8_MMA(0, 1, At, B1); PG8_BAR; PG8_SCHED;
            PG8_LDA(At, 1, 1); PG8_STAGE(PG8_SB(1, 0), b3, voffB); PG8_STAGE(PG8_SB(1, 1), b3 + hstepB, voffB); PG8_STAGE(PG8_SA(1, 0), a3, o20);
            PG8_WAIT_V(8); PG8_WAIT_L(0); PG8_BAR; PG8_MMA(1, 0, At, B0); PG8_MMA(1, 1, At, B1); PG8_BAR; PG8_SCHED;
        }
        if constexpr (ALIGN_EPI) { if (wr == 0) PG8_BAR; }
        if constexpr (FP8) { const int lq = lane_id_fresh();
            if constexpr (Epi::STASH) E(acc, cur, wr, wc, lq & 15, (lq >> 4) & 3, typename Epi::Pre{}); else E(acc, cur, wr, wc, lq & 15, (lq >> 4) & 3, pre); }
        else E(acc, cur, wr, wc, fr, fq, pre);
        if (!has_next) break;
        cur = nxt; cB = nB; ++ui;
#pragma unroll
        for (int i = 0; i < 2; ++i) { ca0[i] = na0[i]; ca1[i] = na1[i]; }
        if constexpr (FP8) { PG8_NAST(nast); const u32x4 nv = *(const LAS u32x4*)(lds + nast); ca0[0] = nv.x; ca0[1] = nv.y; ca1[0] = nv.z; ca1[1] = nv.w; }
        if constexpr (ALIGN_EPI) { if (wr == 1) PG8_BAR; }
    }
    PG8_WAIT_V(0);
    if constexpr (!ALIGN_EPI) { if (wr == 0) PG8_BAR; }
    PG8_BAR;
#undef PG8_SA
#undef PG8_SB
#undef PG8_STAGE
#undef PG8_LDA
#undef PG8_LDB
#undef PG8_MMA
#undef PG8_NAST
#undef PG8_J8
#undef PG8_WAIT_V
#undef PG8_WAIT_L
#undef PG8_BAR
#undef PG8_SCHED
}

struct DenseSched {
    const char* A; const char* Bt; int K, nM, nN, nwg, G, c, stag = 0, amask = -1;
    __device__ __forceinline__ void init(const void* A_, const void* Bt_, int M, int N, int K_, int G_, int c_) { A = (const char*)A_; Bt = (const char*)Bt_; K = K_; nM = M / BM; nN = N / BM; nwg = nM * nN; G = G_; c = c_; }
    __device__ __forceinline__ bool next(int i, Unit& u) const {
        const long L = (long)i * G + c; if (L >= nwg) return false;
        int wgid = (int)L; { const int q = nwg / 8, r = nwg % 8, xcd = wgid % 8, off = wgid / 8; wgid = (xcd < r ? xcd * (q + 1) : r * (q + 1) + (xcd - r) * q) + off; }
        const int nig = 8 * nN, gid = wgid / nig, fm = gid * 8, gsz = (nM - fm) < 8 ? (nM - fm) : 8;
        u.pm = fm + ((wgid % nig) % gsz); u.pn = (wgid % nig) / gsz; u.e = 0; return true;
    }
    __device__ __forceinline__ const char* a_base() const { return A; }
    __device__ __forceinline__ int stagger() const { return stag ? ((c >> 3) & 7) * (K / 55) : 0; }
    __device__ __forceinline__ unsigned a_off(const Unit& u, int row, int col) const { return (unsigned)(((size_t)((u.pm * BM + row) & amask) * K + col) * 2); }
    __device__ __forceinline__ int a_row(const Unit& u, int row) const { return (u.pm * BM + row) & amask; }
    __device__ __forceinline__ unsigned row_off(int r, int col) const { return (unsigned)(((size_t)r * K + col) * 2); }
    __device__ __forceinline__ const char* b_tile(const Unit& u) const { return Bt + (size_t)u.pn * BM * K * 2; }
};
}

namespace pg8 {
struct MoeSched {
    const char* A; const char* Bt; const int* slot_tok; volatile LAS unsigned* tstart; int K, rowsE, nN, c;
    __device__ __forceinline__ bool next(int i, Unit& u) const {
        const int x = c & 7, j = c >> 3, rpr = 32 / nN;
        const int pm = (i * 8 + x) * rpr + j / nN;
        const int T = (int)tstart[32];
        if (pm >= T) return false;
        int e = 0;
#pragma unroll 1
        for (int k = 1; k < 32; ++k) e += ((int)tstart[k] <= pm) ? 1 : 0;
        u.pm = pm; u.pn = j % nN; u.e = __builtin_amdgcn_readfirstlane(e); return true;
    }
    __device__ __forceinline__ const char* a_base() const { return A; }
    __device__ __forceinline__ int stagger() const { const int g = (c >> 3) / nN, ng = 32 / nN; (void)g; (void)ng; return 0; }
    __device__ __forceinline__ unsigned a_off(const Unit& u, int row, int col) const {
        const int pos = u.pm * BM + row;
        const int r = slot_tok ? slot_tok[pos] : pos;
        return (unsigned)(((size_t)r * K + col) * 2);
    }
    __device__ __forceinline__ int a_row(const Unit& u, int row) const { const int pos = u.pm * BM + row; return slot_tok ? ((const GAS int*)slot_tok)[pos] : pos; }
    __device__ __forceinline__ unsigned row_off(int r, int col) const { return (unsigned)(((size_t)r * K + col) * 2); }
    __device__ __forceinline__ const char* b_tile(const Unit& u) const { return Bt + ((size_t)u.e * rowsE + (size_t)u.pn * BM) * K * 2; }
};

struct MergeSched {
    const char* A; const char* Bt; int nM, nN, nwg, G, c;
    __device__ __forceinline__ void init(const void* A_, const void* Bt_, int M, int N, int G_, int c_) { A = (const char*)A_; Bt = (const char*)Bt_; nM = M / BM; nN = N / BM; nwg = nM * nN; G = G_; c = c_; }
    __device__ __forceinline__ bool next(int i, Unit& u) const {
        const int r = i / 3; const long L = (long)r * G + c; if (L >= nwg) return false;
        int wgid = (int)L; { const int q = nwg / 8, rr = nwg % 8, xcd = wgid % 8, off = wgid / 8; wgid = (xcd < rr ? xcd * (q + 1) : rr * (q + 1) + (xcd - rr) * q) + off; }
        const int nig = 8 * nN, gid = wgid / nig, fm = gid * 8, gsz = (nM - fm) < 8 ? (nM - fm) : 8;
        u.pm = fm + ((wgid % nig) % gsz); u.pn = (wgid % nig) / gsz; u.e = i - 3 * r; return true;
    }
    __device__ __forceinline__ const char* a_base() const { return A; }
    __device__ __forceinline__ int stagger() const { return 0; }
    __device__ __forceinline__ unsigned a_off(const Unit& u, int row, int col) const { return (unsigned)(((size_t)(u.pm * BM + row) * 512 + col) * 2 + (size_t)u.e * ((size_t)NTOK * 512 * 2)); }
    __device__ __forceinline__ const char* b_tile(const Unit& u) const { return Bt + ((size_t)u.e * DM + (size_t)u.pn * BM) * 512 * 2; }
};

constexpr int EPI_STAGE_OFF = 131072, EPI_STAGE_WAVE = 2304;
struct NoPre {};
template <int ACT> struct EpiBf16 {
    static constexpr bool PERM = true, DRAIN_TOP = false, STASH = false;
    struct Pre { f32x4 bv[2][2]; };
    bf16_t* O; int ldc; const float* bias; int rowmask = -1;
    __device__ __forceinline__ Pre preload(const Unit& u, int wr, int wc, int fr, int fq) const { Pre p; const int col0 = u.pn * BM + wc * 32 + 8 * fq;
#pragma unroll
        for (int bj = 0; bj < 2; ++bj)
#pragma unroll
            for (int n = 0; n < 2; ++n) p.bv[bj][n] = (f32x4){0.f, 0.f, 0.f, 0.f};
        return p; }
    __device__ __forceinline__ void arrived(Pre& p) const { asm volatile("" : "+v"(p.bv[0][0]), "+v"(p.bv[0][1]), "+v"(p.bv[1][0]), "+v"(p.bv[1][1])); }
    __device__ __forceinline__ void operator()(const f32x4 (&acc)[2][2][4][2], const Unit& u, int wr, int wc, int fr, int fq, const Pre& pre) const {
        const int row0 = u.pm * BM + wr * 64 + fr; const int col0 = u.pn * BM + wc * 32 + 8 * fq;
        f32x4 bv[2][2];
#pragma unroll
        for (int bj = 0; bj < 2; ++bj)
#pragma unroll
            for (int n = 0; n < 2; ++n) bv[bj][n] = bias ? *(const f32x4*)(bias + (ACT == 3 ? u.e * DM : 0) + col0 + bj * HALF + 4 * n) : pre.bv[bj][n];
#pragma unroll
        for (int ai = 0; ai < 2; ++ai)
#pragma unroll
            for (int m = 0; m < 4; ++m) { bf16_t* rowp = O + (size_t)((row0 + ai * HALF + m * 16) & rowmask) * ldc + col0;
#pragma unroll
                for (int bj = 0; bj < 2; ++bj) { constexpr float sc = (ACT >= 2) ? W8_INV : 1.f;
                    f32x4 v0 = acc[ai][bj][m][0] * sc + bv[bj][0], v1 = acc[ai][bj][m][1] * sc + bv[bj][1];
                    u32x4 w; w.x = cvt_pk_bf16(v0[0], v0[1]); w.y = cvt_pk_bf16(v0[2], v0[3]); w.z = cvt_pk_bf16(v1[0], v1[1]); w.w = cvt_pk_bf16(v1[2], v1[3]);
                    *(u32x4*)(rowp + bj * HALF) = w; } }
    }
};
struct EpiMerge {
    static constexpr bool PERM = true, DRAIN_TOP = false, STASH = false;
    typedef NoPre Pre; __device__ __forceinline__ Pre preload(const Unit&, int, int, int, int) const { return Pre{}; }
    const bf16_t* G; bf16_t* Mg;
    __device__ __forceinline__ void operator()(const f32x4 (&acc)[2][2][4][2], const Unit& u, int wr, int wc, int fr, int fq, const Pre&) const {
        const int row0 = u.pm * BM + wr * 64 + fr; const int col0 = u.pn * BM + wc * 32 + 8 * fq;
        const int goff = u.e * DM; const bool first = (u.e == 0);
#pragma unroll
        for (int ai = 0; ai < 2; ++ai)
#pragma unroll
            for (int m = 0; m < 4; ++m) { const size_t row = (size_t)(row0 + ai * HALF + m * 16);
#pragma unroll
                for (int bj = 0; bj < 2; ++bj) {
                    const u32x4 g = *(const u32x4*)(G + row * PW + goff + col0 + bj * HALF);
                    u32x4 p = (u32x4){0u, 0u, 0u, 0u};
                    if (!first) p = *(const u32x4*)(Mg + row * DM + col0 + bj * HALF);
                    const f32x4 a0 = acc[ai][bj][m][0], a1 = acc[ai][bj][m][1];
                    u32x4 w;
#define SGM(x_) __builtin_amdgcn_rcpf(1.f + __builtin_amdgcn_exp2f(-LOG2E * (x_)))
                    w.x = cvt_pk_bf16(bflo(p.x) + SGM(bflo(g.x)) * a0[0], bfhi(p.x) + SGM(bfhi(g.x)) * a0[1]);
                    w.y = cvt_pk_bf16(bflo(p.y) + SGM(bflo(g.y)) * a0[2], bfhi(p.y) + SGM(bfhi(g.y)) * a0[3]);
                    w.z = cvt_pk_bf16(bflo(p.z) + SGM(bflo(g.z)) * a1[0], bfhi(p.z) + SGM(bfhi(g.z)) * a1[1]);
                    w.w = cvt_pk_bf16(bflo(p.w) + SGM(bflo(g.w)) * a1[2], bfhi(p.w) + SGM(bfhi(g.w)) * a1[3]);
#undef SGM
                    *(u32x4*)(Mg + row * DM + col0 + bj * HALF) = w; } }
    }
};
struct EpiResid {
    static constexpr bool PERM = false, DRAIN_TOP = false, STASH = false;
    typedef NoPre Pre; __device__ __forceinline__ Pre preload(const Unit&, int, int, int, int) const { return Pre{}; }
    const float* base; float* out;
    __device__ __forceinline__ void operator()(const f32x4 (&acc)[2][2][4][2], const Unit& u, int wr, int wc, int fr, int fq, const Pre&) const {
        const int row0 = u.pm * BM + wr * 64 + fr; const int col0 = u.pn * BM + wc * 32 + 4 * fq;
#pragma unroll
        for (int ai = 0; ai < 2; ++ai)
#pragma unroll
            for (int m = 0; m < 4; ++m) { const size_t off = (size_t)(row0 + ai * HALF + m * 16) * DM + col0;
#pragma unroll
                for (int bj = 0; bj < 2; ++bj)
#pragma unroll
                    for (int n = 0; n < 2; ++n) { const f32x4 b = *(const f32x4*)(base + off + bj * HALF + n * 16); *(f32x4*)(out + off + bj * HALF + n * 16) = b + acc[ai][bj][m][n]; } }
    }
};
struct EpiSwiglu {
    static constexpr bool PERM = true, DRAIN_TOP = true, STASH = true;
    unsigned char* act; const float* bias; LAS unsigned char* lds;
    struct Pre { f32x4 bg[2], bu[2]; };
    __device__ __forceinline__ Pre preload(const Unit& u, int wr, int wc, int fr, int fq) const {
        const GAS float* be = (const GAS float*)bias + (size_t)u.e * 2048 + u.pn * HALF + wc * 32 + 8 * fq; Pre p;
#pragma unroll
        for (int n = 0; n < 2; ++n) { p.bg[n] = *(const GAS f32x4*)(be + 4 * n); p.bu[n] = *(const GAS f32x4*)(be + 1024 + 4 * n); }
        return p; }
    __device__ __forceinline__ void stash(const Pre& p, int wid, int fr, int fq) const {
        LAS f32x4* st = (LAS f32x4*)(lds + EPI_STAGE_OFF + wid * 256 + fq * 64);
        if (fr == 0) { st[0] = p.bg[0]; st[1] = p.bg[1]; st[2] = p.bu[0]; st[3] = p.bu[1]; } }
    __device__ __forceinline__ void operator()(const f32x4 (&acc)[2][2][4][2], const Unit& u, int wr, int wc, int fr, int fq, const Pre& pre) const {
        const int row0 = u.pm * BM + wr * 64 + fr; const int col0 = u.pn * HALF + wc * 32 + 8 * fq;
        f32x4 bg[2], bu[2];
#pragma unroll
        for (int n = 0; n < 2; ++n) { const LAS f32x4* st = (const LAS f32x4*)(lds + EPI_STAGE_OFF + (wr * 4 + wc) * 256 + fq * 64); bg[n] = st[n]; bu[n] = st[2 + n]; }
#pragma unroll
        for (int ai = 0; ai < 2; ++ai)
#pragma unroll
            for (int m = 0; m < 4; ++m) { unsigned char* rowp = act + (size_t)(row0 + ai * HALF + m * 16) * DEXP + col0;
                float o[8];
#pragma unroll
                for (int n = 0; n < 2; ++n) { const f32x4 gv = acc[ai][0][m][n] * W8_INV + bg[n], uv = acc[ai][1][m][n] * W8_INV + bu[n];
#pragma unroll
                    for (int q = 0; q < 4; ++q) { const float g = fminf(gv[q], 7.0f); const float uu = fminf(fmaxf(uv[q], -7.0f), 7.0f);
                        const float sg = __builtin_amdgcn_rcpf(1.f + __builtin_amdgcn_exp2f(-1.702f * LOG2E * g));
                        o[4 * n + q] = (uu + 1.0f) * (g * sg); } }
                u32x2 w; w.x = pk4_f8(o[0], o[1], o[2], o[3]); w.y = pk4_f8(o[4], o[5], o[6], o[7]);
                *(u32x2*)rowp = w; }
    }
};
struct EpiScatter {
    static constexpr bool PERM = false, DRAIN_TOP = false, STASH = false;
    typedef NoPre Pre; __device__ __forceinline__ Pre preload(const Unit&, int, int, int, int) const { return Pre{}; }
    float* out; const int* slot_tok; const float* slot_w; const float* bias; LAS unsigned char* lds;
    __device__ __forceinline__ void operator()(const f32x4 (&acc)[2][2][4][2], const Unit& u, int wr, int wc, int fr, int fq, const Pre&) const {
        const int lane = fr + 16 * fq, wid = wr * 4 + wc;
        LAS float* st = (LAS float*)(lds + EPI_STAGE_OFF + wid * EPI_STAGE_WAVE);
        const int row0 = u.pm * BM + wr * 64 + fr;
        const int lcol = lane & 31, lrow = lane >> 5;
        float bv[2];
#pragma unroll
        for (int bj = 0; bj < 2; ++bj) bv[bj] = bias[(size_t)u.e * DM + u.pn * BM + bj * HALF + wc * 32 + lcol];
#pragma unroll
        for (int ai = 0; ai < 2; ++ai)
#pragma unroll
            for (int m = 0; m < 4; ++m) { const int pos = row0 + ai * HALF + m * 16; const float w = slot_w[pos]; const int tok = slot_tok[pos];
#pragma unroll
                for (int bj = 0; bj < 2; ++bj) {
#pragma unroll
                    for (int n = 0; n < 2; ++n) *(LAS f32x4*)(st + fr * 36 + 16 * n + 4 * fq) = acc[ai][bj][m][n];
                    asm volatile("s_waitcnt lgkmcnt(0)" ::: "memory");
#pragma unroll
                    for (int i = 0; i < 8; ++i) { const int r = 2 * i + lrow; const float v = st[r * 36 + lcol];
                        const float wr_ = __shfl(w, r); const int tr_ = __shfl(tok, r);
                        if (wr_ != 0.f) unsafeAtomicAdd(out + (size_t)tr_ * DM + u.pn * BM + bj * HALF + wc * 32 + lcol, (v + bv[bj]) * wr_); }
                    asm volatile("s_waitcnt lgkmcnt(0)" ::: "memory");
                } }
    }
};
}

#define XB_TMO      128
#define XB_XCNT(j)  (256  + 64 * (j))
#define XB_XSUB(j)  (1280 + 64 * (j))
#define XB_XGEN(j)  (2304 + 64 * (j))
#define XB_TOP      3328
#define XB_TOPGEN   3392
#define XCD_BAR_WORDS 3456
#define XB_SPIN_CAP (1u << 18)

__device__ __forceinline__ unsigned xb_ld(unsigned* p)              { return __hip_atomic_load(p, __ATOMIC_RELAXED, __HIP_MEMORY_SCOPE_AGENT); }
__device__ __forceinline__ unsigned xb_add(unsigned* p, unsigned v) { return __hip_atomic_fetch_add(p, v, __ATOMIC_RELAXED, __HIP_MEMORY_SCOPE_AGENT); }
__device__ __forceinline__ unsigned xb_xcc_id() { return (unsigned)__builtin_amdgcn_s_getreg((3 << 11) | 20) & 0xFu; }
#define XB_SPIN(cond, bar) do { unsigned _sp = 0; while (cond) { __builtin_amdgcn_s_sleep(1); \
    if ((++_sp & 255u) == 0u) { if (xb_ld(&(bar)[XB_TMO])) break; if (_sp > XB_SPIN_CAP) { atomicAdd(&(bar)[XB_TMO], 1u); break; } } } } while (0)

struct XcdBarrier {
    unsigned* bar; unsigned x; int wave;
    volatile LAS unsigned* st;
};

__device__ __forceinline__ XcdBarrier xcd_barrier_post(unsigned* bar, volatile LAS unsigned* st) {
    XcdBarrier b; b.bar = bar; b.x = xb_xcc_id(); b.st = st; b.wave = __builtin_amdgcn_readfirstlane((int)(threadIdx.x >> 6));
    if (threadIdx.x == 0) (void)xb_add(&bar[XB_XCNT(b.x)], 1u);
    return b;
}
__device__ __forceinline__ void xcd_barrier_complete(unsigned* bar, unsigned x, unsigned& nloc, unsigned& nx) {
    const unsigned G = gridDim.x * gridDim.y * gridDim.z;
    unsigned sum, cnt, mine, sp = 0u;
    for (;;) {
        sum = 0u; cnt = 0u; mine = 0u;
#pragma unroll
        for (unsigned j = 0; j < 16; ++j) { const unsigned c = xb_ld(&bar[XB_XCNT(j)]); sum += c; cnt += (c > 0u) ? 1u : 0u; mine = (j == x) ? c : mine; }
        if (sum == G) break;
        __builtin_amdgcn_s_sleep(1);
        if ((++sp & 255u) == 0u) { if (xb_ld(&bar[XB_TMO])) break; if (sp > XB_SPIN_CAP) { atomicAdd(&bar[XB_TMO], 1u); break; } }
    }
    nloc = mine > 0u ? mine : 1u; nx = cnt > 0u ? cnt : 1u;
}

__device__ __forceinline__ void xcd_barrier(const XcdBarrier& b) {
    asm volatile("s_waitcnt vmcnt(0)" ::: "memory");
    __syncthreads();
    if (b.wave == 0 && lane_id_fresh() == 0) {
        unsigned* bar = b.bar;
        __builtin_amdgcn_s_waitcnt(0);
        unsigned nloc = b.st[0], nx = b.st[1];
        if (nloc == 0u) { xcd_barrier_complete(bar, b.x, nloc, nx); b.st[0] = nloc; b.st[1] = nx; }
        const unsigned old = xb_add(&bar[XB_XSUB(b.x)], 1u);
        const unsigned gen = old / nloc;
        if (old + 1u == (gen + 1u) * nloc) {
            __builtin_amdgcn_fence(__ATOMIC_RELEASE, "agent");
            asm volatile("s_waitcnt vmcnt(0)" ::: "memory");
            const unsigned og = xb_add(&bar[XB_TOP], 1u);
            const unsigned tg = og / nx;
            if (og + 1u == (tg + 1u) * nx) xb_add(&bar[XB_TOPGEN], 1u);
            else XB_SPIN(xb_ld(&bar[XB_TOPGEN]) == tg, bar);
            __builtin_amdgcn_fence(__ATOMIC_ACQUIRE, "agent");
            xb_add(&bar[XB_XGEN(b.x)], 1u);
            asm volatile("s_waitcnt vmcnt(0)" ::: "memory");
        } else {
            XB_SPIN(xb_ld(&bar[XB_XGEN(b.x)]) == gen, bar);
            __builtin_amdgcn_fence(__ATOMIC_ACQUIRE, "agent");
            asm volatile("s_waitcnt vmcnt(0)" ::: "memory");
        }
    }
    __syncthreads();
}

constexpr int NWAVES = 8;
struct Frame {
    LAS unsigned char* lds;
    volatile LAS unsigned* MISC;
    gu32* ctl;
    int tid, lane, wave, G, blk;
    const float* in[21];
    float* out; unsigned char* ws;
};
__device__ __forceinline__ float wave_sum(float v) {
#pragma unroll
    for (int o = 1; o < 64; o <<= 1) v += __shfl_xor(v, o);
    return v;
}

__device__ __forceinline__ int map_src(int mode, int n) {
    if (mode == 1) return n < 2500 ? n : (n >= C_MQ ? n - (C_MQ - 2500) : -1);
    if (mode == 2) { const int pn = n >> 8, bj = (n >> 7) & 1, j = n & 127; return bj * 1024 + pn * 128 + j; }
    return n;
}
__device__ __forceinline__ void transpose_item(const float* W, int K, int Nsrc, int Ndst, bf16_t* WT, int mode, LAS float* scr, int item, int lane) {
    const int nblk = Ndst / 32, kb = item / nblk, nb = item % nblk, k0 = 64 * kb, n0 = 32 * nb;
    const int sc = map_src(mode, n0 + (lane & 31));
    const float scale = (mode == 1 && (n0 + (lane & 31)) < 512) ? 0.125f : 1.0f;
#pragma unroll
    for (int i = 0; i < 32; ++i) { const int kk = 2 * i + (lane >> 5); scr[kk * 33 + (lane & 31)] = sc >= 0 ? W[(size_t)(k0 + kk) * Nsrc + sc] * scale : 0.f; }
    LDS_WAIT(); asm volatile("" ::: "memory");
    const int c = lane & 7;
#pragma unroll
    for (int j = 0; j < 4; ++j) { const int n = (lane >> 3) + 8 * j; const LAS float* s = scr + (8 * c) * 33 + n;
        u32x4 o; o.x = pk2(s[0 * 33], s[1 * 33]); o.y = pk2(s[2 * 33], s[3 * 33]); o.z = pk2(s[4 * 33], s[5 * 33]); o.w = pk2(s[6 * 33], s[7 * 33]);
        *(GAS u32x4*)(WT + (size_t)(n0 + n) * K + k0 + 8 * c) = o; }
    LDS_WAIT(); asm volatile("" ::: "memory");
}
__device__ __forceinline__ void transpose_item_f8(const float* W, int K, int Nsrc, int Ndst, unsigned char* WT, int mode, float scale, LAS float* scr, int item, int lane) {
    const int nblk = Ndst / 32, kb = item / nblk, nb = item % nblk, k0 = 64 * kb, n0 = 32 * nb;
    const int sc = map_src(mode, n0 + (lane & 31));
#pragma unroll
    for (int i = 0; i < 32; ++i) { const int kk = 2 * i + (lane >> 5); scr[kk * 33 + (lane & 31)] = sc >= 0 ? W[(size_t)(k0 + kk) * Nsrc + sc] * scale : 0.f; }
    LDS_WAIT(); asm volatile("" ::: "memory");
    const int c = lane & 7;
#pragma unroll
    for (int j = 0; j < 4; ++j) { const int n = (lane >> 3) + 8 * j; const LAS float* s = scr + (8 * c) * 33 + n;
        u32x2 o; o.x = pk4_f8(s[0 * 33], s[1 * 33], s[2 * 33], s[3 * 33]); o.y = pk4_f8(s[4 * 33], s[5 * 33], s[6 * 33], s[7 * 33]);
        *(GAS u32x2*)(WT + (size_t)(n0 + n) * K + k0 + 8 * c) = o; }
    LDS_WAIT(); asm volatile("" ::: "memory");
}
__device__ __forceinline__ void rms_row_to_bf16(int lane, const float* xrow, const float* g, bf16_t* orow) {
    const GAS f32x4* xr = (const GAS f32x4*)xrow + lane; const GAS f32x4* gr = (const GAS f32x4*)g + lane;
    f32x4 v[4]; float s = 0.f;
#pragma unroll
    for (int j = 0; j < 4; ++j) { v[j] = xr[64 * j]; s += (v[j].x * v[j].x + v[j].y * v[j].y) + (v[j].z * v[j].z + v[j].w * v[j].w); }
    const float rstd = 1.0f / sqrtf(wave_sum(s) * (1.f / DM) + EPS);
    GAS u32x2* o8 = (GAS u32x2*)orow + lane;
#pragma unroll
    for (int j = 0; j < 4; ++j) { const f32x4 gg = gr[64 * j]; u32x2 o; o.x = pk2(v[j].x * rstd * gg.x, v[j].y * rstd * gg.y); o.y = pk2(v[j].z * rstd * gg.z, v[j].w * rstd * gg.w); o8[64 * j] = o; }
}

__device__ __forceinline__ void rms_rows4_to_bf16(int lane, const float* x, const float* g, bf16_t* o, size_t m0, size_t stride, unsigned char* o8f = nullptr) {
    f32x4 v[4][4]; float s[4];
#pragma unroll
    for (int r = 0; r < 4; ++r) { const GAS f32x4* xr = (const GAS f32x4*)(x + (m0 + r * stride) * DM) + lane;
#pragma unroll
        for (int j = 0; j < 4; ++j) v[r][j] = xr[64 * j]; }
    const GAS f32x4* gr = (const GAS f32x4*)g + lane;
    f32x4 gg[4];
#pragma unroll
    for (int j = 0; j < 4; ++j) gg[j] = gr[64 * j];
#pragma unroll
    for (int r = 0; r < 4; ++r) { float a = 0.f;
#pragma unroll
        for (int j = 0; j < 4; ++j) a += (v[r][j].x * v[r][j].x + v[r][j].y * v[r][j].y) + (v[r][j].z * v[r][j].z + v[r][j].w * v[r][j].w);
        s[r] = a; }
#pragma unroll
    for (int of = 1; of < 64; of <<= 1) {
#pragma unroll
        for (int r = 0; r < 4; ++r) s[r] += __shfl_xor(s[r], of); }
#pragma unroll
    for (int r = 0; r < 4; ++r) { const float rstd = 1.0f / sqrtf(s[r] * (1.f / DM) + EPS);
        GAS u32x2* o8 = (GAS u32x2*)(o + (m0 + r * stride) * DM) + lane;
#pragma unroll
        for (int j = 0; j < 4; ++j) { const float a0 = v[r][j].x * rstd * gg[j].x, a1 = v[r][j].y * rstd * gg[j].y, a2 = v[r][j].z * rstd * gg[j].z, a3 = v[r][j].w * rstd * gg[j].w;
            u32x2 w; w.x = pk2(a0, a1); w.y = pk2(a2, a3); o8[64 * j] = w;
            if (o8f) *((GAS unsigned*)(o8f + (m0 + r * stride) * DM) + lane + 64 * j) = pk4_f8(a0, a1, a2, a3); } }
}
__device__ __forceinline__ void p0_prologue(Frame& F) {
    LAS float* scr = (LAS float*)(F.lds + F.wave * 16384);
    const int gw = F.blk * NWAVES + F.wave, NGW = F.G * NWAVES, lane = F.lane;
    unsigned char* ws = F.ws;
    constexpr int I_IN = 16 * 96, I_MKV = 16 * 32, I_G = 16 * 32, I_B = 8 * 32, I_O = 16 * 32, I_EI = 16 * 64, I_EO = 16 * 32;
    constexpr int NITEMS = I_IN + I_MKV + 3 * I_G + 3 * I_B + I_O + NEXP * I_EI + NEXP * I_EO;
    for (int it = gw; it < NITEMS; it += NGW) {
        int r = it;
        if (r < I_IN) { transpose_item(F.in[3], DM, IN_W, PW, (bf16_t*)(ws + WS_WIN), 1, scr, r, lane); continue; } r -= I_IN;
        if (r < I_MKV) { transpose_item(F.in[9], DM, DM, DM, (bf16_t*)(ws + WS_WMKV), 0, scr, r, lane); continue; } r -= I_MKV;
        if (r < 3 * I_G) { const int n = r / I_G; transpose_item_f8(F.in[10] + (size_t)n * DM * DM, DM, DM, DM, ws + WS_WG + (size_t)n * DM * DM, 0, W8_SCALE, scr, r % I_G, lane); continue; } r -= 3 * I_G;
        if (r < 3 * I_B) { const int n = r / I_B; transpose_item(F.in[12] + (size_t)n * 512 * DM, 512, DM, DM, (bf16_t*)(ws + WS_WB) + (size_t)n * DM * 512, 0, scr, r % I_B, lane); continue; } r -= 3 * I_B;
        if (r < I_O) { transpose_item(F.in[13], DM, DM, DM, (bf16_t*)(ws + WS_WO), 0, scr, r, lane); continue; } r -= I_O;
        if (r < NEXP * I_EI) { const int e = r / I_EI; transpose_item_f8(F.in[17] + (size_t)e * DM * 2048, DM, 2048, 2048, ws + WS_WEI + (size_t)e * 2048 * DM, 2, W8_SCALE, scr, r % I_EI, lane); continue; } r -= NEXP * I_EI;
        { const int e = r / I_EO; transpose_item_f8(F.in[19] + (size_t)e * DM * DM, DM, DM, DM, ws + WS_WEO + (size_t)e * DM * DM, 0, W8_SCALE, scr, r % I_EO, lane); }
    }
    { f32x2* tab = (f32x2*)(ws + WS_ROPE);
      for (int idx = (F.blk * NWAVES * 64) + F.tid; idx < SEQ * 32; idx += F.G * NWAVES * 64) {
          const int s = idx >> 5, i = idx & 31;
          const float inv = exp2f(-(float)i * (13.287712379549449f / 32.0f));
          const float ang = (float)s * inv;
          const double rev = (double)ang * 0.15915494309189535;
          const float fr = (float)(rev - __builtin_rint(rev));
          tab[idx] = (f32x2){__builtin_amdgcn_cosf(fr), __builtin_amdgcn_sinf(fr)}; } }
    for (int m = gw; m < NTOK; m += 4 * NGW) rms_rows4_to_bf16(lane, F.in[0], F.in[2], (bf16_t*)(ws + WS_H), (size_t)m, (size_t)NGW, ws + WS_H8);
    for (int m = gw; m < NMEM; m += 4 * NGW) rms_rows4_to_bf16(lane, F.in[1], F.in[8], (bf16_t*)(ws + WS_MEMN), (size_t)m, (size_t)NGW);
    { int* st = (int*)(ws + WS_SLOT_TOK);
      for (int i = F.blk * NWAVES * 64 + F.tid; i < NSLOT_PAD; i += F.G * NWAVES * 64) st[i] = 0; }
}

template <int CTRL> __device__ __forceinline__ float dppf(float v) { return __builtin_bit_cast(float, __builtin_amdgcn_update_dpp(0, __builtin_bit_cast(int, v), CTRL, 0xF, 0xF, false)); }
__device__ __forceinline__ float lx1(float v) { return dppf<0xB1>(v); }
__device__ __forceinline__ float lx2(float v) { return dppf<0x4E>(v); }
__device__ __forceinline__ float lx4(float v) { return dppf<0x1B>(dppf<0x141>(v)); }
__device__ __forceinline__ float lx8(float v) { return dppf<0x128>(v); }
__device__ __forceinline__ void un8(const u32x4 w, float (&v)[8]) { v[0] = bflo(w.x); v[1] = bfhi(w.x); v[2] = bflo(w.y); v[3] = bfhi(w.y); v[4] = bflo(w.z); v[5] = bfhi(w.z); v[6] = bflo(w.w); v[7] = bfhi(w.w); }
__device__ __forceinline__ u32x4 pk8(const float (&v)[8]) { u32x4 w; w.x = pk2(v[0], v[1]); w.y = pk2(v[2], v[3]); w.z = pk2(v[4], v[5]); w.w = pk2(v[6], v[7]); return w; }
__device__ __forceinline__ void rope8(float (&v)[8], const f32x2 (&cs)[8], bool up) {
#pragma unroll
    for (int j = 0; j < 8; ++j) { const float other = lx4(v[j]); v[j] = up ? (other * cs[j].y + v[j] * cs[j].x) : (v[j] * cs[j].x - other * cs[j].y); }
}
__device__ __forceinline__ void p2_prep(Frame& F, const bool dummy = false) {
    const int gw = F.blk * NWAVES + F.wave, NGW = F.G * NWAVES, lane = F.lane;
    bf16_t* proj = (bf16_t*)(F.ws + WS_P);
    bf16_t* projw = dummy ? (bf16_t*)(F.ws + WS_END) : proj;
    const int wmask = dummy ? 8191 : 0x7fffffff;
    const f32x2* tab = (const f32x2*)(F.ws + WS_ROPE);
    float gqd[8], gkd[8], gqm[8];
#pragma unroll
    for (int j = 0; j < 8; ++j) { gqd[j] = F.in[4][8 * (lane & 7) + j] * (0.125f * LOG2E); gkd[j] = F.in[5][8 * (lane & 7) + j]; gqm[j] = F.in[6][8 * (lane & 15) + j] * (0.08838834764831845f * LOG2E); }
    const bool up = (lane & 4) != 0; const int i0 = (lane & 3) * 8;
    for (int m0 = gw; m0 < NTOK; m0 += 2 * NGW) {
        u32x4 raw[2][5]; f32x2 cs[2][8];
#pragma unroll
        for (int t = 0; t < 2; ++t) { const GAS bf16_t* row = (const GAS bf16_t*)proj + (size_t)(m0 + t * NGW) * PW;
            raw[t][0] = *(const GAS u32x4*)(row + C_DQ + 8 * lane); raw[t][1] = *(const GAS u32x4*)(row + C_DK + 8 * (lane & 7)); raw[t][2] = *(const GAS u32x4*)(row + C_IQ + 8 * (lane & 31));
            raw[t][3] = *(const GAS u32x4*)(row + C_IK + 8 * (lane & 7)); raw[t][4] = *(const GAS u32x4*)(row + C_MQ + 8 * lane);
            const GAS f32x2* tr = (const GAS f32x2*)tab + (size_t)((m0 + t * NGW) & (SEQ - 1)) * 32 + i0;
#pragma unroll
            for (int j = 0; j < 8; ++j) cs[t][j] = tr[j]; }
#pragma unroll
        for (int t = 0; t < 2; ++t) {
            GAS bf16_t* roww = (GAS bf16_t*)projw + (size_t)((m0 + t * NGW) & wmask) * PW;
            float v[8];
            { un8(raw[t][0], v); float ss = 0.f;
#pragma unroll
              for (int j = 0; j < 8; ++j) ss += v[j] * v[j];
              ss += lx1(ss); ss += lx2(ss); ss += lx4(ss);
              const float rstd = 1.0f / sqrtf(ss * (1.f / 64.f) + EPS);
#pragma unroll
              for (int j = 0; j < 8; ++j) v[j] = v[j] * rstd * gqd[j];
              rope8(v, cs[t], up);
              *(GAS u32x4*)(roww + C_DQ + 8 * lane) = pk8(v); }
            { un8(raw[t][1], v); float ss = 0.f;
#pragma unroll
              for (int j = 0; j < 8; ++j) ss += v[j] * v[j];
              ss += lx1(ss); ss += lx2(ss); ss += lx4(ss);
              const float rstd = 1.0f / sqrtf(ss * (1.f / 64.f) + EPS);
#pragma unroll
              for (int j = 0; j < 8; ++j) v[j] = v[j] * rstd * gkd[j];
              rope8(v, cs[t], up);
              if (lane < 8) *(GAS u32x4*)(roww + C_DK + 8 * lane) = pk8(v); }
            { un8(raw[t][2], v); rope8(v, cs[t], up); if (lane < 32) *(GAS u32x4*)(roww + C_IQ + 8 * lane) = pk8(v); }
            { un8(raw[t][3], v); rope8(v, cs[t], up); if (lane < 8) *(GAS u32x4*)(roww + C_IK + 8 * lane) = pk8(v); }
            { un8(raw[t][4], v); float ss = 0.f;
#pragma unroll
              for (int j = 0; j < 8; ++j) ss += v[j] * v[j];
              ss += lx1(ss); ss += lx2(ss); ss += lx4(ss); ss += lx8(ss);
              const float rstd = 1.0f / sqrtf(ss * (1.f / 128.f) + EPS);
#pragma unroll
              for (int j = 0; j < 8; ++j) v[j] = v[j] * rstd * gqm[j];
              *(GAS u32x4*)(roww + C_MQ + 8 * lane) = pk8(v); }
        }
    }
    bf16_t* mkv = (bf16_t*)(F.ws + WS_MKV);
    if (!dummy) for (int m = gw; m < NMEM; m += NGW) {
        GAS bf16_t* row = (GAS bf16_t*)mkv + (size_t)m * DM; float v[8];
        un8(*(const GAS u32x4*)(row + 8 * lane), v); float ss = 0.f;
#pragma unroll
        for (int j = 0; j < 8; ++j) ss += v[j] * v[j];
        ss += lx1(ss); ss += lx2(ss); ss += lx4(ss); ss += lx8(ss);
        const float rstd = 1.0f / sqrtf(ss * (1.f / 128.f) + EPS);
#pragma unroll
        for (int j = 0; j < 8; ++j) v[j] = v[j] * rstd * F.in[7][8 * (lane & 15) + j];
        *(GAS u32x4*)(row + 8 * lane) = pk8(v);
    }
}

#define MFMA32(a, b, c) __builtin_amdgcn_mfma_f32_32x32x16_bf16((a), (b), (c), 0, 0, 0)
typedef LAS const unsigned char* lds_cptr;
__device__ __forceinline__ s16x4 vtr(lds_cptr p) { return __builtin_bit_cast(s16x4, __builtin_amdgcn_ds_read_tr16_b64_v4i16((LAS v4i16_t*)p)); }
__device__ __forceinline__ bf16x8 vfrag(lds_cptr vbase_lane, int off) {
    const s16x4 lo = vtr(vbase_lane + off), hi = vtr(vbase_lane + off + 512);
    return (bf16x8){lo[0], lo[1], lo[2], lo[3], hi[0], hi[1], hi[2], hi[3]};
}
__device__ __forceinline__ int vtr_lane_off(int lane) { return ((lane >> 4) & 1) * 32 + (lane & 3) * 8 + (4 * (lane >> 5) + ((lane & 15) >> 2)) * 64; }
__device__ __forceinline__ bf16x8 pack8(const float* p) {
    u32x4 w; w.x = cvt_pk_bf16(p[0], p[1]); w.y = cvt_pk_bf16(p[2], p[3]); w.z = cvt_pk_bf16(p[4], p[5]); w.w = cvt_pk_bf16(p[6], p[7]);
    return __builtin_bit_cast(bf16x8, w);
}
__device__ __forceinline__ float softplus_f(float z) { return fmaxf(z, 0.f) + __logf(1.f + __expf(-fabsf(z))); }

__device__ __forceinline__ void sb_item(const bf16_t* proj, bf16_t* osb, int b, int h, int qblk, LAS unsigned char* vlds, int lane) {
    const int r32 = lane & 31, hi = lane >> 5;
    const size_t tok0 = (size_t)b * SEQ + (size_t)qblk * 32;
    bf16x8 qr[4];
    { const bf16_t* qp = proj + (tok0 + r32) * PW + C_SQ + h * 64 + hi * 8;
#pragma unroll
      for (int kk = 0; kk < 4; ++kk) qr[kk] = *(const bf16x8*)(qp + kk * 16); }
    f32x16 o0 = {}, o1 = {}; float R = 0.f;
    const lds_cptr vrd = (lds_cptr)vlds + vtr_lane_off(lane);
    bf16x8 kfn[4]; u32x4 vvn[4];
#define SB_LOAD(kt_) do { const size_t key0_ = (size_t)b * SEQ + (size_t)(kt_) * 32; const GAS bf16_t* kp_ = (const GAS bf16_t*)proj + (key0_ + r32) * PW + C_SK + h * 64 + hi * 8; \
        _Pragma("unroll") for (int kk = 0; kk < 4; ++kk) kfn[kk] = *(const GAS bf16x8*)(kp_ + kk * 16); \
        _Pragma("unroll") for (int p = 0; p < 4; ++p) vvn[p] = *(const GAS u32x4*)((const GAS bf16_t*)proj + (key0_ + 16 * (p & 1) + (lane >> 2)) * PW + C_SV + h * 64 + (p >> 1) * 32 + (lane & 3) * 8); } while (0)
    SB_LOAD(qblk);
    for (int kt = qblk; kt >= 0; --kt) {
        bf16x8 kf[4]; u32x4 vv[4];
#pragma unroll
        for (int i = 0; i < 4; ++i) { kf[i] = kfn[i]; vv[i] = vvn[i]; }
        if (kt > 0) SB_LOAD(kt - 1);
        f32x16 s = {};
#pragma unroll
        for (int kk = 0; kk < 4; ++kk) s = MFMA32(kf[kk], qr[kk], s);
        asm volatile("" ::: "memory");
#pragma unroll
        for (int p = 0; p < 4; ++p) *(LAS u32x4*)(vlds + p * 1024 + lane * 16) = vv[p];
        const bool diag = (kt == qblk);
        float sp[16], pr[16];
#pragma unroll
        for (int r = 0; r < 16; ++r) { const bool valid = !diag || (crow(r, hi) < r32); sp[r] = valid ? softplus_f(s[r]) : 0.f; }
        float T[4], U[4];
#pragma unroll
        for (int g = 0; g < 4; ++g) { T[g] = (sp[4 * g] + sp[4 * g + 1]) + (sp[4 * g + 2] + sp[4 * g + 3]); { const auto rr = __builtin_amdgcn_permlane32_swap(__float_as_uint(T[g]), __float_as_uint(T[g]), false, false); U[g] = hi ? __uint_as_float(rr[0]) : __uint_as_float(rr[1]); } }
        float run = 0.f, above[4];
#pragma unroll
        for (int g = 3; g >= 0; --g) { above[g] = run + (hi == 0 ? U[g] : 0.f); run += T[g] + U[g]; }
#pragma unroll
        for (int g = 0; g < 4; ++g) { float c = R + above[g];
#pragma unroll
            for (int j = 3; j >= 0; --j) { const int r = 4 * g + j; c += sp[r]; const bool valid = !diag || (crow(r, hi) < r32); pr[r] = valid ? __expf(s[r] - c) : 0.f; } }
        R += run;
        const bf16x8 p0 = pack8(pr), p1 = pack8(pr + 8);
        LDS_WAIT();
        const bf16x8 v00 = vfrag(vrd, 0), v01 = vfrag(vrd, 1024), v10 = vfrag(vrd, 2048), v11 = vfrag(vrd, 3072);
        o0 = MFMA32(v00, p0, o0); o0 = MFMA32(v01, p1, o0);
        o1 = MFMA32(v10, p0, o1); o1 = MFMA32(v11, p1, o1);
        asm volatile("" ::: "memory");
        if (__all(R > 30.0f)) break;
    }
#undef SB_LOAD
    bf16_t* op = osb + (tok0 + r32) * 512 + h * 64 + 4 * hi;
#pragma unroll
    for (int g = 0; g < 4; ++g) {
        u32x2 w0, w1; w0.x = cvt_pk_bf16(o0[4 * g], o0[4 * g + 1]); w0.y = cvt_pk_bf16(o0[4 * g + 2], o0[4 * g + 3]); w1.x = cvt_pk_bf16(o1[4 * g], o1[4 * g + 1]); w1.y = cvt_pk_bf16(o1[4 * g + 2], o1[4 * g + 3]);
        *(u32x2*)(op + 8 * g) = w0; *(u32x2*)(op + 32 + 8 * g) = w1; }
}

constexpr int ML_K = 0, ML_KROW = 272, ML_V = 256 * ML_KROW, ML_END = ML_V + 65536;
__device__ __forceinline__ void mem_unit(const bf16_t* proj, const bf16_t* mkv, bf16_t* omem, int b, int h, int half, LAS unsigned char* ml, int tid) {
    const int lane = tid & 63, wid = __builtin_amdgcn_readfirstlane(tid >> 6), r32 = lane & 31, hi = lane >> 5;
    { const GAS bf16_t* src = (const GAS bf16_t*)mkv + (size_t)b * MEMLEN * DM + h * 128;
#pragma unroll
      for (int i = 0; i < 8; ++i) { const int ch = tid + 512 * i, key = ch >> 4, c16 = ch & 15, kk = key & 31;
          const u32x4 kv = *(const GAS u32x4*)(src + (size_t)key * DM + c16 * 8);
          const u32x4 vv = *(const GAS u32x4*)(src + (size_t)key * DM + 512 + c16 * 8);
          *(LAS u32x4*)(ml + ML_K + key * ML_KROW + c16 * 16) = kv;
          *(LAS u32x4*)(ml + ML_V + (key >> 5) * 8192 + ((c16 >> 2) * 2 + (kk >> 4)) * 1024 + (kk & 15) * 64 + (c16 & 3) * 16) = vv; } }
    __syncthreads();
    for (int i = 0; i < 4; ++i) {
        const int qblk = half * 32 + wid * 4 + i;
        const size_t tok0 = (size_t)b * SEQ + (size_t)qblk * 32;
        bf16x8 qr[8];
        { const GAS bf16_t* qp = (const GAS bf16_t*)proj + (tok0 + r32) * PW + C_MQ + h * 128 + hi * 8;
#pragma unroll
          for (int kk = 0; kk < 8; ++kk) qr[kk] = *(const GAS bf16x8*)(qp + kk * 16); }
        f32x16 o[4] = {{}, {}, {}, {}}; float m = -1e30f, l = 0.f;
        for (int kb = 0; kb < 8; ++kb) {
            const LAS unsigned char* krd = ml + ML_K + (32 * kb + r32) * ML_KROW + hi * 16;
            f32x16 s = {};
#pragma unroll
            for (int kk = 0; kk < 8; ++kk) { const bf16x8 kf = *(const LAS bf16x8*)(krd + kk * 32); s = MFMA32(kf, qr[kk], s); }
            float mx = s[0];
#pragma unroll
            for (int r = 1; r < 16; ++r) mx = fmaxf(mx, s[r]);
            { const auto rr = __builtin_amdgcn_permlane32_swap(__float_as_uint(mx), __float_as_uint(mx), false, false); mx = fmaxf(__uint_as_float(rr[0]), __uint_as_float(rr[1])); }
            if (__any(mx > m + 8.0f)) {
                const float mn = fmaxf(m, mx), alpha = __builtin_amdgcn_exp2f(m - mn);
                l *= alpha; m = mn;
#pragma unroll
                for (int d = 0; d < 4; ++d)
#pragma unroll
                    for (int r = 0; r < 16; ++r) o[d][r] *= alpha;
            }
            float pr[16], rs = 0.f;
#pragma unroll
            for (int r = 0; r < 16; ++r) { pr[r] = __builtin_amdgcn_exp2f(s[r] - m); rs += pr[r]; }
            l += rs;
            const bf16x8 p0 = pack8(pr), p1 = pack8(pr + 8);
            const lds_cptr vrd = (lds_cptr)ml + ML_V + kb * 8192 + vtr_lane_off(lane);
#pragma unroll
            for (int d = 0; d < 4; ++d) { const bf16x8 va = vfrag(vrd, d * 2048), vb = vfrag(vrd, d * 2048 + 1024); o[d] = MFMA32(va, p0, o[d]); o[d] = MFMA32(vb, p1, o[d]); }
        }
        { const auto rr = __builtin_amdgcn_permlane32_swap(__float_as_uint(l), __float_as_uint(l), false, false); l = __uint_as_float(rr[0]) + __uint_as_float(rr[1]); }
        const float il = 1.0f / l;
        bf16_t* op = omem + (tok0 + r32) * 512 + h * 128 + 4 * hi;
#pragma unroll
        for (int d = 0; d < 4; ++d)
#pragma unroll
            for (int g = 0; g < 4; ++g) { u32x2 w; w.x = cvt_pk_bf16(o[d][4 * g] * il, o[d][4 * g + 1] * il); w.y = cvt_pk_bf16(o[d][4 * g + 2] * il, o[d][4 * g + 3] * il); *(u32x2*)(op + 32 * d + 8 * g) = w; }
    }
    __syncthreads();
}

constexpr int DL_HIST = 0, DL_PREFIX = 66048, DL_KREM = DL_PREFIX + 256, DL_MASK = 67072, DL_VT = 73728, DL_KT = DL_VT + 2 * 16384, DL_END = DL_KT + 2 * 18432, DL_IQ = DL_VT;
constexpr int TOPK_DSA = 256;

struct IqLds { const LAS unsigned char* p; __device__ __forceinline__ bf16x8 operator()(int j) const { return *(const LAS bf16x8*)(p + j * 32); } };
template <class QF>
__device__ __forceinline__ void idx_scores(const QF& qf, const bf16x8 (&kf)[4], const float (&wq)[4], unsigned (&uk)[16]) {
    float scv[16];
#pragma unroll
    for (int hd = 0; hd < 4; ++hd) { f32x16 a = (f32x16){};
#pragma unroll
        for (int kk = 0; kk < 4; ++kk) a = MFMA32(kf[kk], qf(hd * 4 + kk), a);
#pragma unroll
        for (int r = 0; r < 16; ++r) scv[r] = (hd == 0) ? wq[0] * fmaxf(a[r], 0.f) : __builtin_fmaf(wq[hd], fmaxf(a[r], 0.f), scv[r]); }
#pragma unroll
    for (int r = 0; r < 16; ++r) {
        unsigned bits = __builtin_bit_cast(unsigned, scv[r]);
        if (bits == 0x80000000u) bits = 0u;
        uk[r] = bits ^ ((unsigned)((int)bits >> 31) | 0x80000000u);
    }
}
__device__ __forceinline__ void load_ik(const bf16_t* proj, size_t tokb, int kbase, int r32, int hi, bf16x8 (&kf)[4]) {
    int kr = kbase + r32; if (kr > SEQ - 1) kr = SEQ - 1;
    const GAS bf16_t* p = (const GAS bf16_t*)proj + (tokb + kr) * PW + C_IK + 8 * hi;
#pragma unroll
    for (int kk = 0; kk < 4; ++kk) kf[kk] = *(const GAS bf16x8*)(p + kk * 16);
}

__device__ __forceinline__ void dsa_unit(const bf16_t* proj, bf16_t* odsa, unsigned* kscr  , int b, int c, LAS unsigned char* dl, int tid) {
    const int lane = tid & 63, wid = __builtin_amdgcn_readfirstlane(tid >> 6), r32 = lane & 31, hi = lane >> 5;
    const int n = 64 * (c + 1), nsteps = (n + 127) >> 7;
    const size_t tokq0 = (size_t)b * SEQ + (size_t)c * 64, tokb = (size_t)b * SEQ;
    LAS unsigned* hist = (LAS unsigned*)(dl + DL_HIST);
    LAS unsigned* prefix = (LAS unsigned*)(dl + DL_PREFIX);
    LAS unsigned* krem = (LAS unsigned*)(dl + DL_KREM);
    LAS unsigned* mask = (LAS unsigned*)(dl + DL_MASK);
    const int kb = wid >> 1, qh = wid & 1;
    { const int row = tid >> 3, c = tid & 7;
      const GAS bf16_t* src = (const GAS bf16_t*)proj + (tokq0 + row) * PW + C_IQ + c * 32;
#pragma unroll
      for (int i = 0; i < 4; ++i) *(LAS u32x4*)(dl + DL_IQ + row * 528 + c * 64 + i * 16) = *(const GAS u32x4*)(src + i * 8); }
    const IqLds iqf{dl + DL_IQ + (32 * qh + r32) * 528 + hi * 16};
    float wq[4];
    { const u32x2 w = *(const u32x2*)(proj + (tokq0 + 32 * qh + r32) * PW + C_IW);
      wq[0] = bflo(w.x) * 0.0625f; wq[1] = bfhi(w.x) * 0.0625f; wq[2] = bflo(w.y) * 0.0625f; wq[3] = bfhi(w.y) * 0.0625f; }
#ifndef REP_SEL
#define REP_SEL 1
#endif
#ifndef REP_B2
#define REP_B2 1
#endif
    LAS unsigned* selall = (LAS unsigned*)(dl + DL_HIST);
#ifndef PROBE_NOATOM
#define PROBE_NOATOM 0
#endif
    unsigned dummy = 0u;
    for (int rep_sel = 0; rep_sel < REP_SEL; ++rep_sel) {
    if (tid < 64) { prefix[tid] = 0u; krem[tid] = (n > TOPK_DSA) ? (unsigned)TOPK_DSA : 0x7fffffffu; }
    __syncthreads();
    const int pass0 = (n > TOPK_DSA) ? 0 : 3;
    GAS u32x4* kmine = (GAS u32x4*)kscr + ((size_t)wid * 64 + lane) * 4;
#define DSA_CONSUME(uk_) do { \
        if (sel) { _Pragma("unroll") for (int r = 0; r < 16; ++r) { const bool match = (pass == 0) || (((uk_)[r] >> (shift + 8)) == pfx); \
                if (match && !(PROBE_NOATOM && rep_sel + 1 < REP_SEL)) __hip_atomic_fetch_add(hist + (32 * qh + r32) * 257 + (((uk_)[r] >> shift) & 255u), 1u, __ATOMIC_RELAXED, __HIP_MEMORY_SCOPE_WORKGROUP); else dummy ^= (uk_)[r]; } } \
        else { _Pragma("unroll") for (int r = 0; r < 16; ++r) { const unsigned k24 = (uk_)[r] >> 8; gtw |= (k24 > pfx ? 1u : 0u) << crow(r, hi); eqw |= (k24 == pfx ? 1u : 0u) << crow(r, hi); } } } while (0)
#define DSA_TIES() do { if (!sel) { \
        LAS unsigned* mk = mask + (step & 1) * 768; \
        { const auto rg = __builtin_amdgcn_permlane32_swap(gtw, gtw, false, false); gtw = rg[0] | rg[1]; const auto re = __builtin_amdgcn_permlane32_swap(eqw, eqw, false, false); eqw = re[0] | re[1]; } \
        if (hi == 0) { mk[(32 * qh + r32) * 4 + kb] = gtw; mk[256 + (32 * qh + r32) * 4 + kb] = eqw; } \
        __syncthreads(); \
        if (wid == 0) { unsigned nd = krem[lane]; \
            _Pragma("unroll") for (int k4 = 0; k4 < 4; ++k4) { const unsigned g = mk[lane * 4 + k4]; unsigned e = mk[256 + lane * 4 + k4]; unsigned sl = g; \
                if (e != 0u) { const unsigned cnt = (unsigned)__builtin_popcount(e); \
                    if (cnt <= nd) { sl |= e; nd -= cnt; } \
                    else { unsigned chosen = 0u; while (nd > 0u) { const unsigned lb = e & (0u - e); chosen |= lb; e ^= lb; --nd; } sl |= chosen; } } \
                selall[lane * 64 + step * 4 + k4] = sl; } \
            krem[lane] = nd; } } } while (0)
    for (int pass = pass0; pass < ((rep_sel + 1 < REP_SEL) ? 3 : 4); ++pass) {
        const bool sel = pass < 3;
        if (sel) { for (int i = tid; i < 64 * 257; i += 512) hist[i] = 0u; __syncthreads(); }
        const int shift = 24 - 8 * pass;
        const unsigned pfx = prefix[32 * qh + r32];
        if (pass == pass0) {
            bf16x8 kfn[4]; load_ik(proj, tokb, 32 * kb, r32, hi, kfn);
            for (int step = 0; step < nsteps; ++step) {
                const int kbase = 128 * step + 32 * kb;
                bf16x8 kf[4];
#pragma unroll
                for (int kk = 0; kk < 4; ++kk) kf[kk] = kfn[kk];
                if (step + 1 < nsteps) load_ik(proj, tokb, kbase + 128, r32, hi, kfn);
                unsigned gtw = 0u, eqw = 0u;
                if (kbase < n) {
                    unsigned uk[16];
                    idx_scores(iqf, kf, wq, uk);
                    if (pass0 == 0) {
#pragma unroll
                        for (int g = 0; g < 4; ++g) kmine[(size_t)step * 2048 + g] = (u32x4){uk[4 * g], uk[4 * g + 1], uk[4 * g + 2], uk[4 * g + 3]};
                    }
                    DSA_CONSUME(uk);
                }
                DSA_TIES();
            }
        } else {
            u32x4 ka[4], kb4[4];
#define DSA_KLOAD(dst, st_) do { _Pragma("unroll") for (int g = 0; g < 4; ++g) dst[g] = kmine[(size_t)(st_) * 2048 + g]; } while (0)
            DSA_KLOAD(ka, 0);
            if (nsteps > 1 && 128 + 32 * kb < n) DSA_KLOAD(kb4, 1);
            for (int step = 0; step < nsteps; ++step) {
                const int kbase = 128 * step + 32 * kb;
                unsigned uk[16];
#pragma unroll
                for (int g = 0; g < 4; ++g) { uk[4 * g] = ka[g].x; uk[4 * g + 1] = ka[g].y; uk[4 * g + 2] = ka[g].z; uk[4 * g + 3] = ka[g].w; }
#pragma unroll
                for (int g = 0; g < 4; ++g) ka[g] = kb4[g];
                if (step + 2 < nsteps && kbase + 256 < n) DSA_KLOAD(kb4, step + 2);
                unsigned gtw = 0u, eqw = 0u;
                if (kbase < n) DSA_CONSUME(uk);
                DSA_TIES();
            }
#undef DSA_KLOAD
        }
        if (sel) {
            __syncthreads();
#pragma unroll
            for (int qi = 0; qi < 8; ++qi) {
                const int q = 8 * wid + qi;
                const LAS unsigned* hq = hist + q * 257;
                const unsigned c0 = hq[255 - 4 * lane], c1 = hq[254 - 4 * lane], c2 = hq[253 - 4 * lane], c3 = hq[252 - 4 * lane];
                const unsigned s4 = c0 + c1 + c2 + c3;
                unsigned incl = s4;
#pragma unroll
                for (int o = 1; o < 64; o <<= 1) { const unsigned t = __shfl_up(incl, o); if (lane >= o) incl += t; }
                const unsigned excl = incl - s4, kr = krem[q];
                if (excl < kr && kr <= incl) {
                    unsigned cum = excl, bin, nk;
                    if (cum + c0 >= kr) { bin = 255 - 4 * lane; nk = kr - cum; }
                    else { cum += c0; if (cum + c1 >= kr) { bin = 254 - 4 * lane; nk = kr - cum; }
                    else { cum += c1; if (cum + c2 >= kr) { bin = 253 - 4 * lane; nk = kr - cum; }
                    else { cum += c2; bin = 252 - 4 * lane; nk = kr - cum; } } }
                    prefix[q] = (prefix[q] << 8) | bin; krem[q] = nk;
                }
            }
            __syncthreads();
        }
    }
    }
    if (dummy == 0x9e3779b9u) hist[tid] = 1u;
    const int hd = wid;
    u32x4 pk[2], pv[2];
#define DSA_LOADKV(step_) do { _Pragma("unroll") for (int i_ = 0; i_ < 2; ++i_) { const int ch_ = tid + 512 * i_; int krow_ = 128 * (step_) + (ch_ >> 3); if (krow_ > SEQ - 1) krow_ = SEQ - 1; \
        const GAS bf16_t* rp_ = (const GAS bf16_t*)proj + (tokb + krow_) * PW + (ch_ & 7) * 8; pk[i_] = *(const GAS u32x4*)(rp_ + C_DK); pv[i_] = *(const GAS u32x4*)(rp_ + C_DV); } } while (0)
#define DSA_STOREKV(buf_) do { _Pragma("unroll") for (int i_ = 0; i_ < 2; ++i_) { const int ch_ = tid + 512 * i_, key_ = ch_ >> 3, c8_ = ch_ & 7, kk_ = key_ & 31; \
        *(LAS u32x4*)(dl + DL_KT + (buf_) * 18432 + key_ * 144 + c8_ * 16) = pk[i_]; \
        *(LAS u32x4*)(dl + DL_VT + (buf_) * 16384 + (key_ >> 5) * 4096 + ((c8_ >> 2) * 2 + (kk_ >> 4)) * 1024 + (kk_ & 15) * 64 + (c8_ & 3) * 16) = pv[i_]; } } while (0)
    for (int rep_b2 = 0; rep_b2 < REP_B2; ++rep_b2)
    for (int qb = 0; qb < 2; ++qb) {
        bf16x8 qr[4];
        { const GAS bf16_t* qp = (const GAS bf16_t*)proj + (tokq0 + 32 * qb + r32) * PW + C_DQ + hd * 64 + 8 * hi;
#pragma unroll
          for (int kk = 0; kk < 4; ++kk) qr[kk] = *(const GAS bf16x8*)(qp + kk * 16); }
        f32x16 o0 = {}, o1 = {}; float mrun = -1e30f, lrun = 0.f;
        DSA_LOADKV(0);
        DSA_STOREKV(0);
        __syncthreads();
#define B2_QK(S_, k4_) do { const LAS unsigned char* krd_ = kt + (32 * (k4_) + r32) * 144 + hi * 16; S_ = (f32x16){}; \
        _Pragma("unroll") for (int kk = 0; kk < 4; ++kk) { const bf16x8 kf_ = *(const LAS bf16x8*)(krd_ + kk * 32); S_ = MFMA32(kf_, qr[kk], S_); } } while (0)
#define B2_SM_PV(S_, k4_) do { \
        const int selw_ = (int)selall[(32 * qb + r32) * 64 + step * 4 + (k4_)]; float mx_ = -INFINITY; \
        _Pragma("unroll") for (int r = 0; r < 16; ++r) { const unsigned m_ = (unsigned)__builtin_amdgcn_sbfe(selw_, crow(r, hi), 1); \
            S_[r] = __uint_as_float((__float_as_uint(S_[r]) & m_) | (0xFF800000u & ~m_)); mx_ = fmaxf(mx_, S_[r]); } \
        { const auto rr_ = __builtin_amdgcn_permlane32_swap(__float_as_uint(mx_), __float_as_uint(mx_), false, false); mx_ = fmaxf(__uint_as_float(rr_[0]), __uint_as_float(rr_[1])); } \
        if (__any(mx_ > mrun + 8.0f)) { const float mn_ = fmaxf(mrun, mx_), alpha_ = __builtin_amdgcn_exp2f(mrun - mn_); lrun *= alpha_; mrun = mn_; \
            _Pragma("unroll") for (int r = 0; r < 16; ++r) { o0[r] *= alpha_; o1[r] *= alpha_; } } \
        float pr_[16], rs_ = 0.f; \
        _Pragma("unroll") for (int r = 0; r < 16; ++r) { pr_[r] = __builtin_amdgcn_exp2f(S_[r] - mrun); rs_ += pr_[r]; } \
        lrun += rs_; \
        const bf16x8 pa_ = pack8(pr_), pb_ = pack8(pr_ + 8); \
        const lds_cptr vrd_ = (lds_cptr)vt + (k4_) * 4096 + vtr_lane_off(lane); \
        const bf16x8 v00_ = vfrag(vrd_, 0), v01_ = vfrag(vrd_, 1024), v10_ = vfrag(vrd_, 2048), v11_ = vfrag(vrd_, 3072); \
        o0 = MFMA32(v00_, pa_, o0); o0 = MFMA32(v01_, pb_, o0); o1 = MFMA32(v10_, pa_, o1); o1 = MFMA32(v11_, pb_, o1); } while (0)
        for (int step = 0; step < nsteps; ++step) {
            const int buf = step & 1;
            if (step + 1 < nsteps) DSA_LOADKV(step + 1);
            LAS unsigned char* kt = dl + DL_KT + buf * 18432;
            LAS unsigned char* vt = dl + DL_VT + buf * 16384;
            f32x16 sa, sb;
            B2_QK(sa, 0);
            B2_QK(sb, 1); B2_SM_PV(sa, 0); __builtin_amdgcn_sched_barrier(0);
            if (128 * step + 64 < n) {
                B2_QK(sa, 2); B2_SM_PV(sb, 1); __builtin_amdgcn_sched_barrier(0);
                B2_QK(sb, 3); B2_SM_PV(sa, 2); __builtin_amdgcn_sched_barrier(0);
                B2_SM_PV(sb, 3);
            } else {
                B2_SM_PV(sb, 1);
            }
            if (step + 1 < nsteps) DSA_STOREKV(buf ^ 1);
            __syncthreads();
        }
#undef B2_QK
#undef B2_SM_PV
        float l = lrun; { const auto rr = __builtin_amdgcn_permlane32_swap(__float_as_uint(l), __float_as_uint(l), false, false); l = __uint_as_float(rr[0]) + __uint_as_float(rr[1]); }
        const float il = 1.0f / l;
        bf16_t* op = odsa + (tokq0 + 32 * qb + r32) * 512 + hd * 64 + 4 * hi;
#pragma unroll
        for (int g = 0; g < 4; ++g) {
            u32x2 w0, w1; w0.x = cvt_pk_bf16(o0[4 * g] * il, o0[4 * g + 1] * il); w0.y = cvt_pk_bf16(o0[4 * g + 2] * il, o0[4 * g + 3] * il);
            w1.x = cvt_pk_bf16(o1[4 * g] * il, o1[4 * g + 1] * il); w1.y = cvt_pk_bf16(o1[4 * g + 2] * il, o1[4 * g + 3] * il);
            *(u32x2*)(op + 8 * g) = w0; *(u32x2*)(op + 32 + 8 * g) = w1; }
    }
#undef DSA_LOADKV
#undef DSA_STOREKV
#undef DSA_CONSUME
#undef DSA_TIES
    __syncthreads();
}

template <int CTRL> __device__ __forceinline__ float dpp_f(float v) { return __builtin_bit_cast(float, __builtin_amdgcn_update_dpp(0, __builtin_bit_cast(int, v), CTRL, 0xF, 0xF, false)); }
constexpr int RL_WROW = 2064, RL_WHI = 0, RL_WLO = 32 * RL_WROW, RL_TKE = 2 * 32 * RL_WROW, RL_TKW = RL_TKE + 4096;
__device__ __forceinline__ void p9_router(Frame& F) {
    const int lane = F.lane, wave = F.wave, tid = F.tid, r32 = lane & 31, hi = lane >> 5;
    LAS int* tke = (LAS int*)(F.lds + RL_TKE); LAS float* tkw = (LAS float*)(F.lds + RL_TKW);
    const float* w_router = F.in[15]; const float* b_router = F.in[16]; const float* g_ffn = F.in[14];
    for (int idx = tid; idx < DM * NEXP; idx += NWAVES * 64) { const int k = idx >> 5, e = idx & 31; const float w = w_router[idx];
        const unsigned wh = f2bf(w); const unsigned wl = f2bf(w - __builtin_bit_cast(float, wh << 16));
        *(LAS bf16_t*)(F.lds + RL_WHI + e * RL_WROW + k * 2) = (bf16_t)wh; *(LAS bf16_t*)(F.lds + RL_WLO + e * RL_WROW + k * 2) = (bf16_t)wl; }
    if (tid < 32) F.MISC[MW_LCNT + tid] = 0u;
    __syncthreads();
    bf16_t* h2 = (bf16_t*)(F.ws + WS_H); unsigned char* h2f8 = F.ws + WS_H2F8;
    const GAS f32x4* gr = (const GAS f32x4*)g_ffn + lane;
    f32x4 gg[4];
#pragma unroll
    for (int j = 0; j < 4; ++j) gg[j] = gr[64 * j];
    const size_t tok0 = (size_t)F.blk * 256 + 32 * wave;
    f32x4 xnext[2][4];
#pragma unroll
    for (int tk = 0; tk < 2; ++tk) { const GAS f32x4* xr = (const GAS f32x4*)(F.out + (tok0 + tk) * DM) + lane;
#pragma unroll
        for (int j = 0; j < 4; ++j) xnext[tk][j] = xr[64 * j]; }
    for (int it = 0; it < 16; ++it) {
        f32x4 hn[2][4];
#pragma unroll
        for (int tk = 0; tk < 2; ++tk)
#pragma unroll
            for (int j = 0; j < 4; ++j) hn[tk][j] = xnext[tk][j];
        if (it + 1 < 16) {
#pragma unroll
            for (int tk = 0; tk < 2; ++tk) { const GAS f32x4* xr = (const GAS f32x4*)(F.out + (tok0 + 2 * it + 2 + tk) * DM) + lane;
#pragma unroll
                for (int j = 0; j < 4; ++j) xnext[tk][j] = xr[64 * j]; } }
        float s[2];
#pragma unroll
        for (int tk = 0; tk < 2; ++tk) { float a = 0.f;
#pragma unroll
            for (int j = 0; j < 4; ++j) a += (hn[tk][j].x * hn[tk][j].x + hn[tk][j].y * hn[tk][j].y) + (hn[tk][j].z * hn[tk][j].z + hn[tk][j].w * hn[tk][j].w);
            s[tk] = a; }
#pragma unroll
        for (int tk = 0; tk < 2; ++tk) { float a = s[tk];
            a += dpp_f<0xB1>(a); a += dpp_f<0x4E>(a); a += dpp_f<0x141>(a); a += dpp_f<0x128>(a);
            { const auto rr = __builtin_amdgcn_permlane16_swap(__float_as_uint(a), __float_as_uint(a), false, false); a = __uint_as_float(rr[0]) + __uint_as_float(rr[1]); }
            { const auto rr = __builtin_amdgcn_permlane32_swap(__float_as_uint(a), __float_as_uint(a), false, false); a = __uint_as_float(rr[0]) + __uint_as_float(rr[1]); }
            s[tk] = a; }
#pragma unroll
        for (int tk = 0; tk < 2; ++tk) {
            const float rstd = 1.0f / sqrtf(s[tk] * (1.f / DM) + EPS);
            GAS u32x2* o8 = (GAS u32x2*)(h2 + (tok0 + 2 * it + tk) * DM) + lane;
#pragma unroll
            for (int j = 0; j < 4; ++j) { const f32x4 v = hn[tk][j] * rstd * gg[j]; u32x2 o; o.x = pk2(v.x, v.y); o.y = pk2(v.z, v.w); o8[64 * j] = o;
                *((GAS unsigned*)(h2f8 + (tok0 + 2 * it + tk) * DM) + lane + 64 * j) = pk4_f8(v.x, v.y, v.z, v.w); }
        }
    }
    asm volatile("s_waitcnt vmcnt(0)" ::: "memory");
    f32x16 acc = {};
    { const GAS bf16_t* hp = (const GAS bf16_t*)h2 + (tok0 + r32) * DM + 8 * hi;
      const LAS unsigned char* wp = F.lds + RL_WHI + r32 * RL_WROW + 16 * hi;
#pragma unroll 8
      for (int kk = 0; kk < 64; ++kk) { const bf16x8 hb = *(const GAS bf16x8*)(hp + 16 * kk);
          const bf16x8 wh = *(const LAS bf16x8*)(wp + 32 * kk), wl = *(const LAS bf16x8*)(wp + RL_WLO + 32 * kk);
          acc = MFMA32(wh, hb, acc); acc = MFMA32(wl, hb, acc); } }
    float lg[16];
#pragma unroll
    for (int r = 0; r < 16; ++r) lg[r] = acc[r] + b_router[crow(r, hi)];
    float lv[4]; int li[4];
#pragma unroll
    for (int k = 0; k < 4; ++k) { float bv = lg[0]; int br = 0;
#pragma unroll
        for (int r = 1; r < 16; ++r) { const bool g = lg[r] > bv; bv = g ? lg[r] : bv; br = g ? r : br; }
        lv[k] = bv; li[k] = crow(br, hi);
#pragma unroll
        for (int r = 0; r < 16; ++r) lg[r] = (r == br) ? -INFINITY : lg[r]; }
    float ov[4]; int oi[4];
#pragma unroll
    for (int k = 0; k < 4; ++k) { const auto rv = __builtin_amdgcn_permlane32_swap(__float_as_uint(lv[k]), __float_as_uint(lv[k]), false, false); const auto ri = __builtin_amdgcn_permlane32_swap((unsigned)li[k], (unsigned)li[k], false, false);
        ov[k] = hi ? __uint_as_float(rv[0]) : __uint_as_float(rv[1]); oi[k] = hi ? (int)ri[0] : (int)ri[1]; }
    float tv[4]; int te[4];
    { float a0 = lv[0], a1 = lv[1], a2 = lv[2], a3 = lv[3], b0 = ov[0], b1 = ov[1], b2 = ov[2], b3 = ov[3];
      int i0 = li[0], i1 = li[1], i2 = li[2], i3 = li[3], j0 = oi[0], j1 = oi[1], j2 = oi[2], j3 = oi[3];
#pragma unroll
      for (int k = 0; k < 4; ++k) { const bool ta = (a0 > b0) || (a0 == b0 && i0 < j0);
          tv[k] = ta ? a0 : b0; te[k] = ta ? i0 : j0;
          if (ta) { a0 = a1; a1 = a2; a2 = a3; a3 = -INFINITY; i0 = i1; i1 = i2; i2 = i3; i3 = 64; }
          else { b0 = b1; b1 = b2; b2 = b3; b3 = -INFINITY; j0 = j1; j1 = j2; j2 = j3; j3 = 64; } } }
    const float e1 = __expf(tv[1] - tv[0]), e2x = __expf(tv[2] - tv[0]), e3 = __expf(tv[3] - tv[0]);
    const float inv = 1.0f / (1.0f + e1 + e2x + e3);
    if (hi == 0) { const int tl = 32 * wave + r32;
        *(LAS int*)(tke + tl * 4 + 0) = te[0]; tke[tl * 4 + 1] = te[1]; tke[tl * 4 + 2] = te[2]; tke[tl * 4 + 3] = te[3];
        tkw[tl * 4 + 0] = inv; tkw[tl * 4 + 1] = e1 * inv; tkw[tl * 4 + 2] = e2x * inv; tkw[tl * 4 + 3] = e3 * inv;
#pragma unroll
        for (int k = 0; k < 4; ++k) __hip_atomic_fetch_add((LAS unsigned*)F.MISC + MW_LCNT + te[k], 1u, __ATOMIC_RELAXED, __HIP_MEMORY_SCOPE_WORKGROUP); }
    __syncthreads();
    if (tid < 32) ((int*)(F.ws + WS_BLKCNT))[F.blk * 32 + tid] = (int)F.MISC[MW_LCNT + tid];
}
__device__ __forceinline__ void p10_assign(Frame& F) {
    const int tid = F.tid;
    const int* blkcnt = (const int*)(F.ws + WS_BLKCNT);
    LAS int* part = (LAS int*)(F.lds);
    LAS int* tke = (LAS int*)(F.lds + RL_TKE); LAS float* tkw = (LAS float*)(F.lds + RL_TKW);
    { const int e = tid & 31, p = tid >> 5; int tot = 0, bef = 0;
      for (int j = 0; j < 16; ++j) { const int bl = p * 16 + j; const int c = blkcnt[bl * 32 + e]; tot += c; bef += (bl < F.blk) ? c : 0; }
      part[p * 32 + e] = tot; part[512 + p * 32 + e] = bef; }
    __syncthreads();
    if (tid < 32) { int tot = 0, bef = 0;
        for (int p = 0; p < 16; ++p) { tot += part[p * 32 + tid]; bef += part[512 + p * 32 + tid]; }
        part[1024 + tid] = tot; F.MISC[MW_BEFORE + tid] = (unsigned)bef; F.MISC[MW_LCNT + tid] = 0u; }
    __syncthreads();
    if (tid == 0) { int ps = 0;
        for (int e = 0; e < 32; ++e) { F.MISC[MW_PSTART + e] = (unsigned)ps; F.MISC[MW_TSTART + e] = (unsigned)(ps >> 8); ps += (part[1024 + e] + 255) & ~255; }
        F.MISC[MW_PSTART + 32] = (unsigned)ps; F.MISC[MW_TSTART + 32] = (unsigned)(ps >> 8); }
    __syncthreads();
    int* slot_tok = (int*)(F.ws + WS_SLOT_TOK); int* tok_slot = (int*)(F.ws + WS_TOK_SLOT); float* tok_gate = (float*)(F.ws + WS_TOK_GATE);
    for (int idx = tid; idx < 1024; idx += NWAVES * 64) {
        const int e = tke[idx]; const float w = tkw[idx];
        const unsigned r = __hip_atomic_fetch_add((LAS unsigned*)F.MISC + MW_LCNT + e, 1u, __ATOMIC_RELAXED, __HIP_MEMORY_SCOPE_WORKGROUP);
        const unsigned pos = F.MISC[MW_PSTART + e] + F.MISC[MW_BEFORE + e] + r;
        slot_tok[pos] = F.blk * 256 + (idx >> 2); tok_slot[F.blk * 1024 + idx] = (int)pos; tok_gate[F.blk * 1024 + idx] = w;
    }
}

__device__ __forceinline__ void p13_combine(Frame& F) {
    const int gw = F.blk * NWAVES + F.wave, NGW = F.G * NWAVES, lane = F.lane;
    const int* tok_slot = (const int*)(F.ws + WS_TOK_SLOT); const float* tok_gate = (const float*)(F.ws + WS_TOK_GATE);
    const GAS bf16_t* Y = (const GAS bf16_t*)(F.ws + WS_Y);
    for (int t0 = gw; t0 < NTOK; t0 += 2 * NGW) {
        u32x4 y[2][4][2]; f32x4 o[2][4]; float g[2][4];
#pragma unroll
        for (int tk = 0; tk < 2; ++tk) { const int t = t0 + tk * NGW;
#pragma unroll
            for (int k = 0; k < 4; ++k) { const int sl = __builtin_amdgcn_readfirstlane(tok_slot[4 * t + k]); g[tk][k] = tok_gate[4 * t + k];
                const GAS bf16_t* yr = Y + (size_t)sl * DM + 8 * lane; y[tk][k][0] = *(const GAS u32x4*)yr; y[tk][k][1] = *(const GAS u32x4*)(yr + 512); }
            const GAS float* orow = (const GAS float*)F.out + (size_t)t * DM + 8 * lane;
            o[tk][0] = *(const GAS f32x4*)orow; o[tk][1] = *(const GAS f32x4*)(orow + 4); o[tk][2] = *(const GAS f32x4*)(orow + 512); o[tk][3] = *(const GAS f32x4*)(orow + 516); }
#pragma unroll
        for (int tk = 0; tk < 2; ++tk) { const int t = t0 + tk * NGW;
#pragma unroll
            for (int k = 0; k < 4; ++k) { const float w = g[tk][k];
#pragma unroll
                for (int h = 0; h < 2; ++h) { const u32x4 v = y[tk][k][h];
                    o[tk][2 * h][0] += w * bflo(v.x); o[tk][2 * h][1] += w * bfhi(v.x); o[tk][2 * h][2] += w * bflo(v.y); o[tk][2 * h][3] += w * bfhi(v.y);
                    o[tk][2 * h + 1][0] += w * bflo(v.z); o[tk][2 * h + 1][1] += w * bfhi(v.z); o[tk][2 * h + 1][2] += w * bflo(v.w); o[tk][2 * h + 1][3] += w * bfhi(v.w); } }
            GAS float* orow = (GAS float*)F.out + (size_t)t * DM + 8 * lane;
            *(GAS f32x4*)orow = o[tk][0]; *(GAS f32x4*)(orow + 4) = o[tk][1]; *(GAS f32x4*)(orow + 512) = o[tk][2]; *(GAS f32x4*)(orow + 516) = o[tk][3]; }
    }
}

#ifndef MK_ONE_LAUNCH
#define MK_ONE_LAUNCH 1
#endif
constexpr int N_PHASES = 14;
struct Args { const float* in[21]; float* out; unsigned char* ws; int ph_lo, ph_hi; };
static_assert(sizeof(Args) == 21 * 8 + 8 + 8 + 8, "no padding");

__global__ void __launch_bounds__(NWAVES * 64, 2) fwd_kernel(Args args) {
    extern __shared__ __attribute__((aligned(16))) unsigned char lds[];
    Frame F;
    F.lds = (LAS unsigned char*)lds;
    F.MISC = (volatile LAS unsigned*)(F.lds + MISC_OFF);
    F.tid = threadIdx.x; F.lane = F.tid & 63; F.wave = __builtin_amdgcn_readfirstlane(F.tid >> 6);
#define FRESH() do { F.lane = lane_id_fresh(); F.tid = F.wave * 64 + F.lane; } while (0)
    F.G = gridDim.x; F.blk = blockIdx.x;
    F.ws = args.ws; F.out = args.out; F.ctl = (gu32*)(args.ws + WS_CTL);
#pragma unroll
    for (int i = 0; i < 21; ++i) F.in[i] = args.in[i];
    for (int u = F.tid; u < (LDS_BYTES - MISC_OFF) / 4; u += NWAVES * 64) ((LAS unsigned*)(F.lds + MISC_OFF))[u] = 0u;
    __syncthreads();
    const int lo = args.ph_lo, hi = args.ph_hi;
    XcdBarrier bar; bar.bar = (unsigned*)(F.ctl + CW_BAR); bar.x = 0; bar.st = nullptr; bar.wave = F.wave;
    if (hi - lo > 1) bar = xcd_barrier_post((unsigned*)(F.ctl + CW_BAR), F.MISC + MW_BAR);
#ifndef STAG
#define STAG 0
#endif
#ifndef PH_MASK
#define PH_MASK 0x3fff
#endif
#define IN(k) (((PH_MASK >> (k)) & 1) && lo <= (k) && (k) < hi)
#ifndef REP_MASK
#define REP_MASK 0
#endif
#define NREP(k) (1 + ((REP_MASK >> (k)) & 1))
#define SEAM(k) do { if (IN(k) && IN((k) + 1)) xcd_barrier(bar); } while (0)
    unsigned char* ws = args.ws;
    bf16_t* proj = (bf16_t*)(ws + WS_P);

    if (IN(0)) for (int rep = 0; rep < NREP(0); ++rep) { if (rep) xcd_barrier(bar); FRESH(); p0_prologue(F); } SEAM(0);

    if (IN(1)) {
#ifdef PROBE_P1
        { pg8::DenseSched S; S.init(ws + WS_H, ws + WS_WIN, NTOK, PW, DM, F.G, F.blk); S.amask = PROBE_P1;
          pg8::EpiBf16<0> E{(bf16_t*)(ws + WS_END), PW, nullptr, 1023};
          pg8::gemm_phase<pg8::EpiBf16<0>, pg8::DenseSched, true>(F.lds, F.wave, DM, S, E); }
        xcd_barrier(bar);
#endif
        { pg8::DenseSched S; S.init(ws + WS_H, ws + WS_WIN, NTOK, PW, DM, F.G, F.blk);
          pg8::EpiBf16<0> E{proj, PW, nullptr};
          pg8::gemm_phase<pg8::EpiBf16<0>, pg8::DenseSched, true>(F.lds, F.wave, DM, S, E); }
        { pg8::DenseSched S; S.init(ws + WS_MEMN, ws + WS_WMKV, NMEM, DM, DM, F.G, F.blk);
          pg8::EpiBf16<0> E{(bf16_t*)(ws + WS_MKV), DM, nullptr};
          pg8::gemm_phase<pg8::EpiBf16<0>, pg8::DenseSched, true>(F.lds, F.wave, DM, S, E); }
    } SEAM(1);

    if (IN(2)) { FRESH(); if (REP_MASK & 4) { p2_prep(F, true); xcd_barrier(bar); } p2_prep(F); } SEAM(2);

    if (IN(3)) {
        FRESH();
        bf16_t* osb = (bf16_t*)(ws + WS_O); bf16_t* odsa = osb + (size_t)NTOK * 512; bf16_t* omem = odsa + (size_t)NTOK * 512;
#ifndef REP_DSA
#define REP_DSA 1
#endif
#ifndef REP_SB
#define REP_SB 1
#endif
#ifndef REP_MEM
#define REP_MEM 1
#endif
#ifndef NO_DSA
        for (int rep = 0; rep < REP_DSA; ++rep)
        for (int i = 0; i < 4; ++i) { const int p = 2 * F.blk + (i >> 1), b = p >> 4, cc = p & 15, c = (i & 1) ? 31 - cc : cc; dsa_unit(proj, odsa, (unsigned*)F.out + (size_t)F.blk * 131072, b, c, F.lds, F.tid); }
#endif
        const int gw = F.blk * NWAVES + F.wave, NGW = F.G * NWAVES;
#ifndef NO_SB
        for (int rep = 0; rep < REP_SB; ++rep)
        for (int it = gw; it < NB * 8 * 64; it += NGW) { const int qblk = 63 - (it >> 8), bh = it & 255; sb_item(proj, osb, bh >> 3, bh & 7, qblk, F.lds + F.wave * 4096, F.lane); }
#endif
#ifndef NO_MEM
        for (int rep = 0; rep < REP_MEM; ++rep) {
            __syncthreads();
            for (int u = F.blk; u < NB * 4 * 2; u += F.G) mem_unit(proj, (const bf16_t*)(ws + WS_MKV), omem, u >> 3, (u >> 1) & 3, u & 1, F.lds, F.tid);
        }
#endif
    } SEAM(3);

    if (IN(4)) {
        pg8::DenseSched S; S.init(ws + WS_H8, ws + WS_WG, NTOK, 3 * DM, DM / 2, F.G, F.blk);
        pg8::EpiBf16<2> E{proj, PW, F.in[11]};
        pg8::gemm_phase<pg8::EpiBf16<2>, pg8::DenseSched, true, true>(F.lds, F.wave, DM / 2, S, E);
    } SEAM(4);

    if (IN(5)) { pg8::MergeSched S; S.init(ws + WS_O, ws + WS_WB, NTOK, DM, F.G, F.blk);
        pg8::EpiMerge E{proj, (bf16_t*)(ws + WS_H)};
        pg8::gemm_phase<pg8::EpiMerge, pg8::MergeSched, true>(F.lds, F.wave, 512, S, E); } SEAM(5);


    if (IN(8)) {
        pg8::DenseSched S; S.init(ws + WS_H, ws + WS_WO, NTOK, DM, DM, F.G, F.blk); S.stag = STAG;
        pg8::EpiResid E{F.in[0], F.out};
        pg8::gemm_phase<pg8::EpiResid, pg8::DenseSched, true>(F.lds, F.wave, DM, S, E);
    } SEAM(8);

    if (IN(9)) for (int rep = 0; rep < NREP(9); ++rep) { if (rep) xcd_barrier(bar); FRESH(); p9_router(F); } SEAM(9);
    if (IN(10)) for (int rep = 0; rep < NREP(10); ++rep) { if (rep) xcd_barrier(bar); FRESH(); p10_assign(F); } SEAM(10);

    if (IN(11)) for (int rep = 0; rep < NREP(11); ++rep) {  if (rep) xcd_barrier(bar);
        pg8::MoeSched S{(const char*)(ws + WS_H2F8), (const char*)(ws + WS_WEI), (const int*)(ws + WS_SLOT_TOK), F.MISC + MW_TSTART, DM / 2, 2048, 8, F.blk};
        pg8::EpiSwiglu E{ws + WS_ACT8, F.in[18], F.lds};
        pg8::gemm_phase<pg8::EpiSwiglu, pg8::MoeSched, true, true>(F.lds, F.wave, DM / 2, S, E);
    } SEAM(11);

    if (IN(12)) {
        pg8::MoeSched S{(const char*)(ws + WS_ACT8), (const char*)(ws + WS_WEO), nullptr, F.MISC + MW_TSTART, DM / 2, DM, 4, F.blk};
        pg8::EpiBf16<3> E{(bf16_t*)(ws + WS_Y), DM, F.in[20]};
        pg8::gemm_phase<pg8::EpiBf16<3>, pg8::MoeSched, true, true>(F.lds, F.wave, DM / 2, S, E);
    } SEAM(12);

    if (IN(13)) { FRESH(); p13_combine(F); }
#undef IN
#undef SEAM
}

extern "C" void kernel_launch(void* const* d_in, const int* in_sizes, int n_in, void* d_out, int out_size, void* d_ws, size_t ws_size, hipStream_t stream) {
    static int grid = 0;
    if (grid == 0) {
        if (n_in != 21 || in_sizes[0] != NTOK * DM || out_size != NTOK * DM || ws_size < WS_END) {
            fprintf(stderr, "kernel_launch: unexpected shapes: n_in %d in0 %d out %d ws %zu (need >= %zu); nothing launched\n", n_in, n_in > 0 ? in_sizes[0] : -1, out_size, ws_size, (size_t)WS_END); grid = -1; return; }
        int dev = 0, cus = 0, per_cu = 0;
        if (hipGetDevice(&dev) != hipSuccess || hipDeviceGetAttribute(&cus, hipDeviceAttributeMultiprocessorCount, dev) != hipSuccess) { fprintf(stderr, "kernel_launch: device query failed\n"); grid = -1; return; }
        if (hipFuncSetAttribute((const void*)fwd_kernel, hipFuncAttributeMaxDynamicSharedMemorySize, LDS_BYTES) != hipSuccess) { fprintf(stderr, "kernel_launch: hipFuncSetAttribute failed\n"); grid = -1; return; }
        if (hipOccupancyMaxActiveBlocksPerMultiprocessor(&per_cu, (const void*)fwd_kernel, NWAVES * 64, LDS_BYTES) != hipSuccess || per_cu < 1)
            fprintf(stderr, "kernel_launch: note: occupancy query reports %d workgroups per CU\n", per_cu);
        (void)hipGetLastError();
        grid = cus;
        if (grid != 256) { fprintf(stderr, "kernel_launch: this kernel is built for 256 CUs (got %d); nothing launched\n", grid); grid = -1; return; }
    }
    if (grid < 0) return;
    if (hipMemsetAsync((char*)d_ws + WS_CTL, 0, CTL_ZERO_BYTES, stream) != hipSuccess) { fprintf(stderr, "kernel_launch: hipMemsetAsync failed\n"); return; }
    Args a{};
    for (int i = 0; i < 21; ++i) a.in[i] = (const float*)d_in[i];
    a.out = (float*)d_out; a.ws = (unsigned char*)d_ws;
#if MK_ONE_LAUNCH
    const int cuts[2] = {0, N_PHASES}; const int nl = 1;
#else
    const int cuts[11] = {0, 1, 2, 3, 4, 5, 6, 7, 8, 9, N_PHASES}; const int nl = 10;
#endif
    for (int li = 0; li < nl; ++li) {
        a.ph_lo = cuts[li]; a.ph_hi = cuts[li + 1];
        hipLaunchKernelGGL(fwd_kernel, dim3(grid), dim3(NWAVES * 64), LDS_BYTES, stream, a);
        const hipError_t le = hipPeekAtLastError();
        if (le != hipSuccess) { fprintf(stderr, "kernel_launch: launch %d failed: %s\n", li, hipGetErrorName(le)); break; }
    }
}
```

```cpp
#include <hip/hip_runtime.h>
#include <cstdio>
#include <cstdint>

#define LAS __attribute__((address_space(3)))
#define GAS __attribute__((address_space(1)))
typedef unsigned short bf16_t;
typedef short bf16x8 __attribute__((ext_vector_type(8)));
typedef short s16x4 __attribute__((ext_vector_type(4)));
typedef short v4i16_t __attribute__((ext_vector_type(4)));
typedef float f32x2 __attribute__((ext_vector_type(2)));
typedef float f32x4 __attribute__((ext_vector_type(4)));
typedef float f32x16 __attribute__((ext_vector_type(16)));
typedef unsigned u32x2 __attribute__((ext_vector_type(2)));
typedef unsigned u32x4 __attribute__((ext_vector_type(4)));
typedef int i32x4 __attribute__((ext_vector_type(4)));
typedef int i32x8 __attribute__((ext_vector_type(8)));
typedef GAS unsigned gu32;

constexpr int NB = 32, SEQ = 2048, DM = 1024, NTOK = NB * SEQ;
constexpr int MEMLEN = 256, NMEM = NB * MEMLEN;
constexpr int PW = 3072;
constexpr int C_SQ = 0, C_SK = 512, C_SV = 1024, C_DQ = 1536, C_DK = 2048, C_DV = 2112, C_IQ = 2176, C_IK = 2432, C_IW = 2496, C_MQ = 2560;
constexpr int IN_W = 3012;
constexpr int NEXP = 32, TOPK = 4, DEXP = 1024;
constexpr int NSLOT = NTOK * TOPK;
constexpr int NSLOT_PAD = NSLOT + NEXP * 256;
constexpr float EPS = 1e-6f;
constexpr float LOG2E = 1.4426950408889634f;

constexpr size_t MiB = 1u << 20;
constexpr size_t WS_CTL = 0, CTL_ZERO_BYTES = 1 * MiB;
constexpr size_t WS_ROPE = 1 * MiB;
constexpr size_t WS_BLKCNT = 1 * MiB + 512 * 1024;
constexpr size_t WS_SLOT_TOK = 2 * MiB;
constexpr size_t WS_TOK_SLOT = 4 * MiB;
constexpr size_t WS_TOK_GATE = 5 * MiB;
constexpr size_t WS_WIN = 8 * MiB;
constexpr size_t WS_WMKV = 14 * MiB;
constexpr size_t WS_WG = 16 * MiB;
constexpr size_t WS_WB = 22 * MiB;
constexpr size_t WS_WO = 25 * MiB;
constexpr size_t WS_WEI = 27 * MiB;
constexpr size_t WS_WEO = 155 * MiB;
__device__ __forceinline__ int lane_id_fresh() { int l; asm volatile("v_mbcnt_lo_u32_b32 %0, -1, 0\n\tv_mbcnt_hi_u32_b32 %0, -1, %0" : "=v"(l)); return l; }
__device__ __forceinline__ unsigned pk4_f8(float a, float b, float c, float d) { int v = __builtin_amdgcn_cvt_pk_fp8_f32(a, b, 0, false); return (unsigned)__builtin_amdgcn_cvt_pk_fp8_f32(c, d, v, true); }
constexpr float W8_SCALE = 64.f, W8_INV = 1.f / 64.f;
constexpr size_t WS_H = 220 * MiB;
constexpr size_t WS_P = 348 * MiB;
constexpr size_t WS_O = 732 * MiB;
constexpr size_t WS_H8 = 91 * MiB;
constexpr size_t WS_H2F8 = 91 * MiB;
constexpr size_t WS_MEMN = 924 * MiB;
constexpr size_t WS_MKV = 940 * MiB;
constexpr size_t WS_Y = 220 * MiB;
constexpr size_t WS_ACT8 = 748 * MiB;
constexpr size_t WS_END = 1012 * MiB;
static_assert(WS_Y + (size_t)NSLOT_PAD * DM * 2 <= WS_ACT8 && WS_ACT8 + (size_t)NSLOT_PAD * DEXP <= WS_END, "y | act8");
static_assert(WS_SLOT_TOK + (size_t)NSLOT_PAD * 4 <= WS_TOK_SLOT && WS_TOK_GATE + (size_t)NTOK * 16 <= WS_WIN, "slot tables");

constexpr int CW_BAR = 4096;

constexpr int RING_BYTES = 151552;
constexpr int MISC_OFF = RING_BYTES;
constexpr int LDS_BYTES = 155648;
constexpr int MW_BAR = 8;
constexpr int MW_LCNT = 16;
constexpr int MW_PSTART = 64;
constexpr int MW_TSTART = 128;
constexpr int MW_BEFORE = 192;
constexpr int MW_PART = 256;

__device__ __forceinline__ unsigned f2bf(float f) { unsigned u = __builtin_bit_cast(unsigned, f); return (u + 0x7fffu + ((u >> 16) & 1u)) >> 16; }
__device__ __forceinline__ unsigned pk2(float lo, float hi) { return f2bf(lo) | (f2bf(hi) << 16); }
__device__ __forceinline__ float bf2f(unsigned short b) { return __builtin_bit_cast(float, (unsigned)b << 16); }
__device__ __forceinline__ float bflo(unsigned w) { return __builtin_bit_cast(float, w << 16); }
__device__ __forceinline__ float bfhi(unsigned w) { return __builtin_bit_cast(float, w & 0xffff0000u); }
__device__ __forceinline__ unsigned cvt_pk_bf16(float lo, float hi) { unsigned r; asm volatile("v_cvt_pk_bf16_f32 %0, %1, %2" : "=v"(r) : "v"(lo), "v"(hi)); return r; }
__device__ __forceinline__ int crow(int r, int hi) { return (r & 3) + 8 * (r >> 2) + 4 * hi; }
#define LDS_WAIT() asm volatile("s_waitcnt lgkmcnt(0)" ::: "memory")
#define VM_WAIT() asm volatile("s_waitcnt vmcnt(0)" ::: "memory")

namespace pg8 {
constexpr int BM = 256, BK = 64, HALF = 128, HTB = HALF * BK * 2, STAGE_BYTES = 8 * HTB, EPI_NA_OFF = STAGE_BYTES + 2048;
__host__ __device__ __forceinline__ int lds_byte(int r, int c) { const int st = (r >> 4) * 2 + (c >> 5), rr = r & 15, cc = c & 31, ob = rr * 64 + cc * 2; return st * 1024 + (ob ^ (((ob >> 9) & 1) << 5)); }
__host__ __device__ __forceinline__ void stage_rc(int b, int& R, int& C) { const int st = b / 1024, sb = b % 1024, swz = sb ^ (((sb >> 9) & 1) << 5); R = (st >> 1) * 16 + swz / 64; C = (st & 1) * 32 + (swz % 64) / 2; }
__host__ __device__ __forceinline__ int perm32(int rho) { const int n = rho >> 4, i = rho & 15; return 8 * (i >> 2) + 4 * n + (i & 3); }

struct Unit { int pm, pn, e; };

template <class Epi, class Sched, bool ALIGN_EPI, bool FP8 = false>
__device__ __forceinline__ void gemm_phase(LAS unsigned char* lds, const int wave_, const int K, const Sched& S, const Epi& E) {
    int tid = wave_ * 64 + lane_id_fresh();
    const int wid = __builtin_amdgcn_readfirstlane(tid >> 6), lane = tid & 63, wr = wid >> 2, wc = wid & 3, fr = lane & 15, fq = lane >> 4;
    const int nt = K / BK;
    int Rr[2], Cc[2]; unsigned voffB[2];
#pragma unroll
    for (int i = 0; i < 2; ++i) { int R, C; stage_rc(tid * 16 + i * 8192, R, C); Rr[i] = R; Cc[i] = C; const int Rb = Epi::PERM ? ((R & ~31) + perm32(R & 31)) : R; voffB[i] = (unsigned)(Rb * K + C) * 2u; }
    const size_t kstep = (size_t)(BK * 2);
    const size_t hstepB = (size_t)HALF * K * 2;
    const unsigned ldsw = (unsigned)wid * 1024u;
    const int aoff = lds_byte(wr * 64 + fr, fq * 8), boff = lds_byte(wc * 32 + fr, fq * 8);
#define PG8_SA(b, h) (((b) * 2 + (h)) * HTB)
#define PG8_SB(b, h) ((4 + (b) * 2 + (h)) * HTB)
#define PG8_STAGE(bufoff, gbase, voff) do { _Pragma("unroll") for (int _i = 0; _i < 2; ++_i) { unsigned o_ = (voff)[_i]; asm volatile("" : "+v"(o_)); \
        __builtin_amdgcn_global_load_lds((const unsigned*)((const char*)(gbase) + o_), (LAS unsigned*)(lds + (bufoff) + ldsw + _i * 8192), 16, 0, 0); } } while (0)
#define PG8_J8(x, y) __builtin_shufflevector(x, y, 0, 1, 2, 3, 4, 5, 6, 7)
#define PG8_LDA(dst, b, h) do { _Pragma("unroll") for (int m = 0; m < 4; ++m) { const LAS unsigned char* p_ = lds + PG8_SA(b, h) + aoff + m * 2048; \
        if constexpr (FP8) dst##8[m] = PG8_J8(*(const LAS i32x4*)p_, *(const LAS i32x4*)(p_ + 1024)); else { dst[m][0] = *(const LAS bf16x8*)p_; dst[m][1] = *(const LAS bf16x8*)(p_ + 1024); } } } while (0)
#define PG8_LDB(dst, b, h) do { _Pragma("unroll") for (int n = 0; n < 2; ++n) { const LAS unsigned char* p_ = lds + PG8_SB(b, h) + boff + n * 2048; \
        if constexpr (FP8) dst##8[n] = PG8_J8(*(const LAS i32x4*)p_, *(const LAS i32x4*)(p_ + 1024)); else { dst[n][0] = *(const LAS bf16x8*)p_; dst[n][1] = *(const LAS bf16x8*)(p_ + 1024); } } } while (0)
#define PG8_MMA(ai, bj, At, Bt) do { __builtin_amdgcn_s_setprio(1); _Pragma("unroll") for (int m = 0; m < 4; ++m) _Pragma("unroll") for (int n = 0; n < 2; ++n) { \
        if constexpr (FP8) acc[ai][bj][m][n] = __builtin_amdgcn_mfma_scale_f32_16x16x128_f8f6f4(Bt##8[n], At##8[m], acc[ai][bj][m][n], 0, 0, 0, 0, 0, 0); \
        else { _Pragma("unroll") for (int k = 0; k < 2; ++k) acc[ai][bj][m][n] = __builtin_amdgcn_mfma_f32_16x16x32_bf16(Bt[n][k], At[m][k], acc[ai][bj][m][n], 0, 0, 0); } } \
        __builtin_amdgcn_s_setprio(0); } while (0)
#define PG8_WAIT_V(n) asm volatile("s_waitcnt vmcnt(" #n ")" ::: "memory")
#define PG8_WAIT_L(n) asm volatile("s_waitcnt lgkmcnt(" #n ")" ::: "memory")
#define PG8_BAR __builtin_amdgcn_s_barrier()
#define PG8_SCHED __builtin_amdgcn_sched_barrier(0)
    Unit cur, nxt; int ui = 0;
    if (!S.next(0, cur)) return;
    { const int ns = S.stagger();
      for (int q = 0; q < ns; ++q) __builtin_amdgcn_s_sleep(4); }
    f32x4 acc[2][2][4][2];
    bf16x8 At[4][2], B0[2][2], B1[2][2]; i32x8 At8[4], B08[2], B18[2];
    const char* Ab = S.a_base();
    unsigned ca0[2], ca1[2], na0[2], na1[2];
#pragma unroll
    for (int i = 0; i < 2; ++i) { ca0[i] = S.a_off(cur, Rr[i], Cc[i]); ca1[i] = S.a_off(cur, HALF + Rr[i], Cc[i]); }
    const char* cB = S.b_tile(cur);
    PG8_STAGE(PG8_SB(0, 0), cB, voffB); PG8_STAGE(PG8_SB(0, 1), cB + hstepB, voffB); PG8_STAGE(PG8_SA(0, 0), Ab, ca0); PG8_STAGE(PG8_SA(0, 1), Ab, ca1);
    if (wr == 1) PG8_BAR;
    PG8_WAIT_V(2); PG8_BAR;
    PG8_STAGE(PG8_SB(1, 0), cB + kstep, voffB); PG8_STAGE(PG8_SA(1, 0), Ab + kstep, ca0); PG8_STAGE(PG8_SB(1, 1), cB + hstepB + kstep, voffB);
    PG8_WAIT_V(6); PG8_BAR;
    for (;;) {
        typename Epi::Pre pre = E.preload(cur, wr, wc, fr, fq);
        const bool has_next = S.next(ui + 1, nxt);
        const char* nB = cB;
#pragma unroll
        for (int i = 0; i < 2; ++i) { na0[i] = ca0[i]; na1[i] = ca1[i]; }
        if (has_next) { nB = S.b_tile(nxt);
#pragma unroll
            for (int i = 0; i < 2; ++i) { int R, C; int tq = tid; if constexpr (FP8) tq = wave_ * 64 + lane_id_fresh();
                stage_rc(tq * 16 + i * 8192, R, C);
                na0[i] = S.a_off(nxt, R, C); na1[i] = S.a_off(nxt, HALF + R, C); } }
        if constexpr (Epi::DRAIN_TOP) { PG8_WAIT_V(0); }
        if constexpr (Epi::STASH) E.stash(pre, wid, fr, fq);
#define PG8_NAST(v) const unsigned v = (unsigned)(EPI_NA_OFF + (wave_ * 64 + lane_id_fresh()) * 16)
        if constexpr (FP8) { PG8_NAST(nast); *(LAS u32x4*)(lds + nast) = (u32x4){na0[0], na0[1], na1[0], na1[1]}; }
#pragma unroll
        for (int a = 0; a < 2; ++a)
#pragma unroll
            for (int b = 0; b < 2; ++b)
#pragma unroll
                for (int m = 0; m < 4; ++m)
#pragma unroll
                    for (int n = 0; n < 2; ++n) acc[a][b][m][n] = (f32x4){0.f, 0.f, 0.f, 0.f};
#pragma unroll 1
        for (int t = 0; t < nt; t += 2) {
            const bool last = (t == nt - 2);
            const char* a1 = Ab + (size_t)(t + 1) * kstep;
            const char* a2 = last ? Ab : Ab + (size_t)(t + 2) * kstep; const char* b2 = last ? nB : cB + (size_t)(t + 2) * kstep;
            const char* a3 = a2 + kstep; const char* b3 = b2 + kstep;
            if constexpr (FP8) { asm volatile("" : "+s"(a1), "+s"(a2), "+s"(b2), "+s"(a3), "+s"(b3)); }
            unsigned o20[2], o21[2];
#pragma unroll
            for (int i = 0; i < 2; ++i) { o20[i] = last ? na0[i] : ca0[i]; o21[i] = last ? na1[i] : ca1[i]; }
            if constexpr (FP8) { if (last) { PG8_NAST(nast); const u32x4 nv = *(const LAS u32x4*)(lds + nast); o20[0] = nv.x; o20[1] = nv.y; o21[0] = nv.z; o21[1] = nv.w; } }
            PG8_LDB(B0, 0, 0); PG8_LDB(B1, 0, 1); PG8_SCHED; PG8_LDA(At, 0, 0); PG8_STAGE(PG8_SA(1, 1), a1, ca1);
            PG8_WAIT_V(8); PG8_WAIT_L(0); PG8_BAR; PG8_MMA(0, 0, At, B0); PG8_MMA(0, 1, At, B1); PG8_BAR; PG8_SCHED;
            PG8_LDA(At, 0, 1); PG8_STAGE(PG8_SB(0, 0), b2, voffB); PG8_STAGE(PG8_SB(0, 1), b2 + hstepB, voffB); PG8_STAGE(PG8_SA(0, 0), a2, o20);
            PG8_WAIT_V(8); PG8_WAIT_L(0); PG8_BAR; PG8_MMA(1, 0, At, B0); PG8_MMA(1, 1, At, B1); PG8_BAR; PG8_SCHED;
            PG8_LDB(B0, 1, 0); PG8_LDB(B1, 1, 1); PG8_SCHED; PG8_LDA(At, 1, 0); PG8_STAGE(PG8_SA(0, 1), a2, o21);
            PG8_WAIT_V(8); PG8_WAIT_L(0); PG8_BAR; PG8_MMA(0, 0, At, B0); PG8_MMA(0, 1, At, B1); PG8_BAR; PG8_SCHED;
            PG8_LDA(At, 1, 1); PG8_STAGE(PG8_SB(1, 0), b3, voffB); PG8_STAGE(PG8_SB(1, 1), b3 + hstepB, voffB); PG8_STAGE(PG8_SA(1, 0), a3, o20);
            PG8_WAIT_V(8); PG8_WAIT_L(0); PG8_BAR; PG8_MMA(1, 0, At, B0); PG8_MMA(1, 1, At, B1); PG8_BAR; PG8_SCHED;
        }
        if constexpr (ALIGN_EPI) { if (wr == 0) PG8_BAR; }
        if constexpr (FP8) { const int lq = lane_id_fresh();
            if constexpr (Epi::STASH) E(acc, cur, wr, wc, lq & 15, (lq >> 4) & 3, typename Epi::Pre{}); else E(acc, cur, wr, wc, lq & 15, (lq >> 4) & 3, pre); }
        else E(acc, cur, wr, wc, fr, fq, pre);
        if (!has_next) break;
        cur = nxt; cB = nB; ++ui;
#pragma unroll
        for (int i = 0; i < 2; ++i) { ca0[i] = na0[i]; ca1[i] = na1[i]; }
        if constexpr (FP8) { PG8_NAST(nast); const u32x4 nv = *(const LAS u32x4*)(lds + nast); ca0[0] = nv.x; ca0[1] = nv.y; ca1[0] = nv.z; ca1[1] = nv.w; }
        if constexpr (ALIGN_EPI) { if (wr == 1) PG8_BAR; }
    }
    PG8_WAIT_V(0);
    if constexpr (!ALIGN_EPI) { if (wr == 0) PG8_BAR; }
    PG8_BAR;
#undef PG8_SA
#undef PG8_SB
#undef PG8_STAGE
#undef PG8_LDA
#undef PG8_LDB
#undef PG8_MMA
#undef PG8_NAST
#undef PG8_J8
#undef PG8_WAIT_V
#undef PG8_WAIT_L
#undef PG8_BAR
#undef PG8_SCHED
}

struct DenseSched {
    const char* A; const char* Bt; int K, nM, nN, nwg, G, c, stag = 0, amask = -1;
    __device__ __forceinline__ void init(const void* A_, const void* Bt_, int M, int N, int K_, int G_, int c_) { A = (const char*)A_; Bt = (const char*)Bt_; K = K_; nM = M / BM; nN = N / BM; nwg = nM * nN; G = G_; c = c_; }
    __device__ __forceinline__ bool next(int i, Unit& u) const {
        const long L = (long)i * G + c; if (L >= nwg) return false;
        int wgid = (int)L; { const int q = nwg / 8, r = nwg % 8, xcd = wgid % 8, off = wgid / 8; wgid = (xcd < r ? xcd * (q + 1) : r * (q + 1) + (xcd - r) * q) + off; }
        const int nig = 8 * nN, gid = wgid / nig, fm = gid * 8, gsz = (nM - fm) < 8 ? (nM - fm) : 8;
        u.pm = fm + ((wgid % nig) % gsz); u.pn = (wgid % nig) / gsz; u.e = 0; return true;
    }
    __device__ __forceinline__ const char* a_base() const { return A; }
    __device__ __forceinline__ int stagger() const { return stag ? ((c >> 3) & 7) * (K / 55) : 0; }
    __device__ __forceinline__ unsigned a_off(const Unit& u, int row, int col) const { return (unsigned)(((size_t)((u.pm * BM + row) & amask) * K + col) * 2); }
    __device__ __forceinline__ int a_row(const Unit& u, int row) const { return (u.pm * BM + row) & amask; }
    __device__ __forceinline__ unsigned row_off(int r, int col) const { return (unsigned)(((size_t)r * K + col) * 2); }
    __device__ __forceinline__ const char* b_tile(const Unit& u) const { return Bt + (size_t)u.pn * BM * K * 2; }
};
}

namespace pg8 {
struct MoeSched {
    const char* A; const char* Bt; const int* slot_tok; volatile LAS unsigned* tstart; int K, rowsE, nN, c;
    __device__ __forceinline__ bool next(int i, Unit& u) const {
        const int x = c & 7, j = c >> 3, rpr = 32 / nN;
        const int pm = (i * 8 + x) * rpr + j / nN;
        const int T = (int)tstart[32];
        if (pm >= T) return false;
        int e = 0;
#pragma unroll 1
        for (int k = 1; k < 32; ++k) e += ((int)tstart[k] <= pm) ? 1 : 0;
        u.pm = pm; u.pn = j % nN; u.e = __builtin_amdgcn_readfirstlane(e); return true;
    }
    __device__ __forceinline__ const char* a_base() const { return A; }
    __device__ __forceinline__ int stagger() const { const int g = (c >> 3) / nN, ng = 32 / nN; (void)g; (void)ng; return 0; }
    __device__ __forceinline__ unsigned a_off(const Unit& u, int row, int col) const {
        const int pos = u.pm * BM + row;
        const int r = slot_tok ? slot_tok[pos] : pos;
        return (unsigned)(((size_t)r * K + col) * 2);
    }
    __device__ __forceinline__ int a_row(const Unit& u, int row) const { const int pos = u.pm * BM + row; return slot_tok ? ((const GAS int*)slot_tok)[pos] : pos; }
    __device__ __forceinline__ unsigned row_off(int r, int col) const { return (unsigned)(((size_t)r * K + col) * 2); }
    __device__ __forceinline__ const char* b_tile(const Unit& u) const { return Bt + ((size_t)u.e * rowsE + (size_t)u.pn * BM) * K * 2; }
};

struct MergeSched {
    const char* A; const char* Bt; int nM, nN, nwg, G, c;
    __device__ __forceinline__ void init(const void* A_, const void* Bt_, int M, int N, int G_, int c_) { A = (const char*)A_; Bt = (const char*)Bt_; nM = M / BM; nN = N / BM; nwg = nM * nN; G = G_; c = c_; }
    __device__ __forceinline__ bool next(int i, Unit& u) const {
        const int r = i / 3; const long L = (long)r * G + c; if (L >= nwg) return false;
        int wgid = (int)L; { const int q = nwg / 8, rr = nwg % 8, xcd = wgid % 8, off = wgid / 8; wgid = (xcd < rr ? xcd * (q + 1) : rr * (q + 1) + (xcd - rr) * q) + off; }
        const int nig = 8 * nN, gid = wgid / nig, fm = gid * 8, gsz = (nM - fm) < 8 ? (nM - fm) : 8;
        u.pm = fm + ((wgid % nig) % gsz); u.pn = (wgid % nig) / gsz; u.e = i - 3 * r; return true;
    }
    __device__ __forceinline__ const char* a_base() const { return A; }
    __device__ __forceinline__ int stagger() const { return 0; }
    __device__ __forceinline__ unsigned a_off(const Unit& u, int row, int col) const { return (unsigned)(((size_t)(u.pm * BM + row) * 512 + col) * 2 + (size_t)u.e * ((size_t)NTOK * 512 * 2)); }
    __device__ __forceinline__ const char* b_tile(const Unit& u) const { return Bt + ((size_t)u.e * DM + (size_t)u.pn * BM) * 512 * 2; }
};

constexpr int EPI_STAGE_OFF = 131072, EPI_STAGE_WAVE = 2304;
struct NoPre {};
template <int ACT> struct EpiBf16 {
    static constexpr bool PERM = true, DRAIN_TOP = false, STASH = false;
    struct Pre { f32x4 bv[2][2]; };
    bf16_t* O; int ldc; const float* bias; int rowmask = -1;
    __device__ __forceinline__ Pre preload(const Unit& u, int wr, int wc, int fr, int fq) const { Pre p; const int col0 = u.pn * BM + wc * 32 + 8 * fq;
#pragma unroll
        for (int bj = 0; bj < 2; ++bj)
#pragma unroll
            for (int n = 0; n < 2; ++n) p.bv[bj][n] = (f32x4){0.f, 0.f, 0.f, 0.f};
        return p; }
    __device__ __forceinline__ void arrived(Pre& p) const { asm volatile("" : "+v"(p.bv[0][0]), "+v"(p.bv[0][1]), "+v"(p.bv[1][0]), "+v"(p.bv[1][1])); }
    __device__ __forceinline__ void operator()(const f32x4 (&acc)[2][2][4][2], const Unit& u, int wr, int wc, int fr, int fq, const Pre& pre) const {
        const int row0 = u.pm * BM + wr * 64 + fr; const int col0 = u.pn * BM + wc * 32 + 8 * fq;
        f32x4 bv[2][2];
#pragma unroll
        for (int bj = 0; bj < 2; ++bj)
#pragma unroll
            for (int n = 0; n < 2; ++n) bv[bj][n] = bias ? *(const f32x4*)(bias + (ACT == 3 ? u.e * DM : 0) + col0 + bj * HALF + 4 * n) : pre.bv[bj][n];
#pragma unroll
        for (int ai = 0; ai < 2; ++ai)
#pragma unroll
            for (int m = 0; m < 4; ++m) { bf16_t* rowp = O + (size_t)((row0 + ai * HALF + m * 16) & rowmask) * ldc + col0;
#pragma unroll
                for (int bj = 0; bj < 2; ++bj) { constexpr float sc = (ACT >= 2) ? W8_INV : 1.f;
                    f32x4 v0 = acc[ai][bj][m][0] * sc + bv[bj][0], v1 = acc[ai][bj][m][1] * sc + bv[bj][1];
                    u32x4 w; w.x = cvt_pk_bf16(v0[0], v0[1]); w.y = cvt_pk_bf16(v0[2], v0[3]); w.z = cvt_pk_bf16(v1[0], v1[1]); w.w = cvt_pk_bf16(v1[2], v1[3]);
                    *(u32x4*)(rowp + bj * HALF) = w; } }
    }
};
struct EpiMerge {
    static constexpr bool PERM = true, DRAIN_TOP = false, STASH = false;
    typedef NoPre Pre; __device__ __forceinline__ Pre preload(const Unit&, int, int, int, int) const { return Pre{}; }
    const bf16_t* G; bf16_t* Mg;
    __device__ __forceinline__ void operator()(const f32x4 (&acc)[2][2][4][2], const Unit& u, int wr, int wc, int fr, int fq, const Pre&) const {
        const int row0 = u.pm * BM + wr * 64 + fr; const int col0 = u.pn * BM + wc * 32 + 8 * fq;
        const int goff = u.e * DM; const bool first = (u.e == 0);
#pragma unroll
        for (int ai = 0; ai < 2; ++ai)
#pragma unroll
            for (int m = 0; m < 4; ++m) { const size_t row = (size_t)(row0 + ai * HALF + m * 16);
#pragma unroll
                for (int bj = 0; bj < 2; ++bj) {
                    const u32x4 g = *(const u32x4*)(G + row * PW + goff + col0 + bj * HALF);
                    u32x4 p = (u32x4){0u, 0u, 0u, 0u};
                    if (!first) p = *(const u32x4*)(Mg + row * DM + col0 + bj * HALF);
                    const f32x4 a0 = acc[ai][bj][m][0], a1 = acc[ai][bj][m][1];
                    u32x4 w;
#define SGM(x_) __builtin_amdgcn_rcpf(1.f + __builtin_amdgcn_exp2f(-LOG2E * (x_)))
                    w.x = cvt_pk_bf16(bflo(p.x) + SGM(bflo(g.x)) * a0[0], bfhi(p.x) + SGM(bfhi(g.x)) * a0[1]);
                    w.y = cvt_pk_bf16(bflo(p.y) + SGM(bflo(g.y)) * a0[2], bfhi(p.y) + SGM(bfhi(g.y)) * a0[3]);
                    w.z = cvt_pk_bf16(bflo(p.z) + SGM(bflo(g.z)) * a1[0], bfhi(p.z) + SGM(bfhi(g.z)) * a1[1]);
                    w.w = cvt_pk_bf16(bflo(p.w) + SGM(bflo(g.w)) * a1[2], bfhi(p.w) + SGM(bfhi(g.w)) * a1[3]);
#undef SGM
                    *(u32x4*)(Mg + row * DM + col0 + bj * HALF) = w; } }
    }
};
struct EpiResid {
    static constexpr bool PERM = true, DRAIN_TOP = false, STASH = false;
    typedef NoPre Pre; __device__ __forceinline__ Pre preload(const Unit&, int, int, int, int) const { return Pre{}; }
    const float* base; bf16_t* out;
    __device__ __forceinline__ void operator()(const f32x4 (&acc)[2][2][4][2], const Unit& u, int wr, int wc, int fr, int fq, const Pre&) const {
        const int row0 = u.pm * BM + wr * 64 + fr; const int col0 = u.pn * BM + wc * 32 + 8 * fq;
#pragma unroll
        for (int ai = 0; ai < 2; ++ai)
#pragma unroll
            for (int m = 0; m < 4; ++m) { const size_t r = (size_t)(row0 + ai * HALF + m * 16); const float* xb = base + r * DM + col0; bf16_t* ob = out + r * 2048 + (r & 1) * 1024 + col0;
#pragma unroll
                for (int bj = 0; bj < 2; ++bj) { const f32x4 v0 = *(const f32x4*)(xb + bj * HALF) + acc[ai][bj][m][0], v1 = *(const f32x4*)(xb + bj * HALF + 4) + acc[ai][bj][m][1];
                    u32x4 w; w.x = cvt_pk_bf16(v0[0], v0[1]); w.y = cvt_pk_bf16(v0[2], v0[3]); w.z = cvt_pk_bf16(v1[0], v1[1]); w.w = cvt_pk_bf16(v1[2], v1[3]);
                    *(u32x4*)(ob + bj * HALF) = w; } }
    }
};
struct EpiSwiglu {
    static constexpr bool PERM = true, DRAIN_TOP = true, STASH = true;
    unsigned char* act; const float* bias; LAS unsigned char* lds;
    struct Pre { f32x4 bg[2], bu[2]; };
    __device__ __forceinline__ Pre preload(const Unit& u, int wr, int wc, int fr, int fq) const {
        const GAS float* be = (const GAS float*)bias + (size_t)u.e * 2048 + u.pn * HALF + wc * 32 + 8 * fq; Pre p;
#pragma unroll
        for (int n = 0; n < 2; ++n) { p.bg[n] = *(const GAS f32x4*)(be + 4 * n); p.bu[n] = *(const GAS f32x4*)(be + 1024 + 4 * n); }
        return p; }
    __device__ __forceinline__ void stash(const Pre& p, int wid, int fr, int fq) const {
        LAS f32x4* st = (LAS f32x4*)(lds + EPI_STAGE_OFF + wid * 256 + fq * 64);
        if (fr == 0) { st[0] = p.bg[0]; st[1] = p.bg[1]; st[2] = p.bu[0]; st[3] = p.bu[1]; } }
    __device__ __forceinline__ void operator()(const f32x4 (&acc)[2][2][4][2], const Unit& u, int wr, int wc, int fr, int fq, const Pre& pre) const {
        const int row0 = u.pm * BM + wr * 64 + fr; const int col0 = u.pn * HALF + wc * 32 + 8 * fq;
        f32x4 bg[2], bu[2];
#pragma unroll
        for (int n = 0; n < 2; ++n) { const LAS f32x4* st = (const LAS f32x4*)(lds + EPI_STAGE_OFF + (wr * 4 + wc) * 256 + fq * 64); bg[n] = st[n]; bu[n] = st[2 + n]; }
#pragma unroll
        for (int ai = 0; ai < 2; ++ai)
#pragma unroll
            for (int m = 0; m < 4; ++m) { unsigned char* rowp = act + (size_t)(row0 + ai * HALF + m * 16) * DEXP + col0;
                float o[8];
#pragma unroll
                for (int n = 0; n < 2; ++n) { const f32x4 gv = acc[ai][0][m][n] * W8_INV + bg[n], uv = acc[ai][1][m][n] * W8_INV + bu[n];
#pragma unroll
                    for (int q = 0; q < 4; ++q) { const float g = fminf(gv[q], 7.0f); const float uu = fminf(fmaxf(uv[q], -7.0f), 7.0f);
                        const float sg = __builtin_amdgcn_rcpf(1.f + __builtin_amdgcn_exp2f(-1.702f * LOG2E * g));
                        o[4 * n + q] = (uu + 1.0f) * (g * sg); } }
                u32x2 w; w.x = pk4_f8(o[0], o[1], o[2], o[3]); w.y = pk4_f8(o[4], o[5], o[6], o[7]);
                *(u32x2*)rowp = w; }
    }
};
struct EpiScatter {
    static constexpr bool PERM = false, DRAIN_TOP = false, STASH = false;
    typedef NoPre Pre; __device__ __forceinline__ Pre preload(const Unit&, int, int, int, int) const { return Pre{}; }
    float* out; const int* slot_tok; const float* slot_w; const float* bias; LAS unsigned char* lds;
    __device__ __forceinline__ void operator()(const f32x4 (&acc)[2][2][4][2], const Unit& u, int wr, int wc, int fr, int fq, const Pre&) const {
        const int lane = fr + 16 * fq, wid = wr * 4 + wc;
        LAS float* st = (LAS float*)(lds + EPI_STAGE_OFF + wid * EPI_STAGE_WAVE);
        const int row0 = u.pm * BM + wr * 64 + fr;
        const int lcol = lane & 31, lrow = lane >> 5;
        float bv[2];
#pragma unroll
        for (int bj = 0; bj < 2; ++bj) bv[bj] = bias[(size_t)u.e * DM + u.pn * BM + bj * HALF + wc * 32 + lcol];
#pragma unroll
        for (int ai = 0; ai < 2; ++ai)
#pragma unroll
            for (int m = 0; m < 4; ++m) { const int pos = row0 + ai * HALF + m * 16; const float w = slot_w[pos]; const int tok = slot_tok[pos];
#pragma unroll
                for (int bj = 0; bj < 2; ++bj) {
#pragma unroll
                    for (int n = 0; n < 2; ++n) *(LAS f32x4*)(st + fr * 36 + 16 * n + 4 * fq) = acc[ai][bj][m][n];
                    asm volatile("s_waitcnt lgkmcnt(0)" ::: "memory");
#pragma unroll
                    for (int i = 0; i < 8; ++i) { const int r = 2 * i + lrow; const float v = st[r * 36 + lcol];
                        const float wr_ = __shfl(w, r); const int tr_ = __shfl(tok, r);
                        if (wr_ != 0.f) unsafeAtomicAdd(out + (size_t)tr_ * DM + u.pn * BM + bj * HALF + wc * 32 + lcol, (v + bv[bj]) * wr_); }
                    asm volatile("s_waitcnt lgkmcnt(0)" ::: "memory");
                } }
    }
};
}

#define XB_TMO      128
#define XB_XCNT(j)  (256  + 64 * (j))
#define XB_XSUB(j)  (1280 + 64 * (j))
#define XB_XGEN(j)  (2304 + 64 * (j))
#define XB_TOP      3328
#define XB_TOPGEN   3392
#define XCD_BAR_WORDS 3456
#define XB_SPIN_CAP (1u << 18)

__device__ __forceinline__ unsigned xb_ld(unsigned* p)              { return __hip_atomic_load(p, __ATOMIC_RELAXED, __HIP_MEMORY_SCOPE_AGENT); }
__device__ __forceinline__ unsigned xb_add(unsigned* p, unsigned v) { return __hip_atomic_fetch_add(p, v, __ATOMIC_RELAXED, __HIP_MEMORY_SCOPE_AGENT); }
__device__ __forceinline__ unsigned xb_xcc_id() { return (unsigned)__builtin_amdgcn_s_getreg((3 << 11) | 20) & 0xFu; }
#define XB_SPIN(cond, bar) do { unsigned _sp = 0; while (cond) { __builtin_amdgcn_s_sleep(1); \
    if ((++_sp & 255u) == 0u) { if (xb_ld(&(bar)[XB_TMO])) break; if (_sp > XB_SPIN_CAP) { atomicAdd(&(bar)[XB_TMO], 1u); break; } } } } while (0)

struct XcdBarrier {
    unsigned* bar; unsigned x; int wave;
    volatile LAS unsigned* st;
};

__device__ __forceinline__ XcdBarrier xcd_barrier_post(unsigned* bar, volatile LAS unsigned* st) {
    XcdBarrier b; b.bar = bar; b.x = xb_xcc_id(); b.st = st; b.wave = __builtin_amdgcn_readfirstlane((int)(threadIdx.x >> 6));
    if (threadIdx.x == 0) (void)xb_add(&bar[XB_XCNT(b.x)], 1u);
    return b;
}
__device__ __forceinline__ void xcd_barrier_complete(unsigned* bar, unsigned x, unsigned& nloc, unsigned& nx) {
    const unsigned G = gridDim.x * gridDim.y * gridDim.z;
    unsigned sum, cnt, mine, sp = 0u;
    for (;;) {
        sum = 0u; cnt = 0u; mine = 0u;
#pragma unroll
        for (unsigned j = 0; j < 16; ++j) { const unsigned c = xb_ld(&bar[XB_XCNT(j)]); sum += c; cnt += (c > 0u) ? 1u : 0u; mine = (j == x) ? c : mine; }
        if (sum == G) break;
        __builtin_amdgcn_s_sleep(1);
        if ((++sp & 255u) == 0u) { if (xb_ld(&bar[XB_TMO])) break; if (sp > XB_SPIN_CAP) { atomicAdd(&bar[XB_TMO], 1u); break; } }
    }
    nloc = mine > 0u ? mine : 1u; nx = cnt > 0u ? cnt : 1u;
}

__device__ __forceinline__ void xcd_barrier(const XcdBarrier& b) {
    asm volatile("s_waitcnt vmcnt(0)" ::: "memory");
    __syncthreads();
    if (b.wave == 0 && lane_id_fresh() == 0) {
        unsigned* bar = b.bar;
        __builtin_amdgcn_s_waitcnt(0);
        unsigned nloc = b.st[0], nx = b.st[1];
        if (nloc == 0u) { xcd_barrier_complete(bar, b.x, nloc, nx); b.st[0] = nloc; b.st[1] = nx; }
        const unsigned old = xb_add(&bar[XB_XSUB(b.x)], 1u);
        const unsigned gen = old / nloc;
        if (old + 1u == (gen + 1u) * nloc) {
            __builtin_amdgcn_fence(__ATOMIC_RELEASE, "agent");
            asm volatile("s_waitcnt vmcnt(0)" ::: "memory");
            const unsigned og = xb_add(&bar[XB_TOP], 1u);
            const unsigned tg = og / nx;
            if (og + 1u == (tg + 1u) * nx) xb_add(&bar[XB_TOPGEN], 1u);
            else XB_SPIN(xb_ld(&bar[XB_TOPGEN]) == tg, bar);
            __builtin_amdgcn_fence(__ATOMIC_ACQUIRE, "agent");
            xb_add(&bar[XB_XGEN(b.x)], 1u);
            asm volatile("s_waitcnt vmcnt(0)" ::: "memory");
        } else {
            XB_SPIN(xb_ld(&bar[XB_XGEN(b.x)]) == gen, bar);
            __builtin_amdgcn_fence(__ATOMIC_ACQUIRE, "agent");
            asm volatile("s_waitcnt vmcnt(0)" ::: "memory");
        }
    }
    __syncthreads();
}

constexpr int NWAVES = 8;
struct Frame {
    LAS unsigned char* lds;
    volatile LAS unsigned* MISC;
    gu32* ctl;
    int tid, lane, wave, G, blk;
    const float* in[21];
    float* out; unsigned char* ws;
};
__device__ __forceinline__ float wave_sum(float v) {
#pragma unroll
    for (int o = 1; o < 64; o <<= 1) v += __shfl_xor(v, o);
    return v;
}

__device__ __forceinline__ int map_src(int mode, int n) {
    if (mode == 1) return n < 2500 ? n : (n >= C_MQ ? n - (C_MQ - 2500) : -1);
    if (mode == 2) { const int pn = n >> 8, bj = (n >> 7) & 1, j = n & 127; return bj * 1024 + pn * 128 + j; }
    return n;
}
__device__ __forceinline__ void transpose_item(const float* W, int K, int Nsrc, int Ndst, bf16_t* WT, int mode, LAS float* scr, int item, int lane) {
    const int nblk = Ndst / 32, kb = item / nblk, nb = item % nblk, k0 = 64 * kb, n0 = 32 * nb;
    const int sc = map_src(mode, n0 + (lane & 31));
    const float scale = (mode == 1 && (n0 + (lane & 31)) < 512) ? 0.125f : 1.0f;
#pragma unroll
    for (int i = 0; i < 32; ++i) { const int kk = 2 * i + (lane >> 5); scr[kk * 33 + (lane & 31)] = sc >= 0 ? W[(size_t)(k0 + kk) * Nsrc + sc] * scale : 0.f; }
    LDS_WAIT(); asm volatile("" ::: "memory");
    const int c = lane & 7;
#pragma unroll
    for (int j = 0; j < 4; ++j) { const int n = (lane >> 3) + 8 * j; const LAS float* s = scr + (8 * c) * 33 + n;
        u32x4 o; o.x = pk2(s[0 * 33], s[1 * 33]); o.y = pk2(s[2 * 33], s[3 * 33]); o.z = pk2(s[4 * 33], s[5 * 33]); o.w = pk2(s[6 * 33], s[7 * 33]);
        *(GAS u32x4*)(WT + (size_t)(n0 + n) * K + k0 + 8 * c) = o; }
    LDS_WAIT(); asm volatile("" ::: "memory");
}
__device__ __forceinline__ void transpose_item_f8(const float* W, int K, int Nsrc, int Ndst, unsigned char* WT, int mode, float scale, LAS float* scr, int item, int lane) {
    const int nblk = Ndst / 32, kb = item / nblk, nb = item % nblk, k0 = 64 * kb, n0 = 32 * nb;
    const int sc = map_src(mode, n0 + (lane & 31));
#pragma unroll
    for (int i = 0; i < 32; ++i) { const int kk = 2 * i + (lane >> 5); scr[kk * 33 + (lane & 31)] = sc >= 0 ? W[(size_t)(k0 + kk) * Nsrc + sc] * scale : 0.f; }
    LDS_WAIT(); asm volatile("" ::: "memory");
    const int c = lane & 7;
#pragma unroll
    for (int j = 0; j < 4; ++j) { const int n = (lane >> 3) + 8 * j; const LAS float* s = scr + (8 * c) * 33 + n;
        u32x2 o; o.x = pk4_f8(s[0 * 33], s[1 * 33], s[2 * 33], s[3 * 33]); o.y = pk4_f8(s[4 * 33], s[5 * 33], s[6 * 33], s[7 * 33]);
        *(GAS u32x2*)(WT + (size_t)(n0 + n) * K + k0 + 8 * c) = o; }
    LDS_WAIT(); asm volatile("" ::: "memory");
}
__device__ __forceinline__ void rms_row_to_bf16(int lane, const float* xrow, const float* g, bf16_t* orow) {
    const GAS f32x4* xr = (const GAS f32x4*)xrow + lane; const GAS f32x4* gr = (const GAS f32x4*)g + lane;
    f32x4 v[4]; float s = 0.f;
#pragma unroll
    for (int j = 0; j < 4; ++j) { v[j] = xr[64 * j]; s += (v[j].x * v[j].x + v[j].y * v[j].y) + (v[j].z * v[j].z + v[j].w * v[j].w); }
    const float rstd = 1.0f / sqrtf(wave_sum(s) * (1.f / DM) + EPS);
    GAS u32x2* o8 = (GAS u32x2*)orow + lane;
#pragma unroll
    for (int j = 0; j < 4; ++j) { const f32x4 gg = gr[64 * j]; u32x2 o; o.x = pk2(v[j].x * rstd * gg.x, v[j].y * rstd * gg.y); o.y = pk2(v[j].z * rstd * gg.z, v[j].w * rstd * gg.w); o8[64 * j] = o; }
}

__device__ __forceinline__ void rms_rows4_to_bf16(int lane, const float* x, const float* g, bf16_t* o, size_t m0, size_t stride, unsigned char* o8f = nullptr) {
    f32x4 v[4][4]; float s[4];
#pragma unroll
    for (int r = 0; r < 4; ++r) { const GAS f32x4* xr = (const GAS f32x4*)(x + (m0 + r * stride) * DM) + lane;
#pragma unroll
        for (int j = 0; j < 4; ++j) v[r][j] = xr[64 * j]; }
    const GAS f32x4* gr = (const GAS f32x4*)g + lane;
    f32x4 gg[4];
#pragma unroll
    for (int j = 0; j < 4; ++j) gg[j] = gr[64 * j];
#pragma unroll
    for (int r = 0; r < 4; ++r) { float a = 0.f;
#pragma unroll
        for (int j = 0; j < 4; ++j) a += (v[r][j].x * v[r][j].x + v[r][j].y * v[r][j].y) + (v[r][j].z * v[r][j].z + v[r][j].w * v[r][j].w);
        s[r] = a; }
#pragma unroll
    for (int of = 1; of < 64; of <<= 1) {
#pragma unroll
        for (int r = 0; r < 4; ++r) s[r] += __shfl_xor(s[r], of); }
#pragma unroll
    for (int r = 0; r < 4; ++r) { const float rstd = 1.0f / sqrtf(s[r] * (1.f / DM) + EPS);
        GAS u32x2* o8 = (GAS u32x2*)(o + (m0 + r * stride) * DM) + lane;
#pragma unroll
        for (int j = 0; j < 4; ++j) { const float a0 = v[r][j].x * rstd * gg[j].x, a1 = v[r][j].y * rstd * gg[j].y, a2 = v[r][j].z * rstd * gg[j].z, a3 = v[r][j].w * rstd * gg[j].w;
            u32x2 w; w.x = pk2(a0, a1); w.y = pk2(a2, a3); o8[64 * j] = w;
            if (o8f) *((GAS unsigned*)(o8f + (m0 + r * stride) * DM) + lane + 64 * j) = pk4_f8(a0, a1, a2, a3); } }
}
__device__ __forceinline__ void p0_prologue(Frame& F) {
    LAS float* scr = (LAS float*)(F.lds + F.wave * 16384);
    const int gw = F.blk * NWAVES + F.wave, NGW = F.G * NWAVES, lane = F.lane;
    unsigned char* ws = F.ws;
    constexpr int I_IN = 16 * 96, I_MKV = 16 * 32, I_G = 16 * 32, I_B = 8 * 32, I_O = 16 * 32, I_EI = 16 * 64, I_EO = 16 * 32;
    constexpr int NITEMS = I_IN + I_MKV + 3 * I_G + 3 * I_B + I_O + NEXP * I_EI + NEXP * I_EO;
    for (int it = gw; it < NITEMS; it += NGW) {
        int r = it;
        if (r < I_IN) { transpose_item(F.in[3], DM, IN_W, PW, (bf16_t*)(ws + WS_WIN), 1, scr, r, lane); continue; } r -= I_IN;
        if (r < I_MKV) { transpose_item(F.in[9], DM, DM, DM, (bf16_t*)(ws + WS_WMKV), 0, scr, r, lane); continue; } r -= I_MKV;
        if (r < 3 * I_G) { const int n = r / I_G; transpose_item_f8(F.in[10] + (size_t)n * DM * DM, DM, DM, DM, ws + WS_WG + (size_t)n * DM * DM, 0, W8_SCALE, scr, r % I_G, lane); continue; } r -= 3 * I_G;
        if (r < 3 * I_B) { const int n = r / I_B; transpose_item(F.in[12] + (size_t)n * 512 * DM, 512, DM, DM, (bf16_t*)(ws + WS_WB) + (size_t)n * DM * 512, 0, scr, r % I_B, lane); continue; } r -= 3 * I_B;
        if (r < I_O) { transpose_item(F.in[13], DM, DM, DM, (bf16_t*)(ws + WS_WO), 0, scr, r, lane); continue; } r -= I_O;
        if (r < NEXP * I_EI) { const int e = r / I_EI; transpose_item_f8(F.in[17] + (size_t)e * DM * 2048, DM, 2048, 2048, ws + WS_WEI + (size_t)e * 2048 * DM, 2, W8_SCALE, scr, r % I_EI, lane); continue; } r -= NEXP * I_EI;
        { const int e = r / I_EO; transpose_item_f8(F.in[19] + (size_t)e * DM * DM, DM, DM, DM, ws + WS_WEO + (size_t)e * DM * DM, 0, W8_SCALE, scr, r % I_EO, lane); }
    }
    { f32x2* tab = (f32x2*)(ws + WS_ROPE);
      for (int idx = (F.blk * NWAVES * 64) + F.tid; idx < SEQ * 32; idx += F.G * NWAVES * 64) {
          const int s = idx >> 5, i = idx & 31;
          const float inv = exp2f(-(float)i * (13.287712379549449f / 32.0f));
          const float ang = (float)s * inv;
          const double rev = (double)ang * 0.15915494309189535;
          const float fr = (float)(rev - __builtin_rint(rev));
          tab[idx] = (f32x2){__builtin_amdgcn_cosf(fr), __builtin_amdgcn_sinf(fr)}; } }
    for (int m = gw; m < NTOK; m += 4 * NGW) rms_rows4_to_bf16(lane, F.in[0], F.in[2], (bf16_t*)(ws + WS_H), (size_t)m, (size_t)NGW, ws + WS_H8);
    for (int m = gw; m < NMEM; m += 4 * NGW) rms_rows4_to_bf16(lane, F.in[1], F.in[8], (bf16_t*)(ws + WS_MEMN), (size_t)m, (size_t)NGW);
    { int* st = (int*)(ws + WS_SLOT_TOK);
      for (int i = F.blk * NWAVES * 64 + F.tid; i < NSLOT_PAD; i += F.G * NWAVES * 64) st[i] = 0; }
}

template <int CTRL> __device__ __forceinline__ float dppf(float v) { return __builtin_bit_cast(float, __builtin_amdgcn_update_dpp(0, __builtin_bit_cast(int, v), CTRL, 0xF, 0xF, false)); }
__device__ __forceinline__ float lx1(float v) { return dppf<0xB1>(v); }
__device__ __forceinline__ float lx2(float v) { return dppf<0x4E>(v); }
__device__ __forceinline__ float lx4(float v) { return dppf<0x1B>(dppf<0x141>(v)); }
__device__ __forceinline__ float lx8(float v) { return dppf<0x128>(v); }
__device__ __forceinline__ void un8(const u32x4 w, float (&v)[8]) { v[0] = bflo(w.x); v[1] = bfhi(w.x); v[2] = bflo(w.y); v[3] = bfhi(w.y); v[4] = bflo(w.z); v[5] = bfhi(w.z); v[6] = bflo(w.w); v[7] = bfhi(w.w); }
__device__ __forceinline__ u32x4 pk8(const float (&v)[8]) { u32x4 w; w.x = pk2(v[0], v[1]); w.y = pk2(v[2], v[3]); w.z = pk2(v[4], v[5]); w.w = pk2(v[6], v[7]); return w; }
__device__ __forceinline__ void rope8(float (&v)[8], const f32x2 (&cs)[8], bool up) {
#pragma unroll
    for (int j = 0; j < 8; ++j) { const float other = lx4(v[j]); v[j] = up ? (other * cs[j].y + v[j] * cs[j].x) : (v[j] * cs[j].x - other * cs[j].y); }
}
__device__ __forceinline__ void p2_prep(Frame& F, const bool dummy = false) {
    const int gw = F.blk * NWAVES + F.wave, NGW = F.G * NWAVES, lane = F.lane;
    bf16_t* proj = (bf16_t*)(F.ws + WS_P);
    bf16_t* projw = dummy ? (bf16_t*)(F.ws + WS_END) : proj;
    const int wmask = dummy ? 8191 : 0x7fffffff;
    const f32x2* tab = (const f32x2*)(F.ws + WS_ROPE);
    float gqd[8], gkd[8], gqm[8];
#pragma unroll
    for (int j = 0; j < 8; ++j) { gqd[j] = F.in[4][8 * (lane & 7) + j] * (0.125f * LOG2E); gkd[j] = F.in[5][8 * (lane & 7) + j]; gqm[j] = F.in[6][8 * (lane & 15) + j] * (0.08838834764831845f * LOG2E); }
    const bool up = (lane & 4) != 0; const int i0 = (lane & 3) * 8;
    for (int m0 = gw; m0 < NTOK; m0 += 2 * NGW) {
        u32x4 raw[2][5]; f32x2 cs[2][8];
#pragma unroll
        for (int t = 0; t < 2; ++t) { const GAS bf16_t* row = (const GAS bf16_t*)proj + (size_t)(m0 + t * NGW) * PW;
            raw[t][0] = *(const GAS u32x4*)(row + C_DQ + 8 * lane); raw[t][1] = *(const GAS u32x4*)(row + C_DK + 8 * (lane & 7)); raw[t][2] = *(const GAS u32x4*)(row + C_IQ + 8 * (lane & 31));
            raw[t][3] = *(const GAS u32x4*)(row + C_IK + 8 * (lane & 7)); raw[t][4] = *(const GAS u32x4*)(row + C_MQ + 8 * lane);
            const GAS f32x2* tr = (const GAS f32x2*)tab + (size_t)((m0 + t * NGW) & (SEQ - 1)) * 32 + i0;
#pragma unroll
            for (int j = 0; j < 8; ++j) cs[t][j] = tr[j]; }
#pragma unroll
        for (int t = 0; t < 2; ++t) {
            GAS bf16_t* roww = (GAS bf16_t*)projw + (size_t)((m0 + t * NGW) & wmask) * PW;
            float v[8];
            { un8(raw[t][0], v); float ss = 0.f;
#pragma unroll
              for (int j = 0; j < 8; ++j) ss += v[j] * v[j];
              ss += lx1(ss); ss += lx2(ss); ss += lx4(ss);
              const float rstd = 1.0f / sqrtf(ss * (1.f / 64.f) + EPS);
#pragma unroll
              for (int j = 0; j < 8; ++j) v[j] = v[j] * rstd * gqd[j];
              rope8(v, cs[t], up);
              *(GAS u32x4*)(roww + C_DQ + 8 * lane) = pk8(v); }
            { un8(raw[t][1], v); float ss = 0.f;
#pragma unroll
              for (int j = 0; j < 8; ++j) ss += v[j] * v[j];
              ss += lx1(ss); ss += lx2(ss); ss += lx4(ss);
              const float rstd = 1.0f / sqrtf(ss * (1.f / 64.f) + EPS);
#pragma unroll
              for (int j = 0; j < 8; ++j) v[j] = v[j] * rstd * gkd[j];
              rope8(v, cs[t], up);
              if (lane < 8) *(GAS u32x4*)(roww + C_DK + 8 * lane) = pk8(v); }
            { un8(raw[t][2], v); rope8(v, cs[t], up); if (lane < 32) *(GAS u32x4*)(roww + C_IQ + 8 * lane) = pk8(v); }
            { un8(raw[t][3], v); rope8(v, cs[t], up); if (lane < 8) *(GAS u32x4*)(roww + C_IK + 8 * lane) = pk8(v); }
            { un8(raw[t][4], v); float ss = 0.f;
#pragma unroll
              for (int j = 0; j < 8; ++j) ss += v[j] * v[j];
              ss += lx1(ss); ss += lx2(ss); ss += lx4(ss); ss += lx8(ss);
              const float rstd = 1.0f / sqrtf(ss * (1.f / 128.f) + EPS);
#pragma unroll
              for (int j = 0; j < 8; ++j) v[j] = v[j] * rstd * gqm[j];
              *(GAS u32x4*)(roww + C_MQ + 8 * lane) = pk8(v); }
        }
    }
    bf16_t* mkv = (bf16_t*)(F.ws + WS_MKV);
    if (!dummy) for (int m = gw; m < NMEM; m += NGW) {
        GAS bf16_t* row = (GAS bf16_t*)mkv + (size_t)m * DM; float v[8];
        un8(*(const GAS u32x4*)(row + 8 * lane), v); float ss = 0.f;
#pragma unroll
        for (int j = 0; j < 8; ++j) ss += v[j] * v[j];
        ss += lx1(ss); ss += lx2(ss); ss += lx4(ss); ss += lx8(ss);
        const float rstd = 1.0f / sqrtf(ss * (1.f / 128.f) + EPS);
#pragma unroll
        for (int j = 0; j < 8; ++j) v[j] = v[j] * rstd * F.in[7][8 * (lane & 15) + j];
        *(GAS u32x4*)(row + 8 * lane) = pk8(v);
    }
}

#define MFMA32(a, b, c) __builtin_amdgcn_mfma_f32_32x32x16_bf16((a), (b), (c), 0, 0, 0)
typedef LAS const unsigned char* lds_cptr;
__device__ __forceinline__ s16x4 vtr(lds_cptr p) { return __builtin_bit_cast(s16x4, __builtin_amdgcn_ds_read_tr16_b64_v4i16((LAS v4i16_t*)p)); }
__device__ __forceinline__ bf16x8 vfrag(lds_cptr vbase_lane, int off) {
    const s16x4 lo = vtr(vbase_lane + off), hi = vtr(vbase_lane + off + 512);
    return (bf16x8){lo[0], lo[1], lo[2], lo[3], hi[0], hi[1], hi[2], hi[3]};
}
__device__ __forceinline__ int vtr_lane_off(int lane) { return ((lane >> 4) & 1) * 32 + (lane & 3) * 8 + (4 * (lane >> 5) + ((lane & 15) >> 2)) * 64; }
__device__ __forceinline__ bf16x8 pack8(const float* p) {
    u32x4 w; w.x = cvt_pk_bf16(p[0], p[1]); w.y = cvt_pk_bf16(p[2], p[3]); w.z = cvt_pk_bf16(p[4], p[5]); w.w = cvt_pk_bf16(p[6], p[7]);
    return __builtin_bit_cast(bf16x8, w);
}
__device__ __forceinline__ float softplus_f(float z) { return fmaxf(z, 0.f) + __logf(1.f + __expf(-fabsf(z))); }

__device__ __forceinline__ void sb_item(const bf16_t* proj, bf16_t* osb, int b, int h, int qblk, LAS unsigned char* vlds, int lane) {
    const int r32 = lane & 31, hi = lane >> 5;
    const size_t tok0 = (size_t)b * SEQ + (size_t)qblk * 32;
    bf16x8 qr[4];
    { const bf16_t* qp = proj + (tok0 + r32) * PW + C_SQ + h * 64 + hi * 8;
#pragma unroll
      for (int kk = 0; kk < 4; ++kk) qr[kk] = *(const bf16x8*)(qp + kk * 16); }
    f32x16 o0 = {}, o1 = {}; float R = 0.f;
    const lds_cptr vrd = (lds_cptr)vlds + vtr_lane_off(lane);
    bf16x8 kfn[4]; u32x4 vvn[4];
#define SB_LOAD(kt_) do { const size_t key0_ = (size_t)b * SEQ + (size_t)(kt_) * 32; const GAS bf16_t* kp_ = (const GAS bf16_t*)proj + (key0_ + r32) * PW + C_SK + h * 64 + hi * 8; \
        _Pragma("unroll") for (int kk = 0; kk < 4; ++kk) kfn[kk] = *(const GAS bf16x8*)(kp_ + kk * 16); \
        _Pragma("unroll") for (int p = 0; p < 4; ++p) vvn[p] = *(const GAS u32x4*)((const GAS bf16_t*)proj + (key0_ + 16 * (p & 1) + (lane >> 2)) * PW + C_SV + h * 64 + (p >> 1) * 32 + (lane & 3) * 8); } while (0)
    SB_LOAD(qblk);
    for (int kt = qblk; kt >= 0; --kt) {
        bf16x8 kf[4]; u32x4 vv[4];
#pragma unroll
        for (int i = 0; i < 4; ++i) { kf[i] = kfn[i]; vv[i] = vvn[i]; }
        if (kt > 0) SB_LOAD(kt - 1);
        f32x16 s = {};
#pragma unroll
        for (int kk = 0; kk < 4; ++kk) s = MFMA32(kf[kk], qr[kk], s);
        asm volatile("" ::: "memory");
#pragma unroll
        for (int p = 0; p < 4; ++p) *(LAS u32x4*)(vlds + p * 1024 + lane * 16) = vv[p];
        const bool diag = (kt == qblk);
        float sp[16], pr[16];
#pragma unroll
        for (int r = 0; r < 16; ++r) { const bool valid = !diag || (crow(r, hi) < r32); sp[r] = valid ? softplus_f(s[r]) : 0.f; }
        float T[4], U[4];
#pragma unroll
        for (int g = 0; g < 4; ++g) { T[g] = (sp[4 * g] + sp[4 * g + 1]) + (sp[4 * g + 2] + sp[4 * g + 3]); { const auto rr = __builtin_amdgcn_permlane32_swap(__float_as_uint(T[g]), __float_as_uint(T[g]), false, false); U[g] = hi ? __uint_as_float(rr[0]) : __uint_as_float(rr[1]); } }
        float run = 0.f, above[4];
#pragma unroll
        for (int g = 3; g >= 0; --g) { above[g] = run + (hi == 0 ? U[g] : 0.f); run += T[g] + U[g]; }
#pragma unroll
        for (int g = 0; g < 4; ++g) { float c = R + above[g];
#pragma unroll
            for (int j = 3; j >= 0; --j) { const int r = 4 * g + j; c += sp[r]; const bool valid = !diag || (crow(r, hi) < r32); pr[r] = valid ? __expf(s[r] - c) : 0.f; } }
        R += run;
        const bf16x8 p0 = pack8(pr), p1 = pack8(pr + 8);
        LDS_WAIT();
        const bf16x8 v00 = vfrag(vrd, 0), v01 = vfrag(vrd, 1024), v10 = vfrag(vrd, 2048), v11 = vfrag(vrd, 3072);
        o0 = MFMA32(v00, p0, o0); o0 = MFMA32(v01, p1, o0);
        o1 = MFMA32(v10, p0, o1); o1 = MFMA32(v11, p1, o1);
        asm volatile("" ::: "memory");
        if (__all(R > 30.0f)) break;
    }
#undef SB_LOAD
    bf16_t* op = osb + (tok0 + r32) * 512 + h * 64 + 4 * hi;
#pragma unroll
    for (int g = 0; g < 4; ++g) {
        u32x2 w0, w1; w0.x = cvt_pk_bf16(o0[4 * g], o0[4 * g + 1]); w0.y = cvt_pk_bf16(o0[4 * g + 2], o0[4 * g + 3]); w1.x = cvt_pk_bf16(o1[4 * g], o1[4 * g + 1]); w1.y = cvt_pk_bf16(o1[4 * g + 2], o1[4 * g + 3]);
        *(u32x2*)(op + 8 * g) = w0; *(u32x2*)(op + 32 + 8 * g) = w1; }
}

constexpr int ML_K = 0, ML_KROW = 272, ML_V = 256 * ML_KROW, ML_END = ML_V + 65536;
__device__ __forceinline__ void mem_unit(const bf16_t* proj, const bf16_t* mkv, bf16_t* omem, int b, int h, int half, LAS unsigned char* ml, int tid) {
    const int lane = tid & 63, wid = __builtin_amdgcn_readfirstlane(tid >> 6), r32 = lane & 31, hi = lane >> 5;
    { const GAS bf16_t* src = (const GAS bf16_t*)mkv + (size_t)b * MEMLEN * DM + h * 128;
#pragma unroll
      for (int i = 0; i < 8; ++i) { const int ch = tid + 512 * i, key = ch >> 4, c16 = ch & 15, kk = key & 31;
          const u32x4 kv = *(const GAS u32x4*)(src + (size_t)key * DM + c16 * 8);
          const u32x4 vv = *(const GAS u32x4*)(src + (size_t)key * DM + 512 + c16 * 8);
          *(LAS u32x4*)(ml + ML_K + key * ML_KROW + c16 * 16) = kv;
          *(LAS u32x4*)(ml + ML_V + (key >> 5) * 8192 + ((c16 >> 2) * 2 + (kk >> 4)) * 1024 + (kk & 15) * 64 + (c16 & 3) * 16) = vv; } }
    __syncthreads();
    for (int i = 0; i < 4; ++i) {
        const int qblk = half * 32 + wid * 4 + i;
        const size_t tok0 = (size_t)b * SEQ + (size_t)qblk * 32;
        bf16x8 qr[8];
        { const GAS bf16_t* qp = (const GAS bf16_t*)proj + (tok0 + r32) * PW + C_MQ + h * 128 + hi * 8;
#pragma unroll
          for (int kk = 0; kk < 8; ++kk) qr[kk] = *(const GAS bf16x8*)(qp + kk * 16); }
        f32x16 o[4] = {{}, {}, {}, {}}; float m = -1e30f, l = 0.f;
        for (int kb = 0; kb < 8; ++kb) {
            const LAS unsigned char* krd = ml + ML_K + (32 * kb + r32) * ML_KROW + hi * 16;
            f32x16 s = {};
#pragma unroll
            for (int kk = 0; kk < 8; ++kk) { const bf16x8 kf = *(const LAS bf16x8*)(krd + kk * 32); s = MFMA32(kf, qr[kk], s); }
            float mx = s[0];
#pragma unroll
            for (int r = 1; r < 16; ++r) mx = fmaxf(mx, s[r]);
            { const auto rr = __builtin_amdgcn_permlane32_swap(__float_as_uint(mx), __float_as_uint(mx), false, false); mx = fmaxf(__uint_as_float(rr[0]), __uint_as_float(rr[1])); }
            if (__any(mx > m + 8.0f)) {
                const float mn = fmaxf(m, mx), alpha = __builtin_amdgcn_exp2f(m - mn);
                l *= alpha; m = mn;
#pragma unroll
                for (int d = 0; d < 4; ++d)
#pragma unroll
                    for (int r = 0; r < 16; ++r) o[d][r] *= alpha;
            }
            float pr[16], rs = 0.f;
#pragma unroll
            for (int r = 0; r < 16; ++r) { pr[r] = __builtin_amdgcn_exp2f(s[r] - m); rs += pr[r]; }
            l += rs;
            const bf16x8 p0 = pack8(pr), p1 = pack8(pr + 8);
            const lds_cptr vrd = (lds_cptr)ml + ML_V + kb * 8192 + vtr_lane_off(lane);
#pragma unroll
            for (int d = 0; d < 4; ++d) { const bf16x8 va = vfrag(vrd, d * 2048), vb = vfrag(vrd, d * 2048 + 1024); o[d] = MFMA32(va, p0, o[d]); o[d] = MFMA32(vb, p1, o[d]); }
        }
        { const auto rr = __builtin_amdgcn_permlane32_swap(__float_as_uint(l), __float_as_uint(l), false, false); l = __uint_as_float(rr[0]) + __uint_as_float(rr[1]); }
        const float il = 1.0f / l;
        bf16_t* op = omem + (tok0 + r32) * 512 + h * 128 + 4 * hi;
#pragma unroll
        for (int d = 0; d < 4; ++d)
#pragma unroll
            for (int g = 0; g < 4; ++g) { u32x2 w; w.x = cvt_pk_bf16(o[d][4 * g] * il, o[d][4 * g + 1] * il); w.y = cvt_pk_bf16(o[d][4 * g + 2] * il, o[d][4 * g + 3] * il); *(u32x2*)(op + 32 * d + 8 * g) = w; }
    }
    __syncthreads();
}

constexpr int DL_HIST = 0, DL_PREFIX = 66048, DL_KREM = DL_PREFIX + 256, DL_MASK = 67072, DL_VT = 73728, DL_KT = DL_VT + 2 * 16384, DL_END = DL_KT + 2 * 18432, DL_IQ = DL_VT;
constexpr int TOPK_DSA = 256;

struct IqLds { const LAS unsigned char* p; __device__ __forceinline__ bf16x8 operator()(int j) const { return *(const LAS bf16x8*)(p + j * 32); } };
template <class QF>
__device__ __forceinline__ void idx_scores(const QF& qf, const bf16x8 (&kf)[4], const float (&wq)[4], unsigned (&uk)[16]) {
    float scv[16];
#pragma unroll
    for (int hd = 0; hd < 4; ++hd) { f32x16 a = (f32x16){};
#pragma unroll
        for (int kk = 0; kk < 4; ++kk) a = MFMA32(kf[kk], qf(hd * 4 + kk), a);
#pragma unroll
        for (int r = 0; r < 16; ++r) scv[r] = (hd == 0) ? wq[0] * fmaxf(a[r], 0.f) : __builtin_fmaf(wq[hd], fmaxf(a[r], 0.f), scv[r]); }
#pragma unroll
    for (int r = 0; r < 16; ++r) {
        unsigned bits = __builtin_bit_cast(unsigned, scv[r]);
        if (bits == 0x80000000u) bits = 0u;
        uk[r] = bits ^ ((unsigned)((int)bits >> 31) | 0x80000000u);
    }
}
__device__ __forceinline__ void load_ik(const bf16_t* proj, size_t tokb, int kbase, int r32, int hi, bf16x8 (&kf)[4]) {
    int kr = kbase + r32; if (kr > SEQ - 1) kr = SEQ - 1;
    const GAS bf16_t* p = (const GAS bf16_t*)proj + (tokb + kr) * PW + C_IK + 8 * hi;
#pragma unroll
    for (int kk = 0; kk < 4; ++kk) kf[kk] = *(const GAS bf16x8*)(p + kk * 16);
}

__device__ __forceinline__ void dsa_unit(const bf16_t* proj, bf16_t* odsa, unsigned* kscr  , int b, int c, LAS unsigned char* dl, int tid) {
    const int lane = tid & 63, wid = __builtin_amdgcn_readfirstlane(tid >> 6), r32 = lane & 31, hi = lane >> 5;
    const int n = 64 * (c + 1), nsteps = (n + 127) >> 7;
    const size_t tokq0 = (size_t)b * SEQ + (size_t)c * 64, tokb = (size_t)b * SEQ;
    LAS unsigned* hist = (LAS unsigned*)(dl + DL_HIST);
    LAS unsigned* prefix = (LAS unsigned*)(dl + DL_PREFIX);
    LAS unsigned* krem = (LAS unsigned*)(dl + DL_KREM);
    LAS unsigned* mask = (LAS unsigned*)(dl + DL_MASK);
    const int kb = wid >> 1, qh = wid & 1;
    { const int row = tid >> 3, c = tid & 7;
      const GAS bf16_t* src = (const GAS bf16_t*)proj + (tokq0 + row) * PW + C_IQ + c * 32;
#pragma unroll
      for (int i = 0; i < 4; ++i) *(LAS u32x4*)(dl + DL_IQ + row * 528 + c * 64 + i * 16) = *(const GAS u32x4*)(src + i * 8); }
    const IqLds iqf{dl + DL_IQ + (32 * qh + r32) * 528 + hi * 16};
    float wq[4];
    { const u32x2 w = *(const u32x2*)(proj + (tokq0 + 32 * qh + r32) * PW + C_IW);
      wq[0] = bflo(w.x) * 0.0625f; wq[1] = bfhi(w.x) * 0.0625f; wq[2] = bflo(w.y) * 0.0625f; wq[3] = bfhi(w.y) * 0.0625f; }
#ifndef REP_SEL
#define REP_SEL 1
#endif
#ifndef REP_B2
#define REP_B2 1
#endif
    LAS unsigned* selall = (LAS unsigned*)(dl + DL_HIST);
#ifndef PROBE_NOATOM
#define PROBE_NOATOM 0
#endif
    unsigned dummy = 0u;
    for (int rep_sel = 0; rep_sel < REP_SEL; ++rep_sel) {
    if (tid < 64) { prefix[tid] = 0u; krem[tid] = (n > TOPK_DSA) ? (unsigned)TOPK_DSA : 0x7fffffffu; }
    __syncthreads();
    const int pass0 = (n > TOPK_DSA) ? 0 : 3;
    GAS u32x4* kmine = (GAS u32x4*)kscr + ((size_t)wid * 64 + lane) * 4;
#define DSA_CONSUME(uk_) do { \
        if (sel) { _Pragma("unroll") for (int r = 0; r < 16; ++r) { const bool match = (pass == 0) || (((uk_)[r] >> (shift + 8)) == pfx); \
                if (match && !(PROBE_NOATOM && rep_sel + 1 < REP_SEL)) __hip_atomic_fetch_add(hist + (32 * qh + r32) * 257 + (((uk_)[r] >> shift) & 255u), 1u, __ATOMIC_RELAXED, __HIP_MEMORY_SCOPE_WORKGROUP); else dummy ^= (uk_)[r]; } } \
        else { _Pragma("unroll") for (int r = 0; r < 16; ++r) { const unsigned k24 = (uk_)[r] >> 8; gtw |= (k24 > pfx ? 1u : 0u) << crow(r, hi); eqw |= (k24 == pfx ? 1u : 0u) << crow(r, hi); } } } while (0)
#define DSA_TIES() do { if (!sel) { \
        LAS unsigned* mk = mask + (step & 1) * 768; \
        { const auto rg = __builtin_amdgcn_permlane32_swap(gtw, gtw, false, false); gtw = rg[0] | rg[1]; const auto re = __builtin_amdgcn_permlane32_swap(eqw, eqw, false, false); eqw = re[0] | re[1]; } \
        if (hi == 0) { mk[(32 * qh + r32) * 4 + kb] = gtw; mk[256 + (32 * qh + r32) * 4 + kb] = eqw; } \
        __syncthreads(); \
        if (wid == 0) { unsigned nd = krem[lane]; \
            _Pragma("unroll") for (int k4 = 0; k4 < 4; ++k4) { const unsigned g = mk[lane * 4 + k4]; unsigned e = mk[256 + lane * 4 + k4]; unsigned sl = g; \
                if (e != 0u) { const unsigned cnt = (unsigned)__builtin_popcount(e); \
                    if (cnt <= nd) { sl |= e; nd -= cnt; } \
                    else { unsigned chosen = 0u; while (nd > 0u) { const unsigned lb = e & (0u - e); chosen |= lb; e ^= lb; --nd; } sl |= chosen; } } \
                selall[lane * 64 + step * 4 + k4] = sl; } \
            krem[lane] = nd; } } } while (0)
    for (int pass = pass0; pass < ((rep_sel + 1 < REP_SEL) ? 3 : 4); ++pass) {
        const bool sel = pass < 3;
        if (sel) { for (int i = tid; i < 64 * 257; i += 512) hist[i] = 0u; __syncthreads(); }
        const int shift = 24 - 8 * pass;
        const unsigned pfx = prefix[32 * qh + r32];
        if (pass == pass0) {
            bf16x8 kfn[4]; load_ik(proj, tokb, 32 * kb, r32, hi, kfn);
            for (int step = 0; step < nsteps; ++step) {
                const int kbase = 128 * step + 32 * kb;
                bf16x8 kf[4];
#pragma unroll
                for (int kk = 0; kk < 4; ++kk) kf[kk] = kfn[kk];
                if (step + 1 < nsteps) load_ik(proj, tokb, kbase + 128, r32, hi, kfn);
                unsigned gtw = 0u, eqw = 0u;
                if (kbase < n) {
                    unsigned uk[16];
                    idx_scores(iqf, kf, wq, uk);
                    if (pass0 == 0) {
#pragma unroll
                        for (int g = 0; g < 4; ++g) kmine[(size_t)step * 2048 + g] = (u32x4){uk[4 * g], uk[4 * g + 1], uk[4 * g + 2], uk[4 * g + 3]};
                    }
                    DSA_CONSUME(uk);
                }
                DSA_TIES();
            }
        } else {
            u32x4 ka[4], kb4[4];
#define DSA_KLOAD(dst, st_) do { _Pragma("unroll") for (int g = 0; g < 4; ++g) dst[g] = kmine[(size_t)(st_) * 2048 + g]; } while (0)
            DSA_KLOAD(ka, 0);
            if (nsteps > 1 && 128 + 32 * kb < n) DSA_KLOAD(kb4, 1);
            for (int step = 0; step < nsteps; ++step) {
                const int kbase = 128 * step + 32 * kb;
                unsigned uk[16];
#pragma unroll
                for (int g = 0; g < 4; ++g) { uk[4 * g] = ka[g].x; uk[4 * g + 1] = ka[g].y; uk[4 * g + 2] = ka[g].z; uk[4 * g + 3] = ka[g].w; }
#pragma unroll
                for (int g = 0; g < 4; ++g) ka[g] = kb4[g];
                if (step + 2 < nsteps && kbase + 256 < n) DSA_KLOAD(kb4, step + 2);
                unsigned gtw = 0u, eqw = 0u;
                if (kbase < n) DSA_CONSUME(uk);
                DSA_TIES();
            }
#undef DSA_KLOAD
        }
        if (sel) {
            __syncthreads();
#pragma unroll
            for (int qi = 0; qi < 8; ++qi) {
                const int q = 8 * wid + qi;
                const LAS unsigned* hq = hist + q * 257;
                const unsigned c0 = hq[255 - 4 * lane], c1 = hq[254 - 4 * lane], c2 = hq[253 - 4 * lane], c3 = hq[252 - 4 * lane];
                const unsigned s4 = c0 + c1 + c2 + c3;
                unsigned incl = s4;
#pragma unroll
                for (int o = 1; o < 64; o <<= 1) { const unsigned t = __shfl_up(incl, o); if (lane >= o) incl += t; }
                const unsigned excl = incl - s4, kr = krem[q];
                if (excl < kr && kr <= incl) {
                    unsigned cum = excl, bin, nk;
                    if (cum + c0 >= kr) { bin = 255 - 4 * lane; nk = kr - cum; }
                    else { cum += c0; if (cum + c1 >= kr) { bin = 254 - 4 * lane; nk = kr - cum; }
                    else { cum += c1; if (cum + c2 >= kr) { bin = 253 - 4 * lane; nk = kr - cum; }
                    else { cum += c2; bin = 252 - 4 * lane; nk = kr - cum; } } }
                    prefix[q] = (prefix[q] << 8) | bin; krem[q] = nk;
                }
            }
            __syncthreads();
        }
    }
    }
    if (dummy == 0x9e3779b9u) hist[tid] = 1u;
    const int hd = wid;
    u32x4 pk[2], pv[2];
#define DSA_LOADKV(step_) do { _Pragma("unroll") for (int i_ = 0; i_ < 2; ++i_) { const int ch_ = tid + 512 * i_; int krow_ = 128 * (step_) + (ch_ >> 3); if (krow_ > SEQ - 1) krow_ = SEQ - 1; \
        const GAS bf16_t* rp_ = (const GAS bf16_t*)proj + (tokb + krow_) * PW + (ch_ & 7) * 8; pk[i_] = *(const GAS u32x4*)(rp_ + C_DK); pv[i_] = *(const GAS u32x4*)(rp_ + C_DV); } } while (0)
#define DSA_STOREKV(buf_) do { _Pragma("unroll") for (int i_ = 0; i_ < 2; ++i_) { const int ch_ = tid + 512 * i_, key_ = ch_ >> 3, c8_ = ch_ & 7, kk_ = key_ & 31; \
        *(LAS u32x4*)(dl + DL_KT + (buf_) * 18432 + key_ * 144 + c8_ * 16) = pk[i_]; \
        *(LAS u32x4*)(dl + DL_VT + (buf_) * 16384 + (key_ >> 5) * 4096 + ((c8_ >> 2) * 2 + (kk_ >> 4)) * 1024 + (kk_ & 15) * 64 + (c8_ & 3) * 16) = pv[i_]; } } while (0)
    for (int rep_b2 = 0; rep_b2 < REP_B2; ++rep_b2)
    for (int qb = 0; qb < 2; ++qb) {
        bf16x8 qr[4];
        { const GAS bf16_t* qp = (const GAS bf16_t*)proj + (tokq0 + 32 * qb + r32) * PW + C_DQ + hd * 64 + 8 * hi;
#pragma unroll
          for (int kk = 0; kk < 4; ++kk) qr[kk] = *(const GAS bf16x8*)(qp + kk * 16); }
        f32x16 o0 = {}, o1 = {}; float mrun = -1e30f, lrun = 0.f;
        DSA_LOADKV(0);
        DSA_STOREKV(0);
        __syncthreads();
#define B2_QK(S_, k4_) do { const LAS unsigned char* krd_ = kt + (32 * (k4_) + r32) * 144 + hi * 16; S_ = (f32x16){}; \
        _Pragma("unroll") for (int kk = 0; kk < 4; ++kk) { const bf16x8 kf_ = *(const LAS bf16x8*)(krd_ + kk * 32); S_ = MFMA32(kf_, qr[kk], S_); } } while (0)
#define B2_SM_PV(S_, k4_) do { \
        const int selw_ = (int)selall[(32 * qb + r32) * 64 + step * 4 + (k4_)]; float mx_ = -INFINITY; \
        _Pragma("unroll") for (int r = 0; r < 16; ++r) { const unsigned m_ = (unsigned)__builtin_amdgcn_sbfe(selw_, crow(r, hi), 1); \
            S_[r] = __uint_as_float((__float_as_uint(S_[r]) & m_) | (0xFF800000u & ~m_)); mx_ = fmaxf(mx_, S_[r]); } \
        { const auto rr_ = __builtin_amdgcn_permlane32_swap(__float_as_uint(mx_), __float_as_uint(mx_), false, false); mx_ = fmaxf(__uint_as_float(rr_[0]), __uint_as_float(rr_[1])); } \
        if (__any(mx_ > mrun + 8.0f)) { const float mn_ = fmaxf(mrun, mx_), alpha_ = __builtin_amdgcn_exp2f(mrun - mn_); lrun *= alpha_; mrun = mn_; \
            _Pragma("unroll") for (int r = 0; r < 16; ++r) { o0[r] *= alpha_; o1[r] *= alpha_; } } \
        float pr_[16], rs_ = 0.f; \
        _Pragma("unroll") for (int r = 0; r < 16; ++r) { pr_[r] = __builtin_amdgcn_exp2f(S_[r] - mrun); rs_ += pr_[r]; } \
        lrun += rs_; \
        const bf16x8 pa_ = pack8(pr_), pb_ = pack8(pr_ + 8); \
        const lds_cptr vrd_ = (lds_cptr)vt + (k4_) * 4096 + vtr_lane_off(lane); \
        const bf16x8 v00_ = vfrag(vrd_, 0), v01_ = vfrag(vrd_, 1024), v10_ = vfrag(vrd_, 2048), v11_ = vfrag(vrd_, 3072); \
        o0 = MFMA32(v00_, pa_, o0); o0 = MFMA32(v01_, pb_, o0); o1 = MFMA32(v10_, pa_, o1); o1 = MFMA32(v11_, pb_, o1); } while (0)
        for (int step = 0; step < nsteps; ++step) {
            const int buf = step & 1;
            if (step + 1 < nsteps) DSA_LOADKV(step + 1);
            LAS unsigned char* kt = dl + DL_KT + buf * 18432;
            LAS unsigned char* vt = dl + DL_VT + buf * 16384;
            f32x16 sa, sb;
            B2_QK(sa, 0);
            B2_QK(sb, 1); B2_SM_PV(sa, 0); __builtin_amdgcn_sched_barrier(0);
            if (128 * step + 64 < n) {
                B2_QK(sa, 2); B2_SM_PV(sb, 1); __builtin_amdgcn_sched_barrier(0);
                B2_QK(sb, 3); B2_SM_PV(sa, 2); __builtin_amdgcn_sched_barrier(0);
                B2_SM_PV(sb, 3);
            } else {
                B2_SM_PV(sb, 1);
            }
            if (step + 1 < nsteps) DSA_STOREKV(buf ^ 1);
            __syncthreads();
        }
#undef B2_QK
#undef B2_SM_PV
        float l = lrun; { const auto rr = __builtin_amdgcn_permlane32_swap(__float_as_uint(l), __float_as_uint(l), false, false); l = __uint_as_float(rr[0]) + __uint_as_float(rr[1]); }
        const float il = 1.0f / l;
        bf16_t* op = odsa + (tokq0 + 32 * qb + r32) * 512 + hd * 64 + 4 * hi;
#pragma unroll
        for (int g = 0; g < 4; ++g) {
            u32x2 w0, w1; w0.x = cvt_pk_bf16(o0[4 * g] * il, o0[4 * g + 1] * il); w0.y = cvt_pk_bf16(o0[4 * g + 2] * il, o0[4 * g + 3] * il);
            w1.x = cvt_pk_bf16(o1[4 * g] * il, o1[4 * g + 1] * il); w1.y = cvt_pk_bf16(o1[4 * g + 2] * il, o1[4 * g + 3] * il);
            *(u32x2*)(op + 8 * g) = w0; *(u32x2*)(op + 32 + 8 * g) = w1; }
    }
#undef DSA_LOADKV
#undef DSA_STOREKV
#undef DSA_CONSUME
#undef DSA_TIES
    __syncthreads();
}

template <int CTRL> __device__ __forceinline__ float dpp_f(float v) { return __builtin_bit_cast(float, __builtin_amdgcn_update_dpp(0, __builtin_bit_cast(int, v), CTRL, 0xF, 0xF, false)); }
constexpr int RL_WROW = 2064, RL_WHI = 0, RL_WLO = 32 * RL_WROW, RL_TKE = 2 * 32 * RL_WROW, RL_TKW = RL_TKE + 4096;
__device__ __forceinline__ void p9_router(Frame& F) {
    const int lane = F.lane, wave = F.wave, tid = F.tid, r32 = lane & 31, hi = lane >> 5;
    LAS int* tke = (LAS int*)(F.lds + RL_TKE); LAS float* tkw = (LAS float*)(F.lds + RL_TKW);
    const float* w_router = F.in[15]; const float* b_router = F.in[16]; const float* g_ffn = F.in[14];
    for (int idx = tid; idx < DM * NEXP; idx += NWAVES * 64) { const int k = idx >> 5, e = idx & 31; const float w = w_router[idx];
        const unsigned wh = f2bf(w); const unsigned wl = f2bf(w - __builtin_bit_cast(float, wh << 16));
        *(LAS bf16_t*)(F.lds + RL_WHI + e * RL_WROW + k * 2) = (bf16_t)wh; *(LAS bf16_t*)(F.lds + RL_WLO + e * RL_WROW + k * 2) = (bf16_t)wl; }
    if (tid < 32) F.MISC[MW_LCNT + tid] = 0u;
    __syncthreads();
    bf16_t* h2 = (bf16_t*)(F.ws + WS_H); unsigned char* h2f8 = F.ws + WS_H2F8;
    const GAS f32x4* gr = (const GAS f32x4*)g_ffn + lane;
    f32x4 gg[4];
#pragma unroll
    for (int j = 0; j < 4; ++j) gg[j] = gr[64 * j];
    const size_t tok0 = (size_t)F.blk * 256 + 32 * wave;
    u32x2 xnext[2][4];
#pragma unroll
    for (int tk = 0; tk < 2; ++tk) { const GAS u32x2* xr = (const GAS u32x2*)((const GAS bf16_t*)F.out + (tok0 + tk) * 2048 + ((tok0 + tk) & 1) * 1024) + lane;
#pragma unroll
        for (int j = 0; j < 4; ++j) xnext[tk][j] = xr[64 * j]; }
    for (int it = 0; it < 16; ++it) {
        f32x4 hn[2][4];
#pragma unroll
        for (int tk = 0; tk < 2; ++tk)
#pragma unroll
            for (int j = 0; j < 4; ++j) hn[tk][j] = (f32x4){bflo(xnext[tk][j].x), bfhi(xnext[tk][j].x), bflo(xnext[tk][j].y), bfhi(xnext[tk][j].y)};
        if (it + 1 < 16) {
#pragma unroll
            for (int tk = 0; tk < 2; ++tk) { const GAS u32x2* xr = (const GAS u32x2*)((const GAS bf16_t*)F.out + (tok0 + 2 * it + 2 + tk) * 2048 + ((tok0 + 2 * it + 2 + tk) & 1) * 1024) + lane;
#pragma unroll
                for (int j = 0; j < 4; ++j) xnext[tk][j] = xr[64 * j]; } }
        float s[2];
#pragma unroll
        for (int tk = 0; tk < 2; ++tk) { float a = 0.f;
#pragma unroll
            for (int j = 0; j < 4; ++j) a += (hn[tk][j].x * hn[tk][j].x + hn[tk][j].y * hn[tk][j].y) + (hn[tk][j].z * hn[tk][j].z + hn[tk][j].w * hn[tk][j].w);
            s[tk] = a; }
#pragma unroll
        for (int tk = 0; tk < 2; ++tk) { float a = s[tk];
            a += dpp_f<0xB1>(a); a += dpp_f<0x4E>(a); a += dpp_f<0x141>(a); a += dpp_f<0x128>(a);
            { const auto rr = __builtin_amdgcn_permlane16_swap(__float_as_uint(a), __float_as_uint(a), false, false); a = __uint_as_float(rr[0]) + __uint_as_float(rr[1]); }
            { const auto rr = __builtin_amdgcn_permlane32_swap(__float_as_uint(a), __float_as_uint(a), false, false); a = __uint_as_float(rr[0]) + __uint_as_float(rr[1]); }
            s[tk] = a; }
#pragma unroll
        for (int tk = 0; tk < 2; ++tk) {
            const float rstd = 1.0f / sqrtf(s[tk] * (1.f / DM) + EPS);
            GAS u32x2* o8 = (GAS u32x2*)(h2 + (tok0 + 2 * it + tk) * DM) + lane;
#pragma unroll
            for (int j = 0; j < 4; ++j) { const f32x4 v = hn[tk][j] * rstd * gg[j]; u32x2 o; o.x = pk2(v.x, v.y); o.y = pk2(v.z, v.w); o8[64 * j] = o;
                *((GAS unsigned*)(h2f8 + (tok0 + 2 * it + tk) * DM) + lane + 64 * j) = pk4_f8(v.x, v.y, v.z, v.w); }
        }
    }
    asm volatile("s_waitcnt vmcnt(0)" ::: "memory");
    f32x16 acc = {};
    { const GAS bf16_t* hp = (const GAS bf16_t*)h2 + (tok0 + r32) * DM + 8 * hi;
      const LAS unsigned char* wp = F.lds + RL_WHI + r32 * RL_WROW + 16 * hi;
#pragma unroll 8
      for (int kk = 0; kk < 64; ++kk) { const bf16x8 hb = *(const GAS bf16x8*)(hp + 16 * kk);
          const bf16x8 wh = *(const LAS bf16x8*)(wp + 32 * kk), wl = *(const LAS bf16x8*)(wp + RL_WLO + 32 * kk);
          acc = MFMA32(wh, hb, acc); acc = MFMA32(wl, hb, acc); } }
    float lg[16];
#pragma unroll
    for (int r = 0; r < 16; ++r) lg[r] = acc[r] + b_router[crow(r, hi)];
    float lv[4]; int li[4];
#pragma unroll
    for (int k = 0; k < 4; ++k) { float bv = lg[0]; int br = 0;
#pragma unroll
        for (int r = 1; r < 16; ++r) { const bool g = lg[r] > bv; bv = g ? lg[r] : bv; br = g ? r : br; }
        lv[k] = bv; li[k] = crow(br, hi);
#pragma unroll
        for (int r = 0; r < 16; ++r) lg[r] = (r == br) ? -INFINITY : lg[r]; }
    float ov[4]; int oi[4];
#pragma unroll
    for (int k = 0; k < 4; ++k) { const auto rv = __builtin_amdgcn_permlane32_swap(__float_as_uint(lv[k]), __float_as_uint(lv[k]), false, false); const auto ri = __builtin_amdgcn_permlane32_swap((unsigned)li[k], (unsigned)li[k], false, false);
        ov[k] = hi ? __uint_as_float(rv[0]) : __uint_as_float(rv[1]); oi[k] = hi ? (int)ri[0] : (int)ri[1]; }
    float tv[4]; int te[4];
    { float a0 = lv[0], a1 = lv[1], a2 = lv[2], a3 = lv[3], b0 = ov[0], b1 = ov[1], b2 = ov[2], b3 = ov[3];
      int i0 = li[0], i1 = li[1], i2 = li[2], i3 = li[3], j0 = oi[0], j1 = oi[1], j2 = oi[2], j3 = oi[3];
#pragma unroll
      for (int k = 0; k < 4; ++k) { const bool ta = (a0 > b0) || (a0 == b0 && i0 < j0);
          tv[k] = ta ? a0 : b0; te[k] = ta ? i0 : j0;
          if (ta) { a0 = a1; a1 = a2; a2 = a3; a3 = -INFINITY; i0 = i1; i1 = i2; i2 = i3; i3 = 64; }
          else { b0 = b1; b1 = b2; b2 = b3; b3 = -INFINITY; j0 = j1; j1 = j2; j2 = j3; j3 = 64; } } }
    const float e1 = __expf(tv[1] - tv[0]), e2x = __expf(tv[2] - tv[0]), e3 = __expf(tv[3] - tv[0]);
    const float inv = 1.0f / (1.0f + e1 + e2x + e3);
    if (hi == 0) { const int tl = 32 * wave + r32;
        *(LAS int*)(tke + tl * 4 + 0) = te[0]; tke[tl * 4 + 1] = te[1]; tke[tl * 4 + 2] = te[2]; tke[tl * 4 + 3] = te[3];
        tkw[tl * 4 + 0] = inv; tkw[tl * 4 + 1] = e1 * inv; tkw[tl * 4 + 2] = e2x * inv; tkw[tl * 4 + 3] = e3 * inv;
#pragma unroll
        for (int k = 0; k < 4; ++k) __hip_atomic_fetch_add((LAS unsigned*)F.MISC + MW_LCNT + te[k], 1u, __ATOMIC_RELAXED, __HIP_MEMORY_SCOPE_WORKGROUP); }
    __syncthreads();
    if (tid < 32) ((int*)(F.ws + WS_BLKCNT))[F.blk * 32 + tid] = (int)F.MISC[MW_LCNT + tid];
}
__device__ __forceinline__ void p10_assign(Frame& F) {
    const int tid = F.tid;
    const int* blkcnt = (const int*)(F.ws + WS_BLKCNT);
    LAS int* part = (LAS int*)(F.lds);
    LAS int* tke = (LAS int*)(F.lds + RL_TKE); LAS float* tkw = (LAS float*)(F.lds + RL_TKW);
    { const int e = tid & 31, p = tid >> 5; int tot = 0, bef = 0;
      for (int j = 0; j < 16; ++j) { const int bl = p * 16 + j; const int c = blkcnt[bl * 32 + e]; tot += c; bef += (bl < F.blk) ? c : 0; }
      part[p * 32 + e] = tot; part[512 + p * 32 + e] = bef; }
    __syncthreads();
    if (tid < 32) { int tot = 0, bef = 0;
        for (int p = 0; p < 16; ++p) { tot += part[p * 32 + tid]; bef += part[512 + p * 32 + tid]; }
        part[1024 + tid] = tot; F.MISC[MW_BEFORE + tid] = (unsigned)bef; F.MISC[MW_LCNT + tid] = 0u; }
    __syncthreads();
    if (tid == 0) { int ps = 0;
        for (int e = 0; e < 32; ++e) { F.MISC[MW_PSTART + e] = (unsigned)ps; F.MISC[MW_TSTART + e] = (unsigned)(ps >> 8); ps += (part[1024 + e] + 255) & ~255; }
        F.MISC[MW_PSTART + 32] = (unsigned)ps; F.MISC[MW_TSTART + 32] = (unsigned)(ps >> 8); }
    __syncthreads();
    int* slot_tok = (int*)(F.ws + WS_SLOT_TOK); int* tok_slot = (int*)(F.ws + WS_TOK_SLOT); float* tok_gate = (float*)(F.ws + WS_TOK_GATE);
    for (int idx = tid; idx < 1024; idx += NWAVES * 64) {
        const int e = tke[idx]; const float w = tkw[idx];
        const unsigned r = __hip_atomic_fetch_add((LAS unsigned*)F.MISC + MW_LCNT + e, 1u, __ATOMIC_RELAXED, __HIP_MEMORY_SCOPE_WORKGROUP);
        const unsigned pos = F.MISC[MW_PSTART + e] + F.MISC[MW_BEFORE + e] + r;
        slot_tok[pos] = F.blk * 256 + (idx >> 2); tok_slot[F.blk * 1024 + idx] = (int)pos; tok_gate[F.blk * 1024 + idx] = w;
    }
}

__device__ __forceinline__ void p13_combine(Frame& F) {
    const int gw = F.blk * NWAVES + F.wave, NGW = F.G * NWAVES, lane = F.lane;
    const int* tok_slot = (const int*)(F.ws + WS_TOK_SLOT); const float* tok_gate = (const float*)(F.ws + WS_TOK_GATE);
    const GAS bf16_t* Y = (const GAS bf16_t*)(F.ws + WS_Y);
    for (int t0 = gw; t0 < NTOK; t0 += 2 * NGW) {
        u32x4 y[2][4][2]; u32x4 xb[2][2]; f32x4 o[2][4]; float g[2][4];
#pragma unroll
        for (int tk = 0; tk < 2; ++tk) { const int t = t0 + tk * NGW;
#pragma unroll
            for (int k = 0; k < 4; ++k) { const int sl = __builtin_amdgcn_readfirstlane(tok_slot[4 * t + k]); g[tk][k] = tok_gate[4 * t + k];
                const GAS bf16_t* yr = Y + (size_t)sl * DM + 8 * lane; y[tk][k][0] = *(const GAS u32x4*)yr; y[tk][k][1] = *(const GAS u32x4*)(yr + 512); }
            const GAS bf16_t* xrow = (const GAS bf16_t*)F.out + (size_t)t * 2048 + (t & 1) * 1024 + 8 * lane;
            xb[tk][0] = *(const GAS u32x4*)xrow; xb[tk][1] = *(const GAS u32x4*)(xrow + 512); }
        asm volatile("s_waitcnt vmcnt(0)" ::: "memory");
#pragma unroll
        for (int tk = 0; tk < 2; ++tk)
#pragma unroll
            for (int h = 0; h < 2; ++h) { const u32x4 v = xb[tk][h];
                o[tk][2 * h] = (f32x4){bflo(v.x), bfhi(v.x), bflo(v.y), bfhi(v.y)}; o[tk][2 * h + 1] = (f32x4){bflo(v.z), bfhi(v.z), bflo(v.w), bfhi(v.w)}; }
#pragma unroll
        for (int tk = 0; tk < 2; ++tk) { const int t = t0 + tk * NGW;
#pragma unroll
            for (int k = 0; k < 4; ++k) { const float w = g[tk][k];
#pragma unroll
                for (int h = 0; h < 2; ++h) { const u32x4 v = y[tk][k][h];
                    o[tk][2 * h][0] += w * bflo(v.x); o[tk][2 * h][1] += w * bfhi(v.x); o[tk][2 * h][2] += w * bflo(v.y); o[tk][2 * h][3] += w * bfhi(v.y);
                    o[tk][2 * h + 1][0] += w * bflo(v.z); o[tk][2 * h + 1][1] += w * bfhi(v.z); o[tk][2 * h + 1][2] += w * bflo(v.w); o[tk][2 * h + 1][3] += w * bfhi(v.w); } }
            GAS float* orow = (GAS float*)F.out + (size_t)t * DM + 8 * lane;
            *(GAS f32x4*)orow = o[tk][0]; *(GAS f32x4*)(orow + 4) = o[tk][1]; *(GAS f32x4*)(orow + 512) = o[tk][2]; *(GAS f32x4*)(orow + 516) = o[tk][3]; }
    }
}

#ifndef MK_ONE_LAUNCH
#define MK_ONE_LAUNCH 1
#endif
constexpr int N_PHASES = 14;
struct Args { const float* in[21]; float* out; unsigned char* ws; int ph_lo, ph_hi; };
static_assert(sizeof(Args) == 21 * 8 + 8 + 8 + 8, "no padding");

__global__ void __launch_bounds__(NWAVES * 64, 2) fwd_kernel(Args args) {
    extern __shared__ __attribute__((aligned(16))) unsigned char lds[];
    Frame F;
    F.lds = (LAS unsigned char*)lds;
    F.MISC = (volatile LAS unsigned*)(F.lds + MISC_OFF);
    F.tid = threadIdx.x; F.lane = F.tid & 63; F.wave = __builtin_amdgcn_readfirstlane(F.tid >> 6);
#define FRESH() do { F.lane = lane_id_fresh(); F.tid = F.wave * 64 + F.lane; } while (0)
    F.G = gridDim.x; F.blk = blockIdx.x;
    F.ws = args.ws; F.out = args.out; F.ctl = (gu32*)(args.ws + WS_CTL);
#pragma unroll
    for (int i = 0; i < 21; ++i) F.in[i] = args.in[i];
    for (int u = F.tid; u < (LDS_BYTES - MISC_OFF) / 4; u += NWAVES * 64) ((LAS unsigned*)(F.lds + MISC_OFF))[u] = 0u;
    __syncthreads();
    const int lo = args.ph_lo, hi = args.ph_hi;
    XcdBarrier bar; bar.bar = (unsigned*)(F.ctl + CW_BAR); bar.x = 0; bar.st = nullptr; bar.wave = F.wave;
    if (hi - lo > 1) bar = xcd_barrier_post((unsigned*)(F.ctl + CW_BAR), F.MISC + MW_BAR);
#ifndef STAG
#define STAG 0
#endif
#ifndef PH_MASK
#define PH_MASK 0x3fff
#endif
#define IN(k) (((PH_MASK >> (k)) & 1) && lo <= (k) && (k) < hi)
#ifndef REP_MASK
#define REP_MASK 0
#endif
#define NREP(k) (1 + ((REP_MASK >> (k)) & 1))
#define SEAM(k) do { if (IN(k) && IN((k) + 1)) xcd_barrier(bar); } while (0)
    unsigned char* ws = args.ws;
    bf16_t* proj = (bf16_t*)(ws + WS_P);

    if (IN(0)) for (int rep = 0; rep < NREP(0); ++rep) { if (rep) xcd_barrier(bar); FRESH(); p0_prologue(F); } SEAM(0);

    if (IN(1)) {
#ifdef PROBE_P1
        { pg8::DenseSched S; S.init(ws + WS_H, ws + WS_WIN, NTOK, PW, DM, F.G, F.blk); S.amask = PROBE_P1;
          pg8::EpiBf16<0> E{(bf16_t*)(ws + WS_END), PW, nullptr, 1023};
          pg8::gemm_phase<pg8::EpiBf16<0>, pg8::DenseSched, true>(F.lds, F.wave, DM, S, E); }
        xcd_barrier(bar);
#endif
        { pg8::DenseSched S; S.init(ws + WS_H, ws + WS_WIN, NTOK, PW, DM, F.G, F.blk);
          pg8::EpiBf16<0> E{proj, PW, nullptr};
          pg8::gemm_phase<pg8::EpiBf16<0>, pg8::DenseSched, true>(F.lds, F.wave, DM, S, E); }
        { pg8::DenseSched S; S.init(ws + WS_MEMN, ws + WS_WMKV, NMEM, DM, DM, F.G, F.blk);
          pg8::EpiBf16<0> E{(bf16_t*)(ws + WS_MKV), DM, nullptr};
          pg8::gemm_phase<pg8::EpiBf16<0>, pg8::DenseSched, true>(F.lds, F.wave, DM, S, E); }
    } SEAM(1);

    if (IN(2)) { FRESH(); if (REP_MASK & 4) { p2_prep(F, true); xcd_barrier(bar); } p2_prep(F); } SEAM(2);

    if (IN(3)) {
        FRESH();
        bf16_t* osb = (bf16_t*)(ws + WS_O); bf16_t* odsa = osb + (size_t)NTOK * 512; bf16_t* omem = odsa + (size_t)NTOK * 512;
#ifndef REP_DSA
#define REP_DSA 1
#endif
#ifndef REP_SB
#define REP_SB 1
#endif
#ifndef REP_MEM
#define REP_MEM 1
#endif
#ifndef NO_DSA
        for (int rep = 0; rep < REP_DSA; ++rep)
        for (int i = 0; i < 4; ++i) { const int p = 2 * F.blk + (i >> 1), b = p >> 4, cc = p & 15, c = (i & 1) ? 31 - cc : cc; dsa_unit(proj, odsa, (unsigned*)F.out + (size_t)F.blk * 131072, b, c, F.lds, F.tid); }
#endif
        const int gw = F.blk * NWAVES + F.wave, NGW = F.G * NWAVES;
#ifndef NO_SB
        for (int rep = 0; rep < REP_SB; ++rep)
        for (int it = gw; it < NB * 8 * 64; it += NGW) { const int qblk = 63 - (it >> 8), bh = it & 255; sb_item(proj, osb, bh >> 3, bh & 7, qblk, F.lds + F.wave * 4096, F.lane); }
#endif
#ifndef NO_MEM
        for (int rep = 0; rep < REP_MEM; ++rep) {
            __syncthreads();
            for (int u = F.blk; u < NB * 4 * 2; u += F.G) mem_unit(proj, (const bf16_t*)(ws + WS_MKV), omem, u >> 3, (u >> 1) & 3, u & 1, F.lds, F.tid);
        }
#endif
    } SEAM(3);

    if (IN(4)) {
        pg8::DenseSched S; S.init(ws + WS_H8, ws + WS_WG, NTOK, 3 * DM, DM / 2, F.G, F.blk);
        pg8::EpiBf16<2> E{proj, PW, F.in[11]};
        pg8::gemm_phase<pg8::EpiBf16<2>, pg8::DenseSched, true, true>(F.lds, F.wave, DM / 2, S, E);
    } SEAM(4);

    if (IN(5)) { pg8::MergeSched S; S.init(ws + WS_O, ws + WS_WB, NTOK, DM, F.G, F.blk);
        pg8::EpiMerge E{proj, (bf16_t*)(ws + WS_H)};
        pg8::gemm_phase<pg8::EpiMerge, pg8::MergeSched, true>(F.lds, F.wave, 512, S, E); } SEAM(5);


    if (IN(8)) {
        pg8::DenseSched S; S.init(ws + WS_H, ws + WS_WO, NTOK, DM, DM, F.G, F.blk); S.stag = STAG;
        pg8::EpiResid E{F.in[0], (bf16_t*)F.out};
        pg8::gemm_phase<pg8::EpiResid, pg8::DenseSched, true>(F.lds, F.wave, DM, S, E);
    } SEAM(8);

    if (IN(9)) for (int rep = 0; rep < NREP(9); ++rep) { if (rep) xcd_barrier(bar); FRESH(); p9_router(F); } SEAM(9);
    if (IN(10)) for (int rep = 0; rep < NREP(10); ++rep) { if (rep) xcd_barrier(bar); FRESH(); p10_assign(F); } SEAM(10);

    if (IN(11)) for (int rep = 0; rep < NREP(11); ++rep) {  if (rep) xcd_barrier(bar);
        pg8::MoeSched S{(const char*)(ws + WS_H2F8), (const char*)(ws + WS_WEI), (const int*)(ws + WS_SLOT_TOK), F.MISC + MW_TSTART, DM / 2, 2048, 8, F.blk};
        pg8::EpiSwiglu E{ws + WS_ACT8, F.in[18], F.lds};
        pg8::gemm_phase<pg8::EpiSwiglu, pg8::MoeSched, true, true>(F.lds, F.wave, DM / 2, S, E);
    } SEAM(11);

    if (IN(12)) {
        pg8::MoeSched S{(const char*)(ws + WS_ACT8), (const char*)(ws + WS_WEO), nullptr, F.MISC + MW_TSTART, DM / 2, DM, 4, F.blk};
        pg8::EpiBf16<3> E{(bf16_t*)(ws + WS_Y), DM, F.in[20]};
        pg8::gemm_phase<pg8::EpiBf16<3>, pg8::MoeSched, true, true>(F.lds, F.wave, DM / 2, S, E);
    } SEAM(12);

    if (IN(13)) { FRESH(); p13_combine(F); }
#undef IN
#undef SEAM
}

extern "C" void kernel_launch(void* const* d_in, const int* in_sizes, int n_in, void* d_out, int out_size, void* d_ws, size_t ws_size, hipStream_t stream) {
    static int grid = 0;
    if (grid == 0) {
        if (n_in != 21 || in_sizes[0] != NTOK * DM || out_size != NTOK * DM || ws_size < WS_END) {
            fprintf(stderr, "kernel_launch: unexpected shapes: n_in %d in0 %d out %d ws %zu (need >= %zu); nothing launched\n", n_in, n_in > 0 ? in_sizes[0] : -1, out_size, ws_size, (size_t)WS_END); grid = -1; return; }
        int dev = 0, cus = 0, per_cu = 0;
        if (hipGetDevice(&dev) != hipSuccess || hipDeviceGetAttribute(&cus, hipDeviceAttributeMultiprocessorCount, dev) != hipSuccess) { fprintf(stderr, "kernel_launch: device query failed\n"); grid = -1; return; }
        if (hipFuncSetAttribute((const void*)fwd_kernel, hipFuncAttributeMaxDynamicSharedMemorySize, LDS_BYTES) != hipSuccess) { fprintf(stderr, "kernel_launch: hipFuncSetAttribute failed\n"); grid = -1; return; }
        if (hipOccupancyMaxActiveBlocksPerMultiprocessor(&per_cu, (const void*)fwd_kernel, NWAVES * 64, LDS_BYTES) != hipSuccess || per_cu < 1)
            fprintf(stderr, "kernel_launch: note: occupancy query reports %d workgroups per CU\n", per_cu);
        (void)hipGetLastError();
        grid = cus;
        if (grid != 256) { fprintf(stderr, "kernel_launch: this kernel is built for 256 CUs (got %d); nothing launched\n", grid); grid = -1; return; }
    }
    if (grid < 0) return;
    if (hipMemsetAsync((char*)d_ws + WS_CTL, 0, CTL_ZERO_BYTES, stream) != hipSuccess) { fprintf(stderr, "kernel_launch: hipMemsetAsync failed\n"); return; }
    Args a{};
    for (int i = 0; i < 21; ++i) a.in[i] = (const float*)d_in[i];
    a.out = (float*)d_out; a.ws = (unsigned char*)d_ws;
#if MK_ONE_LAUNCH
    const int cuts[2] = {0, N_PHASES}; const int nl = 1;
#else
    const int cuts[11] = {0, 1, 2, 3, 4, 5, 6, 7, 8, 9, N_PHASES}; const int nl = 10;
#endif
    for (int li = 0; li < nl; ++li) {
        a.ph_lo = cuts[li]; a.ph_hi = cuts[li + 1];
        hipLaunchKernelGGL(fwd_kernel, dim3(grid), dim3(NWAVES * 64), LDS_BYTES, stream, a);
        const hipError_t le = hipPeekAtLastError();
        if (le != hipSuccess) { fprintf(stderr, "kernel_launch: launch %d failed: %s\n", li, hipGetErrorName(le)); break; }
    }
}
```

```cpp
#include <hip/hip_runtime.h>
#include <cstdio>
#include <cstdint>

#define LAS __attribute__((address_space(3)))
#define GAS __attribute__((address_space(1)))
typedef unsigned short bf16_t;
typedef short bf16x8 __attribute__((ext_vector_type(8)));
typedef short s16x4 __attribute__((ext_vector_type(4)));
typedef short v4i16_t __attribute__((ext_vector_type(4)));
typedef float f32x2 __attribute__((ext_vector_type(2)));
typedef float f32x4 __attribute__((ext_vector_type(4)));
typedef float f32x16 __attribute__((ext_vector_type(16)));
typedef unsigned u32x2 __attribute__((ext_vector_type(2)));
typedef unsigned u32x4 __attribute__((ext_vector_type(4)));
typedef int i32x4 __attribute__((ext_vector_type(4)));
typedef int i32x8 __attribute__((ext_vector_type(8)));
typedef GAS unsigned gu32;

constexpr int NB = 32, SEQ = 2048, DM = 1024, NTOK = NB * SEQ;
constexpr int MEMLEN = 256, NMEM = NB * MEMLEN;
constexpr int PW = 3072;
constexpr int C_SQ = 0, C_SK = 512, C_SV = 1024, C_DQ = 1536, C_DK = 2048, C_DV = 2112, C_IQ = 2176, C_IK = 2432, C_IW = 2496, C_MQ = 2560;
constexpr int IN_W = 3012;
constexpr int NEXP = 32, TOPK = 4, DEXP = 1024;
constexpr int NSLOT = NTOK * TOPK;
constexpr int NSLOT_PAD = NSLOT + NEXP * 256;
constexpr float EPS = 1e-6f;
constexpr float LOG2E = 1.4426950408889634f;

constexpr size_t MiB = 1u << 20;
constexpr size_t WS_CTL = 0, CTL_ZERO_BYTES = 1 * MiB;
constexpr size_t WS_ROPE = 1 * MiB;
constexpr size_t WS_BLKCNT = 1 * MiB + 512 * 1024;
constexpr size_t WS_SLOT_TOK = 2 * MiB;
constexpr size_t WS_TOK_SLOT = 4 * MiB;
constexpr size_t WS_TOK_GATE = 5 * MiB;
constexpr size_t WS_WIN = 8 * MiB;
constexpr size_t WS_WMKV = 14 * MiB;
constexpr size_t WS_WG = 16 * MiB;
constexpr size_t WS_WB = 22 * MiB;
constexpr size_t WS_WO = 25 * MiB;
constexpr size_t WS_WEI = 27 * MiB;
constexpr size_t WS_WEO = 155 * MiB;
__device__ __forceinline__ int lane_id_fresh() { int l; asm volatile("v_mbcnt_lo_u32_b32 %0, -1, 0\n\tv_mbcnt_hi_u32_b32 %0, -1, %0" : "=v"(l)); return l; }
__device__ __forceinline__ unsigned pk4_f8(float a, float b, float c, float d) { int v = __builtin_amdgcn_cvt_pk_fp8_f32(a, b, 0, false); return (unsigned)__builtin_amdgcn_cvt_pk_fp8_f32(c, d, v, true); }
constexpr float W8_SCALE = 64.f, W8_INV = 1.f / 64.f;
constexpr size_t WS_H = 220 * MiB;
constexpr size_t WS_P = 348 * MiB;
constexpr size_t WS_O = 732 * MiB;
constexpr size_t WS_H8 = 91 * MiB;
constexpr size_t WS_H2F8 = 91 * MiB;
constexpr size_t WS_MEMN = 924 * MiB;
constexpr size_t WS_MKV = 940 * MiB;
constexpr size_t WS_Y = 220 * MiB;
constexpr size_t WS_ACT8 = 748 * MiB;
constexpr size_t WS_END = 1012 * MiB;
static_assert(WS_Y + (size_t)NSLOT_PAD * DM * 2 <= WS_ACT8 && WS_ACT8 + (size_t)NSLOT_PAD * DEXP <= WS_END, "y | act8");
static_assert(WS_SLOT_TOK + (size_t)NSLOT_PAD * 4 <= WS_TOK_SLOT && WS_TOK_GATE + (size_t)NTOK * 16 <= WS_WIN, "slot tables");

constexpr int CW_BAR = 4096;

constexpr int RING_BYTES = 151552;
constexpr int MISC_OFF = RING_BYTES;
constexpr int LDS_BYTES = 155648;
constexpr int MW_BAR = 8;
constexpr int MW_LCNT = 16;
constexpr int MW_PSTART = 64;
constexpr int MW_TSTART = 128;
constexpr int MW_BEFORE = 192;
constexpr int MW_PART = 256;

__device__ __forceinline__ unsigned f2bf(float f) { unsigned u = __builtin_bit_cast(unsigned, f); return (u + 0x7fffu + ((u >> 16) & 1u)) >> 16; }
__device__ __forceinline__ unsigned pk2(float lo, float hi) { return f2bf(lo) | (f2bf(hi) << 16); }
__device__ __forceinline__ float bf2f(unsigned short b) { return __builtin_bit_cast(float, (unsigned)b << 16); }
__device__ __forceinline__ float bflo(unsigned w) { return __builtin_bit_cast(float, w << 16); }
__device__ __forceinline__ float bfhi(unsigned w) { return __builtin_bit_cast(float, w & 0xffff0000u); }
__device__ __forceinline__ unsigned cvt_pk_bf16(float lo, float hi) { unsigned r; asm volatile("v_cvt_pk_bf16_f32 %0, %1, %2" : "=v"(r) : "v"(lo), "v"(hi)); return r; }
__device__ __forceinline__ int crow(int r, int hi) { return (r & 3) + 8 * (r >> 2) + 4 * hi; }
#define LDS_WAIT() asm volatile("s_waitcnt lgkmcnt(0)" ::: "memory")
#define VM_WAIT() asm volatile("s_waitcnt vmcnt(0)" ::: "memory")

namespace pg8 {
constexpr int BM = 256, BK = 64, HALF = 128, HTB = HALF * BK * 2, STAGE_BYTES = 8 * HTB, EPI_NA_OFF = STAGE_BYTES + 2048;
__host__ __device__ __forceinline__ int lds_byte(int r, int c) { const int st = (r >> 4) * 2 + (c >> 5), rr = r & 15, cc = c & 31, ob = rr * 64 + cc * 2; return st * 1024 + (ob ^ (((ob >> 9) & 1) << 5)); }
__host__ __device__ __forceinline__ void stage_rc(int b, int& R, int& C) { const int st = b / 1024, sb = b % 1024, swz = sb ^ (((sb >> 9) & 1) << 5); R = (st >> 1) * 16 + swz / 64; C = (st & 1) * 32 + (swz % 64) / 2; }
__host__ __device__ __forceinline__ int perm32(int rho) { const int n = rho >> 4, i = rho & 15; return 8 * (i >> 2) + 4 * n + (i & 3); }

struct Unit { int pm, pn, e; };

template <class Epi, class Sched, bool ALIGN_EPI, bool FP8 = false>
__device__ __forceinline__ void gemm_phase(LAS unsigned char* lds, const int wave_, const int K, const Sched& S, const Epi& E) {
    int tid = wave_ * 64 + lane_id_fresh();
    const int wid = __builtin_amdgcn_readfirstlane(tid >> 6), lane = tid & 63, wr = wid >> 2, wc = wid & 3, fr = lane & 15, fq = lane >> 4;
    const int nt = K / BK;
    int Rr[2], Cc[2]; unsigned voffB[2];
#pragma unroll
    for (int i = 0; i < 2; ++i) { int R, C; stage_rc(tid * 16 + i * 8192, R, C); Rr[i] = R; Cc[i] = C; const int Rb = Epi::PERM ? ((R & ~31) + perm32(R & 31)) : R; voffB[i] = (unsigned)(Rb * K + C) * 2u; }
    const size_t kstep = (size_t)(BK * 2);
    const size_t hstepB = (size_t)HALF * K * 2;
    const unsigned ldsw = (unsigned)wid * 1024u;
    const int aoff = lds_byte(wr * 64 + fr, fq * 8), boff = lds_byte(wc * 32 + fr, fq * 8);
#define PG8_SA(b, h) (((b) * 2 + (h)) * HTB)
#define PG8_SB(b, h) ((4 + (b) * 2 + (h)) * HTB)
#define PG8_STAGE(bufoff, gbase, voff) do { _Pragma("unroll") for (int _i = 0; _i < 2; ++_i) { unsigned o_ = (voff)[_i]; asm volatile("" : "+v"(o_)); \
        __builtin_amdgcn_global_load_lds((const unsigned*)((const char*)(gbase) + o_), (LAS unsigned*)(lds + (bufoff) + ldsw + _i * 8192), 16, 0, 0); } } while (0)
#define PG8_J8(x, y) __builtin_shufflevector(x, y, 0, 1, 2, 3, 4, 5, 6, 7)
#define PG8_LDA(dst, b, h) do { _Pragma("unroll") for (int m = 0; m < 4; ++m) { const LAS unsigned char* p_ = lds + PG8_SA(b, h) + aoff + m * 2048; \
        if constexpr (FP8) dst##8[m] = PG8_J8(*(const LAS i32x4*)p_, *(const LAS i32x4*)(p_ + 1024)); else { dst[m][0] = *(const LAS bf16x8*)p_; dst[m][1] = *(const LAS bf16x8*)(p_ + 1024); } } } while (0)
#define PG8_LDB(dst, b, h) do { _Pragma("unroll") for (int n = 0; n < 2; ++n) { const LAS unsigned char* p_ = lds + PG8_SB(b, h) + boff + n * 2048; \
        if constexpr (FP8) dst##8[n] = PG8_J8(*(const LAS i32x4*)p_, *(const LAS i32x4*)(p_ + 1024)); else { dst[n][0] = *(const LAS bf16x8*)p_; dst[n][1] = *(const LAS bf16x8*)(p_ + 1024); } } } while (0)
#define PG8_MMA(ai, bj, At, Bt) do { __builtin_amdgcn_s_setprio(1); _Pragma("unroll") for (int m = 0; m < 4; ++m) _Pragma("unroll") for (int n = 0; n < 2; ++n) { \
        if constexpr (FP8) acc[ai][bj][m][n] = __builtin_amdgcn_mfma_scale_f32_16x16x128_f8f6f4(Bt##8[n], At##8[m], acc[ai][bj][m][n], 0, 0, 0, 0, 0, 0); \
        else { _Pragma("unroll") for (int k = 0; k < 2; ++k) acc[ai][bj][m][n] = __builtin_amdgcn_mfma_f32_16x16x32_bf16(Bt[n][k], At[m][k], acc[ai][bj][m][n], 0, 0, 0); } } \
        __builtin_amdgcn_s_setprio(0); } while (0)
#define PG8_WAIT_V(n) asm volatile("s_waitcnt vmcnt(" #n ")" ::: "memory")
#define PG8_WAIT_L(n) asm volatile("s_waitcnt lgkmcnt(" #n ")" ::: "memory")
#define PG8_BAR __builtin_amdgcn_s_barrier()
#define PG8_SCHED __builtin_amdgcn_sched_barrier(0)
    Unit cur, nxt; int ui = 0;
    if (!S.next(0, cur)) return;
    { const int ns = S.stagger();
      for (int q = 0; q < ns; ++q) __builtin_amdgcn_s_sleep(4); }
    f32x4 acc[2][2][4][2];
    bf16x8 At[4][2], B0[2][2], B1[2][2]; i32x8 At8[4], B08[2], B18[2];
    const char* Ab = S.a_base();
    unsigned ca0[2], ca1[2], na0[2], na1[2];
#pragma unroll
    for (int i = 0; i < 2; ++i) { ca0[i] = S.a_off(cur, Rr[i], Cc[i]); ca1[i] = S.a_off(cur, HALF + Rr[i], Cc[i]); }
    const char* cB = S.b_tile(cur);
    PG8_STAGE(PG8_SB(0, 0), cB, voffB); PG8_STAGE(PG8_SB(0, 1), cB + hstepB, voffB); PG8_STAGE(PG8_SA(0, 0), Ab, ca0); PG8_STAGE(PG8_SA(0, 1), Ab, ca1);
    if (wr == 1) PG8_BAR;
    PG8_WAIT_V(2); PG8_BAR;
    PG8_STAGE(PG8_SB(1, 0), cB + kstep, voffB); PG8_STAGE(PG8_SA(1, 0), Ab + kstep, ca0); PG8_STAGE(PG8_SB(1, 1), cB + hstepB + kstep, voffB);
    PG8_WAIT_V(6); PG8_BAR;
    for (;;) {
        typename Epi::Pre pre = E.preload(cur, wr, wc, fr, fq);
        const bool has_next = S.next(ui + 1, nxt);
        const char* nB = cB;
#pragma unroll
        for (int i = 0; i < 2; ++i) { na0[i] = ca0[i]; na1[i] = ca1[i]; }
        if (has_next) { nB = S.b_tile(nxt);
#pragma unroll
            for (int i = 0; i < 2; ++i) { int R, C; int tq = tid; if constexpr (FP8) tq = wave_ * 64 + lane_id_fresh();
                stage_rc(tq * 16 + i * 8192, R, C);
                na0[i] = S.a_off(nxt, R, C); na1[i] = S.a_off(nxt, HALF + R, C); } }
        if constexpr (Epi::DRAIN_TOP) { PG8_WAIT_V(0); }
        if constexpr (Epi::STASH) E.stash(pre, wid, fr, fq);
#define PG8_NAST(v) const unsigned v = (unsigned)(EPI_NA_OFF + (wave_ * 64 + lane_id_fresh()) * 16)
        if constexpr (FP8) { PG8_NAST(nast); *(LAS u32x4*)(lds + nast) = (u32x4){na0[0], na0[1], na1[0], na1[1]}; }
#pragma unroll
        for (int a = 0; a < 2; ++a)
#pragma unroll
            for (int b = 0; b < 2; ++b)
#pragma unroll
                for (int m = 0; m < 4; ++m)
#pragma unroll
                    for (int n = 0; n < 2; ++n) acc[a][b][m][n] = (f32x4){0.f, 0.f, 0.f, 0.f};
#pragma unroll 1
        for (int t = 0; t < nt; t += 2) {
            const bool last = (t == nt - 2);
            const char* a1 = Ab + (size_t)(t + 1) * kstep;
            const char* a2 = last ? Ab : Ab + (size_t)(t + 2) * kstep; const char* b2 = last ? nB : cB + (size_t)(t + 2) * kstep;
            const char* a3 = a2 + kstep; const char* b3 = b2 + kstep;
            if constexpr (FP8) { asm volatile("" : "+s"(a1), "+s"(a2), "+s"(b2), "+s"(a3), "+s"(b3)); }
            unsigned o20[2], o21[2];
#pragma unroll
            for (int i = 0; i < 2; ++i) { o20[i] = last ? na0[i] : ca0[i]; o21[i] = last ? na1[i] : ca1[i]; }
            if constexpr (FP8) { if (last) { PG8_NAST(nast); const u32x4 nv = *(const LAS u32x4*)(lds + nast); o20[0] = nv.x; o20[1] = nv.y; o21[0] = nv.z; o21[1] = nv.w; } }
            PG8_LDB(B0, 0, 0); PG8_LDB(B1, 0, 1); PG8_SCHED; PG8_LDA(At, 0, 0); PG8_STAGE(PG8_SA(1, 1), a1, ca1);
            PG8_WAIT_V(8); PG8_WAIT_L(0); PG8_BAR; PG8_MMA(0, 0, At, B0); PG8_MMA(0, 1, At, B1); PG8_BAR; PG8_SCHED;
            PG8_LDA(At, 0, 1); PG8_STAGE(PG8_SB(0, 0), b2, voffB); PG8_STAGE(PG8_SB(0, 1), b2 + hstepB, voffB); PG8_STAGE(PG8_SA(0, 0), a2, o20);
            PG8_WAIT_V(8); PG8_WAIT_L(0); PG8_BAR; PG8_MMA(1, 0, At, B0); PG8_MMA(1, 1, At, B1); PG8_BAR; PG8_SCHED;
            PG8_LDB(B0, 1, 0); PG8_LDB(B1, 1, 1); PG8_SCHED; PG8_LDA(At, 1, 0); PG8_STAGE(PG8_SA(0, 1), a2, o21);
            PG8_WAIT_V(8); PG8_WAIT_L(0); PG8_BAR; PG8_MMA(0, 0, At, B0); PG8_MMA(0, 1, At, B1); PG8_BAR; PG8_SCHED;
            PG8_LDA(At, 1, 1); PG8_STAGE(PG8_SB(1, 0), b3, voffB); PG8_STAGE(PG8_SB(1, 1), b3 + hstepB, voffB); PG8_STAGE(PG8_SA(1, 0), a3, o20);
            PG8_WAIT_V(8); PG8_WAIT_L(0); PG8_BAR; PG8_MMA(1, 0, At, B0); PG8_MMA(1, 1, At, B1); PG8_BAR; PG8_SCHED;
        }
        if constexpr (ALIGN_EPI) { if (wr == 0) PG8_BAR; }
        if constexpr (FP8) { const int lq = lane_id_fresh();
            if constexpr (Epi::STASH) E(acc, cur, wr, wc, lq & 15, (lq >> 4) & 3, typename Epi::Pre{}); else E(acc, cur, wr, wc, lq & 15, (lq >> 4) & 3, pre); }
        else E(acc, cur, wr, wc, fr, fq, pre);
        if (!has_next) break;
        cur = nxt; cB = nB; ++ui;
#pragma unroll
        for (int i = 0; i < 2; ++i) { ca0[i] = na0[i]; ca1[i] = na1[i]; }
        if constexpr (FP8) { PG8_NAST(nast); const u32x4 nv = *(const LAS u32x4*)(lds + nast); ca0[0] = nv.x; ca0[1] = nv.y; ca1[0] = nv.z; ca1[1] = nv.w; }
        if constexpr (ALIGN_EPI) { if (wr == 1) PG8_BAR; }
    }
    PG8_WAIT_V(0);
    if constexpr (!ALIGN_EPI) { if (wr == 0) PG8_BAR; }
    PG8_BAR;
#undef PG8_SA
#undef PG8_SB
#undef PG8_STAGE
#undef PG8_LDA
#undef PG8_LDB
#undef PG8_MMA
#undef PG8_NAST
#undef PG8_J8
#undef PG8_WAIT_V
#undef PG8_WAIT_L
#undef PG8_BAR
#undef PG8_SCHED
}

struct DenseSched {
    const char* A; const char* Bt; int K, nM, nN, nwg, G, c, stag = 0, amask = -1;
    __device__ __forceinline__ void init(const void* A_, const void* Bt_, int M, int N, int K_, int G_, int c_) { A = (const char*)A_; Bt = (const char*)Bt_; K = K_; nM = M / BM; nN = N / BM; nwg = nM * nN; G = G_; c = c_; }
    __device__ __forceinline__ bool next(int i, Unit& u) const {
        const long L = (long)i * G + c; if (L >= nwg) return false;
        int wgid = (int)L; { const int q = nwg / 8, r = nwg % 8, xcd = wgid % 8, off = wgid / 8; wgid = (xcd < r ? xcd * (q + 1) : r * (q + 1) + (xcd - r) * q) + off; }
        const int nig = 8 * nN, gid = wgid / nig, fm = gid * 8, gsz = (nM - fm) < 8 ? (nM - fm) : 8;
        u.pm = fm + ((wgid % nig) % gsz); u.pn = (wgid % nig) / gsz; u.e = 0; return true;
    }
    __device__ __forceinline__ const char* a_base() const { return A; }
    __device__ __forceinline__ int stagger() const { return stag ? ((c >> 3) & 7) * (K / 55) : 0; }
    __device__ __forceinline__ unsigned a_off(const Unit& u, int row, int col) const { return (unsigned)(((size_t)((u.pm * BM + row) & amask) * K + col) * 2); }
    __device__ __forceinline__ int a_row(const Unit& u, int row) const { return (u.pm * BM + row) & amask; }
    __device__ __forceinline__ unsigned row_off(int r, int col) const { return (unsigned)(((size_t)r * K + col) * 2); }
    __device__ __forceinline__ const char* b_tile(const Unit& u) const { return Bt + (size_t)u.pn * BM * K * 2; }
};
}

namespace pg8 {
struct MoeSched {
    const char* A; const char* Bt; const int* slot_tok; volatile LAS unsigned* tstart; int K, rowsE, nN, c;
    __device__ __forceinline__ bool next(int i, Unit& u) const {
        const int x = c & 7, j = c >> 3, rpr = 32 / nN;
        const int pm = (i * 8 + x) * rpr + j / nN;
        const int T = (int)tstart[32];
        if (pm >= T) return false;
        int e = 0;
#pragma unroll 1
        for (int k = 1; k < 32; ++k) e += ((int)tstart[k] <= pm) ? 1 : 0;
        u.pm = pm; u.pn = j % nN; u.e = __builtin_amdgcn_readfirstlane(e); return true;
    }
    __device__ __forceinline__ const char* a_base() const { return A; }
    __device__ __forceinline__ int stagger() const { const int g = (c >> 3) / nN, ng = 32 / nN; (void)g; (void)ng; return 0; }
    __device__ __forceinline__ unsigned a_off(const Unit& u, int row, int col) const {
        const int pos = u.pm * BM + row;
        const int r = slot_tok ? slot_tok[pos] : pos;
        return (unsigned)(((size_t)r * K + col) * 2);
    }
    __device__ __forceinline__ int a_row(const Unit& u, int row) const { const int pos = u.pm * BM + row; return slot_tok ? ((const GAS int*)slot_tok)[pos] : pos; }
    __device__ __forceinline__ unsigned row_off(int r, int col) const { return (unsigned)(((size_t)r * K + col) * 2); }
    __device__ __forceinline__ const char* b_tile(const Unit& u) const { return Bt + ((size_t)u.e * rowsE + (size_t)u.pn * BM) * K * 2; }
};

struct MergeSched {
    const char* A; const char* Bt; int nM, nN, nwg, G, c;
    __device__ __forceinline__ void init(const void* A_, const void* Bt_, int M, int N, int G_, int c_) { A = (const char*)A_; Bt = (const char*)Bt_; nM = M / BM; nN = N / BM; nwg = nM * nN; G = G_; c = c_; }
    __device__ __forceinline__ bool next(int i, Unit& u) const {
        const int r = i / 3; const long L = (long)r * G + c; if (L >= nwg) return false;
        int wgid = (int)L; { const int q = nwg / 8, rr = nwg % 8, xcd = wgid % 8, off = wgid / 8; wgid = (xcd < rr ? xcd * (q + 1) : rr * (q + 1) + (xcd - rr) * q) + off; }
        const int nig = 8 * nN, gid = wgid / nig, fm = gid * 8, gsz = (nM - fm) < 8 ? (nM - fm) : 8;
        u.pm = fm + ((wgid % nig) % gsz); u.pn = (wgid % nig) / gsz; u.e = i - 3 * r; return true;
    }
    __device__ __forceinline__ const char* a_base() const { return A; }
    __device__ __forceinline__ int stagger() const { return 0; }
    __device__ __forceinline__ unsigned a_off(const Unit& u, int row, int col) const { return (unsigned)(((size_t)(u.pm * BM + row) * 512 + col) * 2 + (size_t)u.e * ((size_t)NTOK * 512 * 2)); }
    __device__ __forceinline__ const char* b_tile(const Unit& u) const { return Bt + ((size_t)u.e * DM + (size_t)u.pn * BM) * 512 * 2; }
};

constexpr int EPI_STAGE_OFF = 131072, EPI_STAGE_WAVE = 2304;
struct NoPre {};
template <int ACT> struct EpiBf16 {
    static constexpr bool PERM = true, DRAIN_TOP = false, STASH = false;
    struct Pre { f32x4 bv[2][2]; };
    bf16_t* O; int ldc; const float* bias; int rowmask = -1;
    __device__ __forceinline__ Pre preload(const Unit& u, int wr, int wc, int fr, int fq) const { Pre p; const int col0 = u.pn * BM + wc * 32 + 8 * fq;
#pragma unroll
        for (int bj = 0; bj < 2; ++bj)
#pragma unroll
            for (int n = 0; n < 2; ++n) p.bv[bj][n] = (f32x4){0.f, 0.f, 0.f, 0.f};
        return p; }
    __device__ __forceinline__ void arrived(Pre& p) const { asm volatile("" : "+v"(p.bv[0][0]), "+v"(p.bv[0][1]), "+v"(p.bv[1][0]), "+v"(p.bv[1][1])); }
    __device__ __forceinline__ void operator()(const f32x4 (&acc)[2][2][4][2], const Unit& u, int wr, int wc, int fr, int fq, const Pre& pre) const {
        const int row0 = u.pm * BM + wr * 64 + fr; const int col0 = u.pn * BM + wc * 32 + 8 * fq;
        f32x4 bv[2][2];
#pragma unroll
        for (int bj = 0; bj < 2; ++bj)
#pragma unroll
            for (int n = 0; n < 2; ++n) bv[bj][n] = bias ? *(const f32x4*)(bias + (ACT == 3 ? u.e * DM : 0) + col0 + bj * HALF + 4 * n) : pre.bv[bj][n];
#pragma unroll
        for (int ai = 0; ai < 2; ++ai)
#pragma unroll
            for (int m = 0; m < 4; ++m) { bf16_t* rowp = O + (size_t)((row0 + ai * HALF + m * 16) & rowmask) * ldc + col0;
#pragma unroll
                for (int bj = 0; bj < 2; ++bj) { constexpr float sc = (ACT >= 2) ? W8_INV : 1.f;
                    f32x4 v0 = acc[ai][bj][m][0] * sc + bv[bj][0], v1 = acc[ai][bj][m][1] * sc + bv[bj][1];
                    u32x4 w; w.x = cvt_pk_bf16(v0[0], v0[1]); w.y = cvt_pk_bf16(v0[2], v0[3]); w.z = cvt_pk_bf16(v1[0], v1[1]); w.w = cvt_pk_bf16(v1[2], v1[3]);
                    *(u32x4*)(rowp + bj * HALF) = w; } }
    }
};
struct EpiGateU8 {
    static constexpr bool PERM = true, DRAIN_TOP = false, STASH = false;
    typedef NoPre Pre; __device__ __forceinline__ Pre preload(const Unit&, int, int, int, int) const { return Pre{}; }
    unsigned char* G; const float* bias;
    __device__ __forceinline__ void operator()(const f32x4 (&acc)[2][2][4][2], const Unit& u, int wr, int wc, int fr, int fq, const Pre&) const {
        const int row0 = u.pm * BM + wr * 64 + fr; const int col0 = u.pn * BM + wc * 32 + 8 * fq;
        f32x4 bv[2][2];
#pragma unroll
        for (int bj = 0; bj < 2; ++bj)
#pragma unroll
            for (int n = 0; n < 2; ++n) bv[bj][n] = *(const f32x4*)(bias + col0 + bj * HALF + 4 * n);
#pragma unroll
        for (int ai = 0; ai < 2; ++ai)
#pragma unroll
            for (int m = 0; m < 4; ++m) { unsigned char* rowp = G + (size_t)(row0 + ai * HALF + m * 16) * PW + col0;
#pragma unroll
                for (int bj = 0; bj < 2; ++bj) { u32x2 w;
#pragma unroll
                    for (int n = 0; n < 2; ++n) { const f32x4 v = acc[ai][bj][m][n] * W8_INV + bv[bj][n]; unsigned q[4];
#pragma unroll
                        for (int j = 0; j < 4; ++j) q[j] = (unsigned)(255.f * __builtin_amdgcn_rcpf(1.f + __builtin_amdgcn_exp2f(-LOG2E * v[j])) + 0.5f);
                        const unsigned pk = q[0] | (q[1] << 8) | (q[2] << 16) | (q[3] << 24);
                        if (n == 0) w.x = pk; else w.y = pk; }
                    *(u32x2*)(rowp + bj * HALF) = w; } }
    }
};
struct EpiMerge {
    static constexpr bool PERM = true, DRAIN_TOP = false, STASH = false;
    typedef NoPre Pre; __device__ __forceinline__ Pre preload(const Unit&, int, int, int, int) const { return Pre{}; }
    const unsigned char* G; bf16_t* Mg;
    __device__ __forceinline__ void operator()(const f32x4 (&acc)[2][2][4][2], const Unit& u, int wr, int wc, int fr, int fq, const Pre&) const {
        const int row0 = u.pm * BM + wr * 64 + fr; const int col0 = u.pn * BM + wc * 32 + 8 * fq;
        const int goff = u.e * DM; const bool first = (u.e == 0);
#pragma unroll
        for (int ai = 0; ai < 2; ++ai)
#pragma unroll
            for (int m = 0; m < 4; ++m) { const size_t row = (size_t)(row0 + ai * HALF + m * 16);
#pragma unroll
                for (int bj = 0; bj < 2; ++bj) {
                    const u32x2 g = *(const u32x2*)(G + row * PW + goff + col0 + bj * HALF);
                    u32x4 p = (u32x4){0u, 0u, 0u, 0u};
                    if (!first) p = *(const u32x4*)(Mg + row * DM + col0 + bj * HALF);
                    const f32x4 a0 = acc[ai][bj][m][0] * (1.f / 255.f), a1 = acc[ai][bj][m][1] * (1.f / 255.f);
                    u32x4 w;
                    w.x = cvt_pk_bf16(bflo(p.x) + (float)((g.x >> 0) & 0xffu) * a0[0], bfhi(p.x) + (float)((g.x >> 8) & 0xffu) * a0[1]);
                    w.y = cvt_pk_bf16(bflo(p.y) + (float)((g.x >> 16) & 0xffu) * a0[2], bfhi(p.y) + (float)((g.x >> 24) & 0xffu) * a0[3]);
                    w.z = cvt_pk_bf16(bflo(p.z) + (float)((g.y >> 0) & 0xffu) * a1[0], bfhi(p.z) + (float)((g.y >> 8) & 0xffu) * a1[1]);
                    w.w = cvt_pk_bf16(bflo(p.w) + (float)((g.y >> 16) & 0xffu) * a1[2], bfhi(p.w) + (float)((g.y >> 24) & 0xffu) * a1[3]);
                    *(u32x4*)(Mg + row * DM + col0 + bj * HALF) = w; } }
    }
};
struct EpiResid {
    static constexpr bool PERM = true, DRAIN_TOP = false, STASH = false;
    typedef NoPre Pre; __device__ __forceinline__ Pre preload(const Unit&, int, int, int, int) const { return Pre{}; }
    const float* base; bf16_t* out;
    __device__ __forceinline__ void operator()(const f32x4 (&acc)[2][2][4][2], const Unit& u, int wr, int wc, int fr, int fq, const Pre&) const {
        const int row0 = u.pm * BM + wr * 64 + fr; const int col0 = u.pn * BM + wc * 32 + 8 * fq;
#pragma unroll
        for (int ai = 0; ai < 2; ++ai)
#pragma unroll
            for (int m = 0; m < 4; ++m) { const size_t r = (size_t)(row0 + ai * HALF + m * 16); const float* xb = base + r * DM + col0; bf16_t* ob = out + r * 2048 + (r & 1) * 1024 + col0;
#pragma unroll
                for (int bj = 0; bj < 2; ++bj) { const f32x4 v0 = *(const f32x4*)(xb + bj * HALF) + acc[ai][bj][m][0], v1 = *(const f32x4*)(xb + bj * HALF + 4) + acc[ai][bj][m][1];
                    u32x4 w; w.x = cvt_pk_bf16(v0[0], v0[1]); w.y = cvt_pk_bf16(v0[2], v0[3]); w.z = cvt_pk_bf16(v1[0], v1[1]); w.w = cvt_pk_bf16(v1[2], v1[3]);
                    *(u32x4*)(ob + bj * HALF) = w; } }
    }
};
struct EpiSwiglu {
    static constexpr bool PERM = true, DRAIN_TOP = true, STASH = true;
    unsigned char* act; const float* bias; LAS unsigned char* lds;
    struct Pre { f32x4 bg[2], bu[2]; };
    __device__ __forceinline__ Pre preload(const Unit& u, int wr, int wc, int fr, int fq) const {
        const GAS float* be = (const GAS float*)bias + (size_t)u.e * 2048 + u.pn * HALF + wc * 32 + 8 * fq; Pre p;
#pragma unroll
        for (int n = 0; n < 2; ++n) { p.bg[n] = *(const GAS f32x4*)(be + 4 * n); p.bu[n] = *(const GAS f32x4*)(be + 1024 + 4 * n); }
        return p; }
    __device__ __forceinline__ void stash(const Pre& p, int wid, int fr, int fq) const {
        LAS f32x4* st = (LAS f32x4*)(lds + EPI_STAGE_OFF + wid * 256 + fq * 64);
        if (fr == 0) { st[0] = p.bg[0]; st[1] = p.bg[1]; st[2] = p.bu[0]; st[3] = p.bu[1]; } }
    __device__ __forceinline__ void operator()(const f32x4 (&acc)[2][2][4][2], const Unit& u, int wr, int wc, int fr, int fq, const Pre& pre) const {
        const int row0 = u.pm * BM + wr * 64 + fr; const int col0 = u.pn * HALF + wc * 32 + 8 * fq;
        f32x4 bg[2], bu[2];
#pragma unroll
        for (int n = 0; n < 2; ++n) { const LAS f32x4* st = (const LAS f32x4*)(lds + EPI_STAGE_OFF + (wr * 4 + wc) * 256 + fq * 64); bg[n] = st[n]; bu[n] = st[2 + n]; }
#pragma unroll
        for (int ai = 0; ai < 2; ++ai)
#pragma unroll
            for (int m = 0; m < 4; ++m) { unsigned char* rowp = act + (size_t)(row0 + ai * HALF + m * 16) * DEXP + col0;
                float o[8];
#pragma unroll
                for (int n = 0; n < 2; ++n) { const f32x4 gv = acc[ai][0][m][n] * W8_INV + bg[n], uv = acc[ai][1][m][n] * W8_INV + bu[n];
#pragma unroll
                    for (int q = 0; q < 4; ++q) { const float g = fminf(gv[q], 7.0f); const float uu = fminf(fmaxf(uv[q], -7.0f), 7.0f);
                        const float sg = __builtin_amdgcn_rcpf(1.f + __builtin_amdgcn_exp2f(-1.702f * LOG2E * g));
                        o[4 * n + q] = (uu + 1.0f) * (g * sg); } }
                u32x2 w; w.x = pk4_f8(o[0], o[1], o[2], o[3]); w.y = pk4_f8(o[4], o[5], o[6], o[7]);
                *(u32x2*)rowp = w; }
    }
};
struct EpiScatter {
    static constexpr bool PERM = false, DRAIN_TOP = false, STASH = false;
    typedef NoPre Pre; __device__ __forceinline__ Pre preload(const Unit&, int, int, int, int) const { return Pre{}; }
    float* out; const int* slot_tok; const float* slot_w; const float* bias; LAS unsigned char* lds;
    __device__ __forceinline__ void operator()(const f32x4 (&acc)[2][2][4][2], const Unit& u, int wr, int wc, int fr, int fq, const Pre&) const {
        const int lane = fr + 16 * fq, wid = wr * 4 + wc;
        LAS float* st = (LAS float*)(lds + EPI_STAGE_OFF + wid * EPI_STAGE_WAVE);
        const int row0 = u.pm * BM + wr * 64 + fr;
        const int lcol = lane & 31, lrow = lane >> 5;
        float bv[2];
#pragma unroll
        for (int bj = 0; bj < 2; ++bj) bv[bj] = bias[(size_t)u.e * DM + u.pn * BM + bj * HALF + wc * 32 + lcol];
#pragma unroll
        for (int ai = 0; ai < 2; ++ai)
#pragma unroll
            for (int m = 0; m < 4; ++m) { const int pos = row0 + ai * HALF + m * 16; const float w = slot_w[pos]; const int tok = slot_tok[pos];
#pragma unroll
                for (int bj = 0; bj < 2; ++bj) {
#pragma unroll
                    for (int n = 0; n < 2; ++n) *(LAS f32x4*)(st + fr * 36 + 16 * n + 4 * fq) = acc[ai][bj][m][n];
                    asm volatile("s_waitcnt lgkmcnt(0)" ::: "memory");
#pragma unroll
                    for (int i = 0; i < 8; ++i) { const int r = 2 * i + lrow; const float v = st[r * 36 + lcol];
                        const float wr_ = __shfl(w, r); const int tr_ = __shfl(tok, r);
                        if (wr_ != 0.f) unsafeAtomicAdd(out + (size_t)tr_ * DM + u.pn * BM + bj * HALF + wc * 32 + lcol, (v + bv[bj]) * wr_); }
                    asm volatile("s_waitcnt lgkmcnt(0)" ::: "memory");
                } }
    }
};
}

#define XB_TMO      128
#define XB_XCNT(j)  (256  + 64 * (j))
#define XB_XSUB(j)  (1280 + 64 * (j))
#define XB_XGEN(j)  (2304 + 64 * (j))
#define XB_TOP      3328
#define XB_TOPGEN   3392
#define XCD_BAR_WORDS 3456
#define XB_SPIN_CAP (1u << 18)

__device__ __forceinline__ unsigned xb_ld(unsigned* p)              { return __hip_atomic_load(p, __ATOMIC_RELAXED, __HIP_MEMORY_SCOPE_AGENT); }
__device__ __forceinline__ unsigned xb_add(unsigned* p, unsigned v) { return __hip_atomic_fetch_add(p, v, __ATOMIC_RELAXED, __HIP_MEMORY_SCOPE_AGENT); }
__device__ __forceinline__ unsigned xb_xcc_id() { return (unsigned)__builtin_amdgcn_s_getreg((3 << 11) | 20) & 0xFu; }
#define XB_SPIN(cond, bar) do { unsigned _sp = 0; while (cond) { __builtin_amdgcn_s_sleep(1); \
    if ((++_sp & 255u) == 0u) { if (xb_ld(&(bar)[XB_TMO])) break; if (_sp > XB_SPIN_CAP) { atomicAdd(&(bar)[XB_TMO], 1u); break; } } } } while (0)

struct XcdBarrier {
    unsigned* bar; unsigned x; int wave;
    volatile LAS unsigned* st;
};

__device__ __forceinline__ XcdBarrier xcd_barrier_post(unsigned* bar, volatile LAS unsigned* st) {
    XcdBarrier b; b.bar = bar; b.x = xb_xcc_id(); b.st = st; b.wave = __builtin_amdgcn_readfirstlane((int)(threadIdx.x >> 6));
    if (threadIdx.x == 0) (void)xb_add(&bar[XB_XCNT(b.x)], 1u);
    return b;
}
__device__ __forceinline__ void xcd_barrier_complete(unsigned* bar, unsigned x, unsigned& nloc, unsigned& nx) {
    const unsigned G = gridDim.x * gridDim.y * gridDim.z;
    unsigned sum, cnt, mine, sp = 0u;
    for (;;) {
        sum = 0u; cnt = 0u; mine = 0u;
#pragma unroll
        for (unsigned j = 0; j < 16; ++j) { const unsigned c = xb_ld(&bar[XB_XCNT(j)]); sum += c; cnt += (c > 0u) ? 1u : 0u; mine = (j == x) ? c : mine; }
        if (sum == G) break;
        __builtin_amdgcn_s_sleep(1);
        if ((++sp & 255u) == 0u) { if (xb_ld(&bar[XB_TMO])) break; if (sp > XB_SPIN_CAP) { atomicAdd(&bar[XB_TMO], 1u); break; } }
    }
    nloc = mine > 0u ? mine : 1u; nx = cnt > 0u ? cnt : 1u;
}

__device__ __forceinline__ void xcd_barrier(const XcdBarrier& b) {
    asm volatile("s_waitcnt vmcnt(0)" ::: "memory");
    __syncthreads();
    if (b.wave == 0 && lane_id_fresh() == 0) {
        unsigned* bar = b.bar;
        __builtin_amdgcn_s_waitcnt(0);
        unsigned nloc = b.st[0], nx = b.st[1];
        if (nloc == 0u) { xcd_barrier_complete(bar, b.x, nloc, nx); b.st[0] = nloc; b.st[1] = nx; }
        const unsigned old = xb_add(&bar[XB_XSUB(b.x)], 1u);
        const unsigned gen = old / nloc;
        if (old + 1u == (gen + 1u) * nloc) {
            __builtin_amdgcn_fence(__ATOMIC_RELEASE, "agent");
            asm volatile("s_waitcnt vmcnt(0)" ::: "memory");
            const unsigned og = xb_add(&bar[XB_TOP], 1u);
            const unsigned tg = og / nx;
            if (og + 1u == (tg + 1u) * nx) xb_add(&bar[XB_TOPGEN], 1u);
            else XB_SPIN(xb_ld(&bar[XB_TOPGEN]) == tg, bar);
            __builtin_amdgcn_fence(__ATOMIC_ACQUIRE, "agent");
            xb_add(&bar[XB_XGEN(b.x)], 1u);
            asm volatile("s_waitcnt vmcnt(0)" ::: "memory");
        } else {
            XB_SPIN(xb_ld(&bar[XB_XGEN(b.x)]) == gen, bar);
            __builtin_amdgcn_fence(__ATOMIC_ACQUIRE, "agent");
            asm volatile("s_waitcnt vmcnt(0)" ::: "memory");
        }
    }
    __syncthreads();
}

constexpr int NWAVES = 8;
struct Frame {
    LAS unsigned char* lds;
    volatile LAS unsigned* MISC;
    gu32* ctl;
    int tid, lane, wave, G, blk;
    const float* in[21];
    float* out; unsigned char* ws;
};
__device__ __forceinline__ float wave_sum(float v) {
#pragma unroll
    for (int o = 1; o < 64; o <<= 1) v += __shfl_xor(v, o);
    return v;
}

__device__ __forceinline__ int map_src(int mode, int n) {
    if (mode == 1) return n < 2500 ? n : (n >= C_MQ ? n - (C_MQ - 2500) : -1);
    if (mode == 2) { const int pn = n >> 8, bj = (n >> 7) & 1, j = n & 127; return bj * 1024 + pn * 128 + j; }
    return n;
}
__device__ __forceinline__ void transpose_item(const float* W, int K, int Nsrc, int Ndst, bf16_t* WT, int mode, LAS float* scr, int item, int lane) {
    const int nblk = Ndst / 32, kb = item / nblk, nb = item % nblk, k0 = 64 * kb, n0 = 32 * nb;
    const int sc = map_src(mode, n0 + (lane & 31));
    const float scale = (mode == 1 && (n0 + (lane & 31)) < 512) ? 0.125f : 1.0f;
#pragma unroll
    for (int i = 0; i < 32; ++i) { const int kk = 2 * i + (lane >> 5); scr[kk * 33 + (lane & 31)] = sc >= 0 ? W[(size_t)(k0 + kk) * Nsrc + sc] * scale : 0.f; }
    LDS_WAIT(); asm volatile("" ::: "memory");
    const int c = lane & 7;
#pragma unroll
    for (int j = 0; j < 4; ++j) { const int n = (lane >> 3) + 8 * j; const LAS float* s = scr + (8 * c) * 33 + n;
        u32x4 o; o.x = pk2(s[0 * 33], s[1 * 33]); o.y = pk2(s[2 * 33], s[3 * 33]); o.z = pk2(s[4 * 33], s[5 * 33]); o.w = pk2(s[6 * 33], s[7 * 33]);
        *(GAS u32x4*)(WT + (size_t)(n0 + n) * K + k0 + 8 * c) = o; }
    LDS_WAIT(); asm volatile("" ::: "memory");
}
__device__ __forceinline__ void transpose_item_f8(const float* W, int K, int Nsrc, int Ndst, unsigned char* WT, int mode, float scale, LAS float* scr, int item, int lane) {
    const int nblk = Ndst / 32, kb = item / nblk, nb = item % nblk, k0 = 64 * kb, n0 = 32 * nb;
    const int sc = map_src(mode, n0 + (lane & 31));
#pragma unroll
    for (int i = 0; i < 32; ++i) { const int kk = 2 * i + (lane >> 5); scr[kk * 33 + (lane & 31)] = sc >= 0 ? W[(size_t)(k0 + kk) * Nsrc + sc] * scale : 0.f; }
    LDS_WAIT(); asm volatile("" ::: "memory");
    const int c = lane & 7;
#pragma unroll
    for (int j = 0; j < 4; ++j) { const int n = (lane >> 3) + 8 * j; const LAS float* s = scr + (8 * c) * 33 + n;
        u32x2 o; o.x = pk4_f8(s[0 * 33], s[1 * 33], s[2 * 33], s[3 * 33]); o.y = pk4_f8(s[4 * 33], s[5 * 33], s[6 * 33], s[7 * 33]);
        *(GAS u32x2*)(WT + (size_t)(n0 + n) * K + k0 + 8 * c) = o; }
    LDS_WAIT(); asm volatile("" ::: "memory");
}
__device__ __forceinline__ void rms_row_to_bf16(int lane, const float* xrow, const float* g, bf16_t* orow) {
    const GAS f32x4* xr = (const GAS f32x4*)xrow + lane; const GAS f32x4* gr = (const GAS f32x4*)g + lane;
    f32x4 v[4]; float s = 0.f;
#pragma unroll
    for (int j = 0; j < 4; ++j) { v[j] = xr[64 * j]; s += (v[j].x * v[j].x + v[j].y * v[j].y) + (v[j].z * v[j].z + v[j].w * v[j].w); }
    const float rstd = 1.0f / sqrtf(wave_sum(s) * (1.f / DM) + EPS);
    GAS u32x2* o8 = (GAS u32x2*)orow + lane;
#pragma unroll
    for (int j = 0; j < 4; ++j) { const f32x4 gg = gr[64 * j]; u32x2 o; o.x = pk2(v[j].x * rstd * gg.x, v[j].y * rstd * gg.y); o.y = pk2(v[j].z * rstd * gg.z, v[j].w * rstd * gg.w); o8[64 * j] = o; }
}

__device__ __forceinline__ void rms_rows4_to_bf16(int lane, const float* x, const float* g, bf16_t* o, size_t m0, size_t stride, unsigned char* o8f = nullptr) {
    f32x4 v[4][4]; float s[4];
#pragma unroll
    for (int r = 0; r < 4; ++r) { const GAS f32x4* xr = (const GAS f32x4*)(x + (m0 + r * stride) * DM) + lane;
#pragma unroll
        for (int j = 0; j < 4; ++j) v[r][j] = xr[64 * j]; }
    const GAS f32x4* gr = (const GAS f32x4*)g + lane;
    f32x4 gg[4];
#pragma unroll
    for (int j = 0; j < 4; ++j) gg[j] = gr[64 * j];
#pragma unroll
    for (int r = 0; r < 4; ++r) { float a = 0.f;
#pragma unroll
        for (int j = 0; j < 4; ++j) a += (v[r][j].x * v[r][j].x + v[r][j].y * v[r][j].y) + (v[r][j].z * v[r][j].z + v[r][j].w * v[r][j].w);
        s[r] = a; }
#pragma unroll
    for (int of = 1; of < 64; of <<= 1) {
#pragma unroll
        for (int r = 0; r < 4; ++r) s[r] += __shfl_xor(s[r], of); }
#pragma unroll
    for (int r = 0; r < 4; ++r) { const float rstd = 1.0f / sqrtf(s[r] * (1.f / DM) + EPS);
        GAS u32x2* o8 = (GAS u32x2*)(o + (m0 + r * stride) * DM) + lane;
#pragma unroll
        for (int j = 0; j < 4; ++j) { const float a0 = v[r][j].x * rstd * gg[j].x, a1 = v[r][j].y * rstd * gg[j].y, a2 = v[r][j].z * rstd * gg[j].z, a3 = v[r][j].w * rstd * gg[j].w;
            u32x2 w; w.x = pk2(a0, a1); w.y = pk2(a2, a3); o8[64 * j] = w;
            if (o8f) *((GAS unsigned*)(o8f + (m0 + r * stride) * DM) + lane + 64 * j) = pk4_f8(a0, a1, a2, a3); } }
}
__device__ __forceinline__ void p0_prologue(Frame& F) {
    LAS float* scr = (LAS float*)(F.lds + F.wave * 16384);
    const int gw = F.blk * NWAVES + F.wave, NGW = F.G * NWAVES, lane = F.lane;
    unsigned char* ws = F.ws;
    constexpr int I_IN = 16 * 96, I_MKV = 16 * 32, I_G = 16 * 32, I_B = 8 * 32, I_O = 16 * 32, I_EI = 16 * 64, I_EO = 16 * 32;
    constexpr int NITEMS = I_IN + I_MKV + 3 * I_G + 3 * I_B + I_O + NEXP * I_EI + NEXP * I_EO;
    for (int it = gw; it < NITEMS; it += NGW) {
        int r = it;
        if (r < I_IN) { transpose_item(F.in[3], DM, IN_W, PW, (bf16_t*)(ws + WS_WIN), 1, scr, r, lane); continue; } r -= I_IN;
        if (r < I_MKV) { transpose_item(F.in[9], DM, DM, DM, (bf16_t*)(ws + WS_WMKV), 0, scr, r, lane); continue; } r -= I_MKV;
        if (r < 3 * I_G) { const int n = r / I_G; transpose_item_f8(F.in[10] + (size_t)n * DM * DM, DM, DM, DM, ws + WS_WG + (size_t)n * DM * DM, 0, W8_SCALE, scr, r % I_G, lane); continue; } r -= 3 * I_G;
        if (r < 3 * I_B) { const int n = r / I_B; transpose_item(F.in[12] + (size_t)n * 512 * DM, 512, DM, DM, (bf16_t*)(ws + WS_WB) + (size_t)n * DM * 512, 0, scr, r % I_B, lane); continue; } r -= 3 * I_B;
        if (r < I_O) { transpose_item(F.in[13], DM, DM, DM, (bf16_t*)(ws + WS_WO), 0, scr, r, lane); continue; } r -= I_O;
        if (r < NEXP * I_EI) { const int e = r / I_EI; transpose_item_f8(F.in[17] + (size_t)e * DM * 2048, DM, 2048, 2048, ws + WS_WEI + (size_t)e * 2048 * DM, 2, W8_SCALE, scr, r % I_EI, lane); continue; } r -= NEXP * I_EI;
        { const int e = r / I_EO; transpose_item_f8(F.in[19] + (size_t)e * DM * DM, DM, DM, DM, ws + WS_WEO + (size_t)e * DM * DM, 0, W8_SCALE, scr, r % I_EO, lane); }
    }
    { f32x2* tab = (f32x2*)(ws + WS_ROPE);
      for (int idx = (F.blk * NWAVES * 64) + F.tid; idx < SEQ * 32; idx += F.G * NWAVES * 64) {
          const int s = idx >> 5, i = idx & 31;
          const float inv = exp2f(-(float)i * (13.287712379549449f / 32.0f));
          const float ang = (float)s * inv;
          const double rev = (double)ang * 0.15915494309189535;
          const float fr = (float)(rev - __builtin_rint(rev));
          tab[idx] = (f32x2){__builtin_amdgcn_cosf(fr), __builtin_amdgcn_sinf(fr)}; } }
    for (int m = gw; m < NTOK; m += 4 * NGW) rms_rows4_to_bf16(lane, F.in[0], F.in[2], (bf16_t*)(ws + WS_H), (size_t)m, (size_t)NGW, ws + WS_H8);
    for (int m = gw; m < NMEM; m += 4 * NGW) rms_rows4_to_bf16(lane, F.in[1], F.in[8], (bf16_t*)(ws + WS_MEMN), (size_t)m, (size_t)NGW);
    { int* st = (int*)(ws + WS_SLOT_TOK);
      for (int i = F.blk * NWAVES * 64 + F.tid; i < NSLOT_PAD; i += F.G * NWAVES * 64) st[i] = 0; }
}

template <int CTRL> __device__ __forceinline__ float dppf(float v) { return __builtin_bit_cast(float, __builtin_amdgcn_update_dpp(0, __builtin_bit_cast(int, v), CTRL, 0xF, 0xF, false)); }
__device__ __forceinline__ float lx1(float v) { return dppf<0xB1>(v); }
__device__ __forceinline__ float lx2(float v) { return dppf<0x4E>(v); }
__device__ __forceinline__ float lx4(float v) { return dppf<0x1B>(dppf<0x141>(v)); }
__device__ __forceinline__ float lx8(float v) { return dppf<0x128>(v); }
__device__ __forceinline__ void un8(const u32x4 w, float (&v)[8]) { v[0] = bflo(w.x); v[1] = bfhi(w.x); v[2] = bflo(w.y); v[3] = bfhi(w.y); v[4] = bflo(w.z); v[5] = bfhi(w.z); v[6] = bflo(w.w); v[7] = bfhi(w.w); }
__device__ __forceinline__ u32x4 pk8(const float (&v)[8]) { u32x4 w; w.x = pk2(v[0], v[1]); w.y = pk2(v[2], v[3]); w.z = pk2(v[4], v[5]); w.w = pk2(v[6], v[7]); return w; }
__device__ __forceinline__ void rope8(float (&v)[8], const f32x2 (&cs)[8], bool up) {
#pragma unroll
    for (int j = 0; j < 8; ++j) { const float other = lx4(v[j]); v[j] = up ? (other * cs[j].y + v[j] * cs[j].x) : (v[j] * cs[j].x - other * cs[j].y); }
}
__device__ __forceinline__ void p2_prep(Frame& F, const bool dummy = false) {
    const int gw = F.blk * NWAVES + F.wave, NGW = F.G * NWAVES, lane = F.lane;
    bf16_t* proj = (bf16_t*)(F.ws + WS_P);
    bf16_t* projw = dummy ? (bf16_t*)(F.ws + WS_END) : proj;
    const int wmask = dummy ? 8191 : 0x7fffffff;
    const f32x2* tab = (const f32x2*)(F.ws + WS_ROPE);
    float gqd[8], gkd[8], gqm[8];
#pragma unroll
    for (int j = 0; j < 8; ++j) { gqd[j] = F.in[4][8 * (lane & 7) + j] * (0.125f * LOG2E); gkd[j] = F.in[5][8 * (lane & 7) + j]; gqm[j] = F.in[6][8 * (lane & 15) + j] * (0.08838834764831845f * LOG2E); }
    const bool up = (lane & 4) != 0; const int i0 = (lane & 3) * 8;
    for (int m0 = gw; m0 < NTOK; m0 += 2 * NGW) {
        u32x4 raw[2][5]; f32x2 cs[2][8];
#pragma unroll
        for (int t = 0; t < 2; ++t) { const GAS bf16_t* row = (const GAS bf16_t*)proj + (size_t)(m0 + t * NGW) * PW;
            raw[t][0] = *(const GAS u32x4*)(row + C_DQ + 8 * lane); raw[t][1] = *(const GAS u32x4*)(row + C_DK + 8 * (lane & 7)); raw[t][2] = *(const GAS u32x4*)(row + C_IQ + 8 * (lane & 31));
            raw[t][3] = *(const GAS u32x4*)(row + C_IK + 8 * (lane & 7)); raw[t][4] = *(const GAS u32x4*)(row + C_MQ + 8 * lane);
            const GAS f32x2* tr = (const GAS f32x2*)tab + (size_t)((m0 + t * NGW) & (SEQ - 1)) * 32 + i0;
#pragma unroll
            for (int j = 0; j < 8; ++j) cs[t][j] = tr[j]; }
#pragma unroll
        for (int t = 0; t < 2; ++t) {
            GAS bf16_t* roww = (GAS bf16_t*)projw + (size_t)((m0 + t * NGW) & wmask) * PW;
            float v[8];
            { un8(raw[t][0], v); float ss = 0.f;
#pragma unroll
              for (int j = 0; j < 8; ++j) ss += v[j] * v[j];
              ss += lx1(ss); ss += lx2(ss); ss += lx4(ss);
              const float rstd = 1.0f / sqrtf(ss * (1.f / 64.f) + EPS);
#pragma unroll
              for (int j = 0; j < 8; ++j) v[j] = v[j] * rstd * gqd[j];
              rope8(v, cs[t], up);
              *(GAS u32x4*)(roww + C_DQ + 8 * lane) = pk8(v); }
            { un8(raw[t][1], v); float ss = 0.f;
#pragma unroll
              for (int j = 0; j < 8; ++j) ss += v[j] * v[j];
              ss += lx1(ss); ss += lx2(ss); ss += lx4(ss);
              const float rstd = 1.0f / sqrtf(ss * (1.f / 64.f) + EPS);
#pragma unroll
              for (int j = 0; j < 8; ++j) v[j] = v[j] * rstd * gkd[j];
              rope8(v, cs[t], up);
              if (lane < 8) *(GAS u32x4*)(roww + C_DK + 8 * lane) = pk8(v); }
            { un8(raw[t][2], v); rope8(v, cs[t], up); if (lane < 32) *(GAS u32x4*)(roww + C_IQ + 8 * lane) = pk8(v); }
            { un8(raw[t][3], v); rope8(v, cs[t], up); if (lane < 8) *(GAS u32x4*)(roww + C_IK + 8 * lane) = pk8(v); }
            { un8(raw[t][4], v); float ss = 0.f;
#pragma unroll
              for (int j = 0; j < 8; ++j) ss += v[j] * v[j];
              ss += lx1(ss); ss += lx2(ss); ss += lx4(ss); ss += lx8(ss);
              const float rstd = 1.0f / sqrtf(ss * (1.f / 128.f) + EPS);
#pragma unroll
              for (int j = 0; j < 8; ++j) v[j] = v[j] * rstd * gqm[j];
              *(GAS u32x4*)(roww + C_MQ + 8 * lane) = pk8(v); }
        }
    }
    bf16_t* mkv = (bf16_t*)(F.ws + WS_MKV);
    if (!dummy) for (int m = gw; m < NMEM; m += NGW) {
        GAS bf16_t* row = (GAS bf16_t*)mkv + (size_t)m * DM; float v[8];
        un8(*(const GAS u32x4*)(row + 8 * lane), v); float ss = 0.f;
#pragma unroll
        for (int j = 0; j < 8; ++j) ss += v[j] * v[j];
        ss += lx1(ss); ss += lx2(ss); ss += lx4(ss); ss += lx8(ss);
        const float rstd = 1.0f / sqrtf(ss * (1.f / 128.f) + EPS);
#pragma unroll
        for (int j = 0; j < 8; ++j) v[j] = v[j] * rstd * F.in[7][8 * (lane & 15) + j];
        *(GAS u32x4*)(row + 8 * lane) = pk8(v);
    }
}

#define MFMA32(a, b, c) __builtin_amdgcn_mfma_f32_32x32x16_bf16((a), (b), (c), 0, 0, 0)
typedef LAS const unsigned char* lds_cptr;
__device__ __forceinline__ s16x4 vtr(lds_cptr p) { return __builtin_bit_cast(s16x4, __builtin_amdgcn_ds_read_tr16_b64_v4i16((LAS v4i16_t*)p)); }
__device__ __forceinline__ bf16x8 vfrag(lds_cptr vbase_lane, int off) {
    const s16x4 lo = vtr(vbase_lane + off), hi = vtr(vbase_lane + off + 512);
    return (bf16x8){lo[0], lo[1], lo[2], lo[3], hi[0], hi[1], hi[2], hi[3]};
}
__device__ __forceinline__ int vtr_lane_off(int lane) { return ((lane >> 4) & 1) * 32 + (lane & 3) * 8 + (4 * (lane >> 5) + ((lane & 15) >> 2)) * 64; }
__device__ __forceinline__ bf16x8 pack8(const float* p) {
    u32x4 w; w.x = cvt_pk_bf16(p[0], p[1]); w.y = cvt_pk_bf16(p[2], p[3]); w.z = cvt_pk_bf16(p[4], p[5]); w.w = cvt_pk_bf16(p[6], p[7]);
    return __builtin_bit_cast(bf16x8, w);
}
__device__ __forceinline__ float softplus_f(float z) { return fmaxf(z, 0.f) + __logf(1.f + __expf(-fabsf(z))); }

__device__ __forceinline__ void sb_item(const bf16_t* proj, bf16_t* osb, int b, int h, int qblk, LAS unsigned char* vlds, int lane) {
    const int r32 = lane & 31, hi = lane >> 5;
    const size_t tok0 = (size_t)b * SEQ + (size_t)qblk * 32;
    bf16x8 qr[4];
    { const bf16_t* qp = proj + (tok0 + r32) * PW + C_SQ + h * 64 + hi * 8;
#pragma unroll
      for (int kk = 0; kk < 4; ++kk) qr[kk] = *(const bf16x8*)(qp + kk * 16); }
    f32x16 o0 = {}, o1 = {}; float R = 0.f;
    const lds_cptr vrd = (lds_cptr)vlds + vtr_lane_off(lane);
    bf16x8 kfn[4]; u32x4 vvn[4];
#define SB_LOAD(kt_) do { const size_t key0_ = (size_t)b * SEQ + (size_t)(kt_) * 32; const GAS bf16_t* kp_ = (const GAS bf16_t*)proj + (key0_ + r32) * PW + C_SK + h * 64 + hi * 8; \
        _Pragma("unroll") for (int kk = 0; kk < 4; ++kk) kfn[kk] = *(const GAS bf16x8*)(kp_ + kk * 16); \
        _Pragma("unroll") for (int p = 0; p < 4; ++p) vvn[p] = *(const GAS u32x4*)((const GAS bf16_t*)proj + (key0_ + 16 * (p & 1) + (lane >> 2)) * PW + C_SV + h * 64 + (p >> 1) * 32 + (lane & 3) * 8); } while (0)
    SB_LOAD(qblk);
    for (int kt = qblk; kt >= 0; --kt) {
        bf16x8 kf[4]; u32x4 vv[4];
#pragma unroll
        for (int i = 0; i < 4; ++i) { kf[i] = kfn[i]; vv[i] = vvn[i]; }
        if (kt > 0) SB_LOAD(kt - 1);
        f32x16 s = {};
#pragma unroll
        for (int kk = 0; kk < 4; ++kk) s = MFMA32(kf[kk], qr[kk], s);
        asm volatile("" ::: "memory");
#pragma unroll
        for (int p = 0; p < 4; ++p) *(LAS u32x4*)(vlds + p * 1024 + lane * 16) = vv[p];
        const bool diag = (kt == qblk);
        float sp[16], pr[16];
#pragma unroll
        for (int r = 0; r < 16; ++r) { const bool valid = !diag || (crow(r, hi) < r32); sp[r] = valid ? softplus_f(s[r]) : 0.f; }
        float T[4], U[4];
#pragma unroll
        for (int g = 0; g < 4; ++g) { T[g] = (sp[4 * g] + sp[4 * g + 1]) + (sp[4 * g + 2] + sp[4 * g + 3]); { const auto rr = __builtin_amdgcn_permlane32_swap(__float_as_uint(T[g]), __float_as_uint(T[g]), false, false); U[g] = hi ? __uint_as_float(rr[0]) : __uint_as_float(rr[1]); } }
        float run = 0.f, above[4];
#pragma unroll
        for (int g = 3; g >= 0; --g) { above[g] = run + (hi == 0 ? U[g] : 0.f); run += T[g] + U[g]; }
#pragma unroll
        for (int g = 0; g < 4; ++g) { float c = R + above[g];
#pragma unroll
            for (int j = 3; j >= 0; --j) { const int r = 4 * g + j; c += sp[r]; const bool valid = !diag || (crow(r, hi) < r32); pr[r] = valid ? __expf(s[r] - c) : 0.f; } }
        R += run;
        const bf16x8 p0 = pack8(pr), p1 = pack8(pr + 8);
        LDS_WAIT();
        const bf16x8 v00 = vfrag(vrd, 0), v01 = vfrag(vrd, 1024), v10 = vfrag(vrd, 2048), v11 = vfrag(vrd, 3072);
        o0 = MFMA32(v00, p0, o0); o0 = MFMA32(v01, p1, o0);
        o1 = MFMA32(v10, p0, o1); o1 = MFMA32(v11, p1, o1);
        asm volatile("" ::: "memory");
        if (__all(R > 30.0f)) break;
    }
#undef SB_LOAD
    bf16_t* op = osb + (tok0 + r32) * 512 + h * 64 + 4 * hi;
#pragma unroll
    for (int g = 0; g < 4; ++g) {
        u32x2 w0, w1; w0.x = cvt_pk_bf16(o0[4 * g], o0[4 * g + 1]); w0.y = cvt_pk_bf16(o0[4 * g + 2], o0[4 * g + 3]); w1.x = cvt_pk_bf16(o1[4 * g], o1[4 * g + 1]); w1.y = cvt_pk_bf16(o1[4 * g + 2], o1[4 * g + 3]);
        *(u32x2*)(op + 8 * g) = w0; *(u32x2*)(op + 32 + 8 * g) = w1; }
}

constexpr int ML_K = 0, ML_KROW = 272, ML_V = 256 * ML_KROW, ML_END = ML_V + 65536;
__device__ __forceinline__ void mem_unit(const bf16_t* proj, const bf16_t* mkv, bf16_t* omem, int b, int h, int half, LAS unsigned char* ml, int tid) {
    const int lane = tid & 63, wid = __builtin_amdgcn_readfirstlane(tid >> 6), r32 = lane & 31, hi = lane >> 5;
    { const GAS bf16_t* src = (const GAS bf16_t*)mkv + (size_t)b * MEMLEN * DM + h * 128;
#pragma unroll
      for (int i = 0; i < 8; ++i) { const int ch = tid + 512 * i, key = ch >> 4, c16 = ch & 15, kk = key & 31;
          const u32x4 kv = *(const GAS u32x4*)(src + (size_t)key * DM + c16 * 8);
          const u32x4 vv = *(const GAS u32x4*)(src + (size_t)key * DM + 512 + c16 * 8);
          *(LAS u32x4*)(ml + ML_K + key * ML_KROW + c16 * 16) = kv;
          *(LAS u32x4*)(ml + ML_V + (key >> 5) * 8192 + ((c16 >> 2) * 2 + (kk >> 4)) * 1024 + (kk & 15) * 64 + (c16 & 3) * 16) = vv; } }
    __syncthreads();
    for (int i = 0; i < 4; ++i) {
        const int qblk = half * 32 + wid * 4 + i;
        const size_t tok0 = (size_t)b * SEQ + (size_t)qblk * 32;
        bf16x8 qr[8];
        { const GAS bf16_t* qp = (const GAS bf16_t*)proj + (tok0 + r32) * PW + C_MQ + h * 128 + hi * 8;
#pragma unroll
          for (int kk = 0; kk < 8; ++kk) qr[kk] = *(const GAS bf16x8*)(qp + kk * 16); }
        f32x16 o[4] = {{}, {}, {}, {}}; float m = -1e30f, l = 0.f;
        for (int kb = 0; kb < 8; ++kb) {
            const LAS unsigned char* krd = ml + ML_K + (32 * kb + r32) * ML_KROW + hi * 16;
            f32x16 s = {};
#pragma unroll
            for (int kk = 0; kk < 8; ++kk) { const bf16x8 kf = *(const LAS bf16x8*)(krd + kk * 32); s = MFMA32(kf, qr[kk], s); }
            float mx = s[0];
#pragma unroll
            for (int r = 1; r < 16; ++r) mx = fmaxf(mx, s[r]);
            { const auto rr = __builtin_amdgcn_permlane32_swap(__float_as_uint(mx), __float_as_uint(mx), false, false); mx = fmaxf(__uint_as_float(rr[0]), __uint_as_float(rr[1])); }
            if (__any(mx > m + 8.0f)) {
                const float mn = fmaxf(m, mx), alpha = __builtin_amdgcn_exp2f(m - mn);
                l *= alpha; m = mn;
#pragma unroll
                for (int d = 0; d < 4; ++d)
#pragma unroll
                    for (int r = 0; r < 16; ++r) o[d][r] *= alpha;
            }
            float pr[16], rs = 0.f;
#pragma unroll
            for (int r = 0; r < 16; ++r) { pr[r] = __builtin_amdgcn_exp2f(s[r] - m); rs += pr[r]; }
            l += rs;
            const bf16x8 p0 = pack8(pr), p1 = pack8(pr + 8);
            const lds_cptr vrd = (lds_cptr)ml + ML_V + kb * 8192 + vtr_lane_off(lane);
#pragma unroll
            for (int d = 0; d < 4; ++d) { const bf16x8 va = vfrag(vrd, d * 2048), vb = vfrag(vrd, d * 2048 + 1024); o[d] = MFMA32(va, p0, o[d]); o[d] = MFMA32(vb, p1, o[d]); }
        }
        { const auto rr = __builtin_amdgcn_permlane32_swap(__float_as_uint(l), __float_as_uint(l), false, false); l = __uint_as_float(rr[0]) + __uint_as_float(rr[1]); }
        const float il = 1.0f / l;
        bf16_t* op = omem + (tok0 + r32) * 512 + h * 128 + 4 * hi;
#pragma unroll
        for (int d = 0; d < 4; ++d)
#pragma unroll
            for (int g = 0; g < 4; ++g) { u32x2 w; w.x = cvt_pk_bf16(o[d][4 * g] * il, o[d][4 * g + 1] * il); w.y = cvt_pk_bf16(o[d][4 * g + 2] * il, o[d][4 * g + 3] * il); *(u32x2*)(op + 32 * d + 8 * g) = w; }
    }
    __syncthreads();
}

constexpr int DL_HIST = 0, DL_PREFIX = 66048, DL_KREM = DL_PREFIX + 256, DL_MASK = 67072, DL_VT = 73728, DL_KT = DL_VT + 2 * 16384, DL_END = DL_KT + 2 * 18432, DL_IQ = DL_VT;
constexpr int TOPK_DSA = 256;

struct IqLds { const LAS unsigned char* p; __device__ __forceinline__ bf16x8 operator()(int j) const { return *(const LAS bf16x8*)(p + j * 32); } };
template <class QF>
__device__ __forceinline__ void idx_scores(const QF& qf, const bf16x8 (&kf)[4], const float (&wq)[4], unsigned (&uk)[16]) {
    float scv[16];
#pragma unroll
    for (int hd = 0; hd < 4; ++hd) { f32x16 a = (f32x16){};
#pragma unroll
        for (int kk = 0; kk < 4; ++kk) a = MFMA32(kf[kk], qf(hd * 4 + kk), a);
#pragma unroll
        for (int r = 0; r < 16; ++r) scv[r] = (hd == 0) ? wq[0] * fmaxf(a[r], 0.f) : __builtin_fmaf(wq[hd], fmaxf(a[r], 0.f), scv[r]); }
#pragma unroll
    for (int r = 0; r < 16; ++r) {
        unsigned bits = __builtin_bit_cast(unsigned, scv[r]);
        if (bits == 0x80000000u) bits = 0u;
        uk[r] = bits ^ ((unsigned)((int)bits >> 31) | 0x80000000u);
    }
}
__device__ __forceinline__ void load_ik(const bf16_t* proj, size_t tokb, int kbase, int r32, int hi, bf16x8 (&kf)[4]) {
    int kr = kbase + r32; if (kr > SEQ - 1) kr = SEQ - 1;
    const GAS bf16_t* p = (const GAS bf16_t*)proj + (tokb + kr) * PW + C_IK + 8 * hi;
#pragma unroll
    for (int kk = 0; kk < 4; ++kk) kf[kk] = *(const GAS bf16x8*)(p + kk * 16);
}

__device__ __forceinline__ void dsa_unit(const bf16_t* proj, bf16_t* odsa, unsigned* kscr  , int b, int c, LAS unsigned char* dl, int tid) {
    const int lane = tid & 63, wid = __builtin_amdgcn_readfirstlane(tid >> 6), r32 = lane & 31, hi = lane >> 5;
    const int n = 64 * (c + 1), nsteps = (n + 127) >> 7;
    const size_t tokq0 = (size_t)b * SEQ + (size_t)c * 64, tokb = (size_t)b * SEQ;
    LAS unsigned* hist = (LAS unsigned*)(dl + DL_HIST);
    LAS unsigned* prefix = (LAS unsigned*)(dl + DL_PREFIX);
    LAS unsigned* krem = (LAS unsigned*)(dl + DL_KREM);
    LAS unsigned* mask = (LAS unsigned*)(dl + DL_MASK);
    const int kb = wid >> 1, qh = wid & 1;
    { const int row = tid >> 3, c = tid & 7;
      const GAS bf16_t* src = (const GAS bf16_t*)proj + (tokq0 + row) * PW + C_IQ + c * 32;
#pragma unroll
      for (int i = 0; i < 4; ++i) *(LAS u32x4*)(dl + DL_IQ + row * 528 + c * 64 + i * 16) = *(const GAS u32x4*)(src + i * 8); }
    const IqLds iqf{dl + DL_IQ + (32 * qh + r32) * 528 + hi * 16};
    float wq[4];
    { const u32x2 w = *(const u32x2*)(proj + (tokq0 + 32 * qh + r32) * PW + C_IW);
      wq[0] = bflo(w.x) * 0.0625f; wq[1] = bfhi(w.x) * 0.0625f; wq[2] = bflo(w.y) * 0.0625f; wq[3] = bfhi(w.y) * 0.0625f; }
#ifndef REP_SEL
#define REP_SEL 1
#endif
#ifndef REP_B2
#define REP_B2 1
#endif
    LAS unsigned* selall = (LAS unsigned*)(dl + DL_HIST);
#ifndef PROBE_NOATOM
#define PROBE_NOATOM 0
#endif
    unsigned dummy = 0u;
    for (int rep_sel = 0; rep_sel < REP_SEL; ++rep_sel) {
    if (tid < 64) { prefix[tid] = 0u; krem[tid] = (n > TOPK_DSA) ? (unsigned)TOPK_DSA : 0x7fffffffu; }
    __syncthreads();
    const int pass0 = (n > TOPK_DSA) ? 0 : 3;
    GAS u32x4* kmine = (GAS u32x4*)kscr + ((size_t)wid * 64 + lane) * 4;
#define DSA_CONSUME(uk_) do { \
        if (sel) { _Pragma("unroll") for (int r = 0; r < 16; ++r) { const bool match = (pass == 0) || (((uk_)[r] >> (shift + 8)) == pfx); \
                if (match && !(PROBE_NOATOM && rep_sel + 1 < REP_SEL)) __hip_atomic_fetch_add(hist + (32 * qh + r32) * 257 + (((uk_)[r] >> shift) & 255u), 1u, __ATOMIC_RELAXED, __HIP_MEMORY_SCOPE_WORKGROUP); else dummy ^= (uk_)[r]; } } \
        else { _Pragma("unroll") for (int r = 0; r < 16; ++r) { const unsigned k24 = (uk_)[r] >> 8; gtw |= (k24 > pfx ? 1u : 0u) << crow(r, hi); eqw |= (k24 == pfx ? 1u : 0u) << crow(r, hi); } } } while (0)
#define DSA_TIES() do { if (!sel) { \
        LAS unsigned* mk = mask + (step & 1) * 768; \
        { const auto rg = __builtin_amdgcn_permlane32_swap(gtw, gtw, false, false); gtw = rg[0] | rg[1]; const auto re = __builtin_amdgcn_permlane32_swap(eqw, eqw, false, false); eqw = re[0] | re[1]; } \
        if (hi == 0) { mk[(32 * qh + r32) * 4 + kb] = gtw; mk[256 + (32 * qh + r32) * 4 + kb] = eqw; } \
        __syncthreads(); \
        if (wid == 0) { unsigned nd = krem[lane]; \
            _Pragma("unroll") for (int k4 = 0; k4 < 4; ++k4) { const unsigned g = mk[lane * 4 + k4]; unsigned e = mk[256 + lane * 4 + k4]; unsigned sl = g; \
                if (e != 0u) { const unsigned cnt = (unsigned)__builtin_popcount(e); \
                    if (cnt <= nd) { sl |= e; nd -= cnt; } \
                    else { unsigned chosen = 0u; while (nd > 0u) { const unsigned lb = e & (0u - e); chosen |= lb; e ^= lb; --nd; } sl |= chosen; } } \
                selall[lane * 64 + step * 4 + k4] = sl; } \
            krem[lane] = nd; } } } while (0)
    for (int pass = pass0; pass < ((rep_sel + 1 < REP_SEL) ? 3 : 4); ++pass) {
        const bool sel = pass < 3;
        if (sel) { for (int i = tid; i < 64 * 257; i += 512) hist[i] = 0u; __syncthreads(); }
        const int shift = 24 - 8 * pass;
        const unsigned pfx = prefix[32 * qh + r32];
        if (pass == pass0) {
            bf16x8 kfn[4]; load_ik(proj, tokb, 32 * kb, r32, hi, kfn);
            for (int step = 0; step < nsteps; ++step) {
                const int kbase = 128 * step + 32 * kb;
                bf16x8 kf[4];
#pragma unroll
                for (int kk = 0; kk < 4; ++kk) kf[kk] = kfn[kk];
                if (step + 1 < nsteps) load_ik(proj, tokb, kbase + 128, r32, hi, kfn);
                unsigned gtw = 0u, eqw = 0u;
                if (kbase < n) {
                    unsigned uk[16];
                    idx_scores(iqf, kf, wq, uk);
                    if (pass0 == 0) {
#pragma unroll
                        for (int g = 0; g < 4; ++g) kmine[(size_t)step * 2048 + g] = (u32x4){uk[4 * g], uk[4 * g + 1], uk[4 * g + 2], uk[4 * g + 3]};
                    }
                    DSA_CONSUME(uk);
                }
                DSA_TIES();
            }
        } else {
            u32x4 ka[4], kb4[4];
#define DSA_KLOAD(dst, st_) do { _Pragma("unroll") for (int g = 0; g < 4; ++g) dst[g] = kmine[(size_t)(st_) * 2048 + g]; } while (0)
            DSA_KLOAD(ka, 0);
            if (nsteps > 1 && 128 + 32 * kb < n) DSA_KLOAD(kb4, 1);
            for (int step = 0; step < nsteps; ++step) {
                const int kbase = 128 * step + 32 * kb;
                unsigned uk[16];
#pragma unroll
                for (int g = 0; g < 4; ++g) { uk[4 * g] = ka[g].x; uk[4 * g + 1] = ka[g].y; uk[4 * g + 2] = ka[g].z; uk[4 * g + 3] = ka[g].w; }
#pragma unroll
                for (int g = 0; g < 4; ++g) ka[g] = kb4[g];
                if (step + 2 < nsteps && kbase + 256 < n) DSA_KLOAD(kb4, step + 2);
                unsigned gtw = 0u, eqw = 0u;
                if (kbase < n) DSA_CONSUME(uk);
                DSA_TIES();
            }
#undef DSA_KLOAD
        }
        if (sel) {
            __syncthreads();
#pragma unroll
            for (int qi = 0; qi < 8; ++qi) {
                const int q = 8 * wid + qi;
                const LAS unsigned* hq = hist + q * 257;
                const unsigned c0 = hq[255 - 4 * lane], c1 = hq[254 - 4 * lane], c2 = hq[253 - 4 * lane], c3 = hq[252 - 4 * lane];
                const unsigned s4 = c0 + c1 + c2 + c3;
                unsigned incl = s4;
#pragma unroll
                for (int o = 1; o < 64; o <<= 1) { const unsigned t = __shfl_up(incl, o); if (lane >= o) incl += t; }
                const unsigned excl = incl - s4, kr = krem[q];
                if (excl < kr && kr <= incl) {
                    unsigned cum = excl, bin, nk;
                    if (cum + c0 >= kr) { bin = 255 - 4 * lane; nk = kr - cum; }
                    else { cum += c0; if (cum + c1 >= kr) { bin = 254 - 4 * lane; nk = kr - cum; }
                    else { cum += c1; if (cum + c2 >= kr) { bin = 253 - 4 * lane; nk = kr - cum; }
                    else { cum += c2; bin = 252 - 4 * lane; nk = kr - cum; } } }
                    prefix[q] = (prefix[q] << 8) | bin; krem[q] = nk;
                }
            }
            __syncthreads();
        }
    }
    }
    if (dummy == 0x9e3779b9u) hist[tid] = 1u;
    const int hd = wid;
    u32x4 pk[2], pv[2];
#define DSA_LOADKV(step_) do { _Pragma("unroll") for (int i_ = 0; i_ < 2; ++i_) { const int ch_ = tid + 512 * i_; int krow_ = 128 * (step_) + (ch_ >> 3); if (krow_ > SEQ - 1) krow_ = SEQ - 1; \
        const GAS bf16_t* rp_ = (const GAS bf16_t*)proj + (tokb + krow_) * PW + (ch_ & 7) * 8; pk[i_] = *(const GAS u32x4*)(rp_ + C_DK); pv[i_] = *(const GAS u32x4*)(rp_ + C_DV); } } while (0)
#define DSA_STOREKV(buf_) do { _Pragma("unroll") for (int i_ = 0; i_ < 2; ++i_) { const int ch_ = tid + 512 * i_, key_ = ch_ >> 3, c8_ = ch_ & 7, kk_ = key_ & 31; \
        *(LAS u32x4*)(dl + DL_KT + (buf_) * 18432 + key_ * 144 + c8_ * 16) = pk[i_]; \
        *(LAS u32x4*)(dl + DL_VT + (buf_) * 16384 + (key_ >> 5) * 4096 + ((c8_ >> 2) * 2 + (kk_ >> 4)) * 1024 + (kk_ & 15) * 64 + (c8_ & 3) * 16) = pv[i_]; } } while (0)
    for (int rep_b2 = 0; rep_b2 < REP_B2; ++rep_b2)
    for (int qb = 0; qb < 2; ++qb) {
        bf16x8 qr[4];
        { const GAS bf16_t* qp = (const GAS bf16_t*)proj + (tokq0 + 32 * qb + r32) * PW + C_DQ + hd * 64 + 8 * hi;
#pragma unroll
          for (int kk = 0; kk < 4; ++kk) qr[kk] = *(const GAS bf16x8*)(qp + kk * 16); }
        f32x16 o0 = {}, o1 = {}; float mrun = -1e30f, lrun = 0.f;
        DSA_LOADKV(0);
        DSA_STOREKV(0);
        __syncthreads();
#define B2_QK(S_, k4_) do { const LAS unsigned char* krd_ = kt + (32 * (k4_) + r32) * 144 + hi * 16; S_ = (f32x16){}; \
        _Pragma("unroll") for (int kk = 0; kk < 4; ++kk) { const bf16x8 kf_ = *(const LAS bf16x8*)(krd_ + kk * 32); S_ = MFMA32(kf_, qr[kk], S_); } } while (0)
#define B2_SM_PV(S_, k4_) do { \
        const int selw_ = (int)selall[(32 * qb + r32) * 64 + step * 4 + (k4_)]; float mx_ = -INFINITY; \
        _Pragma("unroll") for (int r = 0; r < 16; ++r) { const unsigned m_ = (unsigned)__builtin_amdgcn_sbfe(selw_, crow(r, hi), 1); \
            S_[r] = __uint_as_float((__float_as_uint(S_[r]) & m_) | (0xFF800000u & ~m_)); mx_ = fmaxf(mx_, S_[r]); } \
        { const auto rr_ = __builtin_amdgcn_permlane32_swap(__float_as_uint(mx_), __float_as_uint(mx_), false, false); mx_ = fmaxf(__uint_as_float(rr_[0]), __uint_as_float(rr_[1])); } \
        if (__any(mx_ > mrun + 8.0f)) { const float mn_ = fmaxf(mrun, mx_), alpha_ = __builtin_amdgcn_exp2f(mrun - mn_); lrun *= alpha_; mrun = mn_; \
            _Pragma("unroll") for (int r = 0; r < 16; ++r) { o0[r] *= alpha_; o1[r] *= alpha_; } } \
        float pr_[16], rs_ = 0.f; \
        _Pragma("unroll") for (int r = 0; r < 16; ++r) { pr_[r] = __builtin_amdgcn_exp2f(S_[r] - mrun); rs_ += pr_[r]; } \
        lrun += rs_; \
        const bf16x8 pa_ = pack8(pr_), pb_ = pack8(pr_ + 8); \
        const lds_cptr vrd_ = (lds_cptr)vt + (k4_) * 4096 + vtr_lane_off(lane); \
        const bf16x8 v00_ = vfrag(vrd_, 0), v01_ = vfrag(vrd_, 1024), v10_ = vfrag(vrd_, 2048), v11_ = vfrag(vrd_, 3072); \
        o0 = MFMA32(v00_, pa_, o0); o0 = MFMA32(v01_, pb_, o0); o1 = MFMA32(v10_, pa_, o1); o1 = MFMA32(v11_, pb_, o1); } while (0)
        for (int step = 0; step < nsteps; ++step) {
            const int buf = step & 1;
            if (step + 1 < nsteps) DSA_LOADKV(step + 1);
            LAS unsigned char* kt = dl + DL_KT + buf * 18432;
            LAS unsigned char* vt = dl + DL_VT + buf * 16384;
            f32x16 sa, sb;
            B2_QK(sa, 0);
            B2_QK(sb, 1); B2_SM_PV(sa, 0); __builtin_amdgcn_sched_barrier(0);
            if (128 * step + 64 < n) {
                B2_QK(sa, 2); B2_SM_PV(sb, 1); __builtin_amdgcn_sched_barrier(0);
                B2_QK(sb, 3); B2_SM_PV(sa, 2); __builtin_amdgcn_sched_barrier(0);
                B2_SM_PV(sb, 3);
            } else {
                B2_SM_PV(sb, 1);
            }
            if (step + 1 < nsteps) DSA_STOREKV(buf ^ 1);
            __syncthreads();
        }
#undef B2_QK
#undef B2_SM_PV
        float l = lrun; { const auto rr = __builtin_amdgcn_permlane32_swap(__float_as_uint(l), __float_as_uint(l), false, false); l = __uint_as_float(rr[0]) + __uint_as_float(rr[1]); }
        const float il = 1.0f / l;
        bf16_t* op = odsa + (tokq0 + 32 * qb + r32) * 512 + hd * 64 + 4 * hi;
#pragma unroll
        for (int g = 0; g < 4; ++g) {
            u32x2 w0, w1; w0.x = cvt_pk_bf16(o0[4 * g] * il, o0[4 * g + 1] * il); w0.y = cvt_pk_bf16(o0[4 * g + 2] * il, o0[4 * g + 3] * il);
            w1.x = cvt_pk_bf16(o1[4 * g] * il, o1[4 * g + 1] * il); w1.y = cvt_pk_bf16(o1[4 * g + 2] * il, o1[4 * g + 3] * il);
            *(u32x2*)(op + 8 * g) = w0; *(u32x2*)(op + 32 + 8 * g) = w1; }
    }
#undef DSA_LOADKV
#undef DSA_STOREKV
#undef DSA_CONSUME
#undef DSA_TIES
    __syncthreads();
}

template <int CTRL> __device__ __forceinline__ float dpp_f(float v) { return __builtin_bit_cast(float, __builtin_amdgcn_update_dpp(0, __builtin_bit_cast(int, v), CTRL, 0xF, 0xF, false)); }
constexpr int RL_WROW = 2064, RL_WHI = 0, RL_WLO = 32 * RL_WROW, RL_TKE = 2 * 32 * RL_WROW, RL_TKW = RL_TKE + 4096;
__device__ __forceinline__ void p9_router(Frame& F) {
    const int lane = F.lane, wave = F.wave, tid = F.tid, r32 = lane & 31, hi = lane >> 5;
    LAS int* tke = (LAS int*)(F.lds + RL_TKE); LAS float* tkw = (LAS float*)(F.lds + RL_TKW);
    const float* w_router = F.in[15]; const float* b_router = F.in[16]; const float* g_ffn = F.in[14];
    for (int idx = tid; idx < DM * NEXP; idx += NWAVES * 64) { const int k = idx >> 5, e = idx & 31; const float w = w_router[idx];
        const unsigned wh = f2bf(w); const unsigned wl = f2bf(w - __builtin_bit_cast(float, wh << 16));
        *(LAS bf16_t*)(F.lds + RL_WHI + e * RL_WROW + k * 2) = (bf16_t)wh; *(LAS bf16_t*)(F.lds + RL_WLO + e * RL_WROW + k * 2) = (bf16_t)wl; }
    if (tid < 32) F.MISC[MW_LCNT + tid] = 0u;
    __syncthreads();
    bf16_t* h2 = (bf16_t*)(F.ws + WS_H); unsigned char* h2f8 = F.ws + WS_H2F8;
    const GAS f32x4* gr = (const GAS f32x4*)g_ffn + lane;
    f32x4 gg[4];
#pragma unroll
    for (int j = 0; j < 4; ++j) gg[j] = gr[64 * j];
    const size_t tok0 = (size_t)F.blk * 256 + 32 * wave;
    u32x2 xnext[2][4];
#pragma unroll
    for (int tk = 0; tk < 2; ++tk) { const GAS u32x2* xr = (const GAS u32x2*)((const GAS bf16_t*)F.out + (tok0 + tk) * 2048 + ((tok0 + tk) & 1) * 1024) + lane;
#pragma unroll
        for (int j = 0; j < 4; ++j) xnext[tk][j] = xr[64 * j]; }
    for (int it = 0; it < 16; ++it) {
        f32x4 hn[2][4];
#pragma unroll
        for (int tk = 0; tk < 2; ++tk)
#pragma unroll
            for (int j = 0; j < 4; ++j) hn[tk][j] = (f32x4){bflo(xnext[tk][j].x), bfhi(xnext[tk][j].x), bflo(xnext[tk][j].y), bfhi(xnext[tk][j].y)};
        if (it + 1 < 16) {
#pragma unroll
            for (int tk = 0; tk < 2; ++tk) { const GAS u32x2* xr = (const GAS u32x2*)((const GAS bf16_t*)F.out + (tok0 + 2 * it + 2 + tk) * 2048 + ((tok0 + 2 * it + 2 + tk) & 1) * 1024) + lane;
#pragma unroll
                for (int j = 0; j < 4; ++j) xnext[tk][j] = xr[64 * j]; } }
        float s[2];
#pragma unroll
        for (int tk = 0; tk < 2; ++tk) { float a = 0.f;
#pragma unroll
            for (int j = 0; j < 4; ++j) a += (hn[tk][j].x * hn[tk][j].x + hn[tk][j].y * hn[tk][j].y) + (hn[tk][j].z * hn[tk][j].z + hn[tk][j].w * hn[tk][j].w);
            s[tk] = a; }
#pragma unroll
        for (int tk = 0; tk < 2; ++tk) { float a = s[tk];
            a += dpp_f<0xB1>(a); a += dpp_f<0x4E>(a); a += dpp_f<0x141>(a); a += dpp_f<0x128>(a);
            { const auto rr = __builtin_amdgcn_permlane16_swap(__float_as_uint(a), __float_as_uint(a), false, false); a = __uint_as_float(rr[0]) + __uint_as_float(rr[1]); }
            { const auto rr = __builtin_amdgcn_permlane32_swap(__float_as_uint(a), __float_as_uint(a), false, false); a = __uint_as_float(rr[0]) + __uint_as_float(rr[1]); }
            s[tk] = a; }
#pragma unroll
        for (int tk = 0; tk < 2; ++tk) {
            const float rstd = 1.0f / sqrtf(s[tk] * (1.f / DM) + EPS);
            GAS u32x2* o8 = (GAS u32x2*)(h2 + (tok0 + 2 * it + tk) * DM) + lane;
#pragma unroll
            for (int j = 0; j < 4; ++j) { const f32x4 v = hn[tk][j] * rstd * gg[j]; u32x2 o; o.x = pk2(v.x, v.y); o.y = pk2(v.z, v.w); o8[64 * j] = o;
                *((GAS unsigned*)(h2f8 + (tok0 + 2 * it + tk) * DM) + lane + 64 * j) = pk4_f8(v.x, v.y, v.z, v.w); }
        }
    }
    asm volatile("s_waitcnt vmcnt(0)" ::: "memory");
    f32x16 acc = {};
    { const GAS bf16_t* hp = (const GAS bf16_t*)h2 + (tok0 + r32) * DM + 8 * hi;
      const LAS unsigned char* wp = F.lds + RL_WHI + r32 * RL_WROW + 16 * hi;
#pragma unroll 8
      for (int kk = 0; kk < 64; ++kk) { const bf16x8 hb = *(const GAS bf16x8*)(hp + 16 * kk);
          const bf16x8 wh = *(const LAS bf16x8*)(wp + 32 * kk), wl = *(const LAS bf16x8*)(wp + RL_WLO + 32 * kk);
          acc = MFMA32(wh, hb, acc); acc = MFMA32(wl, hb, acc); } }
    float lg[16];
#pragma unroll
    for (int r = 0; r < 16; ++r) lg[r] = acc[r] + b_router[crow(r, hi)];
    float lv[4]; int li[4];
#pragma unroll
    for (int k = 0; k < 4; ++k) { float bv = lg[0]; int br = 0;
#pragma unroll
        for (int r = 1; r < 16; ++r) { const bool g = lg[r] > bv; bv = g ? lg[r] : bv; br = g ? r : br; }
        lv[k] = bv; li[k] = crow(br, hi);
#pragma unroll
        for (int r = 0; r < 16; ++r) lg[r] = (r == br) ? -INFINITY : lg[r]; }
    float ov[4]; int oi[4];
#pragma unroll
    for (int k = 0; k < 4; ++k) { const auto rv = __builtin_amdgcn_permlane32_swap(__float_as_uint(lv[k]), __float_as_uint(lv[k]), false, false); const auto ri = __builtin_amdgcn_permlane32_swap((unsigned)li[k], (unsigned)li[k], false, false);
        ov[k] = hi ? __uint_as_float(rv[0]) : __uint_as_float(rv[1]); oi[k] = hi ? (int)ri[0] : (int)ri[1]; }
    float tv[4]; int te[4];
    { float a0 = lv[0], a1 = lv[1], a2 = lv[2], a3 = lv[3], b0 = ov[0], b1 = ov[1], b2 = ov[2], b3 = ov[3];
      int i0 = li[0], i1 = li[1], i2 = li[2], i3 = li[3], j0 = oi[0], j1 = oi[1], j2 = oi[2], j3 = oi[3];
#pragma unroll
      for (int k = 0; k < 4; ++k) { const bool ta = (a0 > b0) || (a0 == b0 && i0 < j0);
          tv[k] = ta ? a0 : b0; te[k] = ta ? i0 : j0;
          if (ta) { a0 = a1; a1 = a2; a2 = a3; a3 = -INFINITY; i0 = i1; i1 = i2; i2 = i3; i3 = 64; }
          else { b0 = b1; b1 = b2; b2 = b3; b3 = -INFINITY; j0 = j1; j1 = j2; j2 = j3; j3 = 64; } } }
    const float e1 = __expf(tv[1] - tv[0]), e2x = __expf(tv[2] - tv[0]), e3 = __expf(tv[3] - tv[0]);
    const float inv = 1.0f / (1.0f + e1 + e2x + e3);
    if (hi == 0) { const int tl = 32 * wave + r32;
        *(LAS int*)(tke + tl * 4 + 0) = te[0]; tke[tl * 4 + 1] = te[1]; tke[tl * 4 + 2] = te[2]; tke[tl * 4 + 3] = te[3];
        tkw[tl * 4 + 0] = inv; tkw[tl * 4 + 1] = e1 * inv; tkw[tl * 4 + 2] = e2x * inv; tkw[tl * 4 + 3] = e3 * inv;
#pragma unroll
        for (int k = 0; k < 4; ++k) __hip_atomic_fetch_add((LAS unsigned*)F.MISC + MW_LCNT + te[k], 1u, __ATOMIC_RELAXED, __HIP_MEMORY_SCOPE_WORKGROUP); }
    __syncthreads();
    if (tid < 32) ((int*)(F.ws + WS_BLKCNT))[F.blk * 32 + tid] = (int)F.MISC[MW_LCNT + tid];
}
__device__ __forceinline__ void p10_assign(Frame& F) {
    const int tid = F.tid;
    const int* blkcnt = (const int*)(F.ws + WS_BLKCNT);
    LAS int* part = (LAS int*)(F.lds);
    LAS int* tke = (LAS int*)(F.lds + RL_TKE); LAS float* tkw = (LAS float*)(F.lds + RL_TKW);
    { const int e = tid & 31, p = tid >> 5; int tot = 0, bef = 0;
      for (int j = 0; j < 16; ++j) { const int bl = p * 16 + j; const int c = blkcnt[bl * 32 + e]; tot += c; bef += (bl < F.blk) ? c : 0; }
      part[p * 32 + e] = tot; part[512 + p * 32 + e] = bef; }
    __syncthreads();
    if (tid < 32) { int tot = 0, bef = 0;
        for (int p = 0; p < 16; ++p) { tot += part[p * 32 + tid]; bef += part[512 + p * 32 + tid]; }
        part[1024 + tid] = tot; F.MISC[MW_BEFORE + tid] = (unsigned)bef; F.MISC[MW_LCNT + tid] = 0u; }
    __syncthreads();
    if (tid == 0) { int ps = 0;
        for (int e = 0; e < 32; ++e) { F.MISC[MW_PSTART + e] = (unsigned)ps; F.MISC[MW_TSTART + e] = (unsigned)(ps >> 8); ps += (part[1024 + e] + 255) & ~255; }
        F.MISC[MW_PSTART + 32] = (unsigned)ps; F.MISC[MW_TSTART + 32] = (unsigned)(ps >> 8); }
    __syncthreads();
    int* slot_tok = (int*)(F.ws + WS_SLOT_TOK); int* tok_slot = (int*)(F.ws + WS_TOK_SLOT); float* tok_gate = (float*)(F.ws + WS_TOK_GATE);
    for (int idx = tid; idx < 1024; idx += NWAVES * 64) {
        const int e = tke[idx]; const float w = tkw[idx];
        const unsigned r = __hip_atomic_fetch_add((LAS unsigned*)F.MISC + MW_LCNT + e, 1u, __ATOMIC_RELAXED, __HIP_MEMORY_SCOPE_WORKGROUP);
        const unsigned pos = F.MISC[MW_PSTART + e] + F.MISC[MW_BEFORE + e] + r;
        slot_tok[pos] = F.blk * 256 + (idx >> 2); tok_slot[F.blk * 1024 + idx] = (int)pos; tok_gate[F.blk * 1024 + idx] = w;
    }
}

__device__ __forceinline__ void p13_combine(Frame& F) {
    const int gw = F.blk * NWAVES + F.wave, NGW = F.G * NWAVES, lane = F.lane;
    const int* tok_slot = (const int*)(F.ws + WS_TOK_SLOT); const float* tok_gate = (const float*)(F.ws + WS_TOK_GATE);
    const GAS bf16_t* Y = (const GAS bf16_t*)(F.ws + WS_Y);
    for (int t0 = gw; t0 < NTOK; t0 += 2 * NGW) {
        u32x4 y[2][4][2]; u32x4 xb[2][2]; f32x4 o[2][4]; float g[2][4];
#pragma unroll
        for (int tk = 0; tk < 2; ++tk) { const int t = t0 + tk * NGW;
#pragma unroll
            for (int k = 0; k < 4; ++k) { const int sl = __builtin_amdgcn_readfirstlane(tok_slot[4 * t + k]); g[tk][k] = tok_gate[4 * t + k];
                const GAS bf16_t* yr = Y + (size_t)sl * DM + 8 * lane; y[tk][k][0] = *(const GAS u32x4*)yr; y[tk][k][1] = *(const GAS u32x4*)(yr + 512); }
            const GAS bf16_t* xrow = (const GAS bf16_t*)F.out + (size_t)t * 2048 + (t & 1) * 1024 + 8 * lane;
            xb[tk][0] = *(const GAS u32x4*)xrow; xb[tk][1] = *(const GAS u32x4*)(xrow + 512); }
        asm volatile("s_waitcnt vmcnt(0)" ::: "memory");
#pragma unroll
        for (int tk = 0; tk < 2; ++tk)
#pragma unroll
            for (int h = 0; h < 2; ++h) { const u32x4 v = xb[tk][h];
                o[tk][2 * h] = (f32x4){bflo(v.x), bfhi(v.x), bflo(v.y), bfhi(v.y)}; o[tk][2 * h + 1] = (f32x4){bflo(v.z), bfhi(v.z), bflo(v.w), bfhi(v.w)}; }
#pragma unroll
        for (int tk = 0; tk < 2; ++tk) { const int t = t0 + tk * NGW;
#pragma unroll
            for (int k = 0; k < 4; ++k) { const float w = g[tk][k];
#pragma unroll
                for (int h = 0; h < 2; ++h) { const u32x4 v = y[tk][k][h];
                    o[tk][2 * h][0] += w * bflo(v.x); o[tk][2 * h][1] += w * bfhi(v.x); o[tk][2 * h][2] += w * bflo(v.y); o[tk][2 * h][3] += w * bfhi(v.y);
                    o[tk][2 * h + 1][0] += w * bflo(v.z); o[tk][2 * h + 1][1] += w * bfhi(v.z); o[tk][2 * h + 1][2] += w * bflo(v.w); o[tk][2 * h + 1][3] += w * bfhi(v.w); } }
            GAS float* orow = (GAS float*)F.out + (size_t)t * DM + 8 * lane;
            *(GAS f32x4*)orow = o[tk][0]; *(GAS f32x4*)(orow + 4) = o[tk][1]; *(GAS f32x4*)(orow + 512) = o[tk][2]; *(GAS f32x4*)(orow + 516) = o[tk][3]; }
    }
}

#ifndef MK_ONE_LAUNCH
#define MK_ONE_LAUNCH 1
#endif
constexpr int N_PHASES = 14;
struct Args { const float* in[21]; float* out; unsigned char* ws; int ph_lo, ph_hi; };
static_assert(sizeof(Args) == 21 * 8 + 8 + 8 + 8, "no padding");

__global__ void __launch_bounds__(NWAVES * 64, 2) fwd_kernel(Args args) {
    extern __shared__ __attribute__((aligned(16))) unsigned char lds[];
    Frame F;
    F.lds = (LAS unsigned char*)lds;
    F.MISC = (volatile LAS unsigned*)(F.lds + MISC_OFF);
    F.tid = threadIdx.x; F.lane = F.tid & 63; F.wave = __builtin_amdgcn_readfirstlane(F.tid >> 6);
#define FRESH() do { F.lane = lane_id_fresh(); F.tid = F.wave * 64 + F.lane; } while (0)
    F.G = gridDim.x; F.blk = blockIdx.x;
    F.ws = args.ws; F.out = args.out; F.ctl = (gu32*)(args.ws + WS_CTL);
#pragma unroll
    for (int i = 0; i < 21; ++i) F.in[i] = args.in[i];
    for (int u = F.tid; u < (LDS_BYTES - MISC_OFF) / 4; u += NWAVES * 64) ((LAS unsigned*)(F.lds + MISC_OFF))[u] = 0u;
    __syncthreads();
    const int lo = args.ph_lo, hi = args.ph_hi;
    XcdBarrier bar; bar.bar = (unsigned*)(F.ctl + CW_BAR); bar.x = 0; bar.st = nullptr; bar.wave = F.wave;
    if (hi - lo > 1) bar = xcd_barrier_post((unsigned*)(F.ctl + CW_BAR), F.MISC + MW_BAR);
#ifndef STAG
#define STAG 0
#endif
#ifndef PH_MASK
#define PH_MASK 0x3fff
#endif
#define IN(k) (((PH_MASK >> (k)) & 1) && lo <= (k) && (k) < hi)
#ifndef REP_MASK
#define REP_MASK 0
#endif
#define NREP(k) (1 + ((REP_MASK >> (k)) & 1))
#define SEAM(k) do { if (IN(k) && IN((k) + 1)) xcd_barrier(bar); } while (0)
    unsigned char* ws = args.ws;
    bf16_t* proj = (bf16_t*)(ws + WS_P);

    if (IN(0)) for (int rep = 0; rep < NREP(0); ++rep) { if (rep) xcd_barrier(bar); FRESH(); p0_prologue(F); } SEAM(0);

    if (IN(1)) {
#ifdef PROBE_P1
        { pg8::DenseSched S; S.init(ws + WS_H, ws + WS_WIN, NTOK, PW, DM, F.G, F.blk); S.amask = PROBE_P1;
          pg8::EpiBf16<0> E{(bf16_t*)(ws + WS_END), PW, nullptr, 1023};
          pg8::gemm_phase<pg8::EpiBf16<0>, pg8::DenseSched, true>(F.lds, F.wave, DM, S, E); }
        xcd_barrier(bar);
#endif
        { pg8::DenseSched S; S.init(ws + WS_H, ws + WS_WIN, NTOK, PW, DM, F.G, F.blk);
          pg8::EpiBf16<0> E{proj, PW, nullptr};
          pg8::gemm_phase<pg8::EpiBf16<0>, pg8::DenseSched, true>(F.lds, F.wave, DM, S, E); }
        { pg8::DenseSched S; S.init(ws + WS_MEMN, ws + WS_WMKV, NMEM, DM, DM, F.G, F.blk);
          pg8::EpiBf16<0> E{(bf16_t*)(ws + WS_MKV), DM, nullptr};
          pg8::gemm_phase<pg8::EpiBf16<0>, pg8::DenseSched, true>(F.lds, F.wave, DM, S, E); }
    } SEAM(1);

    if (IN(2)) { FRESH(); if (REP_MASK & 4) { p2_prep(F, true); xcd_barrier(bar); } p2_prep(F); } SEAM(2);

    if (IN(3)) {
        FRESH();
        bf16_t* osb = (bf16_t*)(ws + WS_O); bf16_t* odsa = osb + (size_t)NTOK * 512; bf16_t* omem = odsa + (size_t)NTOK * 512;
#ifndef REP_DSA
#define REP_DSA 1
#endif
#ifndef REP_SB
#define REP_SB 1
#endif
#ifndef REP_MEM
#define REP_MEM 1
#endif
#ifndef NO_DSA
        for (int rep = 0; rep < REP_DSA; ++rep)
        for (int i = 0; i < 4; ++i) { const int p = 2 * F.blk + (i >> 1), b = p >> 4, cc = p & 15, c = (i & 1) ? 31 - cc : cc; dsa_unit(proj, odsa, (unsigned*)F.out + (size_t)F.blk * 131072, b, c, F.lds, F.tid); }
#endif
        const int gw = F.blk * NWAVES + F.wave, NGW = F.G * NWAVES;
#ifndef NO_SB
        for (int rep = 0; rep < REP_SB; ++rep)
        for (int it = gw; it < NB * 8 * 64; it += NGW) { const int qblk = 63 - (it >> 8), bh = it & 255; sb_item(proj, osb, bh >> 3, bh & 7, qblk, F.lds + F.wave * 4096, F.lane); }
#endif
#ifndef NO_MEM
        for (int rep = 0; rep < REP_MEM; ++rep) {
            __syncthreads();
            for (int u = F.blk; u < NB * 4 * 2; u += F.G) mem_unit(proj, (const bf16_t*)(ws + WS_MKV), omem, u >> 3, (u >> 1) & 3, u & 1, F.lds, F.tid);
        }
#endif
    } SEAM(3);

    if (IN(4)) {
        pg8::DenseSched S; S.init(ws + WS_H8, ws + WS_WG, NTOK, 3 * DM, DM / 2, F.G, F.blk);
        pg8::EpiGateU8 E{(unsigned char*)proj, F.in[11]};
        pg8::gemm_phase<pg8::EpiGateU8, pg8::DenseSched, true, true>(F.lds, F.wave, DM / 2, S, E);
    } SEAM(4);

    if (IN(5)) { pg8::MergeSched S; S.init(ws + WS_O, ws + WS_WB, NTOK, DM, F.G, F.blk);
        pg8::EpiMerge E{(const unsigned char*)proj, (bf16_t*)(ws + WS_H)};
        pg8::gemm_phase<pg8::EpiMerge, pg8::MergeSched, true>(F.lds, F.wave, 512, S, E); } SEAM(5);


    if (IN(8)) {
        pg8::DenseSched S; S.init(ws + WS_H, ws + WS_WO, NTOK, DM, DM, F.G, F.blk); S.stag = STAG;
        pg8::EpiResid E{F.in[0], (bf16_t*)F.out};
        pg8::gemm_phase<pg8::EpiResid, pg8::DenseSched, true>(F.lds, F.wave, DM, S, E);
    } SEAM(8);

    if (IN(9)) for (int rep = 0; rep < NREP(9); ++rep) { if (rep) xcd_barrier(bar); FRESH(); p9_router(F); } SEAM(9);
    if (IN(10)) for (int rep = 0; rep < NREP(10); ++rep) { if (rep) xcd_barrier(bar); FRESH(); p10_assign(F); } SEAM(10);

    if (IN(11)) {
        pg8::MoeSched S{(const char*)(ws + WS_H2F8), (const char*)(ws + WS_WEI), (const int*)(ws + WS_SLOT_TOK), F.MISC + MW_TSTART, DM / 2, 2048, 8, F.blk};
        pg8::EpiSwiglu E{ws + WS_ACT8, F.in[18], F.lds};
        pg8::gemm_phase<pg8::EpiSwiglu, pg8::MoeSched, true, true>(F.lds, F.wave, DM / 2, S, E);
    } SEAM(11);

    if (IN(12)) {
        pg8::MoeSched S{(const char*)(ws + WS_ACT8), (const char*)(ws + WS_WEO), nullptr, F.MISC + MW_TSTART, DM / 2, DM, 4, F.blk};
        pg8::EpiBf16<3> E{(bf16_t*)(ws + WS_Y), DM, F.in[20]};
        pg8::gemm_phase<pg8::EpiBf16<3>, pg8::MoeSched, true, true>(F.lds, F.wave, DM / 2, S, E);
    } SEAM(12);

    if (IN(13)) { FRESH(); p13_combine(F); }
#undef IN
#undef SEAM
}

extern "C" void kernel_launch(void* const* d_in, const int* in_sizes, int n_in, void* d_out, int out_size, void* d_ws, size_t ws_size, hipStream_t stream) {
    static int grid = 0;
    if (grid == 0) {
        if (n_in != 21 || in_sizes[0] != NTOK * DM || out_size != NTOK * DM || ws_size < WS_END) {
            fprintf(stderr, "kernel_launch: unexpected shapes: n_in %d in0 %d out %d ws %zu (need >= %zu); nothing launched\n", n_in, n_in > 0 ? in_sizes[0] : -1, out_size, ws_size, (size_t)WS_END); grid = -1; return; }
        int dev = 0, cus = 0, per_cu = 0;
        if (hipGetDevice(&dev) != hipSuccess || hipDeviceGetAttribute(&cus, hipDeviceAttributeMultiprocessorCount, dev) != hipSuccess) { fprintf(stderr, "kernel_launch: device query failed\n"); grid = -1; return; }
        if (hipFuncSetAttribute((const void*)fwd_kernel, hipFuncAttributeMaxDynamicSharedMemorySize, LDS_BYTES) != hipSuccess) { fprintf(stderr, "kernel_launch: hipFuncSetAttribute failed\n"); grid = -1; return; }
        if (hipOccupancyMaxActiveBlocksPerMultiprocessor(&per_cu, (const void*)fwd_kernel, NWAVES * 64, LDS_BYTES) != hipSuccess || per_cu < 1)
            fprintf(stderr, "kernel_launch: note: occupancy query reports %d workgroups per CU\n", per_cu);
        (void)hipGetLastError();
        grid = cus;
        if (grid != 256) { fprintf(stderr, "kernel_launch: this kernel is built for 256 CUs (got %d); nothing launched\n", grid); grid = -1; return; }
    }
    if (grid < 0) return;
    if (hipMemsetAsync((char*)d_ws + WS_CTL, 0, CTL_ZERO_BYTES, stream) != hipSuccess) { fprintf(stderr, "kernel_launch: hipMemsetAsync failed\n"); return; }
    Args a{};
    for (int i = 0; i < 21; ++i) a.in[i] = (const float*)d_in[i];
    a.out = (float*)d_out; a.ws = (unsigned char*)d_ws;
#if MK_ONE_LAUNCH
    const int cuts[2] = {0, N_PHASES}; const int nl = 1;
#else
    const int cuts[11] = {0, 1, 2, 3, 4, 5, 6, 7, 8, 9, N_PHASES}; const int nl = 10;
#endif
    for (int li = 0; li < nl; ++li) {
        a.ph_lo = cuts[li]; a.ph_hi = cuts[li + 1];
        hipLaunchKernelGGL(fwd_kernel, dim3(grid), dim3(NWAVES * 64), LDS_BYTES, stream, a);
        const hipError_t le = hipPeekAtLastError();
        if (le != hipSuccess) { fprintf(stderr, "kernel_launch: launch %d failed: %s\n", li, hipGetErrorName(le)); break; }
    }
}
```

```cpp
#include <hip/hip_runtime.h>
#include <cstdio>
#include <cstdint>

#define LAS __attribute__((address_space(3)))
#define GAS __attribute__((address_space(1)))
typedef unsigned short bf16_t;
typedef short bf16x8 __attribute__((ext_vector_type(8)));
typedef short s16x4 __attribute__((ext_vector_type(4)));
typedef short v4i16_t __attribute__((ext_vector_type(4)));
typedef float f32x2 __attribute__((ext_vector_type(2)));
typedef float f32x4 __attribute__((ext_vector_type(4)));
typedef float f32x16 __attribute__((ext_vector_type(16)));
typedef unsigned u32x2 __attribute__((ext_vector_type(2)));
typedef unsigned u32x4 __attribute__((ext_vector_type(4)));
typedef int i32x4 __attribute__((ext_vector_type(4)));
typedef int i32x8 __attribute__((ext_vector_type(8)));
typedef GAS unsigned gu32;

constexpr int NB = 32, SEQ = 2048, DM = 1024, NTOK = NB * SEQ;
constexpr int MEMLEN = 256, NMEM = NB * MEMLEN;
constexpr int PW = 3072;
constexpr int C_SQ = 0, C_SK = 512, C_SV = 1024, C_DQ = 1536, C_DK = 2048, C_DV = 2112, C_IQ = 2176, C_IK = 2432, C_IW = 2496, C_MQ = 2560;
constexpr int IN_W = 3012;
constexpr int NEXP = 32, TOPK = 4, DEXP = 1024;
constexpr int NSLOT = NTOK * TOPK;
constexpr int NSLOT_PAD = NSLOT + NEXP * 256;
constexpr float EPS = 1e-6f;
constexpr float LOG2E = 1.4426950408889634f;

constexpr size_t MiB = 1u << 20;
constexpr size_t WS_CTL = 0, CTL_ZERO_BYTES = 1 * MiB;
constexpr size_t WS_ROPE = 1 * MiB;
constexpr size_t WS_BLKCNT = 1 * MiB + 512 * 1024;
constexpr size_t WS_SLOT_TOK = 2 * MiB;
constexpr size_t WS_TOK_SLOT = 4 * MiB;
constexpr size_t WS_TOK_GATE = 5 * MiB;
constexpr size_t WS_WIN = 8 * MiB;
constexpr size_t WS_WMKV = 14 * MiB;
constexpr size_t WS_WG = 16 * MiB;
constexpr size_t WS_WB = 22 * MiB;
constexpr size_t WS_WO = 25 * MiB;
constexpr size_t WS_WEI = 27 * MiB;
constexpr size_t WS_WEO = 155 * MiB;
__device__ __forceinline__ int lane_id_fresh() { int l; asm volatile("v_mbcnt_lo_u32_b32 %0, -1, 0\n\tv_mbcnt_hi_u32_b32 %0, -1, %0" : "=v"(l)); return l; }
__device__ __forceinline__ unsigned pk4_f8(float a, float b, float c, float d) { int v = __builtin_amdgcn_cvt_pk_fp8_f32(a, b, 0, false); return (unsigned)__builtin_amdgcn_cvt_pk_fp8_f32(c, d, v, true); }
constexpr float W8_SCALE = 64.f, W8_INV = 1.f / 64.f;
constexpr size_t WS_H = 220 * MiB;
constexpr size_t WS_P = 348 * MiB;
constexpr size_t WS_O = 732 * MiB;
constexpr size_t WS_H8 = 91 * MiB;
constexpr size_t WS_H2F8 = 91 * MiB;
constexpr size_t WS_MEMN = 924 * MiB;
constexpr size_t WS_MKV = 940 * MiB;
constexpr size_t WS_Y = 220 * MiB;
constexpr size_t WS_ACT8 = 748 * MiB;
constexpr size_t WS_END = 1012 * MiB;
static_assert(WS_Y + (size_t)NSLOT_PAD * DM * 2 <= WS_ACT8 && WS_ACT8 + (size_t)NSLOT_PAD * DEXP <= WS_END, "y | act8");
static_assert(WS_SLOT_TOK + (size_t)NSLOT_PAD * 4 <= WS_TOK_SLOT && WS_TOK_GATE + (size_t)NTOK * 16 <= WS_WIN, "slot tables");

constexpr int CW_BAR = 4096;

constexpr int RING_BYTES = 151552;
constexpr int MISC_OFF = RING_BYTES;
constexpr int LDS_BYTES = 155648;
constexpr int MW_BAR = 8;
constexpr int MW_LCNT = 16;
constexpr int MW_PSTART = 64;
constexpr int MW_TSTART = 128;
constexpr int MW_BEFORE = 192;
constexpr int MW_PART = 256;

__device__ __forceinline__ unsigned f2bf(float f) { unsigned u = __builtin_bit_cast(unsigned, f); return (u + 0x7fffu + ((u >> 16) & 1u)) >> 16; }
__device__ __forceinline__ unsigned pk2(float lo, float hi) { return f2bf(lo) | (f2bf(hi) << 16); }
__device__ __forceinline__ float bf2f(unsigned short b) { return __builtin_bit_cast(float, (unsigned)b << 16); }
__device__ __forceinline__ float bflo(unsigned w) { return __builtin_bit_cast(float, w << 16); }
__device__ __forceinline__ float bfhi(unsigned w) { return __builtin_bit_cast(float, w & 0xffff0000u); }
__device__ __forceinline__ unsigned cvt_pk_bf16(float lo, float hi) { unsigned r; asm volatile("v_cvt_pk_bf16_f32 %0, %1, %2" : "=v"(r) : "v"(lo), "v"(hi)); return r; }
__device__ __forceinline__ int crow(int r, int hi) { return (r & 3) + 8 * (r >> 2) + 4 * hi; }
#define LDS_WAIT() asm volatile("s_waitcnt lgkmcnt(0)" ::: "memory")
#define VM_WAIT() asm volatile("s_waitcnt vmcnt(0)" ::: "memory")

namespace pg8 {
constexpr int BM = 256, BK = 64, HALF = 128, HTB = HALF * BK * 2, STAGE_BYTES = 8 * HTB, EPI_NA_OFF = STAGE_BYTES + 2048;
__host__ __device__ __forceinline__ int lds_byte(int r, int c) { const int st = (r >> 4) * 2 + (c >> 5), rr = r & 15, cc = c & 31, ob = rr * 64 + cc * 2; return st * 1024 + (ob ^ (((ob >> 9) & 1) << 5)); }
__host__ __device__ __forceinline__ void stage_rc(int b, int& R, int& C) { const int st = b / 1024, sb = b % 1024, swz = sb ^ (((sb >> 9) & 1) << 5); R = (st >> 1) * 16 + swz / 64; C = (st & 1) * 32 + (swz % 64) / 2; }
__host__ __device__ __forceinline__ int perm32(int rho) { const int n = rho >> 4, i = rho & 15; return 8 * (i >> 2) + 4 * n + (i & 3); }

struct Unit { int pm, pn, e; };

template <class Epi, class Sched, bool ALIGN_EPI, bool FP8 = false>
__device__ __forceinline__ void gemm_phase(LAS unsigned char* lds, const int wave_, const int K, const Sched& S, const Epi& E) {
    int tid = wave_ * 64 + lane_id_fresh();
    const int wid = __builtin_amdgcn_readfirstlane(tid >> 6), lane = tid & 63, wr = wid >> 2, wc = wid & 3, fr = lane & 15, fq = lane >> 4;
    const int nt = K / BK;
    int Rr[2], Cc[2]; unsigned voffB[2];
#pragma unroll
    for (int i = 0; i < 2; ++i) { int R, C; stage_rc(tid * 16 + i * 8192, R, C); Rr[i] = R; Cc[i] = C; const int Rb = Epi::PERM ? ((R & ~31) + perm32(R & 31)) : R; voffB[i] = (unsigned)(Rb * K + C) * 2u; }
    const size_t kstep = (size_t)(BK * 2);
    const size_t hstepB = (size_t)HALF * K * 2;
    const unsigned ldsw = (unsigned)wid * 1024u;
    const int aoff = lds_byte(wr * 64 + fr, fq * 8), boff = lds_byte(wc * 32 + fr, fq * 8);
#define PG8_SA(b, h) (((b) * 2 + (h)) * HTB)
#define PG8_SB(b, h) ((4 + (b) * 2 + (h)) * HTB)
#define PG8_STAGE(bufoff, gbase, voff) do { _Pragma("unroll") for (int _i = 0; _i < 2; ++_i) { unsigned o_ = (voff)[_i]; asm volatile("" : "+v"(o_)); \
        __builtin_amdgcn_global_load_lds((const unsigned*)((const char*)(gbase) + o_), (LAS unsigned*)(lds + (bufoff) + ldsw + _i * 8192), 16, 0, 0); } } while (0)
#define PG8_J8(x, y) __builtin_shufflevector(x, y, 0, 1, 2, 3, 4, 5, 6, 7)
#define PG8_LDA(dst, b, h) do { _Pragma("unroll") for (int m = 0; m < 4; ++m) { const LAS unsigned char* p_ = lds + PG8_SA(b, h) + aoff + m * 2048; \
        if constexpr (FP8) dst##8[m] = PG8_J8(*(const LAS i32x4*)p_, *(const LAS i32x4*)(p_ + 1024)); else { dst[m][0] = *(const LAS bf16x8*)p_; dst[m][1] = *(const LAS bf16x8*)(p_ + 1024); } } } while (0)
#define PG8_LDB(dst, b, h) do { _Pragma("unroll") for (int n = 0; n < 2; ++n) { const LAS unsigned char* p_ = lds + PG8_SB(b, h) + boff + n * 2048; \
        if constexpr (FP8) dst##8[n] = PG8_J8(*(const LAS i32x4*)p_, *(const LAS i32x4*)(p_ + 1024)); else { dst[n][0] = *(const LAS bf16x8*)p_; dst[n][1] = *(const LAS bf16x8*)(p_ + 1024); } } } while (0)
#define PG8_MMA(ai, bj, At, Bt) do { __builtin_amdgcn_s_setprio(1); _Pragma("unroll") for (int m = 0; m < 4; ++m) _Pragma("unroll") for (int n = 0; n < 2; ++n) { \
        if constexpr (FP8) acc[ai][bj][m][n] = __builtin_amdgcn_mfma_scale_f32_16x16x128_f8f6f4(Bt##8[n], At##8[m], acc[ai][bj][m][n], 0, 0, 0, 0, 0, 0); \
        else { _Pragma("unroll") for (int k = 0; k < 2; ++k) acc[ai][bj][m][n] = __builtin_amdgcn_mfma_f32_16x16x32_bf16(Bt[n][k], At[m][k], acc[ai][bj][m][n], 0, 0, 0); } } \
        __builtin_amdgcn_s_setprio(0); } while (0)
#define PG8_WAIT_V(n) asm volatile("s_waitcnt vmcnt(" #n ")" ::: "memory")
#define PG8_WAIT_L(n) asm volatile("s_waitcnt lgkmcnt(" #n ")" ::: "memory")
#define PG8_BAR __builtin_amdgcn_s_barrier()
#define PG8_SCHED __builtin_amdgcn_sched_barrier(0)
    Unit cur, nxt; int ui = 0;
    if (!S.next(0, cur)) return;
    { const int ns = S.stagger();
      for (int q = 0; q < ns; ++q) __builtin_amdgcn_s_sleep(4); }
    f32x4 acc[2][2][4][2];
    bf16x8 At[4][2], B0[2][2], B1[2][2]; i32x8 At8[4], B08[2], B18[2];
    const char* Ab = S.a_base();
    unsigned ca0[2], ca1[2], na0[2], na1[2];
#pragma unroll
    for (int i = 0; i < 2; ++i) { ca0[i] = S.a_off(cur, Rr[i], Cc[i]); ca1[i] = S.a_off(cur, HALF + Rr[i], Cc[i]); }
    const char* cB = S.b_tile(cur);
    PG8_STAGE(PG8_SB(0, 0), cB, voffB); PG8_STAGE(PG8_SB(0, 1), cB + hstepB, voffB); PG8_STAGE(PG8_SA(0, 0), Ab, ca0); PG8_STAGE(PG8_SA(0, 1), Ab, ca1);
    if (wr == 1) PG8_BAR;
    PG8_WAIT_V(2); PG8_BAR;
    PG8_STAGE(PG8_SB(1, 0), cB + kstep, voffB); PG8_STAGE(PG8_SA(1, 0), Ab + kstep, ca0); PG8_STAGE(PG8_SB(1, 1), cB + hstepB + kstep, voffB);
    PG8_WAIT_V(6); PG8_BAR;
    for (;;) {
        typename Epi::Pre pre = E.preload(cur, wr, wc, fr, fq);
        const bool has_next = S.next(ui + 1, nxt);
        const char* nB = cB;
#pragma unroll
        for (int i = 0; i < 2; ++i) { na0[i] = ca0[i]; na1[i] = ca1[i]; }
        if (has_next) { nB = S.b_tile(nxt);
#pragma unroll
            for (int i = 0; i < 2; ++i) { int R, C; int tq = tid; if constexpr (FP8) tq = wave_ * 64 + lane_id_fresh();
                stage_rc(tq * 16 + i * 8192, R, C);
                na0[i] = S.a_off(nxt, R, C); na1[i] = S.a_off(nxt, HALF + R, C); } }
        if constexpr (Epi::DRAIN_TOP) { PG8_WAIT_V(0); }
        if constexpr (Epi::STASH) E.stash(pre, wid, fr, fq);
#define PG8_NAST(v) const unsigned v = (unsigned)(EPI_NA_OFF + (wave_ * 64 + lane_id_fresh()) * 16)
        if constexpr (FP8) { PG8_NAST(nast); *(LAS u32x4*)(lds + nast) = (u32x4){na0[0], na0[1], na1[0], na1[1]}; }
#pragma unroll
        for (int a = 0; a < 2; ++a)
#pragma unroll
            for (int b = 0; b < 2; ++b)
#pragma unroll
                for (int m = 0; m < 4; ++m)
#pragma unroll
                    for (int n = 0; n < 2; ++n) acc[a][b][m][n] = (f32x4){0.f, 0.f, 0.f, 0.f};
#pragma unroll 1
        for (int t = 0; t < nt; t += 2) {
            const bool last = (t == nt - 2);
            const char* a1 = Ab + (size_t)(t + 1) * kstep;
            const char* a2 = last ? Ab : Ab + (size_t)(t + 2) * kstep; const char* b2 = last ? nB : cB + (size_t)(t + 2) * kstep;
            const char* a3 = a2 + kstep; const char* b3 = b2 + kstep;
            if constexpr (FP8) { asm volatile("" : "+s"(a1), "+s"(a2), "+s"(b2), "+s"(a3), "+s"(b3)); }
            unsigned o20[2], o21[2];
#pragma unroll
            for (int i = 0; i < 2; ++i) { o20[i] = last ? na0[i] : ca0[i]; o21[i] = last ? na1[i] : ca1[i]; }
            if constexpr (FP8) { if (last) { PG8_NAST(nast); const u32x4 nv = *(const LAS u32x4*)(lds + nast); o20[0] = nv.x; o20[1] = nv.y; o21[0] = nv.z; o21[1] = nv.w; } }
            PG8_LDB(B0, 0, 0); PG8_LDB(B1, 0, 1); PG8_SCHED; PG8_LDA(At, 0, 0); PG8_STAGE(PG8_SA(1, 1), a1, ca1);
            PG8_WAIT_V(8); PG8_WAIT_L(0); PG8_BAR; PG8_MMA(0, 0, At, B0); PG8_MMA(0, 1, At, B1); PG8_BAR; PG8_SCHED;
            PG8_LDA(At, 0, 1); PG8_STAGE(PG8_SB(0, 0), b2, voffB); PG8_STAGE(PG8_SB(0, 1), b2 + hstepB, voffB); PG8_STAGE(PG8_SA(0, 0), a2, o20);
            PG8_WAIT_V(8); PG8_WAIT_L(0); PG8_BAR; PG8_MMA(1, 0, At, B0); PG8_MMA(1, 1, At, B1); PG8_BAR; PG8_SCHED;
            PG8_LDB(B0, 1, 0); PG8_LDB(B1, 1, 1); PG8_SCHED; PG8_LDA(At, 1, 0); PG8_STAGE(PG8_SA(0, 1), a2, o21);
            PG8_WAIT_V(8); PG8_WAIT_L(0); PG8_BAR; PG8_MMA(0, 0, At, B0); PG8_MMA(0, 1, At, B1); PG8_BAR; PG8_SCHED;
            PG8_LDA(At, 1, 1); PG8_STAGE(PG8_SB(1, 0), b3, voffB); PG8_STAGE(PG8_SB(1, 1), b3 + hstepB, voffB); PG8_STAGE(PG8_SA(1, 0), a3, o20);
            PG8_WAIT_V(8); PG8_WAIT_L(0); PG8_BAR; PG8_MMA(1, 0, At, B0); PG8_MMA(1, 1, At, B1); PG8_BAR; PG8_SCHED;
        }
        if constexpr (ALIGN_EPI) { if (wr == 0) PG8_BAR; }
        if constexpr (FP8) { const int lq = lane_id_fresh();
            if constexpr (Epi::STASH) E(acc, cur, wr, wc, lq & 15, (lq >> 4) & 3, typename Epi::Pre{}); else E(acc, cur, wr, wc, lq & 15, (lq >> 4) & 3, pre); }
        else E(acc, cur, wr, wc, fr, fq, pre);
        if (!has_next) break;
        cur = nxt; cB = nB; ++ui;
#pragma unroll
        for (int i = 0; i < 2; ++i) { ca0[i] = na0[i]; ca1[i] = na1[i]; }
        if constexpr (FP8) { PG8_NAST(nast); const u32x4 nv = *(const LAS u32x4*)(lds + nast); ca0[0] = nv.x; ca0[1] = nv.y; ca1[0] = nv.z; ca1[1] = nv.w; }
        if constexpr (ALIGN_EPI) { if (wr == 1) PG8_BAR; }
    }
    PG8_WAIT_V(0);
    if constexpr (!ALIGN_EPI) { if (wr == 0) PG8_BAR; }
    PG8_BAR;
#undef PG8_SA
#undef PG8_SB
#undef PG8_STAGE
#undef PG8_LDA
#undef PG8_LDB
#undef PG8_MMA
#undef PG8_NAST
#undef PG8_J8
#undef PG8_WAIT_V
#undef PG8_WAIT_L
#undef PG8_BAR
#undef PG8_SCHED
}

struct DenseSched {
    const char* A; const char* Bt; int K, nM, nN, nwg, G, c, stag = 0, amask = -1;
    __device__ __forceinline__ void init(const void* A_, const void* Bt_, int M, int N, int K_, int G_, int c_) { A = (const char*)A_; Bt = (const char*)Bt_; K = K_; nM = M / BM; nN = N / BM; nwg = nM * nN; G = G_; c = c_; }
    __device__ __forceinline__ bool next(int i, Unit& u) const {
        const long L = (long)i * G + c; if (L >= nwg) return false;
        int wgid = (int)L; { const int q = nwg / 8, r = nwg % 8, xcd = wgid % 8, off = wgid / 8; wgid = (xcd < r ? xcd * (q + 1) : r * (q + 1) + (xcd - r) * q) + off; }
        const int nig = 8 * nN, gid = wgid / nig, fm = gid * 8, gsz = (nM - fm) < 8 ? (nM - fm) : 8;
        u.pm = fm + ((wgid % nig) % gsz); u.pn = (wgid % nig) / gsz; u.e = 0; return true;
    }
    __device__ __forceinline__ const char* a_base() const { return A; }
    __device__ __forceinline__ int stagger() const { return stag ? ((c >> 3) & 7) * (K / 55) : 0; }
    __device__ __forceinline__ unsigned a_off(const Unit& u, int row, int col) const { return (unsigned)(((size_t)((u.pm * BM + row) & amask) * K + col) * 2); }
    __device__ __forceinline__ int a_row(const Unit& u, int row) const { return (u.pm * BM + row) & amask; }
    __device__ __forceinline__ unsigned row_off(int r, int col) const { return (unsigned)(((size_t)r * K + col) * 2); }
    __device__ __forceinline__ const char* b_tile(const Unit& u) const { return Bt + (size_t)u.pn * BM * K * 2; }
};
}

namespace pg8 {
struct MoeSched {
    const char* A; const char* Bt; const int* slot_tok; volatile LAS unsigned* tstart; int K, rowsE, nN, c;
    __device__ __forceinline__ bool next(int i, Unit& u) const {
        const int x = c & 7, j = c >> 3, rpr = 32 / nN;
        const int pm = (i * 8 + x) * rpr + j / nN;
        const int T = (int)tstart[32];
        if (pm >= T) return false;
        int e = 0;
#pragma unroll 1
        for (int k = 1; k < 32; ++k) e += ((int)tstart[k] <= pm) ? 1 : 0;
        u.pm = pm; u.pn = j % nN; u.e = __builtin_amdgcn_readfirstlane(e); return true;
    }
    __device__ __forceinline__ const char* a_base() const { return A; }
    __device__ __forceinline__ int stagger() const { const int g = (c >> 3) / nN, ng = 32 / nN; (void)g; (void)ng; return 0; }
    __device__ __forceinline__ unsigned a_off(const Unit& u, int row, int col) const {
        const int pos = u.pm * BM + row;
        const int r = slot_tok ? slot_tok[pos] : pos;
        return (unsigned)(((size_t)r * K + col) * 2);
    }
    __device__ __forceinline__ int a_row(const Unit& u, int row) const { const int pos = u.pm * BM + row; return slot_tok ? ((const GAS int*)slot_tok)[pos] : pos; }
    __device__ __forceinline__ unsigned row_off(int r, int col) const { return (unsigned)(((size_t)r * K + col) * 2); }
    __device__ __forceinline__ const char* b_tile(const Unit& u) const { return Bt + ((size_t)u.e * rowsE + (size_t)u.pn * BM) * K * 2; }
};

struct MergeSched {
    const char* A; const char* Bt; int nM, nN, nwg, G, c;
    __device__ __forceinline__ void init(const void* A_, const void* Bt_, int M, int N, int G_, int c_) { A = (const char*)A_; Bt = (const char*)Bt_; nM = M / BM; nN = N / BM; nwg = nM * nN; G = G_; c = c_; }
    __device__ __forceinline__ bool next(int i, Unit& u) const {
        const int r = i / 3; const long L = (long)r * G + c; if (L >= nwg) return false;
        int wgid = (int)L; { const int q = nwg / 8, rr = nwg % 8, xcd = wgid % 8, off = wgid / 8; wgid = (xcd < rr ? xcd * (q + 1) : rr * (q + 1) + (xcd - rr) * q) + off; }
        const int nig = 8 * nN, gid = wgid / nig, fm = gid * 8, gsz = (nM - fm) < 8 ? (nM - fm) : 8;
        u.pm = fm + ((wgid % nig) % gsz); u.pn = (wgid % nig) / gsz; u.e = i - 3 * r; return true;
    }
    __device__ __forceinline__ const char* a_base() const { return A; }
    __device__ __forceinline__ int stagger() const { return 0; }
    __device__ __forceinline__ unsigned a_off(const Unit& u, int row, int col) const { return (unsigned)(((size_t)(u.pm * BM + row) * 512 + col) * 2 + (size_t)u.e * ((size_t)NTOK * 512 * 2)); }
    __device__ __forceinline__ const char* b_tile(const Unit& u) const { return Bt + ((size_t)u.e * DM + (size_t)u.pn * BM) * 512 * 2; }
};

constexpr int EPI_STAGE_OFF = 131072, EPI_STAGE_WAVE = 2304;
struct NoPre {};
template <int ACT> struct EpiBf16 {
    static constexpr bool PERM = true, DRAIN_TOP = false, STASH = false;
    struct Pre { f32x4 bv[2][2]; };
    bf16_t* O; int ldc; const float* bias; int rowmask = -1;
    __device__ __forceinline__ Pre preload(const Unit& u, int wr, int wc, int fr, int fq) const { Pre p; const int col0 = u.pn * BM + wc * 32 + 8 * fq;
#pragma unroll
        for (int bj = 0; bj < 2; ++bj)
#pragma unroll
            for (int n = 0; n < 2; ++n) p.bv[bj][n] = (f32x4){0.f, 0.f, 0.f, 0.f};
        return p; }
    __device__ __forceinline__ void arrived(Pre& p) const { asm volatile("" : "+v"(p.bv[0][0]), "+v"(p.bv[0][1]), "+v"(p.bv[1][0]), "+v"(p.bv[1][1])); }
    __device__ __forceinline__ void operator()(const f32x4 (&acc)[2][2][4][2], const Unit& u, int wr, int wc, int fr, int fq, const Pre& pre) const {
        const int row0 = u.pm * BM + wr * 64 + fr; const int col0 = u.pn * BM + wc * 32 + 8 * fq;
        f32x4 bv[2][2];
#pragma unroll
        for (int bj = 0; bj < 2; ++bj)
#pragma unroll
            for (int n = 0; n < 2; ++n) bv[bj][n] = bias ? *(const f32x4*)(bias + (ACT == 3 ? u.e * DM : 0) + col0 + bj * HALF + 4 * n) : pre.bv[bj][n];
#pragma unroll
        for (int ai = 0; ai < 2; ++ai)
#pragma unroll
            for (int m = 0; m < 4; ++m) { bf16_t* rowp = O + (size_t)((row0 + ai * HALF + m * 16) & rowmask) * ldc + col0;
#pragma unroll
                for (int bj = 0; bj < 2; ++bj) { constexpr float sc = (ACT >= 2) ? W8_INV : 1.f;
                    f32x4 v0 = acc[ai][bj][m][0] * sc + bv[bj][0], v1 = acc[ai][bj][m][1] * sc + bv[bj][1];
                    u32x4 w; w.x = cvt_pk_bf16(v0[0], v0[1]); w.y = cvt_pk_bf16(v0[2], v0[3]); w.z = cvt_pk_bf16(v1[0], v1[1]); w.w = cvt_pk_bf16(v1[2], v1[3]);
                    *(u32x4*)(rowp + bj * HALF) = w; } }
    }
};
struct EpiGateU8 {
    static constexpr bool PERM = true, DRAIN_TOP = false, STASH = false;
    typedef NoPre Pre; __device__ __forceinline__ Pre preload(const Unit&, int, int, int, int) const { return Pre{}; }
    unsigned char* G; const float* bias;
    __device__ __forceinline__ void operator()(const f32x4 (&acc)[2][2][4][2], const Unit& u, int wr, int wc, int fr, int fq, const Pre&) const {
        const int row0 = u.pm * BM + wr * 64 + fr; const int col0 = u.pn * BM + wc * 32 + 8 * fq;
        f32x4 bv[2][2];
#pragma unroll
        for (int bj = 0; bj < 2; ++bj)
#pragma unroll
            for (int n = 0; n < 2; ++n) bv[bj][n] = *(const f32x4*)(bias + col0 + bj * HALF + 4 * n);
#pragma unroll
        for (int ai = 0; ai < 2; ++ai)
#pragma unroll
            for (int m = 0; m < 4; ++m) { unsigned char* rowp = G + (size_t)(row0 + ai * HALF + m * 16) * PW + col0;
#pragma unroll
                for (int bj = 0; bj < 2; ++bj) { u32x2 w;
#pragma unroll
                    for (int n = 0; n < 2; ++n) { const f32x4 v = acc[ai][bj][m][n] * W8_INV + bv[bj][n]; unsigned q[4];
#pragma unroll
                        for (int j = 0; j < 4; ++j) q[j] = (unsigned)(255.f * __builtin_amdgcn_rcpf(1.f + __builtin_amdgcn_exp2f(-LOG2E * v[j])) + 0.5f);
                        const unsigned pk = q[0] | (q[1] << 8) | (q[2] << 16) | (q[3] << 24);
                        if (n == 0) w.x = pk; else w.y = pk; }
                    *(u32x2*)(rowp + bj * HALF) = w; } }
    }
};
struct EpiY8 {
    static constexpr bool PERM = true, DRAIN_TOP = false, STASH = false;
    typedef NoPre Pre; __device__ __forceinline__ Pre preload(const Unit&, int, int, int, int) const { return Pre{}; }
    unsigned char* Y; const float* bias;
    __device__ __forceinline__ void operator()(const f32x4 (&acc)[2][2][4][2], const Unit& u, int wr, int wc, int fr, int fq, const Pre&) const {
        const int row0 = u.pm * BM + wr * 64 + fr; const int col0 = u.pn * BM + wc * 32 + 8 * fq;
        f32x4 bv[2][2];
#pragma unroll
        for (int bj = 0; bj < 2; ++bj)
#pragma unroll
            for (int n = 0; n < 2; ++n) bv[bj][n] = *(const f32x4*)(bias + u.e * DM + col0 + bj * HALF + 4 * n);
#pragma unroll
        for (int ai = 0; ai < 2; ++ai)
#pragma unroll
            for (int m = 0; m < 4; ++m) { unsigned char* rowp = Y + (size_t)(row0 + ai * HALF + m * 16) * DM + col0;
#pragma unroll
                for (int bj = 0; bj < 2; ++bj) { const f32x4 v0 = acc[ai][bj][m][0] * W8_INV + bv[bj][0], v1 = acc[ai][bj][m][1] * W8_INV + bv[bj][1];
                    u32x2 w; w.x = pk4_f8(v0[0], v0[1], v0[2], v0[3]); w.y = pk4_f8(v1[0], v1[1], v1[2], v1[3]);
                    *(u32x2*)(rowp + bj * HALF) = w; } }
    }
};
struct EpiMerge {
    static constexpr bool PERM = true, DRAIN_TOP = false, STASH = false;
    typedef NoPre Pre; __device__ __forceinline__ Pre preload(const Unit&, int, int, int, int) const { return Pre{}; }
    const unsigned char* G; bf16_t* Mg;
    __device__ __forceinline__ void operator()(const f32x4 (&acc)[2][2][4][2], const Unit& u, int wr, int wc, int fr, int fq, const Pre&) const {
        const int row0 = u.pm * BM + wr * 64 + fr; const int col0 = u.pn * BM + wc * 32 + 8 * fq;
        const int goff = u.e * DM; const bool first = (u.e == 0);
#pragma unroll
        for (int ai = 0; ai < 2; ++ai)
#pragma unroll
            for (int m = 0; m < 4; ++m) { const size_t row = (size_t)(row0 + ai * HALF + m * 16);
#pragma unroll
                for (int bj = 0; bj < 2; ++bj) {
                    const u32x2 g = *(const u32x2*)(G + row * PW + goff + col0 + bj * HALF);
                    u32x4 p = (u32x4){0u, 0u, 0u, 0u};
                    if (!first) p = *(const u32x4*)(Mg + row * DM + col0 + bj * HALF);
                    const f32x4 a0 = acc[ai][bj][m][0] * (1.f / 255.f), a1 = acc[ai][bj][m][1] * (1.f / 255.f);
                    u32x4 w;
                    w.x = cvt_pk_bf16(bflo(p.x) + (float)((g.x >> 0) & 0xffu) * a0[0], bfhi(p.x) + (float)((g.x >> 8) & 0xffu) * a0[1]);
                    w.y = cvt_pk_bf16(bflo(p.y) + (float)((g.x >> 16) & 0xffu) * a0[2], bfhi(p.y) + (float)((g.x >> 24) & 0xffu) * a0[3]);
                    w.z = cvt_pk_bf16(bflo(p.z) + (float)((g.y >> 0) & 0xffu) * a1[0], bfhi(p.z) + (float)((g.y >> 8) & 0xffu) * a1[1]);
                    w.w = cvt_pk_bf16(bflo(p.w) + (float)((g.y >> 16) & 0xffu) * a1[2], bfhi(p.w) + (float)((g.y >> 24) & 0xffu) * a1[3]);
                    *(u32x4*)(Mg + row * DM + col0 + bj * HALF) = w; } }
    }
};
struct EpiResid {
    static constexpr bool PERM = true, DRAIN_TOP = false, STASH = false;
    typedef NoPre Pre; __device__ __forceinline__ Pre preload(const Unit&, int, int, int, int) const { return Pre{}; }
    const float* base; bf16_t* out;
    __device__ __forceinline__ void operator()(const f32x4 (&acc)[2][2][4][2], const Unit& u, int wr, int wc, int fr, int fq, const Pre&) const {
        const int row0 = u.pm * BM + wr * 64 + fr; const int col0 = u.pn * BM + wc * 32 + 8 * fq;
#pragma unroll
        for (int ai = 0; ai < 2; ++ai)
#pragma unroll
            for (int m = 0; m < 4; ++m) { const size_t r = (size_t)(row0 + ai * HALF + m * 16); const float* xb = base + r * DM + col0; bf16_t* ob = out + r * 2048 + (r & 1) * 1024 + col0;
#pragma unroll
                for (int bj = 0; bj < 2; ++bj) { const f32x4 v0 = *(const f32x4*)(xb + bj * HALF) + acc[ai][bj][m][0], v1 = *(const f32x4*)(xb + bj * HALF + 4) + acc[ai][bj][m][1];
                    u32x4 w; w.x = cvt_pk_bf16(v0[0], v0[1]); w.y = cvt_pk_bf16(v0[2], v0[3]); w.z = cvt_pk_bf16(v1[0], v1[1]); w.w = cvt_pk_bf16(v1[2], v1[3]);
                    *(u32x4*)(ob + bj * HALF) = w; } }
    }
};
struct EpiSwiglu {
    static constexpr bool PERM = true, DRAIN_TOP = true, STASH = true;
    unsigned char* act; const float* bias; LAS unsigned char* lds;
    struct Pre { f32x4 bg[2], bu[2]; };
    __device__ __forceinline__ Pre preload(const Unit& u, int wr, int wc, int fr, int fq) const {
        const GAS float* be = (const GAS float*)bias + (size_t)u.e * 2048 + u.pn * HALF + wc * 32 + 8 * fq; Pre p;
#pragma unroll
        for (int n = 0; n < 2; ++n) { p.bg[n] = *(const GAS f32x4*)(be + 4 * n); p.bu[n] = *(const GAS f32x4*)(be + 1024 + 4 * n); }
        return p; }
    __device__ __forceinline__ void stash(const Pre& p, int wid, int fr, int fq) const {
        LAS f32x4* st = (LAS f32x4*)(lds + EPI_STAGE_OFF + wid * 256 + fq * 64);
        if (fr == 0) { st[0] = p.bg[0]; st[1] = p.bg[1]; st[2] = p.bu[0]; st[3] = p.bu[1]; } }
    __device__ __forceinline__ void operator()(const f32x4 (&acc)[2][2][4][2], const Unit& u, int wr, int wc, int fr, int fq, const Pre& pre) const {
        const int row0 = u.pm * BM + wr * 64 + fr; const int col0 = u.pn * HALF + wc * 32 + 8 * fq;
        f32x4 bg[2], bu[2];
#pragma unroll
        for (int n = 0; n < 2; ++n) { const LAS f32x4* st = (const LAS f32x4*)(lds + EPI_STAGE_OFF + (wr * 4 + wc) * 256 + fq * 64); bg[n] = st[n]; bu[n] = st[2 + n]; }
#pragma unroll
        for (int ai = 0; ai < 2; ++ai)
#pragma unroll
            for (int m = 0; m < 4; ++m) { unsigned char* rowp = act + (size_t)(row0 + ai * HALF + m * 16) * DEXP + col0;
                float o[8];
#pragma unroll
                for (int n = 0; n < 2; ++n) { const f32x4 gv = acc[ai][0][m][n] * W8_INV + bg[n], uv = acc[ai][1][m][n] * W8_INV + bu[n];
#pragma unroll
                    for (int q = 0; q < 4; ++q) { const float g = fminf(gv[q], 7.0f); const float uu = fminf(fmaxf(uv[q], -7.0f), 7.0f);
                        const float sg = __builtin_amdgcn_rcpf(1.f + __builtin_amdgcn_exp2f(-1.702f * LOG2E * g));
                        o[4 * n + q] = (uu + 1.0f) * (g * sg); } }
                u32x2 w; w.x = pk4_f8(o[0], o[1], o[2], o[3]); w.y = pk4_f8(o[4], o[5], o[6], o[7]);
                *(u32x2*)rowp = w; }
    }
};
struct EpiScatter {
    static constexpr bool PERM = false, DRAIN_TOP = false, STASH = false;
    typedef NoPre Pre; __device__ __forceinline__ Pre preload(const Unit&, int, int, int, int) const { return Pre{}; }
    float* out; const int* slot_tok; const float* slot_w; const float* bias; LAS unsigned char* lds;
    __device__ __forceinline__ void operator()(const f32x4 (&acc)[2][2][4][2], const Unit& u, int wr, int wc, int fr, int fq, const Pre&) const {
        const int lane = fr + 16 * fq, wid = wr * 4 + wc;
        LAS float* st = (LAS float*)(lds + EPI_STAGE_OFF + wid * EPI_STAGE_WAVE);
        const int row0 = u.pm * BM + wr * 64 + fr;
        const int lcol = lane & 31, lrow = lane >> 5;
        float bv[2];
#pragma unroll
        for (int bj = 0; bj < 2; ++bj) bv[bj] = bias[(size_t)u.e * DM + u.pn * BM + bj * HALF + wc * 32 + lcol];
#pragma unroll
        for (int ai = 0; ai < 2; ++ai)
#pragma unroll
            for (int m = 0; m < 4; ++m) { const int pos = row0 + ai * HALF + m * 16; const float w = slot_w[pos]; const int tok = slot_tok[pos];
#pragma unroll
                for (int bj = 0; bj < 2; ++bj) {
#pragma unroll
                    for (int n = 0; n < 2; ++n) *(LAS f32x4*)(st + fr * 36 + 16 * n + 4 * fq) = acc[ai][bj][m][n];
                    asm volatile("s_waitcnt lgkmcnt(0)" ::: "memory");
#pragma unroll
                    for (int i = 0; i < 8; ++i) { const int r = 2 * i + lrow; const float v = st[r * 36 + lcol];
                        const float wr_ = __shfl(w, r); const int tr_ = __shfl(tok, r);
                        if (wr_ != 0.f) unsafeAtomicAdd(out + (size_t)tr_ * DM + u.pn * BM + bj * HALF + wc * 32 + lcol, (v + bv[bj]) * wr_); }
                    asm volatile("s_waitcnt lgkmcnt(0)" ::: "memory");
                } }
    }
};
}

#define XB_TMO      128
#define XB_XCNT(j)  (256  + 64 * (j))
#define XB_XSUB(j)  (1280 + 64 * (j))
#define XB_XGEN(j)  (2304 + 64 * (j))
#define XB_TOP      3328
#define XB_TOPGEN   3392
#define XCD_BAR_WORDS 3456
#define XB_SPIN_CAP (1u << 18)

__device__ __forceinline__ unsigned xb_ld(unsigned* p)              { return __hip_atomic_load(p, __ATOMIC_RELAXED, __HIP_MEMORY_SCOPE_AGENT); }
__device__ __forceinline__ unsigned xb_add(unsigned* p, unsigned v) { return __hip_atomic_fetch_add(p, v, __ATOMIC_RELAXED, __HIP_MEMORY_SCOPE_AGENT); }
__device__ __forceinline__ unsigned xb_xcc_id() { return (unsigned)__builtin_amdgcn_s_getreg((3 << 11) | 20) & 0xFu; }
#define XB_SPIN(cond, bar) do { unsigned _sp = 0; while (cond) { __builtin_amdgcn_s_sleep(1); \
    if ((++_sp & 255u) == 0u) { if (xb_ld(&(bar)[XB_TMO])) break; if (_sp > XB_SPIN_CAP) { atomicAdd(&(bar)[XB_TMO], 1u); break; } } } } while (0)

struct XcdBarrier {
    unsigned* bar; unsigned x; int wave;
    volatile LAS unsigned* st;
};

__device__ __forceinline__ XcdBarrier xcd_barrier_post(unsigned* bar, volatile LAS unsigned* st) {
    XcdBarrier b; b.bar = bar; b.x = xb_xcc_id(); b.st = st; b.wave = __builtin_amdgcn_readfirstlane((int)(threadIdx.x >> 6));
    if (threadIdx.x == 0) (void)xb_add(&bar[XB_XCNT(b.x)], 1u);
    return b;
}
__device__ __forceinline__ void xcd_barrier_complete(unsigned* bar, unsigned x, unsigned& nloc, unsigned& nx) {
    const unsigned G = gridDim.x * gridDim.y * gridDim.z;
    unsigned sum, cnt, mine, sp = 0u;
    for (;;) {
        sum = 0u; cnt = 0u; mine = 0u;
#pragma unroll
        for (unsigned j = 0; j < 16; ++j) { const unsigned c = xb_ld(&bar[XB_XCNT(j)]); sum += c; cnt += (c > 0u) ? 1u : 0u; mine = (j == x) ? c : mine; }
        if (sum == G) break;
        __builtin_amdgcn_s_sleep(1);
        if ((++sp & 255u) == 0u) { if (xb_ld(&bar[XB_TMO])) break; if (sp > XB_SPIN_CAP) { atomicAdd(&bar[XB_TMO], 1u); break; } }
    }
    nloc = mine > 0u ? mine : 1u; nx = cnt > 0u ? cnt : 1u;
}

__device__ __forceinline__ void xcd_barrier(const XcdBarrier& b) {
    asm volatile("s_waitcnt vmcnt(0)" ::: "memory");
    __syncthreads();
    if (b.wave == 0 && lane_id_fresh() == 0) {
        unsigned* bar = b.bar;
        __builtin_amdgcn_s_waitcnt(0);
        unsigned nloc = b.st[0], nx = b.st[1];
        if (nloc == 0u) { xcd_barrier_complete(bar, b.x, nloc, nx); b.st[0] = nloc; b.st[1] = nx; }
        const unsigned old = xb_add(&bar[XB_XSUB(b.x)], 1u);
        const unsigned gen = old / nloc;
        if (old + 1u == (gen + 1u) * nloc) {
            __builtin_amdgcn_fence(__ATOMIC_RELEASE, "agent");
            asm volatile("s_waitcnt vmcnt(0)" ::: "memory");
            const unsigned og = xb_add(&bar[XB_TOP], 1u);
            const unsigned tg = og / nx;
            if (og + 1u == (tg + 1u) * nx) xb_add(&bar[XB_TOPGEN], 1u);
            else XB_SPIN(xb_ld(&bar[XB_TOPGEN]) == tg, bar);
            __builtin_amdgcn_fence(__ATOMIC_ACQUIRE, "agent");
            xb_add(&bar[XB_XGEN(b.x)], 1u);
            asm volatile("s_waitcnt vmcnt(0)" ::: "memory");
        } else {
            XB_SPIN(xb_ld(&bar[XB_XGEN(b.x)]) == gen, bar);
            __builtin_amdgcn_fence(__ATOMIC_ACQUIRE, "agent");
            asm volatile("s_waitcnt vmcnt(0)" ::: "memory");
        }
    }
    __syncthreads();
}

constexpr int NWAVES = 8;
struct Frame {
    LAS unsigned char* lds;
    volatile LAS unsigned* MISC;
    gu32* ctl;
    int tid, lane, wave, G, blk;
    const float* in[21];
    float* out; unsigned char* ws;
};
__device__ __forceinline__ float wave_sum(float v) {
#pragma unroll
    for (int o = 1; o < 64; o <<= 1) v += __shfl_xor(v, o);
    return v;
}

__device__ __forceinline__ int map_src(int mode, int n) {
    if (mode == 1) return n < 2500 ? n : (n >= C_MQ ? n - (C_MQ - 2500) : -1);
    if (mode == 2) { const int pn = n >> 8, bj = (n >> 7) & 1, j = n & 127; return bj * 1024 + pn * 128 + j; }
    return n;
}
__device__ __forceinline__ void transpose_item(const float* W, int K, int Nsrc, int Ndst, bf16_t* WT, int mode, LAS float* scr, int item, int lane) {
    const int nblk = Ndst / 32, kb = item / nblk, nb = item % nblk, k0 = 64 * kb, n0 = 32 * nb;
    const int sc = map_src(mode, n0 + (lane & 31));
    const float scale = (mode == 1 && (n0 + (lane & 31)) < 512) ? 0.125f : 1.0f;
#pragma unroll
    for (int i = 0; i < 32; ++i) { const int kk = 2 * i + (lane >> 5); scr[kk * 33 + (lane & 31)] = sc >= 0 ? W[(size_t)(k0 + kk) * Nsrc + sc] * scale : 0.f; }
    LDS_WAIT(); asm volatile("" ::: "memory");
    const int c = lane & 7;
#pragma unroll
    for (int j = 0; j < 4; ++j) { const int n = (lane >> 3) + 8 * j; const LAS float* s = scr + (8 * c) * 33 + n;
        u32x4 o; o.x = pk2(s[0 * 33], s[1 * 33]); o.y = pk2(s[2 * 33], s[3 * 33]); o.z = pk2(s[4 * 33], s[5 * 33]); o.w = pk2(s[6 * 33], s[7 * 33]);
        *(GAS u32x4*)(WT + (size_t)(n0 + n) * K + k0 + 8 * c) = o; }
    LDS_WAIT(); asm volatile("" ::: "memory");
}
__device__ __forceinline__ void transpose_item_f8(const float* W, int K, int Nsrc, int Ndst, unsigned char* WT, int mode, float scale, LAS float* scr, int item, int lane) {
    const int nblk = Ndst / 32, kb = item / nblk, nb = item % nblk, k0 = 64 * kb, n0 = 32 * nb;
    const int sc = map_src(mode, n0 + (lane & 31));
#pragma unroll
    for (int i = 0; i < 32; ++i) { const int kk = 2 * i + (lane >> 5); scr[kk * 33 + (lane & 31)] = sc >= 0 ? W[(size_t)(k0 + kk) * Nsrc + sc] * scale : 0.f; }
    LDS_WAIT(); asm volatile("" ::: "memory");
    const int c = lane & 7;
#pragma unroll
    for (int j = 0; j < 4; ++j) { const int n = (lane >> 3) + 8 * j; const LAS float* s = scr + (8 * c) * 33 + n;
        u32x2 o; o.x = pk4_f8(s[0 * 33], s[1 * 33], s[2 * 33], s[3 * 33]); o.y = pk4_f8(s[4 * 33], s[5 * 33], s[6 * 33], s[7 * 33]);
        *(GAS u32x2*)(WT + (size_t)(n0 + n) * K + k0 + 8 * c) = o; }
    LDS_WAIT(); asm volatile("" ::: "memory");
}
__device__ __forceinline__ void rms_row_to_bf16(int lane, const float* xrow, const float* g, bf16_t* orow) {
    const GAS f32x4* xr = (const GAS f32x4*)xrow + lane; const GAS f32x4* gr = (const GAS f32x4*)g + lane;
    f32x4 v[4]; float s = 0.f;
#pragma unroll
    for (int j = 0; j < 4; ++j) { v[j] = xr[64 * j]; s += (v[j].x * v[j].x + v[j].y * v[j].y) + (v[j].z * v[j].z + v[j].w * v[j].w); }
    const float rstd = 1.0f / sqrtf(wave_sum(s) * (1.f / DM) + EPS);
    GAS u32x2* o8 = (GAS u32x2*)orow + lane;
#pragma unroll
    for (int j = 0; j < 4; ++j) { const f32x4 gg = gr[64 * j]; u32x2 o; o.x = pk2(v[j].x * rstd * gg.x, v[j].y * rstd * gg.y); o.y = pk2(v[j].z * rstd * gg.z, v[j].w * rstd * gg.w); o8[64 * j] = o; }
}

__device__ __forceinline__ void rms_rows4_to_bf16(int lane, const float* x, const float* g, bf16_t* o, size_t m0, size_t stride, unsigned char* o8f = nullptr) {
    f32x4 v[4][4]; float s[4];
#pragma unroll
    for (int r = 0; r < 4; ++r) { const GAS f32x4* xr = (const GAS f32x4*)(x + (m0 + r * stride) * DM) + lane;
#pragma unroll
        for (int j = 0; j < 4; ++j) v[r][j] = xr[64 * j]; }
    const GAS f32x4* gr = (const GAS f32x4*)g + lane;
    f32x4 gg[4];
#pragma unroll
    for (int j = 0; j < 4; ++j) gg[j] = gr[64 * j];
#pragma unroll
    for (int r = 0; r < 4; ++r) { float a = 0.f;
#pragma unroll
        for (int j = 0; j < 4; ++j) a += (v[r][j].x * v[r][j].x + v[r][j].y * v[r][j].y) + (v[r][j].z * v[r][j].z + v[r][j].w * v[r][j].w);
        s[r] = a; }
#pragma unroll
    for (int of = 1; of < 64; of <<= 1) {
#pragma unroll
        for (int r = 0; r < 4; ++r) s[r] += __shfl_xor(s[r], of); }
#pragma unroll
    for (int r = 0; r < 4; ++r) { const float rstd = 1.0f / sqrtf(s[r] * (1.f / DM) + EPS);
        GAS u32x2* o8 = (GAS u32x2*)(o + (m0 + r * stride) * DM) + lane;
#pragma unroll
        for (int j = 0; j < 4; ++j) { const float a0 = v[r][j].x * rstd * gg[j].x, a1 = v[r][j].y * rstd * gg[j].y, a2 = v[r][j].z * rstd * gg[j].z, a3 = v[r][j].w * rstd * gg[j].w;
            u32x2 w; w.x = pk2(a0, a1); w.y = pk2(a2, a3); o8[64 * j] = w;
            if (o8f) *((GAS unsigned*)(o8f + (m0 + r * stride) * DM) + lane + 64 * j) = pk4_f8(a0, a1, a2, a3); } }
}
__device__ __forceinline__ void p0_prologue(Frame& F) {
    LAS float* scr = (LAS float*)(F.lds + F.wave * 16384);
    const int gw = F.blk * NWAVES + F.wave, NGW = F.G * NWAVES, lane = F.lane;
    unsigned char* ws = F.ws;
    constexpr int I_IN = 16 * 96, I_MKV = 16 * 32, I_G = 16 * 32, I_B = 8 * 32, I_O = 16 * 32, I_EI = 16 * 64, I_EO = 16 * 32;
    constexpr int NITEMS = I_IN + I_MKV + 3 * I_G + 3 * I_B + I_O + NEXP * I_EI + NEXP * I_EO;
    for (int it = gw; it < NITEMS; it += NGW) {
        int r = it;
        if (r < I_IN) { transpose_item(F.in[3], DM, IN_W, PW, (bf16_t*)(ws + WS_WIN), 1, scr, r, lane); continue; } r -= I_IN;
        if (r < I_MKV) { transpose_item(F.in[9], DM, DM, DM, (bf16_t*)(ws + WS_WMKV), 0, scr, r, lane); continue; } r -= I_MKV;
        if (r < 3 * I_G) { const int n = r / I_G; transpose_item_f8(F.in[10] + (size_t)n * DM * DM, DM, DM, DM, ws + WS_WG + (size_t)n * DM * DM, 0, W8_SCALE, scr, r % I_G, lane); continue; } r -= 3 * I_G;
        if (r < 3 * I_B) { const int n = r / I_B; transpose_item(F.in[12] + (size_t)n * 512 * DM, 512, DM, DM, (bf16_t*)(ws + WS_WB) + (size_t)n * DM * 512, 0, scr, r % I_B, lane); continue; } r -= 3 * I_B;
        if (r < I_O) { transpose_item(F.in[13], DM, DM, DM, (bf16_t*)(ws + WS_WO), 0, scr, r, lane); continue; } r -= I_O;
        if (r < NEXP * I_EI) { const int e = r / I_EI; transpose_item_f8(F.in[17] + (size_t)e * DM * 2048, DM, 2048, 2048, ws + WS_WEI + (size_t)e * 2048 * DM, 2, W8_SCALE, scr, r % I_EI, lane); continue; } r -= NEXP * I_EI;
        { const int e = r / I_EO; transpose_item_f8(F.in[19] + (size_t)e * DM * DM, DM, DM, DM, ws + WS_WEO + (size_t)e * DM * DM, 0, W8_SCALE, scr, r % I_EO, lane); }
    }
    { f32x2* tab = (f32x2*)(ws + WS_ROPE);
      for (int idx = (F.blk * NWAVES * 64) + F.tid; idx < SEQ * 32; idx += F.G * NWAVES * 64) {
          const int s = idx >> 5, i = idx & 31;
          const float inv = exp2f(-(float)i * (13.287712379549449f / 32.0f));
          const float ang = (float)s * inv;
          const double rev = (double)ang * 0.15915494309189535;
          const float fr = (float)(rev - __builtin_rint(rev));
          tab[idx] = (f32x2){__builtin_amdgcn_cosf(fr), __builtin_amdgcn_sinf(fr)}; } }
    for (int m = gw; m < NTOK; m += 4 * NGW) rms_rows4_to_bf16(lane, F.in[0], F.in[2], (bf16_t*)(ws + WS_H), (size_t)m, (size_t)NGW, ws + WS_H8);
    for (int m = gw; m < NMEM; m += 4 * NGW) rms_rows4_to_bf16(lane, F.in[1], F.in[8], (bf16_t*)(ws + WS_MEMN), (size_t)m, (size_t)NGW);
    { int* st = (int*)(ws + WS_SLOT_TOK);
      for (int i = F.blk * NWAVES * 64 + F.tid; i < NSLOT_PAD; i += F.G * NWAVES * 64) st[i] = 0; }
}

template <int CTRL> __device__ __forceinline__ float dppf(float v) { return __builtin_bit_cast(float, __builtin_amdgcn_update_dpp(0, __builtin_bit_cast(int, v), CTRL, 0xF, 0xF, false)); }
__device__ __forceinline__ float lx1(float v) { return dppf<0xB1>(v); }
__device__ __forceinline__ float lx2(float v) { return dppf<0x4E>(v); }
__device__ __forceinline__ float lx4(float v) { return dppf<0x1B>(dppf<0x141>(v)); }
__device__ __forceinline__ float lx8(float v) { return dppf<0x128>(v); }
__device__ __forceinline__ void un8(const u32x4 w, float (&v)[8]) { v[0] = bflo(w.x); v[1] = bfhi(w.x); v[2] = bflo(w.y); v[3] = bfhi(w.y); v[4] = bflo(w.z); v[5] = bfhi(w.z); v[6] = bflo(w.w); v[7] = bfhi(w.w); }
__device__ __forceinline__ u32x4 pk8(const float (&v)[8]) { u32x4 w; w.x = pk2(v[0], v[1]); w.y = pk2(v[2], v[3]); w.z = pk2(v[4], v[5]); w.w = pk2(v[6], v[7]); return w; }
__device__ __forceinline__ void rope8(float (&v)[8], const f32x2 (&cs)[8], bool up) {
#pragma unroll
    for (int j = 0; j < 8; ++j) { const float other = lx4(v[j]); v[j] = up ? (other * cs[j].y + v[j] * cs[j].x) : (v[j] * cs[j].x - other * cs[j].y); }
}
__device__ __forceinline__ void p2_prep(Frame& F, const bool dummy = false) {
    const int gw = F.blk * NWAVES + F.wave, NGW = F.G * NWAVES, lane = F.lane;
    bf16_t* proj = (bf16_t*)(F.ws + WS_P);
    bf16_t* projw = dummy ? (bf16_t*)(F.ws + WS_END) : proj;
    const int wmask = dummy ? 8191 : 0x7fffffff;
    const f32x2* tab = (const f32x2*)(F.ws + WS_ROPE);
    float gqd[8], gkd[8], gqm[8];
#pragma unroll
    for (int j = 0; j < 8; ++j) { gqd[j] = F.in[4][8 * (lane & 7) + j] * (0.125f * LOG2E); gkd[j] = F.in[5][8 * (lane & 7) + j]; gqm[j] = F.in[6][8 * (lane & 15) + j] * (0.08838834764831845f * LOG2E); }
    const bool up = (lane & 4) != 0; const int i0 = (lane & 3) * 8;
    for (int m0 = gw; m0 < NTOK; m0 += 2 * NGW) {
        u32x4 raw[2][5]; f32x2 cs[2][8];
#pragma unroll
        for (int t = 0; t < 2; ++t) { const GAS bf16_t* row = (const GAS bf16_t*)proj + (size_t)(m0 + t * NGW) * PW;
            raw[t][0] = *(const GAS u32x4*)(row + C_DQ + 8 * lane); raw[t][1] = *(const GAS u32x4*)(row + C_DK + 8 * (lane & 7)); raw[t][2] = *(const GAS u32x4*)(row + C_IQ + 8 * (lane & 31));
            raw[t][3] = *(const GAS u32x4*)(row + C_IK + 8 * (lane & 7)); raw[t][4] = *(const GAS u32x4*)(row + C_MQ + 8 * lane);
            const GAS f32x2* tr = (const GAS f32x2*)tab + (size_t)((m0 + t * NGW) & (SEQ - 1)) * 32 + i0;
#pragma unroll
            for (int j = 0; j < 8; ++j) cs[t][j] = tr[j]; }
#pragma unroll
        for (int t = 0; t < 2; ++t) {
            GAS bf16_t* roww = (GAS bf16_t*)projw + (size_t)((m0 + t * NGW) & wmask) * PW;
            float v[8];
            { un8(raw[t][0], v); float ss = 0.f;
#pragma unroll
              for (int j = 0; j < 8; ++j) ss += v[j] * v[j];
              ss += lx1(ss); ss += lx2(ss); ss += lx4(ss);
              const float rstd = 1.0f / sqrtf(ss * (1.f / 64.f) + EPS);
#pragma unroll
              for (int j = 0; j < 8; ++j) v[j] = v[j] * rstd * gqd[j];
              rope8(v, cs[t], up);
              *(GAS u32x4*)(roww + C_DQ + 8 * lane) = pk8(v); }
            { un8(raw[t][1], v); float ss = 0.f;
#pragma unroll
              for (int j = 0; j < 8; ++j) ss += v[j] * v[j];
              ss += lx1(ss); ss += lx2(ss); ss += lx4(ss);
              const float rstd = 1.0f / sqrtf(ss * (1.f / 64.f) + EPS);
#pragma unroll
              for (int j = 0; j < 8; ++j) v[j] = v[j] * rstd * gkd[j];
              rope8(v, cs[t], up);
              if (lane < 8) *(GAS u32x4*)(roww + C_DK + 8 * lane) = pk8(v); }
            { un8(raw[t][2], v); rope8(v, cs[t], up); if (lane < 32) *(GAS u32x4*)(roww + C_IQ + 8 * lane) = pk8(v); }
            { un8(raw[t][3], v); rope8(v, cs[t], up); if (lane < 8) *(GAS u32x4*)(roww + C_IK + 8 * lane) = pk8(v); }
            { un8(raw[t][4], v); float ss = 0.f;
#pragma unroll
              for (int j = 0; j < 8; ++j) ss += v[j] * v[j];
              ss += lx1(ss); ss += lx2(ss); ss += lx4(ss); ss += lx8(ss);
              const float rstd = 1.0f / sqrtf(ss * (1.f / 128.f) + EPS);
#pragma unroll
              for (int j = 0; j < 8; ++j) v[j] = v[j] * rstd * gqm[j];
              *(GAS u32x4*)(roww + C_MQ + 8 * lane) = pk8(v); }
        }
    }
    bf16_t* mkv = (bf16_t*)(F.ws + WS_MKV);
    if (!dummy) for (int m = gw; m < NMEM; m += NGW) {
        GAS bf16_t* row = (GAS bf16_t*)mkv + (size_t)m * DM; float v[8];
        un8(*(const GAS u32x4*)(row + 8 * lane), v); float ss = 0.f;
#pragma unroll
        for (int j = 0; j < 8; ++j) ss += v[j] * v[j];
        ss += lx1(ss); ss += lx2(ss); ss += lx4(ss); ss += lx8(ss);
        const float rstd = 1.0f / sqrtf(ss * (1.f / 128.f) + EPS);
#pragma unroll
        for (int j = 0; j < 8; ++j) v[j] = v[j] * rstd * F.in[7][8 * (lane & 15) + j];
        *(GAS u32x4*)(row + 8 * lane) = pk8(v);
    }
}

#define MFMA32(a, b, c) __builtin_amdgcn_mfma_f32_32x32x16_bf16((a), (b), (c), 0, 0, 0)
typedef LAS const unsigned char* lds_cptr;
__device__ __forceinline__ s16x4 vtr(lds_cptr p) { return __builtin_bit_cast(s16x4, __builtin_amdgcn_ds_read_tr16_b64_v4i16((LAS v4i16_t*)p)); }
__device__ __forceinline__ bf16x8 vfrag(lds_cptr vbase_lane, int off) {
    const s16x4 lo = vtr(vbase_lane + off), hi = vtr(vbase_lane + off + 512);
    return (bf16x8){lo[0], lo[1], lo[2], lo[3], hi[0], hi[1], hi[2], hi[3]};
}
__device__ __forceinline__ int vtr_lane_off(int lane) { return ((lane >> 4) & 1) * 32 + (lane & 3) * 8 + (4 * (lane >> 5) + ((lane & 15) >> 2)) * 64; }
__device__ __forceinline__ bf16x8 pack8(const float* p) {
    u32x4 w; w.x = cvt_pk_bf16(p[0], p[1]); w.y = cvt_pk_bf16(p[2], p[3]); w.z = cvt_pk_bf16(p[4], p[5]); w.w = cvt_pk_bf16(p[6], p[7]);
    return __builtin_bit_cast(bf16x8, w);
}
__device__ __forceinline__ float softplus_f(float z) { return fmaxf(z, 0.f) + __logf(1.f + __expf(-fabsf(z))); }

__device__ __forceinline__ void sb_item(const bf16_t* proj, bf16_t* osb, int b, int h, int qblk, LAS unsigned char* vlds, int lane) {
    const int r32 = lane & 31, hi = lane >> 5;
    const size_t tok0 = (size_t)b * SEQ + (size_t)qblk * 32;
    bf16x8 qr[4];
    { const bf16_t* qp = proj + (tok0 + r32) * PW + C_SQ + h * 64 + hi * 8;
#pragma unroll
      for (int kk = 0; kk < 4; ++kk) qr[kk] = *(const bf16x8*)(qp + kk * 16); }
    f32x16 o0 = {}, o1 = {}; float R = 0.f;
    const lds_cptr vrd = (lds_cptr)vlds + vtr_lane_off(lane);
    bf16x8 kfn[4]; u32x4 vvn[4];
#define SB_LOAD(kt_) do { const size_t key0_ = (size_t)b * SEQ + (size_t)(kt_) * 32; const GAS bf16_t* kp_ = (const GAS bf16_t*)proj + (key0_ + r32) * PW + C_SK + h * 64 + hi * 8; \
        _Pragma("unroll") for (int kk = 0; kk < 4; ++kk) kfn[kk] = *(const GAS bf16x8*)(kp_ + kk * 16); \
        _Pragma("unroll") for (int p = 0; p < 4; ++p) vvn[p] = *(const GAS u32x4*)((const GAS bf16_t*)proj + (key0_ + 16 * (p & 1) + (lane >> 2)) * PW + C_SV + h * 64 + (p >> 1) * 32 + (lane & 3) * 8); } while (0)
    SB_LOAD(qblk);
    for (int kt = qblk; kt >= 0; --kt) {
        bf16x8 kf[4]; u32x4 vv[4];
#pragma unroll
        for (int i = 0; i < 4; ++i) { kf[i] = kfn[i]; vv[i] = vvn[i]; }
        if (kt > 0) SB_LOAD(kt - 1);
        f32x16 s = {};
#pragma unroll
        for (int kk = 0; kk < 4; ++kk) s = MFMA32(kf[kk], qr[kk], s);
        asm volatile("" ::: "memory");
#pragma unroll
        for (int p = 0; p < 4; ++p) *(LAS u32x4*)(vlds + p * 1024 + lane * 16) = vv[p];
        const bool diag = (kt == qblk);
        float sp[16], pr[16];
#pragma unroll
        for (int r = 0; r < 16; ++r) { const bool valid = !diag || (crow(r, hi) < r32); sp[r] = valid ? softplus_f(s[r]) : 0.f; }
        float T[4], U[4];
#pragma unroll
        for (int g = 0; g < 4; ++g) { T[g] = (sp[4 * g] + sp[4 * g + 1]) + (sp[4 * g + 2] + sp[4 * g + 3]); { const auto rr = __builtin_amdgcn_permlane32_swap(__float_as_uint(T[g]), __float_as_uint(T[g]), false, false); U[g] = hi ? __uint_as_float(rr[0]) : __uint_as_float(rr[1]); } }
        float run = 0.f, above[4];
#pragma unroll
        for (int g = 3; g >= 0; --g) { above[g] = run + (hi == 0 ? U[g] : 0.f); run += T[g] + U[g]; }
#pragma unroll
        for (int g = 0; g < 4; ++g) { float c = R + above[g];
#pragma unroll
            for (int j = 3; j >= 0; --j) { const int r = 4 * g + j; c += sp[r]; const bool valid = !diag || (crow(r, hi) < r32); pr[r] = valid ? __expf(s[r] - c) : 0.f; } }
        R += run;
        const bf16x8 p0 = pack8(pr), p1 = pack8(pr + 8);
        LDS_WAIT();
        const bf16x8 v00 = vfrag(vrd, 0), v01 = vfrag(vrd, 1024), v10 = vfrag(vrd, 2048), v11 = vfrag(vrd, 3072);
        o0 = MFMA32(v00, p0, o0); o0 = MFMA32(v01, p1, o0);
        o1 = MFMA32(v10, p0, o1); o1 = MFMA32(v11, p1, o1);
        asm volatile("" ::: "memory");
        if (__all(R > 30.0f)) break;
    }
#undef SB_LOAD
    bf16_t* op = osb + (tok0 + r32) * 512 + h * 64 + 4 * hi;
#pragma unroll
    for (int g = 0; g < 4; ++g) {
        u32x2 w0, w1; w0.x = cvt_pk_bf16(o0[4 * g], o0[4 * g + 1]); w0.y = cvt_pk_bf16(o0[4 * g + 2], o0[4 * g + 3]); w1.x = cvt_pk_bf16(o1[4 * g], o1[4 * g + 1]); w1.y = cvt_pk_bf16(o1[4 * g + 2], o1[4 * g + 3]);
        *(u32x2*)(op + 8 * g) = w0; *(u32x2*)(op + 32 + 8 * g) = w1; }
}

constexpr int ML_K = 0, ML_KROW = 272, ML_V = 256 * ML_KROW, ML_END = ML_V + 65536;
__device__ __forceinline__ void mem_unit(const bf16_t* proj, const bf16_t* mkv, bf16_t* omem, int b, int h, int half, LAS unsigned char* ml, int tid) {
    const int lane = tid & 63, wid = __builtin_amdgcn_readfirstlane(tid >> 6), r32 = lane & 31, hi = lane >> 5;
    { const GAS bf16_t* src = (const GAS bf16_t*)mkv + (size_t)b * MEMLEN * DM + h * 128;
#pragma unroll
      for (int i = 0; i < 8; ++i) { const int ch = tid + 512 * i, key = ch >> 4, c16 = ch & 15, kk = key & 31;
          const u32x4 kv = *(const GAS u32x4*)(src + (size_t)key * DM + c16 * 8);
          const u32x4 vv = *(const GAS u32x4*)(src + (size_t)key * DM + 512 + c16 * 8);
          *(LAS u32x4*)(ml + ML_K + key * ML_KROW + c16 * 16) = kv;
          *(LAS u32x4*)(ml + ML_V + (key >> 5) * 8192 + ((c16 >> 2) * 2 + (kk >> 4)) * 1024 + (kk & 15) * 64 + (c16 & 3) * 16) = vv; } }
    __syncthreads();
    for (int i = 0; i < 4; ++i) {
        const int qblk = half * 32 + wid * 4 + i;
        const size_t tok0 = (size_t)b * SEQ + (size_t)qblk * 32;
        bf16x8 qr[8];
        { const GAS bf16_t* qp = (const GAS bf16_t*)proj + (tok0 + r32) * PW + C_MQ + h * 128 + hi * 8;
#pragma unroll
          for (int kk = 0; kk < 8; ++kk) qr[kk] = *(const GAS bf16x8*)(qp + kk * 16); }
        f32x16 o[4] = {{}, {}, {}, {}}; float m = -1e30f, l = 0.f;
        for (int kb = 0; kb < 8; ++kb) {
            const LAS unsigned char* krd = ml + ML_K + (32 * kb + r32) * ML_KROW + hi * 16;
            f32x16 s = {};
#pragma unroll
            for (int kk = 0; kk < 8; ++kk) { const bf16x8 kf = *(const LAS bf16x8*)(krd + kk * 32); s = MFMA32(kf, qr[kk], s); }
            float mx = s[0];
#pragma unroll
            for (int r = 1; r < 16; ++r) mx = fmaxf(mx, s[r]);
            { const auto rr = __builtin_amdgcn_permlane32_swap(__float_as_uint(mx), __float_as_uint(mx), false, false); mx = fmaxf(__uint_as_float(rr[0]), __uint_as_float(rr[1])); }
            if (__any(mx > m + 8.0f)) {
                const float mn = fmaxf(m, mx), alpha = __builtin_amdgcn_exp2f(m - mn);
                l *= alpha; m = mn;
#pragma unroll
                for (int d = 0; d < 4; ++d)
#pragma unroll
                    for (int r = 0; r < 16; ++r) o[d][r] *= alpha;
            }
            float pr[16], rs = 0.f;
#pragma unroll
            for (int r = 0; r < 16; ++r) { pr[r] = __builtin_amdgcn_exp2f(s[r] - m); rs += pr[r]; }
            l += rs;
            const bf16x8 p0 = pack8(pr), p1 = pack8(pr + 8);
            const lds_cptr vrd = (lds_cptr)ml + ML_V + kb * 8192 + vtr_lane_off(lane);
#pragma unroll
            for (int d = 0; d < 4; ++d) { const bf16x8 va = vfrag(vrd, d * 2048), vb = vfrag(vrd, d * 2048 + 1024); o[d] = MFMA32(va, p0, o[d]); o[d] = MFMA32(vb, p1, o[d]); }
        }
        { const auto rr = __builtin_amdgcn_permlane32_swap(__float_as_uint(l), __float_as_uint(l), false, false); l = __uint_as_float(rr[0]) + __uint_as_float(rr[1]); }
        const float il = 1.0f / l;
        bf16_t* op = omem + (tok0 + r32) * 512 + h * 128 + 4 * hi;
#pragma unroll
        for (int d = 0; d < 4; ++d)
#pragma unroll
            for (int g = 0; g < 4; ++g) { u32x2 w; w.x = cvt_pk_bf16(o[d][4 * g] * il, o[d][4 * g + 1] * il); w.y = cvt_pk_bf16(o[d][4 * g + 2] * il, o[d][4 * g + 3] * il); *(u32x2*)(op + 32 * d + 8 * g) = w; }
    }
    __syncthreads();
}

constexpr int DL_HIST = 0, DL_PREFIX = 66048, DL_KREM = DL_PREFIX + 256, DL_MASK = 67072, DL_VT = 73728, DL_KT = DL_VT + 2 * 16384, DL_END = DL_KT + 2 * 18432, DL_IQ = DL_VT;
constexpr int TOPK_DSA = 256;

struct IqLds { const LAS unsigned char* p; __device__ __forceinline__ bf16x8 operator()(int j) const { return *(const LAS bf16x8*)(p + j * 32); } };
template <class QF>
__device__ __forceinline__ void idx_scores(const QF& qf, const bf16x8 (&kf)[4], const float (&wq)[4], unsigned (&uk)[16]) {
    float scv[16];
#pragma unroll
    for (int hd = 0; hd < 4; ++hd) { f32x16 a = (f32x16){};
#pragma unroll
        for (int kk = 0; kk < 4; ++kk) a = MFMA32(kf[kk], qf(hd * 4 + kk), a);
#pragma unroll
        for (int r = 0; r < 16; ++r) scv[r] = (hd == 0) ? wq[0] * fmaxf(a[r], 0.f) : __builtin_fmaf(wq[hd], fmaxf(a[r], 0.f), scv[r]); }
#pragma unroll
    for (int r = 0; r < 16; ++r) {
        unsigned bits = __builtin_bit_cast(unsigned, scv[r]);
        if (bits == 0x80000000u) bits = 0u;
        uk[r] = bits ^ ((unsigned)((int)bits >> 31) | 0x80000000u);
    }
}
__device__ __forceinline__ void load_ik(const bf16_t* proj, size_t tokb, int kbase, int r32, int hi, bf16x8 (&kf)[4]) {
    int kr = kbase + r32; if (kr > SEQ - 1) kr = SEQ - 1;
    const GAS bf16_t* p = (const GAS bf16_t*)proj + (tokb + kr) * PW + C_IK + 8 * hi;
#pragma unroll
    for (int kk = 0; kk < 4; ++kk) kf[kk] = *(const GAS bf16x8*)(p + kk * 16);
}

__device__ __forceinline__ void dsa_unit(const bf16_t* proj, bf16_t* odsa, unsigned* kscr  , int b, int c, LAS unsigned char* dl, int tid) {
    const int lane = tid & 63, wid = __builtin_amdgcn_readfirstlane(tid >> 6), r32 = lane & 31, hi = lane >> 5;
    const int n = 64 * (c + 1), nsteps = (n + 127) >> 7;
    const size_t tokq0 = (size_t)b * SEQ + (size_t)c * 64, tokb = (size_t)b * SEQ;
    LAS unsigned* hist = (LAS unsigned*)(dl + DL_HIST);
    LAS unsigned* prefix = (LAS unsigned*)(dl + DL_PREFIX);
    LAS unsigned* krem = (LAS unsigned*)(dl + DL_KREM);
    LAS unsigned* mask = (LAS unsigned*)(dl + DL_MASK);
    const int kb = wid >> 1, qh = wid & 1;
    { const int row = tid >> 3, c = tid & 7;
      const GAS bf16_t* src = (const GAS bf16_t*)proj + (tokq0 + row) * PW + C_IQ + c * 32;
#pragma unroll
      for (int i = 0; i < 4; ++i) *(LAS u32x4*)(dl + DL_IQ + row * 528 + c * 64 + i * 16) = *(const GAS u32x4*)(src + i * 8); }
    const IqLds iqf{dl + DL_IQ + (32 * qh + r32) * 528 + hi * 16};
    float wq[4];
    { const u32x2 w = *(const u32x2*)(proj + (tokq0 + 32 * qh + r32) * PW + C_IW);
      wq[0] = bflo(w.x) * 0.0625f; wq[1] = bfhi(w.x) * 0.0625f; wq[2] = bflo(w.y) * 0.0625f; wq[3] = bfhi(w.y) * 0.0625f; }
#ifndef REP_SEL
#define REP_SEL 1
#endif
#ifndef REP_B2
#define REP_B2 1
#endif
    LAS unsigned* selall = (LAS unsigned*)(dl + DL_HIST);
#ifndef PROBE_NOATOM
#define PROBE_NOATOM 0
#endif
    unsigned dummy = 0u;
    for (int rep_sel = 0; rep_sel < REP_SEL; ++rep_sel) {
    if (tid < 64) { prefix[tid] = 0u; krem[tid] = (n > TOPK_DSA) ? (unsigned)TOPK_DSA : 0x7fffffffu; }
    __syncthreads();
    const int pass0 = (n > TOPK_DSA) ? 0 : 3;
    GAS u32x4* kmine = (GAS u32x4*)kscr + ((size_t)wid * 64 + lane) * 4;
#define DSA_CONSUME(uk_) do { \
        if (sel) { _Pragma("unroll") for (int r = 0; r < 16; ++r) { const bool match = (pass == 0) || (((uk_)[r] >> (shift + 8)) == pfx); \
                if (match && !(PROBE_NOATOM && rep_sel + 1 < REP_SEL)) __hip_atomic_fetch_add(hist + (32 * qh + r32) * 257 + (((uk_)[r] >> shift) & 255u), 1u, __ATOMIC_RELAXED, __HIP_MEMORY_SCOPE_WORKGROUP); else dummy ^= (uk_)[r]; } } \
        else { _Pragma("unroll") for (int r = 0; r < 16; ++r) { const unsigned k24 = (uk_)[r] >> 8; gtw |= (k24 > pfx ? 1u : 0u) << crow(r, hi); eqw |= (k24 == pfx ? 1u : 0u) << crow(r, hi); } } } while (0)
#define DSA_TIES() do { if (!sel) { \
        LAS unsigned* mk = mask + (step & 1) * 768; \
        { const auto rg = __builtin_amdgcn_permlane32_swap(gtw, gtw, false, false); gtw = rg[0] | rg[1]; const auto re = __builtin_amdgcn_permlane32_swap(eqw, eqw, false, false); eqw = re[0] | re[1]; } \
        if (hi == 0) { mk[(32 * qh + r32) * 4 + kb] = gtw; mk[256 + (32 * qh + r32) * 4 + kb] = eqw; } \
        __syncthreads(); \
        if (wid == 0) { unsigned nd = krem[lane]; \
            _Pragma("unroll") for (int k4 = 0; k4 < 4; ++k4) { const unsigned g = mk[lane * 4 + k4]; unsigned e = mk[256 + lane * 4 + k4]; unsigned sl = g; \
                if (e != 0u) { const unsigned cnt = (unsigned)__builtin_popcount(e); \
                    if (cnt <= nd) { sl |= e; nd -= cnt; } \
                    else { unsigned chosen = 0u; while (nd > 0u) { const unsigned lb = e & (0u - e); chosen |= lb; e ^= lb; --nd; } sl |= chosen; } } \
                selall[lane * 64 + step * 4 + k4] = sl; } \
            krem[lane] = nd; } } } while (0)
    for (int pass = pass0; pass < ((rep_sel + 1 < REP_SEL) ? 3 : 4); ++pass) {
        const bool sel = pass < 3;
        if (sel) { for (int i = tid; i < 64 * 257; i += 512) hist[i] = 0u; __syncthreads(); }
        const int shift = 24 - 8 * pass;
        const unsigned pfx = prefix[32 * qh + r32];
        if (pass == pass0) {
            bf16x8 kfn[4]; load_ik(proj, tokb, 32 * kb, r32, hi, kfn);
            for (int step = 0; step < nsteps; ++step) {
                const int kbase = 128 * step + 32 * kb;
                bf16x8 kf[4];
#pragma unroll
                for (int kk = 0; kk < 4; ++kk) kf[kk] = kfn[kk];
                if (step + 1 < nsteps) load_ik(proj, tokb, kbase + 128, r32, hi, kfn);
                unsigned gtw = 0u, eqw = 0u;
                if (kbase < n) {
                    unsigned uk[16];
                    idx_scores(iqf, kf, wq, uk);
                    if (pass0 == 0) {
#pragma unroll
                        for (int g = 0; g < 4; ++g) kmine[(size_t)step * 2048 + g] = (u32x4){uk[4 * g], uk[4 * g + 1], uk[4 * g + 2], uk[4 * g + 3]};
                    }
                    DSA_CONSUME(uk);
                }
                DSA_TIES();
            }
        } else {
            u32x4 ka[4], kb4[4];
#define DSA_KLOAD(dst, st_) do { _Pragma("unroll") for (int g = 0; g < 4; ++g) dst[g] = kmine[(size_t)(st_) * 2048 + g]; } while (0)
            DSA_KLOAD(ka, 0);
            if (nsteps > 1 && 128 + 32 * kb < n) DSA_KLOAD(kb4, 1);
            for (int step = 0; step < nsteps; ++step) {
                const int kbase = 128 * step + 32 * kb;
                unsigned uk[16];
#pragma unroll
                for (int g = 0; g < 4; ++g) { uk[4 * g] = ka[g].x; uk[4 * g + 1] = ka[g].y; uk[4 * g + 2] = ka[g].z; uk[4 * g + 3] = ka[g].w; }
#pragma unroll
                for (int g = 0; g < 4; ++g) ka[g] = kb4[g];
                if (step + 2 < nsteps && kbase + 256 < n) DSA_KLOAD(kb4, step + 2);
                unsigned gtw = 0u, eqw = 0u;
                if (kbase < n) DSA_CONSUME(uk);
                DSA_TIES();
            }
#undef DSA_KLOAD
        }
        if (sel) {
            __syncthreads();
#pragma unroll
            for (int qi = 0; qi < 8; ++qi) {
                const int q = 8 * wid + qi;
                const LAS unsigned* hq = hist + q * 257;
                const unsigned c0 = hq[255 - 4 * lane], c1 = hq[254 - 4 * lane], c2 = hq[253 - 4 * lane], c3 = hq[252 - 4 * lane];
                const unsigned s4 = c0 + c1 + c2 + c3;
                unsigned incl = s4;
#pragma unroll
                for (int o = 1; o < 64; o <<= 1) { const unsigned t = __shfl_up(incl, o); if (lane >= o) incl += t; }
                const unsigned excl = incl - s4, kr = krem[q];
                if (excl < kr && kr <= incl) {
                    unsigned cum = excl, bin, nk;
                    if (cum + c0 >= kr) { bin = 255 - 4 * lane; nk = kr - cum; }
                    else { cum += c0; if (cum + c1 >= kr) { bin = 254 - 4 * lane; nk = kr - cum; }
                    else { cum += c1; if (cum + c2 >= kr) { bin = 253 - 4 * lane; nk = kr - cum; }
                    else { cum += c2; bin = 252 - 4 * lane; nk = kr - cum; } } }
                    prefix[q] = (prefix[q] << 8) | bin; krem[q] = nk;
                }
            }
            __syncthreads();
        }
    }
    }
    if (dummy == 0x9e3779b9u) hist[tid] = 1u;
    const int hd = wid;
    u32x4 pk[2], pv[2];
#define DSA_LOADKV(step_) do { _Pragma("unroll") for (int i_ = 0; i_ < 2; ++i_) { const int ch_ = tid + 512 * i_; int krow_ = 128 * (step_) + (ch_ >> 3); if (krow_ > SEQ - 1) krow_ = SEQ - 1; \
        const GAS bf16_t* rp_ = (const GAS bf16_t*)proj + (tokb + krow_) * PW + (ch_ & 7) * 8; pk[i_] = *(const GAS u32x4*)(rp_ + C_DK); pv[i_] = *(const GAS u32x4*)(rp_ + C_DV); } } while (0)
#define DSA_STOREKV(buf_) do { _Pragma("unroll") for (int i_ = 0; i_ < 2; ++i_) { const int ch_ = tid + 512 * i_, key_ = ch_ >> 3, c8_ = ch_ & 7, kk_ = key_ & 31; \
        *(LAS u32x4*)(dl + DL_KT + (buf_) * 18432 + key_ * 144 + c8_ * 16) = pk[i_]; \
        *(LAS u32x4*)(dl + DL_VT + (buf_) * 16384 + (key_ >> 5) * 4096 + ((c8_ >> 2) * 2 + (kk_ >> 4)) * 1024 + (kk_ & 15) * 64 + (c8_ & 3) * 16) = pv[i_]; } } while (0)
    for (int rep_b2 = 0; rep_b2 < REP_B2; ++rep_b2)
    for (int qb = 0; qb < 2; ++qb) {
        bf16x8 qr[4];
        { const GAS bf16_t* qp = (const GAS bf16_t*)proj + (tokq0 + 32 * qb + r32) * PW + C_DQ + hd * 64 + 8 * hi;
#pragma unroll
          for (int kk = 0; kk < 4; ++kk) qr[kk] = *(const GAS bf16x8*)(qp + kk * 16); }
        f32x16 o0 = {}, o1 = {}; float mrun = -1e30f, lrun = 0.f;
        DSA_LOADKV(0);
        DSA_STOREKV(0);
        __syncthreads();
#define B2_QK(S_, k4_) do { const LAS unsigned char* krd_ = kt + (32 * (k4_) + r32) * 144 + hi * 16; S_ = (f32x16){}; \
        _Pragma("unroll") for (int kk = 0; kk < 4; ++kk) { const bf16x8 kf_ = *(const LAS bf16x8*)(krd_ + kk * 32); S_ = MFMA32(kf_, qr[kk], S_); } } while (0)
#define B2_SM_PV(S_, k4_) do { \
        const int selw_ = (int)selall[(32 * qb + r32) * 64 + step * 4 + (k4_)]; float mx_ = -INFINITY; \
        _Pragma("unroll") for (int r = 0; r < 16; ++r) { const unsigned m_ = (unsigned)__builtin_amdgcn_sbfe(selw_, crow(r, hi), 1); \
            S_[r] = __uint_as_float((__float_as_uint(S_[r]) & m_) | (0xFF800000u & ~m_)); mx_ = fmaxf(mx_, S_[r]); } \
        { const auto rr_ = __builtin_amdgcn_permlane32_swap(__float_as_uint(mx_), __float_as_uint(mx_), false, false); mx_ = fmaxf(__uint_as_float(rr_[0]), __uint_as_float(rr_[1])); } \
        if (__any(mx_ > mrun + 8.0f)) { const float mn_ = fmaxf(mrun, mx_), alpha_ = __builtin_amdgcn_exp2f(mrun - mn_); lrun *= alpha_; mrun = mn_; \
            _Pragma("unroll") for (int r = 0; r < 16; ++r) { o0[r] *= alpha_; o1[r] *= alpha_; } } \
        float pr_[16], rs_ = 0.f; \
        _Pragma("unroll") for (int r = 0; r < 16; ++r) { pr_[r] = __builtin_amdgcn_exp2f(S_[r] - mrun); rs_ += pr_[r]; } \
        lrun += rs_; \
        const bf16x8 pa_ = pack8(pr_), pb_ = pack8(pr_ + 8); \
        const lds_cptr vrd_ = (lds_cptr)vt + (k4_) * 4096 + vtr_lane_off(lane); \
        const bf16x8 v00_ = vfrag(vrd_, 0), v01_ = vfrag(vrd_, 1024), v10_ = vfrag(vrd_, 2048), v11_ = vfrag(vrd_, 3072); \
        o0 = MFMA32(v00_, pa_, o0); o0 = MFMA32(v01_, pb_, o0); o1 = MFMA32(v10_, pa_, o1); o1 = MFMA32(v11_, pb_, o1); } while (0)
        for (int step = 0; step < nsteps; ++step) {
            const int buf = step & 1;
            if (step + 1 < nsteps) DSA_LOADKV(step + 1);
            LAS unsigned char* kt = dl + DL_KT + buf * 18432;
            LAS unsigned char* vt = dl + DL_VT + buf * 16384;
            f32x16 sa, sb;
            B2_QK(sa, 0);
            B2_QK(sb, 1); B2_SM_PV(sa, 0); __builtin_amdgcn_sched_barrier(0);
            if (128 * step + 64 < n) {
                B2_QK(sa, 2); B2_SM_PV(sb, 1); __builtin_amdgcn_sched_barrier(0);
                B2_QK(sb, 3); B2_SM_PV(sa, 2); __builtin_amdgcn_sched_barrier(0);
                B2_SM_PV(sb, 3);
            } else {
                B2_SM_PV(sb, 1);
            }
            if (step + 1 < nsteps) DSA_STOREKV(buf ^ 1);
            __syncthreads();
        }
#undef B2_QK
#undef B2_SM_PV
        float l = lrun; { const auto rr = __builtin_amdgcn_permlane32_swap(__float_as_uint(l), __float_as_uint(l), false, false); l = __uint_as_float(rr[0]) + __uint_as_float(rr[1]); }
        const float il = 1.0f / l;
        bf16_t* op = odsa + (tokq0 + 32 * qb + r32) * 512 + hd * 64 + 4 * hi;
#pragma unroll
        for (int g = 0; g < 4; ++g) {
            u32x2 w0, w1; w0.x = cvt_pk_bf16(o0[4 * g] * il, o0[4 * g + 1] * il); w0.y = cvt_pk_bf16(o0[4 * g + 2] * il, o0[4 * g + 3] * il);
            w1.x = cvt_pk_bf16(o1[4 * g] * il, o1[4 * g + 1] * il); w1.y = cvt_pk_bf16(o1[4 * g + 2] * il, o1[4 * g + 3] * il);
            *(u32x2*)(op + 8 * g) = w0; *(u32x2*)(op + 32 + 8 * g) = w1; }
    }
#undef DSA_LOADKV
#undef DSA_STOREKV
#undef DSA_CONSUME
#undef DSA_TIES
    __syncthreads();
}

template <int CTRL> __device__ __forceinline__ float dpp_f(float v) { return __builtin_bit_cast(float, __builtin_amdgcn_update_dpp(0, __builtin_bit_cast(int, v), CTRL, 0xF, 0xF, false)); }
constexpr int RL_WROW = 2064, RL_WHI = 0, RL_WLO = 32 * RL_WROW, RL_TKE = 2 * 32 * RL_WROW, RL_TKW = RL_TKE + 4096;
__device__ __forceinline__ void p9_router(Frame& F) {
    const int lane = F.lane, wave = F.wave, tid = F.tid, r32 = lane & 31, hi = lane >> 5;
    LAS int* tke = (LAS int*)(F.lds + RL_TKE); LAS float* tkw = (LAS float*)(F.lds + RL_TKW);
    const float* w_router = F.in[15]; const float* b_router = F.in[16]; const float* g_ffn = F.in[14];
    for (int idx = tid; idx < DM * NEXP; idx += NWAVES * 64) { const int k = idx >> 5, e = idx & 31; const float w = w_router[idx];
        const unsigned wh = f2bf(w); const unsigned wl = f2bf(w - __builtin_bit_cast(float, wh << 16));
        *(LAS bf16_t*)(F.lds + RL_WHI + e * RL_WROW + k * 2) = (bf16_t)wh; *(LAS bf16_t*)(F.lds + RL_WLO + e * RL_WROW + k * 2) = (bf16_t)wl; }
    if (tid < 32) F.MISC[MW_LCNT + tid] = 0u;
    __syncthreads();
    bf16_t* h2 = (bf16_t*)(F.ws + WS_H); unsigned char* h2f8 = F.ws + WS_H2F8;
    const GAS f32x4* gr = (const GAS f32x4*)g_ffn + lane;
    f32x4 gg[4];
#pragma unroll
    for (int j = 0; j < 4; ++j) gg[j] = gr[64 * j];
    const size_t tok0 = (size_t)F.blk * 256 + 32 * wave;
    u32x2 xnext[2][4];
#pragma unroll
    for (int tk = 0; tk < 2; ++tk) { const GAS u32x2* xr = (const GAS u32x2*)((const GAS bf16_t*)F.out + (tok0 + tk) * 2048 + ((tok0 + tk) & 1) * 1024) + lane;
#pragma unroll
        for (int j = 0; j < 4; ++j) xnext[tk][j] = xr[64 * j]; }
    for (int it = 0; it < 16; ++it) {
        f32x4 hn[2][4];
#pragma unroll
        for (int tk = 0; tk < 2; ++tk)
#pragma unroll
            for (int j = 0; j < 4; ++j) hn[tk][j] = (f32x4){bflo(xnext[tk][j].x), bfhi(xnext[tk][j].x), bflo(xnext[tk][j].y), bfhi(xnext[tk][j].y)};
        if (it + 1 < 16) {
#pragma unroll
            for (int tk = 0; tk < 2; ++tk) { const GAS u32x2* xr = (const GAS u32x2*)((const GAS bf16_t*)F.out + (tok0 + 2 * it + 2 + tk) * 2048 + ((tok0 + 2 * it + 2 + tk) & 1) * 1024) + lane;
#pragma unroll
                for (int j = 0; j < 4; ++j) xnext[tk][j] = xr[64 * j]; } }
        float s[2];
#pragma unroll
        for (int tk = 0; tk < 2; ++tk) { float a = 0.f;
#pragma unroll
            for (int j = 0; j < 4; ++j) a += (hn[tk][j].x * hn[tk][j].x + hn[tk][j].y * hn[tk][j].y) + (hn[tk][j].z * hn[tk][j].z + hn[tk][j].w * hn[tk][j].w);
            s[tk] = a; }
#pragma unroll
        for (int tk = 0; tk < 2; ++tk) { float a = s[tk];
            a += dpp_f<0xB1>(a); a += dpp_f<0x4E>(a); a += dpp_f<0x141>(a); a += dpp_f<0x128>(a);
            { const auto rr = __builtin_amdgcn_permlane16_swap(__float_as_uint(a), __float_as_uint(a), false, false); a = __uint_as_float(rr[0]) + __uint_as_float(rr[1]); }
            { const auto rr = __builtin_amdgcn_permlane32_swap(__float_as_uint(a), __float_as_uint(a), false, false); a = __uint_as_float(rr[0]) + __uint_as_float(rr[1]); }
            s[tk] = a; }
#pragma unroll
        for (int tk = 0; tk < 2; ++tk) {
            const float rstd = 1.0f / sqrtf(s[tk] * (1.f / DM) + EPS);
            GAS u32x2* o8 = (GAS u32x2*)(h2 + (tok0 + 2 * it + tk) * DM) + lane;
#pragma unroll
            for (int j = 0; j < 4; ++j) { const f32x4 v = hn[tk][j] * rstd * gg[j]; u32x2 o; o.x = pk2(v.x, v.y); o.y = pk2(v.z, v.w); o8[64 * j] = o;
                *((GAS unsigned*)(h2f8 + (tok0 + 2 * it + tk) * DM) + lane + 64 * j) = pk4_f8(v.x, v.y, v.z, v.w); }
        }
    }
    asm volatile("s_waitcnt vmcnt(0)" ::: "memory");
    f32x16 acc = {};
    { const GAS bf16_t* hp = (const GAS bf16_t*)h2 + (tok0 + r32) * DM + 8 * hi;
      const LAS unsigned char* wp = F.lds + RL_WHI + r32 * RL_WROW + 16 * hi;
#pragma unroll 8
      for (int kk = 0; kk < 64; ++kk) { const bf16x8 hb = *(const GAS bf16x8*)(hp + 16 * kk);
          const bf16x8 wh = *(const LAS bf16x8*)(wp + 32 * kk), wl = *(const LAS bf16x8*)(wp + RL_WLO + 32 * kk);
          acc = MFMA32(wh, hb, acc); acc = MFMA32(wl, hb, acc); } }
    float lg[16];
#pragma unroll
    for (int r = 0; r < 16; ++r) lg[r] = acc[r] + b_router[crow(r, hi)];
    float lv[4]; int li[4];
#pragma unroll
    for (int k = 0; k < 4; ++k) { float bv = lg[0]; int br = 0;
#pragma unroll
        for (int r = 1; r < 16; ++r) { const bool g = lg[r] > bv; bv = g ? lg[r] : bv; br = g ? r : br; }
        lv[k] = bv; li[k] = crow(br, hi);
#pragma unroll
        for (int r = 0; r < 16; ++r) lg[r] = (r == br) ? -INFINITY : lg[r]; }
    float ov[4]; int oi[4];
#pragma unroll
    for (int k = 0; k < 4; ++k) { const auto rv = __builtin_amdgcn_permlane32_swap(__float_as_uint(lv[k]), __float_as_uint(lv[k]), false, false); const auto ri = __builtin_amdgcn_permlane32_swap((unsigned)li[k], (unsigned)li[k], false, false);
        ov[k] = hi ? __uint_as_float(rv[0]) : __uint_as_float(rv[1]); oi[k] = hi ? (int)ri[0] : (int)ri[1]; }
    float tv[4]; int te[4];
    { float a0 = lv[0], a1 = lv[1], a2 = lv[2], a3 = lv[3], b0 = ov[0], b1 = ov[1], b2 = ov[2], b3 = ov[3];
      int i0 = li[0], i1 = li[1], i2 = li[2], i3 = li[3], j0 = oi[0], j1 = oi[1], j2 = oi[2], j3 = oi[3];
#pragma unroll
      for (int k = 0; k < 4; ++k) { const bool ta = (a0 > b0) || (a0 == b0 && i0 < j0);
          tv[k] = ta ? a0 : b0; te[k] = ta ? i0 : j0;
          if (ta) { a0 = a1; a1 = a2; a2 = a3; a3 = -INFINITY; i0 = i1; i1 = i2; i2 = i3; i3 = 64; }
          else { b0 = b1; b1 = b2; b2 = b3; b3 = -INFINITY; j0 = j1; j1 = j2; j2 = j3; j3 = 64; } } }
    const float e1 = __expf(tv[1] - tv[0]), e2x = __expf(tv[2] - tv[0]), e3 = __expf(tv[3] - tv[0]);
    const float inv = 1.0f / (1.0f + e1 + e2x + e3);
    if (hi == 0) { const int tl = 32 * wave + r32;
        *(LAS int*)(tke + tl * 4 + 0) = te[0]; tke[tl * 4 + 1] = te[1]; tke[tl * 4 + 2] = te[2]; tke[tl * 4 + 3] = te[3];
        tkw[tl * 4 + 0] = inv; tkw[tl * 4 + 1] = e1 * inv; tkw[tl * 4 + 2] = e2x * inv; tkw[tl * 4 + 3] = e3 * inv;
#pragma unroll
        for (int k = 0; k < 4; ++k) __hip_atomic_fetch_add((LAS unsigned*)F.MISC + MW_LCNT + te[k], 1u, __ATOMIC_RELAXED, __HIP_MEMORY_SCOPE_WORKGROUP); }
    __syncthreads();
    if (tid < 32) ((int*)(F.ws + WS_BLKCNT))[F.blk * 32 + tid] = (int)F.MISC[MW_LCNT + tid];
}
__device__ __forceinline__ void p10_assign(Frame& F) {
    const int tid = F.tid;
    const int* blkcnt = (const int*)(F.ws + WS_BLKCNT);
    LAS int* part = (LAS int*)(F.lds);
    LAS int* tke = (LAS int*)(F.lds + RL_TKE); LAS float* tkw = (LAS float*)(F.lds + RL_TKW);
    { const int e = tid & 31, p = tid >> 5; int tot = 0, bef = 0;
      for (int j = 0; j < 16; ++j) { const int bl = p * 16 + j; const int c = blkcnt[bl * 32 + e]; tot += c; bef += (bl < F.blk) ? c : 0; }
      part[p * 32 + e] = tot; part[512 + p * 32 + e] = bef; }
    __syncthreads();
    if (tid < 32) { int tot = 0, bef = 0;
        for (int p = 0; p < 16; ++p) { tot += part[p * 32 + tid]; bef += part[512 + p * 32 + tid]; }
        part[1024 + tid] = tot; F.MISC[MW_BEFORE + tid] = (unsigned)bef; F.MISC[MW_LCNT + tid] = 0u; }
    __syncthreads();
    if (tid == 0) { int ps = 0;
        for (int e = 0; e < 32; ++e) { F.MISC[MW_PSTART + e] = (unsigned)ps; F.MISC[MW_TSTART + e] = (unsigned)(ps >> 8); ps += (part[1024 + e] + 255) & ~255; }
        F.MISC[MW_PSTART + 32] = (unsigned)ps; F.MISC[MW_TSTART + 32] = (unsigned)(ps >> 8); }
    __syncthreads();
    int* slot_tok = (int*)(F.ws + WS_SLOT_TOK); int* tok_slot = (int*)(F.ws + WS_TOK_SLOT); float* tok_gate = (float*)(F.ws + WS_TOK_GATE);
    for (int idx = tid; idx < 1024; idx += NWAVES * 64) {
        const int e = tke[idx]; const float w = tkw[idx];
        const unsigned r = __hip_atomic_fetch_add((LAS unsigned*)F.MISC + MW_LCNT + e, 1u, __ATOMIC_RELAXED, __HIP_MEMORY_SCOPE_WORKGROUP);
        const unsigned pos = F.MISC[MW_PSTART + e] + F.MISC[MW_BEFORE + e] + r;
        slot_tok[pos] = F.blk * 256 + (idx >> 2); tok_slot[F.blk * 1024 + idx] = (int)pos; tok_gate[F.blk * 1024 + idx] = w;
    }
}

__device__ __forceinline__ void p13_combine(Frame& F) {
    const int gw = F.blk * NWAVES + F.wave, NGW = F.G * NWAVES, lane = F.lane;
    const int* tok_slot = (const int*)(F.ws + WS_TOK_SLOT); const float* tok_gate = (const float*)(F.ws + WS_TOK_GATE);
    const GAS unsigned char* Y = (const GAS unsigned char*)(F.ws + WS_Y);
    typedef float f2_t __attribute__((ext_vector_type(2)));
    for (int t0 = gw; t0 < NTOK; t0 += 2 * NGW) {
        u32x4 y[2][4]; u32x4 xb[2][2]; float g[2][4];
#pragma unroll
        for (int tk = 0; tk < 2; ++tk) { const int t = t0 + tk * NGW;
#pragma unroll
            for (int k = 0; k < 4; ++k) { const int sl = __builtin_amdgcn_readfirstlane(tok_slot[4 * t + k]); g[tk][k] = tok_gate[4 * t + k];
                y[tk][k] = *(const GAS u32x4*)(Y + (size_t)sl * DM + 16 * lane); }
            const GAS bf16_t* xrow = (const GAS bf16_t*)F.out + (size_t)t * 2048 + (t & 1) * 1024 + 16 * lane;
            xb[tk][0] = *(const GAS u32x4*)xrow; xb[tk][1] = *(const GAS u32x4*)(xrow + 8); }
        asm volatile("s_waitcnt vmcnt(0)" ::: "memory");
#pragma unroll
        for (int tk = 0; tk < 2; ++tk) { const int t = t0 + tk * NGW;
            f32x4 o[4];
#pragma unroll
            for (int h = 0; h < 2; ++h) { const u32x4 v = xb[tk][h];
                o[2 * h] = (f32x4){bflo(v.x), bfhi(v.x), bflo(v.y), bfhi(v.y)}; o[2 * h + 1] = (f32x4){bflo(v.z), bfhi(v.z), bflo(v.w), bfhi(v.w)}; }
#pragma unroll
            for (int k = 0; k < 4; ++k) { const float w = g[tk][k];
#pragma unroll
                for (int c = 0; c < 4; ++c) { const f2_t lo = __builtin_amdgcn_cvt_pk_f32_fp8((int)y[tk][k][c], false), hi = __builtin_amdgcn_cvt_pk_f32_fp8((int)y[tk][k][c], true);
                    o[c][0] += w * lo[0]; o[c][1] += w * lo[1]; o[c][2] += w * hi[0]; o[c][3] += w * hi[1]; } }
            GAS float* orow = (GAS float*)F.out + (size_t)t * DM + 16 * lane;
#pragma unroll
            for (int c = 0; c < 4; ++c) *(GAS f32x4*)(orow + 4 * c) = o[c]; }
    }
}

#ifndef MK_ONE_LAUNCH
#define MK_ONE_LAUNCH 1
#endif
constexpr int N_PHASES = 14;
struct Args { const float* in[21]; float* out; unsigned char* ws; int ph_lo, ph_hi; };
static_assert(sizeof(Args) == 21 * 8 + 8 + 8 + 8, "no padding");

__global__ void __launch_bounds__(NWAVES * 64, 2) fwd_kernel(Args args) {
    extern __shared__ __attribute__((aligned(16))) unsigned char lds[];
    Frame F;
    F.lds = (LAS unsigned char*)lds;
    F.MISC = (volatile LAS unsigned*)(F.lds + MISC_OFF);
    F.tid = threadIdx.x; F.lane = F.tid & 63; F.wave = __builtin_amdgcn_readfirstlane(F.tid >> 6);
#define FRESH() do { F.lane = lane_id_fresh(); F.tid = F.wave * 64 + F.lane; } while (0)
    F.G = gridDim.x; F.blk = blockIdx.x;
    F.ws = args.ws; F.out = args.out; F.ctl = (gu32*)(args.ws + WS_CTL);
#pragma unroll
    for (int i = 0; i < 21; ++i) F.in[i] = args.in[i];
    for (int u = F.tid; u < (LDS_BYTES - MISC_OFF) / 4; u += NWAVES * 64) ((LAS unsigned*)(F.lds + MISC_OFF))[u] = 0u;
    __syncthreads();
    const int lo = args.ph_lo, hi = args.ph_hi;
    XcdBarrier bar; bar.bar = (unsigned*)(F.ctl + CW_BAR); bar.x = 0; bar.st = nullptr; bar.wave = F.wave;
    if (hi - lo > 1) bar = xcd_barrier_post((unsigned*)(F.ctl + CW_BAR), F.MISC + MW_BAR);
#ifndef STAG
#define STAG 0
#endif
#ifndef PH_MASK
#define PH_MASK 0x3fff
#endif
#define IN(k) (((PH_MASK >> (k)) & 1) && lo <= (k) && (k) < hi)
#ifndef REP_MASK
#define REP_MASK 0
#endif
#define NREP(k) (1 + ((REP_MASK >> (k)) & 1))
#define SEAM(k) do { if (IN(k) && IN((k) + 1)) xcd_barrier(bar); } while (0)
    unsigned char* ws = args.ws;
    bf16_t* proj = (bf16_t*)(ws + WS_P);

    if (IN(0)) for (int rep = 0; rep < NREP(0); ++rep) { if (rep) xcd_barrier(bar); FRESH(); p0_prologue(F); } SEAM(0);

    if (IN(1)) {
#ifdef PROBE_P1
        { pg8::DenseSched S; S.init(ws + WS_H, ws + WS_WIN, NTOK, PW, DM, F.G, F.blk); S.amask = PROBE_P1;
          pg8::EpiBf16<0> E{(bf16_t*)(ws + WS_END), PW, nullptr, 1023};
          pg8::gemm_phase<pg8::EpiBf16<0>, pg8::DenseSched, true>(F.lds, F.wave, DM, S, E); }
        xcd_barrier(bar);
#endif
        { pg8::DenseSched S; S.init(ws + WS_H, ws + WS_WIN, NTOK, PW, DM, F.G, F.blk);
          pg8::EpiBf16<0> E{proj, PW, nullptr};
          pg8::gemm_phase<pg8::EpiBf16<0>, pg8::DenseSched, true>(F.lds, F.wave, DM, S, E); }
        { pg8::DenseSched S; S.init(ws + WS_MEMN, ws + WS_WMKV, NMEM, DM, DM, F.G, F.blk);
          pg8::EpiBf16<0> E{(bf16_t*)(ws + WS_MKV), DM, nullptr};
          pg8::gemm_phase<pg8::EpiBf16<0>, pg8::DenseSched, true>(F.lds, F.wave, DM, S, E); }
    } SEAM(1);

    if (IN(2)) { FRESH(); if (REP_MASK & 4) { p2_prep(F, true); xcd_barrier(bar); } p2_prep(F); } SEAM(2);

    if (IN(3)) {
        FRESH();
        bf16_t* osb = (bf16_t*)(ws + WS_O); bf16_t* odsa = osb + (size_t)NTOK * 512; bf16_t* omem = odsa + (size_t)NTOK * 512;
#ifndef REP_DSA
#define REP_DSA 1
#endif
#ifndef REP_SB
#define REP_SB 1
#endif
#ifndef REP_MEM
#define REP_MEM 1
#endif
#ifndef NO_DSA
        for (int rep = 0; rep < REP_DSA; ++rep)
        for (int i = 0; i < 4; ++i) { const int p = 2 * F.blk + (i >> 1), b = p >> 4, cc = p & 15, c = (i & 1) ? 31 - cc : cc; dsa_unit(proj, odsa, (unsigned*)F.out + (size_t)F.blk * 131072, b, c, F.lds, F.tid); }
#endif
        const int gw = F.blk * NWAVES + F.wave, NGW = F.G * NWAVES;
#ifndef NO_SB
        for (int rep = 0; rep < REP_SB; ++rep)
        for (int it = gw; it < NB * 8 * 64; it += NGW) { const int qblk = 63 - (it >> 8), bh = it & 255; sb_item(proj, osb, bh >> 3, bh & 7, qblk, F.lds + F.wave * 4096, F.lane); }
#endif
#ifndef NO_MEM
        for (int rep = 0; rep < REP_MEM; ++rep) {
            __syncthreads();
            for (int u = F.blk; u < NB * 4 * 2; u += F.G) mem_unit(proj, (const bf16_t*)(ws + WS_MKV), omem, u >> 3, (u >> 1) & 3, u & 1, F.lds, F.tid);
        }
#endif
    } SEAM(3);

    if (IN(4)) {
        pg8::DenseSched S; S.init(ws + WS_H8, ws + WS_WG, NTOK, 3 * DM, DM / 2, F.G, F.blk);
        pg8::EpiGateU8 E{(unsigned char*)proj, F.in[11]};
        pg8::gemm_phase<pg8::EpiGateU8, pg8::DenseSched, true, true>(F.lds, F.wave, DM / 2, S, E);
    } SEAM(4);

    if (IN(5)) { pg8::MergeSched S; S.init(ws + WS_O, ws + WS_WB, NTOK, DM, F.G, F.blk);
        pg8::EpiMerge E{(const unsigned char*)proj, (bf16_t*)(ws + WS_H)};
        pg8::gemm_phase<pg8::EpiMerge, pg8::MergeSched, true>(F.lds, F.wave, 512, S, E); } SEAM(5);


    if (IN(8)) {
        pg8::DenseSched S; S.init(ws + WS_H, ws + WS_WO, NTOK, DM, DM, F.G, F.blk); S.stag = STAG;
        pg8::EpiResid E{F.in[0], (bf16_t*)F.out};
        pg8::gemm_phase<pg8::EpiResid, pg8::DenseSched, true>(F.lds, F.wave, DM, S, E);
    } SEAM(8);

    if (IN(9)) for (int rep = 0; rep < NREP(9); ++rep) { if (rep) xcd_barrier(bar); FRESH(); p9_router(F); } SEAM(9);
    if (IN(10)) for (int rep = 0; rep < NREP(10); ++rep) { if (rep) xcd_barrier(bar); FRESH(); p10_assign(F); } SEAM(10);

    if (IN(11)) {
        pg8::MoeSched S{(const char*)(ws + WS_H2F8), (const char*)(ws + WS_WEI), (const int*)(ws + WS_SLOT_TOK), F.MISC + MW_TSTART, DM / 2, 2048, 8, F.blk};
        pg8::EpiSwiglu E{ws + WS_ACT8, F.in[18], F.lds};
        pg8::gemm_phase<pg8::EpiSwiglu, pg8::MoeSched, true, true>(F.lds, F.wave, DM / 2, S, E);
    } SEAM(11);

    if (IN(12)) {
        pg8::MoeSched S{(const char*)(ws + WS_ACT8), (const char*)(ws + WS_WEO), nullptr, F.MISC + MW_TSTART, DM / 2, DM, 4, F.blk};
        pg8::EpiY8 E{ws + WS_Y, F.in[20]};
        pg8::gemm_phase<pg8::EpiY8, pg8::MoeSched, true, true>(F.lds, F.wave, DM / 2, S, E);
    } SEAM(12);

    if (IN(13)) { FRESH(); p13_combine(F); }
#undef IN
#undef SEAM
}

extern "C" void kernel_launch(void* const* d_in, const int* in_sizes, int n_in, void* d_out, int out_size, void* d_ws, size_t ws_size, hipStream_t stream) {
    static int grid = 0;
    if (grid == 0) {
        if (n_in != 21 || in_sizes[0] != NTOK * DM || out_size != NTOK * DM || ws_size < WS_END) {
            fprintf(stderr, "kernel_launch: unexpected shapes: n_in %d in0 %d out %d ws %zu (need >= %zu); nothing launched\n", n_in, n_in > 0 ? in_sizes[0] : -1, out_size, ws_size, (size_t)WS_END); grid = -1; return; }
        int dev = 0, cus = 0, per_cu = 0;
        if (hipGetDevice(&dev) != hipSuccess || hipDeviceGetAttribute(&cus, hipDeviceAttributeMultiprocessorCount, dev) != hipSuccess) { fprintf(stderr, "kernel_launch: device query failed\n"); grid = -1; return; }
        if (hipFuncSetAttribute((const void*)fwd_kernel, hipFuncAttributeMaxDynamicSharedMemorySize, LDS_BYTES) != hipSuccess) { fprintf(stderr, "kernel_launch: hipFuncSetAttribute failed\n"); grid = -1; return; }
        if (hipOccupancyMaxActiveBlocksPerMultiprocessor(&per_cu, (const void*)fwd_kernel, NWAVES * 64, LDS_BYTES) != hipSuccess || per_cu < 1)
            fprintf(stderr, "kernel_launch: note: occupancy query reports %d workgroups per CU\n", per_cu);
        (void)hipGetLastError();
        grid = cus;
        if (grid != 256) { fprintf(stderr, "kernel_launch: this kernel is built for 256 CUs (got %d); nothing launched\n", grid); grid = -1; return; }
    }
    if (grid < 0) return;
    if (hipMemsetAsync((char*)d_ws + WS_CTL, 0, CTL_ZERO_BYTES, stream) != hipSuccess) { fprintf(stderr, "kernel_launch: hipMemsetAsync failed\n"); return; }
    Args a{};
    for (int i = 0; i < 21; ++i) a.in[i] = (const float*)d_in[i];
    a.out = (float*)d_out; a.ws = (unsigned char*)d_ws;
#if MK_ONE_LAUNCH
    const int cuts[2] = {0, N_PHASES}; const int nl = 1;
#else
    const int cuts[11] = {0, 1, 2, 3, 4, 5, 6, 7, 8, 9, N_PHASES}; const int nl = 10;
#endif
    for (int li = 0; li < nl; ++li) {
        a.ph_lo = cuts[li]; a.ph_hi = cuts[li + 1];
        hipLaunchKernelGGL(fwd_kernel, dim3(grid), dim3(NWAVES * 64), LDS_BYTES, stream, a);
        const hipError_t le = hipPeekAtLastError();
        if (le != hipSuccess) { fprintf(stderr, "kernel_launch: launch %d failed: %s\n", li, hipGetErrorName(le)); break; }
    }
}
```

```cpp
#include <hip/hip_runtime.h>
#include <cstdio>
#include <cstdint>

#define LAS __attribute__((address_space(3)))
#define GAS __attribute__((address_space(1)))
typedef unsigned short bf16_t;
typedef short bf16x8 __attribute__((ext_vector_type(8)));
typedef short s16x4 __attribute__((ext_vector_type(4)));
typedef short v4i16_t __attribute__((ext_vector_type(4)));
typedef float f32x2 __attribute__((ext_vector_type(2)));
typedef float f32x4 __attribute__((ext_vector_type(4)));
typedef float f32x16 __attribute__((ext_vector_type(16)));
typedef unsigned u32x2 __attribute__((ext_vector_type(2)));
typedef unsigned u32x4 __attribute__((ext_vector_type(4)));
typedef int i32x4 __attribute__((ext_vector_type(4)));
typedef int i32x8 __attribute__((ext_vector_type(8)));
typedef GAS unsigned gu32;

constexpr int NB = 32, SEQ = 2048, DM = 1024, NTOK = NB * SEQ;
constexpr int MEMLEN = 256, NMEM = NB * MEMLEN;
constexpr int PW = 3072;
constexpr int C_SQ = 0, C_SK = 512, C_SV = 1024, C_DQ = 1536, C_DK = 2048, C_DV = 2112, C_IQ = 2176, C_IK = 2432, C_IW = 2496, C_MQ = 2560;
constexpr int IN_W = 3012;
constexpr int NEXP = 32, TOPK = 4, DEXP = 1024;
constexpr int NSLOT = NTOK * TOPK;
constexpr int NSLOT_PAD = NSLOT + NEXP * 256;
constexpr float EPS = 1e-6f;
constexpr float LOG2E = 1.4426950408889634f;

constexpr size_t MiB = 1u << 20;
constexpr size_t WS_CTL = 0, CTL_ZERO_BYTES = 1 * MiB;
constexpr size_t WS_ROPE = 1 * MiB;
constexpr size_t WS_BLKCNT = 1 * MiB + 512 * 1024;
constexpr size_t WS_SLOT_TOK = 2 * MiB;
constexpr size_t WS_TOK_SLOT = 4 * MiB;
constexpr size_t WS_TOK_GATE = 5 * MiB;
constexpr size_t WS_WIN = 8 * MiB;
constexpr size_t WS_WMKV = 14 * MiB;
constexpr size_t WS_WG = 16 * MiB;
constexpr size_t WS_WB = 22 * MiB;
constexpr size_t WS_WO = 25 * MiB;
constexpr size_t WS_WEI = 27 * MiB;
constexpr size_t WS_WEO = 155 * MiB;
__device__ __forceinline__ int lane_id_fresh() { int l; asm volatile("v_mbcnt_lo_u32_b32 %0, -1, 0\n\tv_mbcnt_hi_u32_b32 %0, -1, %0" : "=v"(l)); return l; }
__device__ __forceinline__ unsigned pk4_f8(float a, float b, float c, float d) { int v = __builtin_amdgcn_cvt_pk_fp8_f32(a, b, 0, false); return (unsigned)__builtin_amdgcn_cvt_pk_fp8_f32(c, d, v, true); }
constexpr float W8_SCALE = 64.f, W8_INV = 1.f / 64.f;
constexpr size_t WS_H = 220 * MiB;
constexpr size_t WS_P = 348 * MiB;
constexpr size_t WS_O = 732 * MiB;
constexpr size_t WS_H8 = 91 * MiB;
constexpr size_t WS_H2F8 = 91 * MiB;
constexpr size_t WS_MEMN = 924 * MiB;
constexpr size_t WS_MKV = 940 * MiB;
constexpr size_t WS_Y = 220 * MiB;
constexpr size_t WS_ACT8 = 748 * MiB;
constexpr size_t WS_END = 1012 * MiB;
static_assert(WS_Y + (size_t)NSLOT_PAD * DM * 2 <= WS_ACT8 && WS_ACT8 + (size_t)NSLOT_PAD * DEXP <= WS_END, "y | act8");
static_assert(WS_SLOT_TOK + (size_t)NSLOT_PAD * 4 <= WS_TOK_SLOT && WS_TOK_GATE + (size_t)NTOK * 16 <= WS_WIN, "slot tables");

constexpr int CW_BAR = 4096;

constexpr int RING_BYTES = 151552;
constexpr int MISC_OFF = RING_BYTES;
constexpr int LDS_BYTES = 155648;
constexpr int MW_BAR = 8;
constexpr int MW_LCNT = 16;
constexpr int MW_PSTART = 64;
constexpr int MW_TSTART = 128;
constexpr int MW_BEFORE = 192;
constexpr int MW_PART = 256;

__device__ __forceinline__ unsigned f2bf(float f) { unsigned u = __builtin_bit_cast(unsigned, f); return (u + 0x7fffu + ((u >> 16) & 1u)) >> 16; }
__device__ __forceinline__ unsigned pk2(float lo, float hi) { return f2bf(lo) | (f2bf(hi) << 16); }
__device__ __forceinline__ float bf2f(unsigned short b) { return __builtin_bit_cast(float, (unsigned)b << 16); }
__device__ __forceinline__ float bflo(unsigned w) { return __builtin_bit_cast(float, w << 16); }
__device__ __forceinline__ float bfhi(unsigned w) { return __builtin_bit_cast(float, w & 0xffff0000u); }
__device__ __forceinline__ unsigned cvt_pk_bf16(float lo, float hi) { unsigned r; asm volatile("v_cvt_pk_bf16_f32 %0, %1, %2" : "=v"(r) : "v"(lo), "v"(hi)); return r; }
__device__ __forceinline__ int crow(int r, int hi) { return (r & 3) + 8 * (r >> 2) + 4 * hi; }
#define LDS_WAIT() asm volatile("s_waitcnt lgkmcnt(0)" ::: "memory")
#define VM_WAIT() asm volatile("s_waitcnt vmcnt(0)" ::: "memory")

namespace pg8 {
constexpr int BM = 256, BK = 64, HALF = 128, HTB = HALF * BK * 2, STAGE_BYTES = 8 * HTB;
__host__ __device__ __forceinline__ int lds_byte(int r, int c) { const int st = (r >> 4) * 2 + (c >> 5), rr = r & 15, cc = c & 31, ob = rr * 64 + cc * 2; return st * 1024 + (ob ^ (((ob >> 9) & 1) << 5)); }
__host__ __device__ __forceinline__ void stage_rc(int b, int& R, int& C) { const int st = b / 1024, sb = b % 1024, swz = sb ^ (((sb >> 9) & 1) << 5); R = (st >> 1) * 16 + swz / 64; C = (st & 1) * 32 + (swz % 64) / 2; }
__host__ __device__ __forceinline__ int perm32(int rho) { const int n = rho >> 4, i = rho & 15; return 8 * (i >> 2) + 4 * n + (i & 3); }

struct Unit { int pm, pn, e; };
constexpr int EPI_NA_OFF = STAGE_BYTES;
constexpr int ROWTAB_OFF = STAGE_BYTES + 8192;
constexpr int BIASTAB_OFF = STAGE_BYTES + 10240;

template <class Epi, class Sched, bool ALIGN_EPI, bool FP8 = false>
__device__ __forceinline__ void gemm_phase(LAS unsigned char* lds, const int wave_, const int K, const Sched& S, const Epi& E) {
    int tid = wave_ * 64 + lane_id_fresh();
    const int wid = __builtin_amdgcn_readfirstlane(tid >> 6), lane = tid & 63, wr = wid >> 2, wc = wid & 3, fr = lane & 15, fq = lane >> 4;
    const int nt = K / BK;
    int Rr[2], Cc[2]; unsigned voffB[2];
#pragma unroll
    for (int i = 0; i < 2; ++i) { int R, C; stage_rc(tid * 16 + i * 8192, R, C); Rr[i] = R; Cc[i] = C; const int Rb = Epi::PERM ? ((R & ~31) + perm32(R & 31)) : R; voffB[i] = (unsigned)(Rb * K + C) * 2u; }
    const size_t kstep = (size_t)(BK * 2);
    const size_t hstepB = (size_t)HALF * K * 2;
    const unsigned ldsw = (unsigned)wid * 1024u;
    const int aoff = lds_byte(wr * 64 + fr, fq * 8), boff = lds_byte(wc * 32 + fr, fq * 8);
#define PG8_SA(b, h) (((b) * 2 + (h)) * HTB)
#define PG8_SB(b, h) ((4 + (b) * 2 + (h)) * HTB)
#define PG8_STAGE(bufoff, gbase, voff) do { _Pragma("unroll") for (int _i = 0; _i < 2; ++_i) { unsigned o_ = (voff)[_i]; asm volatile("" : "+v"(o_)); \
        __builtin_amdgcn_global_load_lds((const unsigned*)((const char*)(gbase) + o_), (LAS unsigned*)(lds + (bufoff) + ldsw + _i * 8192), 16, 0, 0); } } while (0)
#define PG8_J8(x, y) __builtin_shufflevector(x, y, 0, 1, 2, 3, 4, 5, 6, 7)
#define PG8_LDA(dst, b, h) do { _Pragma("unroll") for (int m = 0; m < 4; ++m) { const LAS unsigned char* p_ = lds + PG8_SA(b, h) + aoff + m * 2048; \
        if constexpr (FP8) dst##8[m] = PG8_J8(*(const LAS i32x4*)p_, *(const LAS i32x4*)(p_ + 1024)); else { dst[m][0] = *(const LAS bf16x8*)p_; dst[m][1] = *(const LAS bf16x8*)(p_ + 1024); } } } while (0)
#define PG8_LDB(dst, b, h) do { _Pragma("unroll") for (int n = 0; n < 2; ++n) { const LAS unsigned char* p_ = lds + PG8_SB(b, h) + boff + n * 2048; \
        if constexpr (FP8) dst##8[n] = PG8_J8(*(const LAS i32x4*)p_, *(const LAS i32x4*)(p_ + 1024)); else { dst[n][0] = *(const LAS bf16x8*)p_; dst[n][1] = *(const LAS bf16x8*)(p_ + 1024); } } } while (0)
#define PG8_MMA(ai, bj, At, Bt) do { __builtin_amdgcn_s_setprio(1); _Pragma("unroll") for (int m = 0; m < 4; ++m) _Pragma("unroll") for (int n = 0; n < 2; ++n) { \
        if constexpr (FP8) acc[ai][bj][m][n] = __builtin_amdgcn_mfma_scale_f32_16x16x128_f8f6f4(Bt##8[n], At##8[m], acc[ai][bj][m][n], 0, 0, 0, 0, 0, 0); \
        else { _Pragma("unroll") for (int k = 0; k < 2; ++k) acc[ai][bj][m][n] = __builtin_amdgcn_mfma_f32_16x16x32_bf16(Bt[n][k], At[m][k], acc[ai][bj][m][n], 0, 0, 0); } } \
        __builtin_amdgcn_s_setprio(0); } while (0)
#define PG8_WAIT_V(n) asm volatile("s_waitcnt vmcnt(" #n ")" ::: "memory")
#define PG8_WAIT_VR do { if (!(t == 0 && ui > 0)) PG8_WAIT_V(8); } while (0)
#define PG8_WAIT_L(n) asm volatile("s_waitcnt lgkmcnt(" #n ")" ::: "memory")
#define PG8_BAR __builtin_amdgcn_s_barrier()
#define PG8_SCHED __builtin_amdgcn_sched_barrier(0)
#define PG8_TIDQ() (wave_ * 64 + lane_id_fresh())
#define PG8_SIDE(gptr, off) __builtin_amdgcn_global_load_lds((const unsigned*)(gptr), (LAS unsigned*)(lds + (off)), 16, 0, 0)
    Unit cur, nxt, nx2; int ui = 0;
    if (!S.next(0, cur)) return;
    bool has_next = S.next(1, nxt);
    if (S.gather()) { if (wid == 0) { PG8_SIDE(S.row_table(cur) + 4 * lane, ROWTAB_OFF); if (has_next) PG8_SIDE(S.row_table(nxt) + 4 * lane, ROWTAB_OFF + 1024); }
        PG8_WAIT_V(0); PG8_BAR; }
    f32x4 acc[2][2][4][2];
    bf16x8 At[4][2], B0[2][2], B1[2][2]; i32x8 At8[4], B08[2], B18[2];
    const char* Ab = S.a_base();
    unsigned ca0[2], ca1[2], na0[2], na1[2];
#pragma unroll
    for (int i = 0; i < 2; ++i) { ca0[i] = S.a_off(cur, Rr[i], Cc[i], (const LAS int*)(lds + ROWTAB_OFF)); ca1[i] = S.a_off(cur, HALF + Rr[i], Cc[i], (const LAS int*)(lds + ROWTAB_OFF)); }
    const char* cB = S.b_tile(cur);
    PG8_STAGE(PG8_SB(0, 0), cB, voffB); PG8_STAGE(PG8_SB(0, 1), cB + hstepB, voffB); PG8_STAGE(PG8_SA(0, 0), Ab, ca0); PG8_STAGE(PG8_SA(0, 1), Ab, ca1);
    if (wr == 1) PG8_BAR;
    PG8_WAIT_V(2); PG8_BAR;
    PG8_STAGE(PG8_SB(1, 0), cB + kstep, voffB); PG8_STAGE(PG8_SA(1, 0), Ab + kstep, ca0); PG8_STAGE(PG8_SB(1, 1), cB + hstepB + kstep, voffB);
    PG8_WAIT_V(6); PG8_BAR;
    for (;;) {
        const bool has_nx2 = has_next && S.next(ui + 2, nx2);
        const char* nB = cB;
#pragma unroll
        for (int i = 0; i < 2; ++i) { na0[i] = ca0[i]; na1[i] = ca1[i]; }
        if (has_next) { nB = S.b_tile(nxt); const LAS int* tab = (const LAS int*)(lds + ROWTAB_OFF + ((ui + 1) & 1) * 1024);
#pragma unroll
            for (int i = 0; i < 2; ++i) { int R, C; int tq = tid; if constexpr (FP8) tq = PG8_TIDQ();
                stage_rc(tq * 16 + i * 8192, R, C);
                na0[i] = S.a_off(nxt, R, C, tab); na1[i] = S.a_off(nxt, HALF + R, C, tab); } }
#define PG8_NAST(v) const unsigned v = (unsigned)(EPI_NA_OFF + PG8_TIDQ() * 16)
        if constexpr (FP8) { PG8_NAST(nast); *(LAS u32x4*)(lds + nast) = (u32x4){na0[0], na0[1], na1[0], na1[1]}; }
        if (S.gather()) { PG8_WAIT_L(0);
            if (wid == 0 && has_nx2) PG8_SIDE(S.row_table(nx2) + 4 * lane_id_fresh(), ROWTAB_OFF + (ui & 1) * 1024); }
        if constexpr (Epi::HAS_BIAS) { if (wid == 1) PG8_SIDE(E.bias_src(cur, lane_id_fresh()), BIASTAB_OFF + (ui & 1) * 1024); }
#pragma unroll
        for (int a = 0; a < 2; ++a)
#pragma unroll
            for (int b = 0; b < 2; ++b)
#pragma unroll
                for (int m = 0; m < 4; ++m)
#pragma unroll
                    for (int n = 0; n < 2; ++n) acc[a][b][m][n] = (f32x4){0.f, 0.f, 0.f, 0.f};
#pragma unroll 1
        for (int t = 0; t < nt; t += 2) {
            const bool last = (t == nt - 2);
            const char* a1 = Ab + (size_t)(t + 1) * kstep;
            const char* a2 = last ? Ab : Ab + (size_t)(t + 2) * kstep; const char* b2 = last ? nB : cB + (size_t)(t + 2) * kstep;
            const char* a3 = a2 + kstep; const char* b3 = b2 + kstep;
            if constexpr (FP8) { asm volatile("" : "+s"(a1), "+s"(a2), "+s"(b2), "+s"(a3), "+s"(b3)); }
            unsigned o20[2], o21[2];
#pragma unroll
            for (int i = 0; i < 2; ++i) { o20[i] = last ? na0[i] : ca0[i]; o21[i] = last ? na1[i] : ca1[i]; }
            if constexpr (FP8) { if (last) { PG8_NAST(nast); const u32x4 nv = *(const LAS u32x4*)(lds + nast); o20[0] = nv.x; o20[1] = nv.y; o21[0] = nv.z; o21[1] = nv.w; } }
            PG8_LDB(B0, 0, 0); PG8_LDB(B1, 0, 1); PG8_SCHED; PG8_LDA(At, 0, 0); PG8_STAGE(PG8_SA(1, 1), a1, ca1);
            PG8_WAIT_VR; PG8_WAIT_L(0); PG8_BAR; PG8_MMA(0, 0, At, B0); PG8_MMA(0, 1, At, B1); PG8_BAR; PG8_SCHED;
            PG8_LDA(At, 0, 1); PG8_STAGE(PG8_SB(0, 0), b2, voffB); PG8_STAGE(PG8_SB(0, 1), b2 + hstepB, voffB); PG8_STAGE(PG8_SA(0, 0), a2, o20);
            PG8_WAIT_VR; PG8_WAIT_L(0); PG8_BAR; PG8_MMA(1, 0, At, B0); PG8_MMA(1, 1, At, B1); PG8_BAR; PG8_SCHED;
            PG8_LDB(B0, 1, 0); PG8_LDB(B1, 1, 1); PG8_SCHED; PG8_LDA(At, 1, 0); PG8_STAGE(PG8_SA(0, 1), a2, o21);
            PG8_WAIT_VR; PG8_WAIT_L(0); PG8_BAR; PG8_MMA(0, 0, At, B0); PG8_MMA(0, 1, At, B1); PG8_BAR; PG8_SCHED;
            PG8_LDA(At, 1, 1); PG8_STAGE(PG8_SB(1, 0), b3, voffB); PG8_STAGE(PG8_SB(1, 1), b3 + hstepB, voffB); PG8_STAGE(PG8_SA(1, 0), a3, o20);
            PG8_WAIT_V(8); PG8_WAIT_L(0); PG8_BAR; PG8_MMA(1, 0, At, B0); PG8_MMA(1, 1, At, B1); PG8_BAR; PG8_SCHED;
        }
        PG8_WAIT_V(0);
        if constexpr (ALIGN_EPI) { if (wr == 0) PG8_BAR; }
        { const LAS float* bt = (const LAS float*)(lds + BIASTAB_OFF + (ui & 1) * 1024);
          if constexpr (FP8) { const int lq = lane_id_fresh();
              E(acc, cur, wr, wc, lq & 15, (lq >> 4) & 3, bt); }
          else E(acc, cur, wr, wc, fr, fq, bt); }
        if (!has_next) break;
        cur = nxt; nxt = nx2; has_next = has_nx2; cB = nB; ++ui;
#pragma unroll
        for (int i = 0; i < 2; ++i) { ca0[i] = na0[i]; ca1[i] = na1[i]; }
        if constexpr (FP8) { PG8_NAST(nast); const u32x4 nv = *(const LAS u32x4*)(lds + nast); ca0[0] = nv.x; ca0[1] = nv.y; ca1[0] = nv.z; ca1[1] = nv.w; }
        if constexpr (ALIGN_EPI) { if (wr == 1) PG8_BAR; }
    }
    PG8_WAIT_V(0);
    if constexpr (!ALIGN_EPI) { if (wr == 0) PG8_BAR; }
    PG8_BAR;
#undef PG8_SA
#undef PG8_SB
#undef PG8_STAGE
#undef PG8_LDA
#undef PG8_LDB
#undef PG8_MMA
#undef PG8_NAST
#undef PG8_J8
#undef PG8_WAIT_V
#undef PG8_WAIT_VR
#undef PG8_WAIT_L
#undef PG8_BAR
#undef PG8_SCHED
#undef PG8_TIDQ
#undef PG8_SIDE
}

struct DenseSched {
    const char* A; const char* Bt; int K, nM, nN, nwg, G, c, stag = 0, amask = -1;
    __device__ __forceinline__ void init(const void* A_, const void* Bt_, int M, int N, int K_, int G_, int c_) { A = (const char*)A_; Bt = (const char*)Bt_; K = K_; nM = M / BM; nN = N / BM; nwg = nM * nN; G = G_; c = c_; }
    __device__ __forceinline__ bool next(int i, Unit& u) const {
        const long L = (long)i * G + c; if (L >= nwg) return false;
        int wgid = (int)L; { const int q = nwg / 8, r = nwg % 8, xcd = wgid % 8, off = wgid / 8; wgid = (xcd < r ? xcd * (q + 1) : r * (q + 1) + (xcd - r) * q) + off; }
        const int nig = 8 * nN, gid = wgid / nig, fm = gid * 8, gsz = (nM - fm) < 8 ? (nM - fm) : 8;
        u.pm = fm + ((wgid % nig) % gsz); u.pn = (wgid % nig) / gsz; u.e = 0; return true;
    }
    __device__ __forceinline__ const char* a_base() const { return A; }
    __device__ __forceinline__ int stagger() const { return stag ? ((c >> 3) & 7) * (K / 55) : 0; }
    __device__ __forceinline__ bool gather() const { return false; }
    __device__ __forceinline__ const int* row_table(const Unit&) const { return nullptr; }
    __device__ __forceinline__ unsigned a_off(const Unit& u, int row, int col, const LAS int* = nullptr) const { return (unsigned)(((size_t)((u.pm * BM + row) & amask) * K + col) * 2); }
    __device__ __forceinline__ int a_row(const Unit& u, int row) const { return (u.pm * BM + row) & amask; }
    __device__ __forceinline__ unsigned row_off(int r, int col) const { return (unsigned)(((size_t)r * K + col) * 2); }
    __device__ __forceinline__ const char* b_tile(const Unit& u) const { return Bt + (size_t)u.pn * BM * K * 2; }
};
}

namespace pg8 {
struct MoeSched {
    const char* A; const char* Bt; const int* slot_tok; volatile LAS unsigned* tstart; int K, rowsE, nN, c;
    __device__ __forceinline__ bool next(int i, Unit& u) const {
        const int x = c & 7, j = c >> 3, rpr = 32 / nN;
        const int pm = (i * 8 + x) * rpr + j / nN;
        const int l = lane_id_fresh(); const int tv = (int)tstart[l < 32 ? l : 32];
        const int T = __builtin_amdgcn_readlane(tv, 32);
        if (pm >= T) return false;
        const unsigned long long bal = __ballot(l >= 1 && l < 32 && tv <= pm);
        u.pm = pm; u.pn = j % nN; u.e = (int)__builtin_popcountll(bal); return true;
    }
    __device__ __forceinline__ const char* a_base() const { return A; }
    __device__ __forceinline__ int stagger() const { const int g = (c >> 3) / nN, ng = 32 / nN; (void)g; (void)ng; return 0; }
    __device__ __forceinline__ bool gather() const { return slot_tok != nullptr; }
    __device__ __forceinline__ const int* row_table(const Unit& u) const { return slot_tok + u.pm * BM; }
    __device__ __forceinline__ unsigned a_off(const Unit& u, int row, int col, const LAS int* tab) const {
        const int r = slot_tok ? tab[row] : u.pm * BM + row;
        return (unsigned)(((size_t)r * K + col) * 2);
    }
    __device__ __forceinline__ const char* b_tile(const Unit& u) const { return Bt + ((size_t)u.e * rowsE + (size_t)u.pn * BM) * K * 2; }
};

struct MergeSched {
    const char* A; const char* Bt; int nM, nN, nwg, G, c;
    __device__ __forceinline__ void init(const void* A_, const void* Bt_, int M, int N, int G_, int c_) { A = (const char*)A_; Bt = (const char*)Bt_; nM = M / BM; nN = N / BM; nwg = nM * nN; G = G_; c = c_; }
    __device__ __forceinline__ bool next(int i, Unit& u) const {
        const int r = i / 3; const long L = (long)r * G + c; if (L >= nwg) return false;
        int wgid = (int)L; { const int q = nwg / 8, rr = nwg % 8, xcd = wgid % 8, off = wgid / 8; wgid = (xcd < rr ? xcd * (q + 1) : rr * (q + 1) + (xcd - rr) * q) + off; }
        const int nig = 8 * nN, gid = wgid / nig, fm = gid * 8, gsz = (nM - fm) < 8 ? (nM - fm) : 8;
        u.pm = fm + ((wgid % nig) % gsz); u.pn = (wgid % nig) / gsz; u.e = i - 3 * r; return true;
    }
    __device__ __forceinline__ const char* a_base() const { return A; }
    __device__ __forceinline__ int stagger() const { return 0; }
    __device__ __forceinline__ bool gather() const { return false; }
    __device__ __forceinline__ const int* row_table(const Unit&) const { return nullptr; }
    __device__ __forceinline__ unsigned a_off(const Unit& u, int row, int col, const LAS int* = nullptr) const { return (unsigned)(((size_t)(u.pm * BM + row) * 512 + col) * 2 + (size_t)u.e * ((size_t)NTOK * 512 * 2)); }
    __device__ __forceinline__ const char* b_tile(const Unit& u) const { return Bt + ((size_t)u.e * DM + (size_t)u.pn * BM) * 512 * 2; }
};

template <int ACT> struct EpiBf16 {
    static constexpr bool PERM = true, HAS_BIAS = false;
    bf16_t* O; int ldc; const float* bias; int rowmask = -1;
    __device__ __forceinline__ const float* bias_src(const Unit&, int) const { return nullptr; }
    __device__ __forceinline__ void operator()(const f32x4 (&acc)[2][2][4][2], const Unit& u, int wr, int wc, int fr, int fq, const LAS float*) const {
        const int row0 = u.pm * BM + wr * 64 + fr; const int col0 = u.pn * BM + wc * 32 + 8 * fq;
#pragma unroll
        for (int ai = 0; ai < 2; ++ai)
#pragma unroll
            for (int m = 0; m < 4; ++m) { bf16_t* rowp = O + (size_t)((row0 + ai * HALF + m * 16) & rowmask) * ldc + col0;
#pragma unroll
                for (int bj = 0; bj < 2; ++bj) { const f32x4 v0 = acc[ai][bj][m][0], v1 = acc[ai][bj][m][1];
                    u32x4 w; w.x = cvt_pk_bf16(v0[0], v0[1]); w.y = cvt_pk_bf16(v0[2], v0[3]); w.z = cvt_pk_bf16(v1[0], v1[1]); w.w = cvt_pk_bf16(v1[2], v1[3]);
                    *(u32x4*)(rowp + bj * HALF) = w; } }
    }
};
struct EpiGateU8 {
    static constexpr bool PERM = true, HAS_BIAS = true;
    unsigned char* G; const float* bias;
    __device__ __forceinline__ const float* bias_src(const Unit& u, int l) const { return bias + u.pn * BM + 4 * l; }
    __device__ __forceinline__ void operator()(const f32x4 (&acc)[2][2][4][2], const Unit& u, int wr, int wc, int fr, int fq, const LAS float* bt) const {
        const int row0 = u.pm * BM + wr * 64 + fr; const int col0 = u.pn * BM + wc * 32 + 8 * fq;
        f32x4 bv[2][2];
#pragma unroll
        for (int bj = 0; bj < 2; ++bj)
#pragma unroll
            for (int n = 0; n < 2; ++n) bv[bj][n] = *(const LAS f32x4*)(bt + wc * 32 + 8 * fq + bj * HALF + 4 * n);
#pragma unroll
        for (int ai = 0; ai < 2; ++ai)
#pragma unroll
            for (int m = 0; m < 4; ++m) { unsigned char* rowp = G + (size_t)(row0 + ai * HALF + m * 16) * PW + col0;
#pragma unroll
                for (int bj = 0; bj < 2; ++bj) { u32x2 w;
#pragma unroll
                    for (int n = 0; n < 2; ++n) { const f32x4 v = acc[ai][bj][m][n] * W8_INV + bv[bj][n]; unsigned q[4];
#pragma unroll
                        for (int j = 0; j < 4; ++j) q[j] = (unsigned)(255.f * __builtin_amdgcn_rcpf(1.f + __builtin_amdgcn_exp2f(-LOG2E * v[j])) + 0.5f);
                        const unsigned pk = q[0] | (q[1] << 8) | (q[2] << 16) | (q[3] << 24);
                        if (n == 0) w.x = pk; else w.y = pk; }
                    *(u32x2*)(rowp + bj * HALF) = w; } }
    }
};
struct EpiY8 {
    static constexpr bool PERM = true, HAS_BIAS = true;
    unsigned char* Y; const float* bias; int nostore = 0;
    __device__ __forceinline__ const float* bias_src(const Unit& u, int l) const { return bias + u.e * DM + u.pn * BM + 4 * l; }
    __device__ __forceinline__ void operator()(const f32x4 (&acc)[2][2][4][2], const Unit& u, int wr, int wc, int fr, int fq, const LAS float* bt) const {
        const int row0 = u.pm * BM + wr * 64 + fr; const int col0 = u.pn * BM + wc * 32 + 8 * fq;
        f32x4 bv[2][2];
#pragma unroll
        for (int bj = 0; bj < 2; ++bj)
#pragma unroll
            for (int n = 0; n < 2; ++n) bv[bj][n] = *(const LAS f32x4*)(bt + wc * 32 + 8 * fq + bj * HALF + 4 * n);
#pragma unroll
        for (int ai = 0; ai < 2; ++ai)
#pragma unroll
            for (int m = 0; m < 4; ++m) { unsigned char* rowp = Y + (size_t)(row0 + ai * HALF + m * 16) * DM + col0;
#pragma unroll
                for (int bj = 0; bj < 2; ++bj) { const f32x4 v0 = acc[ai][bj][m][0] * W8_INV + bv[bj][0], v1 = acc[ai][bj][m][1] * W8_INV + bv[bj][1];
                    u32x2 w; w.x = pk4_f8(v0[0], v0[1], v0[2], v0[3]); w.y = pk4_f8(v1[0], v1[1], v1[2], v1[3]);
                    if (!nostore) *(u32x2*)(rowp + bj * HALF) = w; } }
    }
};
struct EpiMerge {
    static constexpr bool PERM = true, HAS_BIAS = false;
    __device__ __forceinline__ const float* bias_src(const Unit&, int) const { return nullptr; }
    const unsigned char* G; bf16_t* Mg;
    __device__ __forceinline__ void operator()(const f32x4 (&acc)[2][2][4][2], const Unit& u, int wr, int wc, int fr, int fq, const LAS float*) const {
        const int row0 = u.pm * BM + wr * 64 + fr; const int col0 = u.pn * BM + wc * 32 + 8 * fq;
        const int goff = u.e * DM; const bool first = (u.e == 0);
#pragma unroll
        for (int ai = 0; ai < 2; ++ai)
#pragma unroll
            for (int m = 0; m < 4; ++m) { const size_t row = (size_t)(row0 + ai * HALF + m * 16);
#pragma unroll
                for (int bj = 0; bj < 2; ++bj) {
                    const u32x2 g = *(const u32x2*)(G + row * PW + goff + col0 + bj * HALF);
                    u32x4 p = (u32x4){0u, 0u, 0u, 0u};
                    if (!first) p = *(const u32x4*)(Mg + row * DM + col0 + bj * HALF);
                    const f32x4 a0 = acc[ai][bj][m][0] * (1.f / 255.f), a1 = acc[ai][bj][m][1] * (1.f / 255.f);
                    u32x4 w;
                    w.x = cvt_pk_bf16(bflo(p.x) + (float)((g.x >> 0) & 0xffu) * a0[0], bfhi(p.x) + (float)((g.x >> 8) & 0xffu) * a0[1]);
                    w.y = cvt_pk_bf16(bflo(p.y) + (float)((g.x >> 16) & 0xffu) * a0[2], bfhi(p.y) + (float)((g.x >> 24) & 0xffu) * a0[3]);
                    w.z = cvt_pk_bf16(bflo(p.z) + (float)((g.y >> 0) & 0xffu) * a1[0], bfhi(p.z) + (float)((g.y >> 8) & 0xffu) * a1[1]);
                    w.w = cvt_pk_bf16(bflo(p.w) + (float)((g.y >> 16) & 0xffu) * a1[2], bfhi(p.w) + (float)((g.y >> 24) & 0xffu) * a1[3]);
                    *(u32x4*)(Mg + row * DM + col0 + bj * HALF) = w; } }
    }
};
struct EpiResid {
    static constexpr bool PERM = true, HAS_BIAS = false;
    __device__ __forceinline__ const float* bias_src(const Unit&, int) const { return nullptr; }
    const float* base; bf16_t* out;
    __device__ __forceinline__ void operator()(const f32x4 (&acc)[2][2][4][2], const Unit& u, int wr, int wc, int fr, int fq, const LAS float*) const {
        const int row0 = u.pm * BM + wr * 64 + fr; const int col0 = u.pn * BM + wc * 32 + 8 * fq;
#pragma unroll
        for (int ai = 0; ai < 2; ++ai)
#pragma unroll
            for (int m = 0; m < 4; ++m) { const size_t r = (size_t)(row0 + ai * HALF + m * 16); const float* xb = base + r * DM + col0; bf16_t* ob = out + r * 2048 + (r & 1) * 1024 + col0;
#pragma unroll
                for (int bj = 0; bj < 2; ++bj) { const f32x4 v0 = *(const f32x4*)(xb + bj * HALF) + acc[ai][bj][m][0], v1 = *(const f32x4*)(xb + bj * HALF + 4) + acc[ai][bj][m][1];
                    u32x4 w; w.x = cvt_pk_bf16(v0[0], v0[1]); w.y = cvt_pk_bf16(v0[2], v0[3]); w.z = cvt_pk_bf16(v1[0], v1[1]); w.w = cvt_pk_bf16(v1[2], v1[3]);
                    *(u32x4*)(ob + bj * HALF) = w; } }
    }
};
struct EpiSwiglu {
    static constexpr bool PERM = true, HAS_BIAS = true;
    unsigned char* act; const float* bias;
    __device__ __forceinline__ const float* bias_src(const Unit& u, int l) const { return bias + (size_t)u.e * 2048 + (l >> 5) * 1024 + u.pn * HALF + 4 * (l & 31); }
    __device__ __forceinline__ void operator()(const f32x4 (&acc)[2][2][4][2], const Unit& u, int wr, int wc, int fr, int fq, const LAS float* bt) const {
        const int row0 = u.pm * BM + wr * 64 + fr; const int col0 = u.pn * HALF + wc * 32 + 8 * fq;
        f32x4 bg[2], bu[2];
#pragma unroll
        for (int n = 0; n < 2; ++n) { bg[n] = *(const LAS f32x4*)(bt + wc * 32 + 8 * fq + 4 * n); bu[n] = *(const LAS f32x4*)(bt + HALF + wc * 32 + 8 * fq + 4 * n); }
#pragma unroll
        for (int ai = 0; ai < 2; ++ai)
#pragma unroll
            for (int m = 0; m < 4; ++m) { unsigned char* rowp = act + (size_t)(row0 + ai * HALF + m * 16) * DEXP + col0;
                float o[8];
#pragma unroll
                for (int n = 0; n < 2; ++n) { const f32x4 gv = acc[ai][0][m][n] * W8_INV + bg[n], uv = acc[ai][1][m][n] * W8_INV + bu[n];
#pragma unroll
                    for (int q = 0; q < 4; ++q) { const float g = fminf(gv[q], 7.0f); const float uu = fminf(fmaxf(uv[q], -7.0f), 7.0f);
                        const float sg = __builtin_amdgcn_rcpf(1.f + __builtin_amdgcn_exp2f(-1.702f * LOG2E * g));
                        o[4 * n + q] = (uu + 1.0f) * (g * sg); } }
                u32x2 w; w.x = pk4_f8(o[0], o[1], o[2], o[3]); w.y = pk4_f8(o[4], o[5], o[6], o[7]);
                *(u32x2*)rowp = w; }
    }
};
}

#define XB_TMO      128
#define XB_XCNT(j)  (256  + 64 * (j))
#define XB_XSUB(j)  (1280 + 64 * (j))
#define XB_XGEN(j)  (2304 + 64 * (j))
#define XB_TOP      3328
#define XB_TOPGEN   3392
#define XCD_BAR_WORDS 3456
#define XB_SPIN_CAP (1u << 18)

__device__ __forceinline__ unsigned xb_ld(unsigned* p)              { return __hip_atomic_load(p, __ATOMIC_RELAXED, __HIP_MEMORY_SCOPE_AGENT); }
__device__ __forceinline__ unsigned xb_add(unsigned* p, unsigned v) { return __hip_atomic_fetch_add(p, v, __ATOMIC_RELAXED, __HIP_MEMORY_SCOPE_AGENT); }
__device__ __forceinline__ unsigned xb_xcc_id() { return (unsigned)__builtin_amdgcn_s_getreg((3 << 11) | 20) & 0xFu; }
#define XB_SPIN(cond, bar) do { unsigned _sp = 0; while (cond) { __builtin_amdgcn_s_sleep(1); \
    if ((++_sp & 255u) == 0u) { if (xb_ld(&(bar)[XB_TMO])) break; if (_sp > XB_SPIN_CAP) { atomicAdd(&(bar)[XB_TMO], 1u); break; } } } } while (0)

struct XcdBarrier {
    unsigned* bar; unsigned x; int wave;
    volatile LAS unsigned* st;
};

__device__ __forceinline__ XcdBarrier xcd_barrier_post(unsigned* bar, volatile LAS unsigned* st) {
    XcdBarrier b; b.bar = bar; b.x = xb_xcc_id(); b.st = st; b.wave = __builtin_amdgcn_readfirstlane((int)(threadIdx.x >> 6));
    if (threadIdx.x == 0) (void)xb_add(&bar[XB_XCNT(b.x)], 1u);
    return b;
}
__device__ __forceinline__ void xcd_barrier_complete(unsigned* bar, unsigned x, unsigned& nloc, unsigned& nx) {
    const unsigned G = gridDim.x * gridDim.y * gridDim.z;
    unsigned sum, cnt, mine, sp = 0u;
    for (;;) {
        sum = 0u; cnt = 0u; mine = 0u;
#pragma unroll
        for (unsigned j = 0; j < 16; ++j) { const unsigned c = xb_ld(&bar[XB_XCNT(j)]); sum += c; cnt += (c > 0u) ? 1u : 0u; mine = (j == x) ? c : mine; }
        if (sum == G) break;
        __builtin_amdgcn_s_sleep(1);
        if ((++sp & 255u) == 0u) { if (xb_ld(&bar[XB_TMO])) break; if (sp > XB_SPIN_CAP) { atomicAdd(&bar[XB_TMO], 1u); break; } }
    }
    nloc = mine > 0u ? mine : 1u; nx = cnt > 0u ? cnt : 1u;
}

__device__ __forceinline__ void xcd_barrier(const XcdBarrier& b) {
    asm volatile("s_waitcnt vmcnt(0)" ::: "memory");
    __syncthreads();
    if (b.wave == 0 && lane_id_fresh() == 0) {
        unsigned* bar = b.bar;
        __builtin_amdgcn_s_waitcnt(0);
        unsigned nloc = b.st[0], nx = b.st[1];
        if (nloc == 0u) { xcd_barrier_complete(bar, b.x, nloc, nx); b.st[0] = nloc; b.st[1] = nx; }
        const unsigned old = xb_add(&bar[XB_XSUB(b.x)], 1u);
        const unsigned gen = old / nloc;
        if (old + 1u == (gen + 1u) * nloc) {
            __builtin_amdgcn_fence(__ATOMIC_RELEASE, "agent");
            asm volatile("s_waitcnt vmcnt(0)" ::: "memory");
            const unsigned og = xb_add(&bar[XB_TOP], 1u);
            const unsigned tg = og / nx;
            if (og + 1u == (tg + 1u) * nx) xb_add(&bar[XB_TOPGEN], 1u);
            else XB_SPIN(xb_ld(&bar[XB_TOPGEN]) == tg, bar);
            __builtin_amdgcn_fence(__ATOMIC_ACQUIRE, "agent");
            xb_add(&bar[XB_XGEN(b.x)], 1u);
            asm volatile("s_waitcnt vmcnt(0)" ::: "memory");
        } else {
            XB_SPIN(xb_ld(&bar[XB_XGEN(b.x)]) == gen, bar);
            __builtin_amdgcn_fence(__ATOMIC_ACQUIRE, "agent");
            asm volatile("s_waitcnt vmcnt(0)" ::: "memory");
        }
    }
    __syncthreads();
}

constexpr int NWAVES = 8;
struct Frame {
    LAS unsigned char* lds;
    volatile LAS unsigned* MISC;
    gu32* ctl;
    int tid, lane, wave, G, blk;
    const float* in[21];
    float* out; unsigned char* ws;
};
__device__ __forceinline__ float wave_sum(float v) {
#pragma unroll
    for (int o = 1; o < 64; o <<= 1) v += __shfl_xor(v, o);
    return v;
}

__device__ __forceinline__ int map_src(int mode, int n) {
    if (mode == 1) return n < 2500 ? n : (n >= C_MQ ? n - (C_MQ - 2500) : -1);
    if (mode == 2) { const int pn = n >> 8, bj = (n >> 7) & 1, j = n & 127; return bj * 1024 + pn * 128 + j; }
    return n;
}
__device__ __forceinline__ void transpose_item(const float* W, int K, int Nsrc, int Ndst, bf16_t* WT, int mode, LAS float* scr, int item, int lane) {
    const int nblk = Ndst / 32, kb = item / nblk, nb = item % nblk, k0 = 64 * kb, n0 = 32 * nb;
    const int sc = map_src(mode, n0 + (lane & 31));
    const float scale = (mode == 1 && (n0 + (lane & 31)) < 512) ? 0.125f : 1.0f;
#pragma unroll
    for (int i = 0; i < 32; ++i) { const int kk = 2 * i + (lane >> 5); scr[kk * 33 + (lane & 31)] = sc >= 0 ? W[(size_t)(k0 + kk) * Nsrc + sc] * scale : 0.f; }
    LDS_WAIT(); asm volatile("" ::: "memory");
    const int c = lane & 7;
#pragma unroll
    for (int j = 0; j < 4; ++j) { const int n = (lane >> 3) + 8 * j; const LAS float* s = scr + (8 * c) * 33 + n;
        u32x4 o; o.x = pk2(s[0 * 33], s[1 * 33]); o.y = pk2(s[2 * 33], s[3 * 33]); o.z = pk2(s[4 * 33], s[5 * 33]); o.w = pk2(s[6 * 33], s[7 * 33]);
        *(GAS u32x4*)(WT + (size_t)(n0 + n) * K + k0 + 8 * c) = o; }
    LDS_WAIT(); asm volatile("" ::: "memory");
}
__device__ __forceinline__ void transpose_item_f8(const float* W, int K, int Nsrc, int Ndst, unsigned char* WT, int mode, float scale, LAS float* scr, int item, int lane) {
    const int nblk = Ndst / 32, kb = item / nblk, nb = item % nblk, k0 = 64 * kb, n0 = 32 * nb;
    const int sc = map_src(mode, n0 + (lane & 31));
#pragma unroll
    for (int i = 0; i < 32; ++i) { const int kk = 2 * i + (lane >> 5); scr[kk * 33 + (lane & 31)] = sc >= 0 ? W[(size_t)(k0 + kk) * Nsrc + sc] * scale : 0.f; }
    LDS_WAIT(); asm volatile("" ::: "memory");
    const int c = lane & 7;
#pragma unroll
    for (int j = 0; j < 4; ++j) { const int n = (lane >> 3) + 8 * j; const LAS float* s = scr + (8 * c) * 33 + n;
        u32x2 o; o.x = pk4_f8(s[0 * 33], s[1 * 33], s[2 * 33], s[3 * 33]); o.y = pk4_f8(s[4 * 33], s[5 * 33], s[6 * 33], s[7 * 33]);
        *(GAS u32x2*)(WT + (size_t)(n0 + n) * K + k0 + 8 * c) = o; }
    LDS_WAIT(); asm volatile("" ::: "memory");
}
__device__ __forceinline__ void rms_row_to_bf16(int lane, const float* xrow, const float* g, bf16_t* orow) {
    const GAS f32x4* xr = (const GAS f32x4*)xrow + lane; const GAS f32x4* gr = (const GAS f32x4*)g + lane;
    f32x4 v[4]; float s = 0.f;
#pragma unroll
    for (int j = 0; j < 4; ++j) { v[j] = xr[64 * j]; s += (v[j].x * v[j].x + v[j].y * v[j].y) + (v[j].z * v[j].z + v[j].w * v[j].w); }
    const float rstd = 1.0f / sqrtf(wave_sum(s) * (1.f / DM) + EPS);
    GAS u32x2* o8 = (GAS u32x2*)orow + lane;
#pragma unroll
    for (int j = 0; j < 4; ++j) { const f32x4 gg = gr[64 * j]; u32x2 o; o.x = pk2(v[j].x * rstd * gg.x, v[j].y * rstd * gg.y); o.y = pk2(v[j].z * rstd * gg.z, v[j].w * rstd * gg.w); o8[64 * j] = o; }
}

__device__ __forceinline__ void rms_rows4_to_bf16(int lane, const float* x, const float* g, bf16_t* o, size_t m0, size_t stride, unsigned char* o8f = nullptr) {
    f32x4 v[4][4]; float s[4];
#pragma unroll
    for (int r = 0; r < 4; ++r) { const GAS f32x4* xr = (const GAS f32x4*)(x + (m0 + r * stride) * DM) + lane;
#pragma unroll
        for (int j = 0; j < 4; ++j) v[r][j] = xr[64 * j]; }
    const GAS f32x4* gr = (const GAS f32x4*)g + lane;
    f32x4 gg[4];
#pragma unroll
    for (int j = 0; j < 4; ++j) gg[j] = gr[64 * j];
#pragma unroll
    for (int r = 0; r < 4; ++r) { float a = 0.f;
#pragma unroll
        for (int j = 0; j < 4; ++j) a += (v[r][j].x * v[r][j].x + v[r][j].y * v[r][j].y) + (v[r][j].z * v[r][j].z + v[r][j].w * v[r][j].w);
        s[r] = a; }
#pragma unroll
    for (int of = 1; of < 64; of <<= 1) {
#pragma unroll
        for (int r = 0; r < 4; ++r) s[r] += __shfl_xor(s[r], of); }
#pragma unroll
    for (int r = 0; r < 4; ++r) { const float rstd = 1.0f / sqrtf(s[r] * (1.f / DM) + EPS);
        GAS u32x2* o8 = (GAS u32x2*)(o + (m0 + r * stride) * DM) + lane;
#pragma unroll
        for (int j = 0; j < 4; ++j) { const float a0 = v[r][j].x * rstd * gg[j].x, a1 = v[r][j].y * rstd * gg[j].y, a2 = v[r][j].z * rstd * gg[j].z, a3 = v[r][j].w * rstd * gg[j].w;
            u32x2 w; w.x = pk2(a0, a1); w.y = pk2(a2, a3); o8[64 * j] = w;
            if (o8f) *((GAS unsigned*)(o8f + (m0 + r * stride) * DM) + lane + 64 * j) = pk4_f8(a0, a1, a2, a3); } }
}
__device__ __forceinline__ void p0_prologue(Frame& F) {
    LAS float* scr = (LAS float*)(F.lds + F.wave * 16384);
    const int gw = F.blk * NWAVES + F.wave, NGW = F.G * NWAVES, lane = F.lane;
    unsigned char* ws = F.ws;
    constexpr int I_IN = 16 * 96, I_MKV = 16 * 32, I_G = 16 * 32, I_B = 8 * 32, I_O = 16 * 32, I_EI = 16 * 64, I_EO = 16 * 32;
    constexpr int NITEMS = I_IN + I_MKV + 3 * I_G + 3 * I_B + I_O + NEXP * I_EI + NEXP * I_EO;
    for (int it = gw; it < NITEMS; it += NGW) {
        int r = it;
        if (r < I_IN) { transpose_item(F.in[3], DM, IN_W, PW, (bf16_t*)(ws + WS_WIN), 1, scr, r, lane); continue; } r -= I_IN;
        if (r < I_MKV) { transpose_item(F.in[9], DM, DM, DM, (bf16_t*)(ws + WS_WMKV), 0, scr, r, lane); continue; } r -= I_MKV;
        if (r < 3 * I_G) { const int n = r / I_G; transpose_item_f8(F.in[10] + (size_t)n * DM * DM, DM, DM, DM, ws + WS_WG + (size_t)n * DM * DM, 0, W8_SCALE, scr, r % I_G, lane); continue; } r -= 3 * I_G;
        if (r < 3 * I_B) { const int n = r / I_B; transpose_item(F.in[12] + (size_t)n * 512 * DM, 512, DM, DM, (bf16_t*)(ws + WS_WB) + (size_t)n * DM * 512, 0, scr, r % I_B, lane); continue; } r -= 3 * I_B;
        if (r < I_O) { transpose_item(F.in[13], DM, DM, DM, (bf16_t*)(ws + WS_WO), 0, scr, r, lane); continue; } r -= I_O;
        if (r < NEXP * I_EI) { const int e = r / I_EI; transpose_item_f8(F.in[17] + (size_t)e * DM * 2048, DM, 2048, 2048, ws + WS_WEI + (size_t)e * 2048 * DM, 2, W8_SCALE, scr, r % I_EI, lane); continue; } r -= NEXP * I_EI;
        { const int e = r / I_EO; transpose_item_f8(F.in[19] + (size_t)e * DM * DM, DM, DM, DM, ws + WS_WEO + (size_t)e * DM * DM, 0, W8_SCALE, scr, r % I_EO, lane); }
    }
    { f32x2* tab = (f32x2*)(ws + WS_ROPE);
      for (int idx = (F.blk * NWAVES * 64) + F.tid; idx < SEQ * 32; idx += F.G * NWAVES * 64) {
          const int s = idx >> 5, i = idx & 31;
          const float inv = exp2f(-(float)i * (13.287712379549449f / 32.0f));
          const float ang = (float)s * inv;
          const double rev = (double)ang * 0.15915494309189535;
          const float fr = (float)(rev - __builtin_rint(rev));
          tab[idx] = (f32x2){__builtin_amdgcn_cosf(fr), __builtin_amdgcn_sinf(fr)}; } }
    for (int m = gw; m < NTOK; m += 4 * NGW) rms_rows4_to_bf16(lane, F.in[0], F.in[2], (bf16_t*)(ws + WS_H), (size_t)m, (size_t)NGW, ws + WS_H8);
    for (int m = gw; m < NMEM; m += 4 * NGW) rms_rows4_to_bf16(lane, F.in[1], F.in[8], (bf16_t*)(ws + WS_MEMN), (size_t)m, (size_t)NGW);
    { int* st = (int*)(ws + WS_SLOT_TOK);
      for (int i = F.blk * NWAVES * 64 + F.tid; i < NSLOT_PAD; i += F.G * NWAVES * 64) st[i] = 0; }
}

template <int CTRL> __device__ __forceinline__ float dppf(float v) { return __builtin_bit_cast(float, __builtin_amdgcn_update_dpp(0, __builtin_bit_cast(int, v), CTRL, 0xF, 0xF, false)); }
__device__ __forceinline__ float lx1(float v) { return dppf<0xB1>(v); }
__device__ __forceinline__ float lx2(float v) { return dppf<0x4E>(v); }
__device__ __forceinline__ float lx4(float v) { return dppf<0x1B>(dppf<0x141>(v)); }
__device__ __forceinline__ float lx8(float v) { return dppf<0x128>(v); }
__device__ __forceinline__ void un8(const u32x4 w, float (&v)[8]) { v[0] = bflo(w.x); v[1] = bfhi(w.x); v[2] = bflo(w.y); v[3] = bfhi(w.y); v[4] = bflo(w.z); v[5] = bfhi(w.z); v[6] = bflo(w.w); v[7] = bfhi(w.w); }
__device__ __forceinline__ u32x4 pk8(const float (&v)[8]) { u32x4 w; w.x = pk2(v[0], v[1]); w.y = pk2(v[2], v[3]); w.z = pk2(v[4], v[5]); w.w = pk2(v[6], v[7]); return w; }
__device__ __forceinline__ void rope8(float (&v)[8], const f32x2 (&cs)[8], bool up) {
#pragma unroll
    for (int j = 0; j < 8; ++j) { const float other = lx4(v[j]); v[j] = up ? (other * cs[j].y + v[j] * cs[j].x) : (v[j] * cs[j].x - other * cs[j].y); }
}
__device__ __forceinline__ void p2_prep(Frame& F, const bool dummy = false) {
    const int gw = F.blk * NWAVES + F.wave, NGW = F.G * NWAVES, lane = F.lane;
    bf16_t* proj = (bf16_t*)(F.ws + WS_P);
    bf16_t* projw = dummy ? (bf16_t*)(F.ws + WS_END) : proj;
    const int wmask = dummy ? 8191 : 0x7fffffff;
    const f32x2* tab = (const f32x2*)(F.ws + WS_ROPE);
    float gqd[8], gkd[8], gqm[8];
#pragma unroll
    for (int j = 0; j < 8; ++j) { gqd[j] = F.in[4][8 * (lane & 7) + j] * (0.125f * LOG2E); gkd[j] = F.in[5][8 * (lane & 7) + j]; gqm[j] = F.in[6][8 * (lane & 15) + j] * (0.08838834764831845f * LOG2E); }
    const bool up = (lane & 4) != 0; const int i0 = (lane & 3) * 8;
    for (int m0 = gw; m0 < NTOK; m0 += 2 * NGW) {
        u32x4 raw[2][5]; f32x2 cs[2][8];
#pragma unroll
        for (int t = 0; t < 2; ++t) { const GAS bf16_t* row = (const GAS bf16_t*)proj + (size_t)(m0 + t * NGW) * PW;
            raw[t][0] = *(const GAS u32x4*)(row + C_DQ + 8 * lane); raw[t][1] = *(const GAS u32x4*)(row + C_DK + 8 * (lane & 7)); raw[t][2] = *(const GAS u32x4*)(row + C_IQ + 8 * (lane & 31));
            raw[t][3] = *(const GAS u32x4*)(row + C_IK + 8 * (lane & 7)); raw[t][4] = *(const GAS u32x4*)(row + C_MQ + 8 * lane);
            const GAS f32x2* tr = (const GAS f32x2*)tab + (size_t)((m0 + t * NGW) & (SEQ - 1)) * 32 + i0;
#pragma unroll
            for (int j = 0; j < 8; ++j) cs[t][j] = tr[j]; }
#pragma unroll
        for (int t = 0; t < 2; ++t) {
            GAS bf16_t* roww = (GAS bf16_t*)projw + (size_t)((m0 + t * NGW) & wmask) * PW;
            float v[8];
            { un8(raw[t][0], v); float ss = 0.f;
#pragma unroll
              for (int j = 0; j < 8; ++j) ss += v[j] * v[j];
              ss += lx1(ss); ss += lx2(ss); ss += lx4(ss);
              const float rstd = 1.0f / sqrtf(ss * (1.f / 64.f) + EPS);
#pragma unroll
              for (int j = 0; j < 8; ++j) v[j] = v[j] * rstd * gqd[j];
              rope8(v, cs[t], up);
              *(GAS u32x4*)(roww + C_DQ + 8 * lane) = pk8(v); }
            { un8(raw[t][1], v); float ss = 0.f;
#pragma unroll
              for (int j = 0; j < 8; ++j) ss += v[j] * v[j];
              ss += lx1(ss); ss += lx2(ss); ss += lx4(ss);
              const float rstd = 1.0f / sqrtf(ss * (1.f / 64.f) + EPS);
#pragma unroll
              for (int j = 0; j < 8; ++j) v[j] = v[j] * rstd * gkd[j];
              rope8(v, cs[t], up);
              if (lane < 8) *(GAS u32x4*)(roww + C_DK + 8 * lane) = pk8(v); }
            { un8(raw[t][2], v); rope8(v, cs[t], up); if (lane < 32) *(GAS u32x4*)(roww + C_IQ + 8 * lane) = pk8(v); }
            { un8(raw[t][3], v); rope8(v, cs[t], up); if (lane < 8) *(GAS u32x4*)(roww + C_IK + 8 * lane) = pk8(v); }
            { un8(raw[t][4], v); float ss = 0.f;
#pragma unroll
              for (int j = 0; j < 8; ++j) ss += v[j] * v[j];
              ss += lx1(ss); ss += lx2(ss); ss += lx4(ss); ss += lx8(ss);
              const float rstd = 1.0f / sqrtf(ss * (1.f / 128.f) + EPS);
#pragma unroll
              for (int j = 0; j < 8; ++j) v[j] = v[j] * rstd * gqm[j];
              *(GAS u32x4*)(roww + C_MQ + 8 * lane) = pk8(v); }
        }
    }
    bf16_t* mkv = (bf16_t*)(F.ws + WS_MKV);
    if (!dummy) for (int m = gw; m < NMEM; m += NGW) {
        GAS bf16_t* row = (GAS bf16_t*)mkv + (size_t)m * DM; float v[8];
        un8(*(const GAS u32x4*)(row + 8 * lane), v); float ss = 0.f;
#pragma unroll
        for (int j = 0; j < 8; ++j) ss += v[j] * v[j];
        ss += lx1(ss); ss += lx2(ss); ss += lx4(ss); ss += lx8(ss);
        const float rstd = 1.0f / sqrtf(ss * (1.f / 128.f) + EPS);
#pragma unroll
        for (int j = 0; j < 8; ++j) v[j] = v[j] * rstd * F.in[7][8 * (lane & 15) + j];
        *(GAS u32x4*)(row + 8 * lane) = pk8(v);
    }
}

#define MFMA32(a, b, c) __builtin_amdgcn_mfma_f32_32x32x16_bf16((a), (b), (c), 0, 0, 0)
typedef LAS const unsigned char* lds_cptr;
__device__ __forceinline__ s16x4 vtr(lds_cptr p) { return __builtin_bit_cast(s16x4, __builtin_amdgcn_ds_read_tr16_b64_v4i16((LAS v4i16_t*)p)); }
__device__ __forceinline__ bf16x8 vfrag(lds_cptr vbase_lane, int off) {
    const s16x4 lo = vtr(vbase_lane + off), hi = vtr(vbase_lane + off + 512);
    return (bf16x8){lo[0], lo[1], lo[2], lo[3], hi[0], hi[1], hi[2], hi[3]};
}
__device__ __forceinline__ int vtr_lane_off(int lane) { return ((lane >> 4) & 1) * 32 + (lane & 3) * 8 + (4 * (lane >> 5) + ((lane & 15) >> 2)) * 64; }
__device__ __forceinline__ bf16x8 pack8(const float* p) {
    u32x4 w; w.x = cvt_pk_bf16(p[0], p[1]); w.y = cvt_pk_bf16(p[2], p[3]); w.z = cvt_pk_bf16(p[4], p[5]); w.w = cvt_pk_bf16(p[6], p[7]);
    return __builtin_bit_cast(bf16x8, w);
}
__device__ __forceinline__ float softplus_f(float z) { return fmaxf(z, 0.f) + __logf(1.f + __expf(-fabsf(z))); }

__device__ __forceinline__ void sb_item(const bf16_t* proj, bf16_t* osb, int b, int h, int qblk, LAS unsigned char* vlds, int lane) {
    const int r32 = lane & 31, hi = lane >> 5;
    const size_t tok0 = (size_t)b * SEQ + (size_t)qblk * 32;
    bf16x8 qr[4];
    { const bf16_t* qp = proj + (tok0 + r32) * PW + C_SQ + h * 64 + hi * 8;
#pragma unroll
      for (int kk = 0; kk < 4; ++kk) qr[kk] = *(const bf16x8*)(qp + kk * 16); }
    f32x16 o0 = {}, o1 = {}; float R = 0.f;
    const lds_cptr vrd = (lds_cptr)vlds + vtr_lane_off(lane);
    bf16x8 kfn[4]; u32x4 vvn[4];
#define SB_LOAD(kt_) do { const size_t key0_ = (size_t)b * SEQ + (size_t)(kt_) * 32; const GAS bf16_t* kp_ = (const GAS bf16_t*)proj + (key0_ + r32) * PW + C_SK + h * 64 + hi * 8; \
        _Pragma("unroll") for (int kk = 0; kk < 4; ++kk) kfn[kk] = *(const GAS bf16x8*)(kp_ + kk * 16); \
        _Pragma("unroll") for (int p = 0; p < 4; ++p) vvn[p] = *(const GAS u32x4*)((const GAS bf16_t*)proj + (key0_ + 16 * (p & 1) + (lane >> 2)) * PW + C_SV + h * 64 + (p >> 1) * 32 + (lane & 3) * 8); } while (0)
    SB_LOAD(qblk);
    for (int kt = qblk; kt >= 0; --kt) {
        bf16x8 kf[4]; u32x4 vv[4];
#pragma unroll
        for (int i = 0; i < 4; ++i) { kf[i] = kfn[i]; vv[i] = vvn[i]; }
        if (kt > 0) SB_LOAD(kt - 1);
        f32x16 s = {};
#pragma unroll
        for (int kk = 0; kk < 4; ++kk) s = MFMA32(kf[kk], qr[kk], s);
        asm volatile("" ::: "memory");
#pragma unroll
        for (int p = 0; p < 4; ++p) *(LAS u32x4*)(vlds + p * 1024 + lane * 16) = vv[p];
        const bool diag = (kt == qblk);
        float sp[16], pr[16];
#pragma unroll
        for (int r = 0; r < 16; ++r) { const bool valid = !diag || (crow(r, hi) < r32); sp[r] = valid ? softplus_f(s[r]) : 0.f; }
        float T[4], U[4];
#pragma unroll
        for (int g = 0; g < 4; ++g) { T[g] = (sp[4 * g] + sp[4 * g + 1]) + (sp[4 * g + 2] + sp[4 * g + 3]); { const auto rr = __builtin_amdgcn_permlane32_swap(__float_as_uint(T[g]), __float_as_uint(T[g]), false, false); U[g] = hi ? __uint_as_float(rr[0]) : __uint_as_float(rr[1]); } }
        float run = 0.f, above[4];
#pragma unroll
        for (int g = 3; g >= 0; --g) { above[g] = run + (hi == 0 ? U[g] : 0.f); run += T[g] + U[g]; }
#pragma unroll
        for (int g = 0; g < 4; ++g) { float c = R + above[g];
#pragma unroll
            for (int j = 3; j >= 0; --j) { const int r = 4 * g + j; c += sp[r]; const bool valid = !diag || (crow(r, hi) < r32); pr[r] = valid ? __expf(s[r] - c) : 0.f; } }
        R += run;
        const bf16x8 p0 = pack8(pr), p1 = pack8(pr + 8);
        LDS_WAIT();
        const bf16x8 v00 = vfrag(vrd, 0), v01 = vfrag(vrd, 1024), v10 = vfrag(vrd, 2048), v11 = vfrag(vrd, 3072);
        o0 = MFMA32(v00, p0, o0); o0 = MFMA32(v01, p1, o0);
        o1 = MFMA32(v10, p0, o1); o1 = MFMA32(v11, p1, o1);
        asm volatile("" ::: "memory");
        if (__all(R > 30.0f)) break;
    }
#undef SB_LOAD
    bf16_t* op = osb + (tok0 + r32) * 512 + h * 64 + 4 * hi;
#pragma unroll
    for (int g = 0; g < 4; ++g) {
        u32x2 w0, w1; w0.x = cvt_pk_bf16(o0[4 * g], o0[4 * g + 1]); w0.y = cvt_pk_bf16(o0[4 * g + 2], o0[4 * g + 3]); w1.x = cvt_pk_bf16(o1[4 * g], o1[4 * g + 1]); w1.y = cvt_pk_bf16(o1[4 * g + 2], o1[4 * g + 3]);
        *(u32x2*)(op + 8 * g) = w0; *(u32x2*)(op + 32 + 8 * g) = w1; }
}

constexpr int ML_K = 0, ML_KROW = 272, ML_V = 256 * ML_KROW, ML_END = ML_V + 65536;
__device__ __forceinline__ void mem_unit(const bf16_t* proj, const bf16_t* mkv, bf16_t* omem, int b, int h, int half, LAS unsigned char* ml, int tid) {
    const int lane = tid & 63, wid = __builtin_amdgcn_readfirstlane(tid >> 6), r32 = lane & 31, hi = lane >> 5;
    { const GAS bf16_t* src = (const GAS bf16_t*)mkv + (size_t)b * MEMLEN * DM + h * 128;
#pragma unroll
      for (int i = 0; i < 8; ++i) { const int ch = tid + 512 * i, key = ch >> 4, c16 = ch & 15, kk = key & 31;
          const u32x4 kv = *(const GAS u32x4*)(src + (size_t)key * DM + c16 * 8);
          const u32x4 vv = *(const GAS u32x4*)(src + (size_t)key * DM + 512 + c16 * 8);
          *(LAS u32x4*)(ml + ML_K + key * ML_KROW + c16 * 16) = kv;
          *(LAS u32x4*)(ml + ML_V + (key >> 5) * 8192 + ((c16 >> 2) * 2 + (kk >> 4)) * 1024 + (kk & 15) * 64 + (c16 & 3) * 16) = vv; } }
    __syncthreads();
    for (int i = 0; i < 4; ++i) {
        const int qblk = half * 32 + wid * 4 + i;
        const size_t tok0 = (size_t)b * SEQ + (size_t)qblk * 32;
        bf16x8 qr[8];
        { const GAS bf16_t* qp = (const GAS bf16_t*)proj + (tok0 + r32) * PW + C_MQ + h * 128 + hi * 8;
#pragma unroll
          for (int kk = 0; kk < 8; ++kk) qr[kk] = *(const GAS bf16x8*)(qp + kk * 16); }
        f32x16 o[4] = {{}, {}, {}, {}}; float m = -1e30f, l = 0.f;
        for (int kb = 0; kb < 8; ++kb) {
            const LAS unsigned char* krd = ml + ML_K + (32 * kb + r32) * ML_KROW + hi * 16;
            f32x16 s = {};
#pragma unroll
            for (int kk = 0; kk < 8; ++kk) { const bf16x8 kf = *(const LAS bf16x8*)(krd + kk * 32); s = MFMA32(kf, qr[kk], s); }
            float mx = s[0];
#pragma unroll
            for (int r = 1; r < 16; ++r) mx = fmaxf(mx, s[r]);
            { const auto rr = __builtin_amdgcn_permlane32_swap(__float_as_uint(mx), __float_as_uint(mx), false, false); mx = fmaxf(__uint_as_float(rr[0]), __uint_as_float(rr[1])); }
            if (__any(mx > m + 8.0f)) {
                const float mn = fmaxf(m, mx), alpha = __builtin_amdgcn_exp2f(m - mn);
                l *= alpha; m = mn;
#pragma unroll
                for (int d = 0; d < 4; ++d)
#pragma unroll
                    for (int r = 0; r < 16; ++r) o[d][r] *= alpha;
            }
            float pr[16], rs = 0.f;
#pragma unroll
            for (int r = 0; r < 16; ++r) { pr[r] = __builtin_amdgcn_exp2f(s[r] - m); rs += pr[r]; }
            l += rs;
            const bf16x8 p0 = pack8(pr), p1 = pack8(pr + 8);
            const lds_cptr vrd = (lds_cptr)ml + ML_V + kb * 8192 + vtr_lane_off(lane);
#pragma unroll
            for (int d = 0; d < 4; ++d) { const bf16x8 va = vfrag(vrd, d * 2048), vb = vfrag(vrd, d * 2048 + 1024); o[d] = MFMA32(va, p0, o[d]); o[d] = MFMA32(vb, p1, o[d]); }
        }
        { const auto rr = __builtin_amdgcn_permlane32_swap(__float_as_uint(l), __float_as_uint(l), false, false); l = __uint_as_float(rr[0]) + __uint_as_float(rr[1]); }
        const float il = 1.0f / l;
        bf16_t* op = omem + (tok0 + r32) * 512 + h * 128 + 4 * hi;
#pragma unroll
        for (int d = 0; d < 4; ++d)
#pragma unroll
            for (int g = 0; g < 4; ++g) { u32x2 w; w.x = cvt_pk_bf16(o[d][4 * g] * il, o[d][4 * g + 1] * il); w.y = cvt_pk_bf16(o[d][4 * g + 2] * il, o[d][4 * g + 3] * il); *(u32x2*)(op + 32 * d + 8 * g) = w; }
    }
    __syncthreads();
}

constexpr int DL_HIST = 0, DL_PREFIX = 66048, DL_KREM = DL_PREFIX + 256, DL_MASK = 67072, DL_VT = 73728, DL_KT = DL_VT + 2 * 16384, DL_END = DL_KT + 2 * 18432, DL_IQ = DL_VT;
constexpr int TOPK_DSA = 256;

struct IqLds { const LAS unsigned char* p; __device__ __forceinline__ bf16x8 operator()(int j) const { return *(const LAS bf16x8*)(p + j * 32); } };
template <class QF>
__device__ __forceinline__ void idx_scores(const QF& qf, const bf16x8 (&kf)[4], const float (&wq)[4], unsigned (&uk)[16]) {
    float scv[16];
#pragma unroll
    for (int hd = 0; hd < 4; ++hd) { f32x16 a = (f32x16){};
#pragma unroll
        for (int kk = 0; kk < 4; ++kk) a = MFMA32(kf[kk], qf(hd * 4 + kk), a);
#pragma unroll
        for (int r = 0; r < 16; ++r) scv[r] = (hd == 0) ? wq[0] * fmaxf(a[r], 0.f) : __builtin_fmaf(wq[hd], fmaxf(a[r], 0.f), scv[r]); }
#pragma unroll
    for (int r = 0; r < 16; ++r) {
        unsigned bits = __builtin_bit_cast(unsigned, scv[r]);
        if (bits == 0x80000000u) bits = 0u;
        uk[r] = bits ^ ((unsigned)((int)bits >> 31) | 0x80000000u);
    }
}
__device__ __forceinline__ void load_ik(const bf16_t* proj, size_t tokb, int kbase, int r32, int hi, bf16x8 (&kf)[4]) {
    int kr = kbase + r32; if (kr > SEQ - 1) kr = SEQ - 1;
    const GAS bf16_t* p = (const GAS bf16_t*)proj + (tokb + kr) * PW + C_IK + 8 * hi;
#pragma unroll
    for (int kk = 0; kk < 4; ++kk) kf[kk] = *(const GAS bf16x8*)(p + kk * 16);
}

__device__ __forceinline__ void dsa_unit(const bf16_t* proj, bf16_t* odsa, unsigned* kscr  , int b, int c, LAS unsigned char* dl, int tid) {
    const int lane = tid & 63, wid = __builtin_amdgcn_readfirstlane(tid >> 6), r32 = lane & 31, hi = lane >> 5;
    const int n = 64 * (c + 1), nsteps = (n + 127) >> 7;
    const size_t tokq0 = (size_t)b * SEQ + (size_t)c * 64, tokb = (size_t)b * SEQ;
    LAS unsigned* hist = (LAS unsigned*)(dl + DL_HIST);
    LAS unsigned* prefix = (LAS unsigned*)(dl + DL_PREFIX);
    LAS unsigned* krem = (LAS unsigned*)(dl + DL_KREM);
    LAS unsigned* mask = (LAS unsigned*)(dl + DL_MASK);
    const int kb = wid >> 1, qh = wid & 1;
    { const int row = tid >> 3, c = tid & 7;
      const GAS bf16_t* src = (const GAS bf16_t*)proj + (tokq0 + row) * PW + C_IQ + c * 32;
#pragma unroll
      for (int i = 0; i < 4; ++i) *(LAS u32x4*)(dl + DL_IQ + row * 528 + c * 64 + i * 16) = *(const GAS u32x4*)(src + i * 8); }
    const IqLds iqf{dl + DL_IQ + (32 * qh + r32) * 528 + hi * 16};
    float wq[4];
    { const u32x2 w = *(const u32x2*)(proj + (tokq0 + 32 * qh + r32) * PW + C_IW);
      wq[0] = bflo(w.x) * 0.0625f; wq[1] = bfhi(w.x) * 0.0625f; wq[2] = bflo(w.y) * 0.0625f; wq[3] = bfhi(w.y) * 0.0625f; }
#ifndef REP_SEL
#define REP_SEL 1
#endif
#ifndef REP_B2
#define REP_B2 1
#endif
    LAS unsigned* selall = (LAS unsigned*)(dl + DL_HIST);
#ifndef PROBE_NOATOM
#define PROBE_NOATOM 0
#endif
    unsigned dummy = 0u;
    for (int rep_sel = 0; rep_sel < REP_SEL; ++rep_sel) {
    if (tid < 64) { prefix[tid] = 0u; krem[tid] = (n > TOPK_DSA) ? (unsigned)TOPK_DSA : 0x7fffffffu; }
    __syncthreads();
    const int pass0 = (n > TOPK_DSA) ? 0 : 3;
    GAS u32x4* kmine = (GAS u32x4*)kscr + ((size_t)wid * 64 + lane) * 4;
#define DSA_CONSUME(uk_) do { \
        if (sel) { _Pragma("unroll") for (int r = 0; r < 16; ++r) { const bool match = (pass == 0) || (((uk_)[r] >> (shift + 8)) == pfx); \
                if (match && !(PROBE_NOATOM && rep_sel + 1 < REP_SEL)) __hip_atomic_fetch_add(hist + (32 * qh + r32) * 257 + (((uk_)[r] >> shift) & 255u), 1u, __ATOMIC_RELAXED, __HIP_MEMORY_SCOPE_WORKGROUP); else dummy ^= (uk_)[r]; } } \
        else { _Pragma("unroll") for (int r = 0; r < 16; ++r) { const unsigned k24 = (uk_)[r] >> 8; gtw |= (k24 > pfx ? 1u : 0u) << crow(r, hi); eqw |= (k24 == pfx ? 1u : 0u) << crow(r, hi); } } } while (0)
#define DSA_TIES() do { if (!sel) { \
        LAS unsigned* mk = mask + (step & 1) * 768; \
        { const auto rg = __builtin_amdgcn_permlane32_swap(gtw, gtw, false, false); gtw = rg[0] | rg[1]; const auto re = __builtin_amdgcn_permlane32_swap(eqw, eqw, false, false); eqw = re[0] | re[1]; } \
        if (hi == 0) { mk[(32 * qh + r32) * 4 + kb] = gtw; mk[256 + (32 * qh + r32) * 4 + kb] = eqw; } \
        __syncthreads(); \
        if (wid == 0) { unsigned nd = krem[lane]; \
            _Pragma("unroll") for (int k4 = 0; k4 < 4; ++k4) { const unsigned g = mk[lane * 4 + k4]; unsigned e = mk[256 + lane * 4 + k4]; unsigned sl = g; \
                if (e != 0u) { const unsigned cnt = (unsigned)__builtin_popcount(e); \
                    if (cnt <= nd) { sl |= e; nd -= cnt; } \
                    else { unsigned chosen = 0u; while (nd > 0u) { const unsigned lb = e & (0u - e); chosen |= lb; e ^= lb; --nd; } sl |= chosen; } } \
                selall[lane * 64 + step * 4 + k4] = sl; } \
            krem[lane] = nd; } } } while (0)
    for (int pass = pass0; pass < ((rep_sel + 1 < REP_SEL) ? 3 : 4); ++pass) {
        const bool sel = pass < 3;
        if (sel) { for (int i = tid; i < 64 * 257; i += 512) hist[i] = 0u; __syncthreads(); }
        const int shift = 24 - 8 * pass;
        const unsigned pfx = prefix[32 * qh + r32];
        if (pass == pass0) {
            bf16x8 kfn[4]; load_ik(proj, tokb, 32 * kb, r32, hi, kfn);
            for (int step = 0; step < nsteps; ++step) {
                const int kbase = 128 * step + 32 * kb;
                bf16x8 kf[4];
#pragma unroll
                for (int kk = 0; kk < 4; ++kk) kf[kk] = kfn[kk];
                if (step + 1 < nsteps) load_ik(proj, tokb, kbase + 128, r32, hi, kfn);
                unsigned gtw = 0u, eqw = 0u;
                if (kbase < n) {
                    unsigned uk[16];
                    idx_scores(iqf, kf, wq, uk);
                    if (pass0 == 0) {
#pragma unroll
                        for (int g = 0; g < 4; ++g) kmine[(size_t)step * 2048 + g] = (u32x4){uk[4 * g], uk[4 * g + 1], uk[4 * g + 2], uk[4 * g + 3]};
                    }
                    DSA_CONSUME(uk);
                }
                DSA_TIES();
            }
        } else {
            u32x4 ka[4], kb4[4];
#define DSA_KLOAD(dst, st_) do { _Pragma("unroll") for (int g = 0; g < 4; ++g) dst[g] = kmine[(size_t)(st_) * 2048 + g]; } while (0)
            DSA_KLOAD(ka, 0);
            if (nsteps > 1 && 128 + 32 * kb < n) DSA_KLOAD(kb4, 1);
            for (int step = 0; step < nsteps; ++step) {
                const int kbase = 128 * step + 32 * kb;
                unsigned uk[16];
#pragma unroll
                for (int g = 0; g < 4; ++g) { uk[4 * g] = ka[g].x; uk[4 * g + 1] = ka[g].y; uk[4 * g + 2] = ka[g].z; uk[4 * g + 3] = ka[g].w; }
#pragma unroll
                for (int g = 0; g < 4; ++g) ka[g] = kb4[g];
                if (step + 2 < nsteps && kbase + 256 < n) DSA_KLOAD(kb4, step + 2);
                unsigned gtw = 0u, eqw = 0u;
                if (kbase < n) DSA_CONSUME(uk);
                DSA_TIES();
            }
#undef DSA_KLOAD
        }
        if (sel) {
            __syncthreads();
#pragma unroll
            for (int qi = 0; qi < 8; ++qi) {
                const int q = 8 * wid + qi;
                const LAS unsigned* hq = hist + q * 257;
                const unsigned c0 = hq[255 - 4 * lane], c1 = hq[254 - 4 * lane], c2 = hq[253 - 4 * lane], c3 = hq[252 - 4 * lane];
                const unsigned s4 = c0 + c1 + c2 + c3;
                unsigned incl = s4;
#pragma unroll
                for (int o = 1; o < 64; o <<= 1) { const unsigned t = __shfl_up(incl, o); if (lane >= o) incl += t; }
                const unsigned excl = incl - s4, kr = krem[q];
                if (excl < kr && kr <= incl) {
                    unsigned cum = excl, bin, nk;
                    if (cum + c0 >= kr) { bin = 255 - 4 * lane; nk = kr - cum; }
                    else { cum += c0; if (cum + c1 >= kr) { bin = 254 - 4 * lane; nk = kr - cum; }
                    else { cum += c1; if (cum + c2 >= kr) { bin = 253 - 4 * lane; nk = kr - cum; }
                    else { cum += c2; bin = 252 - 4 * lane; nk = kr - cum; } } }
                    prefix[q] = (prefix[q] << 8) | bin; krem[q] = nk;
                }
            }
            __syncthreads();
        }
    }
    }
    if (dummy == 0x9e3779b9u) hist[tid] = 1u;
    const int hd = wid;
    u32x4 pk[2], pv[2];
#define DSA_LOADKV(step_) do { _Pragma("unroll") for (int i_ = 0; i_ < 2; ++i_) { const int ch_ = tid + 512 * i_; int krow_ = 128 * (step_) + (ch_ >> 3); if (krow_ > SEQ - 1) krow_ = SEQ - 1; \
        const GAS bf16_t* rp_ = (const GAS bf16_t*)proj + (tokb + krow_) * PW + (ch_ & 7) * 8; pk[i_] = *(const GAS u32x4*)(rp_ + C_DK); pv[i_] = *(const GAS u32x4*)(rp_ + C_DV); } } while (0)
#define DSA_STOREKV(buf_) do { _Pragma("unroll") for (int i_ = 0; i_ < 2; ++i_) { const int ch_ = tid + 512 * i_, key_ = ch_ >> 3, c8_ = ch_ & 7, kk_ = key_ & 31; \
        *(LAS u32x4*)(dl + DL_KT + (buf_) * 18432 + key_ * 144 + c8_ * 16) = pk[i_]; \
        *(LAS u32x4*)(dl + DL_VT + (buf_) * 16384 + (key_ >> 5) * 4096 + ((c8_ >> 2) * 2 + (kk_ >> 4)) * 1024 + (kk_ & 15) * 64 + (c8_ & 3) * 16) = pv[i_]; } } while (0)
    for (int rep_b2 = 0; rep_b2 < REP_B2; ++rep_b2)
    for (int qb = 0; qb < 2; ++qb) {
        bf16x8 qr[4];
        { const GAS bf16_t* qp = (const GAS bf16_t*)proj + (tokq0 + 32 * qb + r32) * PW + C_DQ + hd * 64 + 8 * hi;
#pragma unroll
          for (int kk = 0; kk < 4; ++kk) qr[kk] = *(const GAS bf16x8*)(qp + kk * 16); }
        f32x16 o0 = {}, o1 = {}; float mrun = -1e30f, lrun = 0.f;
        DSA_LOADKV(0);
        DSA_STOREKV(0);
        __syncthreads();
#define B2_QK(S_, k4_) do { const LAS unsigned char* krd_ = kt + (32 * (k4_) + r32) * 144 + hi * 16; S_ = (f32x16){}; \
        _Pragma("unroll") for (int kk = 0; kk < 4; ++kk) { const bf16x8 kf_ = *(const LAS bf16x8*)(krd_ + kk * 32); S_ = MFMA32(kf_, qr[kk], S_); } } while (0)
#define B2_SM_PV(S_, k4_) do { \
        const int selw_ = (int)selall[(32 * qb + r32) * 64 + step * 4 + (k4_)]; float mx_ = -INFINITY; \
        _Pragma("unroll") for (int r = 0; r < 16; ++r) { const unsigned m_ = (unsigned)__builtin_amdgcn_sbfe(selw_, crow(r, hi), 1); \
            S_[r] = __uint_as_float((__float_as_uint(S_[r]) & m_) | (0xFF800000u & ~m_)); mx_ = fmaxf(mx_, S_[r]); } \
        { const auto rr_ = __builtin_amdgcn_permlane32_swap(__float_as_uint(mx_), __float_as_uint(mx_), false, false); mx_ = fmaxf(__uint_as_float(rr_[0]), __uint_as_float(rr_[1])); } \
        if (__any(mx_ > mrun + 8.0f)) { const float mn_ = fmaxf(mrun, mx_), alpha_ = __builtin_amdgcn_exp2f(mrun - mn_); lrun *= alpha_; mrun = mn_; \
            _Pragma("unroll") for (int r = 0; r < 16; ++r) { o0[r] *= alpha_; o1[r] *= alpha_; } } \
        float pr_[16], rs_ = 0.f; \
        _Pragma("unroll") for (int r = 0; r < 16; ++r) { pr_[r] = __builtin_amdgcn_exp2f(S_[r] - mrun); rs_ += pr_[r]; } \
        lrun += rs_; \
        const bf16x8 pa_ = pack8(pr_), pb_ = pack8(pr_ + 8); \
        const lds_cptr vrd_ = (lds_cptr)vt + (k4_) * 4096 + vtr_lane_off(lane); \
        const bf16x8 v00_ = vfrag(vrd_, 0), v01_ = vfrag(vrd_, 1024), v10_ = vfrag(vrd_, 2048), v11_ = vfrag(vrd_, 3072); \
        o0 = MFMA32(v00_, pa_, o0); o0 = MFMA32(v01_, pb_, o0); o1 = MFMA32(v10_, pa_, o1); o1 = MFMA32(v11_, pb_, o1); } while (0)
        for (int step = 0; step < nsteps; ++step) {
            const int buf = step & 1;
            if (step + 1 < nsteps) DSA_LOADKV(step + 1);
            LAS unsigned char* kt = dl + DL_KT + buf * 18432;
            LAS unsigned char* vt = dl + DL_VT + buf * 16384;
            f32x16 sa, sb;
            B2_QK(sa, 0);
            B2_QK(sb, 1); B2_SM_PV(sa, 0); __builtin_amdgcn_sched_barrier(0);
            if (128 * step + 64 < n) {
                B2_QK(sa, 2); B2_SM_PV(sb, 1); __builtin_amdgcn_sched_barrier(0);
                B2_QK(sb, 3); B2_SM_PV(sa, 2); __builtin_amdgcn_sched_barrier(0);
                B2_SM_PV(sb, 3);
            } else {
                B2_SM_PV(sb, 1);
            }
            if (step + 1 < nsteps) DSA_STOREKV(buf ^ 1);
            __syncthreads();
        }
#undef B2_QK
#undef B2_SM_PV
        float l = lrun; { const auto rr = __builtin_amdgcn_permlane32_swap(__float_as_uint(l), __float_as_uint(l), false, false); l = __uint_as_float(rr[0]) + __uint_as_float(rr[1]); }
        const float il = 1.0f / l;
        bf16_t* op = odsa + (tokq0 + 32 * qb + r32) * 512 + hd * 64 + 4 * hi;
#pragma unroll
        for (int g = 0; g < 4; ++g) {
            u32x2 w0, w1; w0.x = cvt_pk_bf16(o0[4 * g] * il, o0[4 * g + 1] * il); w0.y = cvt_pk_bf16(o0[4 * g + 2] * il, o0[4 * g + 3] * il);
            w1.x = cvt_pk_bf16(o1[4 * g] * il, o1[4 * g + 1] * il); w1.y = cvt_pk_bf16(o1[4 * g + 2] * il, o1[4 * g + 3] * il);
            *(u32x2*)(op + 8 * g) = w0; *(u32x2*)(op + 32 + 8 * g) = w1; }
    }
#undef DSA_LOADKV
#undef DSA_STOREKV
#undef DSA_CONSUME
#undef DSA_TIES
    __syncthreads();
}

template <int CTRL> __device__ __forceinline__ float dpp_f(float v) { return __builtin_bit_cast(float, __builtin_amdgcn_update_dpp(0, __builtin_bit_cast(int, v), CTRL, 0xF, 0xF, false)); }
constexpr int RL_WROW = 2064, RL_WHI = 0, RL_WLO = 32 * RL_WROW, RL_TKE = 2 * 32 * RL_WROW, RL_TKW = RL_TKE + 4096;
__device__ __forceinline__ void p9_router(Frame& F) {
    const int lane = F.lane, wave = F.wave, tid = F.tid, r32 = lane & 31, hi = lane >> 5;
    LAS int* tke = (LAS int*)(F.lds + RL_TKE); LAS float* tkw = (LAS float*)(F.lds + RL_TKW);
    const float* w_router = F.in[15]; const float* b_router = F.in[16]; const float* g_ffn = F.in[14];
    for (int idx = tid; idx < DM * NEXP; idx += NWAVES * 64) { const int k = idx >> 5, e = idx & 31; const float w = w_router[idx];
        const unsigned wh = f2bf(w); const unsigned wl = f2bf(w - __builtin_bit_cast(float, wh << 16));
        *(LAS bf16_t*)(F.lds + RL_WHI + e * RL_WROW + k * 2) = (bf16_t)wh; *(LAS bf16_t*)(F.lds + RL_WLO + e * RL_WROW + k * 2) = (bf16_t)wl; }
    if (tid < 32) F.MISC[MW_LCNT + tid] = 0u;
    __syncthreads();
    bf16_t* h2 = (bf16_t*)(F.ws + WS_H); unsigned char* h2f8 = F.ws + WS_H2F8;
    const GAS f32x4* gr = (const GAS f32x4*)g_ffn + lane;
    f32x4 gg[4];
#pragma unroll
    for (int j = 0; j < 4; ++j) gg[j] = gr[64 * j];
    const size_t tok0 = (size_t)F.blk * 256 + 32 * wave;
    u32x2 xnext[2][4];
#pragma unroll
    for (int tk = 0; tk < 2; ++tk) { const GAS u32x2* xr = (const GAS u32x2*)((const GAS bf16_t*)F.out + (tok0 + tk) * 2048 + ((tok0 + tk) & 1) * 1024) + lane;
#pragma unroll
        for (int j = 0; j < 4; ++j) xnext[tk][j] = xr[64 * j]; }
    for (int it = 0; it < 16; ++it) {
        f32x4 hn[2][4];
#pragma unroll
        for (int tk = 0; tk < 2; ++tk)
#pragma unroll
            for (int j = 0; j < 4; ++j) hn[tk][j] = (f32x4){bflo(xnext[tk][j].x), bfhi(xnext[tk][j].x), bflo(xnext[tk][j].y), bfhi(xnext[tk][j].y)};
        if (it + 1 < 16) {
#pragma unroll
            for (int tk = 0; tk < 2; ++tk) { const GAS u32x2* xr = (const GAS u32x2*)((const GAS bf16_t*)F.out + (tok0 + 2 * it + 2 + tk) * 2048 + ((tok0 + 2 * it + 2 + tk) & 1) * 1024) + lane;
#pragma unroll
                for (int j = 0; j < 4; ++j) xnext[tk][j] = xr[64 * j]; } }
        float s[2];
#pragma unroll
        for (int tk = 0; tk < 2; ++tk) { float a = 0.f;
#pragma unroll
            for (int j = 0; j < 4; ++j) a += (hn[tk][j].x * hn[tk][j].x + hn[tk][j].y * hn[tk][j].y) + (hn[tk][j].z * hn[tk][j].z + hn[tk][j].w * hn[tk][j].w);
            s[tk] = a; }
#pragma unroll
        for (int tk = 0; tk < 2; ++tk) { float a = s[tk];
            a += dpp_f<0xB1>(a); a += dpp_f<0x4E>(a); a += dpp_f<0x141>(a); a += dpp_f<0x128>(a);
            { const auto rr = __builtin_amdgcn_permlane16_swap(__float_as_uint(a), __float_as_uint(a), false, false); a = __uint_as_float(rr[0]) + __uint_as_float(rr[1]); }
            { const auto rr = __builtin_amdgcn_permlane32_swap(__float_as_uint(a), __float_as_uint(a), false, false); a = __uint_as_float(rr[0]) + __uint_as_float(rr[1]); }
            s[tk] = a; }
#pragma unroll
        for (int tk = 0; tk < 2; ++tk) {
            const float rstd = 1.0f / sqrtf(s[tk] * (1.f / DM) + EPS);
            GAS u32x2* o8 = (GAS u32x2*)(h2 + (tok0 + 2 * it + tk) * DM) + lane;
#pragma unroll
            for (int j = 0; j < 4; ++j) { const f32x4 v = hn[tk][j] * rstd * gg[j]; u32x2 o; o.x = pk2(v.x, v.y); o.y = pk2(v.z, v.w); o8[64 * j] = o;
                *((GAS unsigned*)(h2f8 + (tok0 + 2 * it + tk) * DM) + lane + 64 * j) = pk4_f8(v.x, v.y, v.z, v.w); }
        }
    }
    asm volatile("s_waitcnt vmcnt(0)" ::: "memory");
    f32x16 acc = {};
    { const GAS bf16_t* hp = (const GAS bf16_t*)h2 + (tok0 + r32) * DM + 8 * hi;
      const LAS unsigned char* wp = F.lds + RL_WHI + r32 * RL_WROW + 16 * hi;
#pragma unroll 8
      for (int kk = 0; kk < 64; ++kk) { const bf16x8 hb = *(const GAS bf16x8*)(hp + 16 * kk);
          const bf16x8 wh = *(const LAS bf16x8*)(wp + 32 * kk), wl = *(const LAS bf16x8*)(wp + RL_WLO + 32 * kk);
          acc = MFMA32(wh, hb, acc); acc = MFMA32(wl, hb, acc); } }
    float lg[16];
#pragma unroll
    for (int r = 0; r < 16; ++r) lg[r] = acc[r] + b_router[crow(r, hi)];
    float lv[4]; int li[4];
#pragma unroll
    for (int k = 0; k < 4; ++k) { float bv = lg[0]; int br = 0;
#pragma unroll
        for (int r = 1; r < 16; ++r) { const bool g = lg[r] > bv; bv = g ? lg[r] : bv; br = g ? r : br; }
        lv[k] = bv; li[k] = crow(br, hi);
#pragma unroll
        for (int r = 0; r < 16; ++r) lg[r] = (r == br) ? -INFINITY : lg[r]; }
    float ov[4]; int oi[4];
#pragma unroll
    for (int k = 0; k < 4; ++k) { const auto rv = __builtin_amdgcn_permlane32_swap(__float_as_uint(lv[k]), __float_as_uint(lv[k]), false, false); const auto ri = __builtin_amdgcn_permlane32_swap((unsigned)li[k], (unsigned)li[k], false, false);
        ov[k] = hi ? __uint_as_float(rv[0]) : __uint_as_float(rv[1]); oi[k] = hi ? (int)ri[0] : (int)ri[1]; }
    float tv[4]; int te[4];
    { float a0 = lv[0], a1 = lv[1], a2 = lv[2], a3 = lv[3], b0 = ov[0], b1 = ov[1], b2 = ov[2], b3 = ov[3];
      int i0 = li[0], i1 = li[1], i2 = li[2], i3 = li[3], j0 = oi[0], j1 = oi[1], j2 = oi[2], j3 = oi[3];
#pragma unroll
      for (int k = 0; k < 4; ++k) { const bool ta = (a0 > b0) || (a0 == b0 && i0 < j0);
          tv[k] = ta ? a0 : b0; te[k] = ta ? i0 : j0;
          if (ta) { a0 = a1; a1 = a2; a2 = a3; a3 = -INFINITY; i0 = i1; i1 = i2; i2 = i3; i3 = 64; }
          else { b0 = b1; b1 = b2; b2 = b3; b3 = -INFINITY; j0 = j1; j1 = j2; j2 = j3; j3 = 64; } } }
    const float e1 = __expf(tv[1] - tv[0]), e2x = __expf(tv[2] - tv[0]), e3 = __expf(tv[3] - tv[0]);
    const float inv = 1.0f / (1.0f + e1 + e2x + e3);
    if (hi == 0) { const int tl = 32 * wave + r32;
        *(LAS int*)(tke + tl * 4 + 0) = te[0]; tke[tl * 4 + 1] = te[1]; tke[tl * 4 + 2] = te[2]; tke[tl * 4 + 3] = te[3];
        tkw[tl * 4 + 0] = inv; tkw[tl * 4 + 1] = e1 * inv; tkw[tl * 4 + 2] = e2x * inv; tkw[tl * 4 + 3] = e3 * inv;
#pragma unroll
        for (int k = 0; k < 4; ++k) __hip_atomic_fetch_add((LAS unsigned*)F.MISC + MW_LCNT + te[k], 1u, __ATOMIC_RELAXED, __HIP_MEMORY_SCOPE_WORKGROUP); }
    __syncthreads();
    if (tid < 32) ((int*)(F.ws + WS_BLKCNT))[F.blk * 32 + tid] = (int)F.MISC[MW_LCNT + tid];
}
__device__ __forceinline__ void p10_assign(Frame& F) {
    const int tid = F.tid;
    const int* blkcnt = (const int*)(F.ws + WS_BLKCNT);
    LAS int* part = (LAS int*)(F.lds);
    LAS int* tke = (LAS int*)(F.lds + RL_TKE); LAS float* tkw = (LAS float*)(F.lds + RL_TKW);
    { const int e = tid & 31, p = tid >> 5; int tot = 0, bef = 0;
      for (int j = 0; j < 16; ++j) { const int bl = p * 16 + j; const int c = blkcnt[bl * 32 + e]; tot += c; bef += (bl < F.blk) ? c : 0; }
      part[p * 32 + e] = tot; part[512 + p * 32 + e] = bef; }
    __syncthreads();
    if (tid < 32) { int tot = 0, bef = 0;
        for (int p = 0; p < 16; ++p) { tot += part[p * 32 + tid]; bef += part[512 + p * 32 + tid]; }
        part[1024 + tid] = tot; F.MISC[MW_BEFORE + tid] = (unsigned)bef; F.MISC[MW_LCNT + tid] = 0u; }
    __syncthreads();
    if (tid == 0) { int ps = 0;
        for (int e = 0; e < 32; ++e) { F.MISC[MW_PSTART + e] = (unsigned)ps; F.MISC[MW_TSTART + e] = (unsigned)(ps >> 8); ps += (part[1024 + e] + 255) & ~255; }
        F.MISC[MW_PSTART + 32] = (unsigned)ps; F.MISC[MW_TSTART + 32] = (unsigned)(ps >> 8); }
    __syncthreads();
    int* slot_tok = (int*)(F.ws + WS_SLOT_TOK); int* tok_slot = (int*)(F.ws + WS_TOK_SLOT); float* tok_gate = (float*)(F.ws + WS_TOK_GATE);
    for (int idx = tid; idx < 1024; idx += NWAVES * 64) {
        const int e = tke[idx]; const float w = tkw[idx];
        const unsigned r = __hip_atomic_fetch_add((LAS unsigned*)F.MISC + MW_LCNT + e, 1u, __ATOMIC_RELAXED, __HIP_MEMORY_SCOPE_WORKGROUP);
        const unsigned pos = F.MISC[MW_PSTART + e] + F.MISC[MW_BEFORE + e] + r;
        slot_tok[pos] = F.blk * 256 + (idx >> 2); tok_slot[F.blk * 1024 + idx] = (int)pos; tok_gate[F.blk * 1024 + idx] = w;
    }
}

__device__ __forceinline__ void p13_combine(Frame& F) {
    const int gw = F.blk * NWAVES + F.wave, NGW = F.G * NWAVES, lane = F.lane;
    const int* tok_slot = (const int*)(F.ws + WS_TOK_SLOT); const float* tok_gate = (const float*)(F.ws + WS_TOK_GATE);
    const GAS unsigned char* Y = (const GAS unsigned char*)(F.ws + WS_Y);
    typedef float f2_t __attribute__((ext_vector_type(2)));
    for (int t0 = gw; t0 < NTOK; t0 += 2 * NGW) {
        u32x4 y[2][4]; u32x4 xb[2][2]; float g[2][4];
#pragma unroll
        for (int tk = 0; tk < 2; ++tk) { const int t = t0 + tk * NGW;
#pragma unroll
            for (int k = 0; k < 4; ++k) { const int sl = __builtin_amdgcn_readfirstlane(tok_slot[4 * t + k]); g[tk][k] = tok_gate[4 * t + k];
                y[tk][k] = *(const GAS u32x4*)(Y + (size_t)sl * DM + 16 * lane); }
            const GAS bf16_t* xrow = (const GAS bf16_t*)F.out + (size_t)t * 2048 + (t & 1) * 1024 + 16 * lane;
            xb[tk][0] = *(const GAS u32x4*)xrow; xb[tk][1] = *(const GAS u32x4*)(xrow + 8); }
        asm volatile("s_waitcnt vmcnt(0)" ::: "memory");
#pragma unroll
        for (int tk = 0; tk < 2; ++tk) { const int t = t0 + tk * NGW;
            f32x4 o[4];
#pragma unroll
            for (int h = 0; h < 2; ++h) { const u32x4 v = xb[tk][h];
                o[2 * h] = (f32x4){bflo(v.x), bfhi(v.x), bflo(v.y), bfhi(v.y)}; o[2 * h + 1] = (f32x4){bflo(v.z), bfhi(v.z), bflo(v.w), bfhi(v.w)}; }
#pragma unroll
            for (int k = 0; k < 4; ++k) { const float w = g[tk][k];
#pragma unroll
                for (int c = 0; c < 4; ++c) { const f2_t lo = __builtin_amdgcn_cvt_pk_f32_fp8((int)y[tk][k][c], false), hi = __builtin_amdgcn_cvt_pk_f32_fp8((int)y[tk][k][c], true);
                    o[c][0] += w * lo[0]; o[c][1] += w * lo[1]; o[c][2] += w * hi[0]; o[c][3] += w * hi[1]; } }
            GAS float* orow = (GAS float*)F.out + (size_t)t * DM + 16 * lane;
#pragma unroll
            for (int c = 0; c < 4; ++c) *(GAS f32x4*)(orow + 4 * c) = o[c]; }
    }
}

#ifndef MK_ONE_LAUNCH
#define MK_ONE_LAUNCH 1
#endif
constexpr int N_PHASES = 14;
struct Args { const float* in[21]; float* out; unsigned char* ws; int ph_lo, ph_hi; };
static_assert(sizeof(Args) == 21 * 8 + 8 + 8 + 8, "no padding");

__global__ void __launch_bounds__(NWAVES * 64, 2) fwd_kernel(Args args) {
    extern __shared__ __attribute__((aligned(16))) unsigned char lds[];
    Frame F;
    F.lds = (LAS unsigned char*)lds;
    F.MISC = (volatile LAS unsigned*)(F.lds + MISC_OFF);
    F.tid = threadIdx.x; F.lane = F.tid & 63; F.wave = __builtin_amdgcn_readfirstlane(F.tid >> 6);
#define FRESH() do { F.lane = lane_id_fresh(); F.tid = F.wave * 64 + F.lane; } while (0)
    F.G = gridDim.x; F.blk = blockIdx.x;
    F.ws = args.ws; F.out = args.out; F.ctl = (gu32*)(args.ws + WS_CTL);
#pragma unroll
    for (int i = 0; i < 21; ++i) F.in[i] = args.in[i];
    for (int u = F.tid; u < (LDS_BYTES - MISC_OFF) / 4; u += NWAVES * 64) ((LAS unsigned*)(F.lds + MISC_OFF))[u] = 0u;
    __syncthreads();
    const int lo = args.ph_lo, hi = args.ph_hi;
    XcdBarrier bar; bar.bar = (unsigned*)(F.ctl + CW_BAR); bar.x = 0; bar.st = nullptr; bar.wave = F.wave;
    if (hi - lo > 1) bar = xcd_barrier_post((unsigned*)(F.ctl + CW_BAR), F.MISC + MW_BAR);
#ifndef STAG
#define STAG 0
#endif
#ifndef PH_MASK
#define PH_MASK 0x3fff
#endif
#define IN(k) (((PH_MASK >> (k)) & 1) && lo <= (k) && (k) < hi)
#ifndef REP_MASK
#define REP_MASK 0
#endif
#define NREP(k) (1 + ((REP_MASK >> (k)) & 1))
#define SEAM(k) do { if (IN(k) && IN((k) + 1)) xcd_barrier(bar); } while (0)
    unsigned char* ws = args.ws;
    bf16_t* proj = (bf16_t*)(ws + WS_P);

    if (IN(0)) for (int rep = 0; rep < NREP(0); ++rep) { if (rep) xcd_barrier(bar); FRESH(); p0_prologue(F); } SEAM(0);

    if (IN(1)) {
#ifdef PROBE_P1
        { pg8::DenseSched S; S.init(ws + WS_H, ws + WS_WIN, NTOK, PW, DM, F.G, F.blk); S.amask = PROBE_P1;
          pg8::EpiBf16<0> E{(bf16_t*)(ws + WS_END), PW, nullptr, 1023};
          pg8::gemm_phase<pg8::EpiBf16<0>, pg8::DenseSched, true>(F.lds, F.wave, DM, S, E); }
        xcd_barrier(bar);
#endif
        { pg8::DenseSched S; S.init(ws + WS_H, ws + WS_WIN, NTOK, PW, DM, F.G, F.blk);
          pg8::EpiBf16<0> E{proj, PW, nullptr};
          pg8::gemm_phase<pg8::EpiBf16<0>, pg8::DenseSched, true>(F.lds, F.wave, DM, S, E); }
        { pg8::DenseSched S; S.init(ws + WS_MEMN, ws + WS_WMKV, NMEM, DM, DM, F.G, F.blk);
          pg8::EpiBf16<0> E{(bf16_t*)(ws + WS_MKV), DM, nullptr};
          pg8::gemm_phase<pg8::EpiBf16<0>, pg8::DenseSched, true>(F.lds, F.wave, DM, S, E); }
    } SEAM(1);

    if (IN(2)) { FRESH(); if (REP_MASK & 4) { p2_prep(F, true); xcd_barrier(bar); } p2_prep(F); } SEAM(2);

    if (IN(3)) {
        FRESH();
        bf16_t* osb = (bf16_t*)(ws + WS_O); bf16_t* odsa = osb + (size_t)NTOK * 512; bf16_t* omem = odsa + (size_t)NTOK * 512;
#ifndef REP_DSA
#define REP_DSA 1
#endif
#ifndef REP_SB
#define REP_SB 1
#endif
#ifndef REP_MEM
#define REP_MEM 1
#endif
#ifndef NO_DSA
        for (int rep = 0; rep < REP_DSA; ++rep)
        for (int i = 0; i < 4; ++i) { const int p = 2 * F.blk + (i >> 1), b = p >> 4, cc = p & 15, c = (i & 1) ? 31 - cc : cc; dsa_unit(proj, odsa, (unsigned*)F.out + (size_t)F.blk * 131072, b, c, F.lds, F.tid); }
#endif
        const int gw = F.blk * NWAVES + F.wave, NGW = F.G * NWAVES;
#ifndef NO_SB
        for (int rep = 0; rep < REP_SB; ++rep)
        for (int it = gw; it < NB * 8 * 64; it += NGW) { const int qblk = 63 - (it >> 8), bh = it & 255; sb_item(proj, osb, bh >> 3, bh & 7, qblk, F.lds + F.wave * 4096, F.lane); }
#endif
#ifndef NO_MEM
        for (int rep = 0; rep < REP_MEM; ++rep) {
            __syncthreads();
            for (int u = F.blk; u < NB * 4 * 2; u += F.G) mem_unit(proj, (const bf16_t*)(ws + WS_MKV), omem, u >> 3, (u >> 1) & 3, u & 1, F.lds, F.tid);
        }
#endif
    } SEAM(3);

    if (IN(4)) {
        pg8::DenseSched S; S.init(ws + WS_H8, ws + WS_WG, NTOK, 3 * DM, DM / 2, F.G, F.blk);
        pg8::EpiGateU8 E{(unsigned char*)proj, F.in[11]};
        pg8::gemm_phase<pg8::EpiGateU8, pg8::DenseSched, true, true>(F.lds, F.wave, DM / 2, S, E);
    } SEAM(4);

    if (IN(5)) { pg8::MergeSched S; S.init(ws + WS_O, ws + WS_WB, NTOK, DM, F.G, F.blk);
        pg8::EpiMerge E{(const unsigned char*)proj, (bf16_t*)(ws + WS_H)};
        pg8::gemm_phase<pg8::EpiMerge, pg8::MergeSched, true>(F.lds, F.wave, 512, S, E); } SEAM(5);


    if (IN(8)) {
        pg8::DenseSched S; S.init(ws + WS_H, ws + WS_WO, NTOK, DM, DM, F.G, F.blk); S.stag = STAG;
        pg8::EpiResid E{F.in[0], (bf16_t*)F.out};
        pg8::gemm_phase<pg8::EpiResid, pg8::DenseSched, true>(F.lds, F.wave, DM, S, E);
    } SEAM(8);

    if (IN(9)) for (int rep = 0; rep < NREP(9); ++rep) { if (rep) xcd_barrier(bar); FRESH(); p9_router(F); } SEAM(9);
    if (IN(10)) for (int rep = 0; rep < NREP(10); ++rep) { if (rep) xcd_barrier(bar); FRESH(); p10_assign(F); } SEAM(10);

    if (IN(11)) {
        pg8::MoeSched S{(const char*)(ws + WS_H2F8), (const char*)(ws + WS_WEI), (const int*)(ws + WS_SLOT_TOK), F.MISC + MW_TSTART, DM / 2, 2048, 8, F.blk};
        pg8::EpiSwiglu E{ws + WS_ACT8, F.in[18]};
        pg8::gemm_phase<pg8::EpiSwiglu, pg8::MoeSched, true, true>(F.lds, F.wave, DM / 2, S, E);
    } SEAM(11);

    if (IN(12)) {
        pg8::MoeSched S{(const char*)(ws + WS_ACT8), (const char*)(ws + WS_WEO), nullptr, F.MISC + MW_TSTART, DM / 2, DM, 4, F.blk};
        pg8::EpiY8 E{ws + WS_Y, F.in[20]};
        pg8::gemm_phase<pg8::EpiY8, pg8::MoeSched, true, true>(F.lds, F.wave, DM / 2, S, E);
    } SEAM(12);

    if (IN(13)) { FRESH(); p13_combine(F); }
#undef IN
#undef SEAM
}

extern "C" void kernel_launch(void* const* d_in, const int* in_sizes, int n_in, void* d_out, int out_size, void* d_ws, size_t ws_size, hipStream_t stream) {
    static int grid = 0;
    if (grid == 0) {
        if (n_in != 21 || in_sizes[0] != NTOK * DM || out_size != NTOK * DM || ws_size < WS_END) {
            fprintf(stderr, "kernel_launch: unexpected shapes: n_in %d in0 %d out %d ws %zu (need >= %zu); nothing launched\n", n_in, n_in > 0 ? in_sizes[0] : -1, out_size, ws_size, (size_t)WS_END); grid = -1; return; }
        int dev = 0, cus = 0, per_cu = 0;
        if (hipGetDevice(&dev) != hipSuccess || hipDeviceGetAttribute(&cus, hipDeviceAttributeMultiprocessorCount, dev) != hipSuccess) { fprintf(stderr, "kernel_launch: device query failed\n"); grid = -1; return; }
        if (hipFuncSetAttribute((const void*)fwd_kernel, hipFuncAttributeMaxDynamicSharedMemorySize, LDS_BYTES) != hipSuccess) { fprintf(stderr, "kernel_launch: hipFuncSetAttribute failed\n"); grid = -1; return; }
        if (hipOccupancyMaxActiveBlocksPerMultiprocessor(&per_cu, (const void*)fwd_kernel, NWAVES * 64, LDS_BYTES) != hipSuccess || per_cu < 1)
            fprintf(stderr, "kernel_launch: note: occupancy query reports %d workgroups per CU\n", per_cu);
        (void)hipGetLastError();
        grid = cus;
        if (grid != 256) { fprintf(stderr, "kernel_launch: this kernel is built for 256 CUs (got %d); nothing launched\n", grid); grid = -1; return; }
    }
    if (grid < 0) return;
    if (hipMemsetAsync((char*)d_ws + WS_CTL, 0, CTL_ZERO_BYTES, stream) != hipSuccess) { fprintf(stderr, "kernel_launch: hipMemsetAsync failed\n"); return; }
    Args a{};
    for (int i = 0; i < 21; ++i) a.in[i] = (const float*)d_in[i];
    a.out = (float*)d_out; a.ws = (unsigned char*)d_ws;
#if MK_ONE_LAUNCH
    const int cuts[2] = {0, N_PHASES}; const int nl = 1;
#else
    const int cuts[11] = {0, 1, 2, 3, 4, 5, 6, 7, 8, 9, N_PHASES}; const int nl = 10;
#endif
    for (int li = 0; li < nl; ++li) {
        a.ph_lo = cuts[li]; a.ph_hi = cuts[li + 1];
        hipLaunchKernelGGL(fwd_kernel, dim3(grid), dim3(NWAVES * 64), LDS_BYTES, stream, a);
        const hipError_t le = hipPeekAtLastError();
        if (le != hipSuccess) { fprintf(stderr, "kernel_launch: launch %d failed: %s\n", li, hipGetErrorName(le)); break; }
    }
}
```

```cpp
#include <hip/hip_runtime.h>
#include <cstdio>
#include <cstdint>

#define LAS __attribute__((address_space(3)))
#define GAS __attribute__((address_space(1)))
typedef unsigned short bf16_t;
typedef short bf16x8 __attribute__((ext_vector_type(8)));
typedef short s16x4 __attribute__((ext_vector_type(4)));
typedef short v4i16_t __attribute__((ext_vector_type(4)));
typedef float f32x2 __attribute__((ext_vector_type(2)));
typedef float f32x4 __attribute__((ext_vector_type(4)));
typedef float f32x16 __attribute__((ext_vector_type(16)));
typedef unsigned u32x2 __attribute__((ext_vector_type(2)));
typedef unsigned u32x4 __attribute__((ext_vector_type(4)));
typedef int i32x4 __attribute__((ext_vector_type(4)));
typedef int i32x8 __attribute__((ext_vector_type(8)));
typedef GAS unsigned gu32;

constexpr int NB = 32, SEQ = 2048, DM = 1024, NTOK = NB * SEQ;
constexpr int MEMLEN = 256, NMEM = NB * MEMLEN;
constexpr int PW = 3072;
constexpr int C_SQ = 0, C_SK = 512, C_SV = 1024, C_DQ = 1536, C_DK = 2048, C_DV = 2112, C_IQ = 2176, C_IK = 2432, C_IW = 2496, C_MQ = 2560;
constexpr int IN_W = 3012;
constexpr int NEXP = 32, TOPK = 4, DEXP = 1024;
constexpr int NSLOT = NTOK * TOPK;
constexpr int NSLOT_PAD = NSLOT + NEXP * 256;
constexpr float EPS = 1e-6f;
constexpr float LOG2E = 1.4426950408889634f;

constexpr size_t MiB = 1u << 20;
constexpr size_t WS_CTL = 0, CTL_ZERO_BYTES = 1 * MiB;
constexpr size_t WS_ROPE = 1 * MiB;
constexpr size_t WS_BLKCNT = 1 * MiB + 512 * 1024;
constexpr size_t WS_SLOT_TOK = 2 * MiB;
constexpr size_t WS_TOK_SLOT = 4 * MiB;
constexpr size_t WS_TOK_GATE = 5 * MiB;
constexpr size_t WS_WIN = 8 * MiB;
constexpr size_t WS_WMKV = 14 * MiB;
constexpr size_t WS_WG = 16 * MiB;
constexpr size_t WS_WB = 22 * MiB;
constexpr size_t WS_WO = 25 * MiB;
constexpr size_t WS_WEI = 27 * MiB;
constexpr size_t WS_WEO = 155 * MiB;
__device__ __forceinline__ int lane_id_fresh() { int l; asm volatile("v_mbcnt_lo_u32_b32 %0, -1, 0\n\tv_mbcnt_hi_u32_b32 %0, -1, %0" : "=v"(l)); return l; }
__device__ __forceinline__ unsigned pk4_f8(float a, float b, float c, float d) { int v = __builtin_amdgcn_cvt_pk_fp8_f32(a, b, 0, false); return (unsigned)__builtin_amdgcn_cvt_pk_fp8_f32(c, d, v, true); }
constexpr float W8_SCALE = 64.f, W8_INV = 1.f / 64.f;
constexpr size_t WS_H = 220 * MiB;
constexpr size_t WS_P = 348 * MiB;
constexpr size_t WS_O = 732 * MiB;
constexpr size_t WS_H8 = 91 * MiB;
constexpr size_t WS_H2F8 = 91 * MiB;
constexpr size_t WS_MEMN = 924 * MiB;
constexpr size_t WS_MKV = 940 * MiB;
constexpr size_t WS_Y = 220 * MiB;
constexpr size_t WS_ACT8 = 748 * MiB;
constexpr size_t WS_END = 1012 * MiB;
static_assert(WS_Y + (size_t)NSLOT_PAD * DM * 2 <= WS_ACT8 && WS_ACT8 + (size_t)NSLOT_PAD * DEXP <= WS_END, "y | act8");
static_assert(WS_SLOT_TOK + (size_t)NSLOT_PAD * 4 <= WS_TOK_SLOT && WS_TOK_GATE + (size_t)NTOK * 16 <= WS_WIN, "slot tables");

constexpr int CW_BAR = 4096;

constexpr int RING_BYTES = 151552;
constexpr int MISC_OFF = RING_BYTES;
constexpr int LDS_BYTES = 155648;
constexpr int MW_BAR = 8;
constexpr int MW_LCNT = 16;
constexpr int MW_PSTART = 64;
constexpr int MW_TSTART = 128;
constexpr int MW_BEFORE = 192;
constexpr int MW_PART = 256;

__device__ __forceinline__ unsigned f2bf(float f) { unsigned u = __builtin_bit_cast(unsigned, f); return (u + 0x7fffu + ((u >> 16) & 1u)) >> 16; }
__device__ __forceinline__ unsigned pk2(float lo, float hi) { return f2bf(lo) | (f2bf(hi) << 16); }
__device__ __forceinline__ float bf2f(unsigned short b) { return __builtin_bit_cast(float, (unsigned)b << 16); }
__device__ __forceinline__ float bflo(unsigned w) { return __builtin_bit_cast(float, w << 16); }
__device__ __forceinline__ float bfhi(unsigned w) { return __builtin_bit_cast(float, w & 0xffff0000u); }
__device__ __forceinline__ unsigned cvt_pk_bf16(float lo, float hi) { unsigned r; asm volatile("v_cvt_pk_bf16_f32 %0, %1, %2" : "=v"(r) : "v"(lo), "v"(hi)); return r; }
__device__ __forceinline__ int crow(int r, int hi) { return (r & 3) + 8 * (r >> 2) + 4 * hi; }
#define LDS_WAIT() asm volatile("s_waitcnt lgkmcnt(0)" ::: "memory")
#define VM_WAIT() asm volatile("s_waitcnt vmcnt(0)" ::: "memory")

namespace pg8 {
constexpr int BM = 256, BK = 64, HALF = 128, HTB = HALF * BK * 2, STAGE_BYTES = 8 * HTB;
__host__ __device__ __forceinline__ int lds_byte(int r, int c) { const int st = (r >> 4) * 2 + (c >> 5), rr = r & 15, cc = c & 31, ob = rr * 64 + cc * 2; return st * 1024 + (ob ^ (((ob >> 9) & 1) << 5)); }
__host__ __device__ __forceinline__ void stage_rc(int b, int& R, int& C) { const int st = b / 1024, sb = b % 1024, swz = sb ^ (((sb >> 9) & 1) << 5); R = (st >> 1) * 16 + swz / 64; C = (st & 1) * 32 + (swz % 64) / 2; }
__host__ __device__ __forceinline__ int perm32(int rho) { const int n = rho >> 4, i = rho & 15; return 8 * (i >> 2) + 4 * n + (i & 3); }

struct Unit { int pm, pn, e; };
constexpr int EPI_NA_OFF = STAGE_BYTES;
constexpr int ROWTAB_OFF = STAGE_BYTES + 8192;
constexpr int BIASTAB_OFF = STAGE_BYTES + 10240;

template <class Epi, class Sched, bool ALIGN_EPI, bool FP8 = false>
__device__ __forceinline__ void gemm_phase(LAS unsigned char* lds, const int wave_, const int K, const Sched& S, const Epi& E) {
    int tid = wave_ * 64 + lane_id_fresh();
    const int wid = __builtin_amdgcn_readfirstlane(tid >> 6), lane = tid & 63, wr = wid >> 2, wc = wid & 3, fr = lane & 15, fq = lane >> 4;
    const int nt = K / BK;
    int Rr[2], Cc[2]; unsigned voffB[2];
#pragma unroll
    for (int i = 0; i < 2; ++i) { int R, C; stage_rc(tid * 16 + i * 8192, R, C); Rr[i] = R; Cc[i] = C; const int Rb = Epi::PERM ? ((R & ~31) + perm32(R & 31)) : R; voffB[i] = (unsigned)(Rb * K + C) * 2u; }
    const size_t kstep = (size_t)(BK * 2);
    const size_t hstepB = (size_t)HALF * K * 2;
    const unsigned ldsw = (unsigned)wid * 1024u;
    const int aoff = lds_byte(wr * 64 + fr, fq * 8), boff = lds_byte(wc * 32 + fr, fq * 8);
#define PG8_SA(b, h) (((b) * 2 + (h)) * HTB)
#define PG8_SB(b, h) ((4 + (b) * 2 + (h)) * HTB)
#define PG8_STAGE(bufoff, gbase, voff) do { _Pragma("unroll") for (int _i = 0; _i < 2; ++_i) { unsigned o_ = (voff)[_i]; asm volatile("" : "+v"(o_)); \
        __builtin_amdgcn_global_load_lds((const unsigned*)((const char*)(gbase) + o_), (LAS unsigned*)(lds + (bufoff) + ldsw + _i * 8192), 16, 0, 0); } } while (0)
#define PG8_J8(x, y) __builtin_shufflevector(x, y, 0, 1, 2, 3, 4, 5, 6, 7)
#define PG8_LDA(dst, b, h) do { _Pragma("unroll") for (int m = 0; m < 4; ++m) { const LAS unsigned char* p_ = lds + PG8_SA(b, h) + aoff + m * 2048; \
        if constexpr (FP8) dst##8[m] = PG8_J8(*(const LAS i32x4*)p_, *(const LAS i32x4*)(p_ + 1024)); else { dst[m][0] = *(const LAS bf16x8*)p_; dst[m][1] = *(const LAS bf16x8*)(p_ + 1024); } } } while (0)
#define PG8_LDB(dst, b, h) do { _Pragma("unroll") for (int n = 0; n < 2; ++n) { const LAS unsigned char* p_ = lds + PG8_SB(b, h) + boff + n * 2048; \
        if constexpr (FP8) dst##8[n] = PG8_J8(*(const LAS i32x4*)p_, *(const LAS i32x4*)(p_ + 1024)); else { dst[n][0] = *(const LAS bf16x8*)p_; dst[n][1] = *(const LAS bf16x8*)(p_ + 1024); } } } while (0)
#define PG8_MMA(ai, bj, At, Bt) do { __builtin_amdgcn_s_setprio(1); _Pragma("unroll") for (int m = 0; m < 4; ++m) _Pragma("unroll") for (int n = 0; n < 2; ++n) { \
        if constexpr (FP8) acc[ai][bj][m][n] = __builtin_amdgcn_mfma_scale_f32_16x16x128_f8f6f4(Bt##8[n], At##8[m], acc[ai][bj][m][n], 0, 0, 0, 0, 0, 0); \
        else { _Pragma("unroll") for (int k = 0; k < 2; ++k) acc[ai][bj][m][n] = __builtin_amdgcn_mfma_f32_16x16x32_bf16(Bt[n][k], At[m][k], acc[ai][bj][m][n], 0, 0, 0); } } \
        __builtin_amdgcn_s_setprio(0); } while (0)
#define PG8_WAIT_V(n) asm volatile("s_waitcnt vmcnt(" #n ")" ::: "memory")
#define PG8_WAIT_VR do { if (!(t == 0 && ui > 0)) PG8_WAIT_V(8); } while (0)
#define PG8_WAIT_L(n) asm volatile("s_waitcnt lgkmcnt(" #n ")" ::: "memory")
#define PG8_BAR __builtin_amdgcn_s_barrier()
#define PG8_SCHED __builtin_amdgcn_sched_barrier(0)
#define PG8_TIDQ() (wave_ * 64 + lane_id_fresh())
#define PG8_SIDE(gptr, off) __builtin_amdgcn_global_load_lds((const unsigned*)(gptr), (LAS unsigned*)(lds + (off)), 16, 0, 0)
    Unit cur, nxt, nx2; int ui = 0;
    if (!S.next(0, cur)) return;
    bool has_next = S.next(1, nxt);
    if (S.gather()) { if (wid == 0) { PG8_SIDE(S.row_table(cur) + 4 * lane, ROWTAB_OFF); if (has_next) PG8_SIDE(S.row_table(nxt) + 4 * lane, ROWTAB_OFF + 1024); }
        PG8_WAIT_V(0); PG8_BAR; }
    f32x4 acc[2][2][4][2];
    bf16x8 At[4][2], B0[2][2], B1[2][2]; i32x8 At8[4], B08[2], B18[2];
    const char* Ab = S.a_base();
    unsigned ca0[2], ca1[2], na0[2], na1[2];
#pragma unroll
    for (int i = 0; i < 2; ++i) { ca0[i] = S.a_off(cur, Rr[i], Cc[i], (const LAS int*)(lds + ROWTAB_OFF)); ca1[i] = S.a_off(cur, HALF + Rr[i], Cc[i], (const LAS int*)(lds + ROWTAB_OFF)); }
    const char* cB = S.b_tile(cur);
    PG8_STAGE(PG8_SB(0, 0), cB, voffB); PG8_STAGE(PG8_SB(0, 1), cB + hstepB, voffB); PG8_STAGE(PG8_SA(0, 0), Ab, ca0); PG8_STAGE(PG8_SA(0, 1), Ab, ca1);
    if (wr == 1) PG8_BAR;
    PG8_WAIT_V(2); PG8_BAR;
    PG8_STAGE(PG8_SB(1, 0), cB + kstep, voffB); PG8_STAGE(PG8_SA(1, 0), Ab + kstep, ca0); PG8_STAGE(PG8_SB(1, 1), cB + hstepB + kstep, voffB);
    PG8_WAIT_V(6); PG8_BAR;
    for (;;) {
        const bool has_nx2 = has_next && S.next(ui + 2, nx2);
        const char* nB = cB;
#pragma unroll
        for (int i = 0; i < 2; ++i) { na0[i] = ca0[i]; na1[i] = ca1[i]; }
        if (has_next) { nB = S.b_tile(nxt); const LAS int* tab = (const LAS int*)(lds + ROWTAB_OFF + ((ui + 1) & 1) * 1024);
#pragma unroll
            for (int i = 0; i < 2; ++i) { int R, C; int tq = tid; if constexpr (FP8) tq = PG8_TIDQ();
                stage_rc(tq * 16 + i * 8192, R, C);
                na0[i] = S.a_off(nxt, R, C, tab); na1[i] = S.a_off(nxt, HALF + R, C, tab); } }
#define PG8_NAST(v) const unsigned v = (unsigned)(EPI_NA_OFF + PG8_TIDQ() * 16)
        if constexpr (FP8) { PG8_NAST(nast); *(LAS u32x4*)(lds + nast) = (u32x4){na0[0], na0[1], na1[0], na1[1]}; }
        if (S.gather()) { PG8_WAIT_L(0);
            if (wid == 0 && has_nx2) PG8_SIDE(S.row_table(nx2) + 4 * lane_id_fresh(), ROWTAB_OFF + (ui & 1) * 1024); }
        if constexpr (Epi::HAS_BIAS) { if (wid == 1) PG8_SIDE(E.bias_src(cur, lane_id_fresh()), BIASTAB_OFF + (ui & 1) * 1024); }
#pragma unroll
        for (int a = 0; a < 2; ++a)
#pragma unroll
            for (int b = 0; b < 2; ++b)
#pragma unroll
                for (int m = 0; m < 4; ++m)
#pragma unroll
                    for (int n = 0; n < 2; ++n) acc[a][b][m][n] = (f32x4){0.f, 0.f, 0.f, 0.f};
#pragma unroll 1
        for (int t = 0; t < nt; t += 2) {
            const bool last = (t == nt - 2);
            const char* a1 = Ab + (size_t)(t + 1) * kstep;
            const char* a2 = last ? Ab : Ab + (size_t)(t + 2) * kstep; const char* b2 = last ? nB : cB + (size_t)(t + 2) * kstep;
            const char* a3 = a2 + kstep; const char* b3 = b2 + kstep;
            if constexpr (FP8) { asm volatile("" : "+s"(a1), "+s"(a2), "+s"(b2), "+s"(a3), "+s"(b3)); }
            unsigned o20[2], o21[2];
#pragma unroll
            for (int i = 0; i < 2; ++i) { o20[i] = last ? na0[i] : ca0[i]; o21[i] = last ? na1[i] : ca1[i]; }
            if constexpr (FP8) { if (last) { PG8_NAST(nast); const u32x4 nv = *(const LAS u32x4*)(lds + nast); o20[0] = nv.x; o20[1] = nv.y; o21[0] = nv.z; o21[1] = nv.w; } }
            PG8_LDB(B0, 0, 0); PG8_LDB(B1, 0, 1); PG8_SCHED; PG8_LDA(At, 0, 0); PG8_STAGE(PG8_SA(1, 1), a1, ca1);
            PG8_WAIT_VR; PG8_WAIT_L(0); PG8_BAR; PG8_MMA(0, 0, At, B0); PG8_MMA(0, 1, At, B1); PG8_BAR; PG8_SCHED;
            PG8_LDA(At, 0, 1); PG8_STAGE(PG8_SB(0, 0), b2, voffB); PG8_STAGE(PG8_SB(0, 1), b2 + hstepB, voffB); PG8_STAGE(PG8_SA(0, 0), a2, o20);
            PG8_WAIT_VR; PG8_WAIT_L(0); PG8_BAR; PG8_MMA(1, 0, At, B0); PG8_MMA(1, 1, At, B1); PG8_BAR; PG8_SCHED;
            PG8_LDB(B0, 1, 0); PG8_LDB(B1, 1, 1); PG8_SCHED; PG8_LDA(At, 1, 0); PG8_STAGE(PG8_SA(0, 1), a2, o21);
            PG8_WAIT_VR; PG8_WAIT_L(0); PG8_BAR; PG8_MMA(0, 0, At, B0); PG8_MMA(0, 1, At, B1); PG8_BAR; PG8_SCHED;
            PG8_LDA(At, 1, 1); PG8_STAGE(PG8_SB(1, 0), b3, voffB); PG8_STAGE(PG8_SB(1, 1), b3 + hstepB, voffB); PG8_STAGE(PG8_SA(1, 0), a3, o20);
            PG8_WAIT_V(8); PG8_WAIT_L(0); PG8_BAR; PG8_MMA(1, 0, At, B0); PG8_MMA(1, 1, At, B1); PG8_BAR; PG8_SCHED;
        }
        PG8_WAIT_V(0);
        if constexpr (ALIGN_EPI) { if (wr == 0) PG8_BAR; }
        { const LAS float* bt = (const LAS float*)(lds + BIASTAB_OFF + (ui & 1) * 1024);
          if constexpr (FP8) { const int lq = lane_id_fresh();
              E(acc, cur, wr, wc, lq & 15, (lq >> 4) & 3, bt); }
          else E(acc, cur, wr, wc, fr, fq, bt); }
        if (!has_next) break;
        cur = nxt; nxt = nx2; has_next = has_nx2; cB = nB; ++ui;
#pragma unroll
        for (int i = 0; i < 2; ++i) { ca0[i] = na0[i]; ca1[i] = na1[i]; }
        if constexpr (FP8) { PG8_NAST(nast); const u32x4 nv = *(const LAS u32x4*)(lds + nast); ca0[0] = nv.x; ca0[1] = nv.y; ca1[0] = nv.z; ca1[1] = nv.w; }
        if constexpr (ALIGN_EPI) { if (wr == 1) PG8_BAR; }
    }
    PG8_WAIT_V(0);
    if constexpr (!ALIGN_EPI) { if (wr == 0) PG8_BAR; }
    PG8_BAR;
#undef PG8_SA
#undef PG8_SB
#undef PG8_STAGE
#undef PG8_LDA
#undef PG8_LDB
#undef PG8_MMA
#undef PG8_NAST
#undef PG8_J8
#undef PG8_WAIT_V
#undef PG8_WAIT_VR
#undef PG8_WAIT_L
#undef PG8_BAR
#undef PG8_SCHED
#undef PG8_TIDQ
#undef PG8_SIDE
}

struct DenseSched {
    const char* A; const char* Bt; int K, nM, nN, nwg, G, c, stag = 0, amask = -1;
    __device__ __forceinline__ void init(const void* A_, const void* Bt_, int M, int N, int K_, int G_, int c_) { A = (const char*)A_; Bt = (const char*)Bt_; K = K_; nM = M / BM; nN = N / BM; nwg = nM * nN; G = G_; c = c_; }
    __device__ __forceinline__ bool next(int i, Unit& u) const {
        const long L = (long)i * G + c; if (L >= nwg) return false;
        int wgid = (int)L; { const int q = nwg / 8, r = nwg % 8, xcd = wgid % 8, off = wgid / 8; wgid = (xcd < r ? xcd * (q + 1) : r * (q + 1) + (xcd - r) * q) + off; }
        const int nig = 8 * nN, gid = wgid / nig, fm = gid * 8, gsz = (nM - fm) < 8 ? (nM - fm) : 8;
        u.pm = fm + ((wgid % nig) % gsz); u.pn = (wgid % nig) / gsz; u.e = 0; return true;
    }
    __device__ __forceinline__ const char* a_base() const { return A; }
    __device__ __forceinline__ int stagger() const { return stag ? ((c >> 3) & 7) * (K / 55) : 0; }
    __device__ __forceinline__ bool gather() const { return false; }
    __device__ __forceinline__ const int* row_table(const Unit&) const { return nullptr; }
    __device__ __forceinline__ unsigned a_off(const Unit& u, int row, int col, const LAS int* = nullptr) const { return (unsigned)(((size_t)((u.pm * BM + row) & amask) * K + col) * 2); }
    __device__ __forceinline__ int a_row(const Unit& u, int row) const { return (u.pm * BM + row) & amask; }
    __device__ __forceinline__ unsigned row_off(int r, int col) const { return (unsigned)(((size_t)r * K + col) * 2); }
    __device__ __forceinline__ const char* b_tile(const Unit& u) const { return Bt + (size_t)u.pn * BM * K * 2; }
};
}

namespace pg8 {
struct MoeSched {
    const char* A; const char* Bt; const int* slot_tok; volatile LAS unsigned* tstart; int K, rowsE, nN, c;
    __device__ __forceinline__ bool next(int i, Unit& u) const {
        const int x = c & 7, j = c >> 3, rpr = 32 / nN;
        const int pm = (i * 8 + x) * rpr + j / nN;
        const int l = lane_id_fresh(); const int tv = (int)tstart[l < 32 ? l : 32];
        const int T = __builtin_amdgcn_readlane(tv, 32);
        if (pm >= T) return false;
        const unsigned long long bal = __ballot(l >= 1 && l < 32 && tv <= pm);
        u.pm = pm; u.pn = j % nN; u.e = (int)__builtin_popcountll(bal); return true;
    }
    __device__ __forceinline__ const char* a_base() const { return A; }
    __device__ __forceinline__ int stagger() const { const int g = (c >> 3) / nN, ng = 32 / nN; (void)g; (void)ng; return 0; }
    __device__ __forceinline__ bool gather() const { return slot_tok != nullptr; }
    __device__ __forceinline__ const int* row_table(const Unit& u) const { return slot_tok + u.pm * BM; }
    __device__ __forceinline__ unsigned a_off(const Unit& u, int row, int col, const LAS int* tab) const {
        const int r = slot_tok ? tab[row] : u.pm * BM + row;
        return (unsigned)(((size_t)r * K + col) * 2);
    }
    __device__ __forceinline__ const char* b_tile(const Unit& u) const { return Bt + ((size_t)u.e * rowsE + (size_t)u.pn * BM) * K * 2; }
};

struct MergeSched {
    const char* A; const char* Bt; int nM, nN, nwg, G, c;
    __device__ __forceinline__ void init(const void* A_, const void* Bt_, int M, int N, int G_, int c_) { A = (const char*)A_; Bt = (const char*)Bt_; nM = M / BM; nN = N / BM; nwg = nM * nN; G = G_; c = c_; }
    __device__ __forceinline__ bool next(int i, Unit& u) const {
        const int r = i / 3; const long L = (long)r * G + c; if (L >= nwg) return false;
        int wgid = (int)L; { const int q = nwg / 8, rr = nwg % 8, xcd = wgid % 8, off = wgid / 8; wgid = (xcd < rr ? xcd * (q + 1) : rr * (q + 1) + (xcd - rr) * q) + off; }
        const int nig = 8 * nN, gid = wgid / nig, fm = gid * 8, gsz = (nM - fm) < 8 ? (nM - fm) : 8;
        u.pm = fm + ((wgid % nig) % gsz); u.pn = (wgid % nig) / gsz; u.e = i - 3 * r; return true;
    }
    __device__ __forceinline__ const char* a_base() const { return A; }
    __device__ __forceinline__ int stagger() const { return 0; }
    __device__ __forceinline__ bool gather() const { return false; }
    __device__ __forceinline__ const int* row_table(const Unit&) const { return nullptr; }
    __device__ __forceinline__ unsigned a_off(const Unit& u, int row, int col, const LAS int* = nullptr) const { return (unsigned)(((size_t)(u.pm * BM + row) * 512 + col) * 2 + (size_t)u.e * ((size_t)NTOK * 512 * 2)); }
    __device__ __forceinline__ const char* b_tile(const Unit& u) const { return Bt + ((size_t)u.e * DM + (size_t)u.pn * BM) * 512 * 2; }
};

template <int ACT> struct EpiBf16 {
    static constexpr bool PERM = true, HAS_BIAS = false;
    bf16_t* O; int ldc; const float* bias; int rowmask = -1;
    __device__ __forceinline__ const float* bias_src(const Unit&, int) const { return nullptr; }
    __device__ __forceinline__ void operator()(const f32x4 (&acc)[2][2][4][2], const Unit& u, int wr, int wc, int fr, int fq, const LAS float*) const {
        const int row0 = u.pm * BM + wr * 64 + fr; const int col0 = u.pn * BM + wc * 32 + 8 * fq;
#pragma unroll
        for (int ai = 0; ai < 2; ++ai)
#pragma unroll
            for (int m = 0; m < 4; ++m) { bf16_t* rowp = O + (size_t)((row0 + ai * HALF + m * 16) & rowmask) * ldc + col0;
#pragma unroll
                for (int bj = 0; bj < 2; ++bj) { const f32x4 v0 = acc[ai][bj][m][0], v1 = acc[ai][bj][m][1];
                    u32x4 w; w.x = cvt_pk_bf16(v0[0], v0[1]); w.y = cvt_pk_bf16(v0[2], v0[3]); w.z = cvt_pk_bf16(v1[0], v1[1]); w.w = cvt_pk_bf16(v1[2], v1[3]);
                    *(u32x4*)(rowp + bj * HALF) = w; } }
    }
};
struct EpiGateU8 {
    static constexpr bool PERM = true, HAS_BIAS = true;
    unsigned char* G; const float* bias;
    __device__ __forceinline__ const float* bias_src(const Unit& u, int l) const { return bias + u.pn * BM + 4 * l; }
    __device__ __forceinline__ void operator()(const f32x4 (&acc)[2][2][4][2], const Unit& u, int wr, int wc, int fr, int fq, const LAS float* bt) const {
        const int row0 = u.pm * BM + wr * 64 + fr; const int col0 = u.pn * BM + wc * 32 + 8 * fq;
        f32x4 bv[2][2];
#pragma unroll
        for (int bj = 0; bj < 2; ++bj)
#pragma unroll
            for (int n = 0; n < 2; ++n) bv[bj][n] = *(const LAS f32x4*)(bt + wc * 32 + 8 * fq + bj * HALF + 4 * n);
#pragma unroll
        for (int ai = 0; ai < 2; ++ai)
#pragma unroll
            for (int m = 0; m < 4; ++m) { unsigned char* rowp = G + (size_t)(row0 + ai * HALF + m * 16) * PW + col0;
#pragma unroll
                for (int bj = 0; bj < 2; ++bj) { u32x2 w;
#pragma unroll
                    for (int n = 0; n < 2; ++n) { const f32x4 v = acc[ai][bj][m][n] * W8_INV + bv[bj][n]; unsigned q[4];
#pragma unroll
                        for (int j = 0; j < 4; ++j) q[j] = (unsigned)(255.f * __builtin_amdgcn_rcpf(1.f + __builtin_amdgcn_exp2f(-LOG2E * v[j])) + 0.5f);
                        const unsigned pk = q[0] | (q[1] << 8) | (q[2] << 16) | (q[3] << 24);
                        if (n == 0) w.x = pk; else w.y = pk; }
                    *(u32x2*)(rowp + bj * HALF) = w; } }
    }
};
struct EpiY8 {
    static constexpr bool PERM = true, HAS_BIAS = true;
    unsigned char* Y; const float* bias; int nostore = 0;
    __device__ __forceinline__ const float* bias_src(const Unit& u, int l) const { return bias + u.e * DM + u.pn * BM + 4 * l; }
    __device__ __forceinline__ void operator()(const f32x4 (&acc)[2][2][4][2], const Unit& u, int wr, int wc, int fr, int fq, const LAS float* bt) const {
        const int row0 = u.pm * BM + wr * 64 + fr; const int col0 = u.pn * BM + wc * 32 + 8 * fq;
        f32x4 bv[2][2];
#pragma unroll
        for (int bj = 0; bj < 2; ++bj)
#pragma unroll
            for (int n = 0; n < 2; ++n) bv[bj][n] = *(const LAS f32x4*)(bt + wc * 32 + 8 * fq + bj * HALF + 4 * n);
#pragma unroll
        for (int ai = 0; ai < 2; ++ai)
#pragma unroll
            for (int m = 0; m < 4; ++m) { unsigned char* rowp = Y + (size_t)(row0 + ai * HALF + m * 16) * DM + col0;
#pragma unroll
                for (int bj = 0; bj < 2; ++bj) { const f32x4 v0 = acc[ai][bj][m][0] * W8_INV + bv[bj][0], v1 = acc[ai][bj][m][1] * W8_INV + bv[bj][1];
                    u32x2 w; w.x = pk4_f8(v0[0], v0[1], v0[2], v0[3]); w.y = pk4_f8(v1[0], v1[1], v1[2], v1[3]);
                    if (!nostore) *(u32x2*)(rowp + bj * HALF) = w; } }
    }
};
struct EpiMerge {
    static constexpr bool PERM = true, HAS_BIAS = false;
    __device__ __forceinline__ const float* bias_src(const Unit&, int) const { return nullptr; }
    const unsigned char* G; bf16_t* Mg;
    __device__ __forceinline__ void operator()(const f32x4 (&acc)[2][2][4][2], const Unit& u, int wr, int wc, int fr, int fq, const LAS float*) const {
        const int row0 = u.pm * BM + wr * 64 + fr; const int col0 = u.pn * BM + wc * 32 + 8 * fq;
        const int goff = u.e * DM; const bool first = (u.e == 0);
#pragma unroll
        for (int ai = 0; ai < 2; ++ai)
#pragma unroll
            for (int m = 0; m < 4; ++m) { const size_t row = (size_t)(row0 + ai * HALF + m * 16);
#pragma unroll
                for (int bj = 0; bj < 2; ++bj) {
                    const u32x2 g = *(const u32x2*)(G + row * PW + goff + col0 + bj * HALF);
                    u32x4 p = (u32x4){0u, 0u, 0u, 0u};
                    if (!first) p = *(const u32x4*)(Mg + row * DM + col0 + bj * HALF);
                    const f32x4 a0 = acc[ai][bj][m][0] * (1.f / 255.f), a1 = acc[ai][bj][m][1] * (1.f / 255.f);
                    u32x4 w;
                    w.x = cvt_pk_bf16(bflo(p.x) + (float)((g.x >> 0) & 0xffu) * a0[0], bfhi(p.x) + (float)((g.x >> 8) & 0xffu) * a0[1]);
                    w.y = cvt_pk_bf16(bflo(p.y) + (float)((g.x >> 16) & 0xffu) * a0[2], bfhi(p.y) + (float)((g.x >> 24) & 0xffu) * a0[3]);
                    w.z = cvt_pk_bf16(bflo(p.z) + (float)((g.y >> 0) & 0xffu) * a1[0], bfhi(p.z) + (float)((g.y >> 8) & 0xffu) * a1[1]);
                    w.w = cvt_pk_bf16(bflo(p.w) + (float)((g.y >> 16) & 0xffu) * a1[2], bfhi(p.w) + (float)((g.y >> 24) & 0xffu) * a1[3]);
                    *(u32x4*)(Mg + row * DM + col0 + bj * HALF) = w; } }
    }
};
struct EpiResid {
    static constexpr bool PERM = true, HAS_BIAS = false;
    __device__ __forceinline__ const float* bias_src(const Unit&, int) const { return nullptr; }
    const float* base; bf16_t* out;
    __device__ __forceinline__ void operator()(const f32x4 (&acc)[2][2][4][2], const Unit& u, int wr, int wc, int fr, int fq, const LAS float*) const {
        const int row0 = u.pm * BM + wr * 64 + fr; const int col0 = u.pn * BM + wc * 32 + 8 * fq;
#pragma unroll
        for (int ai = 0; ai < 2; ++ai)
#pragma unroll
            for (int m = 0; m < 4; ++m) { const size_t r = (size_t)(row0 + ai * HALF + m * 16); const float* xb = base + r * DM + col0; bf16_t* ob = out + r * 2048 + (r & 1) * 1024 + col0;
#pragma unroll
                for (int bj = 0; bj < 2; ++bj) { const f32x4 v0 = *(const f32x4*)(xb + bj * HALF) + acc[ai][bj][m][0], v1 = *(const f32x4*)(xb + bj * HALF + 4) + acc[ai][bj][m][1];
                    u32x4 w; w.x = cvt_pk_bf16(v0[0], v0[1]); w.y = cvt_pk_bf16(v0[2], v0[3]); w.z = cvt_pk_bf16(v1[0], v1[1]); w.w = cvt_pk_bf16(v1[2], v1[3]);
                    *(u32x4*)(ob + bj * HALF) = w; } }
    }
};
struct EpiSwiglu {
    static constexpr bool PERM = true, HAS_BIAS = true;
    unsigned char* act; const float* bias;
    __device__ __forceinline__ const float* bias_src(const Unit& u, int l) const { return bias + (size_t)u.e * 2048 + (l >> 5) * 1024 + u.pn * HALF + 4 * (l & 31); }
    __device__ __forceinline__ void operator()(const f32x4 (&acc)[2][2][4][2], const Unit& u, int wr, int wc, int fr, int fq, const LAS float* bt) const {
        const int row0 = u.pm * BM + wr * 64 + fr; const int col0 = u.pn * HALF + wc * 32 + 8 * fq;
        f32x4 bg[2], bu[2];
#pragma unroll
        for (int n = 0; n < 2; ++n) { bg[n] = *(const LAS f32x4*)(bt + wc * 32 + 8 * fq + 4 * n); bu[n] = *(const LAS f32x4*)(bt + HALF + wc * 32 + 8 * fq + 4 * n); }
#pragma unroll
        for (int ai = 0; ai < 2; ++ai)
#pragma unroll
            for (int m = 0; m < 4; ++m) { unsigned char* rowp = act + (size_t)(row0 + ai * HALF + m * 16) * DEXP + col0;
                float o[8];
#pragma unroll
                for (int n = 0; n < 2; ++n) { const f32x4 gv = acc[ai][0][m][n] * W8_INV + bg[n], uv = acc[ai][1][m][n] * W8_INV + bu[n];
#pragma unroll
                    for (int q = 0; q < 4; ++q) { const float g = fminf(gv[q], 7.0f); const float uu = fminf(fmaxf(uv[q], -7.0f), 7.0f);
                        const float sg = __builtin_amdgcn_rcpf(1.f + __builtin_amdgcn_exp2f(-1.702f * LOG2E * g));
                        o[4 * n + q] = (uu + 1.0f) * (g * sg); } }
                u32x2 w; w.x = pk4_f8(o[0], o[1], o[2], o[3]); w.y = pk4_f8(o[4], o[5], o[6], o[7]);
                *(u32x2*)rowp = w; }
    }
};
}

#define XB_TMO      128
#define XB_XCNT(j)  (256  + 64 * (j))
#define XB_XSUB(j)  (1280 + 64 * (j))
#define XB_XGEN(j)  (2304 + 64 * (j))
#define XB_TOP      3328
#define XB_TOPGEN   3392
#define XCD_BAR_WORDS 3456
#define XB_SPIN_CAP (1u << 18)

__device__ __forceinline__ unsigned xb_ld(unsigned* p)              { return __hip_atomic_load(p, __ATOMIC_RELAXED, __HIP_MEMORY_SCOPE_AGENT); }
__device__ __forceinline__ unsigned xb_add(unsigned* p, unsigned v) { return __hip_atomic_fetch_add(p, v, __ATOMIC_RELAXED, __HIP_MEMORY_SCOPE_AGENT); }
__device__ __forceinline__ unsigned xb_xcc_id() { return (unsigned)__builtin_amdgcn_s_getreg((3 << 11) | 20) & 0xFu; }
#define XB_SPIN(cond, bar) do { unsigned _sp = 0; while (cond) { __builtin_amdgcn_s_sleep(1); \
    if ((++_sp & 255u) == 0u) { if (xb_ld(&(bar)[XB_TMO])) break; if (_sp > XB_SPIN_CAP) { atomicAdd(&(bar)[XB_TMO], 1u); break; } } } } while (0)

struct XcdBarrier {
    unsigned* bar; unsigned x; int wave;
    volatile LAS unsigned* st;
};

__device__ __forceinline__ XcdBarrier xcd_barrier_post(unsigned* bar, volatile LAS unsigned* st) {
    XcdBarrier b; b.bar = bar; b.x = xb_xcc_id(); b.st = st; b.wave = __builtin_amdgcn_readfirstlane((int)(threadIdx.x >> 6));
    if (threadIdx.x == 0) (void)xb_add(&bar[XB_XCNT(b.x)], 1u);
    return b;
}
__device__ __forceinline__ void xcd_barrier_complete(unsigned* bar, unsigned x, unsigned& nloc, unsigned& nx) {
    const unsigned G = gridDim.x * gridDim.y * gridDim.z;
    unsigned sum, cnt, mine, sp = 0u;
    for (;;) {
        sum = 0u; cnt = 0u; mine = 0u;
#pragma unroll
        for (unsigned j = 0; j < 16; ++j) { const unsigned c = xb_ld(&bar[XB_XCNT(j)]); sum += c; cnt += (c > 0u) ? 1u : 0u; mine = (j == x) ? c : mine; }
        if (sum == G) break;
        __builtin_amdgcn_s_sleep(1);
        if ((++sp & 255u) == 0u) { if (xb_ld(&bar[XB_TMO])) break; if (sp > XB_SPIN_CAP) { atomicAdd(&bar[XB_TMO], 1u); break; } }
    }
    nloc = mine > 0u ? mine : 1u; nx = cnt > 0u ? cnt : 1u;
}

__device__ __forceinline__ void xcd_barrier(const XcdBarrier& b) {
    asm volatile("s_waitcnt vmcnt(0)" ::: "memory");
    __syncthreads();
    if (b.wave == 0 && lane_id_fresh() == 0) {
        unsigned* bar = b.bar;
        __builtin_amdgcn_s_waitcnt(0);
        unsigned nloc = b.st[0], nx = b.st[1];
        if (nloc == 0u) { xcd_barrier_complete(bar, b.x, nloc, nx); b.st[0] = nloc; b.st[1] = nx; }
        const unsigned old = xb_add(&bar[XB_XSUB(b.x)], 1u);
        const unsigned gen = old / nloc;
        if (old + 1u == (gen + 1u) * nloc) {
            __builtin_amdgcn_fence(__ATOMIC_RELEASE, "agent");
            asm volatile("s_waitcnt vmcnt(0)" ::: "memory");
            const unsigned og = xb_add(&bar[XB_TOP], 1u);
            const unsigned tg = og / nx;
            if (og + 1u == (tg + 1u) * nx) xb_add(&bar[XB_TOPGEN], 1u);
            else XB_SPIN(xb_ld(&bar[XB_TOPGEN]) == tg, bar);
            __builtin_amdgcn_fence(__ATOMIC_ACQUIRE, "agent");
            xb_add(&bar[XB_XGEN(b.x)], 1u);
            asm volatile("s_waitcnt vmcnt(0)" ::: "memory");
        } else {
            XB_SPIN(xb_ld(&bar[XB_XGEN(b.x)]) == gen, bar);
            __builtin_amdgcn_fence(__ATOMIC_ACQUIRE, "agent");
            asm volatile("s_waitcnt vmcnt(0)" ::: "memory");
        }
    }
    __syncthreads();
}

constexpr int NWAVES = 8;
struct Frame {
    LAS unsigned char* lds;
    volatile LAS unsigned* MISC;
    gu32* ctl;
    int tid, lane, wave, G, blk;
    const float* in[21];
    float* out; unsigned char* ws;
};
__device__ __forceinline__ float wave_sum(float v) {
#pragma unroll
    for (int o = 1; o < 64; o <<= 1) v += __shfl_xor(v, o);
    return v;
}

__device__ __forceinline__ int map_src(int mode, int n) {
    if (mode == 1) return n < 2500 ? n : (n >= C_MQ ? n - (C_MQ - 2500) : -1);
    if (mode == 2) { const int pn = n >> 8, bj = (n >> 7) & 1, j = n & 127; return bj * 1024 + pn * 128 + j; }
    return n;
}
__device__ __forceinline__ void transpose_item(const float* W, int K, int Nsrc, int Ndst, bf16_t* WT, int mode, LAS float* scr, int item, int lane) {
    const int nblk = Ndst / 32, kb = item / nblk, nb = item % nblk, k0 = 64 * kb, n0 = 32 * nb;
    const int sc = map_src(mode, n0 + (lane & 31));
    const float scale = (mode == 1 && (n0 + (lane & 31)) < 512) ? 0.125f : 1.0f;
#pragma unroll
    for (int i = 0; i < 32; ++i) { const int kk = 2 * i + (lane >> 5); scr[kk * 33 + (lane & 31)] = sc >= 0 ? W[(size_t)(k0 + kk) * Nsrc + sc] * scale : 0.f; }
    LDS_WAIT(); asm volatile("" ::: "memory");
    const int c = lane & 7;
#pragma unroll
    for (int j = 0; j < 4; ++j) { const int n = (lane >> 3) + 8 * j; const LAS float* s = scr + (8 * c) * 33 + n;
        u32x4 o; o.x = pk2(s[0 * 33], s[1 * 33]); o.y = pk2(s[2 * 33], s[3 * 33]); o.z = pk2(s[4 * 33], s[5 * 33]); o.w = pk2(s[6 * 33], s[7 * 33]);
        *(GAS u32x4*)(WT + (size_t)(n0 + n) * K + k0 + 8 * c) = o; }
    LDS_WAIT(); asm volatile("" ::: "memory");
}
__device__ __forceinline__ void transpose_item_f8(const float* W, int K, int Nsrc, int Ndst, unsigned char* WT, int mode, float scale, LAS float* scr, int item, int lane) {
    const int nblk = Ndst / 32, kb = item / nblk, nb = item % nblk, k0 = 64 * kb, n0 = 32 * nb;
    const int sc = map_src(mode, n0 + (lane & 31));
#pragma unroll
    for (int i = 0; i < 32; ++i) { const int kk = 2 * i + (lane >> 5); scr[kk * 33 + (lane & 31)] = sc >= 0 ? W[(size_t)(k0 + kk) * Nsrc + sc] * scale : 0.f; }
    LDS_WAIT(); asm volatile("" ::: "memory");
    const int c = lane & 7;
#pragma unroll
    for (int j = 0; j < 4; ++j) { const int n = (lane >> 3) + 8 * j; const LAS float* s = scr + (8 * c) * 33 + n;
        u32x2 o; o.x = pk4_f8(s[0 * 33], s[1 * 33], s[2 * 33], s[3 * 33]); o.y = pk4_f8(s[4 * 33], s[5 * 33], s[6 * 33], s[7 * 33]);
        *(GAS u32x2*)(WT + (size_t)(n0 + n) * K + k0 + 8 * c) = o; }
    LDS_WAIT(); asm volatile("" ::: "memory");
}
__device__ __forceinline__ void rms_row_to_bf16(int lane, const float* xrow, const float* g, bf16_t* orow) {
    const GAS f32x4* xr = (const GAS f32x4*)xrow + lane; const GAS f32x4* gr = (const GAS f32x4*)g + lane;
    f32x4 v[4]; float s = 0.f;
#pragma unroll
    for (int j = 0; j < 4; ++j) { v[j] = xr[64 * j]; s += (v[j].x * v[j].x + v[j].y * v[j].y) + (v[j].z * v[j].z + v[j].w * v[j].w); }
    const float rstd = 1.0f / sqrtf(wave_sum(s) * (1.f / DM) + EPS);
    GAS u32x2* o8 = (GAS u32x2*)orow + lane;
#pragma unroll
    for (int j = 0; j < 4; ++j) { const f32x4 gg = gr[64 * j]; u32x2 o; o.x = pk2(v[j].x * rstd * gg.x, v[j].y * rstd * gg.y); o.y = pk2(v[j].z * rstd * gg.z, v[j].w * rstd * gg.w); o8[64 * j] = o; }
}

__device__ __forceinline__ void rms_rows4_to_bf16(int lane, const float* x, const float* g, bf16_t* o, size_t m0, size_t stride, unsigned char* o8f = nullptr) {
    f32x4 v[4][4]; float s[4];
#pragma unroll
    for (int r = 0; r < 4; ++r) { const GAS f32x4* xr = (const GAS f32x4*)(x + (m0 + r * stride) * DM) + lane;
#pragma unroll
        for (int j = 0; j < 4; ++j) v[r][j] = xr[64 * j]; }
    const GAS f32x4* gr = (const GAS f32x4*)g + lane;
    f32x4 gg[4];
#pragma unroll
    for (int j = 0; j < 4; ++j) gg[j] = gr[64 * j];
#pragma unroll
    for (int r = 0; r < 4; ++r) { float a = 0.f;
#pragma unroll
        for (int j = 0; j < 4; ++j) a += (v[r][j].x * v[r][j].x + v[r][j].y * v[r][j].y) + (v[r][j].z * v[r][j].z + v[r][j].w * v[r][j].w);
        s[r] = a; }
#pragma unroll
    for (int of = 1; of < 64; of <<= 1) {
#pragma unroll
        for (int r = 0; r < 4; ++r) s[r] += __shfl_xor(s[r], of); }
#pragma unroll
    for (int r = 0; r < 4; ++r) { const float rstd = 1.0f / sqrtf(s[r] * (1.f / DM) + EPS);
        GAS u32x2* o8 = (GAS u32x2*)(o + (m0 + r * stride) * DM) + lane;
#pragma unroll
        for (int j = 0; j < 4; ++j) { const float a0 = v[r][j].x * rstd * gg[j].x, a1 = v[r][j].y * rstd * gg[j].y, a2 = v[r][j].z * rstd * gg[j].z, a3 = v[r][j].w * rstd * gg[j].w;
            u32x2 w; w.x = pk2(a0, a1); w.y = pk2(a2, a3); o8[64 * j] = w;
            if (o8f) *((GAS unsigned*)(o8f + (m0 + r * stride) * DM) + lane + 64 * j) = pk4_f8(a0, a1, a2, a3); } }
}
__device__ __forceinline__ void p0_prologue(Frame& F) {
    LAS float* scr = (LAS float*)(F.lds + F.wave * 16384);
    const int gw = F.blk * NWAVES + F.wave, NGW = F.G * NWAVES, lane = F.lane;
    unsigned char* ws = F.ws;
    constexpr int I_IN = 16 * 96, I_MKV = 16 * 32, I_G = 16 * 32, I_B = 8 * 32, I_O = 16 * 32, I_EI = 16 * 64, I_EO = 16 * 32;
    constexpr int NITEMS = I_IN + I_MKV + 3 * I_G + 3 * I_B + I_O + NEXP * I_EI + NEXP * I_EO;
    for (int it = gw; it < NITEMS; it += NGW) {
        int r = it;
        if (r < I_IN) { transpose_item(F.in[3], DM, IN_W, PW, (bf16_t*)(ws + WS_WIN), 1, scr, r, lane); continue; } r -= I_IN;
        if (r < I_MKV) { transpose_item(F.in[9], DM, DM, DM, (bf16_t*)(ws + WS_WMKV), 0, scr, r, lane); continue; } r -= I_MKV;
        if (r < 3 * I_G) { const int n = r / I_G; transpose_item_f8(F.in[10] + (size_t)n * DM * DM, DM, DM, DM, ws + WS_WG + (size_t)n * DM * DM, 0, W8_SCALE, scr, r % I_G, lane); continue; } r -= 3 * I_G;
        if (r < 3 * I_B) { const int n = r / I_B; transpose_item(F.in[12] + (size_t)n * 512 * DM, 512, DM, DM, (bf16_t*)(ws + WS_WB) + (size_t)n * DM * 512, 0, scr, r % I_B, lane); continue; } r -= 3 * I_B;
        if (r < I_O) { transpose_item(F.in[13], DM, DM, DM, (bf16_t*)(ws + WS_WO), 0, scr, r, lane); continue; } r -= I_O;
        if (r < NEXP * I_EI) { const int e = r / I_EI; transpose_item_f8(F.in[17] + (size_t)e * DM * 2048, DM, 2048, 2048, ws + WS_WEI + (size_t)e * 2048 * DM, 2, W8_SCALE, scr, r % I_EI, lane); continue; } r -= NEXP * I_EI;
        { const int e = r / I_EO; transpose_item_f8(F.in[19] + (size_t)e * DM * DM, DM, DM, DM, ws + WS_WEO + (size_t)e * DM * DM, 0, W8_SCALE, scr, r % I_EO, lane); }
    }
    { f32x2* tab = (f32x2*)(ws + WS_ROPE);
      for (int idx = (F.blk * NWAVES * 64) + F.tid; idx < SEQ * 32; idx += F.G * NWAVES * 64) {
          const int s = idx >> 5, i = idx & 31;
          const float inv = exp2f(-(float)i * (13.287712379549449f / 32.0f));
          const float ang = (float)s * inv;
          const double rev = (double)ang * 0.15915494309189535;
          const float fr = (float)(rev - __builtin_rint(rev));
          tab[idx] = (f32x2){__builtin_amdgcn_cosf(fr), __builtin_amdgcn_sinf(fr)}; } }
    for (int m = gw; m < NTOK; m += 4 * NGW) rms_rows4_to_bf16(lane, F.in[0], F.in[2], (bf16_t*)(ws + WS_H), (size_t)m, (size_t)NGW, ws + WS_H8);
    for (int m = gw; m < NMEM; m += 4 * NGW) rms_rows4_to_bf16(lane, F.in[1], F.in[8], (bf16_t*)(ws + WS_MEMN), (size_t)m, (size_t)NGW);
    { int* st = (int*)(ws + WS_SLOT_TOK);
      for (int i = F.blk * NWAVES * 64 + F.tid; i < NSLOT_PAD; i += F.G * NWAVES * 64) st[i] = 0; }
}

template <int CTRL> __device__ __forceinline__ float dppf(float v) { return __builtin_bit_cast(float, __builtin_amdgcn_update_dpp(0, __builtin_bit_cast(int, v), CTRL, 0xF, 0xF, false)); }
__device__ __forceinline__ float lx1(float v) { return dppf<0xB1>(v); }
__device__ __forceinline__ float lx2(float v) { return dppf<0x4E>(v); }
__device__ __forceinline__ float lx4(float v) { return dppf<0x1B>(dppf<0x141>(v)); }
__device__ __forceinline__ float lx8(float v) { return dppf<0x128>(v); }
__device__ __forceinline__ void un8(const u32x4 w, float (&v)[8]) { v[0] = bflo(w.x); v[1] = bfhi(w.x); v[2] = bflo(w.y); v[3] = bfhi(w.y); v[4] = bflo(w.z); v[5] = bfhi(w.z); v[6] = bflo(w.w); v[7] = bfhi(w.w); }
__device__ __forceinline__ u32x4 pk8(const float (&v)[8]) { u32x4 w; w.x = pk2(v[0], v[1]); w.y = pk2(v[2], v[3]); w.z = pk2(v[4], v[5]); w.w = pk2(v[6], v[7]); return w; }
__device__ __forceinline__ void rope8(float (&v)[8], const f32x2 (&cs)[8], bool up) {
#pragma unroll
    for (int j = 0; j < 8; ++j) { const float other = lx4(v[j]); v[j] = up ? (other * cs[j].y + v[j] * cs[j].x) : (v[j] * cs[j].x - other * cs[j].y); }
}
__device__ __forceinline__ void p2_prep(Frame& F, const bool dummy = false) {
    const int gw = F.blk * NWAVES + F.wave, NGW = F.G * NWAVES, lane = F.lane;
    bf16_t* proj = (bf16_t*)(F.ws + WS_P);
    bf16_t* projw = dummy ? (bf16_t*)(F.ws + WS_END) : proj;
    const int wmask = dummy ? 8191 : 0x7fffffff;
    const f32x2* tab = (const f32x2*)(F.ws + WS_ROPE);
    float gqd[8], gkd[8], gqm[8];
#pragma unroll
    for (int j = 0; j < 8; ++j) { gqd[j] = F.in[4][8 * (lane & 7) + j] * (0.125f * LOG2E); gkd[j] = F.in[5][8 * (lane & 7) + j]; gqm[j] = F.in[6][8 * (lane & 15) + j] * (0.08838834764831845f * LOG2E); }
    const bool up = (lane & 4) != 0; const int i0 = (lane & 3) * 8;
    for (int m0 = gw; m0 < NTOK; m0 += 2 * NGW) {
        u32x4 raw[2][5]; f32x2 cs[2][8];
#pragma unroll
        for (int t = 0; t < 2; ++t) { const GAS bf16_t* row = (const GAS bf16_t*)proj + (size_t)(m0 + t * NGW) * PW;
            raw[t][0] = *(const GAS u32x4*)(row + C_DQ + 8 * lane); raw[t][1] = *(const GAS u32x4*)(row + C_DK + 8 * (lane & 7)); raw[t][2] = *(const GAS u32x4*)(row + C_IQ + 8 * (lane & 31));
            raw[t][3] = *(const GAS u32x4*)(row + C_IK + 8 * (lane & 7)); raw[t][4] = *(const GAS u32x4*)(row + C_MQ + 8 * lane);
            const GAS f32x2* tr = (const GAS f32x2*)tab + (size_t)((m0 + t * NGW) & (SEQ - 1)) * 32 + i0;
#pragma unroll
            for (int j = 0; j < 8; ++j) cs[t][j] = tr[j]; }
#pragma unroll
        for (int t = 0; t < 2; ++t) {
            GAS bf16_t* roww = (GAS bf16_t*)projw + (size_t)((m0 + t * NGW) & wmask) * PW;
            float v[8];
            { un8(raw[t][0], v); float ss = 0.f;
#pragma unroll
              for (int j = 0; j < 8; ++j) ss += v[j] * v[j];
              ss += lx1(ss); ss += lx2(ss); ss += lx4(ss);
              const float rstd = 1.0f / sqrtf(ss * (1.f / 64.f) + EPS);
#pragma unroll
              for (int j = 0; j < 8; ++j) v[j] = v[j] * rstd * gqd[j];
              rope8(v, cs[t], up);
              *(GAS u32x4*)(roww + C_DQ + 8 * lane) = pk8(v); }
            { un8(raw[t][1], v); float ss = 0.f;
#pragma unroll
              for (int j = 0; j < 8; ++j) ss += v[j] * v[j];
              ss += lx1(ss); ss += lx2(ss); ss += lx4(ss);
              const float rstd = 1.0f / sqrtf(ss * (1.f / 64.f) + EPS);
#pragma unroll
              for (int j = 0; j < 8; ++j) v[j] = v[j] * rstd * gkd[j];
              rope8(v, cs[t], up);
              if (lane < 8) *(GAS u32x4*)(roww + C_DK + 8 * lane) = pk8(v); }
            { un8(raw[t][2], v); rope8(v, cs[t], up); if (lane < 32) *(GAS u32x4*)(roww + C_IQ + 8 * lane) = pk8(v); }
            { un8(raw[t][3], v); rope8(v, cs[t], up); if (lane < 8) *(GAS u32x4*)(roww + C_IK + 8 * lane) = pk8(v); }
            { un8(raw[t][4], v); float ss = 0.f;
#pragma unroll
              for (int j = 0; j < 8; ++j) ss += v[j] * v[j];
              ss += lx1(ss); ss += lx2(ss); ss += lx4(ss); ss += lx8(ss);
              const float rstd = 1.0f / sqrtf(ss * (1.f / 128.f) + EPS);
#pragma unroll
              for (int j = 0; j < 8; ++j) v[j] = v[j] * rstd * gqm[j];
              *(GAS u32x4*)(roww + C_MQ + 8 * lane) = pk8(v); }
        }
    }
    bf16_t* mkv = (bf16_t*)(F.ws + WS_MKV);
    if (!dummy) for (int m = gw; m < NMEM; m += NGW) {
        GAS bf16_t* row = (GAS bf16_t*)mkv + (size_t)m * DM; float v[8];
        un8(*(const GAS u32x4*)(row + 8 * lane), v); float ss = 0.f;
#pragma unroll
        for (int j = 0; j < 8; ++j) ss += v[j] * v[j];
        ss += lx1(ss); ss += lx2(ss); ss += lx4(ss); ss += lx8(ss);
        const float rstd = 1.0f / sqrtf(ss * (1.f / 128.f) + EPS);
#pragma unroll
        for (int j = 0; j < 8; ++j) v[j] = v[j] * rstd * F.in[7][8 * (lane & 15) + j];
        *(GAS u32x4*)(row + 8 * lane) = pk8(v);
    }
}

#define MFMA32(a, b, c) __builtin_amdgcn_mfma_f32_32x32x16_bf16((a), (b), (c), 0, 0, 0)
typedef LAS const unsigned char* lds_cptr;
__device__ __forceinline__ s16x4 vtr(lds_cptr p) { return __builtin_bit_cast(s16x4, __builtin_amdgcn_ds_read_tr16_b64_v4i16((LAS v4i16_t*)p)); }
__device__ __forceinline__ bf16x8 vfrag(lds_cptr vbase_lane, int off) {
    const s16x4 lo = vtr(vbase_lane + off), hi = vtr(vbase_lane + off + 512);
    return (bf16x8){lo[0], lo[1], lo[2], lo[3], hi[0], hi[1], hi[2], hi[3]};
}
__device__ __forceinline__ int vtr_lane_off(int lane) { return ((lane >> 4) & 1) * 32 + (lane & 3) * 8 + (4 * (lane >> 5) + ((lane & 15) >> 2)) * 64; }
__device__ __forceinline__ bf16x8 pack8(const float* p) {
    u32x4 w; w.x = cvt_pk_bf16(p[0], p[1]); w.y = cvt_pk_bf16(p[2], p[3]); w.z = cvt_pk_bf16(p[4], p[5]); w.w = cvt_pk_bf16(p[6], p[7]);
    return __builtin_bit_cast(bf16x8, w);
}
__device__ __forceinline__ float softplus_f(float z) { return fmaxf(z, 0.f) + __logf(1.f + __expf(-fabsf(z))); }

__device__ __forceinline__ void sb_item(const bf16_t* proj, bf16_t* osb, int b, int h, int qblk, LAS unsigned char* vlds, int lane) {
    const int r32 = lane & 31, hi = lane >> 5;
    const size_t tok0 = (size_t)b * SEQ + (size_t)qblk * 32;
    bf16x8 qr[4];
    { const bf16_t* qp = proj + (tok0 + r32) * PW + C_SQ + h * 64 + hi * 8;
#pragma unroll
      for (int kk = 0; kk < 4; ++kk) qr[kk] = *(const bf16x8*)(qp + kk * 16); }
    f32x16 o0 = {}, o1 = {}; float R = 0.f;
    const lds_cptr vrd = (lds_cptr)vlds + vtr_lane_off(lane);
    bf16x8 kfn[4]; u32x4 vvn[4];
#define SB_LOAD(kt_) do { const size_t key0_ = (size_t)b * SEQ + (size_t)(kt_) * 32; const GAS bf16_t* kp_ = (const GAS bf16_t*)proj + (key0_ + r32) * PW + C_SK + h * 64 + hi * 8; \
        _Pragma("unroll") for (int kk = 0; kk < 4; ++kk) kfn[kk] = *(const GAS bf16x8*)(kp_ + kk * 16); \
        _Pragma("unroll") for (int p = 0; p < 4; ++p) vvn[p] = *(const GAS u32x4*)((const GAS bf16_t*)proj + (key0_ + 16 * (p & 1) + (lane >> 2)) * PW + C_SV + h * 64 + (p >> 1) * 32 + (lane & 3) * 8); } while (0)
    SB_LOAD(qblk);
    for (int kt = qblk; kt >= 0; --kt) {
        bf16x8 kf[4]; u32x4 vv[4];
#pragma unroll
        for (int i = 0; i < 4; ++i) { kf[i] = kfn[i]; vv[i] = vvn[i]; }
        if (kt > 0) SB_LOAD(kt - 1);
        f32x16 s = {};
#pragma unroll
        for (int kk = 0; kk < 4; ++kk) s = MFMA32(kf[kk], qr[kk], s);
        asm volatile("" ::: "memory");
#pragma unroll
        for (int p = 0; p < 4; ++p) *(LAS u32x4*)(vlds + p * 1024 + lane * 16) = vv[p];
        const bool diag = (kt == qblk);
        float sp[16], pr[16];
#pragma unroll
        for (int r = 0; r < 16; ++r) { const bool valid = !diag || (crow(r, hi) < r32); sp[r] = valid ? softplus_f(s[r]) : 0.f; }
        float T[4], U[4];
#pragma unroll
        for (int g = 0; g < 4; ++g) { T[g] = (sp[4 * g] + sp[4 * g + 1]) + (sp[4 * g + 2] + sp[4 * g + 3]); { const auto rr = __builtin_amdgcn_permlane32_swap(__float_as_uint(T[g]), __float_as_uint(T[g]), false, false); U[g] = hi ? __uint_as_float(rr[0]) : __uint_as_float(rr[1]); } }
        float run = 0.f, above[4];
#pragma unroll
        for (int g = 3; g >= 0; --g) { above[g] = run + (hi == 0 ? U[g] : 0.f); run += T[g] + U[g]; }
#pragma unroll
        for (int g = 0; g < 4; ++g) { float c = R + above[g];
#pragma unroll
            for (int j = 3; j >= 0; --j) { const int r = 4 * g + j; c += sp[r]; const bool valid = !diag || (crow(r, hi) < r32); pr[r] = valid ? __expf(s[r] - c) : 0.f; } }
        R += run;
        const bf16x8 p0 = pack8(pr), p1 = pack8(pr + 8);
        LDS_WAIT();
        const bf16x8 v00 = vfrag(vrd, 0), v01 = vfrag(vrd, 1024), v10 = vfrag(vrd, 2048), v11 = vfrag(vrd, 3072);
        o0 = MFMA32(v00, p0, o0); o0 = MFMA32(v01, p1, o0);
        o1 = MFMA32(v10, p0, o1); o1 = MFMA32(v11, p1, o1);
        asm volatile("" ::: "memory");
        if (__all(R > 30.0f)) break;
    }
#undef SB_LOAD
    bf16_t* op = osb + (tok0 + r32) * 512 + h * 64 + 4 * hi;
#pragma unroll
    for (int g = 0; g < 4; ++g) {
        u32x2 w0, w1; w0.x = cvt_pk_bf16(o0[4 * g], o0[4 * g + 1]); w0.y = cvt_pk_bf16(o0[4 * g + 2], o0[4 * g + 3]); w1.x = cvt_pk_bf16(o1[4 * g], o1[4 * g + 1]); w1.y = cvt_pk_bf16(o1[4 * g + 2], o1[4 * g + 3]);
        *(u32x2*)(op + 8 * g) = w0; *(u32x2*)(op + 32 + 8 * g) = w1; }
}

constexpr int ML_K = 0, ML_KROW = 272, ML_V = 256 * ML_KROW, ML_END = ML_V + 65536;
__device__ __forceinline__ void mem_unit(const bf16_t* proj, const bf16_t* mkv, bf16_t* omem, int b, int h, int half, LAS unsigned char* ml, int tid) {
    const int lane = tid & 63, wid = __builtin_amdgcn_readfirstlane(tid >> 6), r32 = lane & 31, hi = lane >> 5;
    { const GAS bf16_t* src = (const GAS bf16_t*)mkv + (size_t)b * MEMLEN * DM + h * 128;
#pragma unroll
      for (int i = 0; i < 8; ++i) { const int ch = tid + 512 * i, key = ch >> 4, c16 = ch & 15, kk = key & 31;
          const u32x4 kv = *(const GAS u32x4*)(src + (size_t)key * DM + c16 * 8);
          const u32x4 vv = *(const GAS u32x4*)(src + (size_t)key * DM + 512 + c16 * 8);
          *(LAS u32x4*)(ml + ML_K + key * ML_KROW + c16 * 16) = kv;
          *(LAS u32x4*)(ml + ML_V + (key >> 5) * 8192 + ((c16 >> 2) * 2 + (kk >> 4)) * 1024 + (kk & 15) * 64 + (c16 & 3) * 16) = vv; } }
    __syncthreads();
    for (int i = 0; i < 4; ++i) {
        const int qblk = half * 32 + wid * 4 + i;
        const size_t tok0 = (size_t)b * SEQ + (size_t)qblk * 32;
        bf16x8 qr[8];
        { const GAS bf16_t* qp = (const GAS bf16_t*)proj + (tok0 + r32) * PW + C_MQ + h * 128 + hi * 8;
#pragma unroll
          for (int kk = 0; kk < 8; ++kk) qr[kk] = *(const GAS bf16x8*)(qp + kk * 16); }
        f32x16 o[4] = {{}, {}, {}, {}}; float m = -1e30f, l = 0.f;
        for (int kb = 0; kb < 8; ++kb) {
            const LAS unsigned char* krd = ml + ML_K + (32 * kb + r32) * ML_KROW + hi * 16;
            f32x16 s = {};
#pragma unroll
            for (int kk = 0; kk < 8; ++kk) { const bf16x8 kf = *(const LAS bf16x8*)(krd + kk * 32); s = MFMA32(kf, qr[kk], s); }
            float mx = s[0];
#pragma unroll
            for (int r = 1; r < 16; ++r) mx = fmaxf(mx, s[r]);
            { const auto rr = __builtin_amdgcn_permlane32_swap(__float_as_uint(mx), __float_as_uint(mx), false, false); mx = fmaxf(__uint_as_float(rr[0]), __uint_as_float(rr[1])); }
            if (__any(mx > m + 8.0f)) {
                const float mn = fmaxf(m, mx), alpha = __builtin_amdgcn_exp2f(m - mn);
                l *= alpha; m = mn;
#pragma unroll
                for (int d = 0; d < 4; ++d)
#pragma unroll
                    for (int r = 0; r < 16; ++r) o[d][r] *= alpha;
            }
            float pr[16], rs = 0.f;
#pragma unroll
            for (int r = 0; r < 16; ++r) { pr[r] = __builtin_amdgcn_exp2f(s[r] - m); rs += pr[r]; }
            l += rs;
            const bf16x8 p0 = pack8(pr), p1 = pack8(pr + 8);
            const lds_cptr vrd = (lds_cptr)ml + ML_V + kb * 8192 + vtr_lane_off(lane);
#pragma unroll
            for (int d = 0; d < 4; ++d) { const bf16x8 va = vfrag(vrd, d * 2048), vb = vfrag(vrd, d * 2048 + 1024); o[d] = MFMA32(va, p0, o[d]); o[d] = MFMA32(vb, p1, o[d]); }
        }
        { const auto rr = __builtin_amdgcn_permlane32_swap(__float_as_uint(l), __float_as_uint(l), false, false); l = __uint_as_float(rr[0]) + __uint_as_float(rr[1]); }
        const float il = 1.0f / l;
        bf16_t* op = omem + (tok0 + r32) * 512 + h * 128 + 4 * hi;
#pragma unroll
        for (int d = 0; d < 4; ++d)
#pragma unroll
            for (int g = 0; g < 4; ++g) { u32x2 w; w.x = cvt_pk_bf16(o[d][4 * g] * il, o[d][4 * g + 1] * il); w.y = cvt_pk_bf16(o[d][4 * g + 2] * il, o[d][4 * g + 3] * il); *(u32x2*)(op + 32 * d + 8 * g) = w; }
    }
    __syncthreads();
}

constexpr int DL_HIST = 0, DL_PREFIX = 66048, DL_KREM = DL_PREFIX + 256, DL_MASK = 67072, DL_VT = 73728, DL_KT = DL_VT + 2 * 16384, DL_END = DL_KT + 2 * 18432, DL_IQ = DL_VT;
constexpr int TOPK_DSA = 256;

struct IqLds { const LAS unsigned char* p; __device__ __forceinline__ bf16x8 operator()(int j) const { return *(const LAS bf16x8*)(p + j * 32); } };
__device__ __forceinline__ float relu_f(float x) { float r; asm("v_max_f32 %0, 0, %1" : "=v"(r) : "v"(x)); return r; }
template <class QF>
__device__ __forceinline__ void idx_scores(const QF& qf, const bf16x8 (&kf)[4], const float (&wq)[4], unsigned (&uk)[16]) {
    f32x16 a[4]; bf16x8 qa[4];
#pragma unroll
    for (int hd = 0; hd < 4; ++hd) { a[hd] = (f32x16){}; qa[hd] = qf(hd * 4); }
#pragma unroll
    for (int kk = 0; kk < 4; ++kk) {
#pragma unroll
        for (int hd = 0; hd < 4; ++hd) { a[hd] = MFMA32(kf[kk], qa[hd], a[hd]); if (kk + 1 < 4) qa[hd] = qf(hd * 4 + kk + 1); }
        __builtin_amdgcn_sched_barrier(0);
    }
    float scv[16];
#pragma unroll
    for (int hd = 0; hd < 4; ++hd) {
#pragma unroll
        for (int r = 0; r < 16; ++r) scv[r] = (hd == 0) ? wq[0] * relu_f(a[0][r]) : __builtin_fmaf(wq[hd], relu_f(a[hd][r]), scv[r]); }
#pragma unroll
    for (int r = 0; r < 16; ++r) {
        unsigned bits = __builtin_bit_cast(unsigned, scv[r]);
        if (bits == 0x80000000u) bits = 0u;
        uk[r] = bits ^ ((unsigned)((int)bits >> 31) | 0x80000000u);
    }
}
__device__ __forceinline__ void load_ik(const bf16_t* proj, size_t tokb, int kbase, int r32, int hi, bf16x8 (&kf)[4]) {
    int kr = kbase + r32; if (kr > SEQ - 1) kr = SEQ - 1;
    const GAS bf16_t* p = (const GAS bf16_t*)proj + (tokb + kr) * PW + C_IK + 8 * hi;
#pragma unroll
    for (int kk = 0; kk < 4; ++kk) kf[kk] = *(const GAS bf16x8*)(p + kk * 16);
}

__device__ __forceinline__ void dsa_unit(const bf16_t* proj, bf16_t* odsa, unsigned* kscr  , int b, int c, LAS unsigned char* dl, int tid) {
    const int lane = tid & 63, wid = __builtin_amdgcn_readfirstlane(tid >> 6), r32 = lane & 31, hi = lane >> 5;
    const int n = 64 * (c + 1), nsteps = (n + 127) >> 7;
    const size_t tokq0 = (size_t)b * SEQ + (size_t)c * 64, tokb = (size_t)b * SEQ;
    LAS unsigned* hist = (LAS unsigned*)(dl + DL_HIST);
    LAS unsigned* prefix = (LAS unsigned*)(dl + DL_PREFIX);
    LAS unsigned* krem = (LAS unsigned*)(dl + DL_KREM);
    LAS unsigned* mask = (LAS unsigned*)(dl + DL_MASK);
    const int kb = wid >> 1, qh = wid & 1;
    { const int row = tid >> 3, c = tid & 7;
      const GAS bf16_t* src = (const GAS bf16_t*)proj + (tokq0 + row) * PW + C_IQ + c * 32;
#pragma unroll
      for (int i = 0; i < 4; ++i) *(LAS u32x4*)(dl + DL_IQ + row * 528 + c * 64 + i * 16) = *(const GAS u32x4*)(src + i * 8); }
    const IqLds iqf{dl + DL_IQ + (32 * qh + r32) * 528 + hi * 16};
    float wq[4];
    { const u32x2 w = *(const u32x2*)(proj + (tokq0 + 32 * qh + r32) * PW + C_IW);
      wq[0] = bflo(w.x) * 0.0625f; wq[1] = bfhi(w.x) * 0.0625f; wq[2] = bflo(w.y) * 0.0625f; wq[3] = bfhi(w.y) * 0.0625f; }
#ifndef REP_SEL
#define REP_SEL 1
#endif
#ifndef REP_B2
#define REP_B2 1
#endif
    LAS unsigned* selall = (LAS unsigned*)(dl + DL_HIST);
#ifndef PROBE_NOATOM
#define PROBE_NOATOM 0
#endif
    unsigned dummy = 0u;
    for (int rep_sel = 0; rep_sel < REP_SEL; ++rep_sel) {
    if (tid < 64) { prefix[tid] = 0u; krem[tid] = (n > TOPK_DSA) ? (unsigned)TOPK_DSA : 0x7fffffffu; }
    __syncthreads();
    const int pass0 = (n > TOPK_DSA) ? 0 : 3;
    GAS u32x4* kmine = (GAS u32x4*)kscr + (size_t)wid * 256 + lane;
#define DSA_CONSUME(uk_) do { \
        if (sel) { _Pragma("unroll") for (int r = 0; r < 16; ++r) { const bool match = (pass == 0) || (((uk_)[r] >> (shift + 8)) == pfx); \
                if (match && !(PROBE_NOATOM && rep_sel + 1 < REP_SEL)) __hip_atomic_fetch_add(hist + (32 * qh + r32) * 257 + (((uk_)[r] >> shift) & 255u), 1u, __ATOMIC_RELAXED, __HIP_MEMORY_SCOPE_WORKGROUP); else dummy ^= (uk_)[r]; } } \
        else { _Pragma("unroll") for (int r = 0; r < 16; ++r) { const unsigned k24 = (uk_)[r] >> 8; gtw |= (k24 > pfx ? 1u : 0u) << crow(r, hi); eqw |= (k24 == pfx ? 1u : 0u) << crow(r, hi); } } } while (0)
#define DSA_TIES() do { if (!sel) { \
        LAS unsigned* mk = mask + (step & 1) * 768; \
        { const auto rg = __builtin_amdgcn_permlane32_swap(gtw, gtw, false, false); gtw = rg[0] | rg[1]; const auto re = __builtin_amdgcn_permlane32_swap(eqw, eqw, false, false); eqw = re[0] | re[1]; } \
        if (hi == 0) { mk[(32 * qh + r32) * 4 + kb] = gtw; mk[256 + (32 * qh + r32) * 4 + kb] = eqw; } \
        __syncthreads(); \
        if (wid == 0) { unsigned nd = krem[lane]; \
            _Pragma("unroll") for (int k4 = 0; k4 < 4; ++k4) { const unsigned g = mk[lane * 4 + k4]; unsigned e = mk[256 + lane * 4 + k4]; unsigned sl = g; \
                if (e != 0u) { const unsigned cnt = (unsigned)__builtin_popcount(e); \
                    if (cnt <= nd) { sl |= e; nd -= cnt; } \
                    else { unsigned chosen = 0u; while (nd > 0u) { const unsigned lb = e & (0u - e); chosen |= lb; e ^= lb; --nd; } sl |= chosen; } } \
                selall[lane * 64 + step * 4 + k4] = sl; } \
            krem[lane] = nd; } } } while (0)
#ifndef REP_MASKP
#define REP_MASKP 0
#endif
#ifndef REP_P0
#define REP_P0 0
#endif
    for (int pp = pass0 - ((REP_P0 && pass0 == 0) ? 1 : 0); pp < ((rep_sel + 1 < REP_SEL) ? 3 : 4 + REP_MASKP); ++pp) { const int pass = pp > 3 ? 3 : (pp < 0 ? 0 : pp);
        if (pp > 3) { if (tid < 64) krem[tid] = 0x7fffffffu; __syncthreads(); }
        const bool sel = pass < 3;
        if (sel) { for (int i = tid; i < 64 * 257; i += 512) hist[i] = 0u; __syncthreads(); }
        const int shift = 24 - 8 * pass;
        const unsigned pfx = prefix[32 * qh + r32];
        if (pass == pass0) {
            bf16x8 kfn[4]; load_ik(proj, tokb, 32 * kb, r32, hi, kfn);
            for (int step = 0; step < nsteps; ++step) {
                const int kbase = 128 * step + 32 * kb;
                bf16x8 kf[4];
#pragma unroll
                for (int kk = 0; kk < 4; ++kk) kf[kk] = kfn[kk];
                if (step + 1 < nsteps) load_ik(proj, tokb, kbase + 128, r32, hi, kfn);
                unsigned gtw = 0u, eqw = 0u;
                if (kbase < n) {
                    unsigned uk[16];
                    idx_scores(iqf, kf, wq, uk);
#ifndef P0_VAR
#define P0_VAR 0
#endif
                    if (pass0 == 0 && !(P0_VAR == 1 && pp < 0)) {
#pragma unroll
                        for (int g = 0; g < 4; ++g) kmine[(size_t)step * 2048 + g * 64] = (u32x4){uk[4 * g], uk[4 * g + 1], uk[4 * g + 2], uk[4 * g + 3]};
                    }
                    if (!(P0_VAR == 2 && pp < 0)) DSA_CONSUME(uk); else dummy ^= uk[0] ^ uk[5] ^ uk[9] ^ uk[15];
                }
                DSA_TIES();
            }
        } else {
            u32x4 ka[4], kb4[4];
#define DSA_KLOAD(dst, st_) do { _Pragma("unroll") for (int g = 0; g < 4; ++g) dst[g] = kmine[(size_t)(st_) * 2048 + g * 64]; } while (0)
            DSA_KLOAD(ka, 0);
            if (nsteps > 1 && 128 + 32 * kb < n) DSA_KLOAD(kb4, 1);
            for (int step = 0; step < nsteps; ++step) {
                const int kbase = 128 * step + 32 * kb;
                unsigned uk[16];
#pragma unroll
                for (int g = 0; g < 4; ++g) { uk[4 * g] = ka[g].x; uk[4 * g + 1] = ka[g].y; uk[4 * g + 2] = ka[g].z; uk[4 * g + 3] = ka[g].w; }
#pragma unroll
                for (int g = 0; g < 4; ++g) ka[g] = kb4[g];
                if (step + 2 < nsteps && kbase + 256 < n) DSA_KLOAD(kb4, step + 2);
                unsigned gtw = 0u, eqw = 0u;
                if (kbase < n) DSA_CONSUME(uk);
                DSA_TIES();
            }
#undef DSA_KLOAD
        }
        if (sel && pp < 0) __syncthreads();
        if (sel && pp >= 0) {
            __syncthreads();
#pragma unroll
            for (int qi = 0; qi < 8; ++qi) {
                const int q = 8 * wid + qi;
                const LAS unsigned* hq = hist + q * 257;
                const unsigned c0 = hq[255 - 4 * lane], c1 = hq[254 - 4 * lane], c2 = hq[253 - 4 * lane], c3 = hq[252 - 4 * lane];
                const unsigned s4 = c0 + c1 + c2 + c3;
                unsigned incl = s4;
#pragma unroll
                for (int o = 1; o < 64; o <<= 1) { const unsigned t = __shfl_up(incl, o); if (lane >= o) incl += t; }
                const unsigned excl = incl - s4, kr = krem[q];
                if (excl < kr && kr <= incl) {
                    unsigned cum = excl, bin, nk;
                    if (cum + c0 >= kr) { bin = 255 - 4 * lane; nk = kr - cum; }
                    else { cum += c0; if (cum + c1 >= kr) { bin = 254 - 4 * lane; nk = kr - cum; }
                    else { cum += c1; if (cum + c2 >= kr) { bin = 253 - 4 * lane; nk = kr - cum; }
                    else { cum += c2; bin = 252 - 4 * lane; nk = kr - cum; } } }
                    prefix[q] = (prefix[q] << 8) | bin; krem[q] = nk;
                }
            }
            __syncthreads();
        }
    }
    }
    if (dummy == 0x9e3779b9u) hist[tid] = 1u;
    const int hd = wid;
    u32x4 pk[2], pv[2];
#define DSA_LOADKV(step_) do { _Pragma("unroll") for (int i_ = 0; i_ < 2; ++i_) { const int ch_ = tid + 512 * i_; int krow_ = 128 * (step_) + (ch_ >> 3); if (krow_ > SEQ - 1) krow_ = SEQ - 1; \
        const GAS bf16_t* rp_ = (const GAS bf16_t*)proj + (tokb + krow_) * PW + (ch_ & 7) * 8; pk[i_] = *(const GAS u32x4*)(rp_ + C_DK); pv[i_] = *(const GAS u32x4*)(rp_ + C_DV); } } while (0)
#define DSA_STOREKV(buf_) do { _Pragma("unroll") for (int i_ = 0; i_ < 2; ++i_) { const int ch_ = tid + 512 * i_, key_ = ch_ >> 3, c8_ = ch_ & 7, kk_ = key_ & 31; \
        *(LAS u32x4*)(dl + DL_KT + (buf_) * 18432 + key_ * 144 + c8_ * 16) = pk[i_]; \
        *(LAS u32x4*)(dl + DL_VT + (buf_) * 16384 + (key_ >> 5) * 4096 + ((c8_ >> 2) * 2 + (kk_ >> 4)) * 1024 + (kk_ & 15) * 64 + (c8_ & 3) * 16) = pv[i_]; } } while (0)
    for (int rep_b2 = 0; rep_b2 < REP_B2; ++rep_b2)
    for (int qb = 0; qb < 2; ++qb) {
        bf16x8 qr[4];
        { const GAS bf16_t* qp = (const GAS bf16_t*)proj + (tokq0 + 32 * qb + r32) * PW + C_DQ + hd * 64 + 8 * hi;
#pragma unroll
          for (int kk = 0; kk < 4; ++kk) qr[kk] = *(const GAS bf16x8*)(qp + kk * 16); }
        f32x16 o0 = {}, o1 = {}; float mrun = -1e30f, lrun = 0.f;
        DSA_LOADKV(0);
        DSA_STOREKV(0);
        __syncthreads();
#define B2_QK(S_, k4_) do { const LAS unsigned char* krd_ = kt + (32 * (k4_) + r32) * 144 + hi * 16; S_ = (f32x16){}; \
        _Pragma("unroll") for (int kk = 0; kk < 4; ++kk) { const bf16x8 kf_ = *(const LAS bf16x8*)(krd_ + kk * 32); S_ = MFMA32(kf_, qr[kk], S_); } } while (0)
#define B2_SM_PV(S_, k4_) do { \
        const int selw_ = (int)selall[(32 * qb + r32) * 64 + step * 4 + (k4_)]; float mx_ = -INFINITY; \
        _Pragma("unroll") for (int r = 0; r < 16; ++r) { const unsigned m_ = (unsigned)__builtin_amdgcn_sbfe(selw_, crow(r, hi), 1); \
            S_[r] = __uint_as_float((__float_as_uint(S_[r]) & m_) | (0xFF800000u & ~m_)); mx_ = fmaxf(mx_, S_[r]); } \
        { const auto rr_ = __builtin_amdgcn_permlane32_swap(__float_as_uint(mx_), __float_as_uint(mx_), false, false); mx_ = fmaxf(__uint_as_float(rr_[0]), __uint_as_float(rr_[1])); } \
        if (__any(mx_ > mrun + 8.0f)) { const float mn_ = fmaxf(mrun, mx_), alpha_ = __builtin_amdgcn_exp2f(mrun - mn_); lrun *= alpha_; mrun = mn_; \
            _Pragma("unroll") for (int r = 0; r < 16; ++r) { o0[r] *= alpha_; o1[r] *= alpha_; } } \
        float pr_[16], rs_ = 0.f; \
        _Pragma("unroll") for (int r = 0; r < 16; ++r) { pr_[r] = __builtin_amdgcn_exp2f(S_[r] - mrun); rs_ += pr_[r]; } \
        lrun += rs_; \
        const bf16x8 pa_ = pack8(pr_), pb_ = pack8(pr_ + 8); \
        const lds_cptr vrd_ = (lds_cptr)vt + (k4_) * 4096 + vtr_lane_off(lane); \
        const bf16x8 v00_ = vfrag(vrd_, 0), v01_ = vfrag(vrd_, 1024), v10_ = vfrag(vrd_, 2048), v11_ = vfrag(vrd_, 3072); \
        o0 = MFMA32(v00_, pa_, o0); o0 = MFMA32(v01_, pb_, o0); o1 = MFMA32(v10_, pa_, o1); o1 = MFMA32(v11_, pb_, o1); } while (0)
        for (int step = 0; step < nsteps; ++step) {
            const int buf = step & 1;
            if (step + 1 < nsteps) DSA_LOADKV(step + 1);
            LAS unsigned char* kt = dl + DL_KT + buf * 18432;
            LAS unsigned char* vt = dl + DL_VT + buf * 16384;
            f32x16 sa, sb;
            B2_QK(sa, 0);
            B2_QK(sb, 1); B2_SM_PV(sa, 0); __builtin_amdgcn_sched_barrier(0);
            if (128 * step + 64 < n) {
                B2_QK(sa, 2); B2_SM_PV(sb, 1); __builtin_amdgcn_sched_barrier(0);
                B2_QK(sb, 3); B2_SM_PV(sa, 2); __builtin_amdgcn_sched_barrier(0);
                B2_SM_PV(sb, 3);
            } else {
                B2_SM_PV(sb, 1);
            }
            if (step + 1 < nsteps) DSA_STOREKV(buf ^ 1);
            __syncthreads();
        }
#undef B2_QK
#undef B2_SM_PV
        float l = lrun; { const auto rr = __builtin_amdgcn_permlane32_swap(__float_as_uint(l), __float_as_uint(l), false, false); l = __uint_as_float(rr[0]) + __uint_as_float(rr[1]); }
        const float il = 1.0f / l;
        bf16_t* op = odsa + (tokq0 + 32 * qb + r32) * 512 + hd * 64 + 4 * hi;
#pragma unroll
        for (int g = 0; g < 4; ++g) {
            u32x2 w0, w1; w0.x = cvt_pk_bf16(o0[4 * g] * il, o0[4 * g + 1] * il); w0.y = cvt_pk_bf16(o0[4 * g + 2] * il, o0[4 * g + 3] * il);
            w1.x = cvt_pk_bf16(o1[4 * g] * il, o1[4 * g + 1] * il); w1.y = cvt_pk_bf16(o1[4 * g + 2] * il, o1[4 * g + 3] * il);
            *(u32x2*)(op + 8 * g) = w0; *(u32x2*)(op + 32 + 8 * g) = w1; }
    }
#undef DSA_LOADKV
#undef DSA_STOREKV
#undef DSA_CONSUME
#undef DSA_TIES
    __syncthreads();
}

template <int CTRL> __device__ __forceinline__ float dpp_f(float v) { return __builtin_bit_cast(float, __builtin_amdgcn_update_dpp(0, __builtin_bit_cast(int, v), CTRL, 0xF, 0xF, false)); }
constexpr int RL_WROW = 2064, RL_WHI = 0, RL_WLO = 32 * RL_WROW, RL_TKE = 2 * 32 * RL_WROW, RL_TKW = RL_TKE + 4096;
__device__ __forceinline__ void p9_router(Frame& F) {
    const int lane = F.lane, wave = F.wave, tid = F.tid, r32 = lane & 31, hi = lane >> 5;
    LAS int* tke = (LAS int*)(F.lds + RL_TKE); LAS float* tkw = (LAS float*)(F.lds + RL_TKW);
    const float* w_router = F.in[15]; const float* b_router = F.in[16]; const float* g_ffn = F.in[14];
    for (int idx = tid; idx < DM * NEXP; idx += NWAVES * 64) { const int k = idx >> 5, e = idx & 31; const float w = w_router[idx];
        const unsigned wh = f2bf(w); const unsigned wl = f2bf(w - __builtin_bit_cast(float, wh << 16));
        *(LAS bf16_t*)(F.lds + RL_WHI + e * RL_WROW + k * 2) = (bf16_t)wh; *(LAS bf16_t*)(F.lds + RL_WLO + e * RL_WROW + k * 2) = (bf16_t)wl; }
    if (tid < 32) F.MISC[MW_LCNT + tid] = 0u;
    __syncthreads();
    bf16_t* h2 = (bf16_t*)(F.ws + WS_H); unsigned char* h2f8 = F.ws + WS_H2F8;
    const GAS f32x4* gr = (const GAS f32x4*)g_ffn + lane;
    f32x4 gg[4];
#pragma unroll
    for (int j = 0; j < 4; ++j) gg[j] = gr[64 * j];
    const size_t tok0 = (size_t)F.blk * 256 + 32 * wave;
    u32x2 xnext[2][4];
#pragma unroll
    for (int tk = 0; tk < 2; ++tk) { const GAS u32x2* xr = (const GAS u32x2*)((const GAS bf16_t*)F.out + (tok0 + tk) * 2048 + ((tok0 + tk) & 1) * 1024) + lane;
#pragma unroll
        for (int j = 0; j < 4; ++j) xnext[tk][j] = xr[64 * j]; }
    for (int it = 0; it < 16; ++it) {
        f32x4 hn[2][4];
#pragma unroll
        for (int tk = 0; tk < 2; ++tk)
#pragma unroll
            for (int j = 0; j < 4; ++j) hn[tk][j] = (f32x4){bflo(xnext[tk][j].x), bfhi(xnext[tk][j].x), bflo(xnext[tk][j].y), bfhi(xnext[tk][j].y)};
        if (it + 1 < 16) {
#pragma unroll
            for (int tk = 0; tk < 2; ++tk) { const GAS u32x2* xr = (const GAS u32x2*)((const GAS bf16_t*)F.out + (tok0 + 2 * it + 2 + tk) * 2048 + ((tok0 + 2 * it + 2 + tk) & 1) * 1024) + lane;
#pragma unroll
                for (int j = 0; j < 4; ++j) xnext[tk][j] = xr[64 * j]; } }
        float s[2];
#pragma unroll
        for (int tk = 0; tk < 2; ++tk) { float a = 0.f;
#pragma unroll
            for (int j = 0; j < 4; ++j) a += (hn[tk][j].x * hn[tk][j].x + hn[tk][j].y * hn[tk][j].y) + (hn[tk][j].z * hn[tk][j].z + hn[tk][j].w * hn[tk][j].w);
            s[tk] = a; }
#pragma unroll
        for (int tk = 0; tk < 2; ++tk) { float a = s[tk];
            a += dpp_f<0xB1>(a); a += dpp_f<0x4E>(a); a += dpp_f<0x141>(a); a += dpp_f<0x128>(a);
            { const auto rr = __builtin_amdgcn_permlane16_swap(__float_as_uint(a), __float_as_uint(a), false, false); a = __uint_as_float(rr[0]) + __uint_as_float(rr[1]); }
            { const auto rr = __builtin_amdgcn_permlane32_swap(__float_as_uint(a), __float_as_uint(a), false, false); a = __uint_as_float(rr[0]) + __uint_as_float(rr[1]); }
            s[tk] = a; }
#pragma unroll
        for (int tk = 0; tk < 2; ++tk) {
            const float rstd = 1.0f / sqrtf(s[tk] * (1.f / DM) + EPS);
            GAS u32x2* o8 = (GAS u32x2*)(h2 + (tok0 + 2 * it + tk) * DM) + lane;
#pragma unroll
            for (int j = 0; j < 4; ++j) { const f32x4 v = hn[tk][j] * rstd * gg[j]; u32x2 o; o.x = pk2(v.x, v.y); o.y = pk2(v.z, v.w); o8[64 * j] = o;
                *((GAS unsigned*)(h2f8 + (tok0 + 2 * it + tk) * DM) + lane + 64 * j) = pk4_f8(v.x, v.y, v.z, v.w); }
        }
    }
    asm volatile("s_waitcnt vmcnt(0)" ::: "memory");
    f32x16 acc = {};
    { const GAS bf16_t* hp = (const GAS bf16_t*)h2 + (tok0 + r32) * DM + 8 * hi;
      const LAS unsigned char* wp = F.lds + RL_WHI + r32 * RL_WROW + 16 * hi;
#pragma unroll 8
      for (int kk = 0; kk < 64; ++kk) { const bf16x8 hb = *(const GAS bf16x8*)(hp + 16 * kk);
          const bf16x8 wh = *(const LAS bf16x8*)(wp + 32 * kk), wl = *(const LAS bf16x8*)(wp + RL_WLO + 32 * kk);
          acc = MFMA32(wh, hb, acc); acc = MFMA32(wl, hb, acc); } }
    float lg[16];
#pragma unroll
    for (int r = 0; r < 16; ++r) lg[r] = acc[r] + b_router[crow(r, hi)];
    float lv[4]; int li[4];
#pragma unroll
    for (int k = 0; k < 4; ++k) { float bv = lg[0]; int br = 0;
#pragma unroll
        for (int r = 1; r < 16; ++r) { const bool g = lg[r] > bv; bv = g ? lg[r] : bv; br = g ? r : br; }
        lv[k] = bv; li[k] = crow(br, hi);
#pragma unroll
        for (int r = 0; r < 16; ++r) lg[r] = (r == br) ? -INFINITY : lg[r]; }
    float ov[4]; int oi[4];
#pragma unroll
    for (int k = 0; k < 4; ++k) { const auto rv = __builtin_amdgcn_permlane32_swap(__float_as_uint(lv[k]), __float_as_uint(lv[k]), false, false); const auto ri = __builtin_amdgcn_permlane32_swap((unsigned)li[k], (unsigned)li[k], false, false);
        ov[k] = hi ? __uint_as_float(rv[0]) : __uint_as_float(rv[1]); oi[k] = hi ? (int)ri[0] : (int)ri[1]; }
    float tv[4]; int te[4];
    { float a0 = lv[0], a1 = lv[1], a2 = lv[2], a3 = lv[3], b0 = ov[0], b1 = ov[1], b2 = ov[2], b3 = ov[3];
      int i0 = li[0], i1 = li[1], i2 = li[2], i3 = li[3], j0 = oi[0], j1 = oi[1], j2 = oi[2], j3 = oi[3];
#pragma unroll
      for (int k = 0; k < 4; ++k) { const bool ta = (a0 > b0) || (a0 == b0 && i0 < j0);
          tv[k] = ta ? a0 : b0; te[k] = ta ? i0 : j0;
          if (ta) { a0 = a1; a1 = a2; a2 = a3; a3 = -INFINITY; i0 = i1; i1 = i2; i2 = i3; i3 = 64; }
          else { b0 = b1; b1 = b2; b2 = b3; b3 = -INFINITY; j0 = j1; j1 = j2; j2 = j3; j3 = 64; } } }
    const float e1 = __expf(tv[1] - tv[0]), e2x = __expf(tv[2] - tv[0]), e3 = __expf(tv[3] - tv[0]);
    const float inv = 1.0f / (1.0f + e1 + e2x + e3);
    if (hi == 0) { const int tl = 32 * wave + r32;
        *(LAS int*)(tke + tl * 4 + 0) = te[0]; tke[tl * 4 + 1] = te[1]; tke[tl * 4 + 2] = te[2]; tke[tl * 4 + 3] = te[3];
        tkw[tl * 4 + 0] = inv; tkw[tl * 4 + 1] = e1 * inv; tkw[tl * 4 + 2] = e2x * inv; tkw[tl * 4 + 3] = e3 * inv;
#pragma unroll
        for (int k = 0; k < 4; ++k) __hip_atomic_fetch_add((LAS unsigned*)F.MISC + MW_LCNT + te[k], 1u, __ATOMIC_RELAXED, __HIP_MEMORY_SCOPE_WORKGROUP); }
    __syncthreads();
    if (tid < 32) ((int*)(F.ws + WS_BLKCNT))[F.blk * 32 + tid] = (int)F.MISC[MW_LCNT + tid];
}
__device__ __forceinline__ void p10_assign(Frame& F) {
    const int tid = F.tid;
    const int* blkcnt = (const int*)(F.ws + WS_BLKCNT);
    LAS int* part = (LAS int*)(F.lds);
    LAS int* tke = (LAS int*)(F.lds + RL_TKE); LAS float* tkw = (LAS float*)(F.lds + RL_TKW);
    { const int e = tid & 31, p = tid >> 5; int tot = 0, bef = 0;
      for (int j = 0; j < 16; ++j) { const int bl = p * 16 + j; const int c = blkcnt[bl * 32 + e]; tot += c; bef += (bl < F.blk) ? c : 0; }
      part[p * 32 + e] = tot; part[512 + p * 32 + e] = bef; }
    __syncthreads();
    if (tid < 32) { int tot = 0, bef = 0;
        for (int p = 0; p < 16; ++p) { tot += part[p * 32 + tid]; bef += part[512 + p * 32 + tid]; }
        part[1024 + tid] = tot; F.MISC[MW_BEFORE + tid] = (unsigned)bef; F.MISC[MW_LCNT + tid] = 0u; }
    __syncthreads();
    if (tid == 0) { int ps = 0;
        for (int e = 0; e < 32; ++e) { F.MISC[MW_PSTART + e] = (unsigned)ps; F.MISC[MW_TSTART + e] = (unsigned)(ps >> 8); ps += (part[1024 + e] + 255) & ~255; }
        F.MISC[MW_PSTART + 32] = (unsigned)ps; F.MISC[MW_TSTART + 32] = (unsigned)(ps >> 8); }
    __syncthreads();
    int* slot_tok = (int*)(F.ws + WS_SLOT_TOK); int* tok_slot = (int*)(F.ws + WS_TOK_SLOT); float* tok_gate = (float*)(F.ws + WS_TOK_GATE);
    for (int idx = tid; idx < 1024; idx += NWAVES * 64) {
        const int e = tke[idx]; const float w = tkw[idx];
        const unsigned r = __hip_atomic_fetch_add((LAS unsigned*)F.MISC + MW_LCNT + e, 1u, __ATOMIC_RELAXED, __HIP_MEMORY_SCOPE_WORKGROUP);
        const unsigned pos = F.MISC[MW_PSTART + e] + F.MISC[MW_BEFORE + e] + r;
        slot_tok[pos] = F.blk * 256 + (idx >> 2); tok_slot[F.blk * 1024 + idx] = (int)pos; tok_gate[F.blk * 1024 + idx] = w;
    }
}

__device__ __forceinline__ void p13_combine(Frame& F) {
    const int gw = F.blk * NWAVES + F.wave, NGW = F.G * NWAVES, lane = F.lane;
    const int* tok_slot = (const int*)(F.ws + WS_TOK_SLOT); const float* tok_gate = (const float*)(F.ws + WS_TOK_GATE);
    const GAS unsigned char* Y = (const GAS unsigned char*)(F.ws + WS_Y);
    typedef float f2_t __attribute__((ext_vector_type(2)));
    for (int t0 = gw; t0 < NTOK; t0 += 2 * NGW) {
        u32x4 y[2][4]; u32x4 xb[2][2]; float g[2][4];
#pragma unroll
        for (int tk = 0; tk < 2; ++tk) { const int t = t0 + tk * NGW;
#pragma unroll
            for (int k = 0; k < 4; ++k) { const int sl = __builtin_amdgcn_readfirstlane(tok_slot[4 * t + k]); g[tk][k] = tok_gate[4 * t + k];
                y[tk][k] = *(const GAS u32x4*)(Y + (size_t)sl * DM + 16 * lane); }
            const GAS bf16_t* xrow = (const GAS bf16_t*)F.out + (size_t)t * 2048 + (t & 1) * 1024 + 16 * lane;
            xb[tk][0] = *(const GAS u32x4*)xrow; xb[tk][1] = *(const GAS u32x4*)(xrow + 8); }
        asm volatile("s_waitcnt vmcnt(0)" ::: "memory");
#pragma unroll
        for (int tk = 0; tk < 2; ++tk) { const int t = t0 + tk * NGW;
            f32x4 o[4];
#pragma unroll
            for (int h = 0; h < 2; ++h) { const u32x4 v = xb[tk][h];
                o[2 * h] = (f32x4){bflo(v.x), bfhi(v.x), bflo(v.y), bfhi(v.y)}; o[2 * h + 1] = (f32x4){bflo(v.z), bfhi(v.z), bflo(v.w), bfhi(v.w)}; }
#pragma unroll
            for (int k = 0; k < 4; ++k) { const float w = g[tk][k];
#pragma unroll
                for (int c = 0; c < 4; ++c) { const f2_t lo = __builtin_amdgcn_cvt_pk_f32_fp8((int)y[tk][k][c], false), hi = __builtin_amdgcn_cvt_pk_f32_fp8((int)y[tk][k][c], true);
                    o[c][0] += w * lo[0]; o[c][1] += w * lo[1]; o[c][2] += w * hi[0]; o[c][3] += w * hi[1]; } }
            GAS float* orow = (GAS float*)F.out + (size_t)t * DM + 16 * lane;
#pragma unroll
            for (int c = 0; c < 4; ++c) *(GAS f32x4*)(orow + 4 * c) = o[c]; }
    }
}

#ifndef MK_ONE_LAUNCH
#define MK_ONE_LAUNCH 1
#endif
constexpr int N_PHASES = 14;
struct Args { const float* in[21]; float* out; unsigned char* ws; int ph_lo, ph_hi; };
static_assert(sizeof(Args) == 21 * 8 + 8 + 8 + 8, "no padding");

__global__ void __launch_bounds__(NWAVES * 64, 2) fwd_kernel(Args args) {
    extern __shared__ __attribute__((aligned(16))) unsigned char lds[];
    Frame F;
    F.lds = (LAS unsigned char*)lds;
    F.MISC = (volatile LAS unsigned*)(F.lds + MISC_OFF);
    F.tid = threadIdx.x; F.lane = F.tid & 63; F.wave = __builtin_amdgcn_readfirstlane(F.tid >> 6);
#define FRESH() do { F.lane = lane_id_fresh(); F.tid = F.wave * 64 + F.lane; } while (0)
    F.G = gridDim.x; F.blk = blockIdx.x;
    F.ws = args.ws; F.out = args.out; F.ctl = (gu32*)(args.ws + WS_CTL);
#pragma unroll
    for (int i = 0; i < 21; ++i) F.in[i] = args.in[i];
    for (int u = F.tid; u < (LDS_BYTES - MISC_OFF) / 4; u += NWAVES * 64) ((LAS unsigned*)(F.lds + MISC_OFF))[u] = 0u;
    __syncthreads();
    const int lo = args.ph_lo, hi = args.ph_hi;
    XcdBarrier bar; bar.bar = (unsigned*)(F.ctl + CW_BAR); bar.x = 0; bar.st = nullptr; bar.wave = F.wave;
    if (hi - lo > 1) bar = xcd_barrier_post((unsigned*)(F.ctl + CW_BAR), F.MISC + MW_BAR);
#ifndef STAG
#define STAG 0
#endif
#ifndef PH_MASK
#define PH_MASK 0x3fff
#endif
#define IN(k) (((PH_MASK >> (k)) & 1) && lo <= (k) && (k) < hi)
#ifndef REP_MASK
#define REP_MASK 0
#endif
#define NREP(k) (1 + ((REP_MASK >> (k)) & 1))
#define SEAM(k) do { if (IN(k) && IN((k) + 1)) xcd_barrier(bar); } while (0)
    unsigned char* ws = args.ws;
    bf16_t* proj = (bf16_t*)(ws + WS_P);

    if (IN(0)) for (int rep = 0; rep < NREP(0); ++rep) { if (rep) xcd_barrier(bar); FRESH(); p0_prologue(F); } SEAM(0);

    if (IN(1)) {
#ifdef PROBE_P1
        { pg8::DenseSched S; S.init(ws + WS_H, ws + WS_WIN, NTOK, PW, DM, F.G, F.blk); S.amask = PROBE_P1;
          pg8::EpiBf16<0> E{(bf16_t*)(ws + WS_END), PW, nullptr, 1023};
          pg8::gemm_phase<pg8::EpiBf16<0>, pg8::DenseSched, true>(F.lds, F.wave, DM, S, E); }
        xcd_barrier(bar);
#endif
        { pg8::DenseSched S; S.init(ws + WS_H, ws + WS_WIN, NTOK, PW, DM, F.G, F.blk);
          pg8::EpiBf16<0> E{proj, PW, nullptr};
          pg8::gemm_phase<pg8::EpiBf16<0>, pg8::DenseSched, true>(F.lds, F.wave, DM, S, E); }
        { pg8::DenseSched S; S.init(ws + WS_MEMN, ws + WS_WMKV, NMEM, DM, DM, F.G, F.blk);
          pg8::EpiBf16<0> E{(bf16_t*)(ws + WS_MKV), DM, nullptr};
          pg8::gemm_phase<pg8::EpiBf16<0>, pg8::DenseSched, true>(F.lds, F.wave, DM, S, E); }
    } SEAM(1);

    if (IN(2)) { FRESH(); if (REP_MASK & 4) { p2_prep(F, true); xcd_barrier(bar); } p2_prep(F); } SEAM(2);

    if (IN(3)) {
        FRESH();
        bf16_t* osb = (bf16_t*)(ws + WS_O); bf16_t* odsa = osb + (size_t)NTOK * 512; bf16_t* omem = odsa + (size_t)NTOK * 512;
#ifndef REP_DSA
#define REP_DSA 1
#endif
#ifndef REP_SB
#define REP_SB 1
#endif
#ifndef REP_MEM
#define REP_MEM 1
#endif
#ifndef NO_DSA
        for (int rep = 0; rep < REP_DSA; ++rep)
        for (int i = 0; i < 4; ++i) { const int p = 2 * F.blk + (i >> 1), b = p >> 4, cc = p & 15, c = (i & 1) ? 31 - cc : cc; dsa_unit(proj, odsa, (unsigned*)F.out + (size_t)F.blk * 131072, b, c, F.lds, F.tid); }
#endif
        FRESH();
        const int gw = F.blk * NWAVES + F.wave, NGW = F.G * NWAVES;
#ifndef NO_SB
        for (int rep = 0; rep < REP_SB; ++rep)
        for (int it = gw; it < NB * 8 * 64; it += NGW) { const int qblk = 63 - (it >> 8), bh = it & 255; sb_item(proj, osb, bh >> 3, bh & 7, qblk, F.lds + F.wave * 4096, F.lane); }
#endif
#ifndef NO_MEM
        for (int rep = 0; rep < REP_MEM; ++rep) {
            __syncthreads();
            FRESH();
            for (int u = F.blk; u < NB * 4 * 2; u += F.G) mem_unit(proj, (const bf16_t*)(ws + WS_MKV), omem, u >> 3, (u >> 1) & 3, u & 1, F.lds, F.tid);
        }
#endif
    } SEAM(3);

    if (IN(4)) {
        pg8::DenseSched S; S.init(ws + WS_H8, ws + WS_WG, NTOK, 3 * DM, DM / 2, F.G, F.blk);
        pg8::EpiGateU8 E{(unsigned char*)proj, F.in[11]};
        pg8::gemm_phase<pg8::EpiGateU8, pg8::DenseSched, true, true>(F.lds, F.wave, DM / 2, S, E);
    } SEAM(4);

    if (IN(5)) { pg8::MergeSched S; S.init(ws + WS_O, ws + WS_WB, NTOK, DM, F.G, F.blk);
        pg8::EpiMerge E{(const unsigned char*)proj, (bf16_t*)(ws + WS_H)};
        pg8::gemm_phase<pg8::EpiMerge, pg8::MergeSched, true>(F.lds, F.wave, 512, S, E); } SEAM(5);


    if (IN(8)) {
        pg8::DenseSched S; S.init(ws + WS_H, ws + WS_WO, NTOK, DM, DM, F.G, F.blk); S.stag = STAG;
        pg8::EpiResid E{F.in[0], (bf16_t*)F.out};
        pg8::gemm_phase<pg8::EpiResid, pg8::DenseSched, true>(F.lds, F.wave, DM, S, E);
    } SEAM(8);

    if (IN(9)) for (int rep = 0; rep < NREP(9); ++rep) { if (rep) xcd_barrier(bar); FRESH(); p9_router(F); } SEAM(9);
    if (IN(10)) for (int rep = 0; rep < NREP(10); ++rep) { if (rep) xcd_barrier(bar); FRESH(); p10_assign(F); } SEAM(10);

    if (IN(11)) {
        pg8::MoeSched S{(const char*)(ws + WS_H2F8), (const char*)(ws + WS_WEI), (const int*)(ws + WS_SLOT_TOK), F.MISC + MW_TSTART, DM / 2, 2048, 8, F.blk};
        pg8::EpiSwiglu E{ws + WS_ACT8, F.in[18]};
        pg8::gemm_phase<pg8::EpiSwiglu, pg8::MoeSched, true, true>(F.lds, F.wave, DM / 2, S, E);
    } SEAM(11);

    if (IN(12)) {
        pg8::MoeSched S{(const char*)(ws + WS_ACT8), (const char*)(ws + WS_WEO), nullptr, F.MISC + MW_TSTART, DM / 2, DM, 4, F.blk};
        pg8::EpiY8 E{ws + WS_Y, F.in[20]};
        pg8::gemm_phase<pg8::EpiY8, pg8::MoeSched, true, true>(F.lds, F.wave, DM / 2, S, E);
    } SEAM(12);

    if (IN(13)) { FRESH(); p13_combine(F); }
#undef IN
#undef SEAM
}

extern "C" void kernel_launch(void* const* d_in, const int* in_sizes, int n_in, void* d_out, int out_size, void* d_ws, size_t ws_size, hipStream_t stream) {
    static int grid = 0;
    if (grid == 0) {
        if (n_in != 21 || in_sizes[0] != NTOK * DM || out_size != NTOK * DM || ws_size < WS_END) {
            fprintf(stderr, "kernel_launch: unexpected shapes: n_in %d in0 %d out %d ws %zu (need >= %zu); nothing launched\n", n_in, n_in > 0 ? in_sizes[0] : -1, out_size, ws_size, (size_t)WS_END); grid = -1; return; }
        int dev = 0, cus = 0, per_cu = 0;
        if (hipGetDevice(&dev) != hipSuccess || hipDeviceGetAttribute(&cus, hipDeviceAttributeMultiprocessorCount, dev) != hipSuccess) { fprintf(stderr, "kernel_launch: device query failed\n"); grid = -1; return; }
        if (hipFuncSetAttribute((const void*)fwd_kernel, hipFuncAttributeMaxDynamicSharedMemorySize, LDS_BYTES) != hipSuccess) { fprintf(stderr, "kernel_launch: hipFuncSetAttribute failed\n"); grid = -1; return; }
        if (hipOccupancyMaxActiveBlocksPerMultiprocessor(&per_cu, (const void*)fwd_kernel, NWAVES * 64, LDS_BYTES) != hipSuccess || per_cu < 1)
            fprintf(stderr, "kernel_launch: note: occupancy query reports %d workgroups per CU\n", per_cu);
        (void)hipGetLastError();
        grid = cus;
        if (grid != 256) { fprintf(stderr, "kernel_launch: this kernel is built for 256 CUs (got %d); nothing launched\n", grid); grid = -1; return; }
    }
    if (grid < 0) return;
    if (hipMemsetAsync((char*)d_ws + WS_CTL, 0, CTL_ZERO_BYTES, stream) != hipSuccess) { fprintf(stderr, "kernel_launch: hipMemsetAsync failed\n"); return; }
    Args a{};
    for (int i = 0; i < 21; ++i) a.in[i] = (const float*)d_in[i];
    a.out = (float*)d_out; a.ws = (unsigned char*)d_ws;
#if MK_ONE_LAUNCH
    const int cuts[2] = {0, N_PHASES}; const int nl = 1;
#else
    const int cuts[11] = {0, 1, 2, 3, 4, 5, 6, 7, 8, 9, N_PHASES}; const int nl = 10;
#endif
    for (int li = 0; li < nl; ++li) {
        a.ph_lo = cuts[li]; a.ph_hi = cuts[li + 1];
        hipLaunchKernelGGL(fwd_kernel, dim3(grid), dim3(NWAVES * 64), LDS_BYTES, stream, a);
        const hipError_t le = hipPeekAtLastError();
        if (le != hipSuccess) { fprintf(stderr, "kernel_launch: launch %d failed: %s\n", li, hipGetErrorName(le)); break; }
    }
}
```

```cpp
#include <hip/hip_runtime.h>
#include <cstdio>
#include <cstdint>

#define LAS __attribute__((address_space(3)))
#define GAS __attribute__((address_space(1)))
typedef unsigned short bf16_t;
typedef short bf16x8 __attribute__((ext_vector_type(8)));
typedef short s16x4 __attribute__((ext_vector_type(4)));
typedef short v4i16_t __attribute__((ext_vector_type(4)));
typedef float f32x2 __attribute__((ext_vector_type(2)));
typedef float f32x4 __attribute__((ext_vector_type(4)));
typedef float f32x16 __attribute__((ext_vector_type(16)));
typedef unsigned u32x2 __attribute__((ext_vector_type(2)));
typedef unsigned u32x4 __attribute__((ext_vector_type(4)));
typedef int i32x4 __attribute__((ext_vector_type(4)));
typedef int i32x8 __attribute__((ext_vector_type(8)));
typedef GAS unsigned gu32;

constexpr int NB = 32, SEQ = 2048, DM = 1024, NTOK = NB * SEQ;
constexpr int MEMLEN = 256, NMEM = NB * MEMLEN;
constexpr int PW = 3072;
constexpr int C_SQ = 0, C_SK = 512, C_SV = 1024, C_DQ = 1536, C_DK = 2048, C_DV = 2112, C_IQ = 2176, C_IK = 2432, C_IW = 2496, C_MQ = 2560;
constexpr int IN_W = 3012;
constexpr int NEXP = 32, TOPK = 4, DEXP = 1024;
constexpr int NSLOT = NTOK * TOPK;
constexpr int NSLOT_PAD = NSLOT + NEXP * 256;
constexpr float EPS = 1e-6f;
constexpr float LOG2E = 1.4426950408889634f;

constexpr size_t MiB = 1u << 20;
constexpr size_t WS_CTL = 0, CTL_ZERO_BYTES = 1 * MiB;
constexpr size_t WS_ROPE = 1 * MiB;
constexpr size_t WS_BLKCNT = 1 * MiB + 512 * 1024;
constexpr size_t WS_SLOT_TOK = 2 * MiB;
constexpr size_t WS_TOK_SLOT = 4 * MiB;
constexpr size_t WS_TOK_GATE = 5 * MiB;
constexpr size_t WS_WIN = 8 * MiB;
constexpr size_t WS_WMKV = 14 * MiB;
constexpr size_t WS_WG = 16 * MiB;
constexpr size_t WS_WB = 22 * MiB;
constexpr size_t WS_WO = 25 * MiB;
constexpr size_t WS_WEI = 27 * MiB;
constexpr size_t WS_WEO = 155 * MiB;
__device__ __forceinline__ int lane_id_fresh() { int l; asm volatile("v_mbcnt_lo_u32_b32 %0, -1, 0\n\tv_mbcnt_hi_u32_b32 %0, -1, %0" : "=v"(l)); return l; }
__device__ __forceinline__ unsigned pk4_f8(float a, float b, float c, float d) { int v = __builtin_amdgcn_cvt_pk_fp8_f32(a, b, 0, false); return (unsigned)__builtin_amdgcn_cvt_pk_fp8_f32(c, d, v, true); }
constexpr float W8_SCALE = 64.f, W8_INV = 1.f / 64.f;
constexpr size_t WS_H = 220 * MiB;
constexpr size_t WS_P = 348 * MiB;
constexpr size_t WS_O = 732 * MiB;
constexpr size_t WS_H8 = 91 * MiB;
constexpr size_t WS_H2F8 = 91 * MiB;
constexpr size_t WS_MEMN = 924 * MiB;
constexpr size_t WS_MKV = 940 * MiB;
constexpr size_t WS_Y = 220 * MiB;
constexpr size_t WS_ACT8 = 748 * MiB;
constexpr size_t WS_END = 1012 * MiB;
static_assert(WS_Y + (size_t)NSLOT_PAD * DM * 2 <= WS_ACT8 && WS_ACT8 + (size_t)NSLOT_PAD * DEXP <= WS_END, "y | act8");
static_assert(WS_SLOT_TOK + (size_t)NSLOT_PAD * 4 <= WS_TOK_SLOT && WS_TOK_GATE + (size_t)NTOK * 16 <= WS_WIN, "slot tables");

constexpr int CW_BAR = 4096;

constexpr int RING_BYTES = 151552;
constexpr int MISC_OFF = RING_BYTES;
constexpr int LDS_BYTES = 155648;
constexpr int MW_BAR = 8;
constexpr int MW_LCNT = 16;
constexpr int MW_PSTART = 64;
constexpr int MW_TSTART = 128;
constexpr int MW_BEFORE = 192;
constexpr int MW_PART = 256;

__device__ __forceinline__ unsigned f2bf(float f) { unsigned u = __builtin_bit_cast(unsigned, f); return (u + 0x7fffu + ((u >> 16) & 1u)) >> 16; }
__device__ __forceinline__ unsigned pk2(float lo, float hi) { return f2bf(lo) | (f2bf(hi) << 16); }
__device__ __forceinline__ float bf2f(unsigned short b) { return __builtin_bit_cast(float, (unsigned)b << 16); }
__device__ __forceinline__ float bflo(unsigned w) { return __builtin_bit_cast(float, w << 16); }
__device__ __forceinline__ float bfhi(unsigned w) { return __builtin_bit_cast(float, w & 0xffff0000u); }
__device__ __forceinline__ unsigned cvt_pk_bf16(float lo, float hi) { unsigned r; asm volatile("v_cvt_pk_bf16_f32 %0, %1, %2" : "=v"(r) : "v"(lo), "v"(hi)); return r; }
__device__ __forceinline__ int crow(int r, int hi) { return (r & 3) + 8 * (r >> 2) + 4 * hi; }
#define LDS_WAIT() asm volatile("s_waitcnt lgkmcnt(0)" ::: "memory")
#define VM_WAIT() asm volatile("s_waitcnt vmcnt(0)" ::: "memory")

namespace pg8 {
constexpr int BM = 256, BK = 64, HALF = 128, HTB = HALF * BK * 2, STAGE_BYTES = 8 * HTB;
__host__ __device__ __forceinline__ int lds_byte(int r, int c) { const int st = (r >> 4) * 2 + (c >> 5), rr = r & 15, cc = c & 31, ob = rr * 64 + cc * 2; return st * 1024 + (ob ^ (((ob >> 9) & 1) << 5)); }
__host__ __device__ __forceinline__ void stage_rc(int b, int& R, int& C) { const int st = b / 1024, sb = b % 1024, swz = sb ^ (((sb >> 9) & 1) << 5); R = (st >> 1) * 16 + swz / 64; C = (st & 1) * 32 + (swz % 64) / 2; }
__host__ __device__ __forceinline__ int perm32(int rho) { const int n = rho >> 4, i = rho & 15; return 8 * (i >> 2) + 4 * n + (i & 3); }
__host__ __device__ __forceinline__ int perm256b(int R) { return 64 * ((R >> 5) & 3) + 8 * ((R & 15) >> 2) + 4 * ((R >> 4) & 1) + (R & 3); }
__host__ __device__ __forceinline__ int perm256(int R) { return 64 * ((R >> 5) & 3) + 16 * ((R & 15) >> 2) + 4 * ((R >> 4) & 1) + (R & 3); }

struct Unit { int pm, pn, e; };
constexpr int EPI_NA_OFF = STAGE_BYTES;
constexpr int ROWTAB_OFF = STAGE_BYTES + 8192;
constexpr int BIASTAB_OFF = STAGE_BYTES + 10240;

template <class Epi, class Sched, bool ALIGN_EPI, bool FP8 = false>
__device__ __forceinline__ void gemm_phase(LAS unsigned char* lds, const int wave_, const int K, const Sched& S, const Epi& E) {
    constexpr bool LEAN = FP8 || Epi::KEEP_ACC;
    int tid = wave_ * 64 + lane_id_fresh();
    const int wid = __builtin_amdgcn_readfirstlane(tid >> 6), lane = tid & 63, wr = wid >> 2, wc = wid & 3, fr = lane & 15, fq = lane >> 4;
    const int nt = K / BK;
    int Rr[2], Cc[2]; unsigned voffB[2];
#pragma unroll
    for (int i = 0; i < 2; ++i) { int R, C; stage_rc(tid * 16 + i * 8192, R, C); Rr[i] = R; Cc[i] = C; const int Rb = Epi::PERM == 3 ? perm256b(R) : Epi::PERM == 2 ? perm256(R) : Epi::PERM ? ((R & ~31) + perm32(R & 31)) : R; voffB[i] = (unsigned)(Rb * K + C) * 2u; }
    const size_t kstep = (size_t)(BK * 2);
    const size_t hstepB = (size_t)(Epi::PERM == 3 ? 32 : Epi::PERM == 2 ? 8 : HALF) * K * 2;
    const unsigned ldsw = (unsigned)wid * 1024u;
    const int aoff = lds_byte(wr * 64 + fr, fq * 8), boff = lds_byte(wc * 32 + fr, fq * 8);
#define PG8_SA(b, h) (((b) * 2 + (h)) * HTB)
#define PG8_SB(b, h) ((4 + (b) * 2 + (h)) * HTB)
#define PG8_STAGE(bufoff, gbase, voff) do { _Pragma("unroll") for (int _i = 0; _i < 2; ++_i) { unsigned o_ = (voff)[_i]; asm volatile("" : "+v"(o_)); \
        __builtin_amdgcn_global_load_lds((const unsigned*)((const char*)(gbase) + o_), (LAS unsigned*)(lds + (bufoff) + ldsw + _i * 8192), 16, 0, 0); } } while (0)
#define PG8_J8(x, y) __builtin_shufflevector(x, y, 0, 1, 2, 3, 4, 5, 6, 7)
#define PG8_LDA(dst, b, h) do { _Pragma("unroll") for (int m = 0; m < 4; ++m) { const LAS unsigned char* p_ = lds + PG8_SA(b, h) + aoff + m * 2048; \
        if constexpr (FP8) dst##8[m] = PG8_J8(*(const LAS i32x4*)p_, *(const LAS i32x4*)(p_ + 1024)); else { dst[m][0] = *(const LAS bf16x8*)p_; dst[m][1] = *(const LAS bf16x8*)(p_ + 1024); } } } while (0)
#define PG8_LDB(dst, b, h) do { _Pragma("unroll") for (int n = 0; n < 2; ++n) { const LAS unsigned char* p_ = lds + PG8_SB(b, h) + boff + n * 2048; \
        if constexpr (FP8) dst##8[n] = PG8_J8(*(const LAS i32x4*)p_, *(const LAS i32x4*)(p_ + 1024)); else { dst[n][0] = *(const LAS bf16x8*)p_; dst[n][1] = *(const LAS bf16x8*)(p_ + 1024); } } } while (0)
#define PG8_MMA(ai, bj, At, Bt) do { __builtin_amdgcn_s_setprio(1); _Pragma("unroll") for (int m = 0; m < 4; ++m) _Pragma("unroll") for (int n = 0; n < 2; ++n) { \
        if constexpr (FP8) acc[ai][bj][m][n] = __builtin_amdgcn_mfma_scale_f32_16x16x128_f8f6f4(Bt##8[n], At##8[m], acc[ai][bj][m][n], 0, 0, 0, 0, 0, 0); \
        else { _Pragma("unroll") for (int k = 0; k < 2; ++k) acc[ai][bj][m][n] = __builtin_amdgcn_mfma_f32_16x16x32_bf16(Bt[n][k], At[m][k], acc[ai][bj][m][n], 0, 0, 0); } } \
        __builtin_amdgcn_s_setprio(0); } while (0)
#define PG8_WAIT_V(n) asm volatile("s_waitcnt vmcnt(" #n ")" ::: "memory")
#define PG8_WAIT_VR do { if (!(t == 0 && ui > 0)) PG8_WAIT_V(8); } while (0)
#define PG8_WAIT_L(n) asm volatile("s_waitcnt lgkmcnt(" #n ")" ::: "memory")
#define PG8_BAR __builtin_amdgcn_s_barrier()
#define PG8_SCHED __builtin_amdgcn_sched_barrier(0)
#define PG8_TIDQ() (wave_ * 64 + lane_id_fresh())
#define PG8_SIDE(gptr, off) __builtin_amdgcn_global_load_lds((const unsigned*)(gptr), (LAS unsigned*)(lds + (off)), 16, 0, 0)
    Unit cur, nxt, nx2; int ui = 0;
    if (!S.next(0, cur)) return;
    { const int ns = S.stagger();
      for (int q = 0; q < ns; ++q) __builtin_amdgcn_s_sleep(4); }
    bool has_next = S.next(1, nxt);
    if (S.gather()) { if (wid == 0) { PG8_SIDE(S.row_table(cur) + 4 * lane, ROWTAB_OFF); if (has_next) PG8_SIDE(S.row_table(nxt) + 4 * lane, ROWTAB_OFF + 1024); }
        PG8_WAIT_V(0); PG8_BAR; }
    f32x4 acc[2][2][4][2];
    bf16x8 At[4][2], B0[2][2], B1[2][2]; i32x8 At8[4], B08[2], B18[2];
    const char* Ab = S.a_base();
    unsigned ca0[2], ca1[2], na0[2], na1[2];
#pragma unroll
    for (int i = 0; i < 2; ++i) { ca0[i] = S.a_off(cur, Rr[i], Cc[i], (const LAS int*)(lds + ROWTAB_OFF)); ca1[i] = S.a_off(cur, HALF + Rr[i], Cc[i], (const LAS int*)(lds + ROWTAB_OFF)); }
    const char* cB = S.b_tile(cur);
    PG8_STAGE(PG8_SB(0, 0), cB, voffB); PG8_STAGE(PG8_SB(0, 1), cB + hstepB, voffB); PG8_STAGE(PG8_SA(0, 0), Ab, ca0); PG8_STAGE(PG8_SA(0, 1), Ab, ca1);
    if (wr == 1) PG8_BAR;
    PG8_WAIT_V(2); PG8_BAR;
    PG8_STAGE(PG8_SB(1, 0), cB + kstep, voffB); PG8_STAGE(PG8_SA(1, 0), Ab + kstep, ca0); PG8_STAGE(PG8_SB(1, 1), cB + hstepB + kstep, voffB);
    PG8_WAIT_V(6); PG8_BAR;
#ifdef PROBE_T
    unsigned long long tq_acc = 0, tq0 = 0;
#define TQ_BEGIN(k) do { if (PROBE_T == (k)) tq0 = __builtin_amdgcn_s_memtime(); } while (0)
#define TQ_END(k) do { if (PROBE_T == (k)) tq_acc += __builtin_amdgcn_s_memtime() - tq0; } while (0)
#else
#define TQ_BEGIN(k)
#define TQ_END(k)
#endif
    for (;;) {
        TQ_BEGIN(4);
        const bool has_nx2 = has_next && S.next(ui + 2, nx2);
        const char* nB = cB;
#pragma unroll
        for (int i = 0; i < 2; ++i) { na0[i] = ca0[i]; na1[i] = ca1[i]; }
        if (has_next) { nB = S.b_tile(nxt); const LAS int* tab = (const LAS int*)(lds + ROWTAB_OFF + ((ui + 1) & 1) * 1024);
#pragma unroll
            for (int i = 0; i < 2; ++i) { int R, C; int tq = tid; if constexpr (LEAN) tq = PG8_TIDQ();
                stage_rc(tq * 16 + i * 8192, R, C);
                na0[i] = S.a_off(nxt, R, C, tab); na1[i] = S.a_off(nxt, HALF + R, C, tab); } }
#define PG8_NAST(v) const unsigned v = (unsigned)(EPI_NA_OFF + PG8_TIDQ() * 16)
        if constexpr (LEAN) { PG8_NAST(nast); *(LAS u32x4*)(lds + nast) = (u32x4){na0[0], na0[1], na1[0], na1[1]}; }
        if (S.gather()) { PG8_WAIT_L(0);
            if (wid == 0 && has_nx2) PG8_SIDE(S.row_table(nx2) + 4 * lane_id_fresh(), ROWTAB_OFF + (ui & 1) * 1024); }
        if constexpr (Epi::HAS_BIAS) { if (wid == 1) PG8_SIDE(E.bias_src(cur, lane_id_fresh()), BIASTAB_OFF + (ui & 1) * 1024); }
        if (!(Epi::KEEP_ACC && cur.e != 0))
#pragma unroll
        for (int a = 0; a < 2; ++a)
#pragma unroll
            for (int b = 0; b < 2; ++b)
#pragma unroll
                for (int m = 0; m < 4; ++m)
#pragma unroll
                    for (int n = 0; n < 2; ++n) acc[a][b][m][n] = (f32x4){0.f, 0.f, 0.f, 0.f};
        TQ_END(4); TQ_BEGIN(1);
#pragma unroll 1
        for (int t = 0; t < nt; t += 2) {
            if (t == 0) TQ_BEGIN(5); if (t == 2) { TQ_END(5); TQ_BEGIN(6); }
            const bool last = (t == nt - 2);
            const char* a1 = Ab + (size_t)(t + 1) * kstep;
            const char* a2 = last ? Ab : Ab + (size_t)(t + 2) * kstep; const char* b2 = last ? nB : cB + (size_t)(t + 2) * kstep;
            const char* a3 = a2 + kstep; const char* b3 = b2 + kstep;
            if constexpr (LEAN) { asm volatile("" : "+s"(a1), "+s"(a2), "+s"(b2), "+s"(a3), "+s"(b3)); }
            unsigned o20[2], o21[2];
#pragma unroll
            for (int i = 0; i < 2; ++i) { o20[i] = last ? na0[i] : ca0[i]; o21[i] = last ? na1[i] : ca1[i]; }
            if constexpr (LEAN) { if (last) { PG8_NAST(nast); const u32x4 nv = *(const LAS u32x4*)(lds + nast); o20[0] = nv.x; o20[1] = nv.y; o21[0] = nv.z; o21[1] = nv.w; } }
            PG8_LDB(B0, 0, 0); PG8_LDB(B1, 0, 1); PG8_SCHED; PG8_LDA(At, 0, 0); PG8_STAGE(PG8_SA(1, 1), a1, ca1);
            PG8_WAIT_VR; PG8_WAIT_L(0); PG8_BAR; PG8_MMA(0, 0, At, B0); PG8_MMA(0, 1, At, B1); PG8_BAR; PG8_SCHED;
            PG8_LDA(At, 0, 1); PG8_STAGE(PG8_SB(0, 0), b2, voffB); PG8_STAGE(PG8_SB(0, 1), b2 + hstepB, voffB); PG8_STAGE(PG8_SA(0, 0), a2, o20);
            PG8_WAIT_VR; PG8_WAIT_L(0); PG8_BAR; PG8_MMA(1, 0, At, B0); PG8_MMA(1, 1, At, B1); PG8_BAR; PG8_SCHED;
            PG8_LDB(B0, 1, 0); PG8_LDB(B1, 1, 1); PG8_SCHED; PG8_LDA(At, 1, 0); PG8_STAGE(PG8_SA(0, 1), a2, o21);
            PG8_WAIT_VR; PG8_WAIT_L(0); PG8_BAR; PG8_MMA(0, 0, At, B0); PG8_MMA(0, 1, At, B1); PG8_BAR; PG8_SCHED;
            PG8_LDA(At, 1, 1); PG8_STAGE(PG8_SB(1, 0), b3, voffB); PG8_STAGE(PG8_SB(1, 1), b3 + hstepB, voffB); PG8_STAGE(PG8_SA(1, 0), a3, o20);
            PG8_WAIT_V(8); PG8_WAIT_L(0); PG8_BAR; PG8_MMA(1, 0, At, B0); PG8_MMA(1, 1, At, B1); PG8_BAR; PG8_SCHED;
        }
        TQ_END(6); TQ_END(1); TQ_BEGIN(2);
        PG8_WAIT_V(0);
        if constexpr (ALIGN_EPI) { if (wr == 0) PG8_BAR; }
        TQ_END(2); TQ_BEGIN(3);
        { const LAS float* bt = (const LAS float*)(lds + BIASTAB_OFF + (ui & 1) * 1024);
          if constexpr (LEAN) { const int lq = lane_id_fresh();
              E(acc, cur, wr, wc, lq & 15, (lq >> 4) & 3, bt); }
          else E(acc, cur, wr, wc, fr, fq, bt); }
        TQ_END(3);
        if (!has_next) break;
        cur = nxt; nxt = nx2; has_next = has_nx2; cB = nB; ++ui;
#pragma unroll
        for (int i = 0; i < 2; ++i) { ca0[i] = na0[i]; ca1[i] = na1[i]; }
        if constexpr (LEAN) { PG8_NAST(nast); const u32x4 nv = *(const LAS u32x4*)(lds + nast); ca0[0] = nv.x; ca0[1] = nv.y; ca1[0] = nv.z; ca1[1] = nv.w; }
        if constexpr (ALIGN_EPI) { if (wr == 1) PG8_BAR; }
    }
    PG8_WAIT_V(0);
    if constexpr (!ALIGN_EPI) { if (wr == 0) PG8_BAR; }
    PG8_BAR;
#ifdef PROBE_T
    if (S.tprobe()) { const unsigned long long r1 = __builtin_amdgcn_s_memrealtime();
        while (__builtin_amdgcn_s_memrealtime() - r1 < tq_acc * 4ull * 10ull / 175ull) __builtin_amdgcn_s_sleep(8); }
#endif
#undef PG8_SA
#undef PG8_SB
#undef PG8_STAGE
#undef PG8_LDA
#undef PG8_LDB
#undef PG8_MMA
#undef PG8_NAST
#undef PG8_J8
#undef PG8_WAIT_V
#undef PG8_WAIT_VR
#undef PG8_WAIT_L
#undef PG8_BAR
#undef PG8_SCHED
#undef PG8_TIDQ
#undef PG8_SIDE
}

struct DenseSched {
    const char* A; const char* Bt; int K, nM, nN, nwg, G, c, stag = 0, amask = -1, tp = 0;
    __device__ __forceinline__ void init(const void* A_, const void* Bt_, int M, int N, int K_, int G_, int c_) { A = (const char*)A_; Bt = (const char*)Bt_; K = K_; nM = M / BM; nN = N / BM; nwg = nM * nN; G = G_; c = c_; }
    __device__ __forceinline__ bool next(int i, Unit& u) const {
        const long L = (long)i * G + c; if (L >= nwg) return false;
        int wgid = (int)L; { const int q = nwg / 8, r = nwg % 8, xcd = wgid % 8, off = wgid / 8; wgid = (xcd < r ? xcd * (q + 1) : r * (q + 1) + (xcd - r) * q) + off; }
        const int nig = 8 * nN, gid = wgid / nig, fm = gid * 8, gsz = (nM - fm) < 8 ? (nM - fm) : 8;
        u.pm = fm + ((wgid % nig) % gsz); u.pn = (wgid % nig) / gsz; u.e = 0; return true;
    }
    __device__ __forceinline__ const char* a_base() const { return A; }
    __device__ __forceinline__ int stagger() const { return stag ? ((c >> 3) & 7) * (K / 55) : 0; }
    __device__ __forceinline__ int tprobe() const { return tp; }
    __device__ __forceinline__ bool gather() const { return false; }
    __device__ __forceinline__ const int* row_table(const Unit&) const { return nullptr; }
    __device__ __forceinline__ unsigned a_off(const Unit& u, int row, int col, const LAS int* = nullptr) const { return (unsigned)(((size_t)((u.pm * BM + row) & amask) * K + col) * 2); }
    __device__ __forceinline__ int a_row(const Unit& u, int row) const { return (u.pm * BM + row) & amask; }
    __device__ __forceinline__ unsigned row_off(int r, int col) const { return (unsigned)(((size_t)r * K + col) * 2); }
    __device__ __forceinline__ const char* b_tile(const Unit& u) const { return Bt + (size_t)u.pn * BM * K * 2; }
};
}

namespace pg8 {
struct MoeSched {
    const char* A; const char* Bt; const int* slot_tok; volatile LAS unsigned* tstart; int K, rowsE, nN, c, stag = 0, tp = 0;
    __device__ __forceinline__ bool next(int i, Unit& u) const {
        const int x = c & 7, j = c >> 3, rpr = 32 / nN;
        const int pm = (i * 8 + x) * rpr + j / nN;
        const int l = lane_id_fresh(); const int tv = (int)tstart[l < 32 ? l : 32];
        const int T = __builtin_amdgcn_readlane(tv, 32);
        if (pm >= T) return false;
        const unsigned long long bal = __ballot(l >= 1 && l < 32 && tv <= pm);
        u.pm = pm; u.pn = j % nN; u.e = (int)__builtin_popcountll(bal); return true;
    }
    __device__ __forceinline__ const char* a_base() const { return A; }
    __device__ __forceinline__ int stagger() const { const int g = (c >> 3) / nN, ng = 32 / nN; return stag * g / ng; }
    __device__ __forceinline__ int tprobe() const { return tp; }
    __device__ __forceinline__ bool gather() const { return slot_tok != nullptr; }
    __device__ __forceinline__ const int* row_table(const Unit& u) const { return slot_tok + u.pm * BM; }
    __device__ __forceinline__ unsigned a_off(const Unit& u, int row, int col, const LAS int* tab) const {
        const int r = slot_tok ? tab[row] : u.pm * BM + row;
        return (unsigned)(((size_t)r * K + col) * 2);
    }
    __device__ __forceinline__ const char* b_tile(const Unit& u) const { return Bt + ((size_t)u.e * rowsE + (size_t)u.pn * BM) * K * 2; }
};

struct MergeSched {
    const char* A; const char* Bt; int nM, nN, nwg, G, c, tp = 0, stag = 0;
    __device__ __forceinline__ void init(const void* A_, const void* Bt_, int M, int N, int G_, int c_) { A = (const char*)A_; Bt = (const char*)Bt_; nM = M / BM; nN = N / BM; nwg = nM * nN; G = G_; c = c_; }
    __device__ __forceinline__ bool next(int i, Unit& u) const {
        const int r = i / 3; const long L = (long)r * G + c; if (L >= nwg) return false;
        int wgid = (int)L; { const int q = nwg / 8, rr = nwg % 8, xcd = wgid % 8, off = wgid / 8; wgid = (xcd < rr ? xcd * (q + 1) : rr * (q + 1) + (xcd - rr) * q) + off; }
        const int nig = 8 * nN, gid = wgid / nig, fm = gid * 8, gsz = (nM - fm) < 8 ? (nM - fm) : 8;
        u.pm = fm + ((wgid % nig) % gsz); u.pn = (wgid % nig) / gsz; u.e = i - 3 * r; return true;
    }
    __device__ __forceinline__ const char* a_base() const { return A; }
    __device__ __forceinline__ int stagger() const { return ((c >> 3) & 1) ? stag : 0; }
    __device__ __forceinline__ int tprobe() const { return tp; }
    __device__ __forceinline__ bool gather() const { return false; }
    __device__ __forceinline__ const int* row_table(const Unit&) const { return nullptr; }
    __device__ __forceinline__ unsigned a_off(const Unit& u, int row, int col, const LAS int* = nullptr) const { return (unsigned)(((size_t)(u.pm * BM + row) * 512 + col) * 2 + (size_t)u.e * ((size_t)NTOK * 512 * 2)); }
    __device__ __forceinline__ const char* b_tile(const Unit& u) const { return Bt + ((size_t)u.e * DM + (size_t)u.pn * BM) * 512 * 2; }
};

template <int ACT> struct EpiBf16 {
    static constexpr int PERM = 2; static constexpr bool HAS_BIAS = false, KEEP_ACC = false;
    bf16_t* O; int ldc; const float* bias; int rowmask = -1;
    __device__ __forceinline__ const float* bias_src(const Unit&, int) const { return nullptr; }
    __device__ __forceinline__ void operator()(const f32x4 (&acc)[2][2][4][2], const Unit& u, int wr, int wc, int fr, int fq, const LAS float*) const {
        const int row0 = u.pm * BM + wr * 64 + fr; const int col0 = u.pn * BM + wc * 64 + 16 * fq;
#pragma unroll
        for (int ai = 0; ai < 2; ++ai)
#pragma unroll
            for (int m = 0; m < 4; ++m) { bf16_t* rowp = O + (size_t)((row0 + ai * HALF + m * 16) & rowmask) * ldc + col0;
#pragma unroll
                for (int bj = 0; bj < 2; ++bj) { const f32x4 v0 = acc[ai][bj][m][0], v1 = acc[ai][bj][m][1];
                    u32x4 w; w.x = cvt_pk_bf16(v0[0], v0[1]); w.y = cvt_pk_bf16(v0[2], v0[3]); w.z = cvt_pk_bf16(v1[0], v1[1]); w.w = cvt_pk_bf16(v1[2], v1[3]);
                    *(u32x4*)(rowp + 8 * bj) = w; } }
    }
};
struct EpiGateU8 {
    static constexpr int PERM = 2; static constexpr bool HAS_BIAS = true, KEEP_ACC = false;
    unsigned char* G; const float* bias;
    __device__ __forceinline__ const float* bias_src(const Unit& u, int l) const { return bias + u.pn * BM + 4 * l; }
    __device__ __forceinline__ void operator()(const f32x4 (&acc)[2][2][4][2], const Unit& u, int wr, int wc, int fr, int fq, const LAS float* bt) const {
        const int row0 = u.pm * BM + wr * 64 + fr; const int cw = wc * 64 + 16 * fq;
        f32x4 bv[2][2];
#pragma unroll
        for (int bj = 0; bj < 2; ++bj)
#pragma unroll
            for (int n = 0; n < 2; ++n) bv[bj][n] = *(const LAS f32x4*)(bt + cw + 8 * bj + 4 * n);
#pragma unroll
        for (int ai = 0; ai < 2; ++ai)
#pragma unroll
            for (int m = 0; m < 4; ++m) { unsigned char* rowp = G + (size_t)(row0 + ai * HALF + m * 16) * PW + u.pn * BM + cw;
                unsigned pk[4];
#pragma unroll
                for (int bj = 0; bj < 2; ++bj)
#pragma unroll
                    for (int n = 0; n < 2; ++n) { const f32x4 v = acc[ai][bj][m][n] * W8_INV + bv[bj][n]; unsigned q[4];
#pragma unroll
                        for (int j = 0; j < 4; j += 2) {
                            const f32x2 ea = (f32x2){v[j], v[j + 1]} * (-LOG2E);
                            const f32x2 d = (f32x2){__builtin_amdgcn_exp2f(ea[0]), __builtin_amdgcn_exp2f(ea[1])} + 1.f;
                            const f32x2 qf = (f32x2){__builtin_amdgcn_rcpf(d[0]), __builtin_amdgcn_rcpf(d[1])} * 254.f + 1.5f;
                            q[j] = (unsigned)qf[0]; q[j + 1] = (unsigned)qf[1]; }
                        pk[2 * bj + n] = q[0] | (q[1] << 8) | (q[2] << 16) | (q[3] << 24); }
                u32x4 w; w.x = pk[0]; w.y = pk[1]; w.z = pk[2]; w.w = pk[3];
                *(u32x4*)rowp = w; }
    }
};
struct EpiY8 {
    static constexpr int PERM = 2; static constexpr bool HAS_BIAS = true, KEEP_ACC = false;
    unsigned char* Y; const float* bias; int nostore = 0;
    __device__ __forceinline__ const float* bias_src(const Unit& u, int l) const { return bias + u.e * DM + u.pn * BM + 4 * l; }
    __device__ __forceinline__ void operator()(const f32x4 (&acc)[2][2][4][2], const Unit& u, int wr, int wc, int fr, int fq, const LAS float* bt) const {
        const int row0 = u.pm * BM + wr * 64 + fr; const int cw = wc * 64 + 16 * fq;
        f32x4 bv[2][2];
#pragma unroll
        for (int bj = 0; bj < 2; ++bj)
#pragma unroll
            for (int n = 0; n < 2; ++n) bv[bj][n] = *(const LAS f32x4*)(bt + cw + 8 * bj + 4 * n);
#pragma unroll
        for (int ai = 0; ai < 2; ++ai)
#pragma unroll
            for (int m = 0; m < 4; ++m) { unsigned char* rowp = Y + (size_t)(row0 + ai * HALF + m * 16) * DM + u.pn * BM + cw;
                u32x4 w; unsigned pk[4];
#pragma unroll
                for (int bj = 0; bj < 2; ++bj)
#pragma unroll
                    for (int n = 0; n < 2; ++n) { const f32x4 v = acc[ai][bj][m][n] * W8_INV + bv[bj][n]; pk[2 * bj + n] = pk4_f8(v[0], v[1], v[2], v[3]); }
                w.x = pk[0]; w.y = pk[1]; w.z = pk[2]; w.w = pk[3];
                if (!nostore) *(u32x4*)rowp = w; }
    }
};
struct EpiMerge {
    static constexpr int PERM = 2; static constexpr bool HAS_BIAS = false, KEEP_ACC = true;
    __device__ __forceinline__ const float* bias_src(const Unit&, int) const { return nullptr; }
    const unsigned char* G; bf16_t* Mg;
    __device__ __forceinline__ void operator()(f32x4 (&acc)[2][2][4][2], const Unit& u, int wr, int wc, int fr, int fq, const LAS float*) const {
        const int row0 = u.pm * BM + wr * 64 + fr; const int col0 = u.pn * BM + wc * 64 + 16 * fq;
        const unsigned char* g0p = G + (size_t)row0 * PW + u.e * DM + col0;
        if (u.e < 2) {
#pragma unroll
            for (int ai = 0; ai < 2; ++ai) {
                u32x4 ga[4], gb[4];
#pragma unroll
                for (int m = 0; m < 4; ++m) { ga[m] = *(const u32x4*)(g0p + (size_t)(ai * HALF + m * 16) * PW); gb[m] = *(const u32x4*)(g0p + DM + (size_t)(ai * HALF + m * 16) * PW); }
#pragma unroll
                for (int m = 0; m < 4; ++m)
#pragma unroll
                    for (int bj = 0; bj < 2; ++bj)
#pragma unroll
                        for (int n = 0; n < 2; ++n) { const unsigned a = ga[m][2 * bj + n], b = gb[m][2 * bj + n];
#pragma unroll
                            for (int q = 0; q < 4; ++q) acc[ai][bj][m][n][q] *= (float)((a >> (8 * q)) & 0xffu) * __builtin_amdgcn_rcpf((float)((b >> (8 * q)) & 0xffu)); }
                __builtin_amdgcn_sched_barrier(0); }
        } else {
#pragma unroll
            for (int ai = 0; ai < 2; ++ai) { u32x4 ga[4];
#pragma unroll
                for (int m = 0; m < 4; ++m) ga[m] = *(const u32x4*)(g0p + (size_t)(ai * HALF + m * 16) * PW);
#pragma unroll
                for (int m = 0; m < 4; ++m) { bf16_t* op = Mg + (size_t)(row0 + ai * HALF + m * 16) * DM + col0;
#pragma unroll
                    for (int bj = 0; bj < 2; ++bj) { float v[8];
#pragma unroll
                        for (int n = 0; n < 2; ++n) { const unsigned a = ga[m][2 * bj + n];
#pragma unroll
                            for (int q = 0; q < 4; ++q) v[4 * n + q] = acc[ai][bj][m][n][q] * ((float)((a >> (8 * q)) & 0xffu) * (1.f / 255.f)); }
                        u32x4 w; w.x = cvt_pk_bf16(v[0], v[1]); w.y = cvt_pk_bf16(v[2], v[3]); w.z = cvt_pk_bf16(v[4], v[5]); w.w = cvt_pk_bf16(v[6], v[7]);
                        *(u32x4*)(op + 8 * bj) = w; } }
                __builtin_amdgcn_sched_barrier(0); }
        }
    }
};
struct EpiResid {
    static constexpr int PERM = 2; static constexpr bool HAS_BIAS = false, KEEP_ACC = false;
    __device__ __forceinline__ const float* bias_src(const Unit&, int) const { return nullptr; }
    const float* base; bf16_t* out;
    __device__ __forceinline__ void operator()(const f32x4 (&acc)[2][2][4][2], const Unit& u, int wr, int wc, int fr, int fq, const LAS float*) const {
        const int row0 = u.pm * BM + wr * 64 + fr; const int col0 = u.pn * BM + wc * 64 + 16 * fq;
#pragma unroll
        for (int ai = 0; ai < 2; ++ai)
#pragma unroll
            for (int m = 0; m < 4; ++m) { const size_t r = (size_t)(row0 + ai * HALF + m * 16); const float* xb = base + r * DM + col0;
                bf16_t* ob = out + r * 2048 + (r & 1) * 1024 + col0;
#pragma unroll
                for (int bj = 0; bj < 2; ++bj) { const f32x4 v0 = *(const f32x4*)(xb + 8 * bj) + acc[ai][bj][m][0], v1 = *(const f32x4*)(xb + 8 * bj + 4) + acc[ai][bj][m][1];
                    u32x4 w; w.x = cvt_pk_bf16(v0[0], v0[1]); w.y = cvt_pk_bf16(v0[2], v0[3]); w.z = cvt_pk_bf16(v1[0], v1[1]); w.w = cvt_pk_bf16(v1[2], v1[3]);
                    *(u32x4*)(ob + 8 * bj) = w; } }
    }
};
struct EpiSwiglu {
    static constexpr int PERM = 1; static constexpr bool HAS_BIAS = true, KEEP_ACC = false;
    unsigned char* act; const float* bias;
    __device__ __forceinline__ const float* bias_src(const Unit& u, int l) const { return bias + (size_t)u.e * 2048 + (l >> 5) * 1024 + u.pn * HALF + 4 * (l & 31); }
    __device__ __forceinline__ void operator()(const f32x4 (&acc)[2][2][4][2], const Unit& u, int wr, int wc, int fr, int fq, const LAS float* bt) const {
        const int row0 = u.pm * BM + wr * 64 + fr; const int col0 = u.pn * HALF + wc * 32 + 8 * (fq & 2);
        f32x4 bg[2], bu[2];
#pragma unroll
        for (int n = 0; n < 2; ++n) { bg[n] = *(const LAS f32x4*)(bt + wc * 32 + 8 * fq + 4 * n); bu[n] = *(const LAS f32x4*)(bt + HALF + wc * 32 + 8 * fq + 4 * n); }
#pragma unroll
        for (int ai = 0; ai < 2; ++ai)
#pragma unroll
            for (int mp = 0; mp < 2; ++mp) { u32x2 w[2];
#pragma unroll
                for (int mm = 0; mm < 2; ++mm) { const int m = 2 * mp + mm; float o[8];
#pragma unroll
                    for (int n = 0; n < 2; ++n) { const f32x4 gv = acc[ai][0][m][n] * W8_INV + bg[n], uv = acc[ai][1][m][n] * W8_INV + bu[n];
#pragma unroll
                        for (int q = 0; q < 4; q += 2) {
                            const f32x2 g = {fminf(gv[q], 7.0f), fminf(gv[q + 1], 7.0f)};
                            const f32x2 uu = {__builtin_amdgcn_fmed3f(uv[q], -7.0f, 7.0f), __builtin_amdgcn_fmed3f(uv[q + 1], -7.0f, 7.0f)};
                            const f32x2 ea = g * (-1.702f * LOG2E);
                            const f32x2 d = (f32x2){__builtin_amdgcn_exp2f(ea[0]), __builtin_amdgcn_exp2f(ea[1])} + 1.f;
                            const f32x2 gr = g * (f32x2){__builtin_amdgcn_rcpf(d[0]), __builtin_amdgcn_rcpf(d[1])};
                            const f32x2 r = uu * gr + gr;
                            o[4 * n + q] = r[0]; o[4 * n + q + 1] = r[1]; } }
                    w[mm].x = pk4_f8(o[0], o[1], o[2], o[3]); w[mm].y = pk4_f8(o[4], o[5], o[6], o[7]); }
                const auto sx = __builtin_amdgcn_permlane16_swap(w[0].x, w[1].x, false, false), sy = __builtin_amdgcn_permlane16_swap(w[0].y, w[1].y, false, false);
                unsigned char* rowp = act + (size_t)(row0 + ai * HALF + (2 * mp + (fq & 1)) * 16) * DEXP + col0;
                *(u32x4*)rowp = (u32x4){sx[0], sy[0], sx[1], sy[1]}; }
    }
};
}

#define XB_TMO      128
#define XB_XCNT(j)  (256  + 64 * (j))
#define XB_XSUB(j)  (1280 + 64 * (j))
#define XB_XGEN(j)  (2304 + 64 * (j))
#define XB_TOP      3328
#define XB_TOPGEN   3392
#define XCD_BAR_WORDS 3456
#define XB_SPIN_CAP (1u << 18)

__device__ __forceinline__ unsigned xb_ld(unsigned* p)              { return __hip_atomic_load(p, __ATOMIC_RELAXED, __HIP_MEMORY_SCOPE_AGENT); }
__device__ __forceinline__ unsigned xb_add(unsigned* p, unsigned v) { return __hip_atomic_fetch_add(p, v, __ATOMIC_RELAXED, __HIP_MEMORY_SCOPE_AGENT); }
__device__ __forceinline__ unsigned xb_xcc_id() { return (unsigned)__builtin_amdgcn_s_getreg((3 << 11) | 20) & 0xFu; }
#define XB_SPIN(cond, bar) do { unsigned _sp = 0; while (cond) { __builtin_amdgcn_s_sleep(1); \
    if ((++_sp & 255u) == 0u) { if (xb_ld(&(bar)[XB_TMO])) break; if (_sp > XB_SPIN_CAP) { atomicAdd(&(bar)[XB_TMO], 1u); break; } } } } while (0)

struct XcdBarrier {
    unsigned* bar; unsigned x; int wave;
    volatile LAS unsigned* st;
};

__device__ __forceinline__ XcdBarrier xcd_barrier_post(unsigned* bar, volatile LAS unsigned* st) {
    XcdBarrier b; b.bar = bar; b.x = xb_xcc_id(); b.st = st; b.wave = __builtin_amdgcn_readfirstlane((int)(threadIdx.x >> 6));
    if (threadIdx.x == 0) (void)xb_add(&bar[XB_XCNT(b.x)], 1u);
    return b;
}
__device__ __forceinline__ void xcd_barrier_complete(unsigned* bar, unsigned x, unsigned& nloc, unsigned& nx) {
    const unsigned G = gridDim.x * gridDim.y * gridDim.z;
    unsigned sum, cnt, mine, sp = 0u;
    for (;;) {
        sum = 0u; cnt = 0u; mine = 0u;
#pragma unroll
        for (unsigned j = 0; j < 16; ++j) { const unsigned c = xb_ld(&bar[XB_XCNT(j)]); sum += c; cnt += (c > 0u) ? 1u : 0u; mine = (j == x) ? c : mine; }
        if (sum == G) break;
        __builtin_amdgcn_s_sleep(1);
        if ((++sp & 255u) == 0u) { if (xb_ld(&bar[XB_TMO])) break; if (sp > XB_SPIN_CAP) { atomicAdd(&bar[XB_TMO], 1u); break; } }
    }
    nloc = mine > 0u ? mine : 1u; nx = cnt > 0u ? cnt : 1u;
}

__device__ __forceinline__ void xcd_barrier(const XcdBarrier& b) {
    asm volatile("s_waitcnt vmcnt(0)" ::: "memory");
    __syncthreads();
    if (b.wave == 0 && lane_id_fresh() == 0) {
        unsigned* bar = b.bar;
        __builtin_amdgcn_s_waitcnt(0);
        unsigned nloc = b.st[0], nx = b.st[1];
        if (nloc == 0u) { xcd_barrier_complete(bar, b.x, nloc, nx); b.st[0] = nloc; b.st[1] = nx; }
        const unsigned old = xb_add(&bar[XB_XSUB(b.x)], 1u);
        const unsigned gen = old / nloc;
        if (old + 1u == (gen + 1u) * nloc) {
            __builtin_amdgcn_fence(__ATOMIC_RELEASE, "agent");
            asm volatile("s_waitcnt vmcnt(0)" ::: "memory");
            const unsigned og = xb_add(&bar[XB_TOP], 1u);
            const unsigned tg = og / nx;
            if (og + 1u == (tg + 1u) * nx) xb_add(&bar[XB_TOPGEN], 1u);
            else XB_SPIN(xb_ld(&bar[XB_TOPGEN]) == tg, bar);
            __builtin_amdgcn_fence(__ATOMIC_ACQUIRE, "agent");
            xb_add(&bar[XB_XGEN(b.x)], 1u);
            asm volatile("s_waitcnt vmcnt(0)" ::: "memory");
        } else {
            XB_SPIN(xb_ld(&bar[XB_XGEN(b.x)]) == gen, bar);
            __builtin_amdgcn_fence(__ATOMIC_ACQUIRE, "agent");
            asm volatile("s_waitcnt vmcnt(0)" ::: "memory");
        }
    }
    __syncthreads();
}

constexpr int NWAVES = 8;
struct Frame {
    LAS unsigned char* lds;
    volatile LAS unsigned* MISC;
    gu32* ctl;
    int tid, lane, wave, G, blk;
    const float* in[21];
    float* out; unsigned char* ws;
};
__device__ __forceinline__ float wave_sum(float v) {
#pragma unroll
    for (int o = 1; o < 64; o <<= 1) v += __shfl_xor(v, o);
    return v;
}

__device__ __forceinline__ int map_src(int mode, int n) {
    if (mode == 1) return n < 2500 ? n : (n >= C_MQ ? n - (C_MQ - 2500) : -1);
    if (mode == 2) { const int pn = n >> 8, bj = (n >> 7) & 1, j = n & 127; return bj * 1024 + pn * 128 + j; }
    return n;
}
__device__ __forceinline__ void transpose_item(const float* W, int K, int Nsrc, int Ndst, bf16_t* WT, int mode, LAS float* scr, int item, int lane) {
    const int nblk = Ndst / 32, kb = item / nblk, nb = item % nblk, k0 = 64 * kb, n0 = 32 * nb;
    const int sc = map_src(mode, n0 + (lane & 31));
    const float scale = (mode == 1 && (n0 + (lane & 31)) < 512) ? 0.125f * LOG2E : 1.0f;
#pragma unroll
    for (int i = 0; i < 32; ++i) { const int kk = 2 * i + (lane >> 5); scr[kk * 33 + (lane & 31)] = sc >= 0 ? W[(size_t)(k0 + kk) * Nsrc + sc] * scale : 0.f; }
    LDS_WAIT(); asm volatile("" ::: "memory");
    const int c = lane & 7;
#pragma unroll
    for (int j = 0; j < 4; ++j) { const int n = (lane >> 3) + 8 * j; const LAS float* s = scr + (8 * c) * 33 + n;
        u32x4 o; o.x = pk2(s[0 * 33], s[1 * 33]); o.y = pk2(s[2 * 33], s[3 * 33]); o.z = pk2(s[4 * 33], s[5 * 33]); o.w = pk2(s[6 * 33], s[7 * 33]);
        *(GAS u32x4*)(WT + (size_t)(n0 + n) * K + k0 + 8 * c) = o; }
    LDS_WAIT(); asm volatile("" ::: "memory");
}
__device__ __forceinline__ void transpose_item_f8(const float* W, int K, int Nsrc, int Ndst, unsigned char* WT, int mode, float scale, LAS float* scr, int item, int lane) {
    const int nblk = Ndst / 32, kb = item / nblk, nb = item % nblk, k0 = 64 * kb, n0 = 32 * nb;
    const int sc = map_src(mode, n0 + (lane & 31));
#pragma unroll
    for (int i = 0; i < 32; ++i) { const int kk = 2 * i + (lane >> 5); scr[kk * 33 + (lane & 31)] = sc >= 0 ? W[(size_t)(k0 + kk) * Nsrc + sc] * scale : 0.f; }
    LDS_WAIT(); asm volatile("" ::: "memory");
    const int c = lane & 7;
#pragma unroll
    for (int j = 0; j < 4; ++j) { const int n = (lane >> 3) + 8 * j; const LAS float* s = scr + (8 * c) * 33 + n;
        u32x2 o; o.x = pk4_f8(s[0 * 33], s[1 * 33], s[2 * 33], s[3 * 33]); o.y = pk4_f8(s[4 * 33], s[5 * 33], s[6 * 33], s[7 * 33]);
        *(GAS u32x2*)(WT + (size_t)(n0 + n) * K + k0 + 8 * c) = o; }
    LDS_WAIT(); asm volatile("" ::: "memory");
}
__device__ __forceinline__ void rms_row_to_bf16(int lane, const float* xrow, const float* g, bf16_t* orow) {
    const GAS f32x4* xr = (const GAS f32x4*)xrow + lane; const GAS f32x4* gr = (const GAS f32x4*)g + lane;
    f32x4 v[4]; float s = 0.f;
#pragma unroll
    for (int j = 0; j < 4; ++j) { v[j] = xr[64 * j]; s += (v[j].x * v[j].x + v[j].y * v[j].y) + (v[j].z * v[j].z + v[j].w * v[j].w); }
    const float rstd = 1.0f / sqrtf(wave_sum(s) * (1.f / DM) + EPS);
    GAS u32x2* o8 = (GAS u32x2*)orow + lane;
#pragma unroll
    for (int j = 0; j < 4; ++j) { const f32x4 gg = gr[64 * j]; u32x2 o; o.x = pk2(v[j].x * rstd * gg.x, v[j].y * rstd * gg.y); o.y = pk2(v[j].z * rstd * gg.z, v[j].w * rstd * gg.w); o8[64 * j] = o; }
}

__device__ __forceinline__ void rms_rows4_to_bf16(int lane, const float* x, const float* g, bf16_t* o, size_t m0, size_t stride, unsigned char* o8f = nullptr) {
    f32x4 v[4][4]; float s[4];
#pragma unroll
    for (int r = 0; r < 4; ++r) { const GAS f32x4* xr = (const GAS f32x4*)(x + (m0 + r * stride) * DM) + lane;
#pragma unroll
        for (int j = 0; j < 4; ++j) v[r][j] = xr[64 * j]; }
    const GAS f32x4* gr = (const GAS f32x4*)g + lane;
    f32x4 gg[4];
#pragma unroll
    for (int j = 0; j < 4; ++j) gg[j] = gr[64 * j];
#pragma unroll
    for (int r = 0; r < 4; ++r) { float a = 0.f;
#pragma unroll
        for (int j = 0; j < 4; ++j) a += (v[r][j].x * v[r][j].x + v[r][j].y * v[r][j].y) + (v[r][j].z * v[r][j].z + v[r][j].w * v[r][j].w);
        s[r] = a; }
#pragma unroll
    for (int of = 1; of < 64; of <<= 1) {
#pragma unroll
        for (int r = 0; r < 4; ++r) s[r] += __shfl_xor(s[r], of); }
#pragma unroll
    for (int r = 0; r < 4; ++r) { const float rstd = 1.0f / sqrtf(s[r] * (1.f / DM) + EPS);
        GAS u32x2* o8 = (GAS u32x2*)(o + (m0 + r * stride) * DM) + lane;
#pragma unroll
        for (int j = 0; j < 4; ++j) { const float a0 = v[r][j].x * rstd * gg[j].x, a1 = v[r][j].y * rstd * gg[j].y, a2 = v[r][j].z * rstd * gg[j].z, a3 = v[r][j].w * rstd * gg[j].w;
            u32x2 w; w.x = pk2(a0, a1); w.y = pk2(a2, a3); o8[64 * j] = w;
            if (o8f) *((GAS unsigned*)(o8f + (m0 + r * stride) * DM) + lane + 64 * j) = pk4_f8(a0, a1, a2, a3); } }
}
__device__ __forceinline__ void p0_prologue(Frame& F) {
    LAS float* scr = (LAS float*)(F.lds + F.wave * 16384);
    const int gw = F.blk * NWAVES + F.wave, NGW = F.G * NWAVES, lane = F.lane;
    unsigned char* ws = F.ws;
    constexpr int I_IN = 16 * 96, I_MKV = 16 * 32, I_G = 16 * 32, I_B = 8 * 32, I_O = 16 * 32, I_EI = 16 * 64, I_EO = 16 * 32;
    constexpr int NITEMS = I_IN + I_MKV + 3 * I_G + 3 * I_B + I_O + NEXP * I_EI + NEXP * I_EO;
    for (int it = gw; it < NITEMS; it += NGW) {
        int r = it;
        if (r < I_IN) { transpose_item(F.in[3], DM, IN_W, PW, (bf16_t*)(ws + WS_WIN), 1, scr, r, lane); continue; } r -= I_IN;
        if (r < I_MKV) { transpose_item(F.in[9], DM, DM, DM, (bf16_t*)(ws + WS_WMKV), 0, scr, r, lane); continue; } r -= I_MKV;
        if (r < 3 * I_G) { const int n = r / I_G; transpose_item_f8(F.in[10] + (size_t)n * DM * DM, DM, DM, DM, ws + WS_WG + (size_t)n * DM * DM, 0, W8_SCALE, scr, r % I_G, lane); continue; } r -= 3 * I_G;
        if (r < 3 * I_B) { const int n = r / I_B; transpose_item(F.in[12] + (size_t)n * 512 * DM, 512, DM, DM, (bf16_t*)(ws + WS_WB) + (size_t)n * DM * 512, 0, scr, r % I_B, lane); continue; } r -= 3 * I_B;
        if (r < I_O) { transpose_item(F.in[13], DM, DM, DM, (bf16_t*)(ws + WS_WO), 0, scr, r, lane); continue; } r -= I_O;
        if (r < NEXP * I_EI) { const int e = r / I_EI; transpose_item_f8(F.in[17] + (size_t)e * DM * 2048, DM, 2048, 2048, ws + WS_WEI + (size_t)e * 2048 * DM, 2, W8_SCALE, scr, r % I_EI, lane); continue; } r -= NEXP * I_EI;
        { const int e = r / I_EO; transpose_item_f8(F.in[19] + (size_t)e * DM * DM, DM, DM, DM, ws + WS_WEO + (size_t)e * DM * DM, 0, W8_SCALE, scr, r % I_EO, lane); }
    }
    { f32x2* tab = (f32x2*)(ws + WS_ROPE);
      for (int idx = (F.blk * NWAVES * 64) + F.tid; idx < SEQ * 32; idx += F.G * NWAVES * 64) {
          const int s = idx >> 5, i = idx & 31;
          const float inv = exp2f(-(float)i * (13.287712379549449f / 32.0f));
          const float ang = (float)s * inv;
          const double rev = (double)ang * 0.15915494309189535;
          const float fr = (float)(rev - __builtin_rint(rev));
          tab[idx] = (f32x2){__builtin_amdgcn_cosf(fr), __builtin_amdgcn_sinf(fr)}; } }
    for (int m = gw; m < NTOK; m += 4 * NGW) rms_rows4_to_bf16(lane, F.in[0], F.in[2], (bf16_t*)(ws + WS_H), (size_t)m, (size_t)NGW, ws + WS_H8);
    for (int m = gw; m < NMEM; m += 4 * NGW) rms_rows4_to_bf16(lane, F.in[1], F.in[8], (bf16_t*)(ws + WS_MEMN), (size_t)m, (size_t)NGW);
    { int* st = (int*)(ws + WS_SLOT_TOK);
      for (int i = F.blk * NWAVES * 64 + F.tid; i < NSLOT_PAD; i += F.G * NWAVES * 64) st[i] = 0; }
}

template <int CTRL> __device__ __forceinline__ float dppf(float v) { return __builtin_bit_cast(float, __builtin_amdgcn_update_dpp(0, __builtin_bit_cast(int, v), CTRL, 0xF, 0xF, false)); }
__device__ __forceinline__ float lx1(float v) { return dppf<0xB1>(v); }
__device__ __forceinline__ float lx2(float v) { return dppf<0x4E>(v); }
__device__ __forceinline__ float lx4(float v) { return dppf<0x1B>(dppf<0x141>(v)); }
__device__ __forceinline__ float lx8(float v) { return dppf<0x128>(v); }
__device__ __forceinline__ void un8(const u32x4 w, float (&v)[8]) { v[0] = bflo(w.x); v[1] = bfhi(w.x); v[2] = bflo(w.y); v[3] = bfhi(w.y); v[4] = bflo(w.z); v[5] = bfhi(w.z); v[6] = bflo(w.w); v[7] = bfhi(w.w); }
__device__ __forceinline__ u32x4 pk8(const float (&v)[8]) { u32x4 w; w.x = pk2(v[0], v[1]); w.y = pk2(v[2], v[3]); w.z = pk2(v[4], v[5]); w.w = pk2(v[6], v[7]); return w; }
__device__ __forceinline__ void rope8(float (&v)[8], const f32x2 (&cs)[8], bool up) {
#pragma unroll
    for (int j = 0; j < 8; ++j) { const float other = lx4(v[j]); v[j] = up ? (other * cs[j].y + v[j] * cs[j].x) : (v[j] * cs[j].x - other * cs[j].y); }
}
__device__ __forceinline__ void p2_prep(Frame& F, const bool dummy = false) {
    const int gw = F.blk * NWAVES + F.wave, NGW = F.G * NWAVES, lane = F.lane;
    bf16_t* proj = (bf16_t*)(F.ws + WS_P);
    bf16_t* projw = dummy ? (bf16_t*)(F.ws + WS_END) : proj;
    const int wmask = dummy ? 8191 : 0x7fffffff;
    const f32x2* tab = (const f32x2*)(F.ws + WS_ROPE);
    float gkd[8];
#pragma unroll
    for (int j = 0; j < 8; ++j) gkd[j] = F.in[5][8 * (lane & 7) + j];
    const bool up = (lane & 4) != 0; const int i0 = (lane & 3) * 8;
    constexpr int NRW = 4;
    for (int m0 = gw; m0 < NTOK; m0 += NRW * NGW) {
        u32x4 raw[NRW][4]; f32x2 cs[NRW][8];
#pragma unroll
        for (int t = 0; t < NRW; ++t) { const GAS bf16_t* row = (const GAS bf16_t*)proj + (size_t)(m0 + t * NGW) * PW;
            raw[t][1] = *(const GAS u32x4*)(row + C_DK + 8 * (lane & 7));
            raw[t][3] = *(const GAS u32x4*)(row + C_IK + 8 * (lane & 7));
            const GAS f32x2* tr = (const GAS f32x2*)tab + (size_t)((m0 + t * NGW) & (SEQ - 1)) * 32 + i0;
#pragma unroll
            for (int j = 0; j < 8; ++j) cs[t][j] = tr[j]; }
#pragma unroll
        for (int t = 0; t < NRW; ++t) {
            GAS bf16_t* roww = (GAS bf16_t*)projw + (size_t)((m0 + t * NGW) & wmask) * PW;
            float v[8];
            { un8(raw[t][1], v); float ss = 0.f;
#pragma unroll
              for (int j = 0; j < 8; ++j) ss += v[j] * v[j];
              ss += lx1(ss); ss += lx2(ss); ss += lx4(ss);
              const float rstd = 1.0f / sqrtf(ss * (1.f / 64.f) + EPS);
#pragma unroll
              for (int j = 0; j < 8; ++j) v[j] = v[j] * rstd * gkd[j];
              rope8(v, cs[t], up);
              if (lane < 8) *(GAS u32x4*)(roww + C_DK + 8 * lane) = pk8(v); }
            { un8(raw[t][3], v); rope8(v, cs[t], up); if (lane < 8) *(GAS u32x4*)(roww + C_IK + 8 * lane) = pk8(v); }
        }
    }
    bf16_t* mkv = (bf16_t*)(F.ws + WS_MKV);
    if (!dummy) for (int m = gw; m < NMEM; m += NGW) {
        GAS bf16_t* row = (GAS bf16_t*)mkv + (size_t)m * DM; float v[8];
        un8(*(const GAS u32x4*)(row + 8 * lane), v); float ss = 0.f;
#pragma unroll
        for (int j = 0; j < 8; ++j) ss += v[j] * v[j];
        ss += lx1(ss); ss += lx2(ss); ss += lx4(ss); ss += lx8(ss);
        const float rstd = 1.0f / sqrtf(ss * (1.f / 128.f) + EPS);
#pragma unroll
        for (int j = 0; j < 8; ++j) v[j] = v[j] * rstd * F.in[7][8 * (lane & 15) + j];
        *(GAS u32x4*)(row + 8 * lane) = pk8(v);
    }
}

#define MFMA32(a, b, c) __builtin_amdgcn_mfma_f32_32x32x16_bf16((a), (b), (c), 0, 0, 0)
typedef LAS const unsigned char* lds_cptr;
__device__ __forceinline__ s16x4 vtr(lds_cptr p) { return __builtin_bit_cast(s16x4, __builtin_amdgcn_ds_read_tr16_b64_v4i16((LAS v4i16_t*)p)); }
__device__ __forceinline__ bf16x8 vfrag(lds_cptr vbase_lane, int off) {
    const s16x4 lo = vtr(vbase_lane + off), hi = vtr(vbase_lane + off + 512);
    return (bf16x8){lo[0], lo[1], lo[2], lo[3], hi[0], hi[1], hi[2], hi[3]};
}
__device__ __forceinline__ int vtr_lane_off(int lane) { return ((lane >> 4) & 1) * 32 + (lane & 3) * 8 + (4 * (lane >> 5) + ((lane & 15) >> 2)) * 64; }
__device__ __forceinline__ bf16x8 pack8(const float* p) {
    u32x4 w; w.x = cvt_pk_bf16(p[0], p[1]); w.y = cvt_pk_bf16(p[2], p[3]); w.z = cvt_pk_bf16(p[4], p[5]); w.w = cvt_pk_bf16(p[6], p[7]);
    return __builtin_bit_cast(bf16x8, w);
}
__device__ __forceinline__ float softplus2_f(float z2) { return __builtin_amdgcn_logf(1.f + __builtin_amdgcn_exp2f(fminf(z2, 120.f))); }

__device__ __forceinline__ void sb_item(const bf16_t* proj, bf16_t* osb, int b, int h, int qblk, LAS unsigned char* vlds, int lane) {
    const int r32 = lane & 31, hi = lane >> 5;
    const size_t tok0 = (size_t)b * SEQ + (size_t)qblk * 32;
    bf16x8 qr[4];
    { const bf16_t* qp = proj + (tok0 + r32) * PW + C_SQ + h * 64 + hi * 8;
#pragma unroll
      for (int kk = 0; kk < 4; ++kk) qr[kk] = *(const bf16x8*)(qp + kk * 16); }
    f32x16 o0 = {}, o1 = {}; float R = 0.f;
    const lds_cptr vrd = (lds_cptr)vlds + vtr_lane_off(lane);
    bf16x8 kfn[4]; u32x4 vvn[4];
#define SB_LOAD(kt_) do { const size_t key0_ = (size_t)b * SEQ + (size_t)(kt_) * 32; const GAS bf16_t* kp_ = (const GAS bf16_t*)proj + (key0_ + r32) * PW + C_SK + h * 64 + hi * 8; \
        _Pragma("unroll") for (int kk = 0; kk < 4; ++kk) kfn[kk] = *(const GAS bf16x8*)(kp_ + kk * 16); \
        _Pragma("unroll") for (int p = 0; p < 4; ++p) vvn[p] = *(const GAS u32x4*)((const GAS bf16_t*)proj + (key0_ + 16 * (p & 1) + (lane >> 2)) * PW + C_SV + h * 64 + (p >> 1) * 32 + (lane & 3) * 8); } while (0)
    SB_LOAD(qblk);
    for (int kt = qblk; kt >= 0; --kt) {
        bf16x8 kf[4]; u32x4 vv[4];
#pragma unroll
        for (int i = 0; i < 4; ++i) { kf[i] = kfn[i]; vv[i] = vvn[i]; }
        if (kt > 0) SB_LOAD(kt - 1);
        f32x16 s = {};
#pragma unroll
        for (int kk = 0; kk < 4; ++kk) s = MFMA32(kf[kk], qr[kk], s);
        asm volatile("" ::: "memory");
#pragma unroll
        for (int p = 0; p < 4; ++p) *(LAS u32x4*)(vlds + p * 1024 + lane * 16) = vv[p];
        const bool diag = (kt == qblk);
        float sp[16], pr[16];
#pragma unroll
        for (int r = 0; r < 16; ++r) { const bool valid = !diag || (crow(r, hi) < r32); sp[r] = valid ? softplus2_f(s[r]) : 0.f; }
        float T[4], U[4];
#pragma unroll
        for (int g = 0; g < 4; ++g) { T[g] = (sp[4 * g] + sp[4 * g + 1]) + (sp[4 * g + 2] + sp[4 * g + 3]); { const auto rr = __builtin_amdgcn_permlane32_swap(__float_as_uint(T[g]), __float_as_uint(T[g]), false, false); U[g] = hi ? __uint_as_float(rr[0]) : __uint_as_float(rr[1]); } }
        float run = 0.f, above[4];
#pragma unroll
        for (int g = 3; g >= 0; --g) { above[g] = run + (hi == 0 ? U[g] : 0.f); run += T[g] + U[g]; }
#pragma unroll
        for (int g = 0; g < 4; ++g) { float c = R + above[g];
#pragma unroll
            for (int j = 3; j >= 0; --j) { const int r = 4 * g + j; c += sp[r]; const bool valid = !diag || (crow(r, hi) < r32); pr[r] = valid ? __builtin_amdgcn_exp2f(s[r] - c) : 0.f; } }
        R += run;
        const bf16x8 p0 = pack8(pr), p1 = pack8(pr + 8);
        LDS_WAIT();
        const bf16x8 v00 = vfrag(vrd, 0), v01 = vfrag(vrd, 1024), v10 = vfrag(vrd, 2048), v11 = vfrag(vrd, 3072);
        o0 = MFMA32(v00, p0, o0); o0 = MFMA32(v01, p1, o0);
        o1 = MFMA32(v10, p0, o1); o1 = MFMA32(v11, p1, o1);
        asm volatile("" ::: "memory");
        if (__all(R > 30.0f * LOG2E)) break;
    }
#undef SB_LOAD
    bf16_t* op = osb + (tok0 + r32) * 512 + h * 64 + 4 * hi;
#pragma unroll
    for (int g = 0; g < 4; ++g) {
        u32x2 w0, w1; w0.x = cvt_pk_bf16(o0[4 * g], o0[4 * g + 1]); w0.y = cvt_pk_bf16(o0[4 * g + 2], o0[4 * g + 3]); w1.x = cvt_pk_bf16(o1[4 * g], o1[4 * g + 1]); w1.y = cvt_pk_bf16(o1[4 * g + 2], o1[4 * g + 3]);
        *(u32x2*)(op + 8 * g) = w0; *(u32x2*)(op + 32 + 8 * g) = w1; }
}

constexpr int ML_K = 0, ML_KROW = 272, ML_V = 256 * ML_KROW, ML_END = ML_V + 65536;
__device__ __forceinline__ void mem_unit(const bf16_t* proj, const bf16_t* mkv, bf16_t* omem, int b, int h, int half, LAS unsigned char* ml, int tid, const float* gq  ) {
    const int lane = tid & 63, wid = __builtin_amdgcn_readfirstlane(tid >> 6), r32 = lane & 31, hi = lane >> 5;
    { const GAS bf16_t* src = (const GAS bf16_t*)mkv + (size_t)b * MEMLEN * DM + h * 128;
#pragma unroll
      for (int i = 0; i < 8; ++i) { const int ch = tid + 512 * i, key = ch >> 4, c16 = ch & 15, kk = key & 31;
          const u32x4 kv = *(const GAS u32x4*)(src + (size_t)key * DM + c16 * 8);
          const u32x4 vv = *(const GAS u32x4*)(src + (size_t)key * DM + 512 + c16 * 8);
          *(LAS u32x4*)(ml + ML_K + key * ML_KROW + c16 * 16) = kv;
          *(LAS u32x4*)(ml + ML_V + (key >> 5) * 8192 + ((c16 >> 2) * 2 + (kk >> 4)) * 1024 + (kk & 15) * 64 + (c16 & 3) * 16) = vv; } }
    __syncthreads();
    for (int i = 0; i < 4; ++i) {
        const int qblk = half * 32 + wid * 4 + i;
        const size_t tok0 = (size_t)b * SEQ + (size_t)qblk * 32;
        bf16x8 qr[8];
        { const GAS bf16_t* qp = (const GAS bf16_t*)proj + (tok0 + r32) * PW + C_MQ + h * 128 + hi * 8;
#pragma unroll
          for (int kk = 0; kk < 8; ++kk) qr[kk] = *(const GAS bf16x8*)(qp + kk * 16); }
        { float ss = 0.f;
#pragma unroll
          for (int kk = 0; kk < 8; ++kk)
#pragma unroll
              for (int j = 0; j < 8; ++j) { const float v = __uint_as_float((unsigned)(unsigned short)qr[kk][j] << 16); ss += v * v; }
          { const auto rr = __builtin_amdgcn_permlane32_swap(__float_as_uint(ss), __float_as_uint(ss), false, false); ss = __uint_as_float(rr[0]) + __uint_as_float(rr[1]); }
          const float rstd = 1.0f / sqrtf(ss * (1.f / 128.f) + EPS);
#pragma unroll
          for (int kk = 0; kk < 8; ++kk) { const GAS f32x4* gp = (const GAS f32x4*)(gq + 16 * kk + 8 * hi); const f32x4 g0 = gp[0], g1 = gp[1]; float v[8];
#pragma unroll
              for (int j = 0; j < 8; ++j) v[j] = __uint_as_float((unsigned)(unsigned short)qr[kk][j] << 16) * rstd * ((j < 4 ? g0[j & 3] : g1[j & 3]) * (0.08838834764831845f * LOG2E));
              const u32x4 w = pk8(v); qr[kk] = __builtin_bit_cast(bf16x8, w); } }
        f32x16 o[4] = {{}, {}, {}, {}}; float m = -1e30f, l = 0.f;
        for (int kb = 0; kb < 8; ++kb) {
            const LAS unsigned char* krd = ml + ML_K + (32 * kb + r32) * ML_KROW + hi * 16;
            f32x16 s = {};
#pragma unroll
            for (int kk = 0; kk < 8; ++kk) { const bf16x8 kf = *(const LAS bf16x8*)(krd + kk * 32); s = MFMA32(kf, qr[kk], s); }
            float mx = s[0];
#pragma unroll
            for (int r = 1; r < 16; ++r) mx = fmaxf(mx, s[r]);
            { const auto rr = __builtin_amdgcn_permlane32_swap(__float_as_uint(mx), __float_as_uint(mx), false, false); mx = fmaxf(__uint_as_float(rr[0]), __uint_as_float(rr[1])); }
            if (__any(mx > m + 8.0f)) {
                const float mn = fmaxf(m, mx), alpha = __builtin_amdgcn_exp2f(m - mn);
                l *= alpha; m = mn;
#pragma unroll
                for (int d = 0; d < 4; ++d)
#pragma unroll
                    for (int r = 0; r < 16; ++r) o[d][r] *= alpha;
            }
            float pr[16], rs = 0.f;
#pragma unroll
            for (int r = 0; r < 16; ++r) { pr[r] = __builtin_amdgcn_exp2f(s[r] - m); rs += pr[r]; }
            l += rs;
            const bf16x8 p0 = pack8(pr), p1 = pack8(pr + 8);
            const lds_cptr vrd = (lds_cptr)ml + ML_V + kb * 8192 + vtr_lane_off(lane);
#pragma unroll
            for (int d = 0; d < 4; ++d) { const bf16x8 va = vfrag(vrd, d * 2048), vb = vfrag(vrd, d * 2048 + 1024); o[d] = MFMA32(va, p0, o[d]); o[d] = MFMA32(vb, p1, o[d]); }
        }
        { const auto rr = __builtin_amdgcn_permlane32_swap(__float_as_uint(l), __float_as_uint(l), false, false); l = __uint_as_float(rr[0]) + __uint_as_float(rr[1]); }
        const float il = 1.0f / l;
        bf16_t* op = omem + (tok0 + r32) * 512 + h * 128 + 4 * hi;
#pragma unroll
        for (int d = 0; d < 4; ++d)
#pragma unroll
            for (int g = 0; g < 4; ++g) { u32x2 w; w.x = cvt_pk_bf16(o[d][4 * g] * il, o[d][4 * g + 1] * il); w.y = cvt_pk_bf16(o[d][4 * g + 2] * il, o[d][4 * g + 3] * il); *(u32x2*)(op + 32 * d + 8 * g) = w; }
    }
    __syncthreads();
}

constexpr int DL_HIST = 0, DL_PREFIX = 66048, DL_KREM = DL_PREFIX + 256, DL_MASK = 67072, DL_VT = 73728, DL_KT = DL_VT + 2 * 16384, DL_END = DL_KT + 2 * 18432, DL_IQ = DL_VT;
constexpr int TOPK_DSA = 256;

struct IqLds { const LAS unsigned char* p; __device__ __forceinline__ bf16x8 operator()(int j) const { return *(const LAS bf16x8*)(p + j * 32); } };
__device__ __forceinline__ float relu_f(float x) { float r; asm("v_max_f32 %0, 0, %1" : "=v"(r) : "v"(x)); return r; }
template <class QF>
__device__ __forceinline__ void idx_scores(const QF& qf, const bf16x8 (&kf)[4], const float (&wq)[4], unsigned (&uk)[16]) {
    f32x16 a[4]; bf16x8 qa[4];
#pragma unroll
    for (int hd = 0; hd < 4; ++hd) { a[hd] = (f32x16){}; qa[hd] = qf(hd * 4); }
#pragma unroll
    for (int kk = 0; kk < 4; ++kk) {
#pragma unroll
        for (int hd = 0; hd < 4; ++hd) { a[hd] = MFMA32(kf[kk], qa[hd], a[hd]); if (kk + 1 < 4) qa[hd] = qf(hd * 4 + kk + 1); }
        __builtin_amdgcn_sched_barrier(0);
    }
    float scv[16];
#pragma unroll
    for (int hd = 0; hd < 4; ++hd) {
#pragma unroll
        for (int r = 0; r < 16; ++r) scv[r] = (hd == 0) ? wq[0] * relu_f(a[0][r]) : __builtin_fmaf(wq[hd], relu_f(a[hd][r]), scv[r]); }
#pragma unroll
    for (int r = 0; r < 16; ++r) {
        unsigned bits = __builtin_bit_cast(unsigned, scv[r]);
        if (bits == 0x80000000u) bits = 0u;
        uk[r] = bits ^ ((unsigned)((int)bits >> 31) | 0x80000000u);
    }
}
__device__ __forceinline__ void load_ik(const bf16_t* proj, size_t tokb, int kbase, int r32, int hi, bf16x8 (&kf)[4]) {
    int kr = kbase + r32; if (kr > SEQ - 1) kr = SEQ - 1;
    const GAS bf16_t* p = (const GAS bf16_t*)proj + (tokb + kr) * PW + C_IK + 8 * hi;
#pragma unroll
    for (int kk = 0; kk < 4; ++kk) kf[kk] = *(const GAS bf16x8*)(p + kk * 16);
}

__device__ __forceinline__ void dsa_unit(const bf16_t* proj, bf16_t* odsa, unsigned* kscr  , int b, int c, LAS unsigned char* dl, int tid, const float* gqd  , const f32x2* rope  ) {
    const int lane = tid & 63, wid = __builtin_amdgcn_readfirstlane(tid >> 6), r32 = lane & 31, hi = lane >> 5;
    const int n = 64 * (c + 1), nsteps = (n + 127) >> 7;
    const size_t tokq0 = (size_t)b * SEQ + (size_t)c * 64, tokb = (size_t)b * SEQ;
    LAS unsigned* hist = (LAS unsigned*)(dl + DL_HIST);
    LAS unsigned* prefix = (LAS unsigned*)(dl + DL_PREFIX);
    LAS unsigned* krem = (LAS unsigned*)(dl + DL_KREM);
    LAS unsigned* mask = (LAS unsigned*)(dl + DL_MASK);
    const int kb = wid >> 1, qh = wid & 1;
    { const int row = tid >> 3, cq = tid & 7; const bool up = (cq & 1) != 0;
      const GAS bf16_t* src = (const GAS bf16_t*)proj + (tokq0 + row) * PW + C_IQ + cq * 32;
      const GAS f32x4* tp = (const GAS f32x4*)((const GAS f32x2*)rope + (size_t)(c * 64 + row) * 32);
#pragma unroll
      for (int i = 0; i < 4; ++i) { float v[8]; un8(*(const GAS u32x4*)(src + i * 8), v);
#pragma unroll
          for (int jj = 0; jj < 4; ++jj) { const f32x4 cs2 = tp[4 * i + jj];
#pragma unroll
              for (int e = 0; e < 2; ++e) { const int j = 2 * jj + e; const float cc = e ? cs2[2] : cs2[0], sn = e ? cs2[3] : cs2[1]; const float other = lx1(v[j]);
                  v[j] = up ? (other * sn + v[j] * cc) : (v[j] * cc - other * sn); } }
          *(LAS u32x4*)(dl + DL_IQ + row * 528 + cq * 64 + i * 16) = pk8(v); } }
    const IqLds iqf{dl + DL_IQ + (32 * qh + r32) * 528 + hi * 16};
    float wq[4];
    { const u32x2 w = *(const u32x2*)(proj + (tokq0 + 32 * qh + r32) * PW + C_IW);
      wq[0] = bflo(w.x) * 0.0625f; wq[1] = bfhi(w.x) * 0.0625f; wq[2] = bflo(w.y) * 0.0625f; wq[3] = bfhi(w.y) * 0.0625f; }
#ifndef REP_SEL
#define REP_SEL 1
#endif
#ifndef REP_B2
#define REP_B2 1
#endif
    LAS unsigned* selall = (LAS unsigned*)(dl + DL_HIST);
#ifndef PROBE_NOATOM
#define PROBE_NOATOM 0
#endif
    unsigned dummy = 0u;
    for (int rep_sel = 0; rep_sel < REP_SEL; ++rep_sel) {
    if (tid < 64) { prefix[tid] = 0u; krem[tid] = (n > TOPK_DSA) ? (unsigned)TOPK_DSA : 0x7fffffffu; }
    __syncthreads();
    const int pass0 = (n > TOPK_DSA) ? 0 : 3;
    GAS u32x4* kmine = (GAS u32x4*)kscr + (size_t)wid * 256 + lane;
#define DSA_CONSUME(uk_) do { \
        if (sel) { _Pragma("unroll") for (int r = 0; r < 16; ++r) { const bool match = (pass == 0) || (((uk_)[r] >> (shift + 8)) == pfx); \
                if (match && !(PROBE_NOATOM && rep_sel + 1 < REP_SEL)) __hip_atomic_fetch_add(hist + (32 * qh + r32) * 257 + (((uk_)[r] >> shift) & 255u), 1u, __ATOMIC_RELAXED, __HIP_MEMORY_SCOPE_WORKGROUP); else dummy ^= (uk_)[r]; } } \
        else { _Pragma("unroll") for (int r = 0; r < 16; ++r) { const unsigned k24 = (uk_)[r] >> 8; gtw |= (k24 > pfx ? 1u : 0u) << crow(r, hi); eqw |= (k24 == pfx ? 1u : 0u) << crow(r, hi); } } } while (0)
#define DSA_TIES() do { if (!sel) { \
        LAS unsigned* mk = mask + (step & 1) * 768; \
        { const auto rg = __builtin_amdgcn_permlane32_swap(gtw, gtw, false, false); gtw = rg[0] | rg[1]; const auto re = __builtin_amdgcn_permlane32_swap(eqw, eqw, false, false); eqw = re[0] | re[1]; } \
        if (hi == 0) { mk[(32 * qh + r32) * 4 + kb] = gtw; mk[256 + (32 * qh + r32) * 4 + kb] = eqw; } \
        __syncthreads(); \
        if (wid == 0) { unsigned nd = krem[lane]; \
            _Pragma("unroll") for (int k4 = 0; k4 < 4; ++k4) { const unsigned g = mk[lane * 4 + k4]; unsigned e = mk[256 + lane * 4 + k4]; unsigned sl = g; \
                if (e != 0u) { const unsigned cnt = (unsigned)__builtin_popcount(e); \
                    if (cnt <= nd) { sl |= e; nd -= cnt; } \
                    else { unsigned chosen = 0u; while (nd > 0u) { const unsigned lb = e & (0u - e); chosen |= lb; e ^= lb; --nd; } sl |= chosen; } } \
                selall[lane * 64 + step * 4 + k4] = sl; } \
            krem[lane] = nd; } } } while (0)
#ifndef REP_MASKP
#define REP_MASKP 0
#endif
#ifndef REP_P0
#define REP_P0 0
#endif
    for (int pp = pass0 - ((REP_P0 && pass0 == 0) ? 1 : 0); pp < ((rep_sel + 1 < REP_SEL) ? 3 : 4 + REP_MASKP); ++pp) { const int pass = pp > 3 ? 3 : (pp < 0 ? 0 : pp);
        if (pp > 3) { if (tid < 64) krem[tid] = 0x7fffffffu; __syncthreads(); }
        const bool sel = pass < 3;
        if (sel) { for (int i = tid; i < 64 * 257; i += 512) hist[i] = 0u; __syncthreads(); }
        const int shift = 24 - 8 * pass;
        const unsigned pfx = prefix[32 * qh + r32];
        if (pass == pass0) {
            bf16x8 kfn[4]; load_ik(proj, tokb, 32 * kb, r32, hi, kfn);
            for (int step = 0; step < nsteps; ++step) {
                const int kbase = 128 * step + 32 * kb;
                bf16x8 kf[4];
#pragma unroll
                for (int kk = 0; kk < 4; ++kk) kf[kk] = kfn[kk];
                if (step + 1 < nsteps) load_ik(proj, tokb, kbase + 128, r32, hi, kfn);
                unsigned gtw = 0u, eqw = 0u;
                if (kbase < n) {
                    unsigned uk[16];
                    idx_scores(iqf, kf, wq, uk);
#ifndef P0_VAR
#define P0_VAR 0
#endif
                    if (pass0 == 0 && !(P0_VAR == 1 && pp < 0)) {
#pragma unroll
                        for (int g = 0; g < 4; ++g) kmine[(size_t)step * 2048 + g * 64] = (u32x4){uk[4 * g], uk[4 * g + 1], uk[4 * g + 2], uk[4 * g + 3]};
                    }
                    if (!(P0_VAR == 2 && pp < 0)) DSA_CONSUME(uk); else dummy ^= uk[0] ^ uk[5] ^ uk[9] ^ uk[15];
                }
                DSA_TIES();
            }
        } else {
            u32x4 ka[4], kb4[4];
#define DSA_KLOAD(dst, st_) do { _Pragma("unroll") for (int g = 0; g < 4; ++g) dst[g] = kmine[(size_t)(st_) * 2048 + g * 64]; } while (0)
            DSA_KLOAD(ka, 0);
            if (nsteps > 1 && 128 + 32 * kb < n) DSA_KLOAD(kb4, 1);
            for (int step = 0; step < nsteps; ++step) {
                const int kbase = 128 * step + 32 * kb;
                unsigned uk[16];
#pragma unroll
                for (int g = 0; g < 4; ++g) { uk[4 * g] = ka[g].x; uk[4 * g + 1] = ka[g].y; uk[4 * g + 2] = ka[g].z; uk[4 * g + 3] = ka[g].w; }
#pragma unroll
                for (int g = 0; g < 4; ++g) ka[g] = kb4[g];
                if (step + 2 < nsteps && kbase + 256 < n) DSA_KLOAD(kb4, step + 2);
                unsigned gtw = 0u, eqw = 0u;
                if (kbase < n) DSA_CONSUME(uk);
                DSA_TIES();
            }
#undef DSA_KLOAD
        }
        if (sel && pp < 0) __syncthreads();
        if (sel && pp >= 0) {
            __syncthreads();
#pragma unroll
            for (int qi = 0; qi < 8; ++qi) {
                const int q = 8 * wid + qi;
                const LAS unsigned* hq = hist + q * 257;
                const unsigned c0 = hq[255 - 4 * lane], c1 = hq[254 - 4 * lane], c2 = hq[253 - 4 * lane], c3 = hq[252 - 4 * lane];
                const unsigned s4 = c0 + c1 + c2 + c3;
                unsigned incl = s4;
#pragma unroll
                for (int o = 1; o < 64; o <<= 1) { const unsigned t = __shfl_up(incl, o); if (lane >= o) incl += t; }
                const unsigned excl = incl - s4, kr = krem[q];
                if (excl < kr && kr <= incl) {
                    unsigned cum = excl, bin, nk;
                    if (cum + c0 >= kr) { bin = 255 - 4 * lane; nk = kr - cum; }
                    else { cum += c0; if (cum + c1 >= kr) { bin = 254 - 4 * lane; nk = kr - cum; }
                    else { cum += c1; if (cum + c2 >= kr) { bin = 253 - 4 * lane; nk = kr - cum; }
                    else { cum += c2; bin = 252 - 4 * lane; nk = kr - cum; } } }
                    prefix[q] = (prefix[q] << 8) | bin; krem[q] = nk;
                }
            }
            __syncthreads();
        }
    }
    }
    if (dummy == 0x9e3779b9u) hist[tid] = 1u;
    const int hd = wid;
    u32x4 pk[2], pv[2];
#define DSA_LOADKV(step_) do { _Pragma("unroll") for (int i_ = 0; i_ < 2; ++i_) { const int ch_ = tid + 512 * i_; int krow_ = 128 * (step_) + (ch_ >> 3); if (krow_ > SEQ - 1) krow_ = SEQ - 1; \
        const GAS bf16_t* rp_ = (const GAS bf16_t*)proj + (tokb + krow_) * PW + (ch_ & 7) * 8; pk[i_] = *(const GAS u32x4*)(rp_ + C_DK); pv[i_] = *(const GAS u32x4*)(rp_ + C_DV); } } while (0)
#define DSA_STOREKV(buf_) do { _Pragma("unroll") for (int i_ = 0; i_ < 2; ++i_) { const int ch_ = tid + 512 * i_, key_ = ch_ >> 3, c8_ = ch_ & 7, kk_ = key_ & 31; \
        *(LAS u32x4*)(dl + DL_KT + (buf_) * 18432 + key_ * 144 + c8_ * 16) = pk[i_]; \
        *(LAS u32x4*)(dl + DL_VT + (buf_) * 16384 + (key_ >> 5) * 4096 + ((c8_ >> 2) * 2 + (kk_ >> 4)) * 1024 + (kk_ & 15) * 64 + (c8_ & 3) * 16) = pv[i_]; } } while (0)
    for (int rep_b2 = 0; rep_b2 < REP_B2; ++rep_b2)
    for (int qb = 0; qb < 2; ++qb) {
        bf16x8 qr[4];
        { const GAS bf16_t* qp = (const GAS bf16_t*)proj + (tokq0 + 32 * qb + r32) * PW + C_DQ + hd * 64 + 8 * hi;
#pragma unroll
          for (int kk = 0; kk < 4; ++kk) qr[kk] = *(const GAS bf16x8*)(qp + kk * 16); }
        { float v[4][8]; float ss = 0.f;
#pragma unroll
          for (int kk = 0; kk < 4; ++kk)
#pragma unroll
              for (int j = 0; j < 8; ++j) { v[kk][j] = __uint_as_float((unsigned)(unsigned short)qr[kk][j] << 16); ss += v[kk][j] * v[kk][j]; }
          { const auto rr = __builtin_amdgcn_permlane32_swap(__float_as_uint(ss), __float_as_uint(ss), false, false); ss = __uint_as_float(rr[0]) + __uint_as_float(rr[1]); }
          const float rstd = 1.0f / sqrtf(ss * (1.f / 64.f) + EPS);
#pragma unroll
          for (int kk = 0; kk < 4; ++kk) { const GAS f32x4* gp = (const GAS f32x4*)(gqd + 16 * kk + 8 * hi); const f32x4 g0 = gp[0], g1 = gp[1];
#pragma unroll
              for (int j = 0; j < 8; ++j) v[kk][j] = v[kk][j] * rstd * ((j < 4 ? g0[j & 3] : g1[j & 3]) * (0.125f * LOG2E)); }
          const int pos = c * 64 + 32 * qb + r32;
#pragma unroll
          for (int kk = 0; kk < 2; ++kk) { const GAS f32x4* tp = (const GAS f32x4*)((const GAS f32x2*)rope + (size_t)pos * 32 + 16 * kk + 8 * hi);
#pragma unroll
              for (int jj = 0; jj < 4; ++jj) { const f32x4 cs2 = tp[jj];
#pragma unroll
                  for (int e = 0; e < 2; ++e) { const int j = 2 * jj + e; const float cc = e ? cs2[2] : cs2[0], sn = e ? cs2[3] : cs2[1];
                      const float x1 = v[kk][j], x2 = v[kk + 2][j]; v[kk][j] = x1 * cc - x2 * sn; v[kk + 2][j] = x2 * cc + x1 * sn; } } }
#pragma unroll
          for (int kk = 0; kk < 4; ++kk) { const u32x4 w = pk8(v[kk]); qr[kk] = __builtin_bit_cast(bf16x8, w); } }
        f32x16 o0 = {}, o1 = {}; float mrun = -1e30f, lrun = 0.f;
        DSA_LOADKV(0);
        DSA_STOREKV(0);
        __syncthreads();
#define B2_QK(S_, k4_) do { const LAS unsigned char* krd_ = kt + (32 * (k4_) + r32) * 144 + hi * 16; S_ = (f32x16){}; \
        _Pragma("unroll") for (int kk = 0; kk < 4; ++kk) { const bf16x8 kf_ = *(const LAS bf16x8*)(krd_ + kk * 32); S_ = MFMA32(kf_, qr[kk], S_); } } while (0)
#define B2_SM_PV(S_, k4_) do { \
        const int selw_ = (int)selall[(32 * qb + r32) * 64 + step * 4 + (k4_)]; float mx_ = -INFINITY; \
        _Pragma("unroll") for (int r = 0; r < 16; ++r) { const unsigned m_ = (unsigned)__builtin_amdgcn_sbfe(selw_, crow(r, hi), 1); \
            S_[r] = __uint_as_float((__float_as_uint(S_[r]) & m_) | (0xFF800000u & ~m_)); mx_ = fmaxf(mx_, S_[r]); } \
        { const auto rr_ = __builtin_amdgcn_permlane32_swap(__float_as_uint(mx_), __float_as_uint(mx_), false, false); mx_ = fmaxf(__uint_as_float(rr_[0]), __uint_as_float(rr_[1])); } \
        if (__any(mx_ > mrun + 8.0f)) { const float mn_ = fmaxf(mrun, mx_), alpha_ = __builtin_amdgcn_exp2f(mrun - mn_); lrun *= alpha_; mrun = mn_; \
            _Pragma("unroll") for (int r = 0; r < 16; ++r) { o0[r] *= alpha_; o1[r] *= alpha_; } } \
        float pr_[16], rs_ = 0.f; \
        _Pragma("unroll") for (int r = 0; r < 16; ++r) { pr_[r] = __builtin_amdgcn_exp2f(S_[r] - mrun); rs_ += pr_[r]; } \
        lrun += rs_; \
        const bf16x8 pa_ = pack8(pr_), pb_ = pack8(pr_ + 8); \
        const lds_cptr vrd_ = (lds_cptr)vt + (k4_) * 4096 + vtr_lane_off(lane); \
        const bf16x8 v00_ = vfrag(vrd_, 0), v01_ = vfrag(vrd_, 1024), v10_ = vfrag(vrd_, 2048), v11_ = vfrag(vrd_, 3072); \
        o0 = MFMA32(v00_, pa_, o0); o0 = MFMA32(v01_, pb_, o0); o1 = MFMA32(v10_, pa_, o1); o1 = MFMA32(v11_, pb_, o1); } while (0)
        for (int step = 0; step < nsteps; ++step) {
            const int buf = step & 1;
            if (step + 1 < nsteps) DSA_LOADKV(step + 1);
            LAS unsigned char* kt = dl + DL_KT + buf * 18432;
            LAS unsigned char* vt = dl + DL_VT + buf * 16384;
            f32x16 sa, sb;
            B2_QK(sa, 0);
            B2_QK(sb, 1); B2_SM_PV(sa, 0); __builtin_amdgcn_sched_barrier(0);
            if (128 * step + 64 < n) {
                B2_QK(sa, 2); B2_SM_PV(sb, 1); __builtin_amdgcn_sched_barrier(0);
                B2_QK(sb, 3); B2_SM_PV(sa, 2); __builtin_amdgcn_sched_barrier(0);
                B2_SM_PV(sb, 3);
            } else {
                B2_SM_PV(sb, 1);
            }
            if (step + 1 < nsteps) DSA_STOREKV(buf ^ 1);
            __syncthreads();
        }
#undef B2_QK
#undef B2_SM_PV
        float l = lrun; { const auto rr = __builtin_amdgcn_permlane32_swap(__float_as_uint(l), __float_as_uint(l), false, false); l = __uint_as_float(rr[0]) + __uint_as_float(rr[1]); }
        const float il = 1.0f / l;
        bf16_t* op = odsa + (tokq0 + 32 * qb + r32) * 512 + hd * 64 + 4 * hi;
#pragma unroll
        for (int g = 0; g < 4; ++g) {
            u32x2 w0, w1; w0.x = cvt_pk_bf16(o0[4 * g] * il, o0[4 * g + 1] * il); w0.y = cvt_pk_bf16(o0[4 * g + 2] * il, o0[4 * g + 3] * il);
            w1.x = cvt_pk_bf16(o1[4 * g] * il, o1[4 * g + 1] * il); w1.y = cvt_pk_bf16(o1[4 * g + 2] * il, o1[4 * g + 3] * il);
            *(u32x2*)(op + 8 * g) = w0; *(u32x2*)(op + 32 + 8 * g) = w1; }
    }
#undef DSA_LOADKV
#undef DSA_STOREKV
#undef DSA_CONSUME
#undef DSA_TIES
    __syncthreads();
}

template <int CTRL> __device__ __forceinline__ float dpp_f(float v) { return __builtin_bit_cast(float, __builtin_amdgcn_update_dpp(0, __builtin_bit_cast(int, v), CTRL, 0xF, 0xF, false)); }
constexpr int RL_WROW = 2064, RL_WHI = 0, RL_WLO = 32 * RL_WROW, RL_TKE = 2 * 32 * RL_WROW, RL_TKW = RL_TKE + 4096, RL_RSTD = RL_TKW + 4096;
__device__ __forceinline__ void p9_router(Frame& F) {
    const int lane = F.lane, wave = F.wave, tid = F.tid, r32 = lane & 31, hi = lane >> 5;
    LAS int* tke = (LAS int*)(F.lds + RL_TKE); LAS float* tkw = (LAS float*)(F.lds + RL_TKW);
    const float* w_router = F.in[15]; const float* b_router = F.in[16]; const float* g_ffn = F.in[14];
    for (int idx = tid; idx < DM * NEXP; idx += NWAVES * 64) { const int k = idx >> 5, e = idx & 31; const float w = w_router[idx] * g_ffn[k];
        const unsigned wh = f2bf(w); const unsigned wl = f2bf(w - __builtin_bit_cast(float, wh << 16));
        *(LAS bf16_t*)(F.lds + RL_WHI + e * RL_WROW + k * 2) = (bf16_t)wh; *(LAS bf16_t*)(F.lds + RL_WLO + e * RL_WROW + k * 2) = (bf16_t)wl; }
    if (tid < 32) F.MISC[MW_LCNT + tid] = 0u;
    __syncthreads();
    unsigned char* h2f8 = F.ws + WS_H2F8; LAS float* rsl = (LAS float*)(F.lds + RL_RSTD) + 32 * wave;
    const GAS f32x4* gr = (const GAS f32x4*)g_ffn + lane;
    f32x4 gg[4];
#pragma unroll
    for (int j = 0; j < 4; ++j) gg[j] = gr[64 * j];
    const size_t tok0 = (size_t)F.blk * 256 + 32 * wave;
    constexpr int NR = 4;
    u32x2 xnext[NR][4];
#pragma unroll
    for (int tk = 0; tk < NR; ++tk) { const GAS u32x2* xr = (const GAS u32x2*)((const GAS bf16_t*)F.out + (tok0 + tk) * 2048 + ((tok0 + tk) & 1) * 1024) + lane;
#pragma unroll
        for (int j = 0; j < 4; ++j) xnext[tk][j] = xr[64 * j]; }
    for (int it = 0; it < 32 / NR; ++it) {
        f32x4 hn[NR][4];
#pragma unroll
        for (int tk = 0; tk < NR; ++tk)
#pragma unroll
            for (int j = 0; j < 4; ++j) hn[tk][j] = (f32x4){bflo(xnext[tk][j].x), bfhi(xnext[tk][j].x), bflo(xnext[tk][j].y), bfhi(xnext[tk][j].y)};
        if (it + 1 < 32 / NR) {
#pragma unroll
            for (int tk = 0; tk < NR; ++tk) { const GAS u32x2* xr = (const GAS u32x2*)((const GAS bf16_t*)F.out + (tok0 + NR * it + NR + tk) * 2048 + ((tok0 + NR * it + NR + tk) & 1) * 1024) + lane;
#pragma unroll
                for (int j = 0; j < 4; ++j) xnext[tk][j] = xr[64 * j]; } }
        float s[NR];
#pragma unroll
        for (int tk = 0; tk < NR; ++tk) { float a = 0.f;
#pragma unroll
            for (int j = 0; j < 4; ++j) a += (hn[tk][j].x * hn[tk][j].x + hn[tk][j].y * hn[tk][j].y) + (hn[tk][j].z * hn[tk][j].z + hn[tk][j].w * hn[tk][j].w);
            s[tk] = a; }
#pragma unroll
        for (int tk = 0; tk < NR; ++tk) { float a = s[tk];
            a += dpp_f<0xB1>(a); a += dpp_f<0x4E>(a); a += dpp_f<0x141>(a); a += dpp_f<0x128>(a);
            { const auto rr = __builtin_amdgcn_permlane16_swap(__float_as_uint(a), __float_as_uint(a), false, false); a = __uint_as_float(rr[0]) + __uint_as_float(rr[1]); }
            { const auto rr = __builtin_amdgcn_permlane32_swap(__float_as_uint(a), __float_as_uint(a), false, false); a = __uint_as_float(rr[0]) + __uint_as_float(rr[1]); }
            s[tk] = a; }
#pragma unroll
        for (int tk = 0; tk < NR; ++tk) {
            const float rstd = 1.0f / sqrtf(s[tk] * (1.f / DM) + EPS);
            if (lane == 0) rsl[NR * it + tk] = rstd;
#pragma unroll
            for (int j = 0; j < 4; ++j) { const f32x4 v = hn[tk][j] * rstd * gg[j];
                *((GAS unsigned*)(h2f8 + (tok0 + NR * it + tk) * DM) + lane + 64 * j) = pk4_f8(v.x, v.y, v.z, v.w); }
        }
    }
    f32x16 acc = {};
    { const size_t tq = tok0 + r32; const GAS bf16_t* hp = (const GAS bf16_t*)F.out + tq * 2048 + (tq & 1) * 1024 + 8 * hi;
      const LAS unsigned char* wp = F.lds + RL_WHI + r32 * RL_WROW + 16 * hi;
#pragma unroll 8
      for (int kk = 0; kk < 64; ++kk) { const bf16x8 hb = *(const GAS bf16x8*)(hp + 16 * kk);
          const bf16x8 wh = *(const LAS bf16x8*)(wp + 32 * kk), wl = *(const LAS bf16x8*)(wp + RL_WLO + 32 * kk);
          acc = MFMA32(wh, hb, acc); acc = MFMA32(wl, hb, acc); } }
    float lg[16];
    const float rstd_t = rsl[r32];
#pragma unroll
    for (int r = 0; r < 16; ++r) lg[r] = acc[r] * rstd_t + b_router[crow(r, hi)];
    float lv[4]; int li[4];
#pragma unroll
    for (int k = 0; k < 4; ++k) { float bv = lg[0]; int br = 0;
#pragma unroll
        for (int r = 1; r < 16; ++r) { const bool g = lg[r] > bv; bv = g ? lg[r] : bv; br = g ? r : br; }
        lv[k] = bv; li[k] = crow(br, hi);
#pragma unroll
        for (int r = 0; r < 16; ++r) lg[r] = (r == br) ? -INFINITY : lg[r]; }
    float ov[4]; int oi[4];
#pragma unroll
    for (int k = 0; k < 4; ++k) { const auto rv = __builtin_amdgcn_permlane32_swap(__float_as_uint(lv[k]), __float_as_uint(lv[k]), false, false); const auto ri = __builtin_amdgcn_permlane32_swap((unsigned)li[k], (unsigned)li[k], false, false);
        ov[k] = hi ? __uint_as_float(rv[0]) : __uint_as_float(rv[1]); oi[k] = hi ? (int)ri[0] : (int)ri[1]; }
    float tv[4]; int te[4];
    { float a0 = lv[0], a1 = lv[1], a2 = lv[2], a3 = lv[3], b0 = ov[0], b1 = ov[1], b2 = ov[2], b3 = ov[3];
      int i0 = li[0], i1 = li[1], i2 = li[2], i3 = li[3], j0 = oi[0], j1 = oi[1], j2 = oi[2], j3 = oi[3];
#pragma unroll
      for (int k = 0; k < 4; ++k) { const bool ta = (a0 > b0) || (a0 == b0 && i0 < j0);
          tv[k] = ta ? a0 : b0; te[k] = ta ? i0 : j0;
          if (ta) { a0 = a1; a1 = a2; a2 = a3; a3 = -INFINITY; i0 = i1; i1 = i2; i2 = i3; i3 = 64; }
          else { b0 = b1; b1 = b2; b2 = b3; b3 = -INFINITY; j0 = j1; j1 = j2; j2 = j3; j3 = 64; } } }
    const float e1 = __expf(tv[1] - tv[0]), e2x = __expf(tv[2] - tv[0]), e3 = __expf(tv[3] - tv[0]);
    const float inv = 1.0f / (1.0f + e1 + e2x + e3);
    if (hi == 0) { const int tl = 32 * wave + r32;
        *(LAS int*)(tke + tl * 4 + 0) = te[0]; tke[tl * 4 + 1] = te[1]; tke[tl * 4 + 2] = te[2]; tke[tl * 4 + 3] = te[3];
        tkw[tl * 4 + 0] = inv; tkw[tl * 4 + 1] = e1 * inv; tkw[tl * 4 + 2] = e2x * inv; tkw[tl * 4 + 3] = e3 * inv;
#pragma unroll
        for (int k = 0; k < 4; ++k) __hip_atomic_fetch_add((LAS unsigned*)F.MISC + MW_LCNT + te[k], 1u, __ATOMIC_RELAXED, __HIP_MEMORY_SCOPE_WORKGROUP); }
    __syncthreads();
    if (tid < 32) ((int*)(F.ws + WS_BLKCNT))[F.blk * 32 + tid] = (int)F.MISC[MW_LCNT + tid];
}
__device__ __forceinline__ void p10_assign(Frame& F) {
    const int tid = F.tid;
    const int* blkcnt = (const int*)(F.ws + WS_BLKCNT);
    LAS int* part = (LAS int*)(F.lds);
    LAS int* tke = (LAS int*)(F.lds + RL_TKE); LAS float* tkw = (LAS float*)(F.lds + RL_TKW);
    { const int e = tid & 31, p = tid >> 5; int tot = 0, bef = 0;
      for (int j = 0; j < 16; ++j) { const int bl = p * 16 + j; const int c = blkcnt[bl * 32 + e]; tot += c; bef += (bl < F.blk) ? c : 0; }
      part[p * 32 + e] = tot; part[512 + p * 32 + e] = bef; }
    __syncthreads();
    if (tid < 32) { int tot = 0, bef = 0;
        for (int p = 0; p < 16; ++p) { tot += part[p * 32 + tid]; bef += part[512 + p * 32 + tid]; }
        part[1024 + tid] = tot; F.MISC[MW_BEFORE + tid] = (unsigned)bef; F.MISC[MW_LCNT + tid] = 0u; }
    __syncthreads();
    if (tid == 0) { int ps = 0;
        for (int e = 0; e < 32; ++e) { F.MISC[MW_PSTART + e] = (unsigned)ps; F.MISC[MW_TSTART + e] = (unsigned)(ps >> 8); ps += (part[1024 + e] + 255) & ~255; }
        F.MISC[MW_PSTART + 32] = (unsigned)ps; F.MISC[MW_TSTART + 32] = (unsigned)(ps >> 8); }
    __syncthreads();
    int* slot_tok = (int*)(F.ws + WS_SLOT_TOK); int* tok_slot = (int*)(F.ws + WS_TOK_SLOT); float* tok_gate = (float*)(F.ws + WS_TOK_GATE);
    for (int idx = tid; idx < 1024; idx += NWAVES * 64) {
        const int e = tke[idx]; const float w = tkw[idx];
        const unsigned r = __hip_atomic_fetch_add((LAS unsigned*)F.MISC + MW_LCNT + e, 1u, __ATOMIC_RELAXED, __HIP_MEMORY_SCOPE_WORKGROUP);
        const unsigned pos = F.MISC[MW_PSTART + e] + F.MISC[MW_BEFORE + e] + r;
        slot_tok[pos] = F.blk * 256 + (idx >> 2); tok_slot[F.blk * 1024 + idx] = (int)pos; tok_gate[F.blk * 1024 + idx] = w;
    }
}

__device__ __forceinline__ void p13_combine(Frame& F) {
    const int gw = F.blk * NWAVES + F.wave, NGW = F.G * NWAVES, lane = F.lane;
    const int* tok_slot = (const int*)(F.ws + WS_TOK_SLOT); const float* tok_gate = (const float*)(F.ws + WS_TOK_GATE);
    const GAS unsigned char* Y = (const GAS unsigned char*)(F.ws + WS_Y);
    typedef float f2_t __attribute__((ext_vector_type(2)));
    constexpr int NT = 2;
    for (int t0 = gw; t0 < NTOK; t0 += NT * NGW) {
        u32x4 y[NT][4]; u32x4 xb[NT][2]; float g[NT][4];
#pragma unroll
        for (int tk = 0; tk < NT; ++tk) { const int t = t0 + tk * NGW;
#pragma unroll
            for (int k = 0; k < 4; ++k) { const int sl = __builtin_amdgcn_readfirstlane(tok_slot[4 * t + k]); g[tk][k] = tok_gate[4 * t + k];
                y[tk][k] = *(const GAS u32x4*)(Y + (size_t)sl * DM + 16 * lane); }
            const GAS bf16_t* xrow = (const GAS bf16_t*)F.out + (size_t)t * 2048 + (t & 1) * 1024 + 16 * lane;
            xb[tk][0] = *(const GAS u32x4*)xrow; xb[tk][1] = *(const GAS u32x4*)(xrow + 8); }
        asm volatile("s_waitcnt vmcnt(0)" ::: "memory");
#pragma unroll
        for (int tk = 0; tk < NT; ++tk) { const int t = t0 + tk * NGW;
            f32x4 o[4];
#pragma unroll
            for (int h = 0; h < 2; ++h) { const u32x4 v = xb[tk][h];
                o[2 * h] = (f32x4){bflo(v.x), bfhi(v.x), bflo(v.y), bfhi(v.y)}; o[2 * h + 1] = (f32x4){bflo(v.z), bfhi(v.z), bflo(v.w), bfhi(v.w)}; }
#pragma unroll
            for (int k = 0; k < 4; ++k) { const float w = g[tk][k];
#pragma unroll
                for (int c = 0; c < 4; ++c) { const f2_t lo = __builtin_amdgcn_cvt_pk_f32_fp8((int)y[tk][k][c], false), hi = __builtin_amdgcn_cvt_pk_f32_fp8((int)y[tk][k][c], true);
                    o[c][0] += w * lo[0]; o[c][1] += w * lo[1]; o[c][2] += w * hi[0]; o[c][3] += w * hi[1]; } }
            GAS float* orow = (GAS float*)F.out + (size_t)t * DM + 16 * lane;
#pragma unroll
            for (int c = 0; c < 4; ++c) *(GAS f32x4*)(orow + 4 * c) = o[c]; }
    }
}

#ifndef MK_ONE_LAUNCH
#define MK_ONE_LAUNCH 1
#endif
constexpr int N_PHASES = 14;
struct Args { const float* in[21]; float* out; unsigned char* ws; int ph_lo, ph_hi; };
static_assert(sizeof(Args) == 21 * 8 + 8 + 8 + 8, "no padding");

__global__ void __launch_bounds__(NWAVES * 64, 2) fwd_kernel(Args args) {
    extern __shared__ __attribute__((aligned(16))) unsigned char lds[];
    Frame F;
    F.lds = (LAS unsigned char*)lds;
    F.MISC = (volatile LAS unsigned*)(F.lds + MISC_OFF);
    F.tid = threadIdx.x; F.lane = F.tid & 63; F.wave = __builtin_amdgcn_readfirstlane(F.tid >> 6);
#define FRESH() do { F.lane = lane_id_fresh(); F.tid = F.wave * 64 + F.lane; } while (0)
    F.G = gridDim.x; F.blk = blockIdx.x;
    F.ws = args.ws; F.out = args.out; F.ctl = (gu32*)(args.ws + WS_CTL);
#pragma unroll
    for (int i = 0; i < 21; ++i) F.in[i] = args.in[i];
    for (int u = F.tid; u < (LDS_BYTES - MISC_OFF) / 4; u += NWAVES * 64) ((LAS unsigned*)(F.lds + MISC_OFF))[u] = 0u;
    __syncthreads();
    const int lo = args.ph_lo, hi = args.ph_hi;
    XcdBarrier bar; bar.bar = (unsigned*)(F.ctl + CW_BAR); bar.x = 0; bar.st = nullptr; bar.wave = F.wave;
    if (hi - lo > 1) bar = xcd_barrier_post((unsigned*)(F.ctl + CW_BAR), F.MISC + MW_BAR);
#ifndef STAG
#define STAG 0
#endif
#ifndef STAG11
#define STAG11 0
#endif
#ifndef STAG12
#define STAG12 0
#endif
#ifndef TPROBE12
#define TPROBE12 0
#endif
#ifndef TPROBE1
#define TPROBE1 0
#endif
#ifndef TPROBE5
#define TPROBE5 0
#endif
#ifndef STAG5
#define STAG5 0
#endif
#ifndef PH_MASK
#define PH_MASK 0x3fff
#endif
#define IN(k) (((PH_MASK >> (k)) & 1) && lo <= (k) && (k) < hi)
#ifndef REP_MASK
#define REP_MASK 0
#endif
#define NREP(k) (1 + ((REP_MASK >> (k)) & 1))
#define SEAM(k) do { if (IN(k) && IN((k) + 1)) xcd_barrier(bar); } while (0)
    unsigned char* ws = args.ws;
    bf16_t* proj = (bf16_t*)(ws + WS_P);

    if (IN(0)) for (int rep = 0; rep < NREP(0); ++rep) { if (rep) xcd_barrier(bar); FRESH(); p0_prologue(F); } SEAM(0);

    if (IN(1)) {
#ifdef PROBE_P1
        { pg8::DenseSched S; S.init(ws + WS_H, ws + WS_WIN, NTOK, PW, DM, F.G, F.blk); S.amask = PROBE_P1;
          pg8::EpiBf16<0> E{(bf16_t*)(ws + WS_END), PW, nullptr, 1023};
          pg8::gemm_phase<pg8::EpiBf16<0>, pg8::DenseSched, true>(F.lds, F.wave, DM, S, E); }
        xcd_barrier(bar);
#endif
        { pg8::DenseSched S; S.init(ws + WS_H, ws + WS_WIN, NTOK, PW, DM, F.G, F.blk); S.tp = TPROBE1;
          pg8::EpiBf16<0> E{proj, PW, nullptr};
          pg8::gemm_phase<pg8::EpiBf16<0>, pg8::DenseSched, true>(F.lds, F.wave, DM, S, E); }
        { pg8::DenseSched S; S.init(ws + WS_MEMN, ws + WS_WMKV, NMEM, DM, DM, F.G, F.blk);
          pg8::EpiBf16<0> E{(bf16_t*)(ws + WS_MKV), DM, nullptr};
          pg8::gemm_phase<pg8::EpiBf16<0>, pg8::DenseSched, true>(F.lds, F.wave, DM, S, E); }
    } SEAM(1);

    if (IN(2)) { FRESH(); if (REP_MASK & 4) { p2_prep(F, true); xcd_barrier(bar); } p2_prep(F); } SEAM(2);

    if (IN(3)) {
        FRESH();
        bf16_t* osb = (bf16_t*)(ws + WS_O); bf16_t* odsa = osb + (size_t)NTOK * 512; bf16_t* omem = odsa + (size_t)NTOK * 512;
#ifndef REP_DSA
#define REP_DSA 1
#endif
#ifndef REP_SB
#define REP_SB 1
#endif
#ifndef REP_MEM
#define REP_MEM 1
#endif
#ifndef NO_DSA
        for (int rep = 0; rep < REP_DSA; ++rep)
        for (int i = 0; i < 4; ++i) { const int p = 2 * F.blk + (i >> 1), b = p >> 4, cc = p & 15, c = (i & 1) ? 31 - cc : cc; dsa_unit(proj, odsa, (unsigned*)F.out + (size_t)F.blk * 131072, b, c, F.lds, F.tid, F.in[4], (const f32x2*)(ws + WS_ROPE)); }
#endif
        FRESH();
        const int gw = F.blk * NWAVES + F.wave, NGW = F.G * NWAVES;
#ifndef NO_SB
        for (int rep = 0; rep < REP_SB; ++rep)
        for (int it = gw; it < NB * 8 * 64; it += NGW) { const int qblk = 63 - (it >> 8), bh = it & 255; sb_item(proj, osb, bh >> 3, bh & 7, qblk, F.lds + F.wave * 4096, F.lane); }
#endif
#ifndef NO_MEM
        for (int rep = 0; rep < REP_MEM; ++rep) {
            __syncthreads();
            FRESH();
            for (int u = F.blk; u < NB * 4 * 2; u += F.G) mem_unit(proj, (const bf16_t*)(ws + WS_MKV), omem, u >> 3, (u >> 1) & 3, u & 1, F.lds, F.tid, F.in[6]);
        }
#endif
    } SEAM(3);

    if (IN(4)) {
        pg8::DenseSched S; S.init(ws + WS_H8, ws + WS_WG, NTOK, 3 * DM, DM / 2, F.G, F.blk);
        pg8::EpiGateU8 E{(unsigned char*)proj, F.in[11]};
        pg8::gemm_phase<pg8::EpiGateU8, pg8::DenseSched, true, true>(F.lds, F.wave, DM / 2, S, E);
    } SEAM(4);

    if (IN(5)) { pg8::MergeSched S; S.init(ws + WS_O, ws + WS_WB, NTOK, DM, F.G, F.blk); S.tp = TPROBE5; S.stag = STAG5;
        pg8::EpiMerge E{(const unsigned char*)proj, (bf16_t*)(ws + WS_H)};
        pg8::gemm_phase<pg8::EpiMerge, pg8::MergeSched, true>(F.lds, F.wave, 512, S, E); } SEAM(5);


    if (IN(8)) {
        pg8::DenseSched S; S.init(ws + WS_H, ws + WS_WO, NTOK, DM, DM, F.G, F.blk); S.stag = STAG;
        pg8::EpiResid E{F.in[0], (bf16_t*)F.out};
        pg8::gemm_phase<pg8::EpiResid, pg8::DenseSched, true>(F.lds, F.wave, DM, S, E);
    } SEAM(8);

    if (IN(9)) for (int rep = 0; rep < NREP(9); ++rep) { if (rep) xcd_barrier(bar); FRESH(); p9_router(F); } SEAM(9);
    if (IN(10)) for (int rep = 0; rep < NREP(10); ++rep) { if (rep) xcd_barrier(bar); FRESH(); p10_assign(F); } SEAM(10);

    if (IN(11)) {
        pg8::MoeSched S{(const char*)(ws + WS_H2F8), (const char*)(ws + WS_WEI), (const int*)(ws + WS_SLOT_TOK), F.MISC + MW_TSTART, DM / 2, 2048, 8, F.blk, STAG11};
        pg8::EpiSwiglu E{ws + WS_ACT8, F.in[18]};
        pg8::gemm_phase<pg8::EpiSwiglu, pg8::MoeSched, true, true>(F.lds, F.wave, DM / 2, S, E);
    } SEAM(11);

    if (IN(12)) {
        pg8::MoeSched S{(const char*)(ws + WS_ACT8), (const char*)(ws + WS_WEO), nullptr, F.MISC + MW_TSTART, DM / 2, DM, 4, F.blk, STAG12, TPROBE12};
        pg8::EpiY8 E{ws + WS_Y, F.in[20]};
        pg8::gemm_phase<pg8::EpiY8, pg8::MoeSched, true, true>(F.lds, F.wave, DM / 2, S, E);
    } SEAM(12);

    if (IN(13)) { FRESH(); p13_combine(F); }
#undef IN
#undef SEAM
}

extern "C" void kernel_launch(void* const* d_in, const int* in_sizes, int n_in, void* d_out, int out_size, void* d_ws, size_t ws_size, hipStream_t stream) {
    static int grid = 0;
    if (grid == 0) {
        if (n_in != 21 || in_sizes[0] != NTOK * DM || out_size != NTOK * DM || ws_size < WS_END) {
            fprintf(stderr, "kernel_launch: unexpected shapes: n_in %d in0 %d out %d ws %zu (need >= %zu); nothing launched\n", n_in, n_in > 0 ? in_sizes[0] : -1, out_size, ws_size, (size_t)WS_END); grid = -1; return; }
        int dev = 0, cus = 0, per_cu = 0;
        if (hipGetDevice(&dev) != hipSuccess || hipDeviceGetAttribute(&cus, hipDeviceAttributeMultiprocessorCount, dev) != hipSuccess) { fprintf(stderr, "kernel_launch: device query failed\n"); grid = -1; return; }
        if (hipFuncSetAttribute((const void*)fwd_kernel, hipFuncAttributeMaxDynamicSharedMemorySize, LDS_BYTES) != hipSuccess) { fprintf(stderr, "kernel_launch: hipFuncSetAttribute failed\n"); grid = -1; return; }
        if (hipOccupancyMaxActiveBlocksPerMultiprocessor(&per_cu, (const void*)fwd_kernel, NWAVES * 64, LDS_BYTES) != hipSuccess || per_cu < 1)
            fprintf(stderr, "kernel_launch: note: occupancy query reports %d workgroups per CU\n", per_cu);
        (void)hipGetLastError();
        grid = cus;
        if (grid != 256) { fprintf(stderr, "kernel_launch: this kernel is built for 256 CUs (got %d); nothing launched\n", grid); grid = -1; return; }
    }
    if (grid < 0) return;
    if (hipMemsetAsync((char*)d_ws + WS_CTL, 0, CTL_ZERO_BYTES, stream) != hipSuccess) { fprintf(stderr, "kernel_launch: hipMemsetAsync failed\n"); return; }
    Args a{};
    for (int i = 0; i < 21; ++i) a.in[i] = (const float*)d_in[i];
    a.out = (float*)d_out; a.ws = (unsigned char*)d_ws;
#if MK_ONE_LAUNCH
    const int cuts[2] = {0, N_PHASES}; const int nl = 1;
#else
    const int cuts[11] = {0, 1, 2, 3, 4, 5, 6, 7, 8, 9, N_PHASES}; const int nl = 10;
#endif
    for (int li = 0; li < nl; ++li) {
        a.ph_lo = cuts[li]; a.ph_hi = cuts[li + 1];
        hipLaunchKernelGGL(fwd_kernel, dim3(grid), dim3(NWAVES * 64), LDS_BYTES, stream, a);
        const hipError_t le = hipPeekAtLastError();
        if (le != hipSuccess) { fprintf(stderr, "kernel_launch: launch %d failed: %s\n", li, hipGetErrorName(le)); break; }
    }
}
```

```cpp
#include <hip/hip_runtime.h>
#include <cstdio>
#include <cstdint>

#define LAS __attribute__((address_space(3)))
#define GAS __attribute__((address_space(1)))
typedef unsigned short bf16_t;
typedef short bf16x8 __attribute__((ext_vector_type(8)));
typedef short s16x4 __attribute__((ext_vector_type(4)));
typedef short v4i16_t __attribute__((ext_vector_type(4)));
typedef float f32x2 __attribute__((ext_vector_type(2)));
typedef float f32x4 __attribute__((ext_vector_type(4)));
typedef float f32x16 __attribute__((ext_vector_type(16)));
typedef unsigned u32x2 __attribute__((ext_vector_type(2)));
typedef unsigned u32x4 __attribute__((ext_vector_type(4)));
typedef int i32x4 __attribute__((ext_vector_type(4)));
typedef int i32x8 __attribute__((ext_vector_type(8)));
typedef GAS unsigned gu32;

constexpr int NB = 32, SEQ = 2048, DM = 1024, NTOK = NB * SEQ;
constexpr int MEMLEN = 256, NMEM = NB * MEMLEN;
constexpr int PW = 3072;
constexpr int C_SQ = 0, C_SK = 512, C_SV = 1024, C_DQ = 1536, C_DK = 2048, C_DV = 2112, C_IQ = 2176, C_IK = 2432, C_IW = 2496, C_MQ = 2560;
constexpr int IN_W = 3012;
constexpr int NEXP = 32, TOPK = 4, DEXP = 1024;
constexpr int NSLOT = NTOK * TOPK;
constexpr int NSLOT_PAD = NSLOT + NEXP * 256;
constexpr float EPS = 1e-6f;
constexpr float LOG2E = 1.4426950408889634f;

constexpr size_t MiB = 1u << 20;
constexpr size_t WS_CTL = 0, CTL_ZERO_BYTES = 1 * MiB;
constexpr size_t WS_ROPE = 1 * MiB;
constexpr size_t WS_BLKCNT = 1 * MiB + 512 * 1024;
constexpr size_t WS_SLOT_TOK = 2 * MiB;
constexpr size_t WS_TOK_SLOT = 4 * MiB;
constexpr size_t WS_TOK_GATE = 5 * MiB;
constexpr size_t WS_WIN = 8 * MiB;
constexpr size_t WS_WMKV = 14 * MiB;
constexpr size_t WS_WG = 16 * MiB;
constexpr size_t WS_WB = 22 * MiB;
constexpr size_t WS_WO = 25 * MiB;
constexpr size_t WS_WEI = 27 * MiB;
constexpr size_t WS_WEO = 155 * MiB;
#ifndef NT_LOADS
#define NT_LOADS 1
#endif
#define NT_LD(p_) (NT_LOADS ? __builtin_nontemporal_load(p_) : *(p_))
__device__ __forceinline__ int lane_id_fresh() { int l; asm volatile("v_mbcnt_lo_u32_b32 %0, -1, 0\n\tv_mbcnt_hi_u32_b32 %0, -1, %0" : "=v"(l)); return l; }
__device__ __forceinline__ unsigned pk4_f8(float a, float b, float c, float d) { int v = __builtin_amdgcn_cvt_pk_fp8_f32(a, b, 0, false); return (unsigned)__builtin_amdgcn_cvt_pk_fp8_f32(c, d, v, true); }
constexpr float W8_SCALE = 64.f, W8_INV = 1.f / 64.f;
constexpr size_t WS_H = 220 * MiB;
constexpr size_t WS_P = 412 * MiB;
constexpr size_t WS_MERGED = 412 * MiB;
constexpr size_t WS_G = 796 * MiB;
constexpr size_t WS_O = 220 * MiB;
constexpr size_t WS_H8 = 91 * MiB;
constexpr size_t WS_H2F8 = 91 * MiB;
constexpr size_t WS_MEMN = 187 * MiB;
constexpr size_t WS_MKV = 203 * MiB;
constexpr size_t WS_Y = 220 * MiB;
constexpr size_t WS_ACT8 = 748 * MiB;
constexpr size_t WS_END = 1012 * MiB;
static_assert(WS_Y + (size_t)NSLOT_PAD * DM * 2 <= WS_ACT8 && WS_ACT8 + (size_t)NSLOT_PAD * DEXP <= WS_END, "y | act8");
static_assert(WS_SLOT_TOK + (size_t)NSLOT_PAD * 4 <= WS_TOK_SLOT && WS_TOK_GATE + (size_t)NTOK * 16 <= WS_WIN, "slot tables");
static_assert(WS_WEO + 32 * MiB <= WS_MEMN && WS_MEMN + 16 * MiB <= WS_MKV && WS_MKV + 16 * MiB <= WS_H, "memn | mkv");
static_assert(WS_H + 128 * MiB <= WS_P && WS_O + 192 * MiB <= WS_P && WS_P + 384 * MiB <= WS_G && WS_MERGED + 128 * MiB <= WS_G && WS_G + 192 * MiB <= WS_END, "h / o | proj / merged | gates");

constexpr int CW_BAR = 4096;

constexpr int RING_BYTES = 151552;
constexpr int MISC_OFF = RING_BYTES;
constexpr int LDS_BYTES = 155648;
constexpr int MW_BAR = 8;
constexpr int MW_LCNT = 16;
constexpr int MW_PSTART = 64;
constexpr int MW_TSTART = 128;
constexpr int MW_BEFORE = 192;
constexpr int MW_PART = 256;

__device__ __forceinline__ unsigned f2bf(float f) { unsigned u = __builtin_bit_cast(unsigned, f); return (u + 0x7fffu + ((u >> 16) & 1u)) >> 16; }
__device__ __forceinline__ unsigned pk2(float lo, float hi) { return f2bf(lo) | (f2bf(hi) << 16); }
__device__ __forceinline__ float bf2f(unsigned short b) { return __builtin_bit_cast(float, (unsigned)b << 16); }
__device__ __forceinline__ float bflo(unsigned w) { return __builtin_bit_cast(float, w << 16); }
__device__ __forceinline__ float bfhi(unsigned w) { return __builtin_bit_cast(float, w & 0xffff0000u); }
__device__ __forceinline__ unsigned cvt_pk_bf16(float lo, float hi) { unsigned r; asm volatile("v_cvt_pk_bf16_f32 %0, %1, %2" : "=v"(r) : "v"(lo), "v"(hi)); return r; }
__device__ __forceinline__ int crow(int r, int hi) { return (r & 3) + 8 * (r >> 2) + 4 * hi; }
#define LDS_WAIT() asm volatile("s_waitcnt lgkmcnt(0)" ::: "memory")
#define VM_WAIT() asm volatile("s_waitcnt vmcnt(0)" ::: "memory")

#ifndef PRIO_STATIC
#define PRIO_STATIC 0
#endif
#ifndef PRIO_MMA
#define PRIO_MMA 3
#endif
namespace pg8 {
constexpr int BM = 256, BK = 64, HALF = 128, HTB = HALF * BK * 2, STAGE_BYTES = 8 * HTB;
__host__ __device__ __forceinline__ int lds_byte(int r, int c) { const int st = (r >> 4) * 2 + (c >> 5), rr = r & 15, cc = c & 31, ob = rr * 64 + cc * 2; return st * 1024 + (ob ^ (((ob >> 9) & 1) << 5)); }
__host__ __device__ __forceinline__ void stage_rc(int b, int& R, int& C) { const int st = b / 1024, sb = b % 1024, swz = sb ^ (((sb >> 9) & 1) << 5); R = (st >> 1) * 16 + swz / 64; C = (st & 1) * 32 + (swz % 64) / 2; }
__host__ __device__ __forceinline__ int perm32(int rho) { const int n = rho >> 4, i = rho & 15; return 8 * (i >> 2) + 4 * n + (i & 3); }
__host__ __device__ __forceinline__ int perm256b(int R) { return 64 * ((R >> 5) & 3) + 8 * ((R & 15) >> 2) + 4 * ((R >> 4) & 1) + (R & 3); }
__host__ __device__ __forceinline__ int perm256(int R) { return 64 * ((R >> 5) & 3) + 16 * ((R & 15) >> 2) + 4 * ((R >> 4) & 1) + (R & 3); }

struct Unit { int pm, pn, e; };
constexpr int EPI_NA_OFF = STAGE_BYTES;
constexpr int ROWTAB_OFF = STAGE_BYTES + 8192;
constexpr int BIASTAB_OFF = STAGE_BYTES + 10240;

template <class Epi, class Sched, bool ALIGN_EPI, bool FP8 = false>
__device__ __forceinline__ void gemm_phase(LAS unsigned char* lds, const int wave_, const int K, const Sched& S, const Epi& E) {
    constexpr bool LEAN = FP8 || Epi::KEEP_ACC;
    int tid = wave_ * 64 + lane_id_fresh();
    const int wid = __builtin_amdgcn_readfirstlane(tid >> 6), lane = tid & 63, wr = wid >> 2, wc = wid & 3, fr = lane & 15, fq = lane >> 4;
    const int nt = K / BK;
    int Rr[2], Cc[2]; unsigned voffB[2];
#pragma unroll
    for (int i = 0; i < 2; ++i) { int R, C; stage_rc(tid * 16 + i * 8192, R, C); Rr[i] = R; Cc[i] = C; const int Rb = Epi::PERM == 3 ? perm256b(R) : Epi::PERM == 2 ? perm256(R) : Epi::PERM ? ((R & ~31) + perm32(R & 31)) : R; voffB[i] = (unsigned)(Rb * K + C) * 2u; }
    const size_t kstep = (size_t)(BK * 2);
    const size_t hstepB = (size_t)(Epi::PERM == 3 ? 32 : Epi::PERM == 2 ? 8 : HALF) * K * 2;
    const unsigned ldsw = (unsigned)wid * 1024u;
    const int aoff = lds_byte(wr * 64 + fr, fq * 8), boff = lds_byte(wc * 32 + fr, fq * 8);
#define PG8_SA(b, h) (((b) * 2 + (h)) * HTB)
#define PG8_SB(b, h) ((4 + (b) * 2 + (h)) * HTB)
#define PG8_STAGE(bufoff, gbase, voff) do { _Pragma("unroll") for (int _i = 0; _i < 2; ++_i) { unsigned o_ = (voff)[_i]; asm volatile("" : "+v"(o_)); \
        __builtin_amdgcn_global_load_lds((const unsigned*)((const char*)(gbase) + o_), (LAS unsigned*)(lds + (bufoff) + ldsw + _i * 8192), 16, 0, 0); } } while (0)
#define PG8_J8(x, y) __builtin_shufflevector(x, y, 0, 1, 2, 3, 4, 5, 6, 7)
#define PG8_LDA(dst, b, h) do { _Pragma("unroll") for (int m = 0; m < 4; ++m) { const LAS unsigned char* p_ = lds + PG8_SA(b, h) + aoff + m * 2048; \
        if constexpr (FP8) dst##8[m] = PG8_J8(*(const LAS i32x4*)p_, *(const LAS i32x4*)(p_ + 1024)); else { dst[m][0] = *(const LAS bf16x8*)p_; dst[m][1] = *(const LAS bf16x8*)(p_ + 1024); } } } while (0)
#define PG8_LDB(dst, b, h) do { _Pragma("unroll") for (int n = 0; n < 2; ++n) { const LAS unsigned char* p_ = lds + PG8_SB(b, h) + boff + n * 2048; \
        if constexpr (FP8) dst##8[n] = PG8_J8(*(const LAS i32x4*)p_, *(const LAS i32x4*)(p_ + 1024)); else { dst[n][0] = *(const LAS bf16x8*)p_; dst[n][1] = *(const LAS bf16x8*)(p_ + 1024); } } } while (0)
#define PG8_MMA(ai, bj, At, Bt) do { if (!PRIO_STATIC) __builtin_amdgcn_s_setprio(PRIO_MMA); _Pragma("unroll") for (int m = 0; m < 4; ++m) _Pragma("unroll") for (int n = 0; n < 2; ++n) { \
        if constexpr (FP8) acc[ai][bj][m][n] = __builtin_amdgcn_mfma_scale_f32_16x16x128_f8f6f4(Bt##8[n], At##8[m], acc[ai][bj][m][n], 0, 0, 0, 0, 0, 0); \
        else { _Pragma("unroll") for (int k = 0; k < 2; ++k) acc[ai][bj][m][n] = __builtin_amdgcn_mfma_f32_16x16x32_bf16(Bt[n][k], At[m][k], acc[ai][bj][m][n], 0, 0, 0); } } \
        if (!PRIO_STATIC) __builtin_amdgcn_s_setprio(0); } while (0)
#define PG8_WAIT_V(n) asm volatile("s_waitcnt vmcnt(" #n ")" ::: "memory")
#define PG8_WAIT_VR do { if (!(t == 0 && ui > 0)) PG8_WAIT_V(8); } while (0)
#define PG8_WAIT_L(n) asm volatile("s_waitcnt lgkmcnt(" #n ")" ::: "memory")
#define PG8_BAR __builtin_amdgcn_s_barrier()
#define PG8_SCHED __builtin_amdgcn_sched_barrier(0)
#define PG8_TIDQ() (wave_ * 64 + lane_id_fresh())
#define PG8_SIDE(gptr, off) __builtin_amdgcn_global_load_lds((const unsigned*)(gptr), (LAS unsigned*)(lds + (off)), 16, 0, 0)
    Unit cur, nxt, nx2; int ui = 0;
    if (!S.next(0, cur)) return;
    if (PRIO_STATIC) { if (wr == 1) __builtin_amdgcn_s_setprio(1); }
    { const int ns = S.stagger();
      for (int q = 0; q < ns; ++q) __builtin_amdgcn_s_sleep(4); }
    bool has_next = S.next(1, nxt);
    if (S.gather()) { if (wid == 0) { PG8_SIDE(S.row_table(cur) + 4 * lane, ROWTAB_OFF); if (has_next) PG8_SIDE(S.row_table(nxt) + 4 * lane, ROWTAB_OFF + 1024); }
        PG8_WAIT_V(0); PG8_BAR; }
    f32x4 acc[2][2][4][2];
    bf16x8 At[4][2], B0[2][2], B1[2][2]; i32x8 At8[4], B08[2], B18[2];
    const char* Ab = S.a_base();
    unsigned ca0[2], ca1[2], na0[2], na1[2];
#pragma unroll
    for (int i = 0; i < 2; ++i) { ca0[i] = S.a_off(cur, Rr[i], Cc[i], (const LAS int*)(lds + ROWTAB_OFF)); ca1[i] = S.a_off(cur, HALF + Rr[i], Cc[i], (const LAS int*)(lds + ROWTAB_OFF)); }
    const char* cB = S.b_tile(cur);
    PG8_STAGE(PG8_SB(0, 0), cB, voffB); PG8_STAGE(PG8_SB(0, 1), cB + hstepB, voffB); PG8_STAGE(PG8_SA(0, 0), Ab, ca0); PG8_STAGE(PG8_SA(0, 1), Ab, ca1);
    if (wr == 1) PG8_BAR;
    PG8_WAIT_V(2); PG8_BAR;
    PG8_STAGE(PG8_SB(1, 0), cB + kstep, voffB); PG8_STAGE(PG8_SA(1, 0), Ab + kstep, ca0); PG8_STAGE(PG8_SB(1, 1), cB + hstepB + kstep, voffB);
    PG8_WAIT_V(6); PG8_BAR;
#ifdef PROBE_T
    unsigned long long tq_acc = 0, tq0 = 0;
#define TQ_BEGIN(k) do { if (PROBE_T == (k)) tq0 = __builtin_amdgcn_s_memtime(); } while (0)
#define TQ_END(k) do { if (PROBE_T == (k)) tq_acc += __builtin_amdgcn_s_memtime() - tq0; } while (0)
#else
#define TQ_BEGIN(k)
#define TQ_END(k)
#endif
    for (;;) {
        TQ_BEGIN(4);
        const bool has_nx2 = has_next && S.next(ui + 2, nx2);
        const char* nB = cB;
#pragma unroll
        for (int i = 0; i < 2; ++i) { na0[i] = ca0[i]; na1[i] = ca1[i]; }
        if (has_next) { nB = S.b_tile(nxt); const LAS int* tab = (const LAS int*)(lds + ROWTAB_OFF + ((ui + 1) & 1) * 1024);
#pragma unroll
            for (int i = 0; i < 2; ++i) { int R, C; int tq = tid; if constexpr (LEAN) tq = PG8_TIDQ();
                stage_rc(tq * 16 + i * 8192, R, C);
                na0[i] = S.a_off(nxt, R, C, tab); na1[i] = S.a_off(nxt, HALF + R, C, tab); } }
#define PG8_NAST(v) const unsigned v = (unsigned)(EPI_NA_OFF + PG8_TIDQ() * 16)
        if constexpr (LEAN) { PG8_NAST(nast); *(LAS u32x4*)(lds + nast) = (u32x4){na0[0], na0[1], na1[0], na1[1]}; }
        if (S.gather()) { PG8_WAIT_L(0);
            if (wid == 0 && has_nx2) PG8_SIDE(S.row_table(nx2) + 4 * lane_id_fresh(), ROWTAB_OFF + (ui & 1) * 1024); }
        if constexpr (Epi::HAS_BIAS) { if (wid == 1) PG8_SIDE(E.bias_src(cur, lane_id_fresh()), BIASTAB_OFF + (ui & 1) * 1024); }
        if (!(Epi::KEEP_ACC && cur.e != 0))
#pragma unroll
        for (int a = 0; a < 2; ++a)
#pragma unroll
            for (int b = 0; b < 2; ++b)
#pragma unroll
                for (int m = 0; m < 4; ++m)
#pragma unroll
                    for (int n = 0; n < 2; ++n) acc[a][b][m][n] = (f32x4){0.f, 0.f, 0.f, 0.f};
        TQ_END(4); TQ_BEGIN(1);
#pragma unroll 1
        for (int t = 0; t < nt; t += 2) {
            if (t == 0) TQ_BEGIN(5); if (t == 2) { TQ_END(5); TQ_BEGIN(6); }
            const bool last = (t == nt - 2);
            const char* a1 = Ab + (size_t)(t + 1) * kstep;
            const char* a2 = last ? Ab : Ab + (size_t)(t + 2) * kstep; const char* b2 = last ? nB : cB + (size_t)(t + 2) * kstep;
            const char* a3 = a2 + kstep; const char* b3 = b2 + kstep;
            if constexpr (LEAN) { asm volatile("" : "+s"(a1), "+s"(a2), "+s"(b2), "+s"(a3), "+s"(b3)); }
            unsigned o20[2], o21[2];
#pragma unroll
            for (int i = 0; i < 2; ++i) { o20[i] = last ? na0[i] : ca0[i]; o21[i] = last ? na1[i] : ca1[i]; }
            if constexpr (LEAN) { if (last) { PG8_NAST(nast); const u32x4 nv = *(const LAS u32x4*)(lds + nast); o20[0] = nv.x; o20[1] = nv.y; o21[0] = nv.z; o21[1] = nv.w; } }
            PG8_LDB(B0, 0, 0); PG8_LDB(B1, 0, 1); PG8_SCHED; PG8_LDA(At, 0, 0); PG8_STAGE(PG8_SA(1, 1), a1, ca1);
            PG8_WAIT_VR; PG8_WAIT_L(0); PG8_BAR; PG8_MMA(0, 0, At, B0); PG8_MMA(0, 1, At, B1); PG8_BAR; PG8_SCHED;
            PG8_LDA(At, 0, 1); PG8_STAGE(PG8_SB(0, 0), b2, voffB); PG8_STAGE(PG8_SB(0, 1), b2 + hstepB, voffB); PG8_STAGE(PG8_SA(0, 0), a2, o20);
            PG8_WAIT_VR; PG8_WAIT_L(0); PG8_BAR; PG8_MMA(1, 0, At, B0); PG8_MMA(1, 1, At, B1); PG8_BAR; PG8_SCHED;
            PG8_LDB(B0, 1, 0); PG8_LDB(B1, 1, 1); PG8_SCHED; PG8_LDA(At, 1, 0); PG8_STAGE(PG8_SA(0, 1), a2, o21);
            PG8_WAIT_VR; PG8_WAIT_L(0); PG8_BAR; PG8_MMA(0, 0, At, B0); PG8_MMA(0, 1, At, B1); PG8_BAR; PG8_SCHED;
            PG8_LDA(At, 1, 1); PG8_STAGE(PG8_SB(1, 0), b3, voffB); PG8_STAGE(PG8_SB(1, 1), b3 + hstepB, voffB); PG8_STAGE(PG8_SA(1, 0), a3, o20);
            PG8_WAIT_V(8); PG8_WAIT_L(0); PG8_BAR; PG8_MMA(1, 0, At, B0); PG8_MMA(1, 1, At, B1); PG8_BAR; PG8_SCHED;
        }
        TQ_END(6); TQ_END(1); TQ_BEGIN(2);
        PG8_WAIT_V(0);
        if constexpr (ALIGN_EPI) { if (wr == 0) PG8_BAR; }
        TQ_END(2); TQ_BEGIN(3);
        { const LAS float* bt = (const LAS float*)(lds + BIASTAB_OFF + (ui & 1) * 1024);
          if constexpr (LEAN) { const int lq = lane_id_fresh();
              E(acc, cur, wr, wc, lq & 15, (lq >> 4) & 3, bt); }
          else E(acc, cur, wr, wc, fr, fq, bt); }
        TQ_END(3);
        if (!has_next) break;
        cur = nxt; nxt = nx2; has_next = has_nx2; cB = nB; ++ui;
#pragma unroll
        for (int i = 0; i < 2; ++i) { ca0[i] = na0[i]; ca1[i] = na1[i]; }
        if constexpr (LEAN) { PG8_NAST(nast); const u32x4 nv = *(const LAS u32x4*)(lds + nast); ca0[0] = nv.x; ca0[1] = nv.y; ca1[0] = nv.z; ca1[1] = nv.w; }
        if constexpr (ALIGN_EPI) { if (wr == 1) PG8_BAR; }
    }
    PG8_WAIT_V(0);
    if constexpr (!ALIGN_EPI) { if (wr == 0) PG8_BAR; }
    PG8_BAR;
    if (PRIO_STATIC) __builtin_amdgcn_s_setprio(0);
#ifdef PROBE_T
    if (S.tprobe()) { const unsigned long long r1 = __builtin_amdgcn_s_memrealtime();
        while (__builtin_amdgcn_s_memrealtime() - r1 < tq_acc * 4ull * 10ull / 175ull) __builtin_amdgcn_s_sleep(8); }
#endif
#undef PG8_SA
#undef PG8_SB
#undef PG8_STAGE
#undef PG8_LDA
#undef PG8_LDB
#undef PG8_MMA
#undef PG8_NAST
#undef PG8_J8
#undef PG8_WAIT_V
#undef PG8_WAIT_VR
#undef PG8_WAIT_L
#undef PG8_BAR
#undef PG8_SCHED
#undef PG8_TIDQ
#undef PG8_SIDE
}

struct DenseSched {
    const char* A; const char* Bt; int K, nM, nN, nwg, G, c, stag = 0, amask = -1, tp = 0, split = 0;
    __device__ __forceinline__ void init(const void* A_, const void* Bt_, int M, int N, int K_, int G_, int c_) { A = (const char*)A_; Bt = (const char*)Bt_; K = K_; nM = M / BM; nN = N / BM; nwg = nM * nN; G = G_; c = c_; }
    __device__ __forceinline__ bool next(int i, Unit& u) const {
        long L = (long)i * G + c;
        if (split) { if (i >= 11) { if (c < 128 || i >= 13) return false; L = 2816 + 2 * (c - 128) + (i - 11); } }
        if (L >= nwg) return false;
        int wgid = (int)L; { const int q = nwg / 8, r = nwg % 8, xcd = wgid % 8, off = wgid / 8; wgid = (xcd < r ? xcd * (q + 1) : r * (q + 1) + (xcd - r) * q) + off; }
        const int nig = 8 * nN, gid = wgid / nig, fm = gid * 8, gsz = (nM - fm) < 8 ? (nM - fm) : 8;
        u.pm = fm + ((wgid % nig) % gsz); u.pn = (wgid % nig) / gsz; u.e = 0; return true;
    }
    __device__ __forceinline__ const char* a_base() const { return A; }
    __device__ __forceinline__ int stagger() const { return stag ? ((c >> 3) & 7) * (K / 55) : 0; }
    __device__ __forceinline__ int tprobe() const { return tp; }
    __device__ __forceinline__ bool gather() const { return false; }
    __device__ __forceinline__ const int* row_table(const Unit&) const { return nullptr; }
    __device__ __forceinline__ unsigned a_off(const Unit& u, int row, int col, const LAS int* = nullptr) const { return (unsigned)(((size_t)((u.pm * BM + row) & amask) * K + col) * 2); }
    __device__ __forceinline__ int a_row(const Unit& u, int row) const { return (u.pm * BM + row) & amask; }
    __device__ __forceinline__ unsigned row_off(int r, int col) const { return (unsigned)(((size_t)r * K + col) * 2); }
    __device__ __forceinline__ const char* b_tile(const Unit& u) const { return Bt + (size_t)u.pn * BM * K * 2; }
};
}

namespace pg8 {
struct MoeSched {
    const char* A; const char* Bt; const int* slot_tok; volatile LAS unsigned* tstart; int K, rowsE, nN, c, stag = 0, tp = 0;
    __device__ __forceinline__ bool next(int i, Unit& u) const {
        const int x = c & 7, j = c >> 3, rpr = 32 / nN;
        const int pm = (i * 8 + x) * rpr + j / nN;
        const int l = lane_id_fresh(); const int tv = (int)tstart[l < 32 ? l : 32];
        const int T = __builtin_amdgcn_readlane(tv, 32);
        if (pm >= T) return false;
        const unsigned long long bal = __ballot(l >= 1 && l < 32 && tv <= pm);
        u.pm = pm; u.pn = j % nN; u.e = (int)__builtin_popcountll(bal); return true;
    }
    __device__ __forceinline__ const char* a_base() const { return A; }
    __device__ __forceinline__ int stagger() const { const int g = (c >> 3) / nN, ng = 32 / nN; return stag * g / ng; }
    __device__ __forceinline__ int tprobe() const { return tp; }
    __device__ __forceinline__ bool gather() const { return slot_tok != nullptr; }
    __device__ __forceinline__ const int* row_table(const Unit& u) const { return slot_tok + u.pm * BM; }
    __device__ __forceinline__ unsigned a_off(const Unit& u, int row, int col, const LAS int* tab) const {
        const int r = slot_tok ? tab[row] : u.pm * BM + row;
        return (unsigned)(((size_t)r * K + col) * 2);
    }
    __device__ __forceinline__ const char* b_tile(const Unit& u) const { return Bt + ((size_t)u.e * rowsE + (size_t)u.pn * BM) * K * 2; }
};

struct MergeSched {
    const char* A; const char* Bt; int nM, nN, nwg, G, c, tp = 0, stag = 0;
    __device__ __forceinline__ void init(const void* A_, const void* Bt_, int M, int N, int G_, int c_) { A = (const char*)A_; Bt = (const char*)Bt_; nM = M / BM; nN = N / BM; nwg = nM * nN; G = G_; c = c_; }
    __device__ __forceinline__ bool next(int i, Unit& u) const {
        const int r = i / 3; const long L = (long)r * G + c; if (L >= nwg) return false;
        int wgid = (int)L; { const int q = nwg / 8, rr = nwg % 8, xcd = wgid % 8, off = wgid / 8; wgid = (xcd < rr ? xcd * (q + 1) : rr * (q + 1) + (xcd - rr) * q) + off; }
        const int nig = 8 * nN, gid = wgid / nig, fm = gid * 8, gsz = (nM - fm) < 8 ? (nM - fm) : 8;
        u.pm = fm + ((wgid % nig) % gsz); u.pn = (wgid % nig) / gsz; u.e = i - 3 * r; return true;
    }
    __device__ __forceinline__ const char* a_base() const { return A; }
    __device__ __forceinline__ int stagger() const { return ((c >> 3) & 1) ? stag : 0; }
    __device__ __forceinline__ int tprobe() const { return tp; }
    __device__ __forceinline__ bool gather() const { return false; }
    __device__ __forceinline__ const int* row_table(const Unit&) const { return nullptr; }
    __device__ __forceinline__ unsigned a_off(const Unit& u, int row, int col, const LAS int* = nullptr) const { return (unsigned)(((size_t)(u.pm * BM + row) * 512 + col) * 2 + (size_t)u.e * ((size_t)NTOK * 512 * 2)); }
    __device__ __forceinline__ const char* b_tile(const Unit& u) const { return Bt + ((size_t)u.e * DM + (size_t)u.pn * BM) * 512 * 2; }
};

__device__ __forceinline__ void store_rowpair_bf16(bf16_t* rowp, size_t pitch, const u32x4 w0, const u32x4 w1, int odd) {
    const u32x4 snd = odd ? w0 : w1; u32x4 rcv;
#pragma unroll
    for (int q = 0; q < 4; ++q) rcv[q] = (unsigned)__builtin_amdgcn_update_dpp(0, (int)snd[q], 0xB1, 0xF, 0xF, false);
    *(u32x4*)rowp = odd ? rcv : w0;
    *(u32x4*)(rowp + pitch) = odd ? w1 : rcv;
}
template <int ACT> struct EpiBf16 {
    static constexpr int PERM = 2; static constexpr bool HAS_BIAS = false, KEEP_ACC = false;
    bf16_t* O; int ldc; const float* bias; int rowmask = -1;
    __device__ __forceinline__ const float* bias_src(const Unit&, int) const { return nullptr; }
    __device__ __forceinline__ void operator()(const f32x4 (&acc)[2][2][4][2], const Unit& u, int wr, int wc, int fr, int fq, const LAS float*) const {
        const int odd = fr & 1;
        const int row0 = u.pm * BM + wr * 64 + (fr & ~1); const int col0 = u.pn * BM + wc * 64 + 16 * fq + 8 * odd;
#pragma unroll
        for (int ai = 0; ai < 2; ++ai)
#pragma unroll
            for (int m = 0; m < 4; ++m) { u32x4 w[2];
#pragma unroll
                for (int bj = 0; bj < 2; ++bj) { const f32x4 v0 = acc[ai][bj][m][0], v1 = acc[ai][bj][m][1];
                    w[bj].x = cvt_pk_bf16(v0[0], v0[1]); w[bj].y = cvt_pk_bf16(v0[2], v0[3]); w[bj].z = cvt_pk_bf16(v1[0], v1[1]); w[bj].w = cvt_pk_bf16(v1[2], v1[3]); }
                store_rowpair_bf16(O + (size_t)((row0 + ai * HALF + m * 16) & rowmask) * ldc + col0, (size_t)ldc, w[0], w[1], odd); }
    }
};
struct EpiGateU8 {
    static constexpr int PERM = 2; static constexpr bool HAS_BIAS = true, KEEP_ACC = false;
    unsigned char* G; const float* bias;
    __device__ __forceinline__ const float* bias_src(const Unit& u, int l) const { return bias + u.pn * BM + 4 * l; }
    __device__ __forceinline__ void operator()(const f32x4 (&acc)[2][2][4][2], const Unit& u, int wr, int wc, int fr, int fq, const LAS float* bt) const {
        const int row0 = u.pm * BM + wr * 64 + fr; const int cw = wc * 64 + 16 * fq;
        f32x4 bv[2][2];
#pragma unroll
        for (int bj = 0; bj < 2; ++bj)
#pragma unroll
            for (int n = 0; n < 2; ++n) bv[bj][n] = *(const LAS f32x4*)(bt + cw + 8 * bj + 4 * n);
#pragma unroll
        for (int ai = 0; ai < 2; ++ai)
#pragma unroll
            for (int m = 0; m < 4; ++m) { unsigned char* rowp = G + (size_t)(row0 + ai * HALF + m * 16) * PW + u.pn * BM + cw;
                unsigned pk[4];
#pragma unroll
                for (int bj = 0; bj < 2; ++bj)
#pragma unroll
                    for (int n = 0; n < 2; ++n) { const f32x4 v = acc[ai][bj][m][n] * W8_INV + bv[bj][n]; unsigned q[4];
#pragma unroll
                        for (int j = 0; j < 4; j += 2) {
                            const f32x2 ea = (f32x2){v[j], v[j + 1]} * (-LOG2E);
                            const f32x2 d = (f32x2){__builtin_amdgcn_exp2f(ea[0]), __builtin_amdgcn_exp2f(ea[1])} + 1.f;
                            const f32x2 qf = (f32x2){__builtin_amdgcn_rcpf(d[0]), __builtin_amdgcn_rcpf(d[1])} * 254.f + 1.5f;
                            q[j] = (unsigned)qf[0]; q[j + 1] = (unsigned)qf[1]; }
                        pk[2 * bj + n] = q[0] | (q[1] << 8) | (q[2] << 16) | (q[3] << 24); }
                u32x4 w; w.x = pk[0]; w.y = pk[1]; w.z = pk[2]; w.w = pk[3];
                *(u32x4*)rowp = w; }
    }
};
struct EpiY8 {
    static constexpr int PERM = 2; static constexpr bool HAS_BIAS = true, KEEP_ACC = false;
    unsigned char* Y; const float* bias; int nostore = 0;
    __device__ __forceinline__ const float* bias_src(const Unit& u, int l) const { return bias + u.e * DM + u.pn * BM + 4 * l; }
    __device__ __forceinline__ void operator()(const f32x4 (&acc)[2][2][4][2], const Unit& u, int wr, int wc, int fr, int fq, const LAS float* bt) const {
        const int row0 = u.pm * BM + wr * 64 + fr; const int cw = wc * 64 + 16 * fq;
        f32x4 bv[2][2];
#pragma unroll
        for (int bj = 0; bj < 2; ++bj)
#pragma unroll
            for (int n = 0; n < 2; ++n) bv[bj][n] = *(const LAS f32x4*)(bt + cw + 8 * bj + 4 * n);
#pragma unroll
        for (int ai = 0; ai < 2; ++ai)
#pragma unroll
            for (int m = 0; m < 4; ++m) { unsigned char* rowp = Y + (size_t)(row0 + ai * HALF + m * 16) * DM + u.pn * BM + cw;
                u32x4 w; unsigned pk[4];
#pragma unroll
                for (int bj = 0; bj < 2; ++bj)
#pragma unroll
                    for (int n = 0; n < 2; ++n) { const f32x4 v = acc[ai][bj][m][n] * W8_INV + bv[bj][n]; pk[2 * bj + n] = pk4_f8(v[0], v[1], v[2], v[3]); }
                w.x = pk[0]; w.y = pk[1]; w.z = pk[2]; w.w = pk[3];
                if (!nostore) *(u32x4*)rowp = w; }
    }
};
struct EpiMerge {
    static constexpr int PERM = 2; static constexpr bool HAS_BIAS = false, KEEP_ACC = true;
    __device__ __forceinline__ const float* bias_src(const Unit&, int) const { return nullptr; }
    const unsigned char* G; bf16_t* Mg;
    __device__ __forceinline__ void operator()(f32x4 (&acc)[2][2][4][2], const Unit& u, int wr, int wc, int fr, int fq, const LAS float*) const {
        const int row0 = u.pm * BM + wr * 64 + fr; const int col0 = u.pn * BM + wc * 64 + 16 * fq;
        const unsigned char* g0p = G + (size_t)row0 * PW + u.e * DM + col0;
        if (u.e < 2) {
#pragma unroll
            for (int ai = 0; ai < 2; ++ai) {
                u32x4 ga[4], gb[4];
#pragma unroll
                for (int m = 0; m < 4; ++m) { ga[m] = *(const u32x4*)(g0p + (size_t)(ai * HALF + m * 16) * PW); gb[m] = *(const u32x4*)(g0p + DM + (size_t)(ai * HALF + m * 16) * PW); }
#pragma unroll
                for (int m = 0; m < 4; ++m)
#pragma unroll
                    for (int bj = 0; bj < 2; ++bj)
#pragma unroll
                        for (int n = 0; n < 2; ++n) { const unsigned a = ga[m][2 * bj + n], b = gb[m][2 * bj + n];
#pragma unroll
                            for (int q = 0; q < 4; ++q) acc[ai][bj][m][n][q] *= (float)((a >> (8 * q)) & 0xffu) * __builtin_amdgcn_rcpf((float)((b >> (8 * q)) & 0xffu)); }
                __builtin_amdgcn_sched_barrier(0); }
        } else {
#pragma unroll
            for (int ai = 0; ai < 2; ++ai) { u32x4 ga[4];
#pragma unroll
                for (int m = 0; m < 4; ++m) ga[m] = *(const u32x4*)(g0p + (size_t)(ai * HALF + m * 16) * PW);
#pragma unroll
                for (int m = 0; m < 4; ++m) { u32x4 w[2];
#pragma unroll
                    for (int bj = 0; bj < 2; ++bj) { float v[8];
#pragma unroll
                        for (int n = 0; n < 2; ++n) { const unsigned a = ga[m][2 * bj + n];
#pragma unroll
                            for (int q = 0; q < 4; ++q) v[4 * n + q] = acc[ai][bj][m][n][q] * ((float)((a >> (8 * q)) & 0xffu) * (1.f / 255.f)); }
                        w[bj].x = cvt_pk_bf16(v[0], v[1]); w[bj].y = cvt_pk_bf16(v[2], v[3]); w[bj].z = cvt_pk_bf16(v[4], v[5]); w[bj].w = cvt_pk_bf16(v[6], v[7]); }
                    store_rowpair_bf16(Mg + (size_t)((row0 & ~1) + ai * HALF + m * 16) * DM + col0 + 8 * (fr & 1), DM, w[0], w[1], fr & 1); }
                __builtin_amdgcn_sched_barrier(0); }
        }
    }
};
struct EpiResid {
    static constexpr int PERM = 2; static constexpr bool HAS_BIAS = false, KEEP_ACC = false;
    __device__ __forceinline__ const float* bias_src(const Unit&, int) const { return nullptr; }
    const float* base; bf16_t* out;
    __device__ __forceinline__ void operator()(const f32x4 (&acc)[2][2][4][2], const Unit& u, int wr, int wc, int fr, int fq, const LAS float*) const {
        const int row0 = u.pm * BM + wr * 64 + fr; const int col0 = u.pn * BM + wc * 64 + 16 * fq;
#pragma unroll
        for (int ai = 0; ai < 2; ++ai)
#pragma unroll
            for (int m = 0; m < 4; ++m) { const size_t r = (size_t)(row0 + ai * HALF + m * 16); const float* xb = base + r * DM + col0;
                u32x4 w[2];
#pragma unroll
                for (int bj = 0; bj < 2; ++bj) { const f32x4 v0 = *(const f32x4*)(xb + 8 * bj) + acc[ai][bj][m][0], v1 = *(const f32x4*)(xb + 8 * bj + 4) + acc[ai][bj][m][1];
                    w[bj].x = cvt_pk_bf16(v0[0], v0[1]); w[bj].y = cvt_pk_bf16(v0[2], v0[3]); w[bj].z = cvt_pk_bf16(v1[0], v1[1]); w[bj].w = cvt_pk_bf16(v1[2], v1[3]); }
                store_rowpair_bf16(out + (r & ~(size_t)1) * 2048 + col0 + 8 * (fr & 1), 3072, w[0], w[1], fr & 1); }
    }
};
struct EpiSwiglu {
    static constexpr int PERM = 1; static constexpr bool HAS_BIAS = true, KEEP_ACC = false;
    unsigned char* act; const float* bias;
    __device__ __forceinline__ const float* bias_src(const Unit& u, int l) const { return bias + (size_t)u.e * 2048 + (l >> 5) * 1024 + u.pn * HALF + 4 * (l & 31); }
    __device__ __forceinline__ void operator()(const f32x4 (&acc)[2][2][4][2], const Unit& u, int wr, int wc, int fr, int fq, const LAS float* bt) const {
        const int row0 = u.pm * BM + wr * 64 + fr; const int col0 = u.pn * HALF + wc * 32 + 8 * (fq & 2);
        f32x4 bg[2], bu[2];
#pragma unroll
        for (int n = 0; n < 2; ++n) { bg[n] = *(const LAS f32x4*)(bt + wc * 32 + 8 * fq + 4 * n); bu[n] = *(const LAS f32x4*)(bt + HALF + wc * 32 + 8 * fq + 4 * n); }
#pragma unroll
        for (int ai = 0; ai < 2; ++ai)
#pragma unroll
            for (int mp = 0; mp < 2; ++mp) { u32x2 w[2];
#pragma unroll
                for (int mm = 0; mm < 2; ++mm) { const int m = 2 * mp + mm; float o[8];
#pragma unroll
                    for (int n = 0; n < 2; ++n) { const f32x4 gv = acc[ai][0][m][n] * W8_INV + bg[n], uv = acc[ai][1][m][n] * W8_INV + bu[n];
#pragma unroll
                        for (int q = 0; q < 4; q += 2) {
                            const f32x2 g = {fminf(gv[q], 7.0f), fminf(gv[q + 1], 7.0f)};
                            const f32x2 uu = {__builtin_amdgcn_fmed3f(uv[q], -7.0f, 7.0f), __builtin_amdgcn_fmed3f(uv[q + 1], -7.0f, 7.0f)};
                            const f32x2 ea = g * (-1.702f * LOG2E);
                            const f32x2 d = (f32x2){__builtin_amdgcn_exp2f(ea[0]), __builtin_amdgcn_exp2f(ea[1])} + 1.f;
                            const f32x2 gr = g * (f32x2){__builtin_amdgcn_rcpf(d[0]), __builtin_amdgcn_rcpf(d[1])};
                            const f32x2 r = uu * gr + gr;
                            o[4 * n + q] = r[0]; o[4 * n + q + 1] = r[1]; } }
                    w[mm].x = pk4_f8(o[0], o[1], o[2], o[3]); w[mm].y = pk4_f8(o[4], o[5], o[6], o[7]); }
                const auto sx = __builtin_amdgcn_permlane16_swap(w[0].x, w[1].x, false, false), sy = __builtin_amdgcn_permlane16_swap(w[0].y, w[1].y, false, false);
                unsigned char* rowp = act + (size_t)(row0 + ai * HALF + (2 * mp + (fq & 1)) * 16) * DEXP + col0;
                *(u32x4*)rowp = (u32x4){sx[0], sy[0], sx[1], sy[1]}; }
    }
};
}

#define XB_TMO      128
#define XB_XCNT(j)  (256  + 64 * (j))
#define XB_XSUB(j)  (1280 + 64 * (j))
#define XB_XGEN(j)  (2304 + 64 * (j))
#define XB_TOP      3328
#define XB_TOPGEN   3392
#define XCD_BAR_WORDS 3456
#define XB_SPIN_CAP (1u << 18)

__device__ __forceinline__ unsigned xb_ld(unsigned* p)              { return __hip_atomic_load(p, __ATOMIC_RELAXED, __HIP_MEMORY_SCOPE_AGENT); }
__device__ __forceinline__ unsigned xb_add(unsigned* p, unsigned v) { return __hip_atomic_fetch_add(p, v, __ATOMIC_RELAXED, __HIP_MEMORY_SCOPE_AGENT); }
__device__ __forceinline__ unsigned xb_xcc_id() { return (unsigned)__builtin_amdgcn_s_getreg((3 << 11) | 20) & 0xFu; }
#define XB_SPIN(cond, bar) do { unsigned _sp = 0; while (cond) { __builtin_amdgcn_s_sleep(1); \
    if ((++_sp & 255u) == 0u) { if (xb_ld(&(bar)[XB_TMO])) break; if (_sp > XB_SPIN_CAP) { atomicAdd(&(bar)[XB_TMO], 1u); break; } } } } while (0)

struct XcdBarrier {
    unsigned* bar; unsigned x; int wave;
    volatile LAS unsigned* st;
};

__device__ __forceinline__ XcdBarrier xcd_barrier_post(unsigned* bar, volatile LAS unsigned* st) {
    XcdBarrier b; b.bar = bar; b.x = xb_xcc_id(); b.st = st; b.wave = __builtin_amdgcn_readfirstlane((int)(threadIdx.x >> 6));
    if (threadIdx.x == 0) (void)xb_add(&bar[XB_XCNT(b.x)], 1u);
    return b;
}
__device__ __forceinline__ void xcd_barrier_complete(unsigned* bar, unsigned x, unsigned& nloc, unsigned& nx) {
    const unsigned G = gridDim.x * gridDim.y * gridDim.z;
    unsigned sum, cnt, mine, sp = 0u;
    for (;;) {
        sum = 0u; cnt = 0u; mine = 0u;
#pragma unroll
        for (unsigned j = 0; j < 16; ++j) { const unsigned c = xb_ld(&bar[XB_XCNT(j)]); sum += c; cnt += (c > 0u) ? 1u : 0u; mine = (j == x) ? c : mine; }
        if (sum == G) break;
        __builtin_amdgcn_s_sleep(1);
        if ((++sp & 255u) == 0u) { if (xb_ld(&bar[XB_TMO])) break; if (sp > XB_SPIN_CAP) { atomicAdd(&bar[XB_TMO], 1u); break; } }
    }
    nloc = mine > 0u ? mine : 1u; nx = cnt > 0u ? cnt : 1u;
}

__device__ __forceinline__ void xcd_barrier(const XcdBarrier& b) {
    asm volatile("s_waitcnt vmcnt(0)" ::: "memory");
    __syncthreads();
    if (b.wave == 0 && lane_id_fresh() == 0) {
        unsigned* bar = b.bar;
        __builtin_amdgcn_s_waitcnt(0);
        unsigned nloc = b.st[0], nx = b.st[1];
        if (nloc == 0u) { xcd_barrier_complete(bar, b.x, nloc, nx); b.st[0] = nloc; b.st[1] = nx; }
        const unsigned old = xb_add(&bar[XB_XSUB(b.x)], 1u);
        const unsigned gen = old / nloc;
        if (old + 1u == (gen + 1u) * nloc) {
            __builtin_amdgcn_fence(__ATOMIC_RELEASE, "agent");
            asm volatile("s_waitcnt vmcnt(0)" ::: "memory");
            const unsigned og = xb_add(&bar[XB_TOP], 1u);
            const unsigned tg = og / nx;
            if (og + 1u == (tg + 1u) * nx) xb_add(&bar[XB_TOPGEN], 1u);
            else XB_SPIN(xb_ld(&bar[XB_TOPGEN]) == tg, bar);
            __builtin_amdgcn_fence(__ATOMIC_ACQUIRE, "agent");
            xb_add(&bar[XB_XGEN(b.x)], 1u);
            asm volatile("s_waitcnt vmcnt(0)" ::: "memory");
        } else {
            XB_SPIN(xb_ld(&bar[XB_XGEN(b.x)]) == gen, bar);
            __builtin_amdgcn_fence(__ATOMIC_ACQUIRE, "agent");
            asm volatile("s_waitcnt vmcnt(0)" ::: "memory");
        }
    }
    __syncthreads();
}

constexpr int NWAVES = 8;
struct Frame {
    LAS unsigned char* lds;
    volatile LAS unsigned* MISC;
    gu32* ctl;
    int tid, lane, wave, G, blk;
    const float* in[21];
    float* out; unsigned char* ws;
};
__device__ __forceinline__ float wave_sum_dpp(float a) {
#define WSD(ctrl_) a += __builtin_bit_cast(float, __builtin_amdgcn_update_dpp(0, __builtin_bit_cast(int, a), ctrl_, 0xF, 0xF, false))
    WSD(0xB1); WSD(0x4E); WSD(0x141); WSD(0x128);
#undef WSD
    { const auto rr = __builtin_amdgcn_permlane16_swap(__float_as_uint(a), __float_as_uint(a), false, false); a = __uint_as_float(rr[0]) + __uint_as_float(rr[1]); }
    { const auto rr = __builtin_amdgcn_permlane32_swap(__float_as_uint(a), __float_as_uint(a), false, false); a = __uint_as_float(rr[0]) + __uint_as_float(rr[1]); }
    return a;
}
__device__ __forceinline__ float wave_sum(float v) {
#pragma unroll
    for (int o = 1; o < 64; o <<= 1) v += __shfl_xor(v, o);
    return v;
}

__device__ __forceinline__ int map_src(int mode, int n) {
    if (mode == 1) return n < 2500 ? n : (n >= C_MQ ? n - (C_MQ - 2500) : -1);
    if (mode == 2) { const int pn = n >> 8, bj = (n >> 7) & 1, j = n & 127; return bj * 1024 + pn * 128 + j; }
    return n;
}
__device__ __forceinline__ void transpose_item(const float* W, int K, int Nsrc, int Ndst, bf16_t* WT, int mode, LAS float* scr, int item, int lane) {
    const int nblk = Ndst / 32, kb = item / nblk, nb = item % nblk, k0 = 64 * kb, n0 = 32 * nb;
    const int sc = map_src(mode, n0 + (lane & 31));
    const float scale = (mode == 1 && (n0 + (lane & 31)) < 512) ? 0.125f * LOG2E : 1.0f;
#pragma unroll
    for (int i = 0; i < 32; ++i) { const int kk = 2 * i + (lane >> 5); scr[kk * 33 + (lane & 31)] = sc >= 0 ? NT_LD(W + (size_t)(k0 + kk) * Nsrc + sc) * scale : 0.f; }
    LDS_WAIT(); asm volatile("" ::: "memory");
    const int c = lane & 7;
#pragma unroll
    for (int j = 0; j < 4; ++j) { const int n = (lane >> 3) + 8 * j; const LAS float* s = scr + (8 * c) * 33 + n;
        u32x4 o; o.x = pk2(s[0 * 33], s[1 * 33]); o.y = pk2(s[2 * 33], s[3 * 33]); o.z = pk2(s[4 * 33], s[5 * 33]); o.w = pk2(s[6 * 33], s[7 * 33]);
        *(GAS u32x4*)(WT + (size_t)(n0 + n) * K + k0 + 8 * c) = o; }
    LDS_WAIT(); asm volatile("" ::: "memory");
}
__device__ __forceinline__ void transpose_item_f8(const float* W, int K, int Nsrc, int Ndst, unsigned char* WT, int mode, float scale, LAS float* scr, int item, int lane) {
    const int nblk = Ndst / 32, kb = item / nblk, nb = item % nblk, k0 = 128 * kb, n0 = 32 * nb;
    const int sc = map_src(mode, n0 + (lane & 31));
#pragma unroll
    for (int i = 0; i < 64; ++i) { const int kk = 2 * i + (lane >> 5); scr[kk * 33 + (lane & 31)] = sc >= 0 ? NT_LD(W + (size_t)(k0 + kk) * Nsrc + sc) * scale : 0.f; }
    LDS_WAIT(); asm volatile("" ::: "memory");
    const int c = lane & 7;
#pragma unroll
    for (int j = 0; j < 4; ++j) { const int n = (lane >> 3) + 8 * j; const LAS float* s = scr + (16 * c) * 33 + n;
        u32x4 o; o.x = pk4_f8(s[0 * 33], s[1 * 33], s[2 * 33], s[3 * 33]); o.y = pk4_f8(s[4 * 33], s[5 * 33], s[6 * 33], s[7 * 33]);
        o.z = pk4_f8(s[8 * 33], s[9 * 33], s[10 * 33], s[11 * 33]); o.w = pk4_f8(s[12 * 33], s[13 * 33], s[14 * 33], s[15 * 33]);
        *(GAS u32x4*)(WT + (size_t)(n0 + n) * K + k0 + 16 * c) = o; }
    LDS_WAIT(); asm volatile("" ::: "memory");
}
__device__ __forceinline__ void rms_row_to_bf16(int lane, const float* xrow, const float* g, bf16_t* orow) {
    const GAS f32x4* xr = (const GAS f32x4*)xrow + lane; const GAS f32x4* gr = (const GAS f32x4*)g + lane;
    f32x4 v[4]; float s = 0.f;
#pragma unroll
    for (int j = 0; j < 4; ++j) { v[j] = xr[64 * j]; s += (v[j].x * v[j].x + v[j].y * v[j].y) + (v[j].z * v[j].z + v[j].w * v[j].w); }
    const float rstd = 1.0f / sqrtf(wave_sum(s) * (1.f / DM) + EPS);
    GAS u32x2* o8 = (GAS u32x2*)orow + lane;
#pragma unroll
    for (int j = 0; j < 4; ++j) { const f32x4 gg = gr[64 * j]; u32x2 o; o.x = pk2(v[j].x * rstd * gg.x, v[j].y * rstd * gg.y); o.y = pk2(v[j].z * rstd * gg.z, v[j].w * rstd * gg.w); o8[64 * j] = o; }
}

__device__ __forceinline__ void rms_rows4_to_bf16(int lane, const float* x, const float* g, bf16_t* o, size_t m0, size_t stride, unsigned char* o8f = nullptr) {
    f32x4 v[4][4]; float s[4];
#pragma unroll
    for (int r = 0; r < 4; ++r) { const GAS f32x4* xr = (const GAS f32x4*)(x + (m0 + r * stride) * DM) + lane;
#pragma unroll
        for (int j = 0; j < 4; ++j) v[r][j] = NT_LD(xr + 64 * j); }
    const GAS f32x4* gr = (const GAS f32x4*)g + lane;
    f32x4 gg[4];
#pragma unroll
    for (int j = 0; j < 4; ++j) gg[j] = gr[64 * j];
#pragma unroll
    for (int r = 0; r < 4; ++r) { float a = 0.f;
#pragma unroll
        for (int j = 0; j < 4; ++j) a += (v[r][j].x * v[r][j].x + v[r][j].y * v[r][j].y) + (v[r][j].z * v[r][j].z + v[r][j].w * v[r][j].w);
        s[r] = a; }
#pragma unroll
    for (int r = 0; r < 4; ++r) s[r] = wave_sum_dpp(s[r]);
#pragma unroll
    for (int r = 0; r < 4; ++r) { const float rstd = 1.0f / sqrtf(s[r] * (1.f / DM) + EPS);
        GAS u32x2* o8 = (GAS u32x2*)(o + (m0 + r * stride) * DM) + lane;
#pragma unroll
        for (int j = 0; j < 4; ++j) { const float a0 = v[r][j].x * rstd * gg[j].x, a1 = v[r][j].y * rstd * gg[j].y, a2 = v[r][j].z * rstd * gg[j].z, a3 = v[r][j].w * rstd * gg[j].w;
            u32x2 w; w.x = pk2(a0, a1); w.y = pk2(a2, a3); o8[64 * j] = w;
            if (o8f) *((GAS unsigned*)(o8f + (m0 + r * stride) * DM) + lane + 64 * j) = pk4_f8(a0, a1, a2, a3); } }
}
__device__ __forceinline__ void p0_prologue(Frame& F) {
    LAS float* scr = (LAS float*)(F.lds + F.wave * 16896);
    const int gw = F.blk * NWAVES + F.wave, NGW = F.G * NWAVES, lane = F.lane;
    unsigned char* ws = F.ws;
    constexpr int I_IN = 16 * 96, I_MKV = 16 * 32, I_G = 8 * 32, I_B = 8 * 32, I_O = 16 * 32, I_EI = 8 * 64, I_EO = 8 * 32;
    constexpr int NITEMS = I_IN + I_MKV + 3 * I_G + 3 * I_B + I_O + NEXP * I_EI + NEXP * I_EO;
    for (int it = gw; it < NITEMS; it += NGW) {
        int r = it;
        if (r < I_IN) { transpose_item(F.in[3], DM, IN_W, PW, (bf16_t*)(ws + WS_WIN), 1, scr, r, lane); continue; } r -= I_IN;
        if (r < I_MKV) { transpose_item(F.in[9], DM, DM, DM, (bf16_t*)(ws + WS_WMKV), 0, scr, r, lane); continue; } r -= I_MKV;
        if (r < 3 * I_G) { const int n = r / I_G; transpose_item_f8(F.in[10] + (size_t)n * DM * DM, DM, DM, DM, ws + WS_WG + (size_t)n * DM * DM, 0, W8_SCALE, scr, r % I_G, lane); continue; } r -= 3 * I_G;
        if (r < 3 * I_B) { const int n = r / I_B; transpose_item(F.in[12] + (size_t)n * 512 * DM, 512, DM, DM, (bf16_t*)(ws + WS_WB) + (size_t)n * DM * 512, 0, scr, r % I_B, lane); continue; } r -= 3 * I_B;
        if (r < I_O) { transpose_item(F.in[13], DM, DM, DM, (bf16_t*)(ws + WS_WO), 0, scr, r, lane); continue; } r -= I_O;
        if (r < NEXP * I_EI) { const int e = r / I_EI; transpose_item_f8(F.in[17] + (size_t)e * DM * 2048, DM, 2048, 2048, ws + WS_WEI + (size_t)e * 2048 * DM, 2, W8_SCALE, scr, r % I_EI, lane); continue; } r -= NEXP * I_EI;
        { const int e = r / I_EO; transpose_item_f8(F.in[19] + (size_t)e * DM * DM, DM, DM, DM, ws + WS_WEO + (size_t)e * DM * DM, 0, W8_SCALE, scr, r % I_EO, lane); }
    }
    { f32x2* tab = (f32x2*)(ws + WS_ROPE);
      for (int idx = (F.blk * NWAVES * 64) + F.tid; idx < SEQ * 32; idx += F.G * NWAVES * 64) {
          const int s = idx >> 5, i = idx & 31;
          const float inv = exp2f(-(float)i * (13.287712379549449f / 32.0f));
          const float ang = (float)s * inv;
          const double rev = (double)ang * 0.15915494309189535;
          const float fr = (float)(rev - __builtin_rint(rev));
          tab[idx] = (f32x2){__builtin_amdgcn_cosf(fr), __builtin_amdgcn_sinf(fr)}; } }
    for (int m = gw; m < NTOK; m += 4 * NGW) rms_rows4_to_bf16(lane, F.in[0], F.in[2], (bf16_t*)(ws + WS_H), (size_t)m, (size_t)NGW, ws + WS_H8);
    for (int m = gw; m < NMEM; m += 4 * NGW) rms_rows4_to_bf16(lane, F.in[1], F.in[8], (bf16_t*)(ws + WS_MEMN), (size_t)m, (size_t)NGW);
    { int* st = (int*)(ws + WS_SLOT_TOK);
      for (int i = F.blk * NWAVES * 64 + F.tid; i < NSLOT_PAD; i += F.G * NWAVES * 64) st[i] = 0; }
}

template <int CTRL> __device__ __forceinline__ float dppf(float v) { return __builtin_bit_cast(float, __builtin_amdgcn_update_dpp(0, __builtin_bit_cast(int, v), CTRL, 0xF, 0xF, false)); }
__device__ __forceinline__ float lx1(float v) { return dppf<0xB1>(v); }
__device__ __forceinline__ float lx2(float v) { return dppf<0x4E>(v); }
__device__ __forceinline__ float lx4(float v) { return dppf<0x1B>(dppf<0x141>(v)); }
__device__ __forceinline__ float lx8(float v) { return dppf<0x128>(v); }
__device__ __forceinline__ void un8(const u32x4 w, float (&v)[8]) { v[0] = bflo(w.x); v[1] = bfhi(w.x); v[2] = bflo(w.y); v[3] = bfhi(w.y); v[4] = bflo(w.z); v[5] = bfhi(w.z); v[6] = bflo(w.w); v[7] = bfhi(w.w); }
__device__ __forceinline__ u32x4 pk8(const float (&v)[8]) { u32x4 w; w.x = pk2(v[0], v[1]); w.y = pk2(v[2], v[3]); w.z = pk2(v[4], v[5]); w.w = pk2(v[6], v[7]); return w; }
__device__ __forceinline__ void rope8(float (&v)[8], const f32x2 (&cs)[8], bool up) {
#pragma unroll
    for (int j = 0; j < 8; ++j) { const float other = lx4(v[j]); v[j] = up ? (other * cs[j].y + v[j] * cs[j].x) : (v[j] * cs[j].x - other * cs[j].y); }
}
__device__ __forceinline__ void p2_prep(Frame& F, const bool dummy = false) {
    const int gw = F.blk * NWAVES + F.wave, NGW = F.G * NWAVES, lane = F.lane;
    bf16_t* proj = (bf16_t*)(F.ws + WS_P);
    bf16_t* projw = dummy ? (bf16_t*)(F.ws + WS_END) : proj;
    const int wmask = dummy ? 8191 : 0x7fffffff;
    const f32x2* tab = (const f32x2*)(F.ws + WS_ROPE);
    float gkd[8];
#pragma unroll
    for (int j = 0; j < 8; ++j) gkd[j] = F.in[5][8 * (lane & 7) + j];
    const bool up = (lane & 4) != 0; const int i0 = (lane & 3) * 8;
    constexpr int NRW = 4;
    for (int m0 = gw; m0 < NTOK; m0 += NRW * NGW) {
        u32x4 raw[NRW][4]; f32x2 cs[NRW][8];
#pragma unroll
        for (int t = 0; t < NRW; ++t) { const GAS bf16_t* row = (const GAS bf16_t*)proj + (size_t)(m0 + t * NGW) * PW;
            raw[t][1] = *(const GAS u32x4*)(row + C_DK + 8 * (lane & 7)); raw[t][2] = *(const GAS u32x4*)(row + C_IQ + 8 * (lane & 31));
            raw[t][3] = *(const GAS u32x4*)(row + C_IK + 8 * (lane & 7));
            const GAS f32x2* tr = (const GAS f32x2*)tab + (size_t)((m0 + t * NGW) & (SEQ - 1)) * 32 + i0;
#pragma unroll
            for (int j = 0; j < 8; ++j) cs[t][j] = tr[j]; }
#pragma unroll
        for (int t = 0; t < NRW; ++t) {
            GAS bf16_t* roww = (GAS bf16_t*)projw + (size_t)((m0 + t * NGW) & wmask) * PW;
            float v[8];
            { un8(raw[t][1], v); float ss = 0.f;
#pragma unroll
              for (int j = 0; j < 8; ++j) ss += v[j] * v[j];
              ss += lx1(ss); ss += lx2(ss); ss += lx4(ss);
              const float rstd = 1.0f / sqrtf(ss * (1.f / 64.f) + EPS);
#pragma unroll
              for (int j = 0; j < 8; ++j) v[j] = v[j] * rstd * gkd[j];
              rope8(v, cs[t], up);
              if (lane < 8) *(GAS u32x4*)(roww + C_DK + 8 * lane) = pk8(v); }
            { un8(raw[t][2], v); rope8(v, cs[t], up); if (lane < 32) *(GAS u32x4*)(roww + C_IQ + 8 * lane) = pk8(v); }
            { un8(raw[t][3], v); rope8(v, cs[t], up); if (lane < 8) *(GAS u32x4*)(roww + C_IK + 8 * lane) = pk8(v); }
        }
    }
    bf16_t* mkv = (bf16_t*)(F.ws + WS_MKV);
    if (!dummy) for (int m = gw; m < NMEM; m += NGW) {
        GAS bf16_t* row = (GAS bf16_t*)mkv + (size_t)m * DM; float v[8];
        un8(*(const GAS u32x4*)(row + 8 * lane), v); float ss = 0.f;
#pragma unroll
        for (int j = 0; j < 8; ++j) ss += v[j] * v[j];
        ss += lx1(ss); ss += lx2(ss); ss += lx4(ss); ss += lx8(ss);
        const float rstd = 1.0f / sqrtf(ss * (1.f / 128.f) + EPS);
#pragma unroll
        for (int j = 0; j < 8; ++j) v[j] = v[j] * rstd * F.in[7][8 * (lane & 15) + j];
        *(GAS u32x4*)(row + 8 * lane) = pk8(v);
    }
}

#define MFMA32(a, b, c) __builtin_amdgcn_mfma_f32_32x32x16_bf16((a), (b), (c), 0, 0, 0)
typedef LAS const unsigned char* lds_cptr;
__device__ __forceinline__ s16x4 vtr(lds_cptr p) { return __builtin_bit_cast(s16x4, __builtin_amdgcn_ds_read_tr16_b64_v4i16((LAS v4i16_t*)p)); }
__device__ __forceinline__ bf16x8 vfrag(lds_cptr vbase_lane, int off) {
    const s16x4 lo = vtr(vbase_lane + off), hi = vtr(vbase_lane + off + 512);
    return (bf16x8){lo[0], lo[1], lo[2], lo[3], hi[0], hi[1], hi[2], hi[3]};
}
__device__ __forceinline__ int vtr_lane_off(int lane) { return ((lane >> 4) & 1) * 32 + (lane & 3) * 8 + (4 * (lane >> 5) + ((lane & 15) >> 2)) * 64; }
__device__ __forceinline__ bf16x8 pack8(const float* p) {
    u32x4 w; w.x = cvt_pk_bf16(p[0], p[1]); w.y = cvt_pk_bf16(p[2], p[3]); w.z = cvt_pk_bf16(p[4], p[5]); w.w = cvt_pk_bf16(p[6], p[7]);
    return __builtin_bit_cast(bf16x8, w);
}
__device__ __forceinline__ void store_o32x64(LAS unsigned char* st, const u32x2 (&w0)[4], const u32x2 (&w1)[4], bf16_t* grow0, int lane) {
    const int r32 = lane & 31, hi = lane >> 5;
#pragma unroll
    for (int g = 0; g < 4; ++g) { *(LAS u32x2*)(st + r32 * 128 + ((g ^ (r32 & 7)) * 16) + 8 * hi) = w0[g]; *(LAS u32x2*)(st + r32 * 128 + (((4 + g) ^ (r32 & 7)) * 16) + 8 * hi) = w1[g]; }
    asm volatile("s_waitcnt lgkmcnt(0)" ::: "memory");
    const int rr = lane >> 3, c = lane & 7;
#pragma unroll
    for (int p = 0; p < 4; ++p) { const int row = 8 * p + rr; const u32x4 v = *(const LAS u32x4*)(st + row * 128 + ((c ^ (row & 7)) * 16));
        *(u32x4*)(grow0 + (size_t)row * 512 + 8 * c) = v; }
    asm volatile("s_waitcnt lgkmcnt(0)" ::: "memory");
}
__device__ __forceinline__ float softplus2_f(float z2) { return __builtin_amdgcn_logf(1.f + __builtin_amdgcn_exp2f(fminf(z2, 120.f))); }

__device__ __forceinline__ void sb_item(const bf16_t* proj, bf16_t* osb, int b, int h, int qblk, LAS unsigned char* vlds, int lane) {
    const int r32 = lane & 31, hi = lane >> 5;
    const size_t tok0 = (size_t)b * SEQ + (size_t)qblk * 32;
    bf16x8 qr[4];
    { const bf16_t* qp = proj + (tok0 + r32) * PW + C_SQ + h * 64 + hi * 8;
#pragma unroll
      for (int kk = 0; kk < 4; ++kk) qr[kk] = *(const bf16x8*)(qp + kk * 16); }
    f32x16 o0 = {}, o1 = {}; float R = 0.f;
    const lds_cptr vrd = (lds_cptr)vlds + vtr_lane_off(lane);
    LAS unsigned char* kst = vlds + 4096;
    u32x4 kfn[4]; u32x4 vvn[4];
    const int lrow = lane >> 3, lch = lane & 7;
#define SB_LOAD(kt_) do { const size_t key0_ = (size_t)b * SEQ + (size_t)(kt_) * 32; const GAS bf16_t* rp_ = (const GAS bf16_t*)proj + (key0_ + lrow) * PW + h * 64 + lch * 8; \
        _Pragma("unroll") for (int i = 0; i < 4; ++i) { kfn[i] = *(const GAS u32x4*)(rp_ + (size_t)(8 * i) * PW + C_SK); vvn[i] = *(const GAS u32x4*)(rp_ + (size_t)(8 * i) * PW + C_SV); } } while (0)
    SB_LOAD(qblk);
    for (int kt = qblk; kt >= 0; --kt) {
        u32x4 kw[4]; u32x4 vv[4];
#pragma unroll
        for (int i = 0; i < 4; ++i) { kw[i] = kfn[i]; vv[i] = vvn[i]; }
        if (kt > 0) SB_LOAD(kt - 1);
#pragma unroll
        for (int i = 0; i < 4; ++i) { const int row = 8 * i + lrow;
            *(LAS u32x4*)(kst + row * 128 + ((lch ^ (row & 7)) * 16)) = kw[i];
            *(LAS u32x4*)(vlds + ((row >> 4) + 2 * (lch >> 2)) * 1024 + ((row & 15) * 4 + (lch & 3)) * 16) = vv[i]; }
        LDS_WAIT();
        f32x16 s = {};
#pragma unroll
        for (int kk = 0; kk < 4; ++kk) { const bf16x8 kf = *(const LAS bf16x8*)(kst + r32 * 128 + (((2 * kk + hi) ^ (r32 & 7)) * 16)); s = MFMA32(kf, qr[kk], s); }
        asm volatile("" ::: "memory");
        const bool diag = (kt == qblk);
        float sp[16], pr[16];
#pragma unroll
        for (int r = 0; r < 16; ++r) { const bool valid = !diag || (crow(r, hi) < r32); sp[r] = valid ? softplus2_f(s[r]) : 0.f; }
        float T[4], U[4];
#pragma unroll
        for (int g = 0; g < 4; ++g) { T[g] = (sp[4 * g] + sp[4 * g + 1]) + (sp[4 * g + 2] + sp[4 * g + 3]); { const auto rr = __builtin_amdgcn_permlane32_swap(__float_as_uint(T[g]), __float_as_uint(T[g]), false, false); U[g] = hi ? __uint_as_float(rr[0]) : __uint_as_float(rr[1]); } }
        float run = 0.f, above[4];
#pragma unroll
        for (int g = 3; g >= 0; --g) { above[g] = run + (hi == 0 ? U[g] : 0.f); run += T[g] + U[g]; }
#pragma unroll
        for (int g = 0; g < 4; ++g) { float c = R + above[g];
#pragma unroll
            for (int j = 3; j >= 0; --j) { const int r = 4 * g + j; c += sp[r]; const bool valid = !diag || (crow(r, hi) < r32); pr[r] = valid ? __builtin_amdgcn_exp2f(s[r] - c) : 0.f; } }
        R += run;
        const bf16x8 p0 = pack8(pr), p1 = pack8(pr + 8);
        const bf16x8 v00 = vfrag(vrd, 0), v01 = vfrag(vrd, 1024), v10 = vfrag(vrd, 2048), v11 = vfrag(vrd, 3072);
        o0 = MFMA32(v00, p0, o0); o0 = MFMA32(v01, p1, o0);
        o1 = MFMA32(v10, p0, o1); o1 = MFMA32(v11, p1, o1);
        asm volatile("" ::: "memory");
        if (__all(R > 30.0f * LOG2E)) break;
    }
#undef SB_LOAD
    u32x2 w0[4], w1[4];
#pragma unroll
    for (int g = 0; g < 4; ++g) { w0[g].x = cvt_pk_bf16(o0[4 * g], o0[4 * g + 1]); w0[g].y = cvt_pk_bf16(o0[4 * g + 2], o0[4 * g + 3]); w1[g].x = cvt_pk_bf16(o1[4 * g], o1[4 * g + 1]); w1[g].y = cvt_pk_bf16(o1[4 * g + 2], o1[4 * g + 3]); }
    store_o32x64(vlds, w0, w1, osb + tok0 * 512 + h * 64, lane);
}

constexpr int ML_K = 0, ML_KROW = 272, ML_V = 256 * ML_KROW, ML_END = ML_V + 65536;
__device__ __forceinline__ void mem_unit(const bf16_t* proj, const bf16_t* mkv, bf16_t* omem, int b, int h, int half, LAS unsigned char* ml, int tid, const float* gq  ) {
    const int lane = tid & 63, wid = __builtin_amdgcn_readfirstlane(tid >> 6), r32 = lane & 31, hi = lane >> 5;
    { const GAS bf16_t* src = (const GAS bf16_t*)mkv + (size_t)b * MEMLEN * DM + h * 128;
#pragma unroll
      for (int i = 0; i < 8; ++i) { const int ch = tid + 512 * i, key = ch >> 4, c16 = ch & 15, kk = key & 31;
          const u32x4 kv = *(const GAS u32x4*)(src + (size_t)key * DM + c16 * 8);
          const u32x4 vv = *(const GAS u32x4*)(src + (size_t)key * DM + 512 + c16 * 8);
          *(LAS u32x4*)(ml + ML_K + key * ML_KROW + c16 * 16) = kv;
          *(LAS u32x4*)(ml + ML_V + (key >> 5) * 8192 + ((c16 >> 2) * 2 + (kk >> 4)) * 1024 + (kk & 15) * 64 + (c16 & 3) * 16) = vv; } }
    __syncthreads();
    for (int i = 0; i < 4; ++i) {
        const int qblk = half * 32 + wid * 4 + i;
        const size_t tok0 = (size_t)b * SEQ + (size_t)qblk * 32;
        bf16x8 qr[8];
        { const GAS bf16_t* qp = (const GAS bf16_t*)proj + (tok0 + r32) * PW + C_MQ + h * 128 + hi * 8;
#pragma unroll
          for (int kk = 0; kk < 8; ++kk) qr[kk] = *(const GAS bf16x8*)(qp + kk * 16); }
        { float ss = 0.f;
#pragma unroll
          for (int kk = 0; kk < 8; ++kk)
#pragma unroll
              for (int j = 0; j < 8; ++j) { const float v = __uint_as_float((unsigned)(unsigned short)qr[kk][j] << 16); ss += v * v; }
          { const auto rr = __builtin_amdgcn_permlane32_swap(__float_as_uint(ss), __float_as_uint(ss), false, false); ss = __uint_as_float(rr[0]) + __uint_as_float(rr[1]); }
          const float rstd = 1.0f / sqrtf(ss * (1.f / 128.f) + EPS);
#pragma unroll
          for (int kk = 0; kk < 8; ++kk) { const GAS f32x4* gp = (const GAS f32x4*)(gq + 16 * kk + 8 * hi); const f32x4 g0 = gp[0], g1 = gp[1]; float v[8];
#pragma unroll
              for (int j = 0; j < 8; ++j) v[j] = __uint_as_float((unsigned)(unsigned short)qr[kk][j] << 16) * rstd * ((j < 4 ? g0[j & 3] : g1[j & 3]) * (0.08838834764831845f * LOG2E));
              const u32x4 w = pk8(v); qr[kk] = __builtin_bit_cast(bf16x8, w); } }
        f32x16 o[4] = {{}, {}, {}, {}}; float m = -1e30f, l = 0.f;
        for (int kb = 0; kb < 8; ++kb) {
            const LAS unsigned char* krd = ml + ML_K + (32 * kb + r32) * ML_KROW + hi * 16;
            f32x16 s = {};
#pragma unroll
            for (int kk = 0; kk < 8; ++kk) { const bf16x8 kf = *(const LAS bf16x8*)(krd + kk * 32); s = MFMA32(kf, qr[kk], s); }
            float mx = s[0];
#pragma unroll
            for (int r = 1; r < 16; ++r) mx = fmaxf(mx, s[r]);
            { const auto rr = __builtin_amdgcn_permlane32_swap(__float_as_uint(mx), __float_as_uint(mx), false, false); mx = fmaxf(__uint_as_float(rr[0]), __uint_as_float(rr[1])); }
            if (__any(mx > m + 8.0f)) {
                const float mn = fmaxf(m, mx), alpha = __builtin_amdgcn_exp2f(m - mn);
                l *= alpha; m = mn;
#pragma unroll
                for (int d = 0; d < 4; ++d)
#pragma unroll
                    for (int r = 0; r < 16; ++r) o[d][r] *= alpha;
            }
            float pr[16], rs = 0.f;
#pragma unroll
            for (int r = 0; r < 16; ++r) { pr[r] = __builtin_amdgcn_exp2f(s[r] - m); rs += pr[r]; }
            l += rs;
            const bf16x8 p0 = pack8(pr), p1 = pack8(pr + 8);
            const lds_cptr vrd = (lds_cptr)ml + ML_V + kb * 8192 + vtr_lane_off(lane);
#pragma unroll
            for (int d = 0; d < 4; ++d) { const bf16x8 va = vfrag(vrd, d * 2048), vb = vfrag(vrd, d * 2048 + 1024); o[d] = MFMA32(va, p0, o[d]); o[d] = MFMA32(vb, p1, o[d]); }
        }
        { const auto rr = __builtin_amdgcn_permlane32_swap(__float_as_uint(l), __float_as_uint(l), false, false); l = __uint_as_float(rr[0]) + __uint_as_float(rr[1]); }
        const float il = 1.0f / l;
        bf16_t* op = omem + (tok0 + r32) * 512 + h * 128 + 8 * hi;
#pragma unroll
        for (int d = 0; d < 4; ++d)
#pragma unroll
            for (int gp = 0; gp < 2; ++gp) { u32x2 we, wo; const int ge = 2 * gp, go = 2 * gp + 1;
                we.x = cvt_pk_bf16(o[d][4 * ge] * il, o[d][4 * ge + 1] * il); we.y = cvt_pk_bf16(o[d][4 * ge + 2] * il, o[d][4 * ge + 3] * il);
                wo.x = cvt_pk_bf16(o[d][4 * go] * il, o[d][4 * go + 1] * il); wo.y = cvt_pk_bf16(o[d][4 * go + 2] * il, o[d][4 * go + 3] * il);
                const auto sx = __builtin_amdgcn_permlane32_swap(we.x, wo.x, false, false), sy = __builtin_amdgcn_permlane32_swap(we.y, wo.y, false, false);
                *(u32x4*)(op + 32 * d + 16 * gp) = (u32x4){sx[0], sy[0], sx[1], sy[1]}; }
    }
    __syncthreads();
}

constexpr int DL_HIST = 0, DL_PREFIX = 66048, DL_KREM = DL_PREFIX + 256, DL_MASK = 67072, DL_VT = 73728, DL_KT = DL_VT + 2 * 16384, DL_END = DL_KT + 2 * 18432, DL_IQ = DL_VT;
constexpr int TOPK_DSA = 256;

struct IqLds { const LAS unsigned char* p; __device__ __forceinline__ bf16x8 operator()(int j) const { return *(const LAS bf16x8*)(p + j * 32); } };
__device__ __forceinline__ float relu_f(float x) { float r; asm("v_max_f32 %0, 0, %1" : "=v"(r) : "v"(x)); return r; }
template <class QF>
__device__ __forceinline__ void idx_scores(const QF& qf, const bf16x8 (&kf)[4], const float (&wq)[4], unsigned (&uk)[16]) {
    f32x16 a[4]; bf16x8 qa[4];
#pragma unroll
    for (int hd = 0; hd < 4; ++hd) { a[hd] = (f32x16){}; qa[hd] = qf(hd * 4); }
#pragma unroll
    for (int kk = 0; kk < 4; ++kk) {
#pragma unroll
        for (int hd = 0; hd < 4; ++hd) { a[hd] = MFMA32(kf[kk], qa[hd], a[hd]); if (kk + 1 < 4) qa[hd] = qf(hd * 4 + kk + 1); }
        __builtin_amdgcn_sched_barrier(0);
    }
    float scv[16];
#pragma unroll
    for (int hd = 0; hd < 4; ++hd) {
#pragma unroll
        for (int r = 0; r < 16; ++r) scv[r] = (hd == 0) ? wq[0] * relu_f(a[0][r]) : __builtin_fmaf(wq[hd], relu_f(a[hd][r]), scv[r]); }
#pragma unroll
    for (int r = 0; r < 16; ++r) {
        unsigned bits = __builtin_bit_cast(unsigned, scv[r]);
        if (bits == 0x80000000u) bits = 0u;
        uk[r] = bits ^ ((unsigned)((int)bits >> 31) | 0x80000000u);
    }
}
__device__ __forceinline__ void load_ik(const bf16_t* proj, size_t tokb, int kbase, int r32, int hi, bf16x8 (&kf)[4]) {
    int kr = kbase + r32; if (kr > SEQ - 1) kr = SEQ - 1;
    const GAS bf16_t* p = (const GAS bf16_t*)proj + (tokb + kr) * PW + C_IK + 8 * hi;
#pragma unroll
    for (int kk = 0; kk < 4; ++kk) kf[kk] = *(const GAS bf16x8*)(p + kk * 16);
}

__device__ __forceinline__ void dsa_unit(const bf16_t* proj, bf16_t* odsa, unsigned* kscr  , int b, int c, LAS unsigned char* dl, int tid, const float* gqd  , const f32x2* rope  ) {
    const int lane = tid & 63, wid = __builtin_amdgcn_readfirstlane(tid >> 6), r32 = lane & 31, hi = lane >> 5;
    const int n = 64 * (c + 1), nsteps = (n + 127) >> 7;
    const size_t tokq0 = (size_t)b * SEQ + (size_t)c * 64, tokb = (size_t)b * SEQ;
    LAS unsigned* hist = (LAS unsigned*)(dl + DL_HIST);
    LAS unsigned* prefix = (LAS unsigned*)(dl + DL_PREFIX);
    LAS unsigned* krem = (LAS unsigned*)(dl + DL_KREM);
    LAS unsigned* mask = (LAS unsigned*)(dl + DL_MASK);
    const int kb = wid >> 1, qh = wid & 1;
    { const int row = tid >> 3, c = tid & 7;
      const GAS bf16_t* src = (const GAS bf16_t*)proj + (tokq0 + row) * PW + C_IQ + c * 32;
#pragma unroll
      for (int i = 0; i < 4; ++i) *(LAS u32x4*)(dl + DL_IQ + row * 528 + c * 64 + i * 16) = *(const GAS u32x4*)(src + i * 8); }
    const IqLds iqf{dl + DL_IQ + (32 * qh + r32) * 528 + hi * 16};
    float wq[4];
    { const u32x2 w = *(const u32x2*)(proj + (tokq0 + 32 * qh + r32) * PW + C_IW);
      wq[0] = bflo(w.x) * 0.0625f; wq[1] = bfhi(w.x) * 0.0625f; wq[2] = bflo(w.y) * 0.0625f; wq[3] = bfhi(w.y) * 0.0625f; }
#ifndef REP_SEL
#define REP_SEL 1
#endif
#ifndef REP_B2
#define REP_B2 1
#endif
    LAS unsigned* selall = (LAS unsigned*)(dl + DL_HIST);
#ifndef PROBE_NOATOM
#define PROBE_NOATOM 0
#endif
    unsigned dummy = 0u;
    for (int rep_sel = 0; rep_sel < REP_SEL; ++rep_sel) {
    if (tid < 64) { prefix[tid] = 0u; krem[tid] = (n > TOPK_DSA) ? (unsigned)TOPK_DSA : 0x7fffffffu; }
    __syncthreads();
    const int pass0 = (n > TOPK_DSA) ? 0 : 3;
    GAS u32x4* kmine = (GAS u32x4*)kscr + (size_t)wid * 256 + lane;
#define DSA_CONSUME(uk_) do { \
        if (sel) { _Pragma("unroll") for (int r = 0; r < 16; ++r) { const bool match = (pass == 0) || (((uk_)[r] >> (shift + 8)) == pfx); \
                  \
                __hip_atomic_fetch_add(hist + (32 * qh + r32) * 257 + (match ? (((uk_)[r] >> shift) & 255u) : 256u), 1u, __ATOMIC_RELAXED, __HIP_MEMORY_SCOPE_WORKGROUP); } } \
        else { _Pragma("unroll") for (int r = 0; r < 16; ++r) { const unsigned k24 = (uk_)[r] >> 8; gtw |= (k24 > pfx ? 1u : 0u) << crow(r, hi); eqw |= (k24 == pfx ? 1u : 0u) << crow(r, hi); } } } while (0)
#define DSA_TIES() do { if (!sel) { \
        LAS unsigned* mk = mask + (step & 1) * 768; \
        { const auto rg = __builtin_amdgcn_permlane32_swap(gtw, gtw, false, false); gtw = rg[0] | rg[1]; const auto re = __builtin_amdgcn_permlane32_swap(eqw, eqw, false, false); eqw = re[0] | re[1]; } \
        if (hi == 0) { mk[(32 * qh + r32) * 4 + kb] = gtw; mk[256 + (32 * qh + r32) * 4 + kb] = eqw; } \
        __syncthreads(); \
        if (wid == 0) { unsigned nd = krem[lane]; \
            _Pragma("unroll") for (int k4 = 0; k4 < 4; ++k4) { const unsigned g = mk[lane * 4 + k4]; unsigned e = mk[256 + lane * 4 + k4]; unsigned sl = g; \
                if (e != 0u) { const unsigned cnt = (unsigned)__builtin_popcount(e); \
                    if (cnt <= nd) { sl |= e; nd -= cnt; } \
                    else { unsigned chosen = 0u; while (nd > 0u) { const unsigned lb = e & (0u - e); chosen |= lb; e ^= lb; --nd; } sl |= chosen; } } \
                selall[lane * 64 + step * 4 + k4] = sl; } \
            krem[lane] = nd; } } } while (0)
#ifndef REP_MASKP
#define REP_MASKP 0
#endif
#ifndef REP_P0
#define REP_P0 0
#endif
    for (int pp = pass0 - ((REP_P0 && pass0 == 0) ? 1 : 0); pp < ((rep_sel + 1 < REP_SEL) ? 3 : 4 + REP_MASKP); ++pp) { const int pass = pp > 3 ? 3 : (pp < 0 ? 0 : pp);
        if (pp > 3) { if (tid < 64) krem[tid] = 0x7fffffffu; __syncthreads(); }
        const bool sel = pass < 3;
        if (sel) { for (int i = tid; i < 64 * 257; i += 512) hist[i] = 0u; __syncthreads(); }
        const int shift = 24 - 8 * pass;
        const unsigned pfx = prefix[32 * qh + r32];
        if (pass == pass0) {
            bf16x8 kfn[4]; load_ik(proj, tokb, 32 * kb, r32, hi, kfn);
            for (int step = 0; step < nsteps; ++step) {
                const int kbase = 128 * step + 32 * kb;
                bf16x8 kf[4];
#pragma unroll
                for (int kk = 0; kk < 4; ++kk) kf[kk] = kfn[kk];
                if (step + 1 < nsteps) load_ik(proj, tokb, kbase + 128, r32, hi, kfn);
                unsigned gtw = 0u, eqw = 0u;
                if (kbase < n) {
                    unsigned uk[16];
                    idx_scores(iqf, kf, wq, uk);
#ifndef P0_VAR
#define P0_VAR 0
#endif
                    if (pass0 == 0 && !(P0_VAR == 1 && pp < 0)) {
#pragma unroll
                        for (int g = 0; g < 4; ++g) kmine[(size_t)step * 2048 + g * 64] = (u32x4){uk[4 * g], uk[4 * g + 1], uk[4 * g + 2], uk[4 * g + 3]};
                    }
                    if (!(P0_VAR == 2 && pp < 0)) DSA_CONSUME(uk); else dummy ^= uk[0] ^ uk[5] ^ uk[9] ^ uk[15];
                }
                DSA_TIES();
            }
        } else {
            u32x4 ka[4], kb4[4];
#define DSA_KLOAD(dst, st_) do { _Pragma("unroll") for (int g = 0; g < 4; ++g) dst[g] = kmine[(size_t)(st_) * 2048 + g * 64]; } while (0)
            DSA_KLOAD(ka, 0);
            if (nsteps > 1 && 128 + 32 * kb < n) DSA_KLOAD(kb4, 1);
            for (int step = 0; step < nsteps; ++step) {
                const int kbase = 128 * step + 32 * kb;
                unsigned uk[16];
#pragma unroll
                for (int g = 0; g < 4; ++g) { uk[4 * g] = ka[g].x; uk[4 * g + 1] = ka[g].y; uk[4 * g + 2] = ka[g].z; uk[4 * g + 3] = ka[g].w; }
#pragma unroll
                for (int g = 0; g < 4; ++g) ka[g] = kb4[g];
                if (step + 2 < nsteps && kbase + 256 < n) DSA_KLOAD(kb4, step + 2);
                unsigned gtw = 0u, eqw = 0u;
                if (kbase < n) DSA_CONSUME(uk);
                DSA_TIES();
            }
#undef DSA_KLOAD
        }
        if (sel && pp < 0) __syncthreads();
        if (sel && pp >= 0) {
            __syncthreads();
#pragma unroll
            for (int qi = 0; qi < 8; ++qi) {
                const int q = 8 * wid + qi;
                const LAS unsigned* hq = hist + q * 257;
                const unsigned c0 = hq[255 - 4 * lane], c1 = hq[254 - 4 * lane], c2 = hq[253 - 4 * lane], c3 = hq[252 - 4 * lane];
                const unsigned s4 = c0 + c1 + c2 + c3;
                unsigned incl = s4;
                incl += (unsigned)__builtin_amdgcn_update_dpp(0, (int)incl, 0x111, 0xF, 0xF, true);
                incl += (unsigned)__builtin_amdgcn_update_dpp(0, (int)incl, 0x112, 0xF, 0xF, true);
                incl += (unsigned)__builtin_amdgcn_update_dpp(0, (int)incl, 0x114, 0xF, 0xF, true);
                incl += (unsigned)__builtin_amdgcn_update_dpp(0, (int)incl, 0x118, 0xF, 0xF, true);
                incl += (unsigned)__builtin_amdgcn_update_dpp(0, (int)incl, 0x142, 0xA, 0xF, false);
                incl += (unsigned)__builtin_amdgcn_update_dpp(0, (int)incl, 0x143, 0xC, 0xF, false);
                const unsigned excl = incl - s4, kr = krem[q];
                if (excl < kr && kr <= incl) {
                    unsigned cum = excl, bin, nk;
                    if (cum + c0 >= kr) { bin = 255 - 4 * lane; nk = kr - cum; }
                    else { cum += c0; if (cum + c1 >= kr) { bin = 254 - 4 * lane; nk = kr - cum; }
                    else { cum += c1; if (cum + c2 >= kr) { bin = 253 - 4 * lane; nk = kr - cum; }
                    else { cum += c2; bin = 252 - 4 * lane; nk = kr - cum; } } }
                    prefix[q] = (prefix[q] << 8) | bin; krem[q] = nk;
                }
            }
            __syncthreads();
        }
    }
    }
    if (dummy == 0x9e3779b9u) hist[tid] = 1u;
#ifndef B2_PRIO
#define B2_PRIO 0
#endif
    const int hd = wid;
    u32x4 pk[2], pv[2];
#define DSA_LOADKV(step_) do { _Pragma("unroll") for (int i_ = 0; i_ < 2; ++i_) { const int ch_ = tid + 512 * i_; int krow_ = 128 * (step_) + (ch_ >> 3); if (krow_ > SEQ - 1) krow_ = SEQ - 1; \
        const GAS bf16_t* rp_ = (const GAS bf16_t*)proj + (tokb + krow_) * PW + (ch_ & 7) * 8; pk[i_] = *(const GAS u32x4*)(rp_ + C_DK); pv[i_] = *(const GAS u32x4*)(rp_ + C_DV); } } while (0)
#define DSA_STOREKV(buf_) do { _Pragma("unroll") for (int i_ = 0; i_ < 2; ++i_) { const int ch_ = tid + 512 * i_, key_ = ch_ >> 3, c8_ = ch_ & 7, kk_ = key_ & 31; \
        *(LAS u32x4*)(dl + DL_KT + (buf_) * 18432 + key_ * 144 + c8_ * 16) = pk[i_]; \
        *(LAS u32x4*)(dl + DL_VT + (buf_) * 16384 + (key_ >> 5) * 4096 + ((c8_ >> 2) * 2 + (kk_ >> 4)) * 1024 + (kk_ & 15) * 64 + (c8_ & 3) * 16) = pv[i_]; } } while (0)
    for (int rep_b2 = 0; rep_b2 < REP_B2; ++rep_b2)
    for (int qb = 0; qb < 2; ++qb) {
        bf16x8 qr[4];
        { const GAS bf16_t* qp = (const GAS bf16_t*)proj + (tokq0 + 32 * qb + r32) * PW + C_DQ + hd * 64 + 8 * hi;
#pragma unroll
          for (int kk = 0; kk < 4; ++kk) qr[kk] = *(const GAS bf16x8*)(qp + kk * 16); }
        { float v[4][8]; float ss = 0.f;
#pragma unroll
          for (int kk = 0; kk < 4; ++kk)
#pragma unroll
              for (int j = 0; j < 8; ++j) { v[kk][j] = __uint_as_float((unsigned)(unsigned short)qr[kk][j] << 16); ss += v[kk][j] * v[kk][j]; }
          { const auto rr = __builtin_amdgcn_permlane32_swap(__float_as_uint(ss), __float_as_uint(ss), false, false); ss = __uint_as_float(rr[0]) + __uint_as_float(rr[1]); }
          const float rstd = 1.0f / sqrtf(ss * (1.f / 64.f) + EPS);
#pragma unroll
          for (int kk = 0; kk < 4; ++kk) { const GAS f32x4* gp = (const GAS f32x4*)(gqd + 16 * kk + 8 * hi); const f32x4 g0 = gp[0], g1 = gp[1];
#pragma unroll
              for (int j = 0; j < 8; ++j) v[kk][j] = v[kk][j] * rstd * ((j < 4 ? g0[j & 3] : g1[j & 3]) * (0.125f * LOG2E)); }
          const int pos = c * 64 + 32 * qb + r32;
#pragma unroll
          for (int kk = 0; kk < 2; ++kk) { const GAS f32x4* tp = (const GAS f32x4*)((const GAS f32x2*)rope + (size_t)pos * 32 + 16 * kk + 8 * hi);
#pragma unroll
              for (int jj = 0; jj < 4; ++jj) { const f32x4 cs2 = tp[jj];
#pragma unroll
                  for (int e = 0; e < 2; ++e) { const int j = 2 * jj + e; const float cc = e ? cs2[2] : cs2[0], sn = e ? cs2[3] : cs2[1];
                      const float x1 = v[kk][j], x2 = v[kk + 2][j]; v[kk][j] = x1 * cc - x2 * sn; v[kk + 2][j] = x2 * cc + x1 * sn; } } }
#pragma unroll
          for (int kk = 0; kk < 4; ++kk) { const u32x4 w = pk8(v[kk]); qr[kk] = __builtin_bit_cast(bf16x8, w); } }
        f32x16 o0 = {}, o1 = {}; float mrun = -1e30f, lrun = 0.f;
        DSA_LOADKV(0);
        DSA_STOREKV(0);
        __syncthreads();
#define B2_QK(S_, k4_) do { const LAS unsigned char* krd_ = kt + (32 * (k4_) + r32) * 144 + hi * 16; S_ = (f32x16){}; if (B2_PRIO) __builtin_amdgcn_s_setprio(B2_PRIO); \
        _Pragma("unroll") for (int kk = 0; kk < 4; ++kk) { const bf16x8 kf_ = *(const LAS bf16x8*)(krd_ + kk * 32); S_ = MFMA32(kf_, qr[kk], S_); } if (B2_PRIO) __builtin_amdgcn_s_setprio(0); } while (0)
#define B2_SM_PV(S_, k4_) do { \
        const int selw_ = (int)selall[(32 * qb + r32) * 64 + step * 4 + (k4_)]; float mx_ = -INFINITY; \
        _Pragma("unroll") for (int r = 0; r < 16; ++r) { const unsigned m_ = (unsigned)__builtin_amdgcn_sbfe(selw_, crow(r, hi), 1); \
            S_[r] = __uint_as_float((__float_as_uint(S_[r]) & m_) | (0xFF800000u & ~m_)); mx_ = fmaxf(mx_, S_[r]); } \
        { const auto rr_ = __builtin_amdgcn_permlane32_swap(__float_as_uint(mx_), __float_as_uint(mx_), false, false); mx_ = fmaxf(__uint_as_float(rr_[0]), __uint_as_float(rr_[1])); } \
        if (__any(mx_ > mrun + 8.0f)) { const float mn_ = fmaxf(mrun, mx_), alpha_ = __builtin_amdgcn_exp2f(mrun - mn_); lrun *= alpha_; mrun = mn_; \
            _Pragma("unroll") for (int r = 0; r < 16; ++r) { o0[r] *= alpha_; o1[r] *= alpha_; } } \
        float pr_[16], rs_ = 0.f; \
        _Pragma("unroll") for (int r = 0; r < 16; ++r) { pr_[r] = __builtin_amdgcn_exp2f(S_[r] - mrun); rs_ += pr_[r]; } \
        lrun += rs_; \
        const bf16x8 pa_ = pack8(pr_), pb_ = pack8(pr_ + 8); \
        const lds_cptr vrd_ = (lds_cptr)vt + (k4_) * 4096 + vtr_lane_off(lane); \
        const bf16x8 v00_ = vfrag(vrd_, 0), v01_ = vfrag(vrd_, 1024), v10_ = vfrag(vrd_, 2048), v11_ = vfrag(vrd_, 3072); \
        if (B2_PRIO) __builtin_amdgcn_s_setprio(B2_PRIO); o0 = MFMA32(v00_, pa_, o0); o0 = MFMA32(v01_, pb_, o0); o1 = MFMA32(v10_, pa_, o1); o1 = MFMA32(v11_, pb_, o1); if (B2_PRIO) __builtin_amdgcn_s_setprio(0); } while (0)
        for (int step = 0; step < nsteps; ++step) {
            const int buf = step & 1;
            if (step + 1 < nsteps) DSA_LOADKV(step + 1);
            LAS unsigned char* kt = dl + DL_KT + buf * 18432;
            LAS unsigned char* vt = dl + DL_VT + buf * 16384;
            f32x16 sa, sb;
            B2_QK(sa, 0);
            B2_QK(sb, 1); B2_SM_PV(sa, 0); __builtin_amdgcn_sched_barrier(0);
            if (128 * step + 64 < n) {
                B2_QK(sa, 2); B2_SM_PV(sb, 1); __builtin_amdgcn_sched_barrier(0);
                B2_QK(sb, 3); B2_SM_PV(sa, 2); __builtin_amdgcn_sched_barrier(0);
                B2_SM_PV(sb, 3);
            } else {
                B2_SM_PV(sb, 1);
            }
            if (step + 1 < nsteps) DSA_STOREKV(buf ^ 1);
            __syncthreads();
        }
#undef B2_QK
#undef B2_SM_PV
        float l = lrun; { const auto rr = __builtin_amdgcn_permlane32_swap(__float_as_uint(l), __float_as_uint(l), false, false); l = __uint_as_float(rr[0]) + __uint_as_float(rr[1]); }
        const float il = 1.0f / l;
        u32x2 w0[4], w1[4];
#pragma unroll
        for (int g = 0; g < 4; ++g) { w0[g].x = cvt_pk_bf16(o0[4 * g] * il, o0[4 * g + 1] * il); w0[g].y = cvt_pk_bf16(o0[4 * g + 2] * il, o0[4 * g + 3] * il);
            w1[g].x = cvt_pk_bf16(o1[4 * g] * il, o1[4 * g + 1] * il); w1[g].y = cvt_pk_bf16(o1[4 * g + 2] * il, o1[4 * g + 3] * il); }
        { int lq = lane; asm volatile("" : "+v"(lq));
          store_o32x64(dl + DL_HIST + 16384 + wid * 4096, w0, w1, odsa + (tokq0 + 32 * qb) * 512 + hd * 64, lq); }
    }
#undef DSA_LOADKV
#undef DSA_STOREKV
#undef DSA_CONSUME
#undef DSA_TIES
    __syncthreads();
}

template <int CTRL> __device__ __forceinline__ float dpp_f(float v) { return __builtin_bit_cast(float, __builtin_amdgcn_update_dpp(0, __builtin_bit_cast(int, v), CTRL, 0xF, 0xF, false)); }
constexpr int RL_WROW = 2064, RL_WHI = 0, RL_WLO = 32 * RL_WROW, RL_TKE = 2 * 32 * RL_WROW, RL_TKW = RL_TKE + 4096, RL_RSTD = RL_TKW + 4096;
__device__ __forceinline__ void p9_router(Frame& F) {
    const int lane = F.lane, wave = F.wave, tid = F.tid, r32 = lane & 31, hi = lane >> 5;
    LAS int* tke = (LAS int*)(F.lds + RL_TKE); LAS float* tkw = (LAS float*)(F.lds + RL_TKW);
    const float* w_router = F.in[15]; const float* b_router = F.in[16]; const float* g_ffn = F.in[14];
    for (int idx = tid; idx < DM * NEXP; idx += NWAVES * 64) { const int k = idx >> 5, e = idx & 31; const float w = w_router[idx] * g_ffn[k];
        const unsigned wh = f2bf(w); const unsigned wl = f2bf(w - __builtin_bit_cast(float, wh << 16));
        *(LAS bf16_t*)(F.lds + RL_WHI + e * RL_WROW + k * 2) = (bf16_t)wh; *(LAS bf16_t*)(F.lds + RL_WLO + e * RL_WROW + k * 2) = (bf16_t)wl; }
    if (tid < 32) F.MISC[MW_LCNT + tid] = 0u;
    __syncthreads();
    unsigned char* h2f8 = F.ws + WS_H2F8; LAS float* rsl = (LAS float*)(F.lds + RL_RSTD) + 32 * wave;
    const GAS f32x4* gr = (const GAS f32x4*)g_ffn + lane;
    f32x4 gg[4];
#pragma unroll
    for (int j = 0; j < 4; ++j) gg[j] = gr[64 * j];
    const size_t tok0 = (size_t)F.blk * 256 + 32 * wave;
    constexpr int NR = 4;
    u32x2 xnext[NR][4];
#pragma unroll
    for (int tk = 0; tk < NR; ++tk) { const GAS u32x2* xr = (const GAS u32x2*)((const GAS bf16_t*)F.out + (tok0 + tk) * 2048 + ((tok0 + tk) & 1) * 1024) + lane;
#pragma unroll
        for (int j = 0; j < 4; ++j) xnext[tk][j] = xr[64 * j]; }
    for (int it = 0; it < 32 / NR; ++it) {
        f32x4 hn[NR][4];
#pragma unroll
        for (int tk = 0; tk < NR; ++tk)
#pragma unroll
            for (int j = 0; j < 4; ++j) hn[tk][j] = (f32x4){bflo(xnext[tk][j].x), bfhi(xnext[tk][j].x), bflo(xnext[tk][j].y), bfhi(xnext[tk][j].y)};
        if (it + 1 < 32 / NR) {
#pragma unroll
            for (int tk = 0; tk < NR; ++tk) { const GAS u32x2* xr = (const GAS u32x2*)((const GAS bf16_t*)F.out + (tok0 + NR * it + NR + tk) * 2048 + ((tok0 + NR * it + NR + tk) & 1) * 1024) + lane;
#pragma unroll
                for (int j = 0; j < 4; ++j) xnext[tk][j] = xr[64 * j]; } }
        float s[NR];
#pragma unroll
        for (int tk = 0; tk < NR; ++tk) { float a = 0.f;
#pragma unroll
            for (int j = 0; j < 4; ++j) a += (hn[tk][j].x * hn[tk][j].x + hn[tk][j].y * hn[tk][j].y) + (hn[tk][j].z * hn[tk][j].z + hn[tk][j].w * hn[tk][j].w);
            s[tk] = a; }
#pragma unroll
        for (int tk = 0; tk < NR; ++tk) { float a = s[tk];
            a += dpp_f<0xB1>(a); a += dpp_f<0x4E>(a); a += dpp_f<0x141>(a); a += dpp_f<0x128>(a);
            { const auto rr = __builtin_amdgcn_permlane16_swap(__float_as_uint(a), __float_as_uint(a), false, false); a = __uint_as_float(rr[0]) + __uint_as_float(rr[1]); }
            { const auto rr = __builtin_amdgcn_permlane32_swap(__float_as_uint(a), __float_as_uint(a), false, false); a = __uint_as_float(rr[0]) + __uint_as_float(rr[1]); }
            s[tk] = a; }
#pragma unroll
        for (int tk = 0; tk < NR; ++tk) {
            const float rstd = 1.0f / sqrtf(s[tk] * (1.f / DM) + EPS);
            if (lane == 0) rsl[NR * it + tk] = rstd;
#pragma unroll
            for (int j = 0; j < 4; ++j) { const f32x4 v = hn[tk][j] * rstd * gg[j];
                *((GAS unsigned*)(h2f8 + (tok0 + NR * it + tk) * DM) + lane + 64 * j) = pk4_f8(v.x, v.y, v.z, v.w); }
        }
    }
    f32x16 acc = {};
    { const size_t tq = tok0 + r32; const GAS bf16_t* hp = (const GAS bf16_t*)F.out + tq * 2048 + (tq & 1) * 1024 + 8 * hi;
      const LAS unsigned char* wp = F.lds + RL_WHI + r32 * RL_WROW + 16 * hi;
#pragma unroll 8
      for (int kk = 0; kk < 64; ++kk) { const bf16x8 hb = *(const GAS bf16x8*)(hp + 16 * kk);
          const bf16x8 wh = *(const LAS bf16x8*)(wp + 32 * kk), wl = *(const LAS bf16x8*)(wp + RL_WLO + 32 * kk);
          acc = MFMA32(wh, hb, acc); acc = MFMA32(wl, hb, acc); } }
    float lg[16];
    const float rstd_t = rsl[r32];
#pragma unroll
    for (int r = 0; r < 16; ++r) lg[r] = acc[r] * rstd_t + b_router[crow(r, hi)];
    float lv[4]; int li[4];
#pragma unroll
    for (int k = 0; k < 4; ++k) { float bv = lg[0]; int br = 0;
#pragma unroll
        for (int r = 1; r < 16; ++r) { const bool g = lg[r] > bv; bv = g ? lg[r] : bv; br = g ? r : br; }
        lv[k] = bv; li[k] = crow(br, hi);
#pragma unroll
        for (int r = 0; r < 16; ++r) lg[r] = (r == br) ? -INFINITY : lg[r]; }
    float ov[4]; int oi[4];
#pragma unroll
    for (int k = 0; k < 4; ++k) { const auto rv = __builtin_amdgcn_permlane32_swap(__float_as_uint(lv[k]), __float_as_uint(lv[k]), false, false); const auto ri = __builtin_amdgcn_permlane32_swap((unsigned)li[k], (unsigned)li[k], false, false);
        ov[k] = hi ? __uint_as_float(rv[0]) : __uint_as_float(rv[1]); oi[k] = hi ? (int)ri[0] : (int)ri[1]; }
    float tv[4]; int te[4];
    { float a0 = lv[0], a1 = lv[1], a2 = lv[2], a3 = lv[3], b0 = ov[0], b1 = ov[1], b2 = ov[2], b3 = ov[3];
      int i0 = li[0], i1 = li[1], i2 = li[2], i3 = li[3], j0 = oi[0], j1 = oi[1], j2 = oi[2], j3 = oi[3];
#pragma unroll
      for (int k = 0; k < 4; ++k) { const bool ta = (a0 > b0) || (a0 == b0 && i0 < j0);
          tv[k] = ta ? a0 : b0; te[k] = ta ? i0 : j0;
          if (ta) { a0 = a1; a1 = a2; a2 = a3; a3 = -INFINITY; i0 = i1; i1 = i2; i2 = i3; i3 = 64; }
          else { b0 = b1; b1 = b2; b2 = b3; b3 = -INFINITY; j0 = j1; j1 = j2; j2 = j3; j3 = 64; } } }
    const float e1 = __expf(tv[1] - tv[0]), e2x = __expf(tv[2] - tv[0]), e3 = __expf(tv[3] - tv[0]);
    const float inv = 1.0f / (1.0f + e1 + e2x + e3);
    if (hi == 0) { const int tl = 32 * wave + r32;
        *(LAS int*)(tke + tl * 4 + 0) = te[0]; tke[tl * 4 + 1] = te[1]; tke[tl * 4 + 2] = te[2]; tke[tl * 4 + 3] = te[3];
        tkw[tl * 4 + 0] = inv; tkw[tl * 4 + 1] = e1 * inv; tkw[tl * 4 + 2] = e2x * inv; tkw[tl * 4 + 3] = e3 * inv;
#pragma unroll
        for (int k = 0; k < 4; ++k) __hip_atomic_fetch_add((LAS unsigned*)F.MISC + MW_LCNT + te[k], 1u, __ATOMIC_RELAXED, __HIP_MEMORY_SCOPE_WORKGROUP); }
    __syncthreads();
    if (tid < 32) ((int*)(F.ws + WS_BLKCNT))[F.blk * 32 + tid] = (int)F.MISC[MW_LCNT + tid];
}
__device__ __forceinline__ void p10_assign(Frame& F) {
    const int tid = F.tid;
    const int* blkcnt = (const int*)(F.ws + WS_BLKCNT);
    LAS int* part = (LAS int*)(F.lds);
    LAS int* tke = (LAS int*)(F.lds + RL_TKE); LAS float* tkw = (LAS float*)(F.lds + RL_TKW);
    { const int e = tid & 31, p = tid >> 5; int tot = 0, bef = 0;
      for (int j = 0; j < 16; ++j) { const int bl = p * 16 + j; const int c = blkcnt[bl * 32 + e]; tot += c; bef += (bl < F.blk) ? c : 0; }
      part[p * 32 + e] = tot; part[512 + p * 32 + e] = bef; }
    __syncthreads();
    if (tid < 32) { int tot = 0, bef = 0;
        for (int p = 0; p < 16; ++p) { tot += part[p * 32 + tid]; bef += part[512 + p * 32 + tid]; }
        part[1024 + tid] = tot; F.MISC[MW_BEFORE + tid] = (unsigned)bef; F.MISC[MW_LCNT + tid] = 0u; }
    __syncthreads();
    if (tid == 0) { int ps = 0;
        for (int e = 0; e < 32; ++e) { F.MISC[MW_PSTART + e] = (unsigned)ps; F.MISC[MW_TSTART + e] = (unsigned)(ps >> 8); ps += (part[1024 + e] + 255) & ~255; }
        F.MISC[MW_PSTART + 32] = (unsigned)ps; F.MISC[MW_TSTART + 32] = (unsigned)(ps >> 8); }
    __syncthreads();
    int* slot_tok = (int*)(F.ws + WS_SLOT_TOK); int* tok_slot = (int*)(F.ws + WS_TOK_SLOT); float* tok_gate = (float*)(F.ws + WS_TOK_GATE);
    for (int idx = tid; idx < 1024; idx += NWAVES * 64) {
        const int e = tke[idx]; const float w = tkw[idx];
        const unsigned r = __hip_atomic_fetch_add((LAS unsigned*)F.MISC + MW_LCNT + e, 1u, __ATOMIC_RELAXED, __HIP_MEMORY_SCOPE_WORKGROUP);
        const unsigned pos = F.MISC[MW_PSTART + e] + F.MISC[MW_BEFORE + e] + r;
        slot_tok[pos] = F.blk * 256 + (idx >> 2); tok_slot[F.blk * 1024 + idx] = (int)pos; tok_gate[F.blk * 1024 + idx] = w;
    }
}

__device__ __forceinline__ void p13_combine(Frame& F) {
    const int gw = F.blk * NWAVES + F.wave, NGW = F.G * NWAVES, lane = F.lane;
    const int* tok_slot = (const int*)(F.ws + WS_TOK_SLOT); const float* tok_gate = (const float*)(F.ws + WS_TOK_GATE);
    const GAS unsigned char* Y = (const GAS unsigned char*)(F.ws + WS_Y);
    typedef float f2_t __attribute__((ext_vector_type(2)));
    constexpr int NT = 2;
    for (int t0 = gw; t0 < NTOK; t0 += NT * NGW) {
        unsigned y[NT][4][4]; u32x2 xb[NT][4]; float g[NT][4];
#pragma unroll
        for (int tk = 0; tk < NT; ++tk) { const int t = t0 + tk * NGW;
#pragma unroll
            for (int k = 0; k < 4; ++k) { const int sl = __builtin_amdgcn_readfirstlane(tok_slot[4 * t + k]); g[tk][k] = tok_gate[4 * t + k];
                const GAS unsigned* yr = (const GAS unsigned*)(Y + (size_t)sl * DM) + lane;
#pragma unroll
                for (int c = 0; c < 4; ++c) y[tk][k][c] = NT_LD(yr + 64 * c); }
            const GAS u32x2* xrow = (const GAS u32x2*)((const GAS bf16_t*)F.out + (size_t)t * 2048 + (t & 1) * 1024) + lane;
#pragma unroll
            for (int c = 0; c < 4; ++c) xb[tk][c] = NT_LD(xrow + 64 * c); }
        asm volatile("s_waitcnt vmcnt(0)" ::: "memory");
#pragma unroll
        for (int tk = 0; tk < NT; ++tk) { const int t = t0 + tk * NGW;
            f32x4 o[4];
#pragma unroll
            for (int c = 0; c < 4; ++c) o[c] = (f32x4){bflo(xb[tk][c].x), bfhi(xb[tk][c].x), bflo(xb[tk][c].y), bfhi(xb[tk][c].y)};
#pragma unroll
            for (int k = 0; k < 4; ++k) { const float w = g[tk][k];
#pragma unroll
                for (int c = 0; c < 4; ++c) { const f2_t lo = __builtin_amdgcn_cvt_pk_f32_fp8((int)y[tk][k][c], false), hi = __builtin_amdgcn_cvt_pk_f32_fp8((int)y[tk][k][c], true);
                    o[c][0] += w * lo[0]; o[c][1] += w * lo[1]; o[c][2] += w * hi[0]; o[c][3] += w * hi[1]; } }
            GAS f32x4* orow = (GAS f32x4*)((GAS float*)F.out + (size_t)t * DM) + lane;
#pragma unroll
            for (int c = 0; c < 4; ++c) orow[64 * c] = o[c]; }
    }
}

#ifndef MK_ONE_LAUNCH
#define MK_ONE_LAUNCH 1
#endif
constexpr int N_PHASES = 14;
struct Args { const float* in[21]; float* out; unsigned char* ws; int ph_lo, ph_hi; };
static_assert(sizeof(Args) == 21 * 8 + 8 + 8 + 8, "no padding");

__global__ void __launch_bounds__(NWAVES * 64, 2) fwd_kernel(Args args) {
    extern __shared__ __attribute__((aligned(16))) unsigned char lds[];
    Frame F;
    F.lds = (LAS unsigned char*)lds;
    F.MISC = (volatile LAS unsigned*)(F.lds + MISC_OFF);
    F.tid = threadIdx.x; F.lane = F.tid & 63; F.wave = __builtin_amdgcn_readfirstlane(F.tid >> 6);
#define FRESH() do { F.lane = lane_id_fresh(); F.tid = F.wave * 64 + F.lane; } while (0)
    F.G = gridDim.x; F.blk = blockIdx.x;
    F.ws = args.ws; F.out = args.out; F.ctl = (gu32*)(args.ws + WS_CTL);
#pragma unroll
    for (int i = 0; i < 21; ++i) F.in[i] = args.in[i];
    for (int u = F.tid; u < (LDS_BYTES - MISC_OFF) / 4; u += NWAVES * 64) ((LAS unsigned*)(F.lds + MISC_OFF))[u] = 0u;
    __syncthreads();
    const int lo = args.ph_lo, hi = args.ph_hi;
    XcdBarrier bar; bar.bar = (unsigned*)(F.ctl + CW_BAR); bar.x = 0; bar.st = nullptr; bar.wave = F.wave;
    if (hi - lo > 1) bar = xcd_barrier_post((unsigned*)(F.ctl + CW_BAR), F.MISC + MW_BAR);
#ifndef STAG
#define STAG 0
#endif
#ifndef STAG11
#define STAG11 0
#endif
#ifndef STAG12
#define STAG12 0
#endif
#ifndef TPROBE12
#define TPROBE12 0
#endif
#ifndef TPROBE1
#define TPROBE1 0
#endif
#ifndef TPROBE5
#define TPROBE5 0
#endif
#ifndef STAG5
#define STAG5 0
#endif
#ifndef PH_MASK
#define PH_MASK 0x3fff
#endif
#define IN(k) (((PH_MASK >> (k)) & 1) && lo <= (k) && (k) < hi)
#ifndef REP_MASK
#define REP_MASK 0
#endif
#define NREP(k) (1 + ((REP_MASK >> (k)) & 1))
#define SEAM(k) do { if (IN(k) && IN((k) + 1)) xcd_barrier(bar); } while (0)
    unsigned char* ws = args.ws;
    bf16_t* proj = (bf16_t*)(ws + WS_P);

    if (IN(0)) for (int rep = 0; rep < NREP(0); ++rep) { if (rep) xcd_barrier(bar); FRESH(); p0_prologue(F); } SEAM(0);

    if (IN(1)) {
#ifdef PROBE_P1
        { pg8::DenseSched S; S.init(ws + WS_H, ws + WS_WIN, NTOK, PW, DM, F.G, F.blk); S.amask = PROBE_P1;
          pg8::EpiBf16<0> E{(bf16_t*)(ws + WS_END), PW, nullptr, 1023};
          pg8::gemm_phase<pg8::EpiBf16<0>, pg8::DenseSched, true>(F.lds, F.wave, DM, S, E); }
        xcd_barrier(bar);
#endif
        { pg8::DenseSched S; S.init(ws + WS_H, ws + WS_WIN, NTOK, PW, DM, F.G, F.blk); S.tp = TPROBE1;
          pg8::EpiBf16<0> E{proj, PW, nullptr};
          pg8::gemm_phase<pg8::EpiBf16<0>, pg8::DenseSched, true>(F.lds, F.wave, DM, S, E); }
        { pg8::DenseSched S; S.init(ws + WS_MEMN, ws + WS_WMKV, NMEM, DM, DM, F.G, F.blk);
          pg8::EpiBf16<0> E{(bf16_t*)(ws + WS_MKV), DM, nullptr};
          pg8::gemm_phase<pg8::EpiBf16<0>, pg8::DenseSched, true>(F.lds, F.wave, DM, S, E); }
        { pg8::DenseSched S; S.init(ws + WS_H8, ws + WS_WG, NTOK, 3 * DM, DM / 2, F.G, F.blk); S.split = 1;
          pg8::EpiGateU8 E{ws + WS_G, F.in[11]};
          pg8::gemm_phase<pg8::EpiGateU8, pg8::DenseSched, true, true>(F.lds, F.wave, DM / 2, S, E); }
    } SEAM(1);

    if (IN(2)) { FRESH(); if (REP_MASK & 4) { p2_prep(F, true); xcd_barrier(bar); } p2_prep(F); } SEAM(2);

    if (IN(3)) {
        FRESH();
        bf16_t* osb = (bf16_t*)(ws + WS_O); bf16_t* odsa = osb + (size_t)NTOK * 512; bf16_t* omem = odsa + (size_t)NTOK * 512;
#ifndef REP_DSA
#define REP_DSA 1
#endif
#ifndef REP_SB
#define REP_SB 1
#endif
#ifndef REP_MEM
#define REP_MEM 1
#endif
#ifndef NO_DSA
        for (int rep = 0; rep < REP_DSA; ++rep)
        for (int i = 0; i < 4; ++i) { const int p = 2 * F.blk + (i >> 1), b = p >> 4, cc = p & 15, c = (i & 1) ? 31 - cc : cc; dsa_unit(proj, odsa, (unsigned*)F.out + (size_t)F.blk * 131072, b, c, F.lds, F.tid, F.in[4], (const f32x2*)(ws + WS_ROPE)); }
#endif
        FRESH();
        const int gw = F.blk * NWAVES + F.wave, NGW = F.G * NWAVES;
#ifndef NO_SB
        for (int rep = 0; rep < REP_SB; ++rep)
        for (int it = gw; it < NB * 8 * 64; it += NGW) { const int qblk = 63 - (it >> 8), bh = it & 255; sb_item(proj, osb, bh >> 3, bh & 7, qblk, F.lds + F.wave * 8192, F.lane); }
#endif
#ifndef NO_MEM
        for (int rep = 0; rep < REP_MEM; ++rep) {
            __syncthreads();
            FRESH();
            for (int u = F.blk; u < NB * 4 * 2; u += F.G) mem_unit(proj, (const bf16_t*)(ws + WS_MKV), omem, u >> 3, (u >> 1) & 3, u & 1, F.lds, F.tid, F.in[6]);
        }
#endif
    } SEAM(3);


    if (IN(5)) { pg8::MergeSched S; S.init(ws + WS_O, ws + WS_WB, NTOK, DM, F.G, F.blk); S.tp = TPROBE5; S.stag = STAG5;
        pg8::EpiMerge E{ws + WS_G, (bf16_t*)(ws + WS_MERGED)};
        pg8::gemm_phase<pg8::EpiMerge, pg8::MergeSched, true>(F.lds, F.wave, 512, S, E); } SEAM(5);


    if (IN(8)) {
        pg8::DenseSched S; S.init(ws + WS_MERGED, ws + WS_WO, NTOK, DM, DM, F.G, F.blk); S.stag = STAG;
        pg8::EpiResid E{F.in[0], (bf16_t*)F.out};
        pg8::gemm_phase<pg8::EpiResid, pg8::DenseSched, true>(F.lds, F.wave, DM, S, E);
    } SEAM(8);

    if (IN(9)) for (int rep = 0; rep < NREP(9); ++rep) { if (rep) xcd_barrier(bar); FRESH(); p9_router(F); } SEAM(9);
    if (IN(10)) for (int rep = 0; rep < NREP(10); ++rep) { if (rep) xcd_barrier(bar); FRESH(); p10_assign(F); } SEAM(10);

    if (IN(11)) {
        pg8::MoeSched S{(const char*)(ws + WS_H2F8), (const char*)(ws + WS_WEI), (const int*)(ws + WS_SLOT_TOK), F.MISC + MW_TSTART, DM / 2, 2048, 8, F.blk, STAG11};
        pg8::EpiSwiglu E{ws + WS_ACT8, F.in[18]};
        pg8::gemm_phase<pg8::EpiSwiglu, pg8::MoeSched, true, true>(F.lds, F.wave, DM / 2, S, E);
    } SEAM(11);

    if (IN(12)) {
        pg8::MoeSched S{(const char*)(ws + WS_ACT8), (const char*)(ws + WS_WEO), nullptr, F.MISC + MW_TSTART, DM / 2, DM, 4, F.blk, STAG12, TPROBE12};
        pg8::EpiY8 E{ws + WS_Y, F.in[20]};
        pg8::gemm_phase<pg8::EpiY8, pg8::MoeSched, true, true>(F.lds, F.wave, DM / 2, S, E);
    } SEAM(12);

    if (IN(13)) { FRESH(); p13_combine(F); }
#undef IN
#undef SEAM
}

extern "C" void kernel_launch(void* const* d_in, const int* in_sizes, int n_in, void* d_out, int out_size, void* d_ws, size_t ws_size, hipStream_t stream) {
    static int grid = 0;
    if (grid == 0) {
        if (n_in != 21 || in_sizes[0] != NTOK * DM || out_size != NTOK * DM || ws_size < WS_END) {
            fprintf(stderr, "kernel_launch: unexpected shapes: n_in %d in0 %d out %d ws %zu (need >= %zu); nothing launched\n", n_in, n_in > 0 ? in_sizes[0] : -1, out_size, ws_size, (size_t)WS_END); grid = -1; return; }
        int dev = 0, cus = 0, per_cu = 0;
        if (hipGetDevice(&dev) != hipSuccess || hipDeviceGetAttribute(&cus, hipDeviceAttributeMultiprocessorCount, dev) != hipSuccess) { fprintf(stderr, "kernel_launch: device query failed\n"); grid = -1; return; }
        if (hipFuncSetAttribute((const void*)fwd_kernel, hipFuncAttributeMaxDynamicSharedMemorySize, LDS_BYTES) != hipSuccess) { fprintf(stderr, "kernel_launch: hipFuncSetAttribute failed\n"); grid = -1; return; }
        if (hipOccupancyMaxActiveBlocksPerMultiprocessor(&per_cu, (const void*)fwd_kernel, NWAVES * 64, LDS_BYTES) != hipSuccess || per_cu < 1)
            fprintf(stderr, "kernel_launch: note: occupancy query reports %d workgroups per CU\n", per_cu);
        (void)hipGetLastError();
        grid = cus;
        if (grid != 256) { fprintf(stderr, "kernel_launch: this kernel is built for 256 CUs (got %d); nothing launched\n", grid); grid = -1; return; }
    }
    if (grid < 0) return;
    if (hipMemsetAsync((char*)d_ws + WS_CTL, 0, CTL_ZERO_BYTES, stream) != hipSuccess) { fprintf(stderr, "kernel_launch: hipMemsetAsync failed\n"); return; }
    Args a{};
    for (int i = 0; i < 21; ++i) a.in[i] = (const float*)d_in[i];
    a.out = (float*)d_out; a.ws = (unsigned char*)d_ws;
#if MK_ONE_LAUNCH
    const int cuts[2] = {0, N_PHASES}; const int nl = 1;
#else
    const int cuts[11] = {0, 1, 2, 3, 4, 5, 6, 7, 8, 9, N_PHASES}; const int nl = 10;
#endif
    for (int li = 0; li < nl; ++li) {
        a.ph_lo = cuts[li]; a.ph_hi = cuts[li + 1];
        hipLaunchKernelGGL(fwd_kernel, dim3(grid), dim3(NWAVES * 64), LDS_BYTES, stream, a);
        const hipError_t le = hipPeekAtLastError();
        if (le != hipSuccess) { fprintf(stderr, "kernel_launch: launch %d failed: %s\n", li, hipGetErrorName(le)); break; }
    }
}
```
